# Optimizing an MI355X kernel written in HIP

```python
import math
import jax, jax.numpy as jnp
from jax import lax
import numpy as np

D_MODEL = 1024
BATCH = 4
SEQ = 4096
DEPTH = 4

N_MIXERS = 4
EPS = 1e-6
NEG = -1e30
BIG = 1e30
T5_BUCKETS = 32
T5_MAX_DIST = 128
ATTN_HEADS = 16
HEAD_DIM = D_MODEL // ATTN_HEADS
KV_HEADS = 4
GQA = ATTN_HEADS // KV_HEADS
Q_BLOCK = 128
SWA_WINDOW = 128
RWKV_HEAD = 64
RWKV_HEADS = D_MODEL // RWKV_HEAD
RWKV_LORA_W = 64
RWKV_LORA_A = 64
RWKV_GN_EPS = 64e-5
NSA_CMP_LEN = 32
NSA_CMP_STRIDE = 16
NSA_CMP_HIDDEN = 128
NSA_SEL_LEN = 64
NSA_TOPK = 16
NSA_WINDOW = 512
NSA_SEL_QCHUNK = 64
LRU_WIDTH = 1280
LRU_BLOCKS = 16
LRU_BLOCK = LRU_WIDTH // LRU_BLOCKS
LRU_C = 8.0
CONV_WIDTH = 4

kernel_name = "hybrid_swa_rwkv7_nsa_rglru_trunk"


def _layers_of(m):
    return len(range(m, DEPTH, N_MIXERS))


def rms_norm(x, g):
    xf = x.astype(jnp.float32)
    y = xf * lax.rsqrt(jnp.mean(xf * xf, axis=-1, keepdims=True) + EPS)
    return (y * g.astype(jnp.float32)).astype(x.dtype)


def t5_bucket(dist):
    max_exact = T5_BUCKETS // 2
    d = jnp.maximum(dist, 0)
    df = jnp.maximum(d, 1).astype(jnp.float32)
    large = max_exact + (jnp.log(df / max_exact) / math.log(T5_MAX_DIST / max_exact)
                         * (T5_BUCKETS - max_exact)).astype(jnp.int32)
    large = jnp.minimum(large, T5_BUCKETS - 1)
    return jnp.where(d < max_exact, d, large)


def q_heads(t, B, T):
    return t.reshape(B, T, KV_HEADS, GQA, HEAD_DIM).transpose(0, 2, 3, 1, 4)


def kv_heads(t, B, T):
    return t.reshape(B, T, KV_HEADS, HEAD_DIM).transpose(0, 2, 1, 3)


def merge_heads(o, B, T):
    return o.transpose(0, 3, 1, 2, 4).reshape(B, T, ATTN_HEADS * HEAD_DIM)


def banded_attention(q, k, v, t5_table, window, sinks=None):
    B, G, R, T, Dh = q.shape
    nb = T // Q_BLOCK
    nprev = -(-window // Q_BLOCK)
    kc = (nprev + 1) * Q_BLOCK
    qb = q.reshape(B, G, R, nb, Q_BLOCK, Dh)
    pad = ((0, 0), (0, 0), (nprev * Q_BLOCK, 0), (0, 0))
    kp = jnp.pad(k, pad).reshape(B, G, nb + nprev, Q_BLOCK, Dh)
    vp = jnp.pad(v, pad).reshape(B, G, nb + nprev, Q_BLOCK, Dh)
    kb = jnp.concatenate([kp[:, :, j:j + nb] for j in range(nprev + 1)], axis=3)
    vb = jnp.concatenate([vp[:, :, j:j + nb] for j in range(nprev + 1)], axis=3)
    s = jnp.einsum('bgrnqd,bgnkd->bgrnqk', qb, kb,
                   preferred_element_type=jnp.float32) * (Dh ** -0.5)
    dist = nprev * Q_BLOCK + jnp.arange(Q_BLOCK)[:, None] - jnp.arange(kc)[None, :]
    kpos = (jnp.arange(nb)[:, None, None] - nprev) * Q_BLOCK + jnp.arange(kc)[None, None, :]
    valid = (dist >= 0) & (dist < window) & (kpos >= 0)
    bias = jnp.take(t5_table, t5_bucket(dist), axis=0)
    bias = jnp.moveaxis(bias, -1, 0).reshape(G, R, Q_BLOCK, kc).astype(jnp.float32)
    s = jnp.where(valid, s + bias[None, :, :, None], NEG)
    if sinks is None:
        p = jax.nn.softmax(s, axis=-1)
    else:
        sk = jnp.broadcast_to(sinks.astype(jnp.float32).reshape(1, G, R, 1, 1, 1), s.shape[:-1] + (1,))
        p = jax.nn.softmax(jnp.concatenate([s, sk], axis=-1), axis=-1)[..., :-1]
    o = jnp.einsum('bgrnqk,bgnkd->bgrnqd', p.astype(v.dtype), vb)
    return o.reshape(B, G, R, T, Dh)


def swa_sink_mixer(xn, w_in, sinks, w_out, t5_table):
    B, T, _ = xn.shape
    nq, nkv = ATTN_HEADS * HEAD_DIM, KV_HEADS * HEAD_DIM
    q, k, v, z = jnp.split(xn @ w_in, [nq, nq + nkv, nq + 2 * nkv], axis=-1)
    o = banded_attention(q_heads(q, B, T), kv_heads(k, B, T), kv_heads(v, B, T),
                         t5_table, SWA_WINDOW, sinks)
    return (merge_heads(o, B, T) * jax.nn.silu(z)) @ w_out


def rwkv7_mixer(xn, mu, w_in, w0, w1, w2, a0, a1, a2, k_k, k_a, r_k, lnx_w, lnx_b, w_out):
    B, T, D = xn.shape
    H, N = RWKV_HEADS, RWKV_HEAD
    C = H * N
    f32 = jnp.float32
    xx = jnp.pad(xn, ((0, 0), (1, 0), (0, 0)))[:, :-1] - xn
    lerp = xn[None] + xx[None] * mu[:, None, None, :]
    rkvz = jnp.einsum('sbtd,dsc->sbtc', lerp[:4], w_in.reshape(D, 4, C))
    r, k, v, z = rkvz[0], rkvz[1], rkvz[2], rkvz[3]
    w = -jax.nn.softplus(-(w0 + jnp.tanh(lerp[4] @ w1) @ w2)) - 0.5
    a = jax.nn.sigmoid(a0 + (lerp[5] @ a1) @ a2)
    hs = lambda t: t.astype(f32).reshape(B, T, H, N)
    kk = hs(k * k_k)
    kk = kk / jnp.maximum(jnp.sqrt(jnp.sum(kk * kk, axis=-1, keepdims=True)), 1e-12)
    k = hs(k * (1 + (a - 1) * k_a))
    r, v, a = hs(r), hs(v), hs(a)
    decay = jnp.exp(-jnp.exp(hs(w)))
    aa, bb = -kk, kk * a

    def step(S, inp):
        r_t, w_t, k_t, v_t, a_t, b_t = inp
        sa = jnp.einsum('bhij,bhj->bhi', S, a_t)
        S = S * w_t[:, :, None, :] + sa[..., None] * b_t[:, :, None, :] + v_t[..., None] * k_t[:, :, None, :]
        return S, jnp.einsum('bhij,bhj->bhi', S, r_t)

    xs = tuple(jnp.moveaxis(t, 1, 0) for t in (r, decay, k, v, aa, bb))
    _, y = lax.scan(step, jnp.zeros((B, H, N, N), f32), xs)
    y = jnp.moveaxis(y, 0, 1)
    mean = jnp.mean(y, axis=-1, keepdims=True)
    var = jnp.mean(jnp.square(y - mean), axis=-1, keepdims=True)
    y = ((y - mean) * lax.rsqrt(var + RWKV_GN_EPS)).reshape(B, T, C) * lnx_w.astype(f32) + lnx_b.astype(f32)
    bonus = jnp.sum(r * k * r_k.astype(f32), axis=-1, keepdims=True) * v
    y = (y + bonus.reshape(B, T, C)) * jax.nn.silu(z.astype(f32))
    return y.astype(xn.dtype) @ w_out


def nsa_mixer(xn, w_in, cmp_pos_k, cmp_k_w1, cmp_k_w2, cmp_pos_v, cmp_v_w1, cmp_v_w2, w_out, t5_table):
    B, T, _ = xn.shape
    G, R, Dh = KV_HEADS, GQA, HEAD_DIM
    f32 = jnp.float32
    nq, nkv = ATTN_HEADS * Dh, G * Dh
    splits = np.cumsum([nq] + [nkv] * 6 + [3 * ATTN_HEADS]).tolist()
    q, kc, vc, ks, vs, kw, vw, gates, z = jnp.split(xn @ w_in, splits, axis=-1)
    q = q_heads(q, B, T)
    kc, vc, ks, vs, kw, vw = (kv_heads(t, B, T) for t in (kc, vc, ks, vs, kw, vw))
    scale = Dh ** -0.5
    tpos = jnp.arange(T)

    n_cmp = (T - NSA_CMP_LEN) // NSA_CMP_STRIDE + 1
    tok_idx = np.arange(n_cmp)[:, None] * NSA_CMP_STRIDE + np.arange(NSA_CMP_LEN)[None, :]

    def compress(t, pos, w1, w2):
        blk = (t[:, :, tok_idx] + pos).reshape(B, G, n_cmp, NSA_CMP_LEN * Dh)
        return jax.nn.silu(blk @ w1) @ w2

    k_cmp = compress(kc, cmp_pos_k, cmp_k_w1, cmp_k_w2)
    v_cmp = compress(vc, cmp_pos_v, cmp_v_w1, cmp_v_w2)
    cmp_start = jnp.arange(n_cmp) * NSA_CMP_STRIDE
    cmp_end = cmp_start + NSA_CMP_LEN - 1
    cmp_ok = cmp_end[None, :] <= tpos[:, None]
    s_c = jnp.einsum('bgrtd,bgnd->bgrtn', q, k_cmp, preferred_element_type=f32) * scale
    p_c = jax.nn.softmax(jnp.where(cmp_ok, s_c, NEG), axis=-1) * cmp_ok
    o_cmp = jnp.einsum('bgrtn,bgnd->bgrtd', p_c.astype(v_cmp.dtype), v_cmp)

    n_sel = T // NSA_SEL_LEN
    k_top = min(NSA_TOPK, n_sel)
    sel_start = jnp.arange(n_sel) * NSA_SEL_LEN
    overlap = ((cmp_start[:, None] < sel_start[None, :] + NSA_SEL_LEN)
               & (cmp_end[:, None] >= sel_start[None, :])).astype(f32)
    imp = jnp.einsum('bgrtn,ns->bgts', p_c, overlap)
    blk = jnp.arange(n_sel)[None, :]
    cur = (tpos // NSA_SEL_LEN)[:, None]
    forced = (blk == 0) | (blk == cur) | (blk == cur - 1)
    future = sel_start[None, :] > tpos[:, None]
    imp = jnp.where(forced, BIG, jnp.where(future, NEG, imp))
    _, sel_idx = lax.top_k(imp, k_top)

    ks_blk = ks.reshape(B, G, n_sel, NSA_SEL_LEN, Dh)
    vs_blk = vs.reshape(B, G, n_sel, NSA_SEL_LEN, Dh)
    QC = NSA_SEL_QCHUNK
    nch = T // QC
    q_ch = jnp.moveaxis(q.reshape(B, G, R, nch, QC, Dh), 3, 0)
    idx_ch = jnp.moveaxis(sel_idx.reshape(B, G, nch, QC, k_top), 2, 0)
    pos_ch = tpos.reshape(nch, QC)
    bi = jnp.arange(B)[:, None, None, None]
    gi = jnp.arange(G)[None, :, None, None]
    gi5 = jnp.arange(G)[None, :, None, None, None]
    table_g = t5_table.reshape(T5_BUCKETS, G, R)

    def sel_chunk(args):
        qc, ic, pc = args
        kg = ks_blk[bi, gi, ic]
        vg = vs_blk[bi, gi, ic]
        kpos = ic[..., None] * NSA_SEL_LEN + jnp.arange(NSA_SEL_LEN)
        dist = pc[None, None, :, None, None] - kpos
        s = jnp.einsum('bgrqd,bgqskd->bgrqsk', qc, kg, preferred_element_type=f32) * scale
        bias = jnp.moveaxis(table_g[t5_bucket(dist), gi5], -1, 2).astype(f32)
        s = jnp.where((dist >= 0)[:, :, None], s + bias, NEG)
        p = jax.nn.softmax(s.reshape(B, G, R, QC, k_top * NSA_SEL_LEN), axis=-1)
        p = p.reshape(B, G, R, QC, k_top, NSA_SEL_LEN)
        return jnp.einsum('bgrqsk,bgqskd->bgrqd', p.astype(vg.dtype), vg)

    o_sel = lax.map(sel_chunk, (q_ch, idx_ch, pos_ch))
    o_sel = jnp.moveaxis(o_sel, 0, 3).reshape(B, G, R, T, Dh)

    o_win = banded_attention(q, kw, vw, t5_table, NSA_WINDOW)

    g = jax.nn.sigmoid(gates).reshape(B, T, 3, G, R).transpose(2, 0, 3, 4, 1)[..., None]
    o = g[0] * o_cmp + g[1] * o_sel + g[2] * o_win
    return (merge_heads(o, B, T) * jax.nn.silu(z)) @ w_out


def rglru_mixer(xn, w_in, conv_w, conv_b, gate_a_w, gate_a_b, gate_x_w, gate_x_b, lam, w_out):
    B, T, _ = xn.shape
    f32 = jnp.float32
    u, z = jnp.split(xn @ w_in, 2, axis=-1)
    u = lax.conv_general_dilated(u, conv_w[:, None, :], window_strides=(1,),
                                 padding=[(CONV_WIDTH - 1, 0)],
                                 dimension_numbers=('NWC', 'WIO', 'NWC'),
                                 feature_group_count=LRU_WIDTH) + conv_b
    ub = u.reshape(B, T, LRU_BLOCKS, LRU_BLOCK)
    r = jax.nn.sigmoid(jnp.einsum('btnc,ncd->btnd', ub, gate_a_w).reshape(B, T, LRU_WIDTH) + gate_a_b)
    i = jax.nn.sigmoid(jnp.einsum('btnc,ncd->btnd', ub, gate_x_w).reshape(B, T, LRU_WIDTH) + gate_x_b)
    log_a = -LRU_C * r.astype(f32) * jax.nn.softplus(-lam.astype(f32))
    a = jnp.exp(log_a)
    b = jnp.sqrt(-jnp.expm1(2.0 * log_a)) * (i * u).astype(f32)

    def combine(left, right):
        a1, b1 = left
        a2, b2 = right
        return a1 * a2, a2 * b1 + b2

    _, h = lax.associative_scan(combine, (a, b), axis=1)
    return (h.astype(xn.dtype) * jax.nn.silu(z)) @ w_out


def setup_inputs(seed: int = 0) -> dict:
    key = jax.random.key(seed)
    keys = iter(jax.random.split(key, 64))
    f32 = jnp.float32

    def nrm(shape, scale):
        return jax.random.normal(next(keys), shape, f32) * scale

    def dense(shape):
        return nrm(shape, shape[-2] ** -0.5)

    def unif(shape, lo, hi):
        return jax.random.uniform(next(keys), shape, f32, lo, hi)

    LA, LB, LC, LD = (_layers_of(m) for m in range(N_MIXERS))
    C = RWKV_HEADS * RWKV_HEAD
    nq, nkv = ATTN_HEADS * HEAD_DIM, KV_HEADS * HEAD_DIM
    a_cols = 2 * nq + 2 * nkv
    c_cols = 2 * nq + 6 * nkv + 3 * ATTN_HEADS
    lam_u = unif((LD, LRU_WIDTH), 0.9, 0.999)
    return {
        "x": nrm((BATCH, SEQ, D_MODEL), 1.0),
        "t5_table": nrm((T5_BUCKETS, ATTN_HEADS), 0.5),
        "norm_g": 1.0 + nrm((DEPTH, D_MODEL), 0.05),
        "final_g": 1.0 + nrm((D_MODEL,), 0.05),
        "a_w_in": dense((LA, D_MODEL, a_cols)),
        "a_sinks": nrm((LA, ATTN_HEADS), 0.5),
        "a_w_out": dense((LA, nq, D_MODEL)),
        "b_mu": unif((LB, 6, D_MODEL), 0.0, 1.0),
        "b_w_in": dense((LB, D_MODEL, 4 * C)),
        "b_w0": unif((LB, C), -6.0, 0.0),
        "b_w1": dense((LB, D_MODEL, RWKV_LORA_W)),
        "b_w2": dense((LB, RWKV_LORA_W, C)),
        "b_a0": nrm((LB, C), 0.5),
        "b_a1": dense((LB, D_MODEL, RWKV_LORA_A)),
        "b_a2": dense((LB, RWKV_LORA_A, C)),
        "b_k_k": 0.85 + nrm((LB, C), 0.1),
        "b_k_a": 1.0 + nrm((LB, C), 0.1),
        "b_r_k": nrm((LB, RWKV_HEADS, RWKV_HEAD), 0.1),
        "b_lnx_w": 1.0 + nrm((LB, C), 0.05),
        "b_lnx_b": nrm((LB, C), 0.01),
        "b_w_out": dense((LB, C, D_MODEL)),
        "c_w_in": dense((LC, D_MODEL, c_cols)),
        "c_cmp_pos_k": nrm((LC, NSA_CMP_LEN, HEAD_DIM), 0.1),
        "c_cmp_k_w1": dense((LC, NSA_CMP_LEN * HEAD_DIM, NSA_CMP_HIDDEN)),
        "c_cmp_k_w2": dense((LC, NSA_CMP_HIDDEN, HEAD_DIM)),
        "c_cmp_pos_v": nrm((LC, NSA_CMP_LEN, HEAD_DIM), 0.1),
        "c_cmp_v_w1": dense((LC, NSA_CMP_LEN * HEAD_DIM, NSA_CMP_HIDDEN)),
        "c_cmp_v_w2": dense((LC, NSA_CMP_HIDDEN, HEAD_DIM)),
        "c_w_out": dense((LC, nq, D_MODEL)),
        "d_w_in": dense((LD, D_MODEL, 2 * LRU_WIDTH)),
        "d_conv_w": nrm((LD, CONV_WIDTH, LRU_WIDTH), CONV_WIDTH ** -0.5),
        "d_conv_b": nrm((LD, LRU_WIDTH), 0.01),
        "d_gate_a_w": dense((LD, LRU_BLOCKS, LRU_BLOCK, LRU_BLOCK)),
        "d_gate_a_b": nrm((LD, LRU_WIDTH), 0.01),
        "d_gate_x_w": dense((LD, LRU_BLOCKS, LRU_BLOCK, LRU_BLOCK)),
        "d_gate_x_b": nrm((LD, LRU_WIDTH), 0.01),
        "d_lambda": jnp.log(lam_u) - jnp.log1p(-lam_u),
        "d_w_out": dense((LD, LRU_WIDTH, D_MODEL)),
    }


def reference(x, t5_table, norm_g, final_g,
              a_w_in, a_sinks, a_w_out,
              b_mu, b_w_in, b_w0, b_w1, b_w2, b_a0, b_a1, b_a2, b_k_k, b_k_a, b_r_k,
              b_lnx_w, b_lnx_b, b_w_out,
              c_w_in, c_cmp_pos_k, c_cmp_k_w1, c_cmp_k_w2, c_cmp_pos_v, c_cmp_v_w1, c_cmp_v_w2, c_w_out,
              d_w_in, d_conv_w, d_conv_b, d_gate_a_w, d_gate_a_b, d_gate_x_w, d_gate_x_b,
              d_lambda, d_w_out):
    for layer in range(DEPTH):
        m, j = layer % N_MIXERS, layer // N_MIXERS
        xn = rms_norm(x, norm_g[layer])
        if m == 0:
            y = swa_sink_mixer(xn, a_w_in[j], a_sinks[j], a_w_out[j], t5_table)
        elif m == 1:
            y = rwkv7_mixer(xn, b_mu[j], b_w_in[j], b_w0[j], b_w1[j], b_w2[j], b_a0[j], b_a1[j],
                            b_a2[j], b_k_k[j], b_k_a[j], b_r_k[j], b_lnx_w[j], b_lnx_b[j], b_w_out[j])
        elif m == 2:
            y = nsa_mixer(xn, c_w_in[j], c_cmp_pos_k[j], c_cmp_k_w1[j], c_cmp_k_w2[j],
                          c_cmp_pos_v[j], c_cmp_v_w1[j], c_cmp_v_w2[j], c_w_out[j], t5_table)
        else:
            y = rglru_mixer(xn, d_w_in[j], d_conv_w[j], d_conv_b[j], d_gate_a_w[j], d_gate_a_b[j],
                            d_gate_x_w[j], d_gate_x_b[j], d_lambda[j], d_w_out[j])
        x = x + y.astype(x.dtype)
    return rms_norm(x, final_g)
```

```cpp
#ifndef CPU_SHIM
#include <hip/hip_runtime.h>
#include <hip/hip_cooperative_groups.h>
#include <cstdio>
#define HD __host__ __device__ __forceinline__
#else
#include <cmath>
#include <cstring>
#include <cstdio>
#include <cstdlib>
#include <cstdint>
#define HD inline
typedef void* hipStream_t;
#endif
#include <cstddef>

#ifndef CFG_B
#define CFG_B 4
#endif
#ifndef CFG_T
#define CFG_T 4096
#endif

namespace cfg {
constexpr int B = CFG_B, T = CFG_T, M = B * T, D = 1024;
constexpr int H = 16, G = 4, R = 4, DH = 64;
constexpr int A_COLS = 2560;
constexpr int C_COLS = 3632;
constexpr int NCMP = (T - 32) / 16 + 1;
constexpr int NSEL = T / 64;
constexpr int KTOP = NSEL < 16 ? NSEL : 16;
constexpr int LW = 1280;
}
using namespace cfg;

typedef unsigned short bf16;

HD unsigned f_as_u(float f) {
#ifndef CPU_SHIM
    return __float_as_uint(f);
#else
    unsigned u; memcpy(&u, &f, 4); return u;
#endif
}
HD float u_as_f(unsigned u) {
#ifndef CPU_SHIM
    return __uint_as_float(u);
#else
    float f; memcpy(&f, &u, 4); return f;
#endif
}
HD float bf2f(bf16 v) { return u_as_f(((unsigned)v) << 16); }
HD bf16 f2bf(float f) { unsigned u = f_as_u(f); u += 0x7fffu + ((u >> 16) & 1u); return (bf16)(u >> 16); }
HD float sigmoidf_(float x) { return 1.0f / (1.0f + expf(-x)); }
HD float siluf_(float x) { return x / (1.0f + expf(-x)); }
HD float softplusf_(float x) { return x > 20.f ? x : log1pf(expf(x)); }

HD int t5_bucket(int d) {
    if (d < 16) return d < 0 ? 0 : d;
    if (d >= 113) return 31;
    if (d >= 99) return 30;
    if (d >= 87) return 29;
    if (d >= 77) return 28;
    if (d >= 67) return 27;
    if (d >= 59) return 26;
    if (d >= 52) return 25;
    if (d >= 46) return 24;
    if (d >= 40) return 23;
    if (d >= 35) return 22;
    if (d >= 31) return 21;
    if (d >= 27) return 20;
    if (d >= 24) return 19;
    if (d >= 21) return 18;
    if (d >= 19) return 17;
    return 16;
}

struct Params {
    const float *x, *t5, *norm_g, *final_g;
    const float *a_w_in, *a_sinks, *a_w_out;
    const float *b_mu, *b_w_in, *b_w0, *b_w1, *b_w2, *b_a0, *b_a1, *b_a2, *b_k_k, *b_k_a, *b_r_k, *b_lnx_w, *b_lnx_b, *b_w_out;
    const float *c_w_in, *c_pos_k, *c_k_w1, *c_k_w2, *c_pos_v, *c_v_w1, *c_v_w2, *c_w_out;
    const float *d_w_in, *d_conv_w, *d_conv_b, *d_ga_w, *d_ga_b, *d_gx_w, *d_gx_b, *d_lambda, *d_w_out;
    float* out;
    char* ws;
};

namespace wsl {
constexpr size_t MB = 1024 * 1024;
constexpr size_t RS = 0;
constexpr size_t HK = 1 * MB;
constexpr size_t HV = 3 * MB;
constexpr size_t KC = 5 * MB;
constexpr size_t VC = 6 * MB;
constexpr size_t ST = 7 * MB;
constexpr size_t SEL = 9 * MB;
constexpr size_t LHW = 1 * MB;
constexpr size_t LHA = 5 * MB;
constexpr size_t P = 14 * MB;
constexpr size_t SZ1024 = (size_t)M * 1024 * 2, SZ1280 = (size_t)M * 1280 * 2;
constexpr size_t L0_AO = P + (size_t)M * 2560 * 2;
constexpr size_t L1_XN = P + (size_t)M * 4096 * 2, L1_WL = L1_XN + SZ1024, L1_AV = L1_WL + SZ1024;
constexpr size_t L2_AO = P + (size_t)M * 3632 * 2, L2_OC = L2_AO + SZ1024, L2_OS = L2_OC + SZ1024, L2_IMP = L2_OS + SZ1024;
constexpr size_t L3_AO = P + (size_t)M * 2560 * 2, L3_UC = L3_AO + SZ1280, L3_LA = L3_UC + SZ1280, L3_BV = L3_LA + SZ1280;
constexpr size_t TOTAL = L3_BV + SZ1280;
}

struct RstdF {
    const float* x; float* rs;
    HD void operator()(long m) const {
        const float* r = x + (size_t)m * D; float s = 0.f;
        for (int k = 0; k < D; ++k) s += r[k] * r[k];
        rs[m] = 1.0f / sqrtf(s / D + 1e-6f);
    }
};
struct XnF {
    const float* x; const float* rs; const float* g; bf16* xn;
    HD void operator()(long i) const { long m = i / D; int k = (int)(i % D); xn[i] = f2bf(x[i] * rs[m] * g[k]); }
};
struct GemmInF {
    const float *x, *rs, *g, *W; bf16* P; long long N;
    HD void operator()(long i) const {
        const int n4 = (int)N / 4; const long m = i / n4; const int n = (int)(i % n4) * 4;
        const float* xr = x + (size_t)m * D; const float r = rs[m];
        float a0 = 0, a1 = 0, a2 = 0, a3 = 0;
        for (int k = 0; k < D; ++k) {
            const float a = xr[k] * r * g[k]; const float* w = W + (size_t)k * N + n;
            a0 += a * w[0]; a1 += a * w[1]; a2 += a * w[2]; a3 += a * w[3];
        }
        bf16* p = P + (size_t)m * N + n; p[0] = f2bf(a0); p[1] = f2bf(a1); p[2] = f2bf(a2); p[3] = f2bf(a3);
    }
};
struct GemmOutF {
    const bf16* A; const float* W; const float* xin; float* xout; long long K;
    HD void operator()(long i) const {
        const int n4 = D / 4; const long m = i / n4; const int n = (int)(i % n4) * 4;
        const bf16* ar = A + (size_t)m * K;
        float a0 = 0, a1 = 0, a2 = 0, a3 = 0;
        for (int k = 0; k < K; ++k) {
            const float a = bf2f(ar[k]); const float* w = W + (size_t)k * D + n;
            a0 += a * w[0]; a1 += a * w[1]; a2 += a * w[2]; a3 += a * w[3];
        }
        const float* xi = xin + (size_t)m * D + n; float* xo = xout + (size_t)m * D + n;
        xo[0] = xi[0] + a0; xo[1] = xi[1] + a1; xo[2] = xi[2] + a2; xo[3] = xi[3] + a3;
    }
};

struct SwaF {
    const bf16* P; const float* t5; const float* sinks; bf16* AO;
    HD void operator()(long i) const {
        const long m = i / H; const int h = (int)(i % H), g = h / R; const int t = (int)(m % T); const long mb = m - t;
        float q[DH], o[DH];
#pragma unroll
        for (int d = 0; d < DH; ++d) { q[d] = bf2f(P[(size_t)m * A_COLS + h * DH + d]); o[d] = 0.f; }
        float mx = sinks[h], l = 1.0f;
        const int s0 = t - 127 < 0 ? 0 : t - 127;
        for (int s = s0; s <= t; ++s) {
            const bf16* kr = P + (size_t)(mb + s) * A_COLS + 1024 + g * DH;
            const bf16* vr = kr + 256;
            float sc = 0.f;
#pragma unroll
            for (int d = 0; d < DH; ++d) sc += q[d] * bf2f(kr[d]);
            sc = sc * 0.125f + t5[t5_bucket(t - s) * H + h];
            const float mn = sc > mx ? sc : mx; const float al = expf(mx - mn), p = expf(sc - mn);
            l = l * al + p; mx = mn;
#pragma unroll
            for (int d = 0; d < DH; ++d) o[d] = o[d] * al + p * bf2f(vr[d]);
        }
        const float il = 1.0f / l;
#pragma unroll
        for (int d = 0; d < DH; ++d) {
            const float z = bf2f(P[(size_t)m * A_COLS + 1536 + h * DH + d]);
            AO[(size_t)m * D + h * DH + d] = f2bf(o[d] * il * siluf_(z));
        }
    }
};

struct GemmRwkvF {
    const bf16* xn; const float* mu; const float* W; bf16* P;
    HD void operator()(long i) const {
        const int N = 4096, n4 = N / 4; const long m = i / n4; const int n = (int)(i % n4) * 4; const int s = n / 1024;
        const int t = (int)(m % T);
        const bf16* xr = xn + (size_t)m * D; const float* mus = mu + s * D;
        float a0 = 0, a1 = 0, a2 = 0, a3 = 0;
        for (int k = 0; k < D; ++k) {
            const float xc = bf2f(xr[k]); const float xp = t > 0 ? bf2f(xr[k - D]) : 0.f;
            const float a = xc + (xp - xc) * mus[k]; const float* w = W + (size_t)k * N + n;
            a0 += a * w[0]; a1 += a * w[1]; a2 += a * w[2]; a3 += a * w[3];
        }
        bf16* p = P + (size_t)m * N + n; p[0] = f2bf(a0); p[1] = f2bf(a1); p[2] = f2bf(a2); p[3] = f2bf(a3);
    }
};
struct LoraHidF {
    const bf16* xn; const float* mu; const float* w1; const float* a1; float* hw; float* ha;
    HD void operator()(long i) const {
        const long m = i / 128; const int jj = (int)(i % 128); const int which = jj / 64, j = jj % 64; const int t = (int)(m % T);
        const bf16* xr = xn + (size_t)m * D; const float* mus = mu + (4 + which) * D; const float* W = which ? a1 : w1;
        float acc = 0.f;
        for (int k = 0; k < D; ++k) {
            const float xc = bf2f(xr[k]); const float xp = t > 0 ? bf2f(xr[k - D]) : 0.f;
            acc += (xc + (xp - xc) * mus[k]) * W[(size_t)k * 64 + j];
        }
        if (which) ha[(size_t)m * 64 + j] = acc; else hw[(size_t)m * 64 + j] = tanhf(acc);
    }
};
struct LoraOutF {
    const float *hw, *ha, *w0, *w2, *a0, *a2; bf16* wlog; bf16* av;
    HD void operator()(long i) const {
        const long m = i / D; const int c = (int)(i % D);
        float sw = 0.f, sa = 0.f;
        for (int j = 0; j < 64; ++j) { sw += hw[(size_t)m * 64 + j] * w2[(size_t)j * D + c]; sa += ha[(size_t)m * 64 + j] * a2[(size_t)j * D + c]; }
        const float wr = -softplusf_(-(w0[c] + sw)) - 0.5f;
        wlog[i] = f2bf(-expf(wr)); av[i] = f2bf(sigmoidf_(a0[c] + sa));
    }
};
struct RwkvScanF {
    const bf16* P; const bf16* wlog; const bf16* av; const float* k_k; const float* k_a; bf16* ys;
    HD void operator()(long idx) const {
        const int i = (int)(idx % 64); const int h = (int)((idx / 64) % H); const int b = (int)(idx / (64 * H));
        float S[64];
#pragma unroll
        for (int j = 0; j < 64; ++j) S[j] = 0.f;
        for (int t = 0; t < T; ++t) {
            const size_t m = (size_t)b * T + t; const bf16* pr = P + m * 4096 + h * 64;
            const bf16* wl = wlog + m * D + h * 64; const bf16* ar = av + m * D + h * 64;
            float n2 = 0.f;
#pragma unroll
            for (int j = 0; j < 64; ++j) { const float kk = bf2f(pr[1024 + j]) * k_k[h * 64 + j]; n2 += kk * kk; }
            float nr = sqrtf(n2); nr = nr > 1e-12f ? nr : 1e-12f; const float inr = 1.0f / nr;
            float sa = 0.f;
#pragma unroll
            for (int j = 0; j < 64; ++j) { const float kk = bf2f(pr[1024 + j]) * k_k[h * 64 + j] * inr; sa += S[j] * (-kk); }
            const float vi = bf2f(pr[2048 + i]); float y = 0.f;
#pragma unroll
            for (int j = 0; j < 64; ++j) {
                const float kr = bf2f(pr[1024 + j]); const float a = bf2f(ar[j]);
                const float kk = kr * k_k[h * 64 + j] * inr; const float kp = kr * (1.0f + (a - 1.0f) * k_a[h * 64 + j]);
                const float dec = expf(bf2f(wl[j]));
                S[j] = S[j] * dec + sa * (kk * a) + vi * kp;
                y += S[j] * bf2f(pr[j]);
            }
            ys[m * D + h * 64 + i] = f2bf(y);
        }
    }
};
struct RwkvGnF {
    const bf16* P; const bf16* av; const float *k_a, *r_k, *lnx_w, *lnx_b; bf16* ys;
    HD void operator()(long idx) const {
        const long m = idx / H; const int h = (int)(idx % H);
        bf16* yr = ys + (size_t)m * D + h * 64; const bf16* pr = P + (size_t)m * 4096 + h * 64; const bf16* ar = av + (size_t)m * D + h * 64;
        float mean = 0.f;
        for (int j = 0; j < 64; ++j) mean += bf2f(yr[j]);
        mean /= 64.f; float var = 0.f;
        for (int j = 0; j < 64; ++j) { const float d = bf2f(yr[j]) - mean; var += d * d; }
        var /= 64.f; const float rstd = 1.0f / sqrtf(var + 64e-5f);
        float bs = 0.f;
        for (int j = 0; j < 64; ++j) { const float kr = bf2f(pr[1024 + j]); const float kp = kr * (1.0f + (bf2f(ar[j]) - 1.0f) * k_a[h * 64 + j]); bs += bf2f(pr[j]) * kp * r_k[h * 64 + j]; }
        for (int j = 0; j < 64; ++j) {
            const float yn = (bf2f(yr[j]) - mean) * rstd * lnx_w[h * 64 + j] + lnx_b[h * 64 + j];
            const float z = bf2f(pr[3072 + j]);
            yr[j] = f2bf((yn + bs * bf2f(pr[2048 + j])) * siluf_(z));
        }
    }
};

struct CmpHidF {
    const bf16* P; const float *pos_k, *w1_k, *pos_v, *w1_v; float* hk; float* hv;
    HD void operator()(long idx) const {
        const int j = (int)(idx % 128); long r = idx / 128; const int n = (int)(r % NCMP); r /= NCMP; const int g = (int)(r % G); r /= G;
        const int b = (int)(r % B); const int which = (int)(r / B);
        const float* pos = which ? pos_v : pos_k; const float* w1 = which ? w1_v : w1_k; const int col = 1024 + (which ? 256 : 0) + g * 64;
        float acc = 0.f;
        for (int l = 0; l < 32; ++l) {
            const bf16* src = P + (size_t)(b * T + 16 * n + l) * C_COLS + col;
            for (int d = 0; d < 64; ++d) acc += (bf2f(src[d]) + pos[l * 64 + d]) * w1[(size_t)(l * 64 + d) * 128 + j];
        }
        (which ? hv : hk)[(((size_t)b * G + g) * NCMP + n) * 128 + j] = siluf_(acc);
    }
};
struct CmpOutF {
    const float *hk, *hv, *w2_k, *w2_v; float* kc; float* vc;
    HD void operator()(long idx) const {
        const int d = (int)(idx % 64); long r = idx / 64; const long row = r % ((long)B * G * NCMP); const int which = (int)(r / ((long)B * G * NCMP));
        const float* hsrc = (which ? hv : hk) + (size_t)row * 128; const float* w2 = which ? w2_v : w2_k;
        float acc = 0.f;
        for (int j = 0; j < 128; ++j) acc += hsrc[j] * w2[j * 64 + d];
        (which ? vc : kc)[(size_t)row * 64 + d] = acc;
    }
};
struct CmpAttnF {
    const bf16* P; const float *kc, *vc; float* st; bf16* oc;
    HD void operator()(long i) const {
        const long m = i / H; const int h = (int)(i % H), g = h / R; const int t = (int)(m % T); const int b = (int)(m / T);
        float q[DH], o[DH];
#pragma unroll
        for (int d = 0; d < DH; ++d) { q[d] = bf2f(P[(size_t)m * C_COLS + h * DH + d]); o[d] = 0.f; }
        const int nv = t < 31 ? 0 : (t - 31) / 16 + 1;
        float mx = -1e30f, l = 0.f;
        for (int n = 0; n < nv; ++n) {
            const float* kr = kc + (((size_t)b * G + g) * NCMP + n) * 64; const float* vr = vc + (((size_t)b * G + g) * NCMP + n) * 64;
            float sc = 0.f;
#pragma unroll
            for (int d = 0; d < DH; ++d) sc += q[d] * kr[d];
            sc *= 0.125f;
            const float mn = sc > mx ? sc : mx; const float al = expf(mx - mn), p = expf(sc - mn);
            l = l * al + p; mx = mn;
#pragma unroll
            for (int d = 0; d < DH; ++d) o[d] = o[d] * al + p * vr[d];
        }
        const float il = nv > 0 ? 1.0f / l : 0.f;
        st[(size_t)i * 2] = mx; st[(size_t)i * 2 + 1] = il;
#pragma unroll
        for (int d = 0; d < DH; ++d) oc[(size_t)m * D + h * DH + d] = f2bf(o[d] * il);
    }
};
struct ImpF {
    const bf16* P; const float *kc, *st; float* imp;
    HD void operator()(long idx) const {
        const int s = (int)(idx % NSEL); long r = idx / NSEL; const int g = (int)(r % G); const long m = r / G;
        const int t = (int)(m % T); const int b = (int)(m / T); const int cur = t / 64;
        float v;
        if (s == 0 || s == cur || s == cur - 1) v = 1e30f;
        else if (s * 64 > t) v = -1e30f;
        else {
            v = 0.f; const int nv = t < 31 ? 0 : (t - 31) / 16 + 1;
            int n0 = 4 * s - 1; if (n0 < 0) n0 = 0; int n1 = 4 * s + 3; if (n1 > NCMP - 1) n1 = NCMP - 1; if (n1 > nv - 1) n1 = nv - 1;
            for (int rr = 0; rr < R; ++rr) {
                const int h = g * R + rr; const bf16* qr = P + (size_t)m * C_COLS + h * DH;
                const float mx = st[((size_t)m * H + h) * 2], il = st[((size_t)m * H + h) * 2 + 1];
                for (int n = n0; n <= n1; ++n) {
                    const float* kr = kc + (((size_t)b * G + g) * NCMP + n) * 64; float sc = 0.f;
                    for (int d = 0; d < DH; ++d) sc += bf2f(qr[d]) * kr[d];
                    v += expf(sc * 0.125f - mx) * il;
                }
            }
        }
        imp[idx] = v;
    }
};
struct TopkF {
    const float* imp; int* sel;
    HD void operator()(long idx) const {
        const float* v = imp + (size_t)idx * NSEL; unsigned long long used = 0ull;
        for (int j = 0; j < KTOP; ++j) {
            int best = -1; float bv = 0.f;
            for (int s = 0; s < NSEL; ++s) { if ((used >> s) & 1ull) continue; const float x = v[s]; if (best < 0 || x > bv) { best = s; bv = x; } }
            used |= 1ull << best; sel[(size_t)idx * 16 + j] = best;
        }
    }
};
struct SelAttnF {
    const bf16* P; const float* t5; const int* sel; bf16* os;
    HD void operator()(long i) const {
        const long m = i / H; const int h = (int)(i % H), g = h / R; const int t = (int)(m % T); const long mb = m - t;
        float q[DH], o[DH];
#pragma unroll
        for (int d = 0; d < DH; ++d) { q[d] = bf2f(P[(size_t)m * C_COLS + h * DH + d]); o[d] = 0.f; }
        float mx = -1e30f, l = 0.f;
        for (int j = 0; j < KTOP; ++j) {
            const int blk = sel[((size_t)m * G + g) * 16 + j];
            for (int ll = 0; ll < 64; ++ll) {
                const int s = blk * 64 + ll; if (s > t) break;
                const bf16* kr = P + (size_t)(mb + s) * C_COLS + 1536 + g * DH; const bf16* vr = kr + 256;
                float sc = 0.f;
#pragma unroll
                for (int d = 0; d < DH; ++d) sc += q[d] * bf2f(kr[d]);
                sc = sc * 0.125f + t5[t5_bucket(t - s) * H + h];
                const float mn = sc > mx ? sc : mx; const float al = expf(mx - mn), p = expf(sc - mn);
                l = l * al + p; mx = mn;
#pragma unroll
                for (int d = 0; d < DH; ++d) o[d] = o[d] * al + p * bf2f(vr[d]);
            }
        }
        const float il = 1.0f / l;
#pragma unroll
        for (int d = 0; d < DH; ++d) os[(size_t)m * D + h * DH + d] = f2bf(o[d] * il);
    }
};
struct WinAttnF {
    const bf16* P; const float* t5; const bf16* oc; const bf16* os; bf16* AO;
    HD void operator()(long i) const {
        const long m = i / H; const int h = (int)(i % H), g = h / R, rr = h % R; const int t = (int)(m % T); const long mb = m - t;
        float q[DH], o[DH];
#pragma unroll
        for (int d = 0; d < DH; ++d) { q[d] = bf2f(P[(size_t)m * C_COLS + h * DH + d]); o[d] = 0.f; }
        float mx = -1e30f, l = 0.f;
        const int s0 = t - 511 < 0 ? 0 : t - 511;
        for (int s = s0; s <= t; ++s) {
            const bf16* kr = P + (size_t)(mb + s) * C_COLS + 2048 + g * DH; const bf16* vr = kr + 256;
            float sc = 0.f;
#pragma unroll
            for (int d = 0; d < DH; ++d) sc += q[d] * bf2f(kr[d]);
            sc = sc * 0.125f + t5[t5_bucket(t - s) * H + h];
            const float mn = sc > mx ? sc : mx; const float al = expf(mx - mn), p = expf(sc - mn);
            l = l * al + p; mx = mn;
#pragma unroll
            for (int d = 0; d < DH; ++d) o[d] = o[d] * al + p * bf2f(vr[d]);
        }
        const float il = 1.0f / l;
        const bf16* gr = P + (size_t)m * C_COLS + 2560;
        const float g0 = sigmoidf_(bf2f(gr[0 * 16 + g * R + rr])), g1 = sigmoidf_(bf2f(gr[1 * 16 + g * R + rr])), g2 = sigmoidf_(bf2f(gr[2 * 16 + g * R + rr]));
#pragma unroll
        for (int d = 0; d < DH; ++d) {
            const size_t oi = (size_t)m * D + h * DH + d;
            const float z = bf2f(P[(size_t)m * C_COLS + 2608 + h * DH + d]);
            AO[oi] = f2bf((g0 * bf2f(oc[oi]) + g1 * bf2f(os[oi]) + g2 * o[d] * il) * siluf_(z));
        }
    }
};

struct ConvF {
    const bf16* P; const float *cw, *cb; bf16* uc;
    HD void operator()(long i) const {
        const long m = i / LW; const int c = (int)(i % LW); const int t = (int)(m % T);
        float acc = cb[c];
        for (int w = 0; w < 4; ++w) { const int tt = t - 3 + w; if (tt >= 0) acc += cw[w * LW + c] * bf2f(P[(size_t)(m - 3 + w) * 2560 + c]); }
        uc[i] = f2bf(acc);
    }
};
struct LruGateF {
    const bf16* uc; const float *gaw, *gab, *gxw, *gxb, *lam; bf16* la; bf16* bv;
    HD void operator()(long i) const {
        const long m = i / LW; const int c = (int)(i % LW); const int n = c / 80, d = c % 80;
        const bf16* ub = uc + (size_t)m * LW + n * 80; float ra = gab[c], rx = gxb[c];
        for (int k = 0; k < 80; ++k) { const float u = bf2f(ub[k]); ra += u * gaw[((size_t)n * 80 + k) * 80 + d]; rx += u * gxw[((size_t)n * 80 + k) * 80 + d]; }
        const float r = sigmoidf_(ra), ig = sigmoidf_(rx);
        const float loga = -8.0f * r * softplusf_(-lam[c]);
        la[i] = f2bf(loga);
        bv[i] = f2bf(sqrtf(-expm1f(2.0f * loga)) * (ig * bf2f(uc[i])));
    }
};
struct LruScanF {
    const bf16* P; const bf16* la; const bf16* bv; bf16* AO;
    HD void operator()(long idx) const {
        const int c = (int)(idx % LW); const int b = (int)(idx / LW); float h = 0.f;
        for (int t = 0; t < T; ++t) {
            const size_t m = (size_t)b * T + t;
            h = expf(bf2f(la[m * LW + c])) * h + bf2f(bv[m * LW + c]);
            AO[m * LW + c] = f2bf(h * siluf_(bf2f(P[m * 2560 + LW + c])));
        }
    }
};
struct FinalNormF {
    float* x; const float* g;
    HD void operator()(long m) const {
        float* r = x + (size_t)m * D; float s = 0.f;
        for (int k = 0; k < D; ++k) s += r[k] * r[k];
        const float rs = 1.0f / sqrtf(s / D + 1e-6f);
        for (int k = 0; k < D; ++k) r[k] = r[k] * rs * g[k];
    }
};


#ifndef CPU_SHIM
typedef short bf16x8 __attribute__((ext_vector_type(8)));
typedef float f32x4 __attribute__((ext_vector_type(4)));
typedef unsigned u32x4 __attribute__((ext_vector_type(4)));
typedef unsigned u32x2 __attribute__((ext_vector_type(2)));
#define DI __device__ __forceinline__
#define NTHREADS 256
__device__ __forceinline__ int opaque_tid() { int t = threadIdx.x; asm volatile("" : "+v"(t)); return t; }
#define TIDX (opaque_tid())

typedef __bf16 hbf16x2 __attribute__((ext_vector_type(2)));
typedef float f32x2 __attribute__((ext_vector_type(2)));
DI unsigned pack2bf(float lo, float hi) { f32x2 f = {lo, hi}; return __builtin_bit_cast(unsigned, __builtin_convertvector(f, hbf16x2)); }
DI float bflo(unsigned u) { return __uint_as_float(u << 16); }
DI float bfhi(unsigned u) { return __uint_as_float(u & 0xffff0000u); }

namespace fw {
constexpr size_t MB = 1024 * 1024;
constexpr size_t PARTS = 13 * MB;
constexpr size_t SMALLB = 1 * MB;
constexpr size_t WB = 14 * MB;
constexpr size_t XB = 30 * MB;
constexpr size_t BIG = 62 * MB;
}

DI void convert_tile(const float* __restrict__ W, int ldw, int c0, int K, bf16* __restrict__ Wt, const float* __restrict__ g, int kt, int nt, float* sm) {
    const int tid = TIDX;
    const int k0 = kt * 64, n0 = nt * 64;
#pragma unroll
    for (int i = 0; i < 4; ++i) {
        const int kr = (tid >> 4) + 16 * i; const int nc = (tid & 15) * 4;
        const float4 v = *(const float4*)(W + (size_t)(k0 + kr) * ldw + c0 + n0 + nc);
        const float s = g ? g[k0 + kr] : 1.0f;
        sm[kr * 65 + nc + 0] = v.x * s; sm[kr * 65 + nc + 1] = v.y * s; sm[kr * 65 + nc + 2] = v.z * s; sm[kr * 65 + nc + 3] = v.w * s;
    }
    __syncthreads();
    {
        const int n = tid >> 2, kq = (tid & 3) * 16;
        unsigned w[8];
#pragma unroll
        for (int j = 0; j < 8; ++j) w[j] = pack2bf(sm[(kq + 2 * j) * 65 + n], sm[(kq + 2 * j + 1) * 65 + n]);
        u32x4* dst = (u32x4*)(Wt + (size_t)(n0 + n) * K + k0 + kq);
        dst[0] = (u32x4){w[0], w[1], w[2], w[3]}; dst[1] = (u32x4){w[4], w[5], w[6], w[7]};
    }
    __syncthreads();
}
DI void convert_seg(const float* W, int ldw, int c0, int ncols, int K, bf16* Wt, const float* g, float* sm, int& tbase) {
    const int nkt = K / 64, nnt = ncols / 64, ntile = nkt * nnt;
    const int Gd = (int)gridDim.x;
    for (int t = (((int)blockIdx.x - tbase % Gd) + Gd) % Gd; t < ntile; t += Gd) convert_tile(W, ldw, c0, K, Wt, g, t % nkt, t / nkt, sm);
    tbase += ntile;
}

DI int perm32(int rho) { const int n = rho >> 4, i = rho & 15; return 8 * (i >> 2) + 4 * n + (i & 3); }

struct ALoadPlain {
    const bf16* A; int lda;
    static constexpr bool DMA = true;
    DI const bf16* src(int m, int k) const { return A + (size_t)m * lda + k; }
    struct Raw { u32x4 v; };
    DI Raw load(int m, int k) const { Raw r; r.v = *(const u32x4*)(A + (size_t)m * lda + k); return r; }
    DI u32x4 finish(const Raw& r, int, int) const { return r.v; }
};
struct ALoadLerp {
    const bf16* xn; const float* mu;
    static constexpr bool DMA = false;
    DI const bf16* src(int, int) const { return nullptr; }
    struct Raw { u32x4 c, p; };
    DI Raw load(int m, int k) const {
        Raw r; r.c = *(const u32x4*)(xn + (size_t)m * D + k);
        if ((m % T) != 0) r.p = *(const u32x4*)(xn + (size_t)(m - 1) * D + k); else r.p = (u32x4){0u, 0u, 0u, 0u};
        return r;
    }
    DI u32x4 finish(const Raw& r, int, int k) const {
        const float4 m0 = *(const float4*)(mu + k), m1 = *(const float4*)(mu + k + 4);
        const float mm[8] = {m0.x, m0.y, m0.z, m0.w, m1.x, m1.y, m1.z, m1.w};
        u32x4 o;
#pragma unroll
        for (int j = 0; j < 4; ++j) {
            const float c0 = bflo(r.c[j]), c1 = bfhi(r.c[j]), p0 = bflo(r.p[j]), p1 = bfhi(r.p[j]);
            o[j] = pack2bf(c0 + (p0 - c0) * mm[2 * j], c1 + (p1 - c1) * mm[2 * j + 1]);
        }
        return o;
    }
};

#define GLDS16(gp, lp) __builtin_amdgcn_global_load_lds((const unsigned*)(gp), (unsigned*)(lp), 16, 0, 0)
template <class AL, class Epi>
DI void gemm_tile(const AL& al, const bf16* __restrict__ Bt, int K, int m0, int n0, const Epi& epi, char* smem) {
    const int tid = TIDX, lane = tid & 63, wave = __builtin_amdgcn_readfirstlane(tid >> 6), wr = wave >> 1, wc = wave & 1, q = lane >> 4, l15 = lane & 15;
    const int srow = tid >> 3, sc = tid & 7, scs = sc ^ (srow & 7);
    const int st_off = srow * 128 + (sc << 4);
    const int dma_off = (8 * wave) * 128;
    int brow[4];
#pragma unroll
    for (int i = 0; i < 4; ++i) { const int rho = srow + 32 * i; brow[i] = n0 + (rho & ~31) + perm32(rho & 31); }
    const int fa0 = (wr * 64 + l15) * 128 + ((q ^ (lane & 7)) << 4);
    const int fb0 = (wc * 64 + l15) * 128 + ((q ^ (lane & 7)) << 4);
    f32x4 acc[4][4];
#pragma unroll
    for (int i = 0; i < 4; ++i)
#pragma unroll
        for (int j = 0; j < 4; ++j) acc[i][j] = (f32x4){0.f, 0.f, 0.f, 0.f};
    typename AL::Raw ra[4];
    const int nk = K / 64;
    {
        char* bufA = smem; char* bufB = smem + 16384;
#pragma unroll
        for (int i = 0; i < 4; ++i) {
            GLDS16(Bt + (size_t)brow[i] * K + scs * 8, bufB + dma_off + i * 4096);
            if (AL::DMA) GLDS16(al.src(m0 + srow + 32 * i, scs * 8), bufA + dma_off + i * 4096);
            else ra[i] = al.load(m0 + srow + 32 * i, scs * 8);
        }
        if (!AL::DMA) {
#pragma unroll
            for (int i = 0; i < 4; ++i) *(u32x4*)(bufA + st_off + i * 4096) = al.finish(ra[i], m0 + srow + 32 * i, scs * 8);
        }
    }
    asm volatile("s_waitcnt vmcnt(0)" ::: "memory");
    __syncthreads();
    for (int kt = 0; kt < nk; ++kt) {
        char* bufA = smem + (kt & 1) * 32768; char* bufB = bufA + 16384;
        char* nA = smem + ((kt + 1) & 1) * 32768; char* nB = nA + 16384;
        const bool more = kt + 1 < nk; const int kn = (kt + 1) * 64 + scs * 8;
        if (more) {
#pragma unroll
            for (int i = 0; i < 4; ++i) {
                GLDS16(Bt + (size_t)brow[i] * K + kn, nB + dma_off + i * 4096);
                if (AL::DMA) GLDS16(al.src(m0 + srow + 32 * i, kn), nA + dma_off + i * 4096);
                else ra[i] = al.load(m0 + srow + 32 * i, kn);
            }
        }
#pragma unroll
        for (int ks = 0; ks < 2; ++ks) {
            bf16x8 af[4], bfr[4];
#pragma unroll
            for (int i = 0; i < 4; ++i) {
                af[i] = *(const bf16x8*)(bufA + ((fa0 + i * 2048) ^ (ks << 6)));
                bfr[i] = *(const bf16x8*)(bufB + ((fb0 + i * 2048) ^ (ks << 6)));
            }
#pragma unroll
            for (int i = 0; i < 4; ++i)
#pragma unroll
                for (int j = 0; j < 4; ++j) acc[i][j] = __builtin_amdgcn_mfma_f32_16x16x32_bf16(bfr[j], af[i], acc[i][j], 0, 0, 0);
        }
        if (more && !AL::DMA) {
#pragma unroll
            for (int i = 0; i < 4; ++i) *(u32x4*)(nA + st_off + i * 4096) = al.finish(ra[i], m0 + srow + 32 * i, kn);
        }
        asm volatile("s_waitcnt vmcnt(0)" ::: "memory");
        __syncthreads();
    }
#pragma unroll
    for (int mt = 0; mt < 4; ++mt)
#pragma unroll
        for (int gi = 0; gi < 2; ++gi) {
            float v[8];
#pragma unroll
            for (int r = 0; r < 4; ++r) { v[r] = acc[mt][2 * gi][r]; v[4 + r] = acc[mt][2 * gi + 1][r]; }
            epi(m0 + wr * 64 + mt * 16 + l15, n0 + wc * 64 + gi * 32 + 8 * q, v, mt, gi);
        }
    epi.finish(m0, n0, wr, wc, lane);
}

constexpr int G2_STAGE = 24576;
template <class AL, class Epi>
DI void gemm_tile2(const AL& al, const bf16* __restrict__ Bt, int K, int m0, int n0, const Epi& epi, char* smem) {
    const int tid = TIDX, lane = tid & 63, wave = __builtin_amdgcn_readfirstlane(tid >> 6), wr = wave >> 1, wc = wave & 1, q = lane >> 4, l15 = lane & 15;
    const int prow = tid >> 2, ppos = tid & 3, ca = (ppos - 2 * ((tid >> 4) & 3)) & 3;
    const int dma_off = wave * 1024;
    int brow[4];
#pragma unroll
    for (int i = 0; i < 4; ++i) { const int rho = prow + 64 * i; brow[i] = n0 + (rho & ~31) + perm32(rho & 31); }
    const int fpos = ((q + 2 * ((l15 >> 2) & 3)) & 3) << 4;
    const int fa0 = (wr * 64 + l15) * 64 + fpos, fb0 = 8192 + (wc * 128 + l15) * 64 + fpos;
    f32x4 acc[4][8];
#pragma unroll
    for (int i = 0; i < 4; ++i)
#pragma unroll
        for (int j = 0; j < 8; ++j) acc[i][j] = (f32x4){0.f, 0.f, 0.f, 0.f};
    typename AL::Raw ra[2];
    const int nk = K / 32;
#define G2_ISSUE(kt_) { char* st_ = smem + ((kt_) % 3) * G2_STAGE; const int kk_ = (kt_) * 32 + ca * 8; \
        _Pragma("unroll") for (int i = 0; i < 2; ++i) { if (AL::DMA) GLDS16(al.src(m0 + prow + 64 * i, kk_), st_ + dma_off + i * 4096); else ra[i] = al.load(m0 + prow + 64 * i, kk_); } \
        _Pragma("unroll") for (int i = 0; i < 4; ++i) GLDS16(Bt + (size_t)brow[i] * K + kk_, st_ + 8192 + dma_off + i * 4096); }
#define G2_AWRITE(kt_) { if (!AL::DMA) { char* st_ = smem + ((kt_) % 3) * G2_STAGE; const int kk_ = (kt_) * 32 + ca * 8; \
        _Pragma("unroll") for (int i = 0; i < 2; ++i) *(u32x4*)(st_ + (prow + 64 * i) * 64 + ppos * 16) = al.finish(ra[i], m0 + prow + 64 * i, kk_); } }
#define G2_BARRIER() { asm volatile("s_waitcnt lgkmcnt(0)" ::: "memory"); __builtin_amdgcn_s_barrier(); asm volatile("" ::: "memory"); }
    G2_ISSUE(0); G2_AWRITE(0);
    if (nk > 1) { G2_ISSUE(1); G2_AWRITE(1); }
    if (nk > 1) { if (AL::DMA) asm volatile("s_waitcnt vmcnt(6)" ::: "memory"); else asm volatile("s_waitcnt vmcnt(4)" ::: "memory"); } else asm volatile("s_waitcnt vmcnt(0)" ::: "memory");
    G2_BARRIER();
    for (int kt = 0; kt < nk; ++kt) {
        const char* st = smem + (kt % 3) * G2_STAGE;
        const bool more = kt + 2 < nk;
        if (more) G2_ISSUE(kt + 2);
        bf16x8 af[4];
#pragma unroll
        for (int i = 0; i < 4; ++i) af[i] = *(const bf16x8*)(st + fa0 + i * 1024);
#pragma unroll
        for (int j = 0; j < 8; ++j) {
            const bf16x8 bf_ = *(const bf16x8*)(st + fb0 + j * 1024);
#pragma unroll
            for (int i = 0; i < 4; ++i) acc[i][j] = __builtin_amdgcn_mfma_f32_16x16x32_bf16(bf_, af[i], acc[i][j], 0, 0, 0);
        }
        if (more) G2_AWRITE(kt + 2);
        if (more) { if (AL::DMA) asm volatile("s_waitcnt vmcnt(6)" ::: "memory"); else asm volatile("s_waitcnt vmcnt(4)" ::: "memory"); } else asm volatile("s_waitcnt vmcnt(0)" ::: "memory");
        G2_BARRIER();
    }
#undef G2_ISSUE
#undef G2_AWRITE
#undef G2_BARRIER
#pragma unroll
    for (int mt = 0; mt < 4; ++mt)
#pragma unroll
        for (int gi = 0; gi < 4; ++gi) {
            float v[8];
#pragma unroll
            for (int r = 0; r < 4; ++r) { v[r] = acc[mt][2 * gi][r]; v[4 + r] = acc[mt][2 * gi + 1][r]; }
            epi(m0 + wr * 64 + mt * 16 + l15, n0 + wc * 128 + gi * 32 + 8 * q, v, mt, gi);
        }
    epi.finish_wide(m0, n0, wr, wc, lane);
}
template <class F>
DI void gemm_sched(int nbig, int nsmall, F&& f) {
    const int x = blockIdx.x & 7, lb = blockIdx.x >> 3, nlb = gridDim.x >> 3;
    const int nb16 = 16 * nbig, tot = 16 * (nbig + nsmall);
    for (int s = lb; s < tot; s += nlb) {
        if (s < nb16) f(true, x * 16 + (s & 15), s >> 4);
        else { const int t = s - nb16; f(false, x * 16 + (t & 15), t >> 4); }
    }
}

DI float rstd_from_parts(const float* parts, int m) {
    const float4* p = (const float4*)(parts + (size_t)m * 16); float s = 0.f;
#pragma unroll
    for (int i = 0; i < 4; ++i) { const float4 v = p[i]; s += (v.x + v.y) + (v.z + v.w); }
    return 1.0f / sqrtf(s * (1.0f / D) + 1e-6f);
}
DI void store8bf(bf16* p, const float* v) { *(u32x4*)p = (u32x4){pack2bf(v[0], v[1]), pack2bf(v[2], v[3]), pack2bf(v[4], v[5]), pack2bf(v[6], v[7])}; }

struct EpiBf16 {
    bf16* P; int ldp; const float* parts; mutable float rsc[4];
    DI void operator()(int m, int n, const float* v, int mt, int gi) const {
        if (gi == 0) rsc[mt] = parts ? rstd_from_parts(parts, m) : 1.0f;
        float s = rsc[mt]; float w[8];
#pragma unroll
        for (int j = 0; j < 8; ++j) w[j] = v[j] * s;
        store8bf(P + (size_t)m * ldp + n, w);
    }
    DI void finish(int, int, int, int, int) const {}
    DI void finish_wide(int, int, int, int, int) const {}
};
struct EpiResid {
    const float* xin; float* xout; bf16* xb; float* parts; mutable float sq[4];
    DI void operator()(int m, int n, const float* v, int mt, int gi) const {
        const float4* xi = (const float4*)(xin + (size_t)m * D + n); const float4 a = xi[0], b = xi[1];
        float w[8] = {a.x + v[0], a.y + v[1], a.z + v[2], a.w + v[3], b.x + v[4], b.y + v[5], b.z + v[6], b.w + v[7]};
        float4* xo = (float4*)(xout + (size_t)m * D + n);
        xo[0] = make_float4(w[0], w[1], w[2], w[3]); xo[1] = make_float4(w[4], w[5], w[6], w[7]);
        if (xb) store8bf(xb + (size_t)m * D + n, w);
        float s = 0.f;
#pragma unroll
        for (int j = 0; j < 8; ++j) s += w[j] * w[j];
        if (gi == 0) sq[mt] = s; else sq[mt] += s;
    }
    DI void finish(int m0, int n0, int wr, int wc, int lane) const {
#pragma unroll
        for (int mt = 0; mt < 4; ++mt) {
            float s = sq[mt]; s += __shfl_xor(s, 16); s += __shfl_xor(s, 32);
            if (lane < 16) parts[(size_t)(m0 + wr * 64 + mt * 16 + lane) * 16 + (n0 >> 7) * 2 + wc] = s;
        }
    }
    DI void finish_wide(int m0, int n0, int wr, int wc, int lane) const {
#pragma unroll
        for (int mt = 0; mt < 4; ++mt) {
            float s = sq[mt]; s += __shfl_xor(s, 16); s += __shfl_xor(s, 32);
            if (lane < 16) { float* pr = parts + (size_t)(m0 + wr * 64 + mt * 16 + lane) * 16 + (n0 >> 7) + wc; pr[0] = s; pr[8] = 0.f; }
        }
    }
};
struct EpiRwkv {
    bf16* P; float* hw; float* ha;
    DI void operator()(int m, int n, const float* v, int, int) const {
        if (n < 4096) { store8bf(P + (size_t)m * 4096 + n, v); return; }
        const int c = n - 4096;
        if (c < 64) { float4* o = (float4*)(hw + (size_t)m * 64 + c); o[0] = make_float4(tanhf(v[0]), tanhf(v[1]), tanhf(v[2]), tanhf(v[3])); o[1] = make_float4(tanhf(v[4]), tanhf(v[5]), tanhf(v[6]), tanhf(v[7])); }
        else if (c >= 128 && c < 192) { float4* o = (float4*)(ha + (size_t)m * 64 + (c - 128)); o[0] = make_float4(v[0], v[1], v[2], v[3]); o[1] = make_float4(v[4], v[5], v[6], v[7]); }
    }
    DI void finish(int, int, int, int, int) const {}
    DI void finish_wide(int, int, int, int, int) const {}
};

namespace at {
constexpr int OFF_BIAS = 49152;
constexpr int OFF_X = 61952;
constexpr int OFF_IMP = 49152;
constexpr float L2E = 1.4426950408889634f;
constexpr float NEG_MASK = -1e30f, M_INIT = -1e20f;
}
enum { AM_SWA = 0, AM_WIN = 1, AM_CMP = 2, AM_SEL = 3 };
DI int vt_perm(int k32) { return ((k32 & 15) >> 2) * 8 + (k32 >> 4) * 4 + (k32 & 3); }
DI float fast_exp2(float x) { return __builtin_amdgcn_exp2f(x); }

DI void build_bias_lut(const float* __restrict__ t5, char* smem, bool swa) {
    float* lut = (float*)(smem + at::OFF_BIAS);
    for (int i = TIDX; i < 16 * 200; i += NTHREADS) {
        const int h = i / 200, e = i % 200; float v = at::NEG_MASK;
        if (e >= 64 && e < 192) v = t5[t5_bucket(e - 64) * 16 + h] * at::L2E;
        else if (e >= 192 && !swa) v = t5[31 * 16 + h] * at::L2E;
        lut[i] = v;
    }
    __syncthreads();
}

struct AttnState { f32x4 o[2][4]; f32x4 lacc[2]; float m[2]; };
DI unsigned long long range_mask(int lo, int hi) { return (hi >= 63 ? ~0ull : ((1ull << (hi + 1)) - 1ull)) & ~((1ull << lo) - 1ull); }

DI void attn_load_q(bf16x8 (&qf)[2][2], const bf16* __restrict__ Qp, int ldq, size_t mbase, int hbase) {
    const int lane = TIDX & 63, wave = TIDX >> 6, q = lane >> 4, l15 = lane & 15;
#pragma unroll
    for (int qt = 0; qt < 2; ++qt) {
        const size_t m = mbase + wave * 8 + qt * 4 + (l15 >> 2);
#pragma unroll
        for (int ks = 0; ks < 2; ++ks) qf[qt][ks] = *(const bf16x8*)(Qp + m * ldq + (hbase + (l15 & 3)) * 64 + ks * 32 + q * 8);
    }
}

enum { SK_FAR = 0, SK_NEAR = 1, SK_EDGE = 2, SK_CMP = 3 };
template <int KIND>
DI float attn_fix(f32x4 (&s)[4], int dbase, float cadd, const float* __restrict__ bl, float mx) {
#pragma unroll
    for (int kt = 0; kt < 4; ++kt)
#pragma unroll
        for (int r = 0; r < 4; ++r) {
            float v = s[kt][r]; const int dist = dbase - (kt * 16 + r);
            if (KIND == SK_NEAR) { int idx = dist + 64; idx = idx < 0 ? 0 : (idx > 192 ? 192 : idx); v += bl[idx] + cadd; }
            else if (KIND == SK_EDGE) v = dist < 512 ? v + cadd : at::NEG_MASK;
            else if (KIND == SK_CMP) v = dist >= 0 ? v : at::NEG_MASK;
            if (KIND != SK_FAR) s[kt][r] = v;
            mx = fmaxf(mx, v);
        }
    return mx;
}
template <int MODE>
DI void attn_blocks(AttnState& st, const bf16x8 (&qf)[2][2], const bf16* __restrict__ Kp, size_t krs, const bf16* __restrict__ Vp, size_t vrs,
                    int t0, unsigned long long todo, int hbase, unsigned long long sel0, unsigned long long sel1, char* smem) {
    const int tid = TIDX, lane = tid & 63, wave = __builtin_amdgcn_readfirstlane(tid >> 6), q = lane >> 4, l15 = lane & 15;
    const int tq0 = t0 + wave * 8 + (l15 >> 2);
    const float* bl = (const float*)(smem + at::OFF_BIAS) + (hbase + (l15 & 3)) * 200;
    const float bfar = (MODE != AM_CMP) ? bl[192] : 0.f;
    const int srow = tid >> 3, scs = (tid & 7) ^ (srow & 7);
    const int fo = l15 * 128 + ((q ^ (l15 & 7)) << 4);
#define ATT_DMA(kb_, slot_) { _Pragma("unroll") for (int i = 0; i < 2; ++i) { const int row = srow + 32 * i; char* dst = smem + (slot_) * 16384 + (8 * wave + 32 * i) * 128; \
        GLDS16(Kp + (size_t)((kb_) * 64 + row) * krs + scs * 8, dst); GLDS16(Vp + (size_t)row * vrs + (kb_) * 64 + scs * 8, dst + 8192); } }
#define ATT_BARRIER() { asm volatile("s_waitcnt lgkmcnt(0)" ::: "memory"); __builtin_amdgcn_s_barrier(); asm volatile("" ::: "memory"); }
    if (todo == 0ull) return;
    int kb = __builtin_ctzll(todo); todo &= todo - 1ull;
    int kb1 = -1; if (todo) { kb1 = __builtin_ctzll(todo); todo &= todo - 1ull; }
    ATT_DMA(kb, 0);
    if (kb1 >= 0) { ATT_DMA(kb1, 1); asm volatile("s_waitcnt vmcnt(4)" ::: "memory"); } else { asm volatile("s_waitcnt vmcnt(0)" ::: "memory"); }
    ATT_BARRIER();
    int slot = 0;
    for (;;) {
        char* buf = smem + slot * 16384;
        int kb2 = -1; if (todo) { kb2 = __builtin_ctzll(todo); todo &= todo - 1ull; }
        if (kb2 >= 0) { const int s2 = slot >= 1 ? slot - 1 : 2; ATT_DMA(kb2, s2); }
        f32x4 s[2][4];
#pragma unroll
        for (int qt = 0; qt < 2; ++qt)
#pragma unroll
            for (int kt = 0; kt < 4; ++kt) s[qt][kt] = (f32x4){0.f, 0.f, 0.f, 0.f};
#pragma unroll
        for (int kt = 0; kt < 4; ++kt)
#pragma unroll
            for (int ks = 0; ks < 2; ++ks) {
                const bf16x8 kf = *(const bf16x8*)(buf + ((fo + kt * 2048) ^ (ks << 6)));
                s[0][kt] = __builtin_amdgcn_mfma_f32_16x16x32_bf16(kf, qf[0][ks], s[0][kt], 0, 0, 0);
                s[1][kt] = __builtin_amdgcn_mfma_f32_16x16x32_bf16(kf, qf[1][ks], s[1][kt], 0, 0, 0);
            }
        const int mind = (t0 + wave * 8) - (kb * 64 + 63), maxd = (t0 + wave * 8 + 7) - kb * 64;
        float mx[2], cofs[2] = {0.f, 0.f};
        if (MODE == AM_CMP) {
#pragma unroll
            for (int qt = 0; qt < 2; ++qt) { const int nlim = (tq0 + 4 * qt - 31) >> 4; mx[qt] = attn_fix<SK_CMP>(s[qt], nlim - (kb * 64 + 4 * q), 0.f, bl, at::NEG_MASK); }
        } else {
            float cadd[2] = {0.f, 0.f};
            if (MODE == AM_SEL) { cadd[0] = ((sel0 >> kb) & 1ull) ? 0.f : at::NEG_MASK; cadd[1] = ((sel1 >> kb) & 1ull) ? 0.f : at::NEG_MASK; }
            if (MODE == AM_SWA || mind < 113) {
#pragma unroll
                for (int qt = 0; qt < 2; ++qt) mx[qt] = attn_fix<SK_NEAR>(s[qt], tq0 + 4 * qt - (kb * 64 + 4 * q), cadd[qt], bl, at::NEG_MASK);
            } else if (MODE == AM_WIN && maxd >= 512) {
#pragma unroll
                for (int qt = 0; qt < 2; ++qt) mx[qt] = attn_fix<SK_EDGE>(s[qt], tq0 + 4 * qt - (kb * 64 + 4 * q), bfar, bl, at::NEG_MASK);
            } else {
#pragma unroll
                for (int qt = 0; qt < 2; ++qt) { cofs[qt] = bfar + cadd[qt]; mx[qt] = attn_fix<SK_FAR>(s[qt], 0, 0.f, bl, at::NEG_MASK) + cofs[qt]; }
            }
        }
        float msub[2]; bool grow = false;
#pragma unroll
        for (int qt = 0; qt < 2; ++qt) {
            float m2 = mx[qt];
            m2 = fmaxf(m2, __shfl_xor(m2, 16)); m2 = fmaxf(m2, __shfl_xor(m2, 32));
            const bool g = m2 > st.m[qt] + 4.0f; grow |= g;
            mx[qt] = g ? m2 : st.m[qt];
            msub[qt] = mx[qt] - cofs[qt];
        }
        if (__any(grow)) {
#pragma unroll
            for (int qt = 0; qt < 2; ++qt) {
                const float alpha = fast_exp2(st.m[qt] - mx[qt]);
#pragma unroll
                for (int dt = 0; dt < 4; ++dt) st.o[qt][dt] *= alpha;
                st.lacc[qt] *= alpha;
            }
        }
        st.m[0] = mx[0]; st.m[1] = mx[1];
#pragma unroll
        for (int qt = 0; qt < 2; ++qt)
#pragma unroll
            for (int kt = 0; kt < 4; ++kt)
#pragma unroll
                for (int r = 0; r < 4; ++r) s[qt][kt][r] = fast_exp2(s[qt][kt][r] - msub[qt]);
        const bf16x8 ones = {(short)0x3F80, (short)0x3F80, (short)0x3F80, (short)0x3F80, (short)0x3F80, (short)0x3F80, (short)0x3F80, (short)0x3F80};
#pragma unroll
        for (int kp = 0; kp < 2; ++kp) {
            bf16x8 pf[2];
#pragma unroll
            for (int qt = 0; qt < 2; ++qt) {
                const u32x4 w = {pack2bf(s[qt][2 * kp][0], s[qt][2 * kp][1]), pack2bf(s[qt][2 * kp][2], s[qt][2 * kp][3]),
                                 pack2bf(s[qt][2 * kp + 1][0], s[qt][2 * kp + 1][1]), pack2bf(s[qt][2 * kp + 1][2], s[qt][2 * kp + 1][3])};
                pf[qt] = __builtin_bit_cast(bf16x8, w);
            }
            st.lacc[0] = __builtin_amdgcn_mfma_f32_16x16x32_bf16(ones, pf[0], st.lacc[0], 0, 0, 0);
            st.lacc[1] = __builtin_amdgcn_mfma_f32_16x16x32_bf16(ones, pf[1], st.lacc[1], 0, 0, 0);
#pragma unroll
            for (int dt = 0; dt < 4; ++dt) {
                const bf16x8 vf = *(const bf16x8*)(buf + 8192 + ((fo + dt * 2048) ^ (kp << 6)));
                st.o[0][dt] = __builtin_amdgcn_mfma_f32_16x16x32_bf16(vf, pf[0], st.o[0][dt], 0, 0, 0);
                st.o[1][dt] = __builtin_amdgcn_mfma_f32_16x16x32_bf16(vf, pf[1], st.o[1][dt], 0, 0, 0);
            }
        }
        if (kb1 < 0) break;
        if (kb2 >= 0) { asm volatile("s_waitcnt vmcnt(4)" ::: "memory"); } else { asm volatile("s_waitcnt vmcnt(0)" ::: "memory"); }
        ATT_BARRIER();
        kb = kb1; kb1 = kb2; slot = slot == 2 ? 0 : slot + 1;
    }
    ATT_BARRIER();
#undef ATT_DMA
}
DI void attn_init(AttnState& st, float m0, float l0) {
#pragma unroll
    for (int qt = 0; qt < 2; ++qt) { st.m[qt] = m0; st.lacc[qt] = (f32x4){l0, l0, l0, l0};
#pragma unroll
        for (int dt = 0; dt < 4; ++dt) st.o[qt][dt] = (f32x4){0.f, 0.f, 0.f, 0.f}; }
}
DI float attn_linv(const f32x4& lacc) { const float l = lacc[0]; return l > 0.f ? 1.0f / l : 0.f; }

DI void attn_item_decode(int item, int& b, int& g, int& t0) {
    constexpr int tiles = T / 32;
    const int Gd = (int)gridDim.x;
    int pair, tile;
    if ((Gd % tiles) == 0 && tiles * B * G % Gd == 0) {
        const int bid = item % Gd, rr = item / Gd, tau = bid % tiles;
        pair = bid / tiles + (Gd / tiles) * rr; tile = (rr & 1) ? tiles - 1 - tau : tau;
    } else { tile = item % tiles; pair = item / tiles; }
    t0 = tile * 32; g = pair % G; b = pair / G;
}
DI void swa_item(const bf16* __restrict__ P0, const bf16* __restrict__ VT, const float* __restrict__ sinks, bf16* __restrict__ AO, int item, char* smem) {
    constexpr int LDP = 2304;
    int b, g, t0; attn_item_decode(item, b, g, t0);
    const int lane = TIDX & 63, wave = TIDX >> 6, q = lane >> 4, l15 = lane & 15;
    const size_t mbase = (size_t)b * T + t0; const int hbase = g * 4, h = hbase + (l15 & 3);
    bf16x8 qf[2][2]; attn_load_q(qf, P0, LDP, mbase, hbase);
    AttnState st; attn_init(st, sinks[h] * at::L2E, 1.0f);
    const int lo = t0 - 127 < 0 ? 0 : (t0 - 127) >> 6, hi = (t0 + 31) >> 6;
    attn_blocks<AM_SWA>(st, qf, P0 + (size_t)b * T * LDP + 1024 + g * 64, LDP, VT + (size_t)(b * G + g) * 64 * T, T, t0, range_mask(lo, hi), hbase, 0ull, 0ull, smem);
#pragma unroll
    for (int qt = 0; qt < 2; ++qt) {
        const float li = attn_linv(st.lacc[qt]); const size_t m = mbase + wave * 8 + qt * 4 + (l15 >> 2);
#pragma unroll
        for (int dt = 0; dt < 4; ++dt) {
            const int d0 = dt * 16 + 4 * q; const u32x2 zz = *(const u32x2*)(P0 + m * LDP + 1280 + h * 64 + d0);
            const float z0 = bflo(zz[0]), z1 = bfhi(zz[0]), z2 = bflo(zz[1]), z3 = bfhi(zz[1]);
            const f32x4 o = st.o[qt][dt];
            *(u32x2*)(AO + m * D + h * 64 + d0) = (u32x2){pack2bf(o[0] * li * siluf_(z0), o[1] * li * siluf_(z1)), pack2bf(o[2] * li * siluf_(z2), o[3] * li * siluf_(z3))};
        }
    }
}

struct EpiL0 {
    bf16* P0; bf16* VT; const float* parts; mutable float rsc[4];
    DI void operator()(int m, int n, const float* v, int mt, int gi) const {
        if (gi == 0) rsc[mt] = rstd_from_parts(parts, m);
        float s = rsc[mt]; if (n < 1024) s *= 0.125f * at::L2E; float w[8];
#pragma unroll
        for (int j = 0; j < 8; ++j) w[j] = v[j] * s;
        if (n < 1280) store8bf(P0 + (size_t)m * 2304 + n, w);
        else if (n >= 1536) store8bf(P0 + (size_t)m * 2304 + n - 256, w);
        else {
            const int g = (n - 1280) >> 6, d = (n - 1280) & 63, b = m / T, t = m % T; const int pos = (t & ~31) + vt_perm(t & 31);
            bf16* dst = VT + ((size_t)(b * G + g) * 64 + d) * T + pos;
#pragma unroll
            for (int j = 0; j < 8; ++j) dst[(size_t)j * T] = f2bf(w[j]);
        }
    }
    DI void finish(int, int, int, int, int) const {}
    DI void finish_wide(int, int, int, int, int) const {}
};

constexpr int LDP2 = 3200;
struct EpiL2 {
    bf16* P2; bf16* VTs; bf16* VTw; const float* parts; mutable float rsc[4];
    DI void operator()(int m, int n, const float* v, int mt, int gi) const {
        if (gi == 0) rsc[mt] = rstd_from_parts(parts, m);
        if (n >= C_COLS) return;
        float s = rsc[mt]; if (n < 1024) s *= 0.125f * at::L2E; float w[8];
#pragma unroll
        for (int j = 0; j < 8; ++j) w[j] = v[j] * s;
        const bool isvs = n >= 1792 && n < 2048, isvw = n >= 2304 && n < 2560;
        if (isvs || isvw) {
            const int c = n - (isvs ? 1792 : 2304); const int g = c >> 6, d = c & 63, b = m / T, t = m % T; const int pos = (t & ~31) + vt_perm(t & 31);
            bf16* dst = (isvs ? VTs : VTw) + ((size_t)(b * G + g) * 64 + d) * T + pos;
#pragma unroll
            for (int j = 0; j < 8; ++j) dst[(size_t)j * T] = f2bf(w[j]);
        } else {
            const int c = n < 1792 ? n : (n < 2304 ? n - 256 : n - 512);
            store8bf(P2 + (size_t)m * LDP2 + c, w);
        }
    }
    DI void finish(int, int, int, int, int) const {}
    DI void finish_wide(int, int, int, int, int) const {}
};

struct ALoadCmp {
    const bf16* P2; int col;
    static constexpr bool DMA = true;
    DI const bf16* src(int row, int k) const {
        int n = row & 255; const int bg = row >> 8, b = bg >> 2, g = bg & 3; const int l = k >> 6, d = k & 63; n = n < NCMP ? n : NCMP - 1;
        return P2 + (size_t)(b * T + 16 * n + l) * LDP2 + col + g * 64 + d;
    }
    struct Raw { u32x4 v; };
    DI Raw load(int row, int k) const {
        const int n = row & 255, bg = row >> 8, b = bg >> 2, g = bg & 3; const int l = k >> 6, d = k & 63; Raw r;
        if (n < NCMP) r.v = *(const u32x4*)(P2 + (size_t)(b * T + 16 * n + l) * LDP2 + col + g * 64 + d); else r.v = (u32x4){0u, 0u, 0u, 0u};
        return r;
    }
    DI u32x4 finish(const Raw& r, int, int) const { return r.v; }
};
struct EpiCmpH {
    char* smem; const float* bias8;
    DI void operator()(int m, int n, const float* v, int, int) const {
        const int row = m & 127; float w[8];
#pragma unroll
        for (int j = 0; j < 8; ++j) { float bsum = 0.f;
#pragma unroll
            for (int i = 0; i < 8; ++i) bsum += bias8[i * 128 + n + j];
            w[j] = siluf_(v[j] + bsum); }
        const int kk = n >> 6, c = (n & 63) >> 3;
        *(u32x4*)(smem + kk * 16384 + row * 128 + ((c ^ (row & 7)) << 4)) = (u32x4){pack2bf(w[0], w[1]), pack2bf(w[2], w[3]), pack2bf(w[4], w[5]), pack2bf(w[6], w[7])};
    }
    DI void finish(int, int, int, int, int) const {}
    DI void finish_wide(int, int, int, int, int) const {}
};
DI void cmp_tile(const bf16* __restrict__ P2, const bf16* __restrict__ w1t, const float* __restrict__ bias8, const bf16* __restrict__ w2t, int which, int rt,
                 bf16* __restrict__ KCb, bf16* __restrict__ VCT, char* smem) {
    gemm_tile(ALoadCmp{P2, which ? 1280 : 1024}, w1t, 2048, rt * 128, 0, EpiCmpH{smem, bias8}, smem);
    const int tid = TIDX, lane = tid & 63, wave = tid >> 6, q = lane >> 4, l15 = lane & 15;
#pragma unroll
    for (int i = 0; i < 4; ++i) {
        const int id = i * 256 + tid; const int row = id >> 4, c16 = id & 15, kk = c16 >> 3, c = c16 & 7;
        *(u32x4*)(smem + 32768 + kk * 8192 + row * 128 + ((c ^ (row & 7)) << 4)) = *(const u32x4*)(w2t + (size_t)row * 128 + c16 * 8);
    }
    __syncthreads();
    f32x4 acc[2][4];
#pragma unroll
    for (int i = 0; i < 2; ++i)
#pragma unroll
        for (int j = 0; j < 4; ++j) acc[i][j] = (f32x4){0.f, 0.f, 0.f, 0.f};
    const int fo = l15 * 128 + ((q ^ (l15 & 7)) << 4);
#pragma unroll
    for (int kk = 0; kk < 2; ++kk)
#pragma unroll
        for (int ks = 0; ks < 2; ++ks) {
            bf16x8 hf[2], wf[4];
#pragma unroll
            for (int i = 0; i < 2; ++i) hf[i] = *(const bf16x8*)(smem + kk * 16384 + (((wave * 32 + i * 16) * 128 + fo) ^ (ks << 6)));
#pragma unroll
            for (int j = 0; j < 4; ++j) wf[j] = *(const bf16x8*)(smem + 32768 + kk * 8192 + ((j * 2048 + fo) ^ (ks << 6)));
#pragma unroll
            for (int i = 0; i < 2; ++i)
#pragma unroll
                for (int j = 0; j < 4; ++j) acc[i][j] = __builtin_amdgcn_mfma_f32_16x16x32_bf16(wf[j], hf[i], acc[i][j], 0, 0, 0);
        }
#pragma unroll
    for (int i = 0; i < 2; ++i) {
        const int row = rt * 128 + wave * 32 + i * 16 + l15; const int n = row & 255, bg = row >> 8;
#pragma unroll
        for (int j = 0; j < 4; ++j) {
            const int d0 = j * 16 + 4 * q; const f32x4 a = acc[i][j];
            if (which == 0) *(u32x2*)(KCb + (size_t)row * 64 + d0) = (u32x2){pack2bf(a[0], a[1]), pack2bf(a[2], a[3])};
            else {
                const int pos = (n & ~31) + vt_perm(n & 31);
#pragma unroll
                for (int r = 0; r < 4; ++r) VCT[((size_t)bg * 64 + d0 + r) * 256 + pos] = f2bf(a[r]);
            }
        }
    }
    __syncthreads();
}

DI void win_item(const bf16* __restrict__ P2, const bf16* __restrict__ VTw, bf16* __restrict__ OW, int item, char* smem) {
    int b, g, t0; attn_item_decode(item, b, g, t0);
    const int lane = TIDX & 63, wave = TIDX >> 6, q = lane >> 4, l15 = lane & 15;
    const size_t mbase = (size_t)b * T + t0; const int hbase = g * 4, h = hbase + (l15 & 3);
    bf16x8 qf[2][2]; attn_load_q(qf, P2, LDP2, mbase, hbase);
    AttnState st; attn_init(st, at::M_INIT, 0.f);
    const int lo = t0 - 511 < 0 ? 0 : (t0 - 511) >> 6, hi = (t0 + 31) >> 6;
    attn_blocks<AM_WIN>(st, qf, P2 + (size_t)b * T * LDP2 + 1792 + g * 64, LDP2, VTw + (size_t)(b * G + g) * 64 * T, T, t0, range_mask(lo, hi), hbase, 0ull, 0ull, smem);
#pragma unroll
    for (int qt = 0; qt < 2; ++qt) {
        const float li = attn_linv(st.lacc[qt]); const size_t m = mbase + wave * 8 + qt * 4 + (l15 >> 2);
#pragma unroll
        for (int dt = 0; dt < 4; ++dt) { const f32x4 o = st.o[qt][dt]; *(u32x2*)(OW + m * D + h * 64 + dt * 16 + 4 * q) = (u32x2){pack2bf(o[0] * li, o[1] * li), pack2bf(o[2] * li, o[3] * li)}; }
    }
}

DI void cmpsel_item(const bf16* __restrict__ P2, const bf16* __restrict__ KCb, const bf16* __restrict__ VCT, bf16* __restrict__ OC, unsigned long long* __restrict__ SELM, int item, char* smem) {
    int b, g, t0; attn_item_decode(item, b, g, t0);
    const int tid = TIDX, lane = tid & 63, wave = tid >> 6, q = lane >> 4, l15 = lane & 15;
    const size_t mbase = (size_t)b * T + t0; const int hbase = g * 4, h = hbase + (l15 & 3);
    float* impL = (float*)(smem + at::OFF_IMP);
    for (int i = tid; i < 32 * 64; i += NTHREADS) impL[i] = 0.f;
    bf16x8 qf[2][2]; attn_load_q(qf, P2, LDP2, mbase, hbase);
    AttnState st; attn_init(st, at::M_INIT, 0.f);
    const int nvmax = (t0 + 31 - 31) / 16 + 1;
    const int hi = (nvmax - 1) >> 6;
    const bf16* Kp = KCb + (size_t)(b * G + g) * 256 * 64; const bf16* Vp = VCT + (size_t)(b * G + g) * 64 * 256;
    attn_blocks<AM_CMP>(st, qf, Kp, 64, Vp, 256, t0, range_mask(0, hi), hbase, 0ull, 0ull, smem);
    float linv[2];
#pragma unroll
    for (int qt = 0; qt < 2; ++qt) {
        linv[qt] = attn_linv(st.lacc[qt]); const size_t m = mbase + wave * 8 + qt * 4 + (l15 >> 2);
#pragma unroll
        for (int dt = 0; dt < 4; ++dt) { const f32x4 o = st.o[qt][dt]; *(u32x2*)(OC + m * D + h * 64 + dt * 16 + 4 * q) = (u32x2){pack2bf(o[0] * linv[qt], o[1] * linv[qt]), pack2bf(o[2] * linv[qt], o[3] * linv[qt])}; }
    }
    {
        const int srow = tid >> 3, sc = tid & 7; const int st_off = srow * 128 + ((sc ^ (srow & 7)) << 4); const int fo = l15 * 128 + ((q ^ (l15 & 7)) << 4);
        const int tq0 = t0 + wave * 8 + (l15 >> 2);
        for (int kb = 0; kb <= hi; ++kb) {
#pragma unroll
            for (int i = 0; i < 2; ++i) { const int row = srow + 32 * i; *(u32x4*)(smem + st_off + i * 4096) = *(const u32x4*)(Kp + (size_t)(kb * 64 + row) * 64 + sc * 8); }
            __syncthreads();
            f32x4 s[2][4];
#pragma unroll
            for (int qt = 0; qt < 2; ++qt)
#pragma unroll
                for (int kt = 0; kt < 4; ++kt) s[qt][kt] = (f32x4){0.f, 0.f, 0.f, 0.f};
#pragma unroll
            for (int kt = 0; kt < 4; ++kt)
#pragma unroll
                for (int ks = 0; ks < 2; ++ks) {
                    const bf16x8 kf = *(const bf16x8*)(smem + ((fo + kt * 2048) ^ (ks << 6)));
                    s[0][kt] = __builtin_amdgcn_mfma_f32_16x16x32_bf16(kf, qf[0][ks], s[0][kt], 0, 0, 0);
                    s[1][kt] = __builtin_amdgcn_mfma_f32_16x16x32_bf16(kf, qf[1][ks], s[1][kt], 0, 0, 0);
                }
#pragma unroll
            for (int qt = 0; qt < 2; ++qt) {
                const int tq = tq0 + 4 * qt; const int tl = wave * 8 + qt * 4 + (l15 >> 2);
#pragma unroll
                for (int kt = 0; kt < 4; ++kt) {
                    float pr[4];
#pragma unroll
                    for (int r = 0; r < 4; ++r) { const int key = kb * 64 + kt * 16 + 4 * q + r; pr[r] = (16 * key + 31 <= tq) ? fast_exp2(s[qt][kt][r] - st.m[qt]) * linv[qt] : 0.f; }
                    float s4 = (pr[0] + pr[1]) + (pr[2] + pr[3]), s1 = pr[3];
                    s4 += __shfl_xor(s4, 1); s4 += __shfl_xor(s4, 2); s1 += __shfl_xor(s1, 1); s1 += __shfl_xor(s1, 2);
                    const int s0 = kb * 16 + kt * 4 + q;
                    if ((l15 & 3) == 0) { atomicAdd(&impL[tl * 64 + s0], s4); if (s0 + 1 < 64) atomicAdd(&impL[tl * 64 + s0 + 1], s1); }
                }
            }
            __syncthreads();
        }
    }
    {
        const int tl = tid >> 3, sg = tid & 7; const int t = t0 + tl, cur = t >> 6; float* row = impL + tl * 64;
        float mine[8];
#pragma unroll
        for (int j = 0; j < 8; ++j) { const int s = sg * 8 + j; mine[j] = (s == 0 || s == cur || s == cur - 1) ? 1e30f : (s * 64 > t ? -1e30f : row[s]); }
        __syncthreads();
#pragma unroll
        for (int j = 0; j < 8; ++j) row[sg * 8 + j] = mine[j];
        __syncthreads();
        int rank[8] = {0, 0, 0, 0, 0, 0, 0, 0};
#pragma unroll 4
        for (int s4 = 0; s4 < 16; ++s4) {
            const float4 v4 = *(const float4*)(row + s4 * 4); const float vv[4] = {v4.x, v4.y, v4.z, v4.w};
#pragma unroll
            for (int e = 0; e < 4; ++e) { const int s2 = s4 * 4 + e;
#pragma unroll
                for (int j = 0; j < 8; ++j) rank[j] += (vv[e] > mine[j] || (vv[e] == mine[j] && s2 < sg * 8 + j)) ? 1 : 0; }
        }
        unsigned long long bits = 0ull;
#pragma unroll
        for (int j = 0; j < 8; ++j) if (rank[j] < KTOP) bits |= 1ull << (sg * 8 + j);
        unsigned lo = (unsigned)bits, hi2 = (unsigned)(bits >> 32);
#pragma unroll
        for (int o = 1; o < 8; o <<= 1) { lo |= __shfl_xor(lo, o); hi2 |= __shfl_xor(hi2, o); }
        if (sg == 0) SELM[(mbase + tl) * 4 + g] = ((unsigned long long)hi2 << 32) | lo;
    }
    __syncthreads();
}

DI void sel_item(const bf16* __restrict__ P2, const bf16* __restrict__ VTs, const unsigned long long* __restrict__ SELM, const bf16* __restrict__ OC, const bf16* __restrict__ OW,
                 bf16* __restrict__ AO, int item, char* smem) {
    int b, g, t0; attn_item_decode(item, b, g, t0);
    const int tid = TIDX, lane = tid & 63, wave = tid >> 6, q = lane >> 4, l15 = lane & 15;
    const size_t mbase = (size_t)b * T + t0; const int hbase = g * 4, rr = l15 & 3, h = hbase + rr;
    unsigned long long* orw = (unsigned long long*)(smem + at::OFF_X);
    if (tid == 0) *orw = 0ull;
    __syncthreads();
    if (tid < 32) atomicOr(orw, SELM[(mbase + tid) * 4 + g]);
    const unsigned long long sel0 = SELM[(mbase + wave * 8 + (l15 >> 2)) * 4 + g], sel1 = SELM[(mbase + wave * 8 + 4 + (l15 >> 2)) * 4 + g];
    bf16x8 qf[2][2]; attn_load_q(qf, P2, LDP2, mbase, hbase);
    AttnState st; attn_init(st, at::M_INIT, 0.f);
    __syncthreads();
    const unsigned long long todo_v = (*orw) & range_mask(0, (t0 + 31) >> 6);
    const unsigned long long todo = ((unsigned long long)(unsigned)__builtin_amdgcn_readfirstlane((int)(todo_v >> 32)) << 32) | (unsigned)__builtin_amdgcn_readfirstlane((int)(unsigned)todo_v);
    attn_blocks<AM_SEL>(st, qf, P2 + (size_t)b * T * LDP2 + 1536 + g * 64, LDP2, VTs + (size_t)(b * G + g) * 64 * T, T, t0, todo, hbase, sel0, sel1, smem);
#pragma unroll
    for (int qt = 0; qt < 2; ++qt) {
        const float li = attn_linv(st.lacc[qt]); const size_t m = mbase + wave * 8 + qt * 4 + (l15 >> 2);
        const bf16* gr = P2 + m * LDP2 + 3072;
        const float g0 = sigmoidf_(bf2f(gr[0 * 16 + h])), g1 = sigmoidf_(bf2f(gr[1 * 16 + h])), g2 = sigmoidf_(bf2f(gr[2 * 16 + h]));
#pragma unroll
        for (int dt = 0; dt < 4; ++dt) {
            const int d0 = dt * 16 + 4 * q; const size_t oi = m * D + h * 64 + d0;
            const u32x2 zz = *(const u32x2*)(P2 + m * LDP2 + 2048 + h * 64 + d0), cc = *(const u32x2*)(OC + oi), ww = *(const u32x2*)(OW + oi);
            const f32x4 o = st.o[qt][dt];
            const float r0 = (g0 * bflo(cc[0]) + g1 * o[0] * li + g2 * bflo(ww[0])) * siluf_(bflo(zz[0]));
            const float r1 = (g0 * bfhi(cc[0]) + g1 * o[1] * li + g2 * bfhi(ww[0])) * siluf_(bfhi(zz[0]));
            const float r2 = (g0 * bflo(cc[1]) + g1 * o[2] * li + g2 * bflo(ww[1])) * siluf_(bflo(zz[1]));
            const float r3 = (g0 * bfhi(cc[1]) + g1 * o[3] * li + g2 * bfhi(ww[1])) * siluf_(bfhi(zz[1]));
            *(u32x2*)(AO + oi) = (u32x2){pack2bf(r0, r1), pack2bf(r2, r3)};
        }
    }
    __syncthreads();
}

DI void lru_convert_gates(const float* __restrict__ gaw, const float* __restrict__ gxw, bf16* __restrict__ img) {
    for (int i = blockIdx.x * NTHREADS + TIDX; i < 16 * 160 * 96; i += gridDim.x * NTHREADS) {
        const int k = i % 96, n = (i / 96) % 160, blk = i / (96 * 160);
        float v = 0.f;
        if (k < 80) v = n < 80 ? gaw[((size_t)blk * 80 + k) * 80 + n] : gxw[((size_t)blk * 80 + k) * 80 + (n - 80)];
        img[i] = f2bf(v);
    }
}
DI void lru_gate_item(const bf16* __restrict__ P3, const float* __restrict__ cw, const float* __restrict__ cb, const bf16* __restrict__ gimg, const float* __restrict__ gab, const float* __restrict__ gxb,
                      const float* __restrict__ lam, bf16* __restrict__ LA, bf16* __restrict__ BV, float2* __restrict__ SUM, int item, char* smem) {
    const int rt = item >> 4, nb = item & 15; const int tid = TIDX, lane = tid & 63, wave = tid >> 6, q = lane >> 4, l15 = lane & 15;
    const size_t m0 = (size_t)rt * 128;
    for (int id = tid; id < 128 * 12; id += NTHREADS) {
        const int row = id / 12, c12 = id % 12; u32x4 outv = (u32x4){0u, 0u, 0u, 0u};
        if (c12 < 10) {
            const size_t m = m0 + row; const int t = (int)(m % T); const int ch = nb * 80 + c12 * 8;
            float acc[8];
            { const float4 b0 = *(const float4*)(cb + ch), b1 = *(const float4*)(cb + ch + 4); acc[0] = b0.x; acc[1] = b0.y; acc[2] = b0.z; acc[3] = b0.w; acc[4] = b1.x; acc[5] = b1.y; acc[6] = b1.z; acc[7] = b1.w; }
#pragma unroll
            for (int w = 0; w < 4; ++w) {
                if (t - 3 + w >= 0) {
                    const u32x4 uv = *(const u32x4*)(P3 + (m - 3 + w) * 2560 + ch);
                    const float4 w0 = *(const float4*)(cw + w * LW + ch), w1 = *(const float4*)(cw + w * LW + ch + 4);
                    acc[0] += w0.x * bflo(uv[0]); acc[1] += w0.y * bfhi(uv[0]); acc[2] += w0.z * bflo(uv[1]); acc[3] += w0.w * bfhi(uv[1]);
                    acc[4] += w1.x * bflo(uv[2]); acc[5] += w1.y * bfhi(uv[2]); acc[6] += w1.z * bflo(uv[3]); acc[7] += w1.w * bfhi(uv[3]);
                }
            }
            outv = (u32x4){pack2bf(acc[0], acc[1]), pack2bf(acc[2], acc[3]), pack2bf(acc[4], acc[5]), pack2bf(acc[6], acc[7])};
        }
        const int ks = c12 >> 2, c = c12 & 3;
        *(u32x4*)(smem + ks * 8192 + row * 64 + ((c ^ ((row >> 2) & 3)) << 4)) = outv;
    }
    for (int id = tid; id < 160 * 12; id += NTHREADS) {
        const int row = id / 12, c12 = id % 12; const int ks = c12 >> 2, c = c12 & 3;
        *(u32x4*)(smem + 24576 + ks * 10240 + row * 64 + ((c ^ ((row >> 2) & 3)) << 4)) = *(const u32x4*)(gimg + ((size_t)nb * 160 + row) * 96 + c12 * 8);
    }
    __syncthreads();
    f32x4 acc[2][10];
#pragma unroll
    for (int i = 0; i < 2; ++i)
#pragma unroll
        for (int j = 0; j < 10; ++j) acc[i][j] = (f32x4){0.f, 0.f, 0.f, 0.f};
    const int fo = l15 * 64 + ((q ^ ((l15 >> 2) & 3)) << 4);
#pragma unroll
    for (int ks = 0; ks < 3; ++ks) {
        bf16x8 uf[2];
#pragma unroll
        for (int i = 0; i < 2; ++i) uf[i] = *(const bf16x8*)(smem + ks * 8192 + (wave * 32 + i * 16) * 64 + fo);
#pragma unroll
        for (int j = 0; j < 10; ++j) {
            const bf16x8 wf = *(const bf16x8*)(smem + 24576 + ks * 10240 + j * 1024 + fo);
            acc[0][j] = __builtin_amdgcn_mfma_f32_16x16x32_bf16(wf, uf[0], acc[0][j], 0, 0, 0);
            acc[1][j] = __builtin_amdgcn_mfma_f32_16x16x32_bf16(wf, uf[1], acc[1][j], 0, 0, 0);
        }
    }
    __syncthreads();
#pragma unroll
    for (int i = 0; i < 2; ++i) {
        const int row = wave * 32 + i * 16 + l15; const size_t m = m0 + row;
#pragma unroll
        for (int ct = 0; ct < 5; ++ct) {
            const int kcol = ct * 16 + 4 * q; const int ch = nb * 80 + kcol;
            const u32x2 uu = *(const u32x2*)(smem + (kcol >> 5) * 8192 + row * 64 + ((((kcol & 31) >> 3) ^ ((row >> 2) & 3)) << 4) + (kcol & 7) * 2);
            const float uc[4] = {bflo(uu[0]), bfhi(uu[0]), bflo(uu[1]), bfhi(uu[1])};
            const float4 ba = *(const float4*)(gab + ch), bx = *(const float4*)(gxb + ch), lm = *(const float4*)(lam + ch);
            const float bav[4] = {ba.x, ba.y, ba.z, ba.w}, bxv[4] = {bx.x, bx.y, bx.z, bx.w}, lmv[4] = {lm.x, lm.y, lm.z, lm.w};
            float la[4], bv[4];
#pragma unroll
            for (int r = 0; r < 4; ++r) {
                const float rg = __builtin_amdgcn_rcpf(1.0f + __expf(-(acc[i][ct][r] + bav[r]))), ig = __builtin_amdgcn_rcpf(1.0f + __expf(-(acc[i][ct + 5][r] + bxv[r])));
                la[r] = rg * lmv[r];
                const float om = 1.0f - __expf(2.0f * la[r]);
                bv[r] = __builtin_amdgcn_sqrtf(om > 0.f ? om : 0.f) * (ig * uc[r]);
            }
            const u32x2 lav = {pack2bf(la[0], la[1]), pack2bf(la[2], la[3])}, bvv = {pack2bf(bv[0], bv[1]), pack2bf(bv[2], bv[3])};
            *(u32x2*)(LA + m * LW + ch) = lav; *(u32x2*)(BV + m * LW + ch) = bvv;
            *(u32x2*)(smem + 24576 + (row * 80 + kcol) * 2) = lav; *(u32x2*)(smem + 24576 + 20480 + (row * 80 + kcol) * 2) = bvv;
        }
    }
    __syncthreads();
    if (tid < 160) {
        const int cidx = tid / 80, c = tid % 80; const bf16* li = (const bf16*)(smem + 24576) + (cidx * 64) * 80 + c; const bf16* bi = li + 10240;
        float sla = 0.f, h = 0.f;
#pragma unroll 8
        for (int t = 0; t < 64; ++t) { const float la = bf2f(li[t * 80]), bvv = bf2f(bi[t * 80]); h = __expf(la) * h + bvv; sla += la; }
        const size_t mc = m0 + cidx * 64; const int bb = (int)(mc / T), jj = (int)(mc % T) / 64;
        SUM[((size_t)bb * (T / 64) + jj) * LW + nb * 80 + c] = make_float2(__expf(sla), h);
    }
    __syncthreads();
}
DI void lru_scan2_item(const bf16* __restrict__ LA, const bf16* __restrict__ BV, const float2* __restrict__ SUM, const bf16* __restrict__ P3, bf16* __restrict__ AO, int item) {
    const int cg = item % 5, j = (item / 5) % (T / 64), b = item / (5 * (T / 64)); const int c = cg * 256 + TIDX;
    float h = 0.f;
    for (int jj = 0; jj < j; ++jj) { const float2 s = SUM[((size_t)b * (T / 64) + jj) * LW + c]; h = s.x * h + s.y; }
    const size_t m0 = (size_t)b * T + j * 64;
#pragma unroll 8
    for (int t = 0; t < 64; ++t) {
        const float la = bf2f(LA[(m0 + t) * LW + c]); const float bv = bf2f(BV[(m0 + t) * LW + c]); const float z = bf2f(P3[(m0 + t) * 2560 + LW + c]);
        h = __expf(la) * h + bv; AO[(m0 + t) * LW + c] = f2bf(h * siluf_(z));
    }
}

struct ALoadF32 {
    const float* A;
    static constexpr bool DMA = false;
    DI const bf16* src(int, int) const { return nullptr; }
    struct Raw { float4 a, b; };
    DI Raw load(int m, int k) const { Raw r; r.a = *(const float4*)(A + (size_t)m * 64 + k); r.b = *(const float4*)(A + (size_t)m * 64 + k + 4); return r; }
    DI u32x4 finish(const Raw& r, int, int) const { return (u32x4){pack2bf(r.a.x, r.a.y), pack2bf(r.a.z, r.a.w), pack2bf(r.b.x, r.b.y), pack2bf(r.b.z, r.b.w)}; }
};
struct EpiLora {
    const float* w0; const float* a0; bf16* WL; bf16* AV;
    DI void operator()(int m, int n, const float* v, int, int) const {
        float w[8];
        if (n < 1024) {
#pragma unroll
            for (int j = 0; j < 8; ++j) w[j] = -0.60653065971f * __builtin_amdgcn_rcpf(1.0f + __expf(-(w0[n + j] + v[j])));
            store8bf(WL + (size_t)m * D + n, w);
        } else {
#pragma unroll
            for (int j = 0; j < 8; ++j) w[j] = __builtin_amdgcn_rcpf(1.0f + __expf(-(a0[n - 1024 + j] + v[j])));
            store8bf(AV + (size_t)m * D + n - 1024, w);
        }
    }
    DI void finish(int, int, int, int, int) const {}
    DI void finish_wide(int, int, int, int, int) const {}
};
DI float dpp_sum16(float x) {
    x += __builtin_bit_cast(float, __builtin_amdgcn_update_dpp(0, __builtin_bit_cast(int, x), 0xB1, 0xf, 0xf, false));
    x += __builtin_bit_cast(float, __builtin_amdgcn_update_dpp(0, __builtin_bit_cast(int, x), 0x4E, 0xf, 0xf, false));
    x += __builtin_bit_cast(float, __builtin_amdgcn_update_dpp(0, __builtin_bit_cast(int, x), 0x141, 0xf, 0xf, false));
    x += __builtin_bit_cast(float, __builtin_amdgcn_update_dpp(0, __builtin_bit_cast(int, x), 0x140, 0xf, 0xf, false));
    return x;
}
constexpr int RW_NCH = T / 16;
DI void rwkv_prep_item(bf16* __restrict__ P, bf16* __restrict__ WL, bf16* __restrict__ AV, const float* __restrict__ k_k, const float* __restrict__ k_a, const float* __restrict__ r_k,
                       float* __restrict__ G15, bf16* __restrict__ M2g, bf16* __restrict__ M3g, float* __restrict__ BON, int item, char* smem) {
    const int c = item % RW_NCH, h = (item / RW_NCH) & 15, b = item / (RW_NCH * 16);
    const int tid = TIDX, t = tid >> 4, jq = tid & 15, j0 = jq * 4;
    const size_t m0 = (size_t)b * T + c * 16, m = m0 + t; const size_t ch = (size_t)(b * 16 + h) * RW_NCH + c;
    float* sA = (float*)smem; float* sR = sA + 16 * 68; float* sB = sR + 16 * 68; float* sK = sB + 16 * 68; float* sW = sK + 16 * 68; float* sWl = sW + 16 * 68;
    float* mAab = sWl + 16 * 64; float* mAak = mAab + 16 * 17; float* mArb = mAak + 16 * 17; float* mArk = mArb + 16 * 17; float* mTin = mArk + 16 * 17; float* mM2 = mTin + 16 * 17;
    const u32x2 r2 = *(const u32x2*)(P + m * 4096 + h * 64 + j0), k2 = *(const u32x2*)(P + m * 4096 + 1024 + h * 64 + j0), a2 = *(const u32x2*)(AV + m * D + h * 64 + j0), w2 = *(const u32x2*)(WL + m * D + h * 64 + j0);
    const float rr[4] = {bflo(r2[0]), bfhi(r2[0]), bflo(r2[1]), bfhi(r2[1])}, kr[4] = {bflo(k2[0]), bfhi(k2[0]), bflo(k2[1]), bfhi(k2[1])},
                av[4] = {bflo(a2[0]), bfhi(a2[0]), bflo(a2[1]), bfhi(a2[1])}, wl[4] = {bflo(w2[0]), bfhi(w2[0]), bflo(w2[1]), bfhi(w2[1])};
    const float4 kk4 = *(const float4*)(k_k + h * 64 + j0), ka4 = *(const float4*)(k_a + h * 64 + j0), rk4 = *(const float4*)(r_k + h * 64 + j0);
    const float kkc[4] = {kk4.x, kk4.y, kk4.z, kk4.w}, kac[4] = {ka4.x, ka4.y, ka4.z, ka4.w}, rkc[4] = {rk4.x, rk4.y, rk4.z, rk4.w};
    float kkv[4], n2 = 0.f;
#pragma unroll
    for (int e = 0; e < 4; ++e) { kkv[e] = kr[e] * kkc[e]; n2 += kkv[e] * kkv[e]; }
    n2 = dpp_sum16(n2);
    float nr = sqrtf(n2); nr = nr > 1e-12f ? nr : 1e-12f; const float inr = 1.0f / nr;
    float aa[4], bb[4], kp[4], bon = 0.f;
#pragma unroll
    for (int e = 0; e < 4; ++e) { const float kn = kkv[e] * inr; aa[e] = -kn; bb[e] = kn * av[e]; kp[e] = kr[e] * (1.0f + (av[e] - 1.0f) * kac[e]); bon += rr[e] * kp[e] * rkc[e]; }
    bon = dpp_sum16(bon);
    if (jq == 0) BON[m * 16 + h] = bon;
    *(float4*)(sWl + t * 64 + j0) = make_float4(wl[0], wl[1], wl[2], wl[3]);
    __syncthreads();
    float clx[4] = {0.f, 0.f, 0.f, 0.f};
#pragma unroll
    for (int s = 0; s < 15; ++s) { if (s < t) { const float4 w = *(const float4*)(sWl + s * 64 + j0); clx[0] += w.x; clx[1] += w.y; clx[2] += w.z; clx[3] += w.w; } }
    float bt[4];
    {
        float va[4], vr[4], vk[4], gc[4];
#pragma unroll
        for (int e = 0; e < 4; ++e) { const float cl = clx[e] + wl[e]; const float gp = __expf(clx[e]), gi = __expf(-cl); gc[e] = __expf(cl); va[e] = aa[e] * gp; vr[e] = rr[e] * gc[e]; bt[e] = bb[e] * gi; vk[e] = kp[e] * gi; }
        *(float4*)(sA + t * 68 + j0) = make_float4(va[0], va[1], va[2], va[3]); *(float4*)(sR + t * 68 + j0) = make_float4(vr[0], vr[1], vr[2], vr[3]);
        *(float4*)(sB + t * 68 + j0) = make_float4(bt[0], bt[1], bt[2], bt[3]); *(float4*)(sK + t * 68 + j0) = make_float4(vk[0], vk[1], vk[2], vk[3]);
        {
            char* img = (char*)(mM2 + 16 * 17) + t * 128 + (((j0 >> 3) ^ (t & 7)) << 4) + (j0 & 4) * 2;
            *(u32x2*)(img) = (u32x2){pack2bf(va[0], va[1]), pack2bf(va[2], va[3])}; *(u32x2*)(img + 2048) = (u32x2){pack2bf(vr[0], vr[1]), pack2bf(vr[2], vr[3])};
            *(u32x2*)(img + 4096) = (u32x2){pack2bf(bt[0], bt[1]), pack2bf(bt[2], bt[3])}; *(u32x2*)(img + 6144) = (u32x2){pack2bf(vk[0], vk[1]), pack2bf(vk[2], vk[3])};
        }
        if (t == 15) *(float4*)(G15 + ch * 64 + j0) = make_float4(gc[0], gc[1], gc[2], gc[3]);
#pragma unroll
        for (int e = 0; e < 4; ++e) {   }
#pragma unroll
        for (int e = 0; e < 4; ++e) clx[e] = vk[e];
    }
    __syncthreads();
    {
        const int wv = __builtin_amdgcn_readfirstlane(tid >> 6), lane = tid & 63, q = lane >> 4, l15 = lane & 15;
        const char* xb_ = (const char*)(mM2 + 16 * 17) + (wv >> 1) * 2048;
        const char* yb_ = (const char*)(mM2 + 16 * 17) + 4096 + (wv & 1) * 2048;
        f32x4 acc = {0.f, 0.f, 0.f, 0.f};
#pragma unroll
        for (int ks = 0; ks < 2; ++ks) {
            const int off = l15 * 128 + (((ks * 4 + q) ^ (l15 & 7)) << 4);
            const bf16x8 xf = *(const bf16x8*)(xb_ + off), yf = *(const bf16x8*)(yb_ + off);
            acc = __builtin_amdgcn_mfma_f32_16x16x32_bf16(xf, yf, acc, 0, 0, 0);
        }
        float* dst = wv == 0 ? mAab : (wv == 1 ? mAak : (wv == 2 ? mArb : mArk));
        const bool strict = wv < 2;
#pragma unroll
        for (int r = 0; r < 4; ++r) { const int tt = 4 * q + r, ss = l15; dst[tt * 17 + ss] = (strict ? ss < tt : ss <= tt) ? acc[r] : 0.f; }
    }
    __syncthreads();
    if (tid < 16) {
        float col[16];
#pragma unroll
        for (int i = 0; i < 16; ++i) {
            float acc = (i == tid) ? 1.0f : 0.f;
#pragma unroll
            for (int jj = 0; jj < i; ++jj) acc += mAab[i * 17 + jj] * col[jj];
            col[i] = acc; mTin[i * 17 + tid] = acc;
        }
    }
    __syncthreads();
    float wv[4] = {0.f, 0.f, 0.f, 0.f}, m2 = 0.f;
#pragma unroll
    for (int s = 0; s < 16; ++s) { const float ti = mTin[t * 17 + s]; const float4 a4 = *(const float4*)(sA + s * 68 + j0); wv[0] += ti * a4.x; wv[1] += ti * a4.y; wv[2] += ti * a4.z; wv[3] += ti * a4.w; m2 += ti * mAak[s * 17 + jq]; }
    *(float4*)(sW + t * 68 + j0) = make_float4(wv[0], wv[1], wv[2], wv[3]); mM2[t * 17 + jq] = m2;
    __syncthreads();
    float rh[4]; { const float4 r4 = *(const float4*)(sR + t * 68 + j0); rh[0] = r4.x; rh[1] = r4.y; rh[2] = r4.z; rh[3] = r4.w; }
    float m3 = mArk[t * 17 + jq];
#pragma unroll
    for (int s = 0; s < 16; ++s) { const float ar = mArb[t * 17 + s]; const float4 w4 = *(const float4*)(sW + s * 68 + j0); rh[0] += ar * w4.x; rh[1] += ar * w4.y; rh[2] += ar * w4.z; rh[3] += ar * w4.w; m3 += ar * mM2[s * 17 + jq]; }
    *(u32x2*)(WL + m * D + h * 64 + j0) = (u32x2){pack2bf(wv[0], wv[1]), pack2bf(wv[2], wv[3])};
    *(u32x2*)(P + m * 4096 + h * 64 + j0) = (u32x2){pack2bf(rh[0], rh[1]), pack2bf(rh[2], rh[3])};
#pragma unroll
    for (int e = 0; e < 4; ++e) { AV[(m0 + jq) * D + h * 64 + e * 16 + t] = f2bf(bt[e]); P[(m0 + jq) * 4096 + 1024 + h * 64 + e * 16 + t] = f2bf(clx[e]); }
    M2g[ch * 256 + t * 16 + jq] = f2bf(m2); M3g[ch * 256 + t * 16 + jq] = f2bf(m3);
    __syncthreads();
}

#define MFMA32(a, b, c) __builtin_amdgcn_mfma_f32_16x16x32_bf16(__builtin_bit_cast(bf16x8, a), __builtin_bit_cast(bf16x8, b), c, 0, 0, 0)
DI void rwkv_chunk_scan(const bf16* __restrict__ P, const bf16* __restrict__ WL, const bf16* __restrict__ AV, const float* __restrict__ G15, const bf16* __restrict__ M2g, const bf16* __restrict__ M3g,
                        bf16* __restrict__ YS, int bh, char* smem) {
    constexpr int SLOT = 12288, YOFF = 49152;
    const int tid = TIDX, lane = tid & 63, vs = __builtin_amdgcn_readfirstlane(tid >> 6), q = lane >> 4, l15 = lane & 15; const int b = bh >> 4, h = bh & 15;
    const size_t mb = (size_t)b * T; const size_t ch0 = (size_t)(b * 16 + h) * RW_NCH;
    const char *s0, *s1, *s2; size_t d0, d1, d2;
    if (tid < 128) { const int c8 = tid >> 4, t = tid & 15; s0 = (const char*)(WL + (mb + t) * D + h * 64 + c8 * 8); d0 = (size_t)16 * D * 2; }
    else { const int pp = tid - 128, c8 = pp >> 4, t = pp & 15; s0 = (const char*)(P + (mb + t) * 4096 + h * 64 + c8 * 8); d0 = (size_t)16 * 4096 * 2; }
    if (tid < 128) { const int r = tid >> 3, c8 = tid & 7; s1 = (const char*)(P + (mb + r) * 4096 + 1024 + h * 64 + c8 * 8); d1 = (size_t)16 * 4096 * 2; }
    else { const int pp = tid - 128, r = pp >> 3, c8 = pp & 7; s1 = (const char*)(AV + (mb + r) * D + h * 64 + c8 * 8); d1 = (size_t)16 * D * 2; }
    if (tid < 128) { const int r = tid >> 3, c8 = tid & 7; s2 = (const char*)(P + (mb + r) * 4096 + 2048 + h * 64 + c8 * 8); d2 = (size_t)16 * 4096 * 2; }
    else if (tid < 160) { s2 = (const char*)(M2g + ch0 * 256 + (tid - 128) * 8); d2 = 512; }
    else if (tid < 192) { s2 = (const char*)(M3g + ch0 * 256 + (tid - 160) * 8); d2 = 512; }
    else { const int pp = tid < 208 ? tid - 192 : 0; s2 = (const char*)(G15 + ch0 * 64 + pp * 4); d2 = 256; }
    const int dma_off = vs * 1024;
#define RW_DMA(c_) { char* dst = smem + ((c_) & 3) * SLOT + dma_off; GLDS16(s0 + (size_t)(c_) * d0, dst); GLDS16(s1 + (size_t)(c_) * d1, dst + 4096); GLDS16(s2 + (size_t)(c_) * d2, dst + 8192); }
#define RW_BARRIER() { asm volatile("s_waitcnt lgkmcnt(0)" ::: "memory"); __builtin_amdgcn_s_barrier(); asm volatile("" ::: "memory"); }
    f32x4 H0 = {0.f, 0.f, 0.f, 0.f}, H1 = H0, H2 = H0, H3 = H0;
    const int oW = (((q >> 1)) * 16 + l15) * 16 + (q & 1) * 8;
    const int oK = 4096 + ((l15 >> 2) * 8 + (l15 & 3) * 2 + (q >> 1)) * 16 + (q & 1) * 8;
    const int oM = 10240 + l15 * 32 + q * 8;
    const int oV = 8192 + (4 * q) * 128 + (vs * 16 + l15) * 2;
    const int oG = 11264 + (4 * q) * 4;
    const int oY = YOFF + ((4 * q) * 64 + vs * 16 + l15) * 2;
    RW_DMA(0); RW_DMA(1); RW_DMA(2);
    asm volatile("s_waitcnt vmcnt(6)" ::: "memory");
    RW_BARRIER();
    for (int c = 0; c < RW_NCH; ++c) {
        if (c + 3 < RW_NCH) RW_DMA(c + 3);
        const char* sl = smem + (c & 3) * SLOT;
        {
            const f32x4 z4 = {0.f, 0.f, 0.f, 0.f};
            const u32x4 Hb0 = {pack2bf(H0[0], H0[1]), pack2bf(H0[2], H0[3]), pack2bf(H1[0], H1[1]), pack2bf(H1[2], H1[3])};
            const u32x4 Hb1 = {pack2bf(H2[0], H2[1]), pack2bf(H2[2], H2[3]), pack2bf(H3[0], H3[1]), pack2bf(H3[2], H3[3])};
            const unsigned v0 = *(const bf16*)(sl + oV), v1 = *(const bf16*)(sl + oV + 128), v2 = *(const bf16*)(sl + oV + 256), v3 = *(const bf16*)(sl + oV + 384);
            const unsigned v01 = v0 | (v1 << 16), v23 = v2 | (v3 << 16);
            const u32x4 Vlo = {v01, v23, 0u, 0u};
            const u32x2 m2 = *(const u32x2*)(sl + oM), m3 = *(const u32x2*)(sl + oM + 512);
            const u32x2 w0 = *(const u32x2*)(sl + oW), w1 = *(const u32x2*)(sl + oW + 512), w2 = *(const u32x2*)(sl + oW + 1024), w3 = *(const u32x2*)(sl + oW + 1536);
            const u32x2 r0 = *(const u32x2*)(sl + 2048 + oW), r1 = *(const u32x2*)(sl + 2048 + oW + 512), r2 = *(const u32x2*)(sl + 2048 + oW + 1024), r3 = *(const u32x2*)(sl + 2048 + oW + 1536);
            f32x4 U = MFMA32(((u32x4){m2[0], m2[1], 0u, 0u}), Vlo, z4);
            U = MFMA32(((u32x4){w0[0], w0[1], w1[0], w1[1]}), Hb0, U); U = MFMA32(((u32x4){w2[0], w2[1], w3[0], w3[1]}), Hb1, U);
            f32x4 Y = MFMA32(((u32x4){m3[0], m3[1], 0u, 0u}), Vlo, z4);
            Y = MFMA32(((u32x4){r0[0], r0[1], r1[0], r1[1]}), Hb0, Y); Y = MFMA32(((u32x4){r2[0], r2[1], r3[0], r3[1]}), Hb1, Y);
            const u32x4 VU = {v01, v23, pack2bf(U[0], U[1]), pack2bf(U[2], U[3])};
            const u32x2 k0 = *(const u32x2*)(sl + oK), k1 = *(const u32x2*)(sl + oK + 512), k2 = *(const u32x2*)(sl + oK + 1024), k3 = *(const u32x2*)(sl + oK + 1536);
            const u32x2 b0 = *(const u32x2*)(sl + 2048 + oK), b1 = *(const u32x2*)(sl + 2048 + oK + 512), b2 = *(const u32x2*)(sl + 2048 + oK + 1024), b3 = *(const u32x2*)(sl + 2048 + oK + 1536);
            const f32x4 g0 = *(const f32x4*)(sl + oG), g1 = *(const f32x4*)(sl + oG + 64), g2 = *(const f32x4*)(sl + oG + 128), g3 = *(const f32x4*)(sl + oG + 192);
            const f32x4 a0 = MFMA32(((u32x4){k0[0], k0[1], b0[0], b0[1]}), VU, H0), a1 = MFMA32(((u32x4){k1[0], k1[1], b1[0], b1[1]}), VU, H1);
            const f32x4 a2 = MFMA32(((u32x4){k2[0], k2[1], b2[0], b2[1]}), VU, H2), a3 = MFMA32(((u32x4){k3[0], k3[1], b3[0], b3[1]}), VU, H3);
            H0 = a0 * g0; H1 = a1 * g1; H2 = a2 * g2; H3 = a3 * g3;
            char* yb = smem + oY + (c & 7) * 2048;
#pragma unroll
            for (int r = 0; r < 4; ++r) *(bf16*)(yb + r * 128) = f2bf(Y[r]);
        }
        const bool flush = (c & 7) == 7;
        if (flush) {
            RW_BARRIER();
            u32x4 yv[4];
#pragma unroll
            for (int k = 0; k < 4; ++k) yv[k] = *(const u32x4*)(smem + YOFF + (tid + 256 * k) * 16);
#pragma unroll
            for (int k = 0; k < 4; ++k) { const int pc = tid + 256 * k, rr = pc >> 3, c8 = pc & 7; *(u32x4*)(YS + (mb + (size_t)(c - 7) * 16 + rr) * D + h * 64 + c8 * 8) = yv[k]; }
            asm volatile("s_waitcnt vmcnt(0)" ::: "memory");
        } else if (c + 3 < RW_NCH) { asm volatile("s_waitcnt vmcnt(6)" ::: "memory"); }
        else if (c + 2 < RW_NCH) { asm volatile("s_waitcnt vmcnt(3)" ::: "memory"); }
        else { asm volatile("s_waitcnt vmcnt(0)" ::: "memory"); }
        RW_BARRIER();
    }
#undef RW_DMA
#undef RW_BARRIER
}
DI void rwkv_gn_rows2(const bf16* __restrict__ P, const float* __restrict__ BON, const float* __restrict__ lnw, const float* __restrict__ lnb, bf16* __restrict__ YS) {
    const int tid = TIDX, lane = tid & 63, wave = tid >> 6; const int c = wave * 256 + lane * 4;
    const float4 lw = *(const float4*)(lnw + c), lb = *(const float4*)(lnb + c);
    for (size_t m = blockIdx.x; m < (size_t)M; m += gridDim.x) {
        const u32x2 yy = *(const u32x2*)(YS + m * D + c), vv = *(const u32x2*)(P + m * 4096 + 2048 + c), zz = *(const u32x2*)(P + m * 4096 + 3072 + c);
        const float bs = BON[m * 16 + (c >> 6)];
        const float y[4] = {bflo(yy[0]), bfhi(yy[0]), bflo(yy[1]), bfhi(yy[1])}, v[4] = {bflo(vv[0]), bfhi(vv[0]), bflo(vv[1]), bfhi(vv[1])}, z[4] = {bflo(zz[0]), bfhi(zz[0]), bflo(zz[1]), bfhi(zz[1])};
        const float lwv[4] = {lw.x, lw.y, lw.z, lw.w}, lbv[4] = {lb.x, lb.y, lb.z, lb.w};
        const float mean = dpp_sum16((y[0] + y[1]) + (y[2] + y[3])) * (1.0f / 64.0f);
        float var = 0.f;
#pragma unroll
        for (int i = 0; i < 4; ++i) { const float d = y[i] - mean; var += d * d; }
        var = dpp_sum16(var) * (1.0f / 64.0f);
        const float rstd = 1.0f / sqrtf(var + 64e-5f);
        float o[4];
#pragma unroll
        for (int i = 0; i < 4; ++i) o[i] = ((y[i] - mean) * rstd * lwv[i] + lbv[i] + bs * v[i]) * siluf_(z[i]);
        *(u32x2*)(YS + m * D + c) = (u32x2){pack2bf(o[0], o[1]), pack2bf(o[2], o[3])};
    }
}

struct FastBufs { char* ws; };

DI void rows_xb_parts(const float* __restrict__ x, bf16* xb, float* parts) {
    const int lane = TIDX & 63, wave = TIDX >> 6;
    for (int m = blockIdx.x * 4 + wave; m < M; m += gridDim.x * 4) {
        const float* xr = x + (size_t)m * D; float s = 0.f;
#pragma unroll
        for (int i = 0; i < 2; ++i) {
            const int k = (i * 64 + lane) * 8; const float4 a = *(const float4*)(xr + k), b = *(const float4*)(xr + k + 4);
            const float w[8] = {a.x, a.y, a.z, a.w, b.x, b.y, b.z, b.w};
#pragma unroll
            for (int j = 0; j < 8; ++j) s += w[j] * w[j];
            store8bf(xb + (size_t)m * D + k, w);
        }
#pragma unroll
        for (int o = 32; o >= 1; o >>= 1) s += __shfl_xor(s, o);
        if (lane < 16) parts[(size_t)m * 16 + lane] = lane == 0 ? s : 0.f;
    }
}
DI void rows_xn(const float* __restrict__ x, const float* parts, const float* __restrict__ g, bf16* xn) {
    const int lane = TIDX & 63, wave = TIDX >> 6;
    for (int m = blockIdx.x * 4 + wave; m < M; m += gridDim.x * 4) {
        const float rs = rstd_from_parts(parts, m); const float* xr = x + (size_t)m * D;
#pragma unroll
        for (int i = 0; i < 2; ++i) {
            const int k = (i * 64 + lane) * 8; const float4 a = *(const float4*)(xr + k), b = *(const float4*)(xr + k + 4);
            const float4 ga = *(const float4*)(g + k), gb = *(const float4*)(g + k + 4);
            const float w[8] = {a.x * rs * ga.x, a.y * rs * ga.y, a.z * rs * ga.z, a.w * rs * ga.w, b.x * rs * gb.x, b.y * rs * gb.y, b.z * rs * gb.z, b.w * rs * gb.w};
            store8bf(xn + (size_t)m * D + k, w);
        }
    }
}
DI void rows_final(float* x, const float* parts, const float* __restrict__ g) {
    const int lane = TIDX & 63, wave = TIDX >> 6;
    for (int m = blockIdx.x * 4 + wave; m < M; m += gridDim.x * 4) {
        const float rs = rstd_from_parts(parts, m); float* xr = x + (size_t)m * D;
#pragma unroll
        for (int i = 0; i < 4; ++i) {
            const int k = (i * 64 + lane) * 4; float4 a = *(float4*)(xr + k); const float4 ga = *(const float4*)(g + k);
            a.x *= rs * ga.x; a.y *= rs * ga.y; a.z *= rs * ga.z; a.w *= rs * ga.w; *(float4*)(xr + k) = a;
        }
    }
}
enum { PH_PREP0 = 0, PH_IN0, PH_ATTN0, PH_OUT0, PH_PREP1, PH_IN1, PH_LORA1, PH_CPREP1, PH_SCAN1, PH_GN1, PH_OUT1, PH_PREP2, PH_IN2, PH_B2, PH_C2, PH_D2, PH_OUT2, PH_PREP3, PH_IN3, PH_GATE3, PH_SCANA3, PH_SCANB3, PH_OUT3, PH_FINAL };

namespace wbo {
constexpr size_t IN = 0;
constexpr size_t OUT = (size_t)4352 * 1024;
constexpr size_t EXTRA = OUT + (size_t)1280 * 1024;
}

template <int PH>
DI void run_phase(const Params& p, char* smem) {
    char* ws = p.ws;
    float* parts = (float*)(ws + fw::PARTS);
    constexpr int LAYER = PH <= PH_OUT0 ? 0 : PH <= PH_OUT1 ? 1 : PH <= PH_OUT2 ? 2 : 3;
    constexpr size_t WBOFF = LAYER == 0 ? 200 * fw::MB : LAYER == 1 ? 238 * fw::MB : LAYER == 2 ? 240 * fw::MB : 1 * fw::MB;
    bf16* WB = (bf16*)(ws + WBOFF);
    bf16* XB = (bf16*)(ws + ((PH == PH_PREP0 || PH == PH_IN0) ? 130 * fw::MB : 174 * fw::MB));
    bf16* P = (bf16*)(ws + wsl::P);
    float* X = p.out;
    float* smf = (float*)smem;
    if (PH == PH_PREP0) {
        rows_xb_parts(p.x, XB, parts);
        int tb = 0;
        convert_seg(p.a_w_in, A_COLS, 0, A_COLS, 1024, WB + wbo::IN, p.norm_g + 0 * D, smf, tb);
        convert_seg(p.a_w_out, 1024, 0, 1024, 1024, WB + wbo::OUT, nullptr, smf, tb);
    } else if (PH == PH_IN0) {
        gemm_sched(8, 4, [&](bool big, int mt, int nt) {
            if (big) gemm_tile2(ALoadPlain{XB, D}, WB + wbo::IN, 1024, mt * 128, nt * 256, EpiL0{P, (bf16*)(ws + 86 * fw::MB), parts}, smem);
            else gemm_tile(ALoadPlain{XB, D}, WB + wbo::IN, 1024, mt * 128, 2048 + nt * 128, EpiL0{P, (bf16*)(ws + 86 * fw::MB), parts}, smem);
        });
    } else if (PH == PH_ATTN0) {
        build_bias_lut(p.t5, smem, true);
        for (int it = blockIdx.x; it < B * G * (T / 32); it += gridDim.x) swa_item(P, (const bf16*)(ws + 86 * fw::MB), p.a_sinks, (bf16*)(ws + wsl::L0_AO), it, smem);
    } else if (PH == PH_OUT0) {
        gemm_sched(4, 0, [&](bool, int mt, int nt) { gemm_tile2(ALoadPlain{(const bf16*)(ws + wsl::L0_AO), D}, WB + wbo::OUT, 1024, mt * 128, nt * 256, EpiResid{p.x, X, nullptr, parts}, smem); });
    } else if (PH == PH_PREP1) {
        rows_xn(X, parts, p.norm_g + 1 * D, (bf16*)(ws + wsl::L1_XN));
        int tb = 0;
        convert_seg(p.b_w_in, 4096, 0, 4096, 1024, WB + wbo::IN, nullptr, smf, tb);
        convert_seg(p.b_w1, 64, 0, 64, 1024, WB + wbo::IN + (size_t)4096 * 1024, nullptr, smf, tb);
        convert_seg(p.b_a1, 64, 0, 64, 1024, WB + wbo::IN + (size_t)(4096 + 128) * 1024, nullptr, smf, tb);
        convert_seg(p.b_w_out, 1024, 0, 1024, 1024, WB + wbo::OUT, nullptr, smf, tb);
        convert_seg(p.b_w2, 1024, 0, 1024, 64, WB + wbo::EXTRA, nullptr, smf, tb);
        convert_seg(p.b_a2, 1024, 0, 1024, 64, WB + wbo::EXTRA + (size_t)1024 * 64, nullptr, smf, tb);
        for (size_t i = (size_t)blockIdx.x * 256 + TIDX; i < (size_t)64 * 1024 / 8; i += (size_t)gridDim.x * 256) {
            ((u32x4*)(WB + wbo::IN + (size_t)(4096 + 64) * 1024))[i] = (u32x4){0u, 0u, 0u, 0u};
            ((u32x4*)(WB + wbo::IN + (size_t)(4096 + 192) * 1024))[i] = (u32x4){0u, 0u, 0u, 0u};
        }
    } else if (PH == PH_IN1) {
        const bf16* XN = (const bf16*)(ws + wsl::L1_XN);
        EpiRwkv epi{P, (float*)(ws + wsl::LHW), (float*)(ws + wsl::LHA)};
        gemm_sched(16, 2, [&](bool big, int mt, int nt) {
            if (big) gemm_tile2(ALoadLerp{XN, p.b_mu + (nt >> 2) * D}, WB + wbo::IN, 1024, mt * 128, nt * 256, epi, smem);
            else gemm_tile(ALoadLerp{XN, p.b_mu + (4 + nt) * D}, WB + wbo::IN, 1024, mt * 128, 4096 + nt * 128, epi, smem);
        });
    } else if (PH == PH_LORA1) {
        const int ntile = (M / 128) * 16;
        EpiLora epi{p.b_w0, p.b_a0, (bf16*)(ws + wsl::L1_WL), (bf16*)(ws + wsl::L1_AV)};
        (void)ntile;
        gemm_sched(8, 0, [&](bool, int mt, int nt) { gemm_tile2(ALoadF32{(const float*)(ws + (nt < 4 ? wsl::LHW : wsl::LHA))}, WB + wbo::EXTRA, 64, mt * 128, nt * 256, epi, smem); });
    } else if (PH == PH_CPREP1) {
        for (int it = blockIdx.x; it < B * 16 * RW_NCH; it += gridDim.x)
            rwkv_prep_item(P, (bf16*)(ws + wsl::L1_WL), (bf16*)(ws + wsl::L1_AV), p.b_k_k, p.b_k_a, p.b_r_k, (float*)(ws + 9 * fw::MB), (bf16*)(ws + 1 * fw::MB), WB, (float*)(ws + 254 * fw::MB), it, smem);
    } else if (PH == PH_SCAN1) {
        const int bid = blockIdx.x;
        if ((bid & 31) < 8 && (bid >> 5) < 8) {
            const int it = (bid >> 5) * 8 + (bid & 31);
            rwkv_chunk_scan(P, (const bf16*)(ws + wsl::L1_WL), (const bf16*)(ws + wsl::L1_AV), (const float*)(ws + 9 * fw::MB), (const bf16*)(ws + 1 * fw::MB), WB, (bf16*)(ws + wsl::L1_XN), it, smem);
        }
    } else if (PH == PH_GN1) {
        rwkv_gn_rows2(P, (const float*)(ws + 254 * fw::MB), p.b_lnx_w, p.b_lnx_b, (bf16*)(ws + wsl::L1_XN));
    } else if (PH == PH_OUT1) {
        gemm_sched(4, 0, [&](bool, int mt, int nt) { gemm_tile2(ALoadPlain{(const bf16*)(ws + wsl::L1_XN), D}, WB + wbo::OUT, 1024, mt * 128, nt * 256, EpiResid{X, X, XB, parts}, smem); });
    } else if (PH == PH_PREP2) {
        int tb = 0;
        const float* g2 = p.norm_g + 2 * D;
        convert_seg(p.c_w_in, C_COLS, 0, 2560, 1024, WB + wbo::IN, g2, smf, tb);
        convert_seg(p.c_w_in, C_COLS, 2608, 1024, 1024, WB + wbo::IN + (size_t)2560 * 1024, g2, smf, tb);
        convert_seg(p.c_w_in, C_COLS, 2560, 64, 1024, WB + wbo::IN + (size_t)3584 * 1024, g2, smf, tb);
        convert_seg(p.c_w_out, 1024, 0, 1024, 1024, WB + wbo::OUT, nullptr, smf, tb);
        convert_seg(p.c_k_w1, 128, 0, 128, 2048, WB + wbo::EXTRA, nullptr, smf, tb);
        convert_seg(p.c_v_w1, 128, 0, 128, 2048, WB + wbo::EXTRA + (size_t)128 * 2048, nullptr, smf, tb);
        convert_seg(p.c_k_w2, 64, 0, 64, 128, WB + wbo::EXTRA + (size_t)256 * 2048, nullptr, smf, tb);
        convert_seg(p.c_v_w2, 64, 0, 64, 128, WB + wbo::EXTRA + (size_t)256 * 2048 + 64 * 128, nullptr, smf, tb);
        if (blockIdx.x < 16) {
            const int which = blockIdx.x >> 3, i = blockIdx.x & 7; const float* pos = which ? p.c_pos_v : p.c_pos_k; const float* w1 = which ? p.c_v_w1 : p.c_k_w1;
            float* b8 = (float*)(ws + 12 * fw::MB);
            if (TIDX < 128) { float a = 0.f; for (int k = i * 256; k < i * 256 + 256; ++k) a += pos[k] * w1[(size_t)k * 128 + TIDX]; b8[(which * 8 + i) * 128 + TIDX] = a; }
        }
    } else if (PH == PH_IN2) {
        gemm_sched(14, 1, [&](bool big, int mt, int nt) {
            if (big) gemm_tile2(ALoadPlain{XB, D}, WB + wbo::IN, 1024, mt * 128, nt * 256, EpiL2{P, (bf16*)(ws + 114 * fw::MB), (bf16*)(ws + 122 * fw::MB), parts}, smem);
            else gemm_tile(ALoadPlain{XB, D}, WB + wbo::IN, 1024, mt * 128, 3584 + nt * 128, EpiL2{P, (bf16*)(ws + 114 * fw::MB), (bf16*)(ws + 122 * fw::MB), parts}, smem);
        });
    } else if (PH == PH_B2) {
        for (int it = blockIdx.x; it < 64; it += gridDim.x) { const int which = it >> 5, rt = it & 31;
            cmp_tile(P, WB + wbo::EXTRA + (size_t)which * 128 * 2048, (const float*)(ws + 12 * fw::MB) + which * 8 * 128, WB + wbo::EXTRA + (size_t)256 * 2048 + which * 64 * 128, which, rt,
                     (bf16*)(ws + 5 * fw::MB), (bf16*)(ws + 6 * fw::MB), smem); }
        build_bias_lut(p.t5, smem, false);
        const int nitem = 64 + B * G * (T / 32);
        for (int it = blockIdx.x < 64 ? blockIdx.x + gridDim.x : blockIdx.x; it < nitem; it += gridDim.x) win_item(P, (const bf16*)(ws + 122 * fw::MB), (bf16*)(ws + 130 * fw::MB), it - 64, smem);
    } else if (PH == PH_C2) {
        for (int it = blockIdx.x; it < B * G * (T / 32); it += gridDim.x)
            cmpsel_item(P, (const bf16*)(ws + 5 * fw::MB), (const bf16*)(ws + 6 * fw::MB), (bf16*)(ws + 162 * fw::MB), (unsigned long long*)(ws + 9 * fw::MB), it, smem);
    } else if (PH == PH_D2) {
        build_bias_lut(p.t5, smem, false);
        for (int it = blockIdx.x; it < B * G * (T / 32); it += gridDim.x)
            sel_item(P, (const bf16*)(ws + 114 * fw::MB), (const unsigned long long*)(ws + 9 * fw::MB), (const bf16*)(ws + 162 * fw::MB), (const bf16*)(ws + 130 * fw::MB), (bf16*)(ws + 206 * fw::MB), it, smem);
    } else if (PH == PH_OUT2) {
        gemm_sched(4, 0, [&](bool, int mt, int nt) { gemm_tile2(ALoadPlain{(const bf16*)(ws + 206 * fw::MB), D}, WB + wbo::OUT, 1024, mt * 128, nt * 256, EpiResid{X, X, XB, parts}, smem); });
    } else if (PH == PH_PREP3) {
        int tb = 0;
        convert_seg(p.d_w_in, 2560, 0, 2560, 1024, WB + wbo::IN, p.norm_g + 3 * D, smf, tb);
        convert_seg(p.d_w_out, 1024, 0, 1024, 1280, WB + wbo::OUT, nullptr, smf, tb);
        lru_convert_gates(p.d_ga_w, p.d_gx_w, WB + wbo::EXTRA);
        for (int i = blockIdx.x * NTHREADS + TIDX; i < LW; i += gridDim.x * NTHREADS) ((float*)(ws + 12 * fw::MB + 786432))[i] = -8.0f * softplusf_(-p.d_lambda[i]);
    } else if (PH == PH_IN3) {
        gemm_sched(8, 4, [&](bool big, int mt, int nt) {
            if (big) gemm_tile2(ALoadPlain{XB, D}, WB + wbo::IN, 1024, mt * 128, nt * 256, EpiBf16{P, 2560, parts}, smem);
            else gemm_tile(ALoadPlain{XB, D}, WB + wbo::IN, 1024, mt * 128, 2048 + nt * 128, EpiBf16{P, 2560, parts}, smem);
        });
    } else if (PH == PH_GATE3) {
        for (int it = blockIdx.x; it < (M / 128) * 16; it += gridDim.x)
            lru_gate_item(P, p.d_conv_w, p.d_conv_b, WB + wbo::EXTRA, p.d_ga_b, p.d_gx_b, (const float*)(ws + 12 * fw::MB + 786432), (bf16*)(ws + wsl::L3_LA), (bf16*)(ws + wsl::L3_BV), (float2*)(ws + wsl::L3_UC), it, smem);
    } else if (PH == PH_SCANB3) {
        for (int it = blockIdx.x; it < B * (T / 64) * 5; it += gridDim.x)
            lru_scan2_item((const bf16*)(ws + wsl::L3_LA), (const bf16*)(ws + wsl::L3_BV), (const float2*)(ws + wsl::L3_UC), P, (bf16*)(ws + wsl::L3_AO), it);
    } else if (PH == PH_OUT3) {
        gemm_sched(4, 0, [&](bool, int mt, int nt) { gemm_tile2(ALoadPlain{(const bf16*)(ws + wsl::L3_AO), LW}, WB + wbo::OUT, 1280, mt * 128, nt * 256, EpiResid{X, X, nullptr, parts}, smem); });
    } else if (PH == PH_FINAL) {
        rows_final(X, parts, p.final_g);
    }
}

template <int PH> __global__ void __launch_bounds__(NTHREADS, 2) k_phase(Params p) {
    extern __shared__ __attribute__((aligned(16))) char smem[];
    run_phase<PH>(p, smem);
}
#define LDS_BYTES 73728
#define MEGA_LDS_BYTES (73728 + 64)
template <int PH> static void launch_phase(const Params& p, hipStream_t s) {
    static bool attr = false;
    if (!attr) { hipFuncSetAttribute((const void*)k_phase<PH>, hipFuncAttributeMaxDynamicSharedMemorySize, LDS_BYTES); attr = true; }
    hipLaunchKernelGGL(k_phase<PH>, dim3(512), dim3(NTHREADS), LDS_BYTES, s, p);
}


#define XB_TMO      128
#define XB_XCNT(j)  (256  + 64 * (j))
#define XB_XSUB(j)  (1280 + 64 * (j))
#define XB_XGEN(j)  (2304 + 64 * (j))
#define XB_TOP      3328
#define XB_TOPGEN   3392
#define XCD_BAR_WORDS 3456
#define XB_SPIN_CAP (1u << 22)
#define LAS __attribute__((address_space(3)))
DI unsigned xb_ld(unsigned* p)              { return __hip_atomic_load(p, __ATOMIC_RELAXED, __HIP_MEMORY_SCOPE_AGENT); }
DI unsigned xb_add(unsigned* p, unsigned v) { return __hip_atomic_fetch_add(p, v, __ATOMIC_RELAXED, __HIP_MEMORY_SCOPE_AGENT); }
DI unsigned xb_xcc_id() { return (unsigned)__builtin_amdgcn_s_getreg((3 << 11) | 20) & 0xFu; }
#define XB_SPIN(cond, bar) do { unsigned _sp = 0; while (cond) { if (_sp < 64u) __builtin_amdgcn_s_sleep(2); else __builtin_amdgcn_s_sleep(32); \
    if ((++_sp & 255u) == 0u) { if (xb_ld(&(bar)[XB_TMO])) break; if (_sp > XB_SPIN_CAP) { atomicAdd(&(bar)[XB_TMO], 1u); break; } } } } while (0)
struct XcdBarrier { unsigned* bar; unsigned x; volatile LAS unsigned* st; };
DI XcdBarrier xcd_barrier_post(unsigned* bar, volatile LAS unsigned* st) {
    XcdBarrier b; b.bar = bar; b.x = xb_xcc_id(); b.st = st;
    if (threadIdx.x == 0) (void)xb_add(&bar[XB_XCNT(b.x)], 1u);
    return b;
}
DI void xcd_barrier_complete(unsigned* bar, unsigned x, unsigned& nloc, unsigned& nx) {
    const unsigned G = gridDim.x * gridDim.y * gridDim.z;
    unsigned sum, cnt, mine, sp = 0u;
    for (;;) {
        sum = 0u; cnt = 0u; mine = 0u;
#pragma unroll
        for (unsigned j = 0; j < 16; ++j) { const unsigned c = xb_ld(&bar[XB_XCNT(j)]); sum += c; cnt += (c > 0u) ? 1u : 0u; mine = (j == x) ? c : mine; }
        if (sum == G) break;
        __builtin_amdgcn_s_sleep(1);
        if ((++sp & 255u) == 0u) { if (xb_ld(&bar[XB_TMO])) break; if (sp > XB_SPIN_CAP) { atomicAdd(&bar[XB_TMO], 1u); break; } }
    }
    nloc = mine > 0u ? mine : 1u; nx = cnt > 0u ? cnt : 1u;
}
DI void xcd_barrier(const XcdBarrier& b) {
    asm volatile("s_waitcnt vmcnt(0)" ::: "memory");
    __syncthreads();
    if (threadIdx.x == 0) {
        unsigned* bar = b.bar;
        __builtin_amdgcn_s_waitcnt(0);
        unsigned nloc = b.st[0], nx = b.st[1];
        if (nloc == 0u) { xcd_barrier_complete(bar, b.x, nloc, nx); b.st[0] = nloc; b.st[1] = nx; }
        const unsigned old = xb_add(&bar[XB_XSUB(b.x)], 1u);
        const unsigned gen = old / nloc;
        if (old + 1u == (gen + 1u) * nloc) {
            __builtin_amdgcn_fence(__ATOMIC_RELEASE, "agent");
            asm volatile("s_waitcnt vmcnt(0)" ::: "memory");
            const unsigned og = xb_add(&bar[XB_TOP], 1u);
            const unsigned tg = og / nx;
            if (og + 1u == (tg + 1u) * nx) xb_add(&bar[XB_TOPGEN], 1u);
            else XB_SPIN(xb_ld(&bar[XB_TOPGEN]) == tg, bar);
            __builtin_amdgcn_fence(__ATOMIC_ACQUIRE, "agent");
            xb_add(&bar[XB_XGEN(b.x)], 1u);
            asm volatile("s_waitcnt vmcnt(0)" ::: "memory");
        } else {
            XB_SPIN(xb_ld(&bar[XB_XGEN(b.x)]) == gen, bar);
            __builtin_amdgcn_fence(__ATOMIC_ACQUIRE, "agent");
            asm volatile("s_waitcnt vmcnt(0)" ::: "memory");
        }
    }
    __syncthreads();
}

#define MEGA_PHASES(X) X(PH_IN0) X(PH_ATTN0) X(PH_OUT0) X(PH_PREP1) X(PH_IN1) X(PH_LORA1) X(PH_CPREP1) X(PH_SCAN1) X(PH_GN1) X(PH_OUT1) \
    X(PH_PREP2) X(PH_IN2) X(PH_B2) X(PH_C2) X(PH_D2) X(PH_OUT2) X(PH_PREP3) X(PH_IN3) X(PH_GATE3) X(PH_SCANB3) X(PH_OUT3)
__global__ void __launch_bounds__(NTHREADS, 2) mega_kernel(Params p) {
    extern __shared__ __attribute__((aligned(16))) char smem[];
    cooperative_groups::grid_group grid = cooperative_groups::this_grid();
    volatile LAS unsigned* xst = (volatile LAS unsigned*)(smem + 73728);
    if (threadIdx.x < 4) xst[threadIdx.x] = 0u;
    __syncthreads();
    XcdBarrier xb = xcd_barrier_post((unsigned*)p.ws, xst);
    run_phase<PH_PREP0>(p, smem);
    grid.sync();
#define MEGA_STEP(ph) run_phase<ph>(p, smem); xcd_barrier(xb);
    MEGA_PHASES(MEGA_STEP)
#undef MEGA_STEP
    run_phase<PH_FINAL>(p, smem);
}
static void launch_mega(const Params& p, hipStream_t s) {
    static int grid_blocks = 0;
    if (!grid_blocks) {
        int dev = 0, cus = 0, per_cu = 0;
        hipGetDevice(&dev);
        hipDeviceGetAttribute(&cus, hipDeviceAttributeMultiprocessorCount, dev);
        hipFuncSetAttribute((const void*)mega_kernel, hipFuncAttributeMaxDynamicSharedMemorySize, MEGA_LDS_BYTES);
        hipOccupancyMaxActiveBlocksPerMultiprocessor(&per_cu, mega_kernel, NTHREADS, MEGA_LDS_BYTES);
        if (per_cu > 2) per_cu = 2;
        if (per_cu < 1) per_cu = 1;
        grid_blocks = cus * per_cu;
    }
    hipMemsetAsync(p.ws, 0, 16384, s);
    Params pp = p; void* args[] = {&pp};
    hipError_t e = hipLaunchCooperativeKernel((const void*)mega_kernel, dim3(grid_blocks), dim3(NTHREADS), args, MEGA_LDS_BYTES, s);
    if (e != hipSuccess) fprintf(stderr, "cooperative launch failed: %s (grid %d)\n", hipGetErrorString(e), grid_blocks);
}
#endif

#ifndef CPU_SHIM
template <class F> __global__ void __launch_bounds__(256) k_run(F f, long n) {
    const long i = (long)blockIdx.x * 256 + threadIdx.x; if (i < n) f(i);
}
template <class F> static void launch(const F& f, long n, hipStream_t s) {
    hipLaunchKernelGGL(k_run<F>, dim3((unsigned)((n + 255) / 256)), dim3(256), 0, s, f, n);
}
#else
template <class F> static void launch(const F& f, long n, hipStream_t) {
#pragma omp parallel for schedule(dynamic, 64)
    for (long i = 0; i < n; ++i) f(i);
}
#endif

#ifdef CPU_SHIM
void cpu_layer_hook(int layer, const float* X, const char* ws);
#define LAYER_HOOK(l) cpu_layer_hook(l, X, ws)
#else
#define LAYER_HOOK(l)
#endif

#define FAST_GEMM 0
#if FAST_GEMM
#define FASTP(ph) launch_phase<ph>(p, s)
#else
#define FASTP(ph)
#endif

static void run_naive(const Params& p, hipStream_t s) {
    char* ws = p.ws;
    float* rs = (float*)(ws + wsl::RS);
    bf16* P = (bf16*)(ws + wsl::P);
    float* X = p.out;
    (void)rs;
    {
        bf16* AO = (bf16*)(ws + wsl::L0_AO);
#if FAST_GEMM
        FASTP(PH_PREP0); FASTP(PH_IN0);
#else
        launch(RstdF{p.x, rs}, M, s);
        launch(GemmInF{p.x, rs, p.norm_g + 0 * D, p.a_w_in, P, A_COLS}, (long)M * (A_COLS / 4), s);
#endif
#if FAST_GEMM
        FASTP(PH_ATTN0); (void)AO;
#else
        launch(SwaF{P, p.t5, p.a_sinks, AO}, (long)M * H, s);
#endif
#if FAST_GEMM
        FASTP(PH_OUT0);
#else
        launch(GemmOutF{AO, p.a_w_out, p.x, X, 1024}, (long)M * (D / 4), s);
#endif
    }
    LAYER_HOOK(0);
    {
        bf16* XN = (bf16*)(ws + wsl::L1_XN); bf16* WL = (bf16*)(ws + wsl::L1_WL); bf16* AV = (bf16*)(ws + wsl::L1_AV);
        float* hw = (float*)(ws + wsl::LHW); float* ha = (float*)(ws + wsl::LHA);
#if FAST_GEMM
        FASTP(PH_PREP1); FASTP(PH_IN1); FASTP(PH_LORA1); FASTP(PH_CPREP1); FASTP(PH_SCAN1); FASTP(PH_GN1); FASTP(PH_OUT1);
        (void)XN; (void)WL; (void)AV; (void)hw; (void)ha;
#else
        launch(RstdF{X, rs}, M, s);
        launch(XnF{X, rs, p.norm_g + 1 * D, XN}, (long)M * D, s);
        launch(GemmRwkvF{XN, p.b_mu, p.b_w_in, P}, (long)M * 1024, s);
        launch(LoraHidF{XN, p.b_mu, p.b_w1, p.b_a1, hw, ha}, (long)M * 128, s);
        launch(LoraOutF{hw, ha, p.b_w0, p.b_w2, p.b_a0, p.b_a2, WL, AV}, (long)M * D, s);
        launch(RwkvScanF{P, WL, AV, p.b_k_k, p.b_k_a, XN}, (long)B * H * 64, s);
        launch(RwkvGnF{P, AV, p.b_k_a, p.b_r_k, p.b_lnx_w, p.b_lnx_b, XN}, (long)M * H, s);
        launch(GemmOutF{XN, p.b_w_out, X, X, 1024}, (long)M * (D / 4), s);
#endif
    }
    LAYER_HOOK(1);
    {
        float* hk = (float*)(ws + wsl::HK); float* hv = (float*)(ws + wsl::HV);
        float* kc = (float*)(ws + wsl::KC); float* vc = (float*)(ws + wsl::VC);
        float* st = (float*)(ws + wsl::ST); int* sel = (int*)(ws + wsl::SEL); float* imp = (float*)(ws + wsl::L2_IMP);
        bf16* AO = (bf16*)(ws + wsl::L2_AO); bf16* OC = (bf16*)(ws + wsl::L2_OC); bf16* OS = (bf16*)(ws + wsl::L2_OS);
#if FAST_GEMM
        FASTP(PH_PREP2); FASTP(PH_IN2); FASTP(PH_B2); FASTP(PH_C2); FASTP(PH_D2); FASTP(PH_OUT2);
        (void)hk; (void)hv; (void)kc; (void)vc; (void)st; (void)sel; (void)imp; (void)AO; (void)OC; (void)OS;
#else
        launch(RstdF{X, rs}, M, s);
        launch(GemmInF{X, rs, p.norm_g + 2 * D, p.c_w_in, P, C_COLS}, (long)M * (C_COLS / 4), s);
        launch(CmpHidF{P, p.c_pos_k, p.c_k_w1, p.c_pos_v, p.c_v_w1, hk, hv}, 2L * B * G * NCMP * 128, s);
        launch(CmpOutF{hk, hv, p.c_k_w2, p.c_v_w2, kc, vc}, 2L * B * G * NCMP * 64, s);
        launch(CmpAttnF{P, kc, vc, st, OC}, (long)M * H, s);
        launch(ImpF{P, kc, st, imp}, (long)M * G * NSEL, s);
        launch(TopkF{imp, sel}, (long)M * G, s);
        launch(SelAttnF{P, p.t5, sel, OS}, (long)M * H, s);
        launch(WinAttnF{P, p.t5, OC, OS, AO}, (long)M * H, s);
        LAYER_HOOK(20);
        launch(GemmOutF{AO, p.c_w_out, X, X, 1024}, (long)M * (D / 4), s);
#endif
    }
    LAYER_HOOK(2);
    {
        bf16* AO = (bf16*)(ws + wsl::L3_AO); bf16* UC = (bf16*)(ws + wsl::L3_UC); bf16* LA = (bf16*)(ws + wsl::L3_LA); bf16* BV = (bf16*)(ws + wsl::L3_BV);
#if FAST_GEMM
        FASTP(PH_PREP3); FASTP(PH_IN3); FASTP(PH_GATE3); FASTP(PH_SCANA3); FASTP(PH_SCANB3); FASTP(PH_OUT3);
        (void)AO; (void)UC; (void)LA; (void)BV;
#else
        launch(RstdF{X, rs}, M, s);
        launch(GemmInF{X, rs, p.norm_g + 3 * D, p.d_w_in, P, 2560}, (long)M * (2560 / 4), s);
        launch(ConvF{P, p.d_conv_w, p.d_conv_b, UC}, (long)M * LW, s);
        launch(LruGateF{UC, p.d_ga_w, p.d_ga_b, p.d_gx_w, p.d_gx_b, p.d_lambda, LA, BV}, (long)M * LW, s);
        launch(LruScanF{P, LA, BV, AO}, (long)B * LW, s);
        launch(GemmOutF{AO, p.d_w_out, X, X, LW}, (long)M * (D / 4), s);
#endif
    }
    LAYER_HOOK(3);
#if FAST_GEMM
    FASTP(PH_FINAL);
#else
    launch(FinalNormF{X, p.final_g}, M, s);
#endif
}

extern "C" void kernel_launch(void* const* d_in, const int* in_sizes, int n_in, void* d_out, int out_size, void* d_ws, size_t ws_size,
                              hipStream_t stream) {
    (void)in_sizes; (void)n_in; (void)out_size; (void)ws_size;
    Params p{};
    const float* const* in = (const float* const*)d_in;
    int k = 0;
    p.x = in[k++]; p.t5 = in[k++]; p.norm_g = in[k++]; p.final_g = in[k++];
    p.a_w_in = in[k++]; p.a_sinks = in[k++]; p.a_w_out = in[k++];
    p.b_mu = in[k++]; p.b_w_in = in[k++]; p.b_w0 = in[k++]; p.b_w1 = in[k++]; p.b_w2 = in[k++]; p.b_a0 = in[k++]; p.b_a1 = in[k++]; p.b_a2 = in[k++];
    p.b_k_k = in[k++]; p.b_k_a = in[k++]; p.b_r_k = in[k++]; p.b_lnx_w = in[k++]; p.b_lnx_b = in[k++]; p.b_w_out = in[k++];
    p.c_w_in = in[k++]; p.c_pos_k = in[k++]; p.c_k_w1 = in[k++]; p.c_k_w2 = in[k++]; p.c_pos_v = in[k++]; p.c_v_w1 = in[k++]; p.c_v_w2 = in[k++]; p.c_w_out = in[k++];
    p.d_w_in = in[k++]; p.d_conv_w = in[k++]; p.d_conv_b = in[k++]; p.d_ga_w = in[k++]; p.d_ga_b = in[k++]; p.d_gx_w = in[k++]; p.d_gx_b = in[k++];
    p.d_lambda = in[k++]; p.d_w_out = in[k++];
    p.out = (float*)d_out; p.ws = (char*)d_ws;
#if !defined(CPU_SHIM) && !defined(MULTI_LAUNCH) && !defined(ALL_NAIVE)
    launch_mega(p, stream);
#else
    run_naive(p, stream);
#endif
}
```

```cpp
#ifndef CPU_SHIM
#include <hip/hip_runtime.h>
#include <hip/hip_cooperative_groups.h>
#include <cstdio>
#define HD __host__ __device__ __forceinline__
#else
#include <cmath>
#include <cstring>
#include <cstdio>
#include <cstdlib>
#include <cstdint>
#define HD inline
typedef void* hipStream_t;
#endif
#include <cstddef>

#ifndef CFG_B
#define CFG_B 4
#endif
#ifndef CFG_T
#define CFG_T 4096
#endif

namespace cfg {
constexpr int B = CFG_B, T = CFG_T, M = B * T, D = 1024;
constexpr int H = 16, G = 4, R = 4, DH = 64;
constexpr int A_COLS = 2560;
constexpr int C_COLS = 3632;
constexpr int NCMP = (T - 32) / 16 + 1;
constexpr int NSEL = T / 64;
constexpr int KTOP = NSEL < 16 ? NSEL : 16;
constexpr int LW = 1280;
}
using namespace cfg;

typedef unsigned short bf16;

HD unsigned f_as_u(float f) {
#ifndef CPU_SHIM
    return __float_as_uint(f);
#else
    unsigned u; memcpy(&u, &f, 4); return u;
#endif
}
HD float u_as_f(unsigned u) {
#ifndef CPU_SHIM
    return __uint_as_float(u);
#else
    float f; memcpy(&f, &u, 4); return f;
#endif
}
HD float bf2f(bf16 v) { return u_as_f(((unsigned)v) << 16); }
HD bf16 f2bf(float f) { unsigned u = f_as_u(f); u += 0x7fffu + ((u >> 16) & 1u); return (bf16)(u >> 16); }
HD float sigmoidf_(float x) { return 1.0f / (1.0f + expf(-x)); }
HD float siluf_(float x) { return x / (1.0f + expf(-x)); }
HD float softplusf_(float x) { return x > 20.f ? x : log1pf(expf(x)); }

HD int t5_bucket(int d) {
    if (d < 16) return d < 0 ? 0 : d;
    if (d >= 113) return 31;
    if (d >= 99) return 30;
    if (d >= 87) return 29;
    if (d >= 77) return 28;
    if (d >= 67) return 27;
    if (d >= 59) return 26;
    if (d >= 52) return 25;
    if (d >= 46) return 24;
    if (d >= 40) return 23;
    if (d >= 35) return 22;
    if (d >= 31) return 21;
    if (d >= 27) return 20;
    if (d >= 24) return 19;
    if (d >= 21) return 18;
    if (d >= 19) return 17;
    return 16;
}

struct Params {
    const float *x, *t5, *norm_g, *final_g;
    const float *a_w_in, *a_sinks, *a_w_out;
    const float *b_mu, *b_w_in, *b_w0, *b_w1, *b_w2, *b_a0, *b_a1, *b_a2, *b_k_k, *b_k_a, *b_r_k, *b_lnx_w, *b_lnx_b, *b_w_out;
    const float *c_w_in, *c_pos_k, *c_k_w1, *c_k_w2, *c_pos_v, *c_v_w1, *c_v_w2, *c_w_out;
    const float *d_w_in, *d_conv_w, *d_conv_b, *d_ga_w, *d_ga_b, *d_gx_w, *d_gx_b, *d_lambda, *d_w_out;
    float* out;
    char* ws;
};

namespace wsl {
constexpr size_t MB = 1024 * 1024;
constexpr size_t RS = 0;
constexpr size_t HK = 1 * MB;
constexpr size_t HV = 3 * MB;
constexpr size_t KC = 5 * MB;
constexpr size_t VC = 6 * MB;
constexpr size_t ST = 7 * MB;
constexpr size_t SEL = 9 * MB;
constexpr size_t LHW = 1 * MB;
constexpr size_t LHA = 5 * MB;
constexpr size_t P = 14 * MB;
constexpr size_t SZ1024 = (size_t)M * 1024 * 2, SZ1280 = (size_t)M * 1280 * 2;
constexpr size_t L0_AO = P + (size_t)M * 2560 * 2;
constexpr size_t L1_XN = P + (size_t)M * 4096 * 2, L1_WL = L1_XN + SZ1024, L1_AV = L1_WL + SZ1024;
constexpr size_t L2_AO = P + (size_t)M * 3632 * 2, L2_OC = L2_AO + SZ1024, L2_OS = L2_OC + SZ1024, L2_IMP = L2_OS + SZ1024;
constexpr size_t L3_AO = P + (size_t)M * 2560 * 2, L3_UC = L3_AO + SZ1280, L3_LA = L3_UC + SZ1280, L3_BV = L3_LA + SZ1280;
constexpr size_t TOTAL = L3_BV + SZ1280;
}

struct RstdF {
    const float* x; float* rs;
    HD void operator()(long m) const {
        const float* r = x + (size_t)m * D; float s = 0.f;
        for (int k = 0; k < D; ++k) s += r[k] * r[k];
        rs[m] = 1.0f / sqrtf(s / D + 1e-6f);
    }
};
struct XnF {
    const float* x; const float* rs; const float* g; bf16* xn;
    HD void operator()(long i) const { long m = i / D; int k = (int)(i % D); xn[i] = f2bf(x[i] * rs[m] * g[k]); }
};
struct GemmInF {
    const float *x, *rs, *g, *W; bf16* P; long long N;
    HD void operator()(long i) const {
        const int n4 = (int)N / 4; const long m = i / n4; const int n = (int)(i % n4) * 4;
        const float* xr = x + (size_t)m * D; const float r = rs[m];
        float a0 = 0, a1 = 0, a2 = 0, a3 = 0;
        for (int k = 0; k < D; ++k) {
            const float a = xr[k] * r * g[k]; const float* w = W + (size_t)k * N + n;
            a0 += a * w[0]; a1 += a * w[1]; a2 += a * w[2]; a3 += a * w[3];
        }
        bf16* p = P + (size_t)m * N + n; p[0] = f2bf(a0); p[1] = f2bf(a1); p[2] = f2bf(a2); p[3] = f2bf(a3);
    }
};
struct GemmOutF {
    const bf16* A; const float* W; const float* xin; float* xout; long long K;
    HD void operator()(long i) const {
        const int n4 = D / 4; const long m = i / n4; const int n = (int)(i % n4) * 4;
        const bf16* ar = A + (size_t)m * K;
        float a0 = 0, a1 = 0, a2 = 0, a3 = 0;
        for (int k = 0; k < K; ++k) {
            const float a = bf2f(ar[k]); const float* w = W + (size_t)k * D + n;
            a0 += a * w[0]; a1 += a * w[1]; a2 += a * w[2]; a3 += a * w[3];
        }
        const float* xi = xin + (size_t)m * D + n; float* xo = xout + (size_t)m * D + n;
        xo[0] = xi[0] + a0; xo[1] = xi[1] + a1; xo[2] = xi[2] + a2; xo[3] = xi[3] + a3;
    }
};

struct SwaF {
    const bf16* P; const float* t5; const float* sinks; bf16* AO;
    HD void operator()(long i) const {
        const long m = i / H; const int h = (int)(i % H), g = h / R; const int t = (int)(m % T); const long mb = m - t;
        float q[DH], o[DH];
#pragma unroll
        for (int d = 0; d < DH; ++d) { q[d] = bf2f(P[(size_t)m * A_COLS + h * DH + d]); o[d] = 0.f; }
        float mx = sinks[h], l = 1.0f;
        const int s0 = t - 127 < 0 ? 0 : t - 127;
        for (int s = s0; s <= t; ++s) {
            const bf16* kr = P + (size_t)(mb + s) * A_COLS + 1024 + g * DH;
            const bf16* vr = kr + 256;
            float sc = 0.f;
#pragma unroll
            for (int d = 0; d < DH; ++d) sc += q[d] * bf2f(kr[d]);
            sc = sc * 0.125f + t5[t5_bucket(t - s) * H + h];
            const float mn = sc > mx ? sc : mx; const float al = expf(mx - mn), p = expf(sc - mn);
            l = l * al + p; mx = mn;
#pragma unroll
            for (int d = 0; d < DH; ++d) o[d] = o[d] * al + p * bf2f(vr[d]);
        }
        const float il = 1.0f / l;
#pragma unroll
        for (int d = 0; d < DH; ++d) {
            const float z = bf2f(P[(size_t)m * A_COLS + 1536 + h * DH + d]);
            AO[(size_t)m * D + h * DH + d] = f2bf(o[d] * il * siluf_(z));
        }
    }
};

struct GemmRwkvF {
    const bf16* xn; const float* mu; const float* W; bf16* P;
    HD void operator()(long i) const {
        const int N = 4096, n4 = N / 4; const long m = i / n4; const int n = (int)(i % n4) * 4; const int s = n / 1024;
        const int t = (int)(m % T);
        const bf16* xr = xn + (size_t)m * D; const float* mus = mu + s * D;
        float a0 = 0, a1 = 0, a2 = 0, a3 = 0;
        for (int k = 0; k < D; ++k) {
            const float xc = bf2f(xr[k]); const float xp = t > 0 ? bf2f(xr[k - D]) : 0.f;
            const float a = xc + (xp - xc) * mus[k]; const float* w = W + (size_t)k * N + n;
            a0 += a * w[0]; a1 += a * w[1]; a2 += a * w[2]; a3 += a * w[3];
        }
        bf16* p = P + (size_t)m * N + n; p[0] = f2bf(a0); p[1] = f2bf(a1); p[2] = f2bf(a2); p[3] = f2bf(a3);
    }
};
struct LoraHidF {
    const bf16* xn; const float* mu; const float* w1; const float* a1; float* hw; float* ha;
    HD void operator()(long i) const {
        const long m = i / 128; const int jj = (int)(i % 128); const int which = jj / 64, j = jj % 64; const int t = (int)(m % T);
        const bf16* xr = xn + (size_t)m * D; const float* mus = mu + (4 + which) * D; const float* W = which ? a1 : w1;
        float acc = 0.f;
        for (int k = 0; k < D; ++k) {
            const float xc = bf2f(xr[k]); const float xp = t > 0 ? bf2f(xr[k - D]) : 0.f;
            acc += (xc + (xp - xc) * mus[k]) * W[(size_t)k * 64 + j];
        }
        if (which) ha[(size_t)m * 64 + j] = acc; else hw[(size_t)m * 64 + j] = tanhf(acc);
    }
};
struct LoraOutF {
    const float *hw, *ha, *w0, *w2, *a0, *a2; bf16* wlog; bf16* av;
    HD void operator()(long i) const {
        const long m = i / D; const int c = (int)(i % D);
        float sw = 0.f, sa = 0.f;
        for (int j = 0; j < 64; ++j) { sw += hw[(size_t)m * 64 + j] * w2[(size_t)j * D + c]; sa += ha[(size_t)m * 64 + j] * a2[(size_t)j * D + c]; }
        const float wr = -softplusf_(-(w0[c] + sw)) - 0.5f;
        wlog[i] = f2bf(-expf(wr)); av[i] = f2bf(sigmoidf_(a0[c] + sa));
    }
};
struct RwkvScanF {
    const bf16* P; const bf16* wlog; const bf16* av; const float* k_k; const float* k_a; bf16* ys;
    HD void operator()(long idx) const {
        const int i = (int)(idx % 64); const int h = (int)((idx / 64) % H); const int b = (int)(idx / (64 * H));
        float S[64];
#pragma unroll
        for (int j = 0; j < 64; ++j) S[j] = 0.f;
        for (int t = 0; t < T; ++t) {
            const size_t m = (size_t)b * T + t; const bf16* pr = P + m * 4096 + h * 64;
            const bf16* wl = wlog + m * D + h * 64; const bf16* ar = av + m * D + h * 64;
            float n2 = 0.f;
#pragma unroll
            for (int j = 0; j < 64; ++j) { const float kk = bf2f(pr[1024 + j]) * k_k[h * 64 + j]; n2 += kk * kk; }
            float nr = sqrtf(n2); nr = nr > 1e-12f ? nr : 1e-12f; const float inr = 1.0f / nr;
            float sa = 0.f;
#pragma unroll
            for (int j = 0; j < 64; ++j) { const float kk = bf2f(pr[1024 + j]) * k_k[h * 64 + j] * inr; sa += S[j] * (-kk); }
            const float vi = bf2f(pr[2048 + i]); float y = 0.f;
#pragma unroll
            for (int j = 0; j < 64; ++j) {
                const float kr = bf2f(pr[1024 + j]); const float a = bf2f(ar[j]);
                const float kk = kr * k_k[h * 64 + j] * inr; const float kp = kr * (1.0f + (a - 1.0f) * k_a[h * 64 + j]);
                const float dec = expf(bf2f(wl[j]));
                S[j] = S[j] * dec + sa * (kk * a) + vi * kp;
                y += S[j] * bf2f(pr[j]);
            }
            ys[m * D + h * 64 + i] = f2bf(y);
        }
    }
};
struct RwkvGnF {
    const bf16* P; const bf16* av; const float *k_a, *r_k, *lnx_w, *lnx_b; bf16* ys;
    HD void operator()(long idx) const {
        const long m = idx / H; const int h = (int)(idx % H);
        bf16* yr = ys + (size_t)m * D + h * 64; const bf16* pr = P + (size_t)m * 4096 + h * 64; const bf16* ar = av + (size_t)m * D + h * 64;
        float mean = 0.f;
        for (int j = 0; j < 64; ++j) mean += bf2f(yr[j]);
        mean /= 64.f; float var = 0.f;
        for (int j = 0; j < 64; ++j) { const float d = bf2f(yr[j]) - mean; var += d * d; }
        var /= 64.f; const float rstd = 1.0f / sqrtf(var + 64e-5f);
        float bs = 0.f;
        for (int j = 0; j < 64; ++j) { const float kr = bf2f(pr[1024 + j]); const float kp = kr * (1.0f + (bf2f(ar[j]) - 1.0f) * k_a[h * 64 + j]); bs += bf2f(pr[j]) * kp * r_k[h * 64 + j]; }
        for (int j = 0; j < 64; ++j) {
            const float yn = (bf2f(yr[j]) - mean) * rstd * lnx_w[h * 64 + j] + lnx_b[h * 64 + j];
            const float z = bf2f(pr[3072 + j]);
            yr[j] = f2bf((yn + bs * bf2f(pr[2048 + j])) * siluf_(z));
        }
    }
};

struct CmpHidF {
    const bf16* P; const float *pos_k, *w1_k, *pos_v, *w1_v; float* hk; float* hv;
    HD void operator()(long idx) const {
        const int j = (int)(idx % 128); long r = idx / 128; const int n = (int)(r % NCMP); r /= NCMP; const int g = (int)(r % G); r /= G;
        const int b = (int)(r % B); const int which = (int)(r / B);
        const float* pos = which ? pos_v : pos_k; const float* w1 = which ? w1_v : w1_k; const int col = 1024 + (which ? 256 : 0) + g * 64;
        float acc = 0.f;
        for (int l = 0; l < 32; ++l) {
            const bf16* src = P + (size_t)(b * T + 16 * n + l) * C_COLS + col;
            for (int d = 0; d < 64; ++d) acc += (bf2f(src[d]) + pos[l * 64 + d]) * w1[(size_t)(l * 64 + d) * 128 + j];
        }
        (which ? hv : hk)[(((size_t)b * G + g) * NCMP + n) * 128 + j] = siluf_(acc);
    }
};
struct CmpOutF {
    const float *hk, *hv, *w2_k, *w2_v; float* kc; float* vc;
    HD void operator()(long idx) const {
        const int d = (int)(idx % 64); long r = idx / 64; const long row = r % ((long)B * G * NCMP); const int which = (int)(r / ((long)B * G * NCMP));
        const float* hsrc = (which ? hv : hk) + (size_t)row * 128; const float* w2 = which ? w2_v : w2_k;
        float acc = 0.f;
        for (int j = 0; j < 128; ++j) acc += hsrc[j] * w2[j * 64 + d];
        (which ? vc : kc)[(size_t)row * 64 + d] = acc;
    }
};
struct CmpAttnF {
    const bf16* P; const float *kc, *vc; float* st; bf16* oc;
    HD void operator()(long i) const {
        const long m = i / H; const int h = (int)(i % H), g = h / R; const int t = (int)(m % T); const int b = (int)(m / T);
        float q[DH], o[DH];
#pragma unroll
        for (int d = 0; d < DH; ++d) { q[d] = bf2f(P[(size_t)m * C_COLS + h * DH + d]); o[d] = 0.f; }
        const int nv = t < 31 ? 0 : (t - 31) / 16 + 1;
        float mx = -1e30f, l = 0.f;
        for (int n = 0; n < nv; ++n) {
            const float* kr = kc + (((size_t)b * G + g) * NCMP + n) * 64; const float* vr = vc + (((size_t)b * G + g) * NCMP + n) * 64;
            float sc = 0.f;
#pragma unroll
            for (int d = 0; d < DH; ++d) sc += q[d] * kr[d];
            sc *= 0.125f;
            const float mn = sc > mx ? sc : mx; const float al = expf(mx - mn), p = expf(sc - mn);
            l = l * al + p; mx = mn;
#pragma unroll
            for (int d = 0; d < DH; ++d) o[d] = o[d] * al + p * vr[d];
        }
        const float il = nv > 0 ? 1.0f / l : 0.f;
        st[(size_t)i * 2] = mx; st[(size_t)i * 2 + 1] = il;
#pragma unroll
        for (int d = 0; d < DH; ++d) oc[(size_t)m * D + h * DH + d] = f2bf(o[d] * il);
    }
};
struct ImpF {
    const bf16* P; const float *kc, *st; float* imp;
    HD void operator()(long idx) const {
        const int s = (int)(idx % NSEL); long r = idx / NSEL; const int g = (int)(r % G); const long m = r / G;
        const int t = (int)(m % T); const int b = (int)(m / T); const int cur = t / 64;
        float v;
        if (s == 0 || s == cur || s == cur - 1) v = 1e30f;
        else if (s * 64 > t) v = -1e30f;
        else {
            v = 0.f; const int nv = t < 31 ? 0 : (t - 31) / 16 + 1;
            int n0 = 4 * s - 1; if (n0 < 0) n0 = 0; int n1 = 4 * s + 3; if (n1 > NCMP - 1) n1 = NCMP - 1; if (n1 > nv - 1) n1 = nv - 1;
            for (int rr = 0; rr < R; ++rr) {
                const int h = g * R + rr; const bf16* qr = P + (size_t)m * C_COLS + h * DH;
                const float mx = st[((size_t)m * H + h) * 2], il = st[((size_t)m * H + h) * 2 + 1];
                for (int n = n0; n <= n1; ++n) {
                    const float* kr = kc + (((size_t)b * G + g) * NCMP + n) * 64; float sc = 0.f;
                    for (int d = 0; d < DH; ++d) sc += bf2f(qr[d]) * kr[d];
                    v += expf(sc * 0.125f - mx) * il;
                }
            }
        }
        imp[idx] = v;
    }
};
struct TopkF {
    const float* imp; int* sel;
    HD void operator()(long idx) const {
        const float* v = imp + (size_t)idx * NSEL; unsigned long long used = 0ull;
        for (int j = 0; j < KTOP; ++j) {
            int best = -1; float bv = 0.f;
            for (int s = 0; s < NSEL; ++s) { if ((used >> s) & 1ull) continue; const float x = v[s]; if (best < 0 || x > bv) { best = s; bv = x; } }
            used |= 1ull << best; sel[(size_t)idx * 16 + j] = best;
        }
    }
};
struct SelAttnF {
    const bf16* P; const float* t5; const int* sel; bf16* os;
    HD void operator()(long i) const {
        const long m = i / H; const int h = (int)(i % H), g = h / R; const int t = (int)(m % T); const long mb = m - t;
        float q[DH], o[DH];
#pragma unroll
        for (int d = 0; d < DH; ++d) { q[d] = bf2f(P[(size_t)m * C_COLS + h * DH + d]); o[d] = 0.f; }
        float mx = -1e30f, l = 0.f;
        for (int j = 0; j < KTOP; ++j) {
            const int blk = sel[((size_t)m * G + g) * 16 + j];
            for (int ll = 0; ll < 64; ++ll) {
                const int s = blk * 64 + ll; if (s > t) break;
                const bf16* kr = P + (size_t)(mb + s) * C_COLS + 1536 + g * DH; const bf16* vr = kr + 256;
                float sc = 0.f;
#pragma unroll
                for (int d = 0; d < DH; ++d) sc += q[d] * bf2f(kr[d]);
                sc = sc * 0.125f + t5[t5_bucket(t - s) * H + h];
                const float mn = sc > mx ? sc : mx; const float al = expf(mx - mn), p = expf(sc - mn);
                l = l * al + p; mx = mn;
#pragma unroll
                for (int d = 0; d < DH; ++d) o[d] = o[d] * al + p * bf2f(vr[d]);
            }
        }
        const float il = 1.0f / l;
#pragma unroll
        for (int d = 0; d < DH; ++d) os[(size_t)m * D + h * DH + d] = f2bf(o[d] * il);
    }
};
struct WinAttnF {
    const bf16* P; const float* t5; const bf16* oc; const bf16* os; bf16* AO;
    HD void operator()(long i) const {
        const long m = i / H; const int h = (int)(i % H), g = h / R, rr = h % R; const int t = (int)(m % T); const long mb = m - t;
        float q[DH], o[DH];
#pragma unroll
        for (int d = 0; d < DH; ++d) { q[d] = bf2f(P[(size_t)m * C_COLS + h * DH + d]); o[d] = 0.f; }
        float mx = -1e30f, l = 0.f;
        const int s0 = t - 511 < 0 ? 0 : t - 511;
        for (int s = s0; s <= t; ++s) {
            const bf16* kr = P + (size_t)(mb + s) * C_COLS + 2048 + g * DH; const bf16* vr = kr + 256;
            float sc = 0.f;
#pragma unroll
            for (int d = 0; d < DH; ++d) sc += q[d] * bf2f(kr[d]);
            sc = sc * 0.125f + t5[t5_bucket(t - s) * H + h];
            const float mn = sc > mx ? sc : mx; const float al = expf(mx - mn), p = expf(sc - mn);
            l = l * al + p; mx = mn;
#pragma unroll
            for (int d = 0; d < DH; ++d) o[d] = o[d] * al + p * bf2f(vr[d]);
        }
        const float il = 1.0f / l;
        const bf16* gr = P + (size_t)m * C_COLS + 2560;
        const float g0 = sigmoidf_(bf2f(gr[0 * 16 + g * R + rr])), g1 = sigmoidf_(bf2f(gr[1 * 16 + g * R + rr])), g2 = sigmoidf_(bf2f(gr[2 * 16 + g * R + rr]));
#pragma unroll
        for (int d = 0; d < DH; ++d) {
            const size_t oi = (size_t)m * D + h * DH + d;
            const float z = bf2f(P[(size_t)m * C_COLS + 2608 + h * DH + d]);
            AO[oi] = f2bf((g0 * bf2f(oc[oi]) + g1 * bf2f(os[oi]) + g2 * o[d] * il) * siluf_(z));
        }
    }
};

struct ConvF {
    const bf16* P; const float *cw, *cb; bf16* uc;
    HD void operator()(long i) const {
        const long m = i / LW; const int c = (int)(i % LW); const int t = (int)(m % T);
        float acc = cb[c];
        for (int w = 0; w < 4; ++w) { const int tt = t - 3 + w; if (tt >= 0) acc += cw[w * LW + c] * bf2f(P[(size_t)(m - 3 + w) * 2560 + c]); }
        uc[i] = f2bf(acc);
    }
};
struct LruGateF {
    const bf16* uc; const float *gaw, *gab, *gxw, *gxb, *lam; bf16* la; bf16* bv;
    HD void operator()(long i) const {
        const long m = i / LW; const int c = (int)(i % LW); const int n = c / 80, d = c % 80;
        const bf16* ub = uc + (size_t)m * LW + n * 80; float ra = gab[c], rx = gxb[c];
        for (int k = 0; k < 80; ++k) { const float u = bf2f(ub[k]); ra += u * gaw[((size_t)n * 80 + k) * 80 + d]; rx += u * gxw[((size_t)n * 80 + k) * 80 + d]; }
        const float r = sigmoidf_(ra), ig = sigmoidf_(rx);
        const float loga = -8.0f * r * softplusf_(-lam[c]);
        la[i] = f2bf(loga);
        bv[i] = f2bf(sqrtf(-expm1f(2.0f * loga)) * (ig * bf2f(uc[i])));
    }
};
struct LruScanF {
    const bf16* P; const bf16* la; const bf16* bv; bf16* AO;
    HD void operator()(long idx) const {
        const int c = (int)(idx % LW); const int b = (int)(idx / LW); float h = 0.f;
        for (int t = 0; t < T; ++t) {
            const size_t m = (size_t)b * T + t;
            h = expf(bf2f(la[m * LW + c])) * h + bf2f(bv[m * LW + c]);
            AO[m * LW + c] = f2bf(h * siluf_(bf2f(P[m * 2560 + LW + c])));
        }
    }
};
struct FinalNormF {
    float* x; const float* g;
    HD void operator()(long m) const {
        float* r = x + (size_t)m * D; float s = 0.f;
        for (int k = 0; k < D; ++k) s += r[k] * r[k];
        const float rs = 1.0f / sqrtf(s / D + 1e-6f);
        for (int k = 0; k < D; ++k) r[k] = r[k] * rs * g[k];
    }
};


#ifndef CPU_SHIM
typedef short bf16x8 __attribute__((ext_vector_type(8)));
typedef float f32x4 __attribute__((ext_vector_type(4)));
typedef unsigned u32x4 __attribute__((ext_vector_type(4)));
typedef unsigned u32x2 __attribute__((ext_vector_type(2)));
#define DI __device__ __forceinline__
#define NTHREADS 256
__device__ __forceinline__ int opaque_tid() { int t = threadIdx.x; asm volatile("" : "+v"(t)); return t; }
#define TIDX (opaque_tid())

typedef __bf16 hbf16x2 __attribute__((ext_vector_type(2)));
typedef float f32x2 __attribute__((ext_vector_type(2)));
DI unsigned pack2bf(float lo, float hi) { f32x2 f = {lo, hi}; return __builtin_bit_cast(unsigned, __builtin_convertvector(f, hbf16x2)); }
DI float bflo(unsigned u) { return __uint_as_float(u << 16); }
DI float bfhi(unsigned u) { return __uint_as_float(u & 0xffff0000u); }

namespace fw {
constexpr size_t MB = 1024 * 1024;
constexpr size_t PARTS = 13 * MB;
constexpr size_t SMALLB = 1 * MB;
constexpr size_t WB = 14 * MB;
constexpr size_t XB = 30 * MB;
constexpr size_t BIG = 62 * MB;
}

DI void convert_tile(const float* __restrict__ W, int ldw, int c0, int K, bf16* __restrict__ Wt, const float* __restrict__ g, int kt, int nt, float* sm) {
    const int tid = TIDX;
    const int k0 = kt * 64, n0 = nt * 64;
#pragma unroll
    for (int i = 0; i < 4; ++i) {
        const int kr = (tid >> 4) + 16 * i; const int nc = (tid & 15) * 4;
        const float4 v = *(const float4*)(W + (size_t)(k0 + kr) * ldw + c0 + n0 + nc);
        const float s = g ? g[k0 + kr] : 1.0f;
        sm[kr * 65 + nc + 0] = v.x * s; sm[kr * 65 + nc + 1] = v.y * s; sm[kr * 65 + nc + 2] = v.z * s; sm[kr * 65 + nc + 3] = v.w * s;
    }
    __syncthreads();
    {
        const int n = tid >> 2, kq = (tid & 3) * 16;
        unsigned w[8];
#pragma unroll
        for (int j = 0; j < 8; ++j) w[j] = pack2bf(sm[(kq + 2 * j) * 65 + n], sm[(kq + 2 * j + 1) * 65 + n]);
        u32x4* dst = (u32x4*)(Wt + (size_t)(n0 + n) * K + k0 + kq);
        dst[0] = (u32x4){w[0], w[1], w[2], w[3]}; dst[1] = (u32x4){w[4], w[5], w[6], w[7]};
    }
    __syncthreads();
}
DI void convert_seg(const float* W, int ldw, int c0, int ncols, int K, bf16* Wt, const float* g, float* sm, int& tbase) {
    const int nkt = K / 64, nnt = ncols / 64, ntile = nkt * nnt;
    const int Gd = (int)gridDim.x;
    for (int t = (((int)blockIdx.x - tbase % Gd) + Gd) % Gd; t < ntile; t += Gd) convert_tile(W, ldw, c0, K, Wt, g, t % nkt, t / nkt, sm);
    tbase += ntile;
}

DI int perm32(int rho) { const int n = rho >> 4, i = rho & 15; return 8 * (i >> 2) + 4 * n + (i & 3); }

struct ALoadPlain {
    const bf16* A; int lda;
    static constexpr bool DMA = true;
    DI const bf16* src(int m, int k) const { return A + (size_t)m * lda + k; }
    struct Raw { u32x4 v; };
    DI Raw load(int m, int k) const { Raw r; r.v = *(const u32x4*)(A + (size_t)m * lda + k); return r; }
    DI u32x4 finish(const Raw& r, int, int) const { return r.v; }
};
struct ALoadLerp {
    const bf16* xn; const float* mu;
    static constexpr bool DMA = false;
    DI const bf16* src(int, int) const { return nullptr; }
    struct Raw { u32x4 c, p; };
    DI Raw load(int m, int k) const {
        Raw r; r.c = *(const u32x4*)(xn + (size_t)m * D + k);
        if ((m % T) != 0) r.p = *(const u32x4*)(xn + (size_t)(m - 1) * D + k); else r.p = (u32x4){0u, 0u, 0u, 0u};
        return r;
    }
    DI u32x4 finish(const Raw& r, int, int k) const {
        const float4 m0 = *(const float4*)(mu + k), m1 = *(const float4*)(mu + k + 4);
        const float mm[8] = {m0.x, m0.y, m0.z, m0.w, m1.x, m1.y, m1.z, m1.w};
        u32x4 o;
#pragma unroll
        for (int j = 0; j < 4; ++j) {
            const float c0 = bflo(r.c[j]), c1 = bfhi(r.c[j]), p0 = bflo(r.p[j]), p1 = bfhi(r.p[j]);
            o[j] = pack2bf(c0 + (p0 - c0) * mm[2 * j], c1 + (p1 - c1) * mm[2 * j + 1]);
        }
        return o;
    }
};

#define GLDS16(gp, lp) __builtin_amdgcn_global_load_lds((const unsigned*)(gp), (unsigned*)(lp), 16, 0, 0)
template <class AL, class Epi>
DI void gemm_tile(const AL& al, const bf16* __restrict__ Bt, int K, int m0, int n0, const Epi& epi, char* smem) {
    const int tid = TIDX, lane = tid & 63, wave = __builtin_amdgcn_readfirstlane(tid >> 6), wr = wave >> 1, wc = wave & 1, q = lane >> 4, l15 = lane & 15;
    const int srow = tid >> 3, sc = tid & 7, scs = sc ^ (srow & 7);
    const int st_off = srow * 128 + (sc << 4);
    const int dma_off = (8 * wave) * 128;
    int brow[4];
#pragma unroll
    for (int i = 0; i < 4; ++i) { const int rho = srow + 32 * i; brow[i] = n0 + (rho & ~31) + perm32(rho & 31); }
    const int fa0 = (wr * 64 + l15) * 128 + ((q ^ (lane & 7)) << 4);
    const int fb0 = (wc * 64 + l15) * 128 + ((q ^ (lane & 7)) << 4);
    f32x4 acc[4][4];
#pragma unroll
    for (int i = 0; i < 4; ++i)
#pragma unroll
        for (int j = 0; j < 4; ++j) acc[i][j] = (f32x4){0.f, 0.f, 0.f, 0.f};
    typename AL::Raw ra[4];
    const int nk = K / 64;
    {
        char* bufA = smem; char* bufB = smem + 16384;
#pragma unroll
        for (int i = 0; i < 4; ++i) {
            GLDS16(Bt + (size_t)brow[i] * K + scs * 8, bufB + dma_off + i * 4096);
            if (AL::DMA) GLDS16(al.src(m0 + srow + 32 * i, scs * 8), bufA + dma_off + i * 4096);
            else ra[i] = al.load(m0 + srow + 32 * i, scs * 8);
        }
        if (!AL::DMA) {
#pragma unroll
            for (int i = 0; i < 4; ++i) *(u32x4*)(bufA + st_off + i * 4096) = al.finish(ra[i], m0 + srow + 32 * i, scs * 8);
        }
    }
    asm volatile("s_waitcnt vmcnt(0)" ::: "memory");
    __syncthreads();
    for (int kt = 0; kt < nk; ++kt) {
        char* bufA = smem + (kt & 1) * 32768; char* bufB = bufA + 16384;
        char* nA = smem + ((kt + 1) & 1) * 32768; char* nB = nA + 16384;
        const bool more = kt + 1 < nk; const int kn = (kt + 1) * 64 + scs * 8;
        if (more) {
#pragma unroll
            for (int i = 0; i < 4; ++i) {
                GLDS16(Bt + (size_t)brow[i] * K + kn, nB + dma_off + i * 4096);
                if (AL::DMA) GLDS16(al.src(m0 + srow + 32 * i, kn), nA + dma_off + i * 4096);
                else ra[i] = al.load(m0 + srow + 32 * i, kn);
            }
        }
#pragma unroll
        for (int ks = 0; ks < 2; ++ks) {
            bf16x8 af[4], bfr[4];
#pragma unroll
            for (int i = 0; i < 4; ++i) {
                af[i] = *(const bf16x8*)(bufA + ((fa0 + i * 2048) ^ (ks << 6)));
                bfr[i] = *(const bf16x8*)(bufB + ((fb0 + i * 2048) ^ (ks << 6)));
            }
#pragma unroll
            for (int i = 0; i < 4; ++i)
#pragma unroll
                for (int j = 0; j < 4; ++j) acc[i][j] = __builtin_amdgcn_mfma_f32_16x16x32_bf16(bfr[j], af[i], acc[i][j], 0, 0, 0);
        }
        if (more && !AL::DMA) {
#pragma unroll
            for (int i = 0; i < 4; ++i) *(u32x4*)(nA + st_off + i * 4096) = al.finish(ra[i], m0 + srow + 32 * i, kn);
        }
        asm volatile("s_waitcnt vmcnt(0)" ::: "memory");
        __syncthreads();
    }
#pragma unroll
    for (int mt = 0; mt < 4; ++mt)
#pragma unroll
        for (int gi = 0; gi < 2; ++gi) {
            float v[8];
#pragma unroll
            for (int r = 0; r < 4; ++r) { v[r] = acc[mt][2 * gi][r]; v[4 + r] = acc[mt][2 * gi + 1][r]; }
            epi(m0 + wr * 64 + mt * 16 + l15, n0 + wc * 64 + gi * 32 + 8 * q, v, mt, gi);
        }
    epi.finish(m0, n0, wr, wc, lane);
}

constexpr int G2_STAGE = 24576;
template <class AL, class Epi>
DI void gemm_tile2(const AL& al, const bf16* __restrict__ Bt, int K, int m0, int n0, const Epi& epi, char* smem) {
    const int tid = TIDX, lane = tid & 63, wave = __builtin_amdgcn_readfirstlane(tid >> 6), wr = wave >> 1, wc = wave & 1, q = lane >> 4, l15 = lane & 15;
    const int prow = tid >> 2, ppos = tid & 3, ca = (ppos - 2 * ((tid >> 4) & 3)) & 3;
    const int dma_off = wave * 1024;
    int brow[4];
#pragma unroll
    for (int i = 0; i < 4; ++i) { const int rho = prow + 64 * i; brow[i] = n0 + (rho & ~31) + perm32(rho & 31); }
    const int fpos = ((q + 2 * ((l15 >> 2) & 3)) & 3) << 4;
    const int fa0 = (wr * 64 + l15) * 64 + fpos, fb0 = 8192 + (wc * 128 + l15) * 64 + fpos;
    f32x4 acc[4][8];
#pragma unroll
    for (int i = 0; i < 4; ++i)
#pragma unroll
        for (int j = 0; j < 8; ++j) acc[i][j] = (f32x4){0.f, 0.f, 0.f, 0.f};
    typename AL::Raw ra[2];
    const int nk = K / 32;
#define G2_ISSUE(kt_) { char* st_ = smem + ((kt_) % 3) * G2_STAGE; const int kk_ = (kt_) * 32 + ca * 8; \
        _Pragma("unroll") for (int i = 0; i < 2; ++i) { if (AL::DMA) GLDS16(al.src(m0 + prow + 64 * i, kk_), st_ + dma_off + i * 4096); else ra[i] = al.load(m0 + prow + 64 * i, kk_); } \
        _Pragma("unroll") for (int i = 0; i < 4; ++i) GLDS16(Bt + (size_t)brow[i] * K + kk_, st_ + 8192 + dma_off + i * 4096); }
#define G2_AWRITE(kt_) { if (!AL::DMA) { char* st_ = smem + ((kt_) % 3) * G2_STAGE; const int kk_ = (kt_) * 32 + ca * 8; \
        _Pragma("unroll") for (int i = 0; i < 2; ++i) *(u32x4*)(st_ + (prow + 64 * i) * 64 + ppos * 16) = al.finish(ra[i], m0 + prow + 64 * i, kk_); } }
#define G2_BARRIER() { asm volatile("s_waitcnt lgkmcnt(0)" ::: "memory"); __builtin_amdgcn_s_barrier(); asm volatile("" ::: "memory"); }
    G2_ISSUE(0); G2_AWRITE(0);
    if (nk > 1) { G2_ISSUE(1); G2_AWRITE(1); }
    if (nk > 1) { if (AL::DMA) asm volatile("s_waitcnt vmcnt(6)" ::: "memory"); else asm volatile("s_waitcnt vmcnt(4)" ::: "memory"); } else asm volatile("s_waitcnt vmcnt(0)" ::: "memory");
    G2_BARRIER();
    for (int kt = 0; kt < nk; ++kt) {
        const char* st = smem + (kt % 3) * G2_STAGE;
        const bool more = kt + 2 < nk;
        if (more) G2_ISSUE(kt + 2);
        bf16x8 af[4];
#pragma unroll
        for (int i = 0; i < 4; ++i) af[i] = *(const bf16x8*)(st + fa0 + i * 1024);
#pragma unroll
        for (int j = 0; j < 8; ++j) {
            const bf16x8 bf_ = *(const bf16x8*)(st + fb0 + j * 1024);
#pragma unroll
            for (int i = 0; i < 4; ++i) acc[i][j] = __builtin_amdgcn_mfma_f32_16x16x32_bf16(bf_, af[i], acc[i][j], 0, 0, 0);
        }
        if (more) G2_AWRITE(kt + 2);
        if (more) { if (AL::DMA) asm volatile("s_waitcnt vmcnt(6)" ::: "memory"); else asm volatile("s_waitcnt vmcnt(4)" ::: "memory"); } else asm volatile("s_waitcnt vmcnt(0)" ::: "memory");
        G2_BARRIER();
    }
#undef G2_ISSUE
#undef G2_AWRITE
#undef G2_BARRIER
#pragma unroll
    for (int mt = 0; mt < 4; ++mt)
#pragma unroll
        for (int gi = 0; gi < 4; ++gi) {
            float v[8];
#pragma unroll
            for (int r = 0; r < 4; ++r) { v[r] = acc[mt][2 * gi][r]; v[4 + r] = acc[mt][2 * gi + 1][r]; }
            epi(m0 + wr * 64 + mt * 16 + l15, n0 + wc * 128 + gi * 32 + 8 * q, v, mt, gi);
        }
    epi.finish_wide(m0, n0, wr, wc, lane);
}
template <class F>
DI void gemm_sched(int nbig, int nsmall, F&& f) {
    const int x = blockIdx.x & 7, lb = blockIdx.x >> 3, nlb = gridDim.x >> 3;
    const int nb16 = 16 * nbig, tot = 16 * (nbig + nsmall);
    for (int s = lb; s < tot; s += nlb) {
        if (s < nb16) f(true, x * 16 + (s & 15), s >> 4);
        else { const int t = s - nb16; f(false, x * 16 + (t & 15), t >> 4); }
    }
}

DI float rstd_from_parts(const float* parts, int m) {
    const float4* p = (const float4*)(parts + (size_t)m * 16); float s = 0.f;
#pragma unroll
    for (int i = 0; i < 4; ++i) { const float4 v = p[i]; s += (v.x + v.y) + (v.z + v.w); }
    return 1.0f / sqrtf(s * (1.0f / D) + 1e-6f);
}
DI void store8bf(bf16* p, const float* v) { *(u32x4*)p = (u32x4){pack2bf(v[0], v[1]), pack2bf(v[2], v[3]), pack2bf(v[4], v[5]), pack2bf(v[6], v[7])}; }

struct EpiBf16 {
    bf16* P; int ldp; const float* parts; mutable float rsc[4];
    DI void operator()(int m, int n, const float* v, int mt, int gi) const {
        if (gi == 0) rsc[mt] = parts ? rstd_from_parts(parts, m) : 1.0f;
        float s = rsc[mt]; float w[8];
#pragma unroll
        for (int j = 0; j < 8; ++j) w[j] = v[j] * s;
        store8bf(P + (size_t)m * ldp + n, w);
    }
    DI void finish(int, int, int, int, int) const {}
    DI void finish_wide(int, int, int, int, int) const {}
};
struct EpiResid {
    const float* xin; float* xout; bf16* xb; float* parts; mutable float sq[4];
    DI void operator()(int m, int n, const float* v, int mt, int gi) const {
        const float4* xi = (const float4*)(xin + (size_t)m * D + n); const float4 a = xi[0], b = xi[1];
        float w[8] = {a.x + v[0], a.y + v[1], a.z + v[2], a.w + v[3], b.x + v[4], b.y + v[5], b.z + v[6], b.w + v[7]};
        float4* xo = (float4*)(xout + (size_t)m * D + n);
        xo[0] = make_float4(w[0], w[1], w[2], w[3]); xo[1] = make_float4(w[4], w[5], w[6], w[7]);
        if (xb) store8bf(xb + (size_t)m * D + n, w);
        float s = 0.f;
#pragma unroll
        for (int j = 0; j < 8; ++j) s += w[j] * w[j];
        if (gi == 0) sq[mt] = s; else sq[mt] += s;
    }
    DI void finish(int m0, int n0, int wr, int wc, int lane) const {
#pragma unroll
        for (int mt = 0; mt < 4; ++mt) {
            float s = sq[mt]; s += __shfl_xor(s, 16); s += __shfl_xor(s, 32);
            if (lane < 16) parts[(size_t)(m0 + wr * 64 + mt * 16 + lane) * 16 + (n0 >> 7) * 2 + wc] = s;
        }
    }
    DI void finish_wide(int m0, int n0, int wr, int wc, int lane) const {
#pragma unroll
        for (int mt = 0; mt < 4; ++mt) {
            float s = sq[mt]; s += __shfl_xor(s, 16); s += __shfl_xor(s, 32);
            if (lane < 16) { float* pr = parts + (size_t)(m0 + wr * 64 + mt * 16 + lane) * 16 + (n0 >> 7) + wc; pr[0] = s; pr[8] = 0.f; }
        }
    }
};
struct EpiRwkv {
    bf16* P; float* hw; float* ha;
    DI void operator()(int m, int n, const float* v, int, int) const {
        if (n < 4096) { store8bf(P + (size_t)m * 4096 + n, v); return; }
        const int c = n - 4096;
        if (c < 64) { float4* o = (float4*)(hw + (size_t)m * 64 + c); o[0] = make_float4(tanhf(v[0]), tanhf(v[1]), tanhf(v[2]), tanhf(v[3])); o[1] = make_float4(tanhf(v[4]), tanhf(v[5]), tanhf(v[6]), tanhf(v[7])); }
        else if (c >= 128 && c < 192) { float4* o = (float4*)(ha + (size_t)m * 64 + (c - 128)); o[0] = make_float4(v[0], v[1], v[2], v[3]); o[1] = make_float4(v[4], v[5], v[6], v[7]); }
    }
    DI void finish(int, int, int, int, int) const {}
    DI void finish_wide(int, int, int, int, int) const {}
};

namespace at {
constexpr int OFF_BIAS = 49152;
constexpr int OFF_X = 61952;
constexpr int OFF_IMP = 49152;
constexpr float L2E = 1.4426950408889634f;
constexpr float NEG_MASK = -1e30f, M_INIT = -1e20f;
}
enum { AM_SWA = 0, AM_WIN = 1, AM_CMP = 2, AM_SEL = 3 };
DI int vt_perm(int k32) { return ((k32 & 15) >> 2) * 8 + (k32 >> 4) * 4 + (k32 & 3); }
DI float fast_exp2(float x) { return __builtin_amdgcn_exp2f(x); }

DI void build_bias_lut(const float* __restrict__ t5, char* smem, bool swa) {
    float* lut = (float*)(smem + at::OFF_BIAS);
    for (int i = TIDX; i < 16 * 200; i += NTHREADS) {
        const int h = i / 200, e = i % 200; float v = at::NEG_MASK;
        if (e >= 64 && e < 192) v = t5[t5_bucket(e - 64) * 16 + h] * at::L2E;
        else if (e >= 192 && !swa) v = t5[31 * 16 + h] * at::L2E;
        lut[i] = v;
    }
    __syncthreads();
}

struct AttnState { f32x4 o[2][4]; f32x4 lacc[2]; float m[2]; };
DI unsigned long long range_mask(int lo, int hi) { return (hi >= 63 ? ~0ull : ((1ull << (hi + 1)) - 1ull)) & ~((1ull << lo) - 1ull); }

DI void attn_load_q(bf16x8 (&qf)[2][2], const bf16* __restrict__ Qp, int ldq, size_t mbase, int hbase) {
    const int lane = TIDX & 63, wave = TIDX >> 6, q = lane >> 4, l15 = lane & 15;
#pragma unroll
    for (int qt = 0; qt < 2; ++qt) {
        const size_t m = mbase + wave * 8 + qt * 4 + (l15 >> 2);
#pragma unroll
        for (int ks = 0; ks < 2; ++ks) qf[qt][ks] = *(const bf16x8*)(Qp + m * ldq + (hbase + (l15 & 3)) * 64 + ks * 32 + q * 8);
    }
}

enum { SK_FAR = 0, SK_NEAR = 1, SK_EDGE = 2, SK_CMP = 3 };
template <int KIND>
DI float attn_fix(f32x4 (&s)[4], int dbase, float cadd, const float* __restrict__ bl, float mx) {
#pragma unroll
    for (int kt = 0; kt < 4; ++kt)
#pragma unroll
        for (int r = 0; r < 4; ++r) {
            float v = s[kt][r]; const int dist = dbase - (kt * 16 + r);
            if (KIND == SK_NEAR) { int idx = dist + 64; idx = idx < 0 ? 0 : (idx > 192 ? 192 : idx); v += bl[idx] + cadd; }
            else if (KIND == SK_EDGE) v = dist < 512 ? v + cadd : at::NEG_MASK;
            else if (KIND == SK_CMP) v = dist >= 0 ? v : at::NEG_MASK;
            if (KIND != SK_FAR) s[kt][r] = v;
            mx = fmaxf(mx, v);
        }
    return mx;
}
template <int MODE>
DI void attn_blocks(AttnState& st, const bf16x8 (&qf)[2][2], const bf16* __restrict__ Kp, size_t krs, const bf16* __restrict__ Vp, size_t vrs,
                    int t0, unsigned long long todo, int hbase, unsigned long long sel0, unsigned long long sel1, char* smem) {
    const int tid = TIDX, lane = tid & 63, wave = __builtin_amdgcn_readfirstlane(tid >> 6), q = lane >> 4, l15 = lane & 15;
    const int tq0 = t0 + wave * 8 + (l15 >> 2);
    const float* bl = (const float*)(smem + at::OFF_BIAS) + (hbase + (l15 & 3)) * 200;
    const float bfar = (MODE != AM_CMP) ? bl[192] : 0.f;
    const int srow = tid >> 3, scs = (tid & 7) ^ (srow & 7);
    const int fo = l15 * 128 + ((q ^ (l15 & 7)) << 4);
#define ATT_DMA(kb_, slot_) { _Pragma("unroll") for (int i = 0; i < 2; ++i) { const int row = srow + 32 * i; char* dst = smem + (slot_) * 16384 + (8 * wave + 32 * i) * 128; \
        GLDS16(Kp + (size_t)((kb_) * 64 + row) * krs + scs * 8, dst); GLDS16(Vp + (size_t)row * vrs + (kb_) * 64 + scs * 8, dst + 8192); } }
#define ATT_BARRIER() { asm volatile("s_waitcnt lgkmcnt(0)" ::: "memory"); __builtin_amdgcn_s_barrier(); asm volatile("" ::: "memory"); }
    if (todo == 0ull) return;
    int kb = __builtin_ctzll(todo); todo &= todo - 1ull;
    int kb1 = -1; if (todo) { kb1 = __builtin_ctzll(todo); todo &= todo - 1ull; }
    ATT_DMA(kb, 0);
    if (kb1 >= 0) { ATT_DMA(kb1, 1); asm volatile("s_waitcnt vmcnt(4)" ::: "memory"); } else { asm volatile("s_waitcnt vmcnt(0)" ::: "memory"); }
    ATT_BARRIER();
    int slot = 0;
    for (;;) {
        char* buf = smem + slot * 16384;
        int kb2 = -1; if (todo) { kb2 = __builtin_ctzll(todo); todo &= todo - 1ull; }
        if (kb2 >= 0) { const int s2 = slot >= 1 ? slot - 1 : 2; ATT_DMA(kb2, s2); }
        f32x4 s[2][4];
#pragma unroll
        for (int qt = 0; qt < 2; ++qt)
#pragma unroll
            for (int kt = 0; kt < 4; ++kt) s[qt][kt] = (f32x4){0.f, 0.f, 0.f, 0.f};
#pragma unroll
        for (int kt = 0; kt < 4; ++kt)
#pragma unroll
            for (int ks = 0; ks < 2; ++ks) {
                const bf16x8 kf = *(const bf16x8*)(buf + ((fo + kt * 2048) ^ (ks << 6)));
                s[0][kt] = __builtin_amdgcn_mfma_f32_16x16x32_bf16(kf, qf[0][ks], s[0][kt], 0, 0, 0);
                s[1][kt] = __builtin_amdgcn_mfma_f32_16x16x32_bf16(kf, qf[1][ks], s[1][kt], 0, 0, 0);
            }
        const int mind = (t0 + wave * 8) - (kb * 64 + 63), maxd = (t0 + wave * 8 + 7) - kb * 64;
        float mx[2], cofs[2] = {0.f, 0.f};
        if (MODE == AM_CMP) {
#pragma unroll
            for (int qt = 0; qt < 2; ++qt) { const int nlim = (tq0 + 4 * qt - 31) >> 4; mx[qt] = attn_fix<SK_CMP>(s[qt], nlim - (kb * 64 + 4 * q), 0.f, bl, at::NEG_MASK); }
        } else {
            float cadd[2] = {0.f, 0.f};
            if (MODE == AM_SEL) { cadd[0] = ((sel0 >> kb) & 1ull) ? 0.f : at::NEG_MASK; cadd[1] = ((sel1 >> kb) & 1ull) ? 0.f : at::NEG_MASK; }
            if (MODE == AM_SWA || mind < 113) {
#pragma unroll
                for (int qt = 0; qt < 2; ++qt) mx[qt] = attn_fix<SK_NEAR>(s[qt], tq0 + 4 * qt - (kb * 64 + 4 * q), cadd[qt], bl, at::NEG_MASK);
            } else if (MODE == AM_WIN && maxd >= 512) {
#pragma unroll
                for (int qt = 0; qt < 2; ++qt) mx[qt] = attn_fix<SK_EDGE>(s[qt], tq0 + 4 * qt - (kb * 64 + 4 * q), bfar, bl, at::NEG_MASK);
            } else {
#pragma unroll
                for (int qt = 0; qt < 2; ++qt) { cofs[qt] = bfar + cadd[qt]; mx[qt] = attn_fix<SK_FAR>(s[qt], 0, 0.f, bl, at::NEG_MASK) + cofs[qt]; }
            }
        }
        float msub[2]; bool grow = false;
#pragma unroll
        for (int qt = 0; qt < 2; ++qt) {
            float m2 = mx[qt];
            m2 = fmaxf(m2, __shfl_xor(m2, 16)); m2 = fmaxf(m2, __shfl_xor(m2, 32));
            const bool g = m2 > st.m[qt] + 4.0f; grow |= g;
            mx[qt] = g ? m2 : st.m[qt];
            msub[qt] = mx[qt] - cofs[qt];
        }
        if (__any(grow)) {
#pragma unroll
            for (int qt = 0; qt < 2; ++qt) {
                const float alpha = fast_exp2(st.m[qt] - mx[qt]);
#pragma unroll
                for (int dt = 0; dt < 4; ++dt) st.o[qt][dt] *= alpha;
                st.lacc[qt] *= alpha;
            }
        }
        st.m[0] = mx[0]; st.m[1] = mx[1];
#pragma unroll
        for (int qt = 0; qt < 2; ++qt)
#pragma unroll
            for (int kt = 0; kt < 4; ++kt)
#pragma unroll
                for (int r = 0; r < 4; ++r) s[qt][kt][r] = fast_exp2(s[qt][kt][r] - msub[qt]);
        const bf16x8 ones = {(short)0x3F80, (short)0x3F80, (short)0x3F80, (short)0x3F80, (short)0x3F80, (short)0x3F80, (short)0x3F80, (short)0x3F80};
#pragma unroll
        for (int kp = 0; kp < 2; ++kp) {
            bf16x8 pf[2];
#pragma unroll
            for (int qt = 0; qt < 2; ++qt) {
                const u32x4 w = {pack2bf(s[qt][2 * kp][0], s[qt][2 * kp][1]), pack2bf(s[qt][2 * kp][2], s[qt][2 * kp][3]),
                                 pack2bf(s[qt][2 * kp + 1][0], s[qt][2 * kp + 1][1]), pack2bf(s[qt][2 * kp + 1][2], s[qt][2 * kp + 1][3])};
                pf[qt] = __builtin_bit_cast(bf16x8, w);
            }
            st.lacc[0] = __builtin_amdgcn_mfma_f32_16x16x32_bf16(ones, pf[0], st.lacc[0], 0, 0, 0);
            st.lacc[1] = __builtin_amdgcn_mfma_f32_16x16x32_bf16(ones, pf[1], st.lacc[1], 0, 0, 0);
#pragma unroll
            for (int dt = 0; dt < 4; ++dt) {
                const bf16x8 vf = *(const bf16x8*)(buf + 8192 + ((fo + dt * 2048) ^ (kp << 6)));
                st.o[0][dt] = __builtin_amdgcn_mfma_f32_16x16x32_bf16(vf, pf[0], st.o[0][dt], 0, 0, 0);
                st.o[1][dt] = __builtin_amdgcn_mfma_f32_16x16x32_bf16(vf, pf[1], st.o[1][dt], 0, 0, 0);
            }
        }
        if (kb1 < 0) break;
        if (kb2 >= 0) { asm volatile("s_waitcnt vmcnt(4)" ::: "memory"); } else { asm volatile("s_waitcnt vmcnt(0)" ::: "memory"); }
        ATT_BARRIER();
        kb = kb1; kb1 = kb2; slot = slot == 2 ? 0 : slot + 1;
    }
    ATT_BARRIER();
#undef ATT_DMA
}
DI void attn_init(AttnState& st, float m0, float l0) {
#pragma unroll
    for (int qt = 0; qt < 2; ++qt) { st.m[qt] = m0; st.lacc[qt] = (f32x4){l0, l0, l0, l0};
#pragma unroll
        for (int dt = 0; dt < 4; ++dt) st.o[qt][dt] = (f32x4){0.f, 0.f, 0.f, 0.f}; }
}
DI float attn_linv(const f32x4& lacc) { const float l = lacc[0]; return l > 0.f ? 1.0f / l : 0.f; }

DI void attn_item_decode(int item, int& b, int& g, int& t0) {
    constexpr int tiles = T / 32;
    const int Gd = (int)gridDim.x;
    int pair, tile;
    if ((Gd % tiles) == 0 && tiles * B * G % Gd == 0) {
        const int bid = item % Gd, rr = item / Gd, tau = bid % tiles;
        pair = bid / tiles + (Gd / tiles) * rr; tile = (rr & 1) ? tiles - 1 - tau : tau;
    } else { tile = item % tiles; pair = item / tiles; }
    t0 = tile * 32; g = pair % G; b = pair / G;
}
DI void swa_item(const bf16* __restrict__ P0, const bf16* __restrict__ VT, const float* __restrict__ sinks, bf16* __restrict__ AO, int item, char* smem) {
    constexpr int LDP = 2304;
    int b, g, t0; attn_item_decode(item, b, g, t0);
    const int lane = TIDX & 63, wave = TIDX >> 6, q = lane >> 4, l15 = lane & 15;
    const size_t mbase = (size_t)b * T + t0; const int hbase = g * 4, h = hbase + (l15 & 3);
    bf16x8 qf[2][2]; attn_load_q(qf, P0, LDP, mbase, hbase);
    AttnState st; attn_init(st, sinks[h] * at::L2E, 1.0f);
    const int lo = t0 - 127 < 0 ? 0 : (t0 - 127) >> 6, hi = (t0 + 31) >> 6;
    attn_blocks<AM_SWA>(st, qf, P0 + (size_t)b * T * LDP + 1024 + g * 64, LDP, VT + (size_t)(b * G + g) * 64 * T, T, t0, range_mask(lo, hi), hbase, 0ull, 0ull, smem);
#pragma unroll
    for (int qt = 0; qt < 2; ++qt) {
        const float li = attn_linv(st.lacc[qt]); const size_t m = mbase + wave * 8 + qt * 4 + (l15 >> 2);
#pragma unroll
        for (int dt = 0; dt < 4; ++dt) {
            const int d0 = dt * 16 + 4 * q; const u32x2 zz = *(const u32x2*)(P0 + m * LDP + 1280 + h * 64 + d0);
            const float z0 = bflo(zz[0]), z1 = bfhi(zz[0]), z2 = bflo(zz[1]), z3 = bfhi(zz[1]);
            const f32x4 o = st.o[qt][dt];
            *(u32x2*)(AO + m * D + h * 64 + d0) = (u32x2){pack2bf(o[0] * li * siluf_(z0), o[1] * li * siluf_(z1)), pack2bf(o[2] * li * siluf_(z2), o[3] * li * siluf_(z3))};
        }
    }
}

struct EpiL0 {
    bf16* P0; bf16* VT; const float* parts; mutable float rsc[4];
    DI void operator()(int m, int n, const float* v, int mt, int gi) const {
        if (gi == 0) rsc[mt] = rstd_from_parts(parts, m);
        float s = rsc[mt]; if (n < 1024) s *= 0.125f * at::L2E; float w[8];
#pragma unroll
        for (int j = 0; j < 8; ++j) w[j] = v[j] * s;
        if (n < 1280) store8bf(P0 + (size_t)m * 2304 + n, w);
        else if (n >= 1536) store8bf(P0 + (size_t)m * 2304 + n - 256, w);
        else {
            const int g = (n - 1280) >> 6, d = (n - 1280) & 63, b = m / T, t = m % T; const int pos = (t & ~31) + vt_perm(t & 31);
            bf16* dst = VT + ((size_t)(b * G + g) * 64 + d) * T + pos;
#pragma unroll
            for (int j = 0; j < 8; ++j) dst[(size_t)j * T] = f2bf(w[j]);
        }
    }
    DI void finish(int, int, int, int, int) const {}
    DI void finish_wide(int, int, int, int, int) const {}
};

constexpr int LDP2 = 3200;
struct EpiL2 {
    bf16* P2; bf16* VTs; bf16* VTw; const float* parts; mutable float rsc[4];
    DI void operator()(int m, int n, const float* v, int mt, int gi) const {
        if (gi == 0) rsc[mt] = rstd_from_parts(parts, m);
        if (n >= C_COLS) return;
        float s = rsc[mt]; if (n < 1024) s *= 0.125f * at::L2E; float w[8];
#pragma unroll
        for (int j = 0; j < 8; ++j) w[j] = v[j] * s;
        const bool isvs = n >= 1792 && n < 2048, isvw = n >= 2304 && n < 2560;
        if (isvs || isvw) {
            const int c = n - (isvs ? 1792 : 2304); const int g = c >> 6, d = c & 63, b = m / T, t = m % T; const int pos = (t & ~31) + vt_perm(t & 31);
            bf16* dst = (isvs ? VTs : VTw) + ((size_t)(b * G + g) * 64 + d) * T + pos;
#pragma unroll
            for (int j = 0; j < 8; ++j) dst[(size_t)j * T] = f2bf(w[j]);
        } else {
            const int c = n < 1792 ? n : (n < 2304 ? n - 256 : n - 512);
            store8bf(P2 + (size_t)m * LDP2 + c, w);
        }
    }
    DI void finish(int, int, int, int, int) const {}
    DI void finish_wide(int, int, int, int, int) const {}
};

struct ALoadCmp {
    const bf16* P2; int col;
    static constexpr bool DMA = true;
    DI const bf16* src(int row, int k) const {
        int n = row & 255; const int bg = row >> 8, b = bg >> 2, g = bg & 3; const int l = k >> 6, d = k & 63; n = n < NCMP ? n : NCMP - 1;
        return P2 + (size_t)(b * T + 16 * n + l) * LDP2 + col + g * 64 + d;
    }
    struct Raw { u32x4 v; };
    DI Raw load(int row, int k) const {
        const int n = row & 255, bg = row >> 8, b = bg >> 2, g = bg & 3; const int l = k >> 6, d = k & 63; Raw r;
        if (n < NCMP) r.v = *(const u32x4*)(P2 + (size_t)(b * T + 16 * n + l) * LDP2 + col + g * 64 + d); else r.v = (u32x4){0u, 0u, 0u, 0u};
        return r;
    }
    DI u32x4 finish(const Raw& r, int, int) const { return r.v; }
};
struct EpiCmpH {
    char* smem; const float* bias8;
    DI void operator()(int m, int n, const float* v, int, int) const {
        const int row = m & 127; float w[8];
#pragma unroll
        for (int j = 0; j < 8; ++j) { float bsum = 0.f;
#pragma unroll
            for (int i = 0; i < 8; ++i) bsum += bias8[i * 128 + n + j];
            w[j] = siluf_(v[j] + bsum); }
        const int kk = n >> 6, c = (n & 63) >> 3;
        *(u32x4*)(smem + kk * 16384 + row * 128 + ((c ^ (row & 7)) << 4)) = (u32x4){pack2bf(w[0], w[1]), pack2bf(w[2], w[3]), pack2bf(w[4], w[5]), pack2bf(w[6], w[7])};
    }
    DI void finish(int, int, int, int, int) const {}
    DI void finish_wide(int, int, int, int, int) const {}
};
DI void cmp_tile(const bf16* __restrict__ P2, const bf16* __restrict__ w1t, const float* __restrict__ bias8, const bf16* __restrict__ w2t, int which, int rt,
                 bf16* __restrict__ KCb, bf16* __restrict__ VCT, char* smem) {
    gemm_tile(ALoadCmp{P2, which ? 1280 : 1024}, w1t, 2048, rt * 128, 0, EpiCmpH{smem, bias8}, smem);
    const int tid = TIDX, lane = tid & 63, wave = tid >> 6, q = lane >> 4, l15 = lane & 15;
#pragma unroll
    for (int i = 0; i < 4; ++i) {
        const int id = i * 256 + tid; const int row = id >> 4, c16 = id & 15, kk = c16 >> 3, c = c16 & 7;
        *(u32x4*)(smem + 32768 + kk * 8192 + row * 128 + ((c ^ (row & 7)) << 4)) = *(const u32x4*)(w2t + (size_t)row * 128 + c16 * 8);
    }
    __syncthreads();
    f32x4 acc[2][4];
#pragma unroll
    for (int i = 0; i < 2; ++i)
#pragma unroll
        for (int j = 0; j < 4; ++j) acc[i][j] = (f32x4){0.f, 0.f, 0.f, 0.f};
    const int fo = l15 * 128 + ((q ^ (l15 & 7)) << 4);
#pragma unroll
    for (int kk = 0; kk < 2; ++kk)
#pragma unroll
        for (int ks = 0; ks < 2; ++ks) {
            bf16x8 hf[2], wf[4];
#pragma unroll
            for (int i = 0; i < 2; ++i) hf[i] = *(const bf16x8*)(smem + kk * 16384 + (((wave * 32 + i * 16) * 128 + fo) ^ (ks << 6)));
#pragma unroll
            for (int j = 0; j < 4; ++j) wf[j] = *(const bf16x8*)(smem + 32768 + kk * 8192 + ((j * 2048 + fo) ^ (ks << 6)));
#pragma unroll
            for (int i = 0; i < 2; ++i)
#pragma unroll
                for (int j = 0; j < 4; ++j) acc[i][j] = __builtin_amdgcn_mfma_f32_16x16x32_bf16(wf[j], hf[i], acc[i][j], 0, 0, 0);
        }
#pragma unroll
    for (int i = 0; i < 2; ++i) {
        const int row = rt * 128 + wave * 32 + i * 16 + l15; const int n = row & 255, bg = row >> 8;
#pragma unroll
        for (int j = 0; j < 4; ++j) {
            const int d0 = j * 16 + 4 * q; const f32x4 a = acc[i][j];
            if (which == 0) *(u32x2*)(KCb + (size_t)row * 64 + d0) = (u32x2){pack2bf(a[0], a[1]), pack2bf(a[2], a[3])};
            else {
                const int pos = (n & ~31) + vt_perm(n & 31);
#pragma unroll
                for (int r = 0; r < 4; ++r) VCT[((size_t)bg * 64 + d0 + r) * 256 + pos] = f2bf(a[r]);
            }
        }
    }
    __syncthreads();
}

DI void win_item(const bf16* __restrict__ P2, const bf16* __restrict__ VTw, bf16* __restrict__ OW, int item, char* smem) {
    int b, g, t0; attn_item_decode(item, b, g, t0);
    const int lane = TIDX & 63, wave = TIDX >> 6, q = lane >> 4, l15 = lane & 15;
    const size_t mbase = (size_t)b * T + t0; const int hbase = g * 4, h = hbase + (l15 & 3);
    bf16x8 qf[2][2]; attn_load_q(qf, P2, LDP2, mbase, hbase);
    AttnState st; attn_init(st, at::M_INIT, 0.f);
    const int lo = t0 - 511 < 0 ? 0 : (t0 - 511) >> 6, hi = (t0 + 31) >> 6;
    attn_blocks<AM_WIN>(st, qf, P2 + (size_t)b * T * LDP2 + 1792 + g * 64, LDP2, VTw + (size_t)(b * G + g) * 64 * T, T, t0, range_mask(lo, hi), hbase, 0ull, 0ull, smem);
#pragma unroll
    for (int qt = 0; qt < 2; ++qt) {
        const float li = attn_linv(st.lacc[qt]); const size_t m = mbase + wave * 8 + qt * 4 + (l15 >> 2);
#pragma unroll
        for (int dt = 0; dt < 4; ++dt) { const f32x4 o = st.o[qt][dt]; *(u32x2*)(OW + m * D + h * 64 + dt * 16 + 4 * q) = (u32x2){pack2bf(o[0] * li, o[1] * li), pack2bf(o[2] * li, o[3] * li)}; }
    }
}

DI void cmpsel_item(const bf16* __restrict__ P2, const bf16* __restrict__ KCb, const bf16* __restrict__ VCT, bf16* __restrict__ OC, unsigned long long* __restrict__ SELM, int item, char* smem) {
    int b, g, t0; attn_item_decode(item, b, g, t0);
    const int tid = TIDX, lane = tid & 63, wave = tid >> 6, q = lane >> 4, l15 = lane & 15;
    const size_t mbase = (size_t)b * T + t0; const int hbase = g * 4, h = hbase + (l15 & 3);
    float* impL = (float*)(smem + at::OFF_IMP);
    for (int i = tid; i < 32 * 64; i += NTHREADS) impL[i] = 0.f;
    bf16x8 qf[2][2]; attn_load_q(qf, P2, LDP2, mbase, hbase);
    AttnState st; attn_init(st, at::M_INIT, 0.f);
    const int nvmax = (t0 + 31 - 31) / 16 + 1;
    const int hi = (nvmax - 1) >> 6;
    const bf16* Kp = KCb + (size_t)(b * G + g) * 256 * 64; const bf16* Vp = VCT + (size_t)(b * G + g) * 64 * 256;
    attn_blocks<AM_CMP>(st, qf, Kp, 64, Vp, 256, t0, range_mask(0, hi), hbase, 0ull, 0ull, smem);
    float linv[2];
#pragma unroll
    for (int qt = 0; qt < 2; ++qt) {
        linv[qt] = attn_linv(st.lacc[qt]); const size_t m = mbase + wave * 8 + qt * 4 + (l15 >> 2);
#pragma unroll
        for (int dt = 0; dt < 4; ++dt) { const f32x4 o = st.o[qt][dt]; *(u32x2*)(OC + m * D + h * 64 + dt * 16 + 4 * q) = (u32x2){pack2bf(o[0] * linv[qt], o[1] * linv[qt]), pack2bf(o[2] * linv[qt], o[3] * linv[qt])}; }
    }
    {
        const int srow = tid >> 3, sc = tid & 7; const int st_off = srow * 128 + ((sc ^ (srow & 7)) << 4); const int fo = l15 * 128 + ((q ^ (l15 & 7)) << 4);
        const int tq0 = t0 + wave * 8 + (l15 >> 2);
        for (int kb = 0; kb <= hi; ++kb) {
#pragma unroll
            for (int i = 0; i < 2; ++i) { const int row = srow + 32 * i; *(u32x4*)(smem + st_off + i * 4096) = *(const u32x4*)(Kp + (size_t)(kb * 64 + row) * 64 + sc * 8); }
            __syncthreads();
            f32x4 s[2][4];
#pragma unroll
            for (int qt = 0; qt < 2; ++qt)
#pragma unroll
                for (int kt = 0; kt < 4; ++kt) s[qt][kt] = (f32x4){0.f, 0.f, 0.f, 0.f};
#pragma unroll
            for (int kt = 0; kt < 4; ++kt)
#pragma unroll
                for (int ks = 0; ks < 2; ++ks) {
                    const bf16x8 kf = *(const bf16x8*)(smem + ((fo + kt * 2048) ^ (ks << 6)));
                    s[0][kt] = __builtin_amdgcn_mfma_f32_16x16x32_bf16(kf, qf[0][ks], s[0][kt], 0, 0, 0);
                    s[1][kt] = __builtin_amdgcn_mfma_f32_16x16x32_bf16(kf, qf[1][ks], s[1][kt], 0, 0, 0);
                }
#pragma unroll
            for (int qt = 0; qt < 2; ++qt) {
                const int tq = tq0 + 4 * qt; const int tl = wave * 8 + qt * 4 + (l15 >> 2);
#pragma unroll
                for (int kt = 0; kt < 4; ++kt) {
                    float pr[4];
#pragma unroll
                    for (int r = 0; r < 4; ++r) { const int key = kb * 64 + kt * 16 + 4 * q + r; pr[r] = (16 * key + 31 <= tq) ? fast_exp2(s[qt][kt][r] - st.m[qt]) * linv[qt] : 0.f; }
                    float s4 = (pr[0] + pr[1]) + (pr[2] + pr[3]), s1 = pr[3];
                    s4 += __shfl_xor(s4, 1); s4 += __shfl_xor(s4, 2); s1 += __shfl_xor(s1, 1); s1 += __shfl_xor(s1, 2);
                    const int s0 = kb * 16 + kt * 4 + q;
                    if ((l15 & 3) == 0) { atomicAdd(&impL[tl * 64 + s0], s4); if (s0 + 1 < 64) atomicAdd(&impL[tl * 64 + s0 + 1], s1); }
                }
            }
            __syncthreads();
        }
    }
    {
        const int tl = tid >> 3, sg = tid & 7; const int t = t0 + tl, cur = t >> 6; float* row = impL + tl * 64;
        float mine[8];
#pragma unroll
        for (int j = 0; j < 8; ++j) { const int s = sg * 8 + j; mine[j] = (s == 0 || s == cur || s == cur - 1) ? 1e30f : (s * 64 > t ? -1e30f : row[s]); }
        __syncthreads();
#pragma unroll
        for (int j = 0; j < 8; ++j) row[sg * 8 + j] = mine[j];
        __syncthreads();
        int rank[8] = {0, 0, 0, 0, 0, 0, 0, 0};
#pragma unroll 4
        for (int s4 = 0; s4 < 16; ++s4) {
            const float4 v4 = *(const float4*)(row + s4 * 4); const float vv[4] = {v4.x, v4.y, v4.z, v4.w};
#pragma unroll
            for (int e = 0; e < 4; ++e) { const int s2 = s4 * 4 + e;
#pragma unroll
                for (int j = 0; j < 8; ++j) rank[j] += (vv[e] > mine[j] || (vv[e] == mine[j] && s2 < sg * 8 + j)) ? 1 : 0; }
        }
        unsigned long long bits = 0ull;
#pragma unroll
        for (int j = 0; j < 8; ++j) if (rank[j] < KTOP) bits |= 1ull << (sg * 8 + j);
        unsigned lo = (unsigned)bits, hi2 = (unsigned)(bits >> 32);
#pragma unroll
        for (int o = 1; o < 8; o <<= 1) { lo |= __shfl_xor(lo, o); hi2 |= __shfl_xor(hi2, o); }
        if (sg == 0) SELM[(mbase + tl) * 4 + g] = ((unsigned long long)hi2 << 32) | lo;
    }
    __syncthreads();
}

DI void sel_item(const bf16* __restrict__ P2, const bf16* __restrict__ VTs, const unsigned long long* __restrict__ SELM, const bf16* __restrict__ OC, const bf16* __restrict__ OW,
                 bf16* __restrict__ AO, int item, char* smem) {
    int b, g, t0; attn_item_decode(item, b, g, t0);
    const int tid = TIDX, lane = tid & 63, wave = tid >> 6, q = lane >> 4, l15 = lane & 15;
    const size_t mbase = (size_t)b * T + t0; const int hbase = g * 4, rr = l15 & 3, h = hbase + rr;
    unsigned long long* orw = (unsigned long long*)(smem + at::OFF_X);
    if (tid == 0) *orw = 0ull;
    __syncthreads();
    if (tid < 32) atomicOr(orw, SELM[(mbase + tid) * 4 + g]);
    const unsigned long long sel0 = SELM[(mbase + wave * 8 + (l15 >> 2)) * 4 + g], sel1 = SELM[(mbase + wave * 8 + 4 + (l15 >> 2)) * 4 + g];
    bf16x8 qf[2][2]; attn_load_q(qf, P2, LDP2, mbase, hbase);
    AttnState st; attn_init(st, at::M_INIT, 0.f);
    __syncthreads();
    const unsigned long long todo_v = (*orw) & range_mask(0, (t0 + 31) >> 6);
    const unsigned long long todo = ((unsigned long long)(unsigned)__builtin_amdgcn_readfirstlane((int)(todo_v >> 32)) << 32) | (unsigned)__builtin_amdgcn_readfirstlane((int)(unsigned)todo_v);
    attn_blocks<AM_SEL>(st, qf, P2 + (size_t)b * T * LDP2 + 1536 + g * 64, LDP2, VTs + (size_t)(b * G + g) * 64 * T, T, t0, todo, hbase, sel0, sel1, smem);
#pragma unroll
    for (int qt = 0; qt < 2; ++qt) {
        const float li = attn_linv(st.lacc[qt]); const size_t m = mbase + wave * 8 + qt * 4 + (l15 >> 2);
        const bf16* gr = P2 + m * LDP2 + 3072;
        const float g0 = sigmoidf_(bf2f(gr[0 * 16 + h])), g1 = sigmoidf_(bf2f(gr[1 * 16 + h])), g2 = sigmoidf_(bf2f(gr[2 * 16 + h]));
#pragma unroll
        for (int dt = 0; dt < 4; ++dt) {
            const int d0 = dt * 16 + 4 * q; const size_t oi = m * D + h * 64 + d0;
            const u32x2 zz = *(const u32x2*)(P2 + m * LDP2 + 2048 + h * 64 + d0), cc = *(const u32x2*)(OC + oi), ww = *(const u32x2*)(OW + oi);
            const f32x4 o = st.o[qt][dt];
            const float r0 = (g0 * bflo(cc[0]) + g1 * o[0] * li + g2 * bflo(ww[0])) * siluf_(bflo(zz[0]));
            const float r1 = (g0 * bfhi(cc[0]) + g1 * o[1] * li + g2 * bfhi(ww[0])) * siluf_(bfhi(zz[0]));
            const float r2 = (g0 * bflo(cc[1]) + g1 * o[2] * li + g2 * bflo(ww[1])) * siluf_(bflo(zz[1]));
            const float r3 = (g0 * bfhi(cc[1]) + g1 * o[3] * li + g2 * bfhi(ww[1])) * siluf_(bfhi(zz[1]));
            *(u32x2*)(AO + oi) = (u32x2){pack2bf(r0, r1), pack2bf(r2, r3)};
        }
    }
    __syncthreads();
}

DI void lru_convert_gates(const float* __restrict__ gaw, const float* __restrict__ gxw, bf16* __restrict__ img) {
    for (int i = blockIdx.x * NTHREADS + TIDX; i < 16 * 160 * 96; i += gridDim.x * NTHREADS) {
        const int k = i % 96, n = (i / 96) % 160, blk = i / (96 * 160);
        float v = 0.f;
        if (k < 80) v = n < 80 ? gaw[((size_t)blk * 80 + k) * 80 + n] : gxw[((size_t)blk * 80 + k) * 80 + (n - 80)];
        img[i] = f2bf(v);
    }
}
DI void lru_gate_item(const bf16* __restrict__ P3, const float* __restrict__ cw, const float* __restrict__ cb, const bf16* __restrict__ gimg, const float* __restrict__ gab, const float* __restrict__ gxb,
                      const float* __restrict__ lam, bf16* __restrict__ LA, bf16* __restrict__ BV, float2* __restrict__ SUM, int item, char* smem) {
    const int rt = item >> 4, nb = item & 15; const int tid = TIDX, lane = tid & 63, wave = tid >> 6, q = lane >> 4, l15 = lane & 15;
    const size_t m0 = (size_t)rt * 128;
    for (int id = tid; id < 128 * 12; id += NTHREADS) {
        const int row = id / 12, c12 = id % 12; u32x4 outv = (u32x4){0u, 0u, 0u, 0u};
        if (c12 < 10) {
            const size_t m = m0 + row; const int t = (int)(m % T); const int ch = nb * 80 + c12 * 8;
            float acc[8];
            { const float4 b0 = *(const float4*)(cb + ch), b1 = *(const float4*)(cb + ch + 4); acc[0] = b0.x; acc[1] = b0.y; acc[2] = b0.z; acc[3] = b0.w; acc[4] = b1.x; acc[5] = b1.y; acc[6] = b1.z; acc[7] = b1.w; }
#pragma unroll
            for (int w = 0; w < 4; ++w) {
                if (t - 3 + w >= 0) {
                    const u32x4 uv = *(const u32x4*)(P3 + (m - 3 + w) * 2560 + ch);
                    const float4 w0 = *(const float4*)(cw + w * LW + ch), w1 = *(const float4*)(cw + w * LW + ch + 4);
                    acc[0] += w0.x * bflo(uv[0]); acc[1] += w0.y * bfhi(uv[0]); acc[2] += w0.z * bflo(uv[1]); acc[3] += w0.w * bfhi(uv[1]);
                    acc[4] += w1.x * bflo(uv[2]); acc[5] += w1.y * bfhi(uv[2]); acc[6] += w1.z * bflo(uv[3]); acc[7] += w1.w * bfhi(uv[3]);
                }
            }
            outv = (u32x4){pack2bf(acc[0], acc[1]), pack2bf(acc[2], acc[3]), pack2bf(acc[4], acc[5]), pack2bf(acc[6], acc[7])};
        }
        const int ks = c12 >> 2, c = c12 & 3;
        *(u32x4*)(smem + ks * 8192 + row * 64 + ((c ^ ((row >> 2) & 3)) << 4)) = outv;
    }
    for (int id = tid; id < 160 * 12; id += NTHREADS) {
        const int row = id / 12, c12 = id % 12; const int ks = c12 >> 2, c = c12 & 3;
        *(u32x4*)(smem + 24576 + ks * 10240 + row * 64 + ((c ^ ((row >> 2) & 3)) << 4)) = *(const u32x4*)(gimg + ((size_t)nb * 160 + row) * 96 + c12 * 8);
    }
    __syncthreads();
    f32x4 acc[2][10];
#pragma unroll
    for (int i = 0; i < 2; ++i)
#pragma unroll
        for (int j = 0; j < 10; ++j) acc[i][j] = (f32x4){0.f, 0.f, 0.f, 0.f};
    const int fo = l15 * 64 + ((q ^ ((l15 >> 2) & 3)) << 4);
#pragma unroll
    for (int ks = 0; ks < 3; ++ks) {
        bf16x8 uf[2];
#pragma unroll
        for (int i = 0; i < 2; ++i) uf[i] = *(const bf16x8*)(smem + ks * 8192 + (wave * 32 + i * 16) * 64 + fo);
#pragma unroll
        for (int j = 0; j < 10; ++j) {
            const bf16x8 wf = *(const bf16x8*)(smem + 24576 + ks * 10240 + j * 1024 + fo);
            acc[0][j] = __builtin_amdgcn_mfma_f32_16x16x32_bf16(wf, uf[0], acc[0][j], 0, 0, 0);
            acc[1][j] = __builtin_amdgcn_mfma_f32_16x16x32_bf16(wf, uf[1], acc[1][j], 0, 0, 0);
        }
    }
    __syncthreads();
#pragma unroll
    for (int i = 0; i < 2; ++i) {
        const int row = wave * 32 + i * 16 + l15; const size_t m = m0 + row;
#pragma unroll
        for (int ct = 0; ct < 5; ++ct) {
            const int kcol = ct * 16 + 4 * q; const int ch = nb * 80 + kcol;
            const u32x2 uu = *(const u32x2*)(smem + (kcol >> 5) * 8192 + row * 64 + ((((kcol & 31) >> 3) ^ ((row >> 2) & 3)) << 4) + (kcol & 7) * 2);
            const float uc[4] = {bflo(uu[0]), bfhi(uu[0]), bflo(uu[1]), bfhi(uu[1])};
            const float4 ba = *(const float4*)(gab + ch), bx = *(const float4*)(gxb + ch), lm = *(const float4*)(lam + ch);
            const float bav[4] = {ba.x, ba.y, ba.z, ba.w}, bxv[4] = {bx.x, bx.y, bx.z, bx.w}, lmv[4] = {lm.x, lm.y, lm.z, lm.w};
            float la[4], bv[4];
#pragma unroll
            for (int r = 0; r < 4; ++r) {
                const float rg = __builtin_amdgcn_rcpf(1.0f + __expf(-(acc[i][ct][r] + bav[r]))), ig = __builtin_amdgcn_rcpf(1.0f + __expf(-(acc[i][ct + 5][r] + bxv[r])));
                la[r] = rg * lmv[r];
                const float om = 1.0f - __expf(2.0f * la[r]);
                bv[r] = __builtin_amdgcn_sqrtf(om > 0.f ? om : 0.f) * (ig * uc[r]);
            }
            const u32x2 lav = {pack2bf(la[0], la[1]), pack2bf(la[2], la[3])}, bvv = {pack2bf(bv[0], bv[1]), pack2bf(bv[2], bv[3])};
            *(u32x2*)(LA + m * LW + ch) = lav; *(u32x2*)(BV + m * LW + ch) = bvv;
            *(u32x2*)(smem + 24576 + (row * 80 + kcol) * 2) = lav; *(u32x2*)(smem + 24576 + 20480 + (row * 80 + kcol) * 2) = bvv;
        }
    }
    __syncthreads();
    if (tid < 160) {
        const int cidx = tid / 80, c = tid % 80; const bf16* li = (const bf16*)(smem + 24576) + (cidx * 64) * 80 + c; const bf16* bi = li + 10240;
        float sla = 0.f, h = 0.f;
#pragma unroll 8
        for (int t = 0; t < 64; ++t) { const float la = bf2f(li[t * 80]), bvv = bf2f(bi[t * 80]); h = __expf(la) * h + bvv; sla += la; }
        const size_t mc = m0 + cidx * 64; const int bb = (int)(mc / T), jj = (int)(mc % T) / 64;
        SUM[((size_t)bb * (T / 64) + jj) * LW + nb * 80 + c] = make_float2(__expf(sla), h);
    }
    __syncthreads();
}
DI void lru_scan2_item(const bf16* __restrict__ LA, const bf16* __restrict__ BV, const float2* __restrict__ SUM, const bf16* __restrict__ P3, bf16* __restrict__ AO, int item) {
    const int cg = item % 5, j = (item / 5) % (T / 64), b = item / (5 * (T / 64)); const int c = cg * 256 + TIDX;
    float h = 0.f;
    for (int jj = 0; jj < j; ++jj) { const float2 s = SUM[((size_t)b * (T / 64) + jj) * LW + c]; h = s.x * h + s.y; }
    const size_t m0 = (size_t)b * T + j * 64;
#pragma unroll 8
    for (int t = 0; t < 64; ++t) {
        const float la = bf2f(LA[(m0 + t) * LW + c]); const float bv = bf2f(BV[(m0 + t) * LW + c]); const float z = bf2f(P3[(m0 + t) * 2560 + LW + c]);
        h = __expf(la) * h + bv; AO[(m0 + t) * LW + c] = f2bf(h * siluf_(z));
    }
}

struct ALoadF32 {
    const float* A;
    static constexpr bool DMA = false;
    DI const bf16* src(int, int) const { return nullptr; }
    struct Raw { float4 a, b; };
    DI Raw load(int m, int k) const { Raw r; r.a = *(const float4*)(A + (size_t)m * 64 + k); r.b = *(const float4*)(A + (size_t)m * 64 + k + 4); return r; }
    DI u32x4 finish(const Raw& r, int, int) const { return (u32x4){pack2bf(r.a.x, r.a.y), pack2bf(r.a.z, r.a.w), pack2bf(r.b.x, r.b.y), pack2bf(r.b.z, r.b.w)}; }
};
struct EpiLora {
    const float* w0; const float* a0; bf16* WL; bf16* AV;
    DI void operator()(int m, int n, const float* v, int, int) const {
        float w[8];
        if (n < 1024) {
#pragma unroll
            for (int j = 0; j < 8; ++j) w[j] = -0.60653065971f * __builtin_amdgcn_rcpf(1.0f + __expf(-(w0[n + j] + v[j])));
            store8bf(WL + (size_t)m * D + n, w);
        } else {
#pragma unroll
            for (int j = 0; j < 8; ++j) w[j] = __builtin_amdgcn_rcpf(1.0f + __expf(-(a0[n - 1024 + j] + v[j])));
            store8bf(AV + (size_t)m * D + n - 1024, w);
        }
    }
    DI void finish(int, int, int, int, int) const {}
    DI void finish_wide(int, int, int, int, int) const {}
};
DI float dpp_sum16(float x) {
    x += __builtin_bit_cast(float, __builtin_amdgcn_update_dpp(0, __builtin_bit_cast(int, x), 0xB1, 0xf, 0xf, false));
    x += __builtin_bit_cast(float, __builtin_amdgcn_update_dpp(0, __builtin_bit_cast(int, x), 0x4E, 0xf, 0xf, false));
    x += __builtin_bit_cast(float, __builtin_amdgcn_update_dpp(0, __builtin_bit_cast(int, x), 0x141, 0xf, 0xf, false));
    x += __builtin_bit_cast(float, __builtin_amdgcn_update_dpp(0, __builtin_bit_cast(int, x), 0x140, 0xf, 0xf, false));
    return x;
}
constexpr int RW_NCH = T / 16;
DI void rwkv_prep_item(bf16* __restrict__ P, bf16* __restrict__ WL, bf16* __restrict__ AV, const float* __restrict__ k_k, const float* __restrict__ k_a, const float* __restrict__ r_k,
                       float* __restrict__ G15, bf16* __restrict__ M2g, bf16* __restrict__ M3g, float* __restrict__ BON, int item, char* smem) {
    const int c = item % RW_NCH, h = (item / RW_NCH) & 15, b = item / (RW_NCH * 16);
    const int tid = TIDX, t = tid >> 4, jq = tid & 15, j0 = jq * 4;
    const size_t m0 = (size_t)b * T + c * 16, m = m0 + t; const size_t ch = (size_t)(b * 16 + h) * RW_NCH + c;
    float* sA = (float*)smem; float* sR = sA + 16 * 68; float* sB = sR + 16 * 68; float* sK = sB + 16 * 68; float* sW = sK + 16 * 68; float* sWl = sW + 16 * 68;
    float* mAab = sWl + 16 * 64; float* mAak = mAab + 16 * 17; float* mArb = mAak + 16 * 17; float* mArk = mArb + 16 * 17; float* mTin = mArk + 16 * 17; float* mM2 = mTin + 16 * 17;
    const u32x2 r2 = *(const u32x2*)(P + m * 4096 + h * 64 + j0), k2 = *(const u32x2*)(P + m * 4096 + 1024 + h * 64 + j0), a2 = *(const u32x2*)(AV + m * D + h * 64 + j0), w2 = *(const u32x2*)(WL + m * D + h * 64 + j0);
    const float rr[4] = {bflo(r2[0]), bfhi(r2[0]), bflo(r2[1]), bfhi(r2[1])}, kr[4] = {bflo(k2[0]), bfhi(k2[0]), bflo(k2[1]), bfhi(k2[1])},
                av[4] = {bflo(a2[0]), bfhi(a2[0]), bflo(a2[1]), bfhi(a2[1])}, wl[4] = {bflo(w2[0]), bfhi(w2[0]), bflo(w2[1]), bfhi(w2[1])};
    const float4 kk4 = *(const float4*)(k_k + h * 64 + j0), ka4 = *(const float4*)(k_a + h * 64 + j0), rk4 = *(const float4*)(r_k + h * 64 + j0);
    const float kkc[4] = {kk4.x, kk4.y, kk4.z, kk4.w}, kac[4] = {ka4.x, ka4.y, ka4.z, ka4.w}, rkc[4] = {rk4.x, rk4.y, rk4.z, rk4.w};
    float kkv[4], n2 = 0.f;
#pragma unroll
    for (int e = 0; e < 4; ++e) { kkv[e] = kr[e] * kkc[e]; n2 += kkv[e] * kkv[e]; }
    n2 = dpp_sum16(n2);
    float nr = sqrtf(n2); nr = nr > 1e-12f ? nr : 1e-12f; const float inr = 1.0f / nr;
    float aa[4], bb[4], kp[4], bon = 0.f;
#pragma unroll
    for (int e = 0; e < 4; ++e) { const float kn = kkv[e] * inr; aa[e] = -kn; bb[e] = kn * av[e]; kp[e] = kr[e] * (1.0f + (av[e] - 1.0f) * kac[e]); bon += rr[e] * kp[e] * rkc[e]; }
    bon = dpp_sum16(bon);
    if (jq == 0) BON[m * 16 + h] = bon;
    *(float4*)(sWl + t * 64 + j0) = make_float4(wl[0], wl[1], wl[2], wl[3]);
    __syncthreads();
    float clx[4] = {0.f, 0.f, 0.f, 0.f};
#pragma unroll
    for (int s = 0; s < 15; ++s) { if (s < t) { const float4 w = *(const float4*)(sWl + s * 64 + j0); clx[0] += w.x; clx[1] += w.y; clx[2] += w.z; clx[3] += w.w; } }
    float bt[4];
    {
        float va[4], vr[4], vk[4], gc[4];
#pragma unroll
        for (int e = 0; e < 4; ++e) { const float cl = clx[e] + wl[e]; const float gp = __expf(clx[e]), gi = __expf(-cl); gc[e] = __expf(cl); va[e] = aa[e] * gp; vr[e] = rr[e] * gc[e]; bt[e] = bb[e] * gi; vk[e] = kp[e] * gi; }
        *(float4*)(sA + t * 68 + j0) = make_float4(va[0], va[1], va[2], va[3]); *(float4*)(sR + t * 68 + j0) = make_float4(vr[0], vr[1], vr[2], vr[3]);
        *(float4*)(sB + t * 68 + j0) = make_float4(bt[0], bt[1], bt[2], bt[3]); *(float4*)(sK + t * 68 + j0) = make_float4(vk[0], vk[1], vk[2], vk[3]);
        {
            char* img = (char*)(mM2 + 16 * 17) + t * 128 + (((j0 >> 3) ^ (t & 7)) << 4) + (j0 & 4) * 2;
            *(u32x2*)(img) = (u32x2){pack2bf(va[0], va[1]), pack2bf(va[2], va[3])}; *(u32x2*)(img + 2048) = (u32x2){pack2bf(vr[0], vr[1]), pack2bf(vr[2], vr[3])};
            *(u32x2*)(img + 4096) = (u32x2){pack2bf(bt[0], bt[1]), pack2bf(bt[2], bt[3])}; *(u32x2*)(img + 6144) = (u32x2){pack2bf(vk[0], vk[1]), pack2bf(vk[2], vk[3])};
        }
        if (t == 15) *(float4*)(G15 + ch * 64 + j0) = make_float4(gc[0], gc[1], gc[2], gc[3]);
#pragma unroll
        for (int e = 0; e < 4; ++e) {   }
#pragma unroll
        for (int e = 0; e < 4; ++e) clx[e] = vk[e];
    }
    __syncthreads();
    {
        const int wv = __builtin_amdgcn_readfirstlane(tid >> 6), lane = tid & 63, q = lane >> 4, l15 = lane & 15;
        const char* xb_ = (const char*)(mM2 + 16 * 17) + (wv >> 1) * 2048;
        const char* yb_ = (const char*)(mM2 + 16 * 17) + 4096 + (wv & 1) * 2048;
        f32x4 acc = {0.f, 0.f, 0.f, 0.f};
#pragma unroll
        for (int ks = 0; ks < 2; ++ks) {
            const int off = l15 * 128 + (((ks * 4 + q) ^ (l15 & 7)) << 4);
            const bf16x8 xf = *(const bf16x8*)(xb_ + off), yf = *(const bf16x8*)(yb_ + off);
            acc = __builtin_amdgcn_mfma_f32_16x16x32_bf16(xf, yf, acc, 0, 0, 0);
        }
        float* dst = wv == 0 ? mAab : (wv == 1 ? mAak : (wv == 2 ? mArb : mArk));
        const bool strict = wv < 2;
#pragma unroll
        for (int r = 0; r < 4; ++r) { const int tt = 4 * q + r, ss = l15; dst[tt * 17 + ss] = (strict ? ss < tt : ss <= tt) ? acc[r] : 0.f; }
    }
    __syncthreads();
    if (tid < 16) {
        float col[16];
#pragma unroll
        for (int i = 0; i < 16; ++i) {
            float acc = (i == tid) ? 1.0f : 0.f;
#pragma unroll
            for (int jj = 0; jj < i; ++jj) acc += mAab[i * 17 + jj] * col[jj];
            col[i] = acc; mTin[i * 17 + tid] = acc;
        }
    }
    __syncthreads();
    float wv[4] = {0.f, 0.f, 0.f, 0.f}, m2 = 0.f;
#pragma unroll
    for (int s = 0; s < 16; ++s) { const float ti = mTin[t * 17 + s]; const float4 a4 = *(const float4*)(sA + s * 68 + j0); wv[0] += ti * a4.x; wv[1] += ti * a4.y; wv[2] += ti * a4.z; wv[3] += ti * a4.w; m2 += ti * mAak[s * 17 + jq]; }
    *(float4*)(sW + t * 68 + j0) = make_float4(wv[0], wv[1], wv[2], wv[3]); mM2[t * 17 + jq] = m2;
    __syncthreads();
    float rh[4]; { const float4 r4 = *(const float4*)(sR + t * 68 + j0); rh[0] = r4.x; rh[1] = r4.y; rh[2] = r4.z; rh[3] = r4.w; }
    float m3 = mArk[t * 17 + jq];
#pragma unroll
    for (int s = 0; s < 16; ++s) { const float ar = mArb[t * 17 + s]; const float4 w4 = *(const float4*)(sW + s * 68 + j0); rh[0] += ar * w4.x; rh[1] += ar * w4.y; rh[2] += ar * w4.z; rh[3] += ar * w4.w; m3 += ar * mM2[s * 17 + jq]; }
    *(u32x2*)(WL + m * D + h * 64 + j0) = (u32x2){pack2bf(wv[0], wv[1]), pack2bf(wv[2], wv[3])};
    *(u32x2*)(P + m * 4096 + h * 64 + j0) = (u32x2){pack2bf(rh[0], rh[1]), pack2bf(rh[2], rh[3])};
#pragma unroll
    for (int e = 0; e < 4; ++e) { AV[(m0 + jq) * D + h * 64 + e * 16 + t] = f2bf(bt[e]); P[(m0 + jq) * 4096 + 1024 + h * 64 + e * 16 + t] = f2bf(clx[e]); }
    M2g[ch * 256 + t * 16 + jq] = f2bf(m2); M3g[ch * 256 + t * 16 + jq] = f2bf(m3);
    __syncthreads();
}

#define MFMA32(a, b, c) __builtin_amdgcn_mfma_f32_16x16x32_bf16(__builtin_bit_cast(bf16x8, a), __builtin_bit_cast(bf16x8, b), c, 0, 0, 0)
DI void rwkv_chunk_scan(const bf16* __restrict__ P, const bf16* __restrict__ WL, const bf16* __restrict__ AV, const float* __restrict__ G15, const bf16* __restrict__ M2g, const bf16* __restrict__ M3g,
                        bf16* __restrict__ YS, int bh, char* smem) {
    constexpr int SLOT = 12288, YOFF = 49152;
    const int tid = TIDX, lane = tid & 63, vs = __builtin_amdgcn_readfirstlane(tid >> 6), q = lane >> 4, l15 = lane & 15; const int b = bh >> 4, h = bh & 15;
    const size_t mb = (size_t)b * T; const size_t ch0 = (size_t)(b * 16 + h) * RW_NCH;
    const char *s0, *s1, *s2; size_t d0, d1, d2;
    if (tid < 128) { const int c8 = tid >> 4, t = tid & 15; s0 = (const char*)(WL + (mb + t) * D + h * 64 + c8 * 8); d0 = (size_t)16 * D * 2; }
    else { const int pp = tid - 128, c8 = pp >> 4, t = pp & 15; s0 = (const char*)(P + (mb + t) * 4096 + h * 64 + c8 * 8); d0 = (size_t)16 * 4096 * 2; }
    if (tid < 128) { const int r = tid >> 3, c8 = tid & 7; s1 = (const char*)(P + (mb + r) * 4096 + 1024 + h * 64 + c8 * 8); d1 = (size_t)16 * 4096 * 2; }
    else { const int pp = tid - 128, r = pp >> 3, c8 = pp & 7; s1 = (const char*)(AV + (mb + r) * D + h * 64 + c8 * 8); d1 = (size_t)16 * D * 2; }
    if (tid < 128) { const int r = tid >> 3, c8 = tid & 7; s2 = (const char*)(P + (mb + r) * 4096 + 2048 + h * 64 + c8 * 8); d2 = (size_t)16 * 4096 * 2; }
    else if (tid < 160) { s2 = (const char*)(M2g + ch0 * 256 + (tid - 128) * 8); d2 = 512; }
    else if (tid < 192) { s2 = (const char*)(M3g + ch0 * 256 + (tid - 160) * 8); d2 = 512; }
    else { const int pp = tid < 208 ? tid - 192 : 0; s2 = (const char*)(G15 + ch0 * 64 + pp * 4); d2 = 256; }
    const int dma_off = vs * 1024;
#define RW_DMA(c_) { char* dst = smem + ((c_) & 3) * SLOT + dma_off; GLDS16(s0 + (size_t)(c_) * d0, dst); GLDS16(s1 + (size_t)(c_) * d1, dst + 4096); GLDS16(s2 + (size_t)(c_) * d2, dst + 8192); }
#define RW_BARRIER() { asm volatile("s_waitcnt lgkmcnt(0)" ::: "memory"); __builtin_amdgcn_s_barrier(); asm volatile("" ::: "memory"); }
    f32x4 H0 = {0.f, 0.f, 0.f, 0.f}, H1 = H0, H2 = H0, H3 = H0;
    const int oW = (((q >> 1)) * 16 + l15) * 16 + (q & 1) * 8;
    const int oK = 4096 + ((l15 >> 2) * 8 + (l15 & 3) * 2 + (q >> 1)) * 16 + (q & 1) * 8;
    const int oM = 10240 + l15 * 32 + q * 8;
    const int oV = 8192 + (4 * q) * 128 + (vs * 16 + l15) * 2;
    const int oG = 11264 + (4 * q) * 4;
    const int oY = YOFF + ((4 * q) * 64 + vs * 16 + l15) * 2;
    RW_DMA(0); RW_DMA(1); RW_DMA(2);
    asm volatile("s_waitcnt vmcnt(6)" ::: "memory");
    RW_BARRIER();
    for (int c = 0; c < RW_NCH; ++c) {
        if (c + 3 < RW_NCH) RW_DMA(c + 3);
        const char* sl = smem + (c & 3) * SLOT;
        {
            const f32x4 z4 = {0.f, 0.f, 0.f, 0.f};
            const u32x4 Hb0 = {pack2bf(H0[0], H0[1]), pack2bf(H0[2], H0[3]), pack2bf(H1[0], H1[1]), pack2bf(H1[2], H1[3])};
            const u32x4 Hb1 = {pack2bf(H2[0], H2[1]), pack2bf(H2[2], H2[3]), pack2bf(H3[0], H3[1]), pack2bf(H3[2], H3[3])};
            const unsigned v0 = *(const bf16*)(sl + oV), v1 = *(const bf16*)(sl + oV + 128), v2 = *(const bf16*)(sl + oV + 256), v3 = *(const bf16*)(sl + oV + 384);
            const unsigned v01 = v0 | (v1 << 16), v23 = v2 | (v3 << 16);
            const u32x4 Vlo = {v01, v23, 0u, 0u};
            const u32x2 m2 = *(const u32x2*)(sl + oM), m3 = *(const u32x2*)(sl + oM + 512);
            const u32x2 w0 = *(const u32x2*)(sl + oW), w1 = *(const u32x2*)(sl + oW + 512), w2 = *(const u32x2*)(sl + oW + 1024), w3 = *(const u32x2*)(sl + oW + 1536);
            const u32x2 r0 = *(const u32x2*)(sl + 2048 + oW), r1 = *(const u32x2*)(sl + 2048 + oW + 512), r2 = *(const u32x2*)(sl + 2048 + oW + 1024), r3 = *(const u32x2*)(sl + 2048 + oW + 1536);
            f32x4 U = MFMA32(((u32x4){m2[0], m2[1], 0u, 0u}), Vlo, z4);
            U = MFMA32(((u32x4){w0[0], w0[1], w1[0], w1[1]}), Hb0, U); U = MFMA32(((u32x4){w2[0], w2[1], w3[0], w3[1]}), Hb1, U);
            f32x4 Y = MFMA32(((u32x4){m3[0], m3[1], 0u, 0u}), Vlo, z4);
            Y = MFMA32(((u32x4){r0[0], r0[1], r1[0], r1[1]}), Hb0, Y); Y = MFMA32(((u32x4){r2[0], r2[1], r3[0], r3[1]}), Hb1, Y);
            const u32x4 VU = {v01, v23, pack2bf(U[0], U[1]), pack2bf(U[2], U[3])};
            const u32x2 k0 = *(const u32x2*)(sl + oK), k1 = *(const u32x2*)(sl + oK + 512), k2 = *(const u32x2*)(sl + oK + 1024), k3 = *(const u32x2*)(sl + oK + 1536);
            const u32x2 b0 = *(const u32x2*)(sl + 2048 + oK), b1 = *(const u32x2*)(sl + 2048 + oK + 512), b2 = *(const u32x2*)(sl + 2048 + oK + 1024), b3 = *(const u32x2*)(sl + 2048 + oK + 1536);
            const f32x4 g0 = *(const f32x4*)(sl + oG), g1 = *(const f32x4*)(sl + oG + 64), g2 = *(const f32x4*)(sl + oG + 128), g3 = *(const f32x4*)(sl + oG + 192);
            const f32x4 a0 = MFMA32(((u32x4){k0[0], k0[1], b0[0], b0[1]}), VU, H0), a1 = MFMA32(((u32x4){k1[0], k1[1], b1[0], b1[1]}), VU, H1);
            const f32x4 a2 = MFMA32(((u32x4){k2[0], k2[1], b2[0], b2[1]}), VU, H2), a3 = MFMA32(((u32x4){k3[0], k3[1], b3[0], b3[1]}), VU, H3);
            H0 = a0 * g0; H1 = a1 * g1; H2 = a2 * g2; H3 = a3 * g3;
            char* yb = smem + oY + (c & 7) * 2048;
#pragma unroll
            for (int r = 0; r < 4; ++r) *(bf16*)(yb + r * 128) = f2bf(Y[r]);
        }
        const bool flush = (c & 7) == 7;
        if (flush) {
            RW_BARRIER();
            u32x4 yv[4];
#pragma unroll
            for (int k = 0; k < 4; ++k) yv[k] = *(const u32x4*)(smem + YOFF + (tid + 256 * k) * 16);
#pragma unroll
            for (int k = 0; k < 4; ++k) { const int pc = tid + 256 * k, rr = pc >> 3, c8 = pc & 7; *(u32x4*)(YS + (mb + (size_t)(c - 7) * 16 + rr) * D + h * 64 + c8 * 8) = yv[k]; }
            asm volatile("s_waitcnt vmcnt(0)" ::: "memory");
        } else if (c + 3 < RW_NCH) { asm volatile("s_waitcnt vmcnt(6)" ::: "memory"); }
        else if (c + 2 < RW_NCH) { asm volatile("s_waitcnt vmcnt(3)" ::: "memory"); }
        else { asm volatile("s_waitcnt vmcnt(0)" ::: "memory"); }
        RW_BARRIER();
    }
#undef RW_DMA
#undef RW_BARRIER
}
DI void rwkv_gn_rows2(const bf16* __restrict__ P, const float* __restrict__ BON, const float* __restrict__ lnw, const float* __restrict__ lnb, bf16* __restrict__ YS) {
    const int tid = TIDX, lane = tid & 63, wave = tid >> 6; const int c = wave * 256 + lane * 4;
    const float4 lw = *(const float4*)(lnw + c), lb = *(const float4*)(lnb + c);
    for (size_t m = blockIdx.x; m < (size_t)M; m += gridDim.x) {
        const u32x2 yy = *(const u32x2*)(YS + m * D + c), vv = *(const u32x2*)(P + m * 4096 + 2048 + c), zz = *(const u32x2*)(P + m * 4096 + 3072 + c);
        const float bs = BON[m * 16 + (c >> 6)];
        const float y[4] = {bflo(yy[0]), bfhi(yy[0]), bflo(yy[1]), bfhi(yy[1])}, v[4] = {bflo(vv[0]), bfhi(vv[0]), bflo(vv[1]), bfhi(vv[1])}, z[4] = {bflo(zz[0]), bfhi(zz[0]), bflo(zz[1]), bfhi(zz[1])};
        const float lwv[4] = {lw.x, lw.y, lw.z, lw.w}, lbv[4] = {lb.x, lb.y, lb.z, lb.w};
        const float mean = dpp_sum16((y[0] + y[1]) + (y[2] + y[3])) * (1.0f / 64.0f);
        float var = 0.f;
#pragma unroll
        for (int i = 0; i < 4; ++i) { const float d = y[i] - mean; var += d * d; }
        var = dpp_sum16(var) * (1.0f / 64.0f);
        const float rstd = 1.0f / sqrtf(var + 64e-5f);
        float o[4];
#pragma unroll
        for (int i = 0; i < 4; ++i) o[i] = ((y[i] - mean) * rstd * lwv[i] + lbv[i] + bs * v[i]) * siluf_(z[i]);
        *(u32x2*)(YS + m * D + c) = (u32x2){pack2bf(o[0], o[1]), pack2bf(o[2], o[3])};
    }
}

struct FastBufs { char* ws; };

DI void rows_xb_parts(const float* __restrict__ x, bf16* xb, float* parts) {
    const int lane = TIDX & 63, wave = TIDX >> 6;
    for (int m = blockIdx.x * 4 + wave; m < M; m += gridDim.x * 4) {
        const float* xr = x + (size_t)m * D; float s = 0.f;
#pragma unroll
        for (int i = 0; i < 2; ++i) {
            const int k = (i * 64 + lane) * 8; const float4 a = *(const float4*)(xr + k), b = *(const float4*)(xr + k + 4);
            const float w[8] = {a.x, a.y, a.z, a.w, b.x, b.y, b.z, b.w};
#pragma unroll
            for (int j = 0; j < 8; ++j) s += w[j] * w[j];
            store8bf(xb + (size_t)m * D + k, w);
        }
#pragma unroll
        for (int o = 32; o >= 1; o >>= 1) s += __shfl_xor(s, o);
        if (lane < 16) parts[(size_t)m * 16 + lane] = lane == 0 ? s : 0.f;
    }
}
DI void rows_xn(const float* __restrict__ x, const float* parts, const float* __restrict__ g, bf16* xn) {
    const int lane = TIDX & 63, wave = TIDX >> 6;
    for (int m = blockIdx.x * 4 + wave; m < M; m += gridDim.x * 4) {
        const float rs = rstd_from_parts(parts, m); const float* xr = x + (size_t)m * D;
#pragma unroll
        for (int i = 0; i < 2; ++i) {
            const int k = (i * 64 + lane) * 8; const float4 a = *(const float4*)(xr + k), b = *(const float4*)(xr + k + 4);
            const float4 ga = *(const float4*)(g + k), gb = *(const float4*)(g + k + 4);
            const float w[8] = {a.x * rs * ga.x, a.y * rs * ga.y, a.z * rs * ga.z, a.w * rs * ga.w, b.x * rs * gb.x, b.y * rs * gb.y, b.z * rs * gb.z, b.w * rs * gb.w};
            store8bf(xn + (size_t)m * D + k, w);
        }
    }
}
DI void rows_final(float* x, const float* parts, const float* __restrict__ g) {
    const int lane = TIDX & 63, wave = TIDX >> 6;
    for (int m = blockIdx.x * 4 + wave; m < M; m += gridDim.x * 4) {
        const float rs = rstd_from_parts(parts, m); float* xr = x + (size_t)m * D;
#pragma unroll
        for (int i = 0; i < 4; ++i) {
            const int k = (i * 64 + lane) * 4; float4 a = *(float4*)(xr + k); const float4 ga = *(const float4*)(g + k);
            a.x *= rs * ga.x; a.y *= rs * ga.y; a.z *= rs * ga.z; a.w *= rs * ga.w; *(float4*)(xr + k) = a;
        }
    }
}
enum { PH_PREP0 = 0, PH_IN0, PH_ATTN0, PH_OUT0, PH_PREP1, PH_IN1, PH_LORA1, PH_CPREP1, PH_SCAN1, PH_GN1, PH_OUT1, PH_PREP2, PH_IN2, PH_B2, PH_C2, PH_D2, PH_OUT2, PH_PREP3, PH_IN3, PH_GATE3, PH_SCANA3, PH_SCANB3, PH_OUT3, PH_FINAL };

namespace wbo {
constexpr size_t IN = 0;
constexpr size_t OUT = (size_t)4352 * 1024;
constexpr size_t EXTRA = OUT + (size_t)1280 * 1024;
}

template <int PH>
DI void run_phase(const Params& p, char* smem) {
    char* ws = p.ws;
    float* parts = (float*)(ws + fw::PARTS);
    constexpr int LAYER = PH <= PH_OUT0 ? 0 : PH <= PH_OUT1 ? 1 : PH <= PH_OUT2 ? 2 : 3;
    constexpr size_t WBOFF = LAYER == 0 ? 200 * fw::MB : LAYER == 1 ? 238 * fw::MB : LAYER == 2 ? 240 * fw::MB : 1 * fw::MB;
    bf16* WB = (bf16*)(ws + WBOFF);
    bf16* XB = (bf16*)(ws + ((PH == PH_PREP0 || PH == PH_IN0) ? 130 * fw::MB : 174 * fw::MB));
    bf16* P = (bf16*)(ws + wsl::P);
    float* X = p.out;
    float* smf = (float*)smem;
    if (PH == PH_PREP0) {
        rows_xb_parts(p.x, XB, parts);
        int tb = 0;
        convert_seg(p.a_w_in, A_COLS, 0, A_COLS, 1024, WB + wbo::IN, p.norm_g + 0 * D, smf, tb);
        convert_seg(p.a_w_out, 1024, 0, 1024, 1024, WB + wbo::OUT, nullptr, smf, tb);
    } else if (PH == PH_IN0) {
        gemm_sched(8, 4, [&](bool big, int mt, int nt) {
            if (big) gemm_tile2(ALoadPlain{XB, D}, WB + wbo::IN, 1024, mt * 128, nt * 256, EpiL0{P, (bf16*)(ws + 86 * fw::MB), parts}, smem);
            else gemm_tile(ALoadPlain{XB, D}, WB + wbo::IN, 1024, mt * 128, 2048 + nt * 128, EpiL0{P, (bf16*)(ws + 86 * fw::MB), parts}, smem);
        });
    } else if (PH == PH_ATTN0) {
        build_bias_lut(p.t5, smem, true);
        for (int it = blockIdx.x; it < B * G * (T / 32); it += gridDim.x) swa_item(P, (const bf16*)(ws + 86 * fw::MB), p.a_sinks, (bf16*)(ws + wsl::L0_AO), it, smem);
    } else if (PH == PH_OUT0) {
        gemm_sched(4, 0, [&](bool, int mt, int nt) { gemm_tile2(ALoadPlain{(const bf16*)(ws + wsl::L0_AO), D}, WB + wbo::OUT, 1024, mt * 128, nt * 256, EpiResid{p.x, X, nullptr, parts}, smem); });
    } else if (PH == PH_PREP1) {
        rows_xn(X, parts, p.norm_g + 1 * D, (bf16*)(ws + wsl::L1_XN));
        int tb = 0;
        convert_seg(p.b_w_in, 4096, 0, 4096, 1024, WB + wbo::IN, nullptr, smf, tb);
        convert_seg(p.b_w1, 64, 0, 64, 1024, WB + wbo::IN + (size_t)4096 * 1024, nullptr, smf, tb);
        convert_seg(p.b_a1, 64, 0, 64, 1024, WB + wbo::IN + (size_t)(4096 + 128) * 1024, nullptr, smf, tb);
        convert_seg(p.b_w_out, 1024, 0, 1024, 1024, WB + wbo::OUT, nullptr, smf, tb);
        convert_seg(p.b_w2, 1024, 0, 1024, 64, WB + wbo::EXTRA, nullptr, smf, tb);
        convert_seg(p.b_a2, 1024, 0, 1024, 64, WB + wbo::EXTRA + (size_t)1024 * 64, nullptr, smf, tb);
        for (size_t i = (size_t)blockIdx.x * 256 + TIDX; i < (size_t)64 * 1024 / 8; i += (size_t)gridDim.x * 256) {
            ((u32x4*)(WB + wbo::IN + (size_t)(4096 + 64) * 1024))[i] = (u32x4){0u, 0u, 0u, 0u};
            ((u32x4*)(WB + wbo::IN + (size_t)(4096 + 192) * 1024))[i] = (u32x4){0u, 0u, 0u, 0u};
        }
    } else if (PH == PH_IN1) {
        const bf16* XN = (const bf16*)(ws + wsl::L1_XN);
        EpiRwkv epi{P, (float*)(ws + wsl::LHW), (float*)(ws + wsl::LHA)};
        gemm_sched(16, 2, [&](bool big, int mt, int nt) {
            if (big) gemm_tile2(ALoadLerp{XN, p.b_mu + (nt >> 2) * D}, WB + wbo::IN, 1024, mt * 128, nt * 256, epi, smem);
            else gemm_tile(ALoadLerp{XN, p.b_mu + (4 + nt) * D}, WB + wbo::IN, 1024, mt * 128, 4096 + nt * 128, epi, smem);
        });
    } else if (PH == PH_LORA1) {
        const int ntile = (M / 128) * 16;
        EpiLora epi{p.b_w0, p.b_a0, (bf16*)(ws + wsl::L1_WL), (bf16*)(ws + wsl::L1_AV)};
        (void)ntile;
        gemm_sched(8, 0, [&](bool, int mt, int nt) { gemm_tile2(ALoadF32{(const float*)(ws + (nt < 4 ? wsl::LHW : wsl::LHA))}, WB + wbo::EXTRA, 64, mt * 128, nt * 256, epi, smem); });
    } else if (PH == PH_CPREP1) {
        for (int it = blockIdx.x; it < B * 16 * RW_NCH; it += gridDim.x)
            rwkv_prep_item(P, (bf16*)(ws + wsl::L1_WL), (bf16*)(ws + wsl::L1_AV), p.b_k_k, p.b_k_a, p.b_r_k, (float*)(ws + 9 * fw::MB), (bf16*)(ws + 1 * fw::MB), WB, (float*)(ws + 254 * fw::MB), it, smem);
    } else if (PH == PH_SCAN1) {
        const int bid = blockIdx.x;
        if ((bid & 31) < 8 && (bid >> 5) < 8) {
            const int it = (bid >> 5) * 8 + (bid & 31);
            rwkv_chunk_scan(P, (const bf16*)(ws + wsl::L1_WL), (const bf16*)(ws + wsl::L1_AV), (const float*)(ws + 9 * fw::MB), (const bf16*)(ws + 1 * fw::MB), WB, (bf16*)(ws + wsl::L1_XN), it, smem);
        }
    } else if (PH == PH_GN1) {
        rwkv_gn_rows2(P, (const float*)(ws + 254 * fw::MB), p.b_lnx_w, p.b_lnx_b, (bf16*)(ws + wsl::L1_XN));
    } else if (PH == PH_OUT1) {
        gemm_sched(4, 0, [&](bool, int mt, int nt) { gemm_tile2(ALoadPlain{(const bf16*)(ws + wsl::L1_XN), D}, WB + wbo::OUT, 1024, mt * 128, nt * 256, EpiResid{X, X, XB, parts}, smem); });
    } else if (PH == PH_PREP2) {
        int tb = 0;
        const float* g2 = p.norm_g + 2 * D;
        convert_seg(p.c_w_in, C_COLS, 0, 2560, 1024, WB + wbo::IN, g2, smf, tb);
        convert_seg(p.c_w_in, C_COLS, 2608, 1024, 1024, WB + wbo::IN + (size_t)2560 * 1024, g2, smf, tb);
        convert_seg(p.c_w_in, C_COLS, 2560, 64, 1024, WB + wbo::IN + (size_t)3584 * 1024, g2, smf, tb);
        convert_seg(p.c_w_out, 1024, 0, 1024, 1024, WB + wbo::OUT, nullptr, smf, tb);
        convert_seg(p.c_k_w1, 128, 0, 128, 2048, WB + wbo::EXTRA, nullptr, smf, tb);
        convert_seg(p.c_v_w1, 128, 0, 128, 2048, WB + wbo::EXTRA + (size_t)128 * 2048, nullptr, smf, tb);
        convert_seg(p.c_k_w2, 64, 0, 64, 128, WB + wbo::EXTRA + (size_t)256 * 2048, nullptr, smf, tb);
        convert_seg(p.c_v_w2, 64, 0, 64, 128, WB + wbo::EXTRA + (size_t)256 * 2048 + 64 * 128, nullptr, smf, tb);
        if (blockIdx.x < 16) {
            const int which = blockIdx.x >> 3, i = blockIdx.x & 7; const float* pos = which ? p.c_pos_v : p.c_pos_k; const float* w1 = which ? p.c_v_w1 : p.c_k_w1;
            float* b8 = (float*)(ws + 12 * fw::MB);
            if (TIDX < 128) { float a = 0.f; for (int k = i * 256; k < i * 256 + 256; ++k) a += pos[k] * w1[(size_t)k * 128 + TIDX]; b8[(which * 8 + i) * 128 + TIDX] = a; }
        }
    } else if (PH == PH_IN2) {
        gemm_sched(14, 1, [&](bool big, int mt, int nt) {
            if (big) gemm_tile2(ALoadPlain{XB, D}, WB + wbo::IN, 1024, mt * 128, nt * 256, EpiL2{P, (bf16*)(ws + 114 * fw::MB), (bf16*)(ws + 122 * fw::MB), parts}, smem);
            else gemm_tile(ALoadPlain{XB, D}, WB + wbo::IN, 1024, mt * 128, 3584 + nt * 128, EpiL2{P, (bf16*)(ws + 114 * fw::MB), (bf16*)(ws + 122 * fw::MB), parts}, smem);
        });
    } else if (PH == PH_B2) {
        for (int it = blockIdx.x; it < 64; it += gridDim.x) { const int which = it >> 5, rt = it & 31;
            cmp_tile(P, WB + wbo::EXTRA + (size_t)which * 128 * 2048, (const float*)(ws + 12 * fw::MB) + which * 8 * 128, WB + wbo::EXTRA + (size_t)256 * 2048 + which * 64 * 128, which, rt,
                     (bf16*)(ws + 5 * fw::MB), (bf16*)(ws + 6 * fw::MB), smem); }
        build_bias_lut(p.t5, smem, false);
        const int nitem = 64 + B * G * (T / 32);
        for (int it = blockIdx.x < 64 ? blockIdx.x + gridDim.x : blockIdx.x; it < nitem; it += gridDim.x) win_item(P, (const bf16*)(ws + 122 * fw::MB), (bf16*)(ws + 130 * fw::MB), it - 64, smem);
    } else if (PH == PH_C2) {
        for (int it = blockIdx.x; it < B * G * (T / 32); it += gridDim.x)
            cmpsel_item(P, (const bf16*)(ws + 5 * fw::MB), (const bf16*)(ws + 6 * fw::MB), (bf16*)(ws + 162 * fw::MB), (unsigned long long*)(ws + 9 * fw::MB), it, smem);
    } else if (PH == PH_D2) {
        build_bias_lut(p.t5, smem, false);
        for (int it = blockIdx.x; it < B * G * (T / 32); it += gridDim.x)
            sel_item(P, (const bf16*)(ws + 114 * fw::MB), (const unsigned long long*)(ws + 9 * fw::MB), (const bf16*)(ws + 162 * fw::MB), (const bf16*)(ws + 130 * fw::MB), (bf16*)(ws + 206 * fw::MB), it, smem);
    } else if (PH == PH_OUT2) {
        gemm_sched(4, 0, [&](bool, int mt, int nt) { gemm_tile2(ALoadPlain{(const bf16*)(ws + 206 * fw::MB), D}, WB + wbo::OUT, 1024, mt * 128, nt * 256, EpiResid{X, X, XB, parts}, smem); });
    } else if (PH == PH_PREP3) {
        int tb = 0;
        convert_seg(p.d_w_in, 2560, 0, 2560, 1024, WB + wbo::IN, p.norm_g + 3 * D, smf, tb);
        convert_seg(p.d_w_out, 1024, 0, 1024, 1280, WB + wbo::OUT, nullptr, smf, tb);
        lru_convert_gates(p.d_ga_w, p.d_gx_w, WB + wbo::EXTRA);
        for (int i = blockIdx.x * NTHREADS + TIDX; i < LW; i += gridDim.x * NTHREADS) ((float*)(ws + 12 * fw::MB + 786432))[i] = -8.0f * softplusf_(-p.d_lambda[i]);
    } else if (PH == PH_IN3) {
        gemm_sched(8, 4, [&](bool big, int mt, int nt) {
            if (big) gemm_tile2(ALoadPlain{XB, D}, WB + wbo::IN, 1024, mt * 128, nt * 256, EpiBf16{P, 2560, parts}, smem);
            else gemm_tile(ALoadPlain{XB, D}, WB + wbo::IN, 1024, mt * 128, 2048 + nt * 128, EpiBf16{P, 2560, parts}, smem);
        });
    } else if (PH == PH_GATE3) {
        for (int it = blockIdx.x; it < (M / 128) * 16; it += gridDim.x)
            lru_gate_item(P, p.d_conv_w, p.d_conv_b, WB + wbo::EXTRA, p.d_ga_b, p.d_gx_b, (const float*)(ws + 12 * fw::MB + 786432), (bf16*)(ws + wsl::L3_LA), (bf16*)(ws + wsl::L3_BV), (float2*)(ws + wsl::L3_UC), it, smem);
    } else if (PH == PH_SCANB3) {
        for (int it = blockIdx.x; it < B * (T / 64) * 5; it += gridDim.x)
            lru_scan2_item((const bf16*)(ws + wsl::L3_LA), (const bf16*)(ws + wsl::L3_BV), (const float2*)(ws + wsl::L3_UC), P, (bf16*)(ws + wsl::L3_AO), it);
    } else if (PH == PH_OUT3) {
        gemm_sched(4, 0, [&](bool, int mt, int nt) { gemm_tile2(ALoadPlain{(const bf16*)(ws + wsl::L3_AO), LW}, WB + wbo::OUT, 1280, mt * 128, nt * 256, EpiResid{X, X, nullptr, parts}, smem); });
    } else if (PH == PH_FINAL) {
        rows_final(X, parts, p.final_g);
    }
}

template <int PH> __global__ void __launch_bounds__(NTHREADS, 2) k_phase(Params p) {
    extern __shared__ __attribute__((aligned(16))) char smem[];
    run_phase<PH>(p, smem);
}
#define LDS_BYTES 73728
#define MEGA_LDS_BYTES (73728 + 64)
template <int PH> static void launch_phase(const Params& p, hipStream_t s) {
    static bool attr = false;
    if (!attr) { hipFuncSetAttribute((const void*)k_phase<PH>, hipFuncAttributeMaxDynamicSharedMemorySize, LDS_BYTES); attr = true; }
    hipLaunchKernelGGL(k_phase<PH>, dim3(512), dim3(NTHREADS), LDS_BYTES, s, p);
}


#define XB_TMO      128
#define XB_XCNT(j)  (256  + 64 * (j))
#define XB_XSUB(j)  (1280 + 64 * (j))
#define XB_XGEN(j)  (2304 + 64 * (j))
#define XB_TOP      3328
#define XB_TOPGEN   3392
#define XCD_BAR_WORDS 3456
#define XB_SPIN_CAP (1u << 22)
#define LAS __attribute__((address_space(3)))
DI unsigned xb_ld(unsigned* p)              { return __hip_atomic_load(p, __ATOMIC_RELAXED, __HIP_MEMORY_SCOPE_AGENT); }
DI unsigned xb_add(unsigned* p, unsigned v) { return __hip_atomic_fetch_add(p, v, __ATOMIC_RELAXED, __HIP_MEMORY_SCOPE_AGENT); }
DI unsigned xb_xcc_id() { return (unsigned)__builtin_amdgcn_s_getreg((3 << 11) | 20) & 0xFu; }
#define XB_SPIN(cond, bar) do { unsigned _sp = 0; while (cond) { if (_sp < 64u) __builtin_amdgcn_s_sleep(2); else __builtin_amdgcn_s_sleep(32); \
    if ((++_sp & 255u) == 0u) { if (xb_ld(&(bar)[XB_TMO])) break; if (_sp > XB_SPIN_CAP) { atomicAdd(&(bar)[XB_TMO], 1u); break; } } } } while (0)
struct XcdBarrier { unsigned* bar; unsigned x; volatile LAS unsigned* st; };
DI XcdBarrier xcd_barrier_post(unsigned* bar, volatile LAS unsigned* st) {
    XcdBarrier b; b.bar = bar; b.x = xb_xcc_id(); b.st = st;
    if (threadIdx.x == 0) (void)xb_add(&bar[XB_XCNT(b.x)], 1u);
    return b;
}
DI void xcd_barrier_complete(unsigned* bar, unsigned x, unsigned& nloc, unsigned& nx) {
    const unsigned G = gridDim.x * gridDim.y * gridDim.z;
    unsigned sum, cnt, mine, sp = 0u;
    for (;;) {
        sum = 0u; cnt = 0u; mine = 0u;
#pragma unroll
        for (unsigned j = 0; j < 16; ++j) { const unsigned c = xb_ld(&bar[XB_XCNT(j)]); sum += c; cnt += (c > 0u) ? 1u : 0u; mine = (j == x) ? c : mine; }
        if (sum == G) break;
        __builtin_amdgcn_s_sleep(1);
        if ((++sp & 255u) == 0u) { if (xb_ld(&bar[XB_TMO])) break; if (sp > XB_SPIN_CAP) { atomicAdd(&bar[XB_TMO], 1u); break; } }
    }
    nloc = mine > 0u ? mine : 1u; nx = cnt > 0u ? cnt : 1u;
}
DI void xcd_barrier(const XcdBarrier& b) {
    asm volatile("s_waitcnt vmcnt(0)" ::: "memory");
    __syncthreads();
    if (threadIdx.x == 0) {
        unsigned* bar = b.bar;
        __builtin_amdgcn_s_waitcnt(0);
        unsigned nloc = b.st[0], nx = b.st[1];
        if (nloc == 0u) { xcd_barrier_complete(bar, b.x, nloc, nx); b.st[0] = nloc; b.st[1] = nx; }
        const unsigned old = xb_add(&bar[XB_XSUB(b.x)], 1u);
        const unsigned gen = old / nloc;
        if (old + 1u == (gen + 1u) * nloc) {
            __builtin_amdgcn_fence(__ATOMIC_RELEASE, "agent");
            asm volatile("s_waitcnt vmcnt(0)" ::: "memory");
            const unsigned og = xb_add(&bar[XB_TOP], 1u);
            const unsigned tg = og / nx;
            if (og + 1u == (tg + 1u) * nx) xb_add(&bar[XB_TOPGEN], 1u);
            else XB_SPIN(xb_ld(&bar[XB_TOPGEN]) == tg, bar);
            __builtin_amdgcn_fence(__ATOMIC_ACQUIRE, "agent");
            xb_add(&bar[XB_XGEN(b.x)], 1u);
            asm volatile("s_waitcnt vmcnt(0)" ::: "memory");
        } else {
            XB_SPIN(xb_ld(&bar[XB_XGEN(b.x)]) == gen, bar);
            __builtin_amdgcn_fence(__ATOMIC_ACQUIRE, "agent");
            asm volatile("s_waitcnt vmcnt(0)" ::: "memory");
        }
    }
    __syncthreads();
}

#define MEGA_PHASES(X) X(PH_IN0) X(PH_ATTN0) X(PH_OUT0) X(PH_PREP1) X(PH_IN1) X(PH_LORA1) X(PH_CPREP1) X(PH_SCAN1) X(PH_GN1) X(PH_OUT1) \
    X(PH_PREP2) X(PH_IN2) X(PH_B2) X(PH_C2) X(PH_D2) X(PH_OUT2) X(PH_PREP3) X(PH_IN3) X(PH_GATE3) X(PH_SCANB3) X(PH_OUT3)
__global__ void __launch_bounds__(NTHREADS, 2) mega_kernel(Params p) {
    extern __shared__ __attribute__((aligned(16))) char smem[];
    cooperative_groups::grid_group grid = cooperative_groups::this_grid();
    volatile LAS unsigned* xst = (volatile LAS unsigned*)(smem + 73728);
    if (threadIdx.x < 4) xst[threadIdx.x] = 0u;
    __syncthreads();
    XcdBarrier xb = xcd_barrier_post((unsigned*)p.ws, xst);
    run_phase<PH_PREP0>(p, smem);
    if (p.ws == nullptr) grid.sync();
    xcd_barrier(xb);
#define MEGA_STEP(ph) run_phase<ph>(p, smem); xcd_barrier(xb);
    MEGA_PHASES(MEGA_STEP)
#undef MEGA_STEP
    run_phase<PH_FINAL>(p, smem);
}
static void launch_mega(const Params& p, hipStream_t s) {
    static int grid_blocks = 0;
    if (!grid_blocks) {
        int dev = 0, cus = 0, per_cu = 0;
        hipGetDevice(&dev);
        hipDeviceGetAttribute(&cus, hipDeviceAttributeMultiprocessorCount, dev);
        hipFuncSetAttribute((const void*)mega_kernel, hipFuncAttributeMaxDynamicSharedMemorySize, MEGA_LDS_BYTES);
        hipOccupancyMaxActiveBlocksPerMultiprocessor(&per_cu, mega_kernel, NTHREADS, MEGA_LDS_BYTES);
        if (per_cu > 2) per_cu = 2;
        if (per_cu < 1) per_cu = 1;
        grid_blocks = cus * per_cu;
    }
    hipMemsetAsync(p.ws, 0, 16384, s);
    Params pp = p; void* args[] = {&pp};
    hipError_t e = hipLaunchCooperativeKernel((const void*)mega_kernel, dim3(grid_blocks), dim3(NTHREADS), args, MEGA_LDS_BYTES, s);
    if (e != hipSuccess) fprintf(stderr, "cooperative launch failed: %s (grid %d)\n", hipGetErrorString(e), grid_blocks);
}
#endif

#ifndef CPU_SHIM
template <class F> __global__ void __launch_bounds__(256) k_run(F f, long n) {
    const long i = (long)blockIdx.x * 256 + threadIdx.x; if (i < n) f(i);
}
template <class F> static void launch(const F& f, long n, hipStream_t s) {
    hipLaunchKernelGGL(k_run<F>, dim3((unsigned)((n + 255) / 256)), dim3(256), 0, s, f, n);
}
#else
template <class F> static void launch(const F& f, long n, hipStream_t) {
#pragma omp parallel for schedule(dynamic, 64)
    for (long i = 0; i < n; ++i) f(i);
}
#endif

#ifdef CPU_SHIM
void cpu_layer_hook(int layer, const float* X, const char* ws);
#define LAYER_HOOK(l) cpu_layer_hook(l, X, ws)
#else
#define LAYER_HOOK(l)
#endif

#define FAST_GEMM 0
#if FAST_GEMM
#define FASTP(ph) launch_phase<ph>(p, s)
#else
#define FASTP(ph)
#endif

static void run_naive(const Params& p, hipStream_t s) {
    char* ws = p.ws;
    float* rs = (float*)(ws + wsl::RS);
    bf16* P = (bf16*)(ws + wsl::P);
    float* X = p.out;
    (void)rs;
    {
        bf16* AO = (bf16*)(ws + wsl::L0_AO);
#if FAST_GEMM
        FASTP(PH_PREP0); FASTP(PH_IN0);
#else
        launch(RstdF{p.x, rs}, M, s);
        launch(GemmInF{p.x, rs, p.norm_g + 0 * D, p.a_w_in, P, A_COLS}, (long)M * (A_COLS / 4), s);
#endif
#if FAST_GEMM
        FASTP(PH_ATTN0); (void)AO;
#else
        launch(SwaF{P, p.t5, p.a_sinks, AO}, (long)M * H, s);
#endif
#if FAST_GEMM
        FASTP(PH_OUT0);
#else
        launch(GemmOutF{AO, p.a_w_out, p.x, X, 1024}, (long)M * (D / 4), s);
#endif
    }
    LAYER_HOOK(0);
    {
        bf16* XN = (bf16*)(ws + wsl::L1_XN); bf16* WL = (bf16*)(ws + wsl::L1_WL); bf16* AV = (bf16*)(ws + wsl::L1_AV);
        float* hw = (float*)(ws + wsl::LHW); float* ha = (float*)(ws + wsl::LHA);
#if FAST_GEMM
        FASTP(PH_PREP1); FASTP(PH_IN1); FASTP(PH_LORA1); FASTP(PH_CPREP1); FASTP(PH_SCAN1); FASTP(PH_GN1); FASTP(PH_OUT1);
        (void)XN; (void)WL; (void)AV; (void)hw; (void)ha;
#else
        launch(RstdF{X, rs}, M, s);
        launch(XnF{X, rs, p.norm_g + 1 * D, XN}, (long)M * D, s);
        launch(GemmRwkvF{XN, p.b_mu, p.b_w_in, P}, (long)M * 1024, s);
        launch(LoraHidF{XN, p.b_mu, p.b_w1, p.b_a1, hw, ha}, (long)M * 128, s);
        launch(LoraOutF{hw, ha, p.b_w0, p.b_w2, p.b_a0, p.b_a2, WL, AV}, (long)M * D, s);
        launch(RwkvScanF{P, WL, AV, p.b_k_k, p.b_k_a, XN}, (long)B * H * 64, s);
        launch(RwkvGnF{P, AV, p.b_k_a, p.b_r_k, p.b_lnx_w, p.b_lnx_b, XN}, (long)M * H, s);
        launch(GemmOutF{XN, p.b_w_out, X, X, 1024}, (long)M * (D / 4), s);
#endif
    }
    LAYER_HOOK(1);
    {
        float* hk = (float*)(ws + wsl::HK); float* hv = (float*)(ws + wsl::HV);
        float* kc = (float*)(ws + wsl::KC); float* vc = (float*)(ws + wsl::VC);
        float* st = (float*)(ws + wsl::ST); int* sel = (int*)(ws + wsl::SEL); float* imp = (float*)(ws + wsl::L2_IMP);
        bf16* AO = (bf16*)(ws + wsl::L2_AO); bf16* OC = (bf16*)(ws + wsl::L2_OC); bf16* OS = (bf16*)(ws + wsl::L2_OS);
#if FAST_GEMM
        FASTP(PH_PREP2); FASTP(PH_IN2); FASTP(PH_B2); FASTP(PH_C2); FASTP(PH_D2); FASTP(PH_OUT2);
        (void)hk; (void)hv; (void)kc; (void)vc; (void)st; (void)sel; (void)imp; (void)AO; (void)OC; (void)OS;
#else
        launch(RstdF{X, rs}, M, s);
        launch(GemmInF{X, rs, p.norm_g + 2 * D, p.c_w_in, P, C_COLS}, (long)M * (C_COLS / 4), s);
        launch(CmpHidF{P, p.c_pos_k, p.c_k_w1, p.c_pos_v, p.c_v_w1, hk, hv}, 2L * B * G * NCMP * 128, s);
        launch(CmpOutF{hk, hv, p.c_k_w2, p.c_v_w2, kc, vc}, 2L * B * G * NCMP * 64, s);
        launch(CmpAttnF{P, kc, vc, st, OC}, (long)M * H, s);
        launch(ImpF{P, kc, st, imp}, (long)M * G * NSEL, s);
        launch(TopkF{imp, sel}, (long)M * G, s);
        launch(SelAttnF{P, p.t5, sel, OS}, (long)M * H, s);
        launch(WinAttnF{P, p.t5, OC, OS, AO}, (long)M * H, s);
        LAYER_HOOK(20);
        launch(GemmOutF{AO, p.c_w_out, X, X, 1024}, (long)M * (D / 4), s);
#endif
    }
    LAYER_HOOK(2);
    {
        bf16* AO = (bf16*)(ws + wsl::L3_AO); bf16* UC = (bf16*)(ws + wsl::L3_UC); bf16* LA = (bf16*)(ws + wsl::L3_LA); bf16* BV = (bf16*)(ws + wsl::L3_BV);
#if FAST_GEMM
        FASTP(PH_PREP3); FASTP(PH_IN3); FASTP(PH_GATE3); FASTP(PH_SCANA3); FASTP(PH_SCANB3); FASTP(PH_OUT3);
        (void)AO; (void)UC; (void)LA; (void)BV;
#else
        launch(RstdF{X, rs}, M, s);
        launch(GemmInF{X, rs, p.norm_g + 3 * D, p.d_w_in, P, 2560}, (long)M * (2560 / 4), s);
        launch(ConvF{P, p.d_conv_w, p.d_conv_b, UC}, (long)M * LW, s);
        launch(LruGateF{UC, p.d_ga_w, p.d_ga_b, p.d_gx_w, p.d_gx_b, p.d_lambda, LA, BV}, (long)M * LW, s);
        launch(LruScanF{P, LA, BV, AO}, (long)B * LW, s);
        launch(GemmOutF{AO, p.d_w_out, X, X, LW}, (long)M * (D / 4), s);
#endif
    }
    LAYER_HOOK(3);
#if FAST_GEMM
    FASTP(PH_FINAL);
#else
    launch(FinalNormF{X, p.final_g}, M, s);
#endif
}

extern "C" void kernel_launch(void* const* d_in, const int* in_sizes, int n_in, void* d_out, int out_size, void* d_ws, size_t ws_size,
                              hipStream_t stream) {
    (void)in_sizes; (void)n_in; (void)out_size; (void)ws_size;
    Params p{};
    const float* const* in = (const float* const*)d_in;
    int k = 0;
    p.x = in[k++]; p.t5 = in[k++]; p.norm_g = in[k++]; p.final_g = in[k++];
    p.a_w_in = in[k++]; p.a_sinks = in[k++]; p.a_w_out = in[k++];
    p.b_mu = in[k++]; p.b_w_in = in[k++]; p.b_w0 = in[k++]; p.b_w1 = in[k++]; p.b_w2 = in[k++]; p.b_a0 = in[k++]; p.b_a1 = in[k++]; p.b_a2 = in[k++];
    p.b_k_k = in[k++]; p.b_k_a = in[k++]; p.b_r_k = in[k++]; p.b_lnx_w = in[k++]; p.b_lnx_b = in[k++]; p.b_w_out = in[k++];
    p.c_w_in = in[k++]; p.c_pos_k = in[k++]; p.c_k_w1 = in[k++]; p.c_k_w2 = in[k++]; p.c_pos_v = in[k++]; p.c_v_w1 = in[k++]; p.c_v_w2 = in[k++]; p.c_w_out = in[k++];
    p.d_w_in = in[k++]; p.d_conv_w = in[k++]; p.d_conv_b = in[k++]; p.d_ga_w = in[k++]; p.d_ga_b = in[k++]; p.d_gx_w = in[k++]; p.d_gx_b = in[k++];
    p.d_lambda = in[k++]; p.d_w_out = in[k++];
    p.out = (float*)d_out; p.ws = (char*)d_ws;
#if !defined(CPU_SHIM) && !defined(MULTI_LAUNCH) && !defined(ALL_NAIVE)
    launch_mega(p, stream);
#else
    run_naive(p, stream);
#endif
}
```

```cpp
#ifndef CPU_SHIM
#include <hip/hip_runtime.h>
#include <hip/hip_cooperative_groups.h>
#include <cstdio>
#define HD __host__ __device__ __forceinline__
#else
#include <cmath>
#include <cstring>
#include <cstdio>
#include <cstdlib>
#include <cstdint>
#define HD inline
typedef void* hipStream_t;
#endif
#include <cstddef>

#ifndef CFG_B
#define CFG_B 4
#endif
#ifndef CFG_T
#define CFG_T 4096
#endif

namespace cfg {
constexpr int B = CFG_B, T = CFG_T, M = B * T, D = 1024;
constexpr int H = 16, G = 4, R = 4, DH = 64;
constexpr int A_COLS = 2560;
constexpr int C_COLS = 3632;
constexpr int NCMP = (T - 32) / 16 + 1;
constexpr int NSEL = T / 64;
constexpr int KTOP = NSEL < 16 ? NSEL : 16;
constexpr int LW = 1280;
}
using namespace cfg;

typedef unsigned short bf16;

HD unsigned f_as_u(float f) {
#ifndef CPU_SHIM
    return __float_as_uint(f);
#else
    unsigned u; memcpy(&u, &f, 4); return u;
#endif
}
HD float u_as_f(unsigned u) {
#ifndef CPU_SHIM
    return __uint_as_float(u);
#else
    float f; memcpy(&f, &u, 4); return f;
#endif
}
HD float bf2f(bf16 v) { return u_as_f(((unsigned)v) << 16); }
HD bf16 f2bf(float f) { unsigned u = f_as_u(f); u += 0x7fffu + ((u >> 16) & 1u); return (bf16)(u >> 16); }
HD float sigmoidf_(float x) { return 1.0f / (1.0f + expf(-x)); }
HD float siluf_(float x) { return x / (1.0f + expf(-x)); }
HD float softplusf_(float x) { return x > 20.f ? x : log1pf(expf(x)); }

HD int t5_bucket(int d) {
    if (d < 16) return d < 0 ? 0 : d;
    if (d >= 113) return 31;
    if (d >= 99) return 30;
    if (d >= 87) return 29;
    if (d >= 77) return 28;
    if (d >= 67) return 27;
    if (d >= 59) return 26;
    if (d >= 52) return 25;
    if (d >= 46) return 24;
    if (d >= 40) return 23;
    if (d >= 35) return 22;
    if (d >= 31) return 21;
    if (d >= 27) return 20;
    if (d >= 24) return 19;
    if (d >= 21) return 18;
    if (d >= 19) return 17;
    return 16;
}

struct Params {
    const float *x, *t5, *norm_g, *final_g;
    const float *a_w_in, *a_sinks, *a_w_out;
    const float *b_mu, *b_w_in, *b_w0, *b_w1, *b_w2, *b_a0, *b_a1, *b_a2, *b_k_k, *b_k_a, *b_r_k, *b_lnx_w, *b_lnx_b, *b_w_out;
    const float *c_w_in, *c_pos_k, *c_k_w1, *c_k_w2, *c_pos_v, *c_v_w1, *c_v_w2, *c_w_out;
    const float *d_w_in, *d_conv_w, *d_conv_b, *d_ga_w, *d_ga_b, *d_gx_w, *d_gx_b, *d_lambda, *d_w_out;
    float* out;
    char* ws;
};

namespace wsl {
constexpr size_t MB = 1024 * 1024;
constexpr size_t RS = 0;
constexpr size_t HK = 1 * MB;
constexpr size_t HV = 3 * MB;
constexpr size_t KC = 5 * MB;
constexpr size_t VC = 6 * MB;
constexpr size_t ST = 7 * MB;
constexpr size_t SEL = 9 * MB;
constexpr size_t LHW = 1 * MB;
constexpr size_t LHA = 5 * MB;
constexpr size_t P = 14 * MB;
constexpr size_t SZ1024 = (size_t)M * 1024 * 2, SZ1280 = (size_t)M * 1280 * 2;
constexpr size_t L0_AO = P + (size_t)M * 2560 * 2;
constexpr size_t L1_XN = P + (size_t)M * 4096 * 2, L1_WL = L1_XN + SZ1024, L1_AV = L1_WL + SZ1024;
constexpr size_t L2_AO = P + (size_t)M * 3632 * 2, L2_OC = L2_AO + SZ1024, L2_OS = L2_OC + SZ1024, L2_IMP = L2_OS + SZ1024;
constexpr size_t L3_AO = P + (size_t)M * 2560 * 2, L3_UC = L3_AO + SZ1280, L3_LA = L3_UC + SZ1280, L3_BV = L3_LA + SZ1280;
constexpr size_t TOTAL = L3_BV + SZ1280;
}

struct RstdF {
    const float* x; float* rs;
    HD void operator()(long m) const {
        const float* r = x + (size_t)m * D; float s = 0.f;
        for (int k = 0; k < D; ++k) s += r[k] * r[k];
        rs[m] = 1.0f / sqrtf(s / D + 1e-6f);
    }
};
struct XnF {
    const float* x; const float* rs; const float* g; bf16* xn;
    HD void operator()(long i) const { long m = i / D; int k = (int)(i % D); xn[i] = f2bf(x[i] * rs[m] * g[k]); }
};
struct GemmInF {
    const float *x, *rs, *g, *W; bf16* P; long long N;
    HD void operator()(long i) const {
        const int n4 = (int)N / 4; const long m = i / n4; const int n = (int)(i % n4) * 4;
        const float* xr = x + (size_t)m * D; const float r = rs[m];
        float a0 = 0, a1 = 0, a2 = 0, a3 = 0;
        for (int k = 0; k < D; ++k) {
            const float a = xr[k] * r * g[k]; const float* w = W + (size_t)k * N + n;
            a0 += a * w[0]; a1 += a * w[1]; a2 += a * w[2]; a3 += a * w[3];
        }
        bf16* p = P + (size_t)m * N + n; p[0] = f2bf(a0); p[1] = f2bf(a1); p[2] = f2bf(a2); p[3] = f2bf(a3);
    }
};
struct GemmOutF {
    const bf16* A; const float* W; const float* xin; float* xout; long long K;
    HD void operator()(long i) const {
        const int n4 = D / 4; const long m = i / n4; const int n = (int)(i % n4) * 4;
        const bf16* ar = A + (size_t)m * K;
        float a0 = 0, a1 = 0, a2 = 0, a3 = 0;
        for (int k = 0; k < K; ++k) {
            const float a = bf2f(ar[k]); const float* w = W + (size_t)k * D + n;
            a0 += a * w[0]; a1 += a * w[1]; a2 += a * w[2]; a3 += a * w[3];
        }
        const float* xi = xin + (size_t)m * D + n; float* xo = xout + (size_t)m * D + n;
        xo[0] = xi[0] + a0; xo[1] = xi[1] + a1; xo[2] = xi[2] + a2; xo[3] = xi[3] + a3;
    }
};

struct SwaF {
    const bf16* P; const float* t5; const float* sinks; bf16* AO;
    HD void operator()(long i) const {
        const long m = i / H; const int h = (int)(i % H), g = h / R; const int t = (int)(m % T); const long mb = m - t;
        float q[DH], o[DH];
#pragma unroll
        for (int d = 0; d < DH; ++d) { q[d] = bf2f(P[(size_t)m * A_COLS + h * DH + d]); o[d] = 0.f; }
        float mx = sinks[h], l = 1.0f;
        const int s0 = t - 127 < 0 ? 0 : t - 127;
        for (int s = s0; s <= t; ++s) {
            const bf16* kr = P + (size_t)(mb + s) * A_COLS + 1024 + g * DH;
            const bf16* vr = kr + 256;
            float sc = 0.f;
#pragma unroll
            for (int d = 0; d < DH; ++d) sc += q[d] * bf2f(kr[d]);
            sc = sc * 0.125f + t5[t5_bucket(t - s) * H + h];
            const float mn = sc > mx ? sc : mx; const float al = expf(mx - mn), p = expf(sc - mn);
            l = l * al + p; mx = mn;
#pragma unroll
            for (int d = 0; d < DH; ++d) o[d] = o[d] * al + p * bf2f(vr[d]);
        }
        const float il = 1.0f / l;
#pragma unroll
        for (int d = 0; d < DH; ++d) {
            const float z = bf2f(P[(size_t)m * A_COLS + 1536 + h * DH + d]);
            AO[(size_t)m * D + h * DH + d] = f2bf(o[d] * il * siluf_(z));
        }
    }
};

struct GemmRwkvF {
    const bf16* xn; const float* mu; const float* W; bf16* P;
    HD void operator()(long i) const {
        const int N = 4096, n4 = N / 4; const long m = i / n4; const int n = (int)(i % n4) * 4; const int s = n / 1024;
        const int t = (int)(m % T);
        const bf16* xr = xn + (size_t)m * D; const float* mus = mu + s * D;
        float a0 = 0, a1 = 0, a2 = 0, a3 = 0;
        for (int k = 0; k < D; ++k) {
            const float xc = bf2f(xr[k]); const float xp = t > 0 ? bf2f(xr[k - D]) : 0.f;
            const float a = xc + (xp - xc) * mus[k]; const float* w = W + (size_t)k * N + n;
            a0 += a * w[0]; a1 += a * w[1]; a2 += a * w[2]; a3 += a * w[3];
        }
        bf16* p = P + (size_t)m * N + n; p[0] = f2bf(a0); p[1] = f2bf(a1); p[2] = f2bf(a2); p[3] = f2bf(a3);
    }
};
struct LoraHidF {
    const bf16* xn; const float* mu; const float* w1; const float* a1; float* hw; float* ha;
    HD void operator()(long i) const {
        const long m = i / 128; const int jj = (int)(i % 128); const int which = jj / 64, j = jj % 64; const int t = (int)(m % T);
        const bf16* xr = xn + (size_t)m * D; const float* mus = mu + (4 + which) * D; const float* W = which ? a1 : w1;
        float acc = 0.f;
        for (int k = 0; k < D; ++k) {
            const float xc = bf2f(xr[k]); const float xp = t > 0 ? bf2f(xr[k - D]) : 0.f;
            acc += (xc + (xp - xc) * mus[k]) * W[(size_t)k * 64 + j];
        }
        if (which) ha[(size_t)m * 64 + j] = acc; else hw[(size_t)m * 64 + j] = tanhf(acc);
    }
};
struct LoraOutF {
    const float *hw, *ha, *w0, *w2, *a0, *a2; bf16* wlog; bf16* av;
    HD void operator()(long i) const {
        const long m = i / D; const int c = (int)(i % D);
        float sw = 0.f, sa = 0.f;
        for (int j = 0; j < 64; ++j) { sw += hw[(size_t)m * 64 + j] * w2[(size_t)j * D + c]; sa += ha[(size_t)m * 64 + j] * a2[(size_t)j * D + c]; }
        const float wr = -softplusf_(-(w0[c] + sw)) - 0.5f;
        wlog[i] = f2bf(-expf(wr)); av[i] = f2bf(sigmoidf_(a0[c] + sa));
    }
};
struct RwkvScanF {
    const bf16* P; const bf16* wlog; const bf16* av; const float* k_k; const float* k_a; bf16* ys;
    HD void operator()(long idx) const {
        const int i = (int)(idx % 64); const int h = (int)((idx / 64) % H); const int b = (int)(idx / (64 * H));
        float S[64];
#pragma unroll
        for (int j = 0; j < 64; ++j) S[j] = 0.f;
        for (int t = 0; t < T; ++t) {
            const size_t m = (size_t)b * T + t; const bf16* pr = P + m * 4096 + h * 64;
            const bf16* wl = wlog + m * D + h * 64; const bf16* ar = av + m * D + h * 64;
            float n2 = 0.f;
#pragma unroll
            for (int j = 0; j < 64; ++j) { const float kk = bf2f(pr[1024 + j]) * k_k[h * 64 + j]; n2 += kk * kk; }
            float nr = sqrtf(n2); nr = nr > 1e-12f ? nr : 1e-12f; const float inr = 1.0f / nr;
            float sa = 0.f;
#pragma unroll
            for (int j = 0; j < 64; ++j) { const float kk = bf2f(pr[1024 + j]) * k_k[h * 64 + j] * inr; sa += S[j] * (-kk); }
            const float vi = bf2f(pr[2048 + i]); float y = 0.f;
#pragma unroll
            for (int j = 0; j < 64; ++j) {
                const float kr = bf2f(pr[1024 + j]); const float a = bf2f(ar[j]);
                const float kk = kr * k_k[h * 64 + j] * inr; const float kp = kr * (1.0f + (a - 1.0f) * k_a[h * 64 + j]);
                const float dec = expf(bf2f(wl[j]));
                S[j] = S[j] * dec + sa * (kk * a) + vi * kp;
                y += S[j] * bf2f(pr[j]);
            }
            ys[m * D + h * 64 + i] = f2bf(y);
        }
    }
};
struct RwkvGnF {
    const bf16* P; const bf16* av; const float *k_a, *r_k, *lnx_w, *lnx_b; bf16* ys;
    HD void operator()(long idx) const {
        const long m = idx / H; const int h = (int)(idx % H);
        bf16* yr = ys + (size_t)m * D + h * 64; const bf16* pr = P + (size_t)m * 4096 + h * 64; const bf16* ar = av + (size_t)m * D + h * 64;
        float mean = 0.f;
        for (int j = 0; j < 64; ++j) mean += bf2f(yr[j]);
        mean /= 64.f; float var = 0.f;
        for (int j = 0; j < 64; ++j) { const float d = bf2f(yr[j]) - mean; var += d * d; }
        var /= 64.f; const float rstd = 1.0f / sqrtf(var + 64e-5f);
        float bs = 0.f;
        for (int j = 0; j < 64; ++j) { const float kr = bf2f(pr[1024 + j]); const float kp = kr * (1.0f + (bf2f(ar[j]) - 1.0f) * k_a[h * 64 + j]); bs += bf2f(pr[j]) * kp * r_k[h * 64 + j]; }
        for (int j = 0; j < 64; ++j) {
            const float yn = (bf2f(yr[j]) - mean) * rstd * lnx_w[h * 64 + j] + lnx_b[h * 64 + j];
            const float z = bf2f(pr[3072 + j]);
            yr[j] = f2bf((yn + bs * bf2f(pr[2048 + j])) * siluf_(z));
        }
    }
};

struct CmpHidF {
    const bf16* P; const float *pos_k, *w1_k, *pos_v, *w1_v; float* hk; float* hv;
    HD void operator()(long idx) const {
        const int j = (int)(idx % 128); long r = idx / 128; const int n = (int)(r % NCMP); r /= NCMP; const int g = (int)(r % G); r /= G;
        const int b = (int)(r % B); const int which = (int)(r / B);
        const float* pos = which ? pos_v : pos_k; const float* w1 = which ? w1_v : w1_k; const int col = 1024 + (which ? 256 : 0) + g * 64;
        float acc = 0.f;
        for (int l = 0; l < 32; ++l) {
            const bf16* src = P + (size_t)(b * T + 16 * n + l) * C_COLS + col;
            for (int d = 0; d < 64; ++d) acc += (bf2f(src[d]) + pos[l * 64 + d]) * w1[(size_t)(l * 64 + d) * 128 + j];
        }
        (which ? hv : hk)[(((size_t)b * G + g) * NCMP + n) * 128 + j] = siluf_(acc);
    }
};
struct CmpOutF {
    const float *hk, *hv, *w2_k, *w2_v; float* kc; float* vc;
    HD void operator()(long idx) const {
        const int d = (int)(idx % 64); long r = idx / 64; const long row = r % ((long)B * G * NCMP); const int which = (int)(r / ((long)B * G * NCMP));
        const float* hsrc = (which ? hv : hk) + (size_t)row * 128; const float* w2 = which ? w2_v : w2_k;
        float acc = 0.f;
        for (int j = 0; j < 128; ++j) acc += hsrc[j] * w2[j * 64 + d];
        (which ? vc : kc)[(size_t)row * 64 + d] = acc;
    }
};
struct CmpAttnF {
    const bf16* P; const float *kc, *vc; float* st; bf16* oc;
    HD void operator()(long i) const {
        const long m = i / H; const int h = (int)(i % H), g = h / R; const int t = (int)(m % T); const int b = (int)(m / T);
        float q[DH], o[DH];
#pragma unroll
        for (int d = 0; d < DH; ++d) { q[d] = bf2f(P[(size_t)m * C_COLS + h * DH + d]); o[d] = 0.f; }
        const int nv = t < 31 ? 0 : (t - 31) / 16 + 1;
        float mx = -1e30f, l = 0.f;
        for (int n = 0; n < nv; ++n) {
            const float* kr = kc + (((size_t)b * G + g) * NCMP + n) * 64; const float* vr = vc + (((size_t)b * G + g) * NCMP + n) * 64;
            float sc = 0.f;
#pragma unroll
            for (int d = 0; d < DH; ++d) sc += q[d] * kr[d];
            sc *= 0.125f;
            const float mn = sc > mx ? sc : mx; const float al = expf(mx - mn), p = expf(sc - mn);
            l = l * al + p; mx = mn;
#pragma unroll
            for (int d = 0; d < DH; ++d) o[d] = o[d] * al + p * vr[d];
        }
        const float il = nv > 0 ? 1.0f / l : 0.f;
        st[(size_t)i * 2] = mx; st[(size_t)i * 2 + 1] = il;
#pragma unroll
        for (int d = 0; d < DH; ++d) oc[(size_t)m * D + h * DH + d] = f2bf(o[d] * il);
    }
};
struct ImpF {
    const bf16* P; const float *kc, *st; float* imp;
    HD void operator()(long idx) const {
        const int s = (int)(idx % NSEL); long r = idx / NSEL; const int g = (int)(r % G); const long m = r / G;
        const int t = (int)(m % T); const int b = (int)(m / T); const int cur = t / 64;
        float v;
        if (s == 0 || s == cur || s == cur - 1) v = 1e30f;
        else if (s * 64 > t) v = -1e30f;
        else {
            v = 0.f; const int nv = t < 31 ? 0 : (t - 31) / 16 + 1;
            int n0 = 4 * s - 1; if (n0 < 0) n0 = 0; int n1 = 4 * s + 3; if (n1 > NCMP - 1) n1 = NCMP - 1; if (n1 > nv - 1) n1 = nv - 1;
            for (int rr = 0; rr < R; ++rr) {
                const int h = g * R + rr; const bf16* qr = P + (size_t)m * C_COLS + h * DH;
                const float mx = st[((size_t)m * H + h) * 2], il = st[((size_t)m * H + h) * 2 + 1];
                for (int n = n0; n <= n1; ++n) {
                    const float* kr = kc + (((size_t)b * G + g) * NCMP + n) * 64; float sc = 0.f;
                    for (int d = 0; d < DH; ++d) sc += bf2f(qr[d]) * kr[d];
                    v += expf(sc * 0.125f - mx) * il;
                }
            }
        }
        imp[idx] = v;
    }
};
struct TopkF {
    const float* imp; int* sel;
    HD void operator()(long idx) const {
        const float* v = imp + (size_t)idx * NSEL; unsigned long long used = 0ull;
        for (int j = 0; j < KTOP; ++j) {
            int best = -1; float bv = 0.f;
            for (int s = 0; s < NSEL; ++s) { if ((used >> s) & 1ull) continue; const float x = v[s]; if (best < 0 || x > bv) { best = s; bv = x; } }
            used |= 1ull << best; sel[(size_t)idx * 16 + j] = best;
        }
    }
};
struct SelAttnF {
    const bf16* P; const float* t5; const int* sel; bf16* os;
    HD void operator()(long i) const {
        const long m = i / H; const int h = (int)(i % H), g = h / R; const int t = (int)(m % T); const long mb = m - t;
        float q[DH], o[DH];
#pragma unroll
        for (int d = 0; d < DH; ++d) { q[d] = bf2f(P[(size_t)m * C_COLS + h * DH + d]); o[d] = 0.f; }
        float mx = -1e30f, l = 0.f;
        for (int j = 0; j < KTOP; ++j) {
            const int blk = sel[((size_t)m * G + g) * 16 + j];
            for (int ll = 0; ll < 64; ++ll) {
                const int s = blk * 64 + ll; if (s > t) break;
                const bf16* kr = P + (size_t)(mb + s) * C_COLS + 1536 + g * DH; const bf16* vr = kr + 256;
                float sc = 0.f;
#pragma unroll
                for (int d = 0; d < DH; ++d) sc += q[d] * bf2f(kr[d]);
                sc = sc * 0.125f + t5[t5_bucket(t - s) * H + h];
                const float mn = sc > mx ? sc : mx; const float al = expf(mx - mn), p = expf(sc - mn);
                l = l * al + p; mx = mn;
#pragma unroll
                for (int d = 0; d < DH; ++d) o[d] = o[d] * al + p * bf2f(vr[d]);
            }
        }
        const float il = 1.0f / l;
#pragma unroll
        for (int d = 0; d < DH; ++d) os[(size_t)m * D + h * DH + d] = f2bf(o[d] * il);
    }
};
struct WinAttnF {
    const bf16* P; const float* t5; const bf16* oc; const bf16* os; bf16* AO;
    HD void operator()(long i) const {
        const long m = i / H; const int h = (int)(i % H), g = h / R, rr = h % R; const int t = (int)(m % T); const long mb = m - t;
        float q[DH], o[DH];
#pragma unroll
        for (int d = 0; d < DH; ++d) { q[d] = bf2f(P[(size_t)m * C_COLS + h * DH + d]); o[d] = 0.f; }
        float mx = -1e30f, l = 0.f;
        const int s0 = t - 511 < 0 ? 0 : t - 511;
        for (int s = s0; s <= t; ++s) {
            const bf16* kr = P + (size_t)(mb + s) * C_COLS + 2048 + g * DH; const bf16* vr = kr + 256;
            float sc = 0.f;
#pragma unroll
            for (int d = 0; d < DH; ++d) sc += q[d] * bf2f(kr[d]);
            sc = sc * 0.125f + t5[t5_bucket(t - s) * H + h];
            const float mn = sc > mx ? sc : mx; const float al = expf(mx - mn), p = expf(sc - mn);
            l = l * al + p; mx = mn;
#pragma unroll
            for (int d = 0; d < DH; ++d) o[d] = o[d] * al + p * bf2f(vr[d]);
        }
        const float il = 1.0f / l;
        const bf16* gr = P + (size_t)m * C_COLS + 2560;
        const float g0 = sigmoidf_(bf2f(gr[0 * 16 + g * R + rr])), g1 = sigmoidf_(bf2f(gr[1 * 16 + g * R + rr])), g2 = sigmoidf_(bf2f(gr[2 * 16 + g * R + rr]));
#pragma unroll
        for (int d = 0; d < DH; ++d) {
            const size_t oi = (size_t)m * D + h * DH + d;
            const float z = bf2f(P[(size_t)m * C_COLS + 2608 + h * DH + d]);
            AO[oi] = f2bf((g0 * bf2f(oc[oi]) + g1 * bf2f(os[oi]) + g2 * o[d] * il) * siluf_(z));
        }
    }
};

struct ConvF {
    const bf16* P; const float *cw, *cb; bf16* uc;
    HD void operator()(long i) const {
        const long m = i / LW; const int c = (int)(i % LW); const int t = (int)(m % T);
        float acc = cb[c];
        for (int w = 0; w < 4; ++w) { const int tt = t - 3 + w; if (tt >= 0) acc += cw[w * LW + c] * bf2f(P[(size_t)(m - 3 + w) * 2560 + c]); }
        uc[i] = f2bf(acc);
    }
};
struct LruGateF {
    const bf16* uc; const float *gaw, *gab, *gxw, *gxb, *lam; bf16* la; bf16* bv;
    HD void operator()(long i) const {
        const long m = i / LW; const int c = (int)(i % LW); const int n = c / 80, d = c % 80;
        const bf16* ub = uc + (size_t)m * LW + n * 80; float ra = gab[c], rx = gxb[c];
        for (int k = 0; k < 80; ++k) { const float u = bf2f(ub[k]); ra += u * gaw[((size_t)n * 80 + k) * 80 + d]; rx += u * gxw[((size_t)n * 80 + k) * 80 + d]; }
        const float r = sigmoidf_(ra), ig = sigmoidf_(rx);
        const float loga = -8.0f * r * softplusf_(-lam[c]);
        la[i] = f2bf(loga);
        bv[i] = f2bf(sqrtf(-expm1f(2.0f * loga)) * (ig * bf2f(uc[i])));
    }
};
struct LruScanF {
    const bf16* P; const bf16* la; const bf16* bv; bf16* AO;
    HD void operator()(long idx) const {
        const int c = (int)(idx % LW); const int b = (int)(idx / LW); float h = 0.f;
        for (int t = 0; t < T; ++t) {
            const size_t m = (size_t)b * T + t;
            h = expf(bf2f(la[m * LW + c])) * h + bf2f(bv[m * LW + c]);
            AO[m * LW + c] = f2bf(h * siluf_(bf2f(P[m * 2560 + LW + c])));
        }
    }
};
struct FinalNormF {
    float* x; const float* g;
    HD void operator()(long m) const {
        float* r = x + (size_t)m * D; float s = 0.f;
        for (int k = 0; k < D; ++k) s += r[k] * r[k];
        const float rs = 1.0f / sqrtf(s / D + 1e-6f);
        for (int k = 0; k < D; ++k) r[k] = r[k] * rs * g[k];
    }
};


#ifndef CPU_SHIM
typedef short bf16x8 __attribute__((ext_vector_type(8)));
typedef float f32x4 __attribute__((ext_vector_type(4)));
typedef unsigned u32x4 __attribute__((ext_vector_type(4)));
typedef unsigned u32x2 __attribute__((ext_vector_type(2)));
#define DI __device__ __forceinline__
#define NTHREADS 256
__device__ __forceinline__ int opaque_tid() { int t = threadIdx.x; asm volatile("" : "+v"(t)); return t; }
#define TIDX (opaque_tid())

typedef __bf16 hbf16x2 __attribute__((ext_vector_type(2)));
typedef float f32x2 __attribute__((ext_vector_type(2)));
DI unsigned pack2bf(float lo, float hi) { f32x2 f = {lo, hi}; return __builtin_bit_cast(unsigned, __builtin_convertvector(f, hbf16x2)); }
DI float bflo(unsigned u) { return __uint_as_float(u << 16); }
DI float bfhi(unsigned u) { return __uint_as_float(u & 0xffff0000u); }

namespace fw {
constexpr size_t MB = 1024 * 1024;
constexpr size_t PARTS = 13 * MB;
constexpr size_t SMALLB = 1 * MB;
constexpr size_t WB = 14 * MB;
constexpr size_t XB = 30 * MB;
constexpr size_t BIG = 62 * MB;
}

DI void convert_tile(const float* __restrict__ W, int ldw, int c0, int K, bf16* __restrict__ Wt, const float* __restrict__ g, int kt, int nt, float* sm) {
    const int tid = TIDX;
    const int k0 = kt * 64, n0 = nt * 64;
#pragma unroll
    for (int i = 0; i < 4; ++i) {
        const int kr = (tid >> 4) + 16 * i; const int nc = (tid & 15) * 4;
        const float4 v = *(const float4*)(W + (size_t)(k0 + kr) * ldw + c0 + n0 + nc);
        const float s = g ? g[k0 + kr] : 1.0f;
        sm[kr * 65 + nc + 0] = v.x * s; sm[kr * 65 + nc + 1] = v.y * s; sm[kr * 65 + nc + 2] = v.z * s; sm[kr * 65 + nc + 3] = v.w * s;
    }
    __syncthreads();
    {
        const int n = tid >> 2, kq = (tid & 3) * 16;
        unsigned w[8];
#pragma unroll
        for (int j = 0; j < 8; ++j) w[j] = pack2bf(sm[(kq + 2 * j) * 65 + n], sm[(kq + 2 * j + 1) * 65 + n]);
        u32x4* dst = (u32x4*)(Wt + (size_t)(n0 + n) * K + k0 + kq);
        dst[0] = (u32x4){w[0], w[1], w[2], w[3]}; dst[1] = (u32x4){w[4], w[5], w[6], w[7]};
    }
    __syncthreads();
}
DI void convert_seg(const float* W, int ldw, int c0, int ncols, int K, bf16* Wt, const float* g, float* sm, int& tbase) {
    const int nkt = K / 64, nnt = ncols / 64, ntile = nkt * nnt;
    const int Gd = (int)gridDim.x;
    for (int t = (((int)blockIdx.x - tbase % Gd) + Gd) % Gd; t < ntile; t += Gd) convert_tile(W, ldw, c0, K, Wt, g, t % nkt, t / nkt, sm);
    tbase += ntile;
}

DI int perm32(int rho) { const int n = rho >> 4, i = rho & 15; return 8 * (i >> 2) + 4 * n + (i & 3); }

struct ALoadPlain {
    const bf16* A; int lda;
    static constexpr bool DMA = true;
    DI const bf16* src(int m, int k) const { return A + (size_t)m * lda + k; }
    struct Raw { u32x4 v; };
    DI Raw load(int m, int k) const { Raw r; r.v = *(const u32x4*)(A + (size_t)m * lda + k); return r; }
    DI u32x4 finish(const Raw& r, int, int) const { return r.v; }
};
struct ALoadLerp {
    const bf16* xn; const float* mu;
    static constexpr bool DMA = false;
    DI const bf16* src(int, int) const { return nullptr; }
    struct Raw { u32x4 c, p; };
    DI Raw load(int m, int k) const {
        Raw r; r.c = *(const u32x4*)(xn + (size_t)m * D + k);
        if ((m % T) != 0) r.p = *(const u32x4*)(xn + (size_t)(m - 1) * D + k); else r.p = (u32x4){0u, 0u, 0u, 0u};
        return r;
    }
    DI u32x4 finish(const Raw& r, int, int k) const {
        const float4 m0 = *(const float4*)(mu + k), m1 = *(const float4*)(mu + k + 4);
        const float mm[8] = {m0.x, m0.y, m0.z, m0.w, m1.x, m1.y, m1.z, m1.w};
        u32x4 o;
#pragma unroll
        for (int j = 0; j < 4; ++j) {
            const float c0 = bflo(r.c[j]), c1 = bfhi(r.c[j]), p0 = bflo(r.p[j]), p1 = bfhi(r.p[j]);
            o[j] = pack2bf(c0 + (p0 - c0) * mm[2 * j], c1 + (p1 - c1) * mm[2 * j + 1]);
        }
        return o;
    }
};

#define GLDS16(gp, lp) __builtin_amdgcn_global_load_lds((const unsigned*)(gp), (unsigned*)(lp), 16, 0, 0)
template <class AL, class Epi>
DI void gemm_tile(const AL& al, const bf16* __restrict__ Bt, int K, int m0, int n0, const Epi& epi, char* smem) {
    const int tid = TIDX, lane = tid & 63, wave = __builtin_amdgcn_readfirstlane(tid >> 6), wr = wave >> 1, wc = wave & 1, q = lane >> 4, l15 = lane & 15;
    const int srow = tid >> 3, sc = tid & 7, scs = sc ^ (srow & 7);
    const int st_off = srow * 128 + (sc << 4);
    const int dma_off = (8 * wave) * 128;
    int brow[4];
#pragma unroll
    for (int i = 0; i < 4; ++i) { const int rho = srow + 32 * i; brow[i] = n0 + (rho & ~31) + perm32(rho & 31); }
    const int fa0 = (wr * 64 + l15) * 128 + ((q ^ (lane & 7)) << 4);
    const int fb0 = (wc * 64 + l15) * 128 + ((q ^ (lane & 7)) << 4);
    f32x4 acc[4][4];
#pragma unroll
    for (int i = 0; i < 4; ++i)
#pragma unroll
        for (int j = 0; j < 4; ++j) acc[i][j] = (f32x4){0.f, 0.f, 0.f, 0.f};
    typename AL::Raw ra[4];
    const int nk = K / 64;
    {
        char* bufA = smem; char* bufB = smem + 16384;
#pragma unroll
        for (int i = 0; i < 4; ++i) {
            GLDS16(Bt + (size_t)brow[i] * K + scs * 8, bufB + dma_off + i * 4096);
            if (AL::DMA) GLDS16(al.src(m0 + srow + 32 * i, scs * 8), bufA + dma_off + i * 4096);
            else ra[i] = al.load(m0 + srow + 32 * i, scs * 8);
        }
        if (!AL::DMA) {
#pragma unroll
            for (int i = 0; i < 4; ++i) *(u32x4*)(bufA + st_off + i * 4096) = al.finish(ra[i], m0 + srow + 32 * i, scs * 8);
        }
    }
    asm volatile("s_waitcnt vmcnt(0)" ::: "memory");
    __syncthreads();
    for (int kt = 0; kt < nk; ++kt) {
        char* bufA = smem + (kt & 1) * 32768; char* bufB = bufA + 16384;
        char* nA = smem + ((kt + 1) & 1) * 32768; char* nB = nA + 16384;
        const bool more = kt + 1 < nk; const int kn = (kt + 1) * 64 + scs * 8;
        if (more) {
#pragma unroll
            for (int i = 0; i < 4; ++i) {
                GLDS16(Bt + (size_t)brow[i] * K + kn, nB + dma_off + i * 4096);
                if (AL::DMA) GLDS16(al.src(m0 + srow + 32 * i, kn), nA + dma_off + i * 4096);
                else ra[i] = al.load(m0 + srow + 32 * i, kn);
            }
        }
#pragma unroll
        for (int ks = 0; ks < 2; ++ks) {
            bf16x8 af[4], bfr[4];
#pragma unroll
            for (int i = 0; i < 4; ++i) {
                af[i] = *(const bf16x8*)(bufA + ((fa0 + i * 2048) ^ (ks << 6)));
                bfr[i] = *(const bf16x8*)(bufB + ((fb0 + i * 2048) ^ (ks << 6)));
            }
#pragma unroll
            for (int i = 0; i < 4; ++i)
#pragma unroll
                for (int j = 0; j < 4; ++j) acc[i][j] = __builtin_amdgcn_mfma_f32_16x16x32_bf16(bfr[j], af[i], acc[i][j], 0, 0, 0);
        }
        if (more && !AL::DMA) {
#pragma unroll
            for (int i = 0; i < 4; ++i) *(u32x4*)(nA + st_off + i * 4096) = al.finish(ra[i], m0 + srow + 32 * i, kn);
        }
        asm volatile("s_waitcnt vmcnt(0)" ::: "memory");
        __syncthreads();
    }
#pragma unroll
    for (int mt = 0; mt < 4; ++mt)
#pragma unroll
        for (int gi = 0; gi < 2; ++gi) {
            float v[8];
#pragma unroll
            for (int r = 0; r < 4; ++r) { v[r] = acc[mt][2 * gi][r]; v[4 + r] = acc[mt][2 * gi + 1][r]; }
            epi(m0 + wr * 64 + mt * 16 + l15, n0 + wc * 64 + gi * 32 + 8 * q, v, mt, gi);
        }
    epi.finish(m0, n0, wr, wc, lane);
}

constexpr int G2_STAGE = 24576;
template <class AL, class Epi>
DI void gemm_tile2(const AL& al, const bf16* __restrict__ Bt, int K, int m0, int n0, const Epi& epi, char* smem) {
    const int tid = TIDX, lane = tid & 63, wave = __builtin_amdgcn_readfirstlane(tid >> 6), wr = wave >> 1, wc = wave & 1, q = lane >> 4, l15 = lane & 15;
    const int prow = tid >> 2, ppos = tid & 3, ca = (ppos - 2 * ((tid >> 4) & 3)) & 3;
    const int dma_off = wave * 1024;
    int brow[4];
#pragma unroll
    for (int i = 0; i < 4; ++i) { const int rho = prow + 64 * i; brow[i] = n0 + (rho & ~31) + perm32(rho & 31); }
    const int fpos = ((q + 2 * ((l15 >> 2) & 3)) & 3) << 4;
    const int fa0 = (wr * 64 + l15) * 64 + fpos, fb0 = 8192 + (wc * 128 + l15) * 64 + fpos;
    f32x4 acc[4][8];
#pragma unroll
    for (int i = 0; i < 4; ++i)
#pragma unroll
        for (int j = 0; j < 8; ++j) acc[i][j] = (f32x4){0.f, 0.f, 0.f, 0.f};
    typename AL::Raw ra[2];
    const int nk = K / 32;
#define G2_ISSUE(kt_) { char* st_ = smem + ((kt_) % 3) * G2_STAGE; const int kk_ = (kt_) * 32 + ca * 8; \
        _Pragma("unroll") for (int i = 0; i < 2; ++i) { if (AL::DMA) GLDS16(al.src(m0 + prow + 64 * i, kk_), st_ + dma_off + i * 4096); else ra[i] = al.load(m0 + prow + 64 * i, kk_); } \
        _Pragma("unroll") for (int i = 0; i < 4; ++i) GLDS16(Bt + (size_t)brow[i] * K + kk_, st_ + 8192 + dma_off + i * 4096); }
#define G2_AWRITE(kt_) { if (!AL::DMA) { char* st_ = smem + ((kt_) % 3) * G2_STAGE; const int kk_ = (kt_) * 32 + ca * 8; \
        _Pragma("unroll") for (int i = 0; i < 2; ++i) *(u32x4*)(st_ + (prow + 64 * i) * 64 + ppos * 16) = al.finish(ra[i], m0 + prow + 64 * i, kk_); } }
#define G2_BARRIER() { asm volatile("s_waitcnt lgkmcnt(0)" ::: "memory"); __builtin_amdgcn_s_barrier(); asm volatile("" ::: "memory"); }
    G2_ISSUE(0); G2_AWRITE(0);
    if (nk > 1) { G2_ISSUE(1); G2_AWRITE(1); }
    if (nk > 1) { if (AL::DMA) asm volatile("s_waitcnt vmcnt(6)" ::: "memory"); else asm volatile("s_waitcnt vmcnt(4)" ::: "memory"); } else asm volatile("s_waitcnt vmcnt(0)" ::: "memory");
    G2_BARRIER();
    for (int kt = 0; kt < nk; ++kt) {
        const char* st = smem + (kt % 3) * G2_STAGE;
        const bool more = kt + 2 < nk;
        if (more) G2_ISSUE(kt + 2);
        bf16x8 af[4];
#pragma unroll
        for (int i = 0; i < 4; ++i) af[i] = *(const bf16x8*)(st + fa0 + i * 1024);
#pragma unroll
        for (int j = 0; j < 8; ++j) {
            const bf16x8 bf_ = *(const bf16x8*)(st + fb0 + j * 1024);
#pragma unroll
            for (int i = 0; i < 4; ++i) acc[i][j] = __builtin_amdgcn_mfma_f32_16x16x32_bf16(bf_, af[i], acc[i][j], 0, 0, 0);
        }
        if (more) G2_AWRITE(kt + 2);
        if (more) { if (AL::DMA) asm volatile("s_waitcnt vmcnt(6)" ::: "memory"); else asm volatile("s_waitcnt vmcnt(4)" ::: "memory"); } else asm volatile("s_waitcnt vmcnt(0)" ::: "memory");
        G2_BARRIER();
    }
#undef G2_ISSUE
#undef G2_AWRITE
#undef G2_BARRIER
#pragma unroll
    for (int mt = 0; mt < 4; ++mt)
#pragma unroll
        for (int gi = 0; gi < 4; ++gi) {
            float v[8];
#pragma unroll
            for (int r = 0; r < 4; ++r) { v[r] = acc[mt][2 * gi][r]; v[4 + r] = acc[mt][2 * gi + 1][r]; }
            epi(m0 + wr * 64 + mt * 16 + l15, n0 + wc * 128 + gi * 32 + 8 * q, v, mt, gi);
        }
    epi.finish_wide(m0, n0, wr, wc, lane);
}
template <class F>
DI void gemm_sched(int nbig, int nsmall, F&& f) {
    const int x = blockIdx.x & 7, lb = blockIdx.x >> 3, nlb = gridDim.x >> 3;
    const int nb16 = 16 * nbig, tot = 16 * (nbig + nsmall);
    for (int s = lb; s < tot; s += nlb) {
        if (s < nb16) f(true, x * 16 + (s & 15), s >> 4);
        else { const int t = s - nb16; f(false, x * 16 + (t & 15), t >> 4); }
    }
}

DI float rstd_from_parts(const float* parts, int m) {
    const float4* p = (const float4*)(parts + (size_t)m * 16); float s = 0.f;
#pragma unroll
    for (int i = 0; i < 4; ++i) { const float4 v = p[i]; s += (v.x + v.y) + (v.z + v.w); }
    return 1.0f / sqrtf(s * (1.0f / D) + 1e-6f);
}
DI void store8bf(bf16* p, const float* v) { *(u32x4*)p = (u32x4){pack2bf(v[0], v[1]), pack2bf(v[2], v[3]), pack2bf(v[4], v[5]), pack2bf(v[6], v[7])}; }

struct EpiBf16 {
    bf16* P; int ldp; const float* parts; mutable float rsc[4];
    DI void operator()(int m, int n, const float* v, int mt, int gi) const {
        if (gi == 0) rsc[mt] = parts ? rstd_from_parts(parts, m) : 1.0f;
        float s = rsc[mt]; float w[8];
#pragma unroll
        for (int j = 0; j < 8; ++j) w[j] = v[j] * s;
        store8bf(P + (size_t)m * ldp + n, w);
    }
    DI void finish(int, int, int, int, int) const {}
    DI void finish_wide(int, int, int, int, int) const {}
};
struct EpiResid {
    const float* xin; float* xout; bf16* xb; float* parts; mutable float sq[4];
    DI void operator()(int m, int n, const float* v, int mt, int gi) const {
        const float4* xi = (const float4*)(xin + (size_t)m * D + n); const float4 a = xi[0], b = xi[1];
        float w[8] = {a.x + v[0], a.y + v[1], a.z + v[2], a.w + v[3], b.x + v[4], b.y + v[5], b.z + v[6], b.w + v[7]};
        float4* xo = (float4*)(xout + (size_t)m * D + n);
        xo[0] = make_float4(w[0], w[1], w[2], w[3]); xo[1] = make_float4(w[4], w[5], w[6], w[7]);
        if (xb) store8bf(xb + (size_t)m * D + n, w);
        float s = 0.f;
#pragma unroll
        for (int j = 0; j < 8; ++j) s += w[j] * w[j];
        if (gi == 0) sq[mt] = s; else sq[mt] += s;
    }
    DI void finish(int m0, int n0, int wr, int wc, int lane) const {
#pragma unroll
        for (int mt = 0; mt < 4; ++mt) {
            float s = sq[mt]; s += __shfl_xor(s, 16); s += __shfl_xor(s, 32);
            if (lane < 16) parts[(size_t)(m0 + wr * 64 + mt * 16 + lane) * 16 + (n0 >> 7) * 2 + wc] = s;
        }
    }
    DI void finish_wide(int m0, int n0, int wr, int wc, int lane) const {
#pragma unroll
        for (int mt = 0; mt < 4; ++mt) {
            float s = sq[mt]; s += __shfl_xor(s, 16); s += __shfl_xor(s, 32);
            if (lane < 16) { float* pr = parts + (size_t)(m0 + wr * 64 + mt * 16 + lane) * 16 + (n0 >> 7) + wc; pr[0] = s; pr[8] = 0.f; }
        }
    }
};
struct EpiRwkv {
    bf16* P; float* hw; float* ha;
    DI void operator()(int m, int n, const float* v, int, int) const {
        if (n < 4096) { store8bf(P + (size_t)m * 4096 + n, v); return; }
        const int c = n - 4096;
        if (c < 64) { float4* o = (float4*)(hw + (size_t)m * 64 + c); o[0] = make_float4(tanhf(v[0]), tanhf(v[1]), tanhf(v[2]), tanhf(v[3])); o[1] = make_float4(tanhf(v[4]), tanhf(v[5]), tanhf(v[6]), tanhf(v[7])); }
        else if (c >= 128 && c < 192) { float4* o = (float4*)(ha + (size_t)m * 64 + (c - 128)); o[0] = make_float4(v[0], v[1], v[2], v[3]); o[1] = make_float4(v[4], v[5], v[6], v[7]); }
    }
    DI void finish(int, int, int, int, int) const {}
    DI void finish_wide(int, int, int, int, int) const {}
};

namespace at {
constexpr int OFF_BIAS = 49152;
constexpr int OFF_X = 61952;
constexpr int OFF_IMP = 49152;
constexpr float L2E = 1.4426950408889634f;
constexpr float NEG_MASK = -1e30f, M_INIT = -1e20f;
}
enum { AM_SWA = 0, AM_WIN = 1, AM_CMP = 2, AM_SEL = 3 };
DI int vt_perm(int k32) { return ((k32 & 15) >> 2) * 8 + (k32 >> 4) * 4 + (k32 & 3); }
DI float fast_exp2(float x) { return __builtin_amdgcn_exp2f(x); }

DI void build_bias_lut(const float* __restrict__ t5, char* smem, bool swa) {
    float* lut = (float*)(smem + at::OFF_BIAS);
    for (int i = TIDX; i < 16 * 200; i += NTHREADS) {
        const int h = i / 200, e = i % 200; float v = at::NEG_MASK;
        if (e >= 64 && e < 192) v = t5[t5_bucket(e - 64) * 16 + h] * at::L2E;
        else if (e >= 192 && !swa) v = t5[31 * 16 + h] * at::L2E;
        lut[i] = v;
    }
    __syncthreads();
}

template <int NQT> struct AttnStateT { f32x4 o[NQT][4]; f32x4 lacc[NQT]; float m[NQT]; };
#ifndef ANQT_SWA
#define ANQT_SWA 4
#endif
#ifndef ANQT_WIN
#define ANQT_WIN 2
#endif
#ifndef ANQT_SEL
#define ANQT_SEL 4
#endif
DI unsigned long long range_mask(int lo, int hi) { return (hi >= 63 ? ~0ull : ((1ull << (hi + 1)) - 1ull)) & ~((1ull << lo) - 1ull); }

template <int NQT>
DI void attn_load_q(bf16x8 (&qf)[NQT][2], const bf16* __restrict__ Qp, int ldq, size_t mbase, int hbase) {
    const int lane = TIDX & 63, wave = TIDX >> 6, q = lane >> 4, l15 = lane & 15;
#pragma unroll
    for (int qt = 0; qt < NQT; ++qt) {
        const size_t m = mbase + wave * (4 * NQT) + qt * 4 + (l15 >> 2);
#pragma unroll
        for (int ks = 0; ks < 2; ++ks) qf[qt][ks] = *(const bf16x8*)(Qp + m * ldq + (hbase + (l15 & 3)) * 64 + ks * 32 + q * 8);
    }
}

enum { SK_FAR = 0, SK_NEAR = 1, SK_EDGE = 2, SK_CMP = 3 };
template <int KIND>
DI float attn_fix(f32x4 (&s)[4], int dbase, float cadd, const float* __restrict__ bl, float mx) {
#pragma unroll
    for (int kt = 0; kt < 4; ++kt)
#pragma unroll
        for (int r = 0; r < 4; ++r) {
            float v = s[kt][r]; const int dist = dbase - (kt * 16 + r);
            if (KIND == SK_NEAR) { int idx = dist + 64; idx = idx < 0 ? 0 : (idx > 192 ? 192 : idx); v += bl[idx] + cadd; }
            else if (KIND == SK_EDGE) v = dist < 512 ? v + cadd : at::NEG_MASK;
            else if (KIND == SK_CMP) v = dist >= 0 ? v : at::NEG_MASK;
            if (KIND != SK_FAR) s[kt][r] = v;
            mx = fmaxf(mx, v);
        }
    return mx;
}
template <int MODE, int NQT>
DI void attn_blocks(AttnStateT<NQT>& st, const bf16x8 (&qf)[NQT][2], const bf16* __restrict__ Kp, size_t krs, const bf16* __restrict__ Vp, size_t vrs,
                    int t0, unsigned long long todo, int hbase, const unsigned long long (&sel)[NQT], char* smem) {
    const int tid = TIDX, lane = tid & 63, wave = __builtin_amdgcn_readfirstlane(tid >> 6), q = lane >> 4, l15 = lane & 15;
    const int tq0 = t0 + wave * (4 * NQT) + (l15 >> 2);
    const float* bl = (const float*)(smem + at::OFF_BIAS) + (hbase + (l15 & 3)) * 200;
    const float bfar = (MODE != AM_CMP) ? bl[192] : 0.f;
    const int srow = tid >> 3, scs = (tid & 7) ^ (srow & 7);
    const int fo = l15 * 128 + ((q ^ (l15 & 7)) << 4);
#define ATT_DMA(kb_, slot_) { _Pragma("unroll") for (int i = 0; i < 2; ++i) { const int row = srow + 32 * i; char* dst = smem + (slot_) * 16384 + (8 * wave + 32 * i) * 128; \
        GLDS16(Kp + (size_t)((kb_) * 64 + row) * krs + scs * 8, dst); GLDS16(Vp + (size_t)row * vrs + (kb_) * 64 + scs * 8, dst + 8192); } }
#define ATT_BARRIER() { asm volatile("s_waitcnt lgkmcnt(0)" ::: "memory"); __builtin_amdgcn_s_barrier(); asm volatile("" ::: "memory"); }
    if (todo == 0ull) return;
    int kb = __builtin_ctzll(todo); todo &= todo - 1ull;
    int kb1 = -1; if (todo) { kb1 = __builtin_ctzll(todo); todo &= todo - 1ull; }
    ATT_DMA(kb, 0);
    if (kb1 >= 0) { ATT_DMA(kb1, 1); asm volatile("s_waitcnt vmcnt(4)" ::: "memory"); } else { asm volatile("s_waitcnt vmcnt(0)" ::: "memory"); }
    ATT_BARRIER();
    int slot = 0;
    for (;;) {
        char* buf = smem + slot * 16384;
        int kb2 = -1; if (todo) { kb2 = __builtin_ctzll(todo); todo &= todo - 1ull; }
        if (kb2 >= 0) { const int s2 = slot >= 1 ? slot - 1 : 2; ATT_DMA(kb2, s2); }
        f32x4 s[NQT][4];
#pragma unroll
        for (int qt = 0; qt < NQT; ++qt)
#pragma unroll
            for (int kt = 0; kt < 4; ++kt) s[qt][kt] = (f32x4){0.f, 0.f, 0.f, 0.f};
#pragma unroll
        for (int kt = 0; kt < 4; ++kt)
#pragma unroll
            for (int ks = 0; ks < 2; ++ks) {
                const bf16x8 kf = *(const bf16x8*)(buf + ((fo + kt * 2048) ^ (ks << 6)));
#pragma unroll
                for (int qt = 0; qt < NQT; ++qt) s[qt][kt] = __builtin_amdgcn_mfma_f32_16x16x32_bf16(kf, qf[qt][ks], s[qt][kt], 0, 0, 0);
            }
        const int mind = (t0 + wave * (4 * NQT)) - (kb * 64 + 63), maxd = (t0 + wave * (4 * NQT) + 4 * NQT - 1) - kb * 64;
        float mx[NQT], cofs[NQT];
#pragma unroll
        for (int qt = 0; qt < NQT; ++qt) cofs[qt] = 0.f;
        if (MODE == AM_CMP) {
#pragma unroll
            for (int qt = 0; qt < NQT; ++qt) { const int nlim = (tq0 + 4 * qt - 31) >> 4; mx[qt] = attn_fix<SK_CMP>(s[qt], nlim - (kb * 64 + 4 * q), 0.f, bl, at::NEG_MASK); }
        } else {
            float cadd[NQT];
#pragma unroll
            for (int qt = 0; qt < NQT; ++qt) cadd[qt] = (MODE == AM_SEL && !((sel[qt] >> kb) & 1ull)) ? at::NEG_MASK : 0.f;
            if (MODE == AM_SWA || mind < 113) {
#pragma unroll
                for (int qt = 0; qt < NQT; ++qt) mx[qt] = attn_fix<SK_NEAR>(s[qt], tq0 + 4 * qt - (kb * 64 + 4 * q), cadd[qt], bl, at::NEG_MASK);
            } else if (MODE == AM_WIN && maxd >= 512) {
#pragma unroll
                for (int qt = 0; qt < NQT; ++qt) mx[qt] = attn_fix<SK_EDGE>(s[qt], tq0 + 4 * qt - (kb * 64 + 4 * q), bfar, bl, at::NEG_MASK);
            } else {
#pragma unroll
                for (int qt = 0; qt < NQT; ++qt) { cofs[qt] = bfar + cadd[qt]; mx[qt] = attn_fix<SK_FAR>(s[qt], 0, 0.f, bl, at::NEG_MASK) + cofs[qt]; }
            }
        }
        float msub[NQT]; bool grow = false;
#pragma unroll
        for (int qt = 0; qt < NQT; ++qt) {
            float m2 = mx[qt];
            m2 = fmaxf(m2, __shfl_xor(m2, 16)); m2 = fmaxf(m2, __shfl_xor(m2, 32));
            const bool g = m2 > st.m[qt] + 4.0f; grow |= g;
            mx[qt] = g ? m2 : st.m[qt];
            msub[qt] = mx[qt] - cofs[qt];
        }
        if (__any(grow)) {
#pragma unroll
            for (int qt = 0; qt < NQT; ++qt) {
                const float alpha = fast_exp2(st.m[qt] - mx[qt]);
#pragma unroll
                for (int dt = 0; dt < 4; ++dt) st.o[qt][dt] *= alpha;
                st.lacc[qt] *= alpha;
            }
        }
#pragma unroll
        for (int qt = 0; qt < NQT; ++qt) st.m[qt] = mx[qt];
#pragma unroll
        for (int qt = 0; qt < NQT; ++qt)
#pragma unroll
            for (int kt = 0; kt < 4; ++kt)
#pragma unroll
                for (int r = 0; r < 4; ++r) s[qt][kt][r] = fast_exp2(s[qt][kt][r] - msub[qt]);
        const bf16x8 ones = {(short)0x3F80, (short)0x3F80, (short)0x3F80, (short)0x3F80, (short)0x3F80, (short)0x3F80, (short)0x3F80, (short)0x3F80};
#pragma unroll
        for (int kp = 0; kp < 2; ++kp) {
            bf16x8 pf[NQT];
#pragma unroll
            for (int qt = 0; qt < NQT; ++qt) {
                const u32x4 w = {pack2bf(s[qt][2 * kp][0], s[qt][2 * kp][1]), pack2bf(s[qt][2 * kp][2], s[qt][2 * kp][3]),
                                 pack2bf(s[qt][2 * kp + 1][0], s[qt][2 * kp + 1][1]), pack2bf(s[qt][2 * kp + 1][2], s[qt][2 * kp + 1][3])};
                pf[qt] = __builtin_bit_cast(bf16x8, w);
            }
#pragma unroll
            for (int qt = 0; qt < NQT; ++qt) st.lacc[qt] = __builtin_amdgcn_mfma_f32_16x16x32_bf16(ones, pf[qt], st.lacc[qt], 0, 0, 0);
#pragma unroll
            for (int dt = 0; dt < 4; ++dt) {
                const bf16x8 vf = *(const bf16x8*)(buf + 8192 + ((fo + dt * 2048) ^ (kp << 6)));
#pragma unroll
                for (int qt = 0; qt < NQT; ++qt) st.o[qt][dt] = __builtin_amdgcn_mfma_f32_16x16x32_bf16(vf, pf[qt], st.o[qt][dt], 0, 0, 0);
            }
        }
        if (kb1 < 0) break;
        if (kb2 >= 0) { asm volatile("s_waitcnt vmcnt(4)" ::: "memory"); } else { asm volatile("s_waitcnt vmcnt(0)" ::: "memory"); }
        ATT_BARRIER();
        kb = kb1; kb1 = kb2; slot = slot == 2 ? 0 : slot + 1;
    }
    ATT_BARRIER();
#undef ATT_DMA
}
template <int NQT>
DI void attn_init(AttnStateT<NQT>& st, float m0, float l0) {
#pragma unroll
    for (int qt = 0; qt < NQT; ++qt) { st.m[qt] = m0; st.lacc[qt] = (f32x4){l0, l0, l0, l0};
#pragma unroll
        for (int dt = 0; dt < 4; ++dt) st.o[qt][dt] = (f32x4){0.f, 0.f, 0.f, 0.f}; }
}
DI float attn_linv(const f32x4& lacc) { const float l = lacc[0]; return l > 0.f ? 1.0f / l : 0.f; }

template <int TT>
DI void attn_item_decode(int item, int& b, int& g, int& t0) {
    constexpr int tiles = T / TT;
    const int Gd = (int)gridDim.x;
    int pair, tile;
    if ((Gd % tiles) == 0 && tiles * B * G % Gd == 0) {
        const int bid = item % Gd, rr = item / Gd, tau = bid % tiles;
        pair = bid / tiles + (Gd / tiles) * rr; tile = (rr & 1) ? tiles - 1 - tau : tau;
    } else { tile = item % tiles; pair = item / tiles; }
    t0 = tile * TT; g = pair % G; b = pair / G;
}
DI void swa_item(const bf16* __restrict__ P0, const bf16* __restrict__ VT, const float* __restrict__ sinks, bf16* __restrict__ AO, int item, char* smem) {
    constexpr int LDP = 2304;
    constexpr int NQT = ANQT_SWA;
    int b, g, t0; attn_item_decode<16 * NQT>(item, b, g, t0);
    const int lane = TIDX & 63, wave = TIDX >> 6, q = lane >> 4, l15 = lane & 15;
    const size_t mbase = (size_t)b * T + t0; const int hbase = g * 4, h = hbase + (l15 & 3);
    bf16x8 qf[NQT][2]; attn_load_q<NQT>(qf, P0, LDP, mbase, hbase);
    AttnStateT<NQT> st; attn_init<NQT>(st, sinks[h] * at::L2E, 1.0f);
    const int lo = t0 - 127 < 0 ? 0 : (t0 - 127) >> 6, hi = (t0 + 16 * NQT - 1) >> 6;
    const unsigned long long nosel[NQT] = {};
    attn_blocks<AM_SWA, NQT>(st, qf, P0 + (size_t)b * T * LDP + 1024 + g * 64, LDP, VT + (size_t)(b * G + g) * 64 * T, T, t0, range_mask(lo, hi), hbase, nosel, smem);
#pragma unroll
    for (int qt = 0; qt < NQT; ++qt) {
        const float li = attn_linv(st.lacc[qt]); const size_t m = mbase + wave * (4 * NQT) + qt * 4 + (l15 >> 2);
#pragma unroll
        for (int dt = 0; dt < 4; ++dt) {
            const int d0 = dt * 16 + 4 * q; const u32x2 zz = *(const u32x2*)(P0 + m * LDP + 1280 + h * 64 + d0);
            const float z0 = bflo(zz[0]), z1 = bfhi(zz[0]), z2 = bflo(zz[1]), z3 = bfhi(zz[1]);
            const f32x4 o = st.o[qt][dt];
            *(u32x2*)(AO + m * D + h * 64 + d0) = (u32x2){pack2bf(o[0] * li * siluf_(z0), o[1] * li * siluf_(z1)), pack2bf(o[2] * li * siluf_(z2), o[3] * li * siluf_(z3))};
        }
    }
}

struct EpiL0 {
    bf16* P0; bf16* VT; const float* parts; mutable float rsc[4];
    DI void operator()(int m, int n, const float* v, int mt, int gi) const {
        if (gi == 0) rsc[mt] = rstd_from_parts(parts, m);
        float s = rsc[mt]; if (n < 1024) s *= 0.125f * at::L2E; float w[8];
#pragma unroll
        for (int j = 0; j < 8; ++j) w[j] = v[j] * s;
        if (n < 1280) store8bf(P0 + (size_t)m * 2304 + n, w);
        else if (n >= 1536) store8bf(P0 + (size_t)m * 2304 + n - 256, w);
        else {
            const int g = (n - 1280) >> 6, d = (n - 1280) & 63, b = m / T, t = m % T; const int pos = (t & ~31) + vt_perm(t & 31);
            bf16* dst = VT + ((size_t)(b * G + g) * 64 + d) * T + pos;
#pragma unroll
            for (int j = 0; j < 8; ++j) dst[(size_t)j * T] = f2bf(w[j]);
        }
    }
    DI void finish(int, int, int, int, int) const {}
    DI void finish_wide(int, int, int, int, int) const {}
};

constexpr int LDP2 = 3200;
struct EpiL2 {
    bf16* P2; bf16* VTs; bf16* VTw; const float* parts; mutable float rsc[4];
    DI void operator()(int m, int n, const float* v, int mt, int gi) const {
        if (gi == 0) rsc[mt] = rstd_from_parts(parts, m);
        if (n >= C_COLS) return;
        float s = rsc[mt]; if (n < 1024) s *= 0.125f * at::L2E; float w[8];
#pragma unroll
        for (int j = 0; j < 8; ++j) w[j] = v[j] * s;
        const bool isvs = n >= 1792 && n < 2048, isvw = n >= 2304 && n < 2560;
        if (isvs || isvw) {
            const int c = n - (isvs ? 1792 : 2304); const int g = c >> 6, d = c & 63, b = m / T, t = m % T; const int pos = (t & ~31) + vt_perm(t & 31);
            bf16* dst = (isvs ? VTs : VTw) + ((size_t)(b * G + g) * 64 + d) * T + pos;
#pragma unroll
            for (int j = 0; j < 8; ++j) dst[(size_t)j * T] = f2bf(w[j]);
        } else {
            const int c = n < 1792 ? n : (n < 2304 ? n - 256 : n - 512);
            store8bf(P2 + (size_t)m * LDP2 + c, w);
        }
    }
    DI void finish(int, int, int, int, int) const {}
    DI void finish_wide(int, int, int, int, int) const {}
};

struct ALoadCmp {
    const bf16* P2; int col;
    static constexpr bool DMA = true;
    DI const bf16* src(int row, int k) const {
        int n = row & 255; const int bg = row >> 8, b = bg >> 2, g = bg & 3; const int l = k >> 6, d = k & 63; n = n < NCMP ? n : NCMP - 1;
        return P2 + (size_t)(b * T + 16 * n + l) * LDP2 + col + g * 64 + d;
    }
    struct Raw { u32x4 v; };
    DI Raw load(int row, int k) const {
        const int n = row & 255, bg = row >> 8, b = bg >> 2, g = bg & 3; const int l = k >> 6, d = k & 63; Raw r;
        if (n < NCMP) r.v = *(const u32x4*)(P2 + (size_t)(b * T + 16 * n + l) * LDP2 + col + g * 64 + d); else r.v = (u32x4){0u, 0u, 0u, 0u};
        return r;
    }
    DI u32x4 finish(const Raw& r, int, int) const { return r.v; }
};
struct EpiCmpH {
    char* smem; const float* bias8;
    DI void operator()(int m, int n, const float* v, int, int) const {
        const int row = m & 127; float w[8];
#pragma unroll
        for (int j = 0; j < 8; ++j) { float bsum = 0.f;
#pragma unroll
            for (int i = 0; i < 8; ++i) bsum += bias8[i * 128 + n + j];
            w[j] = siluf_(v[j] + bsum); }
        const int kk = n >> 6, c = (n & 63) >> 3;
        *(u32x4*)(smem + kk * 16384 + row * 128 + ((c ^ (row & 7)) << 4)) = (u32x4){pack2bf(w[0], w[1]), pack2bf(w[2], w[3]), pack2bf(w[4], w[5]), pack2bf(w[6], w[7])};
    }
    DI void finish(int, int, int, int, int) const {}
    DI void finish_wide(int, int, int, int, int) const {}
};
DI void cmp_tile(const bf16* __restrict__ P2, const bf16* __restrict__ w1t, const float* __restrict__ bias8, const bf16* __restrict__ w2t, int which, int rt,
                 bf16* __restrict__ KCb, bf16* __restrict__ VCT, char* smem) {
    gemm_tile(ALoadCmp{P2, which ? 1280 : 1024}, w1t, 2048, rt * 128, 0, EpiCmpH{smem, bias8}, smem);
    const int tid = TIDX, lane = tid & 63, wave = tid >> 6, q = lane >> 4, l15 = lane & 15;
#pragma unroll
    for (int i = 0; i < 4; ++i) {
        const int id = i * 256 + tid; const int row = id >> 4, c16 = id & 15, kk = c16 >> 3, c = c16 & 7;
        *(u32x4*)(smem + 32768 + kk * 8192 + row * 128 + ((c ^ (row & 7)) << 4)) = *(const u32x4*)(w2t + (size_t)row * 128 + c16 * 8);
    }
    __syncthreads();
    f32x4 acc[2][4];
#pragma unroll
    for (int i = 0; i < 2; ++i)
#pragma unroll
        for (int j = 0; j < 4; ++j) acc[i][j] = (f32x4){0.f, 0.f, 0.f, 0.f};
    const int fo = l15 * 128 + ((q ^ (l15 & 7)) << 4);
#pragma unroll
    for (int kk = 0; kk < 2; ++kk)
#pragma unroll
        for (int ks = 0; ks < 2; ++ks) {
            bf16x8 hf[2], wf[4];
#pragma unroll
            for (int i = 0; i < 2; ++i) hf[i] = *(const bf16x8*)(smem + kk * 16384 + (((wave * 32 + i * 16) * 128 + fo) ^ (ks << 6)));
#pragma unroll
            for (int j = 0; j < 4; ++j) wf[j] = *(const bf16x8*)(smem + 32768 + kk * 8192 + ((j * 2048 + fo) ^ (ks << 6)));
#pragma unroll
            for (int i = 0; i < 2; ++i)
#pragma unroll
                for (int j = 0; j < 4; ++j) acc[i][j] = __builtin_amdgcn_mfma_f32_16x16x32_bf16(wf[j], hf[i], acc[i][j], 0, 0, 0);
        }
#pragma unroll
    for (int i = 0; i < 2; ++i) {
        const int row = rt * 128 + wave * 32 + i * 16 + l15; const int n = row & 255, bg = row >> 8;
#pragma unroll
        for (int j = 0; j < 4; ++j) {
            const int d0 = j * 16 + 4 * q; const f32x4 a = acc[i][j];
            if (which == 0) *(u32x2*)(KCb + (size_t)row * 64 + d0) = (u32x2){pack2bf(a[0], a[1]), pack2bf(a[2], a[3])};
            else {
                const int pos = (n & ~31) + vt_perm(n & 31);
#pragma unroll
                for (int r = 0; r < 4; ++r) VCT[((size_t)bg * 64 + d0 + r) * 256 + pos] = f2bf(a[r]);
            }
        }
    }
    __syncthreads();
}

DI void win_item(const bf16* __restrict__ P2, const bf16* __restrict__ VTw, bf16* __restrict__ OW, int item, char* smem) {
    constexpr int NQT = ANQT_WIN;
    int b, g, t0; attn_item_decode<16 * NQT>(item, b, g, t0);
    const int lane = TIDX & 63, wave = TIDX >> 6, q = lane >> 4, l15 = lane & 15;
    const size_t mbase = (size_t)b * T + t0; const int hbase = g * 4, h = hbase + (l15 & 3);
    bf16x8 qf[NQT][2]; attn_load_q<NQT>(qf, P2, LDP2, mbase, hbase);
    AttnStateT<NQT> st; attn_init<NQT>(st, at::M_INIT, 0.f);
    const int lo = t0 - 511 < 0 ? 0 : (t0 - 511) >> 6, hi = (t0 + 16 * NQT - 1) >> 6;
    const unsigned long long nosel[NQT] = {};
    attn_blocks<AM_WIN, NQT>(st, qf, P2 + (size_t)b * T * LDP2 + 1792 + g * 64, LDP2, VTw + (size_t)(b * G + g) * 64 * T, T, t0, range_mask(lo, hi), hbase, nosel, smem);
#pragma unroll
    for (int qt = 0; qt < NQT; ++qt) {
        const float li = attn_linv(st.lacc[qt]); const size_t m = mbase + wave * (4 * NQT) + qt * 4 + (l15 >> 2);
#pragma unroll
        for (int dt = 0; dt < 4; ++dt) { const f32x4 o = st.o[qt][dt]; *(u32x2*)(OW + m * D + h * 64 + dt * 16 + 4 * q) = (u32x2){pack2bf(o[0] * li, o[1] * li), pack2bf(o[2] * li, o[3] * li)}; }
    }
}

DI void cmpsel_item(const bf16* __restrict__ P2, const bf16* __restrict__ KCb, const bf16* __restrict__ VCT, bf16* __restrict__ OC, unsigned long long* __restrict__ SELM, int item, char* smem) {
    int b, g, t0; attn_item_decode<32>(item, b, g, t0);
    const int tid = TIDX, lane = tid & 63, wave = tid >> 6, q = lane >> 4, l15 = lane & 15;
    const size_t mbase = (size_t)b * T + t0; const int hbase = g * 4, h = hbase + (l15 & 3);
    float* impL = (float*)(smem + at::OFF_IMP);
    for (int i = tid; i < 32 * 64; i += NTHREADS) impL[i] = 0.f;
    bf16x8 qf[2][2]; attn_load_q<2>(qf, P2, LDP2, mbase, hbase);
    AttnStateT<2> st; attn_init<2>(st, at::M_INIT, 0.f);
    const int nvmax = (t0 + 31 - 31) / 16 + 1;
    const int hi = (nvmax - 1) >> 6;
    const bf16* Kp = KCb + (size_t)(b * G + g) * 256 * 64; const bf16* Vp = VCT + (size_t)(b * G + g) * 64 * 256;
    const unsigned long long nosel[2] = {0ull, 0ull};
    attn_blocks<AM_CMP, 2>(st, qf, Kp, 64, Vp, 256, t0, range_mask(0, hi), hbase, nosel, smem);
    float linv[2];
#pragma unroll
    for (int qt = 0; qt < 2; ++qt) {
        linv[qt] = attn_linv(st.lacc[qt]); const size_t m = mbase + wave * 8 + qt * 4 + (l15 >> 2);
#pragma unroll
        for (int dt = 0; dt < 4; ++dt) { const f32x4 o = st.o[qt][dt]; *(u32x2*)(OC + m * D + h * 64 + dt * 16 + 4 * q) = (u32x2){pack2bf(o[0] * linv[qt], o[1] * linv[qt]), pack2bf(o[2] * linv[qt], o[3] * linv[qt])}; }
    }
    {
        const int srow = tid >> 3, sc = tid & 7; const int st_off = srow * 128 + ((sc ^ (srow & 7)) << 4); const int fo = l15 * 128 + ((q ^ (l15 & 7)) << 4);
        const int tq0 = t0 + wave * 8 + (l15 >> 2);
        for (int kb = 0; kb <= hi; ++kb) {
#pragma unroll
            for (int i = 0; i < 2; ++i) { const int row = srow + 32 * i; *(u32x4*)(smem + st_off + i * 4096) = *(const u32x4*)(Kp + (size_t)(kb * 64 + row) * 64 + sc * 8); }
            __syncthreads();
            f32x4 s[2][4];
#pragma unroll
            for (int qt = 0; qt < 2; ++qt)
#pragma unroll
                for (int kt = 0; kt < 4; ++kt) s[qt][kt] = (f32x4){0.f, 0.f, 0.f, 0.f};
#pragma unroll
            for (int kt = 0; kt < 4; ++kt)
#pragma unroll
                for (int ks = 0; ks < 2; ++ks) {
                    const bf16x8 kf = *(const bf16x8*)(smem + ((fo + kt * 2048) ^ (ks << 6)));
                    s[0][kt] = __builtin_amdgcn_mfma_f32_16x16x32_bf16(kf, qf[0][ks], s[0][kt], 0, 0, 0);
                    s[1][kt] = __builtin_amdgcn_mfma_f32_16x16x32_bf16(kf, qf[1][ks], s[1][kt], 0, 0, 0);
                }
#pragma unroll
            for (int qt = 0; qt < 2; ++qt) {
                const int tq = tq0 + 4 * qt; const int tl = wave * 8 + qt * 4 + (l15 >> 2);
#pragma unroll
                for (int kt = 0; kt < 4; ++kt) {
                    float pr[4];
#pragma unroll
                    for (int r = 0; r < 4; ++r) { const int key = kb * 64 + kt * 16 + 4 * q + r; pr[r] = (16 * key + 31 <= tq) ? fast_exp2(s[qt][kt][r] - st.m[qt]) * linv[qt] : 0.f; }
                    float s4 = (pr[0] + pr[1]) + (pr[2] + pr[3]), s1 = pr[3];
                    s4 += __shfl_xor(s4, 1); s4 += __shfl_xor(s4, 2); s1 += __shfl_xor(s1, 1); s1 += __shfl_xor(s1, 2);
                    const int s0 = kb * 16 + kt * 4 + q;
                    if ((l15 & 3) == 0) { atomicAdd(&impL[tl * 64 + s0], s4); if (s0 + 1 < 64) atomicAdd(&impL[tl * 64 + s0 + 1], s1); }
                }
            }
            __syncthreads();
        }
    }
    {
        const int tl = tid >> 3, sg = tid & 7; const int t = t0 + tl, cur = t >> 6; float* row = impL + tl * 64;
        float mine[8];
#pragma unroll
        for (int j = 0; j < 8; ++j) { const int s = sg * 8 + j; mine[j] = (s == 0 || s == cur || s == cur - 1) ? 1e30f : (s * 64 > t ? -1e30f : row[s]); }
        __syncthreads();
#pragma unroll
        for (int j = 0; j < 8; ++j) row[sg * 8 + j] = mine[j];
        __syncthreads();
        int rank[8] = {0, 0, 0, 0, 0, 0, 0, 0};
#pragma unroll 4
        for (int s4 = 0; s4 < 16; ++s4) {
            const float4 v4 = *(const float4*)(row + s4 * 4); const float vv[4] = {v4.x, v4.y, v4.z, v4.w};
#pragma unroll
            for (int e = 0; e < 4; ++e) { const int s2 = s4 * 4 + e;
#pragma unroll
                for (int j = 0; j < 8; ++j) rank[j] += (vv[e] > mine[j] || (vv[e] == mine[j] && s2 < sg * 8 + j)) ? 1 : 0; }
        }
        unsigned long long bits = 0ull;
#pragma unroll
        for (int j = 0; j < 8; ++j) if (rank[j] < KTOP) bits |= 1ull << (sg * 8 + j);
        unsigned lo = (unsigned)bits, hi2 = (unsigned)(bits >> 32);
#pragma unroll
        for (int o = 1; o < 8; o <<= 1) { lo |= __shfl_xor(lo, o); hi2 |= __shfl_xor(hi2, o); }
        if (sg == 0) SELM[(mbase + tl) * 4 + g] = ((unsigned long long)hi2 << 32) | lo;
    }
    __syncthreads();
}

DI void sel_item(const bf16* __restrict__ P2, const bf16* __restrict__ VTs, const unsigned long long* __restrict__ SELM, const bf16* __restrict__ OC, const bf16* __restrict__ OW,
                 bf16* __restrict__ AO, int item, char* smem) {
    constexpr int NQT = ANQT_SEL;
    int b, g, t0; attn_item_decode<16 * NQT>(item, b, g, t0);
    const int tid = TIDX, lane = tid & 63, wave = tid >> 6, q = lane >> 4, l15 = lane & 15;
    const size_t mbase = (size_t)b * T + t0; const int hbase = g * 4, rr = l15 & 3, h = hbase + rr;
    unsigned long long* orw = (unsigned long long*)(smem + at::OFF_X);
    if (tid == 0) *orw = 0ull;
    __syncthreads();
    if (tid < 16 * NQT) atomicOr(orw, SELM[(mbase + tid) * 4 + g]);
    unsigned long long sel[NQT];
#pragma unroll
    for (int qt = 0; qt < NQT; ++qt) sel[qt] = SELM[(mbase + wave * (4 * NQT) + qt * 4 + (l15 >> 2)) * 4 + g];
    bf16x8 qf[NQT][2]; attn_load_q<NQT>(qf, P2, LDP2, mbase, hbase);
    AttnStateT<NQT> st; attn_init<NQT>(st, at::M_INIT, 0.f);
    __syncthreads();
    const unsigned long long todo_v = (*orw) & range_mask(0, (t0 + 16 * NQT - 1) >> 6);
    const unsigned long long todo = ((unsigned long long)(unsigned)__builtin_amdgcn_readfirstlane((int)(todo_v >> 32)) << 32) | (unsigned)__builtin_amdgcn_readfirstlane((int)(unsigned)todo_v);
    attn_blocks<AM_SEL, NQT>(st, qf, P2 + (size_t)b * T * LDP2 + 1536 + g * 64, LDP2, VTs + (size_t)(b * G + g) * 64 * T, T, t0, todo, hbase, sel, smem);
#pragma unroll
    for (int qt = 0; qt < NQT; ++qt) {
        const float li = attn_linv(st.lacc[qt]); const size_t m = mbase + wave * (4 * NQT) + qt * 4 + (l15 >> 2);
        const bf16* gr = P2 + m * LDP2 + 3072;
        const float g0 = sigmoidf_(bf2f(gr[0 * 16 + h])), g1 = sigmoidf_(bf2f(gr[1 * 16 + h])), g2 = sigmoidf_(bf2f(gr[2 * 16 + h]));
#pragma unroll
        for (int dt = 0; dt < 4; ++dt) {
            const int d0 = dt * 16 + 4 * q; const size_t oi = m * D + h * 64 + d0;
            const u32x2 zz = *(const u32x2*)(P2 + m * LDP2 + 2048 + h * 64 + d0), cc = *(const u32x2*)(OC + oi), ww = *(const u32x2*)(OW + oi);
            const f32x4 o = st.o[qt][dt];
            const float r0 = (g0 * bflo(cc[0]) + g1 * o[0] * li + g2 * bflo(ww[0])) * siluf_(bflo(zz[0]));
            const float r1 = (g0 * bfhi(cc[0]) + g1 * o[1] * li + g2 * bfhi(ww[0])) * siluf_(bfhi(zz[0]));
            const float r2 = (g0 * bflo(cc[1]) + g1 * o[2] * li + g2 * bflo(ww[1])) * siluf_(bflo(zz[1]));
            const float r3 = (g0 * bfhi(cc[1]) + g1 * o[3] * li + g2 * bfhi(ww[1])) * siluf_(bfhi(zz[1]));
            *(u32x2*)(AO + oi) = (u32x2){pack2bf(r0, r1), pack2bf(r2, r3)};
        }
    }
    __syncthreads();
}

DI void lru_convert_gates(const float* __restrict__ gaw, const float* __restrict__ gxw, bf16* __restrict__ img) {
    for (int i = blockIdx.x * NTHREADS + TIDX; i < 16 * 160 * 96; i += gridDim.x * NTHREADS) {
        const int k = i % 96, n = (i / 96) % 160, blk = i / (96 * 160);
        float v = 0.f;
        if (k < 80) v = n < 80 ? gaw[((size_t)blk * 80 + k) * 80 + n] : gxw[((size_t)blk * 80 + k) * 80 + (n - 80)];
        img[i] = f2bf(v);
    }
}
DI void lru_gate_item(const bf16* __restrict__ P3, const float* __restrict__ cw, const float* __restrict__ cb, const bf16* __restrict__ gimg, const float* __restrict__ gab, const float* __restrict__ gxb,
                      const float* __restrict__ lam, bf16* __restrict__ LA, bf16* __restrict__ BV, float2* __restrict__ SUM, int item, char* smem) {
    const int rt = item >> 4, nb = item & 15; const int tid = TIDX, lane = tid & 63, wave = tid >> 6, q = lane >> 4, l15 = lane & 15;
    const size_t m0 = (size_t)rt * 128;
    for (int id = tid; id < 128 * 12; id += NTHREADS) {
        const int row = id / 12, c12 = id % 12; u32x4 outv = (u32x4){0u, 0u, 0u, 0u};
        if (c12 < 10) {
            const size_t m = m0 + row; const int t = (int)(m % T); const int ch = nb * 80 + c12 * 8;
            float acc[8];
            { const float4 b0 = *(const float4*)(cb + ch), b1 = *(const float4*)(cb + ch + 4); acc[0] = b0.x; acc[1] = b0.y; acc[2] = b0.z; acc[3] = b0.w; acc[4] = b1.x; acc[5] = b1.y; acc[6] = b1.z; acc[7] = b1.w; }
#pragma unroll
            for (int w = 0; w < 4; ++w) {
                if (t - 3 + w >= 0) {
                    const u32x4 uv = *(const u32x4*)(P3 + (m - 3 + w) * 2560 + ch);
                    const float4 w0 = *(const float4*)(cw + w * LW + ch), w1 = *(const float4*)(cw + w * LW + ch + 4);
                    acc[0] += w0.x * bflo(uv[0]); acc[1] += w0.y * bfhi(uv[0]); acc[2] += w0.z * bflo(uv[1]); acc[3] += w0.w * bfhi(uv[1]);
                    acc[4] += w1.x * bflo(uv[2]); acc[5] += w1.y * bfhi(uv[2]); acc[6] += w1.z * bflo(uv[3]); acc[7] += w1.w * bfhi(uv[3]);
                }
            }
            outv = (u32x4){pack2bf(acc[0], acc[1]), pack2bf(acc[2], acc[3]), pack2bf(acc[4], acc[5]), pack2bf(acc[6], acc[7])};
        }
        const int ks = c12 >> 2, c = c12 & 3;
        *(u32x4*)(smem + ks * 8192 + row * 64 + ((c ^ ((row >> 2) & 3)) << 4)) = outv;
    }
    for (int id = tid; id < 160 * 12; id += NTHREADS) {
        const int row = id / 12, c12 = id % 12; const int ks = c12 >> 2, c = c12 & 3;
        *(u32x4*)(smem + 24576 + ks * 10240 + row * 64 + ((c ^ ((row >> 2) & 3)) << 4)) = *(const u32x4*)(gimg + ((size_t)nb * 160 + row) * 96 + c12 * 8);
    }
    __syncthreads();
    f32x4 acc[2][10];
#pragma unroll
    for (int i = 0; i < 2; ++i)
#pragma unroll
        for (int j = 0; j < 10; ++j) acc[i][j] = (f32x4){0.f, 0.f, 0.f, 0.f};
    const int fo = l15 * 64 + ((q ^ ((l15 >> 2) & 3)) << 4);
#pragma unroll
    for (int ks = 0; ks < 3; ++ks) {
        bf16x8 uf[2];
#pragma unroll
        for (int i = 0; i < 2; ++i) uf[i] = *(const bf16x8*)(smem + ks * 8192 + (wave * 32 + i * 16) * 64 + fo);
#pragma unroll
        for (int j = 0; j < 10; ++j) {
            const bf16x8 wf = *(const bf16x8*)(smem + 24576 + ks * 10240 + j * 1024 + fo);
            acc[0][j] = __builtin_amdgcn_mfma_f32_16x16x32_bf16(wf, uf[0], acc[0][j], 0, 0, 0);
            acc[1][j] = __builtin_amdgcn_mfma_f32_16x16x32_bf16(wf, uf[1], acc[1][j], 0, 0, 0);
        }
    }
    __syncthreads();
#pragma unroll
    for (int i = 0; i < 2; ++i) {
        const int row = wave * 32 + i * 16 + l15; const size_t m = m0 + row;
#pragma unroll
        for (int ct = 0; ct < 5; ++ct) {
            const int kcol = ct * 16 + 4 * q; const int ch = nb * 80 + kcol;
            const u32x2 uu = *(const u32x2*)(smem + (kcol >> 5) * 8192 + row * 64 + ((((kcol & 31) >> 3) ^ ((row >> 2) & 3)) << 4) + (kcol & 7) * 2);
            const float uc[4] = {bflo(uu[0]), bfhi(uu[0]), bflo(uu[1]), bfhi(uu[1])};
            const float4 ba = *(const float4*)(gab + ch), bx = *(const float4*)(gxb + ch), lm = *(const float4*)(lam + ch);
            const float bav[4] = {ba.x, ba.y, ba.z, ba.w}, bxv[4] = {bx.x, bx.y, bx.z, bx.w}, lmv[4] = {lm.x, lm.y, lm.z, lm.w};
            float la[4], bv[4];
#pragma unroll
            for (int r = 0; r < 4; ++r) {
                const float rg = __builtin_amdgcn_rcpf(1.0f + __expf(-(acc[i][ct][r] + bav[r]))), ig = __builtin_amdgcn_rcpf(1.0f + __expf(-(acc[i][ct + 5][r] + bxv[r])));
                la[r] = rg * lmv[r];
                const float om = 1.0f - __expf(2.0f * la[r]);
                bv[r] = __builtin_amdgcn_sqrtf(om > 0.f ? om : 0.f) * (ig * uc[r]);
            }
            const u32x2 lav = {pack2bf(la[0], la[1]), pack2bf(la[2], la[3])}, bvv = {pack2bf(bv[0], bv[1]), pack2bf(bv[2], bv[3])};
            *(u32x2*)(LA + m * LW + ch) = lav; *(u32x2*)(BV + m * LW + ch) = bvv;
            *(u32x2*)(smem + 24576 + (row * 80 + kcol) * 2) = lav; *(u32x2*)(smem + 24576 + 20480 + (row * 80 + kcol) * 2) = bvv;
        }
    }
    __syncthreads();
    if (tid < 160) {
        const int cidx = tid / 80, c = tid % 80; const bf16* li = (const bf16*)(smem + 24576) + (cidx * 64) * 80 + c; const bf16* bi = li + 10240;
        float sla = 0.f, h = 0.f;
#pragma unroll 8
        for (int t = 0; t < 64; ++t) { const float la = bf2f(li[t * 80]), bvv = bf2f(bi[t * 80]); h = __expf(la) * h + bvv; sla += la; }
        const size_t mc = m0 + cidx * 64; const int bb = (int)(mc / T), jj = (int)(mc % T) / 64;
        SUM[((size_t)bb * (T / 64) + jj) * LW + nb * 80 + c] = make_float2(__expf(sla), h);
    }
    __syncthreads();
}
DI void lru_scan2_item(const bf16* __restrict__ LA, const bf16* __restrict__ BV, const float2* __restrict__ SUM, const bf16* __restrict__ P3, bf16* __restrict__ AO, int item) {
    const int cg = item % 5, j = (item / 5) % (T / 64), b = item / (5 * (T / 64)); const int c = cg * 256 + TIDX;
    float h = 0.f;
    for (int jj = 0; jj < j; ++jj) { const float2 s = SUM[((size_t)b * (T / 64) + jj) * LW + c]; h = s.x * h + s.y; }
    const size_t m0 = (size_t)b * T + j * 64;
#pragma unroll 8
    for (int t = 0; t < 64; ++t) {
        const float la = bf2f(LA[(m0 + t) * LW + c]); const float bv = bf2f(BV[(m0 + t) * LW + c]); const float z = bf2f(P3[(m0 + t) * 2560 + LW + c]);
        h = __expf(la) * h + bv; AO[(m0 + t) * LW + c] = f2bf(h * siluf_(z));
    }
}

struct ALoadF32 {
    const float* A;
    static constexpr bool DMA = false;
    DI const bf16* src(int, int) const { return nullptr; }
    struct Raw { float4 a, b; };
    DI Raw load(int m, int k) const { Raw r; r.a = *(const float4*)(A + (size_t)m * 64 + k); r.b = *(const float4*)(A + (size_t)m * 64 + k + 4); return r; }
    DI u32x4 finish(const Raw& r, int, int) const { return (u32x4){pack2bf(r.a.x, r.a.y), pack2bf(r.a.z, r.a.w), pack2bf(r.b.x, r.b.y), pack2bf(r.b.z, r.b.w)}; }
};
struct EpiLora {
    const float* w0; const float* a0; bf16* WL; bf16* AV;
    DI void operator()(int m, int n, const float* v, int, int) const {
        float w[8];
        if (n < 1024) {
#pragma unroll
            for (int j = 0; j < 8; ++j) w[j] = -0.60653065971f * __builtin_amdgcn_rcpf(1.0f + __expf(-(w0[n + j] + v[j])));
            store8bf(WL + (size_t)m * D + n, w);
        } else {
#pragma unroll
            for (int j = 0; j < 8; ++j) w[j] = __builtin_amdgcn_rcpf(1.0f + __expf(-(a0[n - 1024 + j] + v[j])));
            store8bf(AV + (size_t)m * D + n - 1024, w);
        }
    }
    DI void finish(int, int, int, int, int) const {}
    DI void finish_wide(int, int, int, int, int) const {}
};
DI float dpp_sum16(float x) {
    x += __builtin_bit_cast(float, __builtin_amdgcn_update_dpp(0, __builtin_bit_cast(int, x), 0xB1, 0xf, 0xf, false));
    x += __builtin_bit_cast(float, __builtin_amdgcn_update_dpp(0, __builtin_bit_cast(int, x), 0x4E, 0xf, 0xf, false));
    x += __builtin_bit_cast(float, __builtin_amdgcn_update_dpp(0, __builtin_bit_cast(int, x), 0x141, 0xf, 0xf, false));
    x += __builtin_bit_cast(float, __builtin_amdgcn_update_dpp(0, __builtin_bit_cast(int, x), 0x140, 0xf, 0xf, false));
    return x;
}
constexpr int RW_NCH = T / 16;
DI void rwkv_prep_item(bf16* __restrict__ P, bf16* __restrict__ WL, bf16* __restrict__ AV, const float* __restrict__ k_k, const float* __restrict__ k_a, const float* __restrict__ r_k,
                       float* __restrict__ G15, bf16* __restrict__ M2g, bf16* __restrict__ M3g, float* __restrict__ BON, int item, char* smem) {
    const int c = item % RW_NCH, h = (item / RW_NCH) & 15, b = item / (RW_NCH * 16);
    const int tid = TIDX, t = tid >> 4, jq = tid & 15, j0 = jq * 4;
    const size_t m0 = (size_t)b * T + c * 16, m = m0 + t; const size_t ch = (size_t)(b * 16 + h) * RW_NCH + c;
    float* sA = (float*)smem; float* sR = sA + 16 * 68; float* sB = sR + 16 * 68; float* sK = sB + 16 * 68; float* sW = sK + 16 * 68; float* sWl = sW + 16 * 68;
    float* mAab = sWl + 16 * 64; float* mAak = mAab + 16 * 17; float* mArb = mAak + 16 * 17; float* mArk = mArb + 16 * 17; float* mTin = mArk + 16 * 17; float* mM2 = mTin + 16 * 17;
    const u32x2 r2 = *(const u32x2*)(P + m * 4096 + h * 64 + j0), k2 = *(const u32x2*)(P + m * 4096 + 1024 + h * 64 + j0), a2 = *(const u32x2*)(AV + m * D + h * 64 + j0), w2 = *(const u32x2*)(WL + m * D + h * 64 + j0);
    const float rr[4] = {bflo(r2[0]), bfhi(r2[0]), bflo(r2[1]), bfhi(r2[1])}, kr[4] = {bflo(k2[0]), bfhi(k2[0]), bflo(k2[1]), bfhi(k2[1])},
                av[4] = {bflo(a2[0]), bfhi(a2[0]), bflo(a2[1]), bfhi(a2[1])}, wl[4] = {bflo(w2[0]), bfhi(w2[0]), bflo(w2[1]), bfhi(w2[1])};
    const float4 kk4 = *(const float4*)(k_k + h * 64 + j0), ka4 = *(const float4*)(k_a + h * 64 + j0), rk4 = *(const float4*)(r_k + h * 64 + j0);
    const float kkc[4] = {kk4.x, kk4.y, kk4.z, kk4.w}, kac[4] = {ka4.x, ka4.y, ka4.z, ka4.w}, rkc[4] = {rk4.x, rk4.y, rk4.z, rk4.w};
    float kkv[4], n2 = 0.f;
#pragma unroll
    for (int e = 0; e < 4; ++e) { kkv[e] = kr[e] * kkc[e]; n2 += kkv[e] * kkv[e]; }
    n2 = dpp_sum16(n2);
    float nr = sqrtf(n2); nr = nr > 1e-12f ? nr : 1e-12f; const float inr = 1.0f / nr;
    float aa[4], bb[4], kp[4], bon = 0.f;
#pragma unroll
    for (int e = 0; e < 4; ++e) { const float kn = kkv[e] * inr; aa[e] = -kn; bb[e] = kn * av[e]; kp[e] = kr[e] * (1.0f + (av[e] - 1.0f) * kac[e]); bon += rr[e] * kp[e] * rkc[e]; }
    bon = dpp_sum16(bon);
    if (jq == 0) BON[m * 16 + h] = bon;
    *(float4*)(sWl + t * 64 + j0) = make_float4(wl[0], wl[1], wl[2], wl[3]);
    __syncthreads();
    float clx[4] = {0.f, 0.f, 0.f, 0.f};
#pragma unroll
    for (int s = 0; s < 15; ++s) { if (s < t) { const float4 w = *(const float4*)(sWl + s * 64 + j0); clx[0] += w.x; clx[1] += w.y; clx[2] += w.z; clx[3] += w.w; } }
    float bt[4];
    {
        float va[4], vr[4], vk[4], gc[4];
#pragma unroll
        for (int e = 0; e < 4; ++e) { const float cl = clx[e] + wl[e]; const float gp = __expf(clx[e]), gi = __expf(-cl); gc[e] = __expf(cl); va[e] = aa[e] * gp; vr[e] = rr[e] * gc[e]; bt[e] = bb[e] * gi; vk[e] = kp[e] * gi; }
        *(float4*)(sA + t * 68 + j0) = make_float4(va[0], va[1], va[2], va[3]); *(float4*)(sR + t * 68 + j0) = make_float4(vr[0], vr[1], vr[2], vr[3]);
        *(float4*)(sB + t * 68 + j0) = make_float4(bt[0], bt[1], bt[2], bt[3]); *(float4*)(sK + t * 68 + j0) = make_float4(vk[0], vk[1], vk[2], vk[3]);
        {
            char* img = (char*)(mM2 + 16 * 17) + t * 128 + (((j0 >> 3) ^ (t & 7)) << 4) + (j0 & 4) * 2;
            *(u32x2*)(img) = (u32x2){pack2bf(va[0], va[1]), pack2bf(va[2], va[3])}; *(u32x2*)(img + 2048) = (u32x2){pack2bf(vr[0], vr[1]), pack2bf(vr[2], vr[3])};
            *(u32x2*)(img + 4096) = (u32x2){pack2bf(bt[0], bt[1]), pack2bf(bt[2], bt[3])}; *(u32x2*)(img + 6144) = (u32x2){pack2bf(vk[0], vk[1]), pack2bf(vk[2], vk[3])};
        }
        if (t == 15) *(float4*)(G15 + ch * 64 + j0) = make_float4(gc[0], gc[1], gc[2], gc[3]);
#pragma unroll
        for (int e = 0; e < 4; ++e) {   }
#pragma unroll
        for (int e = 0; e < 4; ++e) clx[e] = vk[e];
    }
    __syncthreads();
    {
        const int wv = __builtin_amdgcn_readfirstlane(tid >> 6), lane = tid & 63, q = lane >> 4, l15 = lane & 15;
        const char* xb_ = (const char*)(mM2 + 16 * 17) + (wv >> 1) * 2048;
        const char* yb_ = (const char*)(mM2 + 16 * 17) + 4096 + (wv & 1) * 2048;
        f32x4 acc = {0.f, 0.f, 0.f, 0.f};
#pragma unroll
        for (int ks = 0; ks < 2; ++ks) {
            const int off = l15 * 128 + (((ks * 4 + q) ^ (l15 & 7)) << 4);
            const bf16x8 xf = *(const bf16x8*)(xb_ + off), yf = *(const bf16x8*)(yb_ + off);
            acc = __builtin_amdgcn_mfma_f32_16x16x32_bf16(xf, yf, acc, 0, 0, 0);
        }
        float* dst = wv == 0 ? mAab : (wv == 1 ? mAak : (wv == 2 ? mArb : mArk));
        const bool strict = wv < 2;
#pragma unroll
        for (int r = 0; r < 4; ++r) { const int tt = 4 * q + r, ss = l15; dst[tt * 17 + ss] = (strict ? ss < tt : ss <= tt) ? acc[r] : 0.f; }
    }
    __syncthreads();
    if (tid < 16) {
        float col[16];
#pragma unroll
        for (int i = 0; i < 16; ++i) {
            float acc = (i == tid) ? 1.0f : 0.f;
#pragma unroll
            for (int jj = 0; jj < i; ++jj) acc += mAab[i * 17 + jj] * col[jj];
            col[i] = acc; mTin[i * 17 + tid] = acc;
        }
    }
    __syncthreads();
    float wv[4] = {0.f, 0.f, 0.f, 0.f}, m2 = 0.f;
#pragma unroll
    for (int s = 0; s < 16; ++s) { const float ti = mTin[t * 17 + s]; const float4 a4 = *(const float4*)(sA + s * 68 + j0); wv[0] += ti * a4.x; wv[1] += ti * a4.y; wv[2] += ti * a4.z; wv[3] += ti * a4.w; m2 += ti * mAak[s * 17 + jq]; }
    *(float4*)(sW + t * 68 + j0) = make_float4(wv[0], wv[1], wv[2], wv[3]); mM2[t * 17 + jq] = m2;
    __syncthreads();
    float rh[4]; { const float4 r4 = *(const float4*)(sR + t * 68 + j0); rh[0] = r4.x; rh[1] = r4.y; rh[2] = r4.z; rh[3] = r4.w; }
    float m3 = mArk[t * 17 + jq];
#pragma unroll
    for (int s = 0; s < 16; ++s) { const float ar = mArb[t * 17 + s]; const float4 w4 = *(const float4*)(sW + s * 68 + j0); rh[0] += ar * w4.x; rh[1] += ar * w4.y; rh[2] += ar * w4.z; rh[3] += ar * w4.w; m3 += ar * mM2[s * 17 + jq]; }
    *(u32x2*)(WL + m * D + h * 64 + j0) = (u32x2){pack2bf(wv[0], wv[1]), pack2bf(wv[2], wv[3])};
    *(u32x2*)(P + m * 4096 + h * 64 + j0) = (u32x2){pack2bf(rh[0], rh[1]), pack2bf(rh[2], rh[3])};
#pragma unroll
    for (int e = 0; e < 4; ++e) { AV[(m0 + jq) * D + h * 64 + e * 16 + t] = f2bf(bt[e]); P[(m0 + jq) * 4096 + 1024 + h * 64 + e * 16 + t] = f2bf(clx[e]); }
    M2g[ch * 256 + t * 16 + jq] = f2bf(m2); M3g[ch * 256 + t * 16 + jq] = f2bf(m3);
    __syncthreads();
}

#define MFMA32(a, b, c) __builtin_amdgcn_mfma_f32_16x16x32_bf16(__builtin_bit_cast(bf16x8, a), __builtin_bit_cast(bf16x8, b), c, 0, 0, 0)
DI void rwkv_chunk_scan(const bf16* __restrict__ P, const bf16* __restrict__ WL, const bf16* __restrict__ AV, const float* __restrict__ G15, const bf16* __restrict__ M2g, const bf16* __restrict__ M3g,
                        bf16* __restrict__ YS, int bh, char* smem) {
    constexpr int SLOT = 12288, YOFF = 49152;
    const int tid = TIDX, lane = tid & 63, vs = __builtin_amdgcn_readfirstlane(tid >> 6), q = lane >> 4, l15 = lane & 15; const int b = bh >> 4, h = bh & 15;
    const size_t mb = (size_t)b * T; const size_t ch0 = (size_t)(b * 16 + h) * RW_NCH;
    const char *s0, *s1, *s2; size_t d0, d1, d2;
    if (tid < 128) { const int c8 = tid >> 4, t = tid & 15; s0 = (const char*)(WL + (mb + t) * D + h * 64 + c8 * 8); d0 = (size_t)16 * D * 2; }
    else { const int pp = tid - 128, c8 = pp >> 4, t = pp & 15; s0 = (const char*)(P + (mb + t) * 4096 + h * 64 + c8 * 8); d0 = (size_t)16 * 4096 * 2; }
    if (tid < 128) { const int r = tid >> 3, c8 = tid & 7; s1 = (const char*)(P + (mb + r) * 4096 + 1024 + h * 64 + c8 * 8); d1 = (size_t)16 * 4096 * 2; }
    else { const int pp = tid - 128, r = pp >> 3, c8 = pp & 7; s1 = (const char*)(AV + (mb + r) * D + h * 64 + c8 * 8); d1 = (size_t)16 * D * 2; }
    if (tid < 128) { const int r = tid >> 3, c8 = tid & 7; s2 = (const char*)(P + (mb + r) * 4096 + 2048 + h * 64 + c8 * 8); d2 = (size_t)16 * 4096 * 2; }
    else if (tid < 160) { s2 = (const char*)(M2g + ch0 * 256 + (tid - 128) * 8); d2 = 512; }
    else if (tid < 192) { s2 = (const char*)(M3g + ch0 * 256 + (tid - 160) * 8); d2 = 512; }
    else { const int pp = tid < 208 ? tid - 192 : 0; s2 = (const char*)(G15 + ch0 * 64 + pp * 4); d2 = 256; }
    const int dma_off = vs * 1024;
#define RW_DMA(c_) { char* dst = smem + ((c_) & 3) * SLOT + dma_off; GLDS16(s0 + (size_t)(c_) * d0, dst); GLDS16(s1 + (size_t)(c_) * d1, dst + 4096); GLDS16(s2 + (size_t)(c_) * d2, dst + 8192); }
#define RW_BARRIER() { asm volatile("s_waitcnt lgkmcnt(0)" ::: "memory"); __builtin_amdgcn_s_barrier(); asm volatile("" ::: "memory"); }
    f32x4 H0 = {0.f, 0.f, 0.f, 0.f}, H1 = H0, H2 = H0, H3 = H0;
    const int oW = (((q >> 1)) * 16 + l15) * 16 + (q & 1) * 8;
    const int oK = 4096 + ((l15 >> 2) * 8 + (l15 & 3) * 2 + (q >> 1)) * 16 + (q & 1) * 8;
    const int oM = 10240 + l15 * 32 + q * 8;
    const int oV = 8192 + (4 * q) * 128 + (vs * 16 + l15) * 2;
    const int oG = 11264 + (4 * q) * 4;
    const int oY = YOFF + ((4 * q) * 64 + vs * 16 + l15) * 2;
    RW_DMA(0); RW_DMA(1); RW_DMA(2);
    asm volatile("s_waitcnt vmcnt(6)" ::: "memory");
    RW_BARRIER();
    for (int c = 0; c < RW_NCH; ++c) {
        if (c + 3 < RW_NCH) RW_DMA(c + 3);
        const char* sl = smem + (c & 3) * SLOT;
        {
            const f32x4 z4 = {0.f, 0.f, 0.f, 0.f};
            const u32x4 Hb0 = {pack2bf(H0[0], H0[1]), pack2bf(H0[2], H0[3]), pack2bf(H1[0], H1[1]), pack2bf(H1[2], H1[3])};
            const u32x4 Hb1 = {pack2bf(H2[0], H2[1]), pack2bf(H2[2], H2[3]), pack2bf(H3[0], H3[1]), pack2bf(H3[2], H3[3])};
            const unsigned v0 = *(const bf16*)(sl + oV), v1 = *(const bf16*)(sl + oV + 128), v2 = *(const bf16*)(sl + oV + 256), v3 = *(const bf16*)(sl + oV + 384);
            const unsigned v01 = v0 | (v1 << 16), v23 = v2 | (v3 << 16);
            const u32x4 Vlo = {v01, v23, 0u, 0u};
            const u32x2 m2 = *(const u32x2*)(sl + oM), m3 = *(const u32x2*)(sl + oM + 512);
            const u32x2 w0 = *(const u32x2*)(sl + oW), w1 = *(const u32x2*)(sl + oW + 512), w2 = *(const u32x2*)(sl + oW + 1024), w3 = *(const u32x2*)(sl + oW + 1536);
            const u32x2 r0 = *(const u32x2*)(sl + 2048 + oW), r1 = *(const u32x2*)(sl + 2048 + oW + 512), r2 = *(const u32x2*)(sl + 2048 + oW + 1024), r3 = *(const u32x2*)(sl + 2048 + oW + 1536);
            f32x4 U = MFMA32(((u32x4){m2[0], m2[1], 0u, 0u}), Vlo, z4);
            U = MFMA32(((u32x4){w0[0], w0[1], w1[0], w1[1]}), Hb0, U); U = MFMA32(((u32x4){w2[0], w2[1], w3[0], w3[1]}), Hb1, U);
            f32x4 Y = MFMA32(((u32x4){m3[0], m3[1], 0u, 0u}), Vlo, z4);
            Y = MFMA32(((u32x4){r0[0], r0[1], r1[0], r1[1]}), Hb0, Y); Y = MFMA32(((u32x4){r2[0], r2[1], r3[0], r3[1]}), Hb1, Y);
            const u32x4 VU = {v01, v23, pack2bf(U[0], U[1]), pack2bf(U[2], U[3])};
            const u32x2 k0 = *(const u32x2*)(sl + oK), k1 = *(const u32x2*)(sl + oK + 512), k2 = *(const u32x2*)(sl + oK + 1024), k3 = *(const u32x2*)(sl + oK + 1536);
            const u32x2 b0 = *(const u32x2*)(sl + 2048 + oK), b1 = *(const u32x2*)(sl + 2048 + oK + 512), b2 = *(const u32x2*)(sl + 2048 + oK + 1024), b3 = *(const u32x2*)(sl + 2048 + oK + 1536);
            const f32x4 g0 = *(const f32x4*)(sl + oG), g1 = *(const f32x4*)(sl + oG + 64), g2 = *(const f32x4*)(sl + oG + 128), g3 = *(const f32x4*)(sl + oG + 192);
            const f32x4 a0 = MFMA32(((u32x4){k0[0], k0[1], b0[0], b0[1]}), VU, H0), a1 = MFMA32(((u32x4){k1[0], k1[1], b1[0], b1[1]}), VU, H1);
            const f32x4 a2 = MFMA32(((u32x4){k2[0], k2[1], b2[0], b2[1]}), VU, H2), a3 = MFMA32(((u32x4){k3[0], k3[1], b3[0], b3[1]}), VU, H3);
            H0 = a0 * g0; H1 = a1 * g1; H2 = a2 * g2; H3 = a3 * g3;
            char* yb = smem + oY + (c & 7) * 2048;
#pragma unroll
            for (int r = 0; r < 4; ++r) *(bf16*)(yb + r * 128) = f2bf(Y[r]);
        }
        const bool flush = (c & 7) == 7;
        if (flush) {
            RW_BARRIER();
            u32x4 yv[4];
#pragma unroll
            for (int k = 0; k < 4; ++k) yv[k] = *(const u32x4*)(smem + YOFF + (tid + 256 * k) * 16);
#pragma unroll
            for (int k = 0; k < 4; ++k) { const int pc = tid + 256 * k, rr = pc >> 3, c8 = pc & 7; *(u32x4*)(YS + (mb + (size_t)(c - 7) * 16 + rr) * D + h * 64 + c8 * 8) = yv[k]; }
            asm volatile("s_waitcnt vmcnt(0)" ::: "memory");
        } else if (c + 3 < RW_NCH) { asm volatile("s_waitcnt vmcnt(6)" ::: "memory"); }
        else if (c + 2 < RW_NCH) { asm volatile("s_waitcnt vmcnt(3)" ::: "memory"); }
        else { asm volatile("s_waitcnt vmcnt(0)" ::: "memory"); }
        RW_BARRIER();
    }
#undef RW_DMA
#undef RW_BARRIER
}
DI void rwkv_gn_rows2(const bf16* __restrict__ P, const float* __restrict__ BON, const float* __restrict__ lnw, const float* __restrict__ lnb, bf16* __restrict__ YS) {
    const int tid = TIDX, lane = tid & 63, wave = tid >> 6; const int c = wave * 256 + lane * 4;
    const float4 lw = *(const float4*)(lnw + c), lb = *(const float4*)(lnb + c);
    for (size_t m = blockIdx.x; m < (size_t)M; m += gridDim.x) {
        const u32x2 yy = *(const u32x2*)(YS + m * D + c), vv = *(const u32x2*)(P + m * 4096 + 2048 + c), zz = *(const u32x2*)(P + m * 4096 + 3072 + c);
        const float bs = BON[m * 16 + (c >> 6)];
        const float y[4] = {bflo(yy[0]), bfhi(yy[0]), bflo(yy[1]), bfhi(yy[1])}, v[4] = {bflo(vv[0]), bfhi(vv[0]), bflo(vv[1]), bfhi(vv[1])}, z[4] = {bflo(zz[0]), bfhi(zz[0]), bflo(zz[1]), bfhi(zz[1])};
        const float lwv[4] = {lw.x, lw.y, lw.z, lw.w}, lbv[4] = {lb.x, lb.y, lb.z, lb.w};
        const float mean = dpp_sum16((y[0] + y[1]) + (y[2] + y[3])) * (1.0f / 64.0f);
        float var = 0.f;
#pragma unroll
        for (int i = 0; i < 4; ++i) { const float d = y[i] - mean; var += d * d; }
        var = dpp_sum16(var) * (1.0f / 64.0f);
        const float rstd = 1.0f / sqrtf(var + 64e-5f);
        float o[4];
#pragma unroll
        for (int i = 0; i < 4; ++i) o[i] = ((y[i] - mean) * rstd * lwv[i] + lbv[i] + bs * v[i]) * siluf_(z[i]);
        *(u32x2*)(YS + m * D + c) = (u32x2){pack2bf(o[0], o[1]), pack2bf(o[2], o[3])};
    }
}

struct FastBufs { char* ws; };

DI void rows_xb_parts(const float* __restrict__ x, bf16* xb, float* parts) {
    const int lane = TIDX & 63, wave = TIDX >> 6;
    for (int m = blockIdx.x * 4 + wave; m < M; m += gridDim.x * 4) {
        const float* xr = x + (size_t)m * D; float s = 0.f;
#pragma unroll
        for (int i = 0; i < 2; ++i) {
            const int k = (i * 64 + lane) * 8; const float4 a = *(const float4*)(xr + k), b = *(const float4*)(xr + k + 4);
            const float w[8] = {a.x, a.y, a.z, a.w, b.x, b.y, b.z, b.w};
#pragma unroll
            for (int j = 0; j < 8; ++j) s += w[j] * w[j];
            store8bf(xb + (size_t)m * D + k, w);
        }
#pragma unroll
        for (int o = 32; o >= 1; o >>= 1) s += __shfl_xor(s, o);
        if (lane < 16) parts[(size_t)m * 16 + lane] = lane == 0 ? s : 0.f;
    }
}
DI void rows_xn(const float* __restrict__ x, const float* parts, const float* __restrict__ g, bf16* xn) {
    const int lane = TIDX & 63, wave = TIDX >> 6;
    for (int m = blockIdx.x * 4 + wave; m < M; m += gridDim.x * 4) {
        const float rs = rstd_from_parts(parts, m); const float* xr = x + (size_t)m * D;
#pragma unroll
        for (int i = 0; i < 2; ++i) {
            const int k = (i * 64 + lane) * 8; const float4 a = *(const float4*)(xr + k), b = *(const float4*)(xr + k + 4);
            const float4 ga = *(const float4*)(g + k), gb = *(const float4*)(g + k + 4);
            const float w[8] = {a.x * rs * ga.x, a.y * rs * ga.y, a.z * rs * ga.z, a.w * rs * ga.w, b.x * rs * gb.x, b.y * rs * gb.y, b.z * rs * gb.z, b.w * rs * gb.w};
            store8bf(xn + (size_t)m * D + k, w);
        }
    }
}
DI void rows_final(float* x, const float* parts, const float* __restrict__ g) {
    const int lane = TIDX & 63, wave = TIDX >> 6;
    for (int m = blockIdx.x * 4 + wave; m < M; m += gridDim.x * 4) {
        const float rs = rstd_from_parts(parts, m); float* xr = x + (size_t)m * D;
#pragma unroll
        for (int i = 0; i < 4; ++i) {
            const int k = (i * 64 + lane) * 4; float4 a = *(float4*)(xr + k); const float4 ga = *(const float4*)(g + k);
            a.x *= rs * ga.x; a.y *= rs * ga.y; a.z *= rs * ga.z; a.w *= rs * ga.w; *(float4*)(xr + k) = a;
        }
    }
}
enum { PH_PREP0 = 0, PH_IN0, PH_ATTN0, PH_OUT0, PH_PREP1, PH_IN1, PH_LORA1, PH_CPREP1, PH_SCAN1, PH_GN1, PH_OUT1, PH_PREP2, PH_IN2, PH_B2, PH_C2, PH_D2, PH_OUT2, PH_PREP3, PH_IN3, PH_GATE3, PH_SCANA3, PH_SCANB3, PH_OUT3, PH_FINAL };

namespace wbo {
constexpr size_t IN = 0;
constexpr size_t OUT = (size_t)4352 * 1024;
constexpr size_t EXTRA = OUT + (size_t)1280 * 1024;
}

template <int PH>
DI void run_phase(const Params& p, char* smem) {
    char* ws = p.ws;
    float* parts = (float*)(ws + fw::PARTS);
    constexpr int LAYER = PH <= PH_OUT0 ? 0 : PH <= PH_OUT1 ? 1 : PH <= PH_OUT2 ? 2 : 3;
    constexpr size_t WBOFF = LAYER == 0 ? 200 * fw::MB : LAYER == 1 ? 238 * fw::MB : LAYER == 2 ? 240 * fw::MB : 1 * fw::MB;
    bf16* WB = (bf16*)(ws + WBOFF);
    bf16* XB = (bf16*)(ws + ((PH == PH_PREP0 || PH == PH_IN0) ? 130 * fw::MB : 174 * fw::MB));
    bf16* P = (bf16*)(ws + wsl::P);
    float* X = p.out;
    float* smf = (float*)smem;
    if (PH == PH_PREP0) {
        rows_xb_parts(p.x, XB, parts);
        int tb = 0;
        convert_seg(p.a_w_in, A_COLS, 0, A_COLS, 1024, WB + wbo::IN, p.norm_g + 0 * D, smf, tb);
        convert_seg(p.a_w_out, 1024, 0, 1024, 1024, WB + wbo::OUT, nullptr, smf, tb);
    } else if (PH == PH_IN0) {
        gemm_sched(8, 4, [&](bool big, int mt, int nt) {
            if (big) gemm_tile2(ALoadPlain{XB, D}, WB + wbo::IN, 1024, mt * 128, nt * 256, EpiL0{P, (bf16*)(ws + 86 * fw::MB), parts}, smem);
            else gemm_tile(ALoadPlain{XB, D}, WB + wbo::IN, 1024, mt * 128, 2048 + nt * 128, EpiL0{P, (bf16*)(ws + 86 * fw::MB), parts}, smem);
        });
    } else if (PH == PH_ATTN0) {
        build_bias_lut(p.t5, smem, true);
        for (int it = blockIdx.x; it < B * G * (T / (16 * ANQT_SWA)); it += gridDim.x) swa_item(P, (const bf16*)(ws + 86 * fw::MB), p.a_sinks, (bf16*)(ws + wsl::L0_AO), it, smem);
    } else if (PH == PH_OUT0) {
        gemm_sched(4, 0, [&](bool, int mt, int nt) { gemm_tile2(ALoadPlain{(const bf16*)(ws + wsl::L0_AO), D}, WB + wbo::OUT, 1024, mt * 128, nt * 256, EpiResid{p.x, X, nullptr, parts}, smem); });
    } else if (PH == PH_PREP1) {
        rows_xn(X, parts, p.norm_g + 1 * D, (bf16*)(ws + wsl::L1_XN));
        int tb = 0;
        convert_seg(p.b_w_in, 4096, 0, 4096, 1024, WB + wbo::IN, nullptr, smf, tb);
        convert_seg(p.b_w1, 64, 0, 64, 1024, WB + wbo::IN + (size_t)4096 * 1024, nullptr, smf, tb);
        convert_seg(p.b_a1, 64, 0, 64, 1024, WB + wbo::IN + (size_t)(4096 + 128) * 1024, nullptr, smf, tb);
        convert_seg(p.b_w_out, 1024, 0, 1024, 1024, WB + wbo::OUT, nullptr, smf, tb);
        convert_seg(p.b_w2, 1024, 0, 1024, 64, WB + wbo::EXTRA, nullptr, smf, tb);
        convert_seg(p.b_a2, 1024, 0, 1024, 64, WB + wbo::EXTRA + (size_t)1024 * 64, nullptr, smf, tb);
        for (size_t i = (size_t)blockIdx.x * 256 + TIDX; i < (size_t)64 * 1024 / 8; i += (size_t)gridDim.x * 256) {
            ((u32x4*)(WB + wbo::IN + (size_t)(4096 + 64) * 1024))[i] = (u32x4){0u, 0u, 0u, 0u};
            ((u32x4*)(WB + wbo::IN + (size_t)(4096 + 192) * 1024))[i] = (u32x4){0u, 0u, 0u, 0u};
        }
    } else if (PH == PH_IN1) {
        const bf16* XN = (const bf16*)(ws + wsl::L1_XN);
        EpiRwkv epi{P, (float*)(ws + wsl::LHW), (float*)(ws + wsl::LHA)};
        gemm_sched(16, 2, [&](bool big, int mt, int nt) {
            if (big) gemm_tile2(ALoadLerp{XN, p.b_mu + (nt >> 2) * D}, WB + wbo::IN, 1024, mt * 128, nt * 256, epi, smem);
            else gemm_tile(ALoadLerp{XN, p.b_mu + (4 + nt) * D}, WB + wbo::IN, 1024, mt * 128, 4096 + nt * 128, epi, smem);
        });
    } else if (PH == PH_LORA1) {
        const int ntile = (M / 128) * 16;
        EpiLora epi{p.b_w0, p.b_a0, (bf16*)(ws + wsl::L1_WL), (bf16*)(ws + wsl::L1_AV)};
        (void)ntile;
        gemm_sched(8, 0, [&](bool, int mt, int nt) { gemm_tile2(ALoadF32{(const float*)(ws + (nt < 4 ? wsl::LHW : wsl::LHA))}, WB + wbo::EXTRA, 64, mt * 128, nt * 256, epi, smem); });
    } else if (PH == PH_CPREP1) {
        for (int it = blockIdx.x; it < B * 16 * RW_NCH; it += gridDim.x)
            rwkv_prep_item(P, (bf16*)(ws + wsl::L1_WL), (bf16*)(ws + wsl::L1_AV), p.b_k_k, p.b_k_a, p.b_r_k, (float*)(ws + 9 * fw::MB), (bf16*)(ws + 1 * fw::MB), WB, (float*)(ws + 254 * fw::MB), it, smem);
    } else if (PH == PH_SCAN1) {
        const int bid = blockIdx.x;
        if ((bid & 31) < 8 && (bid >> 5) < 8) {
            const int it = (bid >> 5) * 8 + (bid & 31);
            rwkv_chunk_scan(P, (const bf16*)(ws + wsl::L1_WL), (const bf16*)(ws + wsl::L1_AV), (const float*)(ws + 9 * fw::MB), (const bf16*)(ws + 1 * fw::MB), WB, (bf16*)(ws + wsl::L1_XN), it, smem);
        }
    } else if (PH == PH_GN1) {
        rwkv_gn_rows2(P, (const float*)(ws + 254 * fw::MB), p.b_lnx_w, p.b_lnx_b, (bf16*)(ws + wsl::L1_XN));
    } else if (PH == PH_OUT1) {
        gemm_sched(4, 0, [&](bool, int mt, int nt) { gemm_tile2(ALoadPlain{(const bf16*)(ws + wsl::L1_XN), D}, WB + wbo::OUT, 1024, mt * 128, nt * 256, EpiResid{X, X, XB, parts}, smem); });
    } else if (PH == PH_PREP2) {
        int tb = 0;
        const float* g2 = p.norm_g + 2 * D;
        convert_seg(p.c_w_in, C_COLS, 0, 2560, 1024, WB + wbo::IN, g2, smf, tb);
        convert_seg(p.c_w_in, C_COLS, 2608, 1024, 1024, WB + wbo::IN + (size_t)2560 * 1024, g2, smf, tb);
        convert_seg(p.c_w_in, C_COLS, 2560, 64, 1024, WB + wbo::IN + (size_t)3584 * 1024, g2, smf, tb);
        convert_seg(p.c_w_out, 1024, 0, 1024, 1024, WB + wbo::OUT, nullptr, smf, tb);
        convert_seg(p.c_k_w1, 128, 0, 128, 2048, WB + wbo::EXTRA, nullptr, smf, tb);
        convert_seg(p.c_v_w1, 128, 0, 128, 2048, WB + wbo::EXTRA + (size_t)128 * 2048, nullptr, smf, tb);
        convert_seg(p.c_k_w2, 64, 0, 64, 128, WB + wbo::EXTRA + (size_t)256 * 2048, nullptr, smf, tb);
        convert_seg(p.c_v_w2, 64, 0, 64, 128, WB + wbo::EXTRA + (size_t)256 * 2048 + 64 * 128, nullptr, smf, tb);
        if (blockIdx.x < 16) {
            const int which = blockIdx.x >> 3, i = blockIdx.x & 7; const float* pos = which ? p.c_pos_v : p.c_pos_k; const float* w1 = which ? p.c_v_w1 : p.c_k_w1;
            float* b8 = (float*)(ws + 12 * fw::MB);
            if (TIDX < 128) { float a = 0.f; for (int k = i * 256; k < i * 256 + 256; ++k) a += pos[k] * w1[(size_t)k * 128 + TIDX]; b8[(which * 8 + i) * 128 + TIDX] = a; }
        }
    } else if (PH == PH_IN2) {
        gemm_sched(14, 1, [&](bool big, int mt, int nt) {
            if (big) gemm_tile2(ALoadPlain{XB, D}, WB + wbo::IN, 1024, mt * 128, nt * 256, EpiL2{P, (bf16*)(ws + 114 * fw::MB), (bf16*)(ws + 122 * fw::MB), parts}, smem);
            else gemm_tile(ALoadPlain{XB, D}, WB + wbo::IN, 1024, mt * 128, 3584 + nt * 128, EpiL2{P, (bf16*)(ws + 114 * fw::MB), (bf16*)(ws + 122 * fw::MB), parts}, smem);
        });
    } else if (PH == PH_B2) {
        for (int it = blockIdx.x; it < 64; it += gridDim.x) { const int which = it >> 5, rt = it & 31;
            cmp_tile(P, WB + wbo::EXTRA + (size_t)which * 128 * 2048, (const float*)(ws + 12 * fw::MB) + which * 8 * 128, WB + wbo::EXTRA + (size_t)256 * 2048 + which * 64 * 128, which, rt,
                     (bf16*)(ws + 5 * fw::MB), (bf16*)(ws + 6 * fw::MB), smem); }
        build_bias_lut(p.t5, smem, false);
        const int nitem = 64 + B * G * (T / (16 * ANQT_WIN));
        for (int it = blockIdx.x < 64 ? blockIdx.x + gridDim.x : blockIdx.x; it < nitem; it += gridDim.x) win_item(P, (const bf16*)(ws + 122 * fw::MB), (bf16*)(ws + 130 * fw::MB), it - 64, smem);
    } else if (PH == PH_C2) {
        for (int it = blockIdx.x; it < B * G * (T / 32); it += gridDim.x)
            cmpsel_item(P, (const bf16*)(ws + 5 * fw::MB), (const bf16*)(ws + 6 * fw::MB), (bf16*)(ws + 162 * fw::MB), (unsigned long long*)(ws + 9 * fw::MB), it, smem);
    } else if (PH == PH_D2) {
        build_bias_lut(p.t5, smem, false);
        for (int it = blockIdx.x; it < B * G * (T / (16 * ANQT_SEL)); it += gridDim.x)
            sel_item(P, (const bf16*)(ws + 114 * fw::MB), (const unsigned long long*)(ws + 9 * fw::MB), (const bf16*)(ws + 162 * fw::MB), (const bf16*)(ws + 130 * fw::MB), (bf16*)(ws + 206 * fw::MB), it, smem);
    } else if (PH == PH_OUT2) {
        gemm_sched(4, 0, [&](bool, int mt, int nt) { gemm_tile2(ALoadPlain{(const bf16*)(ws + 206 * fw::MB), D}, WB + wbo::OUT, 1024, mt * 128, nt * 256, EpiResid{X, X, XB, parts}, smem); });
    } else if (PH == PH_PREP3) {
        int tb = 0;
        convert_seg(p.d_w_in, 2560, 0, 2560, 1024, WB + wbo::IN, p.norm_g + 3 * D, smf, tb);
        convert_seg(p.d_w_out, 1024, 0, 1024, 1280, WB + wbo::OUT, nullptr, smf, tb);
        lru_convert_gates(p.d_ga_w, p.d_gx_w, WB + wbo::EXTRA);
        for (int i = blockIdx.x * NTHREADS + TIDX; i < LW; i += gridDim.x * NTHREADS) ((float*)(ws + 12 * fw::MB + 786432))[i] = -8.0f * softplusf_(-p.d_lambda[i]);
    } else if (PH == PH_IN3) {
        gemm_sched(8, 4, [&](bool big, int mt, int nt) {
            if (big) gemm_tile2(ALoadPlain{XB, D}, WB + wbo::IN, 1024, mt * 128, nt * 256, EpiBf16{P, 2560, parts}, smem);
            else gemm_tile(ALoadPlain{XB, D}, WB + wbo::IN, 1024, mt * 128, 2048 + nt * 128, EpiBf16{P, 2560, parts}, smem);
        });
    } else if (PH == PH_GATE3) {
        for (int it = blockIdx.x; it < (M / 128) * 16; it += gridDim.x)
            lru_gate_item(P, p.d_conv_w, p.d_conv_b, WB + wbo::EXTRA, p.d_ga_b, p.d_gx_b, (const float*)(ws + 12 * fw::MB + 786432), (bf16*)(ws + wsl::L3_LA), (bf16*)(ws + wsl::L3_BV), (float2*)(ws + wsl::L3_UC), it, smem);
    } else if (PH == PH_SCANB3) {
        for (int it = blockIdx.x; it < B * (T / 64) * 5; it += gridDim.x)
            lru_scan2_item((const bf16*)(ws + wsl::L3_LA), (const bf16*)(ws + wsl::L3_BV), (const float2*)(ws + wsl::L3_UC), P, (bf16*)(ws + wsl::L3_AO), it);
    } else if (PH == PH_OUT3) {
        gemm_sched(4, 0, [&](bool, int mt, int nt) { gemm_tile2(ALoadPlain{(const bf16*)(ws + wsl::L3_AO), LW}, WB + wbo::OUT, 1280, mt * 128, nt * 256, EpiResid{X, X, nullptr, parts}, smem); });
    } else if (PH == PH_FINAL) {
        rows_final(X, parts, p.final_g);
    }
}

template <int PH> __global__ void __launch_bounds__(NTHREADS, 2) k_phase(Params p) {
    extern __shared__ __attribute__((aligned(16))) char smem[];
    run_phase<PH>(p, smem);
}
#define LDS_BYTES 73728
#define MEGA_LDS_BYTES (73728 + 64)
template <int PH> static void launch_phase(const Params& p, hipStream_t s) {
    static bool attr = false;
    if (!attr) { hipFuncSetAttribute((const void*)k_phase<PH>, hipFuncAttributeMaxDynamicSharedMemorySize, LDS_BYTES); attr = true; }
    hipLaunchKernelGGL(k_phase<PH>, dim3(512), dim3(NTHREADS), LDS_BYTES, s, p);
}


#define XB_TMO      128
#define XB_XCNT(j)  (256  + 64 * (j))
#define XB_XSUB(j)  (1280 + 64 * (j))
#define XB_XGEN(j)  (2304 + 64 * (j))
#define XB_TOP      3328
#define XB_TOPGEN   3392
#define XCD_BAR_WORDS 3456
#define XB_SPIN_CAP (1u << 22)
#define LAS __attribute__((address_space(3)))
DI unsigned xb_ld(unsigned* p)              { return __hip_atomic_load(p, __ATOMIC_RELAXED, __HIP_MEMORY_SCOPE_AGENT); }
DI unsigned xb_add(unsigned* p, unsigned v) { return __hip_atomic_fetch_add(p, v, __ATOMIC_RELAXED, __HIP_MEMORY_SCOPE_AGENT); }
DI unsigned xb_xcc_id() { return (unsigned)__builtin_amdgcn_s_getreg((3 << 11) | 20) & 0xFu; }
#define XB_SPIN(cond, bar) do { unsigned _sp = 0; while (cond) { if (_sp < 64u) __builtin_amdgcn_s_sleep(2); else __builtin_amdgcn_s_sleep(32); \
    if ((++_sp & 255u) == 0u) { if (xb_ld(&(bar)[XB_TMO])) break; if (_sp > XB_SPIN_CAP) { atomicAdd(&(bar)[XB_TMO], 1u); break; } } } } while (0)
struct XcdBarrier { unsigned* bar; unsigned x; volatile LAS unsigned* st; };
DI XcdBarrier xcd_barrier_post(unsigned* bar, volatile LAS unsigned* st) {
    XcdBarrier b; b.bar = bar; b.x = xb_xcc_id(); b.st = st;
    if (threadIdx.x == 0) (void)xb_add(&bar[XB_XCNT(b.x)], 1u);
    return b;
}
DI void xcd_barrier_complete(unsigned* bar, unsigned x, unsigned& nloc, unsigned& nx) {
    const unsigned G = gridDim.x * gridDim.y * gridDim.z;
    unsigned sum, cnt, mine, sp = 0u;
    for (;;) {
        sum = 0u; cnt = 0u; mine = 0u;
#pragma unroll
        for (unsigned j = 0; j < 16; ++j) { const unsigned c = xb_ld(&bar[XB_XCNT(j)]); sum += c; cnt += (c > 0u) ? 1u : 0u; mine = (j == x) ? c : mine; }
        if (sum == G) break;
        __builtin_amdgcn_s_sleep(1);
        if ((++sp & 255u) == 0u) { if (xb_ld(&bar[XB_TMO])) break; if (sp > XB_SPIN_CAP) { atomicAdd(&bar[XB_TMO], 1u); break; } }
    }
    nloc = mine > 0u ? mine : 1u; nx = cnt > 0u ? cnt : 1u;
}
DI void xcd_barrier(const XcdBarrier& b) {
    asm volatile("s_waitcnt vmcnt(0)" ::: "memory");
    __syncthreads();
    if (threadIdx.x == 0) {
        unsigned* bar = b.bar;
        __builtin_amdgcn_s_waitcnt(0);
        unsigned nloc = b.st[0], nx = b.st[1];
        if (nloc == 0u) { xcd_barrier_complete(bar, b.x, nloc, nx); b.st[0] = nloc; b.st[1] = nx; }
        const unsigned old = xb_add(&bar[XB_XSUB(b.x)], 1u);
        const unsigned gen = old / nloc;
        if (old + 1u == (gen + 1u) * nloc) {
            __builtin_amdgcn_fence(__ATOMIC_RELEASE, "agent");
            asm volatile("s_waitcnt vmcnt(0)" ::: "memory");
            const unsigned og = xb_add(&bar[XB_TOP], 1u);
            const unsigned tg = og / nx;
            if (og + 1u == (tg + 1u) * nx) xb_add(&bar[XB_TOPGEN], 1u);
            else XB_SPIN(xb_ld(&bar[XB_TOPGEN]) == tg, bar);
            __builtin_amdgcn_fence(__ATOMIC_ACQUIRE, "agent");
            xb_add(&bar[XB_XGEN(b.x)], 1u);
            asm volatile("s_waitcnt vmcnt(0)" ::: "memory");
        } else {
            XB_SPIN(xb_ld(&bar[XB_XGEN(b.x)]) == gen, bar);
            __builtin_amdgcn_fence(__ATOMIC_ACQUIRE, "agent");
            asm volatile("s_waitcnt vmcnt(0)" ::: "memory");
        }
    }
    __syncthreads();
}

#define MEGA_PHASES(X) X(PH_IN0) X(PH_ATTN0) X(PH_OUT0) X(PH_PREP1) X(PH_IN1) X(PH_LORA1) X(PH_CPREP1) X(PH_SCAN1) X(PH_GN1) X(PH_OUT1) \
    X(PH_PREP2) X(PH_IN2) X(PH_B2) X(PH_C2) X(PH_D2) X(PH_OUT2) X(PH_PREP3) X(PH_IN3) X(PH_GATE3) X(PH_SCANB3) X(PH_OUT3)
__global__ void __launch_bounds__(NTHREADS, 2) mega_kernel(Params p) {
    extern __shared__ __attribute__((aligned(16))) char smem[];
    cooperative_groups::grid_group grid = cooperative_groups::this_grid();
    volatile LAS unsigned* xst = (volatile LAS unsigned*)(smem + 73728);
    if (threadIdx.x < 4) xst[threadIdx.x] = 0u;
    __syncthreads();
    XcdBarrier xb = xcd_barrier_post((unsigned*)p.ws, xst);
    run_phase<PH_PREP0>(p, smem);
    if (p.ws == nullptr) grid.sync();
    xcd_barrier(xb);
#define MEGA_STEP(ph) run_phase<ph>(p, smem); xcd_barrier(xb);
    MEGA_PHASES(MEGA_STEP)
#undef MEGA_STEP
    run_phase<PH_FINAL>(p, smem);
}
static void launch_mega(const Params& p, hipStream_t s) {
    static int grid_blocks = 0;
    if (!grid_blocks) {
        int dev = 0, cus = 0, per_cu = 0;
        hipGetDevice(&dev);
        hipDeviceGetAttribute(&cus, hipDeviceAttributeMultiprocessorCount, dev);
        hipFuncSetAttribute((const void*)mega_kernel, hipFuncAttributeMaxDynamicSharedMemorySize, MEGA_LDS_BYTES);
        hipOccupancyMaxActiveBlocksPerMultiprocessor(&per_cu, mega_kernel, NTHREADS, MEGA_LDS_BYTES);
        if (per_cu > 2) per_cu = 2;
        if (per_cu < 1) per_cu = 1;
        grid_blocks = cus * per_cu;
    }
    hipMemsetAsync(p.ws, 0, 16384, s);
    Params pp = p; void* args[] = {&pp};
    hipError_t e = hipLaunchCooperativeKernel((const void*)mega_kernel, dim3(grid_blocks), dim3(NTHREADS), args, MEGA_LDS_BYTES, s);
    if (e != hipSuccess) fprintf(stderr, "cooperative launch failed: %s (grid %d)\n", hipGetErrorString(e), grid_blocks);
}
#endif

#ifndef CPU_SHIM
template <class F> __global__ void __launch_bounds__(256) k_run(F f, long n) {
    const long i = (long)blockIdx.x * 256 + threadIdx.x; if (i < n) f(i);
}
template <class F> static void launch(const F& f, long n, hipStream_t s) {
    hipLaunchKernelGGL(k_run<F>, dim3((unsigned)((n + 255) / 256)), dim3(256), 0, s, f, n);
}
#else
template <class F> static void launch(const F& f, long n, hipStream_t) {
#pragma omp parallel for schedule(dynamic, 64)
    for (long i = 0; i < n; ++i) f(i);
}
#endif

#ifdef CPU_SHIM
void cpu_layer_hook(int layer, const float* X, const char* ws);
#define LAYER_HOOK(l) cpu_layer_hook(l, X, ws)
#else
#define LAYER_HOOK(l)
#endif

#define FAST_GEMM 0
#if FAST_GEMM
#define FASTP(ph) launch_phase<ph>(p, s)
#else
#define FASTP(ph)
#endif

static void run_naive(const Params& p, hipStream_t s) {
    char* ws = p.ws;
    float* rs = (float*)(ws + wsl::RS);
    bf16* P = (bf16*)(ws + wsl::P);
    float* X = p.out;
    (void)rs;
    {
        bf16* AO = (bf16*)(ws + wsl::L0_AO);
#if FAST_GEMM
        FASTP(PH_PREP0); FASTP(PH_IN0);
#else
        launch(RstdF{p.x, rs}, M, s);
        launch(GemmInF{p.x, rs, p.norm_g + 0 * D, p.a_w_in, P, A_COLS}, (long)M * (A_COLS / 4), s);
#endif
#if FAST_GEMM
        FASTP(PH_ATTN0); (void)AO;
#else
        launch(SwaF{P, p.t5, p.a_sinks, AO}, (long)M * H, s);
#endif
#if FAST_GEMM
        FASTP(PH_OUT0);
#else
        launch(GemmOutF{AO, p.a_w_out, p.x, X, 1024}, (long)M * (D / 4), s);
#endif
    }
    LAYER_HOOK(0);
    {
        bf16* XN = (bf16*)(ws + wsl::L1_XN); bf16* WL = (bf16*)(ws + wsl::L1_WL); bf16* AV = (bf16*)(ws + wsl::L1_AV);
        float* hw = (float*)(ws + wsl::LHW); float* ha = (float*)(ws + wsl::LHA);
#if FAST_GEMM
        FASTP(PH_PREP1); FASTP(PH_IN1); FASTP(PH_LORA1); FASTP(PH_CPREP1); FASTP(PH_SCAN1); FASTP(PH_GN1); FASTP(PH_OUT1);
        (void)XN; (void)WL; (void)AV; (void)hw; (void)ha;
#else
        launch(RstdF{X, rs}, M, s);
        launch(XnF{X, rs, p.norm_g + 1 * D, XN}, (long)M * D, s);
        launch(GemmRwkvF{XN, p.b_mu, p.b_w_in, P}, (long)M * 1024, s);
        launch(LoraHidF{XN, p.b_mu, p.b_w1, p.b_a1, hw, ha}, (long)M * 128, s);
        launch(LoraOutF{hw, ha, p.b_w0, p.b_w2, p.b_a0, p.b_a2, WL, AV}, (long)M * D, s);
        launch(RwkvScanF{P, WL, AV, p.b_k_k, p.b_k_a, XN}, (long)B * H * 64, s);
        launch(RwkvGnF{P, AV, p.b_k_a, p.b_r_k, p.b_lnx_w, p.b_lnx_b, XN}, (long)M * H, s);
        launch(GemmOutF{XN, p.b_w_out, X, X, 1024}, (long)M * (D / 4), s);
#endif
    }
    LAYER_HOOK(1);
    {
        float* hk = (float*)(ws + wsl::HK); float* hv = (float*)(ws + wsl::HV);
        float* kc = (float*)(ws + wsl::KC); float* vc = (float*)(ws + wsl::VC);
        float* st = (float*)(ws + wsl::ST); int* sel = (int*)(ws + wsl::SEL); float* imp = (float*)(ws + wsl::L2_IMP);
        bf16* AO = (bf16*)(ws + wsl::L2_AO); bf16* OC = (bf16*)(ws + wsl::L2_OC); bf16* OS = (bf16*)(ws + wsl::L2_OS);
#if FAST_GEMM
        FASTP(PH_PREP2); FASTP(PH_IN2); FASTP(PH_B2); FASTP(PH_C2); FASTP(PH_D2); FASTP(PH_OUT2);
        (void)hk; (void)hv; (void)kc; (void)vc; (void)st; (void)sel; (void)imp; (void)AO; (void)OC; (void)OS;
#else
        launch(RstdF{X, rs}, M, s);
        launch(GemmInF{X, rs, p.norm_g + 2 * D, p.c_w_in, P, C_COLS}, (long)M * (C_COLS / 4), s);
        launch(CmpHidF{P, p.c_pos_k, p.c_k_w1, p.c_pos_v, p.c_v_w1, hk, hv}, 2L * B * G * NCMP * 128, s);
        launch(CmpOutF{hk, hv, p.c_k_w2, p.c_v_w2, kc, vc}, 2L * B * G * NCMP * 64, s);
        launch(CmpAttnF{P, kc, vc, st, OC}, (long)M * H, s);
        launch(ImpF{P, kc, st, imp}, (long)M * G * NSEL, s);
        launch(TopkF{imp, sel}, (long)M * G, s);
        launch(SelAttnF{P, p.t5, sel, OS}, (long)M * H, s);
        launch(WinAttnF{P, p.t5, OC, OS, AO}, (long)M * H, s);
        LAYER_HOOK(20);
        launch(GemmOutF{AO, p.c_w_out, X, X, 1024}, (long)M * (D / 4), s);
#endif
    }
    LAYER_HOOK(2);
    {
        bf16* AO = (bf16*)(ws + wsl::L3_AO); bf16* UC = (bf16*)(ws + wsl::L3_UC); bf16* LA = (bf16*)(ws + wsl::L3_LA); bf16* BV = (bf16*)(ws + wsl::L3_BV);
#if FAST_GEMM
        FASTP(PH_PREP3); FASTP(PH_IN3); FASTP(PH_GATE3); FASTP(PH_SCANA3); FASTP(PH_SCANB3); FASTP(PH_OUT3);
        (void)AO; (void)UC; (void)LA; (void)BV;
#else
        launch(RstdF{X, rs}, M, s);
        launch(GemmInF{X, rs, p.norm_g + 3 * D, p.d_w_in, P, 2560}, (long)M * (2560 / 4), s);
        launch(ConvF{P, p.d_conv_w, p.d_conv_b, UC}, (long)M * LW, s);
        launch(LruGateF{UC, p.d_ga_w, p.d_ga_b, p.d_gx_w, p.d_gx_b, p.d_lambda, LA, BV}, (long)M * LW, s);
        launch(LruScanF{P, LA, BV, AO}, (long)B * LW, s);
        launch(GemmOutF{AO, p.d_w_out, X, X, LW}, (long)M * (D / 4), s);
#endif
    }
    LAYER_HOOK(3);
#if FAST_GEMM
    FASTP(PH_FINAL);
#else
    launch(FinalNormF{X, p.final_g}, M, s);
#endif
}

extern "C" void kernel_launch(void* const* d_in, const int* in_sizes, int n_in, void* d_out, int out_size, void* d_ws, size_t ws_size,
                              hipStream_t stream) {
    (void)in_sizes; (void)n_in; (void)out_size; (void)ws_size;
    Params p{};
    const float* const* in = (const float* const*)d_in;
    int k = 0;
    p.x = in[k++]; p.t5 = in[k++]; p.norm_g = in[k++]; p.final_g = in[k++];
    p.a_w_in = in[k++]; p.a_sinks = in[k++]; p.a_w_out = in[k++];
    p.b_mu = in[k++]; p.b_w_in = in[k++]; p.b_w0 = in[k++]; p.b_w1 = in[k++]; p.b_w2 = in[k++]; p.b_a0 = in[k++]; p.b_a1 = in[k++]; p.b_a2 = in[k++];
    p.b_k_k = in[k++]; p.b_k_a = in[k++]; p.b_r_k = in[k++]; p.b_lnx_w = in[k++]; p.b_lnx_b = in[k++]; p.b_w_out = in[k++];
    p.c_w_in = in[k++]; p.c_pos_k = in[k++]; p.c_k_w1 = in[k++]; p.c_k_w2 = in[k++]; p.c_pos_v = in[k++]; p.c_v_w1 = in[k++]; p.c_v_w2 = in[k++]; p.c_w_out = in[k++];
    p.d_w_in = in[k++]; p.d_conv_w = in[k++]; p.d_conv_b = in[k++]; p.d_ga_w = in[k++]; p.d_ga_b = in[k++]; p.d_gx_w = in[k++]; p.d_gx_b = in[k++];
    p.d_lambda = in[k++]; p.d_w_out = in[k++];
    p.out = (float*)d_out; p.ws = (char*)d_ws;
#if !defined(CPU_SHIM) && !defined(MULTI_LAUNCH) && !defined(ALL_NAIVE)
    launch_mega(p, stream);
#else
    run_naive(p, stream);
#endif
}
```

```cpp
#ifndef CPU_SHIM
#include <hip/hip_runtime.h>
#include <hip/hip_cooperative_groups.h>
#include <cstdio>
#define HD __host__ __device__ __forceinline__
#else
#include <cmath>
#include <cstring>
#include <cstdio>
#include <cstdlib>
#include <cstdint>
#define HD inline
typedef void* hipStream_t;
#endif
#include <cstddef>

#ifndef CFG_B
#define CFG_B 4
#endif
#ifndef CFG_T
#define CFG_T 4096
#endif

namespace cfg {
constexpr int B = CFG_B, T = CFG_T, M = B * T, D = 1024;
constexpr int H = 16, G = 4, R = 4, DH = 64;
constexpr int A_COLS = 2560;
constexpr int C_COLS = 3632;
constexpr int NCMP = (T - 32) / 16 + 1;
constexpr int NSEL = T / 64;
constexpr int KTOP = NSEL < 16 ? NSEL : 16;
constexpr int LW = 1280;
}
using namespace cfg;

typedef unsigned short bf16;

HD unsigned f_as_u(float f) {
#ifndef CPU_SHIM
    return __float_as_uint(f);
#else
    unsigned u; memcpy(&u, &f, 4); return u;
#endif
}
HD float u_as_f(unsigned u) {
#ifndef CPU_SHIM
    return __uint_as_float(u);
#else
    float f; memcpy(&f, &u, 4); return f;
#endif
}
HD float bf2f(bf16 v) { return u_as_f(((unsigned)v) << 16); }
HD bf16 f2bf(float f) { unsigned u = f_as_u(f); u += 0x7fffu + ((u >> 16) & 1u); return (bf16)(u >> 16); }
HD float sigmoidf_(float x) { return 1.0f / (1.0f + expf(-x)); }
HD float siluf_(float x) { return x / (1.0f + expf(-x)); }
HD float softplusf_(float x) { return x > 20.f ? x : log1pf(expf(x)); }

HD int t5_bucket(int d) {
    if (d < 16) return d < 0 ? 0 : d;
    if (d >= 113) return 31;
    if (d >= 99) return 30;
    if (d >= 87) return 29;
    if (d >= 77) return 28;
    if (d >= 67) return 27;
    if (d >= 59) return 26;
    if (d >= 52) return 25;
    if (d >= 46) return 24;
    if (d >= 40) return 23;
    if (d >= 35) return 22;
    if (d >= 31) return 21;
    if (d >= 27) return 20;
    if (d >= 24) return 19;
    if (d >= 21) return 18;
    if (d >= 19) return 17;
    return 16;
}

struct Params {
    const float *x, *t5, *norm_g, *final_g;
    const float *a_w_in, *a_sinks, *a_w_out;
    const float *b_mu, *b_w_in, *b_w0, *b_w1, *b_w2, *b_a0, *b_a1, *b_a2, *b_k_k, *b_k_a, *b_r_k, *b_lnx_w, *b_lnx_b, *b_w_out;
    const float *c_w_in, *c_pos_k, *c_k_w1, *c_k_w2, *c_pos_v, *c_v_w1, *c_v_w2, *c_w_out;
    const float *d_w_in, *d_conv_w, *d_conv_b, *d_ga_w, *d_ga_b, *d_gx_w, *d_gx_b, *d_lambda, *d_w_out;
    float* out;
    char* ws;
};

namespace wsl {
constexpr size_t MB = 1024 * 1024;
constexpr size_t RS = 0;
constexpr size_t HK = 1 * MB;
constexpr size_t HV = 3 * MB;
constexpr size_t KC = 5 * MB;
constexpr size_t VC = 6 * MB;
constexpr size_t ST = 7 * MB;
constexpr size_t SEL = 9 * MB;
constexpr size_t LHW = 1 * MB;
constexpr size_t LHA = 5 * MB;
constexpr size_t P = 14 * MB;
constexpr size_t SZ1024 = (size_t)M * 1024 * 2, SZ1280 = (size_t)M * 1280 * 2;
constexpr size_t L0_AO = P + (size_t)M * 2560 * 2;
constexpr size_t L1_XN = P + (size_t)M * 4096 * 2, L1_WL = L1_XN + SZ1024, L1_AV = L1_WL + SZ1024;
constexpr size_t L2_AO = P + (size_t)M * 3632 * 2, L2_OC = L2_AO + SZ1024, L2_OS = L2_OC + SZ1024, L2_IMP = L2_OS + SZ1024;
constexpr size_t L3_AO = P + (size_t)M * 2560 * 2, L3_UC = L3_AO + SZ1280, L3_LA = L3_UC + SZ1280, L3_BV = L3_LA + SZ1280;
constexpr size_t TOTAL = L3_BV + SZ1280;
}

struct RstdF {
    const float* x; float* rs;
    HD void operator()(long m) const {
        const float* r = x + (size_t)m * D; float s = 0.f;
        for (int k = 0; k < D; ++k) s += r[k] * r[k];
        rs[m] = 1.0f / sqrtf(s / D + 1e-6f);
    }
};
struct XnF {
    const float* x; const float* rs; const float* g; bf16* xn;
    HD void operator()(long i) const { long m = i / D; int k = (int)(i % D); xn[i] = f2bf(x[i] * rs[m] * g[k]); }
};
struct GemmInF {
    const float *x, *rs, *g, *W; bf16* P; long long N;
    HD void operator()(long i) const {
        const int n4 = (int)N / 4; const long m = i / n4; const int n = (int)(i % n4) * 4;
        const float* xr = x + (size_t)m * D; const float r = rs[m];
        float a0 = 0, a1 = 0, a2 = 0, a3 = 0;
        for (int k = 0; k < D; ++k) {
            const float a = xr[k] * r * g[k]; const float* w = W + (size_t)k * N + n;
            a0 += a * w[0]; a1 += a * w[1]; a2 += a * w[2]; a3 += a * w[3];
        }
        bf16* p = P + (size_t)m * N + n; p[0] = f2bf(a0); p[1] = f2bf(a1); p[2] = f2bf(a2); p[3] = f2bf(a3);
    }
};
struct GemmOutF {
    const bf16* A; const float* W; const float* xin; float* xout; long long K;
    HD void operator()(long i) const {
        const int n4 = D / 4; const long m = i / n4; const int n = (int)(i % n4) * 4;
        const bf16* ar = A + (size_t)m * K;
        float a0 = 0, a1 = 0, a2 = 0, a3 = 0;
        for (int k = 0; k < K; ++k) {
            const float a = bf2f(ar[k]); const float* w = W + (size_t)k * D + n;
            a0 += a * w[0]; a1 += a * w[1]; a2 += a * w[2]; a3 += a * w[3];
        }
        const float* xi = xin + (size_t)m * D + n; float* xo = xout + (size_t)m * D + n;
        xo[0] = xi[0] + a0; xo[1] = xi[1] + a1; xo[2] = xi[2] + a2; xo[3] = xi[3] + a3;
    }
};

struct SwaF {
    const bf16* P; const float* t5; const float* sinks; bf16* AO;
    HD void operator()(long i) const {
        const long m = i / H; const int h = (int)(i % H), g = h / R; const int t = (int)(m % T); const long mb = m - t;
        float q[DH], o[DH];
#pragma unroll
        for (int d = 0; d < DH; ++d) { q[d] = bf2f(P[(size_t)m * A_COLS + h * DH + d]); o[d] = 0.f; }
        float mx = sinks[h], l = 1.0f;
        const int s0 = t - 127 < 0 ? 0 : t - 127;
        for (int s = s0; s <= t; ++s) {
            const bf16* kr = P + (size_t)(mb + s) * A_COLS + 1024 + g * DH;
            const bf16* vr = kr + 256;
            float sc = 0.f;
#pragma unroll
            for (int d = 0; d < DH; ++d) sc += q[d] * bf2f(kr[d]);
            sc = sc * 0.125f + t5[t5_bucket(t - s) * H + h];
            const float mn = sc > mx ? sc : mx; const float al = expf(mx - mn), p = expf(sc - mn);
            l = l * al + p; mx = mn;
#pragma unroll
            for (int d = 0; d < DH; ++d) o[d] = o[d] * al + p * bf2f(vr[d]);
        }
        const float il = 1.0f / l;
#pragma unroll
        for (int d = 0; d < DH; ++d) {
            const float z = bf2f(P[(size_t)m * A_COLS + 1536 + h * DH + d]);
            AO[(size_t)m * D + h * DH + d] = f2bf(o[d] * il * siluf_(z));
        }
    }
};

struct GemmRwkvF {
    const bf16* xn; const float* mu; const float* W; bf16* P;
    HD void operator()(long i) const {
        const int N = 4096, n4 = N / 4; const long m = i / n4; const int n = (int)(i % n4) * 4; const int s = n / 1024;
        const int t = (int)(m % T);
        const bf16* xr = xn + (size_t)m * D; const float* mus = mu + s * D;
        float a0 = 0, a1 = 0, a2 = 0, a3 = 0;
        for (int k = 0; k < D; ++k) {
            const float xc = bf2f(xr[k]); const float xp = t > 0 ? bf2f(xr[k - D]) : 0.f;
            const float a = xc + (xp - xc) * mus[k]; const float* w = W + (size_t)k * N + n;
            a0 += a * w[0]; a1 += a * w[1]; a2 += a * w[2]; a3 += a * w[3];
        }
        bf16* p = P + (size_t)m * N + n; p[0] = f2bf(a0); p[1] = f2bf(a1); p[2] = f2bf(a2); p[3] = f2bf(a3);
    }
};
struct LoraHidF {
    const bf16* xn; const float* mu; const float* w1; const float* a1; float* hw; float* ha;
    HD void operator()(long i) const {
        const long m = i / 128; const int jj = (int)(i % 128); const int which = jj / 64, j = jj % 64; const int t = (int)(m % T);
        const bf16* xr = xn + (size_t)m * D; const float* mus = mu + (4 + which) * D; const float* W = which ? a1 : w1;
        float acc = 0.f;
        for (int k = 0; k < D; ++k) {
            const float xc = bf2f(xr[k]); const float xp = t > 0 ? bf2f(xr[k - D]) : 0.f;
            acc += (xc + (xp - xc) * mus[k]) * W[(size_t)k * 64 + j];
        }
        if (which) ha[(size_t)m * 64 + j] = acc; else hw[(size_t)m * 64 + j] = tanhf(acc);
    }
};
struct LoraOutF {
    const float *hw, *ha, *w0, *w2, *a0, *a2; bf16* wlog; bf16* av;
    HD void operator()(long i) const {
        const long m = i / D; const int c = (int)(i % D);
        float sw = 0.f, sa = 0.f;
        for (int j = 0; j < 64; ++j) { sw += hw[(size_t)m * 64 + j] * w2[(size_t)j * D + c]; sa += ha[(size_t)m * 64 + j] * a2[(size_t)j * D + c]; }
        const float wr = -softplusf_(-(w0[c] + sw)) - 0.5f;
        wlog[i] = f2bf(-expf(wr)); av[i] = f2bf(sigmoidf_(a0[c] + sa));
    }
};
struct RwkvScanF {
    const bf16* P; const bf16* wlog; const bf16* av; const float* k_k; const float* k_a; bf16* ys;
    HD void operator()(long idx) const {
        const int i = (int)(idx % 64); const int h = (int)((idx / 64) % H); const int b = (int)(idx / (64 * H));
        float S[64];
#pragma unroll
        for (int j = 0; j < 64; ++j) S[j] = 0.f;
        for (int t = 0; t < T; ++t) {
            const size_t m = (size_t)b * T + t; const bf16* pr = P + m * 4096 + h * 64;
            const bf16* wl = wlog + m * D + h * 64; const bf16* ar = av + m * D + h * 64;
            float n2 = 0.f;
#pragma unroll
            for (int j = 0; j < 64; ++j) { const float kk = bf2f(pr[1024 + j]) * k_k[h * 64 + j]; n2 += kk * kk; }
            float nr = sqrtf(n2); nr = nr > 1e-12f ? nr : 1e-12f; const float inr = 1.0f / nr;
            float sa = 0.f;
#pragma unroll
            for (int j = 0; j < 64; ++j) { const float kk = bf2f(pr[1024 + j]) * k_k[h * 64 + j] * inr; sa += S[j] * (-kk); }
            const float vi = bf2f(pr[2048 + i]); float y = 0.f;
#pragma unroll
            for (int j = 0; j < 64; ++j) {
                const float kr = bf2f(pr[1024 + j]); const float a = bf2f(ar[j]);
                const float kk = kr * k_k[h * 64 + j] * inr; const float kp = kr * (1.0f + (a - 1.0f) * k_a[h * 64 + j]);
                const float dec = expf(bf2f(wl[j]));
                S[j] = S[j] * dec + sa * (kk * a) + vi * kp;
                y += S[j] * bf2f(pr[j]);
            }
            ys[m * D + h * 64 + i] = f2bf(y);
        }
    }
};
struct RwkvGnF {
    const bf16* P; const bf16* av; const float *k_a, *r_k, *lnx_w, *lnx_b; bf16* ys;
    HD void operator()(long idx) const {
        const long m = idx / H; const int h = (int)(idx % H);
        bf16* yr = ys + (size_t)m * D + h * 64; const bf16* pr = P + (size_t)m * 4096 + h * 64; const bf16* ar = av + (size_t)m * D + h * 64;
        float mean = 0.f;
        for (int j = 0; j < 64; ++j) mean += bf2f(yr[j]);
        mean /= 64.f; float var = 0.f;
        for (int j = 0; j < 64; ++j) { const float d = bf2f(yr[j]) - mean; var += d * d; }
        var /= 64.f; const float rstd = 1.0f / sqrtf(var + 64e-5f);
        float bs = 0.f;
        for (int j = 0; j < 64; ++j) { const float kr = bf2f(pr[1024 + j]); const float kp = kr * (1.0f + (bf2f(ar[j]) - 1.0f) * k_a[h * 64 + j]); bs += bf2f(pr[j]) * kp * r_k[h * 64 + j]; }
        for (int j = 0; j < 64; ++j) {
            const float yn = (bf2f(yr[j]) - mean) * rstd * lnx_w[h * 64 + j] + lnx_b[h * 64 + j];
            const float z = bf2f(pr[3072 + j]);
            yr[j] = f2bf((yn + bs * bf2f(pr[2048 + j])) * siluf_(z));
        }
    }
};

struct CmpHidF {
    const bf16* P; const float *pos_k, *w1_k, *pos_v, *w1_v; float* hk; float* hv;
    HD void operator()(long idx) const {
        const int j = (int)(idx % 128); long r = idx / 128; const int n = (int)(r % NCMP); r /= NCMP; const int g = (int)(r % G); r /= G;
        const int b = (int)(r % B); const int which = (int)(r / B);
        const float* pos = which ? pos_v : pos_k; const float* w1 = which ? w1_v : w1_k; const int col = 1024 + (which ? 256 : 0) + g * 64;
        float acc = 0.f;
        for (int l = 0; l < 32; ++l) {
            const bf16* src = P + (size_t)(b * T + 16 * n + l) * C_COLS + col;
            for (int d = 0; d < 64; ++d) acc += (bf2f(src[d]) + pos[l * 64 + d]) * w1[(size_t)(l * 64 + d) * 128 + j];
        }
        (which ? hv : hk)[(((size_t)b * G + g) * NCMP + n) * 128 + j] = siluf_(acc);
    }
};
struct CmpOutF {
    const float *hk, *hv, *w2_k, *w2_v; float* kc; float* vc;
    HD void operator()(long idx) const {
        const int d = (int)(idx % 64); long r = idx / 64; const long row = r % ((long)B * G * NCMP); const int which = (int)(r / ((long)B * G * NCMP));
        const float* hsrc = (which ? hv : hk) + (size_t)row * 128; const float* w2 = which ? w2_v : w2_k;
        float acc = 0.f;
        for (int j = 0; j < 128; ++j) acc += hsrc[j] * w2[j * 64 + d];
        (which ? vc : kc)[(size_t)row * 64 + d] = acc;
    }
};
struct CmpAttnF {
    const bf16* P; const float *kc, *vc; float* st; bf16* oc;
    HD void operator()(long i) const {
        const long m = i / H; const int h = (int)(i % H), g = h / R; const int t = (int)(m % T); const int b = (int)(m / T);
        float q[DH], o[DH];
#pragma unroll
        for (int d = 0; d < DH; ++d) { q[d] = bf2f(P[(size_t)m * C_COLS + h * DH + d]); o[d] = 0.f; }
        const int nv = t < 31 ? 0 : (t - 31) / 16 + 1;
        float mx = -1e30f, l = 0.f;
        for (int n = 0; n < nv; ++n) {
            const float* kr = kc + (((size_t)b * G + g) * NCMP + n) * 64; const float* vr = vc + (((size_t)b * G + g) * NCMP + n) * 64;
            float sc = 0.f;
#pragma unroll
            for (int d = 0; d < DH; ++d) sc += q[d] * kr[d];
            sc *= 0.125f;
            const float mn = sc > mx ? sc : mx; const float al = expf(mx - mn), p = expf(sc - mn);
            l = l * al + p; mx = mn;
#pragma unroll
            for (int d = 0; d < DH; ++d) o[d] = o[d] * al + p * vr[d];
        }
        const float il = nv > 0 ? 1.0f / l : 0.f;
        st[(size_t)i * 2] = mx; st[(size_t)i * 2 + 1] = il;
#pragma unroll
        for (int d = 0; d < DH; ++d) oc[(size_t)m * D + h * DH + d] = f2bf(o[d] * il);
    }
};
struct ImpF {
    const bf16* P; const float *kc, *st; float* imp;
    HD void operator()(long idx) const {
        const int s = (int)(idx % NSEL); long r = idx / NSEL; const int g = (int)(r % G); const long m = r / G;
        const int t = (int)(m % T); const int b = (int)(m / T); const int cur = t / 64;
        float v;
        if (s == 0 || s == cur || s == cur - 1) v = 1e30f;
        else if (s * 64 > t) v = -1e30f;
        else {
            v = 0.f; const int nv = t < 31 ? 0 : (t - 31) / 16 + 1;
            int n0 = 4 * s - 1; if (n0 < 0) n0 = 0; int n1 = 4 * s + 3; if (n1 > NCMP - 1) n1 = NCMP - 1; if (n1 > nv - 1) n1 = nv - 1;
            for (int rr = 0; rr < R; ++rr) {
                const int h = g * R + rr; const bf16* qr = P + (size_t)m * C_COLS + h * DH;
                const float mx = st[((size_t)m * H + h) * 2], il = st[((size_t)m * H + h) * 2 + 1];
                for (int n = n0; n <= n1; ++n) {
                    const float* kr = kc + (((size_t)b * G + g) * NCMP + n) * 64; float sc = 0.f;
                    for (int d = 0; d < DH; ++d) sc += bf2f(qr[d]) * kr[d];
                    v += expf(sc * 0.125f - mx) * il;
                }
            }
        }
        imp[idx] = v;
    }
};
struct TopkF {
    const float* imp; int* sel;
    HD void operator()(long idx) const {
        const float* v = imp + (size_t)idx * NSEL; unsigned long long used = 0ull;
        for (int j = 0; j < KTOP; ++j) {
            int best = -1; float bv = 0.f;
            for (int s = 0; s < NSEL; ++s) { if ((used >> s) & 1ull) continue; const float x = v[s]; if (best < 0 || x > bv) { best = s; bv = x; } }
            used |= 1ull << best; sel[(size_t)idx * 16 + j] = best;
        }
    }
};
struct SelAttnF {
    const bf16* P; const float* t5; const int* sel; bf16* os;
    HD void operator()(long i) const {
        const long m = i / H; const int h = (int)(i % H), g = h / R; const int t = (int)(m % T); const long mb = m - t;
        float q[DH], o[DH];
#pragma unroll
        for (int d = 0; d < DH; ++d) { q[d] = bf2f(P[(size_t)m * C_COLS + h * DH + d]); o[d] = 0.f; }
        float mx = -1e30f, l = 0.f;
        for (int j = 0; j < KTOP; ++j) {
            const int blk = sel[((size_t)m * G + g) * 16 + j];
            for (int ll = 0; ll < 64; ++ll) {
                const int s = blk * 64 + ll; if (s > t) break;
                const bf16* kr = P + (size_t)(mb + s) * C_COLS + 1536 + g * DH; const bf16* vr = kr + 256;
                float sc = 0.f;
#pragma unroll
                for (int d = 0; d < DH; ++d) sc += q[d] * bf2f(kr[d]);
                sc = sc * 0.125f + t5[t5_bucket(t - s) * H + h];
                const float mn = sc > mx ? sc : mx; const float al = expf(mx - mn), p = expf(sc - mn);
                l = l * al + p; mx = mn;
#pragma unroll
                for (int d = 0; d < DH; ++d) o[d] = o[d] * al + p * bf2f(vr[d]);
            }
        }
        const float il = 1.0f / l;
#pragma unroll
        for (int d = 0; d < DH; ++d) os[(size_t)m * D + h * DH + d] = f2bf(o[d] * il);
    }
};
struct WinAttnF {
    const bf16* P; const float* t5; const bf16* oc; const bf16* os; bf16* AO;
    HD void operator()(long i) const {
        const long m = i / H; const int h = (int)(i % H), g = h / R, rr = h % R; const int t = (int)(m % T); const long mb = m - t;
        float q[DH], o[DH];
#pragma unroll
        for (int d = 0; d < DH; ++d) { q[d] = bf2f(P[(size_t)m * C_COLS + h * DH + d]); o[d] = 0.f; }
        float mx = -1e30f, l = 0.f;
        const int s0 = t - 511 < 0 ? 0 : t - 511;
        for (int s = s0; s <= t; ++s) {
            const bf16* kr = P + (size_t)(mb + s) * C_COLS + 2048 + g * DH; const bf16* vr = kr + 256;
            float sc = 0.f;
#pragma unroll
            for (int d = 0; d < DH; ++d) sc += q[d] * bf2f(kr[d]);
            sc = sc * 0.125f + t5[t5_bucket(t - s) * H + h];
            const float mn = sc > mx ? sc : mx; const float al = expf(mx - mn), p = expf(sc - mn);
            l = l * al + p; mx = mn;
#pragma unroll
            for (int d = 0; d < DH; ++d) o[d] = o[d] * al + p * bf2f(vr[d]);
        }
        const float il = 1.0f / l;
        const bf16* gr = P + (size_t)m * C_COLS + 2560;
        const float g0 = sigmoidf_(bf2f(gr[0 * 16 + g * R + rr])), g1 = sigmoidf_(bf2f(gr[1 * 16 + g * R + rr])), g2 = sigmoidf_(bf2f(gr[2 * 16 + g * R + rr]));
#pragma unroll
        for (int d = 0; d < DH; ++d) {
            const size_t oi = (size_t)m * D + h * DH + d;
            const float z = bf2f(P[(size_t)m * C_COLS + 2608 + h * DH + d]);
            AO[oi] = f2bf((g0 * bf2f(oc[oi]) + g1 * bf2f(os[oi]) + g2 * o[d] * il) * siluf_(z));
        }
    }
};

struct ConvF {
    const bf16* P; const float *cw, *cb; bf16* uc;
    HD void operator()(long i) const {
        const long m = i / LW; const int c = (int)(i % LW); const int t = (int)(m % T);
        float acc = cb[c];
        for (int w = 0; w < 4; ++w) { const int tt = t - 3 + w; if (tt >= 0) acc += cw[w * LW + c] * bf2f(P[(size_t)(m - 3 + w) * 2560 + c]); }
        uc[i] = f2bf(acc);
    }
};
struct LruGateF {
    const bf16* uc; const float *gaw, *gab, *gxw, *gxb, *lam; bf16* la; bf16* bv;
    HD void operator()(long i) const {
        const long m = i / LW; const int c = (int)(i % LW); const int n = c / 80, d = c % 80;
        const bf16* ub = uc + (size_t)m * LW + n * 80; float ra = gab[c], rx = gxb[c];
        for (int k = 0; k < 80; ++k) { const float u = bf2f(ub[k]); ra += u * gaw[((size_t)n * 80 + k) * 80 + d]; rx += u * gxw[((size_t)n * 80 + k) * 80 + d]; }
        const float r = sigmoidf_(ra), ig = sigmoidf_(rx);
        const float loga = -8.0f * r * softplusf_(-lam[c]);
        la[i] = f2bf(loga);
        bv[i] = f2bf(sqrtf(-expm1f(2.0f * loga)) * (ig * bf2f(uc[i])));
    }
};
struct LruScanF {
    const bf16* P; const bf16* la; const bf16* bv; bf16* AO;
    HD void operator()(long idx) const {
        const int c = (int)(idx % LW); const int b = (int)(idx / LW); float h = 0.f;
        for (int t = 0; t < T; ++t) {
            const size_t m = (size_t)b * T + t;
            h = expf(bf2f(la[m * LW + c])) * h + bf2f(bv[m * LW + c]);
            AO[m * LW + c] = f2bf(h * siluf_(bf2f(P[m * 2560 + LW + c])));
        }
    }
};
struct FinalNormF {
    float* x; const float* g;
    HD void operator()(long m) const {
        float* r = x + (size_t)m * D; float s = 0.f;
        for (int k = 0; k < D; ++k) s += r[k] * r[k];
        const float rs = 1.0f / sqrtf(s / D + 1e-6f);
        for (int k = 0; k < D; ++k) r[k] = r[k] * rs * g[k];
    }
};


#ifndef CPU_SHIM
typedef short bf16x8 __attribute__((ext_vector_type(8)));
typedef float f32x4 __attribute__((ext_vector_type(4)));
typedef unsigned u32x4 __attribute__((ext_vector_type(4)));
typedef unsigned u32x2 __attribute__((ext_vector_type(2)));
#define DI __device__ __forceinline__
#define NTHREADS 256
__device__ __forceinline__ int opaque_tid() { int t = threadIdx.x; asm volatile("" : "+v"(t)); return t; }
#define TIDX (opaque_tid())

typedef __bf16 hbf16x2 __attribute__((ext_vector_type(2)));
typedef float f32x2 __attribute__((ext_vector_type(2)));
DI unsigned pack2bf(float lo, float hi) { f32x2 f = {lo, hi}; return __builtin_bit_cast(unsigned, __builtin_convertvector(f, hbf16x2)); }
DI float bflo(unsigned u) { return __uint_as_float(u << 16); }
DI float bfhi(unsigned u) { return __uint_as_float(u & 0xffff0000u); }

namespace fw {
constexpr size_t MB = 1024 * 1024;
constexpr size_t PARTS = 13 * MB;
constexpr size_t SMALLB = 1 * MB;
constexpr size_t WB = 14 * MB;
constexpr size_t XB = 30 * MB;
constexpr size_t BIG = 62 * MB;
}

DI void convert_tile(const float* __restrict__ W, int ldw, int c0, int K, bf16* __restrict__ Wt, const float* __restrict__ g, int kt, int nt, float* sm) {
    const int tid = TIDX;
    const int k0 = kt * 64, n0 = nt * 64;
#pragma unroll
    for (int i = 0; i < 4; ++i) {
        const int kr = (tid >> 4) + 16 * i; const int nc = (tid & 15) * 4;
        const float4 v = *(const float4*)(W + (size_t)(k0 + kr) * ldw + c0 + n0 + nc);
        const float s = g ? g[k0 + kr] : 1.0f;
        sm[kr * 65 + nc + 0] = v.x * s; sm[kr * 65 + nc + 1] = v.y * s; sm[kr * 65 + nc + 2] = v.z * s; sm[kr * 65 + nc + 3] = v.w * s;
    }
    __syncthreads();
    {
        const int n = tid >> 2, kq = (tid & 3) * 16;
        unsigned w[8];
#pragma unroll
        for (int j = 0; j < 8; ++j) w[j] = pack2bf(sm[(kq + 2 * j) * 65 + n], sm[(kq + 2 * j + 1) * 65 + n]);
        u32x4* dst = (u32x4*)(Wt + (size_t)(n0 + n) * K + k0 + kq);
        dst[0] = (u32x4){w[0], w[1], w[2], w[3]}; dst[1] = (u32x4){w[4], w[5], w[6], w[7]};
    }
    __syncthreads();
}
DI void convert_seg(const float* W, int ldw, int c0, int ncols, int K, bf16* Wt, const float* g, float* sm, int& tbase) {
    const int nkt = K / 64, nnt = ncols / 64, ntile = nkt * nnt;
    const int Gd = (int)gridDim.x;
    for (int t = (((int)blockIdx.x - tbase % Gd) + Gd) % Gd; t < ntile; t += Gd) convert_tile(W, ldw, c0, K, Wt, g, t % nkt, t / nkt, sm);
    tbase += ntile;
}

DI int perm32(int rho) { const int n = rho >> 4, i = rho & 15; return 8 * (i >> 2) + 4 * n + (i & 3); }

struct ALoadPlain {
    const bf16* A; int lda;
    static constexpr bool DMA = true;
    DI const bf16* src(int m, int k) const { return A + (size_t)m * lda + k; }
    struct Raw { u32x4 v; };
    DI Raw load(int m, int k) const { Raw r; r.v = *(const u32x4*)(A + (size_t)m * lda + k); return r; }
    DI u32x4 finish(const Raw& r, int, int) const { return r.v; }
};
struct ALoadLerp {
    const bf16* xn; const float* mu;
    static constexpr bool DMA = false;
    DI const bf16* src(int, int) const { return nullptr; }
    struct Raw { u32x4 c, p; };
    DI Raw load(int m, int k) const {
        Raw r; r.c = *(const u32x4*)(xn + (size_t)m * D + k);
        if ((m % T) != 0) r.p = *(const u32x4*)(xn + (size_t)(m - 1) * D + k); else r.p = (u32x4){0u, 0u, 0u, 0u};
        return r;
    }
    DI u32x4 finish(const Raw& r, int, int k) const {
        const float4 m0 = *(const float4*)(mu + k), m1 = *(const float4*)(mu + k + 4);
        const float mm[8] = {m0.x, m0.y, m0.z, m0.w, m1.x, m1.y, m1.z, m1.w};
        u32x4 o;
#pragma unroll
        for (int j = 0; j < 4; ++j) {
            const float c0 = bflo(r.c[j]), c1 = bfhi(r.c[j]), p0 = bflo(r.p[j]), p1 = bfhi(r.p[j]);
            o[j] = pack2bf(c0 + (p0 - c0) * mm[2 * j], c1 + (p1 - c1) * mm[2 * j + 1]);
        }
        return o;
    }
};

#define GLDS16(gp, lp) __builtin_amdgcn_global_load_lds((const unsigned*)(gp), (unsigned*)(lp), 16, 0, 0)
template <class AL, class Epi>
DI void gemm_tile(const AL& al, const bf16* __restrict__ Bt, int K, int m0, int n0, const Epi& epi, char* smem) {
    const int tid = TIDX, lane = tid & 63, wave = __builtin_amdgcn_readfirstlane(tid >> 6), wr = wave >> 1, wc = wave & 1, q = lane >> 4, l15 = lane & 15;
    const int srow = tid >> 3, sc = tid & 7, scs = sc ^ (srow & 7);
    const int st_off = srow * 128 + (sc << 4);
    const int dma_off = (8 * wave) * 128;
    int brow[4];
#pragma unroll
    for (int i = 0; i < 4; ++i) { const int rho = srow + 32 * i; brow[i] = n0 + (rho & ~31) + perm32(rho & 31); }
    const int fa0 = (wr * 64 + l15) * 128 + ((q ^ (lane & 7)) << 4);
    const int fb0 = (wc * 64 + l15) * 128 + ((q ^ (lane & 7)) << 4);
    f32x4 acc[4][4];
#pragma unroll
    for (int i = 0; i < 4; ++i)
#pragma unroll
        for (int j = 0; j < 4; ++j) acc[i][j] = (f32x4){0.f, 0.f, 0.f, 0.f};
    typename AL::Raw ra[4];
    const int nk = K / 64;
    {
        char* bufA = smem; char* bufB = smem + 16384;
#pragma unroll
        for (int i = 0; i < 4; ++i) {
            GLDS16(Bt + (size_t)brow[i] * K + scs * 8, bufB + dma_off + i * 4096);
            if (AL::DMA) GLDS16(al.src(m0 + srow + 32 * i, scs * 8), bufA + dma_off + i * 4096);
            else ra[i] = al.load(m0 + srow + 32 * i, scs * 8);
        }
        if (!AL::DMA) {
#pragma unroll
            for (int i = 0; i < 4; ++i) *(u32x4*)(bufA + st_off + i * 4096) = al.finish(ra[i], m0 + srow + 32 * i, scs * 8);
        }
    }
    asm volatile("s_waitcnt vmcnt(0)" ::: "memory");
    __syncthreads();
    for (int kt = 0; kt < nk; ++kt) {
        char* bufA = smem + (kt & 1) * 32768; char* bufB = bufA + 16384;
        char* nA = smem + ((kt + 1) & 1) * 32768; char* nB = nA + 16384;
        const bool more = kt + 1 < nk; const int kn = (kt + 1) * 64 + scs * 8;
        if (more) {
#pragma unroll
            for (int i = 0; i < 4; ++i) {
                GLDS16(Bt + (size_t)brow[i] * K + kn, nB + dma_off + i * 4096);
                if (AL::DMA) GLDS16(al.src(m0 + srow + 32 * i, kn), nA + dma_off + i * 4096);
                else ra[i] = al.load(m0 + srow + 32 * i, kn);
            }
        }
#pragma unroll
        for (int ks = 0; ks < 2; ++ks) {
            bf16x8 af[4], bfr[4];
#pragma unroll
            for (int i = 0; i < 4; ++i) {
                af[i] = *(const bf16x8*)(bufA + ((fa0 + i * 2048) ^ (ks << 6)));
                bfr[i] = *(const bf16x8*)(bufB + ((fb0 + i * 2048) ^ (ks << 6)));
            }
#pragma unroll
            for (int i = 0; i < 4; ++i)
#pragma unroll
                for (int j = 0; j < 4; ++j) acc[i][j] = __builtin_amdgcn_mfma_f32_16x16x32_bf16(bfr[j], af[i], acc[i][j], 0, 0, 0);
        }
        if (more && !AL::DMA) {
#pragma unroll
            for (int i = 0; i < 4; ++i) *(u32x4*)(nA + st_off + i * 4096) = al.finish(ra[i], m0 + srow + 32 * i, kn);
        }
        asm volatile("s_waitcnt vmcnt(0)" ::: "memory");
        __syncthreads();
    }
#pragma unroll
    for (int mt = 0; mt < 4; ++mt)
#pragma unroll
        for (int gi = 0; gi < 2; ++gi) {
            float v[8];
#pragma unroll
            for (int r = 0; r < 4; ++r) { v[r] = acc[mt][2 * gi][r]; v[4 + r] = acc[mt][2 * gi + 1][r]; }
            epi(m0 + wr * 64 + mt * 16 + l15, n0 + wc * 64 + gi * 32 + 8 * q, v, mt, gi);
        }
    epi.finish(m0, n0, wr, wc, lane);
}

constexpr int G2_STAGE = 24576;
template <class AL, class Epi>
DI void gemm_tile2(const AL& al, const bf16* __restrict__ Bt, int K, int m0, int n0, const Epi& epi, char* smem) {
    const int tid = TIDX, lane = tid & 63, wave = __builtin_amdgcn_readfirstlane(tid >> 6), wr = wave >> 1, wc = wave & 1, q = lane >> 4, l15 = lane & 15;
    const int prow = tid >> 2, ppos = tid & 3, ca = (ppos - 2 * ((tid >> 4) & 3)) & 3;
    const int dma_off = wave * 1024;
    int brow[4];
#pragma unroll
    for (int i = 0; i < 4; ++i) { const int rho = prow + 64 * i; brow[i] = n0 + (rho & ~31) + perm32(rho & 31); }
    const int fpos = ((q + 2 * ((l15 >> 2) & 3)) & 3) << 4;
    const int fa0 = (wr * 64 + l15) * 64 + fpos, fb0 = 8192 + (wc * 128 + l15) * 64 + fpos;
    f32x4 acc[4][8];
#pragma unroll
    for (int i = 0; i < 4; ++i)
#pragma unroll
        for (int j = 0; j < 8; ++j) acc[i][j] = (f32x4){0.f, 0.f, 0.f, 0.f};
    typename AL::Raw ra[2];
    const int nk = K / 32;
#define G2_ISSUE(kt_) { char* st_ = smem + ((kt_) % 3) * G2_STAGE; const int kk_ = (kt_) * 32 + ca * 8; \
        _Pragma("unroll") for (int i = 0; i < 2; ++i) { if (AL::DMA) GLDS16(al.src(m0 + prow + 64 * i, kk_), st_ + dma_off + i * 4096); else ra[i] = al.load(m0 + prow + 64 * i, kk_); } \
        _Pragma("unroll") for (int i = 0; i < 4; ++i) GLDS16(Bt + (size_t)brow[i] * K + kk_, st_ + 8192 + dma_off + i * 4096); }
#define G2_AWRITE(kt_) { if (!AL::DMA) { char* st_ = smem + ((kt_) % 3) * G2_STAGE; const int kk_ = (kt_) * 32 + ca * 8; \
        _Pragma("unroll") for (int i = 0; i < 2; ++i) *(u32x4*)(st_ + (prow + 64 * i) * 64 + ppos * 16) = al.finish(ra[i], m0 + prow + 64 * i, kk_); } }
#define G2_BARRIER() { asm volatile("s_waitcnt lgkmcnt(0)" ::: "memory"); __builtin_amdgcn_s_barrier(); asm volatile("" ::: "memory"); }
    G2_ISSUE(0); G2_AWRITE(0);
    if (nk > 1) { G2_ISSUE(1); G2_AWRITE(1); }
    if (nk > 1) { if (AL::DMA) asm volatile("s_waitcnt vmcnt(6)" ::: "memory"); else asm volatile("s_waitcnt vmcnt(4)" ::: "memory"); } else asm volatile("s_waitcnt vmcnt(0)" ::: "memory");
    G2_BARRIER();
    for (int kt = 0; kt < nk; ++kt) {
        const char* st = smem + (kt % 3) * G2_STAGE;
        const bool more = kt + 2 < nk;
        if (more) G2_ISSUE(kt + 2);
        bf16x8 af[4];
#pragma unroll
        for (int i = 0; i < 4; ++i) af[i] = *(const bf16x8*)(st + fa0 + i * 1024);
#pragma unroll
        for (int j = 0; j < 8; ++j) {
            const bf16x8 bf_ = *(const bf16x8*)(st + fb0 + j * 1024);
#pragma unroll
            for (int i = 0; i < 4; ++i) acc[i][j] = __builtin_amdgcn_mfma_f32_16x16x32_bf16(bf_, af[i], acc[i][j], 0, 0, 0);
        }
        if (more) G2_AWRITE(kt + 2);
        if (more) { if (AL::DMA) asm volatile("s_waitcnt vmcnt(6)" ::: "memory"); else asm volatile("s_waitcnt vmcnt(4)" ::: "memory"); } else asm volatile("s_waitcnt vmcnt(0)" ::: "memory");
        G2_BARRIER();
    }
#undef G2_ISSUE
#undef G2_AWRITE
#undef G2_BARRIER
#pragma unroll
    for (int mt = 0; mt < 4; ++mt)
#pragma unroll
        for (int gi = 0; gi < 4; ++gi) {
            float v[8];
#pragma unroll
            for (int r = 0; r < 4; ++r) { v[r] = acc[mt][2 * gi][r]; v[4 + r] = acc[mt][2 * gi + 1][r]; }
            epi(m0 + wr * 64 + mt * 16 + l15, n0 + wc * 128 + gi * 32 + 8 * q, v, mt, gi);
        }
    epi.finish_wide(m0, n0, wr, wc, lane);
}
template <class F>
DI void gemm_sched(int nbig, int nsmall, F&& f) {
    const int x = blockIdx.x & 7, lb = blockIdx.x >> 3, nlb = gridDim.x >> 3;
    const int nb16 = 16 * nbig, tot = 16 * (nbig + nsmall);
    for (int s = lb; s < tot; s += nlb) {
        if (s < nb16) f(true, x * 16 + (s & 15), s >> 4);
        else { const int t = s - nb16; f(false, x * 16 + (t & 15), t >> 4); }
    }
}

DI float rstd_from_parts(const float* parts, int m) {
    const float4* p = (const float4*)(parts + (size_t)m * 16); float s = 0.f;
#pragma unroll
    for (int i = 0; i < 4; ++i) { const float4 v = p[i]; s += (v.x + v.y) + (v.z + v.w); }
    return 1.0f / sqrtf(s * (1.0f / D) + 1e-6f);
}
DI void store8bf(bf16* p, const float* v) { *(u32x4*)p = (u32x4){pack2bf(v[0], v[1]), pack2bf(v[2], v[3]), pack2bf(v[4], v[5]), pack2bf(v[6], v[7])}; }

struct EpiBf16 {
    bf16* P; int ldp; const float* parts; mutable float rsc[4];
    DI void operator()(int m, int n, const float* v, int mt, int gi) const {
        if (gi == 0) rsc[mt] = parts ? rstd_from_parts(parts, m) : 1.0f;
        float s = rsc[mt]; float w[8];
#pragma unroll
        for (int j = 0; j < 8; ++j) w[j] = v[j] * s;
        store8bf(P + (size_t)m * ldp + n, w);
    }
    DI void finish(int, int, int, int, int) const {}
    DI void finish_wide(int, int, int, int, int) const {}
};
struct EpiResid {
    const float* xin; float* xout; bf16* xb; float* parts; mutable float sq[4];
    DI void operator()(int m, int n, const float* v, int mt, int gi) const {
        const float4* xi = (const float4*)(xin + (size_t)m * D + n); const float4 a = xi[0], b = xi[1];
        float w[8] = {a.x + v[0], a.y + v[1], a.z + v[2], a.w + v[3], b.x + v[4], b.y + v[5], b.z + v[6], b.w + v[7]};
        float4* xo = (float4*)(xout + (size_t)m * D + n);
        xo[0] = make_float4(w[0], w[1], w[2], w[3]); xo[1] = make_float4(w[4], w[5], w[6], w[7]);
        if (xb) store8bf(xb + (size_t)m * D + n, w);
        float s = 0.f;
#pragma unroll
        for (int j = 0; j < 8; ++j) s += w[j] * w[j];
        if (gi == 0) sq[mt] = s; else sq[mt] += s;
    }
    DI void finish(int m0, int n0, int wr, int wc, int lane) const {
#pragma unroll
        for (int mt = 0; mt < 4; ++mt) {
            float s = sq[mt]; s += __shfl_xor(s, 16); s += __shfl_xor(s, 32);
            if (lane < 16) parts[(size_t)(m0 + wr * 64 + mt * 16 + lane) * 16 + (n0 >> 7) * 2 + wc] = s;
        }
    }
    DI void finish_wide(int m0, int n0, int wr, int wc, int lane) const {
#pragma unroll
        for (int mt = 0; mt < 4; ++mt) {
            float s = sq[mt]; s += __shfl_xor(s, 16); s += __shfl_xor(s, 32);
            if (lane < 16) { float* pr = parts + (size_t)(m0 + wr * 64 + mt * 16 + lane) * 16 + (n0 >> 7) + wc; pr[0] = s; pr[8] = 0.f; }
        }
    }
};
struct EpiRwkv {
    bf16* P; float* hw; float* ha;
    DI void operator()(int m, int n, const float* v, int, int) const {
        if (n < 4096) { store8bf(P + (size_t)m * 4096 + n, v); return; }
        const int c = n - 4096;
        if (c < 64) { float4* o = (float4*)(hw + (size_t)m * 64 + c); o[0] = make_float4(tanhf(v[0]), tanhf(v[1]), tanhf(v[2]), tanhf(v[3])); o[1] = make_float4(tanhf(v[4]), tanhf(v[5]), tanhf(v[6]), tanhf(v[7])); }
        else if (c >= 128 && c < 192) { float4* o = (float4*)(ha + (size_t)m * 64 + (c - 128)); o[0] = make_float4(v[0], v[1], v[2], v[3]); o[1] = make_float4(v[4], v[5], v[6], v[7]); }
    }
    DI void finish(int, int, int, int, int) const {}
    DI void finish_wide(int, int, int, int, int) const {}
};

namespace at {
constexpr int OFF_BIAS = 49152;
constexpr int OFF_X = 61952;
constexpr int OFF_IMP = 49152;
constexpr float L2E = 1.4426950408889634f;
constexpr float NEG_MASK = -1e30f, M_INIT = -1e20f;
}
enum { AM_SWA = 0, AM_WIN = 1, AM_CMP = 2, AM_SEL = 3 };
DI int vt_perm(int k32) { return ((k32 & 15) >> 2) * 8 + (k32 >> 4) * 4 + (k32 & 3); }
DI float fast_exp2(float x) { return __builtin_amdgcn_exp2f(x); }

DI void build_bias_lut(const float* __restrict__ t5, char* smem, bool swa) {
    float* lut = (float*)(smem + at::OFF_BIAS);
    for (int i = TIDX; i < 16 * 200; i += NTHREADS) {
        const int h = i / 200, e = i % 200; float v = at::NEG_MASK;
        if (e >= 64 && e < 192) v = t5[t5_bucket(e - 64) * 16 + h] * at::L2E;
        else if (e >= 192 && !swa) v = t5[31 * 16 + h] * at::L2E;
        lut[i] = v;
    }
    __syncthreads();
}

template <int NQT> struct AttnStateT { f32x4 o[NQT][4]; f32x4 lacc[NQT]; float m[NQT]; };
#ifndef ANQT_SWA
#define ANQT_SWA 4
#endif
#ifndef ANQT_WIN
#define ANQT_WIN 2
#endif
#ifndef ANQT_SEL
#define ANQT_SEL 4
#endif
DI unsigned long long range_mask(int lo, int hi) { return (hi >= 63 ? ~0ull : ((1ull << (hi + 1)) - 1ull)) & ~((1ull << lo) - 1ull); }

template <int NQT>
DI void attn_load_q(bf16x8 (&qf)[NQT][2], const bf16* __restrict__ Qp, int ldq, size_t mbase, int hbase) {
    const int lane = TIDX & 63, wave = TIDX >> 6, q = lane >> 4, l15 = lane & 15;
#pragma unroll
    for (int qt = 0; qt < NQT; ++qt) {
        const size_t m = mbase + wave * (4 * NQT) + qt * 4 + (l15 >> 2);
#pragma unroll
        for (int ks = 0; ks < 2; ++ks) qf[qt][ks] = *(const bf16x8*)(Qp + m * ldq + (hbase + (l15 & 3)) * 64 + ks * 32 + q * 8);
    }
}

enum { SK_FAR = 0, SK_NEAR = 1, SK_EDGE = 2, SK_CMP = 3 };
template <int KIND>
DI float attn_fix(f32x4 (&s)[4], int dbase, float cadd, const float* __restrict__ bl, float mx) {
#pragma unroll
    for (int kt = 0; kt < 4; ++kt)
#pragma unroll
        for (int r = 0; r < 4; ++r) {
            float v = s[kt][r]; const int dist = dbase - (kt * 16 + r);
            if (KIND == SK_NEAR) { int idx = dist + 64; idx = idx < 0 ? 0 : (idx > 192 ? 192 : idx); v += bl[idx] + cadd; }
            else if (KIND == SK_EDGE) v = dist < 512 ? v + cadd : at::NEG_MASK;
            else if (KIND == SK_CMP) v = dist >= 0 ? v : at::NEG_MASK;
            if (KIND != SK_FAR) s[kt][r] = v;
            mx = fmaxf(mx, v);
        }
    return mx;
}
template <int MODE, int NQT>
DI void attn_blocks(AttnStateT<NQT>& st, const bf16x8 (&qf)[NQT][2], const bf16* __restrict__ Kp, size_t krs, const bf16* __restrict__ Vp, size_t vrs,
                    int t0, unsigned long long todo, int hbase, const unsigned long long (&sel)[NQT], char* smem) {
    const int tid = TIDX, lane = tid & 63, wave = __builtin_amdgcn_readfirstlane(tid >> 6), q = lane >> 4, l15 = lane & 15;
    const int tq0 = t0 + wave * (4 * NQT) + (l15 >> 2);
    const float* bl = (const float*)(smem + at::OFF_BIAS) + (hbase + (l15 & 3)) * 200;
    const float bfar = (MODE != AM_CMP) ? bl[192] : 0.f;
    const int srow = tid >> 3, scs = (tid & 7) ^ (srow & 7);
    const int fo = l15 * 128 + ((q ^ (l15 & 7)) << 4);
#define ATT_DMA(kb_, slot_) { _Pragma("unroll") for (int i = 0; i < 2; ++i) { const int row = srow + 32 * i; char* dst = smem + (slot_) * 16384 + (8 * wave + 32 * i) * 128; \
        GLDS16(Kp + (size_t)((kb_) * 64 + row) * krs + scs * 8, dst); GLDS16(Vp + (size_t)row * vrs + (kb_) * 64 + scs * 8, dst + 8192); } }
#define ATT_BARRIER() { asm volatile("s_waitcnt lgkmcnt(0)" ::: "memory"); __builtin_amdgcn_s_barrier(); asm volatile("" ::: "memory"); }
    if (todo == 0ull) return;
    int kb = __builtin_ctzll(todo); todo &= todo - 1ull;
    int kb1 = -1; if (todo) { kb1 = __builtin_ctzll(todo); todo &= todo - 1ull; }
    ATT_DMA(kb, 0);
    if (kb1 >= 0) { ATT_DMA(kb1, 1); asm volatile("s_waitcnt vmcnt(4)" ::: "memory"); } else { asm volatile("s_waitcnt vmcnt(0)" ::: "memory"); }
    ATT_BARRIER();
    int slot = 0;
    for (;;) {
        char* buf = smem + slot * 16384;
        int kb2 = -1; if (todo) { kb2 = __builtin_ctzll(todo); todo &= todo - 1ull; }
        if (kb2 >= 0) { const int s2 = slot >= 1 ? slot - 1 : 2; ATT_DMA(kb2, s2); }
        f32x4 s[NQT][4];
#pragma unroll
        for (int qt = 0; qt < NQT; ++qt)
#pragma unroll
            for (int kt = 0; kt < 4; ++kt) s[qt][kt] = (f32x4){0.f, 0.f, 0.f, 0.f};
#pragma unroll
        for (int kt = 0; kt < 4; ++kt)
#pragma unroll
            for (int ks = 0; ks < 2; ++ks) {
                const bf16x8 kf = *(const bf16x8*)(buf + ((fo + kt * 2048) ^ (ks << 6)));
#pragma unroll
                for (int qt = 0; qt < NQT; ++qt) s[qt][kt] = __builtin_amdgcn_mfma_f32_16x16x32_bf16(kf, qf[qt][ks], s[qt][kt], 0, 0, 0);
            }
        const int mind = (t0 + wave * (4 * NQT)) - (kb * 64 + 63), maxd = (t0 + wave * (4 * NQT) + 4 * NQT - 1) - kb * 64;
        float mx[NQT], cofs[NQT];
#pragma unroll
        for (int qt = 0; qt < NQT; ++qt) cofs[qt] = 0.f;
        if (MODE == AM_CMP) {
#pragma unroll
            for (int qt = 0; qt < NQT; ++qt) { const int nlim = (tq0 + 4 * qt - 31) >> 4; mx[qt] = attn_fix<SK_CMP>(s[qt], nlim - (kb * 64 + 4 * q), 0.f, bl, at::NEG_MASK); }
        } else {
            float cadd[NQT];
#pragma unroll
            for (int qt = 0; qt < NQT; ++qt) cadd[qt] = (MODE == AM_SEL && !((sel[qt] >> kb) & 1ull)) ? at::NEG_MASK : 0.f;
            if (MODE == AM_SWA || mind < 113) {
#pragma unroll
                for (int qt = 0; qt < NQT; ++qt) mx[qt] = attn_fix<SK_NEAR>(s[qt], tq0 + 4 * qt - (kb * 64 + 4 * q), cadd[qt], bl, at::NEG_MASK);
            } else if (MODE == AM_WIN && maxd >= 512) {
#pragma unroll
                for (int qt = 0; qt < NQT; ++qt) mx[qt] = attn_fix<SK_EDGE>(s[qt], tq0 + 4 * qt - (kb * 64 + 4 * q), bfar, bl, at::NEG_MASK);
            } else {
#pragma unroll
                for (int qt = 0; qt < NQT; ++qt) { cofs[qt] = bfar + cadd[qt]; mx[qt] = attn_fix<SK_FAR>(s[qt], 0, 0.f, bl, at::NEG_MASK) + cofs[qt]; }
            }
        }
        float msub[NQT]; bool grow = false;
#pragma unroll
        for (int qt = 0; qt < NQT; ++qt) {
            float m2 = mx[qt];
            m2 = fmaxf(m2, __shfl_xor(m2, 16)); m2 = fmaxf(m2, __shfl_xor(m2, 32));
            const bool g = m2 > st.m[qt] + 4.0f; grow |= g;
            mx[qt] = g ? m2 : st.m[qt];
            msub[qt] = mx[qt] - cofs[qt];
        }
        if (__any(grow)) {
#pragma unroll
            for (int qt = 0; qt < NQT; ++qt) {
                const float alpha = fast_exp2(st.m[qt] - mx[qt]);
#pragma unroll
                for (int dt = 0; dt < 4; ++dt) st.o[qt][dt] *= alpha;
                st.lacc[qt] *= alpha;
            }
        }
#pragma unroll
        for (int qt = 0; qt < NQT; ++qt) st.m[qt] = mx[qt];
#pragma unroll
        for (int qt = 0; qt < NQT; ++qt)
#pragma unroll
            for (int kt = 0; kt < 4; ++kt)
#pragma unroll
                for (int r = 0; r < 4; ++r) s[qt][kt][r] = fast_exp2(s[qt][kt][r] - msub[qt]);
        const bf16x8 ones = {(short)0x3F80, (short)0x3F80, (short)0x3F80, (short)0x3F80, (short)0x3F80, (short)0x3F80, (short)0x3F80, (short)0x3F80};
#pragma unroll
        for (int kp = 0; kp < 2; ++kp) {
            bf16x8 pf[NQT];
#pragma unroll
            for (int qt = 0; qt < NQT; ++qt) {
                const u32x4 w = {pack2bf(s[qt][2 * kp][0], s[qt][2 * kp][1]), pack2bf(s[qt][2 * kp][2], s[qt][2 * kp][3]),
                                 pack2bf(s[qt][2 * kp + 1][0], s[qt][2 * kp + 1][1]), pack2bf(s[qt][2 * kp + 1][2], s[qt][2 * kp + 1][3])};
                pf[qt] = __builtin_bit_cast(bf16x8, w);
            }
#pragma unroll
            for (int qt = 0; qt < NQT; ++qt) st.lacc[qt] = __builtin_amdgcn_mfma_f32_16x16x32_bf16(ones, pf[qt], st.lacc[qt], 0, 0, 0);
#pragma unroll
            for (int dt = 0; dt < 4; ++dt) {
                const bf16x8 vf = *(const bf16x8*)(buf + 8192 + ((fo + dt * 2048) ^ (kp << 6)));
#pragma unroll
                for (int qt = 0; qt < NQT; ++qt) st.o[qt][dt] = __builtin_amdgcn_mfma_f32_16x16x32_bf16(vf, pf[qt], st.o[qt][dt], 0, 0, 0);
            }
        }
        if (kb1 < 0) break;
        if (kb2 >= 0) { asm volatile("s_waitcnt vmcnt(4)" ::: "memory"); } else { asm volatile("s_waitcnt vmcnt(0)" ::: "memory"); }
        ATT_BARRIER();
        kb = kb1; kb1 = kb2; slot = slot == 2 ? 0 : slot + 1;
    }
    ATT_BARRIER();
#undef ATT_DMA
}
template <int NQT>
DI void attn_init(AttnStateT<NQT>& st, float m0, float l0) {
#pragma unroll
    for (int qt = 0; qt < NQT; ++qt) { st.m[qt] = m0; st.lacc[qt] = (f32x4){l0, l0, l0, l0};
#pragma unroll
        for (int dt = 0; dt < 4; ++dt) st.o[qt][dt] = (f32x4){0.f, 0.f, 0.f, 0.f}; }
}
DI float attn_linv(const f32x4& lacc) { const float l = lacc[0]; return l > 0.f ? 1.0f / l : 0.f; }

template <int TT>
DI void attn_item_decode(int item, int& b, int& g, int& t0) {
    constexpr int tiles = T / TT;
    const int Gd = (int)gridDim.x;
    int pair, tile;
    if ((Gd % tiles) == 0 && tiles * B * G % Gd == 0) {
        const int bid = item % Gd, rr = item / Gd, tau = bid % tiles;
        pair = bid / tiles + (Gd / tiles) * rr; tile = (rr & 1) ? tiles - 1 - tau : tau;
    } else { tile = item % tiles; pair = item / tiles; }
    t0 = tile * TT; g = pair % G; b = pair / G;
}
DI void swa_item(const bf16* __restrict__ P0, const bf16* __restrict__ VT, const float* __restrict__ sinks, bf16* __restrict__ AO, int item, char* smem) {
    constexpr int LDP = 2304;
    constexpr int NQT = ANQT_SWA;
    int b, g, t0; attn_item_decode<16 * NQT>(item, b, g, t0);
    const int lane = TIDX & 63, wave = TIDX >> 6, q = lane >> 4, l15 = lane & 15;
    const size_t mbase = (size_t)b * T + t0; const int hbase = g * 4, h = hbase + (l15 & 3);
    bf16x8 qf[NQT][2]; attn_load_q<NQT>(qf, P0, LDP, mbase, hbase);
    AttnStateT<NQT> st; attn_init<NQT>(st, sinks[h] * at::L2E, 1.0f);
    const int lo = t0 - 127 < 0 ? 0 : (t0 - 127) >> 6, hi = (t0 + 16 * NQT - 1) >> 6;
    const unsigned long long nosel[NQT] = {};
    attn_blocks<AM_SWA, NQT>(st, qf, P0 + (size_t)b * T * LDP + 1024 + g * 64, LDP, VT + (size_t)(b * G + g) * 64 * T, T, t0, range_mask(lo, hi), hbase, nosel, smem);
#pragma unroll
    for (int qt = 0; qt < NQT; ++qt) {
        const float li = attn_linv(st.lacc[qt]); const size_t m = mbase + wave * (4 * NQT) + qt * 4 + (l15 >> 2);
#pragma unroll
        for (int dt = 0; dt < 4; ++dt) {
            const int d0 = dt * 16 + 4 * q; const u32x2 zz = *(const u32x2*)(P0 + m * LDP + 1280 + h * 64 + d0);
            const float z0 = bflo(zz[0]), z1 = bfhi(zz[0]), z2 = bflo(zz[1]), z3 = bfhi(zz[1]);
            const f32x4 o = st.o[qt][dt];
            *(u32x2*)(AO + m * D + h * 64 + d0) = (u32x2){pack2bf(o[0] * li * siluf_(z0), o[1] * li * siluf_(z1)), pack2bf(o[2] * li * siluf_(z2), o[3] * li * siluf_(z3))};
        }
    }
}

struct EpiL0 {
    bf16* P0; bf16* VT; const float* parts; mutable float rsc[4];
    DI void operator()(int m, int n, const float* v, int mt, int gi) const {
        if (gi == 0) rsc[mt] = rstd_from_parts(parts, m);
        float s = rsc[mt]; if (n < 1024) s *= 0.125f * at::L2E; float w[8];
#pragma unroll
        for (int j = 0; j < 8; ++j) w[j] = v[j] * s;
        if (n < 1280) store8bf(P0 + (size_t)m * 2304 + n, w);
        else if (n >= 1536) store8bf(P0 + (size_t)m * 2304 + n - 256, w);
        else {
            const int g = (n - 1280) >> 6, d = (n - 1280) & 63, b = m / T, t = m % T; const int pos = (t & ~31) + vt_perm(t & 31);
            bf16* dst = VT + ((size_t)(b * G + g) * 64 + d) * T + pos;
#pragma unroll
            for (int j = 0; j < 8; ++j) dst[(size_t)j * T] = f2bf(w[j]);
        }
    }
    DI void finish(int, int, int, int, int) const {}
    DI void finish_wide(int, int, int, int, int) const {}
};

constexpr int LDP2 = 3200;
struct EpiL2 {
    bf16* P2; bf16* VTs; bf16* VTw; const float* parts; mutable float rsc[4];
    DI void operator()(int m, int n, const float* v, int mt, int gi) const {
        if (gi == 0) rsc[mt] = rstd_from_parts(parts, m);
        if (n >= C_COLS) return;
        float s = rsc[mt]; if (n < 1024) s *= 0.125f * at::L2E; float w[8];
#pragma unroll
        for (int j = 0; j < 8; ++j) w[j] = v[j] * s;
        const bool isvs = n >= 1792 && n < 2048, isvw = n >= 2304 && n < 2560;
        if (isvs || isvw) {
            const int c = n - (isvs ? 1792 : 2304); const int g = c >> 6, d = c & 63, b = m / T, t = m % T; const int pos = (t & ~31) + vt_perm(t & 31);
            bf16* dst = (isvs ? VTs : VTw) + ((size_t)(b * G + g) * 64 + d) * T + pos;
#pragma unroll
            for (int j = 0; j < 8; ++j) dst[(size_t)j * T] = f2bf(w[j]);
        } else {
            const int c = n < 1792 ? n : (n < 2304 ? n - 256 : n - 512);
            store8bf(P2 + (size_t)m * LDP2 + c, w);
        }
    }
    DI void finish(int, int, int, int, int) const {}
    DI void finish_wide(int, int, int, int, int) const {}
};

struct ALoadCmp {
    const bf16* P2; int col;
    static constexpr bool DMA = true;
    DI const bf16* src(int row, int k) const {
        int n = row & 255; const int bg = row >> 8, b = bg >> 2, g = bg & 3; const int l = k >> 6, d = k & 63; n = n < NCMP ? n : NCMP - 1;
        return P2 + (size_t)(b * T + 16 * n + l) * LDP2 + col + g * 64 + d;
    }
    struct Raw { u32x4 v; };
    DI Raw load(int row, int k) const {
        const int n = row & 255, bg = row >> 8, b = bg >> 2, g = bg & 3; const int l = k >> 6, d = k & 63; Raw r;
        if (n < NCMP) r.v = *(const u32x4*)(P2 + (size_t)(b * T + 16 * n + l) * LDP2 + col + g * 64 + d); else r.v = (u32x4){0u, 0u, 0u, 0u};
        return r;
    }
    DI u32x4 finish(const Raw& r, int, int) const { return r.v; }
};
struct EpiCmpH {
    char* smem; const float* bias8;
    DI void operator()(int m, int n, const float* v, int, int) const {
        const int row = m & 127; float w[8];
#pragma unroll
        for (int j = 0; j < 8; ++j) { float bsum = 0.f;
#pragma unroll
            for (int i = 0; i < 8; ++i) bsum += bias8[i * 128 + n + j];
            w[j] = siluf_(v[j] + bsum); }
        const int kk = n >> 6, c = (n & 63) >> 3;
        *(u32x4*)(smem + kk * 16384 + row * 128 + ((c ^ (row & 7)) << 4)) = (u32x4){pack2bf(w[0], w[1]), pack2bf(w[2], w[3]), pack2bf(w[4], w[5]), pack2bf(w[6], w[7])};
    }
    DI void finish(int, int, int, int, int) const {}
    DI void finish_wide(int, int, int, int, int) const {}
};
DI void cmp_tile(const bf16* __restrict__ P2, const bf16* __restrict__ w1t, const float* __restrict__ bias8, const bf16* __restrict__ w2t, int which, int rt,
                 bf16* __restrict__ KCb, bf16* __restrict__ VCT, char* smem) {
    gemm_tile(ALoadCmp{P2, which ? 1280 : 1024}, w1t, 2048, rt * 128, 0, EpiCmpH{smem, bias8}, smem);
    const int tid = TIDX, lane = tid & 63, wave = tid >> 6, q = lane >> 4, l15 = lane & 15;
#pragma unroll
    for (int i = 0; i < 4; ++i) {
        const int id = i * 256 + tid; const int row = id >> 4, c16 = id & 15, kk = c16 >> 3, c = c16 & 7;
        *(u32x4*)(smem + 32768 + kk * 8192 + row * 128 + ((c ^ (row & 7)) << 4)) = *(const u32x4*)(w2t + (size_t)row * 128 + c16 * 8);
    }
    __syncthreads();
    f32x4 acc[2][4];
#pragma unroll
    for (int i = 0; i < 2; ++i)
#pragma unroll
        for (int j = 0; j < 4; ++j) acc[i][j] = (f32x4){0.f, 0.f, 0.f, 0.f};
    const int fo = l15 * 128 + ((q ^ (l15 & 7)) << 4);
#pragma unroll
    for (int kk = 0; kk < 2; ++kk)
#pragma unroll
        for (int ks = 0; ks < 2; ++ks) {
            bf16x8 hf[2], wf[4];
#pragma unroll
            for (int i = 0; i < 2; ++i) hf[i] = *(const bf16x8*)(smem + kk * 16384 + (((wave * 32 + i * 16) * 128 + fo) ^ (ks << 6)));
#pragma unroll
            for (int j = 0; j < 4; ++j) wf[j] = *(const bf16x8*)(smem + 32768 + kk * 8192 + ((j * 2048 + fo) ^ (ks << 6)));
#pragma unroll
            for (int i = 0; i < 2; ++i)
#pragma unroll
                for (int j = 0; j < 4; ++j) acc[i][j] = __builtin_amdgcn_mfma_f32_16x16x32_bf16(wf[j], hf[i], acc[i][j], 0, 0, 0);
        }
#pragma unroll
    for (int i = 0; i < 2; ++i) {
        const int row = rt * 128 + wave * 32 + i * 16 + l15; const int n = row & 255, bg = row >> 8;
#pragma unroll
        for (int j = 0; j < 4; ++j) {
            const int d0 = j * 16 + 4 * q; const f32x4 a = acc[i][j];
            if (which == 0) *(u32x2*)(KCb + (size_t)row * 64 + d0) = (u32x2){pack2bf(a[0], a[1]), pack2bf(a[2], a[3])};
            else {
                const int pos = (n & ~31) + vt_perm(n & 31);
#pragma unroll
                for (int r = 0; r < 4; ++r) VCT[((size_t)bg * 64 + d0 + r) * 256 + pos] = f2bf(a[r]);
            }
        }
    }
    __syncthreads();
}

DI void win_item(const bf16* __restrict__ P2, const bf16* __restrict__ VTw, bf16* __restrict__ OW, int item, char* smem) {
    constexpr int NQT = ANQT_WIN;
    int b, g, t0; attn_item_decode<16 * NQT>(item, b, g, t0);
    const int lane = TIDX & 63, wave = TIDX >> 6, q = lane >> 4, l15 = lane & 15;
    const size_t mbase = (size_t)b * T + t0; const int hbase = g * 4, h = hbase + (l15 & 3);
    bf16x8 qf[NQT][2]; attn_load_q<NQT>(qf, P2, LDP2, mbase, hbase);
    AttnStateT<NQT> st; attn_init<NQT>(st, at::M_INIT, 0.f);
    const int lo = t0 - 511 < 0 ? 0 : (t0 - 511) >> 6, hi = (t0 + 16 * NQT - 1) >> 6;
    const unsigned long long nosel[NQT] = {};
    attn_blocks<AM_WIN, NQT>(st, qf, P2 + (size_t)b * T * LDP2 + 1792 + g * 64, LDP2, VTw + (size_t)(b * G + g) * 64 * T, T, t0, range_mask(lo, hi), hbase, nosel, smem);
#pragma unroll
    for (int qt = 0; qt < NQT; ++qt) {
        const float li = attn_linv(st.lacc[qt]); const size_t m = mbase + wave * (4 * NQT) + qt * 4 + (l15 >> 2);
#pragma unroll
        for (int dt = 0; dt < 4; ++dt) { const f32x4 o = st.o[qt][dt]; *(u32x2*)(OW + m * D + h * 64 + dt * 16 + 4 * q) = (u32x2){pack2bf(o[0] * li, o[1] * li), pack2bf(o[2] * li, o[3] * li)}; }
    }
}

DI void cmpsel_item(const bf16* __restrict__ P2, const bf16* __restrict__ KCb, const bf16* __restrict__ VCT, bf16* __restrict__ OC, unsigned long long* __restrict__ SELM, int item, char* smem) {
    int b, g, t0; attn_item_decode<32>(item, b, g, t0);
    const int tid = TIDX, lane = tid & 63, wave = tid >> 6, q = lane >> 4, l15 = lane & 15;
    const size_t mbase = (size_t)b * T + t0; const int hbase = g * 4, h = hbase + (l15 & 3);
    float* impL = (float*)(smem + at::OFF_IMP);
    for (int i = tid; i < 32 * 64; i += NTHREADS) impL[i] = 0.f;
    bf16x8 qf[2][2]; attn_load_q<2>(qf, P2, LDP2, mbase, hbase);
    AttnStateT<2> st; attn_init<2>(st, at::M_INIT, 0.f);
    const int nvmax = (t0 + 31 - 31) / 16 + 1;
    const int hi = (nvmax - 1) >> 6;
    const bf16* Kp = KCb + (size_t)(b * G + g) * 256 * 64; const bf16* Vp = VCT + (size_t)(b * G + g) * 64 * 256;
    const unsigned long long nosel[2] = {0ull, 0ull};
    attn_blocks<AM_CMP, 2>(st, qf, Kp, 64, Vp, 256, t0, range_mask(0, hi), hbase, nosel, smem);
    float linv[2];
#pragma unroll
    for (int qt = 0; qt < 2; ++qt) {
        linv[qt] = attn_linv(st.lacc[qt]); const size_t m = mbase + wave * 8 + qt * 4 + (l15 >> 2);
#pragma unroll
        for (int dt = 0; dt < 4; ++dt) { const f32x4 o = st.o[qt][dt]; *(u32x2*)(OC + m * D + h * 64 + dt * 16 + 4 * q) = (u32x2){pack2bf(o[0] * linv[qt], o[1] * linv[qt]), pack2bf(o[2] * linv[qt], o[3] * linv[qt])}; }
    }
    {
        const int srow = tid >> 3, sc = tid & 7; const int st_off = srow * 128 + ((sc ^ (srow & 7)) << 4); const int fo = l15 * 128 + ((q ^ (l15 & 7)) << 4);
        const int tq0 = t0 + wave * 8 + (l15 >> 2);
        for (int kb = 0; kb <= hi; ++kb) {
#pragma unroll
            for (int i = 0; i < 2; ++i) { const int row = srow + 32 * i; *(u32x4*)(smem + st_off + i * 4096) = *(const u32x4*)(Kp + (size_t)(kb * 64 + row) * 64 + sc * 8); }
            __syncthreads();
            f32x4 s[2][4];
#pragma unroll
            for (int qt = 0; qt < 2; ++qt)
#pragma unroll
                for (int kt = 0; kt < 4; ++kt) s[qt][kt] = (f32x4){0.f, 0.f, 0.f, 0.f};
#pragma unroll
            for (int kt = 0; kt < 4; ++kt)
#pragma unroll
                for (int ks = 0; ks < 2; ++ks) {
                    const bf16x8 kf = *(const bf16x8*)(smem + ((fo + kt * 2048) ^ (ks << 6)));
                    s[0][kt] = __builtin_amdgcn_mfma_f32_16x16x32_bf16(kf, qf[0][ks], s[0][kt], 0, 0, 0);
                    s[1][kt] = __builtin_amdgcn_mfma_f32_16x16x32_bf16(kf, qf[1][ks], s[1][kt], 0, 0, 0);
                }
#pragma unroll
            for (int qt = 0; qt < 2; ++qt) {
                const int tq = tq0 + 4 * qt; const int tl = wave * 8 + qt * 4 + (l15 >> 2);
#pragma unroll
                for (int kt = 0; kt < 4; ++kt) {
                    float pr[4];
#pragma unroll
                    for (int r = 0; r < 4; ++r) { const int key = kb * 64 + kt * 16 + 4 * q + r; pr[r] = (16 * key + 31 <= tq) ? fast_exp2(s[qt][kt][r] - st.m[qt]) * linv[qt] : 0.f; }
                    float s4 = (pr[0] + pr[1]) + (pr[2] + pr[3]), s1 = pr[3];
                    s4 += __shfl_xor(s4, 1); s4 += __shfl_xor(s4, 2); s1 += __shfl_xor(s1, 1); s1 += __shfl_xor(s1, 2);
                    const int s0 = kb * 16 + kt * 4 + q;
                    if ((l15 & 3) == 0) { atomicAdd(&impL[tl * 64 + s0], s4); if (s0 + 1 < 64) atomicAdd(&impL[tl * 64 + s0 + 1], s1); }
                }
            }
            __syncthreads();
        }
    }
    {
        const int tl = tid >> 3, sg = tid & 7; const int t = t0 + tl, cur = t >> 6; float* row = impL + tl * 64;
        float mine[8];
#pragma unroll
        for (int j = 0; j < 8; ++j) { const int s = sg * 8 + j; mine[j] = (s == 0 || s == cur || s == cur - 1) ? 1e30f : (s * 64 > t ? -1e30f : row[s]); }
        __syncthreads();
#pragma unroll
        for (int j = 0; j < 8; ++j) row[sg * 8 + j] = mine[j];
        __syncthreads();
        int rank[8] = {0, 0, 0, 0, 0, 0, 0, 0};
#pragma unroll 4
        for (int s4 = 0; s4 < 16; ++s4) {
            const float4 v4 = *(const float4*)(row + s4 * 4); const float vv[4] = {v4.x, v4.y, v4.z, v4.w};
#pragma unroll
            for (int e = 0; e < 4; ++e) { const int s2 = s4 * 4 + e;
#pragma unroll
                for (int j = 0; j < 8; ++j) rank[j] += (vv[e] > mine[j] || (vv[e] == mine[j] && s2 < sg * 8 + j)) ? 1 : 0; }
        }
        unsigned long long bits = 0ull;
#pragma unroll
        for (int j = 0; j < 8; ++j) if (rank[j] < KTOP) bits |= 1ull << (sg * 8 + j);
        unsigned lo = (unsigned)bits, hi2 = (unsigned)(bits >> 32);
#pragma unroll
        for (int o = 1; o < 8; o <<= 1) { lo |= __shfl_xor(lo, o); hi2 |= __shfl_xor(hi2, o); }
        if (sg == 0) SELM[(mbase + tl) * 4 + g] = ((unsigned long long)hi2 << 32) | lo;
    }
    __syncthreads();
}

DI void sel_item(const bf16* __restrict__ P2, const bf16* __restrict__ VTs, const unsigned long long* __restrict__ SELM, const bf16* __restrict__ OC, const bf16* __restrict__ OW,
                 bf16* __restrict__ AO, int item, char* smem) {
    constexpr int NQT = ANQT_SEL;
    int b, g, t0; attn_item_decode<16 * NQT>(item, b, g, t0);
    const int tid = TIDX, lane = tid & 63, wave = tid >> 6, q = lane >> 4, l15 = lane & 15;
    const size_t mbase = (size_t)b * T + t0; const int hbase = g * 4, rr = l15 & 3, h = hbase + rr;
    unsigned long long* orw = (unsigned long long*)(smem + at::OFF_X);
    if (tid == 0) *orw = 0ull;
    __syncthreads();
    if (tid < 16 * NQT) atomicOr(orw, SELM[(mbase + tid) * 4 + g]);
    unsigned long long sel[NQT];
#pragma unroll
    for (int qt = 0; qt < NQT; ++qt) sel[qt] = SELM[(mbase + wave * (4 * NQT) + qt * 4 + (l15 >> 2)) * 4 + g];
    bf16x8 qf[NQT][2]; attn_load_q<NQT>(qf, P2, LDP2, mbase, hbase);
    AttnStateT<NQT> st; attn_init<NQT>(st, at::M_INIT, 0.f);
    __syncthreads();
    const unsigned long long todo_v = (*orw) & range_mask(0, (t0 + 16 * NQT - 1) >> 6);
    const unsigned long long todo = ((unsigned long long)(unsigned)__builtin_amdgcn_readfirstlane((int)(todo_v >> 32)) << 32) | (unsigned)__builtin_amdgcn_readfirstlane((int)(unsigned)todo_v);
    attn_blocks<AM_SEL, NQT>(st, qf, P2 + (size_t)b * T * LDP2 + 1536 + g * 64, LDP2, VTs + (size_t)(b * G + g) * 64 * T, T, t0, todo, hbase, sel, smem);
#pragma unroll
    for (int qt = 0; qt < NQT; ++qt) {
        const float li = attn_linv(st.lacc[qt]); const size_t m = mbase + wave * (4 * NQT) + qt * 4 + (l15 >> 2);
        const bf16* gr = P2 + m * LDP2 + 3072;
        const float g0 = sigmoidf_(bf2f(gr[0 * 16 + h])), g1 = sigmoidf_(bf2f(gr[1 * 16 + h])), g2 = sigmoidf_(bf2f(gr[2 * 16 + h]));
#pragma unroll
        for (int dt = 0; dt < 4; ++dt) {
            const int d0 = dt * 16 + 4 * q; const size_t oi = m * D + h * 64 + d0;
            const u32x2 zz = *(const u32x2*)(P2 + m * LDP2 + 2048 + h * 64 + d0), cc = *(const u32x2*)(OC + oi), ww = *(const u32x2*)(OW + oi);
            const f32x4 o = st.o[qt][dt];
            const float r0 = (g0 * bflo(cc[0]) + g1 * o[0] * li + g2 * bflo(ww[0])) * siluf_(bflo(zz[0]));
            const float r1 = (g0 * bfhi(cc[0]) + g1 * o[1] * li + g2 * bfhi(ww[0])) * siluf_(bfhi(zz[0]));
            const float r2 = (g0 * bflo(cc[1]) + g1 * o[2] * li + g2 * bflo(ww[1])) * siluf_(bflo(zz[1]));
            const float r3 = (g0 * bfhi(cc[1]) + g1 * o[3] * li + g2 * bfhi(ww[1])) * siluf_(bfhi(zz[1]));
            *(u32x2*)(AO + oi) = (u32x2){pack2bf(r0, r1), pack2bf(r2, r3)};
        }
    }
    __syncthreads();
}

DI void lru_convert_gates(const float* __restrict__ gaw, const float* __restrict__ gxw, bf16* __restrict__ img) {
    for (int i = blockIdx.x * NTHREADS + TIDX; i < 16 * 160 * 96; i += gridDim.x * NTHREADS) {
        const int k = i % 96, n = (i / 96) % 160, blk = i / (96 * 160);
        float v = 0.f;
        if (k < 80) v = n < 80 ? gaw[((size_t)blk * 80 + k) * 80 + n] : gxw[((size_t)blk * 80 + k) * 80 + (n - 80)];
        img[i] = f2bf(v);
    }
}
DI void lru_gate_item(const bf16* __restrict__ P3, const float* __restrict__ cw, const float* __restrict__ cb, const bf16* __restrict__ gimg, const float* __restrict__ gab, const float* __restrict__ gxb,
                      const float* __restrict__ lam, bf16* __restrict__ LA, bf16* __restrict__ BV, float2* __restrict__ SUM, int item, char* smem) {
    const int rt = item >> 4, nb = item & 15; const int tid = TIDX, lane = tid & 63, wave = tid >> 6, q = lane >> 4, l15 = lane & 15;
    const size_t m0 = (size_t)rt * 128;
    for (int id = tid; id < 128 * 12; id += NTHREADS) {
        const int row = id / 12, c12 = id % 12; u32x4 outv = (u32x4){0u, 0u, 0u, 0u};
        if (c12 < 10) {
            const size_t m = m0 + row; const int t = (int)(m % T); const int ch = nb * 80 + c12 * 8;
            float acc[8];
            { const float4 b0 = *(const float4*)(cb + ch), b1 = *(const float4*)(cb + ch + 4); acc[0] = b0.x; acc[1] = b0.y; acc[2] = b0.z; acc[3] = b0.w; acc[4] = b1.x; acc[5] = b1.y; acc[6] = b1.z; acc[7] = b1.w; }
#pragma unroll
            for (int w = 0; w < 4; ++w) {
                if (t - 3 + w >= 0) {
                    const u32x4 uv = *(const u32x4*)(P3 + (m - 3 + w) * 2560 + ch);
                    const float4 w0 = *(const float4*)(cw + w * LW + ch), w1 = *(const float4*)(cw + w * LW + ch + 4);
                    acc[0] += w0.x * bflo(uv[0]); acc[1] += w0.y * bfhi(uv[0]); acc[2] += w0.z * bflo(uv[1]); acc[3] += w0.w * bfhi(uv[1]);
                    acc[4] += w1.x * bflo(uv[2]); acc[5] += w1.y * bfhi(uv[2]); acc[6] += w1.z * bflo(uv[3]); acc[7] += w1.w * bfhi(uv[3]);
                }
            }
            outv = (u32x4){pack2bf(acc[0], acc[1]), pack2bf(acc[2], acc[3]), pack2bf(acc[4], acc[5]), pack2bf(acc[6], acc[7])};
        }
        const int ks = c12 >> 2, c = c12 & 3;
        *(u32x4*)(smem + ks * 8192 + row * 64 + ((c ^ ((row >> 2) & 3)) << 4)) = outv;
    }
    for (int id = tid; id < 160 * 12; id += NTHREADS) {
        const int row = id / 12, c12 = id % 12; const int ks = c12 >> 2, c = c12 & 3;
        *(u32x4*)(smem + 24576 + ks * 10240 + row * 64 + ((c ^ ((row >> 2) & 3)) << 4)) = *(const u32x4*)(gimg + ((size_t)nb * 160 + row) * 96 + c12 * 8);
    }
    __syncthreads();
    f32x4 acc[2][10];
#pragma unroll
    for (int i = 0; i < 2; ++i)
#pragma unroll
        for (int j = 0; j < 10; ++j) acc[i][j] = (f32x4){0.f, 0.f, 0.f, 0.f};
    const int fo = l15 * 64 + ((q ^ ((l15 >> 2) & 3)) << 4);
#pragma unroll
    for (int ks = 0; ks < 3; ++ks) {
        bf16x8 uf[2];
#pragma unroll
        for (int i = 0; i < 2; ++i) uf[i] = *(const bf16x8*)(smem + ks * 8192 + (wave * 32 + i * 16) * 64 + fo);
#pragma unroll
        for (int j = 0; j < 10; ++j) {
            const bf16x8 wf = *(const bf16x8*)(smem + 24576 + ks * 10240 + j * 1024 + fo);
            acc[0][j] = __builtin_amdgcn_mfma_f32_16x16x32_bf16(wf, uf[0], acc[0][j], 0, 0, 0);
            acc[1][j] = __builtin_amdgcn_mfma_f32_16x16x32_bf16(wf, uf[1], acc[1][j], 0, 0, 0);
        }
    }
    __syncthreads();
#pragma unroll
    for (int i = 0; i < 2; ++i) {
        const int row = wave * 32 + i * 16 + l15; const size_t m = m0 + row;
#pragma unroll
        for (int ct = 0; ct < 5; ++ct) {
            const int kcol = ct * 16 + 4 * q; const int ch = nb * 80 + kcol;
            const u32x2 uu = *(const u32x2*)(smem + (kcol >> 5) * 8192 + row * 64 + ((((kcol & 31) >> 3) ^ ((row >> 2) & 3)) << 4) + (kcol & 7) * 2);
            const float uc[4] = {bflo(uu[0]), bfhi(uu[0]), bflo(uu[1]), bfhi(uu[1])};
            const float4 ba = *(const float4*)(gab + ch), bx = *(const float4*)(gxb + ch), lm = *(const float4*)(lam + ch);
            const float bav[4] = {ba.x, ba.y, ba.z, ba.w}, bxv[4] = {bx.x, bx.y, bx.z, bx.w}, lmv[4] = {lm.x, lm.y, lm.z, lm.w};
            float la[4], bv[4];
#pragma unroll
            for (int r = 0; r < 4; ++r) {
                const float rg = __builtin_amdgcn_rcpf(1.0f + __expf(-(acc[i][ct][r] + bav[r]))), ig = __builtin_amdgcn_rcpf(1.0f + __expf(-(acc[i][ct + 5][r] + bxv[r])));
                la[r] = rg * lmv[r];
                const float om = 1.0f - __expf(2.0f * la[r]);
                bv[r] = __builtin_amdgcn_sqrtf(om > 0.f ? om : 0.f) * (ig * uc[r]);
            }
            const u32x2 lav = {pack2bf(la[0], la[1]), pack2bf(la[2], la[3])}, bvv = {pack2bf(bv[0], bv[1]), pack2bf(bv[2], bv[3])};
            *(u32x2*)(LA + m * LW + ch) = lav; *(u32x2*)(BV + m * LW + ch) = bvv;
            *(u32x2*)(smem + 24576 + (row * 80 + kcol) * 2) = lav; *(u32x2*)(smem + 24576 + 20480 + (row * 80 + kcol) * 2) = bvv;
        }
    }
    __syncthreads();
    if (tid < 160) {
        const int cidx = tid / 80, c = tid % 80; const bf16* li = (const bf16*)(smem + 24576) + (cidx * 64) * 80 + c; const bf16* bi = li + 10240;
        float sla = 0.f, h = 0.f;
#pragma unroll 8
        for (int t = 0; t < 64; ++t) { const float la = bf2f(li[t * 80]), bvv = bf2f(bi[t * 80]); h = __expf(la) * h + bvv; sla += la; }
        const size_t mc = m0 + cidx * 64; const int bb = (int)(mc / T), jj = (int)(mc % T) / 64;
        SUM[((size_t)bb * (T / 64) + jj) * LW + nb * 80 + c] = make_float2(__expf(sla), h);
    }
    __syncthreads();
}
DI void lru_scan2_item(const bf16* __restrict__ LA, const bf16* __restrict__ BV, const float2* __restrict__ SUM, const bf16* __restrict__ P3, bf16* __restrict__ AO, int item) {
    const int cg = item % 5, j = (item / 5) % (T / 64), b = item / (5 * (T / 64)); const int c = cg * 256 + TIDX;
    float h = 0.f;
    for (int jj = 0; jj < j; ++jj) { const float2 s = SUM[((size_t)b * (T / 64) + jj) * LW + c]; h = s.x * h + s.y; }
    const size_t m0 = (size_t)b * T + j * 64;
#pragma unroll 8
    for (int t = 0; t < 64; ++t) {
        const float la = bf2f(LA[(m0 + t) * LW + c]); const float bv = bf2f(BV[(m0 + t) * LW + c]); const float z = bf2f(P3[(m0 + t) * 2560 + LW + c]);
        h = __expf(la) * h + bv; AO[(m0 + t) * LW + c] = f2bf(h * siluf_(z));
    }
}

struct ALoadF32 {
    const float* A;
    static constexpr bool DMA = false;
    DI const bf16* src(int, int) const { return nullptr; }
    struct Raw { float4 a, b; };
    DI Raw load(int m, int k) const { Raw r; r.a = *(const float4*)(A + (size_t)m * 64 + k); r.b = *(const float4*)(A + (size_t)m * 64 + k + 4); return r; }
    DI u32x4 finish(const Raw& r, int, int) const { return (u32x4){pack2bf(r.a.x, r.a.y), pack2bf(r.a.z, r.a.w), pack2bf(r.b.x, r.b.y), pack2bf(r.b.z, r.b.w)}; }
};
struct EpiLora {
    const float* w0; const float* a0; bf16* WL; bf16* AV;
    DI void operator()(int m, int n, const float* v, int, int) const {
        float w[8];
        if (n < 1024) {
#pragma unroll
            for (int j = 0; j < 8; ++j) w[j] = -0.60653065971f * __builtin_amdgcn_rcpf(1.0f + __expf(-(w0[n + j] + v[j])));
            store8bf(WL + (size_t)m * D + n, w);
        } else {
#pragma unroll
            for (int j = 0; j < 8; ++j) w[j] = __builtin_amdgcn_rcpf(1.0f + __expf(-(a0[n - 1024 + j] + v[j])));
            store8bf(AV + (size_t)m * D + n - 1024, w);
        }
    }
    DI void finish(int, int, int, int, int) const {}
    DI void finish_wide(int, int, int, int, int) const {}
};
DI float dpp_sum16(float x) {
    x += __builtin_bit_cast(float, __builtin_amdgcn_update_dpp(0, __builtin_bit_cast(int, x), 0xB1, 0xf, 0xf, false));
    x += __builtin_bit_cast(float, __builtin_amdgcn_update_dpp(0, __builtin_bit_cast(int, x), 0x4E, 0xf, 0xf, false));
    x += __builtin_bit_cast(float, __builtin_amdgcn_update_dpp(0, __builtin_bit_cast(int, x), 0x141, 0xf, 0xf, false));
    x += __builtin_bit_cast(float, __builtin_amdgcn_update_dpp(0, __builtin_bit_cast(int, x), 0x140, 0xf, 0xf, false));
    return x;
}
constexpr int RW_NCH = T / 16;
DI void rwkv_prep_item(bf16* __restrict__ P, bf16* __restrict__ WL, bf16* __restrict__ AV, const float* __restrict__ k_k, const float* __restrict__ k_a, const float* __restrict__ r_k,
                       float* __restrict__ G15, bf16* __restrict__ M2g, bf16* __restrict__ M3g, float* __restrict__ BON, int item, char* smem) {
    const int c = item % RW_NCH, h = (item / RW_NCH) & 15, b = item / (RW_NCH * 16);
    const int tid = TIDX, t = tid >> 4, jq = tid & 15, j0 = jq * 4;
    const size_t m0 = (size_t)b * T + c * 16, m = m0 + t; const size_t ch = (size_t)(b * 16 + h) * RW_NCH + c;
    float* sA = (float*)smem; float* sR = sA + 16 * 68; float* sB = sR + 16 * 68; float* sK = sB + 16 * 68; float* sW = sK + 16 * 68; float* sWl = sW + 16 * 68;
    float* mAab = sWl + 16 * 64; float* mAak = mAab + 16 * 17; float* mArb = mAak + 16 * 17; float* mArk = mArb + 16 * 17; float* mTin = mArk + 16 * 17; float* mM2 = mTin + 16 * 17;
    const u32x2 r2 = *(const u32x2*)(P + m * 4096 + h * 64 + j0), k2 = *(const u32x2*)(P + m * 4096 + 1024 + h * 64 + j0), a2 = *(const u32x2*)(AV + m * D + h * 64 + j0), w2 = *(const u32x2*)(WL + m * D + h * 64 + j0);
    const float rr[4] = {bflo(r2[0]), bfhi(r2[0]), bflo(r2[1]), bfhi(r2[1])}, kr[4] = {bflo(k2[0]), bfhi(k2[0]), bflo(k2[1]), bfhi(k2[1])},
                av[4] = {bflo(a2[0]), bfhi(a2[0]), bflo(a2[1]), bfhi(a2[1])}, wl[4] = {bflo(w2[0]), bfhi(w2[0]), bflo(w2[1]), bfhi(w2[1])};
    const float4 kk4 = *(const float4*)(k_k + h * 64 + j0), ka4 = *(const float4*)(k_a + h * 64 + j0), rk4 = *(const float4*)(r_k + h * 64 + j0);
    const float kkc[4] = {kk4.x, kk4.y, kk4.z, kk4.w}, kac[4] = {ka4.x, ka4.y, ka4.z, ka4.w}, rkc[4] = {rk4.x, rk4.y, rk4.z, rk4.w};
    float kkv[4], n2 = 0.f;
#pragma unroll
    for (int e = 0; e < 4; ++e) { kkv[e] = kr[e] * kkc[e]; n2 += kkv[e] * kkv[e]; }
    n2 = dpp_sum16(n2);
    float nr = sqrtf(n2); nr = nr > 1e-12f ? nr : 1e-12f; const float inr = 1.0f / nr;
    float aa[4], bb[4], kp[4], bon = 0.f;
#pragma unroll
    for (int e = 0; e < 4; ++e) { const float kn = kkv[e] * inr; aa[e] = -kn; bb[e] = kn * av[e]; kp[e] = kr[e] * (1.0f + (av[e] - 1.0f) * kac[e]); bon += rr[e] * kp[e] * rkc[e]; }
    bon = dpp_sum16(bon);
    if (jq == 0) BON[m * 16 + h] = bon;
    *(float4*)(sWl + t * 64 + j0) = make_float4(wl[0], wl[1], wl[2], wl[3]);
    __syncthreads();
    float clx[4] = {0.f, 0.f, 0.f, 0.f};
#pragma unroll
    for (int s = 0; s < 15; ++s) { if (s < t) { const float4 w = *(const float4*)(sWl + s * 64 + j0); clx[0] += w.x; clx[1] += w.y; clx[2] += w.z; clx[3] += w.w; } }
    float bt[4];
    {
        float va[4], vr[4], vk[4], gc[4];
#pragma unroll
        for (int e = 0; e < 4; ++e) { const float cl = clx[e] + wl[e]; const float gp = __expf(clx[e]), gi = __expf(-cl); gc[e] = __expf(cl); va[e] = aa[e] * gp; vr[e] = rr[e] * gc[e]; bt[e] = bb[e] * gi; vk[e] = kp[e] * gi; }
        *(float4*)(sA + t * 68 + j0) = make_float4(va[0], va[1], va[2], va[3]); *(float4*)(sR + t * 68 + j0) = make_float4(vr[0], vr[1], vr[2], vr[3]);
        *(float4*)(sB + t * 68 + j0) = make_float4(bt[0], bt[1], bt[2], bt[3]); *(float4*)(sK + t * 68 + j0) = make_float4(vk[0], vk[1], vk[2], vk[3]);
        {
            char* img = (char*)(mM2 + 16 * 17) + t * 128 + (((j0 >> 3) ^ (t & 7)) << 4) + (j0 & 4) * 2;
            *(u32x2*)(img) = (u32x2){pack2bf(va[0], va[1]), pack2bf(va[2], va[3])}; *(u32x2*)(img + 2048) = (u32x2){pack2bf(vr[0], vr[1]), pack2bf(vr[2], vr[3])};
            *(u32x2*)(img + 4096) = (u32x2){pack2bf(bt[0], bt[1]), pack2bf(bt[2], bt[3])}; *(u32x2*)(img + 6144) = (u32x2){pack2bf(vk[0], vk[1]), pack2bf(vk[2], vk[3])};
        }
        if (t == 15) *(float4*)(G15 + ch * 64 + j0) = make_float4(gc[0], gc[1], gc[2], gc[3]);
#pragma unroll
        for (int e = 0; e < 4; ++e) {   }
#pragma unroll
        for (int e = 0; e < 4; ++e) clx[e] = vk[e];
    }
    __syncthreads();
    {
        const int wv = __builtin_amdgcn_readfirstlane(tid >> 6), lane = tid & 63, q = lane >> 4, l15 = lane & 15;
        const char* xb_ = (const char*)(mM2 + 16 * 17) + (wv >> 1) * 2048;
        const char* yb_ = (const char*)(mM2 + 16 * 17) + 4096 + (wv & 1) * 2048;
        f32x4 acc = {0.f, 0.f, 0.f, 0.f};
#pragma unroll
        for (int ks = 0; ks < 2; ++ks) {
            const int off = l15 * 128 + (((ks * 4 + q) ^ (l15 & 7)) << 4);
            const bf16x8 xf = *(const bf16x8*)(xb_ + off), yf = *(const bf16x8*)(yb_ + off);
            acc = __builtin_amdgcn_mfma_f32_16x16x32_bf16(xf, yf, acc, 0, 0, 0);
        }
        float* dst = wv == 0 ? mAab : (wv == 1 ? mAak : (wv == 2 ? mArb : mArk));
        const bool strict = wv < 2;
#pragma unroll
        for (int r = 0; r < 4; ++r) { const int tt = 4 * q + r, ss = l15; dst[tt * 17 + ss] = (strict ? ss < tt : ss <= tt) ? acc[r] : 0.f; }
    }
    __syncthreads();
    if (tid < 16) {
        float col[16];
#pragma unroll
        for (int i = 0; i < 16; ++i) {
            float acc = (i == tid) ? 1.0f : 0.f;
#pragma unroll
            for (int jj = 0; jj < i; ++jj) acc += mAab[i * 17 + jj] * col[jj];
            col[i] = acc; mTin[i * 17 + tid] = acc;
        }
    }
    __syncthreads();
    float wv[4] = {0.f, 0.f, 0.f, 0.f}, m2 = 0.f;
#pragma unroll
    for (int s = 0; s < 16; ++s) { const float ti = mTin[t * 17 + s]; const float4 a4 = *(const float4*)(sA + s * 68 + j0); wv[0] += ti * a4.x; wv[1] += ti * a4.y; wv[2] += ti * a4.z; wv[3] += ti * a4.w; m2 += ti * mAak[s * 17 + jq]; }
    *(float4*)(sW + t * 68 + j0) = make_float4(wv[0], wv[1], wv[2], wv[3]); mM2[t * 17 + jq] = m2;
    __syncthreads();
    float rh[4]; { const float4 r4 = *(const float4*)(sR + t * 68 + j0); rh[0] = r4.x; rh[1] = r4.y; rh[2] = r4.z; rh[3] = r4.w; }
    float m3 = mArk[t * 17 + jq];
#pragma unroll
    for (int s = 0; s < 16; ++s) { const float ar = mArb[t * 17 + s]; const float4 w4 = *(const float4*)(sW + s * 68 + j0); rh[0] += ar * w4.x; rh[1] += ar * w4.y; rh[2] += ar * w4.z; rh[3] += ar * w4.w; m3 += ar * mM2[s * 17 + jq]; }
    *(u32x2*)(WL + m * D + h * 64 + j0) = (u32x2){pack2bf(wv[0], wv[1]), pack2bf(wv[2], wv[3])};
    *(u32x2*)(P + m * 4096 + h * 64 + j0) = (u32x2){pack2bf(rh[0], rh[1]), pack2bf(rh[2], rh[3])};
#pragma unroll
    for (int e = 0; e < 4; ++e) { AV[(m0 + jq) * D + h * 64 + e * 16 + t] = f2bf(bt[e]); P[(m0 + jq) * 4096 + 1024 + h * 64 + e * 16 + t] = f2bf(clx[e]); }
    M2g[ch * 256 + t * 16 + jq] = f2bf(m2); M3g[ch * 256 + t * 16 + jq] = f2bf(m3);
    __syncthreads();
}

#define MFMA32(a, b, c) __builtin_amdgcn_mfma_f32_16x16x32_bf16(__builtin_bit_cast(bf16x8, a), __builtin_bit_cast(bf16x8, b), c, 0, 0, 0)
DI void rwkv_chunk_scan(const bf16* __restrict__ P, const bf16* __restrict__ WL, const bf16* __restrict__ AV, const float* __restrict__ G15, const bf16* __restrict__ M2g, const bf16* __restrict__ M3g,
                        bf16* __restrict__ YS, int bh, char* smem) {
    constexpr int SLOT = 12288, YOFF = 49152;
    const int tid = TIDX, lane = tid & 63, vs = __builtin_amdgcn_readfirstlane(tid >> 6), q = lane >> 4, l15 = lane & 15; const int b = bh >> 4, h = bh & 15;
    const size_t mb = (size_t)b * T; const size_t ch0 = (size_t)(b * 16 + h) * RW_NCH;
    const char *s0, *s1, *s2; size_t d0, d1, d2;
    if (tid < 128) { const int c8 = tid >> 4, t = tid & 15; s0 = (const char*)(WL + (mb + t) * D + h * 64 + c8 * 8); d0 = (size_t)16 * D * 2; }
    else { const int pp = tid - 128, c8 = pp >> 4, t = pp & 15; s0 = (const char*)(P + (mb + t) * 4096 + h * 64 + c8 * 8); d0 = (size_t)16 * 4096 * 2; }
    if (tid < 128) { const int r = tid >> 3, c8 = tid & 7; s1 = (const char*)(P + (mb + r) * 4096 + 1024 + h * 64 + c8 * 8); d1 = (size_t)16 * 4096 * 2; }
    else { const int pp = tid - 128, r = pp >> 3, c8 = pp & 7; s1 = (const char*)(AV + (mb + r) * D + h * 64 + c8 * 8); d1 = (size_t)16 * D * 2; }
    if (tid < 128) { const int r = tid >> 3, c8 = tid & 7; s2 = (const char*)(P + (mb + r) * 4096 + 2048 + h * 64 + c8 * 8); d2 = (size_t)16 * 4096 * 2; }
    else if (tid < 160) { s2 = (const char*)(M2g + ch0 * 256 + (tid - 128) * 8); d2 = 512; }
    else if (tid < 192) { s2 = (const char*)(M3g + ch0 * 256 + (tid - 160) * 8); d2 = 512; }
    else { const int pp = tid < 208 ? tid - 192 : 0; s2 = (const char*)(G15 + ch0 * 64 + pp * 4); d2 = 256; }
    const int dma_off = vs * 1024;
#define RW_DMA(c_) { char* dst = smem + ((c_) & 3) * SLOT + dma_off; GLDS16(s0 + (size_t)(c_) * d0, dst); GLDS16(s1 + (size_t)(c_) * d1, dst + 4096); GLDS16(s2 + (size_t)(c_) * d2, dst + 8192); }
#define RW_BARRIER() { asm volatile("s_waitcnt lgkmcnt(0)" ::: "memory"); __builtin_amdgcn_s_barrier(); asm volatile("" ::: "memory"); }
    f32x4 H0 = {0.f, 0.f, 0.f, 0.f}, H1 = H0, H2 = H0, H3 = H0;
    const int oW = (((q >> 1)) * 16 + l15) * 16 + (q & 1) * 8;
    const int oK = 4096 + ((l15 >> 2) * 8 + (l15 & 3) * 2 + (q >> 1)) * 16 + (q & 1) * 8;
    const int oM = 10240 + l15 * 32 + q * 8;
    const int oV = 8192 + (4 * q) * 128 + (vs * 16 + l15) * 2;
    const int oG = 11264 + (4 * q) * 4;
    const int oY = YOFF + ((4 * q) * 64 + vs * 16 + l15) * 2;
    RW_DMA(0); RW_DMA(1); RW_DMA(2);
    asm volatile("s_waitcnt vmcnt(6)" ::: "memory");
    RW_BARRIER();
    for (int c = 0; c < RW_NCH; ++c) {
        if (c + 3 < RW_NCH) RW_DMA(c + 3);
        const char* sl = smem + (c & 3) * SLOT;
        {
            const f32x4 z4 = {0.f, 0.f, 0.f, 0.f};
            const u32x4 Hb0 = {pack2bf(H0[0], H0[1]), pack2bf(H0[2], H0[3]), pack2bf(H1[0], H1[1]), pack2bf(H1[2], H1[3])};
            const u32x4 Hb1 = {pack2bf(H2[0], H2[1]), pack2bf(H2[2], H2[3]), pack2bf(H3[0], H3[1]), pack2bf(H3[2], H3[3])};
            const unsigned v0 = *(const bf16*)(sl + oV), v1 = *(const bf16*)(sl + oV + 128), v2 = *(const bf16*)(sl + oV + 256), v3 = *(const bf16*)(sl + oV + 384);
            const unsigned v01 = v0 | (v1 << 16), v23 = v2 | (v3 << 16);
            const u32x4 Vlo = {v01, v23, 0u, 0u};
            const u32x2 m2 = *(const u32x2*)(sl + oM), m3 = *(const u32x2*)(sl + oM + 512);
            const u32x2 w0 = *(const u32x2*)(sl + oW), w1 = *(const u32x2*)(sl + oW + 512), w2 = *(const u32x2*)(sl + oW + 1024), w3 = *(const u32x2*)(sl + oW + 1536);
            const u32x2 r0 = *(const u32x2*)(sl + 2048 + oW), r1 = *(const u32x2*)(sl + 2048 + oW + 512), r2 = *(const u32x2*)(sl + 2048 + oW + 1024), r3 = *(const u32x2*)(sl + 2048 + oW + 1536);
            f32x4 U = MFMA32(((u32x4){m2[0], m2[1], 0u, 0u}), Vlo, z4);
            U = MFMA32(((u32x4){w0[0], w0[1], w1[0], w1[1]}), Hb0, U); U = MFMA32(((u32x4){w2[0], w2[1], w3[0], w3[1]}), Hb1, U);
            f32x4 Y = MFMA32(((u32x4){m3[0], m3[1], 0u, 0u}), Vlo, z4);
            Y = MFMA32(((u32x4){r0[0], r0[1], r1[0], r1[1]}), Hb0, Y); Y = MFMA32(((u32x4){r2[0], r2[1], r3[0], r3[1]}), Hb1, Y);
            const u32x4 VU = {v01, v23, pack2bf(U[0], U[1]), pack2bf(U[2], U[3])};
            const u32x2 k0 = *(const u32x2*)(sl + oK), k1 = *(const u32x2*)(sl + oK + 512), k2 = *(const u32x2*)(sl + oK + 1024), k3 = *(const u32x2*)(sl + oK + 1536);
            const u32x2 b0 = *(const u32x2*)(sl + 2048 + oK), b1 = *(const u32x2*)(sl + 2048 + oK + 512), b2 = *(const u32x2*)(sl + 2048 + oK + 1024), b3 = *(const u32x2*)(sl + 2048 + oK + 1536);
            const f32x4 g0 = *(const f32x4*)(sl + oG), g1 = *(const f32x4*)(sl + oG + 64), g2 = *(const f32x4*)(sl + oG + 128), g3 = *(const f32x4*)(sl + oG + 192);
            const f32x4 a0 = MFMA32(((u32x4){k0[0], k0[1], b0[0], b0[1]}), VU, H0), a1 = MFMA32(((u32x4){k1[0], k1[1], b1[0], b1[1]}), VU, H1);
            const f32x4 a2 = MFMA32(((u32x4){k2[0], k2[1], b2[0], b2[1]}), VU, H2), a3 = MFMA32(((u32x4){k3[0], k3[1], b3[0], b3[1]}), VU, H3);
            H0 = a0 * g0; H1 = a1 * g1; H2 = a2 * g2; H3 = a3 * g3;
            char* yb = smem + oY + (c & 7) * 2048;
#pragma unroll
            for (int r = 0; r < 4; ++r) *(bf16*)(yb + r * 128) = f2bf(Y[r]);
        }
        const bool flush = (c & 7) == 7;
        if (flush) {
            RW_BARRIER();
            u32x4 yv[4];
#pragma unroll
            for (int k = 0; k < 4; ++k) yv[k] = *(const u32x4*)(smem + YOFF + (tid + 256 * k) * 16);
#pragma unroll
            for (int k = 0; k < 4; ++k) { const int pc = tid + 256 * k, rr = pc >> 3, c8 = pc & 7; *(u32x4*)(YS + (mb + (size_t)(c - 7) * 16 + rr) * D + h * 64 + c8 * 8) = yv[k]; }
            asm volatile("s_waitcnt vmcnt(0)" ::: "memory");
        } else if (c + 3 < RW_NCH) { asm volatile("s_waitcnt vmcnt(6)" ::: "memory"); }
        else if (c + 2 < RW_NCH) { asm volatile("s_waitcnt vmcnt(3)" ::: "memory"); }
        else { asm volatile("s_waitcnt vmcnt(0)" ::: "memory"); }
        RW_BARRIER();
    }
#undef RW_DMA
#undef RW_BARRIER
}
DI void rwkv_gn_rows2(const bf16* __restrict__ P, const float* __restrict__ BON, const float* __restrict__ lnw, const float* __restrict__ lnb, bf16* __restrict__ YS) {
    const int tid = TIDX, lane = tid & 63, wave = tid >> 6; const int c = wave * 256 + lane * 4;
    const float4 lw = *(const float4*)(lnw + c), lb = *(const float4*)(lnb + c);
    for (size_t m = blockIdx.x; m < (size_t)M; m += gridDim.x) {
        const u32x2 yy = *(const u32x2*)(YS + m * D + c), vv = *(const u32x2*)(P + m * 4096 + 2048 + c), zz = *(const u32x2*)(P + m * 4096 + 3072 + c);
        const float bs = BON[m * 16 + (c >> 6)];
        const float y[4] = {bflo(yy[0]), bfhi(yy[0]), bflo(yy[1]), bfhi(yy[1])}, v[4] = {bflo(vv[0]), bfhi(vv[0]), bflo(vv[1]), bfhi(vv[1])}, z[4] = {bflo(zz[0]), bfhi(zz[0]), bflo(zz[1]), bfhi(zz[1])};
        const float lwv[4] = {lw.x, lw.y, lw.z, lw.w}, lbv[4] = {lb.x, lb.y, lb.z, lb.w};
        const float mean = dpp_sum16((y[0] + y[1]) + (y[2] + y[3])) * (1.0f / 64.0f);
        float var = 0.f;
#pragma unroll
        for (int i = 0; i < 4; ++i) { const float d = y[i] - mean; var += d * d; }
        var = dpp_sum16(var) * (1.0f / 64.0f);
        const float rstd = 1.0f / sqrtf(var + 64e-5f);
        float o[4];
#pragma unroll
        for (int i = 0; i < 4; ++i) o[i] = ((y[i] - mean) * rstd * lwv[i] + lbv[i] + bs * v[i]) * siluf_(z[i]);
        *(u32x2*)(YS + m * D + c) = (u32x2){pack2bf(o[0], o[1]), pack2bf(o[2], o[3])};
    }
}

struct FastBufs { char* ws; };

DI void rows_xb_parts(const float* __restrict__ x, bf16* xb, float* parts) {
    const int lane = TIDX & 63, wave = TIDX >> 6;
    for (int m = blockIdx.x * 4 + wave; m < M; m += gridDim.x * 4) {
        const float* xr = x + (size_t)m * D; float s = 0.f;
#pragma unroll
        for (int i = 0; i < 2; ++i) {
            const int k = (i * 64 + lane) * 8; const float4 a = *(const float4*)(xr + k), b = *(const float4*)(xr + k + 4);
            const float w[8] = {a.x, a.y, a.z, a.w, b.x, b.y, b.z, b.w};
#pragma unroll
            for (int j = 0; j < 8; ++j) s += w[j] * w[j];
            store8bf(xb + (size_t)m * D + k, w);
        }
#pragma unroll
        for (int o = 32; o >= 1; o >>= 1) s += __shfl_xor(s, o);
        if (lane < 16) parts[(size_t)m * 16 + lane] = lane == 0 ? s : 0.f;
    }
}
DI void rows_xn(const float* __restrict__ x, const float* parts, const float* __restrict__ g, bf16* xn) {
    const int lane = TIDX & 63, wave = TIDX >> 6;
    for (int m = blockIdx.x * 4 + wave; m < M; m += gridDim.x * 4) {
        const float rs = rstd_from_parts(parts, m); const float* xr = x + (size_t)m * D;
#pragma unroll
        for (int i = 0; i < 2; ++i) {
            const int k = (i * 64 + lane) * 8; const float4 a = *(const float4*)(xr + k), b = *(const float4*)(xr + k + 4);
            const float4 ga = *(const float4*)(g + k), gb = *(const float4*)(g + k + 4);
            const float w[8] = {a.x * rs * ga.x, a.y * rs * ga.y, a.z * rs * ga.z, a.w * rs * ga.w, b.x * rs * gb.x, b.y * rs * gb.y, b.z * rs * gb.z, b.w * rs * gb.w};
            store8bf(xn + (size_t)m * D + k, w);
        }
    }
}
DI void rows_final(float* x, const float* parts, const float* __restrict__ g) {
    const int lane = TIDX & 63, wave = TIDX >> 6;
    for (int m = blockIdx.x * 4 + wave; m < M; m += gridDim.x * 4) {
        const float rs = rstd_from_parts(parts, m); float* xr = x + (size_t)m * D;
#pragma unroll
        for (int i = 0; i < 4; ++i) {
            const int k = (i * 64 + lane) * 4; float4 a = *(float4*)(xr + k); const float4 ga = *(const float4*)(g + k);
            a.x *= rs * ga.x; a.y *= rs * ga.y; a.z *= rs * ga.z; a.w *= rs * ga.w; *(float4*)(xr + k) = a;
        }
    }
}
enum { PH_PREP0 = 0, PH_IN0, PH_ATTN0, PH_OUT0, PH_PREP1, PH_IN1, PH_LORA1, PH_CPREP1, PH_SCAN1, PH_GN1, PH_OUT1, PH_PREP2, PH_IN2, PH_B2, PH_C2, PH_D2, PH_OUT2, PH_PREP3, PH_IN3, PH_GATE3, PH_SCANA3, PH_SCANB3, PH_OUT3, PH_FINAL };

namespace wbo {
constexpr size_t IN = 0;
constexpr size_t OUT = (size_t)4352 * 1024;
constexpr size_t EXTRA = OUT + (size_t)1280 * 1024;
}

template <int PH>
DI void run_phase(const Params& p, char* smem) {
    char* ws = p.ws;
    float* parts = (float*)(ws + fw::PARTS);
    constexpr int LAYER = PH <= PH_OUT0 ? 0 : PH <= PH_OUT1 ? 1 : PH <= PH_OUT2 ? 2 : 3;
    constexpr size_t WBOFF = LAYER == 0 ? 200 * fw::MB : LAYER == 1 ? 238 * fw::MB : LAYER == 2 ? 240 * fw::MB : 1 * fw::MB;
    bf16* WB = (bf16*)(ws + WBOFF);
    bf16* XB = (bf16*)(ws + ((PH == PH_PREP0 || PH == PH_IN0) ? 130 * fw::MB : 174 * fw::MB));
    bf16* P = (bf16*)(ws + wsl::P);
    float* X = p.out;
    float* smf = (float*)smem;
    if (PH == PH_PREP0) {
        rows_xb_parts(p.x, XB, parts);
        int tb = 0;
        convert_seg(p.a_w_in, A_COLS, 0, A_COLS, 1024, WB + wbo::IN, p.norm_g + 0 * D, smf, tb);
        convert_seg(p.a_w_out, 1024, 0, 1024, 1024, WB + wbo::OUT, nullptr, smf, tb);
    } else if (PH == PH_IN0) {
        gemm_sched(8, 4, [&](bool big, int mt, int nt) {
            if (big) gemm_tile2(ALoadPlain{XB, D}, WB + wbo::IN, 1024, mt * 128, nt * 256, EpiL0{P, (bf16*)(ws + 86 * fw::MB), parts}, smem);
            else gemm_tile(ALoadPlain{XB, D}, WB + wbo::IN, 1024, mt * 128, 2048 + nt * 128, EpiL0{P, (bf16*)(ws + 86 * fw::MB), parts}, smem);
        });
    } else if (PH == PH_ATTN0) {
        build_bias_lut(p.t5, smem, true);
        for (int it = blockIdx.x; it < B * G * (T / (16 * ANQT_SWA)); it += gridDim.x) swa_item(P, (const bf16*)(ws + 86 * fw::MB), p.a_sinks, (bf16*)(ws + wsl::L0_AO), it, smem);
    } else if (PH == PH_OUT0) {
        gemm_sched(4, 0, [&](bool, int mt, int nt) { gemm_tile2(ALoadPlain{(const bf16*)(ws + wsl::L0_AO), D}, WB + wbo::OUT, 1024, mt * 128, nt * 256, EpiResid{p.x, X, nullptr, parts}, smem); });
    } else if (PH == PH_PREP1) {
        rows_xn(X, parts, p.norm_g + 1 * D, (bf16*)(ws + wsl::L1_XN));
        int tb = 0;
        convert_seg(p.b_w_in, 4096, 0, 4096, 1024, WB + wbo::IN, nullptr, smf, tb);
        convert_seg(p.b_w1, 64, 0, 64, 1024, WB + wbo::IN + (size_t)4096 * 1024, nullptr, smf, tb);
        convert_seg(p.b_a1, 64, 0, 64, 1024, WB + wbo::IN + (size_t)(4096 + 128) * 1024, nullptr, smf, tb);
        convert_seg(p.b_w_out, 1024, 0, 1024, 1024, WB + wbo::OUT, nullptr, smf, tb);
        convert_seg(p.b_w2, 1024, 0, 1024, 64, WB + wbo::EXTRA, nullptr, smf, tb);
        convert_seg(p.b_a2, 1024, 0, 1024, 64, WB + wbo::EXTRA + (size_t)1024 * 64, nullptr, smf, tb);
        for (size_t i = (size_t)blockIdx.x * 256 + TIDX; i < (size_t)64 * 1024 / 8; i += (size_t)gridDim.x * 256) {
            ((u32x4*)(WB + wbo::IN + (size_t)(4096 + 64) * 1024))[i] = (u32x4){0u, 0u, 0u, 0u};
            ((u32x4*)(WB + wbo::IN + (size_t)(4096 + 192) * 1024))[i] = (u32x4){0u, 0u, 0u, 0u};
        }
    } else if (PH == PH_IN1) {
        const bf16* XN = (const bf16*)(ws + wsl::L1_XN);
        EpiRwkv epi{P, (float*)(ws + wsl::LHW), (float*)(ws + wsl::LHA)};
        gemm_sched(16, 2, [&](bool big, int mt, int nt) {
            if (big) gemm_tile2(ALoadLerp{XN, p.b_mu + (nt >> 2) * D}, WB + wbo::IN, 1024, mt * 128, nt * 256, epi, smem);
            else gemm_tile(ALoadLerp{XN, p.b_mu + (4 + nt) * D}, WB + wbo::IN, 1024, mt * 128, 4096 + nt * 128, epi, smem);
        });
    } else if (PH == PH_LORA1) {
        const int ntile = (M / 128) * 16;
        EpiLora epi{p.b_w0, p.b_a0, (bf16*)(ws + wsl::L1_WL), (bf16*)(ws + wsl::L1_AV)};
        (void)ntile;
        gemm_sched(8, 0, [&](bool, int mt, int nt) { gemm_tile2(ALoadF32{(const float*)(ws + (nt < 4 ? wsl::LHW : wsl::LHA))}, WB + wbo::EXTRA, 64, mt * 128, nt * 256, epi, smem); });
    } else if (PH == PH_CPREP1) {
        for (int it = blockIdx.x; it < B * 16 * RW_NCH; it += gridDim.x)
            rwkv_prep_item(P, (bf16*)(ws + wsl::L1_WL), (bf16*)(ws + wsl::L1_AV), p.b_k_k, p.b_k_a, p.b_r_k, (float*)(ws + 9 * fw::MB), (bf16*)(ws + 1 * fw::MB), WB, (float*)(ws + 254 * fw::MB), it, smem);
    } else if (PH == PH_SCAN1) {
        const int bid = blockIdx.x;
        if ((bid & 31) < 8 && (bid >> 5) < 8) {
            const int it = (bid >> 5) * 8 + (bid & 31);
            rwkv_chunk_scan(P, (const bf16*)(ws + wsl::L1_WL), (const bf16*)(ws + wsl::L1_AV), (const float*)(ws + 9 * fw::MB), (const bf16*)(ws + 1 * fw::MB), WB, (bf16*)(ws + wsl::L1_XN), it, smem);
        }
    } else if (PH == PH_GN1) {
        rwkv_gn_rows2(P, (const float*)(ws + 254 * fw::MB), p.b_lnx_w, p.b_lnx_b, (bf16*)(ws + wsl::L1_XN));
    } else if (PH == PH_OUT1) {
        gemm_sched(4, 0, [&](bool, int mt, int nt) { gemm_tile2(ALoadPlain{(const bf16*)(ws + wsl::L1_XN), D}, WB + wbo::OUT, 1024, mt * 128, nt * 256, EpiResid{X, X, XB, parts}, smem); });
    } else if (PH == PH_PREP2) {
        int tb = 0;
        const float* g2 = p.norm_g + 2 * D;
        convert_seg(p.c_w_in, C_COLS, 0, 2560, 1024, WB + wbo::IN, g2, smf, tb);
        convert_seg(p.c_w_in, C_COLS, 2608, 1024, 1024, WB + wbo::IN + (size_t)2560 * 1024, g2, smf, tb);
        convert_seg(p.c_w_in, C_COLS, 2560, 64, 1024, WB + wbo::IN + (size_t)3584 * 1024, g2, smf, tb);
        convert_seg(p.c_w_out, 1024, 0, 1024, 1024, WB + wbo::OUT, nullptr, smf, tb);
        convert_seg(p.c_k_w1, 128, 0, 128, 2048, WB + wbo::EXTRA, nullptr, smf, tb);
        convert_seg(p.c_v_w1, 128, 0, 128, 2048, WB + wbo::EXTRA + (size_t)128 * 2048, nullptr, smf, tb);
        convert_seg(p.c_k_w2, 64, 0, 64, 128, WB + wbo::EXTRA + (size_t)256 * 2048, nullptr, smf, tb);
        convert_seg(p.c_v_w2, 64, 0, 64, 128, WB + wbo::EXTRA + (size_t)256 * 2048 + 64 * 128, nullptr, smf, tb);
        if (blockIdx.x < 16) {
            const int which = blockIdx.x >> 3, i = blockIdx.x & 7; const float* pos = which ? p.c_pos_v : p.c_pos_k; const float* w1 = which ? p.c_v_w1 : p.c_k_w1;
            float* b8 = (float*)(ws + 12 * fw::MB);
            if (TIDX < 128) { float a = 0.f; for (int k = i * 256; k < i * 256 + 256; ++k) a += pos[k] * w1[(size_t)k * 128 + TIDX]; b8[(which * 8 + i) * 128 + TIDX] = a; }
        }
    } else if (PH == PH_IN2) {
        gemm_sched(14, 1, [&](bool big, int mt, int nt) {
            if (big) gemm_tile2(ALoadPlain{XB, D}, WB + wbo::IN, 1024, mt * 128, nt * 256, EpiL2{P, (bf16*)(ws + 114 * fw::MB), (bf16*)(ws + 122 * fw::MB), parts}, smem);
            else gemm_tile(ALoadPlain{XB, D}, WB + wbo::IN, 1024, mt * 128, 3584 + nt * 128, EpiL2{P, (bf16*)(ws + 114 * fw::MB), (bf16*)(ws + 122 * fw::MB), parts}, smem);
        });
    } else if (PH == PH_B2) {
        for (int it = blockIdx.x; it < 64; it += gridDim.x) { const int which = it >> 5, rt = it & 31;
            cmp_tile(P, WB + wbo::EXTRA + (size_t)which * 128 * 2048, (const float*)(ws + 12 * fw::MB) + which * 8 * 128, WB + wbo::EXTRA + (size_t)256 * 2048 + which * 64 * 128, which, rt,
                     (bf16*)(ws + 5 * fw::MB), (bf16*)(ws + 6 * fw::MB), smem); }
        build_bias_lut(p.t5, smem, false);
        const int nwin = B * G * (T / (16 * ANQT_WIN));
        const bool split = gridDim.x == 512 && nwin == 2048;
        const int bid = blockIdx.x, nb = bid - 64, cnt = bid < 64 ? 2 : (nb < 128 ? 5 : 4);
        for (int k = 0;; ++k) {
            int item;
            if (split) { if (k >= cnt) break; item = bid < 64 ? k * 512 + 448 + bid : (k < 4 ? k * 512 + nb : (2 + (nb >> 6)) * 512 + 448 + (nb & 63)); }
            else { const int it = (bid < 64 ? bid + (int)gridDim.x : bid) + k * (int)gridDim.x; if (it >= 64 + nwin) break; item = it - 64; }
            win_item(P, (const bf16*)(ws + 122 * fw::MB), (bf16*)(ws + 130 * fw::MB), item, smem);
        }
    } else if (PH == PH_C2) {
        for (int it = blockIdx.x; it < B * G * (T / 32); it += gridDim.x)
            cmpsel_item(P, (const bf16*)(ws + 5 * fw::MB), (const bf16*)(ws + 6 * fw::MB), (bf16*)(ws + 162 * fw::MB), (unsigned long long*)(ws + 9 * fw::MB), it, smem);
    } else if (PH == PH_D2) {
        build_bias_lut(p.t5, smem, false);
        for (int it = blockIdx.x; it < B * G * (T / (16 * ANQT_SEL)); it += gridDim.x)
            sel_item(P, (const bf16*)(ws + 114 * fw::MB), (const unsigned long long*)(ws + 9 * fw::MB), (const bf16*)(ws + 162 * fw::MB), (const bf16*)(ws + 130 * fw::MB), (bf16*)(ws + 206 * fw::MB), it, smem);
    } else if (PH == PH_OUT2) {
        gemm_sched(4, 0, [&](bool, int mt, int nt) { gemm_tile2(ALoadPlain{(const bf16*)(ws + 206 * fw::MB), D}, WB + wbo::OUT, 1024, mt * 128, nt * 256, EpiResid{X, X, XB, parts}, smem); });
    } else if (PH == PH_PREP3) {
        int tb = 0;
        convert_seg(p.d_w_in, 2560, 0, 2560, 1024, WB + wbo::IN, p.norm_g + 3 * D, smf, tb);
        convert_seg(p.d_w_out, 1024, 0, 1024, 1280, WB + wbo::OUT, nullptr, smf, tb);
        lru_convert_gates(p.d_ga_w, p.d_gx_w, WB + wbo::EXTRA);
        for (int i = blockIdx.x * NTHREADS + TIDX; i < LW; i += gridDim.x * NTHREADS) ((float*)(ws + 12 * fw::MB + 786432))[i] = -8.0f * softplusf_(-p.d_lambda[i]);
    } else if (PH == PH_IN3) {
        gemm_sched(8, 4, [&](bool big, int mt, int nt) {
            if (big) gemm_tile2(ALoadPlain{XB, D}, WB + wbo::IN, 1024, mt * 128, nt * 256, EpiBf16{P, 2560, parts}, smem);
            else gemm_tile(ALoadPlain{XB, D}, WB + wbo::IN, 1024, mt * 128, 2048 + nt * 128, EpiBf16{P, 2560, parts}, smem);
        });
    } else if (PH == PH_GATE3) {
        for (int it = blockIdx.x; it < (M / 128) * 16; it += gridDim.x)
            lru_gate_item(P, p.d_conv_w, p.d_conv_b, WB + wbo::EXTRA, p.d_ga_b, p.d_gx_b, (const float*)(ws + 12 * fw::MB + 786432), (bf16*)(ws + wsl::L3_LA), (bf16*)(ws + wsl::L3_BV), (float2*)(ws + wsl::L3_UC), it, smem);
    } else if (PH == PH_SCANB3) {
        for (int it = blockIdx.x; it < B * (T / 64) * 5; it += gridDim.x)
            lru_scan2_item((const bf16*)(ws + wsl::L3_LA), (const bf16*)(ws + wsl::L3_BV), (const float2*)(ws + wsl::L3_UC), P, (bf16*)(ws + wsl::L3_AO), it);
    } else if (PH == PH_OUT3) {
        gemm_sched(4, 0, [&](bool, int mt, int nt) { gemm_tile2(ALoadPlain{(const bf16*)(ws + wsl::L3_AO), LW}, WB + wbo::OUT, 1280, mt * 128, nt * 256, EpiResid{X, X, nullptr, parts}, smem); });
    } else if (PH == PH_FINAL) {
        rows_final(X, parts, p.final_g);
    }
}

template <int PH> __global__ void __launch_bounds__(NTHREADS, 2) k_phase(Params p) {
    extern __shared__ __attribute__((aligned(16))) char smem[];
    run_phase<PH>(p, smem);
}
#define LDS_BYTES 73728
#define MEGA_LDS_BYTES (73728 + 64)
template <int PH> static void launch_phase(const Params& p, hipStream_t s) {
    static bool attr = false;
    if (!attr) { hipFuncSetAttribute((const void*)k_phase<PH>, hipFuncAttributeMaxDynamicSharedMemorySize, LDS_BYTES); attr = true; }
    hipLaunchKernelGGL(k_phase<PH>, dim3(512), dim3(NTHREADS), LDS_BYTES, s, p);
}


#define XB_TMO      128
#define XB_XCNT(j)  (256  + 64 * (j))
#define XB_XSUB(j)  (1280 + 64 * (j))
#define XB_XGEN(j)  (2304 + 64 * (j))
#define XB_TOP      3328
#define XB_TOPGEN   3392
#define XCD_BAR_WORDS 3456
#define XB_SPIN_CAP (1u << 22)
#define LAS __attribute__((address_space(3)))
DI unsigned xb_ld(unsigned* p)              { return __hip_atomic_load(p, __ATOMIC_RELAXED, __HIP_MEMORY_SCOPE_AGENT); }
DI unsigned xb_add(unsigned* p, unsigned v) { return __hip_atomic_fetch_add(p, v, __ATOMIC_RELAXED, __HIP_MEMORY_SCOPE_AGENT); }
DI unsigned xb_xcc_id() { return (unsigned)__builtin_amdgcn_s_getreg((3 << 11) | 20) & 0xFu; }
#define XB_SPIN(cond, bar) do { unsigned _sp = 0; while (cond) { if (_sp < 64u) __builtin_amdgcn_s_sleep(2); else __builtin_amdgcn_s_sleep(32); \
    if ((++_sp & 255u) == 0u) { if (xb_ld(&(bar)[XB_TMO])) break; if (_sp > XB_SPIN_CAP) { atomicAdd(&(bar)[XB_TMO], 1u); break; } } } } while (0)
struct XcdBarrier { unsigned* bar; unsigned x; volatile LAS unsigned* st; };
DI XcdBarrier xcd_barrier_post(unsigned* bar, volatile LAS unsigned* st) {
    XcdBarrier b; b.bar = bar; b.x = xb_xcc_id(); b.st = st;
    if (threadIdx.x == 0) (void)xb_add(&bar[XB_XCNT(b.x)], 1u);
    return b;
}
DI void xcd_barrier_complete(unsigned* bar, unsigned x, unsigned& nloc, unsigned& nx) {
    const unsigned G = gridDim.x * gridDim.y * gridDim.z;
    unsigned sum, cnt, mine, sp = 0u;
    for (;;) {
        sum = 0u; cnt = 0u; mine = 0u;
#pragma unroll
        for (unsigned j = 0; j < 16; ++j) { const unsigned c = xb_ld(&bar[XB_XCNT(j)]); sum += c; cnt += (c > 0u) ? 1u : 0u; mine = (j == x) ? c : mine; }
        if (sum == G) break;
        __builtin_amdgcn_s_sleep(1);
        if ((++sp & 255u) == 0u) { if (xb_ld(&bar[XB_TMO])) break; if (sp > XB_SPIN_CAP) { atomicAdd(&bar[XB_TMO], 1u); break; } }
    }
    nloc = mine > 0u ? mine : 1u; nx = cnt > 0u ? cnt : 1u;
}
DI void xcd_barrier(const XcdBarrier& b) {
    asm volatile("s_waitcnt vmcnt(0)" ::: "memory");
    __syncthreads();
    if (threadIdx.x == 0) {
        unsigned* bar = b.bar;
        __builtin_amdgcn_s_waitcnt(0);
        unsigned nloc = b.st[0], nx = b.st[1];
        if (nloc == 0u) { xcd_barrier_complete(bar, b.x, nloc, nx); b.st[0] = nloc; b.st[1] = nx; }
        const unsigned old = xb_add(&bar[XB_XSUB(b.x)], 1u);
        const unsigned gen = old / nloc;
        if (old + 1u == (gen + 1u) * nloc) {
            __builtin_amdgcn_fence(__ATOMIC_RELEASE, "agent");
            asm volatile("s_waitcnt vmcnt(0)" ::: "memory");
            const unsigned og = xb_add(&bar[XB_TOP], 1u);
            const unsigned tg = og / nx;
            if (og + 1u == (tg + 1u) * nx) xb_add(&bar[XB_TOPGEN], 1u);
            else XB_SPIN(xb_ld(&bar[XB_TOPGEN]) == tg, bar);
            __builtin_amdgcn_fence(__ATOMIC_ACQUIRE, "agent");
            xb_add(&bar[XB_XGEN(b.x)], 1u);
            asm volatile("s_waitcnt vmcnt(0)" ::: "memory");
        } else {
            XB_SPIN(xb_ld(&bar[XB_XGEN(b.x)]) == gen, bar);
            __builtin_amdgcn_fence(__ATOMIC_ACQUIRE, "agent");
            asm volatile("s_waitcnt vmcnt(0)" ::: "memory");
        }
    }
    __syncthreads();
}

#define MEGA_PHASES(X) X(PH_IN0) X(PH_ATTN0) X(PH_OUT0) X(PH_PREP1) X(PH_IN1) X(PH_LORA1) X(PH_CPREP1) X(PH_SCAN1) X(PH_GN1) X(PH_OUT1) \
    X(PH_PREP2) X(PH_IN2) X(PH_B2) X(PH_C2) X(PH_D2) X(PH_OUT2) X(PH_PREP3) X(PH_IN3) X(PH_GATE3) X(PH_SCANB3) X(PH_OUT3)
__global__ void __launch_bounds__(NTHREADS, 2) mega_kernel(Params p) {
    extern __shared__ __attribute__((aligned(16))) char smem[];
    cooperative_groups::grid_group grid = cooperative_groups::this_grid();
    volatile LAS unsigned* xst = (volatile LAS unsigned*)(smem + 73728);
    if (threadIdx.x < 4) xst[threadIdx.x] = 0u;
    __syncthreads();
    XcdBarrier xb = xcd_barrier_post((unsigned*)p.ws, xst);
    run_phase<PH_PREP0>(p, smem);
    if (p.ws == nullptr) grid.sync();
    xcd_barrier(xb);
#define MEGA_STEP(ph) run_phase<ph>(p, smem); xcd_barrier(xb);
    MEGA_PHASES(MEGA_STEP)
#undef MEGA_STEP
    run_phase<PH_FINAL>(p, smem);
}
static void launch_mega(const Params& p, hipStream_t s) {
    static int grid_blocks = 0;
    if (!grid_blocks) {
        int dev = 0, cus = 0, per_cu = 0;
        hipGetDevice(&dev);
        hipDeviceGetAttribute(&cus, hipDeviceAttributeMultiprocessorCount, dev);
        hipFuncSetAttribute((const void*)mega_kernel, hipFuncAttributeMaxDynamicSharedMemorySize, MEGA_LDS_BYTES);
        hipOccupancyMaxActiveBlocksPerMultiprocessor(&per_cu, mega_kernel, NTHREADS, MEGA_LDS_BYTES);
        if (per_cu > 2) per_cu = 2;
        if (per_cu < 1) per_cu = 1;
        grid_blocks = cus * per_cu;
    }
    hipMemsetAsync(p.ws, 0, 16384, s);
    Params pp = p; void* args[] = {&pp};
    hipError_t e = hipLaunchCooperativeKernel((const void*)mega_kernel, dim3(grid_blocks), dim3(NTHREADS), args, MEGA_LDS_BYTES, s);
    if (e != hipSuccess) fprintf(stderr, "cooperative launch failed: %s (grid %d)\n", hipGetErrorString(e), grid_blocks);
}
#endif

#ifndef CPU_SHIM
template <class F> __global__ void __launch_bounds__(256) k_run(F f, long n) {
    const long i = (long)blockIdx.x * 256 + threadIdx.x; if (i < n) f(i);
}
template <class F> static void launch(const F& f, long n, hipStream_t s) {
    hipLaunchKernelGGL(k_run<F>, dim3((unsigned)((n + 255) / 256)), dim3(256), 0, s, f, n);
}
#else
template <class F> static void launch(const F& f, long n, hipStream_t) {
#pragma omp parallel for schedule(dynamic, 64)
    for (long i = 0; i < n; ++i) f(i);
}
#endif

#ifdef CPU_SHIM
void cpu_layer_hook(int layer, const float* X, const char* ws);
#define LAYER_HOOK(l) cpu_layer_hook(l, X, ws)
#else
#define LAYER_HOOK(l)
#endif

#define FAST_GEMM 0
#if FAST_GEMM
#define FASTP(ph) launch_phase<ph>(p, s)
#else
#define FASTP(ph)
#endif

static void run_naive(const Params& p, hipStream_t s) {
    char* ws = p.ws;
    float* rs = (float*)(ws + wsl::RS);
    bf16* P = (bf16*)(ws + wsl::P);
    float* X = p.out;
    (void)rs;
    {
        bf16* AO = (bf16*)(ws + wsl::L0_AO);
#if FAST_GEMM
        FASTP(PH_PREP0); FASTP(PH_IN0);
#else
        launch(RstdF{p.x, rs}, M, s);
        launch(GemmInF{p.x, rs, p.norm_g + 0 * D, p.a_w_in, P, A_COLS}, (long)M * (A_COLS / 4), s);
#endif
#if FAST_GEMM
        FASTP(PH_ATTN0); (void)AO;
#else
        launch(SwaF{P, p.t5, p.a_sinks, AO}, (long)M * H, s);
#endif
#if FAST_GEMM
        FASTP(PH_OUT0);
#else
        launch(GemmOutF{AO, p.a_w_out, p.x, X, 1024}, (long)M * (D / 4), s);
#endif
    }
    LAYER_HOOK(0);
    {
        bf16* XN = (bf16*)(ws + wsl::L1_XN); bf16* WL = (bf16*)(ws + wsl::L1_WL); bf16* AV = (bf16*)(ws + wsl::L1_AV);
        float* hw = (float*)(ws + wsl::LHW); float* ha = (float*)(ws + wsl::LHA);
#if FAST_GEMM
        FASTP(PH_PREP1); FASTP(PH_IN1); FASTP(PH_LORA1); FASTP(PH_CPREP1); FASTP(PH_SCAN1); FASTP(PH_GN1); FASTP(PH_OUT1);
        (void)XN; (void)WL; (void)AV; (void)hw; (void)ha;
#else
        launch(RstdF{X, rs}, M, s);
        launch(XnF{X, rs, p.norm_g + 1 * D, XN}, (long)M * D, s);
        launch(GemmRwkvF{XN, p.b_mu, p.b_w_in, P}, (long)M * 1024, s);
        launch(LoraHidF{XN, p.b_mu, p.b_w1, p.b_a1, hw, ha}, (long)M * 128, s);
        launch(LoraOutF{hw, ha, p.b_w0, p.b_w2, p.b_a0, p.b_a2, WL, AV}, (long)M * D, s);
        launch(RwkvScanF{P, WL, AV, p.b_k_k, p.b_k_a, XN}, (long)B * H * 64, s);
        launch(RwkvGnF{P, AV, p.b_k_a, p.b_r_k, p.b_lnx_w, p.b_lnx_b, XN}, (long)M * H, s);
        launch(GemmOutF{XN, p.b_w_out, X, X, 1024}, (long)M * (D / 4), s);
#endif
    }
    LAYER_HOOK(1);
    {
        float* hk = (float*)(ws + wsl::HK); float* hv = (float*)(ws + wsl::HV);
        float* kc = (float*)(ws + wsl::KC); float* vc = (float*)(ws + wsl::VC);
        float* st = (float*)(ws + wsl::ST); int* sel = (int*)(ws + wsl::SEL); float* imp = (float*)(ws + wsl::L2_IMP);
        bf16* AO = (bf16*)(ws + wsl::L2_AO); bf16* OC = (bf16*)(ws + wsl::L2_OC); bf16* OS = (bf16*)(ws + wsl::L2_OS);
#if FAST_GEMM
        FASTP(PH_PREP2); FASTP(PH_IN2); FASTP(PH_B2); FASTP(PH_C2); FASTP(PH_D2); FASTP(PH_OUT2);
        (void)hk; (void)hv; (void)kc; (void)vc; (void)st; (void)sel; (void)imp; (void)AO; (void)OC; (void)OS;
#else
        launch(RstdF{X, rs}, M, s);
        launch(GemmInF{X, rs, p.norm_g + 2 * D, p.c_w_in, P, C_COLS}, (long)M * (C_COLS / 4), s);
        launch(CmpHidF{P, p.c_pos_k, p.c_k_w1, p.c_pos_v, p.c_v_w1, hk, hv}, 2L * B * G * NCMP * 128, s);
        launch(CmpOutF{hk, hv, p.c_k_w2, p.c_v_w2, kc, vc}, 2L * B * G * NCMP * 64, s);
        launch(CmpAttnF{P, kc, vc, st, OC}, (long)M * H, s);
        launch(ImpF{P, kc, st, imp}, (long)M * G * NSEL, s);
        launch(TopkF{imp, sel}, (long)M * G, s);
        launch(SelAttnF{P, p.t5, sel, OS}, (long)M * H, s);
        launch(WinAttnF{P, p.t5, OC, OS, AO}, (long)M * H, s);
        LAYER_HOOK(20);
        launch(GemmOutF{AO, p.c_w_out, X, X, 1024}, (long)M * (D / 4), s);
#endif
    }
    LAYER_HOOK(2);
    {
        bf16* AO = (bf16*)(ws + wsl::L3_AO); bf16* UC = (bf16*)(ws + wsl::L3_UC); bf16* LA = (bf16*)(ws + wsl::L3_LA); bf16* BV = (bf16*)(ws + wsl::L3_BV);
#if FAST_GEMM
        FASTP(PH_PREP3); FASTP(PH_IN3); FASTP(PH_GATE3); FASTP(PH_SCANA3); FASTP(PH_SCANB3); FASTP(PH_OUT3);
        (void)AO; (void)UC; (void)LA; (void)BV;
#else
        launch(RstdF{X, rs}, M, s);
        launch(GemmInF{X, rs, p.norm_g + 3 * D, p.d_w_in, P, 2560}, (long)M * (2560 / 4), s);
        launch(ConvF{P, p.d_conv_w, p.d_conv_b, UC}, (long)M * LW, s);
        launch(LruGateF{UC, p.d_ga_w, p.d_ga_b, p.d_gx_w, p.d_gx_b, p.d_lambda, LA, BV}, (long)M * LW, s);
        launch(LruScanF{P, LA, BV, AO}, (long)B * LW, s);
        launch(GemmOutF{AO, p.d_w_out, X, X, LW}, (long)M * (D / 4), s);
#endif
    }
    LAYER_HOOK(3);
#if FAST_GEMM
    FASTP(PH_FINAL);
#else
    launch(FinalNormF{X, p.final_g}, M, s);
#endif
}

extern "C" void kernel_launch(void* const* d_in, const int* in_sizes, int n_in, void* d_out, int out_size, void* d_ws, size_t ws_size,
                              hipStream_t stream) {
    (void)in_sizes; (void)n_in; (void)out_size; (void)ws_size;
    Params p{};
    const float* const* in = (const float* const*)d_in;
    int k = 0;
    p.x = in[k++]; p.t5 = in[k++]; p.norm_g = in[k++]; p.final_g = in[k++];
    p.a_w_in = in[k++]; p.a_sinks = in[k++]; p.a_w_out = in[k++];
    p.b_mu = in[k++]; p.b_w_in = in[k++]; p.b_w0 = in[k++]; p.b_w1 = in[k++]; p.b_w2 = in[k++]; p.b_a0 = in[k++]; p.b_a1 = in[k++]; p.b_a2 = in[k++];
    p.b_k_k = in[k++]; p.b_k_a = in[k++]; p.b_r_k = in[k++]; p.b_lnx_w = in[k++]; p.b_lnx_b = in[k++]; p.b_w_out = in[k++];
    p.c_w_in = in[k++]; p.c_pos_k = in[k++]; p.c_k_w1 = in[k++]; p.c_k_w2 = in[k++]; p.c_pos_v = in[k++]; p.c_v_w1 = in[k++]; p.c_v_w2 = in[k++]; p.c_w_out = in[k++];
    p.d_w_in = in[k++]; p.d_conv_w = in[k++]; p.d_conv_b = in[k++]; p.d_ga_w = in[k++]; p.d_ga_b = in[k++]; p.d_gx_w = in[k++]; p.d_gx_b = in[k++];
    p.d_lambda = in[k++]; p.d_w_out = in[k++];
    p.out = (float*)d_out; p.ws = (char*)d_ws;
#if !defined(CPU_SHIM) && !defined(MULTI_LAUNCH) && !defined(ALL_NAIVE)
    launch_mega(p, stream);
#else
    run_naive(p, stream);
#endif
}
```

```cpp
#ifndef CPU_SHIM
#include <hip/hip_runtime.h>
#include <hip/hip_cooperative_groups.h>
#include <cstdio>
#define HD __host__ __device__ __forceinline__
#else
#include <cmath>
#include <cstring>
#include <cstdio>
#include <cstdlib>
#include <cstdint>
#define HD inline
typedef void* hipStream_t;
#endif
#include <cstddef>

#ifndef CFG_B
#define CFG_B 4
#endif
#ifndef CFG_T
#define CFG_T 4096
#endif

namespace cfg {
constexpr int B = CFG_B, T = CFG_T, M = B * T, D = 1024;
constexpr int H = 16, G = 4, R = 4, DH = 64;
constexpr int A_COLS = 2560;
constexpr int C_COLS = 3632;
constexpr int NCMP = (T - 32) / 16 + 1;
constexpr int NSEL = T / 64;
constexpr int KTOP = NSEL < 16 ? NSEL : 16;
constexpr int LW = 1280;
}
using namespace cfg;

typedef unsigned short bf16;

HD unsigned f_as_u(float f) {
#ifndef CPU_SHIM
    return __float_as_uint(f);
#else
    unsigned u; memcpy(&u, &f, 4); return u;
#endif
}
HD float u_as_f(unsigned u) {
#ifndef CPU_SHIM
    return __uint_as_float(u);
#else
    float f; memcpy(&f, &u, 4); return f;
#endif
}
HD float bf2f(bf16 v) { return u_as_f(((unsigned)v) << 16); }
HD bf16 f2bf(float f) { unsigned u = f_as_u(f); u += 0x7fffu + ((u >> 16) & 1u); return (bf16)(u >> 16); }
HD float sigmoidf_(float x) { return 1.0f / (1.0f + expf(-x)); }
HD float siluf_(float x) { return x / (1.0f + expf(-x)); }
HD float softplusf_(float x) { return x > 20.f ? x : log1pf(expf(x)); }

HD int t5_bucket(int d) {
    if (d < 16) return d < 0 ? 0 : d;
    if (d >= 113) return 31;
    if (d >= 99) return 30;
    if (d >= 87) return 29;
    if (d >= 77) return 28;
    if (d >= 67) return 27;
    if (d >= 59) return 26;
    if (d >= 52) return 25;
    if (d >= 46) return 24;
    if (d >= 40) return 23;
    if (d >= 35) return 22;
    if (d >= 31) return 21;
    if (d >= 27) return 20;
    if (d >= 24) return 19;
    if (d >= 21) return 18;
    if (d >= 19) return 17;
    return 16;
}

struct Params {
    const float *x, *t5, *norm_g, *final_g;
    const float *a_w_in, *a_sinks, *a_w_out;
    const float *b_mu, *b_w_in, *b_w0, *b_w1, *b_w2, *b_a0, *b_a1, *b_a2, *b_k_k, *b_k_a, *b_r_k, *b_lnx_w, *b_lnx_b, *b_w_out;
    const float *c_w_in, *c_pos_k, *c_k_w1, *c_k_w2, *c_pos_v, *c_v_w1, *c_v_w2, *c_w_out;
    const float *d_w_in, *d_conv_w, *d_conv_b, *d_ga_w, *d_ga_b, *d_gx_w, *d_gx_b, *d_lambda, *d_w_out;
    float* out;
    char* ws;
};

namespace wsl {
constexpr size_t MB = 1024 * 1024;
constexpr size_t RS = 0;
constexpr size_t HK = 1 * MB;
constexpr size_t HV = 3 * MB;
constexpr size_t KC = 5 * MB;
constexpr size_t VC = 6 * MB;
constexpr size_t ST = 7 * MB;
constexpr size_t SEL = 9 * MB;
constexpr size_t LHW = 1 * MB;
constexpr size_t LHA = 5 * MB;
constexpr size_t P = 14 * MB;
constexpr size_t SZ1024 = (size_t)M * 1024 * 2, SZ1280 = (size_t)M * 1280 * 2;
constexpr size_t L0_AO = P + (size_t)M * 2560 * 2;
constexpr size_t L1_XN = P + (size_t)M * 4096 * 2, L1_WL = L1_XN + SZ1024, L1_AV = L1_WL + SZ1024;
constexpr size_t L2_AO = P + (size_t)M * 3632 * 2, L2_OC = L2_AO + SZ1024, L2_OS = L2_OC + SZ1024, L2_IMP = L2_OS + SZ1024;
constexpr size_t L3_AO = P + (size_t)M * 2560 * 2, L3_UC = L3_AO + SZ1280, L3_LA = L3_UC + SZ1280, L3_BV = L3_LA + SZ1280;
constexpr size_t TOTAL = L3_BV + SZ1280;
}

struct RstdF {
    const float* x; float* rs;
    HD void operator()(long m) const {
        const float* r = x + (size_t)m * D; float s = 0.f;
        for (int k = 0; k < D; ++k) s += r[k] * r[k];
        rs[m] = 1.0f / sqrtf(s / D + 1e-6f);
    }
};
struct XnF {
    const float* x; const float* rs; const float* g; bf16* xn;
    HD void operator()(long i) const { long m = i / D; int k = (int)(i % D); xn[i] = f2bf(x[i] * rs[m] * g[k]); }
};
struct GemmInF {
    const float *x, *rs, *g, *W; bf16* P; long long N;
    HD void operator()(long i) const {
        const int n4 = (int)N / 4; const long m = i / n4; const int n = (int)(i % n4) * 4;
        const float* xr = x + (size_t)m * D; const float r = rs[m];
        float a0 = 0, a1 = 0, a2 = 0, a3 = 0;
        for (int k = 0; k < D; ++k) {
            const float a = xr[k] * r * g[k]; const float* w = W + (size_t)k * N + n;
            a0 += a * w[0]; a1 += a * w[1]; a2 += a * w[2]; a3 += a * w[3];
        }
        bf16* p = P + (size_t)m * N + n; p[0] = f2bf(a0); p[1] = f2bf(a1); p[2] = f2bf(a2); p[3] = f2bf(a3);
    }
};
struct GemmOutF {
    const bf16* A; const float* W; const float* xin; float* xout; long long K;
    HD void operator()(long i) const {
        const int n4 = D / 4; const long m = i / n4; const int n = (int)(i % n4) * 4;
        const bf16* ar = A + (size_t)m * K;
        float a0 = 0, a1 = 0, a2 = 0, a3 = 0;
        for (int k = 0; k < K; ++k) {
            const float a = bf2f(ar[k]); const float* w = W + (size_t)k * D + n;
            a0 += a * w[0]; a1 += a * w[1]; a2 += a * w[2]; a3 += a * w[3];
        }
        const float* xi = xin + (size_t)m * D + n; float* xo = xout + (size_t)m * D + n;
        xo[0] = xi[0] + a0; xo[1] = xi[1] + a1; xo[2] = xi[2] + a2; xo[3] = xi[3] + a3;
    }
};

struct SwaF {
    const bf16* P; const float* t5; const float* sinks; bf16* AO;
    HD void operator()(long i) const {
        const long m = i / H; const int h = (int)(i % H), g = h / R; const int t = (int)(m % T); const long mb = m - t;
        float q[DH], o[DH];
#pragma unroll
        for (int d = 0; d < DH; ++d) { q[d] = bf2f(P[(size_t)m * A_COLS + h * DH + d]); o[d] = 0.f; }
        float mx = sinks[h], l = 1.0f;
        const int s0 = t - 127 < 0 ? 0 : t - 127;
        for (int s = s0; s <= t; ++s) {
            const bf16* kr = P + (size_t)(mb + s) * A_COLS + 1024 + g * DH;
            const bf16* vr = kr + 256;
            float sc = 0.f;
#pragma unroll
            for (int d = 0; d < DH; ++d) sc += q[d] * bf2f(kr[d]);
            sc = sc * 0.125f + t5[t5_bucket(t - s) * H + h];
            const float mn = sc > mx ? sc : mx; const float al = expf(mx - mn), p = expf(sc - mn);
            l = l * al + p; mx = mn;
#pragma unroll
            for (int d = 0; d < DH; ++d) o[d] = o[d] * al + p * bf2f(vr[d]);
        }
        const float il = 1.0f / l;
#pragma unroll
        for (int d = 0; d < DH; ++d) {
            const float z = bf2f(P[(size_t)m * A_COLS + 1536 + h * DH + d]);
            AO[(size_t)m * D + h * DH + d] = f2bf(o[d] * il * siluf_(z));
        }
    }
};

struct GemmRwkvF {
    const bf16* xn; const float* mu; const float* W; bf16* P;
    HD void operator()(long i) const {
        const int N = 4096, n4 = N / 4; const long m = i / n4; const int n = (int)(i % n4) * 4; const int s = n / 1024;
        const int t = (int)(m % T);
        const bf16* xr = xn + (size_t)m * D; const float* mus = mu + s * D;
        float a0 = 0, a1 = 0, a2 = 0, a3 = 0;
        for (int k = 0; k < D; ++k) {
            const float xc = bf2f(xr[k]); const float xp = t > 0 ? bf2f(xr[k - D]) : 0.f;
            const float a = xc + (xp - xc) * mus[k]; const float* w = W + (size_t)k * N + n;
            a0 += a * w[0]; a1 += a * w[1]; a2 += a * w[2]; a3 += a * w[3];
        }
        bf16* p = P + (size_t)m * N + n; p[0] = f2bf(a0); p[1] = f2bf(a1); p[2] = f2bf(a2); p[3] = f2bf(a3);
    }
};
struct LoraHidF {
    const bf16* xn; const float* mu; const float* w1; const float* a1; float* hw; float* ha;
    HD void operator()(long i) const {
        const long m = i / 128; const int jj = (int)(i % 128); const int which = jj / 64, j = jj % 64; const int t = (int)(m % T);
        const bf16* xr = xn + (size_t)m * D; const float* mus = mu + (4 + which) * D; const float* W = which ? a1 : w1;
        float acc = 0.f;
        for (int k = 0; k < D; ++k) {
            const float xc = bf2f(xr[k]); const float xp = t > 0 ? bf2f(xr[k - D]) : 0.f;
            acc += (xc + (xp - xc) * mus[k]) * W[(size_t)k * 64 + j];
        }
        if (which) ha[(size_t)m * 64 + j] = acc; else hw[(size_t)m * 64 + j] = tanhf(acc);
    }
};
struct LoraOutF {
    const float *hw, *ha, *w0, *w2, *a0, *a2; bf16* wlog; bf16* av;
    HD void operator()(long i) const {
        const long m = i / D; const int c = (int)(i % D);
        float sw = 0.f, sa = 0.f;
        for (int j = 0; j < 64; ++j) { sw += hw[(size_t)m * 64 + j] * w2[(size_t)j * D + c]; sa += ha[(size_t)m * 64 + j] * a2[(size_t)j * D + c]; }
        const float wr = -softplusf_(-(w0[c] + sw)) - 0.5f;
        wlog[i] = f2bf(-expf(wr)); av[i] = f2bf(sigmoidf_(a0[c] + sa));
    }
};
struct RwkvScanF {
    const bf16* P; const bf16* wlog; const bf16* av; const float* k_k; const float* k_a; bf16* ys;
    HD void operator()(long idx) const {
        const int i = (int)(idx % 64); const int h = (int)((idx / 64) % H); const int b = (int)(idx / (64 * H));
        float S[64];
#pragma unroll
        for (int j = 0; j < 64; ++j) S[j] = 0.f;
        for (int t = 0; t < T; ++t) {
            const size_t m = (size_t)b * T + t; const bf16* pr = P + m * 4096 + h * 64;
            const bf16* wl = wlog + m * D + h * 64; const bf16* ar = av + m * D + h * 64;
            float n2 = 0.f;
#pragma unroll
            for (int j = 0; j < 64; ++j) { const float kk = bf2f(pr[1024 + j]) * k_k[h * 64 + j]; n2 += kk * kk; }
            float nr = sqrtf(n2); nr = nr > 1e-12f ? nr : 1e-12f; const float inr = 1.0f / nr;
            float sa = 0.f;
#pragma unroll
            for (int j = 0; j < 64; ++j) { const float kk = bf2f(pr[1024 + j]) * k_k[h * 64 + j] * inr; sa += S[j] * (-kk); }
            const float vi = bf2f(pr[2048 + i]); float y = 0.f;
#pragma unroll
            for (int j = 0; j < 64; ++j) {
                const float kr = bf2f(pr[1024 + j]); const float a = bf2f(ar[j]);
                const float kk = kr * k_k[h * 64 + j] * inr; const float kp = kr * (1.0f + (a - 1.0f) * k_a[h * 64 + j]);
                const float dec = expf(bf2f(wl[j]));
                S[j] = S[j] * dec + sa * (kk * a) + vi * kp;
                y += S[j] * bf2f(pr[j]);
            }
            ys[m * D + h * 64 + i] = f2bf(y);
        }
    }
};
struct RwkvGnF {
    const bf16* P; const bf16* av; const float *k_a, *r_k, *lnx_w, *lnx_b; bf16* ys;
    HD void operator()(long idx) const {
        const long m = idx / H; const int h = (int)(idx % H);
        bf16* yr = ys + (size_t)m * D + h * 64; const bf16* pr = P + (size_t)m * 4096 + h * 64; const bf16* ar = av + (size_t)m * D + h * 64;
        float mean = 0.f;
        for (int j = 0; j < 64; ++j) mean += bf2f(yr[j]);
        mean /= 64.f; float var = 0.f;
        for (int j = 0; j < 64; ++j) { const float d = bf2f(yr[j]) - mean; var += d * d; }
        var /= 64.f; const float rstd = 1.0f / sqrtf(var + 64e-5f);
        float bs = 0.f;
        for (int j = 0; j < 64; ++j) { const float kr = bf2f(pr[1024 + j]); const float kp = kr * (1.0f + (bf2f(ar[j]) - 1.0f) * k_a[h * 64 + j]); bs += bf2f(pr[j]) * kp * r_k[h * 64 + j]; }
        for (int j = 0; j < 64; ++j) {
            const float yn = (bf2f(yr[j]) - mean) * rstd * lnx_w[h * 64 + j] + lnx_b[h * 64 + j];
            const float z = bf2f(pr[3072 + j]);
            yr[j] = f2bf((yn + bs * bf2f(pr[2048 + j])) * siluf_(z));
        }
    }
};

struct CmpHidF {
    const bf16* P; const float *pos_k, *w1_k, *pos_v, *w1_v; float* hk; float* hv;
    HD void operator()(long idx) const {
        const int j = (int)(idx % 128); long r = idx / 128; const int n = (int)(r % NCMP); r /= NCMP; const int g = (int)(r % G); r /= G;
        const int b = (int)(r % B); const int which = (int)(r / B);
        const float* pos = which ? pos_v : pos_k; const float* w1 = which ? w1_v : w1_k; const int col = 1024 + (which ? 256 : 0) + g * 64;
        float acc = 0.f;
        for (int l = 0; l < 32; ++l) {
            const bf16* src = P + (size_t)(b * T + 16 * n + l) * C_COLS + col;
            for (int d = 0; d < 64; ++d) acc += (bf2f(src[d]) + pos[l * 64 + d]) * w1[(size_t)(l * 64 + d) * 128 + j];
        }
        (which ? hv : hk)[(((size_t)b * G + g) * NCMP + n) * 128 + j] = siluf_(acc);
    }
};
struct CmpOutF {
    const float *hk, *hv, *w2_k, *w2_v; float* kc; float* vc;
    HD void operator()(long idx) const {
        const int d = (int)(idx % 64); long r = idx / 64; const long row = r % ((long)B * G * NCMP); const int which = (int)(r / ((long)B * G * NCMP));
        const float* hsrc = (which ? hv : hk) + (size_t)row * 128; const float* w2 = which ? w2_v : w2_k;
        float acc = 0.f;
        for (int j = 0; j < 128; ++j) acc += hsrc[j] * w2[j * 64 + d];
        (which ? vc : kc)[(size_t)row * 64 + d] = acc;
    }
};
struct CmpAttnF {
    const bf16* P; const float *kc, *vc; float* st; bf16* oc;
    HD void operator()(long i) const {
        const long m = i / H; const int h = (int)(i % H), g = h / R; const int t = (int)(m % T); const int b = (int)(m / T);
        float q[DH], o[DH];
#pragma unroll
        for (int d = 0; d < DH; ++d) { q[d] = bf2f(P[(size_t)m * C_COLS + h * DH + d]); o[d] = 0.f; }
        const int nv = t < 31 ? 0 : (t - 31) / 16 + 1;
        float mx = -1e30f, l = 0.f;
        for (int n = 0; n < nv; ++n) {
            const float* kr = kc + (((size_t)b * G + g) * NCMP + n) * 64; const float* vr = vc + (((size_t)b * G + g) * NCMP + n) * 64;
            float sc = 0.f;
#pragma unroll
            for (int d = 0; d < DH; ++d) sc += q[d] * kr[d];
            sc *= 0.125f;
            const float mn = sc > mx ? sc : mx; const float al = expf(mx - mn), p = expf(sc - mn);
            l = l * al + p; mx = mn;
#pragma unroll
            for (int d = 0; d < DH; ++d) o[d] = o[d] * al + p * vr[d];
        }
        const float il = nv > 0 ? 1.0f / l : 0.f;
        st[(size_t)i * 2] = mx; st[(size_t)i * 2 + 1] = il;
#pragma unroll
        for (int d = 0; d < DH; ++d) oc[(size_t)m * D + h * DH + d] = f2bf(o[d] * il);
    }
};
struct ImpF {
    const bf16* P; const float *kc, *st; float* imp;
    HD void operator()(long idx) const {
        const int s = (int)(idx % NSEL); long r = idx / NSEL; const int g = (int)(r % G); const long m = r / G;
        const int t = (int)(m % T); const int b = (int)(m / T); const int cur = t / 64;
        float v;
        if (s == 0 || s == cur || s == cur - 1) v = 1e30f;
        else if (s * 64 > t) v = -1e30f;
        else {
            v = 0.f; const int nv = t < 31 ? 0 : (t - 31) / 16 + 1;
            int n0 = 4 * s - 1; if (n0 < 0) n0 = 0; int n1 = 4 * s + 3; if (n1 > NCMP - 1) n1 = NCMP - 1; if (n1 > nv - 1) n1 = nv - 1;
            for (int rr = 0; rr < R; ++rr) {
                const int h = g * R + rr; const bf16* qr = P + (size_t)m * C_COLS + h * DH;
                const float mx = st[((size_t)m * H + h) * 2], il = st[((size_t)m * H + h) * 2 + 1];
                for (int n = n0; n <= n1; ++n) {
                    const float* kr = kc + (((size_t)b * G + g) * NCMP + n) * 64; float sc = 0.f;
                    for (int d = 0; d < DH; ++d) sc += bf2f(qr[d]) * kr[d];
                    v += expf(sc * 0.125f - mx) * il;
                }
            }
        }
        imp[idx] = v;
    }
};
struct TopkF {
    const float* imp; int* sel;
    HD void operator()(long idx) const {
        const float* v = imp + (size_t)idx * NSEL; unsigned long long used = 0ull;
        for (int j = 0; j < KTOP; ++j) {
            int best = -1; float bv = 0.f;
            for (int s = 0; s < NSEL; ++s) { if ((used >> s) & 1ull) continue; const float x = v[s]; if (best < 0 || x > bv) { best = s; bv = x; } }
            used |= 1ull << best; sel[(size_t)idx * 16 + j] = best;
        }
    }
};
struct SelAttnF {
    const bf16* P; const float* t5; const int* sel; bf16* os;
    HD void operator()(long i) const {
        const long m = i / H; const int h = (int)(i % H), g = h / R; const int t = (int)(m % T); const long mb = m - t;
        float q[DH], o[DH];
#pragma unroll
        for (int d = 0; d < DH; ++d) { q[d] = bf2f(P[(size_t)m * C_COLS + h * DH + d]); o[d] = 0.f; }
        float mx = -1e30f, l = 0.f;
        for (int j = 0; j < KTOP; ++j) {
            const int blk = sel[((size_t)m * G + g) * 16 + j];
            for (int ll = 0; ll < 64; ++ll) {
                const int s = blk * 64 + ll; if (s > t) break;
                const bf16* kr = P + (size_t)(mb + s) * C_COLS + 1536 + g * DH; const bf16* vr = kr + 256;
                float sc = 0.f;
#pragma unroll
                for (int d = 0; d < DH; ++d) sc += q[d] * bf2f(kr[d]);
                sc = sc * 0.125f + t5[t5_bucket(t - s) * H + h];
                const float mn = sc > mx ? sc : mx; const float al = expf(mx - mn), p = expf(sc - mn);
                l = l * al + p; mx = mn;
#pragma unroll
                for (int d = 0; d < DH; ++d) o[d] = o[d] * al + p * bf2f(vr[d]);
            }
        }
        const float il = 1.0f / l;
#pragma unroll
        for (int d = 0; d < DH; ++d) os[(size_t)m * D + h * DH + d] = f2bf(o[d] * il);
    }
};
struct WinAttnF {
    const bf16* P; const float* t5; const bf16* oc; const bf16* os; bf16* AO;
    HD void operator()(long i) const {
        const long m = i / H; const int h = (int)(i % H), g = h / R, rr = h % R; const int t = (int)(m % T); const long mb = m - t;
        float q[DH], o[DH];
#pragma unroll
        for (int d = 0; d < DH; ++d) { q[d] = bf2f(P[(size_t)m * C_COLS + h * DH + d]); o[d] = 0.f; }
        float mx = -1e30f, l = 0.f;
        const int s0 = t - 511 < 0 ? 0 : t - 511;
        for (int s = s0; s <= t; ++s) {
            const bf16* kr = P + (size_t)(mb + s) * C_COLS + 2048 + g * DH; const bf16* vr = kr + 256;
            float sc = 0.f;
#pragma unroll
            for (int d = 0; d < DH; ++d) sc += q[d] * bf2f(kr[d]);
            sc = sc * 0.125f + t5[t5_bucket(t - s) * H + h];
            const float mn = sc > mx ? sc : mx; const float al = expf(mx - mn), p = expf(sc - mn);
            l = l * al + p; mx = mn;
#pragma unroll
            for (int d = 0; d < DH; ++d) o[d] = o[d] * al + p * bf2f(vr[d]);
        }
        const float il = 1.0f / l;
        const bf16* gr = P + (size_t)m * C_COLS + 2560;
        const float g0 = sigmoidf_(bf2f(gr[0 * 16 + g * R + rr])), g1 = sigmoidf_(bf2f(gr[1 * 16 + g * R + rr])), g2 = sigmoidf_(bf2f(gr[2 * 16 + g * R + rr]));
#pragma unroll
        for (int d = 0; d < DH; ++d) {
            const size_t oi = (size_t)m * D + h * DH + d;
            const float z = bf2f(P[(size_t)m * C_COLS + 2608 + h * DH + d]);
            AO[oi] = f2bf((g0 * bf2f(oc[oi]) + g1 * bf2f(os[oi]) + g2 * o[d] * il) * siluf_(z));
        }
    }
};

struct ConvF {
    const bf16* P; const float *cw, *cb; bf16* uc;
    HD void operator()(long i) const {
        const long m = i / LW; const int c = (int)(i % LW); const int t = (int)(m % T);
        float acc = cb[c];
        for (int w = 0; w < 4; ++w) { const int tt = t - 3 + w; if (tt >= 0) acc += cw[w * LW + c] * bf2f(P[(size_t)(m - 3 + w) * 2560 + c]); }
        uc[i] = f2bf(acc);
    }
};
struct LruGateF {
    const bf16* uc; const float *gaw, *gab, *gxw, *gxb, *lam; bf16* la; bf16* bv;
    HD void operator()(long i) const {
        const long m = i / LW; const int c = (int)(i % LW); const int n = c / 80, d = c % 80;
        const bf16* ub = uc + (size_t)m * LW + n * 80; float ra = gab[c], rx = gxb[c];
        for (int k = 0; k < 80; ++k) { const float u = bf2f(ub[k]); ra += u * gaw[((size_t)n * 80 + k) * 80 + d]; rx += u * gxw[((size_t)n * 80 + k) * 80 + d]; }
        const float r = sigmoidf_(ra), ig = sigmoidf_(rx);
        const float loga = -8.0f * r * softplusf_(-lam[c]);
        la[i] = f2bf(loga);
        bv[i] = f2bf(sqrtf(-expm1f(2.0f * loga)) * (ig * bf2f(uc[i])));
    }
};
struct LruScanF {
    const bf16* P; const bf16* la; const bf16* bv; bf16* AO;
    HD void operator()(long idx) const {
        const int c = (int)(idx % LW); const int b = (int)(idx / LW); float h = 0.f;
        for (int t = 0; t < T; ++t) {
            const size_t m = (size_t)b * T + t;
            h = expf(bf2f(la[m * LW + c])) * h + bf2f(bv[m * LW + c]);
            AO[m * LW + c] = f2bf(h * siluf_(bf2f(P[m * 2560 + LW + c])));
        }
    }
};
struct FinalNormF {
    float* x; const float* g;
    HD void operator()(long m) const {
        float* r = x + (size_t)m * D; float s = 0.f;
        for (int k = 0; k < D; ++k) s += r[k] * r[k];
        const float rs = 1.0f / sqrtf(s / D + 1e-6f);
        for (int k = 0; k < D; ++k) r[k] = r[k] * rs * g[k];
    }
};


#ifndef CPU_SHIM
typedef short bf16x8 __attribute__((ext_vector_type(8)));
typedef float f32x4 __attribute__((ext_vector_type(4)));
typedef unsigned u32x4 __attribute__((ext_vector_type(4)));
typedef unsigned u32x2 __attribute__((ext_vector_type(2)));
#define DI __device__ __forceinline__
#define NTHREADS 256
__device__ __forceinline__ int opaque_tid() { int t = threadIdx.x; asm volatile("" : "+v"(t)); return t; }
#define TIDX (opaque_tid())

typedef __bf16 hbf16x2 __attribute__((ext_vector_type(2)));
typedef float f32x2 __attribute__((ext_vector_type(2)));
DI unsigned pack2bf(float lo, float hi) { f32x2 f = {lo, hi}; return __builtin_bit_cast(unsigned, __builtin_convertvector(f, hbf16x2)); }
DI float bflo(unsigned u) { return __uint_as_float(u << 16); }
DI float bfhi(unsigned u) { return __uint_as_float(u & 0xffff0000u); }

namespace fw {
constexpr size_t MB = 1024 * 1024;
constexpr size_t PARTS = 13 * MB;
constexpr size_t SMALLB = 1 * MB;
constexpr size_t WB = 14 * MB;
constexpr size_t XB = 30 * MB;
constexpr size_t BIG = 62 * MB;
}

DI void convert_tile(const float* __restrict__ W, int ldw, int c0, int K, bf16* __restrict__ Wt, const float* __restrict__ g, int kt, int nt, float* sm) {
    const int tid = TIDX;
    const int k0 = kt * 64, n0 = nt * 64;
#pragma unroll
    for (int i = 0; i < 4; ++i) {
        const int kr = (tid >> 4) + 16 * i; const int nc = (tid & 15) * 4;
        const float4 v = *(const float4*)(W + (size_t)(k0 + kr) * ldw + c0 + n0 + nc);
        const float s = g ? g[k0 + kr] : 1.0f;
        sm[kr * 65 + nc + 0] = v.x * s; sm[kr * 65 + nc + 1] = v.y * s; sm[kr * 65 + nc + 2] = v.z * s; sm[kr * 65 + nc + 3] = v.w * s;
    }
    __syncthreads();
    {
        const int n = tid >> 2, kq = (tid & 3) * 16;
        unsigned w[8];
#pragma unroll
        for (int j = 0; j < 8; ++j) w[j] = pack2bf(sm[(kq + 2 * j) * 65 + n], sm[(kq + 2 * j + 1) * 65 + n]);
        u32x4* dst = (u32x4*)(Wt + (size_t)(n0 + n) * K + k0 + kq);
        dst[0] = (u32x4){w[0], w[1], w[2], w[3]}; dst[1] = (u32x4){w[4], w[5], w[6], w[7]};
    }
    __syncthreads();
}
DI void convert_seg(const float* W, int ldw, int c0, int ncols, int K, bf16* Wt, const float* g, float* sm, int& tbase) {
    const int nkt = K / 64, nnt = ncols / 64, ntile = nkt * nnt;
    const int Gd = (int)gridDim.x;
    for (int t = (((int)blockIdx.x - tbase % Gd) + Gd) % Gd; t < ntile; t += Gd) convert_tile(W, ldw, c0, K, Wt, g, t % nkt, t / nkt, sm);
    tbase += ntile;
}

DI int perm32(int rho) { const int n = rho >> 4, i = rho & 15; return 8 * (i >> 2) + 4 * n + (i & 3); }

struct ALoadPlain {
    const bf16* A; int lda;
    static constexpr bool DMA = true;
    DI const bf16* src(int m, int k) const { return A + (size_t)m * lda + k; }
    struct Raw { u32x4 v; };
    DI Raw load(int m, int k) const { Raw r; r.v = *(const u32x4*)(A + (size_t)m * lda + k); return r; }
    DI u32x4 finish(const Raw& r, int, int) const { return r.v; }
};
struct ALoadLerp {
    const bf16* xn; const float* mu;
    static constexpr bool DMA = false;
    DI const bf16* src(int, int) const { return nullptr; }
    struct Raw { u32x4 c, p; };
    DI Raw load(int m, int k) const {
        Raw r; r.c = *(const u32x4*)(xn + (size_t)m * D + k);
        if ((m % T) != 0) r.p = *(const u32x4*)(xn + (size_t)(m - 1) * D + k); else r.p = (u32x4){0u, 0u, 0u, 0u};
        return r;
    }
    DI u32x4 finish(const Raw& r, int, int k) const {
        const float4 m0 = *(const float4*)(mu + k), m1 = *(const float4*)(mu + k + 4);
        const float mm[8] = {m0.x, m0.y, m0.z, m0.w, m1.x, m1.y, m1.z, m1.w};
        u32x4 o;
#pragma unroll
        for (int j = 0; j < 4; ++j) {
            const float c0 = bflo(r.c[j]), c1 = bfhi(r.c[j]), p0 = bflo(r.p[j]), p1 = bfhi(r.p[j]);
            o[j] = pack2bf(c0 + (p0 - c0) * mm[2 * j], c1 + (p1 - c1) * mm[2 * j + 1]);
        }
        return o;
    }
};

#define GLDS16(gp, lp) __builtin_amdgcn_global_load_lds((const unsigned*)(gp), (unsigned*)(lp), 16, 0, 0)
template <class AL, class Epi>
DI void gemm_tile(const AL& al, const bf16* __restrict__ Bt, int K, int m0, int n0, const Epi& epi, char* smem) {
    const int tid = TIDX, lane = tid & 63, wave = __builtin_amdgcn_readfirstlane(tid >> 6), wr = wave >> 1, wc = wave & 1, q = lane >> 4, l15 = lane & 15;
    const int srow = tid >> 3, sc = tid & 7, scs = sc ^ (srow & 7);
    const int st_off = srow * 128 + (sc << 4);
    const int dma_off = (8 * wave) * 128;
    int brow[4];
#pragma unroll
    for (int i = 0; i < 4; ++i) { const int rho = srow + 32 * i; brow[i] = n0 + (rho & ~31) + perm32(rho & 31); }
    const int fa0 = (wr * 64 + l15) * 128 + ((q ^ (lane & 7)) << 4);
    const int fb0 = (wc * 64 + l15) * 128 + ((q ^ (lane & 7)) << 4);
    f32x4 acc[4][4];
#pragma unroll
    for (int i = 0; i < 4; ++i)
#pragma unroll
        for (int j = 0; j < 4; ++j) acc[i][j] = (f32x4){0.f, 0.f, 0.f, 0.f};
    typename AL::Raw ra[4];
    const int nk = K / 64;
    {
        char* bufA = smem; char* bufB = smem + 16384;
#pragma unroll
        for (int i = 0; i < 4; ++i) {
            GLDS16(Bt + (size_t)brow[i] * K + scs * 8, bufB + dma_off + i * 4096);
            if (AL::DMA) GLDS16(al.src(m0 + srow + 32 * i, scs * 8), bufA + dma_off + i * 4096);
            else ra[i] = al.load(m0 + srow + 32 * i, scs * 8);
        }
        if (!AL::DMA) {
#pragma unroll
            for (int i = 0; i < 4; ++i) *(u32x4*)(bufA + st_off + i * 4096) = al.finish(ra[i], m0 + srow + 32 * i, scs * 8);
        }
    }
    asm volatile("s_waitcnt vmcnt(0)" ::: "memory");
    __syncthreads();
    for (int kt = 0; kt < nk; ++kt) {
        char* bufA = smem + (kt & 1) * 32768; char* bufB = bufA + 16384;
        char* nA = smem + ((kt + 1) & 1) * 32768; char* nB = nA + 16384;
        const bool more = kt + 1 < nk; const int kn = (kt + 1) * 64 + scs * 8;
        if (more) {
#pragma unroll
            for (int i = 0; i < 4; ++i) {
                GLDS16(Bt + (size_t)brow[i] * K + kn, nB + dma_off + i * 4096);
                if (AL::DMA) GLDS16(al.src(m0 + srow + 32 * i, kn), nA + dma_off + i * 4096);
                else ra[i] = al.load(m0 + srow + 32 * i, kn);
            }
        }
#pragma unroll
        for (int ks = 0; ks < 2; ++ks) {
            bf16x8 af[4], bfr[4];
#pragma unroll
            for (int i = 0; i < 4; ++i) {
                af[i] = *(const bf16x8*)(bufA + ((fa0 + i * 2048) ^ (ks << 6)));
                bfr[i] = *(const bf16x8*)(bufB + ((fb0 + i * 2048) ^ (ks << 6)));
            }
#pragma unroll
            for (int i = 0; i < 4; ++i)
#pragma unroll
                for (int j = 0; j < 4; ++j) acc[i][j] = __builtin_amdgcn_mfma_f32_16x16x32_bf16(bfr[j], af[i], acc[i][j], 0, 0, 0);
        }
        if (more && !AL::DMA) {
#pragma unroll
            for (int i = 0; i < 4; ++i) *(u32x4*)(nA + st_off + i * 4096) = al.finish(ra[i], m0 + srow + 32 * i, kn);
        }
        asm volatile("s_waitcnt vmcnt(0)" ::: "memory");
        __syncthreads();
    }
#pragma unroll
    for (int mt = 0; mt < 4; ++mt)
#pragma unroll
        for (int gi = 0; gi < 2; ++gi) {
            float v[8];
#pragma unroll
            for (int r = 0; r < 4; ++r) { v[r] = acc[mt][2 * gi][r]; v[4 + r] = acc[mt][2 * gi + 1][r]; }
            epi(m0 + wr * 64 + mt * 16 + l15, n0 + wc * 64 + gi * 32 + 8 * q, v, mt, gi);
        }
    epi.finish(m0, n0, wr, wc, lane);
}

constexpr int G2_STAGE = 24576;
template <class AL, class Epi>
DI void gemm_tile2(const AL& al, const bf16* __restrict__ Bt, int K, int m0, int n0, const Epi& epi, char* smem) {
    const int tid = TIDX, lane = tid & 63, wave = __builtin_amdgcn_readfirstlane(tid >> 6), wr = wave >> 1, wc = wave & 1, q = lane >> 4, l15 = lane & 15;
    const int prow = tid >> 2, ppos = tid & 3, ca = (ppos - 2 * ((tid >> 4) & 3)) & 3;
    const int dma_off = wave * 1024;
    int brow[4];
#pragma unroll
    for (int i = 0; i < 4; ++i) { const int rho = prow + 64 * i; brow[i] = n0 + (rho & ~31) + perm32(rho & 31); }
    const int fpos = ((q + 2 * ((l15 >> 2) & 3)) & 3) << 4;
    const int fa0 = (wr * 64 + l15) * 64 + fpos, fb0 = 8192 + (wc * 128 + l15) * 64 + fpos;
    f32x4 acc[4][8];
#pragma unroll
    for (int i = 0; i < 4; ++i)
#pragma unroll
        for (int j = 0; j < 8; ++j) acc[i][j] = (f32x4){0.f, 0.f, 0.f, 0.f};
    typename AL::Raw ra[2];
    const int nk = K / 32;
#define G2_ISSUE(kt_) { char* st_ = smem + ((kt_) % 3) * G2_STAGE; const int kk_ = (kt_) * 32 + ca * 8; \
        _Pragma("unroll") for (int i = 0; i < 2; ++i) { if (AL::DMA) GLDS16(al.src(m0 + prow + 64 * i, kk_), st_ + dma_off + i * 4096); else ra[i] = al.load(m0 + prow + 64 * i, kk_); } \
        _Pragma("unroll") for (int i = 0; i < 4; ++i) GLDS16(Bt + (size_t)brow[i] * K + kk_, st_ + 8192 + dma_off + i * 4096); }
#define G2_AWRITE(kt_) { if (!AL::DMA) { char* st_ = smem + ((kt_) % 3) * G2_STAGE; const int kk_ = (kt_) * 32 + ca * 8; \
        _Pragma("unroll") for (int i = 0; i < 2; ++i) *(u32x4*)(st_ + (prow + 64 * i) * 64 + ppos * 16) = al.finish(ra[i], m0 + prow + 64 * i, kk_); } }
#define G2_BARRIER() { asm volatile("s_waitcnt lgkmcnt(0)" ::: "memory"); __builtin_amdgcn_s_barrier(); asm volatile("" ::: "memory"); }
    G2_ISSUE(0); G2_AWRITE(0);
    if (nk > 1) { G2_ISSUE(1); G2_AWRITE(1); }
    if (nk > 1) { if (AL::DMA) asm volatile("s_waitcnt vmcnt(6)" ::: "memory"); else asm volatile("s_waitcnt vmcnt(4)" ::: "memory"); } else asm volatile("s_waitcnt vmcnt(0)" ::: "memory");
    G2_BARRIER();
    for (int kt = 0; kt < nk; ++kt) {
        const char* st = smem + (kt % 3) * G2_STAGE;
        const bool more = kt + 2 < nk;
        if (more) G2_ISSUE(kt + 2);
        bf16x8 af[4];
#pragma unroll
        for (int i = 0; i < 4; ++i) af[i] = *(const bf16x8*)(st + fa0 + i * 1024);
#pragma unroll
        for (int j = 0; j < 8; ++j) {
            const bf16x8 bf_ = *(const bf16x8*)(st + fb0 + j * 1024);
#pragma unroll
            for (int i = 0; i < 4; ++i) acc[i][j] = __builtin_amdgcn_mfma_f32_16x16x32_bf16(bf_, af[i], acc[i][j], 0, 0, 0);
        }
        if (more) G2_AWRITE(kt + 2);
        if (more) { if (AL::DMA) asm volatile("s_waitcnt vmcnt(6)" ::: "memory"); else asm volatile("s_waitcnt vmcnt(4)" ::: "memory"); } else asm volatile("s_waitcnt vmcnt(0)" ::: "memory");
        G2_BARRIER();
    }
#undef G2_ISSUE
#undef G2_AWRITE
#undef G2_BARRIER
#pragma unroll
    for (int mt = 0; mt < 4; ++mt)
#pragma unroll
        for (int gi = 0; gi < 4; ++gi) {
            float v[8];
#pragma unroll
            for (int r = 0; r < 4; ++r) { v[r] = acc[mt][2 * gi][r]; v[4 + r] = acc[mt][2 * gi + 1][r]; }
            epi(m0 + wr * 64 + mt * 16 + l15, n0 + wc * 128 + gi * 32 + 8 * q, v, mt, gi);
        }
    epi.finish_wide(m0, n0, wr, wc, lane);
}
template <class F>
DI void gemm_sched(int nbig, int nsmall, F&& f) {
    const int x = blockIdx.x & 7, lb = blockIdx.x >> 3, nlb = gridDim.x >> 3;
    const int nb16 = 16 * nbig, tot = 16 * (nbig + nsmall);
    for (int s = lb; s < tot; s += nlb) {
        if (s < nb16) f(true, x * 16 + (s & 15), s >> 4);
        else { const int t = s - nb16; f(false, x * 16 + (t & 15), t >> 4); }
    }
}

DI float rstd_from_parts(const float* parts, int m) {
    const float4* p = (const float4*)(parts + (size_t)m * 16); float s = 0.f;
#pragma unroll
    for (int i = 0; i < 4; ++i) { const float4 v = p[i]; s += (v.x + v.y) + (v.z + v.w); }
    return 1.0f / sqrtf(s * (1.0f / D) + 1e-6f);
}
DI void store8bf(bf16* p, const float* v) { *(u32x4*)p = (u32x4){pack2bf(v[0], v[1]), pack2bf(v[2], v[3]), pack2bf(v[4], v[5]), pack2bf(v[6], v[7])}; }

struct EpiBf16 {
    bf16* P; int ldp; const float* parts; mutable float rsc[4];
    DI void operator()(int m, int n, const float* v, int mt, int gi) const {
        if (gi == 0) rsc[mt] = parts ? rstd_from_parts(parts, m) : 1.0f;
        float s = rsc[mt]; float w[8];
#pragma unroll
        for (int j = 0; j < 8; ++j) w[j] = v[j] * s;
        store8bf(P + (size_t)m * ldp + n, w);
    }
    DI void finish(int, int, int, int, int) const {}
    DI void finish_wide(int, int, int, int, int) const {}
};
struct EpiResid {
    const float* xin; float* xout; bf16* xb; float* parts; mutable float sq[4];
    DI void operator()(int m, int n, const float* v, int mt, int gi) const {
        const float4* xi = (const float4*)(xin + (size_t)m * D + n); const float4 a = xi[0], b = xi[1];
        float w[8] = {a.x + v[0], a.y + v[1], a.z + v[2], a.w + v[3], b.x + v[4], b.y + v[5], b.z + v[6], b.w + v[7]};
        float4* xo = (float4*)(xout + (size_t)m * D + n);
        xo[0] = make_float4(w[0], w[1], w[2], w[3]); xo[1] = make_float4(w[4], w[5], w[6], w[7]);
        if (xb) store8bf(xb + (size_t)m * D + n, w);
        float s = 0.f;
#pragma unroll
        for (int j = 0; j < 8; ++j) s += w[j] * w[j];
        if (gi == 0) sq[mt] = s; else sq[mt] += s;
    }
    DI void finish(int m0, int n0, int wr, int wc, int lane) const {
#pragma unroll
        for (int mt = 0; mt < 4; ++mt) {
            float s = sq[mt]; s += __shfl_xor(s, 16); s += __shfl_xor(s, 32);
            if (lane < 16) parts[(size_t)(m0 + wr * 64 + mt * 16 + lane) * 16 + (n0 >> 7) * 2 + wc] = s;
        }
    }
    DI void finish_wide(int m0, int n0, int wr, int wc, int lane) const {
#pragma unroll
        for (int mt = 0; mt < 4; ++mt) {
            float s = sq[mt]; s += __shfl_xor(s, 16); s += __shfl_xor(s, 32);
            if (lane < 16) { float* pr = parts + (size_t)(m0 + wr * 64 + mt * 16 + lane) * 16 + (n0 >> 7) + wc; pr[0] = s; pr[8] = 0.f; }
        }
    }
};
struct EpiRwkv {
    bf16* P; float* hw; float* ha;
    DI void operator()(int m, int n, const float* v, int, int) const {
        if (n < 4096) { store8bf(P + (size_t)m * 4096 + n, v); return; }
        const int c = n - 4096;
        if (c < 64) { float4* o = (float4*)(hw + (size_t)m * 64 + c); o[0] = make_float4(tanhf(v[0]), tanhf(v[1]), tanhf(v[2]), tanhf(v[3])); o[1] = make_float4(tanhf(v[4]), tanhf(v[5]), tanhf(v[6]), tanhf(v[7])); }
        else if (c >= 128 && c < 192) { float4* o = (float4*)(ha + (size_t)m * 64 + (c - 128)); o[0] = make_float4(v[0], v[1], v[2], v[3]); o[1] = make_float4(v[4], v[5], v[6], v[7]); }
    }
    DI void finish(int, int, int, int, int) const {}
    DI void finish_wide(int, int, int, int, int) const {}
};

namespace at {
constexpr int OFF_BIAS = 49152;
constexpr int OFF_X = 61952;
constexpr int OFF_IMP = 49152;
constexpr float L2E = 1.4426950408889634f;
constexpr float NEG_MASK = -1e30f, M_INIT = -1e20f;
}
enum { AM_SWA = 0, AM_WIN = 1, AM_CMP = 2, AM_SEL = 3 };
DI int vt_perm(int k32) { return ((k32 & 15) >> 2) * 8 + (k32 >> 4) * 4 + (k32 & 3); }
DI float fast_exp2(float x) { return __builtin_amdgcn_exp2f(x); }

DI void build_bias_lut(const float* __restrict__ t5, char* smem, bool swa) {
    float* lut = (float*)(smem + at::OFF_BIAS);
    for (int i = TIDX; i < 16 * 200; i += NTHREADS) {
        const int h = i / 200, e = i % 200; float v = at::NEG_MASK;
        if (e >= 64 && e < 192) v = t5[t5_bucket(e - 64) * 16 + h] * at::L2E;
        else if (e >= 192 && !swa) v = t5[31 * 16 + h] * at::L2E;
        lut[i] = v;
    }
    __syncthreads();
}

template <int NQT> struct AttnStateT { f32x4 o[NQT][4]; f32x4 lacc[NQT]; float m[NQT]; };
#ifndef ANQT_SWA
#define ANQT_SWA 4
#endif
#ifndef ANQT_WIN
#define ANQT_WIN 2
#endif
#ifndef ANQT_SEL
#define ANQT_SEL 4
#endif
DI unsigned long long range_mask(int lo, int hi) { return (hi >= 63 ? ~0ull : ((1ull << (hi + 1)) - 1ull)) & ~((1ull << lo) - 1ull); }

template <int NQT>
DI void attn_load_q(bf16x8 (&qf)[NQT][2], const bf16* __restrict__ Qp, int ldq, size_t mbase, int hbase) {
    const int lane = TIDX & 63, wave = TIDX >> 6, q = lane >> 4, l15 = lane & 15;
#pragma unroll
    for (int qt = 0; qt < NQT; ++qt) {
        const size_t m = mbase + wave * (4 * NQT) + qt * 4 + (l15 >> 2);
#pragma unroll
        for (int ks = 0; ks < 2; ++ks) qf[qt][ks] = *(const bf16x8*)(Qp + m * ldq + (hbase + (l15 & 3)) * 64 + ks * 32 + q * 8);
    }
}

enum { SK_FAR = 0, SK_NEAR = 1, SK_EDGE = 2, SK_CMP = 3 };
template <int KIND>
DI float attn_fix(f32x4 (&s)[4], int dbase, float cadd, const float* __restrict__ bl, float mx) {
#pragma unroll
    for (int kt = 0; kt < 4; ++kt)
#pragma unroll
        for (int r = 0; r < 4; ++r) {
            float v = s[kt][r]; const int dist = dbase - (kt * 16 + r);
            if (KIND == SK_NEAR) { int idx = dist + 64; idx = idx < 0 ? 0 : (idx > 192 ? 192 : idx); v += bl[idx] + cadd; }
            else if (KIND == SK_EDGE) v = dist < 512 ? v + cadd : at::NEG_MASK;
            else if (KIND == SK_CMP) v = dist >= 0 ? v : at::NEG_MASK;
            if (KIND != SK_FAR) s[kt][r] = v;
            mx = fmaxf(mx, v);
        }
    return mx;
}
template <int MODE, int NQT>
DI void attn_blocks(AttnStateT<NQT>& st, const bf16x8 (&qf)[NQT][2], const bf16* __restrict__ Kp, size_t krs, const bf16* __restrict__ Vp, size_t vrs,
                    int t0, unsigned long long todo, int hbase, const unsigned long long (&sel)[NQT], char* smem) {
    const int tid = TIDX, lane = tid & 63, wave = __builtin_amdgcn_readfirstlane(tid >> 6), q = lane >> 4, l15 = lane & 15;
    const int tq0 = t0 + wave * (4 * NQT) + (l15 >> 2);
    const float* bl = (const float*)(smem + at::OFF_BIAS) + (hbase + (l15 & 3)) * 200;
    const float bfar = (MODE != AM_CMP) ? bl[192] : 0.f;
    const int srow = tid >> 3, scs = (tid & 7) ^ (srow & 7);
    const int fo = l15 * 128 + ((q ^ (l15 & 7)) << 4);
#define ATT_DMA(kb_, slot_) { _Pragma("unroll") for (int i = 0; i < 2; ++i) { const int row = srow + 32 * i; char* dst = smem + (slot_) * 16384 + (8 * wave + 32 * i) * 128; \
        GLDS16(Kp + (size_t)((kb_) * 64 + row) * krs + scs * 8, dst); GLDS16(Vp + (size_t)row * vrs + (kb_) * 64 + scs * 8, dst + 8192); } }
#define ATT_BARRIER() { asm volatile("s_waitcnt lgkmcnt(0)" ::: "memory"); __builtin_amdgcn_s_barrier(); asm volatile("" ::: "memory"); }
    if (todo == 0ull) return;
    int kb = __builtin_ctzll(todo); todo &= todo - 1ull;
    int kb1 = -1; if (todo) { kb1 = __builtin_ctzll(todo); todo &= todo - 1ull; }
    ATT_DMA(kb, 0);
    if (kb1 >= 0) { ATT_DMA(kb1, 1); asm volatile("s_waitcnt vmcnt(4)" ::: "memory"); } else { asm volatile("s_waitcnt vmcnt(0)" ::: "memory"); }
    ATT_BARRIER();
    int slot = 0;
    for (;;) {
        char* buf = smem + slot * 16384;
        int kb2 = -1; if (todo) { kb2 = __builtin_ctzll(todo); todo &= todo - 1ull; }
        if (kb2 >= 0) { const int s2 = slot >= 1 ? slot - 1 : 2; ATT_DMA(kb2, s2); }
        f32x4 s[NQT][4];
#pragma unroll
        for (int qt = 0; qt < NQT; ++qt)
#pragma unroll
            for (int kt = 0; kt < 4; ++kt) s[qt][kt] = (f32x4){0.f, 0.f, 0.f, 0.f};
#pragma unroll
        for (int kt = 0; kt < 4; ++kt)
#pragma unroll
            for (int ks = 0; ks < 2; ++ks) {
                const bf16x8 kf = *(const bf16x8*)(buf + ((fo + kt * 2048) ^ (ks << 6)));
#pragma unroll
                for (int qt = 0; qt < NQT; ++qt) s[qt][kt] = __builtin_amdgcn_mfma_f32_16x16x32_bf16(kf, qf[qt][ks], s[qt][kt], 0, 0, 0);
            }
        const int mind = (t0 + wave * (4 * NQT)) - (kb * 64 + 63), maxd = (t0 + wave * (4 * NQT) + 4 * NQT - 1) - kb * 64;
        float mx[NQT], cofs[NQT];
#pragma unroll
        for (int qt = 0; qt < NQT; ++qt) cofs[qt] = 0.f;
        if (MODE == AM_CMP) {
#pragma unroll
            for (int qt = 0; qt < NQT; ++qt) { const int nlim = (tq0 + 4 * qt - 31) >> 4; mx[qt] = attn_fix<SK_CMP>(s[qt], nlim - (kb * 64 + 4 * q), 0.f, bl, at::NEG_MASK); }
        } else {
            float cadd[NQT];
#pragma unroll
            for (int qt = 0; qt < NQT; ++qt) cadd[qt] = (MODE == AM_SEL && !((sel[qt] >> kb) & 1ull)) ? at::NEG_MASK : 0.f;
            if (MODE == AM_SWA || mind < 113) {
#pragma unroll
                for (int qt = 0; qt < NQT; ++qt) mx[qt] = attn_fix<SK_NEAR>(s[qt], tq0 + 4 * qt - (kb * 64 + 4 * q), cadd[qt], bl, at::NEG_MASK);
            } else if (MODE == AM_WIN && maxd >= 512) {
#pragma unroll
                for (int qt = 0; qt < NQT; ++qt) mx[qt] = attn_fix<SK_EDGE>(s[qt], tq0 + 4 * qt - (kb * 64 + 4 * q), bfar, bl, at::NEG_MASK);
            } else {
#pragma unroll
                for (int qt = 0; qt < NQT; ++qt) { cofs[qt] = bfar + cadd[qt]; mx[qt] = attn_fix<SK_FAR>(s[qt], 0, 0.f, bl, at::NEG_MASK) + cofs[qt]; }
            }
        }
        float msub[NQT]; bool grow = false;
#pragma unroll
        for (int qt = 0; qt < NQT; ++qt) {
            float m2 = mx[qt];
            m2 = fmaxf(m2, __shfl_xor(m2, 16)); m2 = fmaxf(m2, __shfl_xor(m2, 32));
            const bool g = m2 > st.m[qt] + 4.0f; grow |= g;
            mx[qt] = g ? m2 : st.m[qt];
            msub[qt] = mx[qt] - cofs[qt];
        }
        if (__any(grow)) {
#pragma unroll
            for (int qt = 0; qt < NQT; ++qt) {
                const float alpha = fast_exp2(st.m[qt] - mx[qt]);
#pragma unroll
                for (int dt = 0; dt < 4; ++dt) st.o[qt][dt] *= alpha;
                st.lacc[qt] *= alpha;
            }
        }
#pragma unroll
        for (int qt = 0; qt < NQT; ++qt) st.m[qt] = mx[qt];
#pragma unroll
        for (int qt = 0; qt < NQT; ++qt)
#pragma unroll
            for (int kt = 0; kt < 4; ++kt)
#pragma unroll
                for (int r = 0; r < 4; ++r) s[qt][kt][r] = fast_exp2(s[qt][kt][r] - msub[qt]);
        const bf16x8 ones = {(short)0x3F80, (short)0x3F80, (short)0x3F80, (short)0x3F80, (short)0x3F80, (short)0x3F80, (short)0x3F80, (short)0x3F80};
#pragma unroll
        for (int kp = 0; kp < 2; ++kp) {
            bf16x8 pf[NQT];
#pragma unroll
            for (int qt = 0; qt < NQT; ++qt) {
                const u32x4 w = {pack2bf(s[qt][2 * kp][0], s[qt][2 * kp][1]), pack2bf(s[qt][2 * kp][2], s[qt][2 * kp][3]),
                                 pack2bf(s[qt][2 * kp + 1][0], s[qt][2 * kp + 1][1]), pack2bf(s[qt][2 * kp + 1][2], s[qt][2 * kp + 1][3])};
                pf[qt] = __builtin_bit_cast(bf16x8, w);
            }
#pragma unroll
            for (int qt = 0; qt < NQT; ++qt) st.lacc[qt] = __builtin_amdgcn_mfma_f32_16x16x32_bf16(ones, pf[qt], st.lacc[qt], 0, 0, 0);
#pragma unroll
            for (int dt = 0; dt < 4; ++dt) {
                const bf16x8 vf = *(const bf16x8*)(buf + 8192 + ((fo + dt * 2048) ^ (kp << 6)));
#pragma unroll
                for (int qt = 0; qt < NQT; ++qt) st.o[qt][dt] = __builtin_amdgcn_mfma_f32_16x16x32_bf16(vf, pf[qt], st.o[qt][dt], 0, 0, 0);
            }
        }
        if (kb1 < 0) break;
        if (kb2 >= 0) { asm volatile("s_waitcnt vmcnt(4)" ::: "memory"); } else { asm volatile("s_waitcnt vmcnt(0)" ::: "memory"); }
        ATT_BARRIER();
        kb = kb1; kb1 = kb2; slot = slot == 2 ? 0 : slot + 1;
    }
    ATT_BARRIER();
#undef ATT_DMA
}
template <int NQT>
DI void attn_init(AttnStateT<NQT>& st, float m0, float l0) {
#pragma unroll
    for (int qt = 0; qt < NQT; ++qt) { st.m[qt] = m0; st.lacc[qt] = (f32x4){l0, l0, l0, l0};
#pragma unroll
        for (int dt = 0; dt < 4; ++dt) st.o[qt][dt] = (f32x4){0.f, 0.f, 0.f, 0.f}; }
}
DI float attn_linv(const f32x4& lacc) { const float l = lacc[0]; return l > 0.f ? 1.0f / l : 0.f; }

template <int TT>
DI void attn_item_decode(int item, int& b, int& g, int& t0) {
    constexpr int tiles = T / TT;
    const int Gd = (int)gridDim.x;
    int pair, tile;
    if ((Gd % tiles) == 0 && tiles * B * G % Gd == 0) {
        const int bid = item % Gd, rr = item / Gd, tau = bid % tiles;
        pair = bid / tiles + (Gd / tiles) * rr; tile = (rr & 1) ? tiles - 1 - tau : tau;
    } else { tile = item % tiles; pair = item / tiles; }
    t0 = tile * TT; g = pair % G; b = pair / G;
}
DI void swa_item(const bf16* __restrict__ P0, const bf16* __restrict__ VT, const float* __restrict__ sinks, bf16* __restrict__ AO, int item, char* smem) {
    constexpr int LDP = 2304;
    constexpr int NQT = ANQT_SWA;
    int b, g, t0; attn_item_decode<16 * NQT>(item, b, g, t0);
    const int lane = TIDX & 63, wave = TIDX >> 6, q = lane >> 4, l15 = lane & 15;
    const size_t mbase = (size_t)b * T + t0; const int hbase = g * 4, h = hbase + (l15 & 3);
    bf16x8 qf[NQT][2]; attn_load_q<NQT>(qf, P0, LDP, mbase, hbase);
    AttnStateT<NQT> st; attn_init<NQT>(st, sinks[h] * at::L2E, 1.0f);
    const int lo = t0 - 127 < 0 ? 0 : (t0 - 127) >> 6, hi = (t0 + 16 * NQT - 1) >> 6;
    const unsigned long long nosel[NQT] = {};
    attn_blocks<AM_SWA, NQT>(st, qf, P0 + (size_t)b * T * LDP + 1024 + g * 64, LDP, VT + (size_t)(b * G + g) * 64 * T, T, t0, range_mask(lo, hi), hbase, nosel, smem);
#pragma unroll
    for (int qt = 0; qt < NQT; ++qt) {
        const float li = attn_linv(st.lacc[qt]); const size_t m = mbase + wave * (4 * NQT) + qt * 4 + (l15 >> 2);
#pragma unroll
        for (int dt = 0; dt < 4; ++dt) {
            const int d0 = dt * 16 + 4 * q; const u32x2 zz = *(const u32x2*)(P0 + m * LDP + 1280 + h * 64 + d0);
            const float z0 = bflo(zz[0]), z1 = bfhi(zz[0]), z2 = bflo(zz[1]), z3 = bfhi(zz[1]);
            const f32x4 o = st.o[qt][dt];
            *(u32x2*)(AO + m * D + h * 64 + d0) = (u32x2){pack2bf(o[0] * li * siluf_(z0), o[1] * li * siluf_(z1)), pack2bf(o[2] * li * siluf_(z2), o[3] * li * siluf_(z3))};
        }
    }
}

struct EpiL0 {
    bf16* P0; bf16* VT; const float* parts; mutable float rsc[4];
    DI void operator()(int m, int n, const float* v, int mt, int gi) const {
        if (gi == 0) rsc[mt] = rstd_from_parts(parts, m);
        float s = rsc[mt]; if (n < 1024) s *= 0.125f * at::L2E; float w[8];
#pragma unroll
        for (int j = 0; j < 8; ++j) w[j] = v[j] * s;
        if (n < 1280) store8bf(P0 + (size_t)m * 2304 + n, w);
        else if (n >= 1536) store8bf(P0 + (size_t)m * 2304 + n - 256, w);
        else {
            const int g = (n - 1280) >> 6, d = (n - 1280) & 63, b = m / T, t = m % T; const int pos = (t & ~31) + vt_perm(t & 31);
            bf16* dst = VT + ((size_t)(b * G + g) * 64 + d) * T + pos;
#pragma unroll
            for (int j = 0; j < 8; ++j) dst[(size_t)j * T] = f2bf(w[j]);
        }
    }
    DI void finish(int, int, int, int, int) const {}
    DI void finish_wide(int, int, int, int, int) const {}
};

constexpr int LDP2 = 3200;
struct EpiL2 {
    bf16* P2; bf16* VTs; bf16* VTw; const float* parts; mutable float rsc[4];
    DI void operator()(int m, int n, const float* v, int mt, int gi) const {
        if (gi == 0) rsc[mt] = rstd_from_parts(parts, m);
        if (n >= C_COLS) return;
        float s = rsc[mt]; if (n < 1024) s *= 0.125f * at::L2E; float w[8];
#pragma unroll
        for (int j = 0; j < 8; ++j) w[j] = v[j] * s;
        const bool isvs = n >= 1792 && n < 2048, isvw = n >= 2304 && n < 2560;
        if (isvs || isvw) {
            const int c = n - (isvs ? 1792 : 2304); const int g = c >> 6, d = c & 63, b = m / T, t = m % T; const int pos = (t & ~31) + vt_perm(t & 31);
            bf16* dst = (isvs ? VTs : VTw) + ((size_t)(b * G + g) * 64 + d) * T + pos;
#pragma unroll
            for (int j = 0; j < 8; ++j) dst[(size_t)j * T] = f2bf(w[j]);
        } else {
            const int c = n < 1792 ? n : (n < 2304 ? n - 256 : n - 512);
            store8bf(P2 + (size_t)m * LDP2 + c, w);
        }
    }
    DI void finish(int, int, int, int, int) const {}
    DI void finish_wide(int, int, int, int, int) const {}
};

struct ALoadCmp {
    const bf16* P2; int col;
    static constexpr bool DMA = true;
    DI const bf16* src(int row, int k) const {
        int n = row & 255; const int bg = row >> 8, b = bg >> 2, g = bg & 3; const int l = k >> 6, d = k & 63; n = n < NCMP ? n : NCMP - 1;
        return P2 + (size_t)(b * T + 16 * n + l) * LDP2 + col + g * 64 + d;
    }
    struct Raw { u32x4 v; };
    DI Raw load(int row, int k) const {
        const int n = row & 255, bg = row >> 8, b = bg >> 2, g = bg & 3; const int l = k >> 6, d = k & 63; Raw r;
        if (n < NCMP) r.v = *(const u32x4*)(P2 + (size_t)(b * T + 16 * n + l) * LDP2 + col + g * 64 + d); else r.v = (u32x4){0u, 0u, 0u, 0u};
        return r;
    }
    DI u32x4 finish(const Raw& r, int, int) const { return r.v; }
};
struct EpiCmpH {
    char* smem; const float* bias8;
    DI void operator()(int m, int n, const float* v, int, int) const {
        const int row = m & 127; float w[8];
#pragma unroll
        for (int j = 0; j < 8; ++j) { float bsum = 0.f;
#pragma unroll
            for (int i = 0; i < 8; ++i) bsum += bias8[i * 128 + n + j];
            w[j] = siluf_(v[j] + bsum); }
        const int kk = n >> 6, c = (n & 63) >> 3;
        *(u32x4*)(smem + kk * 16384 + row * 128 + ((c ^ (row & 7)) << 4)) = (u32x4){pack2bf(w[0], w[1]), pack2bf(w[2], w[3]), pack2bf(w[4], w[5]), pack2bf(w[6], w[7])};
    }
    DI void finish(int, int, int, int, int) const {}
    DI void finish_wide(int, int, int, int, int) const {}
};
DI void cmp_tile(const bf16* __restrict__ P2, const bf16* __restrict__ w1t, const float* __restrict__ bias8, const bf16* __restrict__ w2t, int which, int rt,
                 bf16* __restrict__ KCb, bf16* __restrict__ VCT, char* smem) {
    gemm_tile(ALoadCmp{P2, which ? 1280 : 1024}, w1t, 2048, rt * 128, 0, EpiCmpH{smem, bias8}, smem);
    const int tid = TIDX, lane = tid & 63, wave = tid >> 6, q = lane >> 4, l15 = lane & 15;
#pragma unroll
    for (int i = 0; i < 4; ++i) {
        const int id = i * 256 + tid; const int row = id >> 4, c16 = id & 15, kk = c16 >> 3, c = c16 & 7;
        *(u32x4*)(smem + 32768 + kk * 8192 + row * 128 + ((c ^ (row & 7)) << 4)) = *(const u32x4*)(w2t + (size_t)row * 128 + c16 * 8);
    }
    __syncthreads();
    f32x4 acc[2][4];
#pragma unroll
    for (int i = 0; i < 2; ++i)
#pragma unroll
        for (int j = 0; j < 4; ++j) acc[i][j] = (f32x4){0.f, 0.f, 0.f, 0.f};
    const int fo = l15 * 128 + ((q ^ (l15 & 7)) << 4);
#pragma unroll
    for (int kk = 0; kk < 2; ++kk)
#pragma unroll
        for (int ks = 0; ks < 2; ++ks) {
            bf16x8 hf[2], wf[4];
#pragma unroll
            for (int i = 0; i < 2; ++i) hf[i] = *(const bf16x8*)(smem + kk * 16384 + (((wave * 32 + i * 16) * 128 + fo) ^ (ks << 6)));
#pragma unroll
            for (int j = 0; j < 4; ++j) wf[j] = *(const bf16x8*)(smem + 32768 + kk * 8192 + ((j * 2048 + fo) ^ (ks << 6)));
#pragma unroll
            for (int i = 0; i < 2; ++i)
#pragma unroll
                for (int j = 0; j < 4; ++j) acc[i][j] = __builtin_amdgcn_mfma_f32_16x16x32_bf16(wf[j], hf[i], acc[i][j], 0, 0, 0);
        }
#pragma unroll
    for (int i = 0; i < 2; ++i) {
        const int row = rt * 128 + wave * 32 + i * 16 + l15; const int n = row & 255, bg = row >> 8;
#pragma unroll
        for (int j = 0; j < 4; ++j) {
            const int d0 = j * 16 + 4 * q; const f32x4 a = acc[i][j];
            if (which == 0) *(u32x2*)(KCb + (size_t)row * 64 + d0) = (u32x2){pack2bf(a[0], a[1]), pack2bf(a[2], a[3])};
            else {
                const int pos = (n & ~31) + vt_perm(n & 31);
#pragma unroll
                for (int r = 0; r < 4; ++r) VCT[((size_t)bg * 64 + d0 + r) * 256 + pos] = f2bf(a[r]);
            }
        }
    }
    __syncthreads();
}

DI void win_item(const bf16* __restrict__ P2, const bf16* __restrict__ VTw, bf16* __restrict__ OW, int item, char* smem) {
    constexpr int NQT = ANQT_WIN;
    int b, g, t0; attn_item_decode<16 * NQT>(item, b, g, t0);
    const int lane = TIDX & 63, wave = TIDX >> 6, q = lane >> 4, l15 = lane & 15;
    const size_t mbase = (size_t)b * T + t0; const int hbase = g * 4, h = hbase + (l15 & 3);
    bf16x8 qf[NQT][2]; attn_load_q<NQT>(qf, P2, LDP2, mbase, hbase);
    AttnStateT<NQT> st; attn_init<NQT>(st, at::M_INIT, 0.f);
    const int lo = t0 - 511 < 0 ? 0 : (t0 - 511) >> 6, hi = (t0 + 16 * NQT - 1) >> 6;
    const unsigned long long nosel[NQT] = {};
    attn_blocks<AM_WIN, NQT>(st, qf, P2 + (size_t)b * T * LDP2 + 1792 + g * 64, LDP2, VTw + (size_t)(b * G + g) * 64 * T, T, t0, range_mask(lo, hi), hbase, nosel, smem);
#pragma unroll
    for (int qt = 0; qt < NQT; ++qt) {
        const float li = attn_linv(st.lacc[qt]); const size_t m = mbase + wave * (4 * NQT) + qt * 4 + (l15 >> 2);
#pragma unroll
        for (int dt = 0; dt < 4; ++dt) { const f32x4 o = st.o[qt][dt]; *(u32x2*)(OW + m * D + h * 64 + dt * 16 + 4 * q) = (u32x2){pack2bf(o[0] * li, o[1] * li), pack2bf(o[2] * li, o[3] * li)}; }
    }
}

DI void cmpsel_item(const bf16* __restrict__ P2, const bf16* __restrict__ KCb, const bf16* __restrict__ VCT, bf16* __restrict__ OC, unsigned long long* __restrict__ SELM, int item, char* smem) {
    int b, g, t0; attn_item_decode<32>(item, b, g, t0);
    const int tid = TIDX, lane = tid & 63, wave = tid >> 6, q = lane >> 4, l15 = lane & 15;
    const size_t mbase = (size_t)b * T + t0; const int hbase = g * 4, h = hbase + (l15 & 3);
    float* impL = (float*)(smem + at::OFF_IMP);
    for (int i = tid; i < 32 * 64; i += NTHREADS) impL[i] = 0.f;
    bf16x8 qf[2][2]; attn_load_q<2>(qf, P2, LDP2, mbase, hbase);
    AttnStateT<2> st; attn_init<2>(st, at::M_INIT, 0.f);
    const int nvmax = (t0 + 31 - 31) / 16 + 1;
    const int hi = (nvmax - 1) >> 6;
    const bf16* Kp = KCb + (size_t)(b * G + g) * 256 * 64; const bf16* Vp = VCT + (size_t)(b * G + g) * 64 * 256;
    const unsigned long long nosel[2] = {0ull, 0ull};
    attn_blocks<AM_CMP, 2>(st, qf, Kp, 64, Vp, 256, t0, range_mask(0, hi), hbase, nosel, smem);
    float linv[2];
#pragma unroll
    for (int qt = 0; qt < 2; ++qt) {
        linv[qt] = attn_linv(st.lacc[qt]); const size_t m = mbase + wave * 8 + qt * 4 + (l15 >> 2);
#pragma unroll
        for (int dt = 0; dt < 4; ++dt) { const f32x4 o = st.o[qt][dt]; *(u32x2*)(OC + m * D + h * 64 + dt * 16 + 4 * q) = (u32x2){pack2bf(o[0] * linv[qt], o[1] * linv[qt]), pack2bf(o[2] * linv[qt], o[3] * linv[qt])}; }
    }
    {
        const int srow = tid >> 3, sc = tid & 7; const int st_off = srow * 128 + ((sc ^ (srow & 7)) << 4); const int fo = l15 * 128 + ((q ^ (l15 & 7)) << 4);
        const int tq0 = t0 + wave * 8 + (l15 >> 2);
        for (int kb = 0; kb <= hi; ++kb) {
#pragma unroll
            for (int i = 0; i < 2; ++i) { const int row = srow + 32 * i; *(u32x4*)(smem + st_off + i * 4096) = *(const u32x4*)(Kp + (size_t)(kb * 64 + row) * 64 + sc * 8); }
            __syncthreads();
            f32x4 s[2][4];
#pragma unroll
            for (int qt = 0; qt < 2; ++qt)
#pragma unroll
                for (int kt = 0; kt < 4; ++kt) s[qt][kt] = (f32x4){0.f, 0.f, 0.f, 0.f};
#pragma unroll
            for (int kt = 0; kt < 4; ++kt)
#pragma unroll
                for (int ks = 0; ks < 2; ++ks) {
                    const bf16x8 kf = *(const bf16x8*)(smem + ((fo + kt * 2048) ^ (ks << 6)));
                    s[0][kt] = __builtin_amdgcn_mfma_f32_16x16x32_bf16(kf, qf[0][ks], s[0][kt], 0, 0, 0);
                    s[1][kt] = __builtin_amdgcn_mfma_f32_16x16x32_bf16(kf, qf[1][ks], s[1][kt], 0, 0, 0);
                }
#pragma unroll
            for (int qt = 0; qt < 2; ++qt) {
                const int tq = tq0 + 4 * qt; const int tl = wave * 8 + qt * 4 + (l15 >> 2);
#pragma unroll
                for (int kt = 0; kt < 4; ++kt) {
                    float pr[4];
#pragma unroll
                    for (int r = 0; r < 4; ++r) { const int key = kb * 64 + kt * 16 + 4 * q + r; pr[r] = (16 * key + 31 <= tq) ? fast_exp2(s[qt][kt][r] - st.m[qt]) * linv[qt] : 0.f; }
                    float s4 = (pr[0] + pr[1]) + (pr[2] + pr[3]), s1 = pr[3];
                    s4 += __shfl_xor(s4, 1); s4 += __shfl_xor(s4, 2); s1 += __shfl_xor(s1, 1); s1 += __shfl_xor(s1, 2);
                    const int s0 = kb * 16 + kt * 4 + q;
                    if ((l15 & 3) == 0) { atomicAdd(&impL[tl * 64 + s0], s4); if (s0 + 1 < 64) atomicAdd(&impL[tl * 64 + s0 + 1], s1); }
                }
            }
            __syncthreads();
        }
    }
    {
        const int tl = tid >> 3, sg = tid & 7; const int t = t0 + tl, cur = t >> 6; float* row = impL + tl * 64;
        unsigned hk[8]; unsigned long long mine[8];
#pragma unroll
        for (int j = 0; j < 8; ++j) { const int s = sg * 8 + j; const float v = row[s];
            hk[j] = (s == 0 || s == cur || s == cur - 1) ? 0x7F800000u : (s * 64 > t ? 0u : (v > 0.f ? __float_as_uint(v) + 1u : 1u));
            mine[j] = ((unsigned long long)hk[j] << 32) | (unsigned)(63 - s); }
        __syncthreads();
#pragma unroll
        for (int j = 0; j < 8; ++j) ((unsigned*)row)[sg * 8 + j] = hk[j];
        __syncthreads();
        int rank[8] = {0, 0, 0, 0, 0, 0, 0, 0};
#pragma unroll 4
        for (int s4 = 0; s4 < 16; ++s4) {
            const u32x4 v4 = *(const u32x4*)(row + s4 * 4);
#pragma unroll
            for (int e = 0; e < 4; ++e) { const unsigned long long kv = ((unsigned long long)v4[e] << 32) | (unsigned)(63 - (s4 * 4 + e));
#pragma unroll
                for (int j = 0; j < 8; ++j) rank[j] += kv > mine[j] ? 1 : 0; }
        }
        unsigned long long bits = 0ull;
#pragma unroll
        for (int j = 0; j < 8; ++j) if (rank[j] < KTOP) bits |= 1ull << (sg * 8 + j);
        unsigned lo = (unsigned)bits, hi2 = (unsigned)(bits >> 32);
#pragma unroll
        for (int o = 1; o < 8; o <<= 1) { lo |= __shfl_xor(lo, o); hi2 |= __shfl_xor(hi2, o); }
        if (sg == 0) SELM[(mbase + tl) * 4 + g] = ((unsigned long long)hi2 << 32) | lo;
    }
    __syncthreads();
}

DI void sel_item(const bf16* __restrict__ P2, const bf16* __restrict__ VTs, const unsigned long long* __restrict__ SELM, const bf16* __restrict__ OC, const bf16* __restrict__ OW,
                 bf16* __restrict__ AO, int item, char* smem) {
    constexpr int NQT = ANQT_SEL;
    int b, g, t0; attn_item_decode<16 * NQT>(item, b, g, t0);
    const int tid = TIDX, lane = tid & 63, wave = tid >> 6, q = lane >> 4, l15 = lane & 15;
    const size_t mbase = (size_t)b * T + t0; const int hbase = g * 4, rr = l15 & 3, h = hbase + rr;
    unsigned long long* orw = (unsigned long long*)(smem + at::OFF_X);
    if (tid == 0) *orw = 0ull;
    __syncthreads();
    if (tid < 16 * NQT) atomicOr(orw, SELM[(mbase + tid) * 4 + g]);
    unsigned long long sel[NQT];
#pragma unroll
    for (int qt = 0; qt < NQT; ++qt) sel[qt] = SELM[(mbase + wave * (4 * NQT) + qt * 4 + (l15 >> 2)) * 4 + g];
    bf16x8 qf[NQT][2]; attn_load_q<NQT>(qf, P2, LDP2, mbase, hbase);
    AttnStateT<NQT> st; attn_init<NQT>(st, at::M_INIT, 0.f);
    __syncthreads();
    const unsigned long long todo_v = (*orw) & range_mask(0, (t0 + 16 * NQT - 1) >> 6);
    const unsigned long long todo = ((unsigned long long)(unsigned)__builtin_amdgcn_readfirstlane((int)(todo_v >> 32)) << 32) | (unsigned)__builtin_amdgcn_readfirstlane((int)(unsigned)todo_v);
    attn_blocks<AM_SEL, NQT>(st, qf, P2 + (size_t)b * T * LDP2 + 1536 + g * 64, LDP2, VTs + (size_t)(b * G + g) * 64 * T, T, t0, todo, hbase, sel, smem);
#pragma unroll
    for (int qt = 0; qt < NQT; ++qt) {
        const float li = attn_linv(st.lacc[qt]); const size_t m = mbase + wave * (4 * NQT) + qt * 4 + (l15 >> 2);
        const bf16* gr = P2 + m * LDP2 + 3072;
        const float g0 = sigmoidf_(bf2f(gr[0 * 16 + h])), g1 = sigmoidf_(bf2f(gr[1 * 16 + h])), g2 = sigmoidf_(bf2f(gr[2 * 16 + h]));
#pragma unroll
        for (int dt = 0; dt < 4; ++dt) {
            const int d0 = dt * 16 + 4 * q; const size_t oi = m * D + h * 64 + d0;
            const u32x2 zz = *(const u32x2*)(P2 + m * LDP2 + 2048 + h * 64 + d0), cc = *(const u32x2*)(OC + oi), ww = *(const u32x2*)(OW + oi);
            const f32x4 o = st.o[qt][dt];
            const float r0 = (g0 * bflo(cc[0]) + g1 * o[0] * li + g2 * bflo(ww[0])) * siluf_(bflo(zz[0]));
            const float r1 = (g0 * bfhi(cc[0]) + g1 * o[1] * li + g2 * bfhi(ww[0])) * siluf_(bfhi(zz[0]));
            const float r2 = (g0 * bflo(cc[1]) + g1 * o[2] * li + g2 * bflo(ww[1])) * siluf_(bflo(zz[1]));
            const float r3 = (g0 * bfhi(cc[1]) + g1 * o[3] * li + g2 * bfhi(ww[1])) * siluf_(bfhi(zz[1]));
            *(u32x2*)(AO + oi) = (u32x2){pack2bf(r0, r1), pack2bf(r2, r3)};
        }
    }
    __syncthreads();
}

DI void lru_convert_gates(const float* __restrict__ gaw, const float* __restrict__ gxw, bf16* __restrict__ img) {
    for (int i = blockIdx.x * NTHREADS + TIDX; i < 16 * 160 * 96; i += gridDim.x * NTHREADS) {
        const int k = i % 96, n = (i / 96) % 160, blk = i / (96 * 160);
        float v = 0.f;
        if (k < 80) v = n < 80 ? gaw[((size_t)blk * 80 + k) * 80 + n] : gxw[((size_t)blk * 80 + k) * 80 + (n - 80)];
        img[i] = f2bf(v);
    }
}
DI void lru_gate_item(const bf16* __restrict__ P3, const float* __restrict__ cw, const float* __restrict__ cb, const bf16* __restrict__ gimg, const float* __restrict__ gab, const float* __restrict__ gxb,
                      const float* __restrict__ lam, bf16* __restrict__ LA, bf16* __restrict__ BV, float2* __restrict__ SUM, int item, char* smem) {
    const int rt = item >> 4, nb = item & 15; const int tid = TIDX, lane = tid & 63, wave = tid >> 6, q = lane >> 4, l15 = lane & 15;
    const size_t m0 = (size_t)rt * 128;
    for (int id = tid; id < 128 * 12; id += NTHREADS) {
        const int row = id / 12, c12 = id % 12; u32x4 outv = (u32x4){0u, 0u, 0u, 0u};
        if (c12 < 10) {
            const size_t m = m0 + row; const int t = (int)(m % T); const int ch = nb * 80 + c12 * 8;
            float acc[8];
            { const float4 b0 = *(const float4*)(cb + ch), b1 = *(const float4*)(cb + ch + 4); acc[0] = b0.x; acc[1] = b0.y; acc[2] = b0.z; acc[3] = b0.w; acc[4] = b1.x; acc[5] = b1.y; acc[6] = b1.z; acc[7] = b1.w; }
#pragma unroll
            for (int w = 0; w < 4; ++w) {
                if (t - 3 + w >= 0) {
                    const u32x4 uv = *(const u32x4*)(P3 + (m - 3 + w) * 2560 + ch);
                    const float4 w0 = *(const float4*)(cw + w * LW + ch), w1 = *(const float4*)(cw + w * LW + ch + 4);
                    acc[0] += w0.x * bflo(uv[0]); acc[1] += w0.y * bfhi(uv[0]); acc[2] += w0.z * bflo(uv[1]); acc[3] += w0.w * bfhi(uv[1]);
                    acc[4] += w1.x * bflo(uv[2]); acc[5] += w1.y * bfhi(uv[2]); acc[6] += w1.z * bflo(uv[3]); acc[7] += w1.w * bfhi(uv[3]);
                }
            }
            outv = (u32x4){pack2bf(acc[0], acc[1]), pack2bf(acc[2], acc[3]), pack2bf(acc[4], acc[5]), pack2bf(acc[6], acc[7])};
        }
        const int ks = c12 >> 2, c = c12 & 3;
        *(u32x4*)(smem + ks * 8192 + row * 64 + ((c ^ ((row >> 2) & 3)) << 4)) = outv;
    }
    for (int id = tid; id < 160 * 12; id += NTHREADS) {
        const int row = id / 12, c12 = id % 12; const int ks = c12 >> 2, c = c12 & 3;
        *(u32x4*)(smem + 24576 + ks * 10240 + row * 64 + ((c ^ ((row >> 2) & 3)) << 4)) = *(const u32x4*)(gimg + ((size_t)nb * 160 + row) * 96 + c12 * 8);
    }
    __syncthreads();
    f32x4 acc[2][10];
#pragma unroll
    for (int i = 0; i < 2; ++i)
#pragma unroll
        for (int j = 0; j < 10; ++j) acc[i][j] = (f32x4){0.f, 0.f, 0.f, 0.f};
    const int fo = l15 * 64 + ((q ^ ((l15 >> 2) & 3)) << 4);
#pragma unroll
    for (int ks = 0; ks < 3; ++ks) {
        bf16x8 uf[2];
#pragma unroll
        for (int i = 0; i < 2; ++i) uf[i] = *(const bf16x8*)(smem + ks * 8192 + (wave * 32 + i * 16) * 64 + fo);
#pragma unroll
        for (int j = 0; j < 10; ++j) {
            const bf16x8 wf = *(const bf16x8*)(smem + 24576 + ks * 10240 + j * 1024 + fo);
            acc[0][j] = __builtin_amdgcn_mfma_f32_16x16x32_bf16(wf, uf[0], acc[0][j], 0, 0, 0);
            acc[1][j] = __builtin_amdgcn_mfma_f32_16x16x32_bf16(wf, uf[1], acc[1][j], 0, 0, 0);
        }
    }
    __syncthreads();
#pragma unroll
    for (int i = 0; i < 2; ++i) {
        const int row = wave * 32 + i * 16 + l15; const size_t m = m0 + row;
#pragma unroll
        for (int ct = 0; ct < 5; ++ct) {
            const int kcol = ct * 16 + 4 * q; const int ch = nb * 80 + kcol;
            const u32x2 uu = *(const u32x2*)(smem + (kcol >> 5) * 8192 + row * 64 + ((((kcol & 31) >> 3) ^ ((row >> 2) & 3)) << 4) + (kcol & 7) * 2);
            const float uc[4] = {bflo(uu[0]), bfhi(uu[0]), bflo(uu[1]), bfhi(uu[1])};
            const float4 ba = *(const float4*)(gab + ch), bx = *(const float4*)(gxb + ch), lm = *(const float4*)(lam + ch);
            const float bav[4] = {ba.x, ba.y, ba.z, ba.w}, bxv[4] = {bx.x, bx.y, bx.z, bx.w}, lmv[4] = {lm.x, lm.y, lm.z, lm.w};
            float la[4], bv[4];
#pragma unroll
            for (int r = 0; r < 4; ++r) {
                const float rg = __builtin_amdgcn_rcpf(1.0f + __expf(-(acc[i][ct][r] + bav[r]))), ig = __builtin_amdgcn_rcpf(1.0f + __expf(-(acc[i][ct + 5][r] + bxv[r])));
                la[r] = rg * lmv[r];
                const float om = 1.0f - __expf(2.0f * la[r]);
                bv[r] = __builtin_amdgcn_sqrtf(om > 0.f ? om : 0.f) * (ig * uc[r]);
            }
            const u32x2 lav = {pack2bf(la[0], la[1]), pack2bf(la[2], la[3])}, bvv = {pack2bf(bv[0], bv[1]), pack2bf(bv[2], bv[3])};
            *(u32x2*)(LA + m * LW + ch) = lav; *(u32x2*)(BV + m * LW + ch) = bvv;
            *(u32x2*)(smem + 24576 + (row * 80 + kcol) * 2) = lav; *(u32x2*)(smem + 24576 + 20480 + (row * 80 + kcol) * 2) = bvv;
        }
    }
    __syncthreads();
    if (tid < 160) {
        const int cidx = tid / 80, c = tid % 80; const bf16* li = (const bf16*)(smem + 24576) + (cidx * 64) * 80 + c; const bf16* bi = li + 10240;
        float sla = 0.f, h = 0.f;
#pragma unroll 8
        for (int t = 0; t < 64; ++t) { const float la = bf2f(li[t * 80]), bvv = bf2f(bi[t * 80]); h = __expf(la) * h + bvv; sla += la; }
        const size_t mc = m0 + cidx * 64; const int bb = (int)(mc / T), jj = (int)(mc % T) / 64;
        SUM[((size_t)bb * (T / 64) + jj) * LW + nb * 80 + c] = make_float2(__expf(sla), h);
    }
    __syncthreads();
}
DI void lru_scan2_item(const bf16* __restrict__ LA, const bf16* __restrict__ BV, const float2* __restrict__ SUM, const bf16* __restrict__ P3, bf16* __restrict__ AO, int item) {
    const int cg = item % 5, j = (item / 5) % (T / 64), b = item / (5 * (T / 64)); const int c = cg * 256 + TIDX;
    float h = 0.f;
    for (int jj = 0; jj < j; ++jj) { const float2 s = SUM[((size_t)b * (T / 64) + jj) * LW + c]; h = s.x * h + s.y; }
    const size_t m0 = (size_t)b * T + j * 64;
#pragma unroll 8
    for (int t = 0; t < 64; ++t) {
        const float la = bf2f(LA[(m0 + t) * LW + c]); const float bv = bf2f(BV[(m0 + t) * LW + c]); const float z = bf2f(P3[(m0 + t) * 2560 + LW + c]);
        h = __expf(la) * h + bv; AO[(m0 + t) * LW + c] = f2bf(h * siluf_(z));
    }
}

struct ALoadF32 {
    const float* A;
    static constexpr bool DMA = false;
    DI const bf16* src(int, int) const { return nullptr; }
    struct Raw { float4 a, b; };
    DI Raw load(int m, int k) const { Raw r; r.a = *(const float4*)(A + (size_t)m * 64 + k); r.b = *(const float4*)(A + (size_t)m * 64 + k + 4); return r; }
    DI u32x4 finish(const Raw& r, int, int) const { return (u32x4){pack2bf(r.a.x, r.a.y), pack2bf(r.a.z, r.a.w), pack2bf(r.b.x, r.b.y), pack2bf(r.b.z, r.b.w)}; }
};
struct EpiLora {
    const float* w0; const float* a0; bf16* WL; bf16* AV;
    DI void operator()(int m, int n, const float* v, int, int) const {
        float w[8];
        if (n < 1024) {
#pragma unroll
            for (int j = 0; j < 8; ++j) w[j] = -0.60653065971f * __builtin_amdgcn_rcpf(1.0f + __expf(-(w0[n + j] + v[j])));
            store8bf(WL + (size_t)m * D + n, w);
        } else {
#pragma unroll
            for (int j = 0; j < 8; ++j) w[j] = __builtin_amdgcn_rcpf(1.0f + __expf(-(a0[n - 1024 + j] + v[j])));
            store8bf(AV + (size_t)m * D + n - 1024, w);
        }
    }
    DI void finish(int, int, int, int, int) const {}
    DI void finish_wide(int, int, int, int, int) const {}
};
DI float dpp_sum16(float x) {
    x += __builtin_bit_cast(float, __builtin_amdgcn_update_dpp(0, __builtin_bit_cast(int, x), 0xB1, 0xf, 0xf, false));
    x += __builtin_bit_cast(float, __builtin_amdgcn_update_dpp(0, __builtin_bit_cast(int, x), 0x4E, 0xf, 0xf, false));
    x += __builtin_bit_cast(float, __builtin_amdgcn_update_dpp(0, __builtin_bit_cast(int, x), 0x141, 0xf, 0xf, false));
    x += __builtin_bit_cast(float, __builtin_amdgcn_update_dpp(0, __builtin_bit_cast(int, x), 0x140, 0xf, 0xf, false));
    return x;
}
constexpr int RW_NCH = T / 16;
DI void rwkv_prep_item(bf16* __restrict__ P, bf16* __restrict__ WL, bf16* __restrict__ AV, const float* __restrict__ k_k, const float* __restrict__ k_a, const float* __restrict__ r_k,
                       float* __restrict__ G15, bf16* __restrict__ M2g, bf16* __restrict__ M3g, float* __restrict__ BON, int item, char* smem) {
    const int c = item % RW_NCH, h = (item / RW_NCH) & 15, b = item / (RW_NCH * 16);
    const int tid = TIDX, t = tid >> 4, jq = tid & 15, j0 = jq * 4;
    const size_t m0 = (size_t)b * T + c * 16, m = m0 + t; const size_t ch = (size_t)(b * 16 + h) * RW_NCH + c;
    float* sA = (float*)smem; float* sR = sA + 16 * 68; float* sB = sR + 16 * 68; float* sK = sB + 16 * 68; float* sW = sK + 16 * 68; float* sWl = sW + 16 * 68;
    float* mAab = sWl + 16 * 64; float* mAak = mAab + 16 * 17; float* mArb = mAak + 16 * 17; float* mArk = mArb + 16 * 17; float* mTin = mArk + 16 * 17; float* mM2 = mTin + 16 * 17;
    const u32x2 r2 = *(const u32x2*)(P + m * 4096 + h * 64 + j0), k2 = *(const u32x2*)(P + m * 4096 + 1024 + h * 64 + j0), a2 = *(const u32x2*)(AV + m * D + h * 64 + j0), w2 = *(const u32x2*)(WL + m * D + h * 64 + j0);
    const float rr[4] = {bflo(r2[0]), bfhi(r2[0]), bflo(r2[1]), bfhi(r2[1])}, kr[4] = {bflo(k2[0]), bfhi(k2[0]), bflo(k2[1]), bfhi(k2[1])},
                av[4] = {bflo(a2[0]), bfhi(a2[0]), bflo(a2[1]), bfhi(a2[1])}, wl[4] = {bflo(w2[0]), bfhi(w2[0]), bflo(w2[1]), bfhi(w2[1])};
    const float4 kk4 = *(const float4*)(k_k + h * 64 + j0), ka4 = *(const float4*)(k_a + h * 64 + j0), rk4 = *(const float4*)(r_k + h * 64 + j0);
    const float kkc[4] = {kk4.x, kk4.y, kk4.z, kk4.w}, kac[4] = {ka4.x, ka4.y, ka4.z, ka4.w}, rkc[4] = {rk4.x, rk4.y, rk4.z, rk4.w};
    float kkv[4], n2 = 0.f;
#pragma unroll
    for (int e = 0; e < 4; ++e) { kkv[e] = kr[e] * kkc[e]; n2 += kkv[e] * kkv[e]; }
    n2 = dpp_sum16(n2);
    float nr = sqrtf(n2); nr = nr > 1e-12f ? nr : 1e-12f; const float inr = 1.0f / nr;
    float aa[4], bb[4], kp[4], bon = 0.f;
#pragma unroll
    for (int e = 0; e < 4; ++e) { const float kn = kkv[e] * inr; aa[e] = -kn; bb[e] = kn * av[e]; kp[e] = kr[e] * (1.0f + (av[e] - 1.0f) * kac[e]); bon += rr[e] * kp[e] * rkc[e]; }
    bon = dpp_sum16(bon);
    if (jq == 0) BON[m * 16 + h] = bon;
    *(float4*)(sWl + t * 64 + j0) = make_float4(wl[0], wl[1], wl[2], wl[3]);
    __syncthreads();
    float clx[4] = {0.f, 0.f, 0.f, 0.f};
#pragma unroll
    for (int s = 0; s < 15; ++s) { if (s < t) { const float4 w = *(const float4*)(sWl + s * 64 + j0); clx[0] += w.x; clx[1] += w.y; clx[2] += w.z; clx[3] += w.w; } }
    float bt[4];
    {
        float va[4], vr[4], vk[4], gc[4];
#pragma unroll
        for (int e = 0; e < 4; ++e) { const float cl = clx[e] + wl[e]; const float gp = __expf(clx[e]), gi = __expf(-cl); gc[e] = __expf(cl); va[e] = aa[e] * gp; vr[e] = rr[e] * gc[e]; bt[e] = bb[e] * gi; vk[e] = kp[e] * gi; }
        *(float4*)(sA + t * 68 + j0) = make_float4(va[0], va[1], va[2], va[3]); *(float4*)(sR + t * 68 + j0) = make_float4(vr[0], vr[1], vr[2], vr[3]);
        *(float4*)(sB + t * 68 + j0) = make_float4(bt[0], bt[1], bt[2], bt[3]); *(float4*)(sK + t * 68 + j0) = make_float4(vk[0], vk[1], vk[2], vk[3]);
        {
            char* img = (char*)(mM2 + 16 * 17) + t * 128 + (((j0 >> 3) ^ (t & 7)) << 4) + (j0 & 4) * 2;
            *(u32x2*)(img) = (u32x2){pack2bf(va[0], va[1]), pack2bf(va[2], va[3])}; *(u32x2*)(img + 2048) = (u32x2){pack2bf(vr[0], vr[1]), pack2bf(vr[2], vr[3])};
            *(u32x2*)(img + 4096) = (u32x2){pack2bf(bt[0], bt[1]), pack2bf(bt[2], bt[3])}; *(u32x2*)(img + 6144) = (u32x2){pack2bf(vk[0], vk[1]), pack2bf(vk[2], vk[3])};
        }
        if (t == 15) *(float4*)(G15 + ch * 64 + j0) = make_float4(gc[0], gc[1], gc[2], gc[3]);
#pragma unroll
        for (int e = 0; e < 4; ++e) {   }
#pragma unroll
        for (int e = 0; e < 4; ++e) clx[e] = vk[e];
    }
    __syncthreads();
    {
        const int wv = __builtin_amdgcn_readfirstlane(tid >> 6), lane = tid & 63, q = lane >> 4, l15 = lane & 15;
        const char* xb_ = (const char*)(mM2 + 16 * 17) + (wv >> 1) * 2048;
        const char* yb_ = (const char*)(mM2 + 16 * 17) + 4096 + (wv & 1) * 2048;
        f32x4 acc = {0.f, 0.f, 0.f, 0.f};
#pragma unroll
        for (int ks = 0; ks < 2; ++ks) {
            const int off = l15 * 128 + (((ks * 4 + q) ^ (l15 & 7)) << 4);
            const bf16x8 xf = *(const bf16x8*)(xb_ + off), yf = *(const bf16x8*)(yb_ + off);
            acc = __builtin_amdgcn_mfma_f32_16x16x32_bf16(xf, yf, acc, 0, 0, 0);
        }
        float* dst = wv == 0 ? mAab : (wv == 1 ? mAak : (wv == 2 ? mArb : mArk));
        const bool strict = wv < 2;
#pragma unroll
        for (int r = 0; r < 4; ++r) { const int tt = 4 * q + r, ss = l15; dst[tt * 17 + ss] = (strict ? ss < tt : ss <= tt) ? acc[r] : 0.f; }
    }
    __syncthreads();
    if (tid < 16) {
        float col[16];
#pragma unroll
        for (int i = 0; i < 16; ++i) {
            float acc = (i == tid) ? 1.0f : 0.f;
#pragma unroll
            for (int jj = 0; jj < i; ++jj) acc += mAab[i * 17 + jj] * col[jj];
            col[i] = acc; mTin[i * 17 + tid] = acc;
        }
    }
    __syncthreads();
    float wv[4] = {0.f, 0.f, 0.f, 0.f}, m2 = 0.f;
#pragma unroll
    for (int s = 0; s < 16; ++s) { const float ti = mTin[t * 17 + s]; const float4 a4 = *(const float4*)(sA + s * 68 + j0); wv[0] += ti * a4.x; wv[1] += ti * a4.y; wv[2] += ti * a4.z; wv[3] += ti * a4.w; m2 += ti * mAak[s * 17 + jq]; }
    *(float4*)(sW + t * 68 + j0) = make_float4(wv[0], wv[1], wv[2], wv[3]); mM2[t * 17 + jq] = m2;
    __syncthreads();
    float rh[4]; { const float4 r4 = *(const float4*)(sR + t * 68 + j0); rh[0] = r4.x; rh[1] = r4.y; rh[2] = r4.z; rh[3] = r4.w; }
    float m3 = mArk[t * 17 + jq];
#pragma unroll
    for (int s = 0; s < 16; ++s) { const float ar = mArb[t * 17 + s]; const float4 w4 = *(const float4*)(sW + s * 68 + j0); rh[0] += ar * w4.x; rh[1] += ar * w4.y; rh[2] += ar * w4.z; rh[3] += ar * w4.w; m3 += ar * mM2[s * 17 + jq]; }
    *(u32x2*)(WL + m * D + h * 64 + j0) = (u32x2){pack2bf(wv[0], wv[1]), pack2bf(wv[2], wv[3])};
    *(u32x2*)(P + m * 4096 + h * 64 + j0) = (u32x2){pack2bf(rh[0], rh[1]), pack2bf(rh[2], rh[3])};
#pragma unroll
    for (int e = 0; e < 4; ++e) { AV[(m0 + jq) * D + h * 64 + e * 16 + t] = f2bf(bt[e]); P[(m0 + jq) * 4096 + 1024 + h * 64 + e * 16 + t] = f2bf(clx[e]); }
    M2g[ch * 256 + t * 16 + jq] = f2bf(m2); M3g[ch * 256 + t * 16 + jq] = f2bf(m3);
    __syncthreads();
}

#define MFMA32(a, b, c) __builtin_amdgcn_mfma_f32_16x16x32_bf16(__builtin_bit_cast(bf16x8, a), __builtin_bit_cast(bf16x8, b), c, 0, 0, 0)
DI void rwkv_chunk_scan(const bf16* __restrict__ P, const bf16* __restrict__ WL, const bf16* __restrict__ AV, const float* __restrict__ G15, const bf16* __restrict__ M2g, const bf16* __restrict__ M3g,
                        bf16* __restrict__ YS, int bh, char* smem) {
    constexpr int SLOT = 12288, YOFF = 49152;
    const int tid = TIDX, lane = tid & 63, vs = __builtin_amdgcn_readfirstlane(tid >> 6), q = lane >> 4, l15 = lane & 15; const int b = bh >> 4, h = bh & 15;
    const size_t mb = (size_t)b * T; const size_t ch0 = (size_t)(b * 16 + h) * RW_NCH;
    const char *s0, *s1, *s2; size_t d0, d1, d2;
    if (tid < 128) { const int c8 = tid >> 4, t = tid & 15; s0 = (const char*)(WL + (mb + t) * D + h * 64 + c8 * 8); d0 = (size_t)16 * D * 2; }
    else { const int pp = tid - 128, c8 = pp >> 4, t = pp & 15; s0 = (const char*)(P + (mb + t) * 4096 + h * 64 + c8 * 8); d0 = (size_t)16 * 4096 * 2; }
    if (tid < 128) { const int r = tid >> 3, c8 = tid & 7; s1 = (const char*)(P + (mb + r) * 4096 + 1024 + h * 64 + c8 * 8); d1 = (size_t)16 * 4096 * 2; }
    else { const int pp = tid - 128, r = pp >> 3, c8 = pp & 7; s1 = (const char*)(AV + (mb + r) * D + h * 64 + c8 * 8); d1 = (size_t)16 * D * 2; }
    if (tid < 128) { const int r = tid >> 3, c8 = tid & 7; s2 = (const char*)(P + (mb + r) * 4096 + 2048 + h * 64 + c8 * 8); d2 = (size_t)16 * 4096 * 2; }
    else if (tid < 160) { s2 = (const char*)(M2g + ch0 * 256 + (tid - 128) * 8); d2 = 512; }
    else if (tid < 192) { s2 = (const char*)(M3g + ch0 * 256 + (tid - 160) * 8); d2 = 512; }
    else { const int pp = tid < 208 ? tid - 192 : 0; s2 = (const char*)(G15 + ch0 * 64 + pp * 4); d2 = 256; }
    const int dma_off = vs * 1024;
#define RW_DMA(c_) { char* dst = smem + ((c_) & 3) * SLOT + dma_off; GLDS16(s0 + (size_t)(c_) * d0, dst); GLDS16(s1 + (size_t)(c_) * d1, dst + 4096); GLDS16(s2 + (size_t)(c_) * d2, dst + 8192); }
#define RW_BARRIER() { asm volatile("s_waitcnt lgkmcnt(0)" ::: "memory"); __builtin_amdgcn_s_barrier(); asm volatile("" ::: "memory"); }
    f32x4 H0 = {0.f, 0.f, 0.f, 0.f}, H1 = H0, H2 = H0, H3 = H0;
    const int oW = (((q >> 1)) * 16 + l15) * 16 + (q & 1) * 8;
    const int oK = 4096 + ((l15 >> 2) * 8 + (l15 & 3) * 2 + (q >> 1)) * 16 + (q & 1) * 8;
    const int oM = 10240 + l15 * 32 + q * 8;
    const int oV = 8192 + (4 * q) * 128 + (vs * 16 + l15) * 2;
    const int oG = 11264 + (4 * q) * 4;
    const int oY = YOFF + ((4 * q) * 64 + vs * 16 + l15) * 2;
    RW_DMA(0); RW_DMA(1); RW_DMA(2);
    asm volatile("s_waitcnt vmcnt(6)" ::: "memory");
    RW_BARRIER();
    for (int c = 0; c < RW_NCH; ++c) {
        if (c + 3 < RW_NCH) RW_DMA(c + 3);
        const char* sl = smem + (c & 3) * SLOT;
        {
            const f32x4 z4 = {0.f, 0.f, 0.f, 0.f};
            const u32x4 Hb0 = {pack2bf(H0[0], H0[1]), pack2bf(H0[2], H0[3]), pack2bf(H1[0], H1[1]), pack2bf(H1[2], H1[3])};
            const u32x4 Hb1 = {pack2bf(H2[0], H2[1]), pack2bf(H2[2], H2[3]), pack2bf(H3[0], H3[1]), pack2bf(H3[2], H3[3])};
            const unsigned v0 = *(const bf16*)(sl + oV), v1 = *(const bf16*)(sl + oV + 128), v2 = *(const bf16*)(sl + oV + 256), v3 = *(const bf16*)(sl + oV + 384);
            const unsigned v01 = v0 | (v1 << 16), v23 = v2 | (v3 << 16);
            const u32x4 Vlo = {v01, v23, 0u, 0u};
            const u32x2 m2 = *(const u32x2*)(sl + oM), m3 = *(const u32x2*)(sl + oM + 512);
            const u32x2 w0 = *(const u32x2*)(sl + oW), w1 = *(const u32x2*)(sl + oW + 512), w2 = *(const u32x2*)(sl + oW + 1024), w3 = *(const u32x2*)(sl + oW + 1536);
            const u32x2 r0 = *(const u32x2*)(sl + 2048 + oW), r1 = *(const u32x2*)(sl + 2048 + oW + 512), r2 = *(const u32x2*)(sl + 2048 + oW + 1024), r3 = *(const u32x2*)(sl + 2048 + oW + 1536);
            f32x4 U = MFMA32(((u32x4){m2[0], m2[1], 0u, 0u}), Vlo, z4);
            U = MFMA32(((u32x4){w0[0], w0[1], w1[0], w1[1]}), Hb0, U); U = MFMA32(((u32x4){w2[0], w2[1], w3[0], w3[1]}), Hb1, U);
            f32x4 Y = MFMA32(((u32x4){m3[0], m3[1], 0u, 0u}), Vlo, z4);
            Y = MFMA32(((u32x4){r0[0], r0[1], r1[0], r1[1]}), Hb0, Y); Y = MFMA32(((u32x4){r2[0], r2[1], r3[0], r3[1]}), Hb1, Y);
            const u32x4 VU = {v01, v23, pack2bf(U[0], U[1]), pack2bf(U[2], U[3])};
            const u32x2 k0 = *(const u32x2*)(sl + oK), k1 = *(const u32x2*)(sl + oK + 512), k2 = *(const u32x2*)(sl + oK + 1024), k3 = *(const u32x2*)(sl + oK + 1536);
            const u32x2 b0 = *(const u32x2*)(sl + 2048 + oK), b1 = *(const u32x2*)(sl + 2048 + oK + 512), b2 = *(const u32x2*)(sl + 2048 + oK + 1024), b3 = *(const u32x2*)(sl + 2048 + oK + 1536);
            const f32x4 g0 = *(const f32x4*)(sl + oG), g1 = *(const f32x4*)(sl + oG + 64), g2 = *(const f32x4*)(sl + oG + 128), g3 = *(const f32x4*)(sl + oG + 192);
            const f32x4 a0 = MFMA32(((u32x4){k0[0], k0[1], b0[0], b0[1]}), VU, H0), a1 = MFMA32(((u32x4){k1[0], k1[1], b1[0], b1[1]}), VU, H1);
            const f32x4 a2 = MFMA32(((u32x4){k2[0], k2[1], b2[0], b2[1]}), VU, H2), a3 = MFMA32(((u32x4){k3[0], k3[1], b3[0], b3[1]}), VU, H3);
            H0 = a0 * g0; H1 = a1 * g1; H2 = a2 * g2; H3 = a3 * g3;
            char* yb = smem + oY + (c & 7) * 2048;
#pragma unroll
            for (int r = 0; r < 4; ++r) *(bf16*)(yb + r * 128) = f2bf(Y[r]);
        }
        const bool flush = (c & 7) == 7;
        if (flush) {
            RW_BARRIER();
            u32x4 yv[4];
#pragma unroll
            for (int k = 0; k < 4; ++k) yv[k] = *(const u32x4*)(smem + YOFF + (tid + 256 * k) * 16);
#pragma unroll
            for (int k = 0; k < 4; ++k) { const int pc = tid + 256 * k, rr = pc >> 3, c8 = pc & 7; *(u32x4*)(YS + (mb + (size_t)(c - 7) * 16 + rr) * D + h * 64 + c8 * 8) = yv[k]; }
            asm volatile("s_waitcnt vmcnt(0)" ::: "memory");
        } else if (c + 3 < RW_NCH) { asm volatile("s_waitcnt vmcnt(6)" ::: "memory"); }
        else if (c + 2 < RW_NCH) { asm volatile("s_waitcnt vmcnt(3)" ::: "memory"); }
        else { asm volatile("s_waitcnt vmcnt(0)" ::: "memory"); }
        RW_BARRIER();
    }
#undef RW_DMA
#undef RW_BARRIER
}
DI void rwkv_gn_rows2(const bf16* __restrict__ P, const float* __restrict__ BON, const float* __restrict__ lnw, const float* __restrict__ lnb, bf16* __restrict__ YS) {
    const int tid = TIDX, lane = tid & 63, wave = tid >> 6; const int c = wave * 256 + lane * 4;
    const float4 lw = *(const float4*)(lnw + c), lb = *(const float4*)(lnb + c);
    for (size_t m = blockIdx.x; m < (size_t)M; m += gridDim.x) {
        const u32x2 yy = *(const u32x2*)(YS + m * D + c), vv = *(const u32x2*)(P + m * 4096 + 2048 + c), zz = *(const u32x2*)(P + m * 4096 + 3072 + c);
        const float bs = BON[m * 16 + (c >> 6)];
        const float y[4] = {bflo(yy[0]), bfhi(yy[0]), bflo(yy[1]), bfhi(yy[1])}, v[4] = {bflo(vv[0]), bfhi(vv[0]), bflo(vv[1]), bfhi(vv[1])}, z[4] = {bflo(zz[0]), bfhi(zz[0]), bflo(zz[1]), bfhi(zz[1])};
        const float lwv[4] = {lw.x, lw.y, lw.z, lw.w}, lbv[4] = {lb.x, lb.y, lb.z, lb.w};
        const float mean = dpp_sum16((y[0] + y[1]) + (y[2] + y[3])) * (1.0f / 64.0f);
        float var = 0.f;
#pragma unroll
        for (int i = 0; i < 4; ++i) { const float d = y[i] - mean; var += d * d; }
        var = dpp_sum16(var) * (1.0f / 64.0f);
        const float rstd = 1.0f / sqrtf(var + 64e-5f);
        float o[4];
#pragma unroll
        for (int i = 0; i < 4; ++i) o[i] = ((y[i] - mean) * rstd * lwv[i] + lbv[i] + bs * v[i]) * siluf_(z[i]);
        *(u32x2*)(YS + m * D + c) = (u32x2){pack2bf(o[0], o[1]), pack2bf(o[2], o[3])};
    }
}

struct FastBufs { char* ws; };

DI void rows_xb_parts(const float* __restrict__ x, bf16* xb, float* parts) {
    const int lane = TIDX & 63, wave = TIDX >> 6;
    for (int m = blockIdx.x * 4 + wave; m < M; m += gridDim.x * 4) {
        const float* xr = x + (size_t)m * D; float s = 0.f;
#pragma unroll
        for (int i = 0; i < 2; ++i) {
            const int k = (i * 64 + lane) * 8; const float4 a = *(const float4*)(xr + k), b = *(const float4*)(xr + k + 4);
            const float w[8] = {a.x, a.y, a.z, a.w, b.x, b.y, b.z, b.w};
#pragma unroll
            for (int j = 0; j < 8; ++j) s += w[j] * w[j];
            store8bf(xb + (size_t)m * D + k, w);
        }
#pragma unroll
        for (int o = 32; o >= 1; o >>= 1) s += __shfl_xor(s, o);
        if (lane < 16) parts[(size_t)m * 16 + lane] = lane == 0 ? s : 0.f;
    }
}
DI void rows_xn(const float* __restrict__ x, const float* parts, const float* __restrict__ g, bf16* xn) {
    const int lane = TIDX & 63, wave = TIDX >> 6;
    for (int m = blockIdx.x * 4 + wave; m < M; m += gridDim.x * 4) {
        const float rs = rstd_from_parts(parts, m); const float* xr = x + (size_t)m * D;
#pragma unroll
        for (int i = 0; i < 2; ++i) {
            const int k = (i * 64 + lane) * 8; const float4 a = *(const float4*)(xr + k), b = *(const float4*)(xr + k + 4);
            const float4 ga = *(const float4*)(g + k), gb = *(const float4*)(g + k + 4);
            const float w[8] = {a.x * rs * ga.x, a.y * rs * ga.y, a.z * rs * ga.z, a.w * rs * ga.w, b.x * rs * gb.x, b.y * rs * gb.y, b.z * rs * gb.z, b.w * rs * gb.w};
            store8bf(xn + (size_t)m * D + k, w);
        }
    }
}
DI void rows_final(float* x, const float* parts, const float* __restrict__ g) {
    const int lane = TIDX & 63, wave = TIDX >> 6;
    for (int m = blockIdx.x * 4 + wave; m < M; m += gridDim.x * 4) {
        const float rs = rstd_from_parts(parts, m); float* xr = x + (size_t)m * D;
#pragma unroll
        for (int i = 0; i < 4; ++i) {
            const int k = (i * 64 + lane) * 4; float4 a = *(float4*)(xr + k); const float4 ga = *(const float4*)(g + k);
            a.x *= rs * ga.x; a.y *= rs * ga.y; a.z *= rs * ga.z; a.w *= rs * ga.w; *(float4*)(xr + k) = a;
        }
    }
}
enum { PH_PREP0 = 0, PH_IN0, PH_ATTN0, PH_OUT0, PH_PREP1, PH_IN1, PH_LORA1, PH_CPREP1, PH_SCAN1, PH_GN1, PH_OUT1, PH_PREP2, PH_IN2, PH_B2, PH_C2, PH_D2, PH_OUT2, PH_PREP3, PH_IN3, PH_GATE3, PH_SCANA3, PH_SCANB3, PH_OUT3, PH_FINAL };

namespace wbo {
constexpr size_t IN = 0;
constexpr size_t OUT = (size_t)4352 * 1024;
constexpr size_t EXTRA = OUT + (size_t)1280 * 1024;
}

template <int PH>
DI void run_phase(const Params& p, char* smem) {
    char* ws = p.ws;
    float* parts = (float*)(ws + fw::PARTS);
    constexpr int LAYER = PH <= PH_OUT0 ? 0 : PH <= PH_OUT1 ? 1 : PH <= PH_OUT2 ? 2 : 3;
    constexpr size_t WBOFF = LAYER == 0 ? 200 * fw::MB : LAYER == 1 ? 238 * fw::MB : LAYER == 2 ? 240 * fw::MB : 1 * fw::MB;
    bf16* WB = (bf16*)(ws + WBOFF);
    bf16* XB = (bf16*)(ws + ((PH == PH_PREP0 || PH == PH_IN0) ? 130 * fw::MB : 174 * fw::MB));
    bf16* P = (bf16*)(ws + wsl::P);
    float* X = p.out;
    float* smf = (float*)smem;
    if (PH == PH_PREP0) {
        rows_xb_parts(p.x, XB, parts);
        int tb = 0;
        convert_seg(p.a_w_in, A_COLS, 0, A_COLS, 1024, WB + wbo::IN, p.norm_g + 0 * D, smf, tb);
        convert_seg(p.a_w_out, 1024, 0, 1024, 1024, WB + wbo::OUT, nullptr, smf, tb);
    } else if (PH == PH_IN0) {
        gemm_sched(8, 4, [&](bool big, int mt, int nt) {
            if (big) gemm_tile2(ALoadPlain{XB, D}, WB + wbo::IN, 1024, mt * 128, nt * 256, EpiL0{P, (bf16*)(ws + 86 * fw::MB), parts}, smem);
            else gemm_tile(ALoadPlain{XB, D}, WB + wbo::IN, 1024, mt * 128, 2048 + nt * 128, EpiL0{P, (bf16*)(ws + 86 * fw::MB), parts}, smem);
        });
    } else if (PH == PH_ATTN0) {
        build_bias_lut(p.t5, smem, true);
        for (int it = blockIdx.x; it < B * G * (T / (16 * ANQT_SWA)); it += gridDim.x) swa_item(P, (const bf16*)(ws + 86 * fw::MB), p.a_sinks, (bf16*)(ws + wsl::L0_AO), it, smem);
    } else if (PH == PH_OUT0) {
        gemm_sched(4, 0, [&](bool, int mt, int nt) { gemm_tile2(ALoadPlain{(const bf16*)(ws + wsl::L0_AO), D}, WB + wbo::OUT, 1024, mt * 128, nt * 256, EpiResid{p.x, X, nullptr, parts}, smem); });
    } else if (PH == PH_PREP1) {
        rows_xn(X, parts, p.norm_g + 1 * D, (bf16*)(ws + wsl::L1_XN));
        int tb = 0;
        convert_seg(p.b_w_in, 4096, 0, 4096, 1024, WB + wbo::IN, nullptr, smf, tb);
        convert_seg(p.b_w1, 64, 0, 64, 1024, WB + wbo::IN + (size_t)4096 * 1024, nullptr, smf, tb);
        convert_seg(p.b_a1, 64, 0, 64, 1024, WB + wbo::IN + (size_t)(4096 + 128) * 1024, nullptr, smf, tb);
        convert_seg(p.b_w_out, 1024, 0, 1024, 1024, WB + wbo::OUT, nullptr, smf, tb);
        convert_seg(p.b_w2, 1024, 0, 1024, 64, WB + wbo::EXTRA, nullptr, smf, tb);
        convert_seg(p.b_a2, 1024, 0, 1024, 64, WB + wbo::EXTRA + (size_t)1024 * 64, nullptr, smf, tb);
        for (size_t i = (size_t)blockIdx.x * 256 + TIDX; i < (size_t)64 * 1024 / 8; i += (size_t)gridDim.x * 256) {
            ((u32x4*)(WB + wbo::IN + (size_t)(4096 + 64) * 1024))[i] = (u32x4){0u, 0u, 0u, 0u};
            ((u32x4*)(WB + wbo::IN + (size_t)(4096 + 192) * 1024))[i] = (u32x4){0u, 0u, 0u, 0u};
        }
    } else if (PH == PH_IN1) {
        const bf16* XN = (const bf16*)(ws + wsl::L1_XN);
        EpiRwkv epi{P, (float*)(ws + wsl::LHW), (float*)(ws + wsl::LHA)};
        gemm_sched(16, 2, [&](bool big, int mt, int nt) {
            if (big) gemm_tile2(ALoadLerp{XN, p.b_mu + (nt >> 2) * D}, WB + wbo::IN, 1024, mt * 128, nt * 256, epi, smem);
            else gemm_tile(ALoadLerp{XN, p.b_mu + (4 + nt) * D}, WB + wbo::IN, 1024, mt * 128, 4096 + nt * 128, epi, smem);
        });
    } else if (PH == PH_LORA1) {
        const int ntile = (M / 128) * 16;
        EpiLora epi{p.b_w0, p.b_a0, (bf16*)(ws + wsl::L1_WL), (bf16*)(ws + wsl::L1_AV)};
        (void)ntile;
        gemm_sched(8, 0, [&](bool, int mt, int nt) { gemm_tile2(ALoadF32{(const float*)(ws + (nt < 4 ? wsl::LHW : wsl::LHA))}, WB + wbo::EXTRA, 64, mt * 128, nt * 256, epi, smem); });
    } else if (PH == PH_CPREP1) {
        for (int it = blockIdx.x; it < B * 16 * RW_NCH; it += gridDim.x)
            rwkv_prep_item(P, (bf16*)(ws + wsl::L1_WL), (bf16*)(ws + wsl::L1_AV), p.b_k_k, p.b_k_a, p.b_r_k, (float*)(ws + 9 * fw::MB), (bf16*)(ws + 1 * fw::MB), WB, (float*)(ws + 254 * fw::MB), it, smem);
    } else if (PH == PH_SCAN1) {
        const int bid = blockIdx.x;
        if ((bid & 31) < 8 && (bid >> 5) < 8) {
            const int it = (bid >> 5) * 8 + (bid & 31);
            rwkv_chunk_scan(P, (const bf16*)(ws + wsl::L1_WL), (const bf16*)(ws + wsl::L1_AV), (const float*)(ws + 9 * fw::MB), (const bf16*)(ws + 1 * fw::MB), WB, (bf16*)(ws + wsl::L1_XN), it, smem);
        }
    } else if (PH == PH_GN1) {
        rwkv_gn_rows2(P, (const float*)(ws + 254 * fw::MB), p.b_lnx_w, p.b_lnx_b, (bf16*)(ws + wsl::L1_XN));
    } else if (PH == PH_OUT1) {
        gemm_sched(4, 0, [&](bool, int mt, int nt) { gemm_tile2(ALoadPlain{(const bf16*)(ws + wsl::L1_XN), D}, WB + wbo::OUT, 1024, mt * 128, nt * 256, EpiResid{X, X, XB, parts}, smem); });
    } else if (PH == PH_PREP2) {
        int tb = 0;
        const float* g2 = p.norm_g + 2 * D;
        convert_seg(p.c_w_in, C_COLS, 0, 2560, 1024, WB + wbo::IN, g2, smf, tb);
        convert_seg(p.c_w_in, C_COLS, 2608, 1024, 1024, WB + wbo::IN + (size_t)2560 * 1024, g2, smf, tb);
        convert_seg(p.c_w_in, C_COLS, 2560, 64, 1024, WB + wbo::IN + (size_t)3584 * 1024, g2, smf, tb);
        convert_seg(p.c_w_out, 1024, 0, 1024, 1024, WB + wbo::OUT, nullptr, smf, tb);
        convert_seg(p.c_k_w1, 128, 0, 128, 2048, WB + wbo::EXTRA, nullptr, smf, tb);
        convert_seg(p.c_v_w1, 128, 0, 128, 2048, WB + wbo::EXTRA + (size_t)128 * 2048, nullptr, smf, tb);
        convert_seg(p.c_k_w2, 64, 0, 64, 128, WB + wbo::EXTRA + (size_t)256 * 2048, nullptr, smf, tb);
        convert_seg(p.c_v_w2, 64, 0, 64, 128, WB + wbo::EXTRA + (size_t)256 * 2048 + 64 * 128, nullptr, smf, tb);
        if (blockIdx.x < 16) {
            const int which = blockIdx.x >> 3, i = blockIdx.x & 7; const float* pos = which ? p.c_pos_v : p.c_pos_k; const float* w1 = which ? p.c_v_w1 : p.c_k_w1;
            float* b8 = (float*)(ws + 12 * fw::MB);
            if (TIDX < 128) { float a = 0.f; for (int k = i * 256; k < i * 256 + 256; ++k) a += pos[k] * w1[(size_t)k * 128 + TIDX]; b8[(which * 8 + i) * 128 + TIDX] = a; }
        }
    } else if (PH == PH_IN2) {
        gemm_sched(14, 1, [&](bool big, int mt, int nt) {
            if (big) gemm_tile2(ALoadPlain{XB, D}, WB + wbo::IN, 1024, mt * 128, nt * 256, EpiL2{P, (bf16*)(ws + 114 * fw::MB), (bf16*)(ws + 122 * fw::MB), parts}, smem);
            else gemm_tile(ALoadPlain{XB, D}, WB + wbo::IN, 1024, mt * 128, 3584 + nt * 128, EpiL2{P, (bf16*)(ws + 114 * fw::MB), (bf16*)(ws + 122 * fw::MB), parts}, smem);
        });
    } else if (PH == PH_B2) {
        for (int it = blockIdx.x; it < 64; it += gridDim.x) { const int which = it >> 5, rt = it & 31;
            cmp_tile(P, WB + wbo::EXTRA + (size_t)which * 128 * 2048, (const float*)(ws + 12 * fw::MB) + which * 8 * 128, WB + wbo::EXTRA + (size_t)256 * 2048 + which * 64 * 128, which, rt,
                     (bf16*)(ws + 5 * fw::MB), (bf16*)(ws + 6 * fw::MB), smem); }
        build_bias_lut(p.t5, smem, false);
        const int nwin = B * G * (T / (16 * ANQT_WIN));
        const bool split = gridDim.x == 512 && nwin == 2048;
        const int bid = blockIdx.x, nb = bid - 64, cnt = bid < 64 ? 2 : (nb < 128 ? 5 : 4);
        for (int k = 0;; ++k) {
            int item;
            if (split) { if (k >= cnt) break; item = bid < 64 ? k * 512 + 448 + bid : (k < 4 ? k * 512 + nb : (2 + (nb >> 6)) * 512 + 448 + (nb & 63)); }
            else { const int it = (bid < 64 ? bid + (int)gridDim.x : bid) + k * (int)gridDim.x; if (it >= 64 + nwin) break; item = it - 64; }
            win_item(P, (const bf16*)(ws + 122 * fw::MB), (bf16*)(ws + 130 * fw::MB), item, smem);
        }
    } else if (PH == PH_C2) {
        for (int it = blockIdx.x; it < B * G * (T / 32); it += gridDim.x)
            cmpsel_item(P, (const bf16*)(ws + 5 * fw::MB), (const bf16*)(ws + 6 * fw::MB), (bf16*)(ws + 162 * fw::MB), (unsigned long long*)(ws + 9 * fw::MB), it, smem);
    } else if (PH == PH_D2) {
        build_bias_lut(p.t5, smem, false);
        for (int it = blockIdx.x; it < B * G * (T / (16 * ANQT_SEL)); it += gridDim.x)
            sel_item(P, (const bf16*)(ws + 114 * fw::MB), (const unsigned long long*)(ws + 9 * fw::MB), (const bf16*)(ws + 162 * fw::MB), (const bf16*)(ws + 130 * fw::MB), (bf16*)(ws + 206 * fw::MB), it, smem);
    } else if (PH == PH_OUT2) {
        gemm_sched(4, 0, [&](bool, int mt, int nt) { gemm_tile2(ALoadPlain{(const bf16*)(ws + 206 * fw::MB), D}, WB + wbo::OUT, 1024, mt * 128, nt * 256, EpiResid{X, X, XB, parts}, smem); });
    } else if (PH == PH_PREP3) {
        int tb = 0;
        convert_seg(p.d_w_in, 2560, 0, 2560, 1024, WB + wbo::IN, p.norm_g + 3 * D, smf, tb);
        convert_seg(p.d_w_out, 1024, 0, 1024, 1280, WB + wbo::OUT, nullptr, smf, tb);
        lru_convert_gates(p.d_ga_w, p.d_gx_w, WB + wbo::EXTRA);
        for (int i = blockIdx.x * NTHREADS + TIDX; i < LW; i += gridDim.x * NTHREADS) ((float*)(ws + 12 * fw::MB + 786432))[i] = -8.0f * softplusf_(-p.d_lambda[i]);
    } else if (PH == PH_IN3) {
        gemm_sched(8, 4, [&](bool big, int mt, int nt) {
            if (big) gemm_tile2(ALoadPlain{XB, D}, WB + wbo::IN, 1024, mt * 128, nt * 256, EpiBf16{P, 2560, parts}, smem);
            else gemm_tile(ALoadPlain{XB, D}, WB + wbo::IN, 1024, mt * 128, 2048 + nt * 128, EpiBf16{P, 2560, parts}, smem);
        });
    } else if (PH == PH_GATE3) {
        for (int it = blockIdx.x; it < (M / 128) * 16; it += gridDim.x)
            lru_gate_item(P, p.d_conv_w, p.d_conv_b, WB + wbo::EXTRA, p.d_ga_b, p.d_gx_b, (const float*)(ws + 12 * fw::MB + 786432), (bf16*)(ws + wsl::L3_LA), (bf16*)(ws + wsl::L3_BV), (float2*)(ws + wsl::L3_UC), it, smem);
    } else if (PH == PH_SCANB3) {
        for (int it = blockIdx.x; it < B * (T / 64) * 5; it += gridDim.x)
            lru_scan2_item((const bf16*)(ws + wsl::L3_LA), (const bf16*)(ws + wsl::L3_BV), (const float2*)(ws + wsl::L3_UC), P, (bf16*)(ws + wsl::L3_AO), it);
    } else if (PH == PH_OUT3) {
        gemm_sched(4, 0, [&](bool, int mt, int nt) { gemm_tile2(ALoadPlain{(const bf16*)(ws + wsl::L3_AO), LW}, WB + wbo::OUT, 1280, mt * 128, nt * 256, EpiResid{X, X, nullptr, parts}, smem); });
    } else if (PH == PH_FINAL) {
        rows_final(X, parts, p.final_g);
    }
}

template <int PH> __global__ void __launch_bounds__(NTHREADS, 2) k_phase(Params p) {
    extern __shared__ __attribute__((aligned(16))) char smem[];
    run_phase<PH>(p, smem);
}
#define LDS_BYTES 73728
#define MEGA_LDS_BYTES (73728 + 64)
template <int PH> static void launch_phase(const Params& p, hipStream_t s) {
    static bool attr = false;
    if (!attr) { hipFuncSetAttribute((const void*)k_phase<PH>, hipFuncAttributeMaxDynamicSharedMemorySize, LDS_BYTES); attr = true; }
    hipLaunchKernelGGL(k_phase<PH>, dim3(512), dim3(NTHREADS), LDS_BYTES, s, p);
}


#define XB_TMO      128
#define XB_XCNT(j)  (256  + 64 * (j))
#define XB_XSUB(j)  (1280 + 64 * (j))
#define XB_XGEN(j)  (2304 + 64 * (j))
#define XB_TOP      3328
#define XB_TOPGEN   3392
#define XCD_BAR_WORDS 3456
#define XB_SPIN_CAP (1u << 22)
#define LAS __attribute__((address_space(3)))
DI unsigned xb_ld(unsigned* p)              { return __hip_atomic_load(p, __ATOMIC_RELAXED, __HIP_MEMORY_SCOPE_AGENT); }
DI unsigned xb_add(unsigned* p, unsigned v) { return __hip_atomic_fetch_add(p, v, __ATOMIC_RELAXED, __HIP_MEMORY_SCOPE_AGENT); }
DI unsigned xb_xcc_id() { return (unsigned)__builtin_amdgcn_s_getreg((3 << 11) | 20) & 0xFu; }
#define XB_SPIN(cond, bar) do { unsigned _sp = 0; while (cond) { if (_sp < 64u) __builtin_amdgcn_s_sleep(2); else __builtin_amdgcn_s_sleep(32); \
    if ((++_sp & 255u) == 0u) { if (xb_ld(&(bar)[XB_TMO])) break; if (_sp > XB_SPIN_CAP) { atomicAdd(&(bar)[XB_TMO], 1u); break; } } } } while (0)
struct XcdBarrier { unsigned* bar; unsigned x; volatile LAS unsigned* st; };
DI XcdBarrier xcd_barrier_post(unsigned* bar, volatile LAS unsigned* st) {
    XcdBarrier b; b.bar = bar; b.x = xb_xcc_id(); b.st = st;
    if (threadIdx.x == 0) (void)xb_add(&bar[XB_XCNT(b.x)], 1u);
    return b;
}
DI void xcd_barrier_complete(unsigned* bar, unsigned x, unsigned& nloc, unsigned& nx) {
    const unsigned G = gridDim.x * gridDim.y * gridDim.z;
    unsigned sum, cnt, mine, sp = 0u;
    for (;;) {
        sum = 0u; cnt = 0u; mine = 0u;
#pragma unroll
        for (unsigned j = 0; j < 16; ++j) { const unsigned c = xb_ld(&bar[XB_XCNT(j)]); sum += c; cnt += (c > 0u) ? 1u : 0u; mine = (j == x) ? c : mine; }
        if (sum == G) break;
        __builtin_amdgcn_s_sleep(1);
        if ((++sp & 255u) == 0u) { if (xb_ld(&bar[XB_TMO])) break; if (sp > XB_SPIN_CAP) { atomicAdd(&bar[XB_TMO], 1u); break; } }
    }
    nloc = mine > 0u ? mine : 1u; nx = cnt > 0u ? cnt : 1u;
}
DI void xcd_barrier(const XcdBarrier& b) {
    asm volatile("s_waitcnt vmcnt(0)" ::: "memory");
    __syncthreads();
    if (threadIdx.x == 0) {
        unsigned* bar = b.bar;
        __builtin_amdgcn_s_waitcnt(0);
        unsigned nloc = b.st[0], nx = b.st[1];
        if (nloc == 0u) { xcd_barrier_complete(bar, b.x, nloc, nx); b.st[0] = nloc; b.st[1] = nx; }
        const unsigned old = xb_add(&bar[XB_XSUB(b.x)], 1u);
        const unsigned gen = old / nloc;
        if (old + 1u == (gen + 1u) * nloc) {
            __builtin_amdgcn_fence(__ATOMIC_RELEASE, "agent");
            asm volatile("s_waitcnt vmcnt(0)" ::: "memory");
            const unsigned og = xb_add(&bar[XB_TOP], 1u);
            const unsigned tg = og / nx;
            if (og + 1u == (tg + 1u) * nx) xb_add(&bar[XB_TOPGEN], 1u);
            else XB_SPIN(xb_ld(&bar[XB_TOPGEN]) == tg, bar);
            __builtin_amdgcn_fence(__ATOMIC_ACQUIRE, "agent");
            xb_add(&bar[XB_XGEN(b.x)], 1u);
            asm volatile("s_waitcnt vmcnt(0)" ::: "memory");
        } else {
            XB_SPIN(xb_ld(&bar[XB_XGEN(b.x)]) == gen, bar);
            __builtin_amdgcn_fence(__ATOMIC_ACQUIRE, "agent");
            asm volatile("s_waitcnt vmcnt(0)" ::: "memory");
        }
    }
    __syncthreads();
}

#define MEGA_PHASES(X) X(PH_IN0) X(PH_ATTN0) X(PH_OUT0) X(PH_PREP1) X(PH_IN1) X(PH_LORA1) X(PH_CPREP1) X(PH_SCAN1) X(PH_GN1) X(PH_OUT1) \
    X(PH_PREP2) X(PH_IN2) X(PH_B2) X(PH_C2) X(PH_D2) X(PH_OUT2) X(PH_PREP3) X(PH_IN3) X(PH_GATE3) X(PH_SCANB3) X(PH_OUT3)
__global__ void __launch_bounds__(NTHREADS, 2) mega_kernel(Params p) {
    extern __shared__ __attribute__((aligned(16))) char smem[];
    cooperative_groups::grid_group grid = cooperative_groups::this_grid();
    volatile LAS unsigned* xst = (volatile LAS unsigned*)(smem + 73728);
    if (threadIdx.x < 4) xst[threadIdx.x] = 0u;
    __syncthreads();
    XcdBarrier xb = xcd_barrier_post((unsigned*)p.ws, xst);
    run_phase<PH_PREP0>(p, smem);
    if (p.ws == nullptr) grid.sync();
    xcd_barrier(xb);
#define MEGA_STEP(ph) run_phase<ph>(p, smem); xcd_barrier(xb);
    MEGA_PHASES(MEGA_STEP)
#undef MEGA_STEP
    run_phase<PH_FINAL>(p, smem);
}
static void launch_mega(const Params& p, hipStream_t s) {
    static int grid_blocks = 0;
    if (!grid_blocks) {
        int dev = 0, cus = 0, per_cu = 0;
        hipGetDevice(&dev);
        hipDeviceGetAttribute(&cus, hipDeviceAttributeMultiprocessorCount, dev);
        hipFuncSetAttribute((const void*)mega_kernel, hipFuncAttributeMaxDynamicSharedMemorySize, MEGA_LDS_BYTES);
        hipOccupancyMaxActiveBlocksPerMultiprocessor(&per_cu, mega_kernel, NTHREADS, MEGA_LDS_BYTES);
        if (per_cu > 2) per_cu = 2;
        if (per_cu < 1) per_cu = 1;
        grid_blocks = cus * per_cu;
    }
    hipMemsetAsync(p.ws, 0, 16384, s);
    Params pp = p; void* args[] = {&pp};
    hipError_t e = hipLaunchCooperativeKernel((const void*)mega_kernel, dim3(grid_blocks), dim3(NTHREADS), args, MEGA_LDS_BYTES, s);
    if (e != hipSuccess) fprintf(stderr, "cooperative launch failed: %s (grid %d)\n", hipGetErrorString(e), grid_blocks);
}
#endif

#ifndef CPU_SHIM
template <class F> __global__ void __launch_bounds__(256) k_run(F f, long n) {
    const long i = (long)blockIdx.x * 256 + threadIdx.x; if (i < n) f(i);
}
template <class F> static void launch(const F& f, long n, hipStream_t s) {
    hipLaunchKernelGGL(k_run<F>, dim3((unsigned)((n + 255) / 256)), dim3(256), 0, s, f, n);
}
#else
template <class F> static void launch(const F& f, long n, hipStream_t) {
#pragma omp parallel for schedule(dynamic, 64)
    for (long i = 0; i < n; ++i) f(i);
}
#endif

#ifdef CPU_SHIM
void cpu_layer_hook(int layer, const float* X, const char* ws);
#define LAYER_HOOK(l) cpu_layer_hook(l, X, ws)
#else
#define LAYER_HOOK(l)
#endif

#define FAST_GEMM 0
#if FAST_GEMM
#define FASTP(ph) launch_phase<ph>(p, s)
#else
#define FASTP(ph)
#endif

static void run_naive(const Params& p, hipStream_t s) {
    char* ws = p.ws;
    float* rs = (float*)(ws + wsl::RS);
    bf16* P = (bf16*)(ws + wsl::P);
    float* X = p.out;
    (void)rs;
    {
        bf16* AO = (bf16*)(ws + wsl::L0_AO);
#if FAST_GEMM
        FASTP(PH_PREP0); FASTP(PH_IN0);
#else
        launch(RstdF{p.x, rs}, M, s);
        launch(GemmInF{p.x, rs, p.norm_g + 0 * D, p.a_w_in, P, A_COLS}, (long)M * (A_COLS / 4), s);
#endif
#if FAST_GEMM
        FASTP(PH_ATTN0); (void)AO;
#else
        launch(SwaF{P, p.t5, p.a_sinks, AO}, (long)M * H, s);
#endif
#if FAST_GEMM
        FASTP(PH_OUT0);
#else
        launch(GemmOutF{AO, p.a_w_out, p.x, X, 1024}, (long)M * (D / 4), s);
#endif
    }
    LAYER_HOOK(0);
    {
        bf16* XN = (bf16*)(ws + wsl::L1_XN); bf16* WL = (bf16*)(ws + wsl::L1_WL); bf16* AV = (bf16*)(ws + wsl::L1_AV);
        float* hw = (float*)(ws + wsl::LHW); float* ha = (float*)(ws + wsl::LHA);
#if FAST_GEMM
        FASTP(PH_PREP1); FASTP(PH_IN1); FASTP(PH_LORA1); FASTP(PH_CPREP1); FASTP(PH_SCAN1); FASTP(PH_GN1); FASTP(PH_OUT1);
        (void)XN; (void)WL; (void)AV; (void)hw; (void)ha;
#else
        launch(RstdF{X, rs}, M, s);
        launch(XnF{X, rs, p.norm_g + 1 * D, XN}, (long)M * D, s);
        launch(GemmRwkvF{XN, p.b_mu, p.b_w_in, P}, (long)M * 1024, s);
        launch(LoraHidF{XN, p.b_mu, p.b_w1, p.b_a1, hw, ha}, (long)M * 128, s);
        launch(LoraOutF{hw, ha, p.b_w0, p.b_w2, p.b_a0, p.b_a2, WL, AV}, (long)M * D, s);
        launch(RwkvScanF{P, WL, AV, p.b_k_k, p.b_k_a, XN}, (long)B * H * 64, s);
        launch(RwkvGnF{P, AV, p.b_k_a, p.b_r_k, p.b_lnx_w, p.b_lnx_b, XN}, (long)M * H, s);
        launch(GemmOutF{XN, p.b_w_out, X, X, 1024}, (long)M * (D / 4), s);
#endif
    }
    LAYER_HOOK(1);
    {
        float* hk = (float*)(ws + wsl::HK); float* hv = (float*)(ws + wsl::HV);
        float* kc = (float*)(ws + wsl::KC); float* vc = (float*)(ws + wsl::VC);
        float* st = (float*)(ws + wsl::ST); int* sel = (int*)(ws + wsl::SEL); float* imp = (float*)(ws + wsl::L2_IMP);
        bf16* AO = (bf16*)(ws + wsl::L2_AO); bf16* OC = (bf16*)(ws + wsl::L2_OC); bf16* OS = (bf16*)(ws + wsl::L2_OS);
#if FAST_GEMM
        FASTP(PH_PREP2); FASTP(PH_IN2); FASTP(PH_B2); FASTP(PH_C2); FASTP(PH_D2); FASTP(PH_OUT2);
        (void)hk; (void)hv; (void)kc; (void)vc; (void)st; (void)sel; (void)imp; (void)AO; (void)OC; (void)OS;
#else
        launch(RstdF{X, rs}, M, s);
        launch(GemmInF{X, rs, p.norm_g + 2 * D, p.c_w_in, P, C_COLS}, (long)M * (C_COLS / 4), s);
        launch(CmpHidF{P, p.c_pos_k, p.c_k_w1, p.c_pos_v, p.c_v_w1, hk, hv}, 2L * B * G * NCMP * 128, s);
        launch(CmpOutF{hk, hv, p.c_k_w2, p.c_v_w2, kc, vc}, 2L * B * G * NCMP * 64, s);
        launch(CmpAttnF{P, kc, vc, st, OC}, (long)M * H, s);
        launch(ImpF{P, kc, st, imp}, (long)M * G * NSEL, s);
        launch(TopkF{imp, sel}, (long)M * G, s);
        launch(SelAttnF{P, p.t5, sel, OS}, (long)M * H, s);
        launch(WinAttnF{P, p.t5, OC, OS, AO}, (long)M * H, s);
        LAYER_HOOK(20);
        launch(GemmOutF{AO, p.c_w_out, X, X, 1024}, (long)M * (D / 4), s);
#endif
    }
    LAYER_HOOK(2);
    {
        bf16* AO = (bf16*)(ws + wsl::L3_AO); bf16* UC = (bf16*)(ws + wsl::L3_UC); bf16* LA = (bf16*)(ws + wsl::L3_LA); bf16* BV = (bf16*)(ws + wsl::L3_BV);
#if FAST_GEMM
        FASTP(PH_PREP3); FASTP(PH_IN3); FASTP(PH_GATE3); FASTP(PH_SCANA3); FASTP(PH_SCANB3); FASTP(PH_OUT3);
        (void)AO; (void)UC; (void)LA; (void)BV;
#else
        launch(RstdF{X, rs}, M, s);
        launch(GemmInF{X, rs, p.norm_g + 3 * D, p.d_w_in, P, 2560}, (long)M * (2560 / 4), s);
        launch(ConvF{P, p.d_conv_w, p.d_conv_b, UC}, (long)M * LW, s);
        launch(LruGateF{UC, p.d_ga_w, p.d_ga_b, p.d_gx_w, p.d_gx_b, p.d_lambda, LA, BV}, (long)M * LW, s);
        launch(LruScanF{P, LA, BV, AO}, (long)B * LW, s);
        launch(GemmOutF{AO, p.d_w_out, X, X, LW}, (long)M * (D / 4), s);
#endif
    }
    LAYER_HOOK(3);
#if FAST_GEMM
    FASTP(PH_FINAL);
#else
    launch(FinalNormF{X, p.final_g}, M, s);
#endif
}

extern "C" void kernel_launch(void* const* d_in, const int* in_sizes, int n_in, void* d_out, int out_size, void* d_ws, size_t ws_size,
                              hipStream_t stream) {
    (void)in_sizes; (void)n_in; (void)out_size; (void)ws_size;
    Params p{};
    const float* const* in = (const float* const*)d_in;
    int k = 0;
    p.x = in[k++]; p.t5 = in[k++]; p.norm_g = in[k++]; p.final_g = in[k++];
    p.a_w_in = in[k++]; p.a_sinks = in[k++]; p.a_w_out = in[k++];
    p.b_mu = in[k++]; p.b_w_in = in[k++]; p.b_w0 = in[k++]; p.b_w1 = in[k++]; p.b_w2 = in[k++]; p.b_a0 = in[k++]; p.b_a1 = in[k++]; p.b_a2 = in[k++];
    p.b_k_k = in[k++]; p.b_k_a = in[k++]; p.b_r_k = in[k++]; p.b_lnx_w = in[k++]; p.b_lnx_b = in[k++]; p.b_w_out = in[k++];
    p.c_w_in = in[k++]; p.c_pos_k = in[k++]; p.c_k_w1 = in[k++]; p.c_k_w2 = in[k++]; p.c_pos_v = in[k++]; p.c_v_w1 = in[k++]; p.c_v_w2 = in[k++]; p.c_w_out = in[k++];
    p.d_w_in = in[k++]; p.d_conv_w = in[k++]; p.d_conv_b = in[k++]; p.d_ga_w = in[k++]; p.d_ga_b = in[k++]; p.d_gx_w = in[k++]; p.d_gx_b = in[k++];
    p.d_lambda = in[k++]; p.d_w_out = in[k++];
    p.out = (float*)d_out; p.ws = (char*)d_ws;
#if !defined(CPU_SHIM) && !defined(MULTI_LAUNCH) && !defined(ALL_NAIVE)
    launch_mega(p, stream);
#else
    run_naive(p, stream);
#endif
}
```

```cpp
#ifndef CPU_SHIM
#include <hip/hip_runtime.h>
#include <hip/hip_cooperative_groups.h>
#include <cstdio>
#define HD __host__ __device__ __forceinline__
#else
#include <cmath>
#include <cstring>
#include <cstdio>
#include <cstdlib>
#include <cstdint>
#define HD inline
typedef void* hipStream_t;
#endif
#include <cstddef>

#ifndef CFG_B
#define CFG_B 4
#endif
#ifndef CFG_T
#define CFG_T 4096
#endif

namespace cfg {
constexpr int B = CFG_B, T = CFG_T, M = B * T, D = 1024;
constexpr int H = 16, G = 4, R = 4, DH = 64;
constexpr int A_COLS = 2560;
constexpr int C_COLS = 3632;
constexpr int NCMP = (T - 32) / 16 + 1;
constexpr int NSEL = T / 64;
constexpr int KTOP = NSEL < 16 ? NSEL : 16;
constexpr int LW = 1280;
}
using namespace cfg;

typedef unsigned short bf16;

HD unsigned f_as_u(float f) {
#ifndef CPU_SHIM
    return __float_as_uint(f);
#else
    unsigned u; memcpy(&u, &f, 4); return u;
#endif
}
HD float u_as_f(unsigned u) {
#ifndef CPU_SHIM
    return __uint_as_float(u);
#else
    float f; memcpy(&f, &u, 4); return f;
#endif
}
HD float bf2f(bf16 v) { return u_as_f(((unsigned)v) << 16); }
HD bf16 f2bf(float f) { unsigned u = f_as_u(f); u += 0x7fffu + ((u >> 16) & 1u); return (bf16)(u >> 16); }
HD float sigmoidf_(float x) { return 1.0f / (1.0f + expf(-x)); }
HD float siluf_(float x) { return x / (1.0f + expf(-x)); }
HD float softplusf_(float x) { return x > 20.f ? x : log1pf(expf(x)); }

HD int t5_bucket(int d) {
    if (d < 16) return d < 0 ? 0 : d;
    if (d >= 113) return 31;
    if (d >= 99) return 30;
    if (d >= 87) return 29;
    if (d >= 77) return 28;
    if (d >= 67) return 27;
    if (d >= 59) return 26;
    if (d >= 52) return 25;
    if (d >= 46) return 24;
    if (d >= 40) return 23;
    if (d >= 35) return 22;
    if (d >= 31) return 21;
    if (d >= 27) return 20;
    if (d >= 24) return 19;
    if (d >= 21) return 18;
    if (d >= 19) return 17;
    return 16;
}

struct Params {
    const float *x, *t5, *norm_g, *final_g;
    const float *a_w_in, *a_sinks, *a_w_out;
    const float *b_mu, *b_w_in, *b_w0, *b_w1, *b_w2, *b_a0, *b_a1, *b_a2, *b_k_k, *b_k_a, *b_r_k, *b_lnx_w, *b_lnx_b, *b_w_out;
    const float *c_w_in, *c_pos_k, *c_k_w1, *c_k_w2, *c_pos_v, *c_v_w1, *c_v_w2, *c_w_out;
    const float *d_w_in, *d_conv_w, *d_conv_b, *d_ga_w, *d_ga_b, *d_gx_w, *d_gx_b, *d_lambda, *d_w_out;
    float* out;
    char* ws;
};

namespace wsl {
constexpr size_t MB = 1024 * 1024;
constexpr size_t RS = 0;
constexpr size_t HK = 1 * MB;
constexpr size_t HV = 3 * MB;
constexpr size_t KC = 5 * MB;
constexpr size_t VC = 6 * MB;
constexpr size_t ST = 7 * MB;
constexpr size_t SEL = 9 * MB;
constexpr size_t LHW = 1 * MB;
constexpr size_t LHA = 5 * MB;
constexpr size_t P = 14 * MB;
constexpr size_t SZ1024 = (size_t)M * 1024 * 2, SZ1280 = (size_t)M * 1280 * 2;
constexpr size_t L0_AO = P + (size_t)M * 2560 * 2;
constexpr size_t L1_XN = P + (size_t)M * 4096 * 2, L1_WL = L1_XN + SZ1024, L1_AV = L1_WL + SZ1024;
constexpr size_t L2_AO = P + (size_t)M * 3632 * 2, L2_OC = L2_AO + SZ1024, L2_OS = L2_OC + SZ1024, L2_IMP = L2_OS + SZ1024;
constexpr size_t L3_AO = P + (size_t)M * 2560 * 2, L3_UC = L3_AO + SZ1280, L3_LA = L3_UC + SZ1280, L3_BV = L3_LA + SZ1280;
constexpr size_t TOTAL = L3_BV + SZ1280;
}

struct RstdF {
    const float* x; float* rs;
    HD void operator()(long m) const {
        const float* r = x + (size_t)m * D; float s = 0.f;
        for (int k = 0; k < D; ++k) s += r[k] * r[k];
        rs[m] = 1.0f / sqrtf(s / D + 1e-6f);
    }
};
struct XnF {
    const float* x; const float* rs; const float* g; bf16* xn;
    HD void operator()(long i) const { long m = i / D; int k = (int)(i % D); xn[i] = f2bf(x[i] * rs[m] * g[k]); }
};
struct GemmInF {
    const float *x, *rs, *g, *W; bf16* P; long long N;
    HD void operator()(long i) const {
        const int n4 = (int)N / 4; const long m = i / n4; const int n = (int)(i % n4) * 4;
        const float* xr = x + (size_t)m * D; const float r = rs[m];
        float a0 = 0, a1 = 0, a2 = 0, a3 = 0;
        for (int k = 0; k < D; ++k) {
            const float a = xr[k] * r * g[k]; const float* w = W + (size_t)k * N + n;
            a0 += a * w[0]; a1 += a * w[1]; a2 += a * w[2]; a3 += a * w[3];
        }
        bf16* p = P + (size_t)m * N + n; p[0] = f2bf(a0); p[1] = f2bf(a1); p[2] = f2bf(a2); p[3] = f2bf(a3);
    }
};
struct GemmOutF {
    const bf16* A; const float* W; const float* xin; float* xout; long long K;
    HD void operator()(long i) const {
        const int n4 = D / 4; const long m = i / n4; const int n = (int)(i % n4) * 4;
        const bf16* ar = A + (size_t)m * K;
        float a0 = 0, a1 = 0, a2 = 0, a3 = 0;
        for (int k = 0; k < K; ++k) {
            const float a = bf2f(ar[k]); const float* w = W + (size_t)k * D + n;
            a0 += a * w[0]; a1 += a * w[1]; a2 += a * w[2]; a3 += a * w[3];
        }
        const float* xi = xin + (size_t)m * D + n; float* xo = xout + (size_t)m * D + n;
        xo[0] = xi[0] + a0; xo[1] = xi[1] + a1; xo[2] = xi[2] + a2; xo[3] = xi[3] + a3;
    }
};

struct SwaF {
    const bf16* P; const float* t5; const float* sinks; bf16* AO;
    HD void operator()(long i) const {
        const long m = i / H; const int h = (int)(i % H), g = h / R; const int t = (int)(m % T); const long mb = m - t;
        float q[DH], o[DH];
#pragma unroll
        for (int d = 0; d < DH; ++d) { q[d] = bf2f(P[(size_t)m * A_COLS + h * DH + d]); o[d] = 0.f; }
        float mx = sinks[h], l = 1.0f;
        const int s0 = t - 127 < 0 ? 0 : t - 127;
        for (int s = s0; s <= t; ++s) {
            const bf16* kr = P + (size_t)(mb + s) * A_COLS + 1024 + g * DH;
            const bf16* vr = kr + 256;
            float sc = 0.f;
#pragma unroll
            for (int d = 0; d < DH; ++d) sc += q[d] * bf2f(kr[d]);
            sc = sc * 0.125f + t5[t5_bucket(t - s) * H + h];
            const float mn = sc > mx ? sc : mx; const float al = expf(mx - mn), p = expf(sc - mn);
            l = l * al + p; mx = mn;
#pragma unroll
            for (int d = 0; d < DH; ++d) o[d] = o[d] * al + p * bf2f(vr[d]);
        }
        const float il = 1.0f / l;
#pragma unroll
        for (int d = 0; d < DH; ++d) {
            const float z = bf2f(P[(size_t)m * A_COLS + 1536 + h * DH + d]);
            AO[(size_t)m * D + h * DH + d] = f2bf(o[d] * il * siluf_(z));
        }
    }
};

struct GemmRwkvF {
    const bf16* xn; const float* mu; const float* W; bf16* P;
    HD void operator()(long i) const {
        const int N = 4096, n4 = N / 4; const long m = i / n4; const int n = (int)(i % n4) * 4; const int s = n / 1024;
        const int t = (int)(m % T);
        const bf16* xr = xn + (size_t)m * D; const float* mus = mu + s * D;
        float a0 = 0, a1 = 0, a2 = 0, a3 = 0;
        for (int k = 0; k < D; ++k) {
            const float xc = bf2f(xr[k]); const float xp = t > 0 ? bf2f(xr[k - D]) : 0.f;
            const float a = xc + (xp - xc) * mus[k]; const float* w = W + (size_t)k * N + n;
            a0 += a * w[0]; a1 += a * w[1]; a2 += a * w[2]; a3 += a * w[3];
        }
        bf16* p = P + (size_t)m * N + n; p[0] = f2bf(a0); p[1] = f2bf(a1); p[2] = f2bf(a2); p[3] = f2bf(a3);
    }
};
struct LoraHidF {
    const bf16* xn; const float* mu; const float* w1; const float* a1; float* hw; float* ha;
    HD void operator()(long i) const {
        const long m = i / 128; const int jj = (int)(i % 128); const int which = jj / 64, j = jj % 64; const int t = (int)(m % T);
        const bf16* xr = xn + (size_t)m * D; const float* mus = mu + (4 + which) * D; const float* W = which ? a1 : w1;
        float acc = 0.f;
        for (int k = 0; k < D; ++k) {
            const float xc = bf2f(xr[k]); const float xp = t > 0 ? bf2f(xr[k - D]) : 0.f;
            acc += (xc + (xp - xc) * mus[k]) * W[(size_t)k * 64 + j];
        }
        if (which) ha[(size_t)m * 64 + j] = acc; else hw[(size_t)m * 64 + j] = tanhf(acc);
    }
};
struct LoraOutF {
    const float *hw, *ha, *w0, *w2, *a0, *a2; bf16* wlog; bf16* av;
    HD void operator()(long i) const {
        const long m = i / D; const int c = (int)(i % D);
        float sw = 0.f, sa = 0.f;
        for (int j = 0; j < 64; ++j) { sw += hw[(size_t)m * 64 + j] * w2[(size_t)j * D + c]; sa += ha[(size_t)m * 64 + j] * a2[(size_t)j * D + c]; }
        const float wr = -softplusf_(-(w0[c] + sw)) - 0.5f;
        wlog[i] = f2bf(-expf(wr)); av[i] = f2bf(sigmoidf_(a0[c] + sa));
    }
};
struct RwkvScanF {
    const bf16* P; const bf16* wlog; const bf16* av; const float* k_k; const float* k_a; bf16* ys;
    HD void operator()(long idx) const {
        const int i = (int)(idx % 64); const int h = (int)((idx / 64) % H); const int b = (int)(idx / (64 * H));
        float S[64];
#pragma unroll
        for (int j = 0; j < 64; ++j) S[j] = 0.f;
        for (int t = 0; t < T; ++t) {
            const size_t m = (size_t)b * T + t; const bf16* pr = P + m * 4096 + h * 64;
            const bf16* wl = wlog + m * D + h * 64; const bf16* ar = av + m * D + h * 64;
            float n2 = 0.f;
#pragma unroll
            for (int j = 0; j < 64; ++j) { const float kk = bf2f(pr[1024 + j]) * k_k[h * 64 + j]; n2 += kk * kk; }
            float nr = sqrtf(n2); nr = nr > 1e-12f ? nr : 1e-12f; const float inr = 1.0f / nr;
            float sa = 0.f;
#pragma unroll
            for (int j = 0; j < 64; ++j) { const float kk = bf2f(pr[1024 + j]) * k_k[h * 64 + j] * inr; sa += S[j] * (-kk); }
            const float vi = bf2f(pr[2048 + i]); float y = 0.f;
#pragma unroll
            for (int j = 0; j < 64; ++j) {
                const float kr = bf2f(pr[1024 + j]); const float a = bf2f(ar[j]);
                const float kk = kr * k_k[h * 64 + j] * inr; const float kp = kr * (1.0f + (a - 1.0f) * k_a[h * 64 + j]);
                const float dec = expf(bf2f(wl[j]));
                S[j] = S[j] * dec + sa * (kk * a) + vi * kp;
                y += S[j] * bf2f(pr[j]);
            }
            ys[m * D + h * 64 + i] = f2bf(y);
        }
    }
};
struct RwkvGnF {
    const bf16* P; const bf16* av; const float *k_a, *r_k, *lnx_w, *lnx_b; bf16* ys;
    HD void operator()(long idx) const {
        const long m = idx / H; const int h = (int)(idx % H);
        bf16* yr = ys + (size_t)m * D + h * 64; const bf16* pr = P + (size_t)m * 4096 + h * 64; const bf16* ar = av + (size_t)m * D + h * 64;
        float mean = 0.f;
        for (int j = 0; j < 64; ++j) mean += bf2f(yr[j]);
        mean /= 64.f; float var = 0.f;
        for (int j = 0; j < 64; ++j) { const float d = bf2f(yr[j]) - mean; var += d * d; }
        var /= 64.f; const float rstd = 1.0f / sqrtf(var + 64e-5f);
        float bs = 0.f;
        for (int j = 0; j < 64; ++j) { const float kr = bf2f(pr[1024 + j]); const float kp = kr * (1.0f + (bf2f(ar[j]) - 1.0f) * k_a[h * 64 + j]); bs += bf2f(pr[j]) * kp * r_k[h * 64 + j]; }
        for (int j = 0; j < 64; ++j) {
            const float yn = (bf2f(yr[j]) - mean) * rstd * lnx_w[h * 64 + j] + lnx_b[h * 64 + j];
            const float z = bf2f(pr[3072 + j]);
            yr[j] = f2bf((yn + bs * bf2f(pr[2048 + j])) * siluf_(z));
        }
    }
};

struct CmpHidF {
    const bf16* P; const float *pos_k, *w1_k, *pos_v, *w1_v; float* hk; float* hv;
    HD void operator()(long idx) const {
        const int j = (int)(idx % 128); long r = idx / 128; const int n = (int)(r % NCMP); r /= NCMP; const int g = (int)(r % G); r /= G;
        const int b = (int)(r % B); const int which = (int)(r / B);
        const float* pos = which ? pos_v : pos_k; const float* w1 = which ? w1_v : w1_k; const int col = 1024 + (which ? 256 : 0) + g * 64;
        float acc = 0.f;
        for (int l = 0; l < 32; ++l) {
            const bf16* src = P + (size_t)(b * T + 16 * n + l) * C_COLS + col;
            for (int d = 0; d < 64; ++d) acc += (bf2f(src[d]) + pos[l * 64 + d]) * w1[(size_t)(l * 64 + d) * 128 + j];
        }
        (which ? hv : hk)[(((size_t)b * G + g) * NCMP + n) * 128 + j] = siluf_(acc);
    }
};
struct CmpOutF {
    const float *hk, *hv, *w2_k, *w2_v; float* kc; float* vc;
    HD void operator()(long idx) const {
        const int d = (int)(idx % 64); long r = idx / 64; const long row = r % ((long)B * G * NCMP); const int which = (int)(r / ((long)B * G * NCMP));
        const float* hsrc = (which ? hv : hk) + (size_t)row * 128; const float* w2 = which ? w2_v : w2_k;
        float acc = 0.f;
        for (int j = 0; j < 128; ++j) acc += hsrc[j] * w2[j * 64 + d];
        (which ? vc : kc)[(size_t)row * 64 + d] = acc;
    }
};
struct CmpAttnF {
    const bf16* P; const float *kc, *vc; float* st; bf16* oc;
    HD void operator()(long i) const {
        const long m = i / H; const int h = (int)(i % H), g = h / R; const int t = (int)(m % T); const int b = (int)(m / T);
        float q[DH], o[DH];
#pragma unroll
        for (int d = 0; d < DH; ++d) { q[d] = bf2f(P[(size_t)m * C_COLS + h * DH + d]); o[d] = 0.f; }
        const int nv = t < 31 ? 0 : (t - 31) / 16 + 1;
        float mx = -1e30f, l = 0.f;
        for (int n = 0; n < nv; ++n) {
            const float* kr = kc + (((size_t)b * G + g) * NCMP + n) * 64; const float* vr = vc + (((size_t)b * G + g) * NCMP + n) * 64;
            float sc = 0.f;
#pragma unroll
            for (int d = 0; d < DH; ++d) sc += q[d] * kr[d];
            sc *= 0.125f;
            const float mn = sc > mx ? sc : mx; const float al = expf(mx - mn), p = expf(sc - mn);
            l = l * al + p; mx = mn;
#pragma unroll
            for (int d = 0; d < DH; ++d) o[d] = o[d] * al + p * vr[d];
        }
        const float il = nv > 0 ? 1.0f / l : 0.f;
        st[(size_t)i * 2] = mx; st[(size_t)i * 2 + 1] = il;
#pragma unroll
        for (int d = 0; d < DH; ++d) oc[(size_t)m * D + h * DH + d] = f2bf(o[d] * il);
    }
};
struct ImpF {
    const bf16* P; const float *kc, *st; float* imp;
    HD void operator()(long idx) const {
        const int s = (int)(idx % NSEL); long r = idx / NSEL; const int g = (int)(r % G); const long m = r / G;
        const int t = (int)(m % T); const int b = (int)(m / T); const int cur = t / 64;
        float v;
        if (s == 0 || s == cur || s == cur - 1) v = 1e30f;
        else if (s * 64 > t) v = -1e30f;
        else {
            v = 0.f; const int nv = t < 31 ? 0 : (t - 31) / 16 + 1;
            int n0 = 4 * s - 1; if (n0 < 0) n0 = 0; int n1 = 4 * s + 3; if (n1 > NCMP - 1) n1 = NCMP - 1; if (n1 > nv - 1) n1 = nv - 1;
            for (int rr = 0; rr < R; ++rr) {
                const int h = g * R + rr; const bf16* qr = P + (size_t)m * C_COLS + h * DH;
                const float mx = st[((size_t)m * H + h) * 2], il = st[((size_t)m * H + h) * 2 + 1];
                for (int n = n0; n <= n1; ++n) {
                    const float* kr = kc + (((size_t)b * G + g) * NCMP + n) * 64; float sc = 0.f;
                    for (int d = 0; d < DH; ++d) sc += bf2f(qr[d]) * kr[d];
                    v += expf(sc * 0.125f - mx) * il;
                }
            }
        }
        imp[idx] = v;
    }
};
struct TopkF {
    const float* imp; int* sel;
    HD void operator()(long idx) const {
        const float* v = imp + (size_t)idx * NSEL; unsigned long long used = 0ull;
        for (int j = 0; j < KTOP; ++j) {
            int best = -1; float bv = 0.f;
            for (int s = 0; s < NSEL; ++s) { if ((used >> s) & 1ull) continue; const float x = v[s]; if (best < 0 || x > bv) { best = s; bv = x; } }
            used |= 1ull << best; sel[(size_t)idx * 16 + j] = best;
        }
    }
};
struct SelAttnF {
    const bf16* P; const float* t5; const int* sel; bf16* os;
    HD void operator()(long i) const {
        const long m = i / H; const int h = (int)(i % H), g = h / R; const int t = (int)(m % T); const long mb = m - t;
        float q[DH], o[DH];
#pragma unroll
        for (int d = 0; d < DH; ++d) { q[d] = bf2f(P[(size_t)m * C_COLS + h * DH + d]); o[d] = 0.f; }
        float mx = -1e30f, l = 0.f;
        for (int j = 0; j < KTOP; ++j) {
            const int blk = sel[((size_t)m * G + g) * 16 + j];
            for (int ll = 0; ll < 64; ++ll) {
                const int s = blk * 64 + ll; if (s > t) break;
                const bf16* kr = P + (size_t)(mb + s) * C_COLS + 1536 + g * DH; const bf16* vr = kr + 256;
                float sc = 0.f;
#pragma unroll
                for (int d = 0; d < DH; ++d) sc += q[d] * bf2f(kr[d]);
                sc = sc * 0.125f + t5[t5_bucket(t - s) * H + h];
                const float mn = sc > mx ? sc : mx; const float al = expf(mx - mn), p = expf(sc - mn);
                l = l * al + p; mx = mn;
#pragma unroll
                for (int d = 0; d < DH; ++d) o[d] = o[d] * al + p * bf2f(vr[d]);
            }
        }
        const float il = 1.0f / l;
#pragma unroll
        for (int d = 0; d < DH; ++d) os[(size_t)m * D + h * DH + d] = f2bf(o[d] * il);
    }
};
struct WinAttnF {
    const bf16* P; const float* t5; const bf16* oc; const bf16* os; bf16* AO;
    HD void operator()(long i) const {
        const long m = i / H; const int h = (int)(i % H), g = h / R, rr = h % R; const int t = (int)(m % T); const long mb = m - t;
        float q[DH], o[DH];
#pragma unroll
        for (int d = 0; d < DH; ++d) { q[d] = bf2f(P[(size_t)m * C_COLS + h * DH + d]); o[d] = 0.f; }
        float mx = -1e30f, l = 0.f;
        const int s0 = t - 511 < 0 ? 0 : t - 511;
        for (int s = s0; s <= t; ++s) {
            const bf16* kr = P + (size_t)(mb + s) * C_COLS + 2048 + g * DH; const bf16* vr = kr + 256;
            float sc = 0.f;
#pragma unroll
            for (int d = 0; d < DH; ++d) sc += q[d] * bf2f(kr[d]);
            sc = sc * 0.125f + t5[t5_bucket(t - s) * H + h];
            const float mn = sc > mx ? sc : mx; const float al = expf(mx - mn), p = expf(sc - mn);
            l = l * al + p; mx = mn;
#pragma unroll
            for (int d = 0; d < DH; ++d) o[d] = o[d] * al + p * bf2f(vr[d]);
        }
        const float il = 1.0f / l;
        const bf16* gr = P + (size_t)m * C_COLS + 2560;
        const float g0 = sigmoidf_(bf2f(gr[0 * 16 + g * R + rr])), g1 = sigmoidf_(bf2f(gr[1 * 16 + g * R + rr])), g2 = sigmoidf_(bf2f(gr[2 * 16 + g * R + rr]));
#pragma unroll
        for (int d = 0; d < DH; ++d) {
            const size_t oi = (size_t)m * D + h * DH + d;
            const float z = bf2f(P[(size_t)m * C_COLS + 2608 + h * DH + d]);
            AO[oi] = f2bf((g0 * bf2f(oc[oi]) + g1 * bf2f(os[oi]) + g2 * o[d] * il) * siluf_(z));
        }
    }
};

struct ConvF {
    const bf16* P; const float *cw, *cb; bf16* uc;
    HD void operator()(long i) const {
        const long m = i / LW; const int c = (int)(i % LW); const int t = (int)(m % T);
        float acc = cb[c];
        for (int w = 0; w < 4; ++w) { const int tt = t - 3 + w; if (tt >= 0) acc += cw[w * LW + c] * bf2f(P[(size_t)(m - 3 + w) * 2560 + c]); }
        uc[i] = f2bf(acc);
    }
};
struct LruGateF {
    const bf16* uc; const float *gaw, *gab, *gxw, *gxb, *lam; bf16* la; bf16* bv;
    HD void operator()(long i) const {
        const long m = i / LW; const int c = (int)(i % LW); const int n = c / 80, d = c % 80;
        const bf16* ub = uc + (size_t)m * LW + n * 80; float ra = gab[c], rx = gxb[c];
        for (int k = 0; k < 80; ++k) { const float u = bf2f(ub[k]); ra += u * gaw[((size_t)n * 80 + k) * 80 + d]; rx += u * gxw[((size_t)n * 80 + k) * 80 + d]; }
        const float r = sigmoidf_(ra), ig = sigmoidf_(rx);
        const float loga = -8.0f * r * softplusf_(-lam[c]);
        la[i] = f2bf(loga);
        bv[i] = f2bf(sqrtf(-expm1f(2.0f * loga)) * (ig * bf2f(uc[i])));
    }
};
struct LruScanF {
    const bf16* P; const bf16* la; const bf16* bv; bf16* AO;
    HD void operator()(long idx) const {
        const int c = (int)(idx % LW); const int b = (int)(idx / LW); float h = 0.f;
        for (int t = 0; t < T; ++t) {
            const size_t m = (size_t)b * T + t;
            h = expf(bf2f(la[m * LW + c])) * h + bf2f(bv[m * LW + c]);
            AO[m * LW + c] = f2bf(h * siluf_(bf2f(P[m * 2560 + LW + c])));
        }
    }
};
struct FinalNormF {
    float* x; const float* g;
    HD void operator()(long m) const {
        float* r = x + (size_t)m * D; float s = 0.f;
        for (int k = 0; k < D; ++k) s += r[k] * r[k];
        const float rs = 1.0f / sqrtf(s / D + 1e-6f);
        for (int k = 0; k < D; ++k) r[k] = r[k] * rs * g[k];
    }
};


#ifndef CPU_SHIM
typedef short bf16x8 __attribute__((ext_vector_type(8)));
typedef float f32x4 __attribute__((ext_vector_type(4)));
typedef unsigned u32x4 __attribute__((ext_vector_type(4)));
typedef unsigned u32x2 __attribute__((ext_vector_type(2)));
#define DI __device__ __forceinline__
#define NTHREADS 256
__device__ __forceinline__ int opaque_tid() { int t = threadIdx.x; asm volatile("" : "+v"(t)); return t; }
#define TIDX (opaque_tid())

typedef __bf16 hbf16x2 __attribute__((ext_vector_type(2)));
typedef float f32x2 __attribute__((ext_vector_type(2)));
DI unsigned pack2bf(float lo, float hi) { f32x2 f = {lo, hi}; return __builtin_bit_cast(unsigned, __builtin_convertvector(f, hbf16x2)); }
DI float bflo(unsigned u) { return __uint_as_float(u << 16); }
DI float bfhi(unsigned u) { return __uint_as_float(u & 0xffff0000u); }

namespace fw {
constexpr size_t MB = 1024 * 1024;
constexpr size_t PARTS = 13 * MB;
constexpr size_t SMALLB = 1 * MB;
constexpr size_t WB = 14 * MB;
constexpr size_t XB = 30 * MB;
constexpr size_t BIG = 62 * MB;
}

DI void convert_tile(const float* __restrict__ W, int ldw, int c0, int K, bf16* __restrict__ Wt, const float* __restrict__ g, int kt, int nt, float* sm) {
    const int tid = TIDX;
    const int k0 = kt * 64, n0 = nt * 64;
#pragma unroll
    for (int i = 0; i < 4; ++i) {
        const int kr = (tid >> 4) + 16 * i; const int nc = (tid & 15) * 4;
        const float4 v = *(const float4*)(W + (size_t)(k0 + kr) * ldw + c0 + n0 + nc);
        const float s = g ? g[k0 + kr] : 1.0f;
        sm[kr * 65 + nc + 0] = v.x * s; sm[kr * 65 + nc + 1] = v.y * s; sm[kr * 65 + nc + 2] = v.z * s; sm[kr * 65 + nc + 3] = v.w * s;
    }
    __syncthreads();
    {
        const int n = tid >> 2, kq = (tid & 3) * 16;
        unsigned w[8];
#pragma unroll
        for (int j = 0; j < 8; ++j) w[j] = pack2bf(sm[(kq + 2 * j) * 65 + n], sm[(kq + 2 * j + 1) * 65 + n]);
        u32x4* dst = (u32x4*)(Wt + (size_t)(n0 + n) * K + k0 + kq);
        dst[0] = (u32x4){w[0], w[1], w[2], w[3]}; dst[1] = (u32x4){w[4], w[5], w[6], w[7]};
    }
    __syncthreads();
}
DI void convert_seg(const float* W, int ldw, int c0, int ncols, int K, bf16* Wt, const float* g, float* sm, int& tbase) {
    const int nkt = K / 64, nnt = ncols / 64, ntile = nkt * nnt;
    const int Gd = (int)gridDim.x;
    for (int t = (((int)blockIdx.x - tbase % Gd) + Gd) % Gd; t < ntile; t += Gd) convert_tile(W, ldw, c0, K, Wt, g, t % nkt, t / nkt, sm);
    tbase += ntile;
}

DI int perm32(int rho) { const int n = rho >> 4, i = rho & 15; return 8 * (i >> 2) + 4 * n + (i & 3); }

struct ALoadPlain {
    const bf16* A; int lda;
    static constexpr bool DMA = true;
    DI const bf16* src(int m, int k) const { return A + (size_t)m * lda + k; }
    struct Raw { u32x4 v; };
    DI Raw load(int m, int k) const { Raw r; r.v = *(const u32x4*)(A + (size_t)m * lda + k); return r; }
    DI u32x4 finish(const Raw& r, int, int) const { return r.v; }
};
struct ALoadLerp {
    const bf16* xn; const float* mu;
    static constexpr bool DMA = false;
    DI const bf16* src(int, int) const { return nullptr; }
    struct Raw { u32x4 c, p; };
    DI Raw load(int m, int k) const {
        Raw r; r.c = *(const u32x4*)(xn + (size_t)m * D + k);
        if ((m % T) != 0) r.p = *(const u32x4*)(xn + (size_t)(m - 1) * D + k); else r.p = (u32x4){0u, 0u, 0u, 0u};
        return r;
    }
    DI u32x4 finish(const Raw& r, int, int k) const {
        const float4 m0 = *(const float4*)(mu + k), m1 = *(const float4*)(mu + k + 4);
        const float mm[8] = {m0.x, m0.y, m0.z, m0.w, m1.x, m1.y, m1.z, m1.w};
        u32x4 o;
#pragma unroll
        for (int j = 0; j < 4; ++j) {
            const float c0 = bflo(r.c[j]), c1 = bfhi(r.c[j]), p0 = bflo(r.p[j]), p1 = bfhi(r.p[j]);
            o[j] = pack2bf(c0 + (p0 - c0) * mm[2 * j], c1 + (p1 - c1) * mm[2 * j + 1]);
        }
        return o;
    }
};

#define GLDS16(gp, lp) __builtin_amdgcn_global_load_lds((const unsigned*)(gp), (unsigned*)(lp), 16, 0, 0)
template <class AL, class Epi>
DI void gemm_tile(const AL& al, const bf16* __restrict__ Bt, int K, int m0, int n0, const Epi& epi, char* smem) {
    const int tid = TIDX, lane = tid & 63, wave = __builtin_amdgcn_readfirstlane(tid >> 6), wr = wave >> 1, wc = wave & 1, q = lane >> 4, l15 = lane & 15;
    const int srow = tid >> 3, sc = tid & 7, scs = sc ^ (srow & 7);
    const int st_off = srow * 128 + (sc << 4);
    const int dma_off = (8 * wave) * 128;
    int brow[4];
#pragma unroll
    for (int i = 0; i < 4; ++i) { const int rho = srow + 32 * i; brow[i] = n0 + (rho & ~31) + perm32(rho & 31); }
    const int fa0 = (wr * 64 + l15) * 128 + ((q ^ (lane & 7)) << 4);
    const int fb0 = (wc * 64 + l15) * 128 + ((q ^ (lane & 7)) << 4);
    f32x4 acc[4][4];
#pragma unroll
    for (int i = 0; i < 4; ++i)
#pragma unroll
        for (int j = 0; j < 4; ++j) acc[i][j] = (f32x4){0.f, 0.f, 0.f, 0.f};
    typename AL::Raw ra[4];
    const int nk = K / 64;
    {
        char* bufA = smem; char* bufB = smem + 16384;
#pragma unroll
        for (int i = 0; i < 4; ++i) {
            GLDS16(Bt + (size_t)brow[i] * K + scs * 8, bufB + dma_off + i * 4096);
            if (AL::DMA) GLDS16(al.src(m0 + srow + 32 * i, scs * 8), bufA + dma_off + i * 4096);
            else ra[i] = al.load(m0 + srow + 32 * i, scs * 8);
        }
        if (!AL::DMA) {
#pragma unroll
            for (int i = 0; i < 4; ++i) *(u32x4*)(bufA + st_off + i * 4096) = al.finish(ra[i], m0 + srow + 32 * i, scs * 8);
        }
    }
    asm volatile("s_waitcnt vmcnt(0)" ::: "memory");
    __syncthreads();
    for (int kt = 0; kt < nk; ++kt) {
        char* bufA = smem + (kt & 1) * 32768; char* bufB = bufA + 16384;
        char* nA = smem + ((kt + 1) & 1) * 32768; char* nB = nA + 16384;
        const bool more = kt + 1 < nk; const int kn = (kt + 1) * 64 + scs * 8;
        if (more) {
#pragma unroll
            for (int i = 0; i < 4; ++i) {
                GLDS16(Bt + (size_t)brow[i] * K + kn, nB + dma_off + i * 4096);
                if (AL::DMA) GLDS16(al.src(m0 + srow + 32 * i, kn), nA + dma_off + i * 4096);
                else ra[i] = al.load(m0 + srow + 32 * i, kn);
            }
        }
#pragma unroll
        for (int ks = 0; ks < 2; ++ks) {
            bf16x8 af[4], bfr[4];
#pragma unroll
            for (int i = 0; i < 4; ++i) {
                af[i] = *(const bf16x8*)(bufA + ((fa0 + i * 2048) ^ (ks << 6)));
                bfr[i] = *(const bf16x8*)(bufB + ((fb0 + i * 2048) ^ (ks << 6)));
            }
#pragma unroll
            for (int i = 0; i < 4; ++i)
#pragma unroll
                for (int j = 0; j < 4; ++j) acc[i][j] = __builtin_amdgcn_mfma_f32_16x16x32_bf16(bfr[j], af[i], acc[i][j], 0, 0, 0);
        }
        if (more && !AL::DMA) {
#pragma unroll
            for (int i = 0; i < 4; ++i) *(u32x4*)(nA + st_off + i * 4096) = al.finish(ra[i], m0 + srow + 32 * i, kn);
        }
        asm volatile("s_waitcnt vmcnt(0)" ::: "memory");
        __syncthreads();
    }
#pragma unroll
    for (int mt = 0; mt < 4; ++mt)
#pragma unroll
        for (int gi = 0; gi < 2; ++gi) {
            float v[8];
#pragma unroll
            for (int r = 0; r < 4; ++r) { v[r] = acc[mt][2 * gi][r]; v[4 + r] = acc[mt][2 * gi + 1][r]; }
            epi(m0 + wr * 64 + mt * 16 + l15, n0 + wc * 64 + gi * 32 + 8 * q, v, mt, gi);
        }
    epi.finish(m0, n0, wr, wc, lane);
}

constexpr int G2_STAGE = 24576;
template <class AL, class Epi>
DI void gemm_tile2(const AL& al, const bf16* __restrict__ Bt, int K, int m0, int n0, const Epi& epi, char* smem) {
    const int tid = TIDX, lane = tid & 63, wave = __builtin_amdgcn_readfirstlane(tid >> 6), wr = wave >> 1, wc = wave & 1, q = lane >> 4, l15 = lane & 15;
    const int prow = tid >> 2, ppos = tid & 3, ca = (ppos - 2 * ((tid >> 4) & 3)) & 3;
    const int dma_off = wave * 1024;
    int brow[4];
#pragma unroll
    for (int i = 0; i < 4; ++i) { const int rho = prow + 64 * i; brow[i] = n0 + (rho & ~31) + perm32(rho & 31); }
    const int fpos = ((q + 2 * ((l15 >> 2) & 3)) & 3) << 4;
    const int fa0 = (wr * 64 + l15) * 64 + fpos, fb0 = 8192 + (wc * 128 + l15) * 64 + fpos;
    f32x4 acc[4][8];
#pragma unroll
    for (int i = 0; i < 4; ++i)
#pragma unroll
        for (int j = 0; j < 8; ++j) acc[i][j] = (f32x4){0.f, 0.f, 0.f, 0.f};
    typename AL::Raw ra[2];
    const int nk = K / 32;
#define G2_ISSUE(kt_) { char* st_ = smem + ((kt_) % 3) * G2_STAGE; const int kk_ = (kt_) * 32 + ca * 8; \
        _Pragma("unroll") for (int i = 0; i < 2; ++i) { if (AL::DMA) GLDS16(al.src(m0 + prow + 64 * i, kk_), st_ + dma_off + i * 4096); else ra[i] = al.load(m0 + prow + 64 * i, kk_); } \
        _Pragma("unroll") for (int i = 0; i < 4; ++i) GLDS16(Bt + (size_t)brow[i] * K + kk_, st_ + 8192 + dma_off + i * 4096); }
#define G2_AWRITE(kt_) { if (!AL::DMA) { char* st_ = smem + ((kt_) % 3) * G2_STAGE; const int kk_ = (kt_) * 32 + ca * 8; \
        _Pragma("unroll") for (int i = 0; i < 2; ++i) *(u32x4*)(st_ + (prow + 64 * i) * 64 + ppos * 16) = al.finish(ra[i], m0 + prow + 64 * i, kk_); } }
#define G2_BARRIER() { asm volatile("s_waitcnt lgkmcnt(0)" ::: "memory"); __builtin_amdgcn_s_barrier(); asm volatile("" ::: "memory"); }
    G2_ISSUE(0); G2_AWRITE(0);
    if (nk > 1) { G2_ISSUE(1); G2_AWRITE(1); }
    if (nk > 1) { if (AL::DMA) asm volatile("s_waitcnt vmcnt(6)" ::: "memory"); else asm volatile("s_waitcnt vmcnt(4)" ::: "memory"); } else asm volatile("s_waitcnt vmcnt(0)" ::: "memory");
    G2_BARRIER();
    for (int kt = 0; kt < nk; ++kt) {
        const char* st = smem + (kt % 3) * G2_STAGE;
        const bool more = kt + 2 < nk;
        if (more) G2_ISSUE(kt + 2);
        bf16x8 af[4];
#pragma unroll
        for (int i = 0; i < 4; ++i) af[i] = *(const bf16x8*)(st + fa0 + i * 1024);
#pragma unroll
        for (int j = 0; j < 8; ++j) {
            const bf16x8 bf_ = *(const bf16x8*)(st + fb0 + j * 1024);
#pragma unroll
            for (int i = 0; i < 4; ++i) acc[i][j] = __builtin_amdgcn_mfma_f32_16x16x32_bf16(bf_, af[i], acc[i][j], 0, 0, 0);
        }
        if (more) G2_AWRITE(kt + 2);
        if (more) { if (AL::DMA) asm volatile("s_waitcnt vmcnt(6)" ::: "memory"); else asm volatile("s_waitcnt vmcnt(4)" ::: "memory"); } else asm volatile("s_waitcnt vmcnt(0)" ::: "memory");
        G2_BARRIER();
    }
#undef G2_ISSUE
#undef G2_AWRITE
#undef G2_BARRIER
#pragma unroll
    for (int mt = 0; mt < 4; ++mt)
#pragma unroll
        for (int gi = 0; gi < 4; ++gi) {
            float v[8];
#pragma unroll
            for (int r = 0; r < 4; ++r) { v[r] = acc[mt][2 * gi][r]; v[4 + r] = acc[mt][2 * gi + 1][r]; }
            epi(m0 + wr * 64 + mt * 16 + l15, n0 + wc * 128 + gi * 32 + 8 * q, v, mt, gi);
        }
    epi.finish_wide(m0, n0, wr, wc, lane);
}
template <class F>
DI void gemm_sched(int nbig, int nsmall, F&& f) {
    const int x = blockIdx.x & 7, lb = blockIdx.x >> 3, nlb = gridDim.x >> 3;
    const int nb16 = 16 * nbig, tot = 16 * (nbig + nsmall);
    for (int s = lb; s < tot; s += nlb) {
        if (s < nb16) f(true, x * 16 + (s & 15), s >> 4);
        else { const int t = s - nb16; f(false, x * 16 + (t & 15), t >> 4); }
    }
}

DI float rstd_from_parts(const float* parts, int m) {
    const float4* p = (const float4*)(parts + (size_t)m * 16); float s = 0.f;
#pragma unroll
    for (int i = 0; i < 4; ++i) { const float4 v = p[i]; s += (v.x + v.y) + (v.z + v.w); }
    return 1.0f / sqrtf(s * (1.0f / D) + 1e-6f);
}
DI void store8bf(bf16* p, const float* v) { *(u32x4*)p = (u32x4){pack2bf(v[0], v[1]), pack2bf(v[2], v[3]), pack2bf(v[4], v[5]), pack2bf(v[6], v[7])}; }

struct EpiBf16 {
    bf16* P; int ldp; const float* parts; mutable float rsc[4];
    DI void operator()(int m, int n, const float* v, int mt, int gi) const {
        if (gi == 0) rsc[mt] = parts ? rstd_from_parts(parts, m) : 1.0f;
        float s = rsc[mt]; float w[8];
#pragma unroll
        for (int j = 0; j < 8; ++j) w[j] = v[j] * s;
        store8bf(P + (size_t)m * ldp + n, w);
    }
    DI void finish(int, int, int, int, int) const {}
    DI void finish_wide(int, int, int, int, int) const {}
};
struct EpiResid {
    const float* xin; float* xout; bf16* xb; float* parts; mutable float sq[4];
    DI void operator()(int m, int n, const float* v, int mt, int gi) const {
        const float4* xi = (const float4*)(xin + (size_t)m * D + n); const float4 a = xi[0], b = xi[1];
        float w[8] = {a.x + v[0], a.y + v[1], a.z + v[2], a.w + v[3], b.x + v[4], b.y + v[5], b.z + v[6], b.w + v[7]};
        float4* xo = (float4*)(xout + (size_t)m * D + n);
        xo[0] = make_float4(w[0], w[1], w[2], w[3]); xo[1] = make_float4(w[4], w[5], w[6], w[7]);
        if (xb) store8bf(xb + (size_t)m * D + n, w);
        float s = 0.f;
#pragma unroll
        for (int j = 0; j < 8; ++j) s += w[j] * w[j];
        if (gi == 0) sq[mt] = s; else sq[mt] += s;
    }
    DI void finish(int m0, int n0, int wr, int wc, int lane) const {
#pragma unroll
        for (int mt = 0; mt < 4; ++mt) {
            float s = sq[mt]; s += __shfl_xor(s, 16); s += __shfl_xor(s, 32);
            if (lane < 16) parts[(size_t)(m0 + wr * 64 + mt * 16 + lane) * 16 + (n0 >> 7) * 2 + wc] = s;
        }
    }
    DI void finish_wide(int m0, int n0, int wr, int wc, int lane) const {
#pragma unroll
        for (int mt = 0; mt < 4; ++mt) {
            float s = sq[mt]; s += __shfl_xor(s, 16); s += __shfl_xor(s, 32);
            if (lane < 16) { float* pr = parts + (size_t)(m0 + wr * 64 + mt * 16 + lane) * 16 + (n0 >> 7) + wc; pr[0] = s; pr[8] = 0.f; }
        }
    }
};
struct EpiRwkv {
    bf16* P; float* hw; float* ha;
    DI void operator()(int m, int n, const float* v, int, int) const {
        if (n < 4096) { store8bf(P + (size_t)m * 4096 + n, v); return; }
        const int c = n - 4096;
        if (c < 64) { float4* o = (float4*)(hw + (size_t)m * 64 + c); o[0] = make_float4(tanhf(v[0]), tanhf(v[1]), tanhf(v[2]), tanhf(v[3])); o[1] = make_float4(tanhf(v[4]), tanhf(v[5]), tanhf(v[6]), tanhf(v[7])); }
        else if (c >= 128 && c < 192) { float4* o = (float4*)(ha + (size_t)m * 64 + (c - 128)); o[0] = make_float4(v[0], v[1], v[2], v[3]); o[1] = make_float4(v[4], v[5], v[6], v[7]); }
    }
    DI void finish(int, int, int, int, int) const {}
    DI void finish_wide(int, int, int, int, int) const {}
};

namespace at {
constexpr int OFF_BIAS = 49152;
constexpr int OFF_X = 61952;
constexpr int OFF_IMP = 49152;
constexpr float L2E = 1.4426950408889634f;
constexpr float NEG_MASK = -1e30f, M_INIT = -1e20f;
}
enum { AM_SWA = 0, AM_WIN = 1, AM_CMP = 2, AM_SEL = 3 };
DI int vt_perm(int k32) { return ((k32 & 15) >> 2) * 8 + (k32 >> 4) * 4 + (k32 & 3); }
DI float fast_exp2(float x) { return __builtin_amdgcn_exp2f(x); }

DI void build_bias_lut(const float* __restrict__ t5, char* smem, bool swa) {
    float* lut = (float*)(smem + at::OFF_BIAS);
    for (int i = TIDX; i < 16 * 200; i += NTHREADS) {
        const int h = i / 200, e = i % 200; float v = at::NEG_MASK;
        if (e >= 64 && e < 192) v = t5[t5_bucket(e - 64) * 16 + h] * at::L2E;
        else if (e >= 192 && !swa) v = t5[31 * 16 + h] * at::L2E;
        lut[i] = v;
    }
    __syncthreads();
}

template <int NQT> struct AttnStateT { f32x4 o[NQT][4]; f32x4 lacc[NQT]; float m[NQT]; };
#ifndef ANQT_SWA
#define ANQT_SWA 4
#endif
#ifndef ANQT_WIN
#define ANQT_WIN 2
#endif
#ifndef ANQT_SEL
#define ANQT_SEL 4
#endif
DI unsigned long long range_mask(int lo, int hi) { return (hi >= 63 ? ~0ull : ((1ull << (hi + 1)) - 1ull)) & ~((1ull << lo) - 1ull); }

template <int NQT>
DI void attn_load_q(bf16x8 (&qf)[NQT][2], const bf16* __restrict__ Qp, int ldq, size_t mbase, int hbase) {
    const int lane = TIDX & 63, wave = TIDX >> 6, q = lane >> 4, l15 = lane & 15;
#pragma unroll
    for (int qt = 0; qt < NQT; ++qt) {
        const size_t m = mbase + wave * (4 * NQT) + qt * 4 + (l15 >> 2);
#pragma unroll
        for (int ks = 0; ks < 2; ++ks) qf[qt][ks] = *(const bf16x8*)(Qp + m * ldq + (hbase + (l15 & 3)) * 64 + ks * 32 + q * 8);
    }
}

enum { SK_FAR = 0, SK_NEAR = 1, SK_EDGE = 2, SK_CMP = 3 };
template <int KIND>
DI float attn_fix(f32x4 (&s)[4], int dbase, float cadd, const float* __restrict__ bl, float mx) {
#pragma unroll
    for (int kt = 0; kt < 4; ++kt)
#pragma unroll
        for (int r = 0; r < 4; ++r) {
            float v = s[kt][r]; const int dist = dbase - (kt * 16 + r);
            if (KIND == SK_NEAR) { int idx = dist + 64; idx = idx < 0 ? 0 : (idx > 192 ? 192 : idx); v += bl[idx] + cadd; }
            else if (KIND == SK_EDGE) v = dist < 512 ? v + cadd : at::NEG_MASK;
            else if (KIND == SK_CMP) v = dist >= 0 ? v : at::NEG_MASK;
            if (KIND != SK_FAR) s[kt][r] = v;
            mx = fmaxf(mx, v);
        }
    return mx;
}
template <int MODE, int NQT>
DI void attn_blocks(AttnStateT<NQT>& st, const bf16x8 (&qf)[NQT][2], const bf16* __restrict__ Kp, size_t krs, const bf16* __restrict__ Vp, size_t vrs,
                    int t0, unsigned long long todo, int hbase, const unsigned long long (&sel)[NQT], char* smem) {
    const int tid = TIDX, lane = tid & 63, wave = __builtin_amdgcn_readfirstlane(tid >> 6), q = lane >> 4, l15 = lane & 15;
    const int tq0 = t0 + wave * (4 * NQT) + (l15 >> 2);
    const float* bl = (const float*)(smem + at::OFF_BIAS) + (hbase + (l15 & 3)) * 200;
    const float bfar = (MODE != AM_CMP) ? bl[192] : 0.f;
    const int srow = tid >> 3, scs = (tid & 7) ^ (srow & 7);
    const int fo = l15 * 128 + ((q ^ (l15 & 7)) << 4);
#define ATT_DMA(kb_, slot_) { _Pragma("unroll") for (int i = 0; i < 2; ++i) { const int row = srow + 32 * i; char* dst = smem + (slot_) * 16384 + (8 * wave + 32 * i) * 128; \
        GLDS16(Kp + (size_t)((kb_) * 64 + row) * krs + scs * 8, dst); GLDS16(Vp + (size_t)row * vrs + (kb_) * 64 + scs * 8, dst + 8192); } }
#define ATT_BARRIER() { asm volatile("s_waitcnt lgkmcnt(0)" ::: "memory"); __builtin_amdgcn_s_barrier(); asm volatile("" ::: "memory"); }
    if (todo == 0ull) return;
    int kb = __builtin_ctzll(todo); todo &= todo - 1ull;
    int kb1 = -1; if (todo) { kb1 = __builtin_ctzll(todo); todo &= todo - 1ull; }
    ATT_DMA(kb, 0);
    if (kb1 >= 0) { ATT_DMA(kb1, 1); asm volatile("s_waitcnt vmcnt(4)" ::: "memory"); } else { asm volatile("s_waitcnt vmcnt(0)" ::: "memory"); }
    ATT_BARRIER();
    int slot = 0;
    for (;;) {
        char* buf = smem + slot * 16384;
        int kb2 = -1; if (todo) { kb2 = __builtin_ctzll(todo); todo &= todo - 1ull; }
        if (kb2 >= 0) { const int s2 = slot >= 1 ? slot - 1 : 2; ATT_DMA(kb2, s2); }
        f32x4 s[NQT][4];
#pragma unroll
        for (int qt = 0; qt < NQT; ++qt)
#pragma unroll
            for (int kt = 0; kt < 4; ++kt) s[qt][kt] = (f32x4){0.f, 0.f, 0.f, 0.f};
#pragma unroll
        for (int kt = 0; kt < 4; ++kt)
#pragma unroll
            for (int ks = 0; ks < 2; ++ks) {
                const bf16x8 kf = *(const bf16x8*)(buf + ((fo + kt * 2048) ^ (ks << 6)));
#pragma unroll
                for (int qt = 0; qt < NQT; ++qt) s[qt][kt] = __builtin_amdgcn_mfma_f32_16x16x32_bf16(kf, qf[qt][ks], s[qt][kt], 0, 0, 0);
            }
        const int mind = (t0 + wave * (4 * NQT)) - (kb * 64 + 63), maxd = (t0 + wave * (4 * NQT) + 4 * NQT - 1) - kb * 64;
        float mx[NQT], cofs[NQT];
#pragma unroll
        for (int qt = 0; qt < NQT; ++qt) cofs[qt] = 0.f;
        if (MODE == AM_CMP) {
#pragma unroll
            for (int qt = 0; qt < NQT; ++qt) { const int nlim = (tq0 + 4 * qt - 31) >> 4; mx[qt] = attn_fix<SK_CMP>(s[qt], nlim - (kb * 64 + 4 * q), 0.f, bl, at::NEG_MASK); }
        } else {
            float cadd[NQT];
#pragma unroll
            for (int qt = 0; qt < NQT; ++qt) cadd[qt] = (MODE == AM_SEL && !((sel[qt] >> kb) & 1ull)) ? at::NEG_MASK : 0.f;
            if (MODE == AM_SWA || mind < 113) {
#pragma unroll
                for (int qt = 0; qt < NQT; ++qt) mx[qt] = attn_fix<SK_NEAR>(s[qt], tq0 + 4 * qt - (kb * 64 + 4 * q), cadd[qt], bl, at::NEG_MASK);
            } else if (MODE == AM_WIN && maxd >= 512) {
#pragma unroll
                for (int qt = 0; qt < NQT; ++qt) mx[qt] = attn_fix<SK_EDGE>(s[qt], tq0 + 4 * qt - (kb * 64 + 4 * q), bfar, bl, at::NEG_MASK);
            } else {
#pragma unroll
                for (int qt = 0; qt < NQT; ++qt) { cofs[qt] = bfar + cadd[qt]; mx[qt] = attn_fix<SK_FAR>(s[qt], 0, 0.f, bl, at::NEG_MASK) + cofs[qt]; }
            }
        }
        float msub[NQT]; bool grow = false;
#pragma unroll
        for (int qt = 0; qt < NQT; ++qt) {
            float m2 = mx[qt];
            m2 = fmaxf(m2, __shfl_xor(m2, 16)); m2 = fmaxf(m2, __shfl_xor(m2, 32));
            const bool g = m2 > st.m[qt] + 4.0f; grow |= g;
            mx[qt] = g ? m2 : st.m[qt];
            msub[qt] = mx[qt] - cofs[qt];
        }
        if (__any(grow)) {
#pragma unroll
            for (int qt = 0; qt < NQT; ++qt) {
                const float alpha = fast_exp2(st.m[qt] - mx[qt]);
#pragma unroll
                for (int dt = 0; dt < 4; ++dt) st.o[qt][dt] *= alpha;
                st.lacc[qt] *= alpha;
            }
        }
#pragma unroll
        for (int qt = 0; qt < NQT; ++qt) st.m[qt] = mx[qt];
#pragma unroll
        for (int qt = 0; qt < NQT; ++qt)
#pragma unroll
            for (int kt = 0; kt < 4; ++kt)
#pragma unroll
                for (int r = 0; r < 4; ++r) s[qt][kt][r] = fast_exp2(s[qt][kt][r] - msub[qt]);
        const bf16x8 ones = {(short)0x3F80, (short)0x3F80, (short)0x3F80, (short)0x3F80, (short)0x3F80, (short)0x3F80, (short)0x3F80, (short)0x3F80};
#pragma unroll
        for (int kp = 0; kp < 2; ++kp) {
            bf16x8 pf[NQT];
#pragma unroll
            for (int qt = 0; qt < NQT; ++qt) {
                const u32x4 w = {pack2bf(s[qt][2 * kp][0], s[qt][2 * kp][1]), pack2bf(s[qt][2 * kp][2], s[qt][2 * kp][3]),
                                 pack2bf(s[qt][2 * kp + 1][0], s[qt][2 * kp + 1][1]), pack2bf(s[qt][2 * kp + 1][2], s[qt][2 * kp + 1][3])};
                pf[qt] = __builtin_bit_cast(bf16x8, w);
            }
#pragma unroll
            for (int qt = 0; qt < NQT; ++qt) st.lacc[qt] = __builtin_amdgcn_mfma_f32_16x16x32_bf16(ones, pf[qt], st.lacc[qt], 0, 0, 0);
#pragma unroll
            for (int dt = 0; dt < 4; ++dt) {
                const bf16x8 vf = *(const bf16x8*)(buf + 8192 + ((fo + dt * 2048) ^ (kp << 6)));
#pragma unroll
                for (int qt = 0; qt < NQT; ++qt) st.o[qt][dt] = __builtin_amdgcn_mfma_f32_16x16x32_bf16(vf, pf[qt], st.o[qt][dt], 0, 0, 0);
            }
        }
        if (kb1 < 0) break;
        if (kb2 >= 0) { asm volatile("s_waitcnt vmcnt(4)" ::: "memory"); } else { asm volatile("s_waitcnt vmcnt(0)" ::: "memory"); }
        ATT_BARRIER();
        kb = kb1; kb1 = kb2; slot = slot == 2 ? 0 : slot + 1;
    }
    ATT_BARRIER();
#undef ATT_DMA
}
template <int NQT>
DI void attn_init(AttnStateT<NQT>& st, float m0, float l0) {
#pragma unroll
    for (int qt = 0; qt < NQT; ++qt) { st.m[qt] = m0; st.lacc[qt] = (f32x4){l0, l0, l0, l0};
#pragma unroll
        for (int dt = 0; dt < 4; ++dt) st.o[qt][dt] = (f32x4){0.f, 0.f, 0.f, 0.f}; }
}
DI float attn_linv(const f32x4& lacc) { const float l = lacc[0]; return l > 0.f ? 1.0f / l : 0.f; }

template <int TT>
DI void attn_item_decode(int item, int& b, int& g, int& t0) {
    constexpr int tiles = T / TT;
    const int Gd = (int)gridDim.x;
    int pair, tile;
    if ((Gd % tiles) == 0 && tiles * B * G % Gd == 0) {
        const int bid = item % Gd, rr = item / Gd, tau = bid % tiles;
        pair = bid / tiles + (Gd / tiles) * rr; tile = (rr & 1) ? tiles - 1 - tau : tau;
    } else { tile = item % tiles; pair = item / tiles; }
    t0 = tile * TT; g = pair % G; b = pair / G;
}
DI void swa_item(const bf16* __restrict__ P0, const bf16* __restrict__ VT, const float* __restrict__ sinks, bf16* __restrict__ AO, int item, char* smem) {
    constexpr int LDP = 2304;
    constexpr int NQT = ANQT_SWA;
    int b, g, t0; attn_item_decode<16 * NQT>(item, b, g, t0);
    const int lane = TIDX & 63, wave = TIDX >> 6, q = lane >> 4, l15 = lane & 15;
    const size_t mbase = (size_t)b * T + t0; const int hbase = g * 4, h = hbase + (l15 & 3);
    bf16x8 qf[NQT][2]; attn_load_q<NQT>(qf, P0, LDP, mbase, hbase);
    AttnStateT<NQT> st; attn_init<NQT>(st, sinks[h] * at::L2E, 1.0f);
    const int lo = t0 - 127 < 0 ? 0 : (t0 - 127) >> 6, hi = (t0 + 16 * NQT - 1) >> 6;
    const unsigned long long nosel[NQT] = {};
    attn_blocks<AM_SWA, NQT>(st, qf, P0 + (size_t)b * T * LDP + 1024 + g * 64, LDP, VT + (size_t)(b * G + g) * 64 * T, T, t0, range_mask(lo, hi), hbase, nosel, smem);
#pragma unroll
    for (int qt = 0; qt < NQT; ++qt) {
        const float li = attn_linv(st.lacc[qt]); const size_t m = mbase + wave * (4 * NQT) + qt * 4 + (l15 >> 2);
#pragma unroll
        for (int dt = 0; dt < 4; ++dt) {
            const int d0 = dt * 16 + 4 * q; const u32x2 zz = *(const u32x2*)(P0 + m * LDP + 1280 + h * 64 + d0);
            const float z0 = bflo(zz[0]), z1 = bfhi(zz[0]), z2 = bflo(zz[1]), z3 = bfhi(zz[1]);
            const f32x4 o = st.o[qt][dt];
            *(u32x2*)(AO + m * D + h * 64 + d0) = (u32x2){pack2bf(o[0] * li * siluf_(z0), o[1] * li * siluf_(z1)), pack2bf(o[2] * li * siluf_(z2), o[3] * li * siluf_(z3))};
        }
    }
}

struct EpiL0 {
    bf16* P0; bf16* VT; const float* parts; mutable float rsc[4];
    DI void operator()(int m, int n, const float* v, int mt, int gi) const {
        if (gi == 0) rsc[mt] = rstd_from_parts(parts, m);
        float s = rsc[mt]; if (n < 1024) s *= 0.125f * at::L2E; float w[8];
#pragma unroll
        for (int j = 0; j < 8; ++j) w[j] = v[j] * s;
        if (n < 1280) store8bf(P0 + (size_t)m * 2304 + n, w);
        else if (n >= 1536) store8bf(P0 + (size_t)m * 2304 + n - 256, w);
        else {
            const int g = (n - 1280) >> 6, d = (n - 1280) & 63, b = m / T, t = m % T; const int pos = (t & ~31) + vt_perm(t & 31);
            bf16* dst = VT + ((size_t)(b * G + g) * 64 + d) * T + pos;
#pragma unroll
            for (int j = 0; j < 8; ++j) dst[(size_t)j * T] = f2bf(w[j]);
        }
    }
    DI void finish(int, int, int, int, int) const {}
    DI void finish_wide(int, int, int, int, int) const {}
};

constexpr int LDP2 = 3200;
struct EpiL2 {
    bf16* P2; bf16* VTs; bf16* VTw; const float* parts; mutable float rsc[4];
    DI void operator()(int m, int n, const float* v, int mt, int gi) const {
        if (gi == 0) rsc[mt] = rstd_from_parts(parts, m);
        if (n >= C_COLS) return;
        float s = rsc[mt]; if (n < 1024) s *= 0.125f * at::L2E; float w[8];
#pragma unroll
        for (int j = 0; j < 8; ++j) w[j] = v[j] * s;
        const bool isvs = n >= 1792 && n < 2048, isvw = n >= 2304 && n < 2560;
        if (isvs || isvw) {
            const int c = n - (isvs ? 1792 : 2304); const int g = c >> 6, d = c & 63, b = m / T, t = m % T; const int pos = (t & ~31) + vt_perm(t & 31);
            bf16* dst = (isvs ? VTs : VTw) + ((size_t)(b * G + g) * 64 + d) * T + pos;
#pragma unroll
            for (int j = 0; j < 8; ++j) dst[(size_t)j * T] = f2bf(w[j]);
        } else {
            const int c = n < 1792 ? n : (n < 2304 ? n - 256 : n - 512);
            store8bf(P2 + (size_t)m * LDP2 + c, w);
        }
    }
    DI void finish(int, int, int, int, int) const {}
    DI void finish_wide(int, int, int, int, int) const {}
};

struct ALoadCmp {
    const bf16* P2; int col;
    static constexpr bool DMA = true;
    DI const bf16* src(int row, int k) const {
        int n = row & 255; const int bg = row >> 8, b = bg >> 2, g = bg & 3; const int l = k >> 6, d = k & 63; n = n < NCMP ? n : NCMP - 1;
        return P2 + (size_t)(b * T + 16 * n + l) * LDP2 + col + g * 64 + d;
    }
    struct Raw { u32x4 v; };
    DI Raw load(int row, int k) const {
        const int n = row & 255, bg = row >> 8, b = bg >> 2, g = bg & 3; const int l = k >> 6, d = k & 63; Raw r;
        if (n < NCMP) r.v = *(const u32x4*)(P2 + (size_t)(b * T + 16 * n + l) * LDP2 + col + g * 64 + d); else r.v = (u32x4){0u, 0u, 0u, 0u};
        return r;
    }
    DI u32x4 finish(const Raw& r, int, int) const { return r.v; }
};
struct EpiCmpH {
    char* smem; const float* bias8;
    DI void operator()(int m, int n, const float* v, int, int) const {
        const int row = m & 127; float w[8];
#pragma unroll
        for (int j = 0; j < 8; ++j) { float bsum = 0.f;
#pragma unroll
            for (int i = 0; i < 8; ++i) bsum += bias8[i * 128 + n + j];
            w[j] = siluf_(v[j] + bsum); }
        const int kk = n >> 6, c = (n & 63) >> 3;
        *(u32x4*)(smem + kk * 16384 + row * 128 + ((c ^ (row & 7)) << 4)) = (u32x4){pack2bf(w[0], w[1]), pack2bf(w[2], w[3]), pack2bf(w[4], w[5]), pack2bf(w[6], w[7])};
    }
    DI void finish(int, int, int, int, int) const {}
    DI void finish_wide(int, int, int, int, int) const {}
};
DI void cmp_tile(const bf16* __restrict__ P2, const bf16* __restrict__ w1t, const float* __restrict__ bias8, const bf16* __restrict__ w2t, int which, int rt,
                 bf16* __restrict__ KCb, bf16* __restrict__ VCT, char* smem) {
    gemm_tile(ALoadCmp{P2, which ? 1280 : 1024}, w1t, 2048, rt * 128, 0, EpiCmpH{smem, bias8}, smem);
    const int tid = TIDX, lane = tid & 63, wave = tid >> 6, q = lane >> 4, l15 = lane & 15;
#pragma unroll
    for (int i = 0; i < 4; ++i) {
        const int id = i * 256 + tid; const int row = id >> 4, c16 = id & 15, kk = c16 >> 3, c = c16 & 7;
        *(u32x4*)(smem + 32768 + kk * 8192 + row * 128 + ((c ^ (row & 7)) << 4)) = *(const u32x4*)(w2t + (size_t)row * 128 + c16 * 8);
    }
    __syncthreads();
    f32x4 acc[2][4];
#pragma unroll
    for (int i = 0; i < 2; ++i)
#pragma unroll
        for (int j = 0; j < 4; ++j) acc[i][j] = (f32x4){0.f, 0.f, 0.f, 0.f};
    const int fo = l15 * 128 + ((q ^ (l15 & 7)) << 4);
#pragma unroll
    for (int kk = 0; kk < 2; ++kk)
#pragma unroll
        for (int ks = 0; ks < 2; ++ks) {
            bf16x8 hf[2], wf[4];
#pragma unroll
            for (int i = 0; i < 2; ++i) hf[i] = *(const bf16x8*)(smem + kk * 16384 + (((wave * 32 + i * 16) * 128 + fo) ^ (ks << 6)));
#pragma unroll
            for (int j = 0; j < 4; ++j) wf[j] = *(const bf16x8*)(smem + 32768 + kk * 8192 + ((j * 2048 + fo) ^ (ks << 6)));
#pragma unroll
            for (int i = 0; i < 2; ++i)
#pragma unroll
                for (int j = 0; j < 4; ++j) acc[i][j] = __builtin_amdgcn_mfma_f32_16x16x32_bf16(wf[j], hf[i], acc[i][j], 0, 0, 0);
        }
#pragma unroll
    for (int i = 0; i < 2; ++i) {
        const int row = rt * 128 + wave * 32 + i * 16 + l15; const int n = row & 255, bg = row >> 8;
#pragma unroll
        for (int j = 0; j < 4; ++j) {
            const int d0 = j * 16 + 4 * q; const f32x4 a = acc[i][j];
            if (which == 0) *(u32x2*)(KCb + (size_t)row * 64 + d0) = (u32x2){pack2bf(a[0], a[1]), pack2bf(a[2], a[3])};
            else {
                const int pos = (n & ~31) + vt_perm(n & 31);
#pragma unroll
                for (int r = 0; r < 4; ++r) VCT[((size_t)bg * 64 + d0 + r) * 256 + pos] = f2bf(a[r]);
            }
        }
    }
    __syncthreads();
}

DI void win_item(const bf16* __restrict__ P2, const bf16* __restrict__ VTw, bf16* __restrict__ OW, int item, char* smem) {
    constexpr int NQT = ANQT_WIN;
    int b, g, t0; attn_item_decode<16 * NQT>(item, b, g, t0);
    const int lane = TIDX & 63, wave = TIDX >> 6, q = lane >> 4, l15 = lane & 15;
    const size_t mbase = (size_t)b * T + t0; const int hbase = g * 4, h = hbase + (l15 & 3);
    bf16x8 qf[NQT][2]; attn_load_q<NQT>(qf, P2, LDP2, mbase, hbase);
    AttnStateT<NQT> st; attn_init<NQT>(st, at::M_INIT, 0.f);
    const int lo = t0 - 511 < 0 ? 0 : (t0 - 511) >> 6, hi = (t0 + 16 * NQT - 1) >> 6;
    const unsigned long long nosel[NQT] = {};
    attn_blocks<AM_WIN, NQT>(st, qf, P2 + (size_t)b * T * LDP2 + 1792 + g * 64, LDP2, VTw + (size_t)(b * G + g) * 64 * T, T, t0, range_mask(lo, hi), hbase, nosel, smem);
#pragma unroll
    for (int qt = 0; qt < NQT; ++qt) {
        const float li = attn_linv(st.lacc[qt]); const size_t m = mbase + wave * (4 * NQT) + qt * 4 + (l15 >> 2);
#pragma unroll
        for (int dt = 0; dt < 4; ++dt) { const f32x4 o = st.o[qt][dt]; *(u32x2*)(OW + m * D + h * 64 + dt * 16 + 4 * q) = (u32x2){pack2bf(o[0] * li, o[1] * li), pack2bf(o[2] * li, o[3] * li)}; }
    }
}

DI void cmpsel_item(const bf16* __restrict__ P2, const bf16* __restrict__ KCb, const bf16* __restrict__ VCT, bf16* __restrict__ OC, unsigned long long* __restrict__ SELM, int item, char* smem) {
    int b, g, t0; attn_item_decode<32>(item, b, g, t0);
    const int tid = TIDX, lane = tid & 63, wave = tid >> 6, q = lane >> 4, l15 = lane & 15;
    const size_t mbase = (size_t)b * T + t0; const int hbase = g * 4, h = hbase + (l15 & 3);
    float* impL = (float*)(smem + at::OFF_IMP);
    for (int i = tid; i < 32 * 64; i += NTHREADS) impL[i] = 0.f;
    bf16x8 qf[2][2]; attn_load_q<2>(qf, P2, LDP2, mbase, hbase);
    AttnStateT<2> st; attn_init<2>(st, at::M_INIT, 0.f);
    const int nvmax = (t0 + 31 - 31) / 16 + 1;
    const int hi = (nvmax - 1) >> 6;
    const bf16* Kp = KCb + (size_t)(b * G + g) * 256 * 64; const bf16* Vp = VCT + (size_t)(b * G + g) * 64 * 256;
    const unsigned long long nosel[2] = {0ull, 0ull};
    attn_blocks<AM_CMP, 2>(st, qf, Kp, 64, Vp, 256, t0, range_mask(0, hi), hbase, nosel, smem);
    float linv[2];
#pragma unroll
    for (int qt = 0; qt < 2; ++qt) {
        linv[qt] = attn_linv(st.lacc[qt]); const size_t m = mbase + wave * 8 + qt * 4 + (l15 >> 2);
#pragma unroll
        for (int dt = 0; dt < 4; ++dt) { const f32x4 o = st.o[qt][dt]; *(u32x2*)(OC + m * D + h * 64 + dt * 16 + 4 * q) = (u32x2){pack2bf(o[0] * linv[qt], o[1] * linv[qt]), pack2bf(o[2] * linv[qt], o[3] * linv[qt])}; }
    }
    {
        const int srow = tid >> 3, sc = tid & 7; const int st_off = srow * 128 + ((sc ^ (srow & 7)) << 4); const int fo = l15 * 128 + ((q ^ (l15 & 7)) << 4);
        const int tq0 = t0 + wave * 8 + (l15 >> 2);
        for (int kb = 0; kb <= hi; ++kb) {
#pragma unroll
            for (int i = 0; i < 2; ++i) { const int row = srow + 32 * i; *(u32x4*)(smem + st_off + i * 4096) = *(const u32x4*)(Kp + (size_t)(kb * 64 + row) * 64 + sc * 8); }
            __syncthreads();
            f32x4 s[2][4];
#pragma unroll
            for (int qt = 0; qt < 2; ++qt)
#pragma unroll
                for (int kt = 0; kt < 4; ++kt) s[qt][kt] = (f32x4){0.f, 0.f, 0.f, 0.f};
#pragma unroll
            for (int kt = 0; kt < 4; ++kt)
#pragma unroll
                for (int ks = 0; ks < 2; ++ks) {
                    const bf16x8 kf = *(const bf16x8*)(smem + ((fo + kt * 2048) ^ (ks << 6)));
                    s[0][kt] = __builtin_amdgcn_mfma_f32_16x16x32_bf16(kf, qf[0][ks], s[0][kt], 0, 0, 0);
                    s[1][kt] = __builtin_amdgcn_mfma_f32_16x16x32_bf16(kf, qf[1][ks], s[1][kt], 0, 0, 0);
                }
#pragma unroll
            for (int qt = 0; qt < 2; ++qt) {
                const int tq = tq0 + 4 * qt; const int tl = wave * 8 + qt * 4 + (l15 >> 2);
#pragma unroll
                for (int kt = 0; kt < 4; ++kt) {
                    float pr[4];
#pragma unroll
                    for (int r = 0; r < 4; ++r) { const int key = kb * 64 + kt * 16 + 4 * q + r; pr[r] = (16 * key + 31 <= tq) ? fast_exp2(s[qt][kt][r] - st.m[qt]) * linv[qt] : 0.f; }
                    float s4 = (pr[0] + pr[1]) + (pr[2] + pr[3]), s1 = pr[3];
                    s4 += __shfl_xor(s4, 1); s4 += __shfl_xor(s4, 2); s1 += __shfl_xor(s1, 1); s1 += __shfl_xor(s1, 2);
                    const int s0 = kb * 16 + kt * 4 + q;
                    if ((l15 & 3) == 0) { atomicAdd(&impL[tl * 64 + s0], s4); if (s0 + 1 < 64) atomicAdd(&impL[tl * 64 + s0 + 1], s1); }
                }
            }
            __syncthreads();
        }
    }
    {
        const int tl = tid >> 3, sg = tid & 7; const int t = t0 + tl, cur = t >> 6; float* row = impL + tl * 64;
        unsigned hk[8]; unsigned long long mine[8];
#pragma unroll
        for (int j = 0; j < 8; ++j) { const int s = sg * 8 + j; const float v = row[s];
            hk[j] = (s == 0 || s == cur || s == cur - 1) ? 0x7F800000u : (s * 64 > t ? 0u : (v > 0.f ? __float_as_uint(v) + 1u : 1u));
            mine[j] = ((unsigned long long)hk[j] << 32) | (unsigned)(63 - s); }
        __syncthreads();
#pragma unroll
        for (int j = 0; j < 8; ++j) ((unsigned*)row)[sg * 8 + j] = hk[j];
        __syncthreads();
        int rank[8] = {0, 0, 0, 0, 0, 0, 0, 0};
        const int ns4 = ((((t0 + 31) >> 6) >> 2) + 2) & ~1;
#pragma unroll 2
        for (int s4 = 0; s4 < ns4; ++s4) {
            const u32x4 v4 = *(const u32x4*)(row + s4 * 4);
#pragma unroll
            for (int e = 0; e < 4; ++e) { const unsigned long long kv = ((unsigned long long)v4[e] << 32) | (unsigned)(63 - (s4 * 4 + e));
#pragma unroll
                for (int j = 0; j < 8; ++j) rank[j] += kv > mine[j] ? 1 : 0; }
        }
        unsigned long long bits = 0ull;
#pragma unroll
        for (int j = 0; j < 8; ++j) if (rank[j] < KTOP && (sg * 8 + j) * 64 <= t) bits |= 1ull << (sg * 8 + j);
        unsigned lo = (unsigned)bits, hi2 = (unsigned)(bits >> 32);
#pragma unroll
        for (int o = 1; o < 8; o <<= 1) { lo |= __shfl_xor(lo, o); hi2 |= __shfl_xor(hi2, o); }
        if (sg == 0) SELM[(mbase + tl) * 4 + g] = ((unsigned long long)hi2 << 32) | lo;
    }
    __syncthreads();
}

DI void sel_item(const bf16* __restrict__ P2, const bf16* __restrict__ VTs, const unsigned long long* __restrict__ SELM, const bf16* __restrict__ OC, const bf16* __restrict__ OW,
                 bf16* __restrict__ AO, int item, char* smem) {
    constexpr int NQT = ANQT_SEL;
    int b, g, t0; attn_item_decode<16 * NQT>(item, b, g, t0);
    const int tid = TIDX, lane = tid & 63, wave = tid >> 6, q = lane >> 4, l15 = lane & 15;
    const size_t mbase = (size_t)b * T + t0; const int hbase = g * 4, rr = l15 & 3, h = hbase + rr;
    unsigned long long* orw = (unsigned long long*)(smem + at::OFF_X);
    if (tid == 0) *orw = 0ull;
    __syncthreads();
    if (tid < 16 * NQT) atomicOr(orw, SELM[(mbase + tid) * 4 + g]);
    unsigned long long sel[NQT];
#pragma unroll
    for (int qt = 0; qt < NQT; ++qt) sel[qt] = SELM[(mbase + wave * (4 * NQT) + qt * 4 + (l15 >> 2)) * 4 + g];
    bf16x8 qf[NQT][2]; attn_load_q<NQT>(qf, P2, LDP2, mbase, hbase);
    AttnStateT<NQT> st; attn_init<NQT>(st, at::M_INIT, 0.f);
    __syncthreads();
    const unsigned long long todo_v = (*orw) & range_mask(0, (t0 + 16 * NQT - 1) >> 6);
    const unsigned long long todo = ((unsigned long long)(unsigned)__builtin_amdgcn_readfirstlane((int)(todo_v >> 32)) << 32) | (unsigned)__builtin_amdgcn_readfirstlane((int)(unsigned)todo_v);
    attn_blocks<AM_SEL, NQT>(st, qf, P2 + (size_t)b * T * LDP2 + 1536 + g * 64, LDP2, VTs + (size_t)(b * G + g) * 64 * T, T, t0, todo, hbase, sel, smem);
#pragma unroll
    for (int qt = 0; qt < NQT; ++qt) {
        const float li = attn_linv(st.lacc[qt]); const size_t m = mbase + wave * (4 * NQT) + qt * 4 + (l15 >> 2);
        const bf16* gr = P2 + m * LDP2 + 3072;
        const float g0 = sigmoidf_(bf2f(gr[0 * 16 + h])), g1 = sigmoidf_(bf2f(gr[1 * 16 + h])), g2 = sigmoidf_(bf2f(gr[2 * 16 + h]));
#pragma unroll
        for (int dt = 0; dt < 4; ++dt) {
            const int d0 = dt * 16 + 4 * q; const size_t oi = m * D + h * 64 + d0;
            const u32x2 zz = *(const u32x2*)(P2 + m * LDP2 + 2048 + h * 64 + d0), cc = *(const u32x2*)(OC + oi), ww = *(const u32x2*)(OW + oi);
            const f32x4 o = st.o[qt][dt];
            const float r0 = (g0 * bflo(cc[0]) + g1 * o[0] * li + g2 * bflo(ww[0])) * siluf_(bflo(zz[0]));
            const float r1 = (g0 * bfhi(cc[0]) + g1 * o[1] * li + g2 * bfhi(ww[0])) * siluf_(bfhi(zz[0]));
            const float r2 = (g0 * bflo(cc[1]) + g1 * o[2] * li + g2 * bflo(ww[1])) * siluf_(bflo(zz[1]));
            const float r3 = (g0 * bfhi(cc[1]) + g1 * o[3] * li + g2 * bfhi(ww[1])) * siluf_(bfhi(zz[1]));
            *(u32x2*)(AO + oi) = (u32x2){pack2bf(r0, r1), pack2bf(r2, r3)};
        }
    }
    __syncthreads();
}

DI void lru_convert_gates(const float* __restrict__ gaw, const float* __restrict__ gxw, bf16* __restrict__ img) {
    for (int i = blockIdx.x * NTHREADS + TIDX; i < 16 * 160 * 96; i += gridDim.x * NTHREADS) {
        const int k = i % 96, n = (i / 96) % 160, blk = i / (96 * 160);
        float v = 0.f;
        if (k < 80) v = n < 80 ? gaw[((size_t)blk * 80 + k) * 80 + n] : gxw[((size_t)blk * 80 + k) * 80 + (n - 80)];
        img[i] = f2bf(v);
    }
}
DI void lru_gate_item(const bf16* __restrict__ P3, const float* __restrict__ cw, const float* __restrict__ cb, const bf16* __restrict__ gimg, const float* __restrict__ gab, const float* __restrict__ gxb,
                      const float* __restrict__ lam, bf16* __restrict__ LA, bf16* __restrict__ BV, float2* __restrict__ SUM, int item, char* smem) {
    const int rt = item >> 4, nb = item & 15; const int tid = TIDX, lane = tid & 63, wave = tid >> 6, q = lane >> 4, l15 = lane & 15;
    const size_t m0 = (size_t)rt * 128;
    for (int id = tid; id < 128 * 12; id += NTHREADS) {
        const int row = id / 12, c12 = id % 12; u32x4 outv = (u32x4){0u, 0u, 0u, 0u};
        if (c12 < 10) {
            const size_t m = m0 + row; const int t = (int)(m % T); const int ch = nb * 80 + c12 * 8;
            float acc[8];
            { const float4 b0 = *(const float4*)(cb + ch), b1 = *(const float4*)(cb + ch + 4); acc[0] = b0.x; acc[1] = b0.y; acc[2] = b0.z; acc[3] = b0.w; acc[4] = b1.x; acc[5] = b1.y; acc[6] = b1.z; acc[7] = b1.w; }
#pragma unroll
            for (int w = 0; w < 4; ++w) {
                if (t - 3 + w >= 0) {
                    const u32x4 uv = *(const u32x4*)(P3 + (m - 3 + w) * 2560 + ch);
                    const float4 w0 = *(const float4*)(cw + w * LW + ch), w1 = *(const float4*)(cw + w * LW + ch + 4);
                    acc[0] += w0.x * bflo(uv[0]); acc[1] += w0.y * bfhi(uv[0]); acc[2] += w0.z * bflo(uv[1]); acc[3] += w0.w * bfhi(uv[1]);
                    acc[4] += w1.x * bflo(uv[2]); acc[5] += w1.y * bfhi(uv[2]); acc[6] += w1.z * bflo(uv[3]); acc[7] += w1.w * bfhi(uv[3]);
                }
            }
            outv = (u32x4){pack2bf(acc[0], acc[1]), pack2bf(acc[2], acc[3]), pack2bf(acc[4], acc[5]), pack2bf(acc[6], acc[7])};
        }
        const int ks = c12 >> 2, c = c12 & 3;
        *(u32x4*)(smem + ks * 8192 + row * 64 + ((c ^ ((row >> 2) & 3)) << 4)) = outv;
    }
    for (int id = tid; id < 160 * 12; id += NTHREADS) {
        const int row = id / 12, c12 = id % 12; const int ks = c12 >> 2, c = c12 & 3;
        *(u32x4*)(smem + 24576 + ks * 10240 + row * 64 + ((c ^ ((row >> 2) & 3)) << 4)) = *(const u32x4*)(gimg + ((size_t)nb * 160 + row) * 96 + c12 * 8);
    }
    __syncthreads();
    f32x4 acc[2][10];
#pragma unroll
    for (int i = 0; i < 2; ++i)
#pragma unroll
        for (int j = 0; j < 10; ++j) acc[i][j] = (f32x4){0.f, 0.f, 0.f, 0.f};
    const int fo = l15 * 64 + ((q ^ ((l15 >> 2) & 3)) << 4);
#pragma unroll
    for (int ks = 0; ks < 3; ++ks) {
        bf16x8 uf[2];
#pragma unroll
        for (int i = 0; i < 2; ++i) uf[i] = *(const bf16x8*)(smem + ks * 8192 + (wave * 32 + i * 16) * 64 + fo);
#pragma unroll
        for (int j = 0; j < 10; ++j) {
            const bf16x8 wf = *(const bf16x8*)(smem + 24576 + ks * 10240 + j * 1024 + fo);
            acc[0][j] = __builtin_amdgcn_mfma_f32_16x16x32_bf16(wf, uf[0], acc[0][j], 0, 0, 0);
            acc[1][j] = __builtin_amdgcn_mfma_f32_16x16x32_bf16(wf, uf[1], acc[1][j], 0, 0, 0);
        }
    }
    __syncthreads();
#pragma unroll
    for (int i = 0; i < 2; ++i) {
        const int row = wave * 32 + i * 16 + l15; const size_t m = m0 + row;
#pragma unroll
        for (int ct = 0; ct < 5; ++ct) {
            const int kcol = ct * 16 + 4 * q; const int ch = nb * 80 + kcol;
            const u32x2 uu = *(const u32x2*)(smem + (kcol >> 5) * 8192 + row * 64 + ((((kcol & 31) >> 3) ^ ((row >> 2) & 3)) << 4) + (kcol & 7) * 2);
            const float uc[4] = {bflo(uu[0]), bfhi(uu[0]), bflo(uu[1]), bfhi(uu[1])};
            const float4 ba = *(const float4*)(gab + ch), bx = *(const float4*)(gxb + ch), lm = *(const float4*)(lam + ch);
            const float bav[4] = {ba.x, ba.y, ba.z, ba.w}, bxv[4] = {bx.x, bx.y, bx.z, bx.w}, lmv[4] = {lm.x, lm.y, lm.z, lm.w};
            float la[4], bv[4];
#pragma unroll
            for (int r = 0; r < 4; ++r) {
                const float rg = __builtin_amdgcn_rcpf(1.0f + __expf(-(acc[i][ct][r] + bav[r]))), ig = __builtin_amdgcn_rcpf(1.0f + __expf(-(acc[i][ct + 5][r] + bxv[r])));
                la[r] = rg * lmv[r];
                const float om = 1.0f - __expf(2.0f * la[r]);
                bv[r] = __builtin_amdgcn_sqrtf(om > 0.f ? om : 0.f) * (ig * uc[r]);
            }
            const u32x2 lav = {pack2bf(la[0], la[1]), pack2bf(la[2], la[3])}, bvv = {pack2bf(bv[0], bv[1]), pack2bf(bv[2], bv[3])};
            *(u32x2*)(LA + m * LW + ch) = lav; *(u32x2*)(BV + m * LW + ch) = bvv;
            *(u32x2*)(smem + 24576 + (row * 80 + kcol) * 2) = lav; *(u32x2*)(smem + 24576 + 20480 + (row * 80 + kcol) * 2) = bvv;
        }
    }
    __syncthreads();
    if (tid < 160) {
        const int cidx = tid / 80, c = tid % 80; const bf16* li = (const bf16*)(smem + 24576) + (cidx * 64) * 80 + c; const bf16* bi = li + 10240;
        float sla = 0.f, h = 0.f;
#pragma unroll 8
        for (int t = 0; t < 64; ++t) { const float la = bf2f(li[t * 80]), bvv = bf2f(bi[t * 80]); h = __expf(la) * h + bvv; sla += la; }
        const size_t mc = m0 + cidx * 64; const int bb = (int)(mc / T), jj = (int)(mc % T) / 64;
        SUM[((size_t)bb * (T / 64) + jj) * LW + nb * 80 + c] = make_float2(__expf(sla), h);
    }
    __syncthreads();
}
DI void lru_scan2_item(const bf16* __restrict__ LA, const bf16* __restrict__ BV, const float2* __restrict__ SUM, const bf16* __restrict__ P3, bf16* __restrict__ AO, int item) {
    const int cg = item % 5, j = (item / 5) % (T / 64), b = item / (5 * (T / 64)); const int c = cg * 256 + TIDX;
    float h = 0.f;
    for (int jj = 0; jj < j; ++jj) { const float2 s = SUM[((size_t)b * (T / 64) + jj) * LW + c]; h = s.x * h + s.y; }
    const size_t m0 = (size_t)b * T + j * 64;
#pragma unroll 8
    for (int t = 0; t < 64; ++t) {
        const float la = bf2f(LA[(m0 + t) * LW + c]); const float bv = bf2f(BV[(m0 + t) * LW + c]); const float z = bf2f(P3[(m0 + t) * 2560 + LW + c]);
        h = __expf(la) * h + bv; AO[(m0 + t) * LW + c] = f2bf(h * siluf_(z));
    }
}

struct ALoadF32 {
    const float* A;
    static constexpr bool DMA = false;
    DI const bf16* src(int, int) const { return nullptr; }
    struct Raw { float4 a, b; };
    DI Raw load(int m, int k) const { Raw r; r.a = *(const float4*)(A + (size_t)m * 64 + k); r.b = *(const float4*)(A + (size_t)m * 64 + k + 4); return r; }
    DI u32x4 finish(const Raw& r, int, int) const { return (u32x4){pack2bf(r.a.x, r.a.y), pack2bf(r.a.z, r.a.w), pack2bf(r.b.x, r.b.y), pack2bf(r.b.z, r.b.w)}; }
};
struct EpiLora {
    const float* w0; const float* a0; bf16* WL; bf16* AV;
    DI void operator()(int m, int n, const float* v, int, int) const {
        float w[8];
        if (n < 1024) {
#pragma unroll
            for (int j = 0; j < 8; ++j) w[j] = -0.60653065971f * __builtin_amdgcn_rcpf(1.0f + __expf(-(w0[n + j] + v[j])));
            store8bf(WL + (size_t)m * D + n, w);
        } else {
#pragma unroll
            for (int j = 0; j < 8; ++j) w[j] = __builtin_amdgcn_rcpf(1.0f + __expf(-(a0[n - 1024 + j] + v[j])));
            store8bf(AV + (size_t)m * D + n - 1024, w);
        }
    }
    DI void finish(int, int, int, int, int) const {}
    DI void finish_wide(int, int, int, int, int) const {}
};
DI float dpp_sum16(float x) {
    x += __builtin_bit_cast(float, __builtin_amdgcn_update_dpp(0, __builtin_bit_cast(int, x), 0xB1, 0xf, 0xf, false));
    x += __builtin_bit_cast(float, __builtin_amdgcn_update_dpp(0, __builtin_bit_cast(int, x), 0x4E, 0xf, 0xf, false));
    x += __builtin_bit_cast(float, __builtin_amdgcn_update_dpp(0, __builtin_bit_cast(int, x), 0x141, 0xf, 0xf, false));
    x += __builtin_bit_cast(float, __builtin_amdgcn_update_dpp(0, __builtin_bit_cast(int, x), 0x140, 0xf, 0xf, false));
    return x;
}
constexpr int RW_NCH = T / 16;
DI void rwkv_prep_item(bf16* __restrict__ P, bf16* __restrict__ WL, bf16* __restrict__ AV, const float* __restrict__ k_k, const float* __restrict__ k_a, const float* __restrict__ r_k,
                       float* __restrict__ G15, bf16* __restrict__ M2g, bf16* __restrict__ M3g, float* __restrict__ BON, int item, char* smem) {
    const int c = item % RW_NCH, h = (item / RW_NCH) & 15, b = item / (RW_NCH * 16);
    const int tid = TIDX, t = tid >> 4, jq = tid & 15, j0 = jq * 4;
    const size_t m0 = (size_t)b * T + c * 16, m = m0 + t; const size_t ch = (size_t)(b * 16 + h) * RW_NCH + c;
    float* sA = (float*)smem; float* sR = sA + 16 * 68; float* sB = sR + 16 * 68; float* sK = sB + 16 * 68; float* sW = sK + 16 * 68; float* sWl = sW + 16 * 68;
    float* mAab = sWl + 16 * 64; float* mAak = mAab + 16 * 17; float* mArb = mAak + 16 * 17; float* mArk = mArb + 16 * 17; float* mTin = mArk + 16 * 17; float* mM2 = mTin + 16 * 17;
    const u32x2 r2 = *(const u32x2*)(P + m * 4096 + h * 64 + j0), k2 = *(const u32x2*)(P + m * 4096 + 1024 + h * 64 + j0), a2 = *(const u32x2*)(AV + m * D + h * 64 + j0), w2 = *(const u32x2*)(WL + m * D + h * 64 + j0);
    const float rr[4] = {bflo(r2[0]), bfhi(r2[0]), bflo(r2[1]), bfhi(r2[1])}, kr[4] = {bflo(k2[0]), bfhi(k2[0]), bflo(k2[1]), bfhi(k2[1])},
                av[4] = {bflo(a2[0]), bfhi(a2[0]), bflo(a2[1]), bfhi(a2[1])}, wl[4] = {bflo(w2[0]), bfhi(w2[0]), bflo(w2[1]), bfhi(w2[1])};
    const float4 kk4 = *(const float4*)(k_k + h * 64 + j0), ka4 = *(const float4*)(k_a + h * 64 + j0), rk4 = *(const float4*)(r_k + h * 64 + j0);
    const float kkc[4] = {kk4.x, kk4.y, kk4.z, kk4.w}, kac[4] = {ka4.x, ka4.y, ka4.z, ka4.w}, rkc[4] = {rk4.x, rk4.y, rk4.z, rk4.w};
    float kkv[4], n2 = 0.f;
#pragma unroll
    for (int e = 0; e < 4; ++e) { kkv[e] = kr[e] * kkc[e]; n2 += kkv[e] * kkv[e]; }
    n2 = dpp_sum16(n2);
    float nr = sqrtf(n2); nr = nr > 1e-12f ? nr : 1e-12f; const float inr = 1.0f / nr;
    float aa[4], bb[4], kp[4], bon = 0.f;
#pragma unroll
    for (int e = 0; e < 4; ++e) { const float kn = kkv[e] * inr; aa[e] = -kn; bb[e] = kn * av[e]; kp[e] = kr[e] * (1.0f + (av[e] - 1.0f) * kac[e]); bon += rr[e] * kp[e] * rkc[e]; }
    bon = dpp_sum16(bon);
    if (jq == 0) BON[m * 16 + h] = bon;
    *(float4*)(sWl + t * 64 + j0) = make_float4(wl[0], wl[1], wl[2], wl[3]);
    __syncthreads();
    float clx[4] = {0.f, 0.f, 0.f, 0.f};
#pragma unroll
    for (int s = 0; s < 15; ++s) { if (s < t) { const float4 w = *(const float4*)(sWl + s * 64 + j0); clx[0] += w.x; clx[1] += w.y; clx[2] += w.z; clx[3] += w.w; } }
    float bt[4];
    {
        float va[4], vr[4], vk[4], gc[4];
#pragma unroll
        for (int e = 0; e < 4; ++e) { const float cl = clx[e] + wl[e]; const float gp = __expf(clx[e]), gi = __expf(-cl); gc[e] = __expf(cl); va[e] = aa[e] * gp; vr[e] = rr[e] * gc[e]; bt[e] = bb[e] * gi; vk[e] = kp[e] * gi; }
        *(float4*)(sA + t * 68 + j0) = make_float4(va[0], va[1], va[2], va[3]); *(float4*)(sR + t * 68 + j0) = make_float4(vr[0], vr[1], vr[2], vr[3]);
        *(float4*)(sB + t * 68 + j0) = make_float4(bt[0], bt[1], bt[2], bt[3]); *(float4*)(sK + t * 68 + j0) = make_float4(vk[0], vk[1], vk[2], vk[3]);
        {
            char* img = (char*)(mM2 + 16 * 17) + t * 128 + (((j0 >> 3) ^ (t & 7)) << 4) + (j0 & 4) * 2;
            *(u32x2*)(img) = (u32x2){pack2bf(va[0], va[1]), pack2bf(va[2], va[3])}; *(u32x2*)(img + 2048) = (u32x2){pack2bf(vr[0], vr[1]), pack2bf(vr[2], vr[3])};
            *(u32x2*)(img + 4096) = (u32x2){pack2bf(bt[0], bt[1]), pack2bf(bt[2], bt[3])}; *(u32x2*)(img + 6144) = (u32x2){pack2bf(vk[0], vk[1]), pack2bf(vk[2], vk[3])};
        }
        if (t == 15) *(float4*)(G15 + ch * 64 + j0) = make_float4(gc[0], gc[1], gc[2], gc[3]);
#pragma unroll
        for (int e = 0; e < 4; ++e) {   }
#pragma unroll
        for (int e = 0; e < 4; ++e) clx[e] = vk[e];
    }
    __syncthreads();
    {
        const int wv = __builtin_amdgcn_readfirstlane(tid >> 6), lane = tid & 63, q = lane >> 4, l15 = lane & 15;
        const char* xb_ = (const char*)(mM2 + 16 * 17) + (wv >> 1) * 2048;
        const char* yb_ = (const char*)(mM2 + 16 * 17) + 4096 + (wv & 1) * 2048;
        f32x4 acc = {0.f, 0.f, 0.f, 0.f};
#pragma unroll
        for (int ks = 0; ks < 2; ++ks) {
            const int off = l15 * 128 + (((ks * 4 + q) ^ (l15 & 7)) << 4);
            const bf16x8 xf = *(const bf16x8*)(xb_ + off), yf = *(const bf16x8*)(yb_ + off);
            acc = __builtin_amdgcn_mfma_f32_16x16x32_bf16(xf, yf, acc, 0, 0, 0);
        }
        float* dst = wv == 0 ? mAab : (wv == 1 ? mAak : (wv == 2 ? mArb : mArk));
        const bool strict = wv < 2;
#pragma unroll
        for (int r = 0; r < 4; ++r) { const int tt = 4 * q + r, ss = l15; dst[tt * 17 + ss] = (strict ? ss < tt : ss <= tt) ? acc[r] : 0.f; }
    }
    __syncthreads();
    if (tid < 16) {
        float col[16];
#pragma unroll
        for (int i = 0; i < 16; ++i) {
            float acc = (i == tid) ? 1.0f : 0.f;
#pragma unroll
            for (int jj = 0; jj < i; ++jj) acc += mAab[i * 17 + jj] * col[jj];
            col[i] = acc; mTin[i * 17 + tid] = acc;
        }
    }
    __syncthreads();
    float wv[4] = {0.f, 0.f, 0.f, 0.f}, m2 = 0.f;
#pragma unroll
    for (int s = 0; s < 16; ++s) { const float ti = mTin[t * 17 + s]; const float4 a4 = *(const float4*)(sA + s * 68 + j0); wv[0] += ti * a4.x; wv[1] += ti * a4.y; wv[2] += ti * a4.z; wv[3] += ti * a4.w; m2 += ti * mAak[s * 17 + jq]; }
    *(float4*)(sW + t * 68 + j0) = make_float4(wv[0], wv[1], wv[2], wv[3]); mM2[t * 17 + jq] = m2;
    __syncthreads();
    float rh[4]; { const float4 r4 = *(const float4*)(sR + t * 68 + j0); rh[0] = r4.x; rh[1] = r4.y; rh[2] = r4.z; rh[3] = r4.w; }
    float m3 = mArk[t * 17 + jq];
#pragma unroll
    for (int s = 0; s < 16; ++s) { const float ar = mArb[t * 17 + s]; const float4 w4 = *(const float4*)(sW + s * 68 + j0); rh[0] += ar * w4.x; rh[1] += ar * w4.y; rh[2] += ar * w4.z; rh[3] += ar * w4.w; m3 += ar * mM2[s * 17 + jq]; }
    *(u32x2*)(WL + m * D + h * 64 + j0) = (u32x2){pack2bf(wv[0], wv[1]), pack2bf(wv[2], wv[3])};
    *(u32x2*)(P + m * 4096 + h * 64 + j0) = (u32x2){pack2bf(rh[0], rh[1]), pack2bf(rh[2], rh[3])};
#pragma unroll
    for (int e = 0; e < 4; ++e) { AV[(m0 + jq) * D + h * 64 + e * 16 + t] = f2bf(bt[e]); P[(m0 + jq) * 4096 + 1024 + h * 64 + e * 16 + t] = f2bf(clx[e]); }
    M2g[ch * 256 + t * 16 + jq] = f2bf(m2); M3g[ch * 256 + t * 16 + jq] = f2bf(m3);
    __syncthreads();
}

#define MFMA32(a, b, c) __builtin_amdgcn_mfma_f32_16x16x32_bf16(__builtin_bit_cast(bf16x8, a), __builtin_bit_cast(bf16x8, b), c, 0, 0, 0)
DI void rwkv_chunk_scan(const bf16* __restrict__ P, const bf16* __restrict__ WL, const bf16* __restrict__ AV, const float* __restrict__ G15, const bf16* __restrict__ M2g, const bf16* __restrict__ M3g,
                        bf16* __restrict__ YS, int bh, char* smem) {
    constexpr int SLOT = 12288, YOFF = 49152;
    const int tid = TIDX, lane = tid & 63, vs = __builtin_amdgcn_readfirstlane(tid >> 6), q = lane >> 4, l15 = lane & 15; const int b = bh >> 4, h = bh & 15;
    const size_t mb = (size_t)b * T; const size_t ch0 = (size_t)(b * 16 + h) * RW_NCH;
    const char *s0, *s1, *s2; size_t d0, d1, d2;
    if (tid < 128) { const int c8 = tid >> 4, t = tid & 15; s0 = (const char*)(WL + (mb + t) * D + h * 64 + c8 * 8); d0 = (size_t)16 * D * 2; }
    else { const int pp = tid - 128, c8 = pp >> 4, t = pp & 15; s0 = (const char*)(P + (mb + t) * 4096 + h * 64 + c8 * 8); d0 = (size_t)16 * 4096 * 2; }
    if (tid < 128) { const int r = tid >> 3, c8 = tid & 7; s1 = (const char*)(P + (mb + r) * 4096 + 1024 + h * 64 + c8 * 8); d1 = (size_t)16 * 4096 * 2; }
    else { const int pp = tid - 128, r = pp >> 3, c8 = pp & 7; s1 = (const char*)(AV + (mb + r) * D + h * 64 + c8 * 8); d1 = (size_t)16 * D * 2; }
    if (tid < 128) { const int r = tid >> 3, c8 = tid & 7; s2 = (const char*)(P + (mb + r) * 4096 + 2048 + h * 64 + c8 * 8); d2 = (size_t)16 * 4096 * 2; }
    else if (tid < 160) { s2 = (const char*)(M2g + ch0 * 256 + (tid - 128) * 8); d2 = 512; }
    else if (tid < 192) { s2 = (const char*)(M3g + ch0 * 256 + (tid - 160) * 8); d2 = 512; }
    else { const int pp = tid < 208 ? tid - 192 : 0; s2 = (const char*)(G15 + ch0 * 64 + pp * 4); d2 = 256; }
    const int dma_off = vs * 1024;
#define RW_DMA(c_) { char* dst = smem + ((c_) & 3) * SLOT + dma_off; GLDS16(s0 + (size_t)(c_) * d0, dst); GLDS16(s1 + (size_t)(c_) * d1, dst + 4096); GLDS16(s2 + (size_t)(c_) * d2, dst + 8192); }
#define RW_BARRIER() { asm volatile("s_waitcnt lgkmcnt(0)" ::: "memory"); __builtin_amdgcn_s_barrier(); asm volatile("" ::: "memory"); }
    f32x4 H0 = {0.f, 0.f, 0.f, 0.f}, H1 = H0, H2 = H0, H3 = H0;
    const int oW = (((q >> 1)) * 16 + l15) * 16 + (q & 1) * 8;
    const int oK = 4096 + ((l15 >> 2) * 8 + (l15 & 3) * 2 + (q >> 1)) * 16 + (q & 1) * 8;
    const int oM = 10240 + l15 * 32 + q * 8;
    const int oV = 8192 + (4 * q) * 128 + (vs * 16 + l15) * 2;
    const int oG = 11264 + (4 * q) * 4;
    const int oY = YOFF + ((4 * q) * 64 + vs * 16 + l15) * 2;
    RW_DMA(0); RW_DMA(1); RW_DMA(2);
    asm volatile("s_waitcnt vmcnt(6)" ::: "memory");
    RW_BARRIER();
    for (int c = 0; c < RW_NCH; ++c) {
        if (c + 3 < RW_NCH) RW_DMA(c + 3);
        const char* sl = smem + (c & 3) * SLOT;
        {
            const f32x4 z4 = {0.f, 0.f, 0.f, 0.f};
            const u32x4 Hb0 = {pack2bf(H0[0], H0[1]), pack2bf(H0[2], H0[3]), pack2bf(H1[0], H1[1]), pack2bf(H1[2], H1[3])};
            const u32x4 Hb1 = {pack2bf(H2[0], H2[1]), pack2bf(H2[2], H2[3]), pack2bf(H3[0], H3[1]), pack2bf(H3[2], H3[3])};
            const unsigned v0 = *(const bf16*)(sl + oV), v1 = *(const bf16*)(sl + oV + 128), v2 = *(const bf16*)(sl + oV + 256), v3 = *(const bf16*)(sl + oV + 384);
            const unsigned v01 = v0 | (v1 << 16), v23 = v2 | (v3 << 16);
            const u32x4 Vlo = {v01, v23, 0u, 0u};
            const u32x2 m2 = *(const u32x2*)(sl + oM), m3 = *(const u32x2*)(sl + oM + 512);
            const u32x2 w0 = *(const u32x2*)(sl + oW), w1 = *(const u32x2*)(sl + oW + 512), w2 = *(const u32x2*)(sl + oW + 1024), w3 = *(const u32x2*)(sl + oW + 1536);
            const u32x2 r0 = *(const u32x2*)(sl + 2048 + oW), r1 = *(const u32x2*)(sl + 2048 + oW + 512), r2 = *(const u32x2*)(sl + 2048 + oW + 1024), r3 = *(const u32x2*)(sl + 2048 + oW + 1536);
            f32x4 U = MFMA32(((u32x4){m2[0], m2[1], 0u, 0u}), Vlo, z4);
            U = MFMA32(((u32x4){w0[0], w0[1], w1[0], w1[1]}), Hb0, U); U = MFMA32(((u32x4){w2[0], w2[1], w3[0], w3[1]}), Hb1, U);
            f32x4 Y = MFMA32(((u32x4){m3[0], m3[1], 0u, 0u}), Vlo, z4);
            Y = MFMA32(((u32x4){r0[0], r0[1], r1[0], r1[1]}), Hb0, Y); Y = MFMA32(((u32x4){r2[0], r2[1], r3[0], r3[1]}), Hb1, Y);
            const u32x4 VU = {v01, v23, pack2bf(U[0], U[1]), pack2bf(U[2], U[3])};
            const u32x2 k0 = *(const u32x2*)(sl + oK), k1 = *(const u32x2*)(sl + oK + 512), k2 = *(const u32x2*)(sl + oK + 1024), k3 = *(const u32x2*)(sl + oK + 1536);
            const u32x2 b0 = *(const u32x2*)(sl + 2048 + oK), b1 = *(const u32x2*)(sl + 2048 + oK + 512), b2 = *(const u32x2*)(sl + 2048 + oK + 1024), b3 = *(const u32x2*)(sl + 2048 + oK + 1536);
            const f32x4 g0 = *(const f32x4*)(sl + oG), g1 = *(const f32x4*)(sl + oG + 64), g2 = *(const f32x4*)(sl + oG + 128), g3 = *(const f32x4*)(sl + oG + 192);
            const f32x4 a0 = MFMA32(((u32x4){k0[0], k0[1], b0[0], b0[1]}), VU, H0), a1 = MFMA32(((u32x4){k1[0], k1[1], b1[0], b1[1]}), VU, H1);
            const f32x4 a2 = MFMA32(((u32x4){k2[0], k2[1], b2[0], b2[1]}), VU, H2), a3 = MFMA32(((u32x4){k3[0], k3[1], b3[0], b3[1]}), VU, H3);
            H0 = a0 * g0; H1 = a1 * g1; H2 = a2 * g2; H3 = a3 * g3;
            char* yb = smem + oY + (c & 7) * 2048;
#pragma unroll
            for (int r = 0; r < 4; ++r) *(bf16*)(yb + r * 128) = f2bf(Y[r]);
        }
        const bool flush = (c & 7) == 7;
        if (flush) {
            RW_BARRIER();
            u32x4 yv[4];
#pragma unroll
            for (int k = 0; k < 4; ++k) yv[k] = *(const u32x4*)(smem + YOFF + (tid + 256 * k) * 16);
#pragma unroll
            for (int k = 0; k < 4; ++k) { const int pc = tid + 256 * k, rr = pc >> 3, c8 = pc & 7; *(u32x4*)(YS + (mb + (size_t)(c - 7) * 16 + rr) * D + h * 64 + c8 * 8) = yv[k]; }
            asm volatile("s_waitcnt vmcnt(0)" ::: "memory");
        } else if (c + 3 < RW_NCH) { asm volatile("s_waitcnt vmcnt(6)" ::: "memory"); }
        else if (c + 2 < RW_NCH) { asm volatile("s_waitcnt vmcnt(3)" ::: "memory"); }
        else { asm volatile("s_waitcnt vmcnt(0)" ::: "memory"); }
        RW_BARRIER();
    }
#undef RW_DMA
#undef RW_BARRIER
}
DI void rwkv_gn_rows2(const bf16* __restrict__ P, const float* __restrict__ BON, const float* __restrict__ lnw, const float* __restrict__ lnb, bf16* __restrict__ YS) {
    const int tid = TIDX, lane = tid & 63, wave = tid >> 6; const int c = wave * 256 + lane * 4;
    const float4 lw = *(const float4*)(lnw + c), lb = *(const float4*)(lnb + c);
    for (size_t m = blockIdx.x; m < (size_t)M; m += gridDim.x) {
        const u32x2 yy = *(const u32x2*)(YS + m * D + c), vv = *(const u32x2*)(P + m * 4096 + 2048 + c), zz = *(const u32x2*)(P + m * 4096 + 3072 + c);
        const float bs = BON[m * 16 + (c >> 6)];
        const float y[4] = {bflo(yy[0]), bfhi(yy[0]), bflo(yy[1]), bfhi(yy[1])}, v[4] = {bflo(vv[0]), bfhi(vv[0]), bflo(vv[1]), bfhi(vv[1])}, z[4] = {bflo(zz[0]), bfhi(zz[0]), bflo(zz[1]), bfhi(zz[1])};
        const float lwv[4] = {lw.x, lw.y, lw.z, lw.w}, lbv[4] = {lb.x, lb.y, lb.z, lb.w};
        const float mean = dpp_sum16((y[0] + y[1]) + (y[2] + y[3])) * (1.0f / 64.0f);
        float var = 0.f;
#pragma unroll
        for (int i = 0; i < 4; ++i) { const float d = y[i] - mean; var += d * d; }
        var = dpp_sum16(var) * (1.0f / 64.0f);
        const float rstd = 1.0f / sqrtf(var + 64e-5f);
        float o[4];
#pragma unroll
        for (int i = 0; i < 4; ++i) o[i] = ((y[i] - mean) * rstd * lwv[i] + lbv[i] + bs * v[i]) * siluf_(z[i]);
        *(u32x2*)(YS + m * D + c) = (u32x2){pack2bf(o[0], o[1]), pack2bf(o[2], o[3])};
    }
}

struct FastBufs { char* ws; };

DI void rows_xb_parts(const float* __restrict__ x, bf16* xb, float* parts) {
    const int lane = TIDX & 63, wave = TIDX >> 6;
    for (int m = blockIdx.x * 4 + wave; m < M; m += gridDim.x * 4) {
        const float* xr = x + (size_t)m * D; float s = 0.f;
#pragma unroll
        for (int i = 0; i < 2; ++i) {
            const int k = (i * 64 + lane) * 8; const float4 a = *(const float4*)(xr + k), b = *(const float4*)(xr + k + 4);
            const float w[8] = {a.x, a.y, a.z, a.w, b.x, b.y, b.z, b.w};
#pragma unroll
            for (int j = 0; j < 8; ++j) s += w[j] * w[j];
            store8bf(xb + (size_t)m * D + k, w);
        }
#pragma unroll
        for (int o = 32; o >= 1; o >>= 1) s += __shfl_xor(s, o);
        if (lane < 16) parts[(size_t)m * 16 + lane] = lane == 0 ? s : 0.f;
    }
}
DI void rows_xn(const float* __restrict__ x, const float* parts, const float* __restrict__ g, bf16* xn) {
    const int lane = TIDX & 63, wave = TIDX >> 6;
    for (int m = blockIdx.x * 4 + wave; m < M; m += gridDim.x * 4) {
        const float rs = rstd_from_parts(parts, m); const float* xr = x + (size_t)m * D;
#pragma unroll
        for (int i = 0; i < 2; ++i) {
            const int k = (i * 64 + lane) * 8; const float4 a = *(const float4*)(xr + k), b = *(const float4*)(xr + k + 4);
            const float4 ga = *(const float4*)(g + k), gb = *(const float4*)(g + k + 4);
            const float w[8] = {a.x * rs * ga.x, a.y * rs * ga.y, a.z * rs * ga.z, a.w * rs * ga.w, b.x * rs * gb.x, b.y * rs * gb.y, b.z * rs * gb.z, b.w * rs * gb.w};
            store8bf(xn + (size_t)m * D + k, w);
        }
    }
}
DI void rows_final(float* x, const float* parts, const float* __restrict__ g) {
    const int lane = TIDX & 63, wave = TIDX >> 6;
    for (int m = blockIdx.x * 4 + wave; m < M; m += gridDim.x * 4) {
        const float rs = rstd_from_parts(parts, m); float* xr = x + (size_t)m * D;
#pragma unroll
        for (int i = 0; i < 4; ++i) {
            const int k = (i * 64 + lane) * 4; float4 a = *(float4*)(xr + k); const float4 ga = *(const float4*)(g + k);
            a.x *= rs * ga.x; a.y *= rs * ga.y; a.z *= rs * ga.z; a.w *= rs * ga.w; *(float4*)(xr + k) = a;
        }
    }
}
enum { PH_PREP0 = 0, PH_IN0, PH_ATTN0, PH_OUT0, PH_PREP1, PH_IN1, PH_LORA1, PH_CPREP1, PH_SCAN1, PH_GN1, PH_OUT1, PH_PREP2, PH_IN2, PH_B2, PH_C2, PH_D2, PH_OUT2, PH_PREP3, PH_IN3, PH_GATE3, PH_SCANA3, PH_SCANB3, PH_OUT3, PH_FINAL };

namespace wbo {
constexpr size_t IN = 0;
constexpr size_t OUT = (size_t)4352 * 1024;
constexpr size_t EXTRA = OUT + (size_t)1280 * 1024;
}

template <int PH>
DI void run_phase(const Params& p, char* smem) {
    char* ws = p.ws;
    float* parts = (float*)(ws + fw::PARTS);
    constexpr int LAYER = PH <= PH_OUT0 ? 0 : PH <= PH_OUT1 ? 1 : PH <= PH_OUT2 ? 2 : 3;
    constexpr size_t WBOFF = LAYER == 0 ? 200 * fw::MB : LAYER == 1 ? 238 * fw::MB : LAYER == 2 ? 240 * fw::MB : 1 * fw::MB;
    bf16* WB = (bf16*)(ws + WBOFF);
    bf16* XB = (bf16*)(ws + ((PH == PH_PREP0 || PH == PH_IN0) ? 130 * fw::MB : 174 * fw::MB));
    bf16* P = (bf16*)(ws + wsl::P);
    float* X = p.out;
    float* smf = (float*)smem;
    if (PH == PH_PREP0) {
        rows_xb_parts(p.x, XB, parts);
        int tb = 0;
        convert_seg(p.a_w_in, A_COLS, 0, A_COLS, 1024, WB + wbo::IN, p.norm_g + 0 * D, smf, tb);
        convert_seg(p.a_w_out, 1024, 0, 1024, 1024, WB + wbo::OUT, nullptr, smf, tb);
    } else if (PH == PH_IN0) {
        gemm_sched(8, 4, [&](bool big, int mt, int nt) {
            if (big) gemm_tile2(ALoadPlain{XB, D}, WB + wbo::IN, 1024, mt * 128, nt * 256, EpiL0{P, (bf16*)(ws + 86 * fw::MB), parts}, smem);
            else gemm_tile(ALoadPlain{XB, D}, WB + wbo::IN, 1024, mt * 128, 2048 + nt * 128, EpiL0{P, (bf16*)(ws + 86 * fw::MB), parts}, smem);
        });
    } else if (PH == PH_ATTN0) {
        build_bias_lut(p.t5, smem, true);
        for (int it = blockIdx.x; it < B * G * (T / (16 * ANQT_SWA)); it += gridDim.x) swa_item(P, (const bf16*)(ws + 86 * fw::MB), p.a_sinks, (bf16*)(ws + wsl::L0_AO), it, smem);
    } else if (PH == PH_OUT0) {
        gemm_sched(4, 0, [&](bool, int mt, int nt) { gemm_tile2(ALoadPlain{(const bf16*)(ws + wsl::L0_AO), D}, WB + wbo::OUT, 1024, mt * 128, nt * 256, EpiResid{p.x, X, nullptr, parts}, smem); });
    } else if (PH == PH_PREP1) {
        rows_xn(X, parts, p.norm_g + 1 * D, (bf16*)(ws + wsl::L1_XN));
        int tb = 0;
        convert_seg(p.b_w_in, 4096, 0, 4096, 1024, WB + wbo::IN, nullptr, smf, tb);
        convert_seg(p.b_w1, 64, 0, 64, 1024, WB + wbo::IN + (size_t)4096 * 1024, nullptr, smf, tb);
        convert_seg(p.b_a1, 64, 0, 64, 1024, WB + wbo::IN + (size_t)(4096 + 128) * 1024, nullptr, smf, tb);
        convert_seg(p.b_w_out, 1024, 0, 1024, 1024, WB + wbo::OUT, nullptr, smf, tb);
        convert_seg(p.b_w2, 1024, 0, 1024, 64, WB + wbo::EXTRA, nullptr, smf, tb);
        convert_seg(p.b_a2, 1024, 0, 1024, 64, WB + wbo::EXTRA + (size_t)1024 * 64, nullptr, smf, tb);
        for (size_t i = (size_t)blockIdx.x * 256 + TIDX; i < (size_t)64 * 1024 / 8; i += (size_t)gridDim.x * 256) {
            ((u32x4*)(WB + wbo::IN + (size_t)(4096 + 64) * 1024))[i] = (u32x4){0u, 0u, 0u, 0u};
            ((u32x4*)(WB + wbo::IN + (size_t)(4096 + 192) * 1024))[i] = (u32x4){0u, 0u, 0u, 0u};
        }
    } else if (PH == PH_IN1) {
        const bf16* XN = (const bf16*)(ws + wsl::L1_XN);
        EpiRwkv epi{P, (float*)(ws + wsl::LHW), (float*)(ws + wsl::LHA)};
        gemm_sched(16, 2, [&](bool big, int mt, int nt) {
            if (big) gemm_tile2(ALoadLerp{XN, p.b_mu + (nt >> 2) * D}, WB + wbo::IN, 1024, mt * 128, nt * 256, epi, smem);
            else gemm_tile(ALoadLerp{XN, p.b_mu + (4 + nt) * D}, WB + wbo::IN, 1024, mt * 128, 4096 + nt * 128, epi, smem);
        });
    } else if (PH == PH_LORA1) {
        const int ntile = (M / 128) * 16;
        EpiLora epi{p.b_w0, p.b_a0, (bf16*)(ws + wsl::L1_WL), (bf16*)(ws + wsl::L1_AV)};
        (void)ntile;
        gemm_sched(8, 0, [&](bool, int mt, int nt) { gemm_tile2(ALoadF32{(const float*)(ws + (nt < 4 ? wsl::LHW : wsl::LHA))}, WB + wbo::EXTRA, 64, mt * 128, nt * 256, epi, smem); });
    } else if (PH == PH_CPREP1) {
        for (int it = blockIdx.x; it < B * 16 * RW_NCH; it += gridDim.x)
            rwkv_prep_item(P, (bf16*)(ws + wsl::L1_WL), (bf16*)(ws + wsl::L1_AV), p.b_k_k, p.b_k_a, p.b_r_k, (float*)(ws + 9 * fw::MB), (bf16*)(ws + 1 * fw::MB), WB, (float*)(ws + 254 * fw::MB), it, smem);
    } else if (PH == PH_SCAN1) {
        const int bid = blockIdx.x;
        if ((bid & 31) < 8 && (bid >> 5) < 8) {
            const int it = (bid >> 5) * 8 + (bid & 31);
            rwkv_chunk_scan(P, (const bf16*)(ws + wsl::L1_WL), (const bf16*)(ws + wsl::L1_AV), (const float*)(ws + 9 * fw::MB), (const bf16*)(ws + 1 * fw::MB), WB, (bf16*)(ws + wsl::L1_XN), it, smem);
        }
    } else if (PH == PH_GN1) {
        rwkv_gn_rows2(P, (const float*)(ws + 254 * fw::MB), p.b_lnx_w, p.b_lnx_b, (bf16*)(ws + wsl::L1_XN));
    } else if (PH == PH_OUT1) {
        gemm_sched(4, 0, [&](bool, int mt, int nt) { gemm_tile2(ALoadPlain{(const bf16*)(ws + wsl::L1_XN), D}, WB + wbo::OUT, 1024, mt * 128, nt * 256, EpiResid{X, X, XB, parts}, smem); });
    } else if (PH == PH_PREP2) {
        int tb = 0;
        const float* g2 = p.norm_g + 2 * D;
        convert_seg(p.c_w_in, C_COLS, 0, 2560, 1024, WB + wbo::IN, g2, smf, tb);
        convert_seg(p.c_w_in, C_COLS, 2608, 1024, 1024, WB + wbo::IN + (size_t)2560 * 1024, g2, smf, tb);
        convert_seg(p.c_w_in, C_COLS, 2560, 64, 1024, WB + wbo::IN + (size_t)3584 * 1024, g2, smf, tb);
        convert_seg(p.c_w_out, 1024, 0, 1024, 1024, WB + wbo::OUT, nullptr, smf, tb);
        convert_seg(p.c_k_w1, 128, 0, 128, 2048, WB + wbo::EXTRA, nullptr, smf, tb);
        convert_seg(p.c_v_w1, 128, 0, 128, 2048, WB + wbo::EXTRA + (size_t)128 * 2048, nullptr, smf, tb);
        convert_seg(p.c_k_w2, 64, 0, 64, 128, WB + wbo::EXTRA + (size_t)256 * 2048, nullptr, smf, tb);
        convert_seg(p.c_v_w2, 64, 0, 64, 128, WB + wbo::EXTRA + (size_t)256 * 2048 + 64 * 128, nullptr, smf, tb);
        if (blockIdx.x < 16) {
            const int which = blockIdx.x >> 3, i = blockIdx.x & 7; const float* pos = which ? p.c_pos_v : p.c_pos_k; const float* w1 = which ? p.c_v_w1 : p.c_k_w1;
            float* b8 = (float*)(ws + 12 * fw::MB);
            if (TIDX < 128) { float a = 0.f; for (int k = i * 256; k < i * 256 + 256; ++k) a += pos[k] * w1[(size_t)k * 128 + TIDX]; b8[(which * 8 + i) * 128 + TIDX] = a; }
        }
    } else if (PH == PH_IN2) {
        gemm_sched(14, 1, [&](bool big, int mt, int nt) {
            if (big) gemm_tile2(ALoadPlain{XB, D}, WB + wbo::IN, 1024, mt * 128, nt * 256, EpiL2{P, (bf16*)(ws + 114 * fw::MB), (bf16*)(ws + 122 * fw::MB), parts}, smem);
            else gemm_tile(ALoadPlain{XB, D}, WB + wbo::IN, 1024, mt * 128, 3584 + nt * 128, EpiL2{P, (bf16*)(ws + 114 * fw::MB), (bf16*)(ws + 122 * fw::MB), parts}, smem);
        });
    } else if (PH == PH_B2) {
        for (int it = blockIdx.x; it < 64; it += gridDim.x) { const int which = it >> 5, rt = it & 31;
            cmp_tile(P, WB + wbo::EXTRA + (size_t)which * 128 * 2048, (const float*)(ws + 12 * fw::MB) + which * 8 * 128, WB + wbo::EXTRA + (size_t)256 * 2048 + which * 64 * 128, which, rt,
                     (bf16*)(ws + 5 * fw::MB), (bf16*)(ws + 6 * fw::MB), smem); }
        build_bias_lut(p.t5, smem, false);
        const int nwin = B * G * (T / (16 * ANQT_WIN));
        const bool split = gridDim.x == 512 && nwin == 2048;
        const int bid = blockIdx.x, nb = bid - 64, cnt = bid < 64 ? 2 : (nb < 128 ? 5 : 4);
        for (int k = 0;; ++k) {
            int item;
            if (split) { if (k >= cnt) break; item = bid < 64 ? k * 512 + 448 + bid : (k < 4 ? k * 512 + nb : (2 + (nb >> 6)) * 512 + 448 + (nb & 63)); }
            else { const int it = (bid < 64 ? bid + (int)gridDim.x : bid) + k * (int)gridDim.x; if (it >= 64 + nwin) break; item = it - 64; }
            win_item(P, (const bf16*)(ws + 122 * fw::MB), (bf16*)(ws + 130 * fw::MB), item, smem);
        }
    } else if (PH == PH_C2) {
        for (int it = blockIdx.x; it < B * G * (T / 32); it += gridDim.x)
            cmpsel_item(P, (const bf16*)(ws + 5 * fw::MB), (const bf16*)(ws + 6 * fw::MB), (bf16*)(ws + 162 * fw::MB), (unsigned long long*)(ws + 9 * fw::MB), it, smem);
    } else if (PH == PH_D2) {
        build_bias_lut(p.t5, smem, false);
        for (int it = blockIdx.x; it < B * G * (T / (16 * ANQT_SEL)); it += gridDim.x)
            sel_item(P, (const bf16*)(ws + 114 * fw::MB), (const unsigned long long*)(ws + 9 * fw::MB), (const bf16*)(ws + 162 * fw::MB), (const bf16*)(ws + 130 * fw::MB), (bf16*)(ws + 206 * fw::MB), it, smem);
    } else if (PH == PH_OUT2) {
        gemm_sched(4, 0, [&](bool, int mt, int nt) { gemm_tile2(ALoadPlain{(const bf16*)(ws + 206 * fw::MB), D}, WB + wbo::OUT, 1024, mt * 128, nt * 256, EpiResid{X, X, XB, parts}, smem); });
    } else if (PH == PH_PREP3) {
        int tb = 0;
        convert_seg(p.d_w_in, 2560, 0, 2560, 1024, WB + wbo::IN, p.norm_g + 3 * D, smf, tb);
        convert_seg(p.d_w_out, 1024, 0, 1024, 1280, WB + wbo::OUT, nullptr, smf, tb);
        lru_convert_gates(p.d_ga_w, p.d_gx_w, WB + wbo::EXTRA);
        for (int i = blockIdx.x * NTHREADS + TIDX; i < LW; i += gridDim.x * NTHREADS) ((float*)(ws + 12 * fw::MB + 786432))[i] = -8.0f * softplusf_(-p.d_lambda[i]);
    } else if (PH == PH_IN3) {
        gemm_sched(8, 4, [&](bool big, int mt, int nt) {
            if (big) gemm_tile2(ALoadPlain{XB, D}, WB + wbo::IN, 1024, mt * 128, nt * 256, EpiBf16{P, 2560, parts}, smem);
            else gemm_tile(ALoadPlain{XB, D}, WB + wbo::IN, 1024, mt * 128, 2048 + nt * 128, EpiBf16{P, 2560, parts}, smem);
        });
    } else if (PH == PH_GATE3) {
        for (int it = blockIdx.x; it < (M / 128) * 16; it += gridDim.x)
            lru_gate_item(P, p.d_conv_w, p.d_conv_b, WB + wbo::EXTRA, p.d_ga_b, p.d_gx_b, (const float*)(ws + 12 * fw::MB + 786432), (bf16*)(ws + wsl::L3_LA), (bf16*)(ws + wsl::L3_BV), (float2*)(ws + wsl::L3_UC), it, smem);
    } else if (PH == PH_SCANB3) {
        for (int it = blockIdx.x; it < B * (T / 64) * 5; it += gridDim.x)
            lru_scan2_item((const bf16*)(ws + wsl::L3_LA), (const bf16*)(ws + wsl::L3_BV), (const float2*)(ws + wsl::L3_UC), P, (bf16*)(ws + wsl::L3_AO), it);
    } else if (PH == PH_OUT3) {
        gemm_sched(4, 0, [&](bool, int mt, int nt) { gemm_tile2(ALoadPlain{(const bf16*)(ws + wsl::L3_AO), LW}, WB + wbo::OUT, 1280, mt * 128, nt * 256, EpiResid{X, X, nullptr, parts}, smem); });
    } else if (PH == PH_FINAL) {
        rows_final(X, parts, p.final_g);
    }
}

template <int PH> __global__ void __launch_bounds__(NTHREADS, 2) k_phase(Params p) {
    extern __shared__ __attribute__((aligned(16))) char smem[];
    run_phase<PH>(p, smem);
}
#define LDS_BYTES 73728
#define MEGA_LDS_BYTES (73728 + 64)
template <int PH> static void launch_phase(const Params& p, hipStream_t s) {
    static bool attr = false;
    if (!attr) { hipFuncSetAttribute((const void*)k_phase<PH>, hipFuncAttributeMaxDynamicSharedMemorySize, LDS_BYTES); attr = true; }
    hipLaunchKernelGGL(k_phase<PH>, dim3(512), dim3(NTHREADS), LDS_BYTES, s, p);
}


#define XB_TMO      128
#define XB_XCNT(j)  (256  + 64 * (j))
#define XB_XSUB(j)  (1280 + 64 * (j))
#define XB_XGEN(j)  (2304 + 64 * (j))
#define XB_TOP      3328
#define XB_TOPGEN   3392
#define XCD_BAR_WORDS 3456
#define XB_SPIN_CAP (1u << 22)
#define LAS __attribute__((address_space(3)))
DI unsigned xb_ld(unsigned* p)              { return __hip_atomic_load(p, __ATOMIC_RELAXED, __HIP_MEMORY_SCOPE_AGENT); }
DI unsigned xb_add(unsigned* p, unsigned v) { return __hip_atomic_fetch_add(p, v, __ATOMIC_RELAXED, __HIP_MEMORY_SCOPE_AGENT); }
DI unsigned xb_xcc_id() { return (unsigned)__builtin_amdgcn_s_getreg((3 << 11) | 20) & 0xFu; }
#define XB_SPIN(cond, bar) do { unsigned _sp = 0; while (cond) { if (_sp < 64u) __builtin_amdgcn_s_sleep(2); else __builtin_amdgcn_s_sleep(32); \
    if ((++_sp & 255u) == 0u) { if (xb_ld(&(bar)[XB_TMO])) break; if (_sp > XB_SPIN_CAP) { atomicAdd(&(bar)[XB_TMO], 1u); break; } } } } while (0)
struct XcdBarrier { unsigned* bar; unsigned x; volatile LAS unsigned* st; };
DI XcdBarrier xcd_barrier_post(unsigned* bar, volatile LAS unsigned* st) {
    XcdBarrier b; b.bar = bar; b.x = xb_xcc_id(); b.st = st;
    if (threadIdx.x == 0) (void)xb_add(&bar[XB_XCNT(b.x)], 1u);
    return b;
}
DI void xcd_barrier_complete(unsigned* bar, unsigned x, unsigned& nloc, unsigned& nx) {
    const unsigned G = gridDim.x * gridDim.y * gridDim.z;
    unsigned sum, cnt, mine, sp = 0u;
    for (;;) {
        sum = 0u; cnt = 0u; mine = 0u;
#pragma unroll
        for (unsigned j = 0; j < 16; ++j) { const unsigned c = xb_ld(&bar[XB_XCNT(j)]); sum += c; cnt += (c > 0u) ? 1u : 0u; mine = (j == x) ? c : mine; }
        if (sum == G) break;
        __builtin_amdgcn_s_sleep(1);
        if ((++sp & 255u) == 0u) { if (xb_ld(&bar[XB_TMO])) break; if (sp > XB_SPIN_CAP) { atomicAdd(&bar[XB_TMO], 1u); break; } }
    }
    nloc = mine > 0u ? mine : 1u; nx = cnt > 0u ? cnt : 1u;
}
DI void xcd_barrier(const XcdBarrier& b) {
    asm volatile("s_waitcnt vmcnt(0)" ::: "memory");
    __syncthreads();
    if (threadIdx.x == 0) {
        unsigned* bar = b.bar;
        __builtin_amdgcn_s_waitcnt(0);
        unsigned nloc = b.st[0], nx = b.st[1];
        if (nloc == 0u) { xcd_barrier_complete(bar, b.x, nloc, nx); b.st[0] = nloc; b.st[1] = nx; }
        const unsigned old = xb_add(&bar[XB_XSUB(b.x)], 1u);
        const unsigned gen = old / nloc;
        if (old + 1u == (gen + 1u) * nloc) {
            __builtin_amdgcn_fence(__ATOMIC_RELEASE, "agent");
            asm volatile("s_waitcnt vmcnt(0)" ::: "memory");
            const unsigned og = xb_add(&bar[XB_TOP], 1u);
            const unsigned tg = og / nx;
            if (og + 1u == (tg + 1u) * nx) xb_add(&bar[XB_TOPGEN], 1u);
            else XB_SPIN(xb_ld(&bar[XB_TOPGEN]) == tg, bar);
            __builtin_amdgcn_fence(__ATOMIC_ACQUIRE, "agent");
            xb_add(&bar[XB_XGEN(b.x)], 1u);
            asm volatile("s_waitcnt vmcnt(0)" ::: "memory");
        } else {
            XB_SPIN(xb_ld(&bar[XB_XGEN(b.x)]) == gen, bar);
            __builtin_amdgcn_fence(__ATOMIC_ACQUIRE, "agent");
            asm volatile("s_waitcnt vmcnt(0)" ::: "memory");
        }
    }
    __syncthreads();
}

#define MEGA_PHASES(X) X(PH_IN0) X(PH_ATTN0) X(PH_OUT0) X(PH_PREP1) X(PH_IN1) X(PH_LORA1) X(PH_CPREP1) X(PH_SCAN1) X(PH_GN1) X(PH_OUT1) \
    X(PH_PREP2) X(PH_IN2) X(PH_B2) X(PH_C2) X(PH_D2) X(PH_OUT2) X(PH_PREP3) X(PH_IN3) X(PH_GATE3) X(PH_SCANB3) X(PH_OUT3)
__global__ void __launch_bounds__(NTHREADS, 2) mega_kernel(Params p) {
    extern __shared__ __attribute__((aligned(16))) char smem[];
    cooperative_groups::grid_group grid = cooperative_groups::this_grid();
    volatile LAS unsigned* xst = (volatile LAS unsigned*)(smem + 73728);
    if (threadIdx.x < 4) xst[threadIdx.x] = 0u;
    __syncthreads();
    XcdBarrier xb = xcd_barrier_post((unsigned*)p.ws, xst);
    run_phase<PH_PREP0>(p, smem);
    if (p.ws == nullptr) grid.sync();
    xcd_barrier(xb);
#define MEGA_STEP(ph) run_phase<ph>(p, smem); xcd_barrier(xb);
    MEGA_PHASES(MEGA_STEP)
#undef MEGA_STEP
    run_phase<PH_FINAL>(p, smem);
}
static void launch_mega(const Params& p, hipStream_t s) {
    static int grid_blocks = 0;
    if (!grid_blocks) {
        int dev = 0, cus = 0, per_cu = 0;
        hipGetDevice(&dev);
        hipDeviceGetAttribute(&cus, hipDeviceAttributeMultiprocessorCount, dev);
        hipFuncSetAttribute((const void*)mega_kernel, hipFuncAttributeMaxDynamicSharedMemorySize, MEGA_LDS_BYTES);
        hipOccupancyMaxActiveBlocksPerMultiprocessor(&per_cu, mega_kernel, NTHREADS, MEGA_LDS_BYTES);
        if (per_cu > 2) per_cu = 2;
        if (per_cu < 1) per_cu = 1;
        grid_blocks = cus * per_cu;
    }
    hipMemsetAsync(p.ws, 0, 16384, s);
    Params pp = p; void* args[] = {&pp};
    hipError_t e = hipLaunchCooperativeKernel((const void*)mega_kernel, dim3(grid_blocks), dim3(NTHREADS), args, MEGA_LDS_BYTES, s);
    if (e != hipSuccess) fprintf(stderr, "cooperative launch failed: %s (grid %d)\n", hipGetErrorString(e), grid_blocks);
}
#endif

#ifndef CPU_SHIM
template <class F> __global__ void __launch_bounds__(256) k_run(F f, long n) {
    const long i = (long)blockIdx.x * 256 + threadIdx.x; if (i < n) f(i);
}
template <class F> static void launch(const F& f, long n, hipStream_t s) {
    hipLaunchKernelGGL(k_run<F>, dim3((unsigned)((n + 255) / 256)), dim3(256), 0, s, f, n);
}
#else
template <class F> static void launch(const F& f, long n, hipStream_t) {
#pragma omp parallel for schedule(dynamic, 64)
    for (long i = 0; i < n; ++i) f(i);
}
#endif

#ifdef CPU_SHIM
void cpu_layer_hook(int layer, const float* X, const char* ws);
#define LAYER_HOOK(l) cpu_layer_hook(l, X, ws)
#else
#define LAYER_HOOK(l)
#endif

#define FAST_GEMM 0
#if FAST_GEMM
#define FASTP(ph) launch_phase<ph>(p, s)
#else
#define FASTP(ph)
#endif

static void run_naive(const Params& p, hipStream_t s) {
    char* ws = p.ws;
    float* rs = (float*)(ws + wsl::RS);
    bf16* P = (bf16*)(ws + wsl::P);
    float* X = p.out;
    (void)rs;
    {
        bf16* AO = (bf16*)(ws + wsl::L0_AO);
#if FAST_GEMM
        FASTP(PH_PREP0); FASTP(PH_IN0);
#else
        launch(RstdF{p.x, rs}, M, s);
        launch(GemmInF{p.x, rs, p.norm_g + 0 * D, p.a_w_in, P, A_COLS}, (long)M * (A_COLS / 4), s);
#endif
#if FAST_GEMM
        FASTP(PH_ATTN0); (void)AO;
#else
        launch(SwaF{P, p.t5, p.a_sinks, AO}, (long)M * H, s);
#endif
#if FAST_GEMM
        FASTP(PH_OUT0);
#else
        launch(GemmOutF{AO, p.a_w_out, p.x, X, 1024}, (long)M * (D / 4), s);
#endif
    }
    LAYER_HOOK(0);
    {
        bf16* XN = (bf16*)(ws + wsl::L1_XN); bf16* WL = (bf16*)(ws + wsl::L1_WL); bf16* AV = (bf16*)(ws + wsl::L1_AV);
        float* hw = (float*)(ws + wsl::LHW); float* ha = (float*)(ws + wsl::LHA);
#if FAST_GEMM
        FASTP(PH_PREP1); FASTP(PH_IN1); FASTP(PH_LORA1); FASTP(PH_CPREP1); FASTP(PH_SCAN1); FASTP(PH_GN1); FASTP(PH_OUT1);
        (void)XN; (void)WL; (void)AV; (void)hw; (void)ha;
#else
        launch(RstdF{X, rs}, M, s);
        launch(XnF{X, rs, p.norm_g + 1 * D, XN}, (long)M * D, s);
        launch(GemmRwkvF{XN, p.b_mu, p.b_w_in, P}, (long)M * 1024, s);
        launch(LoraHidF{XN, p.b_mu, p.b_w1, p.b_a1, hw, ha}, (long)M * 128, s);
        launch(LoraOutF{hw, ha, p.b_w0, p.b_w2, p.b_a0, p.b_a2, WL, AV}, (long)M * D, s);
        launch(RwkvScanF{P, WL, AV, p.b_k_k, p.b_k_a, XN}, (long)B * H * 64, s);
        launch(RwkvGnF{P, AV, p.b_k_a, p.b_r_k, p.b_lnx_w, p.b_lnx_b, XN}, (long)M * H, s);
        launch(GemmOutF{XN, p.b_w_out, X, X, 1024}, (long)M * (D / 4), s);
#endif
    }
    LAYER_HOOK(1);
    {
        float* hk = (float*)(ws + wsl::HK); float* hv = (float*)(ws + wsl::HV);
        float* kc = (float*)(ws + wsl::KC); float* vc = (float*)(ws + wsl::VC);
        float* st = (float*)(ws + wsl::ST); int* sel = (int*)(ws + wsl::SEL); float* imp = (float*)(ws + wsl::L2_IMP);
        bf16* AO = (bf16*)(ws + wsl::L2_AO); bf16* OC = (bf16*)(ws + wsl::L2_OC); bf16* OS = (bf16*)(ws + wsl::L2_OS);
#if FAST_GEMM
        FASTP(PH_PREP2); FASTP(PH_IN2); FASTP(PH_B2); FASTP(PH_C2); FASTP(PH_D2); FASTP(PH_OUT2);
        (void)hk; (void)hv; (void)kc; (void)vc; (void)st; (void)sel; (void)imp; (void)AO; (void)OC; (void)OS;
#else
        launch(RstdF{X, rs}, M, s);
        launch(GemmInF{X, rs, p.norm_g + 2 * D, p.c_w_in, P, C_COLS}, (long)M * (C_COLS / 4), s);
        launch(CmpHidF{P, p.c_pos_k, p.c_k_w1, p.c_pos_v, p.c_v_w1, hk, hv}, 2L * B * G * NCMP * 128, s);
        launch(CmpOutF{hk, hv, p.c_k_w2, p.c_v_w2, kc, vc}, 2L * B * G * NCMP * 64, s);
        launch(CmpAttnF{P, kc, vc, st, OC}, (long)M * H, s);
        launch(ImpF{P, kc, st, imp}, (long)M * G * NSEL, s);
        launch(TopkF{imp, sel}, (long)M * G, s);
        launch(SelAttnF{P, p.t5, sel, OS}, (long)M * H, s);
        launch(WinAttnF{P, p.t5, OC, OS, AO}, (long)M * H, s);
        LAYER_HOOK(20);
        launch(GemmOutF{AO, p.c_w_out, X, X, 1024}, (long)M * (D / 4), s);
#endif
    }
    LAYER_HOOK(2);
    {
        bf16* AO = (bf16*)(ws + wsl::L3_AO); bf16* UC = (bf16*)(ws + wsl::L3_UC); bf16* LA = (bf16*)(ws + wsl::L3_LA); bf16* BV = (bf16*)(ws + wsl::L3_BV);
#if FAST_GEMM
        FASTP(PH_PREP3); FASTP(PH_IN3); FASTP(PH_GATE3); FASTP(PH_SCANA3); FASTP(PH_SCANB3); FASTP(PH_OUT3);
        (void)AO; (void)UC; (void)LA; (void)BV;
#else
        launch(RstdF{X, rs}, M, s);
        launch(GemmInF{X, rs, p.norm_g + 3 * D, p.d_w_in, P, 2560}, (long)M * (2560 / 4), s);
        launch(ConvF{P, p.d_conv_w, p.d_conv_b, UC}, (long)M * LW, s);
        launch(LruGateF{UC, p.d_ga_w, p.d_ga_b, p.d_gx_w, p.d_gx_b, p.d_lambda, LA, BV}, (long)M * LW, s);
        launch(LruScanF{P, LA, BV, AO}, (long)B * LW, s);
        launch(GemmOutF{AO, p.d_w_out, X, X, LW}, (long)M * (D / 4), s);
#endif
    }
    LAYER_HOOK(3);
#if FAST_GEMM
    FASTP(PH_FINAL);
#else
    launch(FinalNormF{X, p.final_g}, M, s);
#endif
}

extern "C" void kernel_launch(void* const* d_in, const int* in_sizes, int n_in, void* d_out, int out_size, void* d_ws, size_t ws_size,
                              hipStream_t stream) {
    (void)in_sizes; (void)n_in; (void)out_size; (void)ws_size;
    Params p{};
    const float* const* in = (const float* const*)d_in;
    int k = 0;
    p.x = in[k++]; p.t5 = in[k++]; p.norm_g = in[k++]; p.final_g = in[k++];
    p.a_w_in = in[k++]; p.a_sinks = in[k++]; p.a_w_out = in[k++];
    p.b_mu = in[k++]; p.b_w_in = in[k++]; p.b_w0 = in[k++]; p.b_w1 = in[k++]; p.b_w2 = in[k++]; p.b_a0 = in[k++]; p.b_a1 = in[k++]; p.b_a2 = in[k++];
    p.b_k_k = in[k++]; p.b_k_a = in[k++]; p.b_r_k = in[k++]; p.b_lnx_w = in[k++]; p.b_lnx_b = in[k++]; p.b_w_out = in[k++];
    p.c_w_in = in[k++]; p.c_pos_k = in[k++]; p.c_k_w1 = in[k++]; p.c_k_w2 = in[k++]; p.c_pos_v = in[k++]; p.c_v_w1 = in[k++]; p.c_v_w2 = in[k++]; p.c_w_out = in[k++];
    p.d_w_in = in[k++]; p.d_conv_w = in[k++]; p.d_conv_b = in[k++]; p.d_ga_w = in[k++]; p.d_ga_b = in[k++]; p.d_gx_w = in[k++]; p.d_gx_b = in[k++];
    p.d_lambda = in[k++]; p.d_w_out = in[k++];
    p.out = (float*)d_out; p.ws = (char*)d_ws;
#if !defined(CPU_SHIM) && !defined(MULTI_LAUNCH) && !defined(ALL_NAIVE)
    launch_mega(p, stream);
#else
    run_naive(p, stream);
#endif
}
```

```cpp
#ifndef CPU_SHIM
#include <hip/hip_runtime.h>
#include <hip/hip_cooperative_groups.h>
#include <cstdio>
#define HD __host__ __device__ __forceinline__
#else
#include <cmath>
#include <cstring>
#include <cstdio>
#include <cstdlib>
#include <cstdint>
#define HD inline
typedef void* hipStream_t;
#endif
#include <cstddef>

#ifndef CFG_B
#define CFG_B 4
#endif
#ifndef CFG_T
#define CFG_T 4096
#endif

namespace cfg {
constexpr int B = CFG_B, T = CFG_T, M = B * T, D = 1024;
constexpr int H = 16, G = 4, R = 4, DH = 64;
constexpr int A_COLS = 2560;
constexpr int C_COLS = 3632;
constexpr int NCMP = (T - 32) / 16 + 1;
constexpr int NSEL = T / 64;
constexpr int KTOP = NSEL < 16 ? NSEL : 16;
constexpr int LW = 1280;
}
using namespace cfg;

typedef unsigned short bf16;

HD unsigned f_as_u(float f) {
#ifndef CPU_SHIM
    return __float_as_uint(f);
#else
    unsigned u; memcpy(&u, &f, 4); return u;
#endif
}
HD float u_as_f(unsigned u) {
#ifndef CPU_SHIM
    return __uint_as_float(u);
#else
    float f; memcpy(&f, &u, 4); return f;
#endif
}
HD float bf2f(bf16 v) { return u_as_f(((unsigned)v) << 16); }
HD bf16 f2bf(float f) { unsigned u = f_as_u(f); u += 0x7fffu + ((u >> 16) & 1u); return (bf16)(u >> 16); }
HD float sigmoidf_(float x) { return 1.0f / (1.0f + expf(-x)); }
HD float siluf_(float x) { return x / (1.0f + expf(-x)); }
HD float softplusf_(float x) { return x > 20.f ? x : log1pf(expf(x)); }

HD int t5_bucket(int d) {
    if (d < 16) return d < 0 ? 0 : d;
    if (d >= 113) return 31;
    if (d >= 99) return 30;
    if (d >= 87) return 29;
    if (d >= 77) return 28;
    if (d >= 67) return 27;
    if (d >= 59) return 26;
    if (d >= 52) return 25;
    if (d >= 46) return 24;
    if (d >= 40) return 23;
    if (d >= 35) return 22;
    if (d >= 31) return 21;
    if (d >= 27) return 20;
    if (d >= 24) return 19;
    if (d >= 21) return 18;
    if (d >= 19) return 17;
    return 16;
}

struct Params {
    const float *x, *t5, *norm_g, *final_g;
    const float *a_w_in, *a_sinks, *a_w_out;
    const float *b_mu, *b_w_in, *b_w0, *b_w1, *b_w2, *b_a0, *b_a1, *b_a2, *b_k_k, *b_k_a, *b_r_k, *b_lnx_w, *b_lnx_b, *b_w_out;
    const float *c_w_in, *c_pos_k, *c_k_w1, *c_k_w2, *c_pos_v, *c_v_w1, *c_v_w2, *c_w_out;
    const float *d_w_in, *d_conv_w, *d_conv_b, *d_ga_w, *d_ga_b, *d_gx_w, *d_gx_b, *d_lambda, *d_w_out;
    float* out;
    char* ws;
};

namespace wsl {
constexpr size_t MB = 1024 * 1024;
constexpr size_t RS = 0;
constexpr size_t HK = 1 * MB;
constexpr size_t HV = 3 * MB;
constexpr size_t KC = 5 * MB;
constexpr size_t VC = 6 * MB;
constexpr size_t ST = 7 * MB;
constexpr size_t SEL = 9 * MB;
constexpr size_t LHW = 1 * MB;
constexpr size_t LHA = 5 * MB;
constexpr size_t P = 14 * MB;
constexpr size_t SZ1024 = (size_t)M * 1024 * 2, SZ1280 = (size_t)M * 1280 * 2;
constexpr size_t L0_AO = P + (size_t)M * 2560 * 2;
constexpr size_t L1_XN = P + (size_t)M * 4096 * 2, L1_WL = L1_XN + SZ1024, L1_AV = L1_WL + SZ1024;
constexpr size_t L2_AO = P + (size_t)M * 3632 * 2, L2_OC = L2_AO + SZ1024, L2_OS = L2_OC + SZ1024, L2_IMP = L2_OS + SZ1024;
constexpr size_t L3_AO = P + (size_t)M * 2560 * 2, L3_UC = L3_AO + SZ1280, L3_LA = L3_UC + SZ1280, L3_BV = L3_LA + SZ1280;
constexpr size_t TOTAL = L3_BV + SZ1280;
}

struct RstdF {
    const float* x; float* rs;
    HD void operator()(long m) const {
        const float* r = x + (size_t)m * D; float s = 0.f;
        for (int k = 0; k < D; ++k) s += r[k] * r[k];
        rs[m] = 1.0f / sqrtf(s / D + 1e-6f);
    }
};
struct XnF {
    const float* x; const float* rs; const float* g; bf16* xn;
    HD void operator()(long i) const { long m = i / D; int k = (int)(i % D); xn[i] = f2bf(x[i] * rs[m] * g[k]); }
};
struct GemmInF {
    const float *x, *rs, *g, *W; bf16* P; long long N;
    HD void operator()(long i) const {
        const int n4 = (int)N / 4; const long m = i / n4; const int n = (int)(i % n4) * 4;
        const float* xr = x + (size_t)m * D; const float r = rs[m];
        float a0 = 0, a1 = 0, a2 = 0, a3 = 0;
        for (int k = 0; k < D; ++k) {
            const float a = xr[k] * r * g[k]; const float* w = W + (size_t)k * N + n;
            a0 += a * w[0]; a1 += a * w[1]; a2 += a * w[2]; a3 += a * w[3];
        }
        bf16* p = P + (size_t)m * N + n; p[0] = f2bf(a0); p[1] = f2bf(a1); p[2] = f2bf(a2); p[3] = f2bf(a3);
    }
};
struct GemmOutF {
    const bf16* A; const float* W; const float* xin; float* xout; long long K;
    HD void operator()(long i) const {
        const int n4 = D / 4; const long m = i / n4; const int n = (int)(i % n4) * 4;
        const bf16* ar = A + (size_t)m * K;
        float a0 = 0, a1 = 0, a2 = 0, a3 = 0;
        for (int k = 0; k < K; ++k) {
            const float a = bf2f(ar[k]); const float* w = W + (size_t)k * D + n;
            a0 += a * w[0]; a1 += a * w[1]; a2 += a * w[2]; a3 += a * w[3];
        }
        const float* xi = xin + (size_t)m * D + n; float* xo = xout + (size_t)m * D + n;
        xo[0] = xi[0] + a0; xo[1] = xi[1] + a1; xo[2] = xi[2] + a2; xo[3] = xi[3] + a3;
    }
};

struct SwaF {
    const bf16* P; const float* t5; const float* sinks; bf16* AO;
    HD void operator()(long i) const {
        const long m = i / H; const int h = (int)(i % H), g = h / R; const int t = (int)(m % T); const long mb = m - t;
        float q[DH], o[DH];
#pragma unroll
        for (int d = 0; d < DH; ++d) { q[d] = bf2f(P[(size_t)m * A_COLS + h * DH + d]); o[d] = 0.f; }
        float mx = sinks[h], l = 1.0f;
        const int s0 = t - 127 < 0 ? 0 : t - 127;
        for (int s = s0; s <= t; ++s) {
            const bf16* kr = P + (size_t)(mb + s) * A_COLS + 1024 + g * DH;
            const bf16* vr = kr + 256;
            float sc = 0.f;
#pragma unroll
            for (int d = 0; d < DH; ++d) sc += q[d] * bf2f(kr[d]);
            sc = sc * 0.125f + t5[t5_bucket(t - s) * H + h];
            const float mn = sc > mx ? sc : mx; const float al = expf(mx - mn), p = expf(sc - mn);
            l = l * al + p; mx = mn;
#pragma unroll
            for (int d = 0; d < DH; ++d) o[d] = o[d] * al + p * bf2f(vr[d]);
        }
        const float il = 1.0f / l;
#pragma unroll
        for (int d = 0; d < DH; ++d) {
            const float z = bf2f(P[(size_t)m * A_COLS + 1536 + h * DH + d]);
            AO[(size_t)m * D + h * DH + d] = f2bf(o[d] * il * siluf_(z));
        }
    }
};

struct GemmRwkvF {
    const bf16* xn; const float* mu; const float* W; bf16* P;
    HD void operator()(long i) const {
        const int N = 4096, n4 = N / 4; const long m = i / n4; const int n = (int)(i % n4) * 4; const int s = n / 1024;
        const int t = (int)(m % T);
        const bf16* xr = xn + (size_t)m * D; const float* mus = mu + s * D;
        float a0 = 0, a1 = 0, a2 = 0, a3 = 0;
        for (int k = 0; k < D; ++k) {
            const float xc = bf2f(xr[k]); const float xp = t > 0 ? bf2f(xr[k - D]) : 0.f;
            const float a = xc + (xp - xc) * mus[k]; const float* w = W + (size_t)k * N + n;
            a0 += a * w[0]; a1 += a * w[1]; a2 += a * w[2]; a3 += a * w[3];
        }
        bf16* p = P + (size_t)m * N + n; p[0] = f2bf(a0); p[1] = f2bf(a1); p[2] = f2bf(a2); p[3] = f2bf(a3);
    }
};
struct LoraHidF {
    const bf16* xn; const float* mu; const float* w1; const float* a1; float* hw; float* ha;
    HD void operator()(long i) const {
        const long m = i / 128; const int jj = (int)(i % 128); const int which = jj / 64, j = jj % 64; const int t = (int)(m % T);
        const bf16* xr = xn + (size_t)m * D; const float* mus = mu + (4 + which) * D; const float* W = which ? a1 : w1;
        float acc = 0.f;
        for (int k = 0; k < D; ++k) {
            const float xc = bf2f(xr[k]); const float xp = t > 0 ? bf2f(xr[k - D]) : 0.f;
            acc += (xc + (xp - xc) * mus[k]) * W[(size_t)k * 64 + j];
        }
        if (which) ha[(size_t)m * 64 + j] = acc; else hw[(size_t)m * 64 + j] = tanhf(acc);
    }
};
struct LoraOutF {
    const float *hw, *ha, *w0, *w2, *a0, *a2; bf16* wlog; bf16* av;
    HD void operator()(long i) const {
        const long m = i / D; const int c = (int)(i % D);
        float sw = 0.f, sa = 0.f;
        for (int j = 0; j < 64; ++j) { sw += hw[(size_t)m * 64 + j] * w2[(size_t)j * D + c]; sa += ha[(size_t)m * 64 + j] * a2[(size_t)j * D + c]; }
        const float wr = -softplusf_(-(w0[c] + sw)) - 0.5f;
        wlog[i] = f2bf(-expf(wr)); av[i] = f2bf(sigmoidf_(a0[c] + sa));
    }
};
struct RwkvScanF {
    const bf16* P; const bf16* wlog; const bf16* av; const float* k_k; const float* k_a; bf16* ys;
    HD void operator()(long idx) const {
        const int i = (int)(idx % 64); const int h = (int)((idx / 64) % H); const int b = (int)(idx / (64 * H));
        float S[64];
#pragma unroll
        for (int j = 0; j < 64; ++j) S[j] = 0.f;
        for (int t = 0; t < T; ++t) {
            const size_t m = (size_t)b * T + t; const bf16* pr = P + m * 4096 + h * 64;
            const bf16* wl = wlog + m * D + h * 64; const bf16* ar = av + m * D + h * 64;
            float n2 = 0.f;
#pragma unroll
            for (int j = 0; j < 64; ++j) { const float kk = bf2f(pr[1024 + j]) * k_k[h * 64 + j]; n2 += kk * kk; }
            float nr = sqrtf(n2); nr = nr > 1e-12f ? nr : 1e-12f; const float inr = 1.0f / nr;
            float sa = 0.f;
#pragma unroll
            for (int j = 0; j < 64; ++j) { const float kk = bf2f(pr[1024 + j]) * k_k[h * 64 + j] * inr; sa += S[j] * (-kk); }
            const float vi = bf2f(pr[2048 + i]); float y = 0.f;
#pragma unroll
            for (int j = 0; j < 64; ++j) {
                const float kr = bf2f(pr[1024 + j]); const float a = bf2f(ar[j]);
                const float kk = kr * k_k[h * 64 + j] * inr; const float kp = kr * (1.0f + (a - 1.0f) * k_a[h * 64 + j]);
                const float dec = expf(bf2f(wl[j]));
                S[j] = S[j] * dec + sa * (kk * a) + vi * kp;
                y += S[j] * bf2f(pr[j]);
            }
            ys[m * D + h * 64 + i] = f2bf(y);
        }
    }
};
struct RwkvGnF {
    const bf16* P; const bf16* av; const float *k_a, *r_k, *lnx_w, *lnx_b; bf16* ys;
    HD void operator()(long idx) const {
        const long m = idx / H; const int h = (int)(idx % H);
        bf16* yr = ys + (size_t)m * D + h * 64; const bf16* pr = P + (size_t)m * 4096 + h * 64; const bf16* ar = av + (size_t)m * D + h * 64;
        float mean = 0.f;
        for (int j = 0; j < 64; ++j) mean += bf2f(yr[j]);
        mean /= 64.f; float var = 0.f;
        for (int j = 0; j < 64; ++j) { const float d = bf2f(yr[j]) - mean; var += d * d; }
        var /= 64.f; const float rstd = 1.0f / sqrtf(var + 64e-5f);
        float bs = 0.f;
        for (int j = 0; j < 64; ++j) { const float kr = bf2f(pr[1024 + j]); const float kp = kr * (1.0f + (bf2f(ar[j]) - 1.0f) * k_a[h * 64 + j]); bs += bf2f(pr[j]) * kp * r_k[h * 64 + j]; }
        for (int j = 0; j < 64; ++j) {
            const float yn = (bf2f(yr[j]) - mean) * rstd * lnx_w[h * 64 + j] + lnx_b[h * 64 + j];
            const float z = bf2f(pr[3072 + j]);
            yr[j] = f2bf((yn + bs * bf2f(pr[2048 + j])) * siluf_(z));
        }
    }
};

struct CmpHidF {
    const bf16* P; const float *pos_k, *w1_k, *pos_v, *w1_v; float* hk; float* hv;
    HD void operator()(long idx) const {
        const int j = (int)(idx % 128); long r = idx / 128; const int n = (int)(r % NCMP); r /= NCMP; const int g = (int)(r % G); r /= G;
        const int b = (int)(r % B); const int which = (int)(r / B);
        const float* pos = which ? pos_v : pos_k; const float* w1 = which ? w1_v : w1_k; const int col = 1024 + (which ? 256 : 0) + g * 64;
        float acc = 0.f;
        for (int l = 0; l < 32; ++l) {
            const bf16* src = P + (size_t)(b * T + 16 * n + l) * C_COLS + col;
            for (int d = 0; d < 64; ++d) acc += (bf2f(src[d]) + pos[l * 64 + d]) * w1[(size_t)(l * 64 + d) * 128 + j];
        }
        (which ? hv : hk)[(((size_t)b * G + g) * NCMP + n) * 128 + j] = siluf_(acc);
    }
};
struct CmpOutF {
    const float *hk, *hv, *w2_k, *w2_v; float* kc; float* vc;
    HD void operator()(long idx) const {
        const int d = (int)(idx % 64); long r = idx / 64; const long row = r % ((long)B * G * NCMP); const int which = (int)(r / ((long)B * G * NCMP));
        const float* hsrc = (which ? hv : hk) + (size_t)row * 128; const float* w2 = which ? w2_v : w2_k;
        float acc = 0.f;
        for (int j = 0; j < 128; ++j) acc += hsrc[j] * w2[j * 64 + d];
        (which ? vc : kc)[(size_t)row * 64 + d] = acc;
    }
};
struct CmpAttnF {
    const bf16* P; const float *kc, *vc; float* st; bf16* oc;
    HD void operator()(long i) const {
        const long m = i / H; const int h = (int)(i % H), g = h / R; const int t = (int)(m % T); const int b = (int)(m / T);
        float q[DH], o[DH];
#pragma unroll
        for (int d = 0; d < DH; ++d) { q[d] = bf2f(P[(size_t)m * C_COLS + h * DH + d]); o[d] = 0.f; }
        const int nv = t < 31 ? 0 : (t - 31) / 16 + 1;
        float mx = -1e30f, l = 0.f;
        for (int n = 0; n < nv; ++n) {
            const float* kr = kc + (((size_t)b * G + g) * NCMP + n) * 64; const float* vr = vc + (((size_t)b * G + g) * NCMP + n) * 64;
            float sc = 0.f;
#pragma unroll
            for (int d = 0; d < DH; ++d) sc += q[d] * kr[d];
            sc *= 0.125f;
            const float mn = sc > mx ? sc : mx; const float al = expf(mx - mn), p = expf(sc - mn);
            l = l * al + p; mx = mn;
#pragma unroll
            for (int d = 0; d < DH; ++d) o[d] = o[d] * al + p * vr[d];
        }
        const float il = nv > 0 ? 1.0f / l : 0.f;
        st[(size_t)i * 2] = mx; st[(size_t)i * 2 + 1] = il;
#pragma unroll
        for (int d = 0; d < DH; ++d) oc[(size_t)m * D + h * DH + d] = f2bf(o[d] * il);
    }
};
struct ImpF {
    const bf16* P; const float *kc, *st; float* imp;
    HD void operator()(long idx) const {
        const int s = (int)(idx % NSEL); long r = idx / NSEL; const int g = (int)(r % G); const long m = r / G;
        const int t = (int)(m % T); const int b = (int)(m / T); const int cur = t / 64;
        float v;
        if (s == 0 || s == cur || s == cur - 1) v = 1e30f;
        else if (s * 64 > t) v = -1e30f;
        else {
            v = 0.f; const int nv = t < 31 ? 0 : (t - 31) / 16 + 1;
            int n0 = 4 * s - 1; if (n0 < 0) n0 = 0; int n1 = 4 * s + 3; if (n1 > NCMP - 1) n1 = NCMP - 1; if (n1 > nv - 1) n1 = nv - 1;
            for (int rr = 0; rr < R; ++rr) {
                const int h = g * R + rr; const bf16* qr = P + (size_t)m * C_COLS + h * DH;
                const float mx = st[((size_t)m * H + h) * 2], il = st[((size_t)m * H + h) * 2 + 1];
                for (int n = n0; n <= n1; ++n) {
                    const float* kr = kc + (((size_t)b * G + g) * NCMP + n) * 64; float sc = 0.f;
                    for (int d = 0; d < DH; ++d) sc += bf2f(qr[d]) * kr[d];
                    v += expf(sc * 0.125f - mx) * il;
                }
            }
        }
        imp[idx] = v;
    }
};
struct TopkF {
    const float* imp; int* sel;
    HD void operator()(long idx) const {
        const float* v = imp + (size_t)idx * NSEL; unsigned long long used = 0ull;
        for (int j = 0; j < KTOP; ++j) {
            int best = -1; float bv = 0.f;
            for (int s = 0; s < NSEL; ++s) { if ((used >> s) & 1ull) continue; const float x = v[s]; if (best < 0 || x > bv) { best = s; bv = x; } }
            used |= 1ull << best; sel[(size_t)idx * 16 + j] = best;
        }
    }
};
struct SelAttnF {
    const bf16* P; const float* t5; const int* sel; bf16* os;
    HD void operator()(long i) const {
        const long m = i / H; const int h = (int)(i % H), g = h / R; const int t = (int)(m % T); const long mb = m - t;
        float q[DH], o[DH];
#pragma unroll
        for (int d = 0; d < DH; ++d) { q[d] = bf2f(P[(size_t)m * C_COLS + h * DH + d]); o[d] = 0.f; }
        float mx = -1e30f, l = 0.f;
        for (int j = 0; j < KTOP; ++j) {
            const int blk = sel[((size_t)m * G + g) * 16 + j];
            for (int ll = 0; ll < 64; ++ll) {
                const int s = blk * 64 + ll; if (s > t) break;
                const bf16* kr = P + (size_t)(mb + s) * C_COLS + 1536 + g * DH; const bf16* vr = kr + 256;
                float sc = 0.f;
#pragma unroll
                for (int d = 0; d < DH; ++d) sc += q[d] * bf2f(kr[d]);
                sc = sc * 0.125f + t5[t5_bucket(t - s) * H + h];
                const float mn = sc > mx ? sc : mx; const float al = expf(mx - mn), p = expf(sc - mn);
                l = l * al + p; mx = mn;
#pragma unroll
                for (int d = 0; d < DH; ++d) o[d] = o[d] * al + p * bf2f(vr[d]);
            }
        }
        const float il = 1.0f / l;
#pragma unroll
        for (int d = 0; d < DH; ++d) os[(size_t)m * D + h * DH + d] = f2bf(o[d] * il);
    }
};
struct WinAttnF {
    const bf16* P; const float* t5; const bf16* oc; const bf16* os; bf16* AO;
    HD void operator()(long i) const {
        const long m = i / H; const int h = (int)(i % H), g = h / R, rr = h % R; const int t = (int)(m % T); const long mb = m - t;
        float q[DH], o[DH];
#pragma unroll
        for (int d = 0; d < DH; ++d) { q[d] = bf2f(P[(size_t)m * C_COLS + h * DH + d]); o[d] = 0.f; }
        float mx = -1e30f, l = 0.f;
        const int s0 = t - 511 < 0 ? 0 : t - 511;
        for (int s = s0; s <= t; ++s) {
            const bf16* kr = P + (size_t)(mb + s) * C_COLS + 2048 + g * DH; const bf16* vr = kr + 256;
            float sc = 0.f;
#pragma unroll
            for (int d = 0; d < DH; ++d) sc += q[d] * bf2f(kr[d]);
            sc = sc * 0.125f + t5[t5_bucket(t - s) * H + h];
            const float mn = sc > mx ? sc : mx; const float al = expf(mx - mn), p = expf(sc - mn);
            l = l * al + p; mx = mn;
#pragma unroll
            for (int d = 0; d < DH; ++d) o[d] = o[d] * al + p * bf2f(vr[d]);
        }
        const float il = 1.0f / l;
        const bf16* gr = P + (size_t)m * C_COLS + 2560;
        const float g0 = sigmoidf_(bf2f(gr[0 * 16 + g * R + rr])), g1 = sigmoidf_(bf2f(gr[1 * 16 + g * R + rr])), g2 = sigmoidf_(bf2f(gr[2 * 16 + g * R + rr]));
#pragma unroll
        for (int d = 0; d < DH; ++d) {
            const size_t oi = (size_t)m * D + h * DH + d;
            const float z = bf2f(P[(size_t)m * C_COLS + 2608 + h * DH + d]);
            AO[oi] = f2bf((g0 * bf2f(oc[oi]) + g1 * bf2f(os[oi]) + g2 * o[d] * il) * siluf_(z));
        }
    }
};

struct ConvF {
    const bf16* P; const float *cw, *cb; bf16* uc;
    HD void operator()(long i) const {
        const long m = i / LW; const int c = (int)(i % LW); const int t = (int)(m % T);
        float acc = cb[c];
        for (int w = 0; w < 4; ++w) { const int tt = t - 3 + w; if (tt >= 0) acc += cw[w * LW + c] * bf2f(P[(size_t)(m - 3 + w) * 2560 + c]); }
        uc[i] = f2bf(acc);
    }
};
struct LruGateF {
    const bf16* uc; const float *gaw, *gab, *gxw, *gxb, *lam; bf16* la; bf16* bv;
    HD void operator()(long i) const {
        const long m = i / LW; const int c = (int)(i % LW); const int n = c / 80, d = c % 80;
        const bf16* ub = uc + (size_t)m * LW + n * 80; float ra = gab[c], rx = gxb[c];
        for (int k = 0; k < 80; ++k) { const float u = bf2f(ub[k]); ra += u * gaw[((size_t)n * 80 + k) * 80 + d]; rx += u * gxw[((size_t)n * 80 + k) * 80 + d]; }
        const float r = sigmoidf_(ra), ig = sigmoidf_(rx);
        const float loga = -8.0f * r * softplusf_(-lam[c]);
        la[i] = f2bf(loga);
        bv[i] = f2bf(sqrtf(-expm1f(2.0f * loga)) * (ig * bf2f(uc[i])));
    }
};
struct LruScanF {
    const bf16* P; const bf16* la; const bf16* bv; bf16* AO;
    HD void operator()(long idx) const {
        const int c = (int)(idx % LW); const int b = (int)(idx / LW); float h = 0.f;
        for (int t = 0; t < T; ++t) {
            const size_t m = (size_t)b * T + t;
            h = expf(bf2f(la[m * LW + c])) * h + bf2f(bv[m * LW + c]);
            AO[m * LW + c] = f2bf(h * siluf_(bf2f(P[m * 2560 + LW + c])));
        }
    }
};
struct FinalNormF {
    float* x; const float* g;
    HD void operator()(long m) const {
        float* r = x + (size_t)m * D; float s = 0.f;
        for (int k = 0; k < D; ++k) s += r[k] * r[k];
        const float rs = 1.0f / sqrtf(s / D + 1e-6f);
        for (int k = 0; k < D; ++k) r[k] = r[k] * rs * g[k];
    }
};


#ifndef CPU_SHIM
typedef short bf16x8 __attribute__((ext_vector_type(8)));
typedef float f32x4 __attribute__((ext_vector_type(4)));
typedef unsigned u32x4 __attribute__((ext_vector_type(4)));
typedef unsigned u32x2 __attribute__((ext_vector_type(2)));
#define DI __device__ __forceinline__
#define NTHREADS 256
__device__ __forceinline__ int opaque_tid() { int t = threadIdx.x; asm volatile("" : "+v"(t)); return t; }
#define TIDX (opaque_tid())

typedef __bf16 hbf16x2 __attribute__((ext_vector_type(2)));
typedef float f32x2 __attribute__((ext_vector_type(2)));
DI unsigned pack2bf(float lo, float hi) { f32x2 f = {lo, hi}; return __builtin_bit_cast(unsigned, __builtin_convertvector(f, hbf16x2)); }
DI float bflo(unsigned u) { return __uint_as_float(u << 16); }
DI float bfhi(unsigned u) { return __uint_as_float(u & 0xffff0000u); }

namespace fw {
constexpr size_t MB = 1024 * 1024;
constexpr size_t PARTS = 13 * MB;
constexpr size_t SMALLB = 1 * MB;
constexpr size_t WB = 14 * MB;
constexpr size_t XB = 30 * MB;
constexpr size_t BIG = 62 * MB;
}

DI void convert_tile(const float* __restrict__ W, int ldw, int c0, int K, bf16* __restrict__ Wt, const float* __restrict__ g, int kt, int nt, float* sm) {
    const int tid = TIDX;
    const int k0 = kt * 64, n0 = nt * 64;
#pragma unroll
    for (int i = 0; i < 4; ++i) {
        const int kr = (tid >> 4) + 16 * i; const int nc = (tid & 15) * 4;
        const float4 v = *(const float4*)(W + (size_t)(k0 + kr) * ldw + c0 + n0 + nc);
        const float s = g ? g[k0 + kr] : 1.0f;
        sm[kr * 65 + nc + 0] = v.x * s; sm[kr * 65 + nc + 1] = v.y * s; sm[kr * 65 + nc + 2] = v.z * s; sm[kr * 65 + nc + 3] = v.w * s;
    }
    __syncthreads();
    {
        const int n = tid >> 2, kq = (tid & 3) * 16;
        unsigned w[8];
#pragma unroll
        for (int j = 0; j < 8; ++j) w[j] = pack2bf(sm[(kq + 2 * j) * 65 + n], sm[(kq + 2 * j + 1) * 65 + n]);
        u32x4* dst = (u32x4*)(Wt + (size_t)(n0 + n) * K + k0 + kq);
        dst[0] = (u32x4){w[0], w[1], w[2], w[3]}; dst[1] = (u32x4){w[4], w[5], w[6], w[7]};
    }
    __syncthreads();
}
DI void convert_seg(const float* W, int ldw, int c0, int ncols, int K, bf16* Wt, const float* g, float* sm, int& tbase) {
    const int nkt = K / 64, nnt = ncols / 64, ntile = nkt * nnt;
    const int Gd = (int)gridDim.x;
    for (int t = (((int)blockIdx.x - tbase % Gd) + Gd) % Gd; t < ntile; t += Gd) convert_tile(W, ldw, c0, K, Wt, g, t % nkt, t / nkt, sm);
    tbase += ntile;
}

DI int perm32(int rho) { const int n = rho >> 4, i = rho & 15; return 8 * (i >> 2) + 4 * n + (i & 3); }

struct ALoadPlain {
    const bf16* A; int lda;
    static constexpr bool DMA = true;
    DI const bf16* src(int m, int k) const { return A + (size_t)m * lda + k; }
    struct Raw { u32x4 v; };
    DI Raw load(int m, int k) const { Raw r; r.v = *(const u32x4*)(A + (size_t)m * lda + k); return r; }
    DI u32x4 finish(const Raw& r, int, int) const { return r.v; }
};
struct ALoadLerp {
    const bf16* xn; const float* mu;
    static constexpr bool DMA = false;
    DI const bf16* src(int, int) const { return nullptr; }
    struct Raw { u32x4 c, p; };
    DI Raw load(int m, int k) const {
        Raw r; r.c = *(const u32x4*)(xn + (size_t)m * D + k);
        if ((m % T) != 0) r.p = *(const u32x4*)(xn + (size_t)(m - 1) * D + k); else r.p = (u32x4){0u, 0u, 0u, 0u};
        return r;
    }
    DI u32x4 finish(const Raw& r, int, int k) const {
        const float4 m0 = *(const float4*)(mu + k), m1 = *(const float4*)(mu + k + 4);
        const float mm[8] = {m0.x, m0.y, m0.z, m0.w, m1.x, m1.y, m1.z, m1.w};
        u32x4 o;
#pragma unroll
        for (int j = 0; j < 4; ++j) {
            const float c0 = bflo(r.c[j]), c1 = bfhi(r.c[j]), p0 = bflo(r.p[j]), p1 = bfhi(r.p[j]);
            o[j] = pack2bf(c0 + (p0 - c0) * mm[2 * j], c1 + (p1 - c1) * mm[2 * j + 1]);
        }
        return o;
    }
};

#define GLDS16(gp, lp) __builtin_amdgcn_global_load_lds((const unsigned*)(gp), (unsigned*)(lp), 16, 0, 0)
template <class AL, class Epi>
DI void gemm_tile(const AL& al, const bf16* __restrict__ Bt, int K, int m0, int n0, const Epi& epi, char* smem) {
    const int tid = TIDX, lane = tid & 63, wave = __builtin_amdgcn_readfirstlane(tid >> 6), wr = wave >> 1, wc = wave & 1, q = lane >> 4, l15 = lane & 15;
    const int srow = tid >> 3, sc = tid & 7, scs = sc ^ (srow & 7);
    const int st_off = srow * 128 + (sc << 4);
    const int dma_off = (8 * wave) * 128;
    int brow[4];
#pragma unroll
    for (int i = 0; i < 4; ++i) { const int rho = srow + 32 * i; brow[i] = n0 + (rho & ~31) + perm32(rho & 31); }
    const int fa0 = (wr * 64 + l15) * 128 + ((q ^ (lane & 7)) << 4);
    const int fb0 = (wc * 64 + l15) * 128 + ((q ^ (lane & 7)) << 4);
    f32x4 acc[4][4];
#pragma unroll
    for (int i = 0; i < 4; ++i)
#pragma unroll
        for (int j = 0; j < 4; ++j) acc[i][j] = (f32x4){0.f, 0.f, 0.f, 0.f};
    typename AL::Raw ra[4];
    const int nk = K / 64;
    {
        char* bufA = smem; char* bufB = smem + 16384;
#pragma unroll
        for (int i = 0; i < 4; ++i) {
            GLDS16(Bt + (size_t)brow[i] * K + scs * 8, bufB + dma_off + i * 4096);
            if (AL::DMA) GLDS16(al.src(m0 + srow + 32 * i, scs * 8), bufA + dma_off + i * 4096);
            else ra[i] = al.load(m0 + srow + 32 * i, scs * 8);
        }
        if (!AL::DMA) {
#pragma unroll
            for (int i = 0; i < 4; ++i) *(u32x4*)(bufA + st_off + i * 4096) = al.finish(ra[i], m0 + srow + 32 * i, scs * 8);
        }
    }
    asm volatile("s_waitcnt vmcnt(0)" ::: "memory");
    __syncthreads();
    for (int kt = 0; kt < nk; ++kt) {
        char* bufA = smem + (kt & 1) * 32768; char* bufB = bufA + 16384;
        char* nA = smem + ((kt + 1) & 1) * 32768; char* nB = nA + 16384;
        const bool more = kt + 1 < nk; const int kn = (kt + 1) * 64 + scs * 8;
        if (more) {
#pragma unroll
            for (int i = 0; i < 4; ++i) {
                GLDS16(Bt + (size_t)brow[i] * K + kn, nB + dma_off + i * 4096);
                if (AL::DMA) GLDS16(al.src(m0 + srow + 32 * i, kn), nA + dma_off + i * 4096);
                else ra[i] = al.load(m0 + srow + 32 * i, kn);
            }
        }
#pragma unroll
        for (int ks = 0; ks < 2; ++ks) {
            bf16x8 af[4], bfr[4];
#pragma unroll
            for (int i = 0; i < 4; ++i) {
                af[i] = *(const bf16x8*)(bufA + ((fa0 + i * 2048) ^ (ks << 6)));
                bfr[i] = *(const bf16x8*)(bufB + ((fb0 + i * 2048) ^ (ks << 6)));
            }
#pragma unroll
            for (int i = 0; i < 4; ++i)
#pragma unroll
                for (int j = 0; j < 4; ++j) acc[i][j] = __builtin_amdgcn_mfma_f32_16x16x32_bf16(bfr[j], af[i], acc[i][j], 0, 0, 0);
        }
        if (more && !AL::DMA) {
#pragma unroll
            for (int i = 0; i < 4; ++i) *(u32x4*)(nA + st_off + i * 4096) = al.finish(ra[i], m0 + srow + 32 * i, kn);
        }
        asm volatile("s_waitcnt vmcnt(0)" ::: "memory");
        __syncthreads();
    }
#pragma unroll
    for (int mt = 0; mt < 4; ++mt)
#pragma unroll
        for (int gi = 0; gi < 2; ++gi) {
            float v[8];
#pragma unroll
            for (int r = 0; r < 4; ++r) { v[r] = acc[mt][2 * gi][r]; v[4 + r] = acc[mt][2 * gi + 1][r]; }
            epi(m0 + wr * 64 + mt * 16 + l15, n0 + wc * 64 + gi * 32 + 8 * q, v, mt, gi);
        }
    epi.finish(m0, n0, wr, wc, lane);
}

constexpr int G2_STAGE = 24576;
template <class AL, class Epi>
DI void gemm_tile2(const AL& al, const bf16* __restrict__ Bt, int K, int m0, int n0, const Epi& epi, char* smem) {
    const int tid = TIDX, lane = tid & 63, wave = __builtin_amdgcn_readfirstlane(tid >> 6), wr = wave >> 1, wc = wave & 1, q = lane >> 4, l15 = lane & 15;
    const int prow = tid >> 2, ppos = tid & 3, ca = (ppos - 2 * ((tid >> 4) & 3)) & 3;
    const int dma_off = wave * 1024;
    int brow[4];
#pragma unroll
    for (int i = 0; i < 4; ++i) { const int rho = prow + 64 * i; brow[i] = n0 + (rho & ~31) + perm32(rho & 31); }
    const int fpos = ((q + 2 * ((l15 >> 2) & 3)) & 3) << 4;
    const int fa0 = (wr * 64 + l15) * 64 + fpos, fb0 = 8192 + (wc * 128 + l15) * 64 + fpos;
    f32x4 acc[4][8];
#pragma unroll
    for (int i = 0; i < 4; ++i)
#pragma unroll
        for (int j = 0; j < 8; ++j) acc[i][j] = (f32x4){0.f, 0.f, 0.f, 0.f};
    typename AL::Raw ra[2];
    const int nk = K / 32;
#define G2_ISSUE(kt_) { char* st_ = smem + ((kt_) % 3) * G2_STAGE; const int kk_ = (kt_) * 32 + ca * 8; \
        _Pragma("unroll") for (int i = 0; i < 2; ++i) { if (AL::DMA) GLDS16(al.src(m0 + prow + 64 * i, kk_), st_ + dma_off + i * 4096); else ra[i] = al.load(m0 + prow + 64 * i, kk_); } \
        _Pragma("unroll") for (int i = 0; i < 4; ++i) GLDS16(Bt + (size_t)brow[i] * K + kk_, st_ + 8192 + dma_off + i * 4096); }
#define G2_AWRITE(kt_) { if (!AL::DMA) { char* st_ = smem + ((kt_) % 3) * G2_STAGE; const int kk_ = (kt_) * 32 + ca * 8; \
        _Pragma("unroll") for (int i = 0; i < 2; ++i) *(u32x4*)(st_ + (prow + 64 * i) * 64 + ppos * 16) = al.finish(ra[i], m0 + prow + 64 * i, kk_); } }
#define G2_BARRIER() { asm volatile("s_waitcnt lgkmcnt(0)" ::: "memory"); __builtin_amdgcn_s_barrier(); asm volatile("" ::: "memory"); }
    G2_ISSUE(0); G2_AWRITE(0);
    if (nk > 1) { G2_ISSUE(1); G2_AWRITE(1); }
    if (nk > 1) { if (AL::DMA) asm volatile("s_waitcnt vmcnt(6)" ::: "memory"); else asm volatile("s_waitcnt vmcnt(4)" ::: "memory"); } else asm volatile("s_waitcnt vmcnt(0)" ::: "memory");
    G2_BARRIER();
    for (int kt = 0; kt < nk; ++kt) {
        const char* st = smem + (kt % 3) * G2_STAGE;
        const bool more = kt + 2 < nk;
        if (more) G2_ISSUE(kt + 2);
        bf16x8 af[4];
#pragma unroll
        for (int i = 0; i < 4; ++i) af[i] = *(const bf16x8*)(st + fa0 + i * 1024);
#pragma unroll
        for (int j = 0; j < 8; ++j) {
            const bf16x8 bf_ = *(const bf16x8*)(st + fb0 + j * 1024);
#pragma unroll
            for (int i = 0; i < 4; ++i) acc[i][j] = __builtin_amdgcn_mfma_f32_16x16x32_bf16(bf_, af[i], acc[i][j], 0, 0, 0);
        }
        if (more) G2_AWRITE(kt + 2);
        if (more) { if (AL::DMA) asm volatile("s_waitcnt vmcnt(6)" ::: "memory"); else asm volatile("s_waitcnt vmcnt(4)" ::: "memory"); } else asm volatile("s_waitcnt vmcnt(0)" ::: "memory");
        G2_BARRIER();
    }
#undef G2_ISSUE
#undef G2_AWRITE
#undef G2_BARRIER
#pragma unroll
    for (int mt = 0; mt < 4; ++mt)
#pragma unroll
        for (int gi = 0; gi < 4; ++gi) {
            float v[8];
#pragma unroll
            for (int r = 0; r < 4; ++r) { v[r] = acc[mt][2 * gi][r]; v[4 + r] = acc[mt][2 * gi + 1][r]; }
            epi(m0 + wr * 64 + mt * 16 + l15, n0 + wc * 128 + gi * 32 + 8 * q, v, mt, gi);
        }
    epi.finish_wide(m0, n0, wr, wc, lane);
}
template <class F>
DI void gemm_sched(int nbig, int nsmall, F&& f) {
    const int x = blockIdx.x & 7, lb = blockIdx.x >> 3, nlb = gridDim.x >> 3;
    const int nb16 = 16 * nbig, tot = 16 * (nbig + nsmall);
    for (int s = lb; s < tot; s += nlb) {
        if (s < nb16) f(true, x * 16 + (s & 15), s >> 4);
        else { const int t = s - nb16; f(false, x * 16 + (t & 15), t >> 4); }
    }
}

DI float rstd_from_parts(const float* parts, int m) {
    const float4* p = (const float4*)(parts + (size_t)m * 16); float s = 0.f;
#pragma unroll
    for (int i = 0; i < 4; ++i) { const float4 v = p[i]; s += (v.x + v.y) + (v.z + v.w); }
    return 1.0f / sqrtf(s * (1.0f / D) + 1e-6f);
}
DI void store8bf(bf16* p, const float* v) { *(u32x4*)p = (u32x4){pack2bf(v[0], v[1]), pack2bf(v[2], v[3]), pack2bf(v[4], v[5]), pack2bf(v[6], v[7])}; }

struct EpiBf16 {
    bf16* P; int ldp; const float* parts; mutable float rsc[4];
    DI void operator()(int m, int n, const float* v, int mt, int gi) const {
        if (gi == 0) rsc[mt] = parts ? rstd_from_parts(parts, m) : 1.0f;
        float s = rsc[mt]; float w[8];
#pragma unroll
        for (int j = 0; j < 8; ++j) w[j] = v[j] * s;
        store8bf(P + (size_t)m * ldp + n, w);
    }
    DI void finish(int, int, int, int, int) const {}
    DI void finish_wide(int, int, int, int, int) const {}
};
struct EpiResid {
    const float* xin; float* xout; bf16* xb; float* parts; mutable float sq[4];
    DI void operator()(int m, int n, const float* v, int mt, int gi) const {
        const float4* xi = (const float4*)(xin + (size_t)m * D + n); const float4 a = xi[0], b = xi[1];
        float w[8] = {a.x + v[0], a.y + v[1], a.z + v[2], a.w + v[3], b.x + v[4], b.y + v[5], b.z + v[6], b.w + v[7]};
        float4* xo = (float4*)(xout + (size_t)m * D + n);
        xo[0] = make_float4(w[0], w[1], w[2], w[3]); xo[1] = make_float4(w[4], w[5], w[6], w[7]);
        if (xb) store8bf(xb + (size_t)m * D + n, w);
        float s = 0.f;
#pragma unroll
        for (int j = 0; j < 8; ++j) s += w[j] * w[j];
        if (gi == 0) sq[mt] = s; else sq[mt] += s;
    }
    DI void finish(int m0, int n0, int wr, int wc, int lane) const {
#pragma unroll
        for (int mt = 0; mt < 4; ++mt) {
            float s = sq[mt]; s += __shfl_xor(s, 16); s += __shfl_xor(s, 32);
            if (lane < 16) parts[(size_t)(m0 + wr * 64 + mt * 16 + lane) * 16 + (n0 >> 7) * 2 + wc] = s;
        }
    }
    DI void finish_wide(int m0, int n0, int wr, int wc, int lane) const {
#pragma unroll
        for (int mt = 0; mt < 4; ++mt) {
            float s = sq[mt]; s += __shfl_xor(s, 16); s += __shfl_xor(s, 32);
            if (lane < 16) { float* pr = parts + (size_t)(m0 + wr * 64 + mt * 16 + lane) * 16 + (n0 >> 7) + wc; pr[0] = s; pr[8] = 0.f; }
        }
    }
};
struct EpiRwkv {
    bf16* P; float* hw; float* ha;
    DI void operator()(int m, int n, const float* v, int, int) const {
        if (n < 4096) { store8bf(P + (size_t)m * 4096 + n, v); return; }
        const int c = n - 4096;
        if (c < 64) { float4* o = (float4*)(hw + (size_t)m * 64 + c); o[0] = make_float4(tanhf(v[0]), tanhf(v[1]), tanhf(v[2]), tanhf(v[3])); o[1] = make_float4(tanhf(v[4]), tanhf(v[5]), tanhf(v[6]), tanhf(v[7])); }
        else if (c >= 128 && c < 192) { float4* o = (float4*)(ha + (size_t)m * 64 + (c - 128)); o[0] = make_float4(v[0], v[1], v[2], v[3]); o[1] = make_float4(v[4], v[5], v[6], v[7]); }
    }
    DI void finish(int, int, int, int, int) const {}
    DI void finish_wide(int, int, int, int, int) const {}
};

namespace at {
constexpr int OFF_BIAS = 49152;
constexpr int OFF_X = 61952;
constexpr int OFF_IMP = 49152;
constexpr float L2E = 1.4426950408889634f;
constexpr float NEG_MASK = -1e30f, M_INIT = -1e20f;
}
enum { AM_SWA = 0, AM_WIN = 1, AM_CMP = 2, AM_SEL = 3 };
DI int vt_perm(int k32) { return ((k32 & 15) >> 2) * 8 + (k32 >> 4) * 4 + (k32 & 3); }
DI float fast_exp2(float x) { return __builtin_amdgcn_exp2f(x); }

DI void build_bias_lut(const float* __restrict__ t5, char* smem, bool swa) {
    float* lut = (float*)(smem + at::OFF_BIAS);
    for (int i = TIDX; i < 16 * 200; i += NTHREADS) {
        const int h = i / 200, e = i % 200; float v = at::NEG_MASK;
        if (e >= 64 && e < 192) v = t5[t5_bucket(e - 64) * 16 + h] * at::L2E;
        else if (e >= 192 && !swa) v = t5[31 * 16 + h] * at::L2E;
        lut[i] = v;
    }
    __syncthreads();
}

template <int NQT> struct AttnStateT { f32x4 o[NQT][4]; f32x4 lacc[NQT]; float m[NQT]; };
#ifndef ANQT_SWA
#define ANQT_SWA 4
#endif
#ifndef ANQT_WIN
#define ANQT_WIN 2
#endif
#ifndef ANQT_SEL
#define ANQT_SEL 4
#endif
DI unsigned long long range_mask(int lo, int hi) { return (hi >= 63 ? ~0ull : ((1ull << (hi + 1)) - 1ull)) & ~((1ull << lo) - 1ull); }

template <int NQT>
DI void attn_load_q(bf16x8 (&qf)[NQT][2], const bf16* __restrict__ Qp, int ldq, size_t mbase, int hbase) {
    const int lane = TIDX & 63, wave = TIDX >> 6, q = lane >> 4, l15 = lane & 15;
#pragma unroll
    for (int qt = 0; qt < NQT; ++qt) {
        const size_t m = mbase + wave * (4 * NQT) + qt * 4 + (l15 >> 2);
#pragma unroll
        for (int ks = 0; ks < 2; ++ks) qf[qt][ks] = *(const bf16x8*)(Qp + m * ldq + (hbase + (l15 & 3)) * 64 + ks * 32 + q * 8);
    }
}

enum { SK_FAR = 0, SK_NEAR = 1, SK_EDGE = 2, SK_CMP = 3 };
template <int KIND>
DI float attn_fix(f32x4 (&s)[4], int dbase, float cadd, const float* __restrict__ bl, float mx) {
#pragma unroll
    for (int kt = 0; kt < 4; ++kt)
#pragma unroll
        for (int r = 0; r < 4; ++r) {
            float v = s[kt][r]; const int dist = dbase - (kt * 16 + r);
            if (KIND == SK_NEAR) { int idx = dist + 64; idx = idx < 0 ? 0 : (idx > 192 ? 192 : idx); v += bl[idx] + cadd; }
            else if (KIND == SK_EDGE) v = dist < 512 ? v + cadd : at::NEG_MASK;
            else if (KIND == SK_CMP) v = dist >= 0 ? v : at::NEG_MASK;
            if (KIND != SK_FAR) s[kt][r] = v;
            mx = fmaxf(mx, v);
        }
    return mx;
}
template <int MODE, int NQT>
DI void attn_blocks(AttnStateT<NQT>& st, const bf16x8 (&qf)[NQT][2], const bf16* __restrict__ Kp, size_t krs, const bf16* __restrict__ Vp, size_t vrs,
                    int t0, unsigned long long todo, int hbase, const unsigned long long (&sel)[NQT], char* smem) {
    const int tid = TIDX, lane = tid & 63, wave = __builtin_amdgcn_readfirstlane(tid >> 6), q = lane >> 4, l15 = lane & 15;
    const int tq0 = t0 + wave * (4 * NQT) + (l15 >> 2);
    const float* bl = (const float*)(smem + at::OFF_BIAS) + (hbase + (l15 & 3)) * 200;
    const float bfar = (MODE != AM_CMP) ? bl[192] : 0.f;
    const int srow = tid >> 3, scs = (tid & 7) ^ (srow & 7);
    const int fo = l15 * 128 + ((q ^ (l15 & 7)) << 4);
#define ATT_DMA(kb_, slot_) { _Pragma("unroll") for (int i = 0; i < 2; ++i) { const int row = srow + 32 * i; char* dst = smem + (slot_) * 16384 + (8 * wave + 32 * i) * 128; \
        GLDS16(Kp + (size_t)((kb_) * 64 + row) * krs + scs * 8, dst); GLDS16(Vp + (size_t)row * vrs + (kb_) * 64 + scs * 8, dst + 8192); } }
#define ATT_BARRIER() { asm volatile("s_waitcnt lgkmcnt(0)" ::: "memory"); __builtin_amdgcn_s_barrier(); asm volatile("" ::: "memory"); }
    if (todo == 0ull) return;
    int kb = __builtin_ctzll(todo); todo &= todo - 1ull;
    int kb1 = -1; if (todo) { kb1 = __builtin_ctzll(todo); todo &= todo - 1ull; }
    ATT_DMA(kb, 0);
    if (kb1 >= 0) { ATT_DMA(kb1, 1); asm volatile("s_waitcnt vmcnt(4)" ::: "memory"); } else { asm volatile("s_waitcnt vmcnt(0)" ::: "memory"); }
    ATT_BARRIER();
    int slot = 0;
    for (;;) {
        char* buf = smem + slot * 16384;
        int kb2 = -1; if (todo) { kb2 = __builtin_ctzll(todo); todo &= todo - 1ull; }
        if (kb2 >= 0) { const int s2 = slot >= 1 ? slot - 1 : 2; ATT_DMA(kb2, s2); }
        f32x4 s[NQT][4];
#pragma unroll
        for (int qt = 0; qt < NQT; ++qt)
#pragma unroll
            for (int kt = 0; kt < 4; ++kt) s[qt][kt] = (f32x4){0.f, 0.f, 0.f, 0.f};
#pragma unroll
        for (int kt = 0; kt < 4; ++kt)
#pragma unroll
            for (int ks = 0; ks < 2; ++ks) {
                const bf16x8 kf = *(const bf16x8*)(buf + ((fo + kt * 2048) ^ (ks << 6)));
#pragma unroll
                for (int qt = 0; qt < NQT; ++qt) s[qt][kt] = __builtin_amdgcn_mfma_f32_16x16x32_bf16(kf, qf[qt][ks], s[qt][kt], 0, 0, 0);
            }
        const int mind = (t0 + wave * (4 * NQT)) - (kb * 64 + 63), maxd = (t0 + wave * (4 * NQT) + 4 * NQT - 1) - kb * 64;
        float mx[NQT], cofs[NQT];
#pragma unroll
        for (int qt = 0; qt < NQT; ++qt) cofs[qt] = 0.f;
        if (MODE == AM_CMP) {
#pragma unroll
            for (int qt = 0; qt < NQT; ++qt) { const int nlim = (tq0 + 4 * qt - 31) >> 4; mx[qt] = attn_fix<SK_CMP>(s[qt], nlim - (kb * 64 + 4 * q), 0.f, bl, at::NEG_MASK); }
        } else {
            float cadd[NQT];
#pragma unroll
            for (int qt = 0; qt < NQT; ++qt) cadd[qt] = (MODE == AM_SEL && !((sel[qt] >> kb) & 1ull)) ? at::NEG_MASK : 0.f;
            if (MODE == AM_SWA || mind < 113) {
#pragma unroll
                for (int qt = 0; qt < NQT; ++qt) mx[qt] = attn_fix<SK_NEAR>(s[qt], tq0 + 4 * qt - (kb * 64 + 4 * q), cadd[qt], bl, at::NEG_MASK);
            } else if (MODE == AM_WIN && maxd >= 512) {
#pragma unroll
                for (int qt = 0; qt < NQT; ++qt) mx[qt] = attn_fix<SK_EDGE>(s[qt], tq0 + 4 * qt - (kb * 64 + 4 * q), bfar, bl, at::NEG_MASK);
            } else {
#pragma unroll
                for (int qt = 0; qt < NQT; ++qt) { cofs[qt] = bfar + cadd[qt]; mx[qt] = attn_fix<SK_FAR>(s[qt], 0, 0.f, bl, at::NEG_MASK) + cofs[qt]; }
            }
        }
        float msub[NQT]; bool grow = false;
#pragma unroll
        for (int qt = 0; qt < NQT; ++qt) {
            float m2 = mx[qt];
            m2 = fmaxf(m2, __shfl_xor(m2, 16)); m2 = fmaxf(m2, __shfl_xor(m2, 32));
            const bool g = m2 > st.m[qt] + 4.0f; grow |= g;
            mx[qt] = g ? m2 : st.m[qt];
            msub[qt] = mx[qt] - cofs[qt];
        }
        if (__any(grow)) {
#pragma unroll
            for (int qt = 0; qt < NQT; ++qt) {
                const float alpha = fast_exp2(st.m[qt] - mx[qt]);
#pragma unroll
                for (int dt = 0; dt < 4; ++dt) st.o[qt][dt] *= alpha;
                st.lacc[qt] *= alpha;
            }
        }
#pragma unroll
        for (int qt = 0; qt < NQT; ++qt) st.m[qt] = mx[qt];
#pragma unroll
        for (int qt = 0; qt < NQT; ++qt)
#pragma unroll
            for (int kt = 0; kt < 4; ++kt)
#pragma unroll
                for (int r = 0; r < 4; ++r) s[qt][kt][r] = fast_exp2(s[qt][kt][r] - msub[qt]);
        const bf16x8 ones = {(short)0x3F80, (short)0x3F80, (short)0x3F80, (short)0x3F80, (short)0x3F80, (short)0x3F80, (short)0x3F80, (short)0x3F80};
#pragma unroll
        for (int kp = 0; kp < 2; ++kp) {
            bf16x8 pf[NQT];
#pragma unroll
            for (int qt = 0; qt < NQT; ++qt) {
                const u32x4 w = {pack2bf(s[qt][2 * kp][0], s[qt][2 * kp][1]), pack2bf(s[qt][2 * kp][2], s[qt][2 * kp][3]),
                                 pack2bf(s[qt][2 * kp + 1][0], s[qt][2 * kp + 1][1]), pack2bf(s[qt][2 * kp + 1][2], s[qt][2 * kp + 1][3])};
                pf[qt] = __builtin_bit_cast(bf16x8, w);
            }
#pragma unroll
            for (int qt = 0; qt < NQT; ++qt) st.lacc[qt] = __builtin_amdgcn_mfma_f32_16x16x32_bf16(ones, pf[qt], st.lacc[qt], 0, 0, 0);
#pragma unroll
            for (int dt = 0; dt < 4; ++dt) {
                const bf16x8 vf = *(const bf16x8*)(buf + 8192 + ((fo + dt * 2048) ^ (kp << 6)));
#pragma unroll
                for (int qt = 0; qt < NQT; ++qt) st.o[qt][dt] = __builtin_amdgcn_mfma_f32_16x16x32_bf16(vf, pf[qt], st.o[qt][dt], 0, 0, 0);
            }
        }
        if (kb1 < 0) break;
        if (kb2 >= 0) { asm volatile("s_waitcnt vmcnt(4)" ::: "memory"); } else { asm volatile("s_waitcnt vmcnt(0)" ::: "memory"); }
        ATT_BARRIER();
        kb = kb1; kb1 = kb2; slot = slot == 2 ? 0 : slot + 1;
    }
    ATT_BARRIER();
#undef ATT_DMA
}
template <int NQT>
DI void attn_init(AttnStateT<NQT>& st, float m0, float l0) {
#pragma unroll
    for (int qt = 0; qt < NQT; ++qt) { st.m[qt] = m0; st.lacc[qt] = (f32x4){l0, l0, l0, l0};
#pragma unroll
        for (int dt = 0; dt < 4; ++dt) st.o[qt][dt] = (f32x4){0.f, 0.f, 0.f, 0.f}; }
}
DI float attn_linv(const f32x4& lacc) { const float l = lacc[0]; return l > 0.f ? 1.0f / l : 0.f; }

template <int TT>
DI void attn_item_decode(int item, int& b, int& g, int& t0) {
    constexpr int tiles = T / TT;
    const int Gd = (int)gridDim.x;
    int pair, tile;
    if ((Gd % tiles) == 0 && tiles * B * G % Gd == 0) {
        const int bid = item % Gd, rr = item / Gd, tau = bid % tiles;
        pair = bid / tiles + (Gd / tiles) * rr; tile = (rr & 1) ? tiles - 1 - tau : tau;
    } else { tile = item % tiles; pair = item / tiles; }
    t0 = tile * TT; g = pair % G; b = pair / G;
}
DI void swa_item(const bf16* __restrict__ P0, const bf16* __restrict__ VT, const float* __restrict__ sinks, bf16* __restrict__ AO, int item, char* smem) {
    constexpr int LDP = 2304;
    constexpr int NQT = ANQT_SWA;
    int b, g, t0; attn_item_decode<16 * NQT>(item, b, g, t0);
    const int lane = TIDX & 63, wave = TIDX >> 6, q = lane >> 4, l15 = lane & 15;
    const size_t mbase = (size_t)b * T + t0; const int hbase = g * 4, h = hbase + (l15 & 3);
    bf16x8 qf[NQT][2]; attn_load_q<NQT>(qf, P0, LDP, mbase, hbase);
    AttnStateT<NQT> st; attn_init<NQT>(st, sinks[h] * at::L2E, 1.0f);
    const int lo = t0 - 127 < 0 ? 0 : (t0 - 127) >> 6, hi = (t0 + 16 * NQT - 1) >> 6;
    const unsigned long long nosel[NQT] = {};
    attn_blocks<AM_SWA, NQT>(st, qf, P0 + (size_t)b * T * LDP + 1024 + g * 64, LDP, VT + (size_t)(b * G + g) * 64 * T, T, t0, range_mask(lo, hi), hbase, nosel, smem);
#pragma unroll
    for (int qt = 0; qt < NQT; ++qt) {
        const float li = attn_linv(st.lacc[qt]); const size_t m = mbase + wave * (4 * NQT) + qt * 4 + (l15 >> 2);
#pragma unroll
        for (int dt = 0; dt < 4; ++dt) {
            const int d0 = dt * 16 + 4 * q; const u32x2 zz = *(const u32x2*)(P0 + m * LDP + 1280 + h * 64 + d0);
            const float z0 = bflo(zz[0]), z1 = bfhi(zz[0]), z2 = bflo(zz[1]), z3 = bfhi(zz[1]);
            const f32x4 o = st.o[qt][dt];
            *(u32x2*)(AO + m * D + h * 64 + d0) = (u32x2){pack2bf(o[0] * li * siluf_(z0), o[1] * li * siluf_(z1)), pack2bf(o[2] * li * siluf_(z2), o[3] * li * siluf_(z3))};
        }
    }
}

struct EpiL0 {
    bf16* P0; bf16* VT; const float* parts; mutable float rsc[4];
    DI void operator()(int m, int n, const float* v, int mt, int gi) const {
        if (gi == 0) rsc[mt] = rstd_from_parts(parts, m);
        float s = rsc[mt]; if (n < 1024) s *= 0.125f * at::L2E; float w[8];
#pragma unroll
        for (int j = 0; j < 8; ++j) w[j] = v[j] * s;
        if (n < 1280) store8bf(P0 + (size_t)m * 2304 + n, w);
        else if (n >= 1536) store8bf(P0 + (size_t)m * 2304 + n - 256, w);
        else {
            const int g = (n - 1280) >> 6, d = (n - 1280) & 63, b = m / T, t = m % T; const int pos = (t & ~31) + vt_perm(t & 31);
            bf16* dst = VT + ((size_t)(b * G + g) * 64 + d) * T + pos;
#pragma unroll
            for (int j = 0; j < 8; ++j) dst[(size_t)j * T] = f2bf(w[j]);
        }
    }
    DI void finish(int, int, int, int, int) const {}
    DI void finish_wide(int, int, int, int, int) const {}
};

constexpr int LDP2 = 3200;
struct EpiL2 {
    bf16* P2; bf16* VTs; bf16* VTw; const float* parts; mutable float rsc[4];
    DI void operator()(int m, int n, const float* v, int mt, int gi) const {
        if (gi == 0) rsc[mt] = rstd_from_parts(parts, m);
        if (n >= C_COLS) return;
        float s = rsc[mt]; if (n < 1024) s *= 0.125f * at::L2E; float w[8];
#pragma unroll
        for (int j = 0; j < 8; ++j) w[j] = v[j] * s;
        const bool isvs = n >= 1792 && n < 2048, isvw = n >= 2304 && n < 2560;
        if (isvs || isvw) {
            const int c = n - (isvs ? 1792 : 2304); const int g = c >> 6, d = c & 63, b = m / T, t = m % T; const int pos = (t & ~31) + vt_perm(t & 31);
            bf16* dst = (isvs ? VTs : VTw) + ((size_t)(b * G + g) * 64 + d) * T + pos;
#pragma unroll
            for (int j = 0; j < 8; ++j) dst[(size_t)j * T] = f2bf(w[j]);
        } else {
            const int c = n < 1792 ? n : (n < 2304 ? n - 256 : n - 512);
            store8bf(P2 + (size_t)m * LDP2 + c, w);
        }
    }
    DI void finish(int, int, int, int, int) const {}
    DI void finish_wide(int, int, int, int, int) const {}
};

struct ALoadCmp {
    const bf16* P2; int col;
    static constexpr bool DMA = true;
    DI const bf16* src(int row, int k) const {
        int n = row & 255; const int bg = row >> 8, b = bg >> 2, g = bg & 3; const int l = k >> 6, d = k & 63; n = n < NCMP ? n : NCMP - 1;
        return P2 + (size_t)(b * T + 16 * n + l) * LDP2 + col + g * 64 + d;
    }
    struct Raw { u32x4 v; };
    DI Raw load(int row, int k) const {
        const int n = row & 255, bg = row >> 8, b = bg >> 2, g = bg & 3; const int l = k >> 6, d = k & 63; Raw r;
        if (n < NCMP) r.v = *(const u32x4*)(P2 + (size_t)(b * T + 16 * n + l) * LDP2 + col + g * 64 + d); else r.v = (u32x4){0u, 0u, 0u, 0u};
        return r;
    }
    DI u32x4 finish(const Raw& r, int, int) const { return r.v; }
};
struct EpiCmpH {
    char* smem; const float* bias8;
    DI void operator()(int m, int n, const float* v, int, int) const {
        const int row = m & 127; float w[8];
#pragma unroll
        for (int j = 0; j < 8; ++j) { float bsum = 0.f;
#pragma unroll
            for (int i = 0; i < 8; ++i) bsum += bias8[i * 128 + n + j];
            w[j] = siluf_(v[j] + bsum); }
        const int kk = n >> 6, c = (n & 63) >> 3;
        *(u32x4*)(smem + kk * 16384 + row * 128 + ((c ^ (row & 7)) << 4)) = (u32x4){pack2bf(w[0], w[1]), pack2bf(w[2], w[3]), pack2bf(w[4], w[5]), pack2bf(w[6], w[7])};
    }
    DI void finish(int, int, int, int, int) const {}
    DI void finish_wide(int, int, int, int, int) const {}
};
DI void cmp_tile(const bf16* __restrict__ P2, const bf16* __restrict__ w1t, const float* __restrict__ bias8, const bf16* __restrict__ w2t, int which, int rt,
                 bf16* __restrict__ KCb, bf16* __restrict__ VCT, char* smem) {
    gemm_tile(ALoadCmp{P2, which ? 1280 : 1024}, w1t, 2048, rt * 128, 0, EpiCmpH{smem, bias8}, smem);
    const int tid = TIDX, lane = tid & 63, wave = tid >> 6, q = lane >> 4, l15 = lane & 15;
#pragma unroll
    for (int i = 0; i < 4; ++i) {
        const int id = i * 256 + tid; const int row = id >> 4, c16 = id & 15, kk = c16 >> 3, c = c16 & 7;
        *(u32x4*)(smem + 32768 + kk * 8192 + row * 128 + ((c ^ (row & 7)) << 4)) = *(const u32x4*)(w2t + (size_t)row * 128 + c16 * 8);
    }
    __syncthreads();
    f32x4 acc[2][4];
#pragma unroll
    for (int i = 0; i < 2; ++i)
#pragma unroll
        for (int j = 0; j < 4; ++j) acc[i][j] = (f32x4){0.f, 0.f, 0.f, 0.f};
    const int fo = l15 * 128 + ((q ^ (l15 & 7)) << 4);
#pragma unroll
    for (int kk = 0; kk < 2; ++kk)
#pragma unroll
        for (int ks = 0; ks < 2; ++ks) {
            bf16x8 hf[2], wf[4];
#pragma unroll
            for (int i = 0; i < 2; ++i) hf[i] = *(const bf16x8*)(smem + kk * 16384 + (((wave * 32 + i * 16) * 128 + fo) ^ (ks << 6)));
#pragma unroll
            for (int j = 0; j < 4; ++j) wf[j] = *(const bf16x8*)(smem + 32768 + kk * 8192 + ((j * 2048 + fo) ^ (ks << 6)));
#pragma unroll
            for (int i = 0; i < 2; ++i)
#pragma unroll
                for (int j = 0; j < 4; ++j) acc[i][j] = __builtin_amdgcn_mfma_f32_16x16x32_bf16(wf[j], hf[i], acc[i][j], 0, 0, 0);
        }
#pragma unroll
    for (int i = 0; i < 2; ++i) {
        const int row = rt * 128 + wave * 32 + i * 16 + l15; const int n = row & 255, bg = row >> 8;
#pragma unroll
        for (int j = 0; j < 4; ++j) {
            const int d0 = j * 16 + 4 * q; const f32x4 a = acc[i][j];
            if (which == 0) *(u32x2*)(KCb + (size_t)row * 64 + d0) = (u32x2){pack2bf(a[0], a[1]), pack2bf(a[2], a[3])};
            else {
                const int pos = (n & ~31) + vt_perm(n & 31);
#pragma unroll
                for (int r = 0; r < 4; ++r) VCT[((size_t)bg * 64 + d0 + r) * 256 + pos] = f2bf(a[r]);
            }
        }
    }
    __syncthreads();
}

DI void win_item(const bf16* __restrict__ P2, const bf16* __restrict__ VTw, bf16* __restrict__ OW, int item, char* smem) {
    constexpr int NQT = ANQT_WIN;
    int b, g, t0; attn_item_decode<16 * NQT>(item, b, g, t0);
    const int lane = TIDX & 63, wave = TIDX >> 6, q = lane >> 4, l15 = lane & 15;
    const size_t mbase = (size_t)b * T + t0; const int hbase = g * 4, h = hbase + (l15 & 3);
    bf16x8 qf[NQT][2]; attn_load_q<NQT>(qf, P2, LDP2, mbase, hbase);
    AttnStateT<NQT> st; attn_init<NQT>(st, at::M_INIT, 0.f);
    const int lo = t0 - 511 < 0 ? 0 : (t0 - 511) >> 6, hi = (t0 + 16 * NQT - 1) >> 6;
    const unsigned long long nosel[NQT] = {};
    attn_blocks<AM_WIN, NQT>(st, qf, P2 + (size_t)b * T * LDP2 + 1792 + g * 64, LDP2, VTw + (size_t)(b * G + g) * 64 * T, T, t0, range_mask(lo, hi), hbase, nosel, smem);
#pragma unroll
    for (int qt = 0; qt < NQT; ++qt) {
        const float li = attn_linv(st.lacc[qt]); const size_t m = mbase + wave * (4 * NQT) + qt * 4 + (l15 >> 2);
#pragma unroll
        for (int dt = 0; dt < 4; ++dt) { const f32x4 o = st.o[qt][dt]; *(u32x2*)(OW + m * D + h * 64 + dt * 16 + 4 * q) = (u32x2){pack2bf(o[0] * li, o[1] * li), pack2bf(o[2] * li, o[3] * li)}; }
    }
}

DI void cmpsel_item(const bf16* __restrict__ P2, const bf16* __restrict__ KCb, const bf16* __restrict__ VCT, bf16* __restrict__ OC, unsigned long long* __restrict__ SELM, int item, char* smem) {
    int b, g, t0; attn_item_decode<32>(item, b, g, t0);
    const int tid = TIDX, lane = tid & 63, wave = tid >> 6, q = lane >> 4, l15 = lane & 15;
    const size_t mbase = (size_t)b * T + t0; const int hbase = g * 4, h = hbase + (l15 & 3);
    float* impL = (float*)(smem + at::OFF_IMP);
    for (int i = tid; i < 32 * 64; i += NTHREADS) impL[i] = 0.f;
    bf16x8 qf[2][2]; attn_load_q<2>(qf, P2, LDP2, mbase, hbase);
    AttnStateT<2> st; attn_init<2>(st, at::M_INIT, 0.f);
    const int nvmax = (t0 + 31 - 31) / 16 + 1;
    const int hi = (nvmax - 1) >> 6;
    const bf16* Kp = KCb + (size_t)(b * G + g) * 256 * 64; const bf16* Vp = VCT + (size_t)(b * G + g) * 64 * 256;
    const unsigned long long nosel[2] = {0ull, 0ull};
    attn_blocks<AM_CMP, 2>(st, qf, Kp, 64, Vp, 256, t0, range_mask(0, hi), hbase, nosel, smem);
    float linv[2];
#pragma unroll
    for (int qt = 0; qt < 2; ++qt) {
        linv[qt] = attn_linv(st.lacc[qt]); const size_t m = mbase + wave * 8 + qt * 4 + (l15 >> 2);
#pragma unroll
        for (int dt = 0; dt < 4; ++dt) { const f32x4 o = st.o[qt][dt]; *(u32x2*)(OC + m * D + h * 64 + dt * 16 + 4 * q) = (u32x2){pack2bf(o[0] * linv[qt], o[1] * linv[qt]), pack2bf(o[2] * linv[qt], o[3] * linv[qt])}; }
    }
    {
        const int tq0 = t0 + wave * 8 + (l15 >> 2);
        const bf16* kp0 = Kp + (size_t)l15 * 64 + q * 8;
        bf16x8 kfA[4][2], kfB[4][2];
#define CS_LOADK(dst_, kb_) { _Pragma("unroll") for (int kt = 0; kt < 4; ++kt) _Pragma("unroll") for (int ks = 0; ks < 2; ++ks) \
            dst_[kt][ks] = *(const bf16x8*)(kp0 + (size_t)((kb_) * 64 + kt * 16) * 64 + ks * 32); }
#define CS_QSUM(x_) { x_ += __builtin_bit_cast(float, __builtin_amdgcn_update_dpp(0, __builtin_bit_cast(int, x_), 0xB1, 0xf, 0xf, false)); \
                      x_ += __builtin_bit_cast(float, __builtin_amdgcn_update_dpp(0, __builtin_bit_cast(int, x_), 0x4E, 0xf, 0xf, false)); }
#define CS_BLOCK(kf_, kb_) { const int kbi = (kb_); \
            f32x4 s[2][4]; \
            _Pragma("unroll") for (int qt = 0; qt < 2; ++qt) _Pragma("unroll") for (int kt = 0; kt < 4; ++kt) s[qt][kt] = (f32x4){0.f, 0.f, 0.f, 0.f}; \
            _Pragma("unroll") for (int kt = 0; kt < 4; ++kt) _Pragma("unroll") for (int ks = 0; ks < 2; ++ks) { \
                s[0][kt] = __builtin_amdgcn_mfma_f32_16x16x32_bf16(kf_[kt][ks], qf[0][ks], s[0][kt], 0, 0, 0); \
                s[1][kt] = __builtin_amdgcn_mfma_f32_16x16x32_bf16(kf_[kt][ks], qf[1][ks], s[1][kt], 0, 0, 0); } \
            const bool allvis = 16 * (kbi * 64 + 63) + 31 <= t0;         \
            _Pragma("unroll") for (int qt = 0; qt < 2; ++qt) { \
                const int tq = tq0 + 4 * qt; const int tl = wave * 8 + qt * 4 + (l15 >> 2); \
                _Pragma("unroll") for (int kt = 0; kt < 4; ++kt) { \
                    float pr[4]; \
                    _Pragma("unroll") for (int r = 0; r < 4; ++r) { const int key = kbi * 64 + kt * 16 + 4 * q + r; \
                        const float e = fast_exp2(s[qt][kt][r] - st.m[qt]) * linv[qt]; pr[r] = (allvis || 16 * key + 31 <= tq) ? e : 0.f; } \
                    float s4 = (pr[0] + pr[1]) + (pr[2] + pr[3]), s1 = pr[3]; \
                    CS_QSUM(s4); CS_QSUM(s1); \
                    const int s0 = kbi * 16 + kt * 4 + q; \
                    if ((l15 & 3) == 0) { atomicAdd(&impL[tl * 64 + s0], s4); if (s0 + 1 < 64) atomicAdd(&impL[tl * 64 + s0 + 1], s1); } \
                } \
            } }
        CS_LOADK(kfA, 0);
        for (int kb = 0; kb <= hi; kb += 2) {
            if (kb + 1 <= hi) CS_LOADK(kfB, kb + 1);
            CS_BLOCK(kfA, kb);
            if (kb + 1 > hi) break;
            if (kb + 2 <= hi) CS_LOADK(kfA, kb + 2);
            CS_BLOCK(kfB, kb + 1);
        }
#undef CS_LOADK
#undef CS_QSUM
#undef CS_BLOCK
        __syncthreads();
    }
    {
        const int tl = tid >> 3, sg = tid & 7; const int t = t0 + tl, cur = t >> 6; float* row = impL + tl * 64;
        unsigned hk[8]; unsigned long long mine[8];
#pragma unroll
        for (int j = 0; j < 8; ++j) { const int s = sg * 8 + j; const float v = row[s];
            hk[j] = (s == 0 || s == cur || s == cur - 1) ? 0x7F800000u : (s * 64 > t ? 0u : (v > 0.f ? __float_as_uint(v) + 1u : 1u));
            mine[j] = ((unsigned long long)hk[j] << 32) | (unsigned)(63 - s); }
        __syncthreads();
#pragma unroll
        for (int j = 0; j < 8; ++j) ((unsigned*)row)[sg * 8 + j] = hk[j];
        __syncthreads();
        int rank[8] = {0, 0, 0, 0, 0, 0, 0, 0};
        const int ns4 = ((((t0 + 31) >> 6) >> 2) + 2) & ~1;
#pragma unroll 2
        for (int s4 = 0; s4 < ns4; ++s4) {
            const u32x4 v4 = *(const u32x4*)(row + s4 * 4);
#pragma unroll
            for (int e = 0; e < 4; ++e) { const unsigned long long kv = ((unsigned long long)v4[e] << 32) | (unsigned)(63 - (s4 * 4 + e));
#pragma unroll
                for (int j = 0; j < 8; ++j) rank[j] += kv > mine[j] ? 1 : 0; }
        }
        unsigned long long bits = 0ull;
#pragma unroll
        for (int j = 0; j < 8; ++j) if (rank[j] < KTOP && (sg * 8 + j) * 64 <= t) bits |= 1ull << (sg * 8 + j);
        unsigned lo = (unsigned)bits, hi2 = (unsigned)(bits >> 32);
#pragma unroll
        for (int o = 1; o < 8; o <<= 1) { lo |= __shfl_xor(lo, o); hi2 |= __shfl_xor(hi2, o); }
        if (sg == 0) SELM[(mbase + tl) * 4 + g] = ((unsigned long long)hi2 << 32) | lo;
    }
    __syncthreads();
}

DI void sel_item(const bf16* __restrict__ P2, const bf16* __restrict__ VTs, const unsigned long long* __restrict__ SELM, const bf16* __restrict__ OC, const bf16* __restrict__ OW,
                 bf16* __restrict__ AO, int item, char* smem) {
    constexpr int NQT = ANQT_SEL;
    int b, g, t0; attn_item_decode<16 * NQT>(item, b, g, t0);
    const int tid = TIDX, lane = tid & 63, wave = tid >> 6, q = lane >> 4, l15 = lane & 15;
    const size_t mbase = (size_t)b * T + t0; const int hbase = g * 4, rr = l15 & 3, h = hbase + rr;
    unsigned long long* orw = (unsigned long long*)(smem + at::OFF_X);
    if (tid == 0) *orw = 0ull;
    __syncthreads();
    if (tid < 16 * NQT) atomicOr(orw, SELM[(mbase + tid) * 4 + g]);
    unsigned long long sel[NQT];
#pragma unroll
    for (int qt = 0; qt < NQT; ++qt) sel[qt] = SELM[(mbase + wave * (4 * NQT) + qt * 4 + (l15 >> 2)) * 4 + g];
    bf16x8 qf[NQT][2]; attn_load_q<NQT>(qf, P2, LDP2, mbase, hbase);
    AttnStateT<NQT> st; attn_init<NQT>(st, at::M_INIT, 0.f);
    __syncthreads();
    const unsigned long long todo_v = (*orw) & range_mask(0, (t0 + 16 * NQT - 1) >> 6);
    const unsigned long long todo = ((unsigned long long)(unsigned)__builtin_amdgcn_readfirstlane((int)(todo_v >> 32)) << 32) | (unsigned)__builtin_amdgcn_readfirstlane((int)(unsigned)todo_v);
    attn_blocks<AM_SEL, NQT>(st, qf, P2 + (size_t)b * T * LDP2 + 1536 + g * 64, LDP2, VTs + (size_t)(b * G + g) * 64 * T, T, t0, todo, hbase, sel, smem);
#pragma unroll
    for (int qt = 0; qt < NQT; ++qt) {
        const float li = attn_linv(st.lacc[qt]); const size_t m = mbase + wave * (4 * NQT) + qt * 4 + (l15 >> 2);
        const bf16* gr = P2 + m * LDP2 + 3072;
        const float g0 = sigmoidf_(bf2f(gr[0 * 16 + h])), g1 = sigmoidf_(bf2f(gr[1 * 16 + h])), g2 = sigmoidf_(bf2f(gr[2 * 16 + h]));
#pragma unroll
        for (int dt = 0; dt < 4; ++dt) {
            const int d0 = dt * 16 + 4 * q; const size_t oi = m * D + h * 64 + d0;
            const u32x2 zz = *(const u32x2*)(P2 + m * LDP2 + 2048 + h * 64 + d0), cc = *(const u32x2*)(OC + oi), ww = *(const u32x2*)(OW + oi);
            const f32x4 o = st.o[qt][dt];
            const float r0 = (g0 * bflo(cc[0]) + g1 * o[0] * li + g2 * bflo(ww[0])) * siluf_(bflo(zz[0]));
            const float r1 = (g0 * bfhi(cc[0]) + g1 * o[1] * li + g2 * bfhi(ww[0])) * siluf_(bfhi(zz[0]));
            const float r2 = (g0 * bflo(cc[1]) + g1 * o[2] * li + g2 * bflo(ww[1])) * siluf_(bflo(zz[1]));
            const float r3 = (g0 * bfhi(cc[1]) + g1 * o[3] * li + g2 * bfhi(ww[1])) * siluf_(bfhi(zz[1]));
            *(u32x2*)(AO + oi) = (u32x2){pack2bf(r0, r1), pack2bf(r2, r3)};
        }
    }
    __syncthreads();
}

DI void lru_convert_gates(const float* __restrict__ gaw, const float* __restrict__ gxw, bf16* __restrict__ img) {
    for (int i = blockIdx.x * NTHREADS + TIDX; i < 16 * 160 * 96; i += gridDim.x * NTHREADS) {
        const int k = i % 96, n = (i / 96) % 160, blk = i / (96 * 160);
        float v = 0.f;
        if (k < 80) v = n < 80 ? gaw[((size_t)blk * 80 + k) * 80 + n] : gxw[((size_t)blk * 80 + k) * 80 + (n - 80)];
        img[i] = f2bf(v);
    }
}
DI void lru_gate_item(const bf16* __restrict__ P3, const float* __restrict__ cw, const float* __restrict__ cb, const bf16* __restrict__ gimg, const float* __restrict__ gab, const float* __restrict__ gxb,
                      const float* __restrict__ lam, bf16* __restrict__ LA, bf16* __restrict__ BV, float2* __restrict__ SUM, int item, char* smem) {
    const int rt = item >> 4, nb = item & 15; const int tid = TIDX, lane = tid & 63, wave = tid >> 6, q = lane >> 4, l15 = lane & 15;
    const size_t m0 = (size_t)rt * 128;
    for (int id = tid; id < 128 * 12; id += NTHREADS) {
        const int row = id / 12, c12 = id % 12; u32x4 outv = (u32x4){0u, 0u, 0u, 0u};
        if (c12 < 10) {
            const size_t m = m0 + row; const int t = (int)(m % T); const int ch = nb * 80 + c12 * 8;
            float acc[8];
            { const float4 b0 = *(const float4*)(cb + ch), b1 = *(const float4*)(cb + ch + 4); acc[0] = b0.x; acc[1] = b0.y; acc[2] = b0.z; acc[3] = b0.w; acc[4] = b1.x; acc[5] = b1.y; acc[6] = b1.z; acc[7] = b1.w; }
#pragma unroll
            for (int w = 0; w < 4; ++w) {
                if (t - 3 + w >= 0) {
                    const u32x4 uv = *(const u32x4*)(P3 + (m - 3 + w) * 2560 + ch);
                    const float4 w0 = *(const float4*)(cw + w * LW + ch), w1 = *(const float4*)(cw + w * LW + ch + 4);
                    acc[0] += w0.x * bflo(uv[0]); acc[1] += w0.y * bfhi(uv[0]); acc[2] += w0.z * bflo(uv[1]); acc[3] += w0.w * bfhi(uv[1]);
                    acc[4] += w1.x * bflo(uv[2]); acc[5] += w1.y * bfhi(uv[2]); acc[6] += w1.z * bflo(uv[3]); acc[7] += w1.w * bfhi(uv[3]);
                }
            }
            outv = (u32x4){pack2bf(acc[0], acc[1]), pack2bf(acc[2], acc[3]), pack2bf(acc[4], acc[5]), pack2bf(acc[6], acc[7])};
        }
        const int ks = c12 >> 2, c = c12 & 3;
        *(u32x4*)(smem + ks * 8192 + row * 64 + ((c ^ ((row >> 2) & 3)) << 4)) = outv;
    }
    for (int id = tid; id < 160 * 12; id += NTHREADS) {
        const int row = id / 12, c12 = id % 12; const int ks = c12 >> 2, c = c12 & 3;
        *(u32x4*)(smem + 24576 + ks * 10240 + row * 64 + ((c ^ ((row >> 2) & 3)) << 4)) = *(const u32x4*)(gimg + ((size_t)nb * 160 + row) * 96 + c12 * 8);
    }
    __syncthreads();
    f32x4 acc[2][10];
#pragma unroll
    for (int i = 0; i < 2; ++i)
#pragma unroll
        for (int j = 0; j < 10; ++j) acc[i][j] = (f32x4){0.f, 0.f, 0.f, 0.f};
    const int fo = l15 * 64 + ((q ^ ((l15 >> 2) & 3)) << 4);
#pragma unroll
    for (int ks = 0; ks < 3; ++ks) {
        bf16x8 uf[2];
#pragma unroll
        for (int i = 0; i < 2; ++i) uf[i] = *(const bf16x8*)(smem + ks * 8192 + (wave * 32 + i * 16) * 64 + fo);
#pragma unroll
        for (int j = 0; j < 10; ++j) {
            const bf16x8 wf = *(const bf16x8*)(smem + 24576 + ks * 10240 + j * 1024 + fo);
            acc[0][j] = __builtin_amdgcn_mfma_f32_16x16x32_bf16(wf, uf[0], acc[0][j], 0, 0, 0);
            acc[1][j] = __builtin_amdgcn_mfma_f32_16x16x32_bf16(wf, uf[1], acc[1][j], 0, 0, 0);
        }
    }
    __syncthreads();
#pragma unroll
    for (int i = 0; i < 2; ++i) {
        const int row = wave * 32 + i * 16 + l15; const size_t m = m0 + row;
#pragma unroll
        for (int ct = 0; ct < 5; ++ct) {
            const int kcol = ct * 16 + 4 * q; const int ch = nb * 80 + kcol;
            const u32x2 uu = *(const u32x2*)(smem + (kcol >> 5) * 8192 + row * 64 + ((((kcol & 31) >> 3) ^ ((row >> 2) & 3)) << 4) + (kcol & 7) * 2);
            const float uc[4] = {bflo(uu[0]), bfhi(uu[0]), bflo(uu[1]), bfhi(uu[1])};
            const float4 ba = *(const float4*)(gab + ch), bx = *(const float4*)(gxb + ch), lm = *(const float4*)(lam + ch);
            const float bav[4] = {ba.x, ba.y, ba.z, ba.w}, bxv[4] = {bx.x, bx.y, bx.z, bx.w}, lmv[4] = {lm.x, lm.y, lm.z, lm.w};
            float la[4], bv[4];
#pragma unroll
            for (int r = 0; r < 4; ++r) {
                const float rg = __builtin_amdgcn_rcpf(1.0f + __expf(-(acc[i][ct][r] + bav[r]))), ig = __builtin_amdgcn_rcpf(1.0f + __expf(-(acc[i][ct + 5][r] + bxv[r])));
                la[r] = rg * lmv[r];
                const float om = 1.0f - __expf(2.0f * la[r]);
                bv[r] = __builtin_amdgcn_sqrtf(om > 0.f ? om : 0.f) * (ig * uc[r]);
            }
            const u32x2 lav = {pack2bf(la[0], la[1]), pack2bf(la[2], la[3])}, bvv = {pack2bf(bv[0], bv[1]), pack2bf(bv[2], bv[3])};
            *(u32x2*)(LA + m * LW + ch) = lav; *(u32x2*)(BV + m * LW + ch) = bvv;
            *(u32x2*)(smem + 24576 + (row * 80 + kcol) * 2) = lav; *(u32x2*)(smem + 24576 + 20480 + (row * 80 + kcol) * 2) = bvv;
        }
    }
    __syncthreads();
    if (tid < 160) {
        const int cidx = tid / 80, c = tid % 80; const bf16* li = (const bf16*)(smem + 24576) + (cidx * 64) * 80 + c; const bf16* bi = li + 10240;
        float sla = 0.f, h = 0.f;
#pragma unroll 8
        for (int t = 0; t < 64; ++t) { const float la = bf2f(li[t * 80]), bvv = bf2f(bi[t * 80]); h = __expf(la) * h + bvv; sla += la; }
        const size_t mc = m0 + cidx * 64; const int bb = (int)(mc / T), jj = (int)(mc % T) / 64;
        SUM[((size_t)bb * (T / 64) + jj) * LW + nb * 80 + c] = make_float2(__expf(sla), h);
    }
    __syncthreads();
}
DI void lru_scan2_item(const bf16* __restrict__ LA, const bf16* __restrict__ BV, const float2* __restrict__ SUM, const bf16* __restrict__ P3, bf16* __restrict__ AO, int item) {
    const int cg = item % 5, j = (item / 5) % (T / 64), b = item / (5 * (T / 64)); const int c = cg * 256 + TIDX;
    float h = 0.f;
    for (int jj = 0; jj < j; ++jj) { const float2 s = SUM[((size_t)b * (T / 64) + jj) * LW + c]; h = s.x * h + s.y; }
    const size_t m0 = (size_t)b * T + j * 64;
#pragma unroll 8
    for (int t = 0; t < 64; ++t) {
        const float la = bf2f(LA[(m0 + t) * LW + c]); const float bv = bf2f(BV[(m0 + t) * LW + c]); const float z = bf2f(P3[(m0 + t) * 2560 + LW + c]);
        h = __expf(la) * h + bv; AO[(m0 + t) * LW + c] = f2bf(h * siluf_(z));
    }
}

struct ALoadF32 {
    const float* A;
    static constexpr bool DMA = false;
    DI const bf16* src(int, int) const { return nullptr; }
    struct Raw { float4 a, b; };
    DI Raw load(int m, int k) const { Raw r; r.a = *(const float4*)(A + (size_t)m * 64 + k); r.b = *(const float4*)(A + (size_t)m * 64 + k + 4); return r; }
    DI u32x4 finish(const Raw& r, int, int) const { return (u32x4){pack2bf(r.a.x, r.a.y), pack2bf(r.a.z, r.a.w), pack2bf(r.b.x, r.b.y), pack2bf(r.b.z, r.b.w)}; }
};
struct EpiLora {
    const float* w0; const float* a0; bf16* WL; bf16* AV;
    DI void operator()(int m, int n, const float* v, int, int) const {
        float w[8];
        if (n < 1024) {
#pragma unroll
            for (int j = 0; j < 8; ++j) w[j] = -0.60653065971f * __builtin_amdgcn_rcpf(1.0f + __expf(-(w0[n + j] + v[j])));
            store8bf(WL + (size_t)m * D + n, w);
        } else {
#pragma unroll
            for (int j = 0; j < 8; ++j) w[j] = __builtin_amdgcn_rcpf(1.0f + __expf(-(a0[n - 1024 + j] + v[j])));
            store8bf(AV + (size_t)m * D + n - 1024, w);
        }
    }
    DI void finish(int, int, int, int, int) const {}
    DI void finish_wide(int, int, int, int, int) const {}
};
DI float dpp_sum16(float x) {
    x += __builtin_bit_cast(float, __builtin_amdgcn_update_dpp(0, __builtin_bit_cast(int, x), 0xB1, 0xf, 0xf, false));
    x += __builtin_bit_cast(float, __builtin_amdgcn_update_dpp(0, __builtin_bit_cast(int, x), 0x4E, 0xf, 0xf, false));
    x += __builtin_bit_cast(float, __builtin_amdgcn_update_dpp(0, __builtin_bit_cast(int, x), 0x141, 0xf, 0xf, false));
    x += __builtin_bit_cast(float, __builtin_amdgcn_update_dpp(0, __builtin_bit_cast(int, x), 0x140, 0xf, 0xf, false));
    return x;
}
constexpr int RW_NCH = T / 16;
DI void rwkv_prep_item(bf16* __restrict__ P, bf16* __restrict__ WL, bf16* __restrict__ AV, const float* __restrict__ k_k, const float* __restrict__ k_a, const float* __restrict__ r_k,
                       float* __restrict__ G15, bf16* __restrict__ M2g, bf16* __restrict__ M3g, float* __restrict__ BON, int item, char* smem) {
    const int c = item % RW_NCH, h = (item / RW_NCH) & 15, b = item / (RW_NCH * 16);
    const int tid = TIDX, t = tid >> 4, jq = tid & 15, j0 = jq * 4;
    const size_t m0 = (size_t)b * T + c * 16, m = m0 + t; const size_t ch = (size_t)(b * 16 + h) * RW_NCH + c;
    float* sA = (float*)smem; float* sR = sA + 16 * 68; float* sB = sR + 16 * 68; float* sK = sB + 16 * 68; float* sW = sK + 16 * 68; float* sWl = sW + 16 * 68;
    float* mAab = sWl + 16 * 64; float* mAak = mAab + 16 * 17; float* mArb = mAak + 16 * 17; float* mArk = mArb + 16 * 17; float* mTin = mArk + 16 * 17; float* mM2 = mTin + 16 * 17;
    const u32x2 r2 = *(const u32x2*)(P + m * 4096 + h * 64 + j0), k2 = *(const u32x2*)(P + m * 4096 + 1024 + h * 64 + j0), a2 = *(const u32x2*)(AV + m * D + h * 64 + j0), w2 = *(const u32x2*)(WL + m * D + h * 64 + j0);
    const float rr[4] = {bflo(r2[0]), bfhi(r2[0]), bflo(r2[1]), bfhi(r2[1])}, kr[4] = {bflo(k2[0]), bfhi(k2[0]), bflo(k2[1]), bfhi(k2[1])},
                av[4] = {bflo(a2[0]), bfhi(a2[0]), bflo(a2[1]), bfhi(a2[1])}, wl[4] = {bflo(w2[0]), bfhi(w2[0]), bflo(w2[1]), bfhi(w2[1])};
    const float4 kk4 = *(const float4*)(k_k + h * 64 + j0), ka4 = *(const float4*)(k_a + h * 64 + j0), rk4 = *(const float4*)(r_k + h * 64 + j0);
    const float kkc[4] = {kk4.x, kk4.y, kk4.z, kk4.w}, kac[4] = {ka4.x, ka4.y, ka4.z, ka4.w}, rkc[4] = {rk4.x, rk4.y, rk4.z, rk4.w};
    float kkv[4], n2 = 0.f;
#pragma unroll
    for (int e = 0; e < 4; ++e) { kkv[e] = kr[e] * kkc[e]; n2 += kkv[e] * kkv[e]; }
    n2 = dpp_sum16(n2);
    float nr = sqrtf(n2); nr = nr > 1e-12f ? nr : 1e-12f; const float inr = 1.0f / nr;
    float aa[4], bb[4], kp[4], bon = 0.f;
#pragma unroll
    for (int e = 0; e < 4; ++e) { const float kn = kkv[e] * inr; aa[e] = -kn; bb[e] = kn * av[e]; kp[e] = kr[e] * (1.0f + (av[e] - 1.0f) * kac[e]); bon += rr[e] * kp[e] * rkc[e]; }
    bon = dpp_sum16(bon);
    if (jq == 0) BON[m * 16 + h] = bon;
    *(float4*)(sWl + t * 64 + j0) = make_float4(wl[0], wl[1], wl[2], wl[3]);
    __syncthreads();
    float clx[4] = {0.f, 0.f, 0.f, 0.f};
#pragma unroll
    for (int s = 0; s < 15; ++s) { if (s < t) { const float4 w = *(const float4*)(sWl + s * 64 + j0); clx[0] += w.x; clx[1] += w.y; clx[2] += w.z; clx[3] += w.w; } }
    float bt[4];
    {
        float va[4], vr[4], vk[4], gc[4];
#pragma unroll
        for (int e = 0; e < 4; ++e) { const float cl = clx[e] + wl[e]; const float gp = __expf(clx[e]), gi = __expf(-cl); gc[e] = __expf(cl); va[e] = aa[e] * gp; vr[e] = rr[e] * gc[e]; bt[e] = bb[e] * gi; vk[e] = kp[e] * gi; }
        *(float4*)(sA + t * 68 + j0) = make_float4(va[0], va[1], va[2], va[3]); *(float4*)(sR + t * 68 + j0) = make_float4(vr[0], vr[1], vr[2], vr[3]);
        *(float4*)(sB + t * 68 + j0) = make_float4(bt[0], bt[1], bt[2], bt[3]); *(float4*)(sK + t * 68 + j0) = make_float4(vk[0], vk[1], vk[2], vk[3]);
        {
            char* img = (char*)(mM2 + 16 * 17) + t * 128 + (((j0 >> 3) ^ (t & 7)) << 4) + (j0 & 4) * 2;
            *(u32x2*)(img) = (u32x2){pack2bf(va[0], va[1]), pack2bf(va[2], va[3])}; *(u32x2*)(img + 2048) = (u32x2){pack2bf(vr[0], vr[1]), pack2bf(vr[2], vr[3])};
            *(u32x2*)(img + 4096) = (u32x2){pack2bf(bt[0], bt[1]), pack2bf(bt[2], bt[3])}; *(u32x2*)(img + 6144) = (u32x2){pack2bf(vk[0], vk[1]), pack2bf(vk[2], vk[3])};
        }
        if (t == 15) *(float4*)(G15 + ch * 64 + j0) = make_float4(gc[0], gc[1], gc[2], gc[3]);
#pragma unroll
        for (int e = 0; e < 4; ++e) {   }
#pragma unroll
        for (int e = 0; e < 4; ++e) clx[e] = vk[e];
    }
    __syncthreads();
    {
        const int wv = __builtin_amdgcn_readfirstlane(tid >> 6), lane = tid & 63, q = lane >> 4, l15 = lane & 15;
        const char* xb_ = (const char*)(mM2 + 16 * 17) + (wv >> 1) * 2048;
        const char* yb_ = (const char*)(mM2 + 16 * 17) + 4096 + (wv & 1) * 2048;
        f32x4 acc = {0.f, 0.f, 0.f, 0.f};
#pragma unroll
        for (int ks = 0; ks < 2; ++ks) {
            const int off = l15 * 128 + (((ks * 4 + q) ^ (l15 & 7)) << 4);
            const bf16x8 xf = *(const bf16x8*)(xb_ + off), yf = *(const bf16x8*)(yb_ + off);
            acc = __builtin_amdgcn_mfma_f32_16x16x32_bf16(xf, yf, acc, 0, 0, 0);
        }
        float* dst = wv == 0 ? mAab : (wv == 1 ? mAak : (wv == 2 ? mArb : mArk));
        const bool strict = wv < 2;
#pragma unroll
        for (int r = 0; r < 4; ++r) { const int tt = 4 * q + r, ss = l15; dst[tt * 17 + ss] = (strict ? ss < tt : ss <= tt) ? acc[r] : 0.f; }
    }
    __syncthreads();
    if (tid < 16) {
        float col[16];
#pragma unroll
        for (int i = 0; i < 16; ++i) {
            float acc = (i == tid) ? 1.0f : 0.f;
#pragma unroll
            for (int jj = 0; jj < i; ++jj) acc += mAab[i * 17 + jj] * col[jj];
            col[i] = acc; mTin[i * 17 + tid] = acc;
        }
    }
    __syncthreads();
    float wv[4] = {0.f, 0.f, 0.f, 0.f}, m2 = 0.f;
#pragma unroll
    for (int s = 0; s < 16; ++s) { const float ti = mTin[t * 17 + s]; const float4 a4 = *(const float4*)(sA + s * 68 + j0); wv[0] += ti * a4.x; wv[1] += ti * a4.y; wv[2] += ti * a4.z; wv[3] += ti * a4.w; m2 += ti * mAak[s * 17 + jq]; }
    *(float4*)(sW + t * 68 + j0) = make_float4(wv[0], wv[1], wv[2], wv[3]); mM2[t * 17 + jq] = m2;
    __syncthreads();
    float rh[4]; { const float4 r4 = *(const float4*)(sR + t * 68 + j0); rh[0] = r4.x; rh[1] = r4.y; rh[2] = r4.z; rh[3] = r4.w; }
    float m3 = mArk[t * 17 + jq];
#pragma unroll
    for (int s = 0; s < 16; ++s) { const float ar = mArb[t * 17 + s]; const float4 w4 = *(const float4*)(sW + s * 68 + j0); rh[0] += ar * w4.x; rh[1] += ar * w4.y; rh[2] += ar * w4.z; rh[3] += ar * w4.w; m3 += ar * mM2[s * 17 + jq]; }
    *(u32x2*)(WL + m * D + h * 64 + j0) = (u32x2){pack2bf(wv[0], wv[1]), pack2bf(wv[2], wv[3])};
    *(u32x2*)(P + m * 4096 + h * 64 + j0) = (u32x2){pack2bf(rh[0], rh[1]), pack2bf(rh[2], rh[3])};
#pragma unroll
    for (int e = 0; e < 4; ++e) { AV[(m0 + jq) * D + h * 64 + e * 16 + t] = f2bf(bt[e]); P[(m0 + jq) * 4096 + 1024 + h * 64 + e * 16 + t] = f2bf(clx[e]); }
    M2g[ch * 256 + t * 16 + jq] = f2bf(m2); M3g[ch * 256 + t * 16 + jq] = f2bf(m3);
    __syncthreads();
}

#define MFMA32(a, b, c) __builtin_amdgcn_mfma_f32_16x16x32_bf16(__builtin_bit_cast(bf16x8, a), __builtin_bit_cast(bf16x8, b), c, 0, 0, 0)
DI void rwkv_chunk_scan(const bf16* __restrict__ P, const bf16* __restrict__ WL, const bf16* __restrict__ AV, const float* __restrict__ G15, const bf16* __restrict__ M2g, const bf16* __restrict__ M3g,
                        bf16* __restrict__ YS, int bh, char* smem) {
    constexpr int SLOT = 12288, YOFF = 49152;
    const int tid = TIDX, lane = tid & 63, vs = __builtin_amdgcn_readfirstlane(tid >> 6), q = lane >> 4, l15 = lane & 15; const int b = bh >> 4, h = bh & 15;
    const size_t mb = (size_t)b * T; const size_t ch0 = (size_t)(b * 16 + h) * RW_NCH;
    const char *s0, *s1, *s2; size_t d0, d1, d2;
    if (tid < 128) { const int c8 = tid >> 4, t = tid & 15; s0 = (const char*)(WL + (mb + t) * D + h * 64 + c8 * 8); d0 = (size_t)16 * D * 2; }
    else { const int pp = tid - 128, c8 = pp >> 4, t = pp & 15; s0 = (const char*)(P + (mb + t) * 4096 + h * 64 + c8 * 8); d0 = (size_t)16 * 4096 * 2; }
    if (tid < 128) { const int r = tid >> 3, c8 = tid & 7; s1 = (const char*)(P + (mb + r) * 4096 + 1024 + h * 64 + c8 * 8); d1 = (size_t)16 * 4096 * 2; }
    else { const int pp = tid - 128, r = pp >> 3, c8 = pp & 7; s1 = (const char*)(AV + (mb + r) * D + h * 64 + c8 * 8); d1 = (size_t)16 * D * 2; }
    if (tid < 128) { const int r = tid >> 3, c8 = tid & 7; s2 = (const char*)(P + (mb + r) * 4096 + 2048 + h * 64 + c8 * 8); d2 = (size_t)16 * 4096 * 2; }
    else if (tid < 160) { s2 = (const char*)(M2g + ch0 * 256 + (tid - 128) * 8); d2 = 512; }
    else if (tid < 192) { s2 = (const char*)(M3g + ch0 * 256 + (tid - 160) * 8); d2 = 512; }
    else { const int pp = tid < 208 ? tid - 192 : 0; s2 = (const char*)(G15 + ch0 * 64 + pp * 4); d2 = 256; }
    const int dma_off = vs * 1024;
#define RW_DMA(c_) { char* dst = smem + ((c_) & 3) * SLOT + dma_off; GLDS16(s0 + (size_t)(c_) * d0, dst); GLDS16(s1 + (size_t)(c_) * d1, dst + 4096); GLDS16(s2 + (size_t)(c_) * d2, dst + 8192); }
#define RW_BARRIER() { asm volatile("s_waitcnt lgkmcnt(0)" ::: "memory"); __builtin_amdgcn_s_barrier(); asm volatile("" ::: "memory"); }
    f32x4 H0 = {0.f, 0.f, 0.f, 0.f}, H1 = H0, H2 = H0, H3 = H0;
    const int oW = (((q >> 1)) * 16 + l15) * 16 + (q & 1) * 8;
    const int oK = 4096 + ((l15 >> 2) * 8 + (l15 & 3) * 2 + (q >> 1)) * 16 + (q & 1) * 8;
    const int oM = 10240 + l15 * 32 + q * 8;
    const int oV = 8192 + (4 * q) * 128 + (vs * 16 + l15) * 2;
    const int oG = 11264 + (4 * q) * 4;
    const int oY = YOFF + ((4 * q) * 64 + vs * 16 + l15) * 2;
    RW_DMA(0); RW_DMA(1); RW_DMA(2);
    asm volatile("s_waitcnt vmcnt(6)" ::: "memory");
    RW_BARRIER();
    for (int c = 0; c < RW_NCH; ++c) {
        if (c + 3 < RW_NCH) RW_DMA(c + 3);
        const char* sl = smem + (c & 3) * SLOT;
        {
            const f32x4 z4 = {0.f, 0.f, 0.f, 0.f};
            const u32x4 Hb0 = {pack2bf(H0[0], H0[1]), pack2bf(H0[2], H0[3]), pack2bf(H1[0], H1[1]), pack2bf(H1[2], H1[3])};
            const u32x4 Hb1 = {pack2bf(H2[0], H2[1]), pack2bf(H2[2], H2[3]), pack2bf(H3[0], H3[1]), pack2bf(H3[2], H3[3])};
            const unsigned v0 = *(const bf16*)(sl + oV), v1 = *(const bf16*)(sl + oV + 128), v2 = *(const bf16*)(sl + oV + 256), v3 = *(const bf16*)(sl + oV + 384);
            const unsigned v01 = v0 | (v1 << 16), v23 = v2 | (v3 << 16);
            const u32x4 Vlo = {v01, v23, 0u, 0u};
            const u32x2 m2 = *(const u32x2*)(sl + oM), m3 = *(const u32x2*)(sl + oM + 512);
            const u32x2 w0 = *(const u32x2*)(sl + oW), w1 = *(const u32x2*)(sl + oW + 512), w2 = *(const u32x2*)(sl + oW + 1024), w3 = *(const u32x2*)(sl + oW + 1536);
            const u32x2 r0 = *(const u32x2*)(sl + 2048 + oW), r1 = *(const u32x2*)(sl + 2048 + oW + 512), r2 = *(const u32x2*)(sl + 2048 + oW + 1024), r3 = *(const u32x2*)(sl + 2048 + oW + 1536);
            f32x4 U = MFMA32(((u32x4){m2[0], m2[1], 0u, 0u}), Vlo, z4);
            U = MFMA32(((u32x4){w0[0], w0[1], w1[0], w1[1]}), Hb0, U); U = MFMA32(((u32x4){w2[0], w2[1], w3[0], w3[1]}), Hb1, U);
            f32x4 Y = MFMA32(((u32x4){m3[0], m3[1], 0u, 0u}), Vlo, z4);
            Y = MFMA32(((u32x4){r0[0], r0[1], r1[0], r1[1]}), Hb0, Y); Y = MFMA32(((u32x4){r2[0], r2[1], r3[0], r3[1]}), Hb1, Y);
            const u32x4 VU = {v01, v23, pack2bf(U[0], U[1]), pack2bf(U[2], U[3])};
            const u32x2 k0 = *(const u32x2*)(sl + oK), k1 = *(const u32x2*)(sl + oK + 512), k2 = *(const u32x2*)(sl + oK + 1024), k3 = *(const u32x2*)(sl + oK + 1536);
            const u32x2 b0 = *(const u32x2*)(sl + 2048 + oK), b1 = *(const u32x2*)(sl + 2048 + oK + 512), b2 = *(const u32x2*)(sl + 2048 + oK + 1024), b3 = *(const u32x2*)(sl + 2048 + oK + 1536);
            const f32x4 g0 = *(const f32x4*)(sl + oG), g1 = *(const f32x4*)(sl + oG + 64), g2 = *(const f32x4*)(sl + oG + 128), g3 = *(const f32x4*)(sl + oG + 192);
            const f32x4 a0 = MFMA32(((u32x4){k0[0], k0[1], b0[0], b0[1]}), VU, H0), a1 = MFMA32(((u32x4){k1[0], k1[1], b1[0], b1[1]}), VU, H1);
            const f32x4 a2 = MFMA32(((u32x4){k2[0], k2[1], b2[0], b2[1]}), VU, H2), a3 = MFMA32(((u32x4){k3[0], k3[1], b3[0], b3[1]}), VU, H3);
            H0 = a0 * g0; H1 = a1 * g1; H2 = a2 * g2; H3 = a3 * g3;
            char* yb = smem + oY + (c & 7) * 2048;
#pragma unroll
            for (int r = 0; r < 4; ++r) *(bf16*)(yb + r * 128) = f2bf(Y[r]);
        }
        const bool flush = (c & 7) == 7;
        if (flush) {
            RW_BARRIER();
            u32x4 yv[4];
#pragma unroll
            for (int k = 0; k < 4; ++k) yv[k] = *(const u32x4*)(smem + YOFF + (tid + 256 * k) * 16);
#pragma unroll
            for (int k = 0; k < 4; ++k) { const int pc = tid + 256 * k, rr = pc >> 3, c8 = pc & 7; *(u32x4*)(YS + (mb + (size_t)(c - 7) * 16 + rr) * D + h * 64 + c8 * 8) = yv[k]; }
            asm volatile("s_waitcnt vmcnt(0)" ::: "memory");
        } else if (c + 3 < RW_NCH) { asm volatile("s_waitcnt vmcnt(6)" ::: "memory"); }
        else if (c + 2 < RW_NCH) { asm volatile("s_waitcnt vmcnt(3)" ::: "memory"); }
        else { asm volatile("s_waitcnt vmcnt(0)" ::: "memory"); }
        RW_BARRIER();
    }
#undef RW_DMA
#undef RW_BARRIER
}
DI void rwkv_gn_rows2(const bf16* __restrict__ P, const float* __restrict__ BON, const float* __restrict__ lnw, const float* __restrict__ lnb, bf16* __restrict__ YS) {
    const int tid = TIDX, lane = tid & 63, wave = tid >> 6; const int c = wave * 256 + lane * 4;
    const float4 lw = *(const float4*)(lnw + c), lb = *(const float4*)(lnb + c);
    for (size_t m = blockIdx.x; m < (size_t)M; m += gridDim.x) {
        const u32x2 yy = *(const u32x2*)(YS + m * D + c), vv = *(const u32x2*)(P + m * 4096 + 2048 + c), zz = *(const u32x2*)(P + m * 4096 + 3072 + c);
        const float bs = BON[m * 16 + (c >> 6)];
        const float y[4] = {bflo(yy[0]), bfhi(yy[0]), bflo(yy[1]), bfhi(yy[1])}, v[4] = {bflo(vv[0]), bfhi(vv[0]), bflo(vv[1]), bfhi(vv[1])}, z[4] = {bflo(zz[0]), bfhi(zz[0]), bflo(zz[1]), bfhi(zz[1])};
        const float lwv[4] = {lw.x, lw.y, lw.z, lw.w}, lbv[4] = {lb.x, lb.y, lb.z, lb.w};
        const float mean = dpp_sum16((y[0] + y[1]) + (y[2] + y[3])) * (1.0f / 64.0f);
        float var = 0.f;
#pragma unroll
        for (int i = 0; i < 4; ++i) { const float d = y[i] - mean; var += d * d; }
        var = dpp_sum16(var) * (1.0f / 64.0f);
        const float rstd = 1.0f / sqrtf(var + 64e-5f);
        float o[4];
#pragma unroll
        for (int i = 0; i < 4; ++i) o[i] = ((y[i] - mean) * rstd * lwv[i] + lbv[i] + bs * v[i]) * siluf_(z[i]);
        *(u32x2*)(YS + m * D + c) = (u32x2){pack2bf(o[0], o[1]), pack2bf(o[2], o[3])};
    }
}

struct FastBufs { char* ws; };

DI void rows_xb_parts(const float* __restrict__ x, bf16* xb, float* parts) {
    const int lane = TIDX & 63, wave = TIDX >> 6;
    for (int m = blockIdx.x * 4 + wave; m < M; m += gridDim.x * 4) {
        const float* xr = x + (size_t)m * D; float s = 0.f;
#pragma unroll
        for (int i = 0; i < 2; ++i) {
            const int k = (i * 64 + lane) * 8; const float4 a = *(const float4*)(xr + k), b = *(const float4*)(xr + k + 4);
            const float w[8] = {a.x, a.y, a.z, a.w, b.x, b.y, b.z, b.w};
#pragma unroll
            for (int j = 0; j < 8; ++j) s += w[j] * w[j];
            store8bf(xb + (size_t)m * D + k, w);
        }
#pragma unroll
        for (int o = 32; o >= 1; o >>= 1) s += __shfl_xor(s, o);
        if (lane < 16) parts[(size_t)m * 16 + lane] = lane == 0 ? s : 0.f;
    }
}
DI void rows_xn(const float* __restrict__ x, const float* parts, const float* __restrict__ g, bf16* xn) {
    const int lane = TIDX & 63, wave = TIDX >> 6;
    for (int m = blockIdx.x * 4 + wave; m < M; m += gridDim.x * 4) {
        const float rs = rstd_from_parts(parts, m); const float* xr = x + (size_t)m * D;
#pragma unroll
        for (int i = 0; i < 2; ++i) {
            const int k = (i * 64 + lane) * 8; const float4 a = *(const float4*)(xr + k), b = *(const float4*)(xr + k + 4);
            const float4 ga = *(const float4*)(g + k), gb = *(const float4*)(g + k + 4);
            const float w[8] = {a.x * rs * ga.x, a.y * rs * ga.y, a.z * rs * ga.z, a.w * rs * ga.w, b.x * rs * gb.x, b.y * rs * gb.y, b.z * rs * gb.z, b.w * rs * gb.w};
            store8bf(xn + (size_t)m * D + k, w);
        }
    }
}
DI void rows_final(float* x, const float* parts, const float* __restrict__ g) {
    const int lane = TIDX & 63, wave = TIDX >> 6;
    for (int m = blockIdx.x * 4 + wave; m < M; m += gridDim.x * 4) {
        const float rs = rstd_from_parts(parts, m); float* xr = x + (size_t)m * D;
#pragma unroll
        for (int i = 0; i < 4; ++i) {
            const int k = (i * 64 + lane) * 4; float4 a = *(float4*)(xr + k); const float4 ga = *(const float4*)(g + k);
            a.x *= rs * ga.x; a.y *= rs * ga.y; a.z *= rs * ga.z; a.w *= rs * ga.w; *(float4*)(xr + k) = a;
        }
    }
}
enum { PH_PREP0 = 0, PH_IN0, PH_ATTN0, PH_OUT0, PH_PREP1, PH_IN1, PH_LORA1, PH_CPREP1, PH_SCAN1, PH_GN1, PH_OUT1, PH_PREP2, PH_IN2, PH_B2, PH_C2, PH_D2, PH_OUT2, PH_PREP3, PH_IN3, PH_GATE3, PH_SCANA3, PH_SCANB3, PH_OUT3, PH_FINAL };

namespace wbo {
constexpr size_t IN = 0;
constexpr size_t OUT = (size_t)4352 * 1024;
constexpr size_t EXTRA = OUT + (size_t)1280 * 1024;
}

template <int PH>
DI void run_phase(const Params& p, char* smem) {
    char* ws = p.ws;
    float* parts = (float*)(ws + fw::PARTS);
    constexpr int LAYER = PH <= PH_OUT0 ? 0 : PH <= PH_OUT1 ? 1 : PH <= PH_OUT2 ? 2 : 3;
    constexpr size_t WBOFF = LAYER == 0 ? 200 * fw::MB : LAYER == 1 ? 238 * fw::MB : LAYER == 2 ? 240 * fw::MB : 1 * fw::MB;
    bf16* WB = (bf16*)(ws + WBOFF);
    bf16* XB = (bf16*)(ws + ((PH == PH_PREP0 || PH == PH_IN0) ? 130 * fw::MB : 174 * fw::MB));
    bf16* P = (bf16*)(ws + wsl::P);
    float* X = p.out;
    float* smf = (float*)smem;
    if (PH == PH_PREP0) {
        rows_xb_parts(p.x, XB, parts);
        int tb = 0;
        convert_seg(p.a_w_in, A_COLS, 0, A_COLS, 1024, WB + wbo::IN, p.norm_g + 0 * D, smf, tb);
        convert_seg(p.a_w_out, 1024, 0, 1024, 1024, WB + wbo::OUT, nullptr, smf, tb);
    } else if (PH == PH_IN0) {
        gemm_sched(8, 4, [&](bool big, int mt, int nt) {
            if (big) gemm_tile2(ALoadPlain{XB, D}, WB + wbo::IN, 1024, mt * 128, nt * 256, EpiL0{P, (bf16*)(ws + 86 * fw::MB), parts}, smem);
            else gemm_tile(ALoadPlain{XB, D}, WB + wbo::IN, 1024, mt * 128, 2048 + nt * 128, EpiL0{P, (bf16*)(ws + 86 * fw::MB), parts}, smem);
        });
    } else if (PH == PH_ATTN0) {
        build_bias_lut(p.t5, smem, true);
        for (int it = blockIdx.x; it < B * G * (T / (16 * ANQT_SWA)); it += gridDim.x) swa_item(P, (const bf16*)(ws + 86 * fw::MB), p.a_sinks, (bf16*)(ws + wsl::L0_AO), it, smem);
    } else if (PH == PH_OUT0) {
        gemm_sched(4, 0, [&](bool, int mt, int nt) { gemm_tile2(ALoadPlain{(const bf16*)(ws + wsl::L0_AO), D}, WB + wbo::OUT, 1024, mt * 128, nt * 256, EpiResid{p.x, X, nullptr, parts}, smem); });
    } else if (PH == PH_PREP1) {
        rows_xn(X, parts, p.norm_g + 1 * D, (bf16*)(ws + wsl::L1_XN));
        int tb = 0;
        convert_seg(p.b_w_in, 4096, 0, 4096, 1024, WB + wbo::IN, nullptr, smf, tb);
        convert_seg(p.b_w1, 64, 0, 64, 1024, WB + wbo::IN + (size_t)4096 * 1024, nullptr, smf, tb);
        convert_seg(p.b_a1, 64, 0, 64, 1024, WB + wbo::IN + (size_t)(4096 + 128) * 1024, nullptr, smf, tb);
        convert_seg(p.b_w_out, 1024, 0, 1024, 1024, WB + wbo::OUT, nullptr, smf, tb);
        convert_seg(p.b_w2, 1024, 0, 1024, 64, WB + wbo::EXTRA, nullptr, smf, tb);
        convert_seg(p.b_a2, 1024, 0, 1024, 64, WB + wbo::EXTRA + (size_t)1024 * 64, nullptr, smf, tb);
        for (size_t i = (size_t)blockIdx.x * 256 + TIDX; i < (size_t)64 * 1024 / 8; i += (size_t)gridDim.x * 256) {
            ((u32x4*)(WB + wbo::IN + (size_t)(4096 + 64) * 1024))[i] = (u32x4){0u, 0u, 0u, 0u};
            ((u32x4*)(WB + wbo::IN + (size_t)(4096 + 192) * 1024))[i] = (u32x4){0u, 0u, 0u, 0u};
        }
    } else if (PH == PH_IN1) {
        const bf16* XN = (const bf16*)(ws + wsl::L1_XN);
        EpiRwkv epi{P, (float*)(ws + wsl::LHW), (float*)(ws + wsl::LHA)};
        gemm_sched(16, 2, [&](bool big, int mt, int nt) {
            if (big) gemm_tile2(ALoadLerp{XN, p.b_mu + (nt >> 2) * D}, WB + wbo::IN, 1024, mt * 128, nt * 256, epi, smem);
            else gemm_tile(ALoadLerp{XN, p.b_mu + (4 + nt) * D}, WB + wbo::IN, 1024, mt * 128, 4096 + nt * 128, epi, smem);
        });
    } else if (PH == PH_LORA1) {
        const int ntile = (M / 128) * 16;
        EpiLora epi{p.b_w0, p.b_a0, (bf16*)(ws + wsl::L1_WL), (bf16*)(ws + wsl::L1_AV)};
        (void)ntile;
        gemm_sched(8, 0, [&](bool, int mt, int nt) { gemm_tile2(ALoadF32{(const float*)(ws + (nt < 4 ? wsl::LHW : wsl::LHA))}, WB + wbo::EXTRA, 64, mt * 128, nt * 256, epi, smem); });
    } else if (PH == PH_CPREP1) {
        for (int it = blockIdx.x; it < B * 16 * RW_NCH; it += gridDim.x)
            rwkv_prep_item(P, (bf16*)(ws + wsl::L1_WL), (bf16*)(ws + wsl::L1_AV), p.b_k_k, p.b_k_a, p.b_r_k, (float*)(ws + 9 * fw::MB), (bf16*)(ws + 1 * fw::MB), WB, (float*)(ws + 254 * fw::MB), it, smem);
    } else if (PH == PH_SCAN1) {
        const int bid = blockIdx.x;
        if ((bid & 31) < 8 && (bid >> 5) < 8) {
            const int it = (bid >> 5) * 8 + (bid & 31);
            rwkv_chunk_scan(P, (const bf16*)(ws + wsl::L1_WL), (const bf16*)(ws + wsl::L1_AV), (const float*)(ws + 9 * fw::MB), (const bf16*)(ws + 1 * fw::MB), WB, (bf16*)(ws + wsl::L1_XN), it, smem);
        }
    } else if (PH == PH_GN1) {
        rwkv_gn_rows2(P, (const float*)(ws + 254 * fw::MB), p.b_lnx_w, p.b_lnx_b, (bf16*)(ws + wsl::L1_XN));
    } else if (PH == PH_OUT1) {
        gemm_sched(4, 0, [&](bool, int mt, int nt) { gemm_tile2(ALoadPlain{(const bf16*)(ws + wsl::L1_XN), D}, WB + wbo::OUT, 1024, mt * 128, nt * 256, EpiResid{X, X, XB, parts}, smem); });
    } else if (PH == PH_PREP2) {
        int tb = 0;
        const float* g2 = p.norm_g + 2 * D;
        convert_seg(p.c_w_in, C_COLS, 0, 2560, 1024, WB + wbo::IN, g2, smf, tb);
        convert_seg(p.c_w_in, C_COLS, 2608, 1024, 1024, WB + wbo::IN + (size_t)2560 * 1024, g2, smf, tb);
        convert_seg(p.c_w_in, C_COLS, 2560, 64, 1024, WB + wbo::IN + (size_t)3584 * 1024, g2, smf, tb);
        convert_seg(p.c_w_out, 1024, 0, 1024, 1024, WB + wbo::OUT, nullptr, smf, tb);
        convert_seg(p.c_k_w1, 128, 0, 128, 2048, WB + wbo::EXTRA, nullptr, smf, tb);
        convert_seg(p.c_v_w1, 128, 0, 128, 2048, WB + wbo::EXTRA + (size_t)128 * 2048, nullptr, smf, tb);
        convert_seg(p.c_k_w2, 64, 0, 64, 128, WB + wbo::EXTRA + (size_t)256 * 2048, nullptr, smf, tb);
        convert_seg(p.c_v_w2, 64, 0, 64, 128, WB + wbo::EXTRA + (size_t)256 * 2048 + 64 * 128, nullptr, smf, tb);
        if (blockIdx.x < 16) {
            const int which = blockIdx.x >> 3, i = blockIdx.x & 7; const float* pos = which ? p.c_pos_v : p.c_pos_k; const float* w1 = which ? p.c_v_w1 : p.c_k_w1;
            float* b8 = (float*)(ws + 12 * fw::MB);
            if (TIDX < 128) { float a = 0.f; for (int k = i * 256; k < i * 256 + 256; ++k) a += pos[k] * w1[(size_t)k * 128 + TIDX]; b8[(which * 8 + i) * 128 + TIDX] = a; }
        }
    } else if (PH == PH_IN2) {
        gemm_sched(14, 1, [&](bool big, int mt, int nt) {
            if (big) gemm_tile2(ALoadPlain{XB, D}, WB + wbo::IN, 1024, mt * 128, nt * 256, EpiL2{P, (bf16*)(ws + 114 * fw::MB), (bf16*)(ws + 122 * fw::MB), parts}, smem);
            else gemm_tile(ALoadPlain{XB, D}, WB + wbo::IN, 1024, mt * 128, 3584 + nt * 128, EpiL2{P, (bf16*)(ws + 114 * fw::MB), (bf16*)(ws + 122 * fw::MB), parts}, smem);
        });
    } else if (PH == PH_B2) {
        for (int it = blockIdx.x; it < 64; it += gridDim.x) { const int which = it >> 5, rt = it & 31;
            cmp_tile(P, WB + wbo::EXTRA + (size_t)which * 128 * 2048, (const float*)(ws + 12 * fw::MB) + which * 8 * 128, WB + wbo::EXTRA + (size_t)256 * 2048 + which * 64 * 128, which, rt,
                     (bf16*)(ws + 5 * fw::MB), (bf16*)(ws + 6 * fw::MB), smem); }
        build_bias_lut(p.t5, smem, false);
        const int nwin = B * G * (T / (16 * ANQT_WIN));
        const bool split = gridDim.x == 512 && nwin == 2048;
        const int bid = blockIdx.x, nb = bid - 64, cnt = bid < 64 ? 2 : (nb < 128 ? 5 : 4);
        for (int k = 0;; ++k) {
            int item;
            if (split) { if (k >= cnt) break; item = bid < 64 ? k * 512 + 448 + bid : (k < 4 ? k * 512 + nb : (2 + (nb >> 6)) * 512 + 448 + (nb & 63)); }
            else { const int it = (bid < 64 ? bid + (int)gridDim.x : bid) + k * (int)gridDim.x; if (it >= 64 + nwin) break; item = it - 64; }
            win_item(P, (const bf16*)(ws + 122 * fw::MB), (bf16*)(ws + 130 * fw::MB), item, smem);
        }
    } else if (PH == PH_C2) {
        for (int it = blockIdx.x; it < B * G * (T / 32); it += gridDim.x)
            cmpsel_item(P, (const bf16*)(ws + 5 * fw::MB), (const bf16*)(ws + 6 * fw::MB), (bf16*)(ws + 162 * fw::MB), (unsigned long long*)(ws + 9 * fw::MB), it, smem);
    } else if (PH == PH_D2) {
        build_bias_lut(p.t5, smem, false);
        for (int it = blockIdx.x; it < B * G * (T / (16 * ANQT_SEL)); it += gridDim.x)
            sel_item(P, (const bf16*)(ws + 114 * fw::MB), (const unsigned long long*)(ws + 9 * fw::MB), (const bf16*)(ws + 162 * fw::MB), (const bf16*)(ws + 130 * fw::MB), (bf16*)(ws + 206 * fw::MB), it, smem);
    } else if (PH == PH_OUT2) {
        gemm_sched(4, 0, [&](bool, int mt, int nt) { gemm_tile2(ALoadPlain{(const bf16*)(ws + 206 * fw::MB), D}, WB + wbo::OUT, 1024, mt * 128, nt * 256, EpiResid{X, X, XB, parts}, smem); });
    } else if (PH == PH_PREP3) {
        int tb = 0;
        convert_seg(p.d_w_in, 2560, 0, 2560, 1024, WB + wbo::IN, p.norm_g + 3 * D, smf, tb);
        convert_seg(p.d_w_out, 1024, 0, 1024, 1280, WB + wbo::OUT, nullptr, smf, tb);
        lru_convert_gates(p.d_ga_w, p.d_gx_w, WB + wbo::EXTRA);
        for (int i = blockIdx.x * NTHREADS + TIDX; i < LW; i += gridDim.x * NTHREADS) ((float*)(ws + 12 * fw::MB + 786432))[i] = -8.0f * softplusf_(-p.d_lambda[i]);
    } else if (PH == PH_IN3) {
        gemm_sched(8, 4, [&](bool big, int mt, int nt) {
            if (big) gemm_tile2(ALoadPlain{XB, D}, WB + wbo::IN, 1024, mt * 128, nt * 256, EpiBf16{P, 2560, parts}, smem);
            else gemm_tile(ALoadPlain{XB, D}, WB + wbo::IN, 1024, mt * 128, 2048 + nt * 128, EpiBf16{P, 2560, parts}, smem);
        });
    } else if (PH == PH_GATE3) {
        for (int it = blockIdx.x; it < (M / 128) * 16; it += gridDim.x)
            lru_gate_item(P, p.d_conv_w, p.d_conv_b, WB + wbo::EXTRA, p.d_ga_b, p.d_gx_b, (const float*)(ws + 12 * fw::MB + 786432), (bf16*)(ws + wsl::L3_LA), (bf16*)(ws + wsl::L3_BV), (float2*)(ws + wsl::L3_UC), it, smem);
    } else if (PH == PH_SCANB3) {
        for (int it = blockIdx.x; it < B * (T / 64) * 5; it += gridDim.x)
            lru_scan2_item((const bf16*)(ws + wsl::L3_LA), (const bf16*)(ws + wsl::L3_BV), (const float2*)(ws + wsl::L3_UC), P, (bf16*)(ws + wsl::L3_AO), it);
    } else if (PH == PH_OUT3) {
        gemm_sched(4, 0, [&](bool, int mt, int nt) { gemm_tile2(ALoadPlain{(const bf16*)(ws + wsl::L3_AO), LW}, WB + wbo::OUT, 1280, mt * 128, nt * 256, EpiResid{X, X, nullptr, parts}, smem); });
    } else if (PH == PH_FINAL) {
        rows_final(X, parts, p.final_g);
    }
}

template <int PH> __global__ void __launch_bounds__(NTHREADS, 2) k_phase(Params p) {
    extern __shared__ __attribute__((aligned(16))) char smem[];
    run_phase<PH>(p, smem);
}
#define LDS_BYTES 73728
#define MEGA_LDS_BYTES (73728 + 64)
template <int PH> static void launch_phase(const Params& p, hipStream_t s) {
    static bool attr = false;
    if (!attr) { hipFuncSetAttribute((const void*)k_phase<PH>, hipFuncAttributeMaxDynamicSharedMemorySize, LDS_BYTES); attr = true; }
    hipLaunchKernelGGL(k_phase<PH>, dim3(512), dim3(NTHREADS), LDS_BYTES, s, p);
}


#define XB_TMO      128
#define XB_XCNT(j)  (256  + 64 * (j))
#define XB_XSUB(j)  (1280 + 64 * (j))
#define XB_XGEN(j)  (2304 + 64 * (j))
#define XB_TOP      3328
#define XB_TOPGEN   3392
#define XCD_BAR_WORDS 3456
#define XB_SPIN_CAP (1u << 22)
#define LAS __attribute__((address_space(3)))
DI unsigned xb_ld(unsigned* p)              { return __hip_atomic_load(p, __ATOMIC_RELAXED, __HIP_MEMORY_SCOPE_AGENT); }
DI unsigned xb_add(unsigned* p, unsigned v) { return __hip_atomic_fetch_add(p, v, __ATOMIC_RELAXED, __HIP_MEMORY_SCOPE_AGENT); }
DI unsigned xb_xcc_id() { return (unsigned)__builtin_amdgcn_s_getreg((3 << 11) | 20) & 0xFu; }
#define XB_SPIN(cond, bar) do { unsigned _sp = 0; while (cond) { if (_sp < 64u) __builtin_amdgcn_s_sleep(2); else __builtin_amdgcn_s_sleep(32); \
    if ((++_sp & 255u) == 0u) { if (xb_ld(&(bar)[XB_TMO])) break; if (_sp > XB_SPIN_CAP) { atomicAdd(&(bar)[XB_TMO], 1u); break; } } } } while (0)
struct XcdBarrier { unsigned* bar; unsigned x; volatile LAS unsigned* st; };
DI XcdBarrier xcd_barrier_post(unsigned* bar, volatile LAS unsigned* st) {
    XcdBarrier b; b.bar = bar; b.x = xb_xcc_id(); b.st = st;
    if (threadIdx.x == 0) (void)xb_add(&bar[XB_XCNT(b.x)], 1u);
    return b;
}
DI void xcd_barrier_complete(unsigned* bar, unsigned x, unsigned& nloc, unsigned& nx) {
    const unsigned G = gridDim.x * gridDim.y * gridDim.z;
    unsigned sum, cnt, mine, sp = 0u;
    for (;;) {
        sum = 0u; cnt = 0u; mine = 0u;
#pragma unroll
        for (unsigned j = 0; j < 16; ++j) { const unsigned c = xb_ld(&bar[XB_XCNT(j)]); sum += c; cnt += (c > 0u) ? 1u : 0u; mine = (j == x) ? c : mine; }
        if (sum == G) break;
        __builtin_amdgcn_s_sleep(1);
        if ((++sp & 255u) == 0u) { if (xb_ld(&bar[XB_TMO])) break; if (sp > XB_SPIN_CAP) { atomicAdd(&bar[XB_TMO], 1u); break; } }
    }
    nloc = mine > 0u ? mine : 1u; nx = cnt > 0u ? cnt : 1u;
}
DI void xcd_barrier(const XcdBarrier& b) {
    asm volatile("s_waitcnt vmcnt(0)" ::: "memory");
    __syncthreads();
    if (threadIdx.x == 0) {
        unsigned* bar = b.bar;
        __builtin_amdgcn_s_waitcnt(0);
        unsigned nloc = b.st[0], nx = b.st[1];
        if (nloc == 0u) { xcd_barrier_complete(bar, b.x, nloc, nx); b.st[0] = nloc; b.st[1] = nx; }
        const unsigned old = xb_add(&bar[XB_XSUB(b.x)], 1u);
        const unsigned gen = old / nloc;
        if (old + 1u == (gen + 1u) * nloc) {
            __builtin_amdgcn_fence(__ATOMIC_RELEASE, "agent");
            asm volatile("s_waitcnt vmcnt(0)" ::: "memory");
            const unsigned og = xb_add(&bar[XB_TOP], 1u);
            const unsigned tg = og / nx;
            if (og + 1u == (tg + 1u) * nx) xb_add(&bar[XB_TOPGEN], 1u);
            else XB_SPIN(xb_ld(&bar[XB_TOPGEN]) == tg, bar);
            __builtin_amdgcn_fence(__ATOMIC_ACQUIRE, "agent");
            xb_add(&bar[XB_XGEN(b.x)], 1u);
            asm volatile("s_waitcnt vmcnt(0)" ::: "memory");
        } else {
            XB_SPIN(xb_ld(&bar[XB_XGEN(b.x)]) == gen, bar);
            __builtin_amdgcn_fence(__ATOMIC_ACQUIRE, "agent");
            asm volatile("s_waitcnt vmcnt(0)" ::: "memory");
        }
    }
    __syncthreads();
}

#define MEGA_PHASES(X) X(PH_IN0) X(PH_ATTN0) X(PH_OUT0) X(PH_PREP1) X(PH_IN1) X(PH_LORA1) X(PH_CPREP1) X(PH_SCAN1) X(PH_GN1) X(PH_OUT1) \
    X(PH_PREP2) X(PH_IN2) X(PH_B2) X(PH_C2) X(PH_D2) X(PH_OUT2) X(PH_PREP3) X(PH_IN3) X(PH_GATE3) X(PH_SCANB3) X(PH_OUT3)
__global__ void __launch_bounds__(NTHREADS, 2) mega_kernel(Params p) {
    extern __shared__ __attribute__((aligned(16))) char smem[];
    cooperative_groups::grid_group grid = cooperative_groups::this_grid();
    volatile LAS unsigned* xst = (volatile LAS unsigned*)(smem + 73728);
    if (threadIdx.x < 4) xst[threadIdx.x] = 0u;
    __syncthreads();
    XcdBarrier xb = xcd_barrier_post((unsigned*)p.ws, xst);
    run_phase<PH_PREP0>(p, smem);
    if (p.ws == nullptr) grid.sync();
    xcd_barrier(xb);
#define MEGA_STEP(ph) run_phase<ph>(p, smem); xcd_barrier(xb);
    MEGA_PHASES(MEGA_STEP)
#undef MEGA_STEP
    run_phase<PH_FINAL>(p, smem);
}
static void launch_mega(const Params& p, hipStream_t s) {
    static int grid_blocks = 0;
    if (!grid_blocks) {
        int dev = 0, cus = 0, per_cu = 0;
        hipGetDevice(&dev);
        hipDeviceGetAttribute(&cus, hipDeviceAttributeMultiprocessorCount, dev);
        hipFuncSetAttribute((const void*)mega_kernel, hipFuncAttributeMaxDynamicSharedMemorySize, MEGA_LDS_BYTES);
        hipOccupancyMaxActiveBlocksPerMultiprocessor(&per_cu, mega_kernel, NTHREADS, MEGA_LDS_BYTES);
        if (per_cu > 2) per_cu = 2;
        if (per_cu < 1) per_cu = 1;
        grid_blocks = cus * per_cu;
    }
    hipMemsetAsync(p.ws, 0, 16384, s);
    Params pp = p; void* args[] = {&pp};
    hipError_t e = hipLaunchCooperativeKernel((const void*)mega_kernel, dim3(grid_blocks), dim3(NTHREADS), args, MEGA_LDS_BYTES, s);
    if (e != hipSuccess) fprintf(stderr, "cooperative launch failed: %s (grid %d)\n", hipGetErrorString(e), grid_blocks);
}
#endif

#ifndef CPU_SHIM
template <class F> __global__ void __launch_bounds__(256) k_run(F f, long n) {
    const long i = (long)blockIdx.x * 256 + threadIdx.x; if (i < n) f(i);
}
template <class F> static void launch(const F& f, long n, hipStream_t s) {
    hipLaunchKernelGGL(k_run<F>, dim3((unsigned)((n + 255) / 256)), dim3(256), 0, s, f, n);
}
#else
template <class F> static void launch(const F& f, long n, hipStream_t) {
#pragma omp parallel for schedule(dynamic, 64)
    for (long i = 0; i < n; ++i) f(i);
}
#endif

#ifdef CPU_SHIM
void cpu_layer_hook(int layer, const float* X, const char* ws);
#define LAYER_HOOK(l) cpu_layer_hook(l, X, ws)
#else
#define LAYER_HOOK(l)
#endif

#define FAST_GEMM 0
#if FAST_GEMM
#define FASTP(ph) launch_phase<ph>(p, s)
#else
#define FASTP(ph)
#endif

static void run_naive(const Params& p, hipStream_t s) {
    char* ws = p.ws;
    float* rs = (float*)(ws + wsl::RS);
    bf16* P = (bf16*)(ws + wsl::P);
    float* X = p.out;
    (void)rs;
    {
        bf16* AO = (bf16*)(ws + wsl::L0_AO);
#if FAST_GEMM
        FASTP(PH_PREP0); FASTP(PH_IN0);
#else
        launch(RstdF{p.x, rs}, M, s);
        launch(GemmInF{p.x, rs, p.norm_g + 0 * D, p.a_w_in, P, A_COLS}, (long)M * (A_COLS / 4), s);
#endif
#if FAST_GEMM
        FASTP(PH_ATTN0); (void)AO;
#else
        launch(SwaF{P, p.t5, p.a_sinks, AO}, (long)M * H, s);
#endif
#if FAST_GEMM
        FASTP(PH_OUT0);
#else
        launch(GemmOutF{AO, p.a_w_out, p.x, X, 1024}, (long)M * (D / 4), s);
#endif
    }
    LAYER_HOOK(0);
    {
        bf16* XN = (bf16*)(ws + wsl::L1_XN); bf16* WL = (bf16*)(ws + wsl::L1_WL); bf16* AV = (bf16*)(ws + wsl::L1_AV);
        float* hw = (float*)(ws + wsl::LHW); float* ha = (float*)(ws + wsl::LHA);
#if FAST_GEMM
        FASTP(PH_PREP1); FASTP(PH_IN1); FASTP(PH_LORA1); FASTP(PH_CPREP1); FASTP(PH_SCAN1); FASTP(PH_GN1); FASTP(PH_OUT1);
        (void)XN; (void)WL; (void)AV; (void)hw; (void)ha;
#else
        launch(RstdF{X, rs}, M, s);
        launch(XnF{X, rs, p.norm_g + 1 * D, XN}, (long)M * D, s);
        launch(GemmRwkvF{XN, p.b_mu, p.b_w_in, P}, (long)M * 1024, s);
        launch(LoraHidF{XN, p.b_mu, p.b_w1, p.b_a1, hw, ha}, (long)M * 128, s);
        launch(LoraOutF{hw, ha, p.b_w0, p.b_w2, p.b_a0, p.b_a2, WL, AV}, (long)M * D, s);
        launch(RwkvScanF{P, WL, AV, p.b_k_k, p.b_k_a, XN}, (long)B * H * 64, s);
        launch(RwkvGnF{P, AV, p.b_k_a, p.b_r_k, p.b_lnx_w, p.b_lnx_b, XN}, (long)M * H, s);
        launch(GemmOutF{XN, p.b_w_out, X, X, 1024}, (long)M * (D / 4), s);
#endif
    }
    LAYER_HOOK(1);
    {
        float* hk = (float*)(ws + wsl::HK); float* hv = (float*)(ws + wsl::HV);
        float* kc = (float*)(ws + wsl::KC); float* vc = (float*)(ws + wsl::VC);
        float* st = (float*)(ws + wsl::ST); int* sel = (int*)(ws + wsl::SEL); float* imp = (float*)(ws + wsl::L2_IMP);
        bf16* AO = (bf16*)(ws + wsl::L2_AO); bf16* OC = (bf16*)(ws + wsl::L2_OC); bf16* OS = (bf16*)(ws + wsl::L2_OS);
#if FAST_GEMM
        FASTP(PH_PREP2); FASTP(PH_IN2); FASTP(PH_B2); FASTP(PH_C2); FASTP(PH_D2); FASTP(PH_OUT2);
        (void)hk; (void)hv; (void)kc; (void)vc; (void)st; (void)sel; (void)imp; (void)AO; (void)OC; (void)OS;
#else
        launch(RstdF{X, rs}, M, s);
        launch(GemmInF{X, rs, p.norm_g + 2 * D, p.c_w_in, P, C_COLS}, (long)M * (C_COLS / 4), s);
        launch(CmpHidF{P, p.c_pos_k, p.c_k_w1, p.c_pos_v, p.c_v_w1, hk, hv}, 2L * B * G * NCMP * 128, s);
        launch(CmpOutF{hk, hv, p.c_k_w2, p.c_v_w2, kc, vc}, 2L * B * G * NCMP * 64, s);
        launch(CmpAttnF{P, kc, vc, st, OC}, (long)M * H, s);
        launch(ImpF{P, kc, st, imp}, (long)M * G * NSEL, s);
        launch(TopkF{imp, sel}, (long)M * G, s);
        launch(SelAttnF{P, p.t5, sel, OS}, (long)M * H, s);
        launch(WinAttnF{P, p.t5, OC, OS, AO}, (long)M * H, s);
        LAYER_HOOK(20);
        launch(GemmOutF{AO, p.c_w_out, X, X, 1024}, (long)M * (D / 4), s);
#endif
    }
    LAYER_HOOK(2);
    {
        bf16* AO = (bf16*)(ws + wsl::L3_AO); bf16* UC = (bf16*)(ws + wsl::L3_UC); bf16* LA = (bf16*)(ws + wsl::L3_LA); bf16* BV = (bf16*)(ws + wsl::L3_BV);
#if FAST_GEMM
        FASTP(PH_PREP3); FASTP(PH_IN3); FASTP(PH_GATE3); FASTP(PH_SCANA3); FASTP(PH_SCANB3); FASTP(PH_OUT3);
        (void)AO; (void)UC; (void)LA; (void)BV;
#else
        launch(RstdF{X, rs}, M, s);
        launch(GemmInF{X, rs, p.norm_g + 3 * D, p.d_w_in, P, 2560}, (long)M * (2560 / 4), s);
        launch(ConvF{P, p.d_conv_w, p.d_conv_b, UC}, (long)M * LW, s);
        launch(LruGateF{UC, p.d_ga_w, p.d_ga_b, p.d_gx_w, p.d_gx_b, p.d_lambda, LA, BV}, (long)M * LW, s);
        launch(LruScanF{P, LA, BV, AO}, (long)B * LW, s);
        launch(GemmOutF{AO, p.d_w_out, X, X, LW}, (long)M * (D / 4), s);
#endif
    }
    LAYER_HOOK(3);
#if FAST_GEMM
    FASTP(PH_FINAL);
#else
    launch(FinalNormF{X, p.final_g}, M, s);
#endif
}

extern "C" void kernel_launch(void* const* d_in, const int* in_sizes, int n_in, void* d_out, int out_size, void* d_ws, size_t ws_size,
                              hipStream_t stream) {
    (void)in_sizes; (void)n_in; (void)out_size; (void)ws_size;
    Params p{};
    const float* const* in = (const float* const*)d_in;
    int k = 0;
    p.x = in[k++]; p.t5 = in[k++]; p.norm_g = in[k++]; p.final_g = in[k++];
    p.a_w_in = in[k++]; p.a_sinks = in[k++]; p.a_w_out = in[k++];
    p.b_mu = in[k++]; p.b_w_in = in[k++]; p.b_w0 = in[k++]; p.b_w1 = in[k++]; p.b_w2 = in[k++]; p.b_a0 = in[k++]; p.b_a1 = in[k++]; p.b_a2 = in[k++];
    p.b_k_k = in[k++]; p.b_k_a = in[k++]; p.b_r_k = in[k++]; p.b_lnx_w = in[k++]; p.b_lnx_b = in[k++]; p.b_w_out = in[k++];
    p.c_w_in = in[k++]; p.c_pos_k = in[k++]; p.c_k_w1 = in[k++]; p.c_k_w2 = in[k++]; p.c_pos_v = in[k++]; p.c_v_w1 = in[k++]; p.c_v_w2 = in[k++]; p.c_w_out = in[k++];
    p.d_w_in = in[k++]; p.d_conv_w = in[k++]; p.d_conv_b = in[k++]; p.d_ga_w = in[k++]; p.d_ga_b = in[k++]; p.d_gx_w = in[k++]; p.d_gx_b = in[k++];
    p.d_lambda = in[k++]; p.d_w_out = in[k++];
    p.out = (float*)d_out; p.ws = (char*)d_ws;
#if !defined(CPU_SHIM) && !defined(MULTI_LAUNCH) && !defined(ALL_NAIVE)
    launch_mega(p, stream);
#else
    run_naive(p, stream);
#endif
}
```

```cpp
#ifndef CPU_SHIM
#include <hip/hip_runtime.h>
#include <hip/hip_cooperative_groups.h>
#include <cstdio>
#define HD __host__ __device__ __forceinline__
#else
#include <cmath>
#include <cstring>
#include <cstdio>
#include <cstdlib>
#include <cstdint>
#define HD inline
typedef void* hipStream_t;
#endif
#include <cstddef>

#ifndef CFG_B
#define CFG_B 4
#endif
#ifndef CFG_T
#define CFG_T 4096
#endif

namespace cfg {
constexpr int B = CFG_B, T = CFG_T, M = B * T, D = 1024;
constexpr int H = 16, G = 4, R = 4, DH = 64;
constexpr int A_COLS = 2560;
constexpr int C_COLS = 3632;
constexpr int NCMP = (T - 32) / 16 + 1;
constexpr int NSEL = T / 64;
constexpr int KTOP = NSEL < 16 ? NSEL : 16;
constexpr int LW = 1280;
}
using namespace cfg;

typedef unsigned short bf16;

HD unsigned f_as_u(float f) {
#ifndef CPU_SHIM
    return __float_as_uint(f);
#else
    unsigned u; memcpy(&u, &f, 4); return u;
#endif
}
HD float u_as_f(unsigned u) {
#ifndef CPU_SHIM
    return __uint_as_float(u);
#else
    float f; memcpy(&f, &u, 4); return f;
#endif
}
HD float bf2f(bf16 v) { return u_as_f(((unsigned)v) << 16); }
HD bf16 f2bf(float f) { unsigned u = f_as_u(f); u += 0x7fffu + ((u >> 16) & 1u); return (bf16)(u >> 16); }
HD float sigmoidf_(float x) { return 1.0f / (1.0f + expf(-x)); }
HD float siluf_(float x) { return x / (1.0f + expf(-x)); }
HD float softplusf_(float x) { return x > 20.f ? x : log1pf(expf(x)); }

HD int t5_bucket(int d) {
    if (d < 16) return d < 0 ? 0 : d;
    if (d >= 113) return 31;
    if (d >= 99) return 30;
    if (d >= 87) return 29;
    if (d >= 77) return 28;
    if (d >= 67) return 27;
    if (d >= 59) return 26;
    if (d >= 52) return 25;
    if (d >= 46) return 24;
    if (d >= 40) return 23;
    if (d >= 35) return 22;
    if (d >= 31) return 21;
    if (d >= 27) return 20;
    if (d >= 24) return 19;
    if (d >= 21) return 18;
    if (d >= 19) return 17;
    return 16;
}

struct Params {
    const float *x, *t5, *norm_g, *final_g;
    const float *a_w_in, *a_sinks, *a_w_out;
    const float *b_mu, *b_w_in, *b_w0, *b_w1, *b_w2, *b_a0, *b_a1, *b_a2, *b_k_k, *b_k_a, *b_r_k, *b_lnx_w, *b_lnx_b, *b_w_out;
    const float *c_w_in, *c_pos_k, *c_k_w1, *c_k_w2, *c_pos_v, *c_v_w1, *c_v_w2, *c_w_out;
    const float *d_w_in, *d_conv_w, *d_conv_b, *d_ga_w, *d_ga_b, *d_gx_w, *d_gx_b, *d_lambda, *d_w_out;
    float* out;
    char* ws;
};

namespace wsl {
constexpr size_t MB = 1024 * 1024;
constexpr size_t RS = 0;
constexpr size_t HK = 1 * MB;
constexpr size_t HV = 3 * MB;
constexpr size_t KC = 5 * MB;
constexpr size_t VC = 6 * MB;
constexpr size_t ST = 7 * MB;
constexpr size_t SEL = 9 * MB;
constexpr size_t LHW = 1 * MB;
constexpr size_t LHA = 5 * MB;
constexpr size_t P = 14 * MB;
constexpr size_t SZ1024 = (size_t)M * 1024 * 2, SZ1280 = (size_t)M * 1280 * 2;
constexpr size_t L0_AO = P + (size_t)M * 2560 * 2;
constexpr size_t L1_XN = P + (size_t)M * 4096 * 2, L1_WL = L1_XN + SZ1024, L1_AV = L1_WL + SZ1024;
constexpr size_t L2_AO = P + (size_t)M * 3632 * 2, L2_OC = L2_AO + SZ1024, L2_OS = L2_OC + SZ1024, L2_IMP = L2_OS + SZ1024;
constexpr size_t L3_AO = P + (size_t)M * 2560 * 2, L3_UC = L3_AO + SZ1280, L3_LA = L3_UC + SZ1280, L3_BV = L3_LA + SZ1280;
constexpr size_t TOTAL = L3_BV + SZ1280;
}

struct RstdF {
    const float* x; float* rs;
    HD void operator()(long m) const {
        const float* r = x + (size_t)m * D; float s = 0.f;
        for (int k = 0; k < D; ++k) s += r[k] * r[k];
        rs[m] = 1.0f / sqrtf(s / D + 1e-6f);
    }
};
struct XnF {
    const float* x; const float* rs; const float* g; bf16* xn;
    HD void operator()(long i) const { long m = i / D; int k = (int)(i % D); xn[i] = f2bf(x[i] * rs[m] * g[k]); }
};
struct GemmInF {
    const float *x, *rs, *g, *W; bf16* P; long long N;
    HD void operator()(long i) const {
        const int n4 = (int)N / 4; const long m = i / n4; const int n = (int)(i % n4) * 4;
        const float* xr = x + (size_t)m * D; const float r = rs[m];
        float a0 = 0, a1 = 0, a2 = 0, a3 = 0;
        for (int k = 0; k < D; ++k) {
            const float a = xr[k] * r * g[k]; const float* w = W + (size_t)k * N + n;
            a0 += a * w[0]; a1 += a * w[1]; a2 += a * w[2]; a3 += a * w[3];
        }
        bf16* p = P + (size_t)m * N + n; p[0] = f2bf(a0); p[1] = f2bf(a1); p[2] = f2bf(a2); p[3] = f2bf(a3);
    }
};
struct GemmOutF {
    const bf16* A; const float* W; const float* xin; float* xout; long long K;
    HD void operator()(long i) const {
        const int n4 = D / 4; const long m = i / n4; const int n = (int)(i % n4) * 4;
        const bf16* ar = A + (size_t)m * K;
        float a0 = 0, a1 = 0, a2 = 0, a3 = 0;
        for (int k = 0; k < K; ++k) {
            const float a = bf2f(ar[k]); const float* w = W + (size_t)k * D + n;
            a0 += a * w[0]; a1 += a * w[1]; a2 += a * w[2]; a3 += a * w[3];
        }
        const float* xi = xin + (size_t)m * D + n; float* xo = xout + (size_t)m * D + n;
        xo[0] = xi[0] + a0; xo[1] = xi[1] + a1; xo[2] = xi[2] + a2; xo[3] = xi[3] + a3;
    }
};

struct SwaF {
    const bf16* P; const float* t5; const float* sinks; bf16* AO;
    HD void operator()(long i) const {
        const long m = i / H; const int h = (int)(i % H), g = h / R; const int t = (int)(m % T); const long mb = m - t;
        float q[DH], o[DH];
#pragma unroll
        for (int d = 0; d < DH; ++d) { q[d] = bf2f(P[(size_t)m * A_COLS + h * DH + d]); o[d] = 0.f; }
        float mx = sinks[h], l = 1.0f;
        const int s0 = t - 127 < 0 ? 0 : t - 127;
        for (int s = s0; s <= t; ++s) {
            const bf16* kr = P + (size_t)(mb + s) * A_COLS + 1024 + g * DH;
            const bf16* vr = kr + 256;
            float sc = 0.f;
#pragma unroll
            for (int d = 0; d < DH; ++d) sc += q[d] * bf2f(kr[d]);
            sc = sc * 0.125f + t5[t5_bucket(t - s) * H + h];
            const float mn = sc > mx ? sc : mx; const float al = expf(mx - mn), p = expf(sc - mn);
            l = l * al + p; mx = mn;
#pragma unroll
            for (int d = 0; d < DH; ++d) o[d] = o[d] * al + p * bf2f(vr[d]);
        }
        const float il = 1.0f / l;
#pragma unroll
        for (int d = 0; d < DH; ++d) {
            const float z = bf2f(P[(size_t)m * A_COLS + 1536 + h * DH + d]);
            AO[(size_t)m * D + h * DH + d] = f2bf(o[d] * il * siluf_(z));
        }
    }
};

struct GemmRwkvF {
    const bf16* xn; const float* mu; const float* W; bf16* P;
    HD void operator()(long i) const {
        const int N = 4096, n4 = N / 4; const long m = i / n4; const int n = (int)(i % n4) * 4; const int s = n / 1024;
        const int t = (int)(m % T);
        const bf16* xr = xn + (size_t)m * D; const float* mus = mu + s * D;
        float a0 = 0, a1 = 0, a2 = 0, a3 = 0;
        for (int k = 0; k < D; ++k) {
            const float xc = bf2f(xr[k]); const float xp = t > 0 ? bf2f(xr[k - D]) : 0.f;
            const float a = xc + (xp - xc) * mus[k]; const float* w = W + (size_t)k * N + n;
            a0 += a * w[0]; a1 += a * w[1]; a2 += a * w[2]; a3 += a * w[3];
        }
        bf16* p = P + (size_t)m * N + n; p[0] = f2bf(a0); p[1] = f2bf(a1); p[2] = f2bf(a2); p[3] = f2bf(a3);
    }
};
struct LoraHidF {
    const bf16* xn; const float* mu; const float* w1; const float* a1; float* hw; float* ha;
    HD void operator()(long i) const {
        const long m = i / 128; const int jj = (int)(i % 128); const int which = jj / 64, j = jj % 64; const int t = (int)(m % T);
        const bf16* xr = xn + (size_t)m * D; const float* mus = mu + (4 + which) * D; const float* W = which ? a1 : w1;
        float acc = 0.f;
        for (int k = 0; k < D; ++k) {
            const float xc = bf2f(xr[k]); const float xp = t > 0 ? bf2f(xr[k - D]) : 0.f;
            acc += (xc + (xp - xc) * mus[k]) * W[(size_t)k * 64 + j];
        }
        if (which) ha[(size_t)m * 64 + j] = acc; else hw[(size_t)m * 64 + j] = tanhf(acc);
    }
};
struct LoraOutF {
    const float *hw, *ha, *w0, *w2, *a0, *a2; bf16* wlog; bf16* av;
    HD void operator()(long i) const {
        const long m = i / D; const int c = (int)(i % D);
        float sw = 0.f, sa = 0.f;
        for (int j = 0; j < 64; ++j) { sw += hw[(size_t)m * 64 + j] * w2[(size_t)j * D + c]; sa += ha[(size_t)m * 64 + j] * a2[(size_t)j * D + c]; }
        const float wr = -softplusf_(-(w0[c] + sw)) - 0.5f;
        wlog[i] = f2bf(-expf(wr)); av[i] = f2bf(sigmoidf_(a0[c] + sa));
    }
};
struct RwkvScanF {
    const bf16* P; const bf16* wlog; const bf16* av; const float* k_k; const float* k_a; bf16* ys;
    HD void operator()(long idx) const {
        const int i = (int)(idx % 64); const int h = (int)((idx / 64) % H); const int b = (int)(idx / (64 * H));
        float S[64];
#pragma unroll
        for (int j = 0; j < 64; ++j) S[j] = 0.f;
        for (int t = 0; t < T; ++t) {
            const size_t m = (size_t)b * T + t; const bf16* pr = P + m * 4096 + h * 64;
            const bf16* wl = wlog + m * D + h * 64; const bf16* ar = av + m * D + h * 64;
            float n2 = 0.f;
#pragma unroll
            for (int j = 0; j < 64; ++j) { const float kk = bf2f(pr[1024 + j]) * k_k[h * 64 + j]; n2 += kk * kk; }
            float nr = sqrtf(n2); nr = nr > 1e-12f ? nr : 1e-12f; const float inr = 1.0f / nr;
            float sa = 0.f;
#pragma unroll
            for (int j = 0; j < 64; ++j) { const float kk = bf2f(pr[1024 + j]) * k_k[h * 64 + j] * inr; sa += S[j] * (-kk); }
            const float vi = bf2f(pr[2048 + i]); float y = 0.f;
#pragma unroll
            for (int j = 0; j < 64; ++j) {
                const float kr = bf2f(pr[1024 + j]); const float a = bf2f(ar[j]);
                const float kk = kr * k_k[h * 64 + j] * inr; const float kp = kr * (1.0f + (a - 1.0f) * k_a[h * 64 + j]);
                const float dec = expf(bf2f(wl[j]));
                S[j] = S[j] * dec + sa * (kk * a) + vi * kp;
                y += S[j] * bf2f(pr[j]);
            }
            ys[m * D + h * 64 + i] = f2bf(y);
        }
    }
};
struct RwkvGnF {
    const bf16* P; const bf16* av; const float *k_a, *r_k, *lnx_w, *lnx_b; bf16* ys;
    HD void operator()(long idx) const {
        const long m = idx / H; const int h = (int)(idx % H);
        bf16* yr = ys + (size_t)m * D + h * 64; const bf16* pr = P + (size_t)m * 4096 + h * 64; const bf16* ar = av + (size_t)m * D + h * 64;
        float mean = 0.f;
        for (int j = 0; j < 64; ++j) mean += bf2f(yr[j]);
        mean /= 64.f; float var = 0.f;
        for (int j = 0; j < 64; ++j) { const float d = bf2f(yr[j]) - mean; var += d * d; }
        var /= 64.f; const float rstd = 1.0f / sqrtf(var + 64e-5f);
        float bs = 0.f;
        for (int j = 0; j < 64; ++j) { const float kr = bf2f(pr[1024 + j]); const float kp = kr * (1.0f + (bf2f(ar[j]) - 1.0f) * k_a[h * 64 + j]); bs += bf2f(pr[j]) * kp * r_k[h * 64 + j]; }
        for (int j = 0; j < 64; ++j) {
            const float yn = (bf2f(yr[j]) - mean) * rstd * lnx_w[h * 64 + j] + lnx_b[h * 64 + j];
            const float z = bf2f(pr[3072 + j]);
            yr[j] = f2bf((yn + bs * bf2f(pr[2048 + j])) * siluf_(z));
        }
    }
};

struct CmpHidF {
    const bf16* P; const float *pos_k, *w1_k, *pos_v, *w1_v; float* hk; float* hv;
    HD void operator()(long idx) const {
        const int j = (int)(idx % 128); long r = idx / 128; const int n = (int)(r % NCMP); r /= NCMP; const int g = (int)(r % G); r /= G;
        const int b = (int)(r % B); const int which = (int)(r / B);
        const float* pos = which ? pos_v : pos_k; const float* w1 = which ? w1_v : w1_k; const int col = 1024 + (which ? 256 : 0) + g * 64;
        float acc = 0.f;
        for (int l = 0; l < 32; ++l) {
            const bf16* src = P + (size_t)(b * T + 16 * n + l) * C_COLS + col;
            for (int d = 0; d < 64; ++d) acc += (bf2f(src[d]) + pos[l * 64 + d]) * w1[(size_t)(l * 64 + d) * 128 + j];
        }
        (which ? hv : hk)[(((size_t)b * G + g) * NCMP + n) * 128 + j] = siluf_(acc);
    }
};
struct CmpOutF {
    const float *hk, *hv, *w2_k, *w2_v; float* kc; float* vc;
    HD void operator()(long idx) const {
        const int d = (int)(idx % 64); long r = idx / 64; const long row = r % ((long)B * G * NCMP); const int which = (int)(r / ((long)B * G * NCMP));
        const float* hsrc = (which ? hv : hk) + (size_t)row * 128; const float* w2 = which ? w2_v : w2_k;
        float acc = 0.f;
        for (int j = 0; j < 128; ++j) acc += hsrc[j] * w2[j * 64 + d];
        (which ? vc : kc)[(size_t)row * 64 + d] = acc;
    }
};
struct CmpAttnF {
    const bf16* P; const float *kc, *vc; float* st; bf16* oc;
    HD void operator()(long i) const {
        const long m = i / H; const int h = (int)(i % H), g = h / R; const int t = (int)(m % T); const int b = (int)(m / T);
        float q[DH], o[DH];
#pragma unroll
        for (int d = 0; d < DH; ++d) { q[d] = bf2f(P[(size_t)m * C_COLS + h * DH + d]); o[d] = 0.f; }
        const int nv = t < 31 ? 0 : (t - 31) / 16 + 1;
        float mx = -1e30f, l = 0.f;
        for (int n = 0; n < nv; ++n) {
            const float* kr = kc + (((size_t)b * G + g) * NCMP + n) * 64; const float* vr = vc + (((size_t)b * G + g) * NCMP + n) * 64;
            float sc = 0.f;
#pragma unroll
            for (int d = 0; d < DH; ++d) sc += q[d] * kr[d];
            sc *= 0.125f;
            const float mn = sc > mx ? sc : mx; const float al = expf(mx - mn), p = expf(sc - mn);
            l = l * al + p; mx = mn;
#pragma unroll
            for (int d = 0; d < DH; ++d) o[d] = o[d] * al + p * vr[d];
        }
        const float il = nv > 0 ? 1.0f / l : 0.f;
        st[(size_t)i * 2] = mx; st[(size_t)i * 2 + 1] = il;
#pragma unroll
        for (int d = 0; d < DH; ++d) oc[(size_t)m * D + h * DH + d] = f2bf(o[d] * il);
    }
};
struct ImpF {
    const bf16* P; const float *kc, *st; float* imp;
    HD void operator()(long idx) const {
        const int s = (int)(idx % NSEL); long r = idx / NSEL; const int g = (int)(r % G); const long m = r / G;
        const int t = (int)(m % T); const int b = (int)(m / T); const int cur = t / 64;
        float v;
        if (s == 0 || s == cur || s == cur - 1) v = 1e30f;
        else if (s * 64 > t) v = -1e30f;
        else {
            v = 0.f; const int nv = t < 31 ? 0 : (t - 31) / 16 + 1;
            int n0 = 4 * s - 1; if (n0 < 0) n0 = 0; int n1 = 4 * s + 3; if (n1 > NCMP - 1) n1 = NCMP - 1; if (n1 > nv - 1) n1 = nv - 1;
            for (int rr = 0; rr < R; ++rr) {
                const int h = g * R + rr; const bf16* qr = P + (size_t)m * C_COLS + h * DH;
                const float mx = st[((size_t)m * H + h) * 2], il = st[((size_t)m * H + h) * 2 + 1];
                for (int n = n0; n <= n1; ++n) {
                    const float* kr = kc + (((size_t)b * G + g) * NCMP + n) * 64; float sc = 0.f;
                    for (int d = 0; d < DH; ++d) sc += bf2f(qr[d]) * kr[d];
                    v += expf(sc * 0.125f - mx) * il;
                }
            }
        }
        imp[idx] = v;
    }
};
struct TopkF {
    const float* imp; int* sel;
    HD void operator()(long idx) const {
        const float* v = imp + (size_t)idx * NSEL; unsigned long long used = 0ull;
        for (int j = 0; j < KTOP; ++j) {
            int best = -1; float bv = 0.f;
            for (int s = 0; s < NSEL; ++s) { if ((used >> s) & 1ull) continue; const float x = v[s]; if (best < 0 || x > bv) { best = s; bv = x; } }
            used |= 1ull << best; sel[(size_t)idx * 16 + j] = best;
        }
    }
};
struct SelAttnF {
    const bf16* P; const float* t5; const int* sel; bf16* os;
    HD void operator()(long i) const {
        const long m = i / H; const int h = (int)(i % H), g = h / R; const int t = (int)(m % T); const long mb = m - t;
        float q[DH], o[DH];
#pragma unroll
        for (int d = 0; d < DH; ++d) { q[d] = bf2f(P[(size_t)m * C_COLS + h * DH + d]); o[d] = 0.f; }
        float mx = -1e30f, l = 0.f;
        for (int j = 0; j < KTOP; ++j) {
            const int blk = sel[((size_t)m * G + g) * 16 + j];
            for (int ll = 0; ll < 64; ++ll) {
                const int s = blk * 64 + ll; if (s > t) break;
                const bf16* kr = P + (size_t)(mb + s) * C_COLS + 1536 + g * DH; const bf16* vr = kr + 256;
                float sc = 0.f;
#pragma unroll
                for (int d = 0; d < DH; ++d) sc += q[d] * bf2f(kr[d]);
                sc = sc * 0.125f + t5[t5_bucket(t - s) * H + h];
                const float mn = sc > mx ? sc : mx; const float al = expf(mx - mn), p = expf(sc - mn);
                l = l * al + p; mx = mn;
#pragma unroll
                for (int d = 0; d < DH; ++d) o[d] = o[d] * al + p * bf2f(vr[d]);
            }
        }
        const float il = 1.0f / l;
#pragma unroll
        for (int d = 0; d < DH; ++d) os[(size_t)m * D + h * DH + d] = f2bf(o[d] * il);
    }
};
struct WinAttnF {
    const bf16* P; const float* t5; const bf16* oc; const bf16* os; bf16* AO;
    HD void operator()(long i) const {
        const long m = i / H; const int h = (int)(i % H), g = h / R, rr = h % R; const int t = (int)(m % T); const long mb = m - t;
        float q[DH], o[DH];
#pragma unroll
        for (int d = 0; d < DH; ++d) { q[d] = bf2f(P[(size_t)m * C_COLS + h * DH + d]); o[d] = 0.f; }
        float mx = -1e30f, l = 0.f;
        const int s0 = t - 511 < 0 ? 0 : t - 511;
        for (int s = s0; s <= t; ++s) {
            const bf16* kr = P + (size_t)(mb + s) * C_COLS + 2048 + g * DH; const bf16* vr = kr + 256;
            float sc = 0.f;
#pragma unroll
            for (int d = 0; d < DH; ++d) sc += q[d] * bf2f(kr[d]);
            sc = sc * 0.125f + t5[t5_bucket(t - s) * H + h];
            const float mn = sc > mx ? sc : mx; const float al = expf(mx - mn), p = expf(sc - mn);
            l = l * al + p; mx = mn;
#pragma unroll
            for (int d = 0; d < DH; ++d) o[d] = o[d] * al + p * bf2f(vr[d]);
        }
        const float il = 1.0f / l;
        const bf16* gr = P + (size_t)m * C_COLS + 2560;
        const float g0 = sigmoidf_(bf2f(gr[0 * 16 + g * R + rr])), g1 = sigmoidf_(bf2f(gr[1 * 16 + g * R + rr])), g2 = sigmoidf_(bf2f(gr[2 * 16 + g * R + rr]));
#pragma unroll
        for (int d = 0; d < DH; ++d) {
            const size_t oi = (size_t)m * D + h * DH + d;
            const float z = bf2f(P[(size_t)m * C_COLS + 2608 + h * DH + d]);
            AO[oi] = f2bf((g0 * bf2f(oc[oi]) + g1 * bf2f(os[oi]) + g2 * o[d] * il) * siluf_(z));
        }
    }
};

struct ConvF {
    const bf16* P; const float *cw, *cb; bf16* uc;
    HD void operator()(long i) const {
        const long m = i / LW; const int c = (int)(i % LW); const int t = (int)(m % T);
        float acc = cb[c];
        for (int w = 0; w < 4; ++w) { const int tt = t - 3 + w; if (tt >= 0) acc += cw[w * LW + c] * bf2f(P[(size_t)(m - 3 + w) * 2560 + c]); }
        uc[i] = f2bf(acc);
    }
};
struct LruGateF {
    const bf16* uc; const float *gaw, *gab, *gxw, *gxb, *lam; bf16* la; bf16* bv;
    HD void operator()(long i) const {
        const long m = i / LW; const int c = (int)(i % LW); const int n = c / 80, d = c % 80;
        const bf16* ub = uc + (size_t)m * LW + n * 80; float ra = gab[c], rx = gxb[c];
        for (int k = 0; k < 80; ++k) { const float u = bf2f(ub[k]); ra += u * gaw[((size_t)n * 80 + k) * 80 + d]; rx += u * gxw[((size_t)n * 80 + k) * 80 + d]; }
        const float r = sigmoidf_(ra), ig = sigmoidf_(rx);
        const float loga = -8.0f * r * softplusf_(-lam[c]);
        la[i] = f2bf(loga);
        bv[i] = f2bf(sqrtf(-expm1f(2.0f * loga)) * (ig * bf2f(uc[i])));
    }
};
struct LruScanF {
    const bf16* P; const bf16* la; const bf16* bv; bf16* AO;
    HD void operator()(long idx) const {
        const int c = (int)(idx % LW); const int b = (int)(idx / LW); float h = 0.f;
        for (int t = 0; t < T; ++t) {
            const size_t m = (size_t)b * T + t;
            h = expf(bf2f(la[m * LW + c])) * h + bf2f(bv[m * LW + c]);
            AO[m * LW + c] = f2bf(h * siluf_(bf2f(P[m * 2560 + LW + c])));
        }
    }
};
struct FinalNormF {
    float* x; const float* g;
    HD void operator()(long m) const {
        float* r = x + (size_t)m * D; float s = 0.f;
        for (int k = 0; k < D; ++k) s += r[k] * r[k];
        const float rs = 1.0f / sqrtf(s / D + 1e-6f);
        for (int k = 0; k < D; ++k) r[k] = r[k] * rs * g[k];
    }
};


#ifndef CPU_SHIM
typedef short bf16x8 __attribute__((ext_vector_type(8)));
typedef float f32x4 __attribute__((ext_vector_type(4)));
typedef unsigned u32x4 __attribute__((ext_vector_type(4)));
typedef unsigned u32x2 __attribute__((ext_vector_type(2)));
#define DI __device__ __forceinline__
#define NTHREADS 256
__device__ __forceinline__ int opaque_tid() { int t = threadIdx.x; asm volatile("" : "+v"(t)); return t; }
#define TIDX (opaque_tid())

typedef __bf16 hbf16x2 __attribute__((ext_vector_type(2)));
typedef float f32x2 __attribute__((ext_vector_type(2)));
DI unsigned pack2bf(float lo, float hi) { f32x2 f = {lo, hi}; return __builtin_bit_cast(unsigned, __builtin_convertvector(f, hbf16x2)); }
DI float bflo(unsigned u) { return __uint_as_float(u << 16); }
DI float bfhi(unsigned u) { return __uint_as_float(u & 0xffff0000u); }

namespace fw {
constexpr size_t MB = 1024 * 1024;
constexpr size_t PARTS = 13 * MB;
constexpr size_t SMALLB = 1 * MB;
constexpr size_t WB = 14 * MB;
constexpr size_t XB = 30 * MB;
constexpr size_t BIG = 62 * MB;
}

DI void convert_tile(const float* __restrict__ W, int ldw, int c0, int K, bf16* __restrict__ Wt, const float* __restrict__ g, int kt, int nt, float* sm) {
    const int tid = TIDX;
    const int k0 = kt * 64, n0 = nt * 64;
#pragma unroll
    for (int i = 0; i < 4; ++i) {
        const int kr = (tid >> 4) + 16 * i; const int nc = (tid & 15) * 4;
        const float4 v = *(const float4*)(W + (size_t)(k0 + kr) * ldw + c0 + n0 + nc);
        const float s = g ? g[k0 + kr] : 1.0f;
        sm[kr * 65 + nc + 0] = v.x * s; sm[kr * 65 + nc + 1] = v.y * s; sm[kr * 65 + nc + 2] = v.z * s; sm[kr * 65 + nc + 3] = v.w * s;
    }
    __syncthreads();
    {
        const int n = tid >> 2, kq = (tid & 3) * 16;
        unsigned w[8];
#pragma unroll
        for (int j = 0; j < 8; ++j) w[j] = pack2bf(sm[(kq + 2 * j) * 65 + n], sm[(kq + 2 * j + 1) * 65 + n]);
        u32x4* dst = (u32x4*)(Wt + (size_t)(n0 + n) * K + k0 + kq);
        dst[0] = (u32x4){w[0], w[1], w[2], w[3]}; dst[1] = (u32x4){w[4], w[5], w[6], w[7]};
    }
    __syncthreads();
}
DI void convert_seg(const float* W, int ldw, int c0, int ncols, int K, bf16* Wt, const float* g, float* sm, int& tbase) {
    const int nkt = K / 64, nnt = ncols / 64, ntile = nkt * nnt;
    const int Gd = (int)gridDim.x;
    for (int t = (((int)blockIdx.x - tbase % Gd) + Gd) % Gd; t < ntile; t += Gd) convert_tile(W, ldw, c0, K, Wt, g, t % nkt, t / nkt, sm);
    tbase += ntile;
}

DI int perm32(int rho) { const int n = rho >> 4, i = rho & 15; return 8 * (i >> 2) + 4 * n + (i & 3); }

struct ALoadPlain {
    const bf16* A; int lda;
    static constexpr bool DMA = true;
    DI const bf16* src(int m, int k) const { return A + (size_t)m * lda + k; }
    struct Raw { u32x4 v; };
    DI Raw load(int m, int k) const { Raw r; r.v = *(const u32x4*)(A + (size_t)m * lda + k); return r; }
    DI u32x4 finish(const Raw& r, int, int) const { return r.v; }
};
struct ALoadLerp {
    const bf16* xn; const float* mu;
    static constexpr bool DMA = false;
    DI const bf16* src(int, int) const { return nullptr; }
    struct Raw { u32x4 c, p; };
    DI Raw load(int m, int k) const {
        Raw r; r.c = *(const u32x4*)(xn + (size_t)m * D + k);
        if ((m % T) != 0) r.p = *(const u32x4*)(xn + (size_t)(m - 1) * D + k); else r.p = (u32x4){0u, 0u, 0u, 0u};
        return r;
    }
    DI u32x4 finish(const Raw& r, int, int k) const {
        const float4 m0 = *(const float4*)(mu + k), m1 = *(const float4*)(mu + k + 4);
        const float mm[8] = {m0.x, m0.y, m0.z, m0.w, m1.x, m1.y, m1.z, m1.w};
        u32x4 o;
#pragma unroll
        for (int j = 0; j < 4; ++j) {
            const float c0 = bflo(r.c[j]), c1 = bfhi(r.c[j]), p0 = bflo(r.p[j]), p1 = bfhi(r.p[j]);
            o[j] = pack2bf(c0 + (p0 - c0) * mm[2 * j], c1 + (p1 - c1) * mm[2 * j + 1]);
        }
        return o;
    }
};

#define GLDS16(gp, lp) __builtin_amdgcn_global_load_lds((const unsigned*)(gp), (unsigned*)(lp), 16, 0, 0)
template <class AL, class Epi>
DI void gemm_tile(const AL& al, const bf16* __restrict__ Bt, int K, int m0, int n0, const Epi& epi, char* smem) {
    const int tid = TIDX, lane = tid & 63, wave = __builtin_amdgcn_readfirstlane(tid >> 6), wr = wave >> 1, wc = wave & 1, q = lane >> 4, l15 = lane & 15;
    const int srow = tid >> 3, sc = tid & 7, scs = sc ^ (srow & 7);
    const int st_off = srow * 128 + (sc << 4);
    const int dma_off = (8 * wave) * 128;
    int brow[4];
#pragma unroll
    for (int i = 0; i < 4; ++i) { const int rho = srow + 32 * i; brow[i] = n0 + (rho & ~31) + perm32(rho & 31); }
    const int fa0 = (wr * 64 + l15) * 128 + ((q ^ (lane & 7)) << 4);
    const int fb0 = (wc * 64 + l15) * 128 + ((q ^ (lane & 7)) << 4);
    f32x4 acc[4][4];
#pragma unroll
    for (int i = 0; i < 4; ++i)
#pragma unroll
        for (int j = 0; j < 4; ++j) acc[i][j] = (f32x4){0.f, 0.f, 0.f, 0.f};
    typename AL::Raw ra[4];
    const int nk = K / 64;
    {
        char* bufA = smem; char* bufB = smem + 16384;
#pragma unroll
        for (int i = 0; i < 4; ++i) {
            GLDS16(Bt + (size_t)brow[i] * K + scs * 8, bufB + dma_off + i * 4096);
            if (AL::DMA) GLDS16(al.src(m0 + srow + 32 * i, scs * 8), bufA + dma_off + i * 4096);
            else ra[i] = al.load(m0 + srow + 32 * i, scs * 8);
        }
        if (!AL::DMA) {
#pragma unroll
            for (int i = 0; i < 4; ++i) *(u32x4*)(bufA + st_off + i * 4096) = al.finish(ra[i], m0 + srow + 32 * i, scs * 8);
        }
    }
    asm volatile("s_waitcnt vmcnt(0)" ::: "memory");
    __syncthreads();
    for (int kt = 0; kt < nk; ++kt) {
        char* bufA = smem + (kt & 1) * 32768; char* bufB = bufA + 16384;
        char* nA = smem + ((kt + 1) & 1) * 32768; char* nB = nA + 16384;
        const bool more = kt + 1 < nk; const int kn = (kt + 1) * 64 + scs * 8;
        if (more) {
#pragma unroll
            for (int i = 0; i < 4; ++i) {
                GLDS16(Bt + (size_t)brow[i] * K + kn, nB + dma_off + i * 4096);
                if (AL::DMA) GLDS16(al.src(m0 + srow + 32 * i, kn), nA + dma_off + i * 4096);
                else ra[i] = al.load(m0 + srow + 32 * i, kn);
            }
        }
#pragma unroll
        for (int ks = 0; ks < 2; ++ks) {
            bf16x8 af[4], bfr[4];
#pragma unroll
            for (int i = 0; i < 4; ++i) {
                af[i] = *(const bf16x8*)(bufA + ((fa0 + i * 2048) ^ (ks << 6)));
                bfr[i] = *(const bf16x8*)(bufB + ((fb0 + i * 2048) ^ (ks << 6)));
            }
#pragma unroll
            for (int i = 0; i < 4; ++i)
#pragma unroll
                for (int j = 0; j < 4; ++j) acc[i][j] = __builtin_amdgcn_mfma_f32_16x16x32_bf16(bfr[j], af[i], acc[i][j], 0, 0, 0);
        }
        if (more && !AL::DMA) {
#pragma unroll
            for (int i = 0; i < 4; ++i) *(u32x4*)(nA + st_off + i * 4096) = al.finish(ra[i], m0 + srow + 32 * i, kn);
        }
        asm volatile("s_waitcnt vmcnt(0)" ::: "memory");
        __syncthreads();
    }
#pragma unroll
    for (int mt = 0; mt < 4; ++mt)
#pragma unroll
        for (int gi = 0; gi < 2; ++gi) {
            float v[8];
#pragma unroll
            for (int r = 0; r < 4; ++r) { v[r] = acc[mt][2 * gi][r]; v[4 + r] = acc[mt][2 * gi + 1][r]; }
            epi(m0 + wr * 64 + mt * 16 + l15, n0 + wc * 64 + gi * 32 + 8 * q, v, mt, gi);
        }
    epi.finish(m0, n0, wr, wc, lane);
}

constexpr int G2_STAGE = 24576;
template <class AL, class Epi>
DI void gemm_tile2(const AL& al, const bf16* __restrict__ Bt, int K, int m0, int n0, const Epi& epi, char* smem) {
    const int tid = TIDX, lane = tid & 63, wave = __builtin_amdgcn_readfirstlane(tid >> 6), wr = wave >> 1, wc = wave & 1, q = lane >> 4, l15 = lane & 15;
    const int prow = tid >> 2, ppos = tid & 3, ca = (ppos - 2 * ((tid >> 4) & 3)) & 3;
    const int dma_off = wave * 1024;
    int brow[4];
#pragma unroll
    for (int i = 0; i < 4; ++i) { const int rho = prow + 64 * i; brow[i] = n0 + (rho & ~31) + perm32(rho & 31); }
    const int fpos = ((q + 2 * ((l15 >> 2) & 3)) & 3) << 4;
    const int fa0 = (wr * 64 + l15) * 64 + fpos, fb0 = 8192 + (wc * 128 + l15) * 64 + fpos;
    f32x4 acc[4][8];
#pragma unroll
    for (int i = 0; i < 4; ++i)
#pragma unroll
        for (int j = 0; j < 8; ++j) acc[i][j] = (f32x4){0.f, 0.f, 0.f, 0.f};
    typename AL::Raw ra[2];
    const int nk = K / 32;
#define G2_ISSUE(kt_) { char* st_ = smem + ((kt_) % 3) * G2_STAGE; const int kk_ = (kt_) * 32 + ca * 8; \
        _Pragma("unroll") for (int i = 0; i < 2; ++i) { if (AL::DMA) GLDS16(al.src(m0 + prow + 64 * i, kk_), st_ + dma_off + i * 4096); else ra[i] = al.load(m0 + prow + 64 * i, kk_); } \
        _Pragma("unroll") for (int i = 0; i < 4; ++i) GLDS16(Bt + (size_t)brow[i] * K + kk_, st_ + 8192 + dma_off + i * 4096); }
#define G2_AWRITE(kt_) { if (!AL::DMA) { char* st_ = smem + ((kt_) % 3) * G2_STAGE; const int kk_ = (kt_) * 32 + ca * 8; \
        _Pragma("unroll") for (int i = 0; i < 2; ++i) *(u32x4*)(st_ + (prow + 64 * i) * 64 + ppos * 16) = al.finish(ra[i], m0 + prow + 64 * i, kk_); } }
#define G2_BARRIER() { asm volatile("s_waitcnt lgkmcnt(0)" ::: "memory"); __builtin_amdgcn_s_barrier(); asm volatile("" ::: "memory"); }
    G2_ISSUE(0); G2_AWRITE(0);
    if (nk > 1) { G2_ISSUE(1); G2_AWRITE(1); }
    if (nk > 1) { if (AL::DMA) asm volatile("s_waitcnt vmcnt(6)" ::: "memory"); else asm volatile("s_waitcnt vmcnt(4)" ::: "memory"); } else asm volatile("s_waitcnt vmcnt(0)" ::: "memory");
    G2_BARRIER();
    for (int kt = 0; kt < nk; ++kt) {
        const char* st = smem + (kt % 3) * G2_STAGE;
        const bool more = kt + 2 < nk;
        if (more) G2_ISSUE(kt + 2);
        bf16x8 af[4];
#pragma unroll
        for (int i = 0; i < 4; ++i) af[i] = *(const bf16x8*)(st + fa0 + i * 1024);
#pragma unroll
        for (int j = 0; j < 8; ++j) {
            const bf16x8 bf_ = *(const bf16x8*)(st + fb0 + j * 1024);
#pragma unroll
            for (int i = 0; i < 4; ++i) acc[i][j] = __builtin_amdgcn_mfma_f32_16x16x32_bf16(bf_, af[i], acc[i][j], 0, 0, 0);
        }
        if (more) G2_AWRITE(kt + 2);
        if (more) { if (AL::DMA) asm volatile("s_waitcnt vmcnt(6)" ::: "memory"); else asm volatile("s_waitcnt vmcnt(4)" ::: "memory"); } else asm volatile("s_waitcnt vmcnt(0)" ::: "memory");
        G2_BARRIER();
    }
#undef G2_ISSUE
#undef G2_AWRITE
#undef G2_BARRIER
#pragma unroll
    for (int mt = 0; mt < 4; ++mt)
#pragma unroll
        for (int gi = 0; gi < 4; ++gi) {
            float v[8];
#pragma unroll
            for (int r = 0; r < 4; ++r) { v[r] = acc[mt][2 * gi][r]; v[4 + r] = acc[mt][2 * gi + 1][r]; }
            epi(m0 + wr * 64 + mt * 16 + l15, n0 + wc * 128 + gi * 32 + 8 * q, v, mt, gi);
        }
    epi.finish_wide(m0, n0, wr, wc, lane);
}
template <class F>
DI void gemm_sched(int nbig, int nsmall, F&& f) {
    const int x = blockIdx.x & 7, lb = blockIdx.x >> 3, nlb = gridDim.x >> 3;
    const int nb16 = 16 * nbig, tot = 16 * (nbig + nsmall);
    for (int s = lb; s < tot; s += nlb) {
        if (s < nb16) f(true, x * 16 + (s & 15), s >> 4);
        else { const int t = s - nb16; f(false, x * 16 + (t & 15), t >> 4); }
    }
}

DI float rstd_from_parts(const float* parts, int m) {
    const float4* p = (const float4*)(parts + (size_t)m * 16); float s = 0.f;
#pragma unroll
    for (int i = 0; i < 4; ++i) { const float4 v = p[i]; s += (v.x + v.y) + (v.z + v.w); }
    return 1.0f / sqrtf(s * (1.0f / D) + 1e-6f);
}
DI void store8bf(bf16* p, const float* v) { *(u32x4*)p = (u32x4){pack2bf(v[0], v[1]), pack2bf(v[2], v[3]), pack2bf(v[4], v[5]), pack2bf(v[6], v[7])}; }

struct EpiBf16 {
    bf16* P; int ldp; const float* parts; mutable float rsc[4];
    DI void operator()(int m, int n, const float* v, int mt, int gi) const {
        if (gi == 0) rsc[mt] = parts ? rstd_from_parts(parts, m) : 1.0f;
        float s = rsc[mt]; float w[8];
#pragma unroll
        for (int j = 0; j < 8; ++j) w[j] = v[j] * s;
        store8bf(P + (size_t)m * ldp + n, w);
    }
    DI void finish(int, int, int, int, int) const {}
    DI void finish_wide(int, int, int, int, int) const {}
};
struct EpiResid {
    const float* xin; float* xout; bf16* xb; float* parts; mutable float sq[4];
    DI void operator()(int m, int n, const float* v, int mt, int gi) const {
        const float4* xi = (const float4*)(xin + (size_t)m * D + n); const float4 a = xi[0], b = xi[1];
        float w[8] = {a.x + v[0], a.y + v[1], a.z + v[2], a.w + v[3], b.x + v[4], b.y + v[5], b.z + v[6], b.w + v[7]};
        float4* xo = (float4*)(xout + (size_t)m * D + n);
        xo[0] = make_float4(w[0], w[1], w[2], w[3]); xo[1] = make_float4(w[4], w[5], w[6], w[7]);
        if (xb) store8bf(xb + (size_t)m * D + n, w);
        float s = 0.f;
#pragma unroll
        for (int j = 0; j < 8; ++j) s += w[j] * w[j];
        if (gi == 0) sq[mt] = s; else sq[mt] += s;
    }
    DI void finish(int m0, int n0, int wr, int wc, int lane) const {
#pragma unroll
        for (int mt = 0; mt < 4; ++mt) {
            float s = sq[mt]; s += __shfl_xor(s, 16); s += __shfl_xor(s, 32);
            if (lane < 16) parts[(size_t)(m0 + wr * 64 + mt * 16 + lane) * 16 + (n0 >> 7) * 2 + wc] = s;
        }
    }
    DI void finish_wide(int m0, int n0, int wr, int wc, int lane) const {
#pragma unroll
        for (int mt = 0; mt < 4; ++mt) {
            float s = sq[mt]; s += __shfl_xor(s, 16); s += __shfl_xor(s, 32);
            if (lane < 16) { float* pr = parts + (size_t)(m0 + wr * 64 + mt * 16 + lane) * 16 + (n0 >> 7) + wc; pr[0] = s; pr[8] = 0.f; }
        }
    }
};
struct EpiRwkv {
    bf16* P; float* hw; float* ha;
    DI void operator()(int m, int n, const float* v, int, int) const {
        if (n < 4096) { store8bf(P + (size_t)m * 4096 + n, v); return; }
        const int c = n - 4096;
        if (c < 64) { float4* o = (float4*)(hw + (size_t)m * 64 + c); o[0] = make_float4(tanhf(v[0]), tanhf(v[1]), tanhf(v[2]), tanhf(v[3])); o[1] = make_float4(tanhf(v[4]), tanhf(v[5]), tanhf(v[6]), tanhf(v[7])); }
        else if (c >= 128 && c < 192) { float4* o = (float4*)(ha + (size_t)m * 64 + (c - 128)); o[0] = make_float4(v[0], v[1], v[2], v[3]); o[1] = make_float4(v[4], v[5], v[6], v[7]); }
    }
    DI void finish(int, int, int, int, int) const {}
    DI void finish_wide(int, int, int, int, int) const {}
};

namespace at {
constexpr int OFF_BIAS = 49152;
constexpr int OFF_X = 61952;
constexpr int OFF_IMP = 49152;
constexpr float L2E = 1.4426950408889634f;
constexpr float NEG_MASK = -1e30f, M_INIT = -1e20f;
}
enum { AM_SWA = 0, AM_WIN = 1, AM_CMP = 2, AM_SEL = 3 };
DI int vt_perm(int k32) { return ((k32 & 15) >> 2) * 8 + (k32 >> 4) * 4 + (k32 & 3); }
DI float fast_exp2(float x) { return __builtin_amdgcn_exp2f(x); }

DI void build_bias_lut(const float* __restrict__ t5, char* smem, bool swa) {
    float* lut = (float*)(smem + at::OFF_BIAS);
    for (int i = TIDX; i < 16 * 200; i += NTHREADS) {
        const int h = i / 200, e = i % 200; float v = at::NEG_MASK;
        if (e >= 64 && e < 192) v = t5[t5_bucket(e - 64) * 16 + h] * at::L2E;
        else if (e >= 192 && !swa) v = t5[31 * 16 + h] * at::L2E;
        lut[i] = v;
    }
    __syncthreads();
}

template <int NQT> struct AttnStateT { f32x4 o[NQT][4]; f32x4 lacc[NQT]; float m[NQT]; };
#ifndef ANQT_SWA
#define ANQT_SWA 4
#endif
#ifndef ANQT_WIN
#define ANQT_WIN 2
#endif
#ifndef ANQT_SEL
#define ANQT_SEL 4
#endif
DI unsigned long long range_mask(int lo, int hi) { return (hi >= 63 ? ~0ull : ((1ull << (hi + 1)) - 1ull)) & ~((1ull << lo) - 1ull); }

template <int NQT>
DI void attn_load_q(bf16x8 (&qf)[NQT][2], const bf16* __restrict__ Qp, int ldq, size_t mbase, int hbase) {
    const int lane = TIDX & 63, wave = TIDX >> 6, q = lane >> 4, l15 = lane & 15;
#pragma unroll
    for (int qt = 0; qt < NQT; ++qt) {
        const size_t m = mbase + wave * (4 * NQT) + qt * 4 + (l15 >> 2);
#pragma unroll
        for (int ks = 0; ks < 2; ++ks) qf[qt][ks] = *(const bf16x8*)(Qp + m * ldq + (hbase + (l15 & 3)) * 64 + ks * 32 + q * 8);
    }
}

enum { SK_FAR = 0, SK_NEAR = 1, SK_EDGE = 2, SK_CMP = 3 };
template <int KIND>
DI float attn_fix(f32x4 (&s)[4], int dbase, float cadd, const float* __restrict__ bl, float mx) {
#pragma unroll
    for (int kt = 0; kt < 4; ++kt)
#pragma unroll
        for (int r = 0; r < 4; ++r) {
            float v = s[kt][r]; const int dist = dbase - (kt * 16 + r);
            if (KIND == SK_NEAR) { int idx = dist + 64; idx = idx < 0 ? 0 : (idx > 192 ? 192 : idx); v += bl[idx] + cadd; }
            else if (KIND == SK_EDGE) v = dist < 512 ? v + cadd : at::NEG_MASK;
            else if (KIND == SK_CMP) v = dist >= 0 ? v : at::NEG_MASK;
            if (KIND != SK_FAR) s[kt][r] = v;
            mx = fmaxf(mx, v);
        }
    return mx;
}
template <int MODE, int NQT>
DI void attn_blocks(AttnStateT<NQT>& st, const bf16x8 (&qf)[NQT][2], const bf16* __restrict__ Kp, size_t krs, const bf16* __restrict__ Vp, size_t vrs,
                    int t0, unsigned long long todo, int hbase, const unsigned long long (&sel)[NQT], char* smem) {
    const int tid = TIDX, lane = tid & 63, wave = __builtin_amdgcn_readfirstlane(tid >> 6), q = lane >> 4, l15 = lane & 15;
    const int tq0 = t0 + wave * (4 * NQT) + (l15 >> 2);
    const float* bl = (const float*)(smem + at::OFF_BIAS) + (hbase + (l15 & 3)) * 200;
    const float bfar = (MODE != AM_CMP) ? bl[192] : 0.f;
    const int srow = tid >> 3, scs = (tid & 7) ^ (srow & 7);
    const int fo = l15 * 128 + ((q ^ (l15 & 7)) << 4);
#define ATT_DMA(kb_, slot_) { _Pragma("unroll") for (int i = 0; i < 2; ++i) { const int row = srow + 32 * i; char* dst = smem + (slot_) * 16384 + (8 * wave + 32 * i) * 128; \
        GLDS16(Kp + (size_t)((kb_) * 64 + row) * krs + scs * 8, dst); GLDS16(Vp + (size_t)row * vrs + (kb_) * 64 + scs * 8, dst + 8192); } }
#define ATT_BARRIER() { asm volatile("s_waitcnt lgkmcnt(0)" ::: "memory"); __builtin_amdgcn_s_barrier(); asm volatile("" ::: "memory"); }
    if (todo == 0ull) return;
    int kb = __builtin_ctzll(todo); todo &= todo - 1ull;
    int kb1 = -1; if (todo) { kb1 = __builtin_ctzll(todo); todo &= todo - 1ull; }
    ATT_DMA(kb, 0);
    if (kb1 >= 0) { ATT_DMA(kb1, 1); asm volatile("s_waitcnt vmcnt(4)" ::: "memory"); } else { asm volatile("s_waitcnt vmcnt(0)" ::: "memory"); }
    ATT_BARRIER();
    int slot = 0;
    for (;;) {
        char* buf = smem + slot * 16384;
        int kb2 = -1; if (todo) { kb2 = __builtin_ctzll(todo); todo &= todo - 1ull; }
        if (kb2 >= 0) { const int s2 = slot >= 1 ? slot - 1 : 2; ATT_DMA(kb2, s2); }
        f32x4 s[NQT][4];
#pragma unroll
        for (int qt = 0; qt < NQT; ++qt)
#pragma unroll
            for (int kt = 0; kt < 4; ++kt) s[qt][kt] = (f32x4){0.f, 0.f, 0.f, 0.f};
#pragma unroll
        for (int kt = 0; kt < 4; ++kt)
#pragma unroll
            for (int ks = 0; ks < 2; ++ks) {
                const bf16x8 kf = *(const bf16x8*)(buf + ((fo + kt * 2048) ^ (ks << 6)));
#pragma unroll
                for (int qt = 0; qt < NQT; ++qt) s[qt][kt] = __builtin_amdgcn_mfma_f32_16x16x32_bf16(kf, qf[qt][ks], s[qt][kt], 0, 0, 0);
            }
        const int mind = (t0 + wave * (4 * NQT)) - (kb * 64 + 63), maxd = (t0 + wave * (4 * NQT) + 4 * NQT - 1) - kb * 64;
        float mx[NQT], cofs[NQT];
#pragma unroll
        for (int qt = 0; qt < NQT; ++qt) cofs[qt] = 0.f;
        if (MODE == AM_CMP) {
#pragma unroll
            for (int qt = 0; qt < NQT; ++qt) { const int nlim = (tq0 + 4 * qt - 31) >> 4; mx[qt] = attn_fix<SK_CMP>(s[qt], nlim - (kb * 64 + 4 * q), 0.f, bl, at::NEG_MASK); }
        } else {
            float cadd[NQT];
#pragma unroll
            for (int qt = 0; qt < NQT; ++qt) cadd[qt] = (MODE == AM_SEL && !((sel[qt] >> kb) & 1ull)) ? at::NEG_MASK : 0.f;
            if (MODE == AM_SWA || mind < 113) {
#pragma unroll
                for (int qt = 0; qt < NQT; ++qt) mx[qt] = attn_fix<SK_NEAR>(s[qt], tq0 + 4 * qt - (kb * 64 + 4 * q), cadd[qt], bl, at::NEG_MASK);
            } else if (MODE == AM_WIN && maxd >= 512) {
#pragma unroll
                for (int qt = 0; qt < NQT; ++qt) mx[qt] = attn_fix<SK_EDGE>(s[qt], tq0 + 4 * qt - (kb * 64 + 4 * q), bfar, bl, at::NEG_MASK);
            } else {
#pragma unroll
                for (int qt = 0; qt < NQT; ++qt) { cofs[qt] = bfar + cadd[qt]; mx[qt] = attn_fix<SK_FAR>(s[qt], 0, 0.f, bl, at::NEG_MASK) + cofs[qt]; }
            }
        }
        float msub[NQT]; bool grow = false;
#pragma unroll
        for (int qt = 0; qt < NQT; ++qt) {
            float m2 = mx[qt];
            m2 = fmaxf(m2, __shfl_xor(m2, 16)); m2 = fmaxf(m2, __shfl_xor(m2, 32));
            const bool g = m2 > st.m[qt] + 4.0f; grow |= g;
            mx[qt] = g ? m2 : st.m[qt];
            msub[qt] = mx[qt] - cofs[qt];
        }
        if (__any(grow)) {
#pragma unroll
            for (int qt = 0; qt < NQT; ++qt) {
                const float alpha = fast_exp2(st.m[qt] - mx[qt]);
#pragma unroll
                for (int dt = 0; dt < 4; ++dt) st.o[qt][dt] *= alpha;
                st.lacc[qt] *= alpha;
            }
        }
#pragma unroll
        for (int qt = 0; qt < NQT; ++qt) st.m[qt] = mx[qt];
#pragma unroll
        for (int qt = 0; qt < NQT; ++qt)
#pragma unroll
            for (int kt = 0; kt < 4; ++kt)
#pragma unroll
                for (int r = 0; r < 4; ++r) s[qt][kt][r] = fast_exp2(s[qt][kt][r] - msub[qt]);
        const bf16x8 ones = {(short)0x3F80, (short)0x3F80, (short)0x3F80, (short)0x3F80, (short)0x3F80, (short)0x3F80, (short)0x3F80, (short)0x3F80};
#pragma unroll
        for (int kp = 0; kp < 2; ++kp) {
            bf16x8 pf[NQT];
#pragma unroll
            for (int qt = 0; qt < NQT; ++qt) {
                const u32x4 w = {pack2bf(s[qt][2 * kp][0], s[qt][2 * kp][1]), pack2bf(s[qt][2 * kp][2], s[qt][2 * kp][3]),
                                 pack2bf(s[qt][2 * kp + 1][0], s[qt][2 * kp + 1][1]), pack2bf(s[qt][2 * kp + 1][2], s[qt][2 * kp + 1][3])};
                pf[qt] = __builtin_bit_cast(bf16x8, w);
            }
#pragma unroll
            for (int qt = 0; qt < NQT; ++qt) st.lacc[qt] = __builtin_amdgcn_mfma_f32_16x16x32_bf16(ones, pf[qt], st.lacc[qt], 0, 0, 0);
#pragma unroll
            for (int dt = 0; dt < 4; ++dt) {
                const bf16x8 vf = *(const bf16x8*)(buf + 8192 + ((fo + dt * 2048) ^ (kp << 6)));
#pragma unroll
                for (int qt = 0; qt < NQT; ++qt) st.o[qt][dt] = __builtin_amdgcn_mfma_f32_16x16x32_bf16(vf, pf[qt], st.o[qt][dt], 0, 0, 0);
            }
        }
        if (kb1 < 0) break;
        if (kb2 >= 0) { asm volatile("s_waitcnt vmcnt(4)" ::: "memory"); } else { asm volatile("s_waitcnt vmcnt(0)" ::: "memory"); }
        ATT_BARRIER();
        kb = kb1; kb1 = kb2; slot = slot == 2 ? 0 : slot + 1;
    }
    ATT_BARRIER();
#undef ATT_DMA
}
template <int NQT>
DI void attn_init(AttnStateT<NQT>& st, float m0, float l0) {
#pragma unroll
    for (int qt = 0; qt < NQT; ++qt) { st.m[qt] = m0; st.lacc[qt] = (f32x4){l0, l0, l0, l0};
#pragma unroll
        for (int dt = 0; dt < 4; ++dt) st.o[qt][dt] = (f32x4){0.f, 0.f, 0.f, 0.f}; }
}
DI float attn_linv(const f32x4& lacc) { const float l = lacc[0]; return l > 0.f ? 1.0f / l : 0.f; }

template <int TT>
DI void attn_item_decode(int item, int& b, int& g, int& t0) {
    constexpr int tiles = T / TT;
    const int Gd = (int)gridDim.x;
    int pair, tile;
    if ((Gd % tiles) == 0 && tiles * B * G % Gd == 0) {
        const int bid = item % Gd, rr = item / Gd, tau = bid % tiles;
        pair = bid / tiles + (Gd / tiles) * rr; tile = (rr & 1) ? tiles - 1 - tau : tau;
    } else { tile = item % tiles; pair = item / tiles; }
    t0 = tile * TT; g = pair % G; b = pair / G;
}
DI void swa_item(const bf16* __restrict__ P0, const bf16* __restrict__ VT, const float* __restrict__ sinks, bf16* __restrict__ AO, int item, char* smem) {
    constexpr int LDP = 2304;
    constexpr int NQT = ANQT_SWA;
    int b, g, t0; attn_item_decode<16 * NQT>(item, b, g, t0);
    const int lane = TIDX & 63, wave = TIDX >> 6, q = lane >> 4, l15 = lane & 15;
    const size_t mbase = (size_t)b * T + t0; const int hbase = g * 4, h = hbase + (l15 & 3);
    bf16x8 qf[NQT][2]; attn_load_q<NQT>(qf, P0, LDP, mbase, hbase);
    AttnStateT<NQT> st; attn_init<NQT>(st, sinks[h] * at::L2E, 1.0f);
    const int lo = t0 - 127 < 0 ? 0 : (t0 - 127) >> 6, hi = (t0 + 16 * NQT - 1) >> 6;
    const unsigned long long nosel[NQT] = {};
    attn_blocks<AM_SWA, NQT>(st, qf, P0 + (size_t)b * T * LDP + 1024 + g * 64, LDP, VT + (size_t)(b * G + g) * 64 * T, T, t0, range_mask(lo, hi), hbase, nosel, smem);
#pragma unroll
    for (int qt = 0; qt < NQT; ++qt) {
        const float li = attn_linv(st.lacc[qt]); const size_t m = mbase + wave * (4 * NQT) + qt * 4 + (l15 >> 2);
#pragma unroll
        for (int dt = 0; dt < 4; ++dt) {
            const int d0 = dt * 16 + 4 * q; const u32x2 zz = *(const u32x2*)(P0 + m * LDP + 1280 + h * 64 + d0);
            const float z0 = bflo(zz[0]), z1 = bfhi(zz[0]), z2 = bflo(zz[1]), z3 = bfhi(zz[1]);
            const f32x4 o = st.o[qt][dt];
            *(u32x2*)(AO + m * D + h * 64 + d0) = (u32x2){pack2bf(o[0] * li * siluf_(z0), o[1] * li * siluf_(z1)), pack2bf(o[2] * li * siluf_(z2), o[3] * li * siluf_(z3))};
        }
    }
}

struct EpiL0 {
    bf16* P0; bf16* VT; const float* parts; mutable float rsc[4];
    DI void operator()(int m, int n, const float* v, int mt, int gi) const {
        if (gi == 0) rsc[mt] = rstd_from_parts(parts, m);
        float s = rsc[mt]; if (n < 1024) s *= 0.125f * at::L2E; float w[8];
#pragma unroll
        for (int j = 0; j < 8; ++j) w[j] = v[j] * s;
        if (n < 1280) store8bf(P0 + (size_t)m * 2304 + n, w);
        else if (n >= 1536) store8bf(P0 + (size_t)m * 2304 + n - 256, w);
        else {
            const int g = (n - 1280) >> 6, d = (n - 1280) & 63, b = m / T, t = m % T; const int pos = (t & ~31) + vt_perm(t & 31);
            bf16* dst = VT + ((size_t)(b * G + g) * 64 + d) * T + pos;
#pragma unroll
            for (int j = 0; j < 8; ++j) dst[(size_t)j * T] = f2bf(w[j]);
        }
    }
    DI void finish(int, int, int, int, int) const {}
    DI void finish_wide(int, int, int, int, int) const {}
};

constexpr int LDP2 = 3200;
struct EpiL2 {
    bf16* P2; bf16* VTs; bf16* VTw; const float* parts; mutable float rsc[4];
    DI void operator()(int m, int n, const float* v, int mt, int gi) const {
        if (gi == 0) rsc[mt] = rstd_from_parts(parts, m);
        if (n >= C_COLS) return;
        float s = rsc[mt]; if (n < 1024) s *= 0.125f * at::L2E; float w[8];
#pragma unroll
        for (int j = 0; j < 8; ++j) w[j] = v[j] * s;
        const bool isvs = n >= 1792 && n < 2048, isvw = n >= 2304 && n < 2560;
        if (isvs || isvw) {
            const int c = n - (isvs ? 1792 : 2304); const int g = c >> 6, d = c & 63, b = m / T, t = m % T; const int pos = (t & ~31) + vt_perm(t & 31);
            bf16* dst = (isvs ? VTs : VTw) + ((size_t)(b * G + g) * 64 + d) * T + pos;
#pragma unroll
            for (int j = 0; j < 8; ++j) dst[(size_t)j * T] = f2bf(w[j]);
        } else {
            const int c = n < 1792 ? n : (n < 2304 ? n - 256 : n - 512);
            store8bf(P2 + (size_t)m * LDP2 + c, w);
        }
    }
    DI void finish(int, int, int, int, int) const {}
    DI void finish_wide(int, int, int, int, int) const {}
};

struct ALoadCmp {
    const bf16* P2; int col;
    static constexpr bool DMA = true;
    DI const bf16* src(int row, int k) const {
        int n = row & 255; const int bg = row >> 8, b = bg >> 2, g = bg & 3; const int l = k >> 6, d = k & 63; n = n < NCMP ? n : NCMP - 1;
        return P2 + (size_t)(b * T + 16 * n + l) * LDP2 + col + g * 64 + d;
    }
    struct Raw { u32x4 v; };
    DI Raw load(int row, int k) const {
        const int n = row & 255, bg = row >> 8, b = bg >> 2, g = bg & 3; const int l = k >> 6, d = k & 63; Raw r;
        if (n < NCMP) r.v = *(const u32x4*)(P2 + (size_t)(b * T + 16 * n + l) * LDP2 + col + g * 64 + d); else r.v = (u32x4){0u, 0u, 0u, 0u};
        return r;
    }
    DI u32x4 finish(const Raw& r, int, int) const { return r.v; }
};
struct EpiCmpH {
    char* smem; const float* bias8;
    DI void operator()(int m, int n, const float* v, int, int) const {
        const int row = m & 127; float w[8];
#pragma unroll
        for (int j = 0; j < 8; ++j) { float bsum = 0.f;
#pragma unroll
            for (int i = 0; i < 8; ++i) bsum += bias8[i * 128 + n + j];
            w[j] = siluf_(v[j] + bsum); }
        const int kk = n >> 6, c = (n & 63) >> 3;
        *(u32x4*)(smem + kk * 16384 + row * 128 + ((c ^ (row & 7)) << 4)) = (u32x4){pack2bf(w[0], w[1]), pack2bf(w[2], w[3]), pack2bf(w[4], w[5]), pack2bf(w[6], w[7])};
    }
    DI void finish(int, int, int, int, int) const {}
    DI void finish_wide(int, int, int, int, int) const {}
};
DI void cmp_tile(const bf16* __restrict__ P2, const bf16* __restrict__ w1t, const float* __restrict__ bias8, const bf16* __restrict__ w2t, int which, int rt,
                 bf16* __restrict__ KCb, bf16* __restrict__ VCT, char* smem) {
    gemm_tile(ALoadCmp{P2, which ? 1280 : 1024}, w1t, 2048, rt * 128, 0, EpiCmpH{smem, bias8}, smem);
    const int tid = TIDX, lane = tid & 63, wave = tid >> 6, q = lane >> 4, l15 = lane & 15;
#pragma unroll
    for (int i = 0; i < 4; ++i) {
        const int id = i * 256 + tid; const int row = id >> 4, c16 = id & 15, kk = c16 >> 3, c = c16 & 7;
        *(u32x4*)(smem + 32768 + kk * 8192 + row * 128 + ((c ^ (row & 7)) << 4)) = *(const u32x4*)(w2t + (size_t)row * 128 + c16 * 8);
    }
    __syncthreads();
    f32x4 acc[2][4];
#pragma unroll
    for (int i = 0; i < 2; ++i)
#pragma unroll
        for (int j = 0; j < 4; ++j) acc[i][j] = (f32x4){0.f, 0.f, 0.f, 0.f};
    const int fo = l15 * 128 + ((q ^ (l15 & 7)) << 4);
#pragma unroll
    for (int kk = 0; kk < 2; ++kk)
#pragma unroll
        for (int ks = 0; ks < 2; ++ks) {
            bf16x8 hf[2], wf[4];
#pragma unroll
            for (int i = 0; i < 2; ++i) hf[i] = *(const bf16x8*)(smem + kk * 16384 + (((wave * 32 + i * 16) * 128 + fo) ^ (ks << 6)));
#pragma unroll
            for (int j = 0; j < 4; ++j) wf[j] = *(const bf16x8*)(smem + 32768 + kk * 8192 + ((j * 2048 + fo) ^ (ks << 6)));
#pragma unroll
            for (int i = 0; i < 2; ++i)
#pragma unroll
                for (int j = 0; j < 4; ++j) acc[i][j] = __builtin_amdgcn_mfma_f32_16x16x32_bf16(wf[j], hf[i], acc[i][j], 0, 0, 0);
        }
#pragma unroll
    for (int i = 0; i < 2; ++i) {
        const int row = rt * 128 + wave * 32 + i * 16 + l15; const int n = row & 255, bg = row >> 8;
#pragma unroll
        for (int j = 0; j < 4; ++j) {
            const int d0 = j * 16 + 4 * q; const f32x4 a = acc[i][j];
            if (which == 0) *(u32x2*)(KCb + (size_t)row * 64 + d0) = (u32x2){pack2bf(a[0], a[1]), pack2bf(a[2], a[3])};
            else {
                const int pos = (n & ~31) + vt_perm(n & 31);
#pragma unroll
                for (int r = 0; r < 4; ++r) VCT[((size_t)bg * 64 + d0 + r) * 256 + pos] = f2bf(a[r]);
            }
        }
    }
    __syncthreads();
}

DI void win_item(const bf16* __restrict__ P2, const bf16* __restrict__ VTw, bf16* __restrict__ OW, int item, char* smem) {
    constexpr int NQT = ANQT_WIN;
    int b, g, t0; attn_item_decode<16 * NQT>(item, b, g, t0);
    const int lane = TIDX & 63, wave = TIDX >> 6, q = lane >> 4, l15 = lane & 15;
    const size_t mbase = (size_t)b * T + t0; const int hbase = g * 4, h = hbase + (l15 & 3);
    bf16x8 qf[NQT][2]; attn_load_q<NQT>(qf, P2, LDP2, mbase, hbase);
    AttnStateT<NQT> st; attn_init<NQT>(st, at::M_INIT, 0.f);
    const int lo = t0 - 511 < 0 ? 0 : (t0 - 511) >> 6, hi = (t0 + 16 * NQT - 1) >> 6;
    const unsigned long long nosel[NQT] = {};
    attn_blocks<AM_WIN, NQT>(st, qf, P2 + (size_t)b * T * LDP2 + 1792 + g * 64, LDP2, VTw + (size_t)(b * G + g) * 64 * T, T, t0, range_mask(lo, hi), hbase, nosel, smem);
#pragma unroll
    for (int qt = 0; qt < NQT; ++qt) {
        const float li = attn_linv(st.lacc[qt]); const size_t m = mbase + wave * (4 * NQT) + qt * 4 + (l15 >> 2);
#pragma unroll
        for (int dt = 0; dt < 4; ++dt) { const f32x4 o = st.o[qt][dt]; *(u32x2*)(OW + m * D + h * 64 + dt * 16 + 4 * q) = (u32x2){pack2bf(o[0] * li, o[1] * li), pack2bf(o[2] * li, o[3] * li)}; }
    }
}

DI void cmpsel_item(const bf16* __restrict__ P2, const bf16* __restrict__ KCb, const bf16* __restrict__ VCT, bf16* __restrict__ OC, unsigned long long* __restrict__ SELM, int item, char* smem) {
    int b, g, t0; attn_item_decode<32>(item, b, g, t0);
    const int tid = TIDX, lane = tid & 63, wave = tid >> 6, q = lane >> 4, l15 = lane & 15;
    const size_t mbase = (size_t)b * T + t0; const int hbase = g * 4, h = hbase + (l15 & 3);
    float* impL = (float*)(smem + at::OFF_IMP);
    for (int i = tid; i < 32 * 64; i += NTHREADS) impL[i] = 0.f;
    bf16x8 qf[2][2]; attn_load_q<2>(qf, P2, LDP2, mbase, hbase);
    AttnStateT<2> st; attn_init<2>(st, at::M_INIT, 0.f);
    const int nvmax = (t0 + 31 - 31) / 16 + 1;
    const int hi = (nvmax - 1) >> 6;
    const bf16* Kp = KCb + (size_t)(b * G + g) * 256 * 64; const bf16* Vp = VCT + (size_t)(b * G + g) * 64 * 256;
    const unsigned long long nosel[2] = {0ull, 0ull};
    attn_blocks<AM_CMP, 2>(st, qf, Kp, 64, Vp, 256, t0, range_mask(0, hi), hbase, nosel, smem);
    float linv[2];
#pragma unroll
    for (int qt = 0; qt < 2; ++qt) {
        linv[qt] = attn_linv(st.lacc[qt]); const size_t m = mbase + wave * 8 + qt * 4 + (l15 >> 2);
#pragma unroll
        for (int dt = 0; dt < 4; ++dt) { const f32x4 o = st.o[qt][dt]; *(u32x2*)(OC + m * D + h * 64 + dt * 16 + 4 * q) = (u32x2){pack2bf(o[0] * linv[qt], o[1] * linv[qt]), pack2bf(o[2] * linv[qt], o[3] * linv[qt])}; }
    }
    {
        const int tq0 = t0 + wave * 8 + (l15 >> 2);
        const bf16* kp0 = Kp + (size_t)l15 * 64 + q * 8;
        bf16x8 kfA[4][2], kfB[4][2];
#define CS_LOADK(dst_, kb_) { _Pragma("unroll") for (int kt = 0; kt < 4; ++kt) _Pragma("unroll") for (int ks = 0; ks < 2; ++ks) \
            dst_[kt][ks] = *(const bf16x8*)(kp0 + (size_t)((kb_) * 64 + kt * 16) * 64 + ks * 32); }
#define CS_QSUM(x_) { x_ += __builtin_bit_cast(float, __builtin_amdgcn_update_dpp(0, __builtin_bit_cast(int, x_), 0xB1, 0xf, 0xf, false)); \
                      x_ += __builtin_bit_cast(float, __builtin_amdgcn_update_dpp(0, __builtin_bit_cast(int, x_), 0x4E, 0xf, 0xf, false)); }
#define CS_BLOCK(kf_, kb_) { const int kbi = (kb_); \
            f32x4 s[2][4]; \
            _Pragma("unroll") for (int qt = 0; qt < 2; ++qt) _Pragma("unroll") for (int kt = 0; kt < 4; ++kt) s[qt][kt] = (f32x4){0.f, 0.f, 0.f, 0.f}; \
            _Pragma("unroll") for (int kt = 0; kt < 4; ++kt) _Pragma("unroll") for (int ks = 0; ks < 2; ++ks) { \
                s[0][kt] = __builtin_amdgcn_mfma_f32_16x16x32_bf16(kf_[kt][ks], qf[0][ks], s[0][kt], 0, 0, 0); \
                s[1][kt] = __builtin_amdgcn_mfma_f32_16x16x32_bf16(kf_[kt][ks], qf[1][ks], s[1][kt], 0, 0, 0); } \
            const bool allvis = 16 * (kbi * 64 + 63) + 31 <= t0;         \
            _Pragma("unroll") for (int qt = 0; qt < 2; ++qt) { \
                const int tq = tq0 + 4 * qt; const int tl = wave * 8 + qt * 4 + (l15 >> 2); \
                _Pragma("unroll") for (int kt = 0; kt < 4; ++kt) { \
                    float pr[4]; \
                    _Pragma("unroll") for (int r = 0; r < 4; ++r) { const int key = kbi * 64 + kt * 16 + 4 * q + r; \
                        const float e = fast_exp2(s[qt][kt][r] - st.m[qt]) * linv[qt]; pr[r] = (allvis || 16 * key + 31 <= tq) ? e : 0.f; } \
                    float s4 = (pr[0] + pr[1]) + (pr[2] + pr[3]), s1 = pr[3]; \
                    CS_QSUM(s4); CS_QSUM(s1); \
                    const int s0 = kbi * 16 + kt * 4 + q; \
                    if ((l15 & 3) == 0) { atomicAdd(&impL[tl * 64 + s0], s4); if (s0 + 1 < 64) atomicAdd(&impL[tl * 64 + s0 + 1], s1); } \
                } \
            } }
        CS_LOADK(kfA, 0);
        for (int kb = 0; kb <= hi; kb += 2) {
            if (kb + 1 <= hi) CS_LOADK(kfB, kb + 1);
            CS_BLOCK(kfA, kb);
            if (kb + 1 > hi) break;
            if (kb + 2 <= hi) CS_LOADK(kfA, kb + 2);
            CS_BLOCK(kfB, kb + 1);
        }
#undef CS_LOADK
#undef CS_QSUM
#undef CS_BLOCK
        __syncthreads();
    }
    {
        const int tl = tid >> 3, sg = tid & 7; const int t = t0 + tl, cur = t >> 6; float* row = impL + tl * 64;
        unsigned hk[8]; unsigned long long mine[8];
#pragma unroll
        for (int j = 0; j < 8; ++j) { const int s = sg * 8 + j; const float v = row[s];
            hk[j] = (s == 0 || s == cur || s == cur - 1) ? 0x7F800000u : (s * 64 > t ? 0u : (v > 0.f ? __float_as_uint(v) + 1u : 1u));
            mine[j] = ((unsigned long long)hk[j] << 32) | (unsigned)(63 - s); }
        __syncthreads();
#pragma unroll
        for (int j = 0; j < 8; ++j) ((unsigned*)row)[sg * 8 + j] = hk[j];
        __syncthreads();
        int rank[8] = {0, 0, 0, 0, 0, 0, 0, 0};
        const int ns4 = ((((t0 + 31) >> 6) >> 2) + 2) & ~1;
#pragma unroll 2
        for (int s4 = 0; s4 < ns4; ++s4) {
            const u32x4 v4 = *(const u32x4*)(row + s4 * 4);
#pragma unroll
            for (int e = 0; e < 4; ++e) { const unsigned long long kv = ((unsigned long long)v4[e] << 32) | (unsigned)(63 - (s4 * 4 + e));
#pragma unroll
                for (int j = 0; j < 8; ++j) rank[j] += kv > mine[j] ? 1 : 0; }
        }
        unsigned long long bits = 0ull;
#pragma unroll
        for (int j = 0; j < 8; ++j) if (rank[j] < KTOP && (sg * 8 + j) * 64 <= t) bits |= 1ull << (sg * 8 + j);
        unsigned lo = (unsigned)bits, hi2 = (unsigned)(bits >> 32);
#pragma unroll
        for (int o = 1; o < 8; o <<= 1) { lo |= __shfl_xor(lo, o); hi2 |= __shfl_xor(hi2, o); }
        if (sg == 0) SELM[(mbase + tl) * 4 + g] = ((unsigned long long)hi2 << 32) | lo;
    }
    __syncthreads();
}

DI void sel_item(const bf16* __restrict__ P2, const bf16* __restrict__ VTs, const unsigned long long* __restrict__ SELM, const bf16* __restrict__ OC, const bf16* __restrict__ OW,
                 bf16* __restrict__ AO, int item, char* smem) {
    constexpr int NQT = ANQT_SEL;
    int b, g, t0; attn_item_decode<16 * NQT>(item, b, g, t0);
    const int tid = TIDX, lane = tid & 63, wave = tid >> 6, q = lane >> 4, l15 = lane & 15;
    const size_t mbase = (size_t)b * T + t0; const int hbase = g * 4, rr = l15 & 3, h = hbase + rr;
    unsigned long long* orw = (unsigned long long*)(smem + at::OFF_X);
    if (tid == 0) *orw = 0ull;
    __syncthreads();
    if (tid < 16 * NQT) atomicOr(orw, SELM[(mbase + tid) * 4 + g]);
    unsigned long long sel[NQT];
#pragma unroll
    for (int qt = 0; qt < NQT; ++qt) sel[qt] = SELM[(mbase + wave * (4 * NQT) + qt * 4 + (l15 >> 2)) * 4 + g];
    bf16x8 qf[NQT][2]; attn_load_q<NQT>(qf, P2, LDP2, mbase, hbase);
    AttnStateT<NQT> st; attn_init<NQT>(st, at::M_INIT, 0.f);
    __syncthreads();
    const unsigned long long todo_v = (*orw) & range_mask(0, (t0 + 16 * NQT - 1) >> 6);
    const unsigned long long todo = ((unsigned long long)(unsigned)__builtin_amdgcn_readfirstlane((int)(todo_v >> 32)) << 32) | (unsigned)__builtin_amdgcn_readfirstlane((int)(unsigned)todo_v);
    attn_blocks<AM_SEL, NQT>(st, qf, P2 + (size_t)b * T * LDP2 + 1536 + g * 64, LDP2, VTs + (size_t)(b * G + g) * 64 * T, T, t0, todo, hbase, sel, smem);
#pragma unroll
    for (int qt = 0; qt < NQT; ++qt) {
        const float li = attn_linv(st.lacc[qt]); const size_t m = mbase + wave * (4 * NQT) + qt * 4 + (l15 >> 2);
        const bf16* gr = P2 + m * LDP2 + 3072;
        const float g0 = sigmoidf_(bf2f(gr[0 * 16 + h])), g1 = sigmoidf_(bf2f(gr[1 * 16 + h])), g2 = sigmoidf_(bf2f(gr[2 * 16 + h]));
#pragma unroll
        for (int dt = 0; dt < 4; ++dt) {
            const int d0 = dt * 16 + 4 * q; const size_t oi = m * D + h * 64 + d0;
            const u32x2 zz = *(const u32x2*)(P2 + m * LDP2 + 2048 + h * 64 + d0), cc = *(const u32x2*)(OC + oi), ww = *(const u32x2*)(OW + oi);
            const f32x4 o = st.o[qt][dt];
            const float r0 = (g0 * bflo(cc[0]) + g1 * o[0] * li + g2 * bflo(ww[0])) * siluf_(bflo(zz[0]));
            const float r1 = (g0 * bfhi(cc[0]) + g1 * o[1] * li + g2 * bfhi(ww[0])) * siluf_(bfhi(zz[0]));
            const float r2 = (g0 * bflo(cc[1]) + g1 * o[2] * li + g2 * bflo(ww[1])) * siluf_(bflo(zz[1]));
            const float r3 = (g0 * bfhi(cc[1]) + g1 * o[3] * li + g2 * bfhi(ww[1])) * siluf_(bfhi(zz[1]));
            *(u32x2*)(AO + oi) = (u32x2){pack2bf(r0, r1), pack2bf(r2, r3)};
        }
    }
    __syncthreads();
}

DI void lru_convert_gates(const float* __restrict__ gaw, const float* __restrict__ gxw, bf16* __restrict__ img) {
    for (int i = blockIdx.x * NTHREADS + TIDX; i < 16 * 160 * 96; i += gridDim.x * NTHREADS) {
        const int k = i % 96, n = (i / 96) % 160, blk = i / (96 * 160);
        float v = 0.f;
        if (k < 80) v = n < 80 ? gaw[((size_t)blk * 80 + k) * 80 + n] : gxw[((size_t)blk * 80 + k) * 80 + (n - 80)];
        img[i] = f2bf(v);
    }
}
DI void lru_gate_item(const bf16* __restrict__ P3, const float* __restrict__ cw, const float* __restrict__ cb, const bf16* __restrict__ gimg, const float* __restrict__ gab, const float* __restrict__ gxb,
                      const float* __restrict__ lam, bf16* __restrict__ LA, bf16* __restrict__ BV, float2* __restrict__ SUM, int item, char* smem) {
    const int rt = item >> 4, nb = item & 15; const int tid = TIDX, lane = tid & 63, wave = tid >> 6, q = lane >> 4, l15 = lane & 15;
    const size_t m0 = (size_t)rt * 128;
    for (int id = tid; id < 128 * 12; id += NTHREADS) {
        const int row = id / 12, c12 = id % 12; u32x4 outv = (u32x4){0u, 0u, 0u, 0u};
        if (c12 < 10) {
            const size_t m = m0 + row; const int t = (int)(m % T); const int ch = nb * 80 + c12 * 8;
            float acc[8];
            { const float4 b0 = *(const float4*)(cb + ch), b1 = *(const float4*)(cb + ch + 4); acc[0] = b0.x; acc[1] = b0.y; acc[2] = b0.z; acc[3] = b0.w; acc[4] = b1.x; acc[5] = b1.y; acc[6] = b1.z; acc[7] = b1.w; }
#pragma unroll
            for (int w = 0; w < 4; ++w) {
                if (t - 3 + w >= 0) {
                    const u32x4 uv = *(const u32x4*)(P3 + (m - 3 + w) * 2560 + ch);
                    const float4 w0 = *(const float4*)(cw + w * LW + ch), w1 = *(const float4*)(cw + w * LW + ch + 4);
                    acc[0] += w0.x * bflo(uv[0]); acc[1] += w0.y * bfhi(uv[0]); acc[2] += w0.z * bflo(uv[1]); acc[3] += w0.w * bfhi(uv[1]);
                    acc[4] += w1.x * bflo(uv[2]); acc[5] += w1.y * bfhi(uv[2]); acc[6] += w1.z * bflo(uv[3]); acc[7] += w1.w * bfhi(uv[3]);
                }
            }
            outv = (u32x4){pack2bf(acc[0], acc[1]), pack2bf(acc[2], acc[3]), pack2bf(acc[4], acc[5]), pack2bf(acc[6], acc[7])};
        }
        const int ks = c12 >> 2, c = c12 & 3;
        *(u32x4*)(smem + ks * 8192 + row * 64 + ((c ^ ((row >> 2) & 3)) << 4)) = outv;
    }
    for (int id = tid; id < 160 * 12; id += NTHREADS) {
        const int row = id / 12, c12 = id % 12; const int ks = c12 >> 2, c = c12 & 3;
        *(u32x4*)(smem + 24576 + ks * 10240 + row * 64 + ((c ^ ((row >> 2) & 3)) << 4)) = *(const u32x4*)(gimg + ((size_t)nb * 160 + row) * 96 + c12 * 8);
    }
    __syncthreads();
    f32x4 acc[2][10];
#pragma unroll
    for (int i = 0; i < 2; ++i)
#pragma unroll
        for (int j = 0; j < 10; ++j) acc[i][j] = (f32x4){0.f, 0.f, 0.f, 0.f};
    const int fo = l15 * 64 + ((q ^ ((l15 >> 2) & 3)) << 4);
#pragma unroll
    for (int ks = 0; ks < 3; ++ks) {
        bf16x8 uf[2];
#pragma unroll
        for (int i = 0; i < 2; ++i) uf[i] = *(const bf16x8*)(smem + ks * 8192 + (wave * 32 + i * 16) * 64 + fo);
#pragma unroll
        for (int j = 0; j < 10; ++j) {
            const bf16x8 wf = *(const bf16x8*)(smem + 24576 + ks * 10240 + j * 1024 + fo);
            acc[0][j] = __builtin_amdgcn_mfma_f32_16x16x32_bf16(wf, uf[0], acc[0][j], 0, 0, 0);
            acc[1][j] = __builtin_amdgcn_mfma_f32_16x16x32_bf16(wf, uf[1], acc[1][j], 0, 0, 0);
        }
    }
    __syncthreads();
#pragma unroll
    for (int i = 0; i < 2; ++i) {
        const int row = wave * 32 + i * 16 + l15; const size_t m = m0 + row;
#pragma unroll
        for (int ct = 0; ct < 5; ++ct) {
            const int kcol = ct * 16 + 4 * q; const int ch = nb * 80 + kcol;
            const u32x2 uu = *(const u32x2*)(smem + (kcol >> 5) * 8192 + row * 64 + ((((kcol & 31) >> 3) ^ ((row >> 2) & 3)) << 4) + (kcol & 7) * 2);
            const float uc[4] = {bflo(uu[0]), bfhi(uu[0]), bflo(uu[1]), bfhi(uu[1])};
            const float4 ba = *(const float4*)(gab + ch), bx = *(const float4*)(gxb + ch), lm = *(const float4*)(lam + ch);
            const float bav[4] = {ba.x, ba.y, ba.z, ba.w}, bxv[4] = {bx.x, bx.y, bx.z, bx.w}, lmv[4] = {lm.x, lm.y, lm.z, lm.w};
            float la[4], bv[4];
#pragma unroll
            for (int r = 0; r < 4; ++r) {
                const float rg = __builtin_amdgcn_rcpf(1.0f + __expf(-(acc[i][ct][r] + bav[r]))), ig = __builtin_amdgcn_rcpf(1.0f + __expf(-(acc[i][ct + 5][r] + bxv[r])));
                la[r] = rg * lmv[r];
                const float om = 1.0f - __expf(2.0f * la[r]);
                bv[r] = __builtin_amdgcn_sqrtf(om > 0.f ? om : 0.f) * (ig * uc[r]);
            }
            const u32x2 lav = {pack2bf(la[0], la[1]), pack2bf(la[2], la[3])}, bvv = {pack2bf(bv[0], bv[1]), pack2bf(bv[2], bv[3])};
            *(u32x2*)(LA + m * LW + ch) = lav; *(u32x2*)(BV + m * LW + ch) = bvv;
            *(u32x2*)(smem + 24576 + (row * 80 + kcol) * 2) = lav; *(u32x2*)(smem + 24576 + 20480 + (row * 80 + kcol) * 2) = bvv;
        }
    }
    __syncthreads();
    if (tid < 160) {
        const int cidx = tid / 80, c = tid % 80; const bf16* li = (const bf16*)(smem + 24576) + (cidx * 64) * 80 + c; const bf16* bi = li + 10240;
        float sla = 0.f, h = 0.f;
#pragma unroll 8
        for (int t = 0; t < 64; ++t) { const float la = bf2f(li[t * 80]), bvv = bf2f(bi[t * 80]); h = __expf(la) * h + bvv; sla += la; }
        const size_t mc = m0 + cidx * 64; const int bb = (int)(mc / T), jj = (int)(mc % T) / 64;
        SUM[((size_t)bb * (T / 64) + jj) * LW + nb * 80 + c] = make_float2(__expf(sla), h);
    }
    __syncthreads();
}
DI void lru_scan2_item(const bf16* __restrict__ LA, const bf16* __restrict__ BV, const float2* __restrict__ SUM, const bf16* __restrict__ P3, bf16* __restrict__ AO, int item) {
    const int cg = item % 5, j = (item / 5) % (T / 64), b = item / (5 * (T / 64)); const int c = cg * 256 + TIDX;
    float h = 0.f;
    for (int jj = 0; jj < j; ++jj) { const float2 s = SUM[((size_t)b * (T / 64) + jj) * LW + c]; h = s.x * h + s.y; }
    const size_t m0 = (size_t)b * T + j * 64;
#pragma unroll 8
    for (int t = 0; t < 64; ++t) {
        const float la = bf2f(LA[(m0 + t) * LW + c]); const float bv = bf2f(BV[(m0 + t) * LW + c]); const float z = bf2f(P3[(m0 + t) * 2560 + LW + c]);
        h = __expf(la) * h + bv; AO[(m0 + t) * LW + c] = f2bf(h * siluf_(z));
    }
}

struct ALoadF32 {
    const float* A;
    static constexpr bool DMA = false;
    DI const bf16* src(int, int) const { return nullptr; }
    struct Raw { float4 a, b; };
    DI Raw load(int m, int k) const { Raw r; r.a = *(const float4*)(A + (size_t)m * 64 + k); r.b = *(const float4*)(A + (size_t)m * 64 + k + 4); return r; }
    DI u32x4 finish(const Raw& r, int, int) const { return (u32x4){pack2bf(r.a.x, r.a.y), pack2bf(r.a.z, r.a.w), pack2bf(r.b.x, r.b.y), pack2bf(r.b.z, r.b.w)}; }
};
struct EpiLora {
    const float* w0; const float* a0; bf16* WL; bf16* AV;
    DI void operator()(int m, int n, const float* v, int, int) const {
        float w[8];
        if (n < 1024) {
#pragma unroll
            for (int j = 0; j < 8; ++j) w[j] = -0.60653065971f * __builtin_amdgcn_rcpf(1.0f + __expf(-(w0[n + j] + v[j])));
            store8bf(WL + (size_t)m * D + n, w);
        } else {
#pragma unroll
            for (int j = 0; j < 8; ++j) w[j] = __builtin_amdgcn_rcpf(1.0f + __expf(-(a0[n - 1024 + j] + v[j])));
            store8bf(AV + (size_t)m * D + n - 1024, w);
        }
    }
    DI void finish(int, int, int, int, int) const {}
    DI void finish_wide(int, int, int, int, int) const {}
};
DI float dpp_sum16(float x) {
    x += __builtin_bit_cast(float, __builtin_amdgcn_update_dpp(0, __builtin_bit_cast(int, x), 0xB1, 0xf, 0xf, false));
    x += __builtin_bit_cast(float, __builtin_amdgcn_update_dpp(0, __builtin_bit_cast(int, x), 0x4E, 0xf, 0xf, false));
    x += __builtin_bit_cast(float, __builtin_amdgcn_update_dpp(0, __builtin_bit_cast(int, x), 0x141, 0xf, 0xf, false));
    x += __builtin_bit_cast(float, __builtin_amdgcn_update_dpp(0, __builtin_bit_cast(int, x), 0x140, 0xf, 0xf, false));
    return x;
}
constexpr int RW_NCH = T / 16;
DI void rwkv_prep_item(bf16* __restrict__ P, bf16* __restrict__ WL, bf16* __restrict__ AV, const float* __restrict__ k_k, const float* __restrict__ k_a, const float* __restrict__ r_k,
                       float* __restrict__ G15, bf16* __restrict__ M2g, bf16* __restrict__ M3g, float* __restrict__ BON, int item, char* smem) {
    const int c = item % RW_NCH, h = (item / RW_NCH) & 15, b = item / (RW_NCH * 16);
    const int tid = TIDX, t = tid >> 4, jq = tid & 15, j0 = jq * 4;
    const size_t m0 = (size_t)b * T + c * 16, m = m0 + t; const size_t ch = (size_t)(b * 16 + h) * RW_NCH + c;
    float* sA = (float*)smem; float* sR = sA + 16 * 68; float* sB = sR + 16 * 68; float* sK = sB + 16 * 68; float* sW = sK + 16 * 68; float* sWl = sW + 16 * 68;
    float* mAab = sWl + 16 * 64; float* mAak = mAab + 16 * 17; float* mArb = mAak + 16 * 17; float* mArk = mArb + 16 * 17; float* mTin = mArk + 16 * 17; float* mM2 = mTin + 16 * 17;
    const u32x2 r2 = *(const u32x2*)(P + m * 4096 + h * 64 + j0), k2 = *(const u32x2*)(P + m * 4096 + 1024 + h * 64 + j0), a2 = *(const u32x2*)(AV + m * D + h * 64 + j0), w2 = *(const u32x2*)(WL + m * D + h * 64 + j0);
    const float rr[4] = {bflo(r2[0]), bfhi(r2[0]), bflo(r2[1]), bfhi(r2[1])}, kr[4] = {bflo(k2[0]), bfhi(k2[0]), bflo(k2[1]), bfhi(k2[1])},
                av[4] = {bflo(a2[0]), bfhi(a2[0]), bflo(a2[1]), bfhi(a2[1])}, wl[4] = {bflo(w2[0]), bfhi(w2[0]), bflo(w2[1]), bfhi(w2[1])};
    const float4 kk4 = *(const float4*)(k_k + h * 64 + j0), ka4 = *(const float4*)(k_a + h * 64 + j0), rk4 = *(const float4*)(r_k + h * 64 + j0);
    const float kkc[4] = {kk4.x, kk4.y, kk4.z, kk4.w}, kac[4] = {ka4.x, ka4.y, ka4.z, ka4.w}, rkc[4] = {rk4.x, rk4.y, rk4.z, rk4.w};
    float kkv[4], n2 = 0.f;
#pragma unroll
    for (int e = 0; e < 4; ++e) { kkv[e] = kr[e] * kkc[e]; n2 += kkv[e] * kkv[e]; }
    n2 = dpp_sum16(n2);
    float nr = sqrtf(n2); nr = nr > 1e-12f ? nr : 1e-12f; const float inr = 1.0f / nr;
    float aa[4], bb[4], kp[4], bon = 0.f;
#pragma unroll
    for (int e = 0; e < 4; ++e) { const float kn = kkv[e] * inr; aa[e] = -kn; bb[e] = kn * av[e]; kp[e] = kr[e] * (1.0f + (av[e] - 1.0f) * kac[e]); bon += rr[e] * kp[e] * rkc[e]; }
    bon = dpp_sum16(bon);
    if (jq == 0) BON[m * 16 + h] = bon;
    *(float4*)(sWl + t * 64 + j0) = make_float4(wl[0], wl[1], wl[2], wl[3]);
    __syncthreads();
    float clx[4] = {0.f, 0.f, 0.f, 0.f};
#pragma unroll
    for (int s = 0; s < 15; ++s) { if (s < t) { const float4 w = *(const float4*)(sWl + s * 64 + j0); clx[0] += w.x; clx[1] += w.y; clx[2] += w.z; clx[3] += w.w; } }
    float bt[4];
    {
        float va[4], vr[4], vk[4], gc[4];
#pragma unroll
        for (int e = 0; e < 4; ++e) { const float cl = clx[e] + wl[e]; const float gp = __expf(clx[e]), gi = __expf(-cl); gc[e] = __expf(cl); va[e] = aa[e] * gp; vr[e] = rr[e] * gc[e]; bt[e] = bb[e] * gi; vk[e] = kp[e] * gi; }
        *(float4*)(sA + t * 68 + j0) = make_float4(va[0], va[1], va[2], va[3]); *(float4*)(sR + t * 68 + j0) = make_float4(vr[0], vr[1], vr[2], vr[3]);
        *(float4*)(sB + t * 68 + j0) = make_float4(bt[0], bt[1], bt[2], bt[3]); *(float4*)(sK + t * 68 + j0) = make_float4(vk[0], vk[1], vk[2], vk[3]);
        {
            char* img = (char*)(mM2 + 16 * 17) + t * 128 + (((j0 >> 3) ^ (t & 7)) << 4) + (j0 & 4) * 2;
            *(u32x2*)(img) = (u32x2){pack2bf(va[0], va[1]), pack2bf(va[2], va[3])}; *(u32x2*)(img + 2048) = (u32x2){pack2bf(vr[0], vr[1]), pack2bf(vr[2], vr[3])};
            *(u32x2*)(img + 4096) = (u32x2){pack2bf(bt[0], bt[1]), pack2bf(bt[2], bt[3])}; *(u32x2*)(img + 6144) = (u32x2){pack2bf(vk[0], vk[1]), pack2bf(vk[2], vk[3])};
        }
        if (t == 15) *(float4*)(G15 + ch * 64 + j0) = make_float4(gc[0], gc[1], gc[2], gc[3]);
#pragma unroll
        for (int e = 0; e < 4; ++e) {   }
#pragma unroll
        for (int e = 0; e < 4; ++e) clx[e] = vk[e];
    }
    __syncthreads();
    {
        const int wv = __builtin_amdgcn_readfirstlane(tid >> 6), lane = tid & 63, q = lane >> 4, l15 = lane & 15;
        const char* xb_ = (const char*)(mM2 + 16 * 17) + (wv >> 1) * 2048;
        const char* yb_ = (const char*)(mM2 + 16 * 17) + 4096 + (wv & 1) * 2048;
        f32x4 acc = {0.f, 0.f, 0.f, 0.f};
#pragma unroll
        for (int ks = 0; ks < 2; ++ks) {
            const int off = l15 * 128 + (((ks * 4 + q) ^ (l15 & 7)) << 4);
            const bf16x8 xf = *(const bf16x8*)(xb_ + off), yf = *(const bf16x8*)(yb_ + off);
            acc = __builtin_amdgcn_mfma_f32_16x16x32_bf16(xf, yf, acc, 0, 0, 0);
        }
        float* dst = wv == 0 ? mAab : (wv == 1 ? mAak : (wv == 2 ? mArb : mArk));
        const bool strict = wv < 2;
#pragma unroll
        for (int r = 0; r < 4; ++r) { const int tt = 4 * q + r, ss = l15; dst[tt * 17 + ss] = (strict ? ss < tt : ss <= tt) ? acc[r] : 0.f; }
    }
    __syncthreads();
    if (tid < 16) {
        float col[16];
#pragma unroll
        for (int i = 0; i < 16; ++i) {
            float acc = (i == tid) ? 1.0f : 0.f;
#pragma unroll
            for (int jj = 0; jj < i; ++jj) acc += mAab[i * 17 + jj] * col[jj];
            col[i] = acc; mTin[i * 17 + tid] = acc;
        }
    }
    __syncthreads();
    float wv[4] = {0.f, 0.f, 0.f, 0.f}, m2 = 0.f;
#pragma unroll
    for (int s = 0; s < 16; ++s) { const float ti = mTin[t * 17 + s]; const float4 a4 = *(const float4*)(sA + s * 68 + j0); wv[0] += ti * a4.x; wv[1] += ti * a4.y; wv[2] += ti * a4.z; wv[3] += ti * a4.w; m2 += ti * mAak[s * 17 + jq]; }
    *(float4*)(sW + t * 68 + j0) = make_float4(wv[0], wv[1], wv[2], wv[3]); mM2[t * 17 + jq] = m2;
    __syncthreads();
    float rh[4]; { const float4 r4 = *(const float4*)(sR + t * 68 + j0); rh[0] = r4.x; rh[1] = r4.y; rh[2] = r4.z; rh[3] = r4.w; }
    float m3 = mArk[t * 17 + jq];
#pragma unroll
    for (int s = 0; s < 16; ++s) { const float ar = mArb[t * 17 + s]; const float4 w4 = *(const float4*)(sW + s * 68 + j0); rh[0] += ar * w4.x; rh[1] += ar * w4.y; rh[2] += ar * w4.z; rh[3] += ar * w4.w; m3 += ar * mM2[s * 17 + jq]; }
    *(u32x2*)(WL + m * D + h * 64 + j0) = (u32x2){pack2bf(wv[0], wv[1]), pack2bf(wv[2], wv[3])};
    *(u32x2*)(P + m * 4096 + h * 64 + j0) = (u32x2){pack2bf(rh[0], rh[1]), pack2bf(rh[2], rh[3])};
#pragma unroll
    for (int e = 0; e < 4; ++e) { AV[(m0 + jq) * D + h * 64 + e * 16 + t] = f2bf(bt[e]); P[(m0 + jq) * 4096 + 1024 + h * 64 + e * 16 + t] = f2bf(clx[e]); }
    M2g[ch * 256 + t * 16 + jq] = f2bf(m2); M3g[ch * 256 + t * 16 + jq] = f2bf(m3);
    __syncthreads();
}

#define MFMA32(a, b, c) __builtin_amdgcn_mfma_f32_16x16x32_bf16(__builtin_bit_cast(bf16x8, a), __builtin_bit_cast(bf16x8, b), c, 0, 0, 0)
DI void rwkv_chunk_scan(const bf16* __restrict__ P, const bf16* __restrict__ WL, const bf16* __restrict__ AV, const float* __restrict__ G15, const bf16* __restrict__ M2g, const bf16* __restrict__ M3g,
                        bf16* __restrict__ YS, int bh, char* smem) {
    constexpr int SLOT = 12288, YOFF = 49152;
    const int tid = TIDX, lane = tid & 63, vs = __builtin_amdgcn_readfirstlane(tid >> 6), q = lane >> 4, l15 = lane & 15; const int b = bh >> 4, h = bh & 15;
    const size_t mb = (size_t)b * T; const size_t ch0 = (size_t)(b * 16 + h) * RW_NCH;
    const char *s0, *s1, *s2; size_t d0, d1, d2;
    if (tid < 128) { const int c8 = tid >> 4, t = tid & 15; s0 = (const char*)(WL + (mb + t) * D + h * 64 + c8 * 8); d0 = (size_t)16 * D * 2; }
    else { const int pp = tid - 128, c8 = pp >> 4, t = pp & 15; s0 = (const char*)(P + (mb + t) * 4096 + h * 64 + c8 * 8); d0 = (size_t)16 * 4096 * 2; }
    if (tid < 128) { const int r = tid >> 3, c8 = tid & 7; s1 = (const char*)(P + (mb + r) * 4096 + 1024 + h * 64 + c8 * 8); d1 = (size_t)16 * 4096 * 2; }
    else { const int pp = tid - 128, r = pp >> 3, c8 = pp & 7; s1 = (const char*)(AV + (mb + r) * D + h * 64 + c8 * 8); d1 = (size_t)16 * D * 2; }
    if (tid < 128) { const int r = tid >> 3, c8 = tid & 7; s2 = (const char*)(P + (mb + r) * 4096 + 2048 + h * 64 + c8 * 8); d2 = (size_t)16 * 4096 * 2; }
    else if (tid < 160) { s2 = (const char*)(M2g + ch0 * 256 + (tid - 128) * 8); d2 = 512; }
    else if (tid < 192) { s2 = (const char*)(M3g + ch0 * 256 + (tid - 160) * 8); d2 = 512; }
    else { const int pp = tid < 208 ? tid - 192 : 0; s2 = (const char*)(G15 + ch0 * 64 + pp * 4); d2 = 256; }
    const int dma_off = vs * 1024;
#define RW_DMA(c_) { char* dst = smem + ((c_) & 3) * SLOT + dma_off; GLDS16(s0 + (size_t)(c_) * d0, dst); GLDS16(s1 + (size_t)(c_) * d1, dst + 4096); GLDS16(s2 + (size_t)(c_) * d2, dst + 8192); }
#define RW_BARRIER() { asm volatile("s_waitcnt lgkmcnt(0)" ::: "memory"); __builtin_amdgcn_s_barrier(); asm volatile("" ::: "memory"); }
    f32x4 H0 = {0.f, 0.f, 0.f, 0.f}, H1 = H0, H2 = H0, H3 = H0;
    const int oW = (((q >> 1)) * 16 + l15) * 16 + (q & 1) * 8;
    const int oK = 4096 + ((l15 >> 2) * 8 + (l15 & 3) * 2 + (q >> 1)) * 16 + (q & 1) * 8;
    const int oM = 10240 + l15 * 32 + q * 8;
    const int oV = 8192 + (4 * q) * 128 + (vs * 16 + l15) * 2;
    const int oG = 11264 + (4 * q) * 4;
    const int oY = YOFF + ((4 * q) * 64 + vs * 16 + l15) * 2;
    RW_DMA(0); RW_DMA(1); RW_DMA(2);
    asm volatile("s_waitcnt vmcnt(6)" ::: "memory");
    RW_BARRIER();
    for (int c = 0; c < RW_NCH; ++c) {
        if (c + 3 < RW_NCH) RW_DMA(c + 3);
        const char* sl = smem + (c & 3) * SLOT;
        {
            const f32x4 z4 = {0.f, 0.f, 0.f, 0.f};
            const u32x4 Hb0 = {pack2bf(H0[0], H0[1]), pack2bf(H0[2], H0[3]), pack2bf(H1[0], H1[1]), pack2bf(H1[2], H1[3])};
            const u32x4 Hb1 = {pack2bf(H2[0], H2[1]), pack2bf(H2[2], H2[3]), pack2bf(H3[0], H3[1]), pack2bf(H3[2], H3[3])};
            const unsigned v0 = *(const bf16*)(sl + oV), v1 = *(const bf16*)(sl + oV + 128), v2 = *(const bf16*)(sl + oV + 256), v3 = *(const bf16*)(sl + oV + 384);
            const unsigned v01 = v0 | (v1 << 16), v23 = v2 | (v3 << 16);
            const u32x4 Vlo = {v01, v23, 0u, 0u};
            const u32x2 m2 = *(const u32x2*)(sl + oM), m3 = *(const u32x2*)(sl + oM + 512);
            const u32x2 w0 = *(const u32x2*)(sl + oW), w1 = *(const u32x2*)(sl + oW + 512), w2 = *(const u32x2*)(sl + oW + 1024), w3 = *(const u32x2*)(sl + oW + 1536);
            const u32x2 r0 = *(const u32x2*)(sl + 2048 + oW), r1 = *(const u32x2*)(sl + 2048 + oW + 512), r2 = *(const u32x2*)(sl + 2048 + oW + 1024), r3 = *(const u32x2*)(sl + 2048 + oW + 1536);
            f32x4 U = MFMA32(((u32x4){m2[0], m2[1], 0u, 0u}), Vlo, z4);
            U = MFMA32(((u32x4){w0[0], w0[1], w1[0], w1[1]}), Hb0, U); U = MFMA32(((u32x4){w2[0], w2[1], w3[0], w3[1]}), Hb1, U);
            f32x4 Y = MFMA32(((u32x4){m3[0], m3[1], 0u, 0u}), Vlo, z4);
            Y = MFMA32(((u32x4){r0[0], r0[1], r1[0], r1[1]}), Hb0, Y); Y = MFMA32(((u32x4){r2[0], r2[1], r3[0], r3[1]}), Hb1, Y);
            const u32x4 VU = {v01, v23, pack2bf(U[0], U[1]), pack2bf(U[2], U[3])};
            const u32x2 k0 = *(const u32x2*)(sl + oK), k1 = *(const u32x2*)(sl + oK + 512), k2 = *(const u32x2*)(sl + oK + 1024), k3 = *(const u32x2*)(sl + oK + 1536);
            const u32x2 b0 = *(const u32x2*)(sl + 2048 + oK), b1 = *(const u32x2*)(sl + 2048 + oK + 512), b2 = *(const u32x2*)(sl + 2048 + oK + 1024), b3 = *(const u32x2*)(sl + 2048 + oK + 1536);
            const f32x4 g0 = *(const f32x4*)(sl + oG), g1 = *(const f32x4*)(sl + oG + 64), g2 = *(const f32x4*)(sl + oG + 128), g3 = *(const f32x4*)(sl + oG + 192);
            const f32x4 a0 = MFMA32(((u32x4){k0[0], k0[1], b0[0], b0[1]}), VU, H0), a1 = MFMA32(((u32x4){k1[0], k1[1], b1[0], b1[1]}), VU, H1);
            const f32x4 a2 = MFMA32(((u32x4){k2[0], k2[1], b2[0], b2[1]}), VU, H2), a3 = MFMA32(((u32x4){k3[0], k3[1], b3[0], b3[1]}), VU, H3);
            H0 = a0 * g0; H1 = a1 * g1; H2 = a2 * g2; H3 = a3 * g3;
            char* yb = smem + oY + (c & 7) * 2048;
#pragma unroll
            for (int r = 0; r < 4; ++r) *(bf16*)(yb + r * 128) = f2bf(Y[r]);
        }
        const bool flush = (c & 7) == 7;
        if (flush) {
            RW_BARRIER();
            u32x4 yv[4];
#pragma unroll
            for (int k = 0; k < 4; ++k) yv[k] = *(const u32x4*)(smem + YOFF + (tid + 256 * k) * 16);
#pragma unroll
            for (int k = 0; k < 4; ++k) { const int pc = tid + 256 * k, rr = pc >> 3, c8 = pc & 7; *(u32x4*)(YS + (mb + (size_t)(c - 7) * 16 + rr) * D + h * 64 + c8 * 8) = yv[k]; }
            asm volatile("s_waitcnt vmcnt(0)" ::: "memory");
        } else if (c + 3 < RW_NCH) { asm volatile("s_waitcnt vmcnt(6)" ::: "memory"); }
        else if (c + 2 < RW_NCH) { asm volatile("s_waitcnt vmcnt(3)" ::: "memory"); }
        else { asm volatile("s_waitcnt vmcnt(0)" ::: "memory"); }
        RW_BARRIER();
    }
#undef RW_DMA
#undef RW_BARRIER
}
DI void rwkv_gn_rows2(const bf16* __restrict__ P, const float* __restrict__ BON, const float* __restrict__ lnw, const float* __restrict__ lnb, bf16* __restrict__ YS) {
    const int tid = TIDX, lane = tid & 63, wave = tid >> 6; const int c = wave * 256 + lane * 4;
    const float4 lw = *(const float4*)(lnw + c), lb = *(const float4*)(lnb + c);
    for (size_t m = blockIdx.x; m < (size_t)M; m += gridDim.x) {
        const u32x2 yy = *(const u32x2*)(YS + m * D + c), vv = *(const u32x2*)(P + m * 4096 + 2048 + c), zz = *(const u32x2*)(P + m * 4096 + 3072 + c);
        const float bs = BON[m * 16 + (c >> 6)];
        const float y[4] = {bflo(yy[0]), bfhi(yy[0]), bflo(yy[1]), bfhi(yy[1])}, v[4] = {bflo(vv[0]), bfhi(vv[0]), bflo(vv[1]), bfhi(vv[1])}, z[4] = {bflo(zz[0]), bfhi(zz[0]), bflo(zz[1]), bfhi(zz[1])};
        const float lwv[4] = {lw.x, lw.y, lw.z, lw.w}, lbv[4] = {lb.x, lb.y, lb.z, lb.w};
        const float mean = dpp_sum16((y[0] + y[1]) + (y[2] + y[3])) * (1.0f / 64.0f);
        float var = 0.f;
#pragma unroll
        for (int i = 0; i < 4; ++i) { const float d = y[i] - mean; var += d * d; }
        var = dpp_sum16(var) * (1.0f / 64.0f);
        const float rstd = 1.0f / sqrtf(var + 64e-5f);
        float o[4];
#pragma unroll
        for (int i = 0; i < 4; ++i) o[i] = ((y[i] - mean) * rstd * lwv[i] + lbv[i] + bs * v[i]) * siluf_(z[i]);
        *(u32x2*)(YS + m * D + c) = (u32x2){pack2bf(o[0], o[1]), pack2bf(o[2], o[3])};
    }
}

struct FastBufs { char* ws; };

DI void rows_xb_parts(const float* __restrict__ x, bf16* xb, float* parts) {
    const int lane = TIDX & 63, wave = TIDX >> 6;
    for (int m = blockIdx.x * 4 + wave; m < M; m += gridDim.x * 4) {
        const float* xr = x + (size_t)m * D; float s = 0.f;
#pragma unroll
        for (int i = 0; i < 2; ++i) {
            const int k = (i * 64 + lane) * 8; const float4 a = *(const float4*)(xr + k), b = *(const float4*)(xr + k + 4);
            const float w[8] = {a.x, a.y, a.z, a.w, b.x, b.y, b.z, b.w};
#pragma unroll
            for (int j = 0; j < 8; ++j) s += w[j] * w[j];
            store8bf(xb + (size_t)m * D + k, w);
        }
#pragma unroll
        for (int o = 32; o >= 1; o >>= 1) s += __shfl_xor(s, o);
        if (lane < 16) parts[(size_t)m * 16 + lane] = lane == 0 ? s : 0.f;
    }
}
DI void rows_xn(const float* __restrict__ x, const float* parts, const float* __restrict__ g, bf16* xn) {
    const int lane = TIDX & 63, wave = TIDX >> 6;
    for (int m = blockIdx.x * 4 + wave; m < M; m += gridDim.x * 4) {
        const float rs = rstd_from_parts(parts, m); const float* xr = x + (size_t)m * D;
#pragma unroll
        for (int i = 0; i < 2; ++i) {
            const int k = (i * 64 + lane) * 8; const float4 a = *(const float4*)(xr + k), b = *(const float4*)(xr + k + 4);
            const float4 ga = *(const float4*)(g + k), gb = *(const float4*)(g + k + 4);
            const float w[8] = {a.x * rs * ga.x, a.y * rs * ga.y, a.z * rs * ga.z, a.w * rs * ga.w, b.x * rs * gb.x, b.y * rs * gb.y, b.z * rs * gb.z, b.w * rs * gb.w};
            store8bf(xn + (size_t)m * D + k, w);
        }
    }
}
DI void rows_final(float* x, const float* parts, const float* __restrict__ g) {
    const int lane = TIDX & 63, wave = TIDX >> 6;
    for (int m = blockIdx.x * 4 + wave; m < M; m += gridDim.x * 4) {
        const float rs = rstd_from_parts(parts, m); float* xr = x + (size_t)m * D;
#pragma unroll
        for (int i = 0; i < 4; ++i) {
            const int k = (i * 64 + lane) * 4; float4 a = *(float4*)(xr + k); const float4 ga = *(const float4*)(g + k);
            a.x *= rs * ga.x; a.y *= rs * ga.y; a.z *= rs * ga.z; a.w *= rs * ga.w; *(float4*)(xr + k) = a;
        }
    }
}
enum { PH_PREP0 = 0, PH_IN0, PH_ATTN0, PH_OUT0, PH_PREP1, PH_IN1, PH_LORA1, PH_CPREP1, PH_SCAN1, PH_GN1, PH_OUT1, PH_PREP2, PH_IN2, PH_B2, PH_C2, PH_D2, PH_OUT2, PH_PREP3, PH_IN3, PH_GATE3, PH_SCANA3, PH_SCANB3, PH_OUT3, PH_FINAL };

namespace wbo {
constexpr size_t IN = 0;
constexpr size_t OUT = (size_t)4352 * 1024;
constexpr size_t EXTRA = OUT + (size_t)1280 * 1024;
}

template <int PH>
DI void run_phase(const Params& p, char* smem) {
    char* ws = p.ws;
    float* parts = (float*)(ws + fw::PARTS);
    constexpr int LAYER = PH <= PH_OUT0 ? 0 : PH <= PH_OUT1 ? 1 : PH <= PH_OUT2 ? 2 : 3;
    constexpr size_t WBOFF = LAYER == 0 ? 200 * fw::MB : LAYER == 1 ? 238 * fw::MB : LAYER == 2 ? 240 * fw::MB : 1 * fw::MB;
    bf16* WB = (bf16*)(ws + WBOFF);
    bf16* XB = (bf16*)(ws + ((PH == PH_PREP0 || PH == PH_IN0) ? 130 * fw::MB : 174 * fw::MB));
    bf16* P = (bf16*)(ws + wsl::P);
    float* X = p.out;
    float* smf = (float*)smem;
    if (PH == PH_PREP0) {
        rows_xb_parts(p.x, XB, parts);
        int tb = 0;
        convert_seg(p.a_w_in, A_COLS, 0, A_COLS, 1024, WB + wbo::IN, p.norm_g + 0 * D, smf, tb);
        convert_seg(p.a_w_out, 1024, 0, 1024, 1024, WB + wbo::OUT, nullptr, smf, tb);
    } else if (PH == PH_IN0) {
        gemm_sched(8, 4, [&](bool big, int mt, int nt) {
            if (big) gemm_tile2(ALoadPlain{XB, D}, WB + wbo::IN, 1024, mt * 128, nt * 256, EpiL0{P, (bf16*)(ws + 86 * fw::MB), parts}, smem);
            else gemm_tile(ALoadPlain{XB, D}, WB + wbo::IN, 1024, mt * 128, 2048 + nt * 128, EpiL0{P, (bf16*)(ws + 86 * fw::MB), parts}, smem);
        });
    } else if (PH == PH_ATTN0) {
        build_bias_lut(p.t5, smem, true);
        for (int it = blockIdx.x; it < B * G * (T / (16 * ANQT_SWA)); it += gridDim.x) swa_item(P, (const bf16*)(ws + 86 * fw::MB), p.a_sinks, (bf16*)(ws + wsl::L0_AO), it, smem);
    } else if (PH == PH_OUT0) {
        gemm_sched(4, 0, [&](bool, int mt, int nt) { gemm_tile2(ALoadPlain{(const bf16*)(ws + wsl::L0_AO), D}, WB + wbo::OUT, 1024, mt * 128, nt * 256, EpiResid{p.x, X, nullptr, parts}, smem); });
    } else if (PH == PH_PREP1) {
        rows_xn(X, parts, p.norm_g + 1 * D, (bf16*)(ws + wsl::L1_XN));
        int tb = 0;
        convert_seg(p.b_w_in, 4096, 0, 4096, 1024, WB + wbo::IN, nullptr, smf, tb);
        convert_seg(p.b_w1, 64, 0, 64, 1024, WB + wbo::IN + (size_t)4096 * 1024, nullptr, smf, tb);
        convert_seg(p.b_a1, 64, 0, 64, 1024, WB + wbo::IN + (size_t)(4096 + 128) * 1024, nullptr, smf, tb);
        convert_seg(p.b_w_out, 1024, 0, 1024, 1024, WB + wbo::OUT, nullptr, smf, tb);
        convert_seg(p.b_w2, 1024, 0, 1024, 64, WB + wbo::EXTRA, nullptr, smf, tb);
        convert_seg(p.b_a2, 1024, 0, 1024, 64, WB + wbo::EXTRA + (size_t)1024 * 64, nullptr, smf, tb);
        for (size_t i = (size_t)blockIdx.x * 256 + TIDX; i < (size_t)64 * 1024 / 8; i += (size_t)gridDim.x * 256) {
            ((u32x4*)(WB + wbo::IN + (size_t)(4096 + 64) * 1024))[i] = (u32x4){0u, 0u, 0u, 0u};
            ((u32x4*)(WB + wbo::IN + (size_t)(4096 + 192) * 1024))[i] = (u32x4){0u, 0u, 0u, 0u};
        }
    } else if (PH == PH_IN1) {
        const bf16* XN = (const bf16*)(ws + wsl::L1_XN);
        EpiRwkv epi{P, (float*)(ws + wsl::LHW), (float*)(ws + wsl::LHA)};
        gemm_sched(16, 2, [&](bool big, int mt, int nt) {
            if (big) gemm_tile2(ALoadLerp{XN, p.b_mu + (nt >> 2) * D}, WB + wbo::IN, 1024, mt * 128, nt * 256, epi, smem);
            else gemm_tile(ALoadLerp{XN, p.b_mu + (4 + nt) * D}, WB + wbo::IN, 1024, mt * 128, 4096 + nt * 128, epi, smem);
        });
    } else if (PH == PH_LORA1) {
        const int ntile = (M / 128) * 16;
        EpiLora epi{p.b_w0, p.b_a0, (bf16*)(ws + wsl::L1_WL), (bf16*)(ws + wsl::L1_AV)};
        (void)ntile;
        gemm_sched(8, 0, [&](bool, int mt, int nt) { gemm_tile2(ALoadF32{(const float*)(ws + (nt < 4 ? wsl::LHW : wsl::LHA))}, WB + wbo::EXTRA, 64, mt * 128, nt * 256, epi, smem); });
    } else if (PH == PH_CPREP1) {
        for (int it = blockIdx.x; it < B * 16 * RW_NCH; it += gridDim.x)
            rwkv_prep_item(P, (bf16*)(ws + wsl::L1_WL), (bf16*)(ws + wsl::L1_AV), p.b_k_k, p.b_k_a, p.b_r_k, (float*)(ws + 9 * fw::MB), (bf16*)(ws + 1 * fw::MB), WB, (float*)(ws + 254 * fw::MB), it, smem);
    } else if (PH == PH_SCAN1) {
        const int bid = blockIdx.x;
        if ((bid & 31) < 8 && (bid >> 5) < 8) {
            const int it = (bid >> 5) * 8 + (bid & 31);
            rwkv_chunk_scan(P, (const bf16*)(ws + wsl::L1_WL), (const bf16*)(ws + wsl::L1_AV), (const float*)(ws + 9 * fw::MB), (const bf16*)(ws + 1 * fw::MB), WB, (bf16*)(ws + wsl::L1_XN), it, smem);
        }
    } else if (PH == PH_GN1) {
        rwkv_gn_rows2(P, (const float*)(ws + 254 * fw::MB), p.b_lnx_w, p.b_lnx_b, (bf16*)(ws + wsl::L1_XN));
    } else if (PH == PH_OUT1) {
        gemm_sched(4, 0, [&](bool, int mt, int nt) { gemm_tile2(ALoadPlain{(const bf16*)(ws + wsl::L1_XN), D}, WB + wbo::OUT, 1024, mt * 128, nt * 256, EpiResid{X, X, XB, parts}, smem); });
    } else if (PH == PH_PREP2) {
        int tb = 0;
        const float* g2 = p.norm_g + 2 * D;
        convert_seg(p.c_w_in, C_COLS, 0, 2560, 1024, WB + wbo::IN, g2, smf, tb);
        convert_seg(p.c_w_in, C_COLS, 2608, 1024, 1024, WB + wbo::IN + (size_t)2560 * 1024, g2, smf, tb);
        convert_seg(p.c_w_in, C_COLS, 2560, 64, 1024, WB + wbo::IN + (size_t)3584 * 1024, g2, smf, tb);
        convert_seg(p.c_w_out, 1024, 0, 1024, 1024, WB + wbo::OUT, nullptr, smf, tb);
        convert_seg(p.c_k_w1, 128, 0, 128, 2048, WB + wbo::EXTRA, nullptr, smf, tb);
        convert_seg(p.c_v_w1, 128, 0, 128, 2048, WB + wbo::EXTRA + (size_t)128 * 2048, nullptr, smf, tb);
        convert_seg(p.c_k_w2, 64, 0, 64, 128, WB + wbo::EXTRA + (size_t)256 * 2048, nullptr, smf, tb);
        convert_seg(p.c_v_w2, 64, 0, 64, 128, WB + wbo::EXTRA + (size_t)256 * 2048 + 64 * 128, nullptr, smf, tb);
        if (blockIdx.x < 16) {
            const int which = blockIdx.x >> 3, i = blockIdx.x & 7; const float* pos = which ? p.c_pos_v : p.c_pos_k; const float* w1 = which ? p.c_v_w1 : p.c_k_w1;
            float* b8 = (float*)(ws + 12 * fw::MB);
            if (TIDX < 128) { float a = 0.f; for (int k = i * 256; k < i * 256 + 256; ++k) a += pos[k] * w1[(size_t)k * 128 + TIDX]; b8[(which * 8 + i) * 128 + TIDX] = a; }
        }
    } else if (PH == PH_IN2) {
        gemm_sched(14, 1, [&](bool big, int mt, int nt) {
            if (big) gemm_tile2(ALoadPlain{XB, D}, WB + wbo::IN, 1024, mt * 128, nt * 256, EpiL2{P, (bf16*)(ws + 114 * fw::MB), (bf16*)(ws + 122 * fw::MB), parts}, smem);
            else gemm_tile(ALoadPlain{XB, D}, WB + wbo::IN, 1024, mt * 128, 3584 + nt * 128, EpiL2{P, (bf16*)(ws + 114 * fw::MB), (bf16*)(ws + 122 * fw::MB), parts}, smem);
        });
    } else if (PH == PH_B2) {
        for (int it = blockIdx.x; it < 64; it += gridDim.x) { const int which = it >> 5, rt = it & 31;
            cmp_tile(P, WB + wbo::EXTRA + (size_t)which * 128 * 2048, (const float*)(ws + 12 * fw::MB) + which * 8 * 128, WB + wbo::EXTRA + (size_t)256 * 2048 + which * 64 * 128, which, rt,
                     (bf16*)(ws + 5 * fw::MB), (bf16*)(ws + 6 * fw::MB), smem); }
        build_bias_lut(p.t5, smem, false);
        const int nwin = B * G * (T / (16 * ANQT_WIN));
        const bool split = gridDim.x == 512 && nwin == 2048;
        const int bid = blockIdx.x, nb = bid - 64, cnt = bid < 64 ? 2 : (nb < 128 ? 5 : 4);
        for (int k = 0;; ++k) {
            int item;
            if (split) { if (k >= cnt) break; item = bid < 64 ? k * 512 + 448 + bid : (k < 4 ? k * 512 + nb : (2 + (nb >> 6)) * 512 + 448 + (nb & 63)); }
            else { const int it = (bid < 64 ? bid + (int)gridDim.x : bid) + k * (int)gridDim.x; if (it >= 64 + nwin) break; item = it - 64; }
            win_item(P, (const bf16*)(ws + 122 * fw::MB), (bf16*)(ws + 130 * fw::MB), item, smem);
        }
    } else if (PH == PH_C2) {
        for (int it = blockIdx.x; it < B * G * (T / 32); it += gridDim.x)
            cmpsel_item(P, (const bf16*)(ws + 5 * fw::MB), (const bf16*)(ws + 6 * fw::MB), (bf16*)(ws + 162 * fw::MB), (unsigned long long*)(ws + 9 * fw::MB), it, smem);
    } else if (PH == PH_D2) {
        build_bias_lut(p.t5, smem, false);
        for (int it = blockIdx.x; it < B * G * (T / (16 * ANQT_SEL)); it += gridDim.x)
            sel_item(P, (const bf16*)(ws + 114 * fw::MB), (const unsigned long long*)(ws + 9 * fw::MB), (const bf16*)(ws + 162 * fw::MB), (const bf16*)(ws + 130 * fw::MB), (bf16*)(ws + 206 * fw::MB), it, smem);
    } else if (PH == PH_OUT2) {
        gemm_sched(4, 0, [&](bool, int mt, int nt) { gemm_tile2(ALoadPlain{(const bf16*)(ws + 206 * fw::MB), D}, WB + wbo::OUT, 1024, mt * 128, nt * 256, EpiResid{X, X, XB, parts}, smem); });
    } else if (PH == PH_PREP3) {
        int tb = 0;
        convert_seg(p.d_w_in, 2560, 0, 2560, 1024, WB + wbo::IN, p.norm_g + 3 * D, smf, tb);
        convert_seg(p.d_w_out, 1024, 0, 1024, 1280, WB + wbo::OUT, nullptr, smf, tb);
        lru_convert_gates(p.d_ga_w, p.d_gx_w, WB + wbo::EXTRA);
        for (int i = blockIdx.x * NTHREADS + TIDX; i < LW; i += gridDim.x * NTHREADS) ((float*)(ws + 12 * fw::MB + 786432))[i] = -8.0f * softplusf_(-p.d_lambda[i]);
    } else if (PH == PH_IN3) {
        gemm_sched(8, 4, [&](bool big, int mt, int nt) {
            if (big) gemm_tile2(ALoadPlain{XB, D}, WB + wbo::IN, 1024, mt * 128, nt * 256, EpiBf16{P, 2560, parts}, smem);
            else gemm_tile(ALoadPlain{XB, D}, WB + wbo::IN, 1024, mt * 128, 2048 + nt * 128, EpiBf16{P, 2560, parts}, smem);
        });
    } else if (PH == PH_GATE3) {
        for (int it = blockIdx.x; it < (M / 128) * 16; it += gridDim.x)
            lru_gate_item(P, p.d_conv_w, p.d_conv_b, WB + wbo::EXTRA, p.d_ga_b, p.d_gx_b, (const float*)(ws + 12 * fw::MB + 786432), (bf16*)(ws + wsl::L3_LA), (bf16*)(ws + wsl::L3_BV), (float2*)(ws + wsl::L3_UC), it, smem);
    } else if (PH == PH_SCANB3) {
        for (int it = blockIdx.x; it < B * (T / 64) * 5; it += gridDim.x)
            lru_scan2_item((const bf16*)(ws + wsl::L3_LA), (const bf16*)(ws + wsl::L3_BV), (const float2*)(ws + wsl::L3_UC), P, (bf16*)(ws + wsl::L3_AO), it);
    } else if (PH == PH_OUT3) {
        gemm_sched(4, 0, [&](bool, int mt, int nt) { gemm_tile2(ALoadPlain{(const bf16*)(ws + wsl::L3_AO), LW}, WB + wbo::OUT, 1280, mt * 128, nt * 256, EpiResid{X, X, nullptr, parts}, smem); });
    } else if (PH == PH_FINAL) {
        rows_final(X, parts, p.final_g);
    }
}

template <int PH> __global__ void __launch_bounds__(NTHREADS, 2) k_phase(Params p) {
    extern __shared__ __attribute__((aligned(16))) char smem[];
    run_phase<PH>(p, smem);
}
#define LDS_BYTES 73728
#define MEGA_LDS_BYTES (73728 + 64)
template <int PH> static void launch_phase(const Params& p, hipStream_t s) {
    static bool attr = false;
    if (!attr) { hipFuncSetAttribute((const void*)k_phase<PH>, hipFuncAttributeMaxDynamicSharedMemorySize, LDS_BYTES); attr = true; }
    hipLaunchKernelGGL(k_phase<PH>, dim3(512), dim3(NTHREADS), LDS_BYTES, s, p);
}


#define XB_TMO      128
#define XB_XCNT(j)  (256  + 64 * (j))
#define XB_XSUB(j)  (1280 + 64 * (j))
#define XB_XGEN(j)  (2304 + 64 * (j))
#define XB_TOP      3328
#define XB_TOPGEN   3392
#define XCD_BAR_WORDS 3456
#define XB_SPIN_CAP (1u << 22)
#define LAS __attribute__((address_space(3)))
DI unsigned xb_ld(unsigned* p)              { return __hip_atomic_load(p, __ATOMIC_RELAXED, __HIP_MEMORY_SCOPE_AGENT); }
DI unsigned xb_add(unsigned* p, unsigned v) { return __hip_atomic_fetch_add(p, v, __ATOMIC_RELAXED, __HIP_MEMORY_SCOPE_AGENT); }
DI unsigned xb_xcc_id() { return (unsigned)__builtin_amdgcn_s_getreg((3 << 11) | 20) & 0xFu; }
#define XB_SPIN(cond, bar) do { unsigned _sp = 0; while (cond) { if (_sp < 64u) __builtin_amdgcn_s_sleep(2); else __builtin_amdgcn_s_sleep(32); \
    if ((++_sp & 255u) == 0u) { if (xb_ld(&(bar)[XB_TMO])) break; if (_sp > XB_SPIN_CAP) { atomicAdd(&(bar)[XB_TMO], 1u); break; } } } } while (0)
struct XcdBarrier { unsigned* bar; unsigned x; volatile LAS unsigned* st; };
DI XcdBarrier xcd_barrier_post(unsigned* bar, volatile LAS unsigned* st) {
    XcdBarrier b; b.bar = bar; b.x = xb_xcc_id(); b.st = st;
    if (threadIdx.x == 0) (void)xb_add(&bar[XB_XCNT(b.x)], 1u);
    return b;
}
DI void xcd_barrier_complete(unsigned* bar, unsigned x, unsigned& nloc, unsigned& nx) {
    const unsigned G = gridDim.x * gridDim.y * gridDim.z;
    unsigned sum, cnt, mine, sp = 0u;
    for (;;) {
        sum = 0u; cnt = 0u; mine = 0u;
#pragma unroll
        for (unsigned j = 0; j < 16; ++j) { const unsigned c = xb_ld(&bar[XB_XCNT(j)]); sum += c; cnt += (c > 0u) ? 1u : 0u; mine = (j == x) ? c : mine; }
        if (sum == G) break;
        __builtin_amdgcn_s_sleep(1);
        if ((++sp & 255u) == 0u) { if (xb_ld(&bar[XB_TMO])) break; if (sp > XB_SPIN_CAP) { atomicAdd(&bar[XB_TMO], 1u); break; } }
    }
    nloc = mine > 0u ? mine : 1u; nx = cnt > 0u ? cnt : 1u;
}
DI void xcd_barrier(const XcdBarrier& b) {
    asm volatile("s_waitcnt vmcnt(0)" ::: "memory");
    __syncthreads();
    if (threadIdx.x == 0) {
        unsigned* bar = b.bar;
        __builtin_amdgcn_s_waitcnt(0);
        unsigned nloc = b.st[0], nx = b.st[1];
        if (nloc == 0u) { xcd_barrier_complete(bar, b.x, nloc, nx); b.st[0] = nloc; b.st[1] = nx; }
        const unsigned old = xb_add(&bar[XB_XSUB(b.x)], 1u);
        const unsigned gen = old / nloc;
        asm volatile("buffer_inv sc1" ::: "memory");
        if (old + 1u == (gen + 1u) * nloc) {
            __builtin_amdgcn_fence(__ATOMIC_RELEASE, "agent");
            asm volatile("s_waitcnt vmcnt(0)" ::: "memory");
            const unsigned og = xb_add(&bar[XB_TOP], 1u);
            const unsigned tg = og / nx;
            if (og + 1u == (tg + 1u) * nx) xb_add(&bar[XB_TOPGEN], 1u);
            else XB_SPIN(xb_ld(&bar[XB_TOPGEN]) == tg, bar);
            xb_add(&bar[XB_XGEN(b.x)], 1u);
            asm volatile("s_waitcnt vmcnt(0)" ::: "memory");
        } else {
            XB_SPIN(xb_ld(&bar[XB_XGEN(b.x)]) == gen, bar);
            asm volatile("s_waitcnt vmcnt(0)" ::: "memory");
        }
    }
    __syncthreads();
}

#define MEGA_PHASES(X) X(PH_IN0) X(PH_ATTN0) X(PH_OUT0) X(PH_PREP1) X(PH_IN1) X(PH_LORA1) X(PH_CPREP1) X(PH_SCAN1) X(PH_GN1) X(PH_OUT1) \
    X(PH_PREP2) X(PH_IN2) X(PH_B2) X(PH_C2) X(PH_D2) X(PH_OUT2) X(PH_PREP3) X(PH_IN3) X(PH_GATE3) X(PH_SCANB3) X(PH_OUT3)
__global__ void __launch_bounds__(NTHREADS, 2) mega_kernel(Params p) {
    extern __shared__ __attribute__((aligned(16))) char smem[];
    cooperative_groups::grid_group grid = cooperative_groups::this_grid();
    volatile LAS unsigned* xst = (volatile LAS unsigned*)(smem + 73728);
    if (threadIdx.x < 4) xst[threadIdx.x] = 0u;
    __syncthreads();
    XcdBarrier xb = xcd_barrier_post((unsigned*)p.ws, xst);
    run_phase<PH_PREP0>(p, smem);
    if (p.ws == nullptr) grid.sync();
    xcd_barrier(xb);
#define MEGA_STEP(ph) run_phase<ph>(p, smem); xcd_barrier(xb);
    MEGA_PHASES(MEGA_STEP)
#undef MEGA_STEP
    run_phase<PH_FINAL>(p, smem);
}
static void launch_mega(const Params& p, hipStream_t s) {
    static int grid_blocks = 0;
    if (!grid_blocks) {
        int dev = 0, cus = 0, per_cu = 0;
        hipGetDevice(&dev);
        hipDeviceGetAttribute(&cus, hipDeviceAttributeMultiprocessorCount, dev);
        hipFuncSetAttribute((const void*)mega_kernel, hipFuncAttributeMaxDynamicSharedMemorySize, MEGA_LDS_BYTES);
        hipOccupancyMaxActiveBlocksPerMultiprocessor(&per_cu, mega_kernel, NTHREADS, MEGA_LDS_BYTES);
        if (per_cu > 2) per_cu = 2;
        if (per_cu < 1) per_cu = 1;
        grid_blocks = cus * per_cu;
    }
    hipMemsetAsync(p.ws, 0, 16384, s);
    Params pp = p; void* args[] = {&pp};
    hipError_t e = hipLaunchCooperativeKernel((const void*)mega_kernel, dim3(grid_blocks), dim3(NTHREADS), args, MEGA_LDS_BYTES, s);
    if (e != hipSuccess) fprintf(stderr, "cooperative launch failed: %s (grid %d)\n", hipGetErrorString(e), grid_blocks);
}
#endif

#ifndef CPU_SHIM
template <class F> __global__ void __launch_bounds__(256) k_run(F f, long n) {
    const long i = (long)blockIdx.x * 256 + threadIdx.x; if (i < n) f(i);
}
template <class F> static void launch(const F& f, long n, hipStream_t s) {
    hipLaunchKernelGGL(k_run<F>, dim3((unsigned)((n + 255) / 256)), dim3(256), 0, s, f, n);
}
#else
template <class F> static void launch(const F& f, long n, hipStream_t) {
#pragma omp parallel for schedule(dynamic, 64)
    for (long i = 0; i < n; ++i) f(i);
}
#endif

#ifdef CPU_SHIM
void cpu_layer_hook(int layer, const float* X, const char* ws);
#define LAYER_HOOK(l) cpu_layer_hook(l, X, ws)
#else
#define LAYER_HOOK(l)
#endif

#define FAST_GEMM 0
#if FAST_GEMM
#define FASTP(ph) launch_phase<ph>(p, s)
#else
#define FASTP(ph)
#endif

static void run_naive(const Params& p, hipStream_t s) {
    char* ws = p.ws;
    float* rs = (float*)(ws + wsl::RS);
    bf16* P = (bf16*)(ws + wsl::P);
    float* X = p.out;
    (void)rs;
    {
        bf16* AO = (bf16*)(ws + wsl::L0_AO);
#if FAST_GEMM
        FASTP(PH_PREP0); FASTP(PH_IN0);
#else
        launch(RstdF{p.x, rs}, M, s);
        launch(GemmInF{p.x, rs, p.norm_g + 0 * D, p.a_w_in, P, A_COLS}, (long)M * (A_COLS / 4), s);
#endif
#if FAST_GEMM
        FASTP(PH_ATTN0); (void)AO;
#else
        launch(SwaF{P, p.t5, p.a_sinks, AO}, (long)M * H, s);
#endif
#if FAST_GEMM
        FASTP(PH_OUT0);
#else
        launch(GemmOutF{AO, p.a_w_out, p.x, X, 1024}, (long)M * (D / 4), s);
#endif
    }
    LAYER_HOOK(0);
    {
        bf16* XN = (bf16*)(ws + wsl::L1_XN); bf16* WL = (bf16*)(ws + wsl::L1_WL); bf16* AV = (bf16*)(ws + wsl::L1_AV);
        float* hw = (float*)(ws + wsl::LHW); float* ha = (float*)(ws + wsl::LHA);
#if FAST_GEMM
        FASTP(PH_PREP1); FASTP(PH_IN1); FASTP(PH_LORA1); FASTP(PH_CPREP1); FASTP(PH_SCAN1); FASTP(PH_GN1); FASTP(PH_OUT1);
        (void)XN; (void)WL; (void)AV; (void)hw; (void)ha;
#else
        launch(RstdF{X, rs}, M, s);
        launch(XnF{X, rs, p.norm_g + 1 * D, XN}, (long)M * D, s);
        launch(GemmRwkvF{XN, p.b_mu, p.b_w_in, P}, (long)M * 1024, s);
        launch(LoraHidF{XN, p.b_mu, p.b_w1, p.b_a1, hw, ha}, (long)M * 128, s);
        launch(LoraOutF{hw, ha, p.b_w0, p.b_w2, p.b_a0, p.b_a2, WL, AV}, (long)M * D, s);
        launch(RwkvScanF{P, WL, AV, p.b_k_k, p.b_k_a, XN}, (long)B * H * 64, s);
        launch(RwkvGnF{P, AV, p.b_k_a, p.b_r_k, p.b_lnx_w, p.b_lnx_b, XN}, (long)M * H, s);
        launch(GemmOutF{XN, p.b_w_out, X, X, 1024}, (long)M * (D / 4), s);
#endif
    }
    LAYER_HOOK(1);
    {
        float* hk = (float*)(ws + wsl::HK); float* hv = (float*)(ws + wsl::HV);
        float* kc = (float*)(ws + wsl::KC); float* vc = (float*)(ws + wsl::VC);
        float* st = (float*)(ws + wsl::ST); int* sel = (int*)(ws + wsl::SEL); float* imp = (float*)(ws + wsl::L2_IMP);
        bf16* AO = (bf16*)(ws + wsl::L2_AO); bf16* OC = (bf16*)(ws + wsl::L2_OC); bf16* OS = (bf16*)(ws + wsl::L2_OS);
#if FAST_GEMM
        FASTP(PH_PREP2); FASTP(PH_IN2); FASTP(PH_B2); FASTP(PH_C2); FASTP(PH_D2); FASTP(PH_OUT2);
        (void)hk; (void)hv; (void)kc; (void)vc; (void)st; (void)sel; (void)imp; (void)AO; (void)OC; (void)OS;
#else
        launch(RstdF{X, rs}, M, s);
        launch(GemmInF{X, rs, p.norm_g + 2 * D, p.c_w_in, P, C_COLS}, (long)M * (C_COLS / 4), s);
        launch(CmpHidF{P, p.c_pos_k, p.c_k_w1, p.c_pos_v, p.c_v_w1, hk, hv}, 2L * B * G * NCMP * 128, s);
        launch(CmpOutF{hk, hv, p.c_k_w2, p.c_v_w2, kc, vc}, 2L * B * G * NCMP * 64, s);
        launch(CmpAttnF{P, kc, vc, st, OC}, (long)M * H, s);
        launch(ImpF{P, kc, st, imp}, (long)M * G * NSEL, s);
        launch(TopkF{imp, sel}, (long)M * G, s);
        launch(SelAttnF{P, p.t5, sel, OS}, (long)M * H, s);
        launch(WinAttnF{P, p.t5, OC, OS, AO}, (long)M * H, s);
        LAYER_HOOK(20);
        launch(GemmOutF{AO, p.c_w_out, X, X, 1024}, (long)M * (D / 4), s);
#endif
    }
    LAYER_HOOK(2);
    {
        bf16* AO = (bf16*)(ws + wsl::L3_AO); bf16* UC = (bf16*)(ws + wsl::L3_UC); bf16* LA = (bf16*)(ws + wsl::L3_LA); bf16* BV = (bf16*)(ws + wsl::L3_BV);
#if FAST_GEMM
        FASTP(PH_PREP3); FASTP(PH_IN3); FASTP(PH_GATE3); FASTP(PH_SCANA3); FASTP(PH_SCANB3); FASTP(PH_OUT3);
        (void)AO; (void)UC; (void)LA; (void)BV;
#else
        launch(RstdF{X, rs}, M, s);
        launch(GemmInF{X, rs, p.norm_g + 3 * D, p.d_w_in, P, 2560}, (long)M * (2560 / 4), s);
        launch(ConvF{P, p.d_conv_w, p.d_conv_b, UC}, (long)M * LW, s);
        launch(LruGateF{UC, p.d_ga_w, p.d_ga_b, p.d_gx_w, p.d_gx_b, p.d_lambda, LA, BV}, (long)M * LW, s);
        launch(LruScanF{P, LA, BV, AO}, (long)B * LW, s);
        launch(GemmOutF{AO, p.d_w_out, X, X, LW}, (long)M * (D / 4), s);
#endif
    }
    LAYER_HOOK(3);
#if FAST_GEMM
    FASTP(PH_FINAL);
#else
    launch(FinalNormF{X, p.final_g}, M, s);
#endif
}

extern "C" void kernel_launch(void* const* d_in, const int* in_sizes, int n_in, void* d_out, int out_size, void* d_ws, size_t ws_size,
                              hipStream_t stream) {
    (void)in_sizes; (void)n_in; (void)out_size; (void)ws_size;
    Params p{};
    const float* const* in = (const float* const*)d_in;
    int k = 0;
    p.x = in[k++]; p.t5 = in[k++]; p.norm_g = in[k++]; p.final_g = in[k++];
    p.a_w_in = in[k++]; p.a_sinks = in[k++]; p.a_w_out = in[k++];
    p.b_mu = in[k++]; p.b_w_in = in[k++]; p.b_w0 = in[k++]; p.b_w1 = in[k++]; p.b_w2 = in[k++]; p.b_a0 = in[k++]; p.b_a1 = in[k++]; p.b_a2 = in[k++];
    p.b_k_k = in[k++]; p.b_k_a = in[k++]; p.b_r_k = in[k++]; p.b_lnx_w = in[k++]; p.b_lnx_b = in[k++]; p.b_w_out = in[k++];
    p.c_w_in = in[k++]; p.c_pos_k = in[k++]; p.c_k_w1 = in[k++]; p.c_k_w2 = in[k++]; p.c_pos_v = in[k++]; p.c_v_w1 = in[k++]; p.c_v_w2 = in[k++]; p.c_w_out = in[k++];
    p.d_w_in = in[k++]; p.d_conv_w = in[k++]; p.d_conv_b = in[k++]; p.d_ga_w = in[k++]; p.d_ga_b = in[k++]; p.d_gx_w = in[k++]; p.d_gx_b = in[k++];
    p.d_lambda = in[k++]; p.d_w_out = in[k++];
    p.out = (float*)d_out; p.ws = (char*)d_ws;
#if !defined(CPU_SHIM) && !defined(MULTI_LAUNCH) && !defined(ALL_NAIVE)
    launch_mega(p, stream);
#else
    run_naive(p, stream);
#endif
}
```

```cpp
#ifndef CPU_SHIM
#include <hip/hip_runtime.h>
#include <hip/hip_cooperative_groups.h>
#include <cstdio>
#define HD __host__ __device__ __forceinline__
#else
#include <cmath>
#include <cstring>
#include <cstdio>
#include <cstdlib>
#include <cstdint>
#define HD inline
typedef void* hipStream_t;
#endif
#include <cstddef>

#ifndef CFG_B
#define CFG_B 4
#endif
#ifndef CFG_T
#define CFG_T 4096
#endif

namespace cfg {
constexpr int B = CFG_B, T = CFG_T, M = B * T, D = 1024;
constexpr int H = 16, G = 4, R = 4, DH = 64;
constexpr int A_COLS = 2560;
constexpr int C_COLS = 3632;
constexpr int NCMP = (T - 32) / 16 + 1;
constexpr int NSEL = T / 64;
constexpr int KTOP = NSEL < 16 ? NSEL : 16;
constexpr int LW = 1280;
}
using namespace cfg;

typedef unsigned short bf16;

HD unsigned f_as_u(float f) {
#ifndef CPU_SHIM
    return __float_as_uint(f);
#else
    unsigned u; memcpy(&u, &f, 4); return u;
#endif
}
HD float u_as_f(unsigned u) {
#ifndef CPU_SHIM
    return __uint_as_float(u);
#else
    float f; memcpy(&f, &u, 4); return f;
#endif
}
HD float bf2f(bf16 v) { return u_as_f(((unsigned)v) << 16); }
HD bf16 f2bf(float f) { unsigned u = f_as_u(f); u += 0x7fffu + ((u >> 16) & 1u); return (bf16)(u >> 16); }
HD float sigmoidf_(float x) { return 1.0f / (1.0f + expf(-x)); }
HD float siluf_(float x) { return x / (1.0f + expf(-x)); }
HD float softplusf_(float x) { return x > 20.f ? x : log1pf(expf(x)); }

HD int t5_bucket(int d) {
    if (d < 16) return d < 0 ? 0 : d;
    if (d >= 113) return 31;
    if (d >= 99) return 30;
    if (d >= 87) return 29;
    if (d >= 77) return 28;
    if (d >= 67) return 27;
    if (d >= 59) return 26;
    if (d >= 52) return 25;
    if (d >= 46) return 24;
    if (d >= 40) return 23;
    if (d >= 35) return 22;
    if (d >= 31) return 21;
    if (d >= 27) return 20;
    if (d >= 24) return 19;
    if (d >= 21) return 18;
    if (d >= 19) return 17;
    return 16;
}

struct Params {
    const float *x, *t5, *norm_g, *final_g;
    const float *a_w_in, *a_sinks, *a_w_out;
    const float *b_mu, *b_w_in, *b_w0, *b_w1, *b_w2, *b_a0, *b_a1, *b_a2, *b_k_k, *b_k_a, *b_r_k, *b_lnx_w, *b_lnx_b, *b_w_out;
    const float *c_w_in, *c_pos_k, *c_k_w1, *c_k_w2, *c_pos_v, *c_v_w1, *c_v_w2, *c_w_out;
    const float *d_w_in, *d_conv_w, *d_conv_b, *d_ga_w, *d_ga_b, *d_gx_w, *d_gx_b, *d_lambda, *d_w_out;
    float* out;
    char* ws;
};

namespace wsl {
constexpr size_t MB = 1024 * 1024;
constexpr size_t RS = 0;
constexpr size_t HK = 1 * MB;
constexpr size_t HV = 3 * MB;
constexpr size_t KC = 5 * MB;
constexpr size_t VC = 6 * MB;
constexpr size_t ST = 7 * MB;
constexpr size_t SEL = 9 * MB;
constexpr size_t LHW = 1 * MB;
constexpr size_t LHA = 5 * MB;
constexpr size_t P = 14 * MB;
constexpr size_t SZ1024 = (size_t)M * 1024 * 2, SZ1280 = (size_t)M * 1280 * 2;
constexpr size_t L0_AO = P + (size_t)M * 2560 * 2;
constexpr size_t L1_XN = P + (size_t)M * 4096 * 2, L1_WL = L1_XN + SZ1024, L1_AV = L1_WL + SZ1024;
constexpr size_t L2_AO = P + (size_t)M * 3632 * 2, L2_OC = L2_AO + SZ1024, L2_OS = L2_OC + SZ1024, L2_IMP = L2_OS + SZ1024;
constexpr size_t L3_AO = P + (size_t)M * 2560 * 2, L3_UC = L3_AO + SZ1280, L3_LA = L3_UC + SZ1280, L3_BV = L3_LA + SZ1280;
constexpr size_t TOTAL = L3_BV + SZ1280;
}

struct RstdF {
    const float* x; float* rs;
    HD void operator()(long m) const {
        const float* r = x + (size_t)m * D; float s = 0.f;
        for (int k = 0; k < D; ++k) s += r[k] * r[k];
        rs[m] = 1.0f / sqrtf(s / D + 1e-6f);
    }
};
struct XnF {
    const float* x; const float* rs; const float* g; bf16* xn;
    HD void operator()(long i) const { long m = i / D; int k = (int)(i % D); xn[i] = f2bf(x[i] * rs[m] * g[k]); }
};
struct GemmInF {
    const float *x, *rs, *g, *W; bf16* P; long long N;
    HD void operator()(long i) const {
        const int n4 = (int)N / 4; const long m = i / n4; const int n = (int)(i % n4) * 4;
        const float* xr = x + (size_t)m * D; const float r = rs[m];
        float a0 = 0, a1 = 0, a2 = 0, a3 = 0;
        for (int k = 0; k < D; ++k) {
            const float a = xr[k] * r * g[k]; const float* w = W + (size_t)k * N + n;
            a0 += a * w[0]; a1 += a * w[1]; a2 += a * w[2]; a3 += a * w[3];
        }
        bf16* p = P + (size_t)m * N + n; p[0] = f2bf(a0); p[1] = f2bf(a1); p[2] = f2bf(a2); p[3] = f2bf(a3);
    }
};
struct GemmOutF {
    const bf16* A; const float* W; const float* xin; float* xout; long long K;
    HD void operator()(long i) const {
        const int n4 = D / 4; const long m = i / n4; const int n = (int)(i % n4) * 4;
        const bf16* ar = A + (size_t)m * K;
        float a0 = 0, a1 = 0, a2 = 0, a3 = 0;
        for (int k = 0; k < K; ++k) {
            const float a = bf2f(ar[k]); const float* w = W + (size_t)k * D + n;
            a0 += a * w[0]; a1 += a * w[1]; a2 += a * w[2]; a3 += a * w[3];
        }
        const float* xi = xin + (size_t)m * D + n; float* xo = xout + (size_t)m * D + n;
        xo[0] = xi[0] + a0; xo[1] = xi[1] + a1; xo[2] = xi[2] + a2; xo[3] = xi[3] + a3;
    }
};

struct SwaF {
    const bf16* P; const float* t5; const float* sinks; bf16* AO;
    HD void operator()(long i) const {
        const long m = i / H; const int h = (int)(i % H), g = h / R; const int t = (int)(m % T); const long mb = m - t;
        float q[DH], o[DH];
#pragma unroll
        for (int d = 0; d < DH; ++d) { q[d] = bf2f(P[(size_t)m * A_COLS + h * DH + d]); o[d] = 0.f; }
        float mx = sinks[h], l = 1.0f;
        const int s0 = t - 127 < 0 ? 0 : t - 127;
        for (int s = s0; s <= t; ++s) {
            const bf16* kr = P + (size_t)(mb + s) * A_COLS + 1024 + g * DH;
            const bf16* vr = kr + 256;
            float sc = 0.f;
#pragma unroll
            for (int d = 0; d < DH; ++d) sc += q[d] * bf2f(kr[d]);
            sc = sc * 0.125f + t5[t5_bucket(t - s) * H + h];
            const float mn = sc > mx ? sc : mx; const float al = expf(mx - mn), p = expf(sc - mn);
            l = l * al + p; mx = mn;
#pragma unroll
            for (int d = 0; d < DH; ++d) o[d] = o[d] * al + p * bf2f(vr[d]);
        }
        const float il = 1.0f / l;
#pragma unroll
        for (int d = 0; d < DH; ++d) {
            const float z = bf2f(P[(size_t)m * A_COLS + 1536 + h * DH + d]);
            AO[(size_t)m * D + h * DH + d] = f2bf(o[d] * il * siluf_(z));
        }
    }
};

struct GemmRwkvF {
    const bf16* xn; const float* mu; const float* W; bf16* P;
    HD void operator()(long i) const {
        const int N = 4096, n4 = N / 4; const long m = i / n4; const int n = (int)(i % n4) * 4; const int s = n / 1024;
        const int t = (int)(m % T);
        const bf16* xr = xn + (size_t)m * D; const float* mus = mu + s * D;
        float a0 = 0, a1 = 0, a2 = 0, a3 = 0;
        for (int k = 0; k < D; ++k) {
            const float xc = bf2f(xr[k]); const float xp = t > 0 ? bf2f(xr[k - D]) : 0.f;
            const float a = xc + (xp - xc) * mus[k]; const float* w = W + (size_t)k * N + n;
            a0 += a * w[0]; a1 += a * w[1]; a2 += a * w[2]; a3 += a * w[3];
        }
        bf16* p = P + (size_t)m * N + n; p[0] = f2bf(a0); p[1] = f2bf(a1); p[2] = f2bf(a2); p[3] = f2bf(a3);
    }
};
struct LoraHidF {
    const bf16* xn; const float* mu; const float* w1; const float* a1; float* hw; float* ha;
    HD void operator()(long i) const {
        const long m = i / 128; const int jj = (int)(i % 128); const int which = jj / 64, j = jj % 64; const int t = (int)(m % T);
        const bf16* xr = xn + (size_t)m * D; const float* mus = mu + (4 + which) * D; const float* W = which ? a1 : w1;
        float acc = 0.f;
        for (int k = 0; k < D; ++k) {
            const float xc = bf2f(xr[k]); const float xp = t > 0 ? bf2f(xr[k - D]) : 0.f;
            acc += (xc + (xp - xc) * mus[k]) * W[(size_t)k * 64 + j];
        }
        if (which) ha[(size_t)m * 64 + j] = acc; else hw[(size_t)m * 64 + j] = tanhf(acc);
    }
};
struct LoraOutF {
    const float *hw, *ha, *w0, *w2, *a0, *a2; bf16* wlog; bf16* av;
    HD void operator()(long i) const {
        const long m = i / D; const int c = (int)(i % D);
        float sw = 0.f, sa = 0.f;
        for (int j = 0; j < 64; ++j) { sw += hw[(size_t)m * 64 + j] * w2[(size_t)j * D + c]; sa += ha[(size_t)m * 64 + j] * a2[(size_t)j * D + c]; }
        const float wr = -softplusf_(-(w0[c] + sw)) - 0.5f;
        wlog[i] = f2bf(-expf(wr)); av[i] = f2bf(sigmoidf_(a0[c] + sa));
    }
};
struct RwkvScanF {
    const bf16* P; const bf16* wlog; const bf16* av; const float* k_k; const float* k_a; bf16* ys;
    HD void operator()(long idx) const {
        const int i = (int)(idx % 64); const int h = (int)((idx / 64) % H); const int b = (int)(idx / (64 * H));
        float S[64];
#pragma unroll
        for (int j = 0; j < 64; ++j) S[j] = 0.f;
        for (int t = 0; t < T; ++t) {
            const size_t m = (size_t)b * T + t; const bf16* pr = P + m * 4096 + h * 64;
            const bf16* wl = wlog + m * D + h * 64; const bf16* ar = av + m * D + h * 64;
            float n2 = 0.f;
#pragma unroll
            for (int j = 0; j < 64; ++j) { const float kk = bf2f(pr[1024 + j]) * k_k[h * 64 + j]; n2 += kk * kk; }
            float nr = sqrtf(n2); nr = nr > 1e-12f ? nr : 1e-12f; const float inr = 1.0f / nr;
            float sa = 0.f;
#pragma unroll
            for (int j = 0; j < 64; ++j) { const float kk = bf2f(pr[1024 + j]) * k_k[h * 64 + j] * inr; sa += S[j] * (-kk); }
            const float vi = bf2f(pr[2048 + i]); float y = 0.f;
#pragma unroll
            for (int j = 0; j < 64; ++j) {
                const float kr = bf2f(pr[1024 + j]); const float a = bf2f(ar[j]);
                const float kk = kr * k_k[h * 64 + j] * inr; const float kp = kr * (1.0f + (a - 1.0f) * k_a[h * 64 + j]);
                const float dec = expf(bf2f(wl[j]));
                S[j] = S[j] * dec + sa * (kk * a) + vi * kp;
                y += S[j] * bf2f(pr[j]);
            }
            ys[m * D + h * 64 + i] = f2bf(y);
        }
    }
};
struct RwkvGnF {
    const bf16* P; const bf16* av; const float *k_a, *r_k, *lnx_w, *lnx_b; bf16* ys;
    HD void operator()(long idx) const {
        const long m = idx / H; const int h = (int)(idx % H);
        bf16* yr = ys + (size_t)m * D + h * 64; const bf16* pr = P + (size_t)m * 4096 + h * 64; const bf16* ar = av + (size_t)m * D + h * 64;
        float mean = 0.f;
        for (int j = 0; j < 64; ++j) mean += bf2f(yr[j]);
        mean /= 64.f; float var = 0.f;
        for (int j = 0; j < 64; ++j) { const float d = bf2f(yr[j]) - mean; var += d * d; }
        var /= 64.f; const float rstd = 1.0f / sqrtf(var + 64e-5f);
        float bs = 0.f;
        for (int j = 0; j < 64; ++j) { const float kr = bf2f(pr[1024 + j]); const float kp = kr * (1.0f + (bf2f(ar[j]) - 1.0f) * k_a[h * 64 + j]); bs += bf2f(pr[j]) * kp * r_k[h * 64 + j]; }
        for (int j = 0; j < 64; ++j) {
            const float yn = (bf2f(yr[j]) - mean) * rstd * lnx_w[h * 64 + j] + lnx_b[h * 64 + j];
            const float z = bf2f(pr[3072 + j]);
            yr[j] = f2bf((yn + bs * bf2f(pr[2048 + j])) * siluf_(z));
        }
    }
};

struct CmpHidF {
    const bf16* P; const float *pos_k, *w1_k, *pos_v, *w1_v; float* hk; float* hv;
    HD void operator()(long idx) const {
        const int j = (int)(idx % 128); long r = idx / 128; const int n = (int)(r % NCMP); r /= NCMP; const int g = (int)(r % G); r /= G;
        const int b = (int)(r % B); const int which = (int)(r / B);
        const float* pos = which ? pos_v : pos_k; const float* w1 = which ? w1_v : w1_k; const int col = 1024 + (which ? 256 : 0) + g * 64;
        float acc = 0.f;
        for (int l = 0; l < 32; ++l) {
            const bf16* src = P + (size_t)(b * T + 16 * n + l) * C_COLS + col;
            for (int d = 0; d < 64; ++d) acc += (bf2f(src[d]) + pos[l * 64 + d]) * w1[(size_t)(l * 64 + d) * 128 + j];
        }
        (which ? hv : hk)[(((size_t)b * G + g) * NCMP + n) * 128 + j] = siluf_(acc);
    }
};
struct CmpOutF {
    const float *hk, *hv, *w2_k, *w2_v; float* kc; float* vc;
    HD void operator()(long idx) const {
        const int d = (int)(idx % 64); long r = idx / 64; const long row = r % ((long)B * G * NCMP); const int which = (int)(r / ((long)B * G * NCMP));
        const float* hsrc = (which ? hv : hk) + (size_t)row * 128; const float* w2 = which ? w2_v : w2_k;
        float acc = 0.f;
        for (int j = 0; j < 128; ++j) acc += hsrc[j] * w2[j * 64 + d];
        (which ? vc : kc)[(size_t)row * 64 + d] = acc;
    }
};
struct CmpAttnF {
    const bf16* P; const float *kc, *vc; float* st; bf16* oc;
    HD void operator()(long i) const {
        const long m = i / H; const int h = (int)(i % H), g = h / R; const int t = (int)(m % T); const int b = (int)(m / T);
        float q[DH], o[DH];
#pragma unroll
        for (int d = 0; d < DH; ++d) { q[d] = bf2f(P[(size_t)m * C_COLS + h * DH + d]); o[d] = 0.f; }
        const int nv = t < 31 ? 0 : (t - 31) / 16 + 1;
        float mx = -1e30f, l = 0.f;
        for (int n = 0; n < nv; ++n) {
            const float* kr = kc + (((size_t)b * G + g) * NCMP + n) * 64; const float* vr = vc + (((size_t)b * G + g) * NCMP + n) * 64;
            float sc = 0.f;
#pragma unroll
            for (int d = 0; d < DH; ++d) sc += q[d] * kr[d];
            sc *= 0.125f;
            const float mn = sc > mx ? sc : mx; const float al = expf(mx - mn), p = expf(sc - mn);
            l = l * al + p; mx = mn;
#pragma unroll
            for (int d = 0; d < DH; ++d) o[d] = o[d] * al + p * vr[d];
        }
        const float il = nv > 0 ? 1.0f / l : 0.f;
        st[(size_t)i * 2] = mx; st[(size_t)i * 2 + 1] = il;
#pragma unroll
        for (int d = 0; d < DH; ++d) oc[(size_t)m * D + h * DH + d] = f2bf(o[d] * il);
    }
};
struct ImpF {
    const bf16* P; const float *kc, *st; float* imp;
    HD void operator()(long idx) const {
        const int s = (int)(idx % NSEL); long r = idx / NSEL; const int g = (int)(r % G); const long m = r / G;
        const int t = (int)(m % T); const int b = (int)(m / T); const int cur = t / 64;
        float v;
        if (s == 0 || s == cur || s == cur - 1) v = 1e30f;
        else if (s * 64 > t) v = -1e30f;
        else {
            v = 0.f; const int nv = t < 31 ? 0 : (t - 31) / 16 + 1;
            int n0 = 4 * s - 1; if (n0 < 0) n0 = 0; int n1 = 4 * s + 3; if (n1 > NCMP - 1) n1 = NCMP - 1; if (n1 > nv - 1) n1 = nv - 1;
            for (int rr = 0; rr < R; ++rr) {
                const int h = g * R + rr; const bf16* qr = P + (size_t)m * C_COLS + h * DH;
                const float mx = st[((size_t)m * H + h) * 2], il = st[((size_t)m * H + h) * 2 + 1];
                for (int n = n0; n <= n1; ++n) {
                    const float* kr = kc + (((size_t)b * G + g) * NCMP + n) * 64; float sc = 0.f;
                    for (int d = 0; d < DH; ++d) sc += bf2f(qr[d]) * kr[d];
                    v += expf(sc * 0.125f - mx) * il;
                }
            }
        }
        imp[idx] = v;
    }
};
struct TopkF {
    const float* imp; int* sel;
    HD void operator()(long idx) const {
        const float* v = imp + (size_t)idx * NSEL; unsigned long long used = 0ull;
        for (int j = 0; j < KTOP; ++j) {
            int best = -1; float bv = 0.f;
            for (int s = 0; s < NSEL; ++s) { if ((used >> s) & 1ull) continue; const float x = v[s]; if (best < 0 || x > bv) { best = s; bv = x; } }
            used |= 1ull << best; sel[(size_t)idx * 16 + j] = best;
        }
    }
};
struct SelAttnF {
    const bf16* P; const float* t5; const int* sel; bf16* os;
    HD void operator()(long i) const {
        const long m = i / H; const int h = (int)(i % H), g = h / R; const int t = (int)(m % T); const long mb = m - t;
        float q[DH], o[DH];
#pragma unroll
        for (int d = 0; d < DH; ++d) { q[d] = bf2f(P[(size_t)m * C_COLS + h * DH + d]); o[d] = 0.f; }
        float mx = -1e30f, l = 0.f;
        for (int j = 0; j < KTOP; ++j) {
            const int blk = sel[((size_t)m * G + g) * 16 + j];
            for (int ll = 0; ll < 64; ++ll) {
                const int s = blk * 64 + ll; if (s > t) break;
                const bf16* kr = P + (size_t)(mb + s) * C_COLS + 1536 + g * DH; const bf16* vr = kr + 256;
                float sc = 0.f;
#pragma unroll
                for (int d = 0; d < DH; ++d) sc += q[d] * bf2f(kr[d]);
                sc = sc * 0.125f + t5[t5_bucket(t - s) * H + h];
                const float mn = sc > mx ? sc : mx; const float al = expf(mx - mn), p = expf(sc - mn);
                l = l * al + p; mx = mn;
#pragma unroll
                for (int d = 0; d < DH; ++d) o[d] = o[d] * al + p * bf2f(vr[d]);
            }
        }
        const float il = 1.0f / l;
#pragma unroll
        for (int d = 0; d < DH; ++d) os[(size_t)m * D + h * DH + d] = f2bf(o[d] * il);
    }
};
struct WinAttnF {
    const bf16* P; const float* t5; const bf16* oc; const bf16* os; bf16* AO;
    HD void operator()(long i) const {
        const long m = i / H; const int h = (int)(i % H), g = h / R, rr = h % R; const int t = (int)(m % T); const long mb = m - t;
        float q[DH], o[DH];
#pragma unroll
        for (int d = 0; d < DH; ++d) { q[d] = bf2f(P[(size_t)m * C_COLS + h * DH + d]); o[d] = 0.f; }
        float mx = -1e30f, l = 0.f;
        const int s0 = t - 511 < 0 ? 0 : t - 511;
        for (int s = s0; s <= t; ++s) {
            const bf16* kr = P + (size_t)(mb + s) * C_COLS + 2048 + g * DH; const bf16* vr = kr + 256;
            float sc = 0.f;
#pragma unroll
            for (int d = 0; d < DH; ++d) sc += q[d] * bf2f(kr[d]);
            sc = sc * 0.125f + t5[t5_bucket(t - s) * H + h];
            const float mn = sc > mx ? sc : mx; const float al = expf(mx - mn), p = expf(sc - mn);
            l = l * al + p; mx = mn;
#pragma unroll
            for (int d = 0; d < DH; ++d) o[d] = o[d] * al + p * bf2f(vr[d]);
        }
        const float il = 1.0f / l;
        const bf16* gr = P + (size_t)m * C_COLS + 2560;
        const float g0 = sigmoidf_(bf2f(gr[0 * 16 + g * R + rr])), g1 = sigmoidf_(bf2f(gr[1 * 16 + g * R + rr])), g2 = sigmoidf_(bf2f(gr[2 * 16 + g * R + rr]));
#pragma unroll
        for (int d = 0; d < DH; ++d) {
            const size_t oi = (size_t)m * D + h * DH + d;
            const float z = bf2f(P[(size_t)m * C_COLS + 2608 + h * DH + d]);
            AO[oi] = f2bf((g0 * bf2f(oc[oi]) + g1 * bf2f(os[oi]) + g2 * o[d] * il) * siluf_(z));
        }
    }
};

struct ConvF {
    const bf16* P; const float *cw, *cb; bf16* uc;
    HD void operator()(long i) const {
        const long m = i / LW; const int c = (int)(i % LW); const int t = (int)(m % T);
        float acc = cb[c];
        for (int w = 0; w < 4; ++w) { const int tt = t - 3 + w; if (tt >= 0) acc += cw[w * LW + c] * bf2f(P[(size_t)(m - 3 + w) * 2560 + c]); }
        uc[i] = f2bf(acc);
    }
};
struct LruGateF {
    const bf16* uc; const float *gaw, *gab, *gxw, *gxb, *lam; bf16* la; bf16* bv;
    HD void operator()(long i) const {
        const long m = i / LW; const int c = (int)(i % LW); const int n = c / 80, d = c % 80;
        const bf16* ub = uc + (size_t)m * LW + n * 80; float ra = gab[c], rx = gxb[c];
        for (int k = 0; k < 80; ++k) { const float u = bf2f(ub[k]); ra += u * gaw[((size_t)n * 80 + k) * 80 + d]; rx += u * gxw[((size_t)n * 80 + k) * 80 + d]; }
        const float r = sigmoidf_(ra), ig = sigmoidf_(rx);
        const float loga = -8.0f * r * softplusf_(-lam[c]);
        la[i] = f2bf(loga);
        bv[i] = f2bf(sqrtf(-expm1f(2.0f * loga)) * (ig * bf2f(uc[i])));
    }
};
struct LruScanF {
    const bf16* P; const bf16* la; const bf16* bv; bf16* AO;
    HD void operator()(long idx) const {
        const int c = (int)(idx % LW); const int b = (int)(idx / LW); float h = 0.f;
        for (int t = 0; t < T; ++t) {
            const size_t m = (size_t)b * T + t;
            h = expf(bf2f(la[m * LW + c])) * h + bf2f(bv[m * LW + c]);
            AO[m * LW + c] = f2bf(h * siluf_(bf2f(P[m * 2560 + LW + c])));
        }
    }
};
struct FinalNormF {
    float* x; const float* g;
    HD void operator()(long m) const {
        float* r = x + (size_t)m * D; float s = 0.f;
        for (int k = 0; k < D; ++k) s += r[k] * r[k];
        const float rs = 1.0f / sqrtf(s / D + 1e-6f);
        for (int k = 0; k < D; ++k) r[k] = r[k] * rs * g[k];
    }
};


#ifndef CPU_SHIM
typedef short bf16x8 __attribute__((ext_vector_type(8)));
typedef float f32x4 __attribute__((ext_vector_type(4)));
typedef unsigned u32x4 __attribute__((ext_vector_type(4)));
typedef unsigned u32x2 __attribute__((ext_vector_type(2)));
#define DI __device__ __forceinline__
#define NTHREADS 256
__device__ __forceinline__ int opaque_tid() { int t = threadIdx.x; asm volatile("" : "+v"(t)); return t; }
#define TIDX (opaque_tid())

typedef __bf16 hbf16x2 __attribute__((ext_vector_type(2)));
typedef float f32x2 __attribute__((ext_vector_type(2)));
DI unsigned pack2bf(float lo, float hi) { f32x2 f = {lo, hi}; return __builtin_bit_cast(unsigned, __builtin_convertvector(f, hbf16x2)); }
DI float bflo(unsigned u) { return __uint_as_float(u << 16); }
DI float bfhi(unsigned u) { return __uint_as_float(u & 0xffff0000u); }

namespace fw {
constexpr size_t MB = 1024 * 1024;
constexpr size_t PARTS = 13 * MB;
constexpr size_t SMALLB = 1 * MB;
constexpr size_t WB = 14 * MB;
constexpr size_t XB = 30 * MB;
constexpr size_t BIG = 62 * MB;
}

DI void convert_tile(const float* __restrict__ W, int ldw, int c0, int K, bf16* __restrict__ Wt, const float* __restrict__ g, int kt, int nt, float* sm) {
    const int tid = TIDX;
    const int k0 = kt * 64, n0 = nt * 64;
#pragma unroll
    for (int i = 0; i < 4; ++i) {
        const int kr = (tid >> 4) + 16 * i; const int nc = (tid & 15) * 4;
        const float4 v = *(const float4*)(W + (size_t)(k0 + kr) * ldw + c0 + n0 + nc);
        const float s = g ? g[k0 + kr] : 1.0f;
        sm[kr * 65 + nc + 0] = v.x * s; sm[kr * 65 + nc + 1] = v.y * s; sm[kr * 65 + nc + 2] = v.z * s; sm[kr * 65 + nc + 3] = v.w * s;
    }
    __syncthreads();
    {
        const int n = tid >> 2, kq = (tid & 3) * 16;
        unsigned w[8];
#pragma unroll
        for (int j = 0; j < 8; ++j) w[j] = pack2bf(sm[(kq + 2 * j) * 65 + n], sm[(kq + 2 * j + 1) * 65 + n]);
        u32x4* dst = (u32x4*)(Wt + (size_t)(n0 + n) * K + k0 + kq);
        dst[0] = (u32x4){w[0], w[1], w[2], w[3]}; dst[1] = (u32x4){w[4], w[5], w[6], w[7]};
    }
    __syncthreads();
}
DI void convert_seg(const float* W, int ldw, int c0, int ncols, int K, bf16* Wt, const float* g, float* sm, int& tbase) {
    const int nkt = K / 64, nnt = ncols / 64, ntile = nkt * nnt;
    const int Gd = (int)gridDim.x;
    for (int t = (((int)blockIdx.x - tbase % Gd) + Gd) % Gd; t < ntile; t += Gd) convert_tile(W, ldw, c0, K, Wt, g, t % nkt, t / nkt, sm);
    tbase += ntile;
}

DI int perm32(int rho) { const int n = rho >> 4, i = rho & 15; return 8 * (i >> 2) + 4 * n + (i & 3); }

struct ALoadPlain {
    const bf16* A; int lda;
    static constexpr bool DMA = true;
    DI const bf16* src(int m, int k) const { return A + (size_t)m * lda + k; }
    struct Raw { u32x4 v; };
    DI Raw load(int m, int k) const { Raw r; r.v = *(const u32x4*)(A + (size_t)m * lda + k); return r; }
    DI u32x4 finish(const Raw& r, int, int) const { return r.v; }
};
struct ALoadLerp {
    const bf16* xn; const float* mu;
    static constexpr bool DMA = false;
    DI const bf16* src(int, int) const { return nullptr; }
    struct Raw { u32x4 c, p; };
    DI Raw load(int m, int k) const {
        Raw r; r.c = *(const u32x4*)(xn + (size_t)m * D + k);
        if ((m % T) != 0) r.p = *(const u32x4*)(xn + (size_t)(m - 1) * D + k); else r.p = (u32x4){0u, 0u, 0u, 0u};
        return r;
    }
    DI u32x4 finish(const Raw& r, int, int k) const {
        const float4 m0 = *(const float4*)(mu + k), m1 = *(const float4*)(mu + k + 4);
        const float mm[8] = {m0.x, m0.y, m0.z, m0.w, m1.x, m1.y, m1.z, m1.w};
        u32x4 o;
#pragma unroll
        for (int j = 0; j < 4; ++j) {
            const float c0 = bflo(r.c[j]), c1 = bfhi(r.c[j]), p0 = bflo(r.p[j]), p1 = bfhi(r.p[j]);
            o[j] = pack2bf(c0 + (p0 - c0) * mm[2 * j], c1 + (p1 - c1) * mm[2 * j + 1]);
        }
        return o;
    }
};

#define GLDS16(gp, lp) __builtin_amdgcn_global_load_lds((const unsigned*)(gp), (unsigned*)(lp), 16, 0, 0)
template <class AL, class Epi>
DI void gemm_tile(const AL& al, const bf16* __restrict__ Bt, int K, int m0, int n0, const Epi& epi, char* smem) {
    const int tid = TIDX, lane = tid & 63, wave = __builtin_amdgcn_readfirstlane(tid >> 6), wr = wave >> 1, wc = wave & 1, q = lane >> 4, l15 = lane & 15;
    const int srow = tid >> 3, sc = tid & 7, scs = sc ^ (srow & 7);
    const int st_off = srow * 128 + (sc << 4);
    const int dma_off = (8 * wave) * 128;
    int brow[4];
#pragma unroll
    for (int i = 0; i < 4; ++i) { const int rho = srow + 32 * i; brow[i] = n0 + (rho & ~31) + perm32(rho & 31); }
    const int fa0 = (wr * 64 + l15) * 128 + ((q ^ (lane & 7)) << 4);
    const int fb0 = (wc * 64 + l15) * 128 + ((q ^ (lane & 7)) << 4);
    f32x4 acc[4][4];
#pragma unroll
    for (int i = 0; i < 4; ++i)
#pragma unroll
        for (int j = 0; j < 4; ++j) acc[i][j] = (f32x4){0.f, 0.f, 0.f, 0.f};
    typename AL::Raw ra[4];
    const int nk = K / 64;
    {
        char* bufA = smem; char* bufB = smem + 16384;
#pragma unroll
        for (int i = 0; i < 4; ++i) {
            GLDS16(Bt + (size_t)brow[i] * K + scs * 8, bufB + dma_off + i * 4096);
            if (AL::DMA) GLDS16(al.src(m0 + srow + 32 * i, scs * 8), bufA + dma_off + i * 4096);
            else ra[i] = al.load(m0 + srow + 32 * i, scs * 8);
        }
        if (!AL::DMA) {
#pragma unroll
            for (int i = 0; i < 4; ++i) *(u32x4*)(bufA + st_off + i * 4096) = al.finish(ra[i], m0 + srow + 32 * i, scs * 8);
        }
    }
    asm volatile("s_waitcnt vmcnt(0)" ::: "memory");
    __syncthreads();
    for (int kt = 0; kt < nk; ++kt) {
        char* bufA = smem + (kt & 1) * 32768; char* bufB = bufA + 16384;
        char* nA = smem + ((kt + 1) & 1) * 32768; char* nB = nA + 16384;
        const bool more = kt + 1 < nk; const int kn = (kt + 1) * 64 + scs * 8;
        if (more) {
#pragma unroll
            for (int i = 0; i < 4; ++i) {
                GLDS16(Bt + (size_t)brow[i] * K + kn, nB + dma_off + i * 4096);
                if (AL::DMA) GLDS16(al.src(m0 + srow + 32 * i, kn), nA + dma_off + i * 4096);
                else ra[i] = al.load(m0 + srow + 32 * i, kn);
            }
        }
#pragma unroll
        for (int ks = 0; ks < 2; ++ks) {
            bf16x8 af[4], bfr[4];
#pragma unroll
            for (int i = 0; i < 4; ++i) {
                af[i] = *(const bf16x8*)(bufA + ((fa0 + i * 2048) ^ (ks << 6)));
                bfr[i] = *(const bf16x8*)(bufB + ((fb0 + i * 2048) ^ (ks << 6)));
            }
#pragma unroll
            for (int i = 0; i < 4; ++i)
#pragma unroll
                for (int j = 0; j < 4; ++j) acc[i][j] = __builtin_amdgcn_mfma_f32_16x16x32_bf16(bfr[j], af[i], acc[i][j], 0, 0, 0);
        }
        if (more && !AL::DMA) {
#pragma unroll
            for (int i = 0; i < 4; ++i) *(u32x4*)(nA + st_off + i * 4096) = al.finish(ra[i], m0 + srow + 32 * i, kn);
        }
        asm volatile("s_waitcnt vmcnt(0)" ::: "memory");
        __syncthreads();
    }
#pragma unroll
    for (int mt = 0; mt < 4; ++mt)
#pragma unroll
        for (int gi = 0; gi < 2; ++gi) {
            float v[8];
#pragma unroll
            for (int r = 0; r < 4; ++r) { v[r] = acc[mt][2 * gi][r]; v[4 + r] = acc[mt][2 * gi + 1][r]; }
            epi(m0 + wr * 64 + mt * 16 + l15, n0 + wc * 64 + gi * 32 + 8 * q, v, mt, gi);
        }
    epi.finish(m0, n0, wr, wc, lane);
}

constexpr int G2_STAGE = 24576;
template <class AL, class Epi>
DI void gemm_tile2(const AL& al, const bf16* __restrict__ Bt, int K, int m0, int n0, const Epi& epi, char* smem) {
    const int tid = TIDX, lane = tid & 63, wave = __builtin_amdgcn_readfirstlane(tid >> 6), wr = wave >> 1, wc = wave & 1, q = lane >> 4, l15 = lane & 15;
    const int prow = tid >> 2, ppos = tid & 3, ca = (ppos - 2 * ((tid >> 4) & 3)) & 3;
    const int dma_off = wave * 1024;
    int brow[4];
#pragma unroll
    for (int i = 0; i < 4; ++i) { const int rho = prow + 64 * i; brow[i] = n0 + (rho & ~31) + perm32(rho & 31); }
    const int fpos = ((q + 2 * ((l15 >> 2) & 3)) & 3) << 4;
    const int fa0 = (wr * 64 + l15) * 64 + fpos, fb0 = 8192 + (wc * 128 + l15) * 64 + fpos;
    f32x4 acc[4][8];
#pragma unroll
    for (int i = 0; i < 4; ++i)
#pragma unroll
        for (int j = 0; j < 8; ++j) acc[i][j] = (f32x4){0.f, 0.f, 0.f, 0.f};
    typename AL::Raw ra[2];
    const int nk = K / 32;
#define G2_ISSUE(kt_) { char* st_ = smem + ((kt_) % 3) * G2_STAGE; const int kk_ = (kt_) * 32 + ca * 8; \
        _Pragma("unroll") for (int i = 0; i < 2; ++i) { if (AL::DMA) GLDS16(al.src(m0 + prow + 64 * i, kk_), st_ + dma_off + i * 4096); else ra[i] = al.load(m0 + prow + 64 * i, kk_); } \
        _Pragma("unroll") for (int i = 0; i < 4; ++i) GLDS16(Bt + (size_t)brow[i] * K + kk_, st_ + 8192 + dma_off + i * 4096); }
#define G2_AWRITE(kt_) { if (!AL::DMA) { char* st_ = smem + ((kt_) % 3) * G2_STAGE; const int kk_ = (kt_) * 32 + ca * 8; \
        _Pragma("unroll") for (int i = 0; i < 2; ++i) *(u32x4*)(st_ + (prow + 64 * i) * 64 + ppos * 16) = al.finish(ra[i], m0 + prow + 64 * i, kk_); } }
#define G2_BARRIER() { asm volatile("s_waitcnt lgkmcnt(0)" ::: "memory"); __builtin_amdgcn_s_barrier(); asm volatile("" ::: "memory"); }
    G2_ISSUE(0); G2_AWRITE(0);
    if (nk > 1) { G2_ISSUE(1); G2_AWRITE(1); }
    if (nk > 1) { if (AL::DMA) asm volatile("s_waitcnt vmcnt(6)" ::: "memory"); else asm volatile("s_waitcnt vmcnt(4)" ::: "memory"); } else asm volatile("s_waitcnt vmcnt(0)" ::: "memory");
    G2_BARRIER();
    for (int kt = 0; kt < nk; ++kt) {
        const char* st = smem + (kt % 3) * G2_STAGE;
        const bool more = kt + 2 < nk;
        if (more) G2_ISSUE(kt + 2);
        bf16x8 af[4];
#pragma unroll
        for (int i = 0; i < 4; ++i) af[i] = *(const bf16x8*)(st + fa0 + i * 1024);
#pragma unroll
        for (int j = 0; j < 8; ++j) {
            const bf16x8 bf_ = *(const bf16x8*)(st + fb0 + j * 1024);
#pragma unroll
            for (int i = 0; i < 4; ++i) acc[i][j] = __builtin_amdgcn_mfma_f32_16x16x32_bf16(bf_, af[i], acc[i][j], 0, 0, 0);
        }
        if (more) G2_AWRITE(kt + 2);
        if (more) { if (AL::DMA) asm volatile("s_waitcnt vmcnt(6)" ::: "memory"); else asm volatile("s_waitcnt vmcnt(4)" ::: "memory"); } else asm volatile("s_waitcnt vmcnt(0)" ::: "memory");
        G2_BARRIER();
    }
#undef G2_ISSUE
#undef G2_AWRITE
#undef G2_BARRIER
#pragma unroll
    for (int mt = 0; mt < 4; ++mt)
#pragma unroll
        for (int gi = 0; gi < 4; ++gi) {
            float v[8];
#pragma unroll
            for (int r = 0; r < 4; ++r) { v[r] = acc[mt][2 * gi][r]; v[4 + r] = acc[mt][2 * gi + 1][r]; }
            epi(m0 + wr * 64 + mt * 16 + l15, n0 + wc * 128 + gi * 32 + 8 * q, v, mt, gi);
        }
    epi.finish_wide(m0, n0, wr, wc, lane);
}
template <class F>
DI void gemm_sched(int nbig, int nsmall, F&& f) {
    const int x = blockIdx.x & 7, lb = blockIdx.x >> 3, nlb = gridDim.x >> 3;
    const int nb16 = 16 * nbig, tot = 16 * (nbig + nsmall);
    for (int s = lb; s < tot; s += nlb) {
        if (s < nb16) f(true, x * 16 + (s & 15), s >> 4);
        else { const int t = s - nb16; f(false, x * 16 + (t & 15), t >> 4); }
    }
}

DI float rstd_from_parts(const float* parts, int m) {
    const float4* p = (const float4*)(parts + (size_t)m * 16); float s = 0.f;
#pragma unroll
    for (int i = 0; i < 4; ++i) { const float4 v = p[i]; s += (v.x + v.y) + (v.z + v.w); }
    return 1.0f / sqrtf(s * (1.0f / D) + 1e-6f);
}
DI void store8bf(bf16* p, const float* v) { *(u32x4*)p = (u32x4){pack2bf(v[0], v[1]), pack2bf(v[2], v[3]), pack2bf(v[4], v[5]), pack2bf(v[6], v[7])}; }

struct EpiBf16 {
    bf16* P; int ldp; const float* parts; mutable float rsc[4];
    DI void operator()(int m, int n, const float* v, int mt, int gi) const {
        if (gi == 0) rsc[mt] = parts ? rstd_from_parts(parts, m) : 1.0f;
        float s = rsc[mt]; float w[8];
#pragma unroll
        for (int j = 0; j < 8; ++j) w[j] = v[j] * s;
        store8bf(P + (size_t)m * ldp + n, w);
    }
    DI void finish(int, int, int, int, int) const {}
    DI void finish_wide(int, int, int, int, int) const {}
};
struct EpiResid {
    const float* xin; float* xout; bf16* xb; float* parts; mutable float sq[4];
    DI void operator()(int m, int n, const float* v, int mt, int gi) const {
        const float4* xi = (const float4*)(xin + (size_t)m * D + n); const float4 a = xi[0], b = xi[1];
        float w[8] = {a.x + v[0], a.y + v[1], a.z + v[2], a.w + v[3], b.x + v[4], b.y + v[5], b.z + v[6], b.w + v[7]};
        float4* xo = (float4*)(xout + (size_t)m * D + n);
        xo[0] = make_float4(w[0], w[1], w[2], w[3]); xo[1] = make_float4(w[4], w[5], w[6], w[7]);
        if (xb) store8bf(xb + (size_t)m * D + n, w);
        float s = 0.f;
#pragma unroll
        for (int j = 0; j < 8; ++j) s += w[j] * w[j];
        if (gi == 0) sq[mt] = s; else sq[mt] += s;
    }
    DI void finish(int m0, int n0, int wr, int wc, int lane) const {
#pragma unroll
        for (int mt = 0; mt < 4; ++mt) {
            float s = sq[mt]; s += __shfl_xor(s, 16); s += __shfl_xor(s, 32);
            if (lane < 16) parts[(size_t)(m0 + wr * 64 + mt * 16 + lane) * 16 + (n0 >> 7) * 2 + wc] = s;
        }
    }
    DI void finish_wide(int m0, int n0, int wr, int wc, int lane) const {
#pragma unroll
        for (int mt = 0; mt < 4; ++mt) {
            float s = sq[mt]; s += __shfl_xor(s, 16); s += __shfl_xor(s, 32);
            if (lane < 16) { float* pr = parts + (size_t)(m0 + wr * 64 + mt * 16 + lane) * 16 + (n0 >> 7) + wc; pr[0] = s; pr[8] = 0.f; }
        }
    }
};
struct EpiRwkv {
    bf16* P; float* hw; float* ha;
    DI void operator()(int m, int n, const float* v, int, int) const {
        if (n < 4096) { store8bf(P + (size_t)m * 4096 + n, v); return; }
        const int c = n - 4096;
        if (c < 64) { float4* o = (float4*)(hw + (size_t)m * 64 + c); o[0] = make_float4(tanhf(v[0]), tanhf(v[1]), tanhf(v[2]), tanhf(v[3])); o[1] = make_float4(tanhf(v[4]), tanhf(v[5]), tanhf(v[6]), tanhf(v[7])); }
        else if (c >= 128 && c < 192) { float4* o = (float4*)(ha + (size_t)m * 64 + (c - 128)); o[0] = make_float4(v[0], v[1], v[2], v[3]); o[1] = make_float4(v[4], v[5], v[6], v[7]); }
    }
    DI void finish(int, int, int, int, int) const {}
    DI void finish_wide(int, int, int, int, int) const {}
};

namespace at {
constexpr int OFF_BIAS = 49152;
constexpr int OFF_X = 61952;
constexpr int OFF_IMP = 49152;
constexpr float L2E = 1.4426950408889634f;
constexpr float NEG_MASK = -1e30f, M_INIT = -1e20f;
}
enum { AM_SWA = 0, AM_WIN = 1, AM_CMP = 2, AM_SEL = 3 };
DI int vt_perm(int k32) { return ((k32 & 15) >> 2) * 8 + (k32 >> 4) * 4 + (k32 & 3); }
DI float fast_exp2(float x) { return __builtin_amdgcn_exp2f(x); }

DI void build_bias_lut(const float* __restrict__ t5, char* smem, bool swa) {
    float* lut = (float*)(smem + at::OFF_BIAS);
    for (int i = TIDX; i < 16 * 200; i += NTHREADS) {
        const int h = i / 200, e = i % 200; float v = at::NEG_MASK;
        if (e >= 64 && e < 192) v = t5[t5_bucket(e - 64) * 16 + h] * at::L2E;
        else if (e >= 192 && !swa) v = t5[31 * 16 + h] * at::L2E;
        lut[i] = v;
    }
    __syncthreads();
}

template <int NQT> struct AttnStateT { f32x4 o[NQT][4]; f32x4 lacc[NQT]; float m[NQT]; };
#ifndef ANQT_SWA
#define ANQT_SWA 4
#endif
#ifndef ANQT_WIN
#define ANQT_WIN 2
#endif
#ifndef ANQT_SEL
#define ANQT_SEL 4
#endif
DI unsigned long long range_mask(int lo, int hi) { return (hi >= 63 ? ~0ull : ((1ull << (hi + 1)) - 1ull)) & ~((1ull << lo) - 1ull); }

template <int NQT>
DI void attn_load_q(bf16x8 (&qf)[NQT][2], const bf16* __restrict__ Qp, int ldq, size_t mbase, int hbase) {
    const int lane = TIDX & 63, wave = TIDX >> 6, q = lane >> 4, l15 = lane & 15;
#pragma unroll
    for (int qt = 0; qt < NQT; ++qt) {
        const size_t m = mbase + wave * (4 * NQT) + qt * 4 + (l15 >> 2);
#pragma unroll
        for (int ks = 0; ks < 2; ++ks) qf[qt][ks] = *(const bf16x8*)(Qp + m * ldq + (hbase + (l15 & 3)) * 64 + ks * 32 + q * 8);
    }
}

enum { SK_FAR = 0, SK_NEAR = 1, SK_EDGE = 2, SK_CMP = 3 };
template <int KIND>
DI float attn_fix(f32x4 (&s)[4], int dbase, float cadd, const float* __restrict__ bl, float mx) {
#pragma unroll
    for (int kt = 0; kt < 4; ++kt)
#pragma unroll
        for (int r = 0; r < 4; ++r) {
            float v = s[kt][r]; const int dist = dbase - (kt * 16 + r);
            if (KIND == SK_NEAR) { int idx = dist + 64; idx = idx < 0 ? 0 : (idx > 192 ? 192 : idx); v += bl[idx] + cadd; }
            else if (KIND == SK_EDGE) v = dist < 512 ? v + cadd : at::NEG_MASK;
            else if (KIND == SK_CMP) v = dist >= 0 ? v : at::NEG_MASK;
            if (KIND != SK_FAR) s[kt][r] = v;
            mx = fmaxf(mx, v);
        }
    return mx;
}
template <int MODE, int NQT>
DI void attn_blocks(AttnStateT<NQT>& st, const bf16x8 (&qf)[NQT][2], const bf16* __restrict__ Kp, size_t krs, const bf16* __restrict__ Vp, size_t vrs,
                    int t0, unsigned long long todo, int hbase, const unsigned long long (&sel)[NQT], char* smem) {
    const int tid = TIDX, lane = tid & 63, wave = __builtin_amdgcn_readfirstlane(tid >> 6), q = lane >> 4, l15 = lane & 15;
    const int tq0 = t0 + wave * (4 * NQT) + (l15 >> 2);
    const float* bl = (const float*)(smem + at::OFF_BIAS) + (hbase + (l15 & 3)) * 200;
    const float bfar = (MODE != AM_CMP) ? bl[192] : 0.f;
    const int srow = tid >> 3, scs = (tid & 7) ^ (srow & 7);
    const int fo = l15 * 128 + ((q ^ (l15 & 7)) << 4);
#define ATT_DMA(kb_, slot_) { _Pragma("unroll") for (int i = 0; i < 2; ++i) { const int row = srow + 32 * i; char* dst = smem + (slot_) * 16384 + (8 * wave + 32 * i) * 128; \
        GLDS16(Kp + (size_t)((kb_) * 64 + row) * krs + scs * 8, dst); GLDS16(Vp + (size_t)row * vrs + (kb_) * 64 + scs * 8, dst + 8192); } }
#define ATT_BARRIER() { asm volatile("s_waitcnt lgkmcnt(0)" ::: "memory"); __builtin_amdgcn_s_barrier(); asm volatile("" ::: "memory"); }
    if (todo == 0ull) return;
    int kb = __builtin_ctzll(todo); todo &= todo - 1ull;
    int kb1 = -1; if (todo) { kb1 = __builtin_ctzll(todo); todo &= todo - 1ull; }
    ATT_DMA(kb, 0);
    if (kb1 >= 0) { ATT_DMA(kb1, 1); asm volatile("s_waitcnt vmcnt(4)" ::: "memory"); } else { asm volatile("s_waitcnt vmcnt(0)" ::: "memory"); }
    ATT_BARRIER();
    int slot = 0;
    for (;;) {
        char* buf = smem + slot * 16384;
        int kb2 = -1; if (todo) { kb2 = __builtin_ctzll(todo); todo &= todo - 1ull; }
        if (kb2 >= 0) { const int s2 = slot >= 1 ? slot - 1 : 2; ATT_DMA(kb2, s2); }
        f32x4 s[NQT][4];
#pragma unroll
        for (int qt = 0; qt < NQT; ++qt)
#pragma unroll
            for (int kt = 0; kt < 4; ++kt) s[qt][kt] = (f32x4){0.f, 0.f, 0.f, 0.f};
#pragma unroll
        for (int kt = 0; kt < 4; ++kt)
#pragma unroll
            for (int ks = 0; ks < 2; ++ks) {
                const bf16x8 kf = *(const bf16x8*)(buf + ((fo + kt * 2048) ^ (ks << 6)));
#pragma unroll
                for (int qt = 0; qt < NQT; ++qt) s[qt][kt] = __builtin_amdgcn_mfma_f32_16x16x32_bf16(kf, qf[qt][ks], s[qt][kt], 0, 0, 0);
            }
        const int mind = (t0 + wave * (4 * NQT)) - (kb * 64 + 63), maxd = (t0 + wave * (4 * NQT) + 4 * NQT - 1) - kb * 64;
        float mx[NQT], cofs[NQT];
#pragma unroll
        for (int qt = 0; qt < NQT; ++qt) cofs[qt] = 0.f;
        if (MODE == AM_CMP) {
#pragma unroll
            for (int qt = 0; qt < NQT; ++qt) { const int nlim = (tq0 + 4 * qt - 31) >> 4; mx[qt] = attn_fix<SK_CMP>(s[qt], nlim - (kb * 64 + 4 * q), 0.f, bl, at::NEG_MASK); }
        } else {
            float cadd[NQT];
#pragma unroll
            for (int qt = 0; qt < NQT; ++qt) cadd[qt] = (MODE == AM_SEL && !((sel[qt] >> kb) & 1ull)) ? at::NEG_MASK : 0.f;
            if (MODE == AM_SWA || mind < 113) {
#pragma unroll
                for (int qt = 0; qt < NQT; ++qt) mx[qt] = attn_fix<SK_NEAR>(s[qt], tq0 + 4 * qt - (kb * 64 + 4 * q), cadd[qt], bl, at::NEG_MASK);
            } else if (MODE == AM_WIN && maxd >= 512) {
#pragma unroll
                for (int qt = 0; qt < NQT; ++qt) mx[qt] = attn_fix<SK_EDGE>(s[qt], tq0 + 4 * qt - (kb * 64 + 4 * q), bfar, bl, at::NEG_MASK);
            } else {
#pragma unroll
                for (int qt = 0; qt < NQT; ++qt) { cofs[qt] = bfar + cadd[qt]; mx[qt] = attn_fix<SK_FAR>(s[qt], 0, 0.f, bl, at::NEG_MASK) + cofs[qt]; }
            }
        }
        float msub[NQT]; bool grow = false;
#pragma unroll
        for (int qt = 0; qt < NQT; ++qt) {
            float m2 = mx[qt];
            m2 = fmaxf(m2, __shfl_xor(m2, 16)); m2 = fmaxf(m2, __shfl_xor(m2, 32));
            const bool g = m2 > st.m[qt] + 4.0f; grow |= g;
            mx[qt] = g ? m2 : st.m[qt];
            msub[qt] = mx[qt] - cofs[qt];
        }
        if (__any(grow)) {
#pragma unroll
            for (int qt = 0; qt < NQT; ++qt) {
                const float alpha = fast_exp2(st.m[qt] - mx[qt]);
#pragma unroll
                for (int dt = 0; dt < 4; ++dt) st.o[qt][dt] *= alpha;
                st.lacc[qt] *= alpha;
            }
        }
#pragma unroll
        for (int qt = 0; qt < NQT; ++qt) st.m[qt] = mx[qt];
#pragma unroll
        for (int qt = 0; qt < NQT; ++qt)
#pragma unroll
            for (int kt = 0; kt < 4; ++kt)
#pragma unroll
                for (int r = 0; r < 4; ++r) s[qt][kt][r] = fast_exp2(s[qt][kt][r] - msub[qt]);
        const bf16x8 ones = {(short)0x3F80, (short)0x3F80, (short)0x3F80, (short)0x3F80, (short)0x3F80, (short)0x3F80, (short)0x3F80, (short)0x3F80};
#pragma unroll
        for (int kp = 0; kp < 2; ++kp) {
            bf16x8 pf[NQT];
#pragma unroll
            for (int qt = 0; qt < NQT; ++qt) {
                const u32x4 w = {pack2bf(s[qt][2 * kp][0], s[qt][2 * kp][1]), pack2bf(s[qt][2 * kp][2], s[qt][2 * kp][3]),
                                 pack2bf(s[qt][2 * kp + 1][0], s[qt][2 * kp + 1][1]), pack2bf(s[qt][2 * kp + 1][2], s[qt][2 * kp + 1][3])};
                pf[qt] = __builtin_bit_cast(bf16x8, w);
            }
#pragma unroll
            for (int qt = 0; qt < NQT; ++qt) st.lacc[qt] = __builtin_amdgcn_mfma_f32_16x16x32_bf16(ones, pf[qt], st.lacc[qt], 0, 0, 0);
#pragma unroll
            for (int dt = 0; dt < 4; ++dt) {
                const bf16x8 vf = *(const bf16x8*)(buf + 8192 + ((fo + dt * 2048) ^ (kp << 6)));
#pragma unroll
                for (int qt = 0; qt < NQT; ++qt) st.o[qt][dt] = __builtin_amdgcn_mfma_f32_16x16x32_bf16(vf, pf[qt], st.o[qt][dt], 0, 0, 0);
            }
        }
        if (kb1 < 0) break;
        if (kb2 >= 0) { asm volatile("s_waitcnt vmcnt(4)" ::: "memory"); } else { asm volatile("s_waitcnt vmcnt(0)" ::: "memory"); }
        ATT_BARRIER();
        kb = kb1; kb1 = kb2; slot = slot == 2 ? 0 : slot + 1;
    }
    ATT_BARRIER();
#undef ATT_DMA
}
template <int NQT>
DI void attn_init(AttnStateT<NQT>& st, float m0, float l0) {
#pragma unroll
    for (int qt = 0; qt < NQT; ++qt) { st.m[qt] = m0; st.lacc[qt] = (f32x4){l0, l0, l0, l0};
#pragma unroll
        for (int dt = 0; dt < 4; ++dt) st.o[qt][dt] = (f32x4){0.f, 0.f, 0.f, 0.f}; }
}
DI float attn_linv(const f32x4& lacc) { const float l = lacc[0]; return l > 0.f ? 1.0f / l : 0.f; }

template <int TT>
DI void attn_item_decode(int item, int& b, int& g, int& t0) {
    constexpr int tiles = T / TT;
    const int Gd = (int)gridDim.x;
    int pair, tile;
    if ((Gd % tiles) == 0 && tiles * B * G % Gd == 0) {
        const int bid = item % Gd, rr = item / Gd, tau = bid % tiles;
        pair = bid / tiles + (Gd / tiles) * rr; tile = (rr & 1) ? tiles - 1 - tau : tau;
    } else { tile = item % tiles; pair = item / tiles; }
    t0 = tile * TT; g = pair % G; b = pair / G;
}
DI void swa_item(const bf16* __restrict__ P0, const bf16* __restrict__ VT, const float* __restrict__ sinks, bf16* __restrict__ AO, int item, char* smem) {
    constexpr int LDP = 2304;
    constexpr int NQT = ANQT_SWA;
    int b, g, t0; attn_item_decode<16 * NQT>(item, b, g, t0);
    const int lane = TIDX & 63, wave = TIDX >> 6, q = lane >> 4, l15 = lane & 15;
    const size_t mbase = (size_t)b * T + t0; const int hbase = g * 4, h = hbase + (l15 & 3);
    bf16x8 qf[NQT][2]; attn_load_q<NQT>(qf, P0, LDP, mbase, hbase);
    AttnStateT<NQT> st; attn_init<NQT>(st, sinks[h] * at::L2E, 1.0f);
    const int lo = t0 - 127 < 0 ? 0 : (t0 - 127) >> 6, hi = (t0 + 16 * NQT - 1) >> 6;
    const unsigned long long nosel[NQT] = {};
    attn_blocks<AM_SWA, NQT>(st, qf, P0 + (size_t)b * T * LDP + 1024 + g * 64, LDP, VT + (size_t)(b * G + g) * 64 * T, T, t0, range_mask(lo, hi), hbase, nosel, smem);
#pragma unroll
    for (int qt = 0; qt < NQT; ++qt) {
        const float li = attn_linv(st.lacc[qt]); const size_t m = mbase + wave * (4 * NQT) + qt * 4 + (l15 >> 2);
#pragma unroll
        for (int dt = 0; dt < 4; ++dt) {
            const int d0 = dt * 16 + 4 * q; const u32x2 zz = *(const u32x2*)(P0 + m * LDP + 1280 + h * 64 + d0);
            const float z0 = bflo(zz[0]), z1 = bfhi(zz[0]), z2 = bflo(zz[1]), z3 = bfhi(zz[1]);
            const f32x4 o = st.o[qt][dt];
            *(u32x2*)(AO + m * D + h * 64 + d0) = (u32x2){pack2bf(o[0] * li * siluf_(z0), o[1] * li * siluf_(z1)), pack2bf(o[2] * li * siluf_(z2), o[3] * li * siluf_(z3))};
        }
    }
}

struct EpiL0 {
    bf16* P0; bf16* VT; const float* parts; mutable float rsc[4];
    DI void operator()(int m, int n, const float* v, int mt, int gi) const {
        if (gi == 0) rsc[mt] = rstd_from_parts(parts, m);
        float s = rsc[mt]; if (n < 1024) s *= 0.125f * at::L2E; float w[8];
#pragma unroll
        for (int j = 0; j < 8; ++j) w[j] = v[j] * s;
        if (n < 1280) store8bf(P0 + (size_t)m * 2304 + n, w);
        else if (n >= 1536) store8bf(P0 + (size_t)m * 2304 + n - 256, w);
        else {
            const int g = (n - 1280) >> 6, d = (n - 1280) & 63, b = m / T, t = m % T; const int pos = (t & ~31) + vt_perm(t & 31);
            bf16* dst = VT + ((size_t)(b * G + g) * 64 + d) * T + pos;
#pragma unroll
            for (int j = 0; j < 8; ++j) dst[(size_t)j * T] = f2bf(w[j]);
        }
    }
    DI void finish(int, int, int, int, int) const {}
    DI void finish_wide(int, int, int, int, int) const {}
};

constexpr int LDP2 = 3200;
struct EpiL2 {
    bf16* P2; bf16* VTs; bf16* VTw; const float* parts; mutable float rsc[4];
    DI void operator()(int m, int n, const float* v, int mt, int gi) const {
        if (gi == 0) rsc[mt] = rstd_from_parts(parts, m);
        if (n >= C_COLS) return;
        float s = rsc[mt]; if (n < 1024) s *= 0.125f * at::L2E; float w[8];
#pragma unroll
        for (int j = 0; j < 8; ++j) w[j] = v[j] * s;
        const bool isvs = n >= 1792 && n < 2048, isvw = n >= 2304 && n < 2560;
        if (isvs || isvw) {
            const int c = n - (isvs ? 1792 : 2304); const int g = c >> 6, d = c & 63, b = m / T, t = m % T; const int pos = (t & ~31) + vt_perm(t & 31);
            bf16* dst = (isvs ? VTs : VTw) + ((size_t)(b * G + g) * 64 + d) * T + pos;
#pragma unroll
            for (int j = 0; j < 8; ++j) dst[(size_t)j * T] = f2bf(w[j]);
        } else {
            const int c = n < 1792 ? n : (n < 2304 ? n - 256 : n - 512);
            store8bf(P2 + (size_t)m * LDP2 + c, w);
        }
    }
    DI void finish(int, int, int, int, int) const {}
    DI void finish_wide(int, int, int, int, int) const {}
};

struct ALoadCmp {
    const bf16* P2; int col;
    static constexpr bool DMA = true;
    DI const bf16* src(int row, int k) const {
        int n = row & 255; const int bg = row >> 8, b = bg >> 2, g = bg & 3; const int l = k >> 6, d = k & 63; n = n < NCMP ? n : NCMP - 1;
        return P2 + (size_t)(b * T + 16 * n + l) * LDP2 + col + g * 64 + d;
    }
    struct Raw { u32x4 v; };
    DI Raw load(int row, int k) const {
        const int n = row & 255, bg = row >> 8, b = bg >> 2, g = bg & 3; const int l = k >> 6, d = k & 63; Raw r;
        if (n < NCMP) r.v = *(const u32x4*)(P2 + (size_t)(b * T + 16 * n + l) * LDP2 + col + g * 64 + d); else r.v = (u32x4){0u, 0u, 0u, 0u};
        return r;
    }
    DI u32x4 finish(const Raw& r, int, int) const { return r.v; }
};
struct EpiCmpH {
    char* smem; const float* bias8;
    DI void operator()(int m, int n, const float* v, int, int) const {
        const int row = m & 127; float w[8];
#pragma unroll
        for (int j = 0; j < 8; ++j) { float bsum = 0.f;
#pragma unroll
            for (int i = 0; i < 8; ++i) bsum += bias8[i * 128 + n + j];
            w[j] = siluf_(v[j] + bsum); }
        const int kk = n >> 6, c = (n & 63) >> 3;
        *(u32x4*)(smem + kk * 16384 + row * 128 + ((c ^ (row & 7)) << 4)) = (u32x4){pack2bf(w[0], w[1]), pack2bf(w[2], w[3]), pack2bf(w[4], w[5]), pack2bf(w[6], w[7])};
    }
    DI void finish(int, int, int, int, int) const {}
    DI void finish_wide(int, int, int, int, int) const {}
};
DI void cmp_tile(const bf16* __restrict__ P2, const bf16* __restrict__ w1t, const float* __restrict__ bias8, const bf16* __restrict__ w2t, int which, int rt,
                 bf16* __restrict__ KCb, bf16* __restrict__ VCT, char* smem) {
    gemm_tile(ALoadCmp{P2, which ? 1280 : 1024}, w1t, 2048, rt * 128, 0, EpiCmpH{smem, bias8}, smem);
    const int tid = TIDX, lane = tid & 63, wave = tid >> 6, q = lane >> 4, l15 = lane & 15;
#pragma unroll
    for (int i = 0; i < 4; ++i) {
        const int id = i * 256 + tid; const int row = id >> 4, c16 = id & 15, kk = c16 >> 3, c = c16 & 7;
        *(u32x4*)(smem + 32768 + kk * 8192 + row * 128 + ((c ^ (row & 7)) << 4)) = *(const u32x4*)(w2t + (size_t)row * 128 + c16 * 8);
    }
    __syncthreads();
    f32x4 acc[2][4];
#pragma unroll
    for (int i = 0; i < 2; ++i)
#pragma unroll
        for (int j = 0; j < 4; ++j) acc[i][j] = (f32x4){0.f, 0.f, 0.f, 0.f};
    const int fo = l15 * 128 + ((q ^ (l15 & 7)) << 4);
#pragma unroll
    for (int kk = 0; kk < 2; ++kk)
#pragma unroll
        for (int ks = 0; ks < 2; ++ks) {
            bf16x8 hf[2], wf[4];
#pragma unroll
            for (int i = 0; i < 2; ++i) hf[i] = *(const bf16x8*)(smem + kk * 16384 + (((wave * 32 + i * 16) * 128 + fo) ^ (ks << 6)));
#pragma unroll
            for (int j = 0; j < 4; ++j) wf[j] = *(const bf16x8*)(smem + 32768 + kk * 8192 + ((j * 2048 + fo) ^ (ks << 6)));
#pragma unroll
            for (int i = 0; i < 2; ++i)
#pragma unroll
                for (int j = 0; j < 4; ++j) acc[i][j] = __builtin_amdgcn_mfma_f32_16x16x32_bf16(wf[j], hf[i], acc[i][j], 0, 0, 0);
        }
#pragma unroll
    for (int i = 0; i < 2; ++i) {
        const int row = rt * 128 + wave * 32 + i * 16 + l15; const int n = row & 255, bg = row >> 8;
#pragma unroll
        for (int j = 0; j < 4; ++j) {
            const int d0 = j * 16 + 4 * q; const f32x4 a = acc[i][j];
            if (which == 0) *(u32x2*)(KCb + (size_t)row * 64 + d0) = (u32x2){pack2bf(a[0], a[1]), pack2bf(a[2], a[3])};
            else {
                const int pos = (n & ~31) + vt_perm(n & 31);
#pragma unroll
                for (int r = 0; r < 4; ++r) VCT[((size_t)bg * 64 + d0 + r) * 256 + pos] = f2bf(a[r]);
            }
        }
    }
    __syncthreads();
}

DI void win_item(const bf16* __restrict__ P2, const bf16* __restrict__ VTw, bf16* __restrict__ OW, int item, char* smem) {
    constexpr int NQT = ANQT_WIN;
    int b, g, t0; attn_item_decode<16 * NQT>(item, b, g, t0);
    const int lane = TIDX & 63, wave = TIDX >> 6, q = lane >> 4, l15 = lane & 15;
    const size_t mbase = (size_t)b * T + t0; const int hbase = g * 4, h = hbase + (l15 & 3);
    bf16x8 qf[NQT][2]; attn_load_q<NQT>(qf, P2, LDP2, mbase, hbase);
    AttnStateT<NQT> st; attn_init<NQT>(st, at::M_INIT, 0.f);
    const int lo = t0 - 511 < 0 ? 0 : (t0 - 511) >> 6, hi = (t0 + 16 * NQT - 1) >> 6;
    const unsigned long long nosel[NQT] = {};
    attn_blocks<AM_WIN, NQT>(st, qf, P2 + (size_t)b * T * LDP2 + 1792 + g * 64, LDP2, VTw + (size_t)(b * G + g) * 64 * T, T, t0, range_mask(lo, hi), hbase, nosel, smem);
#pragma unroll
    for (int qt = 0; qt < NQT; ++qt) {
        const float li = attn_linv(st.lacc[qt]); const size_t m = mbase + wave * (4 * NQT) + qt * 4 + (l15 >> 2);
#pragma unroll
        for (int dt = 0; dt < 4; ++dt) { const f32x4 o = st.o[qt][dt]; *(u32x2*)(OW + m * D + h * 64 + dt * 16 + 4 * q) = (u32x2){pack2bf(o[0] * li, o[1] * li), pack2bf(o[2] * li, o[3] * li)}; }
    }
}

DI void cmpsel_item(const bf16* __restrict__ P2, const bf16* __restrict__ KCb, const bf16* __restrict__ VCT, bf16* __restrict__ OC, unsigned long long* __restrict__ SELM, int item, char* smem) {
    int b, g, t0; attn_item_decode<32>(item, b, g, t0);
    const int tid = TIDX, lane = tid & 63, wave = tid >> 6, q = lane >> 4, l15 = lane & 15;
    const size_t mbase = (size_t)b * T + t0; const int hbase = g * 4, h = hbase + (l15 & 3);
    float* impL = (float*)(smem + at::OFF_IMP);
    for (int i = tid; i < 32 * 64; i += NTHREADS) impL[i] = 0.f;
    bf16x8 qf[2][2]; attn_load_q<2>(qf, P2, LDP2, mbase, hbase);
    AttnStateT<2> st; attn_init<2>(st, at::M_INIT, 0.f);
    const int nvmax = (t0 + 31 - 31) / 16 + 1;
    const int hi = (nvmax - 1) >> 6;
    const bf16* Kp = KCb + (size_t)(b * G + g) * 256 * 64; const bf16* Vp = VCT + (size_t)(b * G + g) * 64 * 256;
    const unsigned long long nosel[2] = {0ull, 0ull};
    attn_blocks<AM_CMP, 2>(st, qf, Kp, 64, Vp, 256, t0, range_mask(0, hi), hbase, nosel, smem);
    float linv[2];
#pragma unroll
    for (int qt = 0; qt < 2; ++qt) {
        linv[qt] = attn_linv(st.lacc[qt]); const size_t m = mbase + wave * 8 + qt * 4 + (l15 >> 2);
#pragma unroll
        for (int dt = 0; dt < 4; ++dt) { const f32x4 o = st.o[qt][dt]; *(u32x2*)(OC + m * D + h * 64 + dt * 16 + 4 * q) = (u32x2){pack2bf(o[0] * linv[qt], o[1] * linv[qt]), pack2bf(o[2] * linv[qt], o[3] * linv[qt])}; }
    }
    {
        const int tq0 = t0 + wave * 8 + (l15 >> 2);
        const bf16* kp0 = Kp + (size_t)l15 * 64 + q * 8;
        bf16x8 kfA[4][2], kfB[4][2];
#define CS_LOADK(dst_, kb_) { _Pragma("unroll") for (int kt = 0; kt < 4; ++kt) _Pragma("unroll") for (int ks = 0; ks < 2; ++ks) \
            dst_[kt][ks] = *(const bf16x8*)(kp0 + (size_t)((kb_) * 64 + kt * 16) * 64 + ks * 32); }
#define CS_QSUM(x_) { x_ += __builtin_bit_cast(float, __builtin_amdgcn_update_dpp(0, __builtin_bit_cast(int, x_), 0xB1, 0xf, 0xf, false)); \
                      x_ += __builtin_bit_cast(float, __builtin_amdgcn_update_dpp(0, __builtin_bit_cast(int, x_), 0x4E, 0xf, 0xf, false)); }
#define CS_BLOCK(kf_, kb_) { const int kbi = (kb_); \
            f32x4 s[2][4]; \
            _Pragma("unroll") for (int qt = 0; qt < 2; ++qt) _Pragma("unroll") for (int kt = 0; kt < 4; ++kt) s[qt][kt] = (f32x4){0.f, 0.f, 0.f, 0.f}; \
            _Pragma("unroll") for (int kt = 0; kt < 4; ++kt) _Pragma("unroll") for (int ks = 0; ks < 2; ++ks) { \
                s[0][kt] = __builtin_amdgcn_mfma_f32_16x16x32_bf16(kf_[kt][ks], qf[0][ks], s[0][kt], 0, 0, 0); \
                s[1][kt] = __builtin_amdgcn_mfma_f32_16x16x32_bf16(kf_[kt][ks], qf[1][ks], s[1][kt], 0, 0, 0); } \
            const bool allvis = 16 * (kbi * 64 + 63) + 31 <= t0;         \
            _Pragma("unroll") for (int qt = 0; qt < 2; ++qt) { \
                const int tq = tq0 + 4 * qt; const int tl = wave * 8 + qt * 4 + (l15 >> 2); \
                _Pragma("unroll") for (int kt = 0; kt < 4; ++kt) { \
                    float pr[4]; \
                    _Pragma("unroll") for (int r = 0; r < 4; ++r) { const int key = kbi * 64 + kt * 16 + 4 * q + r; \
                        const float e = fast_exp2(s[qt][kt][r] - st.m[qt]) * linv[qt]; pr[r] = (allvis || 16 * key + 31 <= tq) ? e : 0.f; } \
                    float s4 = (pr[0] + pr[1]) + (pr[2] + pr[3]), s1 = pr[3]; \
                    CS_QSUM(s4); CS_QSUM(s1); \
                    const int s0 = kbi * 16 + kt * 4 + q; \
                    if ((l15 & 3) == 0) { atomicAdd(&impL[tl * 64 + s0], s4); if (s0 + 1 < 64) atomicAdd(&impL[tl * 64 + s0 + 1], s1); } \
                } \
            } }
        CS_LOADK(kfA, 0);
        for (int kb = 0; kb <= hi; kb += 2) {
            if (kb + 1 <= hi) CS_LOADK(kfB, kb + 1);
            CS_BLOCK(kfA, kb);
            if (kb + 1 > hi) break;
            if (kb + 2 <= hi) CS_LOADK(kfA, kb + 2);
            CS_BLOCK(kfB, kb + 1);
        }
#undef CS_LOADK
#undef CS_QSUM
#undef CS_BLOCK
        __syncthreads();
    }
    {
        const int tl = tid >> 3, sg = tid & 7; const int t = t0 + tl, cur = t >> 6; float* row = impL + tl * 64;
        unsigned hk[8]; unsigned long long mine[8];
#pragma unroll
        for (int j = 0; j < 8; ++j) { const int s = sg * 8 + j; const float v = row[s];
            hk[j] = (s == 0 || s == cur || s == cur - 1) ? 0x7F800000u : (s * 64 > t ? 0u : (v > 0.f ? __float_as_uint(v) + 1u : 1u));
            mine[j] = ((unsigned long long)hk[j] << 32) | (unsigned)(63 - s); }
        __syncthreads();
#pragma unroll
        for (int j = 0; j < 8; ++j) ((unsigned*)row)[sg * 8 + j] = hk[j];
        __syncthreads();
        int rank[8] = {0, 0, 0, 0, 0, 0, 0, 0};
        const int ns4 = ((((t0 + 31) >> 6) >> 2) + 2) & ~1;
#pragma unroll 2
        for (int s4 = 0; s4 < ns4; ++s4) {
            const u32x4 v4 = *(const u32x4*)(row + s4 * 4);
#pragma unroll
            for (int e = 0; e < 4; ++e) { const unsigned long long kv = ((unsigned long long)v4[e] << 32) | (unsigned)(63 - (s4 * 4 + e));
#pragma unroll
                for (int j = 0; j < 8; ++j) rank[j] += kv > mine[j] ? 1 : 0; }
        }
        unsigned long long bits = 0ull;
#pragma unroll
        for (int j = 0; j < 8; ++j) if (rank[j] < KTOP && (sg * 8 + j) * 64 <= t) bits |= 1ull << (sg * 8 + j);
        unsigned lo = (unsigned)bits, hi2 = (unsigned)(bits >> 32);
#pragma unroll
        for (int o = 1; o < 8; o <<= 1) { lo |= __shfl_xor(lo, o); hi2 |= __shfl_xor(hi2, o); }
        if (sg == 0) SELM[(mbase + tl) * 4 + g] = ((unsigned long long)hi2 << 32) | lo;
    }
    __syncthreads();
}

DI void sel_item(const bf16* __restrict__ P2, const bf16* __restrict__ VTs, const unsigned long long* __restrict__ SELM, const bf16* __restrict__ OC, const bf16* __restrict__ OW,
                 bf16* __restrict__ AO, int item, char* smem) {
    constexpr int NQT = ANQT_SEL;
    int b, g, t0; attn_item_decode<16 * NQT>(item, b, g, t0);
    const int tid = TIDX, lane = tid & 63, wave = tid >> 6, q = lane >> 4, l15 = lane & 15;
    const size_t mbase = (size_t)b * T + t0; const int hbase = g * 4, rr = l15 & 3, h = hbase + rr;
    unsigned long long* orw = (unsigned long long*)(smem + at::OFF_X);
    if (tid == 0) *orw = 0ull;
    __syncthreads();
    if (tid < 16 * NQT) atomicOr(orw, SELM[(mbase + tid) * 4 + g]);
    unsigned long long sel[NQT];
#pragma unroll
    for (int qt = 0; qt < NQT; ++qt) sel[qt] = SELM[(mbase + wave * (4 * NQT) + qt * 4 + (l15 >> 2)) * 4 + g];
    bf16x8 qf[NQT][2]; attn_load_q<NQT>(qf, P2, LDP2, mbase, hbase);
    AttnStateT<NQT> st; attn_init<NQT>(st, at::M_INIT, 0.f);
    __syncthreads();
    const unsigned long long todo_v = (*orw) & range_mask(0, (t0 + 16 * NQT - 1) >> 6);
    const unsigned long long todo = ((unsigned long long)(unsigned)__builtin_amdgcn_readfirstlane((int)(todo_v >> 32)) << 32) | (unsigned)__builtin_amdgcn_readfirstlane((int)(unsigned)todo_v);
    attn_blocks<AM_SEL, NQT>(st, qf, P2 + (size_t)b * T * LDP2 + 1536 + g * 64, LDP2, VTs + (size_t)(b * G + g) * 64 * T, T, t0, todo, hbase, sel, smem);
#pragma unroll
    for (int qt = 0; qt < NQT; ++qt) {
        const float li = attn_linv(st.lacc[qt]); const size_t m = mbase + wave * (4 * NQT) + qt * 4 + (l15 >> 2);
        const bf16* gr = P2 + m * LDP2 + 3072;
        const float g0 = sigmoidf_(bf2f(gr[0 * 16 + h])), g1 = sigmoidf_(bf2f(gr[1 * 16 + h])), g2 = sigmoidf_(bf2f(gr[2 * 16 + h]));
#pragma unroll
        for (int dt = 0; dt < 4; ++dt) {
            const int d0 = dt * 16 + 4 * q; const size_t oi = m * D + h * 64 + d0;
            const u32x2 zz = *(const u32x2*)(P2 + m * LDP2 + 2048 + h * 64 + d0), cc = *(const u32x2*)(OC + oi), ww = *(const u32x2*)(OW + oi);
            const f32x4 o = st.o[qt][dt];
            const float r0 = (g0 * bflo(cc[0]) + g1 * o[0] * li + g2 * bflo(ww[0])) * siluf_(bflo(zz[0]));
            const float r1 = (g0 * bfhi(cc[0]) + g1 * o[1] * li + g2 * bfhi(ww[0])) * siluf_(bfhi(zz[0]));
            const float r2 = (g0 * bflo(cc[1]) + g1 * o[2] * li + g2 * bflo(ww[1])) * siluf_(bflo(zz[1]));
            const float r3 = (g0 * bfhi(cc[1]) + g1 * o[3] * li + g2 * bfhi(ww[1])) * siluf_(bfhi(zz[1]));
            *(u32x2*)(AO + oi) = (u32x2){pack2bf(r0, r1), pack2bf(r2, r3)};
        }
    }
    __syncthreads();
}

DI void lru_convert_gates(const float* __restrict__ gaw, const float* __restrict__ gxw, bf16* __restrict__ img) {
    for (int i = blockIdx.x * NTHREADS + TIDX; i < 16 * 160 * 96; i += gridDim.x * NTHREADS) {
        const int k = i % 96, n = (i / 96) % 160, blk = i / (96 * 160);
        float v = 0.f;
        if (k < 80) v = n < 80 ? gaw[((size_t)blk * 80 + k) * 80 + n] : gxw[((size_t)blk * 80 + k) * 80 + (n - 80)];
        img[i] = f2bf(v);
    }
}
DI void lru_gate_item(const bf16* __restrict__ P3, const float* __restrict__ cw, const float* __restrict__ cb, const bf16* __restrict__ gimg, const float* __restrict__ gab, const float* __restrict__ gxb,
                      const float* __restrict__ lam, bf16* __restrict__ LA, bf16* __restrict__ BV, float2* __restrict__ SUM, int item, char* smem) {
    const int rt = item >> 4, nb = item & 15; const int tid = TIDX, lane = tid & 63, wave = tid >> 6, q = lane >> 4, l15 = lane & 15;
    const size_t m0 = (size_t)rt * 128;
    for (int id = tid; id < 128 * 12; id += NTHREADS) {
        const int row = id / 12, c12 = id % 12; u32x4 outv = (u32x4){0u, 0u, 0u, 0u};
        if (c12 < 10) {
            const size_t m = m0 + row; const int t = (int)(m % T); const int ch = nb * 80 + c12 * 8;
            float acc[8];
            { const float4 b0 = *(const float4*)(cb + ch), b1 = *(const float4*)(cb + ch + 4); acc[0] = b0.x; acc[1] = b0.y; acc[2] = b0.z; acc[3] = b0.w; acc[4] = b1.x; acc[5] = b1.y; acc[6] = b1.z; acc[7] = b1.w; }
#pragma unroll
            for (int w = 0; w < 4; ++w) {
                if (t - 3 + w >= 0) {
                    const u32x4 uv = *(const u32x4*)(P3 + (m - 3 + w) * 2560 + ch);
                    const float4 w0 = *(const float4*)(cw + w * LW + ch), w1 = *(const float4*)(cw + w * LW + ch + 4);
                    acc[0] += w0.x * bflo(uv[0]); acc[1] += w0.y * bfhi(uv[0]); acc[2] += w0.z * bflo(uv[1]); acc[3] += w0.w * bfhi(uv[1]);
                    acc[4] += w1.x * bflo(uv[2]); acc[5] += w1.y * bfhi(uv[2]); acc[6] += w1.z * bflo(uv[3]); acc[7] += w1.w * bfhi(uv[3]);
                }
            }
            outv = (u32x4){pack2bf(acc[0], acc[1]), pack2bf(acc[2], acc[3]), pack2bf(acc[4], acc[5]), pack2bf(acc[6], acc[7])};
        }
        const int ks = c12 >> 2, c = c12 & 3;
        *(u32x4*)(smem + ks * 8192 + row * 64 + ((c ^ ((row >> 2) & 3)) << 4)) = outv;
    }
    for (int id = tid; id < 160 * 12; id += NTHREADS) {
        const int row = id / 12, c12 = id % 12; const int ks = c12 >> 2, c = c12 & 3;
        *(u32x4*)(smem + 24576 + ks * 10240 + row * 64 + ((c ^ ((row >> 2) & 3)) << 4)) = *(const u32x4*)(gimg + ((size_t)nb * 160 + row) * 96 + c12 * 8);
    }
    __syncthreads();
    f32x4 acc[2][10];
#pragma unroll
    for (int i = 0; i < 2; ++i)
#pragma unroll
        for (int j = 0; j < 10; ++j) acc[i][j] = (f32x4){0.f, 0.f, 0.f, 0.f};
    const int fo = l15 * 64 + ((q ^ ((l15 >> 2) & 3)) << 4);
#pragma unroll
    for (int ks = 0; ks < 3; ++ks) {
        bf16x8 uf[2];
#pragma unroll
        for (int i = 0; i < 2; ++i) uf[i] = *(const bf16x8*)(smem + ks * 8192 + (wave * 32 + i * 16) * 64 + fo);
#pragma unroll
        for (int j = 0; j < 10; ++j) {
            const bf16x8 wf = *(const bf16x8*)(smem + 24576 + ks * 10240 + j * 1024 + fo);
            acc[0][j] = __builtin_amdgcn_mfma_f32_16x16x32_bf16(wf, uf[0], acc[0][j], 0, 0, 0);
            acc[1][j] = __builtin_amdgcn_mfma_f32_16x16x32_bf16(wf, uf[1], acc[1][j], 0, 0, 0);
        }
    }
    __syncthreads();
#pragma unroll
    for (int i = 0; i < 2; ++i) {
        const int row = wave * 32 + i * 16 + l15; const size_t m = m0 + row;
#pragma unroll
        for (int ct = 0; ct < 5; ++ct) {
            const int kcol = ct * 16 + 4 * q; const int ch = nb * 80 + kcol;
            const u32x2 uu = *(const u32x2*)(smem + (kcol >> 5) * 8192 + row * 64 + ((((kcol & 31) >> 3) ^ ((row >> 2) & 3)) << 4) + (kcol & 7) * 2);
            const float uc[4] = {bflo(uu[0]), bfhi(uu[0]), bflo(uu[1]), bfhi(uu[1])};
            const float4 ba = *(const float4*)(gab + ch), bx = *(const float4*)(gxb + ch), lm = *(const float4*)(lam + ch);
            const float bav[4] = {ba.x, ba.y, ba.z, ba.w}, bxv[4] = {bx.x, bx.y, bx.z, bx.w}, lmv[4] = {lm.x, lm.y, lm.z, lm.w};
            float la[4], bv[4];
#pragma unroll
            for (int r = 0; r < 4; ++r) {
                const float rg = __builtin_amdgcn_rcpf(1.0f + __expf(-(acc[i][ct][r] + bav[r]))), ig = __builtin_amdgcn_rcpf(1.0f + __expf(-(acc[i][ct + 5][r] + bxv[r])));
                la[r] = rg * lmv[r];
                const float om = 1.0f - __expf(2.0f * la[r]);
                bv[r] = __builtin_amdgcn_sqrtf(om > 0.f ? om : 0.f) * (ig * uc[r]);
            }
            const u32x2 lav = {pack2bf(la[0], la[1]), pack2bf(la[2], la[3])}, bvv = {pack2bf(bv[0], bv[1]), pack2bf(bv[2], bv[3])};
            *(u32x2*)(LA + m * LW + ch) = lav; *(u32x2*)(BV + m * LW + ch) = bvv;
            *(u32x2*)(smem + 24576 + (row * 80 + kcol) * 2) = lav; *(u32x2*)(smem + 24576 + 20480 + (row * 80 + kcol) * 2) = bvv;
        }
    }
    __syncthreads();
    if (tid < 160) {
        const int cidx = tid / 80, c = tid % 80; const bf16* li = (const bf16*)(smem + 24576) + (cidx * 64) * 80 + c; const bf16* bi = li + 10240;
        float sla = 0.f, h = 0.f;
#pragma unroll 8
        for (int t = 0; t < 64; ++t) { const float la = bf2f(li[t * 80]), bvv = bf2f(bi[t * 80]); h = __expf(la) * h + bvv; sla += la; }
        const size_t mc = m0 + cidx * 64; const int bb = (int)(mc / T), jj = (int)(mc % T) / 64;
        SUM[((size_t)bb * (T / 64) + jj) * LW + nb * 80 + c] = make_float2(__expf(sla), h);
    }
    __syncthreads();
}
DI void lru_scan2_item(const bf16* __restrict__ LA, const bf16* __restrict__ BV, const float2* __restrict__ SUM, const bf16* __restrict__ P3, bf16* __restrict__ AO, int item) {
    const int cg = item % 5, j = (item / 5) % (T / 64), b = item / (5 * (T / 64)); const int c = cg * 256 + TIDX;
    float h = 0.f;
    for (int jj = 0; jj < j; ++jj) { const float2 s = SUM[((size_t)b * (T / 64) + jj) * LW + c]; h = s.x * h + s.y; }
    const size_t m0 = (size_t)b * T + j * 64;
#pragma unroll 8
    for (int t = 0; t < 64; ++t) {
        const float la = bf2f(LA[(m0 + t) * LW + c]); const float bv = bf2f(BV[(m0 + t) * LW + c]); const float z = bf2f(P3[(m0 + t) * 2560 + LW + c]);
        h = __expf(la) * h + bv; AO[(m0 + t) * LW + c] = f2bf(h * siluf_(z));
    }
}

struct ALoadF32 {
    const float* A;
    static constexpr bool DMA = false;
    DI const bf16* src(int, int) const { return nullptr; }
    struct Raw { float4 a, b; };
    DI Raw load(int m, int k) const { Raw r; r.a = *(const float4*)(A + (size_t)m * 64 + k); r.b = *(const float4*)(A + (size_t)m * 64 + k + 4); return r; }
    DI u32x4 finish(const Raw& r, int, int) const { return (u32x4){pack2bf(r.a.x, r.a.y), pack2bf(r.a.z, r.a.w), pack2bf(r.b.x, r.b.y), pack2bf(r.b.z, r.b.w)}; }
};
struct EpiLora {
    const float* w0; const float* a0; bf16* WL; bf16* AV;
    DI void operator()(int m, int n, const float* v, int, int) const {
        float w[8];
        if (n < 1024) {
#pragma unroll
            for (int j = 0; j < 8; ++j) w[j] = -0.60653065971f * __builtin_amdgcn_rcpf(1.0f + __expf(-(w0[n + j] + v[j])));
            store8bf(WL + (size_t)m * D + n, w);
        } else {
#pragma unroll
            for (int j = 0; j < 8; ++j) w[j] = __builtin_amdgcn_rcpf(1.0f + __expf(-(a0[n - 1024 + j] + v[j])));
            store8bf(AV + (size_t)m * D + n - 1024, w);
        }
    }
    DI void finish(int, int, int, int, int) const {}
    DI void finish_wide(int, int, int, int, int) const {}
};
DI float dpp_sum16(float x) {
    x += __builtin_bit_cast(float, __builtin_amdgcn_update_dpp(0, __builtin_bit_cast(int, x), 0xB1, 0xf, 0xf, false));
    x += __builtin_bit_cast(float, __builtin_amdgcn_update_dpp(0, __builtin_bit_cast(int, x), 0x4E, 0xf, 0xf, false));
    x += __builtin_bit_cast(float, __builtin_amdgcn_update_dpp(0, __builtin_bit_cast(int, x), 0x141, 0xf, 0xf, false));
    x += __builtin_bit_cast(float, __builtin_amdgcn_update_dpp(0, __builtin_bit_cast(int, x), 0x140, 0xf, 0xf, false));
    return x;
}
constexpr int RW_NCH = T / 16;
DI void rwkv_prep_item(bf16* __restrict__ P, bf16* __restrict__ WL, bf16* __restrict__ AV, const float* __restrict__ k_k, const float* __restrict__ k_a, const float* __restrict__ r_k,
                       float* __restrict__ G15, bf16* __restrict__ M2g, bf16* __restrict__ M3g, float* __restrict__ BON, int item, char* smem) {
    const int c = item % RW_NCH, h = (item / RW_NCH) & 15, b = item / (RW_NCH * 16);
    const int tid = TIDX, t = tid >> 4, jq = tid & 15, j0 = jq * 4;
    const size_t m0 = (size_t)b * T + c * 16, m = m0 + t; const size_t ch = (size_t)(b * 16 + h) * RW_NCH + c;
    float* sA = (float*)smem; float* sR = sA + 16 * 68; float* sB = sR + 16 * 68; float* sK = sB + 16 * 68; float* sW = sK + 16 * 68; float* sWl = sW + 16 * 68;
    float* mAab = sWl + 16 * 64; float* mAak = mAab + 16 * 17; float* mArb = mAak + 16 * 17; float* mArk = mArb + 16 * 17; float* mTin = mArk + 16 * 17; float* mM2 = mTin + 16 * 17;
    const u32x2 r2 = *(const u32x2*)(P + m * 4096 + h * 64 + j0), k2 = *(const u32x2*)(P + m * 4096 + 1024 + h * 64 + j0), a2 = *(const u32x2*)(AV + m * D + h * 64 + j0), w2 = *(const u32x2*)(WL + m * D + h * 64 + j0);
    const float rr[4] = {bflo(r2[0]), bfhi(r2[0]), bflo(r2[1]), bfhi(r2[1])}, kr[4] = {bflo(k2[0]), bfhi(k2[0]), bflo(k2[1]), bfhi(k2[1])},
                av[4] = {bflo(a2[0]), bfhi(a2[0]), bflo(a2[1]), bfhi(a2[1])}, wl[4] = {bflo(w2[0]), bfhi(w2[0]), bflo(w2[1]), bfhi(w2[1])};
    const float4 kk4 = *(const float4*)(k_k + h * 64 + j0), ka4 = *(const float4*)(k_a + h * 64 + j0), rk4 = *(const float4*)(r_k + h * 64 + j0);
    const float kkc[4] = {kk4.x, kk4.y, kk4.z, kk4.w}, kac[4] = {ka4.x, ka4.y, ka4.z, ka4.w}, rkc[4] = {rk4.x, rk4.y, rk4.z, rk4.w};
    float kkv[4], n2 = 0.f;
#pragma unroll
    for (int e = 0; e < 4; ++e) { kkv[e] = kr[e] * kkc[e]; n2 += kkv[e] * kkv[e]; }
    n2 = dpp_sum16(n2);
    float nr = sqrtf(n2); nr = nr > 1e-12f ? nr : 1e-12f; const float inr = 1.0f / nr;
    float aa[4], bb[4], kp[4], bon = 0.f;
#pragma unroll
    for (int e = 0; e < 4; ++e) { const float kn = kkv[e] * inr; aa[e] = -kn; bb[e] = kn * av[e]; kp[e] = kr[e] * (1.0f + (av[e] - 1.0f) * kac[e]); bon += rr[e] * kp[e] * rkc[e]; }
    bon = dpp_sum16(bon);
    if (jq == 0) BON[m * 16 + h] = bon;
    *(float4*)(sWl + t * 64 + j0) = make_float4(wl[0], wl[1], wl[2], wl[3]);
    __syncthreads();
    float clx[4] = {0.f, 0.f, 0.f, 0.f};
#pragma unroll
    for (int s = 0; s < 15; ++s) { if (s < t) { const float4 w = *(const float4*)(sWl + s * 64 + j0); clx[0] += w.x; clx[1] += w.y; clx[2] += w.z; clx[3] += w.w; } }
    float bt[4];
    {
        float va[4], vr[4], vk[4], gc[4];
#pragma unroll
        for (int e = 0; e < 4; ++e) { const float cl = clx[e] + wl[e]; const float gp = __expf(clx[e]), gi = __expf(-cl); gc[e] = __expf(cl); va[e] = aa[e] * gp; vr[e] = rr[e] * gc[e]; bt[e] = bb[e] * gi; vk[e] = kp[e] * gi; }
        *(float4*)(sA + t * 68 + j0) = make_float4(va[0], va[1], va[2], va[3]); *(float4*)(sR + t * 68 + j0) = make_float4(vr[0], vr[1], vr[2], vr[3]);
        *(float4*)(sB + t * 68 + j0) = make_float4(bt[0], bt[1], bt[2], bt[3]); *(float4*)(sK + t * 68 + j0) = make_float4(vk[0], vk[1], vk[2], vk[3]);
        {
            char* img = (char*)(mM2 + 16 * 17) + t * 128 + (((j0 >> 3) ^ (t & 7)) << 4) + (j0 & 4) * 2;
            *(u32x2*)(img) = (u32x2){pack2bf(va[0], va[1]), pack2bf(va[2], va[3])}; *(u32x2*)(img + 2048) = (u32x2){pack2bf(vr[0], vr[1]), pack2bf(vr[2], vr[3])};
            *(u32x2*)(img + 4096) = (u32x2){pack2bf(bt[0], bt[1]), pack2bf(bt[2], bt[3])}; *(u32x2*)(img + 6144) = (u32x2){pack2bf(vk[0], vk[1]), pack2bf(vk[2], vk[3])};
        }
        if (t == 15) *(float4*)(G15 + ch * 64 + j0) = make_float4(gc[0], gc[1], gc[2], gc[3]);
#pragma unroll
        for (int e = 0; e < 4; ++e) {   }
#pragma unroll
        for (int e = 0; e < 4; ++e) clx[e] = vk[e];
    }
    __syncthreads();
    {
        const int wv = __builtin_amdgcn_readfirstlane(tid >> 6), lane = tid & 63, q = lane >> 4, l15 = lane & 15;
        const char* xb_ = (const char*)(mM2 + 16 * 17) + (wv >> 1) * 2048;
        const char* yb_ = (const char*)(mM2 + 16 * 17) + 4096 + (wv & 1) * 2048;
        f32x4 acc = {0.f, 0.f, 0.f, 0.f};
#pragma unroll
        for (int ks = 0; ks < 2; ++ks) {
            const int off = l15 * 128 + (((ks * 4 + q) ^ (l15 & 7)) << 4);
            const bf16x8 xf = *(const bf16x8*)(xb_ + off), yf = *(const bf16x8*)(yb_ + off);
            acc = __builtin_amdgcn_mfma_f32_16x16x32_bf16(xf, yf, acc, 0, 0, 0);
        }
        float* dst = wv == 0 ? mAab : (wv == 1 ? mAak : (wv == 2 ? mArb : mArk));
        const bool strict = wv < 2;
#pragma unroll
        for (int r = 0; r < 4; ++r) { const int tt = 4 * q + r, ss = l15; dst[tt * 17 + ss] = (strict ? ss < tt : ss <= tt) ? acc[r] : 0.f; }
    }
    __syncthreads();
    if (tid < 16) {
        float col[16];
#pragma unroll
        for (int i = 0; i < 16; ++i) {
            float acc = (i == tid) ? 1.0f : 0.f;
#pragma unroll
            for (int jj = 0; jj < i; ++jj) acc += mAab[i * 17 + jj] * col[jj];
            col[i] = acc; mTin[i * 17 + tid] = acc;
        }
    }
    __syncthreads();
    float wv[4] = {0.f, 0.f, 0.f, 0.f}, m2 = 0.f;
#pragma unroll
    for (int s = 0; s < 16; ++s) { const float ti = mTin[t * 17 + s]; const float4 a4 = *(const float4*)(sA + s * 68 + j0); wv[0] += ti * a4.x; wv[1] += ti * a4.y; wv[2] += ti * a4.z; wv[3] += ti * a4.w; m2 += ti * mAak[s * 17 + jq]; }
    *(float4*)(sW + t * 68 + j0) = make_float4(wv[0], wv[1], wv[2], wv[3]); mM2[t * 17 + jq] = m2;
    __syncthreads();
    float rh[4]; { const float4 r4 = *(const float4*)(sR + t * 68 + j0); rh[0] = r4.x; rh[1] = r4.y; rh[2] = r4.z; rh[3] = r4.w; }
    float m3 = mArk[t * 17 + jq];
#pragma unroll
    for (int s = 0; s < 16; ++s) { const float ar = mArb[t * 17 + s]; const float4 w4 = *(const float4*)(sW + s * 68 + j0); rh[0] += ar * w4.x; rh[1] += ar * w4.y; rh[2] += ar * w4.z; rh[3] += ar * w4.w; m3 += ar * mM2[s * 17 + jq]; }
    *(u32x2*)(WL + m * D + h * 64 + j0) = (u32x2){pack2bf(wv[0], wv[1]), pack2bf(wv[2], wv[3])};
    *(u32x2*)(P + m * 4096 + h * 64 + j0) = (u32x2){pack2bf(rh[0], rh[1]), pack2bf(rh[2], rh[3])};
#pragma unroll
    for (int e = 0; e < 4; ++e) { AV[(m0 + jq) * D + h * 64 + e * 16 + t] = f2bf(bt[e]); P[(m0 + jq) * 4096 + 1024 + h * 64 + e * 16 + t] = f2bf(clx[e]); }
    M2g[ch * 256 + t * 16 + jq] = f2bf(m2); M3g[ch * 256 + t * 16 + jq] = f2bf(m3);
    __syncthreads();
}

#define MFMA32(a, b, c) __builtin_amdgcn_mfma_f32_16x16x32_bf16(__builtin_bit_cast(bf16x8, a), __builtin_bit_cast(bf16x8, b), c, 0, 0, 0)
DI void rwkv_chunk_scan(const bf16* __restrict__ P, const bf16* __restrict__ WL, const bf16* __restrict__ AV, const float* __restrict__ G15, const bf16* __restrict__ M2g, const bf16* __restrict__ M3g,
                        bf16* __restrict__ YS, int bh, char* smem) {
    constexpr int SLOT = 12288, YOFF = 49152;
    const int tid = TIDX, lane = tid & 63, vs = __builtin_amdgcn_readfirstlane(tid >> 6), q = lane >> 4, l15 = lane & 15; const int b = bh >> 4, h = bh & 15;
    const size_t mb = (size_t)b * T; const size_t ch0 = (size_t)(b * 16 + h) * RW_NCH;
    const char *s0, *s1, *s2; size_t d0, d1, d2;
    if (tid < 128) { const int c8 = tid >> 4, t = tid & 15; s0 = (const char*)(WL + (mb + t) * D + h * 64 + c8 * 8); d0 = (size_t)16 * D * 2; }
    else { const int pp = tid - 128, c8 = pp >> 4, t = pp & 15; s0 = (const char*)(P + (mb + t) * 4096 + h * 64 + c8 * 8); d0 = (size_t)16 * 4096 * 2; }
    if (tid < 128) { const int r = tid >> 3, c8 = tid & 7; s1 = (const char*)(P + (mb + r) * 4096 + 1024 + h * 64 + c8 * 8); d1 = (size_t)16 * 4096 * 2; }
    else { const int pp = tid - 128, r = pp >> 3, c8 = pp & 7; s1 = (const char*)(AV + (mb + r) * D + h * 64 + c8 * 8); d1 = (size_t)16 * D * 2; }
    if (tid < 128) { const int r = tid >> 3, c8 = tid & 7; s2 = (const char*)(P + (mb + r) * 4096 + 2048 + h * 64 + c8 * 8); d2 = (size_t)16 * 4096 * 2; }
    else if (tid < 160) { s2 = (const char*)(M2g + ch0 * 256 + (tid - 128) * 8); d2 = 512; }
    else if (tid < 192) { s2 = (const char*)(M3g + ch0 * 256 + (tid - 160) * 8); d2 = 512; }
    else { const int pp = tid < 208 ? tid - 192 : 0; s2 = (const char*)(G15 + ch0 * 64 + pp * 4); d2 = 256; }
    const int dma_off = vs * 1024;
#define RW_DMA(c_) { char* dst = smem + ((c_) & 3) * SLOT + dma_off; GLDS16(s0 + (size_t)(c_) * d0, dst); GLDS16(s1 + (size_t)(c_) * d1, dst + 4096); GLDS16(s2 + (size_t)(c_) * d2, dst + 8192); }
#define RW_BARRIER() { asm volatile("s_waitcnt lgkmcnt(0)" ::: "memory"); __builtin_amdgcn_s_barrier(); asm volatile("" ::: "memory"); }
    f32x4 H0 = {0.f, 0.f, 0.f, 0.f}, H1 = H0, H2 = H0, H3 = H0;
    const int oW = (((q >> 1)) * 16 + l15) * 16 + (q & 1) * 8;
    const int oK = 4096 + ((l15 >> 2) * 8 + (l15 & 3) * 2 + (q >> 1)) * 16 + (q & 1) * 8;
    const int oM = 10240 + l15 * 32 + q * 8;
    const int oV = 8192 + (4 * q) * 128 + (vs * 16 + l15) * 2;
    const int oG = 11264 + (4 * q) * 4;
    const int oY = YOFF + ((4 * q) * 64 + vs * 16 + l15) * 2;
    RW_DMA(0); RW_DMA(1); RW_DMA(2);
    asm volatile("s_waitcnt vmcnt(6)" ::: "memory");
    RW_BARRIER();
    for (int c = 0; c < RW_NCH; ++c) {
        if (c + 3 < RW_NCH) RW_DMA(c + 3);
        const char* sl = smem + (c & 3) * SLOT;
        {
            const f32x4 z4 = {0.f, 0.f, 0.f, 0.f};
            const u32x4 Hb0 = {pack2bf(H0[0], H0[1]), pack2bf(H0[2], H0[3]), pack2bf(H1[0], H1[1]), pack2bf(H1[2], H1[3])};
            const u32x4 Hb1 = {pack2bf(H2[0], H2[1]), pack2bf(H2[2], H2[3]), pack2bf(H3[0], H3[1]), pack2bf(H3[2], H3[3])};
            const unsigned v0 = *(const bf16*)(sl + oV), v1 = *(const bf16*)(sl + oV + 128), v2 = *(const bf16*)(sl + oV + 256), v3 = *(const bf16*)(sl + oV + 384);
            const unsigned v01 = v0 | (v1 << 16), v23 = v2 | (v3 << 16);
            const u32x4 Vlo = {v01, v23, 0u, 0u};
            const u32x2 m2 = *(const u32x2*)(sl + oM), m3 = *(const u32x2*)(sl + oM + 512);
            const u32x2 w0 = *(const u32x2*)(sl + oW), w1 = *(const u32x2*)(sl + oW + 512), w2 = *(const u32x2*)(sl + oW + 1024), w3 = *(const u32x2*)(sl + oW + 1536);
            const u32x2 r0 = *(const u32x2*)(sl + 2048 + oW), r1 = *(const u32x2*)(sl + 2048 + oW + 512), r2 = *(const u32x2*)(sl + 2048 + oW + 1024), r3 = *(const u32x2*)(sl + 2048 + oW + 1536);
            f32x4 U = MFMA32(((u32x4){m2[0], m2[1], 0u, 0u}), Vlo, z4);
            U = MFMA32(((u32x4){w0[0], w0[1], w1[0], w1[1]}), Hb0, U); U = MFMA32(((u32x4){w2[0], w2[1], w3[0], w3[1]}), Hb1, U);
            f32x4 Y = MFMA32(((u32x4){m3[0], m3[1], 0u, 0u}), Vlo, z4);
            Y = MFMA32(((u32x4){r0[0], r0[1], r1[0], r1[1]}), Hb0, Y); Y = MFMA32(((u32x4){r2[0], r2[1], r3[0], r3[1]}), Hb1, Y);
            const u32x4 VU = {v01, v23, pack2bf(U[0], U[1]), pack2bf(U[2], U[3])};
            const u32x2 k0 = *(const u32x2*)(sl + oK), k1 = *(const u32x2*)(sl + oK + 512), k2 = *(const u32x2*)(sl + oK + 1024), k3 = *(const u32x2*)(sl + oK + 1536);
            const u32x2 b0 = *(const u32x2*)(sl + 2048 + oK), b1 = *(const u32x2*)(sl + 2048 + oK + 512), b2 = *(const u32x2*)(sl + 2048 + oK + 1024), b3 = *(const u32x2*)(sl + 2048 + oK + 1536);
            const f32x4 g0 = *(const f32x4*)(sl + oG), g1 = *(const f32x4*)(sl + oG + 64), g2 = *(const f32x4*)(sl + oG + 128), g3 = *(const f32x4*)(sl + oG + 192);
            const f32x4 a0 = MFMA32(((u32x4){k0[0], k0[1], b0[0], b0[1]}), VU, H0), a1 = MFMA32(((u32x4){k1[0], k1[1], b1[0], b1[1]}), VU, H1);
            const f32x4 a2 = MFMA32(((u32x4){k2[0], k2[1], b2[0], b2[1]}), VU, H2), a3 = MFMA32(((u32x4){k3[0], k3[1], b3[0], b3[1]}), VU, H3);
            H0 = a0 * g0; H1 = a1 * g1; H2 = a2 * g2; H3 = a3 * g3;
            char* yb = smem + oY + (c & 7) * 2048;
#pragma unroll
            for (int r = 0; r < 4; ++r) *(bf16*)(yb + r * 128) = f2bf(Y[r]);
        }
        const bool flush = (c & 7) == 7;
        if (flush) {
            RW_BARRIER();
            u32x4 yv[4];
#pragma unroll
            for (int k = 0; k < 4; ++k) yv[k] = *(const u32x4*)(smem + YOFF + (tid + 256 * k) * 16);
#pragma unroll
            for (int k = 0; k < 4; ++k) { const int pc = tid + 256 * k, rr = pc >> 3, c8 = pc & 7; *(u32x4*)(YS + (mb + (size_t)(c - 7) * 16 + rr) * D + h * 64 + c8 * 8) = yv[k]; }
            asm volatile("s_waitcnt vmcnt(0)" ::: "memory");
        } else if (c + 3 < RW_NCH) { asm volatile("s_waitcnt vmcnt(6)" ::: "memory"); }
        else if (c + 2 < RW_NCH) { asm volatile("s_waitcnt vmcnt(3)" ::: "memory"); }
        else { asm volatile("s_waitcnt vmcnt(0)" ::: "memory"); }
        RW_BARRIER();
    }
#undef RW_DMA
#undef RW_BARRIER
}
DI void rwkv_gn_rows2(const bf16* __restrict__ P, const float* __restrict__ BON, const float* __restrict__ lnw, const float* __restrict__ lnb, bf16* __restrict__ YS) {
    const int tid = TIDX, lane = tid & 63, wave = tid >> 6; const int c = wave * 256 + lane * 4;
    const float4 lw = *(const float4*)(lnw + c), lb = *(const float4*)(lnb + c);
    for (size_t m = blockIdx.x; m < (size_t)M; m += gridDim.x) {
        const u32x2 yy = *(const u32x2*)(YS + m * D + c), vv = *(const u32x2*)(P + m * 4096 + 2048 + c), zz = *(const u32x2*)(P + m * 4096 + 3072 + c);
        const float bs = BON[m * 16 + (c >> 6)];
        const float y[4] = {bflo(yy[0]), bfhi(yy[0]), bflo(yy[1]), bfhi(yy[1])}, v[4] = {bflo(vv[0]), bfhi(vv[0]), bflo(vv[1]), bfhi(vv[1])}, z[4] = {bflo(zz[0]), bfhi(zz[0]), bflo(zz[1]), bfhi(zz[1])};
        const float lwv[4] = {lw.x, lw.y, lw.z, lw.w}, lbv[4] = {lb.x, lb.y, lb.z, lb.w};
        const float mean = dpp_sum16((y[0] + y[1]) + (y[2] + y[3])) * (1.0f / 64.0f);
        float var = 0.f;
#pragma unroll
        for (int i = 0; i < 4; ++i) { const float d = y[i] - mean; var += d * d; }
        var = dpp_sum16(var) * (1.0f / 64.0f);
        const float rstd = 1.0f / sqrtf(var + 64e-5f);
        float o[4];
#pragma unroll
        for (int i = 0; i < 4; ++i) o[i] = ((y[i] - mean) * rstd * lwv[i] + lbv[i] + bs * v[i]) * siluf_(z[i]);
        *(u32x2*)(YS + m * D + c) = (u32x2){pack2bf(o[0], o[1]), pack2bf(o[2], o[3])};
    }
}

struct FastBufs { char* ws; };

DI void rows_xb_parts(const float* __restrict__ x, bf16* xb, float* parts) {
    const int lane = TIDX & 63, wave = TIDX >> 6;
    for (int m = blockIdx.x * 4 + wave; m < M; m += gridDim.x * 4) {
        const float* xr = x + (size_t)m * D; float s = 0.f;
#pragma unroll
        for (int i = 0; i < 2; ++i) {
            const int k = (i * 64 + lane) * 8; const float4 a = *(const float4*)(xr + k), b = *(const float4*)(xr + k + 4);
            const float w[8] = {a.x, a.y, a.z, a.w, b.x, b.y, b.z, b.w};
#pragma unroll
            for (int j = 0; j < 8; ++j) s += w[j] * w[j];
            store8bf(xb + (size_t)m * D + k, w);
        }
#pragma unroll
        for (int o = 32; o >= 1; o >>= 1) s += __shfl_xor(s, o);
        if (lane < 16) parts[(size_t)m * 16 + lane] = lane == 0 ? s : 0.f;
    }
}
DI void rows_xn(const float* __restrict__ x, const float* parts, const float* __restrict__ g, bf16* xn) {
    const int lane = TIDX & 63, wave = TIDX >> 6;
    for (int m = blockIdx.x * 4 + wave; m < M; m += gridDim.x * 4) {
        const float rs = rstd_from_parts(parts, m); const float* xr = x + (size_t)m * D;
#pragma unroll
        for (int i = 0; i < 2; ++i) {
            const int k = (i * 64 + lane) * 8; const float4 a = *(const float4*)(xr + k), b = *(const float4*)(xr + k + 4);
            const float4 ga = *(const float4*)(g + k), gb = *(const float4*)(g + k + 4);
            const float w[8] = {a.x * rs * ga.x, a.y * rs * ga.y, a.z * rs * ga.z, a.w * rs * ga.w, b.x * rs * gb.x, b.y * rs * gb.y, b.z * rs * gb.z, b.w * rs * gb.w};
            store8bf(xn + (size_t)m * D + k, w);
        }
    }
}
DI void rows_final(float* x, const float* parts, const float* __restrict__ g) {
    const int lane = TIDX & 63, wave = TIDX >> 6;
    for (int m = blockIdx.x * 4 + wave; m < M; m += gridDim.x * 4) {
        const float rs = rstd_from_parts(parts, m); float* xr = x + (size_t)m * D;
#pragma unroll
        for (int i = 0; i < 4; ++i) {
            const int k = (i * 64 + lane) * 4; float4 a = *(float4*)(xr + k); const float4 ga = *(const float4*)(g + k);
            a.x *= rs * ga.x; a.y *= rs * ga.y; a.z *= rs * ga.z; a.w *= rs * ga.w; *(float4*)(xr + k) = a;
        }
    }
}
enum { PH_PREP0 = 0, PH_IN0, PH_ATTN0, PH_OUT0, PH_PREP1, PH_IN1, PH_LORA1, PH_CPREP1, PH_SCAN1, PH_GN1, PH_OUT1, PH_PREP2, PH_IN2, PH_B2, PH_C2, PH_D2, PH_OUT2, PH_PREP3, PH_IN3, PH_GATE3, PH_SCANA3, PH_SCANB3, PH_OUT3, PH_FINAL };

namespace wbo {
constexpr size_t IN = 0;
constexpr size_t OUT = (size_t)4352 * 1024;
constexpr size_t EXTRA = OUT + (size_t)1280 * 1024;
}

template <int PH>
DI void run_phase(const Params& p, char* smem) {
    char* ws = p.ws;
    float* parts = (float*)(ws + fw::PARTS);
    constexpr int LAYER = PH <= PH_OUT0 ? 0 : PH <= PH_OUT1 ? 1 : PH <= PH_OUT2 ? 2 : 3;
    constexpr size_t WBOFF = LAYER == 0 ? 200 * fw::MB : LAYER == 1 ? 238 * fw::MB : LAYER == 2 ? 240 * fw::MB : 1 * fw::MB;
    bf16* WB = (bf16*)(ws + WBOFF);
    bf16* XB = (bf16*)(ws + ((PH == PH_PREP0 || PH == PH_IN0) ? 130 * fw::MB : 174 * fw::MB));
    bf16* P = (bf16*)(ws + wsl::P);
    float* X = p.out;
    float* smf = (float*)smem;
    if (PH == PH_PREP0) {
        rows_xb_parts(p.x, XB, parts);
        int tb = 0;
        convert_seg(p.a_w_in, A_COLS, 0, A_COLS, 1024, WB + wbo::IN, p.norm_g + 0 * D, smf, tb);
        convert_seg(p.a_w_out, 1024, 0, 1024, 1024, WB + wbo::OUT, nullptr, smf, tb);
    } else if (PH == PH_IN0) {
        gemm_sched(8, 4, [&](bool big, int mt, int nt) {
            if (big) gemm_tile2(ALoadPlain{XB, D}, WB + wbo::IN, 1024, mt * 128, nt * 256, EpiL0{P, (bf16*)(ws + 86 * fw::MB), parts}, smem);
            else gemm_tile(ALoadPlain{XB, D}, WB + wbo::IN, 1024, mt * 128, 2048 + nt * 128, EpiL0{P, (bf16*)(ws + 86 * fw::MB), parts}, smem);
        });
    } else if (PH == PH_ATTN0) {
        build_bias_lut(p.t5, smem, true);
        for (int it = blockIdx.x; it < B * G * (T / (16 * ANQT_SWA)); it += gridDim.x) swa_item(P, (const bf16*)(ws + 86 * fw::MB), p.a_sinks, (bf16*)(ws + wsl::L0_AO), it, smem);
    } else if (PH == PH_OUT0) {
        gemm_sched(4, 0, [&](bool, int mt, int nt) { gemm_tile2(ALoadPlain{(const bf16*)(ws + wsl::L0_AO), D}, WB + wbo::OUT, 1024, mt * 128, nt * 256, EpiResid{p.x, X, nullptr, parts}, smem); });
    } else if (PH == PH_PREP1) {
        rows_xn(X, parts, p.norm_g + 1 * D, (bf16*)(ws + wsl::L1_XN));
        int tb = 0;
        convert_seg(p.b_w_in, 4096, 0, 4096, 1024, WB + wbo::IN, nullptr, smf, tb);
        convert_seg(p.b_w1, 64, 0, 64, 1024, WB + wbo::IN + (size_t)4096 * 1024, nullptr, smf, tb);
        convert_seg(p.b_a1, 64, 0, 64, 1024, WB + wbo::IN + (size_t)(4096 + 128) * 1024, nullptr, smf, tb);
        convert_seg(p.b_w_out, 1024, 0, 1024, 1024, WB + wbo::OUT, nullptr, smf, tb);
        convert_seg(p.b_w2, 1024, 0, 1024, 64, WB + wbo::EXTRA, nullptr, smf, tb);
        convert_seg(p.b_a2, 1024, 0, 1024, 64, WB + wbo::EXTRA + (size_t)1024 * 64, nullptr, smf, tb);
        for (size_t i = (size_t)blockIdx.x * 256 + TIDX; i < (size_t)64 * 1024 / 8; i += (size_t)gridDim.x * 256) {
            ((u32x4*)(WB + wbo::IN + (size_t)(4096 + 64) * 1024))[i] = (u32x4){0u, 0u, 0u, 0u};
            ((u32x4*)(WB + wbo::IN + (size_t)(4096 + 192) * 1024))[i] = (u32x4){0u, 0u, 0u, 0u};
        }
    } else if (PH == PH_IN1) {
        const bf16* XN = (const bf16*)(ws + wsl::L1_XN);
        EpiRwkv epi{P, (float*)(ws + wsl::LHW), (float*)(ws + wsl::LHA)};
        gemm_sched(16, 2, [&](bool big, int mt, int nt) {
            if (big) gemm_tile2(ALoadLerp{XN, p.b_mu + (nt >> 2) * D}, WB + wbo::IN, 1024, mt * 128, nt * 256, epi, smem);
            else gemm_tile(ALoadLerp{XN, p.b_mu + (4 + nt) * D}, WB + wbo::IN, 1024, mt * 128, 4096 + nt * 128, epi, smem);
        });
    } else if (PH == PH_LORA1) {
        const int ntile = (M / 128) * 16;
        EpiLora epi{p.b_w0, p.b_a0, (bf16*)(ws + wsl::L1_WL), (bf16*)(ws + wsl::L1_AV)};
        (void)ntile;
        gemm_sched(8, 0, [&](bool, int mt, int nt) { gemm_tile2(ALoadF32{(const float*)(ws + (nt < 4 ? wsl::LHW : wsl::LHA))}, WB + wbo::EXTRA, 64, mt * 128, nt * 256, epi, smem); });
    } else if (PH == PH_CPREP1) {
        for (int it = blockIdx.x; it < B * 16 * RW_NCH; it += gridDim.x)
            rwkv_prep_item(P, (bf16*)(ws + wsl::L1_WL), (bf16*)(ws + wsl::L1_AV), p.b_k_k, p.b_k_a, p.b_r_k, (float*)(ws + 9 * fw::MB), (bf16*)(ws + 1 * fw::MB), WB, (float*)(ws + 254 * fw::MB), it, smem);
    } else if (PH == PH_SCAN1) {
        const int bid = blockIdx.x;
        if ((bid & 31) < 8 && (bid >> 5) < 8) {
            const int it = (bid >> 5) * 8 + (bid & 31);
            rwkv_chunk_scan(P, (const bf16*)(ws + wsl::L1_WL), (const bf16*)(ws + wsl::L1_AV), (const float*)(ws + 9 * fw::MB), (const bf16*)(ws + 1 * fw::MB), WB, (bf16*)(ws + wsl::L1_XN), it, smem);
        }
    } else if (PH == PH_GN1) {
        rwkv_gn_rows2(P, (const float*)(ws + 254 * fw::MB), p.b_lnx_w, p.b_lnx_b, (bf16*)(ws + wsl::L1_XN));
    } else if (PH == PH_OUT1) {
        gemm_sched(4, 0, [&](bool, int mt, int nt) { gemm_tile2(ALoadPlain{(const bf16*)(ws + wsl::L1_XN), D}, WB + wbo::OUT, 1024, mt * 128, nt * 256, EpiResid{X, X, XB, parts}, smem); });
    } else if (PH == PH_PREP2) {
        int tb = 0;
        const float* g2 = p.norm_g + 2 * D;
        convert_seg(p.c_w_in, C_COLS, 0, 2560, 1024, WB + wbo::IN, g2, smf, tb);
        convert_seg(p.c_w_in, C_COLS, 2608, 1024, 1024, WB + wbo::IN + (size_t)2560 * 1024, g2, smf, tb);
        convert_seg(p.c_w_in, C_COLS, 2560, 64, 1024, WB + wbo::IN + (size_t)3584 * 1024, g2, smf, tb);
        convert_seg(p.c_w_out, 1024, 0, 1024, 1024, WB + wbo::OUT, nullptr, smf, tb);
        convert_seg(p.c_k_w1, 128, 0, 128, 2048, WB + wbo::EXTRA, nullptr, smf, tb);
        convert_seg(p.c_v_w1, 128, 0, 128, 2048, WB + wbo::EXTRA + (size_t)128 * 2048, nullptr, smf, tb);
        convert_seg(p.c_k_w2, 64, 0, 64, 128, WB + wbo::EXTRA + (size_t)256 * 2048, nullptr, smf, tb);
        convert_seg(p.c_v_w2, 64, 0, 64, 128, WB + wbo::EXTRA + (size_t)256 * 2048 + 64 * 128, nullptr, smf, tb);
        if (blockIdx.x < 16) {
            const int which = blockIdx.x >> 3, i = blockIdx.x & 7; const float* pos = which ? p.c_pos_v : p.c_pos_k; const float* w1 = which ? p.c_v_w1 : p.c_k_w1;
            float* b8 = (float*)(ws + 12 * fw::MB);
            if (TIDX < 128) { float a = 0.f; for (int k = i * 256; k < i * 256 + 256; ++k) a += pos[k] * w1[(size_t)k * 128 + TIDX]; b8[(which * 8 + i) * 128 + TIDX] = a; }
        }
    } else if (PH == PH_IN2) {
        gemm_sched(14, 1, [&](bool big, int mt, int nt) {
            if (big) gemm_tile2(ALoadPlain{XB, D}, WB + wbo::IN, 1024, mt * 128, nt * 256, EpiL2{P, (bf16*)(ws + 114 * fw::MB), (bf16*)(ws + 122 * fw::MB), parts}, smem);
            else gemm_tile(ALoadPlain{XB, D}, WB + wbo::IN, 1024, mt * 128, 3584 + nt * 128, EpiL2{P, (bf16*)(ws + 114 * fw::MB), (bf16*)(ws + 122 * fw::MB), parts}, smem);
        });
    } else if (PH == PH_B2) {
        for (int it = blockIdx.x; it < 64; it += gridDim.x) { const int which = it >> 5, rt = it & 31;
            cmp_tile(P, WB + wbo::EXTRA + (size_t)which * 128 * 2048, (const float*)(ws + 12 * fw::MB) + which * 8 * 128, WB + wbo::EXTRA + (size_t)256 * 2048 + which * 64 * 128, which, rt,
                     (bf16*)(ws + 5 * fw::MB), (bf16*)(ws + 6 * fw::MB), smem); }
        build_bias_lut(p.t5, smem, false);
        const int nwin = B * G * (T / (16 * ANQT_WIN));
        const bool split = gridDim.x == 512 && nwin == 2048;
        const int bid = blockIdx.x, nb = bid - 64, cnt = bid < 64 ? 2 : (nb < 128 ? 5 : 4);
        for (int k = 0;; ++k) {
            int item;
            if (split) { if (k >= cnt) break; item = bid < 64 ? k * 512 + 448 + bid : (k < 4 ? k * 512 + nb : (2 + (nb >> 6)) * 512 + 448 + (nb & 63)); }
            else { const int it = (bid < 64 ? bid + (int)gridDim.x : bid) + k * (int)gridDim.x; if (it >= 64 + nwin) break; item = it - 64; }
            win_item(P, (const bf16*)(ws + 122 * fw::MB), (bf16*)(ws + 130 * fw::MB), item, smem);
        }
    } else if (PH == PH_C2) {
        for (int it = blockIdx.x; it < B * G * (T / 32); it += gridDim.x)
            cmpsel_item(P, (const bf16*)(ws + 5 * fw::MB), (const bf16*)(ws + 6 * fw::MB), (bf16*)(ws + 162 * fw::MB), (unsigned long long*)(ws + 9 * fw::MB), it, smem);
    } else if (PH == PH_D2) {
        build_bias_lut(p.t5, smem, false);
        for (int it = blockIdx.x; it < B * G * (T / (16 * ANQT_SEL)); it += gridDim.x)
            sel_item(P, (const bf16*)(ws + 114 * fw::MB), (const unsigned long long*)(ws + 9 * fw::MB), (const bf16*)(ws + 162 * fw::MB), (const bf16*)(ws + 130 * fw::MB), (bf16*)(ws + 206 * fw::MB), it, smem);
    } else if (PH == PH_OUT2) {
        gemm_sched(4, 0, [&](bool, int mt, int nt) { gemm_tile2(ALoadPlain{(const bf16*)(ws + 206 * fw::MB), D}, WB + wbo::OUT, 1024, mt * 128, nt * 256, EpiResid{X, X, XB, parts}, smem); });
    } else if (PH == PH_PREP3) {
        int tb = 0;
        convert_seg(p.d_w_in, 2560, 0, 2560, 1024, WB + wbo::IN, p.norm_g + 3 * D, smf, tb);
        convert_seg(p.d_w_out, 1024, 0, 1024, 1280, WB + wbo::OUT, nullptr, smf, tb);
        lru_convert_gates(p.d_ga_w, p.d_gx_w, WB + wbo::EXTRA);
        for (int i = blockIdx.x * NTHREADS + TIDX; i < LW; i += gridDim.x * NTHREADS) ((float*)(ws + 12 * fw::MB + 786432))[i] = -8.0f * softplusf_(-p.d_lambda[i]);
    } else if (PH == PH_IN3) {
        gemm_sched(8, 4, [&](bool big, int mt, int nt) {
            if (big) gemm_tile2(ALoadPlain{XB, D}, WB + wbo::IN, 1024, mt * 128, nt * 256, EpiBf16{P, 2560, parts}, smem);
            else gemm_tile(ALoadPlain{XB, D}, WB + wbo::IN, 1024, mt * 128, 2048 + nt * 128, EpiBf16{P, 2560, parts}, smem);
        });
    } else if (PH == PH_GATE3) {
        for (int it = blockIdx.x; it < (M / 128) * 16; it += gridDim.x)
            lru_gate_item(P, p.d_conv_w, p.d_conv_b, WB + wbo::EXTRA, p.d_ga_b, p.d_gx_b, (const float*)(ws + 12 * fw::MB + 786432), (bf16*)(ws + wsl::L3_LA), (bf16*)(ws + wsl::L3_BV), (float2*)(ws + wsl::L3_UC), it, smem);
    } else if (PH == PH_SCANB3) {
        for (int it = blockIdx.x; it < B * (T / 64) * 5; it += gridDim.x)
            lru_scan2_item((const bf16*)(ws + wsl::L3_LA), (const bf16*)(ws + wsl::L3_BV), (const float2*)(ws + wsl::L3_UC), P, (bf16*)(ws + wsl::L3_AO), it);
    } else if (PH == PH_OUT3) {
        gemm_sched(4, 0, [&](bool, int mt, int nt) { gemm_tile2(ALoadPlain{(const bf16*)(ws + wsl::L3_AO), LW}, WB + wbo::OUT, 1280, mt * 128, nt * 256, EpiResid{X, X, nullptr, parts}, smem); });
    } else if (PH == PH_FINAL) {
        rows_final(X, parts, p.final_g);
    }
}

template <int PH> __global__ void __launch_bounds__(NTHREADS, 2) k_phase(Params p) {
    extern __shared__ __attribute__((aligned(16))) char smem[];
    run_phase<PH>(p, smem);
}
#define LDS_BYTES 73728
#define MEGA_LDS_BYTES (73728 + 64)
template <int PH> static void launch_phase(const Params& p, hipStream_t s) {
    static bool attr = false;
    if (!attr) { hipFuncSetAttribute((const void*)k_phase<PH>, hipFuncAttributeMaxDynamicSharedMemorySize, LDS_BYTES); attr = true; }
    hipLaunchKernelGGL(k_phase<PH>, dim3(512), dim3(NTHREADS), LDS_BYTES, s, p);
}


#define XB_TMO      128
#define XB_XCNT(j)  (256  + 64 * (j))
#define XB_XSUB(j)  (1280 + 64 * (j))
#define XB_XGEN(j)  (2304 + 64 * (j))
#define XB_TOP      3328
#define XB_TOPGEN   3392
#define XCD_BAR_WORDS 3456
#define XB_SPIN_CAP (1u << 22)
#define LAS __attribute__((address_space(3)))
DI unsigned xb_ld(unsigned* p)              { return __hip_atomic_load(p, __ATOMIC_RELAXED, __HIP_MEMORY_SCOPE_AGENT); }
DI unsigned xb_add(unsigned* p, unsigned v) { return __hip_atomic_fetch_add(p, v, __ATOMIC_RELAXED, __HIP_MEMORY_SCOPE_AGENT); }
DI unsigned xb_xcc_id() { return (unsigned)__builtin_amdgcn_s_getreg((3 << 11) | 20) & 0xFu; }
#define XB_SPIN(cond, bar) do { unsigned _sp = 0; while (cond) { if (_sp < 64u) __builtin_amdgcn_s_sleep(2); else __builtin_amdgcn_s_sleep(8); \
    if ((++_sp & 255u) == 0u) { if (xb_ld(&(bar)[XB_TMO])) break; if (_sp > XB_SPIN_CAP) { atomicAdd(&(bar)[XB_TMO], 1u); break; } } } } while (0)
struct XcdBarrier { unsigned* bar; unsigned x; volatile LAS unsigned* st; };
DI XcdBarrier xcd_barrier_post(unsigned* bar, volatile LAS unsigned* st) {
    XcdBarrier b; b.bar = bar; b.x = xb_xcc_id(); b.st = st;
    if (threadIdx.x == 0) (void)xb_add(&bar[XB_XCNT(b.x)], 1u);
    return b;
}
DI void xcd_barrier_complete(unsigned* bar, unsigned x, unsigned& nloc, unsigned& nx) {
    const unsigned G = gridDim.x * gridDim.y * gridDim.z;
    unsigned sum, cnt, mine, sp = 0u;
    for (;;) {
        sum = 0u; cnt = 0u; mine = 0u;
#pragma unroll
        for (unsigned j = 0; j < 16; ++j) { const unsigned c = xb_ld(&bar[XB_XCNT(j)]); sum += c; cnt += (c > 0u) ? 1u : 0u; mine = (j == x) ? c : mine; }
        if (sum == G) break;
        __builtin_amdgcn_s_sleep(1);
        if ((++sp & 255u) == 0u) { if (xb_ld(&bar[XB_TMO])) break; if (sp > XB_SPIN_CAP) { atomicAdd(&bar[XB_TMO], 1u); break; } }
    }
    nloc = mine > 0u ? mine : 1u; nx = cnt > 0u ? cnt : 1u;
}
DI void xcd_barrier(const XcdBarrier& b) {
    asm volatile("s_waitcnt vmcnt(0)" ::: "memory");
    __syncthreads();
    if (threadIdx.x == 0) {
        unsigned* bar = b.bar;
        __builtin_amdgcn_s_waitcnt(0);
        unsigned nloc = b.st[0], nx = b.st[1];
        if (nloc == 0u) { xcd_barrier_complete(bar, b.x, nloc, nx); b.st[0] = nloc; b.st[1] = nx; }
        const unsigned old = xb_add(&bar[XB_XSUB(b.x)], 1u);
        const unsigned gen = old / nloc;
        asm volatile("buffer_inv sc1" ::: "memory");
        if (old + 1u == (gen + 1u) * nloc) {
            __builtin_amdgcn_fence(__ATOMIC_RELEASE, "agent");
            asm volatile("s_waitcnt vmcnt(0)" ::: "memory");
            const unsigned og = xb_add(&bar[XB_TOP], 1u);
            const unsigned tg = og / nx;
            if (og + 1u == (tg + 1u) * nx) xb_add(&bar[XB_TOPGEN], 1u);
            else XB_SPIN(xb_ld(&bar[XB_TOPGEN]) == tg, bar);
            xb_add(&bar[XB_XGEN(b.x)], 1u);
            asm volatile("s_waitcnt vmcnt(0)" ::: "memory");
        } else {
            XB_SPIN(xb_ld(&bar[XB_XGEN(b.x)]) == gen, bar);
            asm volatile("s_waitcnt vmcnt(0)" ::: "memory");
        }
    }
    __syncthreads();
}

#define MEGA_PHASES(X) X(PH_IN0) X(PH_ATTN0) X(PH_OUT0) X(PH_PREP1) X(PH_IN1) X(PH_LORA1) X(PH_CPREP1) X(PH_SCAN1) X(PH_GN1) X(PH_OUT1) \
    X(PH_PREP2) X(PH_IN2) X(PH_B2) X(PH_C2) X(PH_D2) X(PH_OUT2) X(PH_PREP3) X(PH_IN3) X(PH_GATE3) X(PH_SCANB3) X(PH_OUT3)
__global__ void __launch_bounds__(NTHREADS, 2) mega_kernel(Params p) {
    extern __shared__ __attribute__((aligned(16))) char smem[];
    cooperative_groups::grid_group grid = cooperative_groups::this_grid();
    volatile LAS unsigned* xst = (volatile LAS unsigned*)(smem + 73728);
    if (threadIdx.x < 4) xst[threadIdx.x] = 0u;
    __syncthreads();
    XcdBarrier xb = xcd_barrier_post((unsigned*)p.ws, xst);
    run_phase<PH_PREP0>(p, smem);
    if (p.ws == nullptr) grid.sync();
    xcd_barrier(xb);
#define MEGA_STEP(ph) run_phase<ph>(p, smem); xcd_barrier(xb);
    MEGA_PHASES(MEGA_STEP)
#undef MEGA_STEP
    run_phase<PH_FINAL>(p, smem);
}
static void launch_mega(const Params& p, hipStream_t s) {
    static int grid_blocks = 0;
    if (!grid_blocks) {
        int dev = 0, cus = 0, per_cu = 0;
        hipGetDevice(&dev);
        hipDeviceGetAttribute(&cus, hipDeviceAttributeMultiprocessorCount, dev);
        hipFuncSetAttribute((const void*)mega_kernel, hipFuncAttributeMaxDynamicSharedMemorySize, MEGA_LDS_BYTES);
        hipOccupancyMaxActiveBlocksPerMultiprocessor(&per_cu, mega_kernel, NTHREADS, MEGA_LDS_BYTES);
        if (per_cu > 2) per_cu = 2;
        if (per_cu < 1) per_cu = 1;
        grid_blocks = cus * per_cu;
    }
    hipMemsetAsync(p.ws, 0, 16384, s);
    Params pp = p; void* args[] = {&pp};
    hipError_t e = hipLaunchCooperativeKernel((const void*)mega_kernel, dim3(grid_blocks), dim3(NTHREADS), args, MEGA_LDS_BYTES, s);
    if (e != hipSuccess) fprintf(stderr, "cooperative launch failed: %s (grid %d)\n", hipGetErrorString(e), grid_blocks);
}
#endif

#ifndef CPU_SHIM
template <class F> __global__ void __launch_bounds__(256) k_run(F f, long n) {
    const long i = (long)blockIdx.x * 256 + threadIdx.x; if (i < n) f(i);
}
template <class F> static void launch(const F& f, long n, hipStream_t s) {
    hipLaunchKernelGGL(k_run<F>, dim3((unsigned)((n + 255) / 256)), dim3(256), 0, s, f, n);
}
#else
template <class F> static void launch(const F& f, long n, hipStream_t) {
#pragma omp parallel for schedule(dynamic, 64)
    for (long i = 0; i < n; ++i) f(i);
}
#endif

#ifdef CPU_SHIM
void cpu_layer_hook(int layer, const float* X, const char* ws);
#define LAYER_HOOK(l) cpu_layer_hook(l, X, ws)
#else
#define LAYER_HOOK(l)
#endif

#define FAST_GEMM 0
#if FAST_GEMM
#define FASTP(ph) launch_phase<ph>(p, s)
#else
#define FASTP(ph)
#endif

static void run_naive(const Params& p, hipStream_t s) {
    char* ws = p.ws;
    float* rs = (float*)(ws + wsl::RS);
    bf16* P = (bf16*)(ws + wsl::P);
    float* X = p.out;
    (void)rs;
    {
        bf16* AO = (bf16*)(ws + wsl::L0_AO);
#if FAST_GEMM
        FASTP(PH_PREP0); FASTP(PH_IN0);
#else
        launch(RstdF{p.x, rs}, M, s);
        launch(GemmInF{p.x, rs, p.norm_g + 0 * D, p.a_w_in, P, A_COLS}, (long)M * (A_COLS / 4), s);
#endif
#if FAST_GEMM
        FASTP(PH_ATTN0); (void)AO;
#else
        launch(SwaF{P, p.t5, p.a_sinks, AO}, (long)M * H, s);
#endif
#if FAST_GEMM
        FASTP(PH_OUT0);
#else
        launch(GemmOutF{AO, p.a_w_out, p.x, X, 1024}, (long)M * (D / 4), s);
#endif
    }
    LAYER_HOOK(0);
    {
        bf16* XN = (bf16*)(ws + wsl::L1_XN); bf16* WL = (bf16*)(ws + wsl::L1_WL); bf16* AV = (bf16*)(ws + wsl::L1_AV);
        float* hw = (float*)(ws + wsl::LHW); float* ha = (float*)(ws + wsl::LHA);
#if FAST_GEMM
        FASTP(PH_PREP1); FASTP(PH_IN1); FASTP(PH_LORA1); FASTP(PH_CPREP1); FASTP(PH_SCAN1); FASTP(PH_GN1); FASTP(PH_OUT1);
        (void)XN; (void)WL; (void)AV; (void)hw; (void)ha;
#else
        launch(RstdF{X, rs}, M, s);
        launch(XnF{X, rs, p.norm_g + 1 * D, XN}, (long)M * D, s);
        launch(GemmRwkvF{XN, p.b_mu, p.b_w_in, P}, (long)M * 1024, s);
        launch(LoraHidF{XN, p.b_mu, p.b_w1, p.b_a1, hw, ha}, (long)M * 128, s);
        launch(LoraOutF{hw, ha, p.b_w0, p.b_w2, p.b_a0, p.b_a2, WL, AV}, (long)M * D, s);
        launch(RwkvScanF{P, WL, AV, p.b_k_k, p.b_k_a, XN}, (long)B * H * 64, s);
        launch(RwkvGnF{P, AV, p.b_k_a, p.b_r_k, p.b_lnx_w, p.b_lnx_b, XN}, (long)M * H, s);
        launch(GemmOutF{XN, p.b_w_out, X, X, 1024}, (long)M * (D / 4), s);
#endif
    }
    LAYER_HOOK(1);
    {
        float* hk = (float*)(ws + wsl::HK); float* hv = (float*)(ws + wsl::HV);
        float* kc = (float*)(ws + wsl::KC); float* vc = (float*)(ws + wsl::VC);
        float* st = (float*)(ws + wsl::ST); int* sel = (int*)(ws + wsl::SEL); float* imp = (float*)(ws + wsl::L2_IMP);
        bf16* AO = (bf16*)(ws + wsl::L2_AO); bf16* OC = (bf16*)(ws + wsl::L2_OC); bf16* OS = (bf16*)(ws + wsl::L2_OS);
#if FAST_GEMM
        FASTP(PH_PREP2); FASTP(PH_IN2); FASTP(PH_B2); FASTP(PH_C2); FASTP(PH_D2); FASTP(PH_OUT2);
        (void)hk; (void)hv; (void)kc; (void)vc; (void)st; (void)sel; (void)imp; (void)AO; (void)OC; (void)OS;
#else
        launch(RstdF{X, rs}, M, s);
        launch(GemmInF{X, rs, p.norm_g + 2 * D, p.c_w_in, P, C_COLS}, (long)M * (C_COLS / 4), s);
        launch(CmpHidF{P, p.c_pos_k, p.c_k_w1, p.c_pos_v, p.c_v_w1, hk, hv}, 2L * B * G * NCMP * 128, s);
        launch(CmpOutF{hk, hv, p.c_k_w2, p.c_v_w2, kc, vc}, 2L * B * G * NCMP * 64, s);
        launch(CmpAttnF{P, kc, vc, st, OC}, (long)M * H, s);
        launch(ImpF{P, kc, st, imp}, (long)M * G * NSEL, s);
        launch(TopkF{imp, sel}, (long)M * G, s);
        launch(SelAttnF{P, p.t5, sel, OS}, (long)M * H, s);
        launch(WinAttnF{P, p.t5, OC, OS, AO}, (long)M * H, s);
        LAYER_HOOK(20);
        launch(GemmOutF{AO, p.c_w_out, X, X, 1024}, (long)M * (D / 4), s);
#endif
    }
    LAYER_HOOK(2);
    {
        bf16* AO = (bf16*)(ws + wsl::L3_AO); bf16* UC = (bf16*)(ws + wsl::L3_UC); bf16* LA = (bf16*)(ws + wsl::L3_LA); bf16* BV = (bf16*)(ws + wsl::L3_BV);
#if FAST_GEMM
        FASTP(PH_PREP3); FASTP(PH_IN3); FASTP(PH_GATE3); FASTP(PH_SCANA3); FASTP(PH_SCANB3); FASTP(PH_OUT3);
        (void)AO; (void)UC; (void)LA; (void)BV;
#else
        launch(RstdF{X, rs}, M, s);
        launch(GemmInF{X, rs, p.norm_g + 3 * D, p.d_w_in, P, 2560}, (long)M * (2560 / 4), s);
        launch(ConvF{P, p.d_conv_w, p.d_conv_b, UC}, (long)M * LW, s);
        launch(LruGateF{UC, p.d_ga_w, p.d_ga_b, p.d_gx_w, p.d_gx_b, p.d_lambda, LA, BV}, (long)M * LW, s);
        launch(LruScanF{P, LA, BV, AO}, (long)B * LW, s);
        launch(GemmOutF{AO, p.d_w_out, X, X, LW}, (long)M * (D / 4), s);
#endif
    }
    LAYER_HOOK(3);
#if FAST_GEMM
    FASTP(PH_FINAL);
#else
    launch(FinalNormF{X, p.final_g}, M, s);
#endif
}

extern "C" void kernel_launch(void* const* d_in, const int* in_sizes, int n_in, void* d_out, int out_size, void* d_ws, size_t ws_size,
                              hipStream_t stream) {
    (void)in_sizes; (void)n_in; (void)out_size; (void)ws_size;
    Params p{};
    const float* const* in = (const float* const*)d_in;
    int k = 0;
    p.x = in[k++]; p.t5 = in[k++]; p.norm_g = in[k++]; p.final_g = in[k++];
    p.a_w_in = in[k++]; p.a_sinks = in[k++]; p.a_w_out = in[k++];
    p.b_mu = in[k++]; p.b_w_in = in[k++]; p.b_w0 = in[k++]; p.b_w1 = in[k++]; p.b_w2 = in[k++]; p.b_a0 = in[k++]; p.b_a1 = in[k++]; p.b_a2 = in[k++];
    p.b_k_k = in[k++]; p.b_k_a = in[k++]; p.b_r_k = in[k++]; p.b_lnx_w = in[k++]; p.b_lnx_b = in[k++]; p.b_w_out = in[k++];
    p.c_w_in = in[k++]; p.c_pos_k = in[k++]; p.c_k_w1 = in[k++]; p.c_k_w2 = in[k++]; p.c_pos_v = in[k++]; p.c_v_w1 = in[k++]; p.c_v_w2 = in[k++]; p.c_w_out = in[k++];
    p.d_w_in = in[k++]; p.d_conv_w = in[k++]; p.d_conv_b = in[k++]; p.d_ga_w = in[k++]; p.d_ga_b = in[k++]; p.d_gx_w = in[k++]; p.d_gx_b = in[k++];
    p.d_lambda = in[k++]; p.d_w_out = in[k++];
    p.out = (float*)d_out; p.ws = (char*)d_ws;
#if !defined(CPU_SHIM) && !defined(MULTI_LAUNCH) && !defined(ALL_NAIVE)
    launch_mega(p, stream);
#else
    run_naive(p, stream);
#endif
}
```

```cpp
#ifndef CPU_SHIM
#include <hip/hip_runtime.h>
#include <hip/hip_cooperative_groups.h>
#include <cstdio>
#define HD __host__ __device__ __forceinline__
#else
#include <cmath>
#include <cstring>
#include <cstdio>
#include <cstdlib>
#include <cstdint>
#define HD inline
typedef void* hipStream_t;
#endif
#include <cstddef>

#ifndef CFG_B
#define CFG_B 4
#endif
#ifndef CFG_T
#define CFG_T 4096
#endif

namespace cfg {
constexpr int B = CFG_B, T = CFG_T, M = B * T, D = 1024;
constexpr int H = 16, G = 4, R = 4, DH = 64;
constexpr int A_COLS = 2560;
constexpr int C_COLS = 3632;
constexpr int NCMP = (T - 32) / 16 + 1;
constexpr int NSEL = T / 64;
constexpr int KTOP = NSEL < 16 ? NSEL : 16;
constexpr int LW = 1280;
}
using namespace cfg;

typedef unsigned short bf16;

HD unsigned f_as_u(float f) {
#ifndef CPU_SHIM
    return __float_as_uint(f);
#else
    unsigned u; memcpy(&u, &f, 4); return u;
#endif
}
HD float u_as_f(unsigned u) {
#ifndef CPU_SHIM
    return __uint_as_float(u);
#else
    float f; memcpy(&f, &u, 4); return f;
#endif
}
HD float bf2f(bf16 v) { return u_as_f(((unsigned)v) << 16); }
HD bf16 f2bf(float f) { unsigned u = f_as_u(f); u += 0x7fffu + ((u >> 16) & 1u); return (bf16)(u >> 16); }
HD float sigmoidf_(float x) { return 1.0f / (1.0f + expf(-x)); }
HD float siluf_(float x) { return x / (1.0f + expf(-x)); }
HD float softplusf_(float x) { return x > 20.f ? x : log1pf(expf(x)); }

HD int t5_bucket(int d) {
    if (d < 16) return d < 0 ? 0 : d;
    if (d >= 113) return 31;
    if (d >= 99) return 30;
    if (d >= 87) return 29;
    if (d >= 77) return 28;
    if (d >= 67) return 27;
    if (d >= 59) return 26;
    if (d >= 52) return 25;
    if (d >= 46) return 24;
    if (d >= 40) return 23;
    if (d >= 35) return 22;
    if (d >= 31) return 21;
    if (d >= 27) return 20;
    if (d >= 24) return 19;
    if (d >= 21) return 18;
    if (d >= 19) return 17;
    return 16;
}

struct Params {
    const float *x, *t5, *norm_g, *final_g;
    const float *a_w_in, *a_sinks, *a_w_out;
    const float *b_mu, *b_w_in, *b_w0, *b_w1, *b_w2, *b_a0, *b_a1, *b_a2, *b_k_k, *b_k_a, *b_r_k, *b_lnx_w, *b_lnx_b, *b_w_out;
    const float *c_w_in, *c_pos_k, *c_k_w1, *c_k_w2, *c_pos_v, *c_v_w1, *c_v_w2, *c_w_out;
    const float *d_w_in, *d_conv_w, *d_conv_b, *d_ga_w, *d_ga_b, *d_gx_w, *d_gx_b, *d_lambda, *d_w_out;
    float* out;
    char* ws;
};

namespace wsl {
constexpr size_t MB = 1024 * 1024;
constexpr size_t RS = 0;
constexpr size_t HK = 1 * MB;
constexpr size_t HV = 3 * MB;
constexpr size_t KC = 5 * MB;
constexpr size_t VC = 6 * MB;
constexpr size_t ST = 7 * MB;
constexpr size_t SEL = 9 * MB;
constexpr size_t LHW = 1 * MB;
constexpr size_t LHA = 5 * MB;
constexpr size_t P = 14 * MB;
constexpr size_t SZ1024 = (size_t)M * 1024 * 2, SZ1280 = (size_t)M * 1280 * 2;
constexpr size_t L0_AO = P + (size_t)M * 2560 * 2;
constexpr size_t L1_XN = P + (size_t)M * 4096 * 2, L1_WL = L1_XN + SZ1024, L1_AV = L1_WL + SZ1024;
constexpr size_t L2_AO = P + (size_t)M * 3632 * 2, L2_OC = L2_AO + SZ1024, L2_OS = L2_OC + SZ1024, L2_IMP = L2_OS + SZ1024;
constexpr size_t L3_AO = P + (size_t)M * 2560 * 2, L3_UC = L3_AO + SZ1280, L3_LA = L3_UC + SZ1280, L3_BV = L3_LA + SZ1280;
constexpr size_t TOTAL = L3_BV + SZ1280;
}

struct RstdF {
    const float* x; float* rs;
    HD void operator()(long m) const {
        const float* r = x + (size_t)m * D; float s = 0.f;
        for (int k = 0; k < D; ++k) s += r[k] * r[k];
        rs[m] = 1.0f / sqrtf(s / D + 1e-6f);
    }
};
struct XnF {
    const float* x; const float* rs; const float* g; bf16* xn;
    HD void operator()(long i) const { long m = i / D; int k = (int)(i % D); xn[i] = f2bf(x[i] * rs[m] * g[k]); }
};
struct GemmInF {
    const float *x, *rs, *g, *W; bf16* P; long long N;
    HD void operator()(long i) const {
        const int n4 = (int)N / 4; const long m = i / n4; const int n = (int)(i % n4) * 4;
        const float* xr = x + (size_t)m * D; const float r = rs[m];
        float a0 = 0, a1 = 0, a2 = 0, a3 = 0;
        for (int k = 0; k < D; ++k) {
            const float a = xr[k] * r * g[k]; const float* w = W + (size_t)k * N + n;
            a0 += a * w[0]; a1 += a * w[1]; a2 += a * w[2]; a3 += a * w[3];
        }
        bf16* p = P + (size_t)m * N + n; p[0] = f2bf(a0); p[1] = f2bf(a1); p[2] = f2bf(a2); p[3] = f2bf(a3);
    }
};
struct GemmOutF {
    const bf16* A; const float* W; const float* xin; float* xout; long long K;
    HD void operator()(long i) const {
        const int n4 = D / 4; const long m = i / n4; const int n = (int)(i % n4) * 4;
        const bf16* ar = A + (size_t)m * K;
        float a0 = 0, a1 = 0, a2 = 0, a3 = 0;
        for (int k = 0; k < K; ++k) {
            const float a = bf2f(ar[k]); const float* w = W + (size_t)k * D + n;
            a0 += a * w[0]; a1 += a * w[1]; a2 += a * w[2]; a3 += a * w[3];
        }
        const float* xi = xin + (size_t)m * D + n; float* xo = xout + (size_t)m * D + n;
        xo[0] = xi[0] + a0; xo[1] = xi[1] + a1; xo[2] = xi[2] + a2; xo[3] = xi[3] + a3;
    }
};

struct SwaF {
    const bf16* P; const float* t5; const float* sinks; bf16* AO;
    HD void operator()(long i) const {
        const long m = i / H; const int h = (int)(i % H), g = h / R; const int t = (int)(m % T); const long mb = m - t;
        float q[DH], o[DH];
#pragma unroll
        for (int d = 0; d < DH; ++d) { q[d] = bf2f(P[(size_t)m * A_COLS + h * DH + d]); o[d] = 0.f; }
        float mx = sinks[h], l = 1.0f;
        const int s0 = t - 127 < 0 ? 0 : t - 127;
        for (int s = s0; s <= t; ++s) {
            const bf16* kr = P + (size_t)(mb + s) * A_COLS + 1024 + g * DH;
            const bf16* vr = kr + 256;
            float sc = 0.f;
#pragma unroll
            for (int d = 0; d < DH; ++d) sc += q[d] * bf2f(kr[d]);
            sc = sc * 0.125f + t5[t5_bucket(t - s) * H + h];
            const float mn = sc > mx ? sc : mx; const float al = expf(mx - mn), p = expf(sc - mn);
            l = l * al + p; mx = mn;
#pragma unroll
            for (int d = 0; d < DH; ++d) o[d] = o[d] * al + p * bf2f(vr[d]);
        }
        const float il = 1.0f / l;
#pragma unroll
        for (int d = 0; d < DH; ++d) {
            const float z = bf2f(P[(size_t)m * A_COLS + 1536 + h * DH + d]);
            AO[(size_t)m * D + h * DH + d] = f2bf(o[d] * il * siluf_(z));
        }
    }
};

struct GemmRwkvF {
    const bf16* xn; const float* mu; const float* W; bf16* P;
    HD void operator()(long i) const {
        const int N = 4096, n4 = N / 4; const long m = i / n4; const int n = (int)(i % n4) * 4; const int s = n / 1024;
        const int t = (int)(m % T);
        const bf16* xr = xn + (size_t)m * D; const float* mus = mu + s * D;
        float a0 = 0, a1 = 0, a2 = 0, a3 = 0;
        for (int k = 0; k < D; ++k) {
            const float xc = bf2f(xr[k]); const float xp = t > 0 ? bf2f(xr[k - D]) : 0.f;
            const float a = xc + (xp - xc) * mus[k]; const float* w = W + (size_t)k * N + n;
            a0 += a * w[0]; a1 += a * w[1]; a2 += a * w[2]; a3 += a * w[3];
        }
        bf16* p = P + (size_t)m * N + n; p[0] = f2bf(a0); p[1] = f2bf(a1); p[2] = f2bf(a2); p[3] = f2bf(a3);
    }
};
struct LoraHidF {
    const bf16* xn; const float* mu; const float* w1; const float* a1; float* hw; float* ha;
    HD void operator()(long i) const {
        const long m = i / 128; const int jj = (int)(i % 128); const int which = jj / 64, j = jj % 64; const int t = (int)(m % T);
        const bf16* xr = xn + (size_t)m * D; const float* mus = mu + (4 + which) * D; const float* W = which ? a1 : w1;
        float acc = 0.f;
        for (int k = 0; k < D; ++k) {
            const float xc = bf2f(xr[k]); const float xp = t > 0 ? bf2f(xr[k - D]) : 0.f;
            acc += (xc + (xp - xc) * mus[k]) * W[(size_t)k * 64 + j];
        }
        if (which) ha[(size_t)m * 64 + j] = acc; else hw[(size_t)m * 64 + j] = tanhf(acc);
    }
};
struct LoraOutF {
    const float *hw, *ha, *w0, *w2, *a0, *a2; bf16* wlog; bf16* av;
    HD void operator()(long i) const {
        const long m = i / D; const int c = (int)(i % D);
        float sw = 0.f, sa = 0.f;
        for (int j = 0; j < 64; ++j) { sw += hw[(size_t)m * 64 + j] * w2[(size_t)j * D + c]; sa += ha[(size_t)m * 64 + j] * a2[(size_t)j * D + c]; }
        const float wr = -softplusf_(-(w0[c] + sw)) - 0.5f;
        wlog[i] = f2bf(-expf(wr)); av[i] = f2bf(sigmoidf_(a0[c] + sa));
    }
};
struct RwkvScanF {
    const bf16* P; const bf16* wlog; const bf16* av; const float* k_k; const float* k_a; bf16* ys;
    HD void operator()(long idx) const {
        const int i = (int)(idx % 64); const int h = (int)((idx / 64) % H); const int b = (int)(idx / (64 * H));
        float S[64];
#pragma unroll
        for (int j = 0; j < 64; ++j) S[j] = 0.f;
        for (int t = 0; t < T; ++t) {
            const size_t m = (size_t)b * T + t; const bf16* pr = P + m * 4096 + h * 64;
            const bf16* wl = wlog + m * D + h * 64; const bf16* ar = av + m * D + h * 64;
            float n2 = 0.f;
#pragma unroll
            for (int j = 0; j < 64; ++j) { const float kk = bf2f(pr[1024 + j]) * k_k[h * 64 + j]; n2 += kk * kk; }
            float nr = sqrtf(n2); nr = nr > 1e-12f ? nr : 1e-12f; const float inr = 1.0f / nr;
            float sa = 0.f;
#pragma unroll
            for (int j = 0; j < 64; ++j) { const float kk = bf2f(pr[1024 + j]) * k_k[h * 64 + j] * inr; sa += S[j] * (-kk); }
            const float vi = bf2f(pr[2048 + i]); float y = 0.f;
#pragma unroll
            for (int j = 0; j < 64; ++j) {
                const float kr = bf2f(pr[1024 + j]); const float a = bf2f(ar[j]);
                const float kk = kr * k_k[h * 64 + j] * inr; const float kp = kr * (1.0f + (a - 1.0f) * k_a[h * 64 + j]);
                const float dec = expf(bf2f(wl[j]));
                S[j] = S[j] * dec + sa * (kk * a) + vi * kp;
                y += S[j] * bf2f(pr[j]);
            }
            ys[m * D + h * 64 + i] = f2bf(y);
        }
    }
};
struct RwkvGnF {
    const bf16* P; const bf16* av; const float *k_a, *r_k, *lnx_w, *lnx_b; bf16* ys;
    HD void operator()(long idx) const {
        const long m = idx / H; const int h = (int)(idx % H);
        bf16* yr = ys + (size_t)m * D + h * 64; const bf16* pr = P + (size_t)m * 4096 + h * 64; const bf16* ar = av + (size_t)m * D + h * 64;
        float mean = 0.f;
        for (int j = 0; j < 64; ++j) mean += bf2f(yr[j]);
        mean /= 64.f; float var = 0.f;
        for (int j = 0; j < 64; ++j) { const float d = bf2f(yr[j]) - mean; var += d * d; }
        var /= 64.f; const float rstd = 1.0f / sqrtf(var + 64e-5f);
        float bs = 0.f;
        for (int j = 0; j < 64; ++j) { const float kr = bf2f(pr[1024 + j]); const float kp = kr * (1.0f + (bf2f(ar[j]) - 1.0f) * k_a[h * 64 + j]); bs += bf2f(pr[j]) * kp * r_k[h * 64 + j]; }
        for (int j = 0; j < 64; ++j) {
            const float yn = (bf2f(yr[j]) - mean) * rstd * lnx_w[h * 64 + j] + lnx_b[h * 64 + j];
            const float z = bf2f(pr[3072 + j]);
            yr[j] = f2bf((yn + bs * bf2f(pr[2048 + j])) * siluf_(z));
        }
    }
};

struct CmpHidF {
    const bf16* P; const float *pos_k, *w1_k, *pos_v, *w1_v; float* hk; float* hv;
    HD void operator()(long idx) const {
        const int j = (int)(idx % 128); long r = idx / 128; const int n = (int)(r % NCMP); r /= NCMP; const int g = (int)(r % G); r /= G;
        const int b = (int)(r % B); const int which = (int)(r / B);
        const float* pos = which ? pos_v : pos_k; const float* w1 = which ? w1_v : w1_k; const int col = 1024 + (which ? 256 : 0) + g * 64;
        float acc = 0.f;
        for (int l = 0; l < 32; ++l) {
            const bf16* src = P + (size_t)(b * T + 16 * n + l) * C_COLS + col;
            for (int d = 0; d < 64; ++d) acc += (bf2f(src[d]) + pos[l * 64 + d]) * w1[(size_t)(l * 64 + d) * 128 + j];
        }
        (which ? hv : hk)[(((size_t)b * G + g) * NCMP + n) * 128 + j] = siluf_(acc);
    }
};
struct CmpOutF {
    const float *hk, *hv, *w2_k, *w2_v; float* kc; float* vc;
    HD void operator()(long idx) const {
        const int d = (int)(idx % 64); long r = idx / 64; const long row = r % ((long)B * G * NCMP); const int which = (int)(r / ((long)B * G * NCMP));
        const float* hsrc = (which ? hv : hk) + (size_t)row * 128; const float* w2 = which ? w2_v : w2_k;
        float acc = 0.f;
        for (int j = 0; j < 128; ++j) acc += hsrc[j] * w2[j * 64 + d];
        (which ? vc : kc)[(size_t)row * 64 + d] = acc;
    }
};
struct CmpAttnF {
    const bf16* P; const float *kc, *vc; float* st; bf16* oc;
    HD void operator()(long i) const {
        const long m = i / H; const int h = (int)(i % H), g = h / R; const int t = (int)(m % T); const int b = (int)(m / T);
        float q[DH], o[DH];
#pragma unroll
        for (int d = 0; d < DH; ++d) { q[d] = bf2f(P[(size_t)m * C_COLS + h * DH + d]); o[d] = 0.f; }
        const int nv = t < 31 ? 0 : (t - 31) / 16 + 1;
        float mx = -1e30f, l = 0.f;
        for (int n = 0; n < nv; ++n) {
            const float* kr = kc + (((size_t)b * G + g) * NCMP + n) * 64; const float* vr = vc + (((size_t)b * G + g) * NCMP + n) * 64;
            float sc = 0.f;
#pragma unroll
            for (int d = 0; d < DH; ++d) sc += q[d] * kr[d];
            sc *= 0.125f;
            const float mn = sc > mx ? sc : mx; const float al = expf(mx - mn), p = expf(sc - mn);
            l = l * al + p; mx = mn;
#pragma unroll
            for (int d = 0; d < DH; ++d) o[d] = o[d] * al + p * vr[d];
        }
        const float il = nv > 0 ? 1.0f / l : 0.f;
        st[(size_t)i * 2] = mx; st[(size_t)i * 2 + 1] = il;
#pragma unroll
        for (int d = 0; d < DH; ++d) oc[(size_t)m * D + h * DH + d] = f2bf(o[d] * il);
    }
};
struct ImpF {
    const bf16* P; const float *kc, *st; float* imp;
    HD void operator()(long idx) const {
        const int s = (int)(idx % NSEL); long r = idx / NSEL; const int g = (int)(r % G); const long m = r / G;
        const int t = (int)(m % T); const int b = (int)(m / T); const int cur = t / 64;
        float v;
        if (s == 0 || s == cur || s == cur - 1) v = 1e30f;
        else if (s * 64 > t) v = -1e30f;
        else {
            v = 0.f; const int nv = t < 31 ? 0 : (t - 31) / 16 + 1;
            int n0 = 4 * s - 1; if (n0 < 0) n0 = 0; int n1 = 4 * s + 3; if (n1 > NCMP - 1) n1 = NCMP - 1; if (n1 > nv - 1) n1 = nv - 1;
            for (int rr = 0; rr < R; ++rr) {
                const int h = g * R + rr; const bf16* qr = P + (size_t)m * C_COLS + h * DH;
                const float mx = st[((size_t)m * H + h) * 2], il = st[((size_t)m * H + h) * 2 + 1];
                for (int n = n0; n <= n1; ++n) {
                    const float* kr = kc + (((size_t)b * G + g) * NCMP + n) * 64; float sc = 0.f;
                    for (int d = 0; d < DH; ++d) sc += bf2f(qr[d]) * kr[d];
                    v += expf(sc * 0.125f - mx) * il;
                }
            }
        }
        imp[idx] = v;
    }
};
struct TopkF {
    const float* imp; int* sel;
    HD void operator()(long idx) const {
        const float* v = imp + (size_t)idx * NSEL; unsigned long long used = 0ull;
        for (int j = 0; j < KTOP; ++j) {
            int best = -1; float bv = 0.f;
            for (int s = 0; s < NSEL; ++s) { if ((used >> s) & 1ull) continue; const float x = v[s]; if (best < 0 || x > bv) { best = s; bv = x; } }
            used |= 1ull << best; sel[(size_t)idx * 16 + j] = best;
        }
    }
};
struct SelAttnF {
    const bf16* P; const float* t5; const int* sel; bf16* os;
    HD void operator()(long i) const {
        const long m = i / H; const int h = (int)(i % H), g = h / R; const int t = (int)(m % T); const long mb = m - t;
        float q[DH], o[DH];
#pragma unroll
        for (int d = 0; d < DH; ++d) { q[d] = bf2f(P[(size_t)m * C_COLS + h * DH + d]); o[d] = 0.f; }
        float mx = -1e30f, l = 0.f;
        for (int j = 0; j < KTOP; ++j) {
            const int blk = sel[((size_t)m * G + g) * 16 + j];
            for (int ll = 0; ll < 64; ++ll) {
                const int s = blk * 64 + ll; if (s > t) break;
                const bf16* kr = P + (size_t)(mb + s) * C_COLS + 1536 + g * DH; const bf16* vr = kr + 256;
                float sc = 0.f;
#pragma unroll
                for (int d = 0; d < DH; ++d) sc += q[d] * bf2f(kr[d]);
                sc = sc * 0.125f + t5[t5_bucket(t - s) * H + h];
                const float mn = sc > mx ? sc : mx; const float al = expf(mx - mn), p = expf(sc - mn);
                l = l * al + p; mx = mn;
#pragma unroll
                for (int d = 0; d < DH; ++d) o[d] = o[d] * al + p * bf2f(vr[d]);
            }
        }
        const float il = 1.0f / l;
#pragma unroll
        for (int d = 0; d < DH; ++d) os[(size_t)m * D + h * DH + d] = f2bf(o[d] * il);
    }
};
struct WinAttnF {
    const bf16* P; const float* t5; const bf16* oc; const bf16* os; bf16* AO;
    HD void operator()(long i) const {
        const long m = i / H; const int h = (int)(i % H), g = h / R, rr = h % R; const int t = (int)(m % T); const long mb = m - t;
        float q[DH], o[DH];
#pragma unroll
        for (int d = 0; d < DH; ++d) { q[d] = bf2f(P[(size_t)m * C_COLS + h * DH + d]); o[d] = 0.f; }
        float mx = -1e30f, l = 0.f;
        const int s0 = t - 511 < 0 ? 0 : t - 511;
        for (int s = s0; s <= t; ++s) {
            const bf16* kr = P + (size_t)(mb + s) * C_COLS + 2048 + g * DH; const bf16* vr = kr + 256;
            float sc = 0.f;
#pragma unroll
            for (int d = 0; d < DH; ++d) sc += q[d] * bf2f(kr[d]);
            sc = sc * 0.125f + t5[t5_bucket(t - s) * H + h];
            const float mn = sc > mx ? sc : mx; const float al = expf(mx - mn), p = expf(sc - mn);
            l = l * al + p; mx = mn;
#pragma unroll
            for (int d = 0; d < DH; ++d) o[d] = o[d] * al + p * bf2f(vr[d]);
        }
        const float il = 1.0f / l;
        const bf16* gr = P + (size_t)m * C_COLS + 2560;
        const float g0 = sigmoidf_(bf2f(gr[0 * 16 + g * R + rr])), g1 = sigmoidf_(bf2f(gr[1 * 16 + g * R + rr])), g2 = sigmoidf_(bf2f(gr[2 * 16 + g * R + rr]));
#pragma unroll
        for (int d = 0; d < DH; ++d) {
            const size_t oi = (size_t)m * D + h * DH + d;
            const float z = bf2f(P[(size_t)m * C_COLS + 2608 + h * DH + d]);
            AO[oi] = f2bf((g0 * bf2f(oc[oi]) + g1 * bf2f(os[oi]) + g2 * o[d] * il) * siluf_(z));
        }
    }
};

struct ConvF {
    const bf16* P; const float *cw, *cb; bf16* uc;
    HD void operator()(long i) const {
        const long m = i / LW; const int c = (int)(i % LW); const int t = (int)(m % T);
        float acc = cb[c];
        for (int w = 0; w < 4; ++w) { const int tt = t - 3 + w; if (tt >= 0) acc += cw[w * LW + c] * bf2f(P[(size_t)(m - 3 + w) * 2560 + c]); }
        uc[i] = f2bf(acc);
    }
};
struct LruGateF {
    const bf16* uc; const float *gaw, *gab, *gxw, *gxb, *lam; bf16* la; bf16* bv;
    HD void operator()(long i) const {
        const long m = i / LW; const int c = (int)(i % LW); const int n = c / 80, d = c % 80;
        const bf16* ub = uc + (size_t)m * LW + n * 80; float ra = gab[c], rx = gxb[c];
        for (int k = 0; k < 80; ++k) { const float u = bf2f(ub[k]); ra += u * gaw[((size_t)n * 80 + k) * 80 + d]; rx += u * gxw[((size_t)n * 80 + k) * 80 + d]; }
        const float r = sigmoidf_(ra), ig = sigmoidf_(rx);
        const float loga = -8.0f * r * softplusf_(-lam[c]);
        la[i] = f2bf(loga);
        bv[i] = f2bf(sqrtf(-expm1f(2.0f * loga)) * (ig * bf2f(uc[i])));
    }
};
struct LruScanF {
    const bf16* P; const bf16* la; const bf16* bv; bf16* AO;
    HD void operator()(long idx) const {
        const int c = (int)(idx % LW); const int b = (int)(idx / LW); float h = 0.f;
        for (int t = 0; t < T; ++t) {
            const size_t m = (size_t)b * T + t;
            h = expf(bf2f(la[m * LW + c])) * h + bf2f(bv[m * LW + c]);
            AO[m * LW + c] = f2bf(h * siluf_(bf2f(P[m * 2560 + LW + c])));
        }
    }
};
struct FinalNormF {
    float* x; const float* g;
    HD void operator()(long m) const {
        float* r = x + (size_t)m * D; float s = 0.f;
        for (int k = 0; k < D; ++k) s += r[k] * r[k];
        const float rs = 1.0f / sqrtf(s / D + 1e-6f);
        for (int k = 0; k < D; ++k) r[k] = r[k] * rs * g[k];
    }
};


#ifndef CPU_SHIM
typedef short bf16x8 __attribute__((ext_vector_type(8)));
typedef float f32x4 __attribute__((ext_vector_type(4)));
typedef unsigned u32x4 __attribute__((ext_vector_type(4)));
typedef unsigned u32x2 __attribute__((ext_vector_type(2)));
#define DI __device__ __forceinline__
#define NTHREADS 256
__device__ __forceinline__ int opaque_tid() { int t = threadIdx.x; asm volatile("" : "+v"(t)); return t; }
#define TIDX (opaque_tid())

typedef __bf16 hbf16x2 __attribute__((ext_vector_type(2)));
typedef float f32x2 __attribute__((ext_vector_type(2)));
DI unsigned pack2bf(float lo, float hi) { f32x2 f = {lo, hi}; return __builtin_bit_cast(unsigned, __builtin_convertvector(f, hbf16x2)); }
DI float bflo(unsigned u) { return __uint_as_float(u << 16); }
DI float bfhi(unsigned u) { return __uint_as_float(u & 0xffff0000u); }

namespace fw {
constexpr size_t MB = 1024 * 1024;
constexpr size_t PARTS = 13 * MB;
constexpr size_t SMALLB = 1 * MB;
constexpr size_t WB = 14 * MB;
constexpr size_t XB = 30 * MB;
constexpr size_t BIG = 62 * MB;
}

DI void convert_tile(const float* __restrict__ W, int ldw, int c0, int K, bf16* __restrict__ Wt, const float* __restrict__ g, int kt, int nt, float* sm) {
    const int tid = TIDX;
    const int k0 = kt * 64, n0 = nt * 64;
#pragma unroll
    for (int i = 0; i < 4; ++i) {
        const int kr = (tid >> 4) + 16 * i; const int nc = (tid & 15) * 4;
        const float4 v = *(const float4*)(W + (size_t)(k0 + kr) * ldw + c0 + n0 + nc);
        const float s = g ? g[k0 + kr] : 1.0f;
        sm[kr * 65 + nc + 0] = v.x * s; sm[kr * 65 + nc + 1] = v.y * s; sm[kr * 65 + nc + 2] = v.z * s; sm[kr * 65 + nc + 3] = v.w * s;
    }
    __syncthreads();
    {
        const int n = tid >> 2, kq = (tid & 3) * 16;
        unsigned w[8];
#pragma unroll
        for (int j = 0; j < 8; ++j) w[j] = pack2bf(sm[(kq + 2 * j) * 65 + n], sm[(kq + 2 * j + 1) * 65 + n]);
        u32x4* dst = (u32x4*)(Wt + (size_t)(n0 + n) * K + k0 + kq);
        dst[0] = (u32x4){w[0], w[1], w[2], w[3]}; dst[1] = (u32x4){w[4], w[5], w[6], w[7]};
    }
    __syncthreads();
}
DI void convert_seg(const float* W, int ldw, int c0, int ncols, int K, bf16* Wt, const float* g, float* sm, int& tbase) {
    const int nkt = K / 64, nnt = ncols / 64, ntile = nkt * nnt;
    const int Gd = (int)gridDim.x;
    for (int t = (((int)blockIdx.x - tbase % Gd) + Gd) % Gd; t < ntile; t += Gd) convert_tile(W, ldw, c0, K, Wt, g, t % nkt, t / nkt, sm);
    tbase += ntile;
}

DI int perm32(int rho) { const int n = rho >> 4, i = rho & 15; return 8 * (i >> 2) + 4 * n + (i & 3); }

struct ALoadPlain {
    const bf16* A; int lda;
    static constexpr bool DMA = true;
    DI const bf16* src(int m, int k) const { return A + (size_t)m * lda + k; }
    struct Raw { u32x4 v; };
    DI Raw load(int m, int k) const { Raw r; r.v = *(const u32x4*)(A + (size_t)m * lda + k); return r; }
    DI u32x4 finish(const Raw& r, int, int) const { return r.v; }
};
struct ALoadLerp {
    const bf16* xn; const float* mu;
    static constexpr bool DMA = false;
    DI const bf16* src(int, int) const { return nullptr; }
    struct Raw { u32x4 c, p; };
    DI Raw load(int m, int k) const {
        Raw r; r.c = *(const u32x4*)(xn + (size_t)m * D + k);
        if ((m % T) != 0) r.p = *(const u32x4*)(xn + (size_t)(m - 1) * D + k); else r.p = (u32x4){0u, 0u, 0u, 0u};
        return r;
    }
    DI u32x4 finish(const Raw& r, int, int k) const {
        const float4 m0 = *(const float4*)(mu + k), m1 = *(const float4*)(mu + k + 4);
        const float mm[8] = {m0.x, m0.y, m0.z, m0.w, m1.x, m1.y, m1.z, m1.w};
        u32x4 o;
#pragma unroll
        for (int j = 0; j < 4; ++j) {
            const float c0 = bflo(r.c[j]), c1 = bfhi(r.c[j]), p0 = bflo(r.p[j]), p1 = bfhi(r.p[j]);
            o[j] = pack2bf(c0 + (p0 - c0) * mm[2 * j], c1 + (p1 - c1) * mm[2 * j + 1]);
        }
        return o;
    }
};

#define GLDS16(gp, lp) __builtin_amdgcn_global_load_lds((const unsigned*)(gp), (unsigned*)(lp), 16, 0, 0)
template <class AL, class Epi>
DI void gemm_tile(const AL& al, const bf16* __restrict__ Bt, int K, int m0, int n0, const Epi& epi, char* smem) {
    const int tid = TIDX, lane = tid & 63, wave = __builtin_amdgcn_readfirstlane(tid >> 6), wr = wave >> 1, wc = wave & 1, q = lane >> 4, l15 = lane & 15;
    const int srow = tid >> 3, sc = tid & 7, scs = sc ^ (srow & 7);
    const int st_off = srow * 128 + (sc << 4);
    const int dma_off = (8 * wave) * 128;
    int brow[4];
#pragma unroll
    for (int i = 0; i < 4; ++i) { const int rho = srow + 32 * i; brow[i] = n0 + (rho & ~31) + perm32(rho & 31); }
    const int fa0 = (wr * 64 + l15) * 128 + ((q ^ (lane & 7)) << 4);
    const int fb0 = (wc * 64 + l15) * 128 + ((q ^ (lane & 7)) << 4);
    f32x4 acc[4][4];
#pragma unroll
    for (int i = 0; i < 4; ++i)
#pragma unroll
        for (int j = 0; j < 4; ++j) acc[i][j] = (f32x4){0.f, 0.f, 0.f, 0.f};
    typename AL::Raw ra[4];
    const int nk = K / 64;
    {
        char* bufA = smem; char* bufB = smem + 16384;
#pragma unroll
        for (int i = 0; i < 4; ++i) {
            GLDS16(Bt + (size_t)brow[i] * K + scs * 8, bufB + dma_off + i * 4096);
            if (AL::DMA) GLDS16(al.src(m0 + srow + 32 * i, scs * 8), bufA + dma_off + i * 4096);
            else ra[i] = al.load(m0 + srow + 32 * i, scs * 8);
        }
        if (!AL::DMA) {
#pragma unroll
            for (int i = 0; i < 4; ++i) *(u32x4*)(bufA + st_off + i * 4096) = al.finish(ra[i], m0 + srow + 32 * i, scs * 8);
        }
    }
    asm volatile("s_waitcnt vmcnt(0)" ::: "memory");
    __syncthreads();
    for (int kt = 0; kt < nk; ++kt) {
        char* bufA = smem + (kt & 1) * 32768; char* bufB = bufA + 16384;
        char* nA = smem + ((kt + 1) & 1) * 32768; char* nB = nA + 16384;
        const bool more = kt + 1 < nk; const int kn = (kt + 1) * 64 + scs * 8;
        if (more) {
#pragma unroll
            for (int i = 0; i < 4; ++i) {
                GLDS16(Bt + (size_t)brow[i] * K + kn, nB + dma_off + i * 4096);
                if (AL::DMA) GLDS16(al.src(m0 + srow + 32 * i, kn), nA + dma_off + i * 4096);
                else ra[i] = al.load(m0 + srow + 32 * i, kn);
            }
        }
#pragma unroll
        for (int ks = 0; ks < 2; ++ks) {
            bf16x8 af[4], bfr[4];
#pragma unroll
            for (int i = 0; i < 4; ++i) {
                af[i] = *(const bf16x8*)(bufA + ((fa0 + i * 2048) ^ (ks << 6)));
                bfr[i] = *(const bf16x8*)(bufB + ((fb0 + i * 2048) ^ (ks << 6)));
            }
#pragma unroll
            for (int i = 0; i < 4; ++i)
#pragma unroll
                for (int j = 0; j < 4; ++j) acc[i][j] = __builtin_amdgcn_mfma_f32_16x16x32_bf16(bfr[j], af[i], acc[i][j], 0, 0, 0);
        }
        if (more && !AL::DMA) {
#pragma unroll
            for (int i = 0; i < 4; ++i) *(u32x4*)(nA + st_off + i * 4096) = al.finish(ra[i], m0 + srow + 32 * i, kn);
        }
        asm volatile("s_waitcnt vmcnt(0)" ::: "memory");
        __syncthreads();
    }
#pragma unroll
    for (int mt = 0; mt < 4; ++mt)
#pragma unroll
        for (int gi = 0; gi < 2; ++gi) {
            float v[8];
#pragma unroll
            for (int r = 0; r < 4; ++r) { v[r] = acc[mt][2 * gi][r]; v[4 + r] = acc[mt][2 * gi + 1][r]; }
            epi(m0 + wr * 64 + mt * 16 + l15, n0 + wc * 64 + gi * 32 + 8 * q, v, mt, gi);
        }
    epi.finish(m0, n0, wr, wc, lane);
}

constexpr int G2_STAGE = 24576;
template <class AL, class Epi>
DI void gemm_tile2(const AL& al, const bf16* __restrict__ Bt, int K, int m0, int n0, const Epi& epi, char* smem) {
    const int tid = TIDX, lane = tid & 63, wave = __builtin_amdgcn_readfirstlane(tid >> 6), wr = wave >> 1, wc = wave & 1, q = lane >> 4, l15 = lane & 15;
    const int prow = tid >> 2, ppos = tid & 3, ca = (ppos - 2 * ((tid >> 4) & 3)) & 3;
    const int dma_off = wave * 1024;
    int brow[4];
#pragma unroll
    for (int i = 0; i < 4; ++i) { const int rho = prow + 64 * i; brow[i] = n0 + (rho & ~31) + perm32(rho & 31); }
    const int fpos = ((q + 2 * ((l15 >> 2) & 3)) & 3) << 4;
    const int fa0 = (wr * 64 + l15) * 64 + fpos, fb0 = 8192 + (wc * 128 + l15) * 64 + fpos;
    f32x4 acc[4][8];
#pragma unroll
    for (int i = 0; i < 4; ++i)
#pragma unroll
        for (int j = 0; j < 8; ++j) acc[i][j] = (f32x4){0.f, 0.f, 0.f, 0.f};
    typename AL::Raw ra[2];
    const int nk = K / 32;
#define G2_ISSUE(kt_) { char* st_ = smem + ((kt_) % 3) * G2_STAGE; const int kk_ = (kt_) * 32 + ca * 8; \
        _Pragma("unroll") for (int i = 0; i < 2; ++i) { if (AL::DMA) GLDS16(al.src(m0 + prow + 64 * i, kk_), st_ + dma_off + i * 4096); else ra[i] = al.load(m0 + prow + 64 * i, kk_); } \
        _Pragma("unroll") for (int i = 0; i < 4; ++i) GLDS16(Bt + (size_t)brow[i] * K + kk_, st_ + 8192 + dma_off + i * 4096); }
#define G2_AWRITE(kt_) { if (!AL::DMA) { char* st_ = smem + ((kt_) % 3) * G2_STAGE; const int kk_ = (kt_) * 32 + ca * 8; \
        _Pragma("unroll") for (int i = 0; i < 2; ++i) *(u32x4*)(st_ + (prow + 64 * i) * 64 + ppos * 16) = al.finish(ra[i], m0 + prow + 64 * i, kk_); } }
#define G2_BARRIER() { asm volatile("s_waitcnt lgkmcnt(0)" ::: "memory"); __builtin_amdgcn_s_barrier(); asm volatile("" ::: "memory"); }
    G2_ISSUE(0); G2_AWRITE(0);
    if (nk > 1) { G2_ISSUE(1); G2_AWRITE(1); }
    if (nk > 1) { if (AL::DMA) asm volatile("s_waitcnt vmcnt(6)" ::: "memory"); else asm volatile("s_waitcnt vmcnt(4)" ::: "memory"); } else asm volatile("s_waitcnt vmcnt(0)" ::: "memory");
    G2_BARRIER();
    for (int kt = 0; kt < nk; ++kt) {
        const char* st = smem + (kt % 3) * G2_STAGE;
        const bool more = kt + 2 < nk;
        if (more) G2_ISSUE(kt + 2);
        bf16x8 af[4];
#pragma unroll
        for (int i = 0; i < 4; ++i) af[i] = *(const bf16x8*)(st + fa0 + i * 1024);
#pragma unroll
        for (int j = 0; j < 8; ++j) {
            const bf16x8 bf_ = *(const bf16x8*)(st + fb0 + j * 1024);
#pragma unroll
            for (int i = 0; i < 4; ++i) acc[i][j] = __builtin_amdgcn_mfma_f32_16x16x32_bf16(bf_, af[i], acc[i][j], 0, 0, 0);
        }
        if (more) G2_AWRITE(kt + 2);
        if (more) { if (AL::DMA) asm volatile("s_waitcnt vmcnt(6)" ::: "memory"); else asm volatile("s_waitcnt vmcnt(4)" ::: "memory"); } else asm volatile("s_waitcnt vmcnt(0)" ::: "memory");
        G2_BARRIER();
    }
#undef G2_ISSUE
#undef G2_AWRITE
#undef G2_BARRIER
#pragma unroll
    for (int mt = 0; mt < 4; ++mt)
#pragma unroll
        for (int gi = 0; gi < 4; ++gi) {
            float v[8];
#pragma unroll
            for (int r = 0; r < 4; ++r) { v[r] = acc[mt][2 * gi][r]; v[4 + r] = acc[mt][2 * gi + 1][r]; }
            epi(m0 + wr * 64 + mt * 16 + l15, n0 + wc * 128 + gi * 32 + 8 * q, v, mt, gi);
        }
    epi.finish_wide(m0, n0, wr, wc, lane);
}
template <class F>
DI void gemm_sched(int nbig, int nsmall, F&& f) {
    const int x = blockIdx.x & 7, lb = blockIdx.x >> 3, nlb = gridDim.x >> 3;
    const int nb16 = 16 * nbig, tot = 16 * (nbig + nsmall);
    for (int s = lb; s < tot; s += nlb) {
        if (s < nb16) f(true, x * 16 + (s & 15), s >> 4);
        else { const int t = s - nb16; f(false, x * 16 + (t & 15), t >> 4); }
    }
}

DI float rstd_from_parts(const float* parts, int m) {
    const float4* p = (const float4*)(parts + (size_t)m * 16); float s = 0.f;
#pragma unroll
    for (int i = 0; i < 4; ++i) { const float4 v = p[i]; s += (v.x + v.y) + (v.z + v.w); }
    return 1.0f / sqrtf(s * (1.0f / D) + 1e-6f);
}
DI void store8bf(bf16* p, const float* v) { *(u32x4*)p = (u32x4){pack2bf(v[0], v[1]), pack2bf(v[2], v[3]), pack2bf(v[4], v[5]), pack2bf(v[6], v[7])}; }

struct EpiBf16 {
    bf16* P; int ldp; const float* parts; mutable float rsc[4];
    DI void operator()(int m, int n, const float* v, int mt, int gi) const {
        if (gi == 0) rsc[mt] = parts ? rstd_from_parts(parts, m) : 1.0f;
        float s = rsc[mt]; float w[8];
#pragma unroll
        for (int j = 0; j < 8; ++j) w[j] = v[j] * s;
        store8bf(P + (size_t)m * ldp + n, w);
    }
    DI void finish(int, int, int, int, int) const {}
    DI void finish_wide(int, int, int, int, int) const {}
};
struct EpiResid {
    const float* xin; float* xout; bf16* xb; float* parts; mutable float sq[4];
    DI void operator()(int m, int n, const float* v, int mt, int gi) const {
        const float4* xi = (const float4*)(xin + (size_t)m * D + n); const float4 a = xi[0], b = xi[1];
        float w[8] = {a.x + v[0], a.y + v[1], a.z + v[2], a.w + v[3], b.x + v[4], b.y + v[5], b.z + v[6], b.w + v[7]};
        float4* xo = (float4*)(xout + (size_t)m * D + n);
        xo[0] = make_float4(w[0], w[1], w[2], w[3]); xo[1] = make_float4(w[4], w[5], w[6], w[7]);
        if (xb) store8bf(xb + (size_t)m * D + n, w);
        float s = 0.f;
#pragma unroll
        for (int j = 0; j < 8; ++j) s += w[j] * w[j];
        if (gi == 0) sq[mt] = s; else sq[mt] += s;
    }
    DI void finish(int m0, int n0, int wr, int wc, int lane) const {
#pragma unroll
        for (int mt = 0; mt < 4; ++mt) {
            float s = sq[mt]; s += __shfl_xor(s, 16); s += __shfl_xor(s, 32);
            if (lane < 16) parts[(size_t)(m0 + wr * 64 + mt * 16 + lane) * 16 + (n0 >> 7) * 2 + wc] = s;
        }
    }
    DI void finish_wide(int m0, int n0, int wr, int wc, int lane) const {
#pragma unroll
        for (int mt = 0; mt < 4; ++mt) {
            float s = sq[mt]; s += __shfl_xor(s, 16); s += __shfl_xor(s, 32);
            if (lane < 16) { float* pr = parts + (size_t)(m0 + wr * 64 + mt * 16 + lane) * 16 + (n0 >> 7) + wc; pr[0] = s; pr[8] = 0.f; }
        }
    }
};
struct EpiRwkv {
    bf16* P; float* hw; float* ha;
    DI void operator()(int m, int n, const float* v, int, int) const {
        if (n < 4096) { store8bf(P + (size_t)m * 4096 + n, v); return; }
        const int c = n - 4096;
        if (c < 64) { float4* o = (float4*)(hw + (size_t)m * 64 + c); o[0] = make_float4(tanhf(v[0]), tanhf(v[1]), tanhf(v[2]), tanhf(v[3])); o[1] = make_float4(tanhf(v[4]), tanhf(v[5]), tanhf(v[6]), tanhf(v[7])); }
        else if (c >= 128 && c < 192) { float4* o = (float4*)(ha + (size_t)m * 64 + (c - 128)); o[0] = make_float4(v[0], v[1], v[2], v[3]); o[1] = make_float4(v[4], v[5], v[6], v[7]); }
    }
    DI void finish(int, int, int, int, int) const {}
    DI void finish_wide(int, int, int, int, int) const {}
};

namespace at {
constexpr int OFF_BIAS = 49152;
constexpr int OFF_X = 61952;
constexpr int OFF_IMP = 49152;
constexpr float L2E = 1.4426950408889634f;
constexpr float NEG_MASK = -1e30f, M_INIT = -1e20f;
}
enum { AM_SWA = 0, AM_WIN = 1, AM_CMP = 2, AM_SEL = 3 };
DI int vt_perm(int k32) { return ((k32 & 15) >> 2) * 8 + (k32 >> 4) * 4 + (k32 & 3); }
DI float fast_exp2(float x) { return __builtin_amdgcn_exp2f(x); }

DI void build_bias_lut(const float* __restrict__ t5, char* smem, bool swa) {
    float* lut = (float*)(smem + at::OFF_BIAS);
    for (int i = TIDX; i < 16 * 200; i += NTHREADS) {
        const int h = i / 200, e = i % 200; float v = at::NEG_MASK;
        if (e >= 64 && e < 192) v = t5[t5_bucket(e - 64) * 16 + h] * at::L2E;
        else if (e >= 192 && !swa) v = t5[31 * 16 + h] * at::L2E;
        lut[i] = v;
    }
    __syncthreads();
}

template <int NQT> struct AttnStateT { f32x4 o[NQT][4]; f32x4 lacc[NQT]; float m[NQT]; };
#ifndef ANQT_SWA
#define ANQT_SWA 4
#endif
#ifndef ANQT_WIN
#define ANQT_WIN 2
#endif
#ifndef ANQT_SEL
#define ANQT_SEL 4
#endif
DI unsigned long long range_mask(int lo, int hi) { return (hi >= 63 ? ~0ull : ((1ull << (hi + 1)) - 1ull)) & ~((1ull << lo) - 1ull); }

template <int NQT>
DI void attn_load_q(bf16x8 (&qf)[NQT][2], const bf16* __restrict__ Qp, int ldq, size_t mbase, int hbase) {
    const int lane = TIDX & 63, wave = TIDX >> 6, q = lane >> 4, l15 = lane & 15;
#pragma unroll
    for (int qt = 0; qt < NQT; ++qt) {
        const size_t m = mbase + wave * (4 * NQT) + qt * 4 + (l15 >> 2);
#pragma unroll
        for (int ks = 0; ks < 2; ++ks) qf[qt][ks] = *(const bf16x8*)(Qp + m * ldq + (hbase + (l15 & 3)) * 64 + ks * 32 + q * 8);
    }
}

enum { SK_FAR = 0, SK_NEAR = 1, SK_EDGE = 2, SK_CMP = 3 };
template <int KIND>
DI float attn_fix(f32x4 (&s)[4], int dbase, float cadd, const float* __restrict__ bl, float mx) {
#pragma unroll
    for (int kt = 0; kt < 4; ++kt)
#pragma unroll
        for (int r = 0; r < 4; ++r) {
            float v = s[kt][r]; const int dist = dbase - (kt * 16 + r);
            if (KIND == SK_NEAR) { int idx = dist + 64; idx = idx < 0 ? 0 : (idx > 192 ? 192 : idx); v += bl[idx] + cadd; }
            else if (KIND == SK_EDGE) v = dist < 512 ? v + cadd : at::NEG_MASK;
            else if (KIND == SK_CMP) v = dist >= 0 ? v : at::NEG_MASK;
            if (KIND != SK_FAR) s[kt][r] = v;
            mx = fmaxf(mx, v);
        }
    return mx;
}
template <int MODE, int NQT>
DI void attn_blocks(AttnStateT<NQT>& st, const bf16x8 (&qf)[NQT][2], const bf16* __restrict__ Kp, size_t krs, const bf16* __restrict__ Vp, size_t vrs,
                    int t0, unsigned long long todo, int hbase, const unsigned long long (&sel)[NQT], char* smem) {
    const int tid = TIDX, lane = tid & 63, wave = __builtin_amdgcn_readfirstlane(tid >> 6), q = lane >> 4, l15 = lane & 15;
    const int tq0 = t0 + wave * (4 * NQT) + (l15 >> 2);
    const float* bl = (const float*)(smem + at::OFF_BIAS) + (hbase + (l15 & 3)) * 200;
    const float bfar = (MODE != AM_CMP) ? bl[192] : 0.f;
    const int srow = tid >> 3, scs = (tid & 7) ^ (srow & 7);
    const int fo = l15 * 128 + ((q ^ (l15 & 7)) << 4);
#define ATT_DMA(kb_, slot_) { _Pragma("unroll") for (int i = 0; i < 2; ++i) { const int row = srow + 32 * i; char* dst = smem + (slot_) * 16384 + (8 * wave + 32 * i) * 128; \
        GLDS16(Kp + (size_t)((kb_) * 64 + row) * krs + scs * 8, dst); GLDS16(Vp + (size_t)row * vrs + (kb_) * 64 + scs * 8, dst + 8192); } }
#define ATT_BARRIER() { asm volatile("s_waitcnt lgkmcnt(0)" ::: "memory"); __builtin_amdgcn_s_barrier(); asm volatile("" ::: "memory"); }
    if (todo == 0ull) return;
    int kb = __builtin_ctzll(todo); todo &= todo - 1ull;
    int kb1 = -1; if (todo) { kb1 = __builtin_ctzll(todo); todo &= todo - 1ull; }
    ATT_DMA(kb, 0);
    if (kb1 >= 0) { ATT_DMA(kb1, 1); asm volatile("s_waitcnt vmcnt(4)" ::: "memory"); } else { asm volatile("s_waitcnt vmcnt(0)" ::: "memory"); }
    ATT_BARRIER();
    int slot = 0;
    for (;;) {
        char* buf = smem + slot * 16384;
        int kb2 = -1; if (todo) { kb2 = __builtin_ctzll(todo); todo &= todo - 1ull; }
        if (kb2 >= 0) { const int s2 = slot >= 1 ? slot - 1 : 2; ATT_DMA(kb2, s2); }
        f32x4 s[NQT][4];
#pragma unroll
        for (int qt = 0; qt < NQT; ++qt)
#pragma unroll
            for (int kt = 0; kt < 4; ++kt) s[qt][kt] = (f32x4){0.f, 0.f, 0.f, 0.f};
#pragma unroll
        for (int kt = 0; kt < 4; ++kt)
#pragma unroll
            for (int ks = 0; ks < 2; ++ks) {
                const bf16x8 kf = *(const bf16x8*)(buf + ((fo + kt * 2048) ^ (ks << 6)));
#pragma unroll
                for (int qt = 0; qt < NQT; ++qt) s[qt][kt] = __builtin_amdgcn_mfma_f32_16x16x32_bf16(kf, qf[qt][ks], s[qt][kt], 0, 0, 0);
            }
        const int mind = (t0 + wave * (4 * NQT)) - (kb * 64 + 63), maxd = (t0 + wave * (4 * NQT) + 4 * NQT - 1) - kb * 64;
        float mx[NQT], cofs[NQT];
#pragma unroll
        for (int qt = 0; qt < NQT; ++qt) cofs[qt] = 0.f;
        if (MODE == AM_CMP) {
#pragma unroll
            for (int qt = 0; qt < NQT; ++qt) { const int nlim = (tq0 + 4 * qt - 31) >> 4; mx[qt] = attn_fix<SK_CMP>(s[qt], nlim - (kb * 64 + 4 * q), 0.f, bl, at::NEG_MASK); }
        } else {
            float cadd[NQT];
#pragma unroll
            for (int qt = 0; qt < NQT; ++qt) cadd[qt] = (MODE == AM_SEL && !((sel[qt] >> kb) & 1ull)) ? at::NEG_MASK : 0.f;
            if (MODE == AM_SWA || mind < 113) {
#pragma unroll
                for (int qt = 0; qt < NQT; ++qt) mx[qt] = attn_fix<SK_NEAR>(s[qt], tq0 + 4 * qt - (kb * 64 + 4 * q), cadd[qt], bl, at::NEG_MASK);
            } else if (MODE == AM_WIN && maxd >= 512) {
#pragma unroll
                for (int qt = 0; qt < NQT; ++qt) mx[qt] = attn_fix<SK_EDGE>(s[qt], tq0 + 4 * qt - (kb * 64 + 4 * q), bfar, bl, at::NEG_MASK);
            } else {
#pragma unroll
                for (int qt = 0; qt < NQT; ++qt) { cofs[qt] = bfar + cadd[qt]; mx[qt] = attn_fix<SK_FAR>(s[qt], 0, 0.f, bl, at::NEG_MASK) + cofs[qt]; }
            }
        }
        float msub[NQT]; bool grow = false;
#pragma unroll
        for (int qt = 0; qt < NQT; ++qt) {
            float m2 = mx[qt];
            m2 = fmaxf(m2, __shfl_xor(m2, 16)); m2 = fmaxf(m2, __shfl_xor(m2, 32));
            const bool g = m2 > st.m[qt] + 4.0f; grow |= g;
            mx[qt] = g ? m2 : st.m[qt];
            msub[qt] = mx[qt] - cofs[qt];
        }
        if (__any(grow)) {
#pragma unroll
            for (int qt = 0; qt < NQT; ++qt) {
                const float alpha = fast_exp2(st.m[qt] - mx[qt]);
#pragma unroll
                for (int dt = 0; dt < 4; ++dt) st.o[qt][dt] *= alpha;
                st.lacc[qt] *= alpha;
            }
        }
#pragma unroll
        for (int qt = 0; qt < NQT; ++qt) st.m[qt] = mx[qt];
#pragma unroll
        for (int qt = 0; qt < NQT; ++qt)
#pragma unroll
            for (int kt = 0; kt < 4; ++kt)
#pragma unroll
                for (int r = 0; r < 4; ++r) s[qt][kt][r] = fast_exp2(s[qt][kt][r] - msub[qt]);
        const bf16x8 ones = {(short)0x3F80, (short)0x3F80, (short)0x3F80, (short)0x3F80, (short)0x3F80, (short)0x3F80, (short)0x3F80, (short)0x3F80};
#pragma unroll
        for (int kp = 0; kp < 2; ++kp) {
            bf16x8 pf[NQT];
#pragma unroll
            for (int qt = 0; qt < NQT; ++qt) {
                const u32x4 w = {pack2bf(s[qt][2 * kp][0], s[qt][2 * kp][1]), pack2bf(s[qt][2 * kp][2], s[qt][2 * kp][3]),
                                 pack2bf(s[qt][2 * kp + 1][0], s[qt][2 * kp + 1][1]), pack2bf(s[qt][2 * kp + 1][2], s[qt][2 * kp + 1][3])};
                pf[qt] = __builtin_bit_cast(bf16x8, w);
            }
#pragma unroll
            for (int qt = 0; qt < NQT; ++qt) st.lacc[qt] = __builtin_amdgcn_mfma_f32_16x16x32_bf16(ones, pf[qt], st.lacc[qt], 0, 0, 0);
#pragma unroll
            for (int dt = 0; dt < 4; ++dt) {
                const bf16x8 vf = *(const bf16x8*)(buf + 8192 + ((fo + dt * 2048) ^ (kp << 6)));
#pragma unroll
                for (int qt = 0; qt < NQT; ++qt) st.o[qt][dt] = __builtin_amdgcn_mfma_f32_16x16x32_bf16(vf, pf[qt], st.o[qt][dt], 0, 0, 0);
            }
        }
        if (kb1 < 0) break;
        if (kb2 >= 0) { asm volatile("s_waitcnt vmcnt(4)" ::: "memory"); } else { asm volatile("s_waitcnt vmcnt(0)" ::: "memory"); }
        ATT_BARRIER();
        kb = kb1; kb1 = kb2; slot = slot == 2 ? 0 : slot + 1;
    }
    ATT_BARRIER();
#undef ATT_DMA
}
template <int NQT>
DI void attn_init(AttnStateT<NQT>& st, float m0, float l0) {
#pragma unroll
    for (int qt = 0; qt < NQT; ++qt) { st.m[qt] = m0; st.lacc[qt] = (f32x4){l0, l0, l0, l0};
#pragma unroll
        for (int dt = 0; dt < 4; ++dt) st.o[qt][dt] = (f32x4){0.f, 0.f, 0.f, 0.f}; }
}
DI float attn_linv(const f32x4& lacc) { const float l = lacc[0]; return l > 0.f ? 1.0f / l : 0.f; }

template <int TT>
DI void attn_item_decode(int item, int& b, int& g, int& t0) {
    constexpr int tiles = T / TT;
    const int Gd = (int)gridDim.x;
    int pair, tile;
    if ((Gd % tiles) == 0 && tiles * B * G % Gd == 0) {
        const int bid = item % Gd, rr = item / Gd, tau = bid % tiles;
        pair = bid / tiles + (Gd / tiles) * rr; tile = (rr & 1) ? tiles - 1 - tau : tau;
    } else { tile = item % tiles; pair = item / tiles; }
    t0 = tile * TT; g = pair % G; b = pair / G;
}
DI void swa_item(const bf16* __restrict__ P0, const bf16* __restrict__ VT, const float* __restrict__ sinks, bf16* __restrict__ AO, int item, char* smem) {
    constexpr int LDP = 2304;
    constexpr int NQT = ANQT_SWA;
    int b, g, t0; attn_item_decode<16 * NQT>(item, b, g, t0);
    const int lane = TIDX & 63, wave = TIDX >> 6, q = lane >> 4, l15 = lane & 15;
    const size_t mbase = (size_t)b * T + t0; const int hbase = g * 4, h = hbase + (l15 & 3);
    bf16x8 qf[NQT][2]; attn_load_q<NQT>(qf, P0, LDP, mbase, hbase);
    AttnStateT<NQT> st; attn_init<NQT>(st, sinks[h] * at::L2E, 1.0f);
    const int lo = t0 - 127 < 0 ? 0 : (t0 - 127) >> 6, hi = (t0 + 16 * NQT - 1) >> 6;
    const unsigned long long nosel[NQT] = {};
    attn_blocks<AM_SWA, NQT>(st, qf, P0 + (size_t)b * T * LDP + 1024 + g * 64, LDP, VT + (size_t)(b * G + g) * 64 * T, T, t0, range_mask(lo, hi), hbase, nosel, smem);
#pragma unroll
    for (int qt = 0; qt < NQT; ++qt) {
        const float li = attn_linv(st.lacc[qt]); const size_t m = mbase + wave * (4 * NQT) + qt * 4 + (l15 >> 2);
#pragma unroll
        for (int dt = 0; dt < 4; ++dt) {
            const int d0 = dt * 16 + 4 * q; const u32x2 zz = *(const u32x2*)(P0 + m * LDP + 1280 + h * 64 + d0);
            const float z0 = bflo(zz[0]), z1 = bfhi(zz[0]), z2 = bflo(zz[1]), z3 = bfhi(zz[1]);
            const f32x4 o = st.o[qt][dt];
            *(u32x2*)(AO + m * D + h * 64 + d0) = (u32x2){pack2bf(o[0] * li * siluf_(z0), o[1] * li * siluf_(z1)), pack2bf(o[2] * li * siluf_(z2), o[3] * li * siluf_(z3))};
        }
    }
}

struct EpiL0 {
    bf16* P0; bf16* VT; const float* parts; mutable float rsc[4];
    DI void operator()(int m, int n, const float* v, int mt, int gi) const {
        if (gi == 0) rsc[mt] = rstd_from_parts(parts, m);
        float s = rsc[mt]; if (n < 1024) s *= 0.125f * at::L2E; float w[8];
#pragma unroll
        for (int j = 0; j < 8; ++j) w[j] = v[j] * s;
        if (n < 1280) store8bf(P0 + (size_t)m * 2304 + n, w);
        else if (n >= 1536) store8bf(P0 + (size_t)m * 2304 + n - 256, w);
        else {
            const int g = (n - 1280) >> 6, d = (n - 1280) & 63, b = m / T, t = m % T; const int pos = (t & ~31) + vt_perm(t & 31);
            bf16* dst = VT + ((size_t)(b * G + g) * 64 + d) * T + pos;
#pragma unroll
            for (int j = 0; j < 8; ++j) dst[(size_t)j * T] = f2bf(w[j]);
        }
    }
    DI void finish(int, int, int, int, int) const {}
    DI void finish_wide(int, int, int, int, int) const {}
};

constexpr int LDP2 = 3200;
struct EpiL2 {
    bf16* P2; bf16* VTs; bf16* VTw; const float* parts; mutable float rsc[4];
    DI void operator()(int m, int n, const float* v, int mt, int gi) const {
        if (gi == 0) rsc[mt] = rstd_from_parts(parts, m);
        if (n >= C_COLS) return;
        float s = rsc[mt]; if (n < 1024) s *= 0.125f * at::L2E; float w[8];
#pragma unroll
        for (int j = 0; j < 8; ++j) w[j] = v[j] * s;
        const bool isvs = n >= 1792 && n < 2048, isvw = n >= 2304 && n < 2560;
        if (isvs || isvw) {
            const int c = n - (isvs ? 1792 : 2304); const int g = c >> 6, d = c & 63, b = m / T, t = m % T; const int pos = (t & ~31) + vt_perm(t & 31);
            bf16* dst = (isvs ? VTs : VTw) + ((size_t)(b * G + g) * 64 + d) * T + pos;
#pragma unroll
            for (int j = 0; j < 8; ++j) dst[(size_t)j * T] = f2bf(w[j]);
        } else {
            const int c = n < 1792 ? n : (n < 2304 ? n - 256 : n - 512);
            store8bf(P2 + (size_t)m * LDP2 + c, w);
        }
    }
    DI void finish(int, int, int, int, int) const {}
    DI void finish_wide(int, int, int, int, int) const {}
};

struct ALoadCmp {
    const bf16* P2; int col;
    static constexpr bool DMA = true;
    DI const bf16* src(int row, int k) const {
        int n = row & 255; const int bg = row >> 8, b = bg >> 2, g = bg & 3; const int l = k >> 6, d = k & 63; n = n < NCMP ? n : NCMP - 1;
        return P2 + (size_t)(b * T + 16 * n + l) * LDP2 + col + g * 64 + d;
    }
    struct Raw { u32x4 v; };
    DI Raw load(int row, int k) const {
        const int n = row & 255, bg = row >> 8, b = bg >> 2, g = bg & 3; const int l = k >> 6, d = k & 63; Raw r;
        if (n < NCMP) r.v = *(const u32x4*)(P2 + (size_t)(b * T + 16 * n + l) * LDP2 + col + g * 64 + d); else r.v = (u32x4){0u, 0u, 0u, 0u};
        return r;
    }
    DI u32x4 finish(const Raw& r, int, int) const { return r.v; }
};
struct EpiCmpH {
    char* smem; const float* bias8;
    DI void operator()(int m, int n, const float* v, int, int) const {
        const int row = m & 127; float w[8];
#pragma unroll
        for (int j = 0; j < 8; ++j) { float bsum = 0.f;
#pragma unroll
            for (int i = 0; i < 8; ++i) bsum += bias8[i * 128 + n + j];
            w[j] = siluf_(v[j] + bsum); }
        const int kk = n >> 6, c = (n & 63) >> 3;
        *(u32x4*)(smem + kk * 16384 + row * 128 + ((c ^ (row & 7)) << 4)) = (u32x4){pack2bf(w[0], w[1]), pack2bf(w[2], w[3]), pack2bf(w[4], w[5]), pack2bf(w[6], w[7])};
    }
    DI void finish(int, int, int, int, int) const {}
    DI void finish_wide(int, int, int, int, int) const {}
};
DI void cmp_tile(const bf16* __restrict__ P2, const bf16* __restrict__ w1t, const float* __restrict__ bias8, const bf16* __restrict__ w2t, int which, int rt,
                 bf16* __restrict__ KCb, bf16* __restrict__ VCT, char* smem) {
    gemm_tile(ALoadCmp{P2, which ? 1280 : 1024}, w1t, 2048, rt * 128, 0, EpiCmpH{smem, bias8}, smem);
    const int tid = TIDX, lane = tid & 63, wave = tid >> 6, q = lane >> 4, l15 = lane & 15;
#pragma unroll
    for (int i = 0; i < 4; ++i) {
        const int id = i * 256 + tid; const int row = id >> 4, c16 = id & 15, kk = c16 >> 3, c = c16 & 7;
        *(u32x4*)(smem + 32768 + kk * 8192 + row * 128 + ((c ^ (row & 7)) << 4)) = *(const u32x4*)(w2t + (size_t)row * 128 + c16 * 8);
    }
    __syncthreads();
    f32x4 acc[2][4];
#pragma unroll
    for (int i = 0; i < 2; ++i)
#pragma unroll
        for (int j = 0; j < 4; ++j) acc[i][j] = (f32x4){0.f, 0.f, 0.f, 0.f};
    const int fo = l15 * 128 + ((q ^ (l15 & 7)) << 4);
#pragma unroll
    for (int kk = 0; kk < 2; ++kk)
#pragma unroll
        for (int ks = 0; ks < 2; ++ks) {
            bf16x8 hf[2], wf[4];
#pragma unroll
            for (int i = 0; i < 2; ++i) hf[i] = *(const bf16x8*)(smem + kk * 16384 + (((wave * 32 + i * 16) * 128 + fo) ^ (ks << 6)));
#pragma unroll
            for (int j = 0; j < 4; ++j) wf[j] = *(const bf16x8*)(smem + 32768 + kk * 8192 + ((j * 2048 + fo) ^ (ks << 6)));
#pragma unroll
            for (int i = 0; i < 2; ++i)
#pragma unroll
                for (int j = 0; j < 4; ++j) acc[i][j] = __builtin_amdgcn_mfma_f32_16x16x32_bf16(wf[j], hf[i], acc[i][j], 0, 0, 0);
        }
#pragma unroll
    for (int i = 0; i < 2; ++i) {
        const int row = rt * 128 + wave * 32 + i * 16 + l15; const int n = row & 255, bg = row >> 8;
#pragma unroll
        for (int j = 0; j < 4; ++j) {
            const int d0 = j * 16 + 4 * q; const f32x4 a = acc[i][j];
            if (which == 0) *(u32x2*)(KCb + (size_t)row * 64 + d0) = (u32x2){pack2bf(a[0], a[1]), pack2bf(a[2], a[3])};
            else {
                const int pos = (n & ~31) + vt_perm(n & 31);
#pragma unroll
                for (int r = 0; r < 4; ++r) VCT[((size_t)bg * 64 + d0 + r) * 256 + pos] = f2bf(a[r]);
            }
        }
    }
    __syncthreads();
}

DI void win_item(const bf16* __restrict__ P2, const bf16* __restrict__ VTw, bf16* __restrict__ OW, int item, char* smem) {
    constexpr int NQT = ANQT_WIN;
    int b, g, t0; attn_item_decode<16 * NQT>(item, b, g, t0);
    const int lane = TIDX & 63, wave = TIDX >> 6, q = lane >> 4, l15 = lane & 15;
    const size_t mbase = (size_t)b * T + t0; const int hbase = g * 4, h = hbase + (l15 & 3);
    bf16x8 qf[NQT][2]; attn_load_q<NQT>(qf, P2, LDP2, mbase, hbase);
    AttnStateT<NQT> st; attn_init<NQT>(st, at::M_INIT, 0.f);
    const int lo = t0 - 511 < 0 ? 0 : (t0 - 511) >> 6, hi = (t0 + 16 * NQT - 1) >> 6;
    const unsigned long long nosel[NQT] = {};
    attn_blocks<AM_WIN, NQT>(st, qf, P2 + (size_t)b * T * LDP2 + 1792 + g * 64, LDP2, VTw + (size_t)(b * G + g) * 64 * T, T, t0, range_mask(lo, hi), hbase, nosel, smem);
#pragma unroll
    for (int qt = 0; qt < NQT; ++qt) {
        const float li = attn_linv(st.lacc[qt]); const size_t m = mbase + wave * (4 * NQT) + qt * 4 + (l15 >> 2);
#pragma unroll
        for (int dt = 0; dt < 4; ++dt) { const f32x4 o = st.o[qt][dt]; *(u32x2*)(OW + m * D + h * 64 + dt * 16 + 4 * q) = (u32x2){pack2bf(o[0] * li, o[1] * li), pack2bf(o[2] * li, o[3] * li)}; }
    }
}

DI void cmpsel_item(const bf16* __restrict__ P2, const bf16* __restrict__ KCb, const bf16* __restrict__ VCT, bf16* __restrict__ OC, unsigned long long* __restrict__ SELM, int item, char* smem) {
    int b, g, t0; attn_item_decode<32>(item, b, g, t0);
    const int tid = TIDX, lane = tid & 63, wave = tid >> 6, q = lane >> 4, l15 = lane & 15;
    const size_t mbase = (size_t)b * T + t0; const int hbase = g * 4, h = hbase + (l15 & 3);
    float* impL = (float*)(smem + at::OFF_IMP);
    for (int i = tid; i < 32 * 64; i += NTHREADS) impL[i] = 0.f;
    bf16x8 qf[2][2]; attn_load_q<2>(qf, P2, LDP2, mbase, hbase);
    AttnStateT<2> st; attn_init<2>(st, at::M_INIT, 0.f);
    const int nvmax = (t0 + 31 - 31) / 16 + 1;
    const int hi = (nvmax - 1) >> 6;
    const bf16* Kp = KCb + (size_t)(b * G + g) * 256 * 64; const bf16* Vp = VCT + (size_t)(b * G + g) * 64 * 256;
    const unsigned long long nosel[2] = {0ull, 0ull};
    attn_blocks<AM_CMP, 2>(st, qf, Kp, 64, Vp, 256, t0, range_mask(0, hi), hbase, nosel, smem);
    float linv[2];
#pragma unroll
    for (int qt = 0; qt < 2; ++qt) {
        linv[qt] = attn_linv(st.lacc[qt]); const size_t m = mbase + wave * 8 + qt * 4 + (l15 >> 2);
#pragma unroll
        for (int dt = 0; dt < 4; ++dt) { const f32x4 o = st.o[qt][dt]; *(u32x2*)(OC + m * D + h * 64 + dt * 16 + 4 * q) = (u32x2){pack2bf(o[0] * linv[qt], o[1] * linv[qt]), pack2bf(o[2] * linv[qt], o[3] * linv[qt])}; }
    }
    {
        const int tq0 = t0 + wave * 8 + (l15 >> 2);
        const bf16* kp0 = Kp + (size_t)l15 * 64 + q * 8;
        bf16x8 kfA[4][2], kfB[4][2];
#define CS_LOADK(dst_, kb_) { _Pragma("unroll") for (int kt = 0; kt < 4; ++kt) _Pragma("unroll") for (int ks = 0; ks < 2; ++ks) \
            dst_[kt][ks] = *(const bf16x8*)(kp0 + (size_t)((kb_) * 64 + kt * 16) * 64 + ks * 32); }
#define CS_QSUM(x_) { x_ += __builtin_bit_cast(float, __builtin_amdgcn_update_dpp(0, __builtin_bit_cast(int, x_), 0xB1, 0xf, 0xf, false)); \
                      x_ += __builtin_bit_cast(float, __builtin_amdgcn_update_dpp(0, __builtin_bit_cast(int, x_), 0x4E, 0xf, 0xf, false)); }
#define CS_BLOCK(kf_, kb_) { const int kbi = (kb_); \
            f32x4 s[2][4]; \
            _Pragma("unroll") for (int qt = 0; qt < 2; ++qt) _Pragma("unroll") for (int kt = 0; kt < 4; ++kt) s[qt][kt] = (f32x4){0.f, 0.f, 0.f, 0.f}; \
            _Pragma("unroll") for (int kt = 0; kt < 4; ++kt) _Pragma("unroll") for (int ks = 0; ks < 2; ++ks) { \
                s[0][kt] = __builtin_amdgcn_mfma_f32_16x16x32_bf16(kf_[kt][ks], qf[0][ks], s[0][kt], 0, 0, 0); \
                s[1][kt] = __builtin_amdgcn_mfma_f32_16x16x32_bf16(kf_[kt][ks], qf[1][ks], s[1][kt], 0, 0, 0); } \
            const bool allvis = 16 * (kbi * 64 + 63) + 31 <= t0;         \
            _Pragma("unroll") for (int qt = 0; qt < 2; ++qt) { \
                const int tq = tq0 + 4 * qt; const int tl = wave * 8 + qt * 4 + (l15 >> 2); \
                _Pragma("unroll") for (int kt = 0; kt < 4; ++kt) { \
                    float pr[4]; \
                    _Pragma("unroll") for (int r = 0; r < 4; ++r) { const int key = kbi * 64 + kt * 16 + 4 * q + r; \
                        const float e = fast_exp2(s[qt][kt][r] - st.m[qt]) * linv[qt]; pr[r] = (allvis || 16 * key + 31 <= tq) ? e : 0.f; } \
                    float s4 = (pr[0] + pr[1]) + (pr[2] + pr[3]), s1 = pr[3]; \
                    CS_QSUM(s4); CS_QSUM(s1); \
                    const int s0 = kbi * 16 + kt * 4 + q; \
                    if ((l15 & 3) == 0) { atomicAdd(&impL[tl * 64 + s0], s4); if (s0 + 1 < 64) atomicAdd(&impL[tl * 64 + s0 + 1], s1); } \
                } \
            } }
        CS_LOADK(kfA, 0);
        for (int kb = 0; kb <= hi; kb += 2) {
            if (kb + 1 <= hi) CS_LOADK(kfB, kb + 1);
            CS_BLOCK(kfA, kb);
            if (kb + 1 > hi) break;
            if (kb + 2 <= hi) CS_LOADK(kfA, kb + 2);
            CS_BLOCK(kfB, kb + 1);
        }
#undef CS_LOADK
#undef CS_QSUM
#undef CS_BLOCK
        __syncthreads();
    }
    {
        const int tl = tid >> 3, sg = tid & 7; const int t = t0 + tl, cur = t >> 6; float* row = impL + tl * 64;
        unsigned hk[8]; unsigned long long mine[8];
#pragma unroll
        for (int j = 0; j < 8; ++j) { const int s = sg * 8 + j; const float v = row[s];
            hk[j] = (s == 0 || s == cur || s == cur - 1) ? 0x7F800000u : (s * 64 > t ? 0u : (v > 0.f ? __float_as_uint(v) + 1u : 1u));
            mine[j] = ((unsigned long long)hk[j] << 32) | (unsigned)(63 - s); }
        __syncthreads();
#pragma unroll
        for (int j = 0; j < 8; ++j) ((unsigned*)row)[sg * 8 + j] = hk[j];
        __syncthreads();
        int rank[8] = {0, 0, 0, 0, 0, 0, 0, 0};
        const int ns4 = ((((t0 + 31) >> 6) >> 2) + 2) & ~1;
#pragma unroll 2
        for (int s4 = 0; s4 < ns4; ++s4) {
            const u32x4 v4 = *(const u32x4*)(row + s4 * 4);
#pragma unroll
            for (int e = 0; e < 4; ++e) { const unsigned long long kv = ((unsigned long long)v4[e] << 32) | (unsigned)(63 - (s4 * 4 + e));
#pragma unroll
                for (int j = 0; j < 8; ++j) rank[j] += kv > mine[j] ? 1 : 0; }
        }
        unsigned long long bits = 0ull;
#pragma unroll
        for (int j = 0; j < 8; ++j) if (rank[j] < KTOP && (sg * 8 + j) * 64 <= t) bits |= 1ull << (sg * 8 + j);
        unsigned lo = (unsigned)bits, hi2 = (unsigned)(bits >> 32);
#pragma unroll
        for (int o = 1; o < 8; o <<= 1) { lo |= __shfl_xor(lo, o); hi2 |= __shfl_xor(hi2, o); }
        if (sg == 0) SELM[(mbase + tl) * 4 + g] = ((unsigned long long)hi2 << 32) | lo;
    }
    __syncthreads();
}

DI void sel_item(const bf16* __restrict__ P2, const bf16* __restrict__ VTs, const unsigned long long* __restrict__ SELM, const bf16* __restrict__ OC, const bf16* __restrict__ OW,
                 bf16* __restrict__ AO, int item, char* smem) {
    constexpr int NQT = ANQT_SEL;
    int b, g, t0; attn_item_decode<16 * NQT>(item, b, g, t0);
    const int tid = TIDX, lane = tid & 63, wave = tid >> 6, q = lane >> 4, l15 = lane & 15;
    const size_t mbase = (size_t)b * T + t0; const int hbase = g * 4, rr = l15 & 3, h = hbase + rr;
    unsigned long long* orw = (unsigned long long*)(smem + at::OFF_X);
    if (tid == 0) *orw = 0ull;
    __syncthreads();
    if (tid < 16 * NQT) atomicOr(orw, SELM[(mbase + tid) * 4 + g]);
    unsigned long long sel[NQT];
#pragma unroll
    for (int qt = 0; qt < NQT; ++qt) sel[qt] = SELM[(mbase + wave * (4 * NQT) + qt * 4 + (l15 >> 2)) * 4 + g];
    bf16x8 qf[NQT][2]; attn_load_q<NQT>(qf, P2, LDP2, mbase, hbase);
    AttnStateT<NQT> st; attn_init<NQT>(st, at::M_INIT, 0.f);
    __syncthreads();
    const unsigned long long todo_v = (*orw) & range_mask(0, (t0 + 16 * NQT - 1) >> 6);
    const unsigned long long todo = ((unsigned long long)(unsigned)__builtin_amdgcn_readfirstlane((int)(todo_v >> 32)) << 32) | (unsigned)__builtin_amdgcn_readfirstlane((int)(unsigned)todo_v);
    attn_blocks<AM_SEL, NQT>(st, qf, P2 + (size_t)b * T * LDP2 + 1536 + g * 64, LDP2, VTs + (size_t)(b * G + g) * 64 * T, T, t0, todo, hbase, sel, smem);
#pragma unroll
    for (int qt = 0; qt < NQT; ++qt) {
        const float li = attn_linv(st.lacc[qt]); const size_t m = mbase + wave * (4 * NQT) + qt * 4 + (l15 >> 2);
        const bf16* gr = P2 + m * LDP2 + 3072;
        const float g0 = sigmoidf_(bf2f(gr[0 * 16 + h])), g1 = sigmoidf_(bf2f(gr[1 * 16 + h])), g2 = sigmoidf_(bf2f(gr[2 * 16 + h]));
#pragma unroll
        for (int dt = 0; dt < 4; ++dt) {
            const int d0 = dt * 16 + 4 * q; const size_t oi = m * D + h * 64 + d0;
            const u32x2 zz = *(const u32x2*)(P2 + m * LDP2 + 2048 + h * 64 + d0), cc = *(const u32x2*)(OC + oi), ww = *(const u32x2*)(OW + oi);
            const f32x4 o = st.o[qt][dt];
            const float r0 = (g0 * bflo(cc[0]) + g1 * o[0] * li + g2 * bflo(ww[0])) * siluf_(bflo(zz[0]));
            const float r1 = (g0 * bfhi(cc[0]) + g1 * o[1] * li + g2 * bfhi(ww[0])) * siluf_(bfhi(zz[0]));
            const float r2 = (g0 * bflo(cc[1]) + g1 * o[2] * li + g2 * bflo(ww[1])) * siluf_(bflo(zz[1]));
            const float r3 = (g0 * bfhi(cc[1]) + g1 * o[3] * li + g2 * bfhi(ww[1])) * siluf_(bfhi(zz[1]));
            *(u32x2*)(AO + oi) = (u32x2){pack2bf(r0, r1), pack2bf(r2, r3)};
        }
    }
    __syncthreads();
}

DI void lru_convert_gates(const float* __restrict__ gaw, const float* __restrict__ gxw, bf16* __restrict__ img) {
    for (int i = blockIdx.x * NTHREADS + TIDX; i < 16 * 160 * 96; i += gridDim.x * NTHREADS) {
        const int k = i % 96, n = (i / 96) % 160, blk = i / (96 * 160);
        float v = 0.f;
        if (k < 80) v = n < 80 ? gaw[((size_t)blk * 80 + k) * 80 + n] : gxw[((size_t)blk * 80 + k) * 80 + (n - 80)];
        img[i] = f2bf(v);
    }
}
DI void lru_gate_item(const bf16* __restrict__ P3, const float* __restrict__ cw, const float* __restrict__ cb, const bf16* __restrict__ gimg, const float* __restrict__ gab, const float* __restrict__ gxb,
                      const float* __restrict__ lam, bf16* __restrict__ LA, bf16* __restrict__ BV, float2* __restrict__ SUM, int item, char* smem) {
    const int rt = item >> 4, nb = item & 15; const int tid = TIDX, lane = tid & 63, wave = tid >> 6, q = lane >> 4, l15 = lane & 15;
    const size_t m0 = (size_t)rt * 128;
    for (int id = tid; id < 128 * 12; id += NTHREADS) {
        const int row = id / 12, c12 = id % 12; u32x4 outv = (u32x4){0u, 0u, 0u, 0u};
        if (c12 < 10) {
            const size_t m = m0 + row; const int t = (int)(m % T); const int ch = nb * 80 + c12 * 8;
            float acc[8];
            { const float4 b0 = *(const float4*)(cb + ch), b1 = *(const float4*)(cb + ch + 4); acc[0] = b0.x; acc[1] = b0.y; acc[2] = b0.z; acc[3] = b0.w; acc[4] = b1.x; acc[5] = b1.y; acc[6] = b1.z; acc[7] = b1.w; }
#pragma unroll
            for (int w = 0; w < 4; ++w) {
                if (t - 3 + w >= 0) {
                    const u32x4 uv = *(const u32x4*)(P3 + (m - 3 + w) * 2560 + ch);
                    const float4 w0 = *(const float4*)(cw + w * LW + ch), w1 = *(const float4*)(cw + w * LW + ch + 4);
                    acc[0] += w0.x * bflo(uv[0]); acc[1] += w0.y * bfhi(uv[0]); acc[2] += w0.z * bflo(uv[1]); acc[3] += w0.w * bfhi(uv[1]);
                    acc[4] += w1.x * bflo(uv[2]); acc[5] += w1.y * bfhi(uv[2]); acc[6] += w1.z * bflo(uv[3]); acc[7] += w1.w * bfhi(uv[3]);
                }
            }
            outv = (u32x4){pack2bf(acc[0], acc[1]), pack2bf(acc[2], acc[3]), pack2bf(acc[4], acc[5]), pack2bf(acc[6], acc[7])};
        }
        const int ks = c12 >> 2, c = c12 & 3;
        *(u32x4*)(smem + ks * 8192 + row * 64 + ((c ^ ((row >> 2) & 3)) << 4)) = outv;
    }
    for (int id = tid; id < 160 * 12; id += NTHREADS) {
        const int row = id / 12, c12 = id % 12; const int ks = c12 >> 2, c = c12 & 3;
        *(u32x4*)(smem + 24576 + ks * 10240 + row * 64 + ((c ^ ((row >> 2) & 3)) << 4)) = *(const u32x4*)(gimg + ((size_t)nb * 160 + row) * 96 + c12 * 8);
    }
    __syncthreads();
    f32x4 acc[2][10];
#pragma unroll
    for (int i = 0; i < 2; ++i)
#pragma unroll
        for (int j = 0; j < 10; ++j) acc[i][j] = (f32x4){0.f, 0.f, 0.f, 0.f};
    const int fo = l15 * 64 + ((q ^ ((l15 >> 2) & 3)) << 4);
#pragma unroll
    for (int ks = 0; ks < 3; ++ks) {
        bf16x8 uf[2];
#pragma unroll
        for (int i = 0; i < 2; ++i) uf[i] = *(const bf16x8*)(smem + ks * 8192 + (wave * 32 + i * 16) * 64 + fo);
#pragma unroll
        for (int j = 0; j < 10; ++j) {
            const bf16x8 wf = *(const bf16x8*)(smem + 24576 + ks * 10240 + j * 1024 + fo);
            acc[0][j] = __builtin_amdgcn_mfma_f32_16x16x32_bf16(wf, uf[0], acc[0][j], 0, 0, 0);
            acc[1][j] = __builtin_amdgcn_mfma_f32_16x16x32_bf16(wf, uf[1], acc[1][j], 0, 0, 0);
        }
    }
    __syncthreads();
#pragma unroll
    for (int i = 0; i < 2; ++i) {
        const int row = wave * 32 + i * 16 + l15; const size_t m = m0 + row;
#pragma unroll
        for (int ct = 0; ct < 5; ++ct) {
            const int kcol = ct * 16 + 4 * q; const int ch = nb * 80 + kcol;
            const u32x2 uu = *(const u32x2*)(smem + (kcol >> 5) * 8192 + row * 64 + ((((kcol & 31) >> 3) ^ ((row >> 2) & 3)) << 4) + (kcol & 7) * 2);
            const float uc[4] = {bflo(uu[0]), bfhi(uu[0]), bflo(uu[1]), bfhi(uu[1])};
            const float4 ba = *(const float4*)(gab + ch), bx = *(const float4*)(gxb + ch), lm = *(const float4*)(lam + ch);
            const float bav[4] = {ba.x, ba.y, ba.z, ba.w}, bxv[4] = {bx.x, bx.y, bx.z, bx.w}, lmv[4] = {lm.x, lm.y, lm.z, lm.w};
            float la[4], bv[4];
#pragma unroll
            for (int r = 0; r < 4; ++r) {
                const float rg = __builtin_amdgcn_rcpf(1.0f + __expf(-(acc[i][ct][r] + bav[r]))), ig = __builtin_amdgcn_rcpf(1.0f + __expf(-(acc[i][ct + 5][r] + bxv[r])));
                la[r] = rg * lmv[r];
                const float om = 1.0f - __expf(2.0f * la[r]);
                bv[r] = __builtin_amdgcn_sqrtf(om > 0.f ? om : 0.f) * (ig * uc[r]);
            }
            const u32x2 lav = {pack2bf(la[0], la[1]), pack2bf(la[2], la[3])}, bvv = {pack2bf(bv[0], bv[1]), pack2bf(bv[2], bv[3])};
            *(u32x2*)(LA + m * LW + ch) = lav; *(u32x2*)(BV + m * LW + ch) = bvv;
            *(u32x2*)(smem + 24576 + (row * 80 + kcol) * 2) = lav; *(u32x2*)(smem + 24576 + 20480 + (row * 80 + kcol) * 2) = bvv;
        }
    }
    __syncthreads();
    if (tid < 160) {
        const int cidx = tid / 80, c = tid % 80; const bf16* li = (const bf16*)(smem + 24576) + (cidx * 64) * 80 + c; const bf16* bi = li + 10240;
        float sla = 0.f, h = 0.f;
#pragma unroll 8
        for (int t = 0; t < 64; ++t) { const float la = bf2f(li[t * 80]), bvv = bf2f(bi[t * 80]); h = __expf(la) * h + bvv; sla += la; }
        const size_t mc = m0 + cidx * 64; const int bb = (int)(mc / T), jj = (int)(mc % T) / 64;
        SUM[((size_t)bb * (T / 64) + jj) * LW + nb * 80 + c] = make_float2(__expf(sla), h);
    }
    __syncthreads();
}
DI void lru_scan2_item(const bf16* __restrict__ LA, const bf16* __restrict__ BV, const float2* __restrict__ SUM, const bf16* __restrict__ P3, bf16* __restrict__ AO, int item) {
    const int cg = item % 5, j = (item / 5) % (T / 64), b = item / (5 * (T / 64)); const int c = cg * 256 + TIDX;
    float h = 0.f;
    for (int jj = 0; jj < j; ++jj) { const float2 s = SUM[((size_t)b * (T / 64) + jj) * LW + c]; h = s.x * h + s.y; }
    const size_t m0 = (size_t)b * T + j * 64;
#pragma unroll 8
    for (int t = 0; t < 64; ++t) {
        const float la = bf2f(LA[(m0 + t) * LW + c]); const float bv = bf2f(BV[(m0 + t) * LW + c]); const float z = bf2f(P3[(m0 + t) * 2560 + LW + c]);
        h = __expf(la) * h + bv; AO[(m0 + t) * LW + c] = f2bf(h * siluf_(z));
    }
}

struct ALoadF32 {
    const float* A;
    static constexpr bool DMA = false;
    DI const bf16* src(int, int) const { return nullptr; }
    struct Raw { float4 a, b; };
    DI Raw load(int m, int k) const { Raw r; r.a = *(const float4*)(A + (size_t)m * 64 + k); r.b = *(const float4*)(A + (size_t)m * 64 + k + 4); return r; }
    DI u32x4 finish(const Raw& r, int, int) const { return (u32x4){pack2bf(r.a.x, r.a.y), pack2bf(r.a.z, r.a.w), pack2bf(r.b.x, r.b.y), pack2bf(r.b.z, r.b.w)}; }
};
struct EpiLora {
    const float* w0; const float* a0; bf16* WL; bf16* AV;
    DI void operator()(int m, int n, const float* v, int, int) const {
        float w[8];
        if (n < 1024) {
#pragma unroll
            for (int j = 0; j < 8; ++j) w[j] = -0.60653065971f * __builtin_amdgcn_rcpf(1.0f + __expf(-(w0[n + j] + v[j])));
            store8bf(WL + (size_t)m * D + n, w);
        } else {
#pragma unroll
            for (int j = 0; j < 8; ++j) w[j] = __builtin_amdgcn_rcpf(1.0f + __expf(-(a0[n - 1024 + j] + v[j])));
            store8bf(AV + (size_t)m * D + n - 1024, w);
        }
    }
    DI void finish(int, int, int, int, int) const {}
    DI void finish_wide(int, int, int, int, int) const {}
};
DI float dpp_sum16(float x) {
    x += __builtin_bit_cast(float, __builtin_amdgcn_update_dpp(0, __builtin_bit_cast(int, x), 0xB1, 0xf, 0xf, false));
    x += __builtin_bit_cast(float, __builtin_amdgcn_update_dpp(0, __builtin_bit_cast(int, x), 0x4E, 0xf, 0xf, false));
    x += __builtin_bit_cast(float, __builtin_amdgcn_update_dpp(0, __builtin_bit_cast(int, x), 0x141, 0xf, 0xf, false));
    x += __builtin_bit_cast(float, __builtin_amdgcn_update_dpp(0, __builtin_bit_cast(int, x), 0x140, 0xf, 0xf, false));
    return x;
}
constexpr int RW_NCH = T / 16;
DI void rwkv_prep_item(bf16* __restrict__ P, bf16* __restrict__ WL, bf16* __restrict__ AV, const float* __restrict__ k_k, const float* __restrict__ k_a, const float* __restrict__ r_k,
                       float* __restrict__ G15, bf16* __restrict__ M2g, bf16* __restrict__ M3g, float* __restrict__ BON, int item, char* smem) {
    const int c = item % RW_NCH, h = (item / RW_NCH) & 15, b = item / (RW_NCH * 16);
    const int tid = TIDX, t = tid >> 4, jq = tid & 15, j0 = jq * 4;
    const size_t m0 = (size_t)b * T + c * 16, m = m0 + t; const size_t ch = (size_t)(b * 16 + h) * RW_NCH + c;
    float* sA = (float*)smem; float* sR = sA + 16 * 68; float* sB = sR + 16 * 68; float* sK = sB + 16 * 68; float* sW = sK + 16 * 68; float* sWl = sW + 16 * 68;
    float* mAab = sWl + 16 * 64; float* mAak = mAab + 16 * 17; float* mArb = mAak + 16 * 17; float* mArk = mArb + 16 * 17; float* mTin = mArk + 16 * 17; float* mM2 = mTin + 16 * 17;
    const u32x2 r2 = *(const u32x2*)(P + m * 4096 + h * 64 + j0), k2 = *(const u32x2*)(P + m * 4096 + 1024 + h * 64 + j0), a2 = *(const u32x2*)(AV + m * D + h * 64 + j0), w2 = *(const u32x2*)(WL + m * D + h * 64 + j0);
    const float rr[4] = {bflo(r2[0]), bfhi(r2[0]), bflo(r2[1]), bfhi(r2[1])}, kr[4] = {bflo(k2[0]), bfhi(k2[0]), bflo(k2[1]), bfhi(k2[1])},
                av[4] = {bflo(a2[0]), bfhi(a2[0]), bflo(a2[1]), bfhi(a2[1])}, wl[4] = {bflo(w2[0]), bfhi(w2[0]), bflo(w2[1]), bfhi(w2[1])};
    const float4 kk4 = *(const float4*)(k_k + h * 64 + j0), ka4 = *(const float4*)(k_a + h * 64 + j0), rk4 = *(const float4*)(r_k + h * 64 + j0);
    const float kkc[4] = {kk4.x, kk4.y, kk4.z, kk4.w}, kac[4] = {ka4.x, ka4.y, ka4.z, ka4.w}, rkc[4] = {rk4.x, rk4.y, rk4.z, rk4.w};
    float kkv[4], n2 = 0.f;
#pragma unroll
    for (int e = 0; e < 4; ++e) { kkv[e] = kr[e] * kkc[e]; n2 += kkv[e] * kkv[e]; }
    n2 = dpp_sum16(n2);
    float nr = sqrtf(n2); nr = nr > 1e-12f ? nr : 1e-12f; const float inr = 1.0f / nr;
    float aa[4], bb[4], kp[4], bon = 0.f;
#pragma unroll
    for (int e = 0; e < 4; ++e) { const float kn = kkv[e] * inr; aa[e] = -kn; bb[e] = kn * av[e]; kp[e] = kr[e] * (1.0f + (av[e] - 1.0f) * kac[e]); bon += rr[e] * kp[e] * rkc[e]; }
    bon = dpp_sum16(bon);
    if (jq == 0) BON[m * 16 + h] = bon;
    *(float4*)(sWl + t * 64 + j0) = make_float4(wl[0], wl[1], wl[2], wl[3]);
    __syncthreads();
    float clx[4] = {0.f, 0.f, 0.f, 0.f};
#pragma unroll
    for (int s = 0; s < 15; ++s) { if (s < t) { const float4 w = *(const float4*)(sWl + s * 64 + j0); clx[0] += w.x; clx[1] += w.y; clx[2] += w.z; clx[3] += w.w; } }
    float bt[4];
    {
        float va[4], vr[4], vk[4], gc[4];
#pragma unroll
        for (int e = 0; e < 4; ++e) { const float cl = clx[e] + wl[e]; const float gp = __expf(clx[e]), gi = __expf(-cl); gc[e] = __expf(cl); va[e] = aa[e] * gp; vr[e] = rr[e] * gc[e]; bt[e] = bb[e] * gi; vk[e] = kp[e] * gi; }
        *(float4*)(sA + t * 68 + j0) = make_float4(va[0], va[1], va[2], va[3]); *(float4*)(sR + t * 68 + j0) = make_float4(vr[0], vr[1], vr[2], vr[3]);
        *(float4*)(sB + t * 68 + j0) = make_float4(bt[0], bt[1], bt[2], bt[3]); *(float4*)(sK + t * 68 + j0) = make_float4(vk[0], vk[1], vk[2], vk[3]);
        {
            char* img = (char*)(mM2 + 16 * 17) + t * 128 + (((j0 >> 3) ^ (t & 7)) << 4) + (j0 & 4) * 2;
            *(u32x2*)(img) = (u32x2){pack2bf(va[0], va[1]), pack2bf(va[2], va[3])}; *(u32x2*)(img + 2048) = (u32x2){pack2bf(vr[0], vr[1]), pack2bf(vr[2], vr[3])};
            *(u32x2*)(img + 4096) = (u32x2){pack2bf(bt[0], bt[1]), pack2bf(bt[2], bt[3])}; *(u32x2*)(img + 6144) = (u32x2){pack2bf(vk[0], vk[1]), pack2bf(vk[2], vk[3])};
        }
        if (t == 15) *(float4*)(G15 + ch * 64 + j0) = make_float4(gc[0], gc[1], gc[2], gc[3]);
#pragma unroll
        for (int e = 0; e < 4; ++e) {   }
#pragma unroll
        for (int e = 0; e < 4; ++e) clx[e] = vk[e];
    }
    __syncthreads();
    {
        const int wv = __builtin_amdgcn_readfirstlane(tid >> 6), lane = tid & 63, q = lane >> 4, l15 = lane & 15;
        const char* xb_ = (const char*)(mM2 + 16 * 17) + (wv >> 1) * 2048;
        const char* yb_ = (const char*)(mM2 + 16 * 17) + 4096 + (wv & 1) * 2048;
        f32x4 acc = {0.f, 0.f, 0.f, 0.f};
#pragma unroll
        for (int ks = 0; ks < 2; ++ks) {
            const int off = l15 * 128 + (((ks * 4 + q) ^ (l15 & 7)) << 4);
            const bf16x8 xf = *(const bf16x8*)(xb_ + off), yf = *(const bf16x8*)(yb_ + off);
            acc = __builtin_amdgcn_mfma_f32_16x16x32_bf16(xf, yf, acc, 0, 0, 0);
        }
        float* dst = wv == 0 ? mAab : (wv == 1 ? mAak : (wv == 2 ? mArb : mArk));
        const bool strict = wv < 2;
#pragma unroll
        for (int r = 0; r < 4; ++r) { const int tt = 4 * q + r, ss = l15; dst[tt * 17 + ss] = (strict ? ss < tt : ss <= tt) ? acc[r] : 0.f; }
    }
    __syncthreads();
    if (tid < 16) {
        float col[16];
#pragma unroll
        for (int i = 0; i < 16; ++i) {
            float acc = (i == tid) ? 1.0f : 0.f;
#pragma unroll
            for (int jj = 0; jj < i; ++jj) acc += mAab[i * 17 + jj] * col[jj];
            col[i] = acc; mTin[i * 17 + tid] = acc;
        }
    }
    __syncthreads();
    float wv[4] = {0.f, 0.f, 0.f, 0.f}, m2 = 0.f;
#pragma unroll
    for (int s = 0; s < 16; ++s) { const float ti = mTin[t * 17 + s]; const float4 a4 = *(const float4*)(sA + s * 68 + j0); wv[0] += ti * a4.x; wv[1] += ti * a4.y; wv[2] += ti * a4.z; wv[3] += ti * a4.w; m2 += ti * mAak[s * 17 + jq]; }
    *(float4*)(sW + t * 68 + j0) = make_float4(wv[0], wv[1], wv[2], wv[3]); mM2[t * 17 + jq] = m2;
    __syncthreads();
    float rh[4]; { const float4 r4 = *(const float4*)(sR + t * 68 + j0); rh[0] = r4.x; rh[1] = r4.y; rh[2] = r4.z; rh[3] = r4.w; }
    float m3 = mArk[t * 17 + jq];
#pragma unroll
    for (int s = 0; s < 16; ++s) { const float ar = mArb[t * 17 + s]; const float4 w4 = *(const float4*)(sW + s * 68 + j0); rh[0] += ar * w4.x; rh[1] += ar * w4.y; rh[2] += ar * w4.z; rh[3] += ar * w4.w; m3 += ar * mM2[s * 17 + jq]; }
    *(u32x2*)(WL + m * D + h * 64 + j0) = (u32x2){pack2bf(wv[0], wv[1]), pack2bf(wv[2], wv[3])};
    *(u32x2*)(P + m * 4096 + h * 64 + j0) = (u32x2){pack2bf(rh[0], rh[1]), pack2bf(rh[2], rh[3])};
#pragma unroll
    for (int e = 0; e < 4; ++e) { AV[(m0 + jq) * D + h * 64 + e * 16 + t] = f2bf(bt[e]); P[(m0 + jq) * 4096 + 1024 + h * 64 + e * 16 + t] = f2bf(clx[e]); }
    M2g[ch * 256 + t * 16 + jq] = f2bf(m2); M3g[ch * 256 + t * 16 + jq] = f2bf(m3);
    __syncthreads();
}

#define MFMA32(a, b, c) __builtin_amdgcn_mfma_f32_16x16x32_bf16(__builtin_bit_cast(bf16x8, a), __builtin_bit_cast(bf16x8, b), c, 0, 0, 0)
DI void rwkv_chunk_scan(const bf16* __restrict__ P, const bf16* __restrict__ WL, const bf16* __restrict__ AV, const float* __restrict__ G15, const bf16* __restrict__ M2g, const bf16* __restrict__ M3g,
                        bf16* __restrict__ YS, int bh, char* smem) {
    constexpr int SLOT = 12288, YOFF = 49152;
    const int tid = TIDX, lane = tid & 63, vs = __builtin_amdgcn_readfirstlane(tid >> 6), q = lane >> 4, l15 = lane & 15; const int b = bh >> 4, h = bh & 15;
    const size_t mb = (size_t)b * T; const size_t ch0 = (size_t)(b * 16 + h) * RW_NCH;
    const char *s0, *s1, *s2; size_t d0, d1, d2;
    if (tid < 128) { const int c8 = tid >> 4, t = tid & 15; s0 = (const char*)(WL + (mb + t) * D + h * 64 + c8 * 8); d0 = (size_t)16 * D * 2; }
    else { const int pp = tid - 128, c8 = pp >> 4, t = pp & 15; s0 = (const char*)(P + (mb + t) * 4096 + h * 64 + c8 * 8); d0 = (size_t)16 * 4096 * 2; }
    if (tid < 128) { const int r = tid >> 3, c8 = tid & 7; s1 = (const char*)(P + (mb + r) * 4096 + 1024 + h * 64 + c8 * 8); d1 = (size_t)16 * 4096 * 2; }
    else { const int pp = tid - 128, r = pp >> 3, c8 = pp & 7; s1 = (const char*)(AV + (mb + r) * D + h * 64 + c8 * 8); d1 = (size_t)16 * D * 2; }
    if (tid < 128) { const int r = tid >> 3, c8 = tid & 7; s2 = (const char*)(P + (mb + r) * 4096 + 2048 + h * 64 + c8 * 8); d2 = (size_t)16 * 4096 * 2; }
    else if (tid < 160) { s2 = (const char*)(M2g + ch0 * 256 + (tid - 128) * 8); d2 = 512; }
    else if (tid < 192) { s2 = (const char*)(M3g + ch0 * 256 + (tid - 160) * 8); d2 = 512; }
    else { const int pp = tid < 208 ? tid - 192 : 0; s2 = (const char*)(G15 + ch0 * 64 + pp * 4); d2 = 256; }
    const int dma_off = vs * 1024;
#define RW_DMA(c_) { char* dst = smem + ((c_) & 3) * SLOT + dma_off; GLDS16(s0 + (size_t)(c_) * d0, dst); GLDS16(s1 + (size_t)(c_) * d1, dst + 4096); GLDS16(s2 + (size_t)(c_) * d2, dst + 8192); }
#define RW_BARRIER() { asm volatile("s_waitcnt lgkmcnt(0)" ::: "memory"); __builtin_amdgcn_s_barrier(); asm volatile("" ::: "memory"); }
    f32x4 H0 = {0.f, 0.f, 0.f, 0.f}, H1 = H0, H2 = H0, H3 = H0;
    const int oW = (((q >> 1)) * 16 + l15) * 16 + (q & 1) * 8;
    const int oK = 4096 + ((l15 >> 2) * 8 + (l15 & 3) * 2 + (q >> 1)) * 16 + (q & 1) * 8;
    const int oM = 10240 + l15 * 32 + q * 8;
    const int oV = 8192 + (4 * q) * 128 + (vs * 16 + l15) * 2;
    const int oG = 11264 + (4 * q) * 4;
    const int oY = YOFF + ((4 * q) * 64 + vs * 16 + l15) * 2;
    RW_DMA(0); RW_DMA(1); RW_DMA(2);
    asm volatile("s_waitcnt vmcnt(6)" ::: "memory");
    RW_BARRIER();
    u32x4 pHb0 = {0u, 0u, 0u, 0u}, pHb1 = pHb0, pVlo = pHb0; u32x2 pm3 = {0u, 0u}, pr0 = pm3, pr1 = pm3, pr2 = pm3, pr3 = pm3;
    int sincef = 3;
#define RW_FLUSH(cbase_) { u32x4 yv[4]; \
        _Pragma("unroll") for (int k = 0; k < 4; ++k) yv[k] = *(const u32x4*)(smem + YOFF + (tid + 256 * k) * 16); \
        _Pragma("unroll") for (int k = 0; k < 4; ++k) { const int pc = tid + 256 * k, rr = pc >> 3, c8 = pc & 7; *(u32x4*)(YS + (mb + (size_t)(cbase_) * 16 + rr) * D + h * 64 + c8 * 8) = yv[k]; } }
    for (int c = 0; c < RW_NCH; ++c) {
        if (c + 3 < RW_NCH) RW_DMA(c + 3);
        const char* sl = smem + (c & 3) * SLOT;
        {
            const f32x4 z4 = {0.f, 0.f, 0.f, 0.f};
            const u32x4 Hb0 = {pack2bf(H0[0], H0[1]), pack2bf(H0[2], H0[3]), pack2bf(H1[0], H1[1]), pack2bf(H1[2], H1[3])};
            const u32x4 Hb1 = {pack2bf(H2[0], H2[1]), pack2bf(H2[2], H2[3]), pack2bf(H3[0], H3[1]), pack2bf(H3[2], H3[3])};
            const unsigned v0 = *(const bf16*)(sl + oV), v1 = *(const bf16*)(sl + oV + 128), v2 = *(const bf16*)(sl + oV + 256), v3 = *(const bf16*)(sl + oV + 384);
            const unsigned v01 = v0 | (v1 << 16), v23 = v2 | (v3 << 16);
            const u32x4 Vlo = {v01, v23, 0u, 0u};
            const u32x2 m2 = *(const u32x2*)(sl + oM), m3 = *(const u32x2*)(sl + oM + 512);
            const u32x2 w0 = *(const u32x2*)(sl + oW), w1 = *(const u32x2*)(sl + oW + 512), w2 = *(const u32x2*)(sl + oW + 1024), w3 = *(const u32x2*)(sl + oW + 1536);
            const u32x2 r0 = *(const u32x2*)(sl + 2048 + oW), r1 = *(const u32x2*)(sl + 2048 + oW + 512), r2 = *(const u32x2*)(sl + 2048 + oW + 1024), r3 = *(const u32x2*)(sl + 2048 + oW + 1536);
            f32x4 U = MFMA32(((u32x4){m2[0], m2[1], 0u, 0u}), Vlo, z4);
            f32x4 Y = MFMA32(((u32x4){pm3[0], pm3[1], 0u, 0u}), pVlo, z4);
            U = MFMA32(((u32x4){w0[0], w0[1], w1[0], w1[1]}), Hb0, U);
            Y = MFMA32(((u32x4){pr0[0], pr0[1], pr1[0], pr1[1]}), pHb0, Y);
            U = MFMA32(((u32x4){w2[0], w2[1], w3[0], w3[1]}), Hb1, U);
            Y = MFMA32(((u32x4){pr2[0], pr2[1], pr3[0], pr3[1]}), pHb1, Y);
            const u32x4 VU = {v01, v23, pack2bf(U[0], U[1]), pack2bf(U[2], U[3])};
            const u32x2 k0 = *(const u32x2*)(sl + oK), k1 = *(const u32x2*)(sl + oK + 512), k2 = *(const u32x2*)(sl + oK + 1024), k3 = *(const u32x2*)(sl + oK + 1536);
            const u32x2 b0 = *(const u32x2*)(sl + 2048 + oK), b1 = *(const u32x2*)(sl + 2048 + oK + 512), b2 = *(const u32x2*)(sl + 2048 + oK + 1024), b3 = *(const u32x2*)(sl + 2048 + oK + 1536);
            const f32x4 g0 = *(const f32x4*)(sl + oG), g1 = *(const f32x4*)(sl + oG + 64), g2 = *(const f32x4*)(sl + oG + 128), g3 = *(const f32x4*)(sl + oG + 192);
            const f32x4 a0 = MFMA32(((u32x4){k0[0], k0[1], b0[0], b0[1]}), VU, H0), a1 = MFMA32(((u32x4){k1[0], k1[1], b1[0], b1[1]}), VU, H1);
            const f32x4 a2 = MFMA32(((u32x4){k2[0], k2[1], b2[0], b2[1]}), VU, H2), a3 = MFMA32(((u32x4){k3[0], k3[1], b3[0], b3[1]}), VU, H3);
            H0 = a0 * g0; H1 = a1 * g1; H2 = a2 * g2; H3 = a3 * g3;
            if (c > 0) {
                char* yb = smem + oY + ((c - 1) & 7) * 2048;
                const unsigned y01 = pack2bf(Y[0], Y[1]), y23 = pack2bf(Y[2], Y[3]);
                *(unsigned short*)(yb) = (unsigned short)y01; *(unsigned short*)(yb + 128) = (unsigned short)(y01 >> 16);
                *(unsigned short*)(yb + 256) = (unsigned short)y23; *(unsigned short*)(yb + 384) = (unsigned short)(y23 >> 16);
            }
            pHb0 = Hb0; pHb1 = Hb1; pVlo = Vlo; pm3 = m3; pr0 = r0; pr1 = r1; pr2 = r2; pr3 = r3;
        }
        const bool flush = c > 0 && (c & 7) == 0;
        if (flush) {
            RW_BARRIER();
            RW_FLUSH(c - 8);
            sincef = 0;
        }
        if (c + 3 < RW_NCH) { if (sincef <= 2) asm volatile("s_waitcnt vmcnt(10)" ::: "memory"); else asm volatile("s_waitcnt vmcnt(6)" ::: "memory"); }
        else if (c + 2 < RW_NCH) { asm volatile("s_waitcnt vmcnt(3)" ::: "memory"); }
        else { asm volatile("s_waitcnt vmcnt(0)" ::: "memory"); }
        RW_BARRIER();
        ++sincef;
    }
    {
        const f32x4 z4 = {0.f, 0.f, 0.f, 0.f};
        f32x4 Y = MFMA32(((u32x4){pm3[0], pm3[1], 0u, 0u}), pVlo, z4);
        Y = MFMA32(((u32x4){pr0[0], pr0[1], pr1[0], pr1[1]}), pHb0, Y);
        Y = MFMA32(((u32x4){pr2[0], pr2[1], pr3[0], pr3[1]}), pHb1, Y);
        char* yb = smem + oY + ((RW_NCH - 1) & 7) * 2048;
        const unsigned y01 = pack2bf(Y[0], Y[1]), y23 = pack2bf(Y[2], Y[3]);
        *(unsigned short*)(yb) = (unsigned short)y01; *(unsigned short*)(yb + 128) = (unsigned short)(y01 >> 16);
        *(unsigned short*)(yb + 256) = (unsigned short)y23; *(unsigned short*)(yb + 384) = (unsigned short)(y23 >> 16);
        RW_BARRIER();
        RW_FLUSH(RW_NCH - 8);
    }
#undef RW_FLUSH
#undef RW_DMA
#undef RW_BARRIER
}
DI void rwkv_gn_rows2(const bf16* __restrict__ P, const float* __restrict__ BON, const float* __restrict__ lnw, const float* __restrict__ lnb, bf16* __restrict__ YS) {
    const int tid = TIDX, lane = tid & 63, wave = tid >> 6; const int c = wave * 256 + lane * 4;
    const float4 lw = *(const float4*)(lnw + c), lb = *(const float4*)(lnb + c);
    for (size_t m = blockIdx.x; m < (size_t)M; m += gridDim.x) {
        const u32x2 yy = *(const u32x2*)(YS + m * D + c), vv = *(const u32x2*)(P + m * 4096 + 2048 + c), zz = *(const u32x2*)(P + m * 4096 + 3072 + c);
        const float bs = BON[m * 16 + (c >> 6)];
        const float y[4] = {bflo(yy[0]), bfhi(yy[0]), bflo(yy[1]), bfhi(yy[1])}, v[4] = {bflo(vv[0]), bfhi(vv[0]), bflo(vv[1]), bfhi(vv[1])}, z[4] = {bflo(zz[0]), bfhi(zz[0]), bflo(zz[1]), bfhi(zz[1])};
        const float lwv[4] = {lw.x, lw.y, lw.z, lw.w}, lbv[4] = {lb.x, lb.y, lb.z, lb.w};
        const float mean = dpp_sum16((y[0] + y[1]) + (y[2] + y[3])) * (1.0f / 64.0f);
        float var = 0.f;
#pragma unroll
        for (int i = 0; i < 4; ++i) { const float d = y[i] - mean; var += d * d; }
        var = dpp_sum16(var) * (1.0f / 64.0f);
        const float rstd = 1.0f / sqrtf(var + 64e-5f);
        float o[4];
#pragma unroll
        for (int i = 0; i < 4; ++i) o[i] = ((y[i] - mean) * rstd * lwv[i] + lbv[i] + bs * v[i]) * siluf_(z[i]);
        *(u32x2*)(YS + m * D + c) = (u32x2){pack2bf(o[0], o[1]), pack2bf(o[2], o[3])};
    }
}

struct FastBufs { char* ws; };

DI void rows_xb_parts(const float* __restrict__ x, bf16* xb, float* parts) {
    const int lane = TIDX & 63, wave = TIDX >> 6;
    for (int m = blockIdx.x * 4 + wave; m < M; m += gridDim.x * 4) {
        const float* xr = x + (size_t)m * D; float s = 0.f;
#pragma unroll
        for (int i = 0; i < 2; ++i) {
            const int k = (i * 64 + lane) * 8; const float4 a = *(const float4*)(xr + k), b = *(const float4*)(xr + k + 4);
            const float w[8] = {a.x, a.y, a.z, a.w, b.x, b.y, b.z, b.w};
#pragma unroll
            for (int j = 0; j < 8; ++j) s += w[j] * w[j];
            store8bf(xb + (size_t)m * D + k, w);
        }
#pragma unroll
        for (int o = 32; o >= 1; o >>= 1) s += __shfl_xor(s, o);
        if (lane < 16) parts[(size_t)m * 16 + lane] = lane == 0 ? s : 0.f;
    }
}
DI void rows_xn(const float* __restrict__ x, const float* parts, const float* __restrict__ g, bf16* xn) {
    const int lane = TIDX & 63, wave = TIDX >> 6;
    for (int m = blockIdx.x * 4 + wave; m < M; m += gridDim.x * 4) {
        const float rs = rstd_from_parts(parts, m); const float* xr = x + (size_t)m * D;
#pragma unroll
        for (int i = 0; i < 2; ++i) {
            const int k = (i * 64 + lane) * 8; const float4 a = *(const float4*)(xr + k), b = *(const float4*)(xr + k + 4);
            const float4 ga = *(const float4*)(g + k), gb = *(const float4*)(g + k + 4);
            const float w[8] = {a.x * rs * ga.x, a.y * rs * ga.y, a.z * rs * ga.z, a.w * rs * ga.w, b.x * rs * gb.x, b.y * rs * gb.y, b.z * rs * gb.z, b.w * rs * gb.w};
            store8bf(xn + (size_t)m * D + k, w);
        }
    }
}
DI void rows_final(float* x, const float* parts, const float* __restrict__ g) {
    const int lane = TIDX & 63, wave = TIDX >> 6;
    for (int m = blockIdx.x * 4 + wave; m < M; m += gridDim.x * 4) {
        const float rs = rstd_from_parts(parts, m); float* xr = x + (size_t)m * D;
#pragma unroll
        for (int i = 0; i < 4; ++i) {
            const int k = (i * 64 + lane) * 4; float4 a = *(float4*)(xr + k); const float4 ga = *(const float4*)(g + k);
            a.x *= rs * ga.x; a.y *= rs * ga.y; a.z *= rs * ga.z; a.w *= rs * ga.w; *(float4*)(xr + k) = a;
        }
    }
}
enum { PH_PREP0 = 0, PH_IN0, PH_ATTN0, PH_OUT0, PH_PREP1, PH_IN1, PH_LORA1, PH_CPREP1, PH_SCAN1, PH_GN1, PH_OUT1, PH_PREP2, PH_IN2, PH_B2, PH_C2, PH_D2, PH_OUT2, PH_PREP3, PH_IN3, PH_GATE3, PH_SCANA3, PH_SCANB3, PH_OUT3, PH_FINAL };

namespace wbo {
constexpr size_t IN = 0;
constexpr size_t OUT = (size_t)4352 * 1024;
constexpr size_t EXTRA = OUT + (size_t)1280 * 1024;
}

template <int PH>
DI void run_phase(const Params& p, char* smem) {
    char* ws = p.ws;
    float* parts = (float*)(ws + fw::PARTS);
    constexpr int LAYER = PH <= PH_OUT0 ? 0 : PH <= PH_OUT1 ? 1 : PH <= PH_OUT2 ? 2 : 3;
    constexpr size_t WBOFF = LAYER == 0 ? 200 * fw::MB : LAYER == 1 ? 238 * fw::MB : LAYER == 2 ? 240 * fw::MB : 1 * fw::MB;
    bf16* WB = (bf16*)(ws + WBOFF);
    bf16* XB = (bf16*)(ws + ((PH == PH_PREP0 || PH == PH_IN0) ? 130 * fw::MB : 174 * fw::MB));
    bf16* P = (bf16*)(ws + wsl::P);
    float* X = p.out;
    float* smf = (float*)smem;
    if (PH == PH_PREP0) {
        rows_xb_parts(p.x, XB, parts);
        int tb = 0;
        convert_seg(p.a_w_in, A_COLS, 0, A_COLS, 1024, WB + wbo::IN, p.norm_g + 0 * D, smf, tb);
        convert_seg(p.a_w_out, 1024, 0, 1024, 1024, WB + wbo::OUT, nullptr, smf, tb);
    } else if (PH == PH_IN0) {
        gemm_sched(8, 4, [&](bool big, int mt, int nt) {
            if (big) gemm_tile2(ALoadPlain{XB, D}, WB + wbo::IN, 1024, mt * 128, nt * 256, EpiL0{P, (bf16*)(ws + 86 * fw::MB), parts}, smem);
            else gemm_tile(ALoadPlain{XB, D}, WB + wbo::IN, 1024, mt * 128, 2048 + nt * 128, EpiL0{P, (bf16*)(ws + 86 * fw::MB), parts}, smem);
        });
    } else if (PH == PH_ATTN0) {
        build_bias_lut(p.t5, smem, true);
        for (int it = blockIdx.x; it < B * G * (T / (16 * ANQT_SWA)); it += gridDim.x) swa_item(P, (const bf16*)(ws + 86 * fw::MB), p.a_sinks, (bf16*)(ws + wsl::L0_AO), it, smem);
    } else if (PH == PH_OUT0) {
        gemm_sched(4, 0, [&](bool, int mt, int nt) { gemm_tile2(ALoadPlain{(const bf16*)(ws + wsl::L0_AO), D}, WB + wbo::OUT, 1024, mt * 128, nt * 256, EpiResid{p.x, X, nullptr, parts}, smem); });
    } else if (PH == PH_PREP1) {
        rows_xn(X, parts, p.norm_g + 1 * D, (bf16*)(ws + wsl::L1_XN));
        int tb = 0;
        convert_seg(p.b_w_in, 4096, 0, 4096, 1024, WB + wbo::IN, nullptr, smf, tb);
        convert_seg(p.b_w1, 64, 0, 64, 1024, WB + wbo::IN + (size_t)4096 * 1024, nullptr, smf, tb);
        convert_seg(p.b_a1, 64, 0, 64, 1024, WB + wbo::IN + (size_t)(4096 + 128) * 1024, nullptr, smf, tb);
        convert_seg(p.b_w_out, 1024, 0, 1024, 1024, WB + wbo::OUT, nullptr, smf, tb);
        convert_seg(p.b_w2, 1024, 0, 1024, 64, WB + wbo::EXTRA, nullptr, smf, tb);
        convert_seg(p.b_a2, 1024, 0, 1024, 64, WB + wbo::EXTRA + (size_t)1024 * 64, nullptr, smf, tb);
        for (size_t i = (size_t)blockIdx.x * 256 + TIDX; i < (size_t)64 * 1024 / 8; i += (size_t)gridDim.x * 256) {
            ((u32x4*)(WB + wbo::IN + (size_t)(4096 + 64) * 1024))[i] = (u32x4){0u, 0u, 0u, 0u};
            ((u32x4*)(WB + wbo::IN + (size_t)(4096 + 192) * 1024))[i] = (u32x4){0u, 0u, 0u, 0u};
        }
    } else if (PH == PH_IN1) {
        const bf16* XN = (const bf16*)(ws + wsl::L1_XN);
        EpiRwkv epi{P, (float*)(ws + wsl::LHW), (float*)(ws + wsl::LHA)};
        gemm_sched(16, 2, [&](bool big, int mt, int nt) {
            if (big) gemm_tile2(ALoadLerp{XN, p.b_mu + (nt >> 2) * D}, WB + wbo::IN, 1024, mt * 128, nt * 256, epi, smem);
            else gemm_tile(ALoadLerp{XN, p.b_mu + (4 + nt) * D}, WB + wbo::IN, 1024, mt * 128, 4096 + nt * 128, epi, smem);
        });
    } else if (PH == PH_LORA1) {
        const int ntile = (M / 128) * 16;
        EpiLora epi{p.b_w0, p.b_a0, (bf16*)(ws + wsl::L1_WL), (bf16*)(ws + wsl::L1_AV)};
        (void)ntile;
        gemm_sched(8, 0, [&](bool, int mt, int nt) { gemm_tile2(ALoadF32{(const float*)(ws + (nt < 4 ? wsl::LHW : wsl::LHA))}, WB + wbo::EXTRA, 64, mt * 128, nt * 256, epi, smem); });
    } else if (PH == PH_CPREP1) {
        for (int it = blockIdx.x; it < B * 16 * RW_NCH; it += gridDim.x)
            rwkv_prep_item(P, (bf16*)(ws + wsl::L1_WL), (bf16*)(ws + wsl::L1_AV), p.b_k_k, p.b_k_a, p.b_r_k, (float*)(ws + 9 * fw::MB), (bf16*)(ws + 1 * fw::MB), WB, (float*)(ws + 254 * fw::MB), it, smem);
    } else if (PH == PH_SCAN1) {
        const int bid = blockIdx.x;
        if ((bid & 31) < 8 && (bid >> 5) < 8) {
            const int it = (bid >> 5) * 8 + (bid & 31);
            rwkv_chunk_scan(P, (const bf16*)(ws + wsl::L1_WL), (const bf16*)(ws + wsl::L1_AV), (const float*)(ws + 9 * fw::MB), (const bf16*)(ws + 1 * fw::MB), WB, (bf16*)(ws + wsl::L1_XN), it, smem);
        }
    } else if (PH == PH_GN1) {
        rwkv_gn_rows2(P, (const float*)(ws + 254 * fw::MB), p.b_lnx_w, p.b_lnx_b, (bf16*)(ws + wsl::L1_XN));
    } else if (PH == PH_OUT1) {
        gemm_sched(4, 0, [&](bool, int mt, int nt) { gemm_tile2(ALoadPlain{(const bf16*)(ws + wsl::L1_XN), D}, WB + wbo::OUT, 1024, mt * 128, nt * 256, EpiResid{X, X, XB, parts}, smem); });
    } else if (PH == PH_PREP2) {
        int tb = 0;
        const float* g2 = p.norm_g + 2 * D;
        convert_seg(p.c_w_in, C_COLS, 0, 2560, 1024, WB + wbo::IN, g2, smf, tb);
        convert_seg(p.c_w_in, C_COLS, 2608, 1024, 1024, WB + wbo::IN + (size_t)2560 * 1024, g2, smf, tb);
        convert_seg(p.c_w_in, C_COLS, 2560, 64, 1024, WB + wbo::IN + (size_t)3584 * 1024, g2, smf, tb);
        convert_seg(p.c_w_out, 1024, 0, 1024, 1024, WB + wbo::OUT, nullptr, smf, tb);
        convert_seg(p.c_k_w1, 128, 0, 128, 2048, WB + wbo::EXTRA, nullptr, smf, tb);
        convert_seg(p.c_v_w1, 128, 0, 128, 2048, WB + wbo::EXTRA + (size_t)128 * 2048, nullptr, smf, tb);
        convert_seg(p.c_k_w2, 64, 0, 64, 128, WB + wbo::EXTRA + (size_t)256 * 2048, nullptr, smf, tb);
        convert_seg(p.c_v_w2, 64, 0, 64, 128, WB + wbo::EXTRA + (size_t)256 * 2048 + 64 * 128, nullptr, smf, tb);
        if (blockIdx.x < 16) {
            const int which = blockIdx.x >> 3, i = blockIdx.x & 7; const float* pos = which ? p.c_pos_v : p.c_pos_k; const float* w1 = which ? p.c_v_w1 : p.c_k_w1;
            float* b8 = (float*)(ws + 12 * fw::MB);
            if (TIDX < 128) { float a = 0.f; for (int k = i * 256; k < i * 256 + 256; ++k) a += pos[k] * w1[(size_t)k * 128 + TIDX]; b8[(which * 8 + i) * 128 + TIDX] = a; }
        }
    } else if (PH == PH_IN2) {
        gemm_sched(14, 1, [&](bool big, int mt, int nt) {
            if (big) gemm_tile2(ALoadPlain{XB, D}, WB + wbo::IN, 1024, mt * 128, nt * 256, EpiL2{P, (bf16*)(ws + 114 * fw::MB), (bf16*)(ws + 122 * fw::MB), parts}, smem);
            else gemm_tile(ALoadPlain{XB, D}, WB + wbo::IN, 1024, mt * 128, 3584 + nt * 128, EpiL2{P, (bf16*)(ws + 114 * fw::MB), (bf16*)(ws + 122 * fw::MB), parts}, smem);
        });
    } else if (PH == PH_B2) {
        for (int it = blockIdx.x; it < 64; it += gridDim.x) { const int which = it >> 5, rt = it & 31;
            cmp_tile(P, WB + wbo::EXTRA + (size_t)which * 128 * 2048, (const float*)(ws + 12 * fw::MB) + which * 8 * 128, WB + wbo::EXTRA + (size_t)256 * 2048 + which * 64 * 128, which, rt,
                     (bf16*)(ws + 5 * fw::MB), (bf16*)(ws + 6 * fw::MB), smem); }
        build_bias_lut(p.t5, smem, false);
        const int nwin = B * G * (T / (16 * ANQT_WIN));
        const bool split = gridDim.x == 512 && nwin == 2048;
        const int bid = blockIdx.x, nb = bid - 64, cnt = bid < 64 ? 2 : (nb < 128 ? 5 : 4);
        for (int k = 0;; ++k) {
            int item;
            if (split) { if (k >= cnt) break; item = bid < 64 ? k * 512 + 448 + bid : (k < 4 ? k * 512 + nb : (2 + (nb >> 6)) * 512 + 448 + (nb & 63)); }
            else { const int it = (bid < 64 ? bid + (int)gridDim.x : bid) + k * (int)gridDim.x; if (it >= 64 + nwin) break; item = it - 64; }
            win_item(P, (const bf16*)(ws + 122 * fw::MB), (bf16*)(ws + 130 * fw::MB), item, smem);
        }
    } else if (PH == PH_C2) {
        for (int it = blockIdx.x; it < B * G * (T / 32); it += gridDim.x)
            cmpsel_item(P, (const bf16*)(ws + 5 * fw::MB), (const bf16*)(ws + 6 * fw::MB), (bf16*)(ws + 162 * fw::MB), (unsigned long long*)(ws + 9 * fw::MB), it, smem);
    } else if (PH == PH_D2) {
        build_bias_lut(p.t5, smem, false);
        for (int it = blockIdx.x; it < B * G * (T / (16 * ANQT_SEL)); it += gridDim.x)
            sel_item(P, (const bf16*)(ws + 114 * fw::MB), (const unsigned long long*)(ws + 9 * fw::MB), (const bf16*)(ws + 162 * fw::MB), (const bf16*)(ws + 130 * fw::MB), (bf16*)(ws + 206 * fw::MB), it, smem);
    } else if (PH == PH_OUT2) {
        gemm_sched(4, 0, [&](bool, int mt, int nt) { gemm_tile2(ALoadPlain{(const bf16*)(ws + 206 * fw::MB), D}, WB + wbo::OUT, 1024, mt * 128, nt * 256, EpiResid{X, X, XB, parts}, smem); });
    } else if (PH == PH_PREP3) {
        int tb = 0;
        convert_seg(p.d_w_in, 2560, 0, 2560, 1024, WB + wbo::IN, p.norm_g + 3 * D, smf, tb);
        convert_seg(p.d_w_out, 1024, 0, 1024, 1280, WB + wbo::OUT, nullptr, smf, tb);
        lru_convert_gates(p.d_ga_w, p.d_gx_w, WB + wbo::EXTRA);
        for (int i = blockIdx.x * NTHREADS + TIDX; i < LW; i += gridDim.x * NTHREADS) ((float*)(ws + 12 * fw::MB + 786432))[i] = -8.0f * softplusf_(-p.d_lambda[i]);
    } else if (PH == PH_IN3) {
        gemm_sched(8, 4, [&](bool big, int mt, int nt) {
            if (big) gemm_tile2(ALoadPlain{XB, D}, WB + wbo::IN, 1024, mt * 128, nt * 256, EpiBf16{P, 2560, parts}, smem);
            else gemm_tile(ALoadPlain{XB, D}, WB + wbo::IN, 1024, mt * 128, 2048 + nt * 128, EpiBf16{P, 2560, parts}, smem);
        });
    } else if (PH == PH_GATE3) {
        for (int it = blockIdx.x; it < (M / 128) * 16; it += gridDim.x)
            lru_gate_item(P, p.d_conv_w, p.d_conv_b, WB + wbo::EXTRA, p.d_ga_b, p.d_gx_b, (const float*)(ws + 12 * fw::MB + 786432), (bf16*)(ws + wsl::L3_LA), (bf16*)(ws + wsl::L3_BV), (float2*)(ws + wsl::L3_UC), it, smem);
    } else if (PH == PH_SCANB3) {
        for (int it = blockIdx.x; it < B * (T / 64) * 5; it += gridDim.x)
            lru_scan2_item((const bf16*)(ws + wsl::L3_LA), (const bf16*)(ws + wsl::L3_BV), (const float2*)(ws + wsl::L3_UC), P, (bf16*)(ws + wsl::L3_AO), it);
    } else if (PH == PH_OUT3) {
        gemm_sched(4, 0, [&](bool, int mt, int nt) { gemm_tile2(ALoadPlain{(const bf16*)(ws + wsl::L3_AO), LW}, WB + wbo::OUT, 1280, mt * 128, nt * 256, EpiResid{X, X, nullptr, parts}, smem); });
    } else if (PH == PH_FINAL) {
        rows_final(X, parts, p.final_g);
    }
}

template <int PH> __global__ void __launch_bounds__(NTHREADS, 2) k_phase(Params p) {
    extern __shared__ __attribute__((aligned(16))) char smem[];
    run_phase<PH>(p, smem);
}
#define LDS_BYTES 73728
#define MEGA_LDS_BYTES (73728 + 64)
template <int PH> static void launch_phase(const Params& p, hipStream_t s) {
    static bool attr = false;
    if (!attr) { hipFuncSetAttribute((const void*)k_phase<PH>, hipFuncAttributeMaxDynamicSharedMemorySize, LDS_BYTES); attr = true; }
    hipLaunchKernelGGL(k_phase<PH>, dim3(512), dim3(NTHREADS), LDS_BYTES, s, p);
}


#define XB_TMO      128
#define XB_XCNT(j)  (256  + 64 * (j))
#define XB_XSUB(j)  (1280 + 64 * (j))
#define XB_XGEN(j)  (2304 + 64 * (j))
#define XB_TOP      3328
#define XB_TOPGEN   3392
#define XCD_BAR_WORDS 3456
#define XB_SPIN_CAP (1u << 22)
#define LAS __attribute__((address_space(3)))
DI unsigned xb_ld(unsigned* p)              { return __hip_atomic_load(p, __ATOMIC_RELAXED, __HIP_MEMORY_SCOPE_AGENT); }
DI unsigned xb_add(unsigned* p, unsigned v) { return __hip_atomic_fetch_add(p, v, __ATOMIC_RELAXED, __HIP_MEMORY_SCOPE_AGENT); }
DI unsigned xb_xcc_id() { return (unsigned)__builtin_amdgcn_s_getreg((3 << 11) | 20) & 0xFu; }
#define XB_SPIN(cond, bar) do { unsigned _sp = 0; while (cond) { if (_sp < 64u) __builtin_amdgcn_s_sleep(2); else __builtin_amdgcn_s_sleep(32); \
    if ((++_sp & 255u) == 0u) { if (xb_ld(&(bar)[XB_TMO])) break; if (_sp > XB_SPIN_CAP) { atomicAdd(&(bar)[XB_TMO], 1u); break; } } } } while (0)
struct XcdBarrier { unsigned* bar; unsigned x; volatile LAS unsigned* st; };
DI XcdBarrier xcd_barrier_post(unsigned* bar, volatile LAS unsigned* st) {
    XcdBarrier b; b.bar = bar; b.x = xb_xcc_id(); b.st = st;
    if (threadIdx.x == 0) (void)xb_add(&bar[XB_XCNT(b.x)], 1u);
    return b;
}
DI void xcd_barrier_complete(unsigned* bar, unsigned x, unsigned& nloc, unsigned& nx) {
    const unsigned G = gridDim.x * gridDim.y * gridDim.z;
    unsigned sum, cnt, mine, sp = 0u;
    for (;;) {
        sum = 0u; cnt = 0u; mine = 0u;
#pragma unroll
        for (unsigned j = 0; j < 16; ++j) { const unsigned c = xb_ld(&bar[XB_XCNT(j)]); sum += c; cnt += (c > 0u) ? 1u : 0u; mine = (j == x) ? c : mine; }
        if (sum == G) break;
        __builtin_amdgcn_s_sleep(1);
        if ((++sp & 255u) == 0u) { if (xb_ld(&bar[XB_TMO])) break; if (sp > XB_SPIN_CAP) { atomicAdd(&bar[XB_TMO], 1u); break; } }
    }
    nloc = mine > 0u ? mine : 1u; nx = cnt > 0u ? cnt : 1u;
}
DI void xcd_barrier(const XcdBarrier& b) {
    asm volatile("s_waitcnt vmcnt(0)" ::: "memory");
    __syncthreads();
    if (threadIdx.x == 0) {
        unsigned* bar = b.bar;
        __builtin_amdgcn_s_waitcnt(0);
        unsigned nloc = b.st[0], nx = b.st[1];
        if (nloc == 0u) { xcd_barrier_complete(bar, b.x, nloc, nx); b.st[0] = nloc; b.st[1] = nx; }
        const unsigned old = xb_add(&bar[XB_XSUB(b.x)], 1u);
        const unsigned gen = old / nloc;
        asm volatile("buffer_inv sc1" ::: "memory");
        if (old + 1u == (gen + 1u) * nloc) {
            __builtin_amdgcn_fence(__ATOMIC_RELEASE, "agent");
            asm volatile("s_waitcnt vmcnt(0)" ::: "memory");
            const unsigned og = xb_add(&bar[XB_TOP], 1u);
            const unsigned tg = og / nx;
            if (og + 1u == (tg + 1u) * nx) xb_add(&bar[XB_TOPGEN], 1u);
            else XB_SPIN(xb_ld(&bar[XB_TOPGEN]) == tg, bar);
            xb_add(&bar[XB_XGEN(b.x)], 1u);
            asm volatile("s_waitcnt vmcnt(0)" ::: "memory");
        } else {
            XB_SPIN(xb_ld(&bar[XB_XGEN(b.x)]) == gen, bar);
            asm volatile("s_waitcnt vmcnt(0)" ::: "memory");
        }
    }
    __syncthreads();
}

#define MEGA_PHASES(X) X(PH_IN0) X(PH_ATTN0) X(PH_OUT0) X(PH_PREP1) X(PH_IN1) X(PH_LORA1) X(PH_CPREP1) X(PH_SCAN1) X(PH_GN1) X(PH_OUT1) \
    X(PH_PREP2) X(PH_IN2) X(PH_B2) X(PH_C2) X(PH_D2) X(PH_OUT2) X(PH_PREP3) X(PH_IN3) X(PH_GATE3) X(PH_SCANB3) X(PH_OUT3)
__global__ void __launch_bounds__(NTHREADS, 2) mega_kernel(Params p) {
    extern __shared__ __attribute__((aligned(16))) char smem[];
    cooperative_groups::grid_group grid = cooperative_groups::this_grid();
    volatile LAS unsigned* xst = (volatile LAS unsigned*)(smem + 73728);
    if (threadIdx.x < 4) xst[threadIdx.x] = 0u;
    __syncthreads();
    XcdBarrier xb = xcd_barrier_post((unsigned*)p.ws, xst);
    run_phase<PH_PREP0>(p, smem);
    if (p.ws == nullptr) grid.sync();
    xcd_barrier(xb);
#define MEGA_STEP(ph) run_phase<ph>(p, smem); xcd_barrier(xb);
    MEGA_PHASES(MEGA_STEP)
#undef MEGA_STEP
    run_phase<PH_FINAL>(p, smem);
}
static void launch_mega(const Params& p, hipStream_t s) {
    static int grid_blocks = 0;
    if (!grid_blocks) {
        int dev = 0, cus = 0, per_cu = 0;
        hipGetDevice(&dev);
        hipDeviceGetAttribute(&cus, hipDeviceAttributeMultiprocessorCount, dev);
        hipFuncSetAttribute((const void*)mega_kernel, hipFuncAttributeMaxDynamicSharedMemorySize, MEGA_LDS_BYTES);
        hipOccupancyMaxActiveBlocksPerMultiprocessor(&per_cu, mega_kernel, NTHREADS, MEGA_LDS_BYTES);
        if (per_cu > 2) per_cu = 2;
        if (per_cu < 1) per_cu = 1;
        grid_blocks = cus * per_cu;
    }
    hipMemsetAsync(p.ws, 0, 16384, s);
    Params pp = p; void* args[] = {&pp};
    hipError_t e = hipLaunchCooperativeKernel((const void*)mega_kernel, dim3(grid_blocks), dim3(NTHREADS), args, MEGA_LDS_BYTES, s);
    if (e != hipSuccess) fprintf(stderr, "cooperative launch failed: %s (grid %d)\n", hipGetErrorString(e), grid_blocks);
}
#endif

#ifndef CPU_SHIM
template <class F> __global__ void __launch_bounds__(256) k_run(F f, long n) {
    const long i = (long)blockIdx.x * 256 + threadIdx.x; if (i < n) f(i);
}
template <class F> static void launch(const F& f, long n, hipStream_t s) {
    hipLaunchKernelGGL(k_run<F>, dim3((unsigned)((n + 255) / 256)), dim3(256), 0, s, f, n);
}
#else
template <class F> static void launch(const F& f, long n, hipStream_t) {
#pragma omp parallel for schedule(dynamic, 64)
    for (long i = 0; i < n; ++i) f(i);
}
#endif

#ifdef CPU_SHIM
void cpu_layer_hook(int layer, const float* X, const char* ws);
#define LAYER_HOOK(l) cpu_layer_hook(l, X, ws)
#else
#define LAYER_HOOK(l)
#endif

#define FAST_GEMM 0
#if FAST_GEMM
#define FASTP(ph) launch_phase<ph>(p, s)
#else
#define FASTP(ph)
#endif

static void run_naive(const Params& p, hipStream_t s) {
    char* ws = p.ws;
    float* rs = (float*)(ws + wsl::RS);
    bf16* P = (bf16*)(ws + wsl::P);
    float* X = p.out;
    (void)rs;
    {
        bf16* AO = (bf16*)(ws + wsl::L0_AO);
#if FAST_GEMM
        FASTP(PH_PREP0); FASTP(PH_IN0);
#else
        launch(RstdF{p.x, rs}, M, s);
        launch(GemmInF{p.x, rs, p.norm_g + 0 * D, p.a_w_in, P, A_COLS}, (long)M * (A_COLS / 4), s);
#endif
#if FAST_GEMM
        FASTP(PH_ATTN0); (void)AO;
#else
        launch(SwaF{P, p.t5, p.a_sinks, AO}, (long)M * H, s);
#endif
#if FAST_GEMM
        FASTP(PH_OUT0);
#else
        launch(GemmOutF{AO, p.a_w_out, p.x, X, 1024}, (long)M * (D / 4), s);
#endif
    }
    LAYER_HOOK(0);
    {
        bf16* XN = (bf16*)(ws + wsl::L1_XN); bf16* WL = (bf16*)(ws + wsl::L1_WL); bf16* AV = (bf16*)(ws + wsl::L1_AV);
        float* hw = (float*)(ws + wsl::LHW); float* ha = (float*)(ws + wsl::LHA);
#if FAST_GEMM
        FASTP(PH_PREP1); FASTP(PH_IN1); FASTP(PH_LORA1); FASTP(PH_CPREP1); FASTP(PH_SCAN1); FASTP(PH_GN1); FASTP(PH_OUT1);
        (void)XN; (void)WL; (void)AV; (void)hw; (void)ha;
#else
        launch(RstdF{X, rs}, M, s);
        launch(XnF{X, rs, p.norm_g + 1 * D, XN}, (long)M * D, s);
        launch(GemmRwkvF{XN, p.b_mu, p.b_w_in, P}, (long)M * 1024, s);
        launch(LoraHidF{XN, p.b_mu, p.b_w1, p.b_a1, hw, ha}, (long)M * 128, s);
        launch(LoraOutF{hw, ha, p.b_w0, p.b_w2, p.b_a0, p.b_a2, WL, AV}, (long)M * D, s);
        launch(RwkvScanF{P, WL, AV, p.b_k_k, p.b_k_a, XN}, (long)B * H * 64, s);
        launch(RwkvGnF{P, AV, p.b_k_a, p.b_r_k, p.b_lnx_w, p.b_lnx_b, XN}, (long)M * H, s);
        launch(GemmOutF{XN, p.b_w_out, X, X, 1024}, (long)M * (D / 4), s);
#endif
    }
    LAYER_HOOK(1);
    {
        float* hk = (float*)(ws + wsl::HK); float* hv = (float*)(ws + wsl::HV);
        float* kc = (float*)(ws + wsl::KC); float* vc = (float*)(ws + wsl::VC);
        float* st = (float*)(ws + wsl::ST); int* sel = (int*)(ws + wsl::SEL); float* imp = (float*)(ws + wsl::L2_IMP);
        bf16* AO = (bf16*)(ws + wsl::L2_AO); bf16* OC = (bf16*)(ws + wsl::L2_OC); bf16* OS = (bf16*)(ws + wsl::L2_OS);
#if FAST_GEMM
        FASTP(PH_PREP2); FASTP(PH_IN2); FASTP(PH_B2); FASTP(PH_C2); FASTP(PH_D2); FASTP(PH_OUT2);
        (void)hk; (void)hv; (void)kc; (void)vc; (void)st; (void)sel; (void)imp; (void)AO; (void)OC; (void)OS;
#else
        launch(RstdF{X, rs}, M, s);
        launch(GemmInF{X, rs, p.norm_g + 2 * D, p.c_w_in, P, C_COLS}, (long)M * (C_COLS / 4), s);
        launch(CmpHidF{P, p.c_pos_k, p.c_k_w1, p.c_pos_v, p.c_v_w1, hk, hv}, 2L * B * G * NCMP * 128, s);
        launch(CmpOutF{hk, hv, p.c_k_w2, p.c_v_w2, kc, vc}, 2L * B * G * NCMP * 64, s);
        launch(CmpAttnF{P, kc, vc, st, OC}, (long)M * H, s);
        launch(ImpF{P, kc, st, imp}, (long)M * G * NSEL, s);
        launch(TopkF{imp, sel}, (long)M * G, s);
        launch(SelAttnF{P, p.t5, sel, OS}, (long)M * H, s);
        launch(WinAttnF{P, p.t5, OC, OS, AO}, (long)M * H, s);
        LAYER_HOOK(20);
        launch(GemmOutF{AO, p.c_w_out, X, X, 1024}, (long)M * (D / 4), s);
#endif
    }
    LAYER_HOOK(2);
    {
        bf16* AO = (bf16*)(ws + wsl::L3_AO); bf16* UC = (bf16*)(ws + wsl::L3_UC); bf16* LA = (bf16*)(ws + wsl::L3_LA); bf16* BV = (bf16*)(ws + wsl::L3_BV);
#if FAST_GEMM
        FASTP(PH_PREP3); FASTP(PH_IN3); FASTP(PH_GATE3); FASTP(PH_SCANA3); FASTP(PH_SCANB3); FASTP(PH_OUT3);
        (void)AO; (void)UC; (void)LA; (void)BV;
#else
        launch(RstdF{X, rs}, M, s);
        launch(GemmInF{X, rs, p.norm_g + 3 * D, p.d_w_in, P, 2560}, (long)M * (2560 / 4), s);
        launch(ConvF{P, p.d_conv_w, p.d_conv_b, UC}, (long)M * LW, s);
        launch(LruGateF{UC, p.d_ga_w, p.d_ga_b, p.d_gx_w, p.d_gx_b, p.d_lambda, LA, BV}, (long)M * LW, s);
        launch(LruScanF{P, LA, BV, AO}, (long)B * LW, s);
        launch(GemmOutF{AO, p.d_w_out, X, X, LW}, (long)M * (D / 4), s);
#endif
    }
    LAYER_HOOK(3);
#if FAST_GEMM
    FASTP(PH_FINAL);
#else
    launch(FinalNormF{X, p.final_g}, M, s);
#endif
}

extern "C" void kernel_launch(void* const* d_in, const int* in_sizes, int n_in, void* d_out, int out_size, void* d_ws, size_t ws_size,
                              hipStream_t stream) {
    (void)in_sizes; (void)n_in; (void)out_size; (void)ws_size;
    Params p{};
    const float* const* in = (const float* const*)d_in;
    int k = 0;
    p.x = in[k++]; p.t5 = in[k++]; p.norm_g = in[k++]; p.final_g = in[k++];
    p.a_w_in = in[k++]; p.a_sinks = in[k++]; p.a_w_out = in[k++];
    p.b_mu = in[k++]; p.b_w_in = in[k++]; p.b_w0 = in[k++]; p.b_w1 = in[k++]; p.b_w2 = in[k++]; p.b_a0 = in[k++]; p.b_a1 = in[k++]; p.b_a2 = in[k++];
    p.b_k_k = in[k++]; p.b_k_a = in[k++]; p.b_r_k = in[k++]; p.b_lnx_w = in[k++]; p.b_lnx_b = in[k++]; p.b_w_out = in[k++];
    p.c_w_in = in[k++]; p.c_pos_k = in[k++]; p.c_k_w1 = in[k++]; p.c_k_w2 = in[k++]; p.c_pos_v = in[k++]; p.c_v_w1 = in[k++]; p.c_v_w2 = in[k++]; p.c_w_out = in[k++];
    p.d_w_in = in[k++]; p.d_conv_w = in[k++]; p.d_conv_b = in[k++]; p.d_ga_w = in[k++]; p.d_ga_b = in[k++]; p.d_gx_w = in[k++]; p.d_gx_b = in[k++];
    p.d_lambda = in[k++]; p.d_w_out = in[k++];
    p.out = (float*)d_out; p.ws = (char*)d_ws;
#if !defined(CPU_SHIM) && !defined(MULTI_LAUNCH) && !defined(ALL_NAIVE)
    launch_mega(p, stream);
#else
    run_naive(p, stream);
#endif
}
```

```cpp
#ifndef CPU_SHIM
#include <hip/hip_runtime.h>
#include <hip/hip_cooperative_groups.h>
#include <cstdio>
#define HD __host__ __device__ __forceinline__
#else
#include <cmath>
#include <cstring>
#include <cstdio>
#include <cstdlib>
#include <cstdint>
#define HD inline
typedef void* hipStream_t;
#endif
#include <cstddef>

#ifndef CFG_B
#define CFG_B 4
#endif
#ifndef CFG_T
#define CFG_T 4096
#endif

namespace cfg {
constexpr int B = CFG_B, T = CFG_T, M = B * T, D = 1024;
constexpr int H = 16, G = 4, R = 4, DH = 64;
constexpr int A_COLS = 2560;
constexpr int C_COLS = 3632;
constexpr int NCMP = (T - 32) / 16 + 1;
constexpr int NSEL = T / 64;
constexpr int KTOP = NSEL < 16 ? NSEL : 16;
constexpr int LW = 1280;
}
using namespace cfg;

typedef unsigned short bf16;

HD unsigned f_as_u(float f) {
#ifndef CPU_SHIM
    return __float_as_uint(f);
#else
    unsigned u; memcpy(&u, &f, 4); return u;
#endif
}
HD float u_as_f(unsigned u) {
#ifndef CPU_SHIM
    return __uint_as_float(u);
#else
    float f; memcpy(&f, &u, 4); return f;
#endif
}
HD float bf2f(bf16 v) { return u_as_f(((unsigned)v) << 16); }
HD bf16 f2bf(float f) { unsigned u = f_as_u(f); u += 0x7fffu + ((u >> 16) & 1u); return (bf16)(u >> 16); }
HD float sigmoidf_(float x) { return 1.0f / (1.0f + expf(-x)); }
HD float siluf_(float x) { return x / (1.0f + expf(-x)); }
HD float softplusf_(float x) { return x > 20.f ? x : log1pf(expf(x)); }

HD int t5_bucket(int d) {
    if (d < 16) return d < 0 ? 0 : d;
    if (d >= 113) return 31;
    if (d >= 99) return 30;
    if (d >= 87) return 29;
    if (d >= 77) return 28;
    if (d >= 67) return 27;
    if (d >= 59) return 26;
    if (d >= 52) return 25;
    if (d >= 46) return 24;
    if (d >= 40) return 23;
    if (d >= 35) return 22;
    if (d >= 31) return 21;
    if (d >= 27) return 20;
    if (d >= 24) return 19;
    if (d >= 21) return 18;
    if (d >= 19) return 17;
    return 16;
}

struct Params {
    const float *x, *t5, *norm_g, *final_g;
    const float *a_w_in, *a_sinks, *a_w_out;
    const float *b_mu, *b_w_in, *b_w0, *b_w1, *b_w2, *b_a0, *b_a1, *b_a2, *b_k_k, *b_k_a, *b_r_k, *b_lnx_w, *b_lnx_b, *b_w_out;
    const float *c_w_in, *c_pos_k, *c_k_w1, *c_k_w2, *c_pos_v, *c_v_w1, *c_v_w2, *c_w_out;
    const float *d_w_in, *d_conv_w, *d_conv_b, *d_ga_w, *d_ga_b, *d_gx_w, *d_gx_b, *d_lambda, *d_w_out;
    float* out;
    char* ws;
};

namespace wsl {
constexpr size_t MB = 1024 * 1024;
constexpr size_t RS = 0;
constexpr size_t HK = 1 * MB;
constexpr size_t HV = 3 * MB;
constexpr size_t KC = 5 * MB;
constexpr size_t VC = 6 * MB;
constexpr size_t ST = 7 * MB;
constexpr size_t SEL = 9 * MB;
constexpr size_t LHW = 1 * MB;
constexpr size_t LHA = 5 * MB;
constexpr size_t P = 14 * MB;
constexpr size_t SZ1024 = (size_t)M * 1024 * 2, SZ1280 = (size_t)M * 1280 * 2;
constexpr size_t L0_AO = P + (size_t)M * 2560 * 2;
constexpr size_t L1_XN = P + (size_t)M * 4096 * 2, L1_WL = L1_XN + SZ1024, L1_AV = L1_WL + SZ1024;
constexpr size_t L2_AO = P + (size_t)M * 3632 * 2, L2_OC = L2_AO + SZ1024, L2_OS = L2_OC + SZ1024, L2_IMP = L2_OS + SZ1024;
constexpr size_t L3_AO = P + (size_t)M * 2560 * 2, L3_UC = L3_AO + SZ1280, L3_LA = L3_UC + SZ1280, L3_BV = L3_LA + SZ1280;
constexpr size_t TOTAL = L3_BV + SZ1280;
}

struct RstdF {
    const float* x; float* rs;
    HD void operator()(long m) const {
        const float* r = x + (size_t)m * D; float s = 0.f;
        for (int k = 0; k < D; ++k) s += r[k] * r[k];
        rs[m] = 1.0f / sqrtf(s / D + 1e-6f);
    }
};
struct XnF {
    const float* x; const float* rs; const float* g; bf16* xn;
    HD void operator()(long i) const { long m = i / D; int k = (int)(i % D); xn[i] = f2bf(x[i] * rs[m] * g[k]); }
};
struct GemmInF {
    const float *x, *rs, *g, *W; bf16* P; long long N;
    HD void operator()(long i) const {
        const int n4 = (int)N / 4; const long m = i / n4; const int n = (int)(i % n4) * 4;
        const float* xr = x + (size_t)m * D; const float r = rs[m];
        float a0 = 0, a1 = 0, a2 = 0, a3 = 0;
        for (int k = 0; k < D; ++k) {
            const float a = xr[k] * r * g[k]; const float* w = W + (size_t)k * N + n;
            a0 += a * w[0]; a1 += a * w[1]; a2 += a * w[2]; a3 += a * w[3];
        }
        bf16* p = P + (size_t)m * N + n; p[0] = f2bf(a0); p[1] = f2bf(a1); p[2] = f2bf(a2); p[3] = f2bf(a3);
    }
};
struct GemmOutF {
    const bf16* A; const float* W; const float* xin; float* xout; long long K;
    HD void operator()(long i) const {
        const int n4 = D / 4; const long m = i / n4; const int n = (int)(i % n4) * 4;
        const bf16* ar = A + (size_t)m * K;
        float a0 = 0, a1 = 0, a2 = 0, a3 = 0;
        for (int k = 0; k < K; ++k) {
            const float a = bf2f(ar[k]); const float* w = W + (size_t)k * D + n;
            a0 += a * w[0]; a1 += a * w[1]; a2 += a * w[2]; a3 += a * w[3];
        }
        const float* xi = xin + (size_t)m * D + n; float* xo = xout + (size_t)m * D + n;
        xo[0] = xi[0] + a0; xo[1] = xi[1] + a1; xo[2] = xi[2] + a2; xo[3] = xi[3] + a3;
    }
};

struct SwaF {
    const bf16* P; const float* t5; const float* sinks; bf16* AO;
    HD void operator()(long i) const {
        const long m = i / H; const int h = (int)(i % H), g = h / R; const int t = (int)(m % T); const long mb = m - t;
        float q[DH], o[DH];
#pragma unroll
        for (int d = 0; d < DH; ++d) { q[d] = bf2f(P[(size_t)m * A_COLS + h * DH + d]); o[d] = 0.f; }
        float mx = sinks[h], l = 1.0f;
        const int s0 = t - 127 < 0 ? 0 : t - 127;
        for (int s = s0; s <= t; ++s) {
            const bf16* kr = P + (size_t)(mb + s) * A_COLS + 1024 + g * DH;
            const bf16* vr = kr + 256;
            float sc = 0.f;
#pragma unroll
            for (int d = 0; d < DH; ++d) sc += q[d] * bf2f(kr[d]);
            sc = sc * 0.125f + t5[t5_bucket(t - s) * H + h];
            const float mn = sc > mx ? sc : mx; const float al = expf(mx - mn), p = expf(sc - mn);
            l = l * al + p; mx = mn;
#pragma unroll
            for (int d = 0; d < DH; ++d) o[d] = o[d] * al + p * bf2f(vr[d]);
        }
        const float il = 1.0f / l;
#pragma unroll
        for (int d = 0; d < DH; ++d) {
            const float z = bf2f(P[(size_t)m * A_COLS + 1536 + h * DH + d]);
            AO[(size_t)m * D + h * DH + d] = f2bf(o[d] * il * siluf_(z));
        }
    }
};

struct GemmRwkvF {
    const bf16* xn; const float* mu; const float* W; bf16* P;
    HD void operator()(long i) const {
        const int N = 4096, n4 = N / 4; const long m = i / n4; const int n = (int)(i % n4) * 4; const int s = n / 1024;
        const int t = (int)(m % T);
        const bf16* xr = xn + (size_t)m * D; const float* mus = mu + s * D;
        float a0 = 0, a1 = 0, a2 = 0, a3 = 0;
        for (int k = 0; k < D; ++k) {
            const float xc = bf2f(xr[k]); const float xp = t > 0 ? bf2f(xr[k - D]) : 0.f;
            const float a = xc + (xp - xc) * mus[k]; const float* w = W + (size_t)k * N + n;
            a0 += a * w[0]; a1 += a * w[1]; a2 += a * w[2]; a3 += a * w[3];
        }
        bf16* p = P + (size_t)m * N + n; p[0] = f2bf(a0); p[1] = f2bf(a1); p[2] = f2bf(a2); p[3] = f2bf(a3);
    }
};
struct LoraHidF {
    const bf16* xn; const float* mu; const float* w1; const float* a1; float* hw; float* ha;
    HD void operator()(long i) const {
        const long m = i / 128; const int jj = (int)(i % 128); const int which = jj / 64, j = jj % 64; const int t = (int)(m % T);
        const bf16* xr = xn + (size_t)m * D; const float* mus = mu + (4 + which) * D; const float* W = which ? a1 : w1;
        float acc = 0.f;
        for (int k = 0; k < D; ++k) {
            const float xc = bf2f(xr[k]); const float xp = t > 0 ? bf2f(xr[k - D]) : 0.f;
            acc += (xc + (xp - xc) * mus[k]) * W[(size_t)k * 64 + j];
        }
        if (which) ha[(size_t)m * 64 + j] = acc; else hw[(size_t)m * 64 + j] = tanhf(acc);
    }
};
struct LoraOutF {
    const float *hw, *ha, *w0, *w2, *a0, *a2; bf16* wlog; bf16* av;
    HD void operator()(long i) const {
        const long m = i / D; const int c = (int)(i % D);
        float sw = 0.f, sa = 0.f;
        for (int j = 0; j < 64; ++j) { sw += hw[(size_t)m * 64 + j] * w2[(size_t)j * D + c]; sa += ha[(size_t)m * 64 + j] * a2[(size_t)j * D + c]; }
        const float wr = -softplusf_(-(w0[c] + sw)) - 0.5f;
        wlog[i] = f2bf(-expf(wr)); av[i] = f2bf(sigmoidf_(a0[c] + sa));
    }
};
struct RwkvScanF {
    const bf16* P; const bf16* wlog; const bf16* av; const float* k_k; const float* k_a; bf16* ys;
    HD void operator()(long idx) const {
        const int i = (int)(idx % 64); const int h = (int)((idx / 64) % H); const int b = (int)(idx / (64 * H));
        float S[64];
#pragma unroll
        for (int j = 0; j < 64; ++j) S[j] = 0.f;
        for (int t = 0; t < T; ++t) {
            const size_t m = (size_t)b * T + t; const bf16* pr = P + m * 4096 + h * 64;
            const bf16* wl = wlog + m * D + h * 64; const bf16* ar = av + m * D + h * 64;
            float n2 = 0.f;
#pragma unroll
            for (int j = 0; j < 64; ++j) { const float kk = bf2f(pr[1024 + j]) * k_k[h * 64 + j]; n2 += kk * kk; }
            float nr = sqrtf(n2); nr = nr > 1e-12f ? nr : 1e-12f; const float inr = 1.0f / nr;
            float sa = 0.f;
#pragma unroll
            for (int j = 0; j < 64; ++j) { const float kk = bf2f(pr[1024 + j]) * k_k[h * 64 + j] * inr; sa += S[j] * (-kk); }
            const float vi = bf2f(pr[2048 + i]); float y = 0.f;
#pragma unroll
            for (int j = 0; j < 64; ++j) {
                const float kr = bf2f(pr[1024 + j]); const float a = bf2f(ar[j]);
                const float kk = kr * k_k[h * 64 + j] * inr; const float kp = kr * (1.0f + (a - 1.0f) * k_a[h * 64 + j]);
                const float dec = expf(bf2f(wl[j]));
                S[j] = S[j] * dec + sa * (kk * a) + vi * kp;
                y += S[j] * bf2f(pr[j]);
            }
            ys[m * D + h * 64 + i] = f2bf(y);
        }
    }
};
struct RwkvGnF {
    const bf16* P; const bf16* av; const float *k_a, *r_k, *lnx_w, *lnx_b; bf16* ys;
    HD void operator()(long idx) const {
        const long m = idx / H; const int h = (int)(idx % H);
        bf16* yr = ys + (size_t)m * D + h * 64; const bf16* pr = P + (size_t)m * 4096 + h * 64; const bf16* ar = av + (size_t)m * D + h * 64;
        float mean = 0.f;
        for (int j = 0; j < 64; ++j) mean += bf2f(yr[j]);
        mean /= 64.f; float var = 0.f;
        for (int j = 0; j < 64; ++j) { const float d = bf2f(yr[j]) - mean; var += d * d; }
        var /= 64.f; const float rstd = 1.0f / sqrtf(var + 64e-5f);
        float bs = 0.f;
        for (int j = 0; j < 64; ++j) { const float kr = bf2f(pr[1024 + j]); const float kp = kr * (1.0f + (bf2f(ar[j]) - 1.0f) * k_a[h * 64 + j]); bs += bf2f(pr[j]) * kp * r_k[h * 64 + j]; }
        for (int j = 0; j < 64; ++j) {
            const float yn = (bf2f(yr[j]) - mean) * rstd * lnx_w[h * 64 + j] + lnx_b[h * 64 + j];
            const float z = bf2f(pr[3072 + j]);
            yr[j] = f2bf((yn + bs * bf2f(pr[2048 + j])) * siluf_(z));
        }
    }
};

struct CmpHidF {
    const bf16* P; const float *pos_k, *w1_k, *pos_v, *w1_v; float* hk; float* hv;
    HD void operator()(long idx) const {
        const int j = (int)(idx % 128); long r = idx / 128; const int n = (int)(r % NCMP); r /= NCMP; const int g = (int)(r % G); r /= G;
        const int b = (int)(r % B); const int which = (int)(r / B);
        const float* pos = which ? pos_v : pos_k; const float* w1 = which ? w1_v : w1_k; const int col = 1024 + (which ? 256 : 0) + g * 64;
        float acc = 0.f;
        for (int l = 0; l < 32; ++l) {
            const bf16* src = P + (size_t)(b * T + 16 * n + l) * C_COLS + col;
            for (int d = 0; d < 64; ++d) acc += (bf2f(src[d]) + pos[l * 64 + d]) * w1[(size_t)(l * 64 + d) * 128 + j];
        }
        (which ? hv : hk)[(((size_t)b * G + g) * NCMP + n) * 128 + j] = siluf_(acc);
    }
};
struct CmpOutF {
    const float *hk, *hv, *w2_k, *w2_v; float* kc; float* vc;
    HD void operator()(long idx) const {
        const int d = (int)(idx % 64); long r = idx / 64; const long row = r % ((long)B * G * NCMP); const int which = (int)(r / ((long)B * G * NCMP));
        const float* hsrc = (which ? hv : hk) + (size_t)row * 128; const float* w2 = which ? w2_v : w2_k;
        float acc = 0.f;
        for (int j = 0; j < 128; ++j) acc += hsrc[j] * w2[j * 64 + d];
        (which ? vc : kc)[(size_t)row * 64 + d] = acc;
    }
};
struct CmpAttnF {
    const bf16* P; const float *kc, *vc; float* st; bf16* oc;
    HD void operator()(long i) const {
        const long m = i / H; const int h = (int)(i % H), g = h / R; const int t = (int)(m % T); const int b = (int)(m / T);
        float q[DH], o[DH];
#pragma unroll
        for (int d = 0; d < DH; ++d) { q[d] = bf2f(P[(size_t)m * C_COLS + h * DH + d]); o[d] = 0.f; }
        const int nv = t < 31 ? 0 : (t - 31) / 16 + 1;
        float mx = -1e30f, l = 0.f;
        for (int n = 0; n < nv; ++n) {
            const float* kr = kc + (((size_t)b * G + g) * NCMP + n) * 64; const float* vr = vc + (((size_t)b * G + g) * NCMP + n) * 64;
            float sc = 0.f;
#pragma unroll
            for (int d = 0; d < DH; ++d) sc += q[d] * kr[d];
            sc *= 0.125f;
            const float mn = sc > mx ? sc : mx; const float al = expf(mx - mn), p = expf(sc - mn);
            l = l * al + p; mx = mn;
#pragma unroll
            for (int d = 0; d < DH; ++d) o[d] = o[d] * al + p * vr[d];
        }
        const float il = nv > 0 ? 1.0f / l : 0.f;
        st[(size_t)i * 2] = mx; st[(size_t)i * 2 + 1] = il;
#pragma unroll
        for (int d = 0; d < DH; ++d) oc[(size_t)m * D + h * DH + d] = f2bf(o[d] * il);
    }
};
struct ImpF {
    const bf16* P; const float *kc, *st; float* imp;
    HD void operator()(long idx) const {
        const int s = (int)(idx % NSEL); long r = idx / NSEL; const int g = (int)(r % G); const long m = r / G;
        const int t = (int)(m % T); const int b = (int)(m / T); const int cur = t / 64;
        float v;
        if (s == 0 || s == cur || s == cur - 1) v = 1e30f;
        else if (s * 64 > t) v = -1e30f;
        else {
            v = 0.f; const int nv = t < 31 ? 0 : (t - 31) / 16 + 1;
            int n0 = 4 * s - 1; if (n0 < 0) n0 = 0; int n1 = 4 * s + 3; if (n1 > NCMP - 1) n1 = NCMP - 1; if (n1 > nv - 1) n1 = nv - 1;
            for (int rr = 0; rr < R; ++rr) {
                const int h = g * R + rr; const bf16* qr = P + (size_t)m * C_COLS + h * DH;
                const float mx = st[((size_t)m * H + h) * 2], il = st[((size_t)m * H + h) * 2 + 1];
                for (int n = n0; n <= n1; ++n) {
                    const float* kr = kc + (((size_t)b * G + g) * NCMP + n) * 64; float sc = 0.f;
                    for (int d = 0; d < DH; ++d) sc += bf2f(qr[d]) * kr[d];
                    v += expf(sc * 0.125f - mx) * il;
                }
            }
        }
        imp[idx] = v;
    }
};
struct TopkF {
    const float* imp; int* sel;
    HD void operator()(long idx) const {
        const float* v = imp + (size_t)idx * NSEL; unsigned long long used = 0ull;
        for (int j = 0; j < KTOP; ++j) {
            int best = -1; float bv = 0.f;
            for (int s = 0; s < NSEL; ++s) { if ((used >> s) & 1ull) continue; const float x = v[s]; if (best < 0 || x > bv) { best = s; bv = x; } }
            used |= 1ull << best; sel[(size_t)idx * 16 + j] = best;
        }
    }
};
struct SelAttnF {
    const bf16* P; const float* t5; const int* sel; bf16* os;
    HD void operator()(long i) const {
        const long m = i / H; const int h = (int)(i % H), g = h / R; const int t = (int)(m % T); const long mb = m - t;
        float q[DH], o[DH];
#pragma unroll
        for (int d = 0; d < DH; ++d) { q[d] = bf2f(P[(size_t)m * C_COLS + h * DH + d]); o[d] = 0.f; }
        float mx = -1e30f, l = 0.f;
        for (int j = 0; j < KTOP; ++j) {
            const int blk = sel[((size_t)m * G + g) * 16 + j];
            for (int ll = 0; ll < 64; ++ll) {
                const int s = blk * 64 + ll; if (s > t) break;
                const bf16* kr = P + (size_t)(mb + s) * C_COLS + 1536 + g * DH; const bf16* vr = kr + 256;
                float sc = 0.f;
#pragma unroll
                for (int d = 0; d < DH; ++d) sc += q[d] * bf2f(kr[d]);
                sc = sc * 0.125f + t5[t5_bucket(t - s) * H + h];
                const float mn = sc > mx ? sc : mx; const float al = expf(mx - mn), p = expf(sc - mn);
                l = l * al + p; mx = mn;
#pragma unroll
                for (int d = 0; d < DH; ++d) o[d] = o[d] * al + p * bf2f(vr[d]);
            }
        }
        const float il = 1.0f / l;
#pragma unroll
        for (int d = 0; d < DH; ++d) os[(size_t)m * D + h * DH + d] = f2bf(o[d] * il);
    }
};
struct WinAttnF {
    const bf16* P; const float* t5; const bf16* oc; const bf16* os; bf16* AO;
    HD void operator()(long i) const {
        const long m = i / H; const int h = (int)(i % H), g = h / R, rr = h % R; const int t = (int)(m % T); const long mb = m - t;
        float q[DH], o[DH];
#pragma unroll
        for (int d = 0; d < DH; ++d) { q[d] = bf2f(P[(size_t)m * C_COLS + h * DH + d]); o[d] = 0.f; }
        float mx = -1e30f, l = 0.f;
        const int s0 = t - 511 < 0 ? 0 : t - 511;
        for (int s = s0; s <= t; ++s) {
            const bf16* kr = P + (size_t)(mb + s) * C_COLS + 2048 + g * DH; const bf16* vr = kr + 256;
            float sc = 0.f;
#pragma unroll
            for (int d = 0; d < DH; ++d) sc += q[d] * bf2f(kr[d]);
            sc = sc * 0.125f + t5[t5_bucket(t - s) * H + h];
            const float mn = sc > mx ? sc : mx; const float al = expf(mx - mn), p = expf(sc - mn);
            l = l * al + p; mx = mn;
#pragma unroll
            for (int d = 0; d < DH; ++d) o[d] = o[d] * al + p * bf2f(vr[d]);
        }
        const float il = 1.0f / l;
        const bf16* gr = P + (size_t)m * C_COLS + 2560;
        const float g0 = sigmoidf_(bf2f(gr[0 * 16 + g * R + rr])), g1 = sigmoidf_(bf2f(gr[1 * 16 + g * R + rr])), g2 = sigmoidf_(bf2f(gr[2 * 16 + g * R + rr]));
#pragma unroll
        for (int d = 0; d < DH; ++d) {
            const size_t oi = (size_t)m * D + h * DH + d;
            const float z = bf2f(P[(size_t)m * C_COLS + 2608 + h * DH + d]);
            AO[oi] = f2bf((g0 * bf2f(oc[oi]) + g1 * bf2f(os[oi]) + g2 * o[d] * il) * siluf_(z));
        }
    }
};

struct ConvF {
    const bf16* P; const float *cw, *cb; bf16* uc;
    HD void operator()(long i) const {
        const long m = i / LW; const int c = (int)(i % LW); const int t = (int)(m % T);
        float acc = cb[c];
        for (int w = 0; w < 4; ++w) { const int tt = t - 3 + w; if (tt >= 0) acc += cw[w * LW + c] * bf2f(P[(size_t)(m - 3 + w) * 2560 + c]); }
        uc[i] = f2bf(acc);
    }
};
struct LruGateF {
    const bf16* uc; const float *gaw, *gab, *gxw, *gxb, *lam; bf16* la; bf16* bv;
    HD void operator()(long i) const {
        const long m = i / LW; const int c = (int)(i % LW); const int n = c / 80, d = c % 80;
        const bf16* ub = uc + (size_t)m * LW + n * 80; float ra = gab[c], rx = gxb[c];
        for (int k = 0; k < 80; ++k) { const float u = bf2f(ub[k]); ra += u * gaw[((size_t)n * 80 + k) * 80 + d]; rx += u * gxw[((size_t)n * 80 + k) * 80 + d]; }
        const float r = sigmoidf_(ra), ig = sigmoidf_(rx);
        const float loga = -8.0f * r * softplusf_(-lam[c]);
        la[i] = f2bf(loga);
        bv[i] = f2bf(sqrtf(-expm1f(2.0f * loga)) * (ig * bf2f(uc[i])));
    }
};
struct LruScanF {
    const bf16* P; const bf16* la; const bf16* bv; bf16* AO;
    HD void operator()(long idx) const {
        const int c = (int)(idx % LW); const int b = (int)(idx / LW); float h = 0.f;
        for (int t = 0; t < T; ++t) {
            const size_t m = (size_t)b * T + t;
            h = expf(bf2f(la[m * LW + c])) * h + bf2f(bv[m * LW + c]);
            AO[m * LW + c] = f2bf(h * siluf_(bf2f(P[m * 2560 + LW + c])));
        }
    }
};
struct FinalNormF {
    float* x; const float* g;
    HD void operator()(long m) const {
        float* r = x + (size_t)m * D; float s = 0.f;
        for (int k = 0; k < D; ++k) s += r[k] * r[k];
        const float rs = 1.0f / sqrtf(s / D + 1e-6f);
        for (int k = 0; k < D; ++k) r[k] = r[k] * rs * g[k];
    }
};


#ifndef CPU_SHIM
typedef short bf16x8 __attribute__((ext_vector_type(8)));
typedef float f32x4 __attribute__((ext_vector_type(4)));
typedef unsigned u32x4 __attribute__((ext_vector_type(4)));
typedef unsigned u32x2 __attribute__((ext_vector_type(2)));
#define DI __device__ __forceinline__
#define NTHREADS 256
__device__ __forceinline__ int opaque_tid() { int t = threadIdx.x; asm volatile("" : "+v"(t)); return t; }
#define TIDX (opaque_tid())

typedef __bf16 hbf16x2 __attribute__((ext_vector_type(2)));
typedef float f32x2 __attribute__((ext_vector_type(2)));
DI unsigned pack2bf(float lo, float hi) { f32x2 f = {lo, hi}; return __builtin_bit_cast(unsigned, __builtin_convertvector(f, hbf16x2)); }
DI float bflo(unsigned u) { return __uint_as_float(u << 16); }
DI float bfhi(unsigned u) { return __uint_as_float(u & 0xffff0000u); }

namespace fw {
constexpr size_t MB = 1024 * 1024;
constexpr size_t PARTS = 13 * MB;
constexpr size_t SMALLB = 1 * MB;
constexpr size_t WB = 14 * MB;
constexpr size_t XB = 30 * MB;
constexpr size_t BIG = 62 * MB;
}

DI void convert_tile(const float* __restrict__ W, int ldw, int c0, int K, bf16* __restrict__ Wt, const float* __restrict__ g, int kt, int nt, float* sm) {
    const int tid = TIDX;
    const int k0 = kt * 64, n0 = nt * 64;
#pragma unroll
    for (int i = 0; i < 4; ++i) {
        const int kr = (tid >> 4) + 16 * i; const int nc = (tid & 15) * 4;
        const float4 v = *(const float4*)(W + (size_t)(k0 + kr) * ldw + c0 + n0 + nc);
        const float s = g ? g[k0 + kr] : 1.0f;
        sm[kr * 65 + nc + 0] = v.x * s; sm[kr * 65 + nc + 1] = v.y * s; sm[kr * 65 + nc + 2] = v.z * s; sm[kr * 65 + nc + 3] = v.w * s;
    }
    __syncthreads();
    {
        const int n = tid >> 2, kq = (tid & 3) * 16;
        unsigned w[8];
#pragma unroll
        for (int j = 0; j < 8; ++j) w[j] = pack2bf(sm[(kq + 2 * j) * 65 + n], sm[(kq + 2 * j + 1) * 65 + n]);
        u32x4* dst = (u32x4*)(Wt + (size_t)(n0 + n) * K + k0 + kq);
        dst[0] = (u32x4){w[0], w[1], w[2], w[3]}; dst[1] = (u32x4){w[4], w[5], w[6], w[7]};
    }
    __syncthreads();
}
DI void convert_seg(const float* W, int ldw, int c0, int ncols, int K, bf16* Wt, const float* g, float* sm, int& tbase) {
    const int nkt = K / 64, nnt = ncols / 64, ntile = nkt * nnt;
    const int Gd = (int)gridDim.x;
    for (int t = (((int)blockIdx.x - tbase % Gd) + Gd) % Gd; t < ntile; t += Gd) convert_tile(W, ldw, c0, K, Wt, g, t % nkt, t / nkt, sm);
    tbase += ntile;
}

DI int perm32(int rho) { const int n = rho >> 4, i = rho & 15; return 8 * (i >> 2) + 4 * n + (i & 3); }

struct ALoadPlain {
    const bf16* A; int lda;
    static constexpr bool DMA = true;
    DI const bf16* src(int m, int k) const { return A + (size_t)m * lda + k; }
    struct Raw { u32x4 v; };
    DI Raw load(int m, int k) const { Raw r; r.v = *(const u32x4*)(A + (size_t)m * lda + k); return r; }
    DI u32x4 finish(const Raw& r, int, int) const { return r.v; }
};
struct ALoadLerp {
    const bf16* xn; const float* mu;
    static constexpr bool DMA = false;
    DI const bf16* src(int, int) const { return nullptr; }
    struct Raw { u32x4 c, p; };
    DI Raw load(int m, int k) const {
        Raw r; r.c = *(const u32x4*)(xn + (size_t)m * D + k);
        if ((m % T) != 0) r.p = *(const u32x4*)(xn + (size_t)(m - 1) * D + k); else r.p = (u32x4){0u, 0u, 0u, 0u};
        return r;
    }
    DI u32x4 finish(const Raw& r, int, int k) const {
        const float4 m0 = *(const float4*)(mu + k), m1 = *(const float4*)(mu + k + 4);
        const float mm[8] = {m0.x, m0.y, m0.z, m0.w, m1.x, m1.y, m1.z, m1.w};
        u32x4 o;
#pragma unroll
        for (int j = 0; j < 4; ++j) {
            const float c0 = bflo(r.c[j]), c1 = bfhi(r.c[j]), p0 = bflo(r.p[j]), p1 = bfhi(r.p[j]);
            o[j] = pack2bf(c0 + (p0 - c0) * mm[2 * j], c1 + (p1 - c1) * mm[2 * j + 1]);
        }
        return o;
    }
};

#define GLDS16(gp, lp) __builtin_amdgcn_global_load_lds((const unsigned*)(gp), (unsigned*)(lp), 16, 0, 0)
template <class AL, class Epi>
DI void gemm_tile(const AL& al, const bf16* __restrict__ Bt, int K, int m0, int n0, const Epi& epi, char* smem) {
    const int tid = TIDX, lane = tid & 63, wave = __builtin_amdgcn_readfirstlane(tid >> 6), wr = wave >> 1, wc = wave & 1, q = lane >> 4, l15 = lane & 15;
    const int srow = tid >> 3, sc = tid & 7, scs = sc ^ (srow & 7);
    const int st_off = srow * 128 + (sc << 4);
    const int dma_off = (8 * wave) * 128;
    int brow[4];
#pragma unroll
    for (int i = 0; i < 4; ++i) { const int rho = srow + 32 * i; brow[i] = n0 + (rho & ~31) + perm32(rho & 31); }
    const int fa0 = (wr * 64 + l15) * 128 + ((q ^ (lane & 7)) << 4);
    const int fb0 = (wc * 64 + l15) * 128 + ((q ^ (lane & 7)) << 4);
    f32x4 acc[4][4];
#pragma unroll
    for (int i = 0; i < 4; ++i)
#pragma unroll
        for (int j = 0; j < 4; ++j) acc[i][j] = (f32x4){0.f, 0.f, 0.f, 0.f};
    typename AL::Raw ra[4];
    const int nk = K / 64;
    {
        char* bufA = smem; char* bufB = smem + 16384;
#pragma unroll
        for (int i = 0; i < 4; ++i) {
            GLDS16(Bt + (size_t)brow[i] * K + scs * 8, bufB + dma_off + i * 4096);
            if (AL::DMA) GLDS16(al.src(m0 + srow + 32 * i, scs * 8), bufA + dma_off + i * 4096);
            else ra[i] = al.load(m0 + srow + 32 * i, scs * 8);
        }
        if (!AL::DMA) {
#pragma unroll
            for (int i = 0; i < 4; ++i) *(u32x4*)(bufA + st_off + i * 4096) = al.finish(ra[i], m0 + srow + 32 * i, scs * 8);
        }
    }
    asm volatile("s_waitcnt vmcnt(0)" ::: "memory");
    __syncthreads();
    for (int kt = 0; kt < nk; ++kt) {
        char* bufA = smem + (kt & 1) * 32768; char* bufB = bufA + 16384;
        char* nA = smem + ((kt + 1) & 1) * 32768; char* nB = nA + 16384;
        const bool more = kt + 1 < nk; const int kn = (kt + 1) * 64 + scs * 8;
        if (more) {
#pragma unroll
            for (int i = 0; i < 4; ++i) {
                GLDS16(Bt + (size_t)brow[i] * K + kn, nB + dma_off + i * 4096);
                if (AL::DMA) GLDS16(al.src(m0 + srow + 32 * i, kn), nA + dma_off + i * 4096);
                else ra[i] = al.load(m0 + srow + 32 * i, kn);
            }
        }
#pragma unroll
        for (int ks = 0; ks < 2; ++ks) {
            bf16x8 af[4], bfr[4];
#pragma unroll
            for (int i = 0; i < 4; ++i) {
                af[i] = *(const bf16x8*)(bufA + ((fa0 + i * 2048) ^ (ks << 6)));
                bfr[i] = *(const bf16x8*)(bufB + ((fb0 + i * 2048) ^ (ks << 6)));
            }
#pragma unroll
            for (int i = 0; i < 4; ++i)
#pragma unroll
                for (int j = 0; j < 4; ++j) acc[i][j] = __builtin_amdgcn_mfma_f32_16x16x32_bf16(bfr[j], af[i], acc[i][j], 0, 0, 0);
        }
        if (more && !AL::DMA) {
#pragma unroll
            for (int i = 0; i < 4; ++i) *(u32x4*)(nA + st_off + i * 4096) = al.finish(ra[i], m0 + srow + 32 * i, kn);
        }
        asm volatile("s_waitcnt vmcnt(0)" ::: "memory");
        __syncthreads();
    }
#pragma unroll
    for (int mt = 0; mt < 4; ++mt)
#pragma unroll
        for (int gi = 0; gi < 2; ++gi) {
            float v[8];
#pragma unroll
            for (int r = 0; r < 4; ++r) { v[r] = acc[mt][2 * gi][r]; v[4 + r] = acc[mt][2 * gi + 1][r]; }
            epi(m0 + wr * 64 + mt * 16 + l15, n0 + wc * 64 + gi * 32 + 8 * q, v, mt, gi);
        }
    epi.finish(m0, n0, wr, wc, lane);
}

constexpr int G2_STAGE = 24576;
template <class AL, class Epi>
DI void gemm_tile2(const AL& al, const bf16* __restrict__ Bt, int K, int m0, int n0, const Epi& epi, char* smem) {
    const int tid = TIDX, lane = tid & 63, wave = __builtin_amdgcn_readfirstlane(tid >> 6), wr = wave >> 1, wc = wave & 1, q = lane >> 4, l15 = lane & 15;
    const int prow = tid >> 2, ppos = tid & 3, ca = (ppos - 2 * ((tid >> 4) & 3)) & 3;
    const int dma_off = wave * 1024;
    int brow[4];
#pragma unroll
    for (int i = 0; i < 4; ++i) { const int rho = prow + 64 * i; brow[i] = n0 + (rho & ~31) + perm32(rho & 31); }
    const int fpos = ((q + 2 * ((l15 >> 2) & 3)) & 3) << 4;
    const int fa0 = (wr * 64 + l15) * 64 + fpos, fb0 = 8192 + (wc * 128 + l15) * 64 + fpos;
    f32x4 acc[4][8];
#pragma unroll
    for (int i = 0; i < 4; ++i)
#pragma unroll
        for (int j = 0; j < 8; ++j) acc[i][j] = (f32x4){0.f, 0.f, 0.f, 0.f};
    typename AL::Raw ra[2];
    const int nk = K / 32;
#define G2_ISSUE(kt_) { char* st_ = smem + ((kt_) % 3) * G2_STAGE; const int kk_ = (kt_) * 32 + ca * 8; \
        _Pragma("unroll") for (int i = 0; i < 2; ++i) { if (AL::DMA) GLDS16(al.src(m0 + prow + 64 * i, kk_), st_ + dma_off + i * 4096); else ra[i] = al.load(m0 + prow + 64 * i, kk_); } \
        _Pragma("unroll") for (int i = 0; i < 4; ++i) GLDS16(Bt + (size_t)brow[i] * K + kk_, st_ + 8192 + dma_off + i * 4096); }
#define G2_AWRITE(kt_) { if (!AL::DMA) { char* st_ = smem + ((kt_) % 3) * G2_STAGE; const int kk_ = (kt_) * 32 + ca * 8; \
        _Pragma("unroll") for (int i = 0; i < 2; ++i) *(u32x4*)(st_ + (prow + 64 * i) * 64 + ppos * 16) = al.finish(ra[i], m0 + prow + 64 * i, kk_); } }
#define G2_BARRIER() { asm volatile("s_waitcnt lgkmcnt(0)" ::: "memory"); __builtin_amdgcn_s_barrier(); asm volatile("" ::: "memory"); }
    G2_ISSUE(0); G2_AWRITE(0);
    if (nk > 1) { G2_ISSUE(1); G2_AWRITE(1); }
    if (nk > 1) { if (AL::DMA) asm volatile("s_waitcnt vmcnt(6)" ::: "memory"); else asm volatile("s_waitcnt vmcnt(4)" ::: "memory"); } else asm volatile("s_waitcnt vmcnt(0)" ::: "memory");
    G2_BARRIER();
    for (int kt = 0; kt < nk; ++kt) {
        const char* st = smem + (kt % 3) * G2_STAGE;
        const bool more = kt + 2 < nk;
        if (more) G2_ISSUE(kt + 2);
        bf16x8 af[4];
#pragma unroll
        for (int i = 0; i < 4; ++i) af[i] = *(const bf16x8*)(st + fa0 + i * 1024);
#pragma unroll
        for (int j = 0; j < 8; ++j) {
            const bf16x8 bf_ = *(const bf16x8*)(st + fb0 + j * 1024);
#pragma unroll
            for (int i = 0; i < 4; ++i) acc[i][j] = __builtin_amdgcn_mfma_f32_16x16x32_bf16(bf_, af[i], acc[i][j], 0, 0, 0);
        }
        if (more) G2_AWRITE(kt + 2);
        if (more) { if (AL::DMA) asm volatile("s_waitcnt vmcnt(6)" ::: "memory"); else asm volatile("s_waitcnt vmcnt(4)" ::: "memory"); } else asm volatile("s_waitcnt vmcnt(0)" ::: "memory");
        G2_BARRIER();
    }
#undef G2_ISSUE
#undef G2_AWRITE
#undef G2_BARRIER
#pragma unroll
    for (int mt = 0; mt < 4; ++mt)
#pragma unroll
        for (int gi = 0; gi < 4; ++gi) {
            float v[8];
#pragma unroll
            for (int r = 0; r < 4; ++r) { v[r] = acc[mt][2 * gi][r]; v[4 + r] = acc[mt][2 * gi + 1][r]; }
            epi(m0 + wr * 64 + mt * 16 + l15, n0 + wc * 128 + gi * 32 + 8 * q, v, mt, gi);
        }
    epi.finish_wide(m0, n0, wr, wc, lane);
}
template <class F>
DI void gemm_sched(int nbig, int nsmall, F&& f) {
    const int x = blockIdx.x & 7, lb = blockIdx.x >> 3, nlb = gridDim.x >> 3;
    const int nb16 = 16 * nbig, tot = 16 * (nbig + nsmall);
    for (int s = lb; s < tot; s += nlb) {
        if (s < nb16) f(true, x * 16 + (s & 15), s >> 4);
        else { const int t = s - nb16; f(false, x * 16 + (t & 15), t >> 4); }
    }
}

DI float rstd_from_parts(const float* parts, int m) {
    const float4* p = (const float4*)(parts + (size_t)m * 16); float s = 0.f;
#pragma unroll
    for (int i = 0; i < 4; ++i) { const float4 v = p[i]; s += (v.x + v.y) + (v.z + v.w); }
    return 1.0f / sqrtf(s * (1.0f / D) + 1e-6f);
}
DI void store8bf(bf16* p, const float* v) { *(u32x4*)p = (u32x4){pack2bf(v[0], v[1]), pack2bf(v[2], v[3]), pack2bf(v[4], v[5]), pack2bf(v[6], v[7])}; }

struct EpiBf16 {
    bf16* P; int ldp; const float* parts; mutable float rsc[4];
    DI void operator()(int m, int n, const float* v, int mt, int gi) const {
        if (gi == 0) rsc[mt] = parts ? rstd_from_parts(parts, m) : 1.0f;
        float s = rsc[mt]; float w[8];
#pragma unroll
        for (int j = 0; j < 8; ++j) w[j] = v[j] * s;
        store8bf(P + (size_t)m * ldp + n, w);
    }
    DI void finish(int, int, int, int, int) const {}
    DI void finish_wide(int, int, int, int, int) const {}
};
struct EpiResid {
    const float* xin; float* xout; bf16* xb; float* parts; mutable float sq[4];
    DI void operator()(int m, int n, const float* v, int mt, int gi) const {
        const float4* xi = (const float4*)(xin + (size_t)m * D + n); const float4 a = xi[0], b = xi[1];
        float w[8] = {a.x + v[0], a.y + v[1], a.z + v[2], a.w + v[3], b.x + v[4], b.y + v[5], b.z + v[6], b.w + v[7]};
        float4* xo = (float4*)(xout + (size_t)m * D + n);
        xo[0] = make_float4(w[0], w[1], w[2], w[3]); xo[1] = make_float4(w[4], w[5], w[6], w[7]);
        if (xb) store8bf(xb + (size_t)m * D + n, w);
        float s = 0.f;
#pragma unroll
        for (int j = 0; j < 8; ++j) s += w[j] * w[j];
        if (gi == 0) sq[mt] = s; else sq[mt] += s;
    }
    DI void finish(int m0, int n0, int wr, int wc, int lane) const {
#pragma unroll
        for (int mt = 0; mt < 4; ++mt) {
            float s = sq[mt]; s += __shfl_xor(s, 16); s += __shfl_xor(s, 32);
            if (lane < 16) parts[(size_t)(m0 + wr * 64 + mt * 16 + lane) * 16 + (n0 >> 7) * 2 + wc] = s;
        }
    }
    DI void finish_wide(int m0, int n0, int wr, int wc, int lane) const {
#pragma unroll
        for (int mt = 0; mt < 4; ++mt) {
            float s = sq[mt]; s += __shfl_xor(s, 16); s += __shfl_xor(s, 32);
            if (lane < 16) { float* pr = parts + (size_t)(m0 + wr * 64 + mt * 16 + lane) * 16 + (n0 >> 7) + wc; pr[0] = s; pr[8] = 0.f; }
        }
    }
};
struct EpiRwkv {
    bf16* P; float* hw; float* ha;
    DI void operator()(int m, int n, const float* v, int, int) const {
        if (n < 4096) { store8bf(P + (size_t)m * 4096 + n, v); return; }
        const int c = n - 4096;
        if (c < 64) { float4* o = (float4*)(hw + (size_t)m * 64 + c); o[0] = make_float4(tanhf(v[0]), tanhf(v[1]), tanhf(v[2]), tanhf(v[3])); o[1] = make_float4(tanhf(v[4]), tanhf(v[5]), tanhf(v[6]), tanhf(v[7])); }
        else if (c >= 128 && c < 192) { float4* o = (float4*)(ha + (size_t)m * 64 + (c - 128)); o[0] = make_float4(v[0], v[1], v[2], v[3]); o[1] = make_float4(v[4], v[5], v[6], v[7]); }
    }
    DI void finish(int, int, int, int, int) const {}
    DI void finish_wide(int, int, int, int, int) const {}
};

namespace at {
constexpr int OFF_BIAS = 49152;
constexpr int OFF_X = 61952;
constexpr int OFF_IMP = 49152;
constexpr float L2E = 1.4426950408889634f;
constexpr float NEG_MASK = -1e30f, M_INIT = -1e20f;
}
enum { AM_SWA = 0, AM_WIN = 1, AM_CMP = 2, AM_SEL = 3 };
DI int vt_perm(int k32) { return ((k32 & 15) >> 2) * 8 + (k32 >> 4) * 4 + (k32 & 3); }
DI float fast_exp2(float x) { return __builtin_amdgcn_exp2f(x); }

DI void build_bias_lut(const float* __restrict__ t5, char* smem, bool swa) {
    float* lut = (float*)(smem + at::OFF_BIAS);
    for (int i = TIDX; i < 16 * 200; i += NTHREADS) {
        const int h = i / 200, e = i % 200; float v = at::NEG_MASK;
        if (e >= 64 && e < 192) v = t5[t5_bucket(e - 64) * 16 + h] * at::L2E;
        else if (e >= 192 && !swa) v = t5[31 * 16 + h] * at::L2E;
        lut[i] = v;
    }
    __syncthreads();
}

template <int NQT> struct AttnStateT { f32x4 o[NQT][4]; f32x4 lacc[NQT]; float m[NQT]; };
#ifndef ANQT_SWA
#define ANQT_SWA 4
#endif
#ifndef ANQT_WIN
#define ANQT_WIN 2
#endif
#ifndef ANQT_SEL
#define ANQT_SEL 4
#endif
DI unsigned long long range_mask(int lo, int hi) { return (hi >= 63 ? ~0ull : ((1ull << (hi + 1)) - 1ull)) & ~((1ull << lo) - 1ull); }

template <int NQT>
DI void attn_load_q(bf16x8 (&qf)[NQT][2], const bf16* __restrict__ Qp, int ldq, size_t mbase, int hbase) {
    const int lane = TIDX & 63, wave = TIDX >> 6, q = lane >> 4, l15 = lane & 15;
#pragma unroll
    for (int qt = 0; qt < NQT; ++qt) {
        const size_t m = mbase + wave * (4 * NQT) + qt * 4 + (l15 >> 2);
#pragma unroll
        for (int ks = 0; ks < 2; ++ks) qf[qt][ks] = *(const bf16x8*)(Qp + m * ldq + (hbase + (l15 & 3)) * 64 + ks * 32 + q * 8);
    }
}

enum { SK_FAR = 0, SK_NEAR = 1, SK_EDGE = 2, SK_CMP = 3 };
template <int KIND>
DI float attn_fix(f32x4 (&s)[4], int dbase, float cadd, const float* __restrict__ bl, float mx) {
#pragma unroll
    for (int kt = 0; kt < 4; ++kt)
#pragma unroll
        for (int r = 0; r < 4; ++r) {
            float v = s[kt][r]; const int dist = dbase - (kt * 16 + r);
            if (KIND == SK_NEAR) { int idx = dist + 64; idx = idx < 0 ? 0 : (idx > 192 ? 192 : idx); v += bl[idx] + cadd; }
            else if (KIND == SK_EDGE) v = dist < 512 ? v + cadd : at::NEG_MASK;
            else if (KIND == SK_CMP) v = dist >= 0 ? v : at::NEG_MASK;
            if (KIND != SK_FAR) s[kt][r] = v;
            mx = fmaxf(mx, v);
        }
    return mx;
}
template <int MODE, int NQT>
DI void attn_blocks(AttnStateT<NQT>& st, const bf16x8 (&qf)[NQT][2], const bf16* __restrict__ Kp, size_t krs, const bf16* __restrict__ Vp, size_t vrs,
                    int t0, unsigned long long todo, int hbase, const unsigned long long (&sel)[NQT], char* smem) {
    const int tid = TIDX, lane = tid & 63, wave = __builtin_amdgcn_readfirstlane(tid >> 6), q = lane >> 4, l15 = lane & 15;
    const int tq0 = t0 + wave * (4 * NQT) + (l15 >> 2);
    const float* bl = (const float*)(smem + at::OFF_BIAS) + (hbase + (l15 & 3)) * 200;
    const float bfar = (MODE != AM_CMP) ? bl[192] : 0.f;
    const int srow = tid >> 3, scs = (tid & 7) ^ (srow & 7);
    const int fo = l15 * 128 + ((q ^ (l15 & 7)) << 4);
#define ATT_DMA(kb_, slot_) { _Pragma("unroll") for (int i = 0; i < 2; ++i) { const int row = srow + 32 * i; char* dst = smem + (slot_) * 16384 + (8 * wave + 32 * i) * 128; \
        GLDS16(Kp + (size_t)((kb_) * 64 + row) * krs + scs * 8, dst); GLDS16(Vp + (size_t)row * vrs + (kb_) * 64 + scs * 8, dst + 8192); } }
#define ATT_BARRIER() { asm volatile("s_waitcnt lgkmcnt(0)" ::: "memory"); __builtin_amdgcn_s_barrier(); asm volatile("" ::: "memory"); }
    if (todo == 0ull) return;
    int kb = __builtin_ctzll(todo); todo &= todo - 1ull;
    int kb1 = -1; if (todo) { kb1 = __builtin_ctzll(todo); todo &= todo - 1ull; }
    ATT_DMA(kb, 0);
    if (kb1 >= 0) { ATT_DMA(kb1, 1); asm volatile("s_waitcnt vmcnt(4)" ::: "memory"); } else { asm volatile("s_waitcnt vmcnt(0)" ::: "memory"); }
    ATT_BARRIER();
    int slot = 0;
    for (;;) {
        char* buf = smem + slot * 16384;
        int kb2 = -1; if (todo) { kb2 = __builtin_ctzll(todo); todo &= todo - 1ull; }
        if (kb2 >= 0) { const int s2 = slot >= 1 ? slot - 1 : 2; ATT_DMA(kb2, s2); }
        f32x4 s[NQT][4];
#pragma unroll
        for (int qt = 0; qt < NQT; ++qt)
#pragma unroll
            for (int kt = 0; kt < 4; ++kt) s[qt][kt] = (f32x4){0.f, 0.f, 0.f, 0.f};
#pragma unroll
        for (int kt = 0; kt < 4; ++kt)
#pragma unroll
            for (int ks = 0; ks < 2; ++ks) {
                const bf16x8 kf = *(const bf16x8*)(buf + ((fo + kt * 2048) ^ (ks << 6)));
#pragma unroll
                for (int qt = 0; qt < NQT; ++qt) s[qt][kt] = __builtin_amdgcn_mfma_f32_16x16x32_bf16(kf, qf[qt][ks], s[qt][kt], 0, 0, 0);
            }
        const int mind = (t0 + wave * (4 * NQT)) - (kb * 64 + 63), maxd = (t0 + wave * (4 * NQT) + 4 * NQT - 1) - kb * 64;
        float mx[NQT], cofs[NQT];
#pragma unroll
        for (int qt = 0; qt < NQT; ++qt) cofs[qt] = 0.f;
        if (MODE == AM_CMP) {
#pragma unroll
            for (int qt = 0; qt < NQT; ++qt) { const int nlim = (tq0 + 4 * qt - 31) >> 4; mx[qt] = attn_fix<SK_CMP>(s[qt], nlim - (kb * 64 + 4 * q), 0.f, bl, at::NEG_MASK); }
        } else {
            float cadd[NQT];
#pragma unroll
            for (int qt = 0; qt < NQT; ++qt) cadd[qt] = (MODE == AM_SEL && !((sel[qt] >> kb) & 1ull)) ? at::NEG_MASK : 0.f;
            if (MODE == AM_SWA || mind < 113) {
#pragma unroll
                for (int qt = 0; qt < NQT; ++qt) mx[qt] = attn_fix<SK_NEAR>(s[qt], tq0 + 4 * qt - (kb * 64 + 4 * q), cadd[qt], bl, at::NEG_MASK);
            } else if (MODE == AM_WIN && maxd >= 512) {
#pragma unroll
                for (int qt = 0; qt < NQT; ++qt) mx[qt] = attn_fix<SK_EDGE>(s[qt], tq0 + 4 * qt - (kb * 64 + 4 * q), bfar, bl, at::NEG_MASK);
            } else {
#pragma unroll
                for (int qt = 0; qt < NQT; ++qt) { cofs[qt] = bfar + cadd[qt]; mx[qt] = attn_fix<SK_FAR>(s[qt], 0, 0.f, bl, at::NEG_MASK) + cofs[qt]; }
            }
        }
        float msub[NQT]; bool grow = false;
#pragma unroll
        for (int qt = 0; qt < NQT; ++qt) {
            float m2 = mx[qt];
            m2 = fmaxf(m2, __shfl_xor(m2, 16)); m2 = fmaxf(m2, __shfl_xor(m2, 32));
            const bool g = m2 > st.m[qt] + 4.0f; grow |= g;
            mx[qt] = g ? m2 : st.m[qt];
            msub[qt] = mx[qt] - cofs[qt];
        }
        if (__any(grow)) {
#pragma unroll
            for (int qt = 0; qt < NQT; ++qt) {
                const float alpha = fast_exp2(st.m[qt] - mx[qt]);
#pragma unroll
                for (int dt = 0; dt < 4; ++dt) st.o[qt][dt] *= alpha;
                st.lacc[qt] *= alpha;
            }
        }
#pragma unroll
        for (int qt = 0; qt < NQT; ++qt) st.m[qt] = mx[qt];
#pragma unroll
        for (int qt = 0; qt < NQT; ++qt)
#pragma unroll
            for (int kt = 0; kt < 4; ++kt)
#pragma unroll
                for (int r = 0; r < 4; ++r) s[qt][kt][r] = fast_exp2(s[qt][kt][r] - msub[qt]);
        const bf16x8 ones = {(short)0x3F80, (short)0x3F80, (short)0x3F80, (short)0x3F80, (short)0x3F80, (short)0x3F80, (short)0x3F80, (short)0x3F80};
#pragma unroll
        for (int kp = 0; kp < 2; ++kp) {
            bf16x8 pf[NQT];
#pragma unroll
            for (int qt = 0; qt < NQT; ++qt) {
                const u32x4 w = {pack2bf(s[qt][2 * kp][0], s[qt][2 * kp][1]), pack2bf(s[qt][2 * kp][2], s[qt][2 * kp][3]),
                                 pack2bf(s[qt][2 * kp + 1][0], s[qt][2 * kp + 1][1]), pack2bf(s[qt][2 * kp + 1][2], s[qt][2 * kp + 1][3])};
                pf[qt] = __builtin_bit_cast(bf16x8, w);
            }
#pragma unroll
            for (int qt = 0; qt < NQT; ++qt) st.lacc[qt] = __builtin_amdgcn_mfma_f32_16x16x32_bf16(ones, pf[qt], st.lacc[qt], 0, 0, 0);
#pragma unroll
            for (int dt = 0; dt < 4; ++dt) {
                const bf16x8 vf = *(const bf16x8*)(buf + 8192 + ((fo + dt * 2048) ^ (kp << 6)));
#pragma unroll
                for (int qt = 0; qt < NQT; ++qt) st.o[qt][dt] = __builtin_amdgcn_mfma_f32_16x16x32_bf16(vf, pf[qt], st.o[qt][dt], 0, 0, 0);
            }
        }
        if (kb1 < 0) break;
        if (kb2 >= 0) { asm volatile("s_waitcnt vmcnt(4)" ::: "memory"); } else { asm volatile("s_waitcnt vmcnt(0)" ::: "memory"); }
        ATT_BARRIER();
        kb = kb1; kb1 = kb2; slot = slot == 2 ? 0 : slot + 1;
    }
    ATT_BARRIER();
#undef ATT_DMA
}
template <int NQT>
DI void attn_init(AttnStateT<NQT>& st, float m0, float l0) {
#pragma unroll
    for (int qt = 0; qt < NQT; ++qt) { st.m[qt] = m0; st.lacc[qt] = (f32x4){l0, l0, l0, l0};
#pragma unroll
        for (int dt = 0; dt < 4; ++dt) st.o[qt][dt] = (f32x4){0.f, 0.f, 0.f, 0.f}; }
}
DI float attn_linv(const f32x4& lacc) { const float l = lacc[0]; return l > 0.f ? 1.0f / l : 0.f; }

template <int TT>
DI void attn_item_decode(int item, int& b, int& g, int& t0) {
    constexpr int tiles = T / TT;
    const int Gd = (int)gridDim.x;
    int pair, tile;
    if ((Gd % tiles) == 0 && tiles * B * G % Gd == 0) {
        const int bid = item % Gd, rr = item / Gd, tau = bid % tiles;
        pair = bid / tiles + (Gd / tiles) * rr; tile = (rr & 1) ? tiles - 1 - tau : tau;
    } else { tile = item % tiles; pair = item / tiles; }
    t0 = tile * TT; g = pair % G; b = pair / G;
}
DI void swa_item(const bf16* __restrict__ P0, const bf16* __restrict__ VT, const float* __restrict__ sinks, bf16* __restrict__ AO, int item, char* smem) {
    constexpr int LDP = 2304;
    constexpr int NQT = ANQT_SWA;
    int b, g, t0; attn_item_decode<16 * NQT>(item, b, g, t0);
    const int lane = TIDX & 63, wave = TIDX >> 6, q = lane >> 4, l15 = lane & 15;
    const size_t mbase = (size_t)b * T + t0; const int hbase = g * 4, h = hbase + (l15 & 3);
    bf16x8 qf[NQT][2]; attn_load_q<NQT>(qf, P0, LDP, mbase, hbase);
    AttnStateT<NQT> st; attn_init<NQT>(st, sinks[h] * at::L2E, 1.0f);
    const int lo = t0 - 127 < 0 ? 0 : (t0 - 127) >> 6, hi = (t0 + 16 * NQT - 1) >> 6;
    const unsigned long long nosel[NQT] = {};
    attn_blocks<AM_SWA, NQT>(st, qf, P0 + (size_t)b * T * LDP + 1024 + g * 64, LDP, VT + (size_t)(b * G + g) * 64 * T, T, t0, range_mask(lo, hi), hbase, nosel, smem);
#pragma unroll
    for (int qt = 0; qt < NQT; ++qt) {
        const float li = attn_linv(st.lacc[qt]); const size_t m = mbase + wave * (4 * NQT) + qt * 4 + (l15 >> 2);
#pragma unroll
        for (int dt = 0; dt < 4; ++dt) {
            const int d0 = dt * 16 + 4 * q; const u32x2 zz = *(const u32x2*)(P0 + m * LDP + 1280 + h * 64 + d0);
            const float z0 = bflo(zz[0]), z1 = bfhi(zz[0]), z2 = bflo(zz[1]), z3 = bfhi(zz[1]);
            const f32x4 o = st.o[qt][dt];
            *(u32x2*)(AO + m * D + h * 64 + d0) = (u32x2){pack2bf(o[0] * li * siluf_(z0), o[1] * li * siluf_(z1)), pack2bf(o[2] * li * siluf_(z2), o[3] * li * siluf_(z3))};
        }
    }
}

struct EpiL0 {
    bf16* P0; bf16* VT; const float* parts; mutable float rsc[4];
    DI void operator()(int m, int n, const float* v, int mt, int gi) const {
        if (gi == 0) rsc[mt] = rstd_from_parts(parts, m);
        float s = rsc[mt]; if (n < 1024) s *= 0.125f * at::L2E; float w[8];
#pragma unroll
        for (int j = 0; j < 8; ++j) w[j] = v[j] * s;
        if (n < 1280) store8bf(P0 + (size_t)m * 2304 + n, w);
        else if (n >= 1536) store8bf(P0 + (size_t)m * 2304 + n - 256, w);
        else {
            const int g = (n - 1280) >> 6, d = (n - 1280) & 63, b = m / T, t = m % T; const int pos = (t & ~31) + vt_perm(t & 31);
            bf16* dst = VT + ((size_t)(b * G + g) * 64 + d) * T + pos;
#pragma unroll
            for (int j = 0; j < 8; ++j) dst[(size_t)j * T] = f2bf(w[j]);
        }
    }
    DI void finish(int, int, int, int, int) const {}
    DI void finish_wide(int, int, int, int, int) const {}
};

constexpr int LDP2 = 3200;
struct EpiL2 {
    bf16* P2; bf16* VTs; bf16* VTw; const float* parts; mutable float rsc[4];
    DI void operator()(int m, int n, const float* v, int mt, int gi) const {
        if (gi == 0) rsc[mt] = rstd_from_parts(parts, m);
        if (n >= C_COLS) return;
        float s = rsc[mt]; if (n < 1024) s *= 0.125f * at::L2E; float w[8];
#pragma unroll
        for (int j = 0; j < 8; ++j) w[j] = v[j] * s;
        const bool isvs = n >= 1792 && n < 2048, isvw = n >= 2304 && n < 2560;
        if (isvs || isvw) {
            const int c = n - (isvs ? 1792 : 2304); const int g = c >> 6, d = c & 63, b = m / T, t = m % T; const int pos = (t & ~31) + vt_perm(t & 31);
            bf16* dst = (isvs ? VTs : VTw) + ((size_t)(b * G + g) * 64 + d) * T + pos;
#pragma unroll
            for (int j = 0; j < 8; ++j) dst[(size_t)j * T] = f2bf(w[j]);
        } else {
            const int c = n < 1792 ? n : (n < 2304 ? n - 256 : n - 512);
            store8bf(P2 + (size_t)m * LDP2 + c, w);
        }
    }
    DI void finish(int, int, int, int, int) const {}
    DI void finish_wide(int, int, int, int, int) const {}
};

struct ALoadCmp {
    const bf16* P2; int col;
    static constexpr bool DMA = true;
    DI const bf16* src(int row, int k) const {
        int n = row & 255; const int bg = row >> 8, b = bg >> 2, g = bg & 3; const int l = k >> 6, d = k & 63; n = n < NCMP ? n : NCMP - 1;
        return P2 + (size_t)(b * T + 16 * n + l) * LDP2 + col + g * 64 + d;
    }
    struct Raw { u32x4 v; };
    DI Raw load(int row, int k) const {
        const int n = row & 255, bg = row >> 8, b = bg >> 2, g = bg & 3; const int l = k >> 6, d = k & 63; Raw r;
        if (n < NCMP) r.v = *(const u32x4*)(P2 + (size_t)(b * T + 16 * n + l) * LDP2 + col + g * 64 + d); else r.v = (u32x4){0u, 0u, 0u, 0u};
        return r;
    }
    DI u32x4 finish(const Raw& r, int, int) const { return r.v; }
};
struct EpiCmpH {
    char* smem; const float* bias8;
    DI void operator()(int m, int n, const float* v, int, int) const {
        const int row = m & 127; float w[8];
#pragma unroll
        for (int j = 0; j < 8; ++j) { float bsum = 0.f;
#pragma unroll
            for (int i = 0; i < 8; ++i) bsum += bias8[i * 128 + n + j];
            w[j] = siluf_(v[j] + bsum); }
        const int kk = n >> 6, c = (n & 63) >> 3;
        *(u32x4*)(smem + kk * 16384 + row * 128 + ((c ^ (row & 7)) << 4)) = (u32x4){pack2bf(w[0], w[1]), pack2bf(w[2], w[3]), pack2bf(w[4], w[5]), pack2bf(w[6], w[7])};
    }
    DI void finish(int, int, int, int, int) const {}
    DI void finish_wide(int, int, int, int, int) const {}
};
DI void cmp_tile(const bf16* __restrict__ P2, const bf16* __restrict__ w1t, const float* __restrict__ bias8, const bf16* __restrict__ w2t, int which, int rt,
                 bf16* __restrict__ KCb, bf16* __restrict__ VCT, char* smem) {
    gemm_tile(ALoadCmp{P2, which ? 1280 : 1024}, w1t, 2048, rt * 128, 0, EpiCmpH{smem, bias8}, smem);
    const int tid = TIDX, lane = tid & 63, wave = tid >> 6, q = lane >> 4, l15 = lane & 15;
#pragma unroll
    for (int i = 0; i < 4; ++i) {
        const int id = i * 256 + tid; const int row = id >> 4, c16 = id & 15, kk = c16 >> 3, c = c16 & 7;
        *(u32x4*)(smem + 32768 + kk * 8192 + row * 128 + ((c ^ (row & 7)) << 4)) = *(const u32x4*)(w2t + (size_t)row * 128 + c16 * 8);
    }
    __syncthreads();
    f32x4 acc[2][4];
#pragma unroll
    for (int i = 0; i < 2; ++i)
#pragma unroll
        for (int j = 0; j < 4; ++j) acc[i][j] = (f32x4){0.f, 0.f, 0.f, 0.f};
    const int fo = l15 * 128 + ((q ^ (l15 & 7)) << 4);
#pragma unroll
    for (int kk = 0; kk < 2; ++kk)
#pragma unroll
        for (int ks = 0; ks < 2; ++ks) {
            bf16x8 hf[2], wf[4];
#pragma unroll
            for (int i = 0; i < 2; ++i) hf[i] = *(const bf16x8*)(smem + kk * 16384 + (((wave * 32 + i * 16) * 128 + fo) ^ (ks << 6)));
#pragma unroll
            for (int j = 0; j < 4; ++j) wf[j] = *(const bf16x8*)(smem + 32768 + kk * 8192 + ((j * 2048 + fo) ^ (ks << 6)));
#pragma unroll
            for (int i = 0; i < 2; ++i)
#pragma unroll
                for (int j = 0; j < 4; ++j) acc[i][j] = __builtin_amdgcn_mfma_f32_16x16x32_bf16(wf[j], hf[i], acc[i][j], 0, 0, 0);
        }
#pragma unroll
    for (int i = 0; i < 2; ++i) {
        const int row = rt * 128 + wave * 32 + i * 16 + l15; const int n = row & 255, bg = row >> 8;
#pragma unroll
        for (int j = 0; j < 4; ++j) {
            const int d0 = j * 16 + 4 * q; const f32x4 a = acc[i][j];
            if (which == 0) *(u32x2*)(KCb + (size_t)row * 64 + d0) = (u32x2){pack2bf(a[0], a[1]), pack2bf(a[2], a[3])};
            else {
                const int pos = (n & ~31) + vt_perm(n & 31);
#pragma unroll
                for (int r = 0; r < 4; ++r) VCT[((size_t)bg * 64 + d0 + r) * 256 + pos] = f2bf(a[r]);
            }
        }
    }
    __syncthreads();
}

DI void win_item(const bf16* __restrict__ P2, const bf16* __restrict__ VTw, bf16* __restrict__ OW, int item, char* smem) {
    constexpr int NQT = ANQT_WIN;
    int b, g, t0; attn_item_decode<16 * NQT>(item, b, g, t0);
    const int lane = TIDX & 63, wave = TIDX >> 6, q = lane >> 4, l15 = lane & 15;
    const size_t mbase = (size_t)b * T + t0; const int hbase = g * 4, h = hbase + (l15 & 3);
    bf16x8 qf[NQT][2]; attn_load_q<NQT>(qf, P2, LDP2, mbase, hbase);
    AttnStateT<NQT> st; attn_init<NQT>(st, at::M_INIT, 0.f);
    const int lo = t0 - 511 < 0 ? 0 : (t0 - 511) >> 6, hi = (t0 + 16 * NQT - 1) >> 6;
    const unsigned long long nosel[NQT] = {};
    attn_blocks<AM_WIN, NQT>(st, qf, P2 + (size_t)b * T * LDP2 + 1792 + g * 64, LDP2, VTw + (size_t)(b * G + g) * 64 * T, T, t0, range_mask(lo, hi), hbase, nosel, smem);
#pragma unroll
    for (int qt = 0; qt < NQT; ++qt) {
        const float li = attn_linv(st.lacc[qt]); const size_t m = mbase + wave * (4 * NQT) + qt * 4 + (l15 >> 2);
#pragma unroll
        for (int dt = 0; dt < 4; ++dt) { const f32x4 o = st.o[qt][dt]; *(u32x2*)(OW + m * D + h * 64 + dt * 16 + 4 * q) = (u32x2){pack2bf(o[0] * li, o[1] * li), pack2bf(o[2] * li, o[3] * li)}; }
    }
}

DI void cmpsel_item(const bf16* __restrict__ P2, const bf16* __restrict__ KCb, const bf16* __restrict__ VCT, bf16* __restrict__ OC, unsigned long long* __restrict__ SELM, int item, char* smem) {
    int b, g, t0; attn_item_decode<32>(item, b, g, t0);
    const int tid = TIDX, lane = tid & 63, wave = tid >> 6, q = lane >> 4, l15 = lane & 15;
    const size_t mbase = (size_t)b * T + t0; const int hbase = g * 4, h = hbase + (l15 & 3);
    float* impL = (float*)(smem + at::OFF_IMP);
    for (int i = tid; i < 32 * 64; i += NTHREADS) impL[i] = 0.f;
    bf16x8 qf[2][2]; attn_load_q<2>(qf, P2, LDP2, mbase, hbase);
    AttnStateT<2> st; attn_init<2>(st, at::M_INIT, 0.f);
    const int nvmax = (t0 + 31 - 31) / 16 + 1;
    const int hi = (nvmax - 1) >> 6;
    const bf16* Kp = KCb + (size_t)(b * G + g) * 256 * 64; const bf16* Vp = VCT + (size_t)(b * G + g) * 64 * 256;
    const unsigned long long nosel[2] = {0ull, 0ull};
    attn_blocks<AM_CMP, 2>(st, qf, Kp, 64, Vp, 256, t0, range_mask(0, hi), hbase, nosel, smem);
    float linv[2];
#pragma unroll
    for (int qt = 0; qt < 2; ++qt) {
        linv[qt] = attn_linv(st.lacc[qt]); const size_t m = mbase + wave * 8 + qt * 4 + (l15 >> 2);
#pragma unroll
        for (int dt = 0; dt < 4; ++dt) { const f32x4 o = st.o[qt][dt]; *(u32x2*)(OC + m * D + h * 64 + dt * 16 + 4 * q) = (u32x2){pack2bf(o[0] * linv[qt], o[1] * linv[qt]), pack2bf(o[2] * linv[qt], o[3] * linv[qt])}; }
    }
    {
        const int tq0 = t0 + wave * 8 + (l15 >> 2);
        const bf16* kp0 = Kp + (size_t)l15 * 64 + q * 8;
        bf16x8 kfA[4][2], kfB[4][2];
#define CS_LOADK(dst_, kb_) { _Pragma("unroll") for (int kt = 0; kt < 4; ++kt) _Pragma("unroll") for (int ks = 0; ks < 2; ++ks) \
            dst_[kt][ks] = *(const bf16x8*)(kp0 + (size_t)((kb_) * 64 + kt * 16) * 64 + ks * 32); }
#define CS_QSUM(x_) { x_ += __builtin_bit_cast(float, __builtin_amdgcn_update_dpp(0, __builtin_bit_cast(int, x_), 0xB1, 0xf, 0xf, false)); \
                      x_ += __builtin_bit_cast(float, __builtin_amdgcn_update_dpp(0, __builtin_bit_cast(int, x_), 0x4E, 0xf, 0xf, false)); }
#define CS_BLOCK(kf_, kb_) { const int kbi = (kb_); \
            f32x4 s[2][4]; \
            _Pragma("unroll") for (int qt = 0; qt < 2; ++qt) _Pragma("unroll") for (int kt = 0; kt < 4; ++kt) s[qt][kt] = (f32x4){0.f, 0.f, 0.f, 0.f}; \
            _Pragma("unroll") for (int kt = 0; kt < 4; ++kt) _Pragma("unroll") for (int ks = 0; ks < 2; ++ks) { \
                s[0][kt] = __builtin_amdgcn_mfma_f32_16x16x32_bf16(kf_[kt][ks], qf[0][ks], s[0][kt], 0, 0, 0); \
                s[1][kt] = __builtin_amdgcn_mfma_f32_16x16x32_bf16(kf_[kt][ks], qf[1][ks], s[1][kt], 0, 0, 0); } \
            const bool allvis = 16 * (kbi * 64 + 63) + 31 <= t0;         \
            _Pragma("unroll") for (int qt = 0; qt < 2; ++qt) { \
                const int tq = tq0 + 4 * qt; const int tl = wave * 8 + qt * 4 + (l15 >> 2); \
                _Pragma("unroll") for (int kt = 0; kt < 4; ++kt) { \
                    float pr[4]; \
                    _Pragma("unroll") for (int r = 0; r < 4; ++r) { const int key = kbi * 64 + kt * 16 + 4 * q + r; \
                        const float e = fast_exp2(s[qt][kt][r] - st.m[qt]) * linv[qt]; pr[r] = (allvis || 16 * key + 31 <= tq) ? e : 0.f; } \
                    float s4 = (pr[0] + pr[1]) + (pr[2] + pr[3]), s1 = pr[3]; \
                    CS_QSUM(s4); CS_QSUM(s1); \
                    const int s0 = kbi * 16 + kt * 4 + q; \
                    if ((l15 & 3) == 0) { atomicAdd(&impL[tl * 64 + s0], s4); if (s0 + 1 < 64) atomicAdd(&impL[tl * 64 + s0 + 1], s1); } \
                } \
            } }
        CS_LOADK(kfA, 0);
        for (int kb = 0; kb <= hi; kb += 2) {
            if (kb + 1 <= hi) CS_LOADK(kfB, kb + 1);
            CS_BLOCK(kfA, kb);
            if (kb + 1 > hi) break;
            if (kb + 2 <= hi) CS_LOADK(kfA, kb + 2);
            CS_BLOCK(kfB, kb + 1);
        }
#undef CS_LOADK
#undef CS_QSUM
#undef CS_BLOCK
        __syncthreads();
    }
    {
        const int tl = tid >> 3, sg = tid & 7; const int t = t0 + tl, cur = t >> 6; float* row = impL + tl * 64;
        unsigned hk[8]; unsigned long long mine[8];
#pragma unroll
        for (int j = 0; j < 8; ++j) { const int s = sg * 8 + j; const float v = row[s];
            hk[j] = (s == 0 || s == cur || s == cur - 1) ? 0x7F800000u : (s * 64 > t ? 0u : (v > 0.f ? __float_as_uint(v) + 1u : 1u));
            mine[j] = ((unsigned long long)hk[j] << 32) | (unsigned)(63 - s); }
        __syncthreads();
#pragma unroll
        for (int j = 0; j < 8; ++j) ((unsigned*)row)[sg * 8 + j] = hk[j];
        __syncthreads();
        int rank[8] = {0, 0, 0, 0, 0, 0, 0, 0};
        const int ns4 = ((((t0 + 31) >> 6) >> 2) + 2) & ~1;
#pragma unroll 2
        for (int s4 = 0; s4 < ns4; ++s4) {
            const u32x4 v4 = *(const u32x4*)(row + s4 * 4);
#pragma unroll
            for (int e = 0; e < 4; ++e) { const unsigned long long kv = ((unsigned long long)v4[e] << 32) | (unsigned)(63 - (s4 * 4 + e));
#pragma unroll
                for (int j = 0; j < 8; ++j) rank[j] += kv > mine[j] ? 1 : 0; }
        }
        unsigned long long bits = 0ull;
#pragma unroll
        for (int j = 0; j < 8; ++j) if (rank[j] < KTOP && (sg * 8 + j) * 64 <= t) bits |= 1ull << (sg * 8 + j);
        unsigned lo = (unsigned)bits, hi2 = (unsigned)(bits >> 32);
#pragma unroll
        for (int o = 1; o < 8; o <<= 1) { lo |= __shfl_xor(lo, o); hi2 |= __shfl_xor(hi2, o); }
        if (sg == 0) SELM[(mbase + tl) * 4 + g] = ((unsigned long long)hi2 << 32) | lo;
    }
    __syncthreads();
}

DI void sel_item(const bf16* __restrict__ P2, const bf16* __restrict__ VTs, const unsigned long long* __restrict__ SELM, const bf16* __restrict__ OC, const bf16* __restrict__ OW,
                 bf16* __restrict__ AO, int item, char* smem) {
    constexpr int NQT = ANQT_SEL;
    int b, g, t0; attn_item_decode<16 * NQT>(item, b, g, t0);
    const int tid = TIDX, lane = tid & 63, wave = tid >> 6, q = lane >> 4, l15 = lane & 15;
    const size_t mbase = (size_t)b * T + t0; const int hbase = g * 4, rr = l15 & 3, h = hbase + rr;
    unsigned long long* orw = (unsigned long long*)(smem + at::OFF_X);
    if (tid == 0) *orw = 0ull;
    __syncthreads();
    if (tid < 16 * NQT) atomicOr(orw, SELM[(mbase + tid) * 4 + g]);
    unsigned long long sel[NQT];
#pragma unroll
    for (int qt = 0; qt < NQT; ++qt) sel[qt] = SELM[(mbase + wave * (4 * NQT) + qt * 4 + (l15 >> 2)) * 4 + g];
    bf16x8 qf[NQT][2]; attn_load_q<NQT>(qf, P2, LDP2, mbase, hbase);
    AttnStateT<NQT> st; attn_init<NQT>(st, at::M_INIT, 0.f);
    __syncthreads();
    const unsigned long long todo_v = (*orw) & range_mask(0, (t0 + 16 * NQT - 1) >> 6);
    const unsigned long long todo = ((unsigned long long)(unsigned)__builtin_amdgcn_readfirstlane((int)(todo_v >> 32)) << 32) | (unsigned)__builtin_amdgcn_readfirstlane((int)(unsigned)todo_v);
    attn_blocks<AM_SEL, NQT>(st, qf, P2 + (size_t)b * T * LDP2 + 1536 + g * 64, LDP2, VTs + (size_t)(b * G + g) * 64 * T, T, t0, todo, hbase, sel, smem);
#pragma unroll
    for (int qt = 0; qt < NQT; ++qt) {
        const float li = attn_linv(st.lacc[qt]); const size_t m = mbase + wave * (4 * NQT) + qt * 4 + (l15 >> 2);
        const bf16* gr = P2 + m * LDP2 + 3072;
        const float g0 = sigmoidf_(bf2f(gr[0 * 16 + h])), g1 = sigmoidf_(bf2f(gr[1 * 16 + h])), g2 = sigmoidf_(bf2f(gr[2 * 16 + h]));
#pragma unroll
        for (int dt = 0; dt < 4; ++dt) {
            const int d0 = dt * 16 + 4 * q; const size_t oi = m * D + h * 64 + d0;
            const u32x2 zz = *(const u32x2*)(P2 + m * LDP2 + 2048 + h * 64 + d0), cc = *(const u32x2*)(OC + oi), ww = *(const u32x2*)(OW + oi);
            const f32x4 o = st.o[qt][dt];
            const float r0 = (g0 * bflo(cc[0]) + g1 * o[0] * li + g2 * bflo(ww[0])) * siluf_(bflo(zz[0]));
            const float r1 = (g0 * bfhi(cc[0]) + g1 * o[1] * li + g2 * bfhi(ww[0])) * siluf_(bfhi(zz[0]));
            const float r2 = (g0 * bflo(cc[1]) + g1 * o[2] * li + g2 * bflo(ww[1])) * siluf_(bflo(zz[1]));
            const float r3 = (g0 * bfhi(cc[1]) + g1 * o[3] * li + g2 * bfhi(ww[1])) * siluf_(bfhi(zz[1]));
            *(u32x2*)(AO + oi) = (u32x2){pack2bf(r0, r1), pack2bf(r2, r3)};
        }
    }
    __syncthreads();
}

DI void lru_convert_gates(const float* __restrict__ gaw, const float* __restrict__ gxw, bf16* __restrict__ img) {
    for (int i = blockIdx.x * NTHREADS + TIDX; i < 16 * 160 * 96; i += gridDim.x * NTHREADS) {
        const int k = i % 96, n = (i / 96) % 160, blk = i / (96 * 160);
        float v = 0.f;
        if (k < 80) v = n < 80 ? gaw[((size_t)blk * 80 + k) * 80 + n] : gxw[((size_t)blk * 80 + k) * 80 + (n - 80)];
        img[i] = f2bf(v);
    }
}
DI void lru_gate_item(const bf16* __restrict__ P3, const float* __restrict__ cw, const float* __restrict__ cb, const bf16* __restrict__ gimg, const float* __restrict__ gab, const float* __restrict__ gxb,
                      const float* __restrict__ lam, bf16* __restrict__ LA, bf16* __restrict__ BV, float2* __restrict__ SUM, int item, char* smem) {
    const int rt = item >> 4, nb = item & 15; const int tid = TIDX, lane = tid & 63, wave = tid >> 6, q = lane >> 4, l15 = lane & 15;
    const size_t m0 = (size_t)rt * 128;
    for (int id = tid; id < 128 * 12; id += NTHREADS) {
        const int row = id / 12, c12 = id % 12; u32x4 outv = (u32x4){0u, 0u, 0u, 0u};
        if (c12 < 10) {
            const size_t m = m0 + row; const int t = (int)(m % T); const int ch = nb * 80 + c12 * 8;
            float acc[8];
            { const float4 b0 = *(const float4*)(cb + ch), b1 = *(const float4*)(cb + ch + 4); acc[0] = b0.x; acc[1] = b0.y; acc[2] = b0.z; acc[3] = b0.w; acc[4] = b1.x; acc[5] = b1.y; acc[6] = b1.z; acc[7] = b1.w; }
#pragma unroll
            for (int w = 0; w < 4; ++w) {
                if (t - 3 + w >= 0) {
                    const u32x4 uv = *(const u32x4*)(P3 + (m - 3 + w) * 2560 + ch);
                    const float4 w0 = *(const float4*)(cw + w * LW + ch), w1 = *(const float4*)(cw + w * LW + ch + 4);
                    acc[0] += w0.x * bflo(uv[0]); acc[1] += w0.y * bfhi(uv[0]); acc[2] += w0.z * bflo(uv[1]); acc[3] += w0.w * bfhi(uv[1]);
                    acc[4] += w1.x * bflo(uv[2]); acc[5] += w1.y * bfhi(uv[2]); acc[6] += w1.z * bflo(uv[3]); acc[7] += w1.w * bfhi(uv[3]);
                }
            }
            outv = (u32x4){pack2bf(acc[0], acc[1]), pack2bf(acc[2], acc[3]), pack2bf(acc[4], acc[5]), pack2bf(acc[6], acc[7])};
        }
        const int ks = c12 >> 2, c = c12 & 3;
        *(u32x4*)(smem + ks * 8192 + row * 64 + ((c ^ ((row >> 2) & 3)) << 4)) = outv;
    }
    for (int id = tid; id < 160 * 12; id += NTHREADS) {
        const int row = id / 12, c12 = id % 12; const int ks = c12 >> 2, c = c12 & 3;
        *(u32x4*)(smem + 24576 + ks * 10240 + row * 64 + ((c ^ ((row >> 2) & 3)) << 4)) = *(const u32x4*)(gimg + ((size_t)nb * 160 + row) * 96 + c12 * 8);
    }
    __syncthreads();
    f32x4 acc[2][10];
#pragma unroll
    for (int i = 0; i < 2; ++i)
#pragma unroll
        for (int j = 0; j < 10; ++j) acc[i][j] = (f32x4){0.f, 0.f, 0.f, 0.f};
    const int fo = l15 * 64 + ((q ^ ((l15 >> 2) & 3)) << 4);
#pragma unroll
    for (int ks = 0; ks < 3; ++ks) {
        bf16x8 uf[2];
#pragma unroll
        for (int i = 0; i < 2; ++i) uf[i] = *(const bf16x8*)(smem + ks * 8192 + (wave * 32 + i * 16) * 64 + fo);
#pragma unroll
        for (int j = 0; j < 10; ++j) {
            const bf16x8 wf = *(const bf16x8*)(smem + 24576 + ks * 10240 + j * 1024 + fo);
            acc[0][j] = __builtin_amdgcn_mfma_f32_16x16x32_bf16(wf, uf[0], acc[0][j], 0, 0, 0);
            acc[1][j] = __builtin_amdgcn_mfma_f32_16x16x32_bf16(wf, uf[1], acc[1][j], 0, 0, 0);
        }
    }
    __syncthreads();
#pragma unroll
    for (int i = 0; i < 2; ++i) {
        const int row = wave * 32 + i * 16 + l15; const size_t m = m0 + row;
#pragma unroll
        for (int ct = 0; ct < 5; ++ct) {
            const int kcol = ct * 16 + 4 * q; const int ch = nb * 80 + kcol;
            const u32x2 uu = *(const u32x2*)(smem + (kcol >> 5) * 8192 + row * 64 + ((((kcol & 31) >> 3) ^ ((row >> 2) & 3)) << 4) + (kcol & 7) * 2);
            const float uc[4] = {bflo(uu[0]), bfhi(uu[0]), bflo(uu[1]), bfhi(uu[1])};
            const float4 ba = *(const float4*)(gab + ch), bx = *(const float4*)(gxb + ch), lm = *(const float4*)(lam + ch);
            const float bav[4] = {ba.x, ba.y, ba.z, ba.w}, bxv[4] = {bx.x, bx.y, bx.z, bx.w}, lmv[4] = {lm.x, lm.y, lm.z, lm.w};
            float la[4], bv[4];
#pragma unroll
            for (int r = 0; r < 4; ++r) {
                const float rg = __builtin_amdgcn_rcpf(1.0f + __expf(-(acc[i][ct][r] + bav[r]))), ig = __builtin_amdgcn_rcpf(1.0f + __expf(-(acc[i][ct + 5][r] + bxv[r])));
                la[r] = rg * lmv[r];
                const float om = 1.0f - __expf(2.0f * la[r]);
                bv[r] = __builtin_amdgcn_sqrtf(om > 0.f ? om : 0.f) * (ig * uc[r]);
            }
            const u32x2 lav = {pack2bf(la[0], la[1]), pack2bf(la[2], la[3])}, bvv = {pack2bf(bv[0], bv[1]), pack2bf(bv[2], bv[3])};
            *(u32x2*)(LA + m * LW + ch) = lav; *(u32x2*)(BV + m * LW + ch) = bvv;
            *(u32x2*)(smem + 24576 + (row * 80 + kcol) * 2) = lav; *(u32x2*)(smem + 24576 + 20480 + (row * 80 + kcol) * 2) = bvv;
        }
    }
    __syncthreads();
    if (tid < 160) {
        const int cidx = tid / 80, c = tid % 80; const bf16* li = (const bf16*)(smem + 24576) + (cidx * 64) * 80 + c; const bf16* bi = li + 10240;
        float sla = 0.f, h = 0.f;
#pragma unroll 8
        for (int t = 0; t < 64; ++t) { const float la = bf2f(li[t * 80]), bvv = bf2f(bi[t * 80]); h = __expf(la) * h + bvv; sla += la; }
        const size_t mc = m0 + cidx * 64; const int bb = (int)(mc / T), jj = (int)(mc % T) / 64;
        SUM[((size_t)bb * (T / 64) + jj) * LW + nb * 80 + c] = make_float2(__expf(sla), h);
    }
    __syncthreads();
}
DI void lru_scan2_item(const bf16* __restrict__ LA, const bf16* __restrict__ BV, const float2* __restrict__ SUM, const bf16* __restrict__ P3, bf16* __restrict__ AO, int item) {
    const int cg = item % 5, j = (item / 5) % (T / 64), b = item / (5 * (T / 64)); const int c = cg * 256 + TIDX;
    float h = 0.f;
    for (int jj = 0; jj < j; ++jj) { const float2 s = SUM[((size_t)b * (T / 64) + jj) * LW + c]; h = s.x * h + s.y; }
    const size_t m0 = (size_t)b * T + j * 64;
#pragma unroll 8
    for (int t = 0; t < 64; ++t) {
        const float la = bf2f(LA[(m0 + t) * LW + c]); const float bv = bf2f(BV[(m0 + t) * LW + c]); const float z = bf2f(P3[(m0 + t) * 2560 + LW + c]);
        h = __expf(la) * h + bv; AO[(m0 + t) * LW + c] = f2bf(h * siluf_(z));
    }
}

struct ALoadF32 {
    const float* A;
    static constexpr bool DMA = false;
    DI const bf16* src(int, int) const { return nullptr; }
    struct Raw { float4 a, b; };
    DI Raw load(int m, int k) const { Raw r; r.a = *(const float4*)(A + (size_t)m * 64 + k); r.b = *(const float4*)(A + (size_t)m * 64 + k + 4); return r; }
    DI u32x4 finish(const Raw& r, int, int) const { return (u32x4){pack2bf(r.a.x, r.a.y), pack2bf(r.a.z, r.a.w), pack2bf(r.b.x, r.b.y), pack2bf(r.b.z, r.b.w)}; }
};
struct EpiLora {
    const float* w0; const float* a0; bf16* WL; bf16* AV;
    DI void operator()(int m, int n, const float* v, int, int) const {
        float w[8];
        if (n < 1024) {
#pragma unroll
            for (int j = 0; j < 8; ++j) w[j] = -0.60653065971f * __builtin_amdgcn_rcpf(1.0f + __expf(-(w0[n + j] + v[j])));
            store8bf(WL + (size_t)m * D + n, w);
        } else {
#pragma unroll
            for (int j = 0; j < 8; ++j) w[j] = __builtin_amdgcn_rcpf(1.0f + __expf(-(a0[n - 1024 + j] + v[j])));
            store8bf(AV + (size_t)m * D + n - 1024, w);
        }
    }
    DI void finish(int, int, int, int, int) const {}
    DI void finish_wide(int, int, int, int, int) const {}
};
DI float dpp_sum16(float x) {
    x += __builtin_bit_cast(float, __builtin_amdgcn_update_dpp(0, __builtin_bit_cast(int, x), 0xB1, 0xf, 0xf, false));
    x += __builtin_bit_cast(float, __builtin_amdgcn_update_dpp(0, __builtin_bit_cast(int, x), 0x4E, 0xf, 0xf, false));
    x += __builtin_bit_cast(float, __builtin_amdgcn_update_dpp(0, __builtin_bit_cast(int, x), 0x141, 0xf, 0xf, false));
    x += __builtin_bit_cast(float, __builtin_amdgcn_update_dpp(0, __builtin_bit_cast(int, x), 0x140, 0xf, 0xf, false));
    return x;
}
constexpr int RW_NCH = T / 16;
DI void rwkv_prep_item(bf16* __restrict__ P, bf16* __restrict__ WL, bf16* __restrict__ AV, const float* __restrict__ k_k, const float* __restrict__ k_a, const float* __restrict__ r_k,
                       float* __restrict__ G15, bf16* __restrict__ M2g, bf16* __restrict__ M3g, float* __restrict__ BON, int item, char* smem) {
    const int c = item % RW_NCH, h = (item / RW_NCH) & 15, b = item / (RW_NCH * 16);
    const int tid = TIDX, t = tid >> 4, jq = tid & 15, j0 = jq * 4;
    const size_t m0 = (size_t)b * T + c * 16, m = m0 + t; const size_t ch = (size_t)(b * 16 + h) * RW_NCH + c;
    float* sA = (float*)smem; float* sR = sA + 16 * 68; float* sB = sR + 16 * 68; float* sK = sB + 16 * 68; float* sW = sK + 16 * 68; float* sWl = sW + 16 * 68;
    float* mAab = sWl + 16 * 64; float* mAak = mAab + 16 * 17; float* mArb = mAak + 16 * 17; float* mArk = mArb + 16 * 17; float* mTin = mArk + 16 * 17; float* mM2 = mTin + 16 * 17;
    const u32x2 r2 = *(const u32x2*)(P + m * 4096 + h * 64 + j0), k2 = *(const u32x2*)(P + m * 4096 + 1024 + h * 64 + j0), a2 = *(const u32x2*)(AV + m * D + h * 64 + j0), w2 = *(const u32x2*)(WL + m * D + h * 64 + j0);
    const float rr[4] = {bflo(r2[0]), bfhi(r2[0]), bflo(r2[1]), bfhi(r2[1])}, kr[4] = {bflo(k2[0]), bfhi(k2[0]), bflo(k2[1]), bfhi(k2[1])},
                av[4] = {bflo(a2[0]), bfhi(a2[0]), bflo(a2[1]), bfhi(a2[1])}, wl[4] = {bflo(w2[0]), bfhi(w2[0]), bflo(w2[1]), bfhi(w2[1])};
    const float4 kk4 = *(const float4*)(k_k + h * 64 + j0), ka4 = *(const float4*)(k_a + h * 64 + j0), rk4 = *(const float4*)(r_k + h * 64 + j0);
    const float kkc[4] = {kk4.x, kk4.y, kk4.z, kk4.w}, kac[4] = {ka4.x, ka4.y, ka4.z, ka4.w}, rkc[4] = {rk4.x, rk4.y, rk4.z, rk4.w};
    float kkv[4], n2 = 0.f;
#pragma unroll
    for (int e = 0; e < 4; ++e) { kkv[e] = kr[e] * kkc[e]; n2 += kkv[e] * kkv[e]; }
    n2 = dpp_sum16(n2);
    float nr = sqrtf(n2); nr = nr > 1e-12f ? nr : 1e-12f; const float inr = 1.0f / nr;
    float aa[4], bb[4], kp[4], bon = 0.f;
#pragma unroll
    for (int e = 0; e < 4; ++e) { const float kn = kkv[e] * inr; aa[e] = -kn; bb[e] = kn * av[e]; kp[e] = kr[e] * (1.0f + (av[e] - 1.0f) * kac[e]); bon += rr[e] * kp[e] * rkc[e]; }
    bon = dpp_sum16(bon);
    if (jq == 0) BON[m * 16 + h] = bon;
    *(float4*)(sWl + t * 64 + j0) = make_float4(wl[0], wl[1], wl[2], wl[3]);
    __syncthreads();
    float clx[4] = {0.f, 0.f, 0.f, 0.f};
#pragma unroll
    for (int s = 0; s < 15; ++s) { if (s < t) { const float4 w = *(const float4*)(sWl + s * 64 + j0); clx[0] += w.x; clx[1] += w.y; clx[2] += w.z; clx[3] += w.w; } }
    float bt[4];
    {
        float va[4], vr[4], vk[4], gc[4];
#pragma unroll
        for (int e = 0; e < 4; ++e) { const float cl = clx[e] + wl[e]; const float gp = __expf(clx[e]), gi = __expf(-cl); gc[e] = __expf(cl); va[e] = aa[e] * gp; vr[e] = rr[e] * gc[e]; bt[e] = bb[e] * gi; vk[e] = kp[e] * gi; }
        *(float4*)(sA + t * 68 + j0) = make_float4(va[0], va[1], va[2], va[3]); *(float4*)(sR + t * 68 + j0) = make_float4(vr[0], vr[1], vr[2], vr[3]);
        *(float4*)(sB + t * 68 + j0) = make_float4(bt[0], bt[1], bt[2], bt[3]); *(float4*)(sK + t * 68 + j0) = make_float4(vk[0], vk[1], vk[2], vk[3]);
        {
            char* img = (char*)(mM2 + 16 * 17) + t * 128 + (((j0 >> 3) ^ (t & 7)) << 4) + (j0 & 4) * 2;
            *(u32x2*)(img) = (u32x2){pack2bf(va[0], va[1]), pack2bf(va[2], va[3])}; *(u32x2*)(img + 2048) = (u32x2){pack2bf(vr[0], vr[1]), pack2bf(vr[2], vr[3])};
            *(u32x2*)(img + 4096) = (u32x2){pack2bf(bt[0], bt[1]), pack2bf(bt[2], bt[3])}; *(u32x2*)(img + 6144) = (u32x2){pack2bf(vk[0], vk[1]), pack2bf(vk[2], vk[3])};
        }
        if (t == 15) *(float4*)(G15 + ch * 64 + j0) = make_float4(gc[0], gc[1], gc[2], gc[3]);
#pragma unroll
        for (int e = 0; e < 4; ++e) {   }
#pragma unroll
        for (int e = 0; e < 4; ++e) clx[e] = vk[e];
    }
    __syncthreads();
    {
        const int wv = __builtin_amdgcn_readfirstlane(tid >> 6), lane = tid & 63, q = lane >> 4, l15 = lane & 15;
        const char* xb_ = (const char*)(mM2 + 16 * 17) + (wv >> 1) * 2048;
        const char* yb_ = (const char*)(mM2 + 16 * 17) + 4096 + (wv & 1) * 2048;
        f32x4 acc = {0.f, 0.f, 0.f, 0.f};
#pragma unroll
        for (int ks = 0; ks < 2; ++ks) {
            const int off = l15 * 128 + (((ks * 4 + q) ^ (l15 & 7)) << 4);
            const bf16x8 xf = *(const bf16x8*)(xb_ + off), yf = *(const bf16x8*)(yb_ + off);
            acc = __builtin_amdgcn_mfma_f32_16x16x32_bf16(xf, yf, acc, 0, 0, 0);
        }
        float* dst = wv == 0 ? mAab : (wv == 1 ? mAak : (wv == 2 ? mArb : mArk));
        const bool strict = wv < 2;
#pragma unroll
        for (int r = 0; r < 4; ++r) { const int tt = 4 * q + r, ss = l15; dst[tt * 17 + ss] = (strict ? ss < tt : ss <= tt) ? acc[r] : 0.f; }
    }
    __syncthreads();
    if (tid < 16) {
        float col[16];
#pragma unroll
        for (int i = 0; i < 16; ++i) {
            float acc = (i == tid) ? 1.0f : 0.f;
#pragma unroll
            for (int jj = 0; jj < i; ++jj) acc += mAab[i * 17 + jj] * col[jj];
            col[i] = acc; mTin[i * 17 + tid] = acc;
        }
    }
    __syncthreads();
    float wv[4] = {0.f, 0.f, 0.f, 0.f}, m2 = 0.f;
#pragma unroll
    for (int s = 0; s < 16; ++s) { const float ti = mTin[t * 17 + s]; const float4 a4 = *(const float4*)(sA + s * 68 + j0); wv[0] += ti * a4.x; wv[1] += ti * a4.y; wv[2] += ti * a4.z; wv[3] += ti * a4.w; m2 += ti * mAak[s * 17 + jq]; }
    *(float4*)(sW + t * 68 + j0) = make_float4(wv[0], wv[1], wv[2], wv[3]); mM2[t * 17 + jq] = m2;
    __syncthreads();
    float rh[4]; { const float4 r4 = *(const float4*)(sR + t * 68 + j0); rh[0] = r4.x; rh[1] = r4.y; rh[2] = r4.z; rh[3] = r4.w; }
    float m3 = mArk[t * 17 + jq];
#pragma unroll
    for (int s = 0; s < 16; ++s) { const float ar = mArb[t * 17 + s]; const float4 w4 = *(const float4*)(sW + s * 68 + j0); rh[0] += ar * w4.x; rh[1] += ar * w4.y; rh[2] += ar * w4.z; rh[3] += ar * w4.w; m3 += ar * mM2[s * 17 + jq]; }
    const int jp = (((jq >> 3) * 4 + (jq & 3)) * 8 + ((jq >> 2) & 1) * 4);
    *(u32x2*)(WL + m * D + h * 64 + jp) = (u32x2){pack2bf(wv[0], wv[1]), pack2bf(wv[2], wv[3])};
    *(u32x2*)(P + m * 4096 + h * 64 + jp) = (u32x2){pack2bf(rh[0], rh[1]), pack2bf(rh[2], rh[3])};
#pragma unroll
    for (int e = 0; e < 4; ++e) {
        const int pos = ((e & 1) * 4 + (t >> 2)) * 8 + (t & 3);
        bf16* dst = e < 2 ? P + (m0 + jq) * 4096 + 1024 + h * 64 : AV + (m0 + jq) * D + h * 64;
        dst[pos] = f2bf(clx[e]); dst[pos + 4] = f2bf(bt[e]);
    }
    M2g[ch * 256 + t * 16 + jq] = f2bf(m2); M3g[ch * 256 + t * 16 + jq] = f2bf(m3);
    __syncthreads();
}

#define MFMA32(a, b, c) __builtin_amdgcn_mfma_f32_16x16x32_bf16(__builtin_bit_cast(bf16x8, a), __builtin_bit_cast(bf16x8, b), c, 0, 0, 0)
DI void rwkv_chunk_scan(const bf16* __restrict__ P, const bf16* __restrict__ WL, const bf16* __restrict__ AV, const float* __restrict__ G15, const bf16* __restrict__ M2g, const bf16* __restrict__ M3g,
                        bf16* __restrict__ YS, int bh, char* smem) {
    constexpr int SLOT = 12288, YOFF = 49152;
    const int tid = TIDX, lane = tid & 63, vs = __builtin_amdgcn_readfirstlane(tid >> 6), q = lane >> 4, l15 = lane & 15; const int b = bh >> 4, h = bh & 15;
    const size_t mb = (size_t)b * T; const size_t ch0 = (size_t)(b * 16 + h) * RW_NCH;
    const char *s0, *s1, *s2; size_t d0, d1, d2;
    if (tid < 128) { const int c8 = tid >> 4, t = tid & 15; s0 = (const char*)(WL + (mb + t) * D + h * 64 + c8 * 8); d0 = (size_t)16 * D * 2; }
    else { const int pp = tid - 128, c8 = pp >> 4, t = pp & 15; s0 = (const char*)(P + (mb + t) * 4096 + h * 64 + c8 * 8); d0 = (size_t)16 * 4096 * 2; }
    if (tid < 128) { const int r = tid >> 3, c8 = tid & 7; s1 = (const char*)(P + (mb + r) * 4096 + 1024 + h * 64 + c8 * 8); d1 = (size_t)16 * 4096 * 2; }
    else { const int pp = tid - 128, r = pp >> 3, c8 = pp & 7; s1 = (const char*)(AV + (mb + r) * D + h * 64 + c8 * 8); d1 = (size_t)16 * D * 2; }
    if (tid < 128) { const int r = tid >> 3, c8 = tid & 7; s2 = (const char*)(P + (mb + r) * 4096 + 2048 + h * 64 + c8 * 8); d2 = (size_t)16 * 4096 * 2; }
    else if (tid < 160) { s2 = (const char*)(M2g + ch0 * 256 + (tid - 128) * 8); d2 = 512; }
    else if (tid < 192) { s2 = (const char*)(M3g + ch0 * 256 + (tid - 160) * 8); d2 = 512; }
    else { const int pp = tid < 208 ? tid - 192 : 0; s2 = (const char*)(G15 + ch0 * 64 + pp * 4); d2 = 256; }
    const int dma_off = vs * 1024;
#define RW_DMA(c_) { char* dst = smem + ((c_) & 3) * SLOT + dma_off; GLDS16(s0 + (size_t)(c_) * d0, dst); GLDS16(s1 + (size_t)(c_) * d1, dst + 4096); GLDS16(s2 + (size_t)(c_) * d2, dst + 8192); }
#define RW_BARRIER() { asm volatile("s_waitcnt lgkmcnt(0)" ::: "memory"); __builtin_amdgcn_s_barrier(); asm volatile("" ::: "memory"); }
    f32x4 H0 = {0.f, 0.f, 0.f, 0.f}, H1 = H0, H2 = H0, H3 = H0;
    const int oW = (q * 16 + l15) * 16;
    const int oK = 4096 + ((l15 & 3) >> 1) * 2048 + ((l15 >> 2) * 8 + (l15 & 1) * 4 + q) * 16;
    const int oM = 10240 + l15 * 32 + q * 8;
    const int oV = 8192 + (4 * q) * 128 + (vs * 16 + l15) * 2;
    const int oG = 11264 + (4 * q) * 4;
    const int oY = YOFF + ((4 * q) * 64 + vs * 16 + l15) * 2;
    RW_DMA(0); RW_DMA(1); RW_DMA(2);
    asm volatile("s_waitcnt vmcnt(6)" ::: "memory");
    RW_BARRIER();
    u32x4 pHb0 = {0u, 0u, 0u, 0u}, pHb1 = pHb0, pVlo = pHb0, prA = pHb0, prB = pHb0; u32x2 pm3 = {0u, 0u};
    int sincef = 3;
#define RW_FLUSH(cbase_) { u32x4 yv[4]; \
        _Pragma("unroll") for (int k = 0; k < 4; ++k) yv[k] = *(const u32x4*)(smem + YOFF + (tid + 256 * k) * 16); \
        _Pragma("unroll") for (int k = 0; k < 4; ++k) { const int pc = tid + 256 * k, rr = pc >> 3, c8 = pc & 7; *(u32x4*)(YS + (mb + (size_t)(cbase_) * 16 + rr) * D + h * 64 + c8 * 8) = yv[k]; } }
    for (int c = 0; c < RW_NCH; ++c) {
        if (c + 3 < RW_NCH) RW_DMA(c + 3);
        const char* sl = smem + (c & 3) * SLOT;
        {
            const f32x4 z4 = {0.f, 0.f, 0.f, 0.f};
            const u32x4 Hb0 = {pack2bf(H0[0], H0[1]), pack2bf(H0[2], H0[3]), pack2bf(H1[0], H1[1]), pack2bf(H1[2], H1[3])};
            const u32x4 Hb1 = {pack2bf(H2[0], H2[1]), pack2bf(H2[2], H2[3]), pack2bf(H3[0], H3[1]), pack2bf(H3[2], H3[3])};
            const unsigned v0 = *(const bf16*)(sl + oV), v1 = *(const bf16*)(sl + oV + 128), v2 = *(const bf16*)(sl + oV + 256), v3 = *(const bf16*)(sl + oV + 384);
            const unsigned v01 = v0 | (v1 << 16), v23 = v2 | (v3 << 16);
            const u32x4 Vlo = {v01, v23, 0u, 0u};
            const u32x2 m2 = *(const u32x2*)(sl + oM), m3 = *(const u32x2*)(sl + oM + 512);
            const u32x4 wA = *(const u32x4*)(sl + oW), wB = *(const u32x4*)(sl + oW + 1024);
            const u32x4 rA = *(const u32x4*)(sl + 2048 + oW), rB = *(const u32x4*)(sl + 2048 + oW + 1024);
            f32x4 U = MFMA32(((u32x4){m2[0], m2[1], 0u, 0u}), Vlo, z4);
            f32x4 Y = MFMA32(((u32x4){pm3[0], pm3[1], 0u, 0u}), pVlo, z4);
            U = MFMA32(wA, Hb0, U);
            Y = MFMA32(prA, pHb0, Y);
            U = MFMA32(wB, Hb1, U);
            Y = MFMA32(prB, pHb1, Y);
            const u32x4 VU = {v01, v23, pack2bf(U[0], U[1]), pack2bf(U[2], U[3])};
            const u32x4 kb0 = *(const u32x4*)(sl + oK), kb1 = *(const u32x4*)(sl + oK + 512), kb2 = *(const u32x4*)(sl + oK + 1024), kb3 = *(const u32x4*)(sl + oK + 1536);
            const f32x4 g0 = *(const f32x4*)(sl + oG), g1 = *(const f32x4*)(sl + oG + 64), g2 = *(const f32x4*)(sl + oG + 128), g3 = *(const f32x4*)(sl + oG + 192);
            const f32x4 a0 = MFMA32(kb0, VU, H0), a1 = MFMA32(kb1, VU, H1);
            const f32x4 a2 = MFMA32(kb2, VU, H2), a3 = MFMA32(kb3, VU, H3);
            H0 = a0 * g0; H1 = a1 * g1; H2 = a2 * g2; H3 = a3 * g3;
            if (c > 0) {
                char* yb = smem + oY + ((c - 1) & 7) * 2048;
                const unsigned y01 = pack2bf(Y[0], Y[1]), y23 = pack2bf(Y[2], Y[3]);
                *(unsigned short*)(yb) = (unsigned short)y01; *(unsigned short*)(yb + 128) = (unsigned short)(y01 >> 16);
                *(unsigned short*)(yb + 256) = (unsigned short)y23; *(unsigned short*)(yb + 384) = (unsigned short)(y23 >> 16);
            }
            pHb0 = Hb0; pHb1 = Hb1; pVlo = Vlo; pm3 = m3; prA = rA; prB = rB;
        }
        const bool flush = c > 0 && (c & 7) == 0;
        if (flush) {
            RW_BARRIER();
            RW_FLUSH(c - 8);
            sincef = 0;
        }
        if (c + 3 < RW_NCH) { if (sincef <= 2) asm volatile("s_waitcnt vmcnt(10)" ::: "memory"); else asm volatile("s_waitcnt vmcnt(6)" ::: "memory"); }
        else if (c + 2 < RW_NCH) { asm volatile("s_waitcnt vmcnt(3)" ::: "memory"); }
        else { asm volatile("s_waitcnt vmcnt(0)" ::: "memory"); }
        RW_BARRIER();
        ++sincef;
    }
    {
        const f32x4 z4 = {0.f, 0.f, 0.f, 0.f};
        f32x4 Y = MFMA32(((u32x4){pm3[0], pm3[1], 0u, 0u}), pVlo, z4);
        Y = MFMA32(prA, pHb0, Y);
        Y = MFMA32(prB, pHb1, Y);
        char* yb = smem + oY + ((RW_NCH - 1) & 7) * 2048;
        const unsigned y01 = pack2bf(Y[0], Y[1]), y23 = pack2bf(Y[2], Y[3]);
        *(unsigned short*)(yb) = (unsigned short)y01; *(unsigned short*)(yb + 128) = (unsigned short)(y01 >> 16);
        *(unsigned short*)(yb + 256) = (unsigned short)y23; *(unsigned short*)(yb + 384) = (unsigned short)(y23 >> 16);
        RW_BARRIER();
        RW_FLUSH(RW_NCH - 8);
    }
#undef RW_FLUSH
#undef RW_DMA
#undef RW_BARRIER
}
DI void rwkv_gn_rows2(const bf16* __restrict__ P, const float* __restrict__ BON, const float* __restrict__ lnw, const float* __restrict__ lnb, bf16* __restrict__ YS) {
    const int tid = TIDX, lane = tid & 63, wave = tid >> 6; const int c = wave * 256 + lane * 4;
    const float4 lw = *(const float4*)(lnw + c), lb = *(const float4*)(lnb + c);
    for (size_t m = blockIdx.x; m < (size_t)M; m += gridDim.x) {
        const u32x2 yy = *(const u32x2*)(YS + m * D + c), vv = *(const u32x2*)(P + m * 4096 + 2048 + c), zz = *(const u32x2*)(P + m * 4096 + 3072 + c);
        const float bs = BON[m * 16 + (c >> 6)];
        const float y[4] = {bflo(yy[0]), bfhi(yy[0]), bflo(yy[1]), bfhi(yy[1])}, v[4] = {bflo(vv[0]), bfhi(vv[0]), bflo(vv[1]), bfhi(vv[1])}, z[4] = {bflo(zz[0]), bfhi(zz[0]), bflo(zz[1]), bfhi(zz[1])};
        const float lwv[4] = {lw.x, lw.y, lw.z, lw.w}, lbv[4] = {lb.x, lb.y, lb.z, lb.w};
        const float mean = dpp_sum16((y[0] + y[1]) + (y[2] + y[3])) * (1.0f / 64.0f);
        float var = 0.f;
#pragma unroll
        for (int i = 0; i < 4; ++i) { const float d = y[i] - mean; var += d * d; }
        var = dpp_sum16(var) * (1.0f / 64.0f);
        const float rstd = 1.0f / sqrtf(var + 64e-5f);
        float o[4];
#pragma unroll
        for (int i = 0; i < 4; ++i) o[i] = ((y[i] - mean) * rstd * lwv[i] + lbv[i] + bs * v[i]) * siluf_(z[i]);
        *(u32x2*)(YS + m * D + c) = (u32x2){pack2bf(o[0], o[1]), pack2bf(o[2], o[3])};
    }
}

struct FastBufs { char* ws; };

DI void rows_xb_parts(const float* __restrict__ x, bf16* xb, float* parts) {
    const int lane = TIDX & 63, wave = TIDX >> 6;
    for (int m = blockIdx.x * 4 + wave; m < M; m += gridDim.x * 4) {
        const float* xr = x + (size_t)m * D; float s = 0.f;
#pragma unroll
        for (int i = 0; i < 2; ++i) {
            const int k = (i * 64 + lane) * 8; const float4 a = *(const float4*)(xr + k), b = *(const float4*)(xr + k + 4);
            const float w[8] = {a.x, a.y, a.z, a.w, b.x, b.y, b.z, b.w};
#pragma unroll
            for (int j = 0; j < 8; ++j) s += w[j] * w[j];
            store8bf(xb + (size_t)m * D + k, w);
        }
#pragma unroll
        for (int o = 32; o >= 1; o >>= 1) s += __shfl_xor(s, o);
        if (lane < 16) parts[(size_t)m * 16 + lane] = lane == 0 ? s : 0.f;
    }
}
DI void rows_xn(const float* __restrict__ x, const float* parts, const float* __restrict__ g, bf16* xn) {
    const int lane = TIDX & 63, wave = TIDX >> 6;
    for (int m = blockIdx.x * 4 + wave; m < M; m += gridDim.x * 4) {
        const float rs = rstd_from_parts(parts, m); const float* xr = x + (size_t)m * D;
#pragma unroll
        for (int i = 0; i < 2; ++i) {
            const int k = (i * 64 + lane) * 8; const float4 a = *(const float4*)(xr + k), b = *(const float4*)(xr + k + 4);
            const float4 ga = *(const float4*)(g + k), gb = *(const float4*)(g + k + 4);
            const float w[8] = {a.x * rs * ga.x, a.y * rs * ga.y, a.z * rs * ga.z, a.w * rs * ga.w, b.x * rs * gb.x, b.y * rs * gb.y, b.z * rs * gb.z, b.w * rs * gb.w};
            store8bf(xn + (size_t)m * D + k, w);
        }
    }
}
DI void rows_final(float* x, const float* parts, const float* __restrict__ g) {
    const int lane = TIDX & 63, wave = TIDX >> 6;
    for (int m = blockIdx.x * 4 + wave; m < M; m += gridDim.x * 4) {
        const float rs = rstd_from_parts(parts, m); float* xr = x + (size_t)m * D;
#pragma unroll
        for (int i = 0; i < 4; ++i) {
            const int k = (i * 64 + lane) * 4; float4 a = *(float4*)(xr + k); const float4 ga = *(const float4*)(g + k);
            a.x *= rs * ga.x; a.y *= rs * ga.y; a.z *= rs * ga.z; a.w *= rs * ga.w; *(float4*)(xr + k) = a;
        }
    }
}
enum { PH_PREP0 = 0, PH_IN0, PH_ATTN0, PH_OUT0, PH_PREP1, PH_IN1, PH_LORA1, PH_CPREP1, PH_SCAN1, PH_GN1, PH_OUT1, PH_PREP2, PH_IN2, PH_B2, PH_C2, PH_D2, PH_OUT2, PH_PREP3, PH_IN3, PH_GATE3, PH_SCANA3, PH_SCANB3, PH_OUT3, PH_FINAL };

namespace wbo {
constexpr size_t IN = 0;
constexpr size_t OUT = (size_t)4352 * 1024;
constexpr size_t EXTRA = OUT + (size_t)1280 * 1024;
}

template <int PH>
DI void run_phase(const Params& p, char* smem) {
    char* ws = p.ws;
    float* parts = (float*)(ws + fw::PARTS);
    constexpr int LAYER = PH <= PH_OUT0 ? 0 : PH <= PH_OUT1 ? 1 : PH <= PH_OUT2 ? 2 : 3;
    constexpr size_t WBOFF = LAYER == 0 ? 200 * fw::MB : LAYER == 1 ? 238 * fw::MB : LAYER == 2 ? 240 * fw::MB : 1 * fw::MB;
    bf16* WB = (bf16*)(ws + WBOFF);
    bf16* XB = (bf16*)(ws + ((PH == PH_PREP0 || PH == PH_IN0) ? 130 * fw::MB : 174 * fw::MB));
    bf16* P = (bf16*)(ws + wsl::P);
    float* X = p.out;
    float* smf = (float*)smem;
    if (PH == PH_PREP0) {
        rows_xb_parts(p.x, XB, parts);
        int tb = 0;
        convert_seg(p.a_w_in, A_COLS, 0, A_COLS, 1024, WB + wbo::IN, p.norm_g + 0 * D, smf, tb);
        convert_seg(p.a_w_out, 1024, 0, 1024, 1024, WB + wbo::OUT, nullptr, smf, tb);
    } else if (PH == PH_IN0) {
        gemm_sched(8, 4, [&](bool big, int mt, int nt) {
            if (big) gemm_tile2(ALoadPlain{XB, D}, WB + wbo::IN, 1024, mt * 128, nt * 256, EpiL0{P, (bf16*)(ws + 86 * fw::MB), parts}, smem);
            else gemm_tile(ALoadPlain{XB, D}, WB + wbo::IN, 1024, mt * 128, 2048 + nt * 128, EpiL0{P, (bf16*)(ws + 86 * fw::MB), parts}, smem);
        });
    } else if (PH == PH_ATTN0) {
        build_bias_lut(p.t5, smem, true);
        for (int it = blockIdx.x; it < B * G * (T / (16 * ANQT_SWA)); it += gridDim.x) swa_item(P, (const bf16*)(ws + 86 * fw::MB), p.a_sinks, (bf16*)(ws + wsl::L0_AO), it, smem);
    } else if (PH == PH_OUT0) {
        gemm_sched(4, 0, [&](bool, int mt, int nt) { gemm_tile2(ALoadPlain{(const bf16*)(ws + wsl::L0_AO), D}, WB + wbo::OUT, 1024, mt * 128, nt * 256, EpiResid{p.x, X, nullptr, parts}, smem); });
    } else if (PH == PH_PREP1) {
        rows_xn(X, parts, p.norm_g + 1 * D, (bf16*)(ws + wsl::L1_XN));
        int tb = 0;
        convert_seg(p.b_w_in, 4096, 0, 4096, 1024, WB + wbo::IN, nullptr, smf, tb);
        convert_seg(p.b_w1, 64, 0, 64, 1024, WB + wbo::IN + (size_t)4096 * 1024, nullptr, smf, tb);
        convert_seg(p.b_a1, 64, 0, 64, 1024, WB + wbo::IN + (size_t)(4096 + 128) * 1024, nullptr, smf, tb);
        convert_seg(p.b_w_out, 1024, 0, 1024, 1024, WB + wbo::OUT, nullptr, smf, tb);
        convert_seg(p.b_w2, 1024, 0, 1024, 64, WB + wbo::EXTRA, nullptr, smf, tb);
        convert_seg(p.b_a2, 1024, 0, 1024, 64, WB + wbo::EXTRA + (size_t)1024 * 64, nullptr, smf, tb);
        for (size_t i = (size_t)blockIdx.x * 256 + TIDX; i < (size_t)64 * 1024 / 8; i += (size_t)gridDim.x * 256) {
            ((u32x4*)(WB + wbo::IN + (size_t)(4096 + 64) * 1024))[i] = (u32x4){0u, 0u, 0u, 0u};
            ((u32x4*)(WB + wbo::IN + (size_t)(4096 + 192) * 1024))[i] = (u32x4){0u, 0u, 0u, 0u};
        }
    } else if (PH == PH_IN1) {
        const bf16* XN = (const bf16*)(ws + wsl::L1_XN);
        EpiRwkv epi{P, (float*)(ws + wsl::LHW), (float*)(ws + wsl::LHA)};
        gemm_sched(16, 2, [&](bool big, int mt, int nt) {
            if (big) gemm_tile2(ALoadLerp{XN, p.b_mu + (nt >> 2) * D}, WB + wbo::IN, 1024, mt * 128, nt * 256, epi, smem);
            else gemm_tile(ALoadLerp{XN, p.b_mu + (4 + nt) * D}, WB + wbo::IN, 1024, mt * 128, 4096 + nt * 128, epi, smem);
        });
    } else if (PH == PH_LORA1) {
        const int ntile = (M / 128) * 16;
        EpiLora epi{p.b_w0, p.b_a0, (bf16*)(ws + wsl::L1_WL), (bf16*)(ws + wsl::L1_AV)};
        (void)ntile;
        gemm_sched(8, 0, [&](bool, int mt, int nt) { gemm_tile2(ALoadF32{(const float*)(ws + (nt < 4 ? wsl::LHW : wsl::LHA))}, WB + wbo::EXTRA, 64, mt * 128, nt * 256, epi, smem); });
    } else if (PH == PH_CPREP1) {
        for (int it = blockIdx.x; it < B * 16 * RW_NCH; it += gridDim.x)
            rwkv_prep_item(P, (bf16*)(ws + wsl::L1_WL), (bf16*)(ws + wsl::L1_AV), p.b_k_k, p.b_k_a, p.b_r_k, (float*)(ws + 9 * fw::MB), (bf16*)(ws + 1 * fw::MB), WB, (float*)(ws + 254 * fw::MB), it, smem);
    } else if (PH == PH_SCAN1) {
        const int bid = blockIdx.x;
        if ((bid & 31) < 8 && (bid >> 5) < 8) {
            const int it = (bid >> 5) * 8 + (bid & 31);
            rwkv_chunk_scan(P, (const bf16*)(ws + wsl::L1_WL), (const bf16*)(ws + wsl::L1_AV), (const float*)(ws + 9 * fw::MB), (const bf16*)(ws + 1 * fw::MB), WB, (bf16*)(ws + wsl::L1_XN), it, smem);
        }
    } else if (PH == PH_GN1) {
        rwkv_gn_rows2(P, (const float*)(ws + 254 * fw::MB), p.b_lnx_w, p.b_lnx_b, (bf16*)(ws + wsl::L1_XN));
    } else if (PH == PH_OUT1) {
        gemm_sched(4, 0, [&](bool, int mt, int nt) { gemm_tile2(ALoadPlain{(const bf16*)(ws + wsl::L1_XN), D}, WB + wbo::OUT, 1024, mt * 128, nt * 256, EpiResid{X, X, XB, parts}, smem); });
    } else if (PH == PH_PREP2) {
        int tb = 0;
        const float* g2 = p.norm_g + 2 * D;
        convert_seg(p.c_w_in, C_COLS, 0, 2560, 1024, WB + wbo::IN, g2, smf, tb);
        convert_seg(p.c_w_in, C_COLS, 2608, 1024, 1024, WB + wbo::IN + (size_t)2560 * 1024, g2, smf, tb);
        convert_seg(p.c_w_in, C_COLS, 2560, 64, 1024, WB + wbo::IN + (size_t)3584 * 1024, g2, smf, tb);
        convert_seg(p.c_w_out, 1024, 0, 1024, 1024, WB + wbo::OUT, nullptr, smf, tb);
        convert_seg(p.c_k_w1, 128, 0, 128, 2048, WB + wbo::EXTRA, nullptr, smf, tb);
        convert_seg(p.c_v_w1, 128, 0, 128, 2048, WB + wbo::EXTRA + (size_t)128 * 2048, nullptr, smf, tb);
        convert_seg(p.c_k_w2, 64, 0, 64, 128, WB + wbo::EXTRA + (size_t)256 * 2048, nullptr, smf, tb);
        convert_seg(p.c_v_w2, 64, 0, 64, 128, WB + wbo::EXTRA + (size_t)256 * 2048 + 64 * 128, nullptr, smf, tb);
        if (blockIdx.x < 16) {
            const int which = blockIdx.x >> 3, i = blockIdx.x & 7; const float* pos = which ? p.c_pos_v : p.c_pos_k; const float* w1 = which ? p.c_v_w1 : p.c_k_w1;
            float* b8 = (float*)(ws + 12 * fw::MB);
            if (TIDX < 128) { float a = 0.f; for (int k = i * 256; k < i * 256 + 256; ++k) a += pos[k] * w1[(size_t)k * 128 + TIDX]; b8[(which * 8 + i) * 128 + TIDX] = a; }
        }
    } else if (PH == PH_IN2) {
        gemm_sched(14, 1, [&](bool big, int mt, int nt) {
            if (big) gemm_tile2(ALoadPlain{XB, D}, WB + wbo::IN, 1024, mt * 128, nt * 256, EpiL2{P, (bf16*)(ws + 114 * fw::MB), (bf16*)(ws + 122 * fw::MB), parts}, smem);
            else gemm_tile(ALoadPlain{XB, D}, WB + wbo::IN, 1024, mt * 128, 3584 + nt * 128, EpiL2{P, (bf16*)(ws + 114 * fw::MB), (bf16*)(ws + 122 * fw::MB), parts}, smem);
        });
    } else if (PH == PH_B2) {
        for (int it = blockIdx.x; it < 64; it += gridDim.x) { const int which = it >> 5, rt = it & 31;
            cmp_tile(P, WB + wbo::EXTRA + (size_t)which * 128 * 2048, (const float*)(ws + 12 * fw::MB) + which * 8 * 128, WB + wbo::EXTRA + (size_t)256 * 2048 + which * 64 * 128, which, rt,
                     (bf16*)(ws + 5 * fw::MB), (bf16*)(ws + 6 * fw::MB), smem); }
        build_bias_lut(p.t5, smem, false);
        const int nwin = B * G * (T / (16 * ANQT_WIN));
        const bool split = gridDim.x == 512 && nwin == 2048;
        const int bid = blockIdx.x, nb = bid - 64, cnt = bid < 64 ? 2 : (nb < 128 ? 5 : 4);
        for (int k = 0;; ++k) {
            int item;
            if (split) { if (k >= cnt) break; item = bid < 64 ? k * 512 + 448 + bid : (k < 4 ? k * 512 + nb : (2 + (nb >> 6)) * 512 + 448 + (nb & 63)); }
            else { const int it = (bid < 64 ? bid + (int)gridDim.x : bid) + k * (int)gridDim.x; if (it >= 64 + nwin) break; item = it - 64; }
            win_item(P, (const bf16*)(ws + 122 * fw::MB), (bf16*)(ws + 130 * fw::MB), item, smem);
        }
    } else if (PH == PH_C2) {
        for (int it = blockIdx.x; it < B * G * (T / 32); it += gridDim.x)
            cmpsel_item(P, (const bf16*)(ws + 5 * fw::MB), (const bf16*)(ws + 6 * fw::MB), (bf16*)(ws + 162 * fw::MB), (unsigned long long*)(ws + 9 * fw::MB), it, smem);
    } else if (PH == PH_D2) {
        build_bias_lut(p.t5, smem, false);
        for (int it = blockIdx.x; it < B * G * (T / (16 * ANQT_SEL)); it += gridDim.x)
            sel_item(P, (const bf16*)(ws + 114 * fw::MB), (const unsigned long long*)(ws + 9 * fw::MB), (const bf16*)(ws + 162 * fw::MB), (const bf16*)(ws + 130 * fw::MB), (bf16*)(ws + 206 * fw::MB), it, smem);
    } else if (PH == PH_OUT2) {
        gemm_sched(4, 0, [&](bool, int mt, int nt) { gemm_tile2(ALoadPlain{(const bf16*)(ws + 206 * fw::MB), D}, WB + wbo::OUT, 1024, mt * 128, nt * 256, EpiResid{X, X, XB, parts}, smem); });
    } else if (PH == PH_PREP3) {
        int tb = 0;
        convert_seg(p.d_w_in, 2560, 0, 2560, 1024, WB + wbo::IN, p.norm_g + 3 * D, smf, tb);
        convert_seg(p.d_w_out, 1024, 0, 1024, 1280, WB + wbo::OUT, nullptr, smf, tb);
        lru_convert_gates(p.d_ga_w, p.d_gx_w, WB + wbo::EXTRA);
        for (int i = blockIdx.x * NTHREADS + TIDX; i < LW; i += gridDim.x * NTHREADS) ((float*)(ws + 12 * fw::MB + 786432))[i] = -8.0f * softplusf_(-p.d_lambda[i]);
    } else if (PH == PH_IN3) {
        gemm_sched(8, 4, [&](bool big, int mt, int nt) {
            if (big) gemm_tile2(ALoadPlain{XB, D}, WB + wbo::IN, 1024, mt * 128, nt * 256, EpiBf16{P, 2560, parts}, smem);
            else gemm_tile(ALoadPlain{XB, D}, WB + wbo::IN, 1024, mt * 128, 2048 + nt * 128, EpiBf16{P, 2560, parts}, smem);
        });
    } else if (PH == PH_GATE3) {
        for (int it = blockIdx.x; it < (M / 128) * 16; it += gridDim.x)
            lru_gate_item(P, p.d_conv_w, p.d_conv_b, WB + wbo::EXTRA, p.d_ga_b, p.d_gx_b, (const float*)(ws + 12 * fw::MB + 786432), (bf16*)(ws + wsl::L3_LA), (bf16*)(ws + wsl::L3_BV), (float2*)(ws + wsl::L3_UC), it, smem);
    } else if (PH == PH_SCANB3) {
        for (int it = blockIdx.x; it < B * (T / 64) * 5; it += gridDim.x)
            lru_scan2_item((const bf16*)(ws + wsl::L3_LA), (const bf16*)(ws + wsl::L3_BV), (const float2*)(ws + wsl::L3_UC), P, (bf16*)(ws + wsl::L3_AO), it);
    } else if (PH == PH_OUT3) {
        gemm_sched(4, 0, [&](bool, int mt, int nt) { gemm_tile2(ALoadPlain{(const bf16*)(ws + wsl::L3_AO), LW}, WB + wbo::OUT, 1280, mt * 128, nt * 256, EpiResid{X, X, nullptr, parts}, smem); });
    } else if (PH == PH_FINAL) {
        rows_final(X, parts, p.final_g);
    }
}

template <int PH> __global__ void __launch_bounds__(NTHREADS, 2) k_phase(Params p) {
    extern __shared__ __attribute__((aligned(16))) char smem[];
    run_phase<PH>(p, smem);
}
#define LDS_BYTES 73728
#define MEGA_LDS_BYTES (73728 + 64)
template <int PH> static void launch_phase(const Params& p, hipStream_t s) {
    static bool attr = false;
    if (!attr) { hipFuncSetAttribute((const void*)k_phase<PH>, hipFuncAttributeMaxDynamicSharedMemorySize, LDS_BYTES); attr = true; }
    hipLaunchKernelGGL(k_phase<PH>, dim3(512), dim3(NTHREADS), LDS_BYTES, s, p);
}


#define XB_TMO      128
#define XB_XCNT(j)  (256  + 64 * (j))
#define XB_XSUB(j)  (1280 + 64 * (j))
#define XB_XGEN(j)  (2304 + 64 * (j))
#define XB_TOP      3328
#define XB_TOPGEN   3392
#define XCD_BAR_WORDS 3456
#define XB_SPIN_CAP (1u << 22)
#define LAS __attribute__((address_space(3)))
DI unsigned xb_ld(unsigned* p)              { return __hip_atomic_load(p, __ATOMIC_RELAXED, __HIP_MEMORY_SCOPE_AGENT); }
DI unsigned xb_add(unsigned* p, unsigned v) { return __hip_atomic_fetch_add(p, v, __ATOMIC_RELAXED, __HIP_MEMORY_SCOPE_AGENT); }
DI unsigned xb_xcc_id() { return (unsigned)__builtin_amdgcn_s_getreg((3 << 11) | 20) & 0xFu; }
#define XB_SPIN(cond, bar) do { unsigned _sp = 0; while (cond) { if (_sp < 64u) __builtin_amdgcn_s_sleep(2); else __builtin_amdgcn_s_sleep(32); \
    if ((++_sp & 255u) == 0u) { if (xb_ld(&(bar)[XB_TMO])) break; if (_sp > XB_SPIN_CAP) { atomicAdd(&(bar)[XB_TMO], 1u); break; } } } } while (0)
struct XcdBarrier { unsigned* bar; unsigned x; volatile LAS unsigned* st; };
DI XcdBarrier xcd_barrier_post(unsigned* bar, volatile LAS unsigned* st) {
    XcdBarrier b; b.bar = bar; b.x = xb_xcc_id(); b.st = st;
    if (threadIdx.x == 0) (void)xb_add(&bar[XB_XCNT(b.x)], 1u);
    return b;
}
DI void xcd_barrier_complete(unsigned* bar, unsigned x, unsigned& nloc, unsigned& nx) {
    const unsigned G = gridDim.x * gridDim.y * gridDim.z;
    unsigned sum, cnt, mine, sp = 0u;
    for (;;) {
        sum = 0u; cnt = 0u; mine = 0u;
#pragma unroll
        for (unsigned j = 0; j < 16; ++j) { const unsigned c = xb_ld(&bar[XB_XCNT(j)]); sum += c; cnt += (c > 0u) ? 1u : 0u; mine = (j == x) ? c : mine; }
        if (sum == G) break;
        __builtin_amdgcn_s_sleep(1);
        if ((++sp & 255u) == 0u) { if (xb_ld(&bar[XB_TMO])) break; if (sp > XB_SPIN_CAP) { atomicAdd(&bar[XB_TMO], 1u); break; } }
    }
    nloc = mine > 0u ? mine : 1u; nx = cnt > 0u ? cnt : 1u;
}
DI void xcd_barrier(const XcdBarrier& b) {
    asm volatile("s_waitcnt vmcnt(0)" ::: "memory");
    __syncthreads();
    if (threadIdx.x == 0) {
        unsigned* bar = b.bar;
        __builtin_amdgcn_s_waitcnt(0);
        unsigned nloc = b.st[0], nx = b.st[1];
        if (nloc == 0u) { xcd_barrier_complete(bar, b.x, nloc, nx); b.st[0] = nloc; b.st[1] = nx; }
        const unsigned old = xb_add(&bar[XB_XSUB(b.x)], 1u);
        const unsigned gen = old / nloc;
        asm volatile("buffer_inv sc1" ::: "memory");
        if (old + 1u == (gen + 1u) * nloc) {
            __builtin_amdgcn_fence(__ATOMIC_RELEASE, "agent");
            asm volatile("s_waitcnt vmcnt(0)" ::: "memory");
            const unsigned og = xb_add(&bar[XB_TOP], 1u);
            const unsigned tg = og / nx;
            if (og + 1u == (tg + 1u) * nx) xb_add(&bar[XB_TOPGEN], 1u);
            else XB_SPIN(xb_ld(&bar[XB_TOPGEN]) == tg, bar);
            xb_add(&bar[XB_XGEN(b.x)], 1u);
            asm volatile("s_waitcnt vmcnt(0)" ::: "memory");
        } else {
            XB_SPIN(xb_ld(&bar[XB_XGEN(b.x)]) == gen, bar);
            asm volatile("s_waitcnt vmcnt(0)" ::: "memory");
        }
    }
    __syncthreads();
}

#define MEGA_PHASES(X) X(PH_IN0) X(PH_ATTN0) X(PH_OUT0) X(PH_PREP1) X(PH_IN1) X(PH_LORA1) X(PH_CPREP1) X(PH_SCAN1) X(PH_GN1) X(PH_OUT1) \
    X(PH_PREP2) X(PH_IN2) X(PH_B2) X(PH_C2) X(PH_D2) X(PH_OUT2) X(PH_PREP3) X(PH_IN3) X(PH_GATE3) X(PH_SCANB3) X(PH_OUT3)
__global__ void __launch_bounds__(NTHREADS, 2) mega_kernel(Params p) {
    extern __shared__ __attribute__((aligned(16))) char smem[];
    cooperative_groups::grid_group grid = cooperative_groups::this_grid();
    volatile LAS unsigned* xst = (volatile LAS unsigned*)(smem + 73728);
    if (threadIdx.x < 4) xst[threadIdx.x] = 0u;
    __syncthreads();
    XcdBarrier xb = xcd_barrier_post((unsigned*)p.ws, xst);
    run_phase<PH_PREP0>(p, smem);
    if (p.ws == nullptr) grid.sync();
    xcd_barrier(xb);
#define MEGA_STEP(ph) run_phase<ph>(p, smem); xcd_barrier(xb);
    MEGA_PHASES(MEGA_STEP)
#undef MEGA_STEP
    run_phase<PH_FINAL>(p, smem);
}
static void launch_mega(const Params& p, hipStream_t s) {
    static int grid_blocks = 0;
    if (!grid_blocks) {
        int dev = 0, cus = 0, per_cu = 0;
        hipGetDevice(&dev);
        hipDeviceGetAttribute(&cus, hipDeviceAttributeMultiprocessorCount, dev);
        hipFuncSetAttribute((const void*)mega_kernel, hipFuncAttributeMaxDynamicSharedMemorySize, MEGA_LDS_BYTES);
        hipOccupancyMaxActiveBlocksPerMultiprocessor(&per_cu, mega_kernel, NTHREADS, MEGA_LDS_BYTES);
        if (per_cu > 2) per_cu = 2;
        if (per_cu < 1) per_cu = 1;
        grid_blocks = cus * per_cu;
    }
    hipMemsetAsync(p.ws, 0, 16384, s);
    Params pp = p; void* args[] = {&pp};
    hipError_t e = hipLaunchCooperativeKernel((const void*)mega_kernel, dim3(grid_blocks), dim3(NTHREADS), args, MEGA_LDS_BYTES, s);
    if (e != hipSuccess) fprintf(stderr, "cooperative launch failed: %s (grid %d)\n", hipGetErrorString(e), grid_blocks);
}
#endif

#ifndef CPU_SHIM
template <class F> __global__ void __launch_bounds__(256) k_run(F f, long n) {
    const long i = (long)blockIdx.x * 256 + threadIdx.x; if (i < n) f(i);
}
template <class F> static void launch(const F& f, long n, hipStream_t s) {
    hipLaunchKernelGGL(k_run<F>, dim3((unsigned)((n + 255) / 256)), dim3(256), 0, s, f, n);
}
#else
template <class F> static void launch(const F& f, long n, hipStream_t) {
#pragma omp parallel for schedule(dynamic, 64)
    for (long i = 0; i < n; ++i) f(i);
}
#endif

#ifdef CPU_SHIM
void cpu_layer_hook(int layer, const float* X, const char* ws);
#define LAYER_HOOK(l) cpu_layer_hook(l, X, ws)
#else
#define LAYER_HOOK(l)
#endif

#define FAST_GEMM 0
#if FAST_GEMM
#define FASTP(ph) launch_phase<ph>(p, s)
#else
#define FASTP(ph)
#endif

static void run_naive(const Params& p, hipStream_t s) {
    char* ws = p.ws;
    float* rs = (float*)(ws + wsl::RS);
    bf16* P = (bf16*)(ws + wsl::P);
    float* X = p.out;
    (void)rs;
    {
        bf16* AO = (bf16*)(ws + wsl::L0_AO);
#if FAST_GEMM
        FASTP(PH_PREP0); FASTP(PH_IN0);
#else
        launch(RstdF{p.x, rs}, M, s);
        launch(GemmInF{p.x, rs, p.norm_g + 0 * D, p.a_w_in, P, A_COLS}, (long)M * (A_COLS / 4), s);
#endif
#if FAST_GEMM
        FASTP(PH_ATTN0); (void)AO;
#else
        launch(SwaF{P, p.t5, p.a_sinks, AO}, (long)M * H, s);
#endif
#if FAST_GEMM
        FASTP(PH_OUT0);
#else
        launch(GemmOutF{AO, p.a_w_out, p.x, X, 1024}, (long)M * (D / 4), s);
#endif
    }
    LAYER_HOOK(0);
    {
        bf16* XN = (bf16*)(ws + wsl::L1_XN); bf16* WL = (bf16*)(ws + wsl::L1_WL); bf16* AV = (bf16*)(ws + wsl::L1_AV);
        float* hw = (float*)(ws + wsl::LHW); float* ha = (float*)(ws + wsl::LHA);
#if FAST_GEMM
        FASTP(PH_PREP1); FASTP(PH_IN1); FASTP(PH_LORA1); FASTP(PH_CPREP1); FASTP(PH_SCAN1); FASTP(PH_GN1); FASTP(PH_OUT1);
        (void)XN; (void)WL; (void)AV; (void)hw; (void)ha;
#else
        launch(RstdF{X, rs}, M, s);
        launch(XnF{X, rs, p.norm_g + 1 * D, XN}, (long)M * D, s);
        launch(GemmRwkvF{XN, p.b_mu, p.b_w_in, P}, (long)M * 1024, s);
        launch(LoraHidF{XN, p.b_mu, p.b_w1, p.b_a1, hw, ha}, (long)M * 128, s);
        launch(LoraOutF{hw, ha, p.b_w0, p.b_w2, p.b_a0, p.b_a2, WL, AV}, (long)M * D, s);
        launch(RwkvScanF{P, WL, AV, p.b_k_k, p.b_k_a, XN}, (long)B * H * 64, s);
        launch(RwkvGnF{P, AV, p.b_k_a, p.b_r_k, p.b_lnx_w, p.b_lnx_b, XN}, (long)M * H, s);
        launch(GemmOutF{XN, p.b_w_out, X, X, 1024}, (long)M * (D / 4), s);
#endif
    }
    LAYER_HOOK(1);
    {
        float* hk = (float*)(ws + wsl::HK); float* hv = (float*)(ws + wsl::HV);
        float* kc = (float*)(ws + wsl::KC); float* vc = (float*)(ws + wsl::VC);
        float* st = (float*)(ws + wsl::ST); int* sel = (int*)(ws + wsl::SEL); float* imp = (float*)(ws + wsl::L2_IMP);
        bf16* AO = (bf16*)(ws + wsl::L2_AO); bf16* OC = (bf16*)(ws + wsl::L2_OC); bf16* OS = (bf16*)(ws + wsl::L2_OS);
#if FAST_GEMM
        FASTP(PH_PREP2); FASTP(PH_IN2); FASTP(PH_B2); FASTP(PH_C2); FASTP(PH_D2); FASTP(PH_OUT2);
        (void)hk; (void)hv; (void)kc; (void)vc; (void)st; (void)sel; (void)imp; (void)AO; (void)OC; (void)OS;
#else
        launch(RstdF{X, rs}, M, s);
        launch(GemmInF{X, rs, p.norm_g + 2 * D, p.c_w_in, P, C_COLS}, (long)M * (C_COLS / 4), s);
        launch(CmpHidF{P, p.c_pos_k, p.c_k_w1, p.c_pos_v, p.c_v_w1, hk, hv}, 2L * B * G * NCMP * 128, s);
        launch(CmpOutF{hk, hv, p.c_k_w2, p.c_v_w2, kc, vc}, 2L * B * G * NCMP * 64, s);
        launch(CmpAttnF{P, kc, vc, st, OC}, (long)M * H, s);
        launch(ImpF{P, kc, st, imp}, (long)M * G * NSEL, s);
        launch(TopkF{imp, sel}, (long)M * G, s);
        launch(SelAttnF{P, p.t5, sel, OS}, (long)M * H, s);
        launch(WinAttnF{P, p.t5, OC, OS, AO}, (long)M * H, s);
        LAYER_HOOK(20);
        launch(GemmOutF{AO, p.c_w_out, X, X, 1024}, (long)M * (D / 4), s);
#endif
    }
    LAYER_HOOK(2);
    {
        bf16* AO = (bf16*)(ws + wsl::L3_AO); bf16* UC = (bf16*)(ws + wsl::L3_UC); bf16* LA = (bf16*)(ws + wsl::L3_LA); bf16* BV = (bf16*)(ws + wsl::L3_BV);
#if FAST_GEMM
        FASTP(PH_PREP3); FASTP(PH_IN3); FASTP(PH_GATE3); FASTP(PH_SCANA3); FASTP(PH_SCANB3); FASTP(PH_OUT3);
        (void)AO; (void)UC; (void)LA; (void)BV;
#else
        launch(RstdF{X, rs}, M, s);
        launch(GemmInF{X, rs, p.norm_g + 3 * D, p.d_w_in, P, 2560}, (long)M * (2560 / 4), s);
        launch(ConvF{P, p.d_conv_w, p.d_conv_b, UC}, (long)M * LW, s);
        launch(LruGateF{UC, p.d_ga_w, p.d_ga_b, p.d_gx_w, p.d_gx_b, p.d_lambda, LA, BV}, (long)M * LW, s);
        launch(LruScanF{P, LA, BV, AO}, (long)B * LW, s);
        launch(GemmOutF{AO, p.d_w_out, X, X, LW}, (long)M * (D / 4), s);
#endif
    }
    LAYER_HOOK(3);
#if FAST_GEMM
    FASTP(PH_FINAL);
#else
    launch(FinalNormF{X, p.final_g}, M, s);
#endif
}

extern "C" void kernel_launch(void* const* d_in, const int* in_sizes, int n_in, void* d_out, int out_size, void* d_ws, size_t ws_size,
                              hipStream_t stream) {
    (void)in_sizes; (void)n_in; (void)out_size; (void)ws_size;
    Params p{};
    const float* const* in = (const float* const*)d_in;
    int k = 0;
    p.x = in[k++]; p.t5 = in[k++]; p.norm_g = in[k++]; p.final_g = in[k++];
    p.a_w_in = in[k++]; p.a_sinks = in[k++]; p.a_w_out = in[k++];
    p.b_mu = in[k++]; p.b_w_in = in[k++]; p.b_w0 = in[k++]; p.b_w1 = in[k++]; p.b_w2 = in[k++]; p.b_a0 = in[k++]; p.b_a1 = in[k++]; p.b_a2 = in[k++];
    p.b_k_k = in[k++]; p.b_k_a = in[k++]; p.b_r_k = in[k++]; p.b_lnx_w = in[k++]; p.b_lnx_b = in[k++]; p.b_w_out = in[k++];
    p.c_w_in = in[k++]; p.c_pos_k = in[k++]; p.c_k_w1 = in[k++]; p.c_k_w2 = in[k++]; p.c_pos_v = in[k++]; p.c_v_w1 = in[k++]; p.c_v_w2 = in[k++]; p.c_w_out = in[k++];
    p.d_w_in = in[k++]; p.d_conv_w = in[k++]; p.d_conv_b = in[k++]; p.d_ga_w = in[k++]; p.d_ga_b = in[k++]; p.d_gx_w = in[k++]; p.d_gx_b = in[k++];
    p.d_lambda = in[k++]; p.d_w_out = in[k++];
    p.out = (float*)d_out; p.ws = (char*)d_ws;
#if !defined(CPU_SHIM) && !defined(MULTI_LAUNCH) && !defined(ALL_NAIVE)
    launch_mega(p, stream);
#else
    run_naive(p, stream);
#endif
}
```

```cpp
#ifndef CPU_SHIM
#include <hip/hip_runtime.h>
#include <hip/hip_cooperative_groups.h>
#include <cstdio>
#define HD __host__ __device__ __forceinline__
#else
#include <cmath>
#include <cstring>
#include <cstdio>
#include <cstdlib>
#include <cstdint>
#define HD inline
typedef void* hipStream_t;
#endif
#include <cstddef>

#ifndef CFG_B
#define CFG_B 4
#endif
#ifndef CFG_T
#define CFG_T 4096
#endif

namespace cfg {
constexpr int B = CFG_B, T = CFG_T, M = B * T, D = 1024;
constexpr int H = 16, G = 4, R = 4, DH = 64;
constexpr int A_COLS = 2560;
constexpr int C_COLS = 3632;
constexpr int NCMP = (T - 32) / 16 + 1;
constexpr int NSEL = T / 64;
constexpr int KTOP = NSEL < 16 ? NSEL : 16;
constexpr int LW = 1280;
}
using namespace cfg;

typedef unsigned short bf16;

HD unsigned f_as_u(float f) {
#ifndef CPU_SHIM
    return __float_as_uint(f);
#else
    unsigned u; memcpy(&u, &f, 4); return u;
#endif
}
HD float u_as_f(unsigned u) {
#ifndef CPU_SHIM
    return __uint_as_float(u);
#else
    float f; memcpy(&f, &u, 4); return f;
#endif
}
HD float bf2f(bf16 v) { return u_as_f(((unsigned)v) << 16); }
HD bf16 f2bf(float f) { unsigned u = f_as_u(f); u += 0x7fffu + ((u >> 16) & 1u); return (bf16)(u >> 16); }
HD float sigmoidf_(float x) { return 1.0f / (1.0f + expf(-x)); }
HD float siluf_(float x) { return x / (1.0f + expf(-x)); }
HD float softplusf_(float x) { return x > 20.f ? x : log1pf(expf(x)); }

HD int t5_bucket(int d) {
    if (d < 16) return d < 0 ? 0 : d;
    if (d >= 113) return 31;
    if (d >= 99) return 30;
    if (d >= 87) return 29;
    if (d >= 77) return 28;
    if (d >= 67) return 27;
    if (d >= 59) return 26;
    if (d >= 52) return 25;
    if (d >= 46) return 24;
    if (d >= 40) return 23;
    if (d >= 35) return 22;
    if (d >= 31) return 21;
    if (d >= 27) return 20;
    if (d >= 24) return 19;
    if (d >= 21) return 18;
    if (d >= 19) return 17;
    return 16;
}

struct Params {
    const float *x, *t5, *norm_g, *final_g;
    const float *a_w_in, *a_sinks, *a_w_out;
    const float *b_mu, *b_w_in, *b_w0, *b_w1, *b_w2, *b_a0, *b_a1, *b_a2, *b_k_k, *b_k_a, *b_r_k, *b_lnx_w, *b_lnx_b, *b_w_out;
    const float *c_w_in, *c_pos_k, *c_k_w1, *c_k_w2, *c_pos_v, *c_v_w1, *c_v_w2, *c_w_out;
    const float *d_w_in, *d_conv_w, *d_conv_b, *d_ga_w, *d_ga_b, *d_gx_w, *d_gx_b, *d_lambda, *d_w_out;
    float* out;
    char* ws;
};

namespace wsl {
constexpr size_t MB = 1024 * 1024;
constexpr size_t RS = 0;
constexpr size_t HK = 1 * MB;
constexpr size_t HV = 3 * MB;
constexpr size_t KC = 5 * MB;
constexpr size_t VC = 6 * MB;
constexpr size_t ST = 7 * MB;
constexpr size_t SEL = 9 * MB;
constexpr size_t LHW = 1 * MB;
constexpr size_t LHA = 5 * MB;
constexpr size_t P = 14 * MB;
constexpr size_t SZ1024 = (size_t)M * 1024 * 2, SZ1280 = (size_t)M * 1280 * 2;
constexpr size_t L0_AO = P + (size_t)M * 2560 * 2;
constexpr size_t L1_XN = P + (size_t)M * 4096 * 2, L1_WL = L1_XN + SZ1024, L1_AV = L1_WL + SZ1024;
constexpr size_t L2_AO = P + (size_t)M * 3632 * 2, L2_OC = L2_AO + SZ1024, L2_OS = L2_OC + SZ1024, L2_IMP = L2_OS + SZ1024;
constexpr size_t L3_AO = P + (size_t)M * 2560 * 2, L3_UC = L3_AO + SZ1280, L3_LA = L3_UC + SZ1280, L3_BV = L3_LA + SZ1280;
constexpr size_t TOTAL = L3_BV + SZ1280;
}

struct RstdF {
    const float* x; float* rs;
    HD void operator()(long m) const {
        const float* r = x + (size_t)m * D; float s = 0.f;
        for (int k = 0; k < D; ++k) s += r[k] * r[k];
        rs[m] = 1.0f / sqrtf(s / D + 1e-6f);
    }
};
struct XnF {
    const float* x; const float* rs; const float* g; bf16* xn;
    HD void operator()(long i) const { long m = i / D; int k = (int)(i % D); xn[i] = f2bf(x[i] * rs[m] * g[k]); }
};
struct GemmInF {
    const float *x, *rs, *g, *W; bf16* P; long long N;
    HD void operator()(long i) const {
        const int n4 = (int)N / 4; const long m = i / n4; const int n = (int)(i % n4) * 4;
        const float* xr = x + (size_t)m * D; const float r = rs[m];
        float a0 = 0, a1 = 0, a2 = 0, a3 = 0;
        for (int k = 0; k < D; ++k) {
            const float a = xr[k] * r * g[k]; const float* w = W + (size_t)k * N + n;
            a0 += a * w[0]; a1 += a * w[1]; a2 += a * w[2]; a3 += a * w[3];
        }
        bf16* p = P + (size_t)m * N + n; p[0] = f2bf(a0); p[1] = f2bf(a1); p[2] = f2bf(a2); p[3] = f2bf(a3);
    }
};
struct GemmOutF {
    const bf16* A; const float* W; const float* xin; float* xout; long long K;
    HD void operator()(long i) const {
        const int n4 = D / 4; const long m = i / n4; const int n = (int)(i % n4) * 4;
        const bf16* ar = A + (size_t)m * K;
        float a0 = 0, a1 = 0, a2 = 0, a3 = 0;
        for (int k = 0; k < K; ++k) {
            const float a = bf2f(ar[k]); const float* w = W + (size_t)k * D + n;
            a0 += a * w[0]; a1 += a * w[1]; a2 += a * w[2]; a3 += a * w[3];
        }
        const float* xi = xin + (size_t)m * D + n; float* xo = xout + (size_t)m * D + n;
        xo[0] = xi[0] + a0; xo[1] = xi[1] + a1; xo[2] = xi[2] + a2; xo[3] = xi[3] + a3;
    }
};

struct SwaF {
    const bf16* P; const float* t5; const float* sinks; bf16* AO;
    HD void operator()(long i) const {
        const long m = i / H; const int h = (int)(i % H), g = h / R; const int t = (int)(m % T); const long mb = m - t;
        float q[DH], o[DH];
#pragma unroll
        for (int d = 0; d < DH; ++d) { q[d] = bf2f(P[(size_t)m * A_COLS + h * DH + d]); o[d] = 0.f; }
        float mx = sinks[h], l = 1.0f;
        const int s0 = t - 127 < 0 ? 0 : t - 127;
        for (int s = s0; s <= t; ++s) {
            const bf16* kr = P + (size_t)(mb + s) * A_COLS + 1024 + g * DH;
            const bf16* vr = kr + 256;
            float sc = 0.f;
#pragma unroll
            for (int d = 0; d < DH; ++d) sc += q[d] * bf2f(kr[d]);
            sc = sc * 0.125f + t5[t5_bucket(t - s) * H + h];
            const float mn = sc > mx ? sc : mx; const float al = expf(mx - mn), p = expf(sc - mn);
            l = l * al + p; mx = mn;
#pragma unroll
            for (int d = 0; d < DH; ++d) o[d] = o[d] * al + p * bf2f(vr[d]);
        }
        const float il = 1.0f / l;
#pragma unroll
        for (int d = 0; d < DH; ++d) {
            const float z = bf2f(P[(size_t)m * A_COLS + 1536 + h * DH + d]);
            AO[(size_t)m * D + h * DH + d] = f2bf(o[d] * il * siluf_(z));
        }
    }
};

struct GemmRwkvF {
    const bf16* xn; const float* mu; const float* W; bf16* P;
    HD void operator()(long i) const {
        const int N = 4096, n4 = N / 4; const long m = i / n4; const int n = (int)(i % n4) * 4; const int s = n / 1024;
        const int t = (int)(m % T);
        const bf16* xr = xn + (size_t)m * D; const float* mus = mu + s * D;
        float a0 = 0, a1 = 0, a2 = 0, a3 = 0;
        for (int k = 0; k < D; ++k) {
            const float xc = bf2f(xr[k]); const float xp = t > 0 ? bf2f(xr[k - D]) : 0.f;
            const float a = xc + (xp - xc) * mus[k]; const float* w = W + (size_t)k * N + n;
            a0 += a * w[0]; a1 += a * w[1]; a2 += a * w[2]; a3 += a * w[3];
        }
        bf16* p = P + (size_t)m * N + n; p[0] = f2bf(a0); p[1] = f2bf(a1); p[2] = f2bf(a2); p[3] = f2bf(a3);
    }
};
struct LoraHidF {
    const bf16* xn; const float* mu; const float* w1; const float* a1; float* hw; float* ha;
    HD void operator()(long i) const {
        const long m = i / 128; const int jj = (int)(i % 128); const int which = jj / 64, j = jj % 64; const int t = (int)(m % T);
        const bf16* xr = xn + (size_t)m * D; const float* mus = mu + (4 + which) * D; const float* W = which ? a1 : w1;
        float acc = 0.f;
        for (int k = 0; k < D; ++k) {
            const float xc = bf2f(xr[k]); const float xp = t > 0 ? bf2f(xr[k - D]) : 0.f;
            acc += (xc + (xp - xc) * mus[k]) * W[(size_t)k * 64 + j];
        }
        if (which) ha[(size_t)m * 64 + j] = acc; else hw[(size_t)m * 64 + j] = tanhf(acc);
    }
};
struct LoraOutF {
    const float *hw, *ha, *w0, *w2, *a0, *a2; bf16* wlog; bf16* av;
    HD void operator()(long i) const {
        const long m = i / D; const int c = (int)(i % D);
        float sw = 0.f, sa = 0.f;
        for (int j = 0; j < 64; ++j) { sw += hw[(size_t)m * 64 + j] * w2[(size_t)j * D + c]; sa += ha[(size_t)m * 64 + j] * a2[(size_t)j * D + c]; }
        const float wr = -softplusf_(-(w0[c] + sw)) - 0.5f;
        wlog[i] = f2bf(-expf(wr)); av[i] = f2bf(sigmoidf_(a0[c] + sa));
    }
};
struct RwkvScanF {
    const bf16* P; const bf16* wlog; const bf16* av; const float* k_k; const float* k_a; bf16* ys;
    HD void operator()(long idx) const {
        const int i = (int)(idx % 64); const int h = (int)((idx / 64) % H); const int b = (int)(idx / (64 * H));
        float S[64];
#pragma unroll
        for (int j = 0; j < 64; ++j) S[j] = 0.f;
        for (int t = 0; t < T; ++t) {
            const size_t m = (size_t)b * T + t; const bf16* pr = P + m * 4096 + h * 64;
            const bf16* wl = wlog + m * D + h * 64; const bf16* ar = av + m * D + h * 64;
            float n2 = 0.f;
#pragma unroll
            for (int j = 0; j < 64; ++j) { const float kk = bf2f(pr[1024 + j]) * k_k[h * 64 + j]; n2 += kk * kk; }
            float nr = sqrtf(n2); nr = nr > 1e-12f ? nr : 1e-12f; const float inr = 1.0f / nr;
            float sa = 0.f;
#pragma unroll
            for (int j = 0; j < 64; ++j) { const float kk = bf2f(pr[1024 + j]) * k_k[h * 64 + j] * inr; sa += S[j] * (-kk); }
            const float vi = bf2f(pr[2048 + i]); float y = 0.f;
#pragma unroll
            for (int j = 0; j < 64; ++j) {
                const float kr = bf2f(pr[1024 + j]); const float a = bf2f(ar[j]);
                const float kk = kr * k_k[h * 64 + j] * inr; const float kp = kr * (1.0f + (a - 1.0f) * k_a[h * 64 + j]);
                const float dec = expf(bf2f(wl[j]));
                S[j] = S[j] * dec + sa * (kk * a) + vi * kp;
                y += S[j] * bf2f(pr[j]);
            }
            ys[m * D + h * 64 + i] = f2bf(y);
        }
    }
};
struct RwkvGnF {
    const bf16* P; const bf16* av; const float *k_a, *r_k, *lnx_w, *lnx_b; bf16* ys;
    HD void operator()(long idx) const {
        const long m = idx / H; const int h = (int)(idx % H);
        bf16* yr = ys + (size_t)m * D + h * 64; const bf16* pr = P + (size_t)m * 4096 + h * 64; const bf16* ar = av + (size_t)m * D + h * 64;
        float mean = 0.f;
        for (int j = 0; j < 64; ++j) mean += bf2f(yr[j]);
        mean /= 64.f; float var = 0.f;
        for (int j = 0; j < 64; ++j) { const float d = bf2f(yr[j]) - mean; var += d * d; }
        var /= 64.f; const float rstd = 1.0f / sqrtf(var + 64e-5f);
        float bs = 0.f;
        for (int j = 0; j < 64; ++j) { const float kr = bf2f(pr[1024 + j]); const float kp = kr * (1.0f + (bf2f(ar[j]) - 1.0f) * k_a[h * 64 + j]); bs += bf2f(pr[j]) * kp * r_k[h * 64 + j]; }
        for (int j = 0; j < 64; ++j) {
            const float yn = (bf2f(yr[j]) - mean) * rstd * lnx_w[h * 64 + j] + lnx_b[h * 64 + j];
            const float z = bf2f(pr[3072 + j]);
            yr[j] = f2bf((yn + bs * bf2f(pr[2048 + j])) * siluf_(z));
        }
    }
};

struct CmpHidF {
    const bf16* P; const float *pos_k, *w1_k, *pos_v, *w1_v; float* hk; float* hv;
    HD void operator()(long idx) const {
        const int j = (int)(idx % 128); long r = idx / 128; const int n = (int)(r % NCMP); r /= NCMP; const int g = (int)(r % G); r /= G;
        const int b = (int)(r % B); const int which = (int)(r / B);
        const float* pos = which ? pos_v : pos_k; const float* w1 = which ? w1_v : w1_k; const int col = 1024 + (which ? 256 : 0) + g * 64;
        float acc = 0.f;
        for (int l = 0; l < 32; ++l) {
            const bf16* src = P + (size_t)(b * T + 16 * n + l) * C_COLS + col;
            for (int d = 0; d < 64; ++d) acc += (bf2f(src[d]) + pos[l * 64 + d]) * w1[(size_t)(l * 64 + d) * 128 + j];
        }
        (which ? hv : hk)[(((size_t)b * G + g) * NCMP + n) * 128 + j] = siluf_(acc);
    }
};
struct CmpOutF {
    const float *hk, *hv, *w2_k, *w2_v; float* kc; float* vc;
    HD void operator()(long idx) const {
        const int d = (int)(idx % 64); long r = idx / 64; const long row = r % ((long)B * G * NCMP); const int which = (int)(r / ((long)B * G * NCMP));
        const float* hsrc = (which ? hv : hk) + (size_t)row * 128; const float* w2 = which ? w2_v : w2_k;
        float acc = 0.f;
        for (int j = 0; j < 128; ++j) acc += hsrc[j] * w2[j * 64 + d];
        (which ? vc : kc)[(size_t)row * 64 + d] = acc;
    }
};
struct CmpAttnF {
    const bf16* P; const float *kc, *vc; float* st; bf16* oc;
    HD void operator()(long i) const {
        const long m = i / H; const int h = (int)(i % H), g = h / R; const int t = (int)(m % T); const int b = (int)(m / T);
        float q[DH], o[DH];
#pragma unroll
        for (int d = 0; d < DH; ++d) { q[d] = bf2f(P[(size_t)m * C_COLS + h * DH + d]); o[d] = 0.f; }
        const int nv = t < 31 ? 0 : (t - 31) / 16 + 1;
        float mx = -1e30f, l = 0.f;
        for (int n = 0; n < nv; ++n) {
            const float* kr = kc + (((size_t)b * G + g) * NCMP + n) * 64; const float* vr = vc + (((size_t)b * G + g) * NCMP + n) * 64;
            float sc = 0.f;
#pragma unroll
            for (int d = 0; d < DH; ++d) sc += q[d] * kr[d];
            sc *= 0.125f;
            const float mn = sc > mx ? sc : mx; const float al = expf(mx - mn), p = expf(sc - mn);
            l = l * al + p; mx = mn;
#pragma unroll
            for (int d = 0; d < DH; ++d) o[d] = o[d] * al + p * vr[d];
        }
        const float il = nv > 0 ? 1.0f / l : 0.f;
        st[(size_t)i * 2] = mx; st[(size_t)i * 2 + 1] = il;
#pragma unroll
        for (int d = 0; d < DH; ++d) oc[(size_t)m * D + h * DH + d] = f2bf(o[d] * il);
    }
};
struct ImpF {
    const bf16* P; const float *kc, *st; float* imp;
    HD void operator()(long idx) const {
        const int s = (int)(idx % NSEL); long r = idx / NSEL; const int g = (int)(r % G); const long m = r / G;
        const int t = (int)(m % T); const int b = (int)(m / T); const int cur = t / 64;
        float v;
        if (s == 0 || s == cur || s == cur - 1) v = 1e30f;
        else if (s * 64 > t) v = -1e30f;
        else {
            v = 0.f; const int nv = t < 31 ? 0 : (t - 31) / 16 + 1;
            int n0 = 4 * s - 1; if (n0 < 0) n0 = 0; int n1 = 4 * s + 3; if (n1 > NCMP - 1) n1 = NCMP - 1; if (n1 > nv - 1) n1 = nv - 1;
            for (int rr = 0; rr < R; ++rr) {
                const int h = g * R + rr; const bf16* qr = P + (size_t)m * C_COLS + h * DH;
                const float mx = st[((size_t)m * H + h) * 2], il = st[((size_t)m * H + h) * 2 + 1];
                for (int n = n0; n <= n1; ++n) {
                    const float* kr = kc + (((size_t)b * G + g) * NCMP + n) * 64; float sc = 0.f;
                    for (int d = 0; d < DH; ++d) sc += bf2f(qr[d]) * kr[d];
                    v += expf(sc * 0.125f - mx) * il;
                }
            }
        }
        imp[idx] = v;
    }
};
struct TopkF {
    const float* imp; int* sel;
    HD void operator()(long idx) const {
        const float* v = imp + (size_t)idx * NSEL; unsigned long long used = 0ull;
        for (int j = 0; j < KTOP; ++j) {
            int best = -1; float bv = 0.f;
            for (int s = 0; s < NSEL; ++s) { if ((used >> s) & 1ull) continue; const float x = v[s]; if (best < 0 || x > bv) { best = s; bv = x; } }
            used |= 1ull << best; sel[(size_t)idx * 16 + j] = best;
        }
    }
};
struct SelAttnF {
    const bf16* P; const float* t5; const int* sel; bf16* os;
    HD void operator()(long i) const {
        const long m = i / H; const int h = (int)(i % H), g = h / R; const int t = (int)(m % T); const long mb = m - t;
        float q[DH], o[DH];
#pragma unroll
        for (int d = 0; d < DH; ++d) { q[d] = bf2f(P[(size_t)m * C_COLS + h * DH + d]); o[d] = 0.f; }
        float mx = -1e30f, l = 0.f;
        for (int j = 0; j < KTOP; ++j) {
            const int blk = sel[((size_t)m * G + g) * 16 + j];
            for (int ll = 0; ll < 64; ++ll) {
                const int s = blk * 64 + ll; if (s > t) break;
                const bf16* kr = P + (size_t)(mb + s) * C_COLS + 1536 + g * DH; const bf16* vr = kr + 256;
                float sc = 0.f;
#pragma unroll
                for (int d = 0; d < DH; ++d) sc += q[d] * bf2f(kr[d]);
                sc = sc * 0.125f + t5[t5_bucket(t - s) * H + h];
                const float mn = sc > mx ? sc : mx; const float al = expf(mx - mn), p = expf(sc - mn);
                l = l * al + p; mx = mn;
#pragma unroll
                for (int d = 0; d < DH; ++d) o[d] = o[d] * al + p * bf2f(vr[d]);
            }
        }
        const float il = 1.0f / l;
#pragma unroll
        for (int d = 0; d < DH; ++d) os[(size_t)m * D + h * DH + d] = f2bf(o[d] * il);
    }
};
struct WinAttnF {
    const bf16* P; const float* t5; const bf16* oc; const bf16* os; bf16* AO;
    HD void operator()(long i) const {
        const long m = i / H; const int h = (int)(i % H), g = h / R, rr = h % R; const int t = (int)(m % T); const long mb = m - t;
        float q[DH], o[DH];
#pragma unroll
        for (int d = 0; d < DH; ++d) { q[d] = bf2f(P[(size_t)m * C_COLS + h * DH + d]); o[d] = 0.f; }
        float mx = -1e30f, l = 0.f;
        const int s0 = t - 511 < 0 ? 0 : t - 511;
        for (int s = s0; s <= t; ++s) {
            const bf16* kr = P + (size_t)(mb + s) * C_COLS + 2048 + g * DH; const bf16* vr = kr + 256;
            float sc = 0.f;
#pragma unroll
            for (int d = 0; d < DH; ++d) sc += q[d] * bf2f(kr[d]);
            sc = sc * 0.125f + t5[t5_bucket(t - s) * H + h];
            const float mn = sc > mx ? sc : mx; const float al = expf(mx - mn), p = expf(sc - mn);
            l = l * al + p; mx = mn;
#pragma unroll
            for (int d = 0; d < DH; ++d) o[d] = o[d] * al + p * bf2f(vr[d]);
        }
        const float il = 1.0f / l;
        const bf16* gr = P + (size_t)m * C_COLS + 2560;
        const float g0 = sigmoidf_(bf2f(gr[0 * 16 + g * R + rr])), g1 = sigmoidf_(bf2f(gr[1 * 16 + g * R + rr])), g2 = sigmoidf_(bf2f(gr[2 * 16 + g * R + rr]));
#pragma unroll
        for (int d = 0; d < DH; ++d) {
            const size_t oi = (size_t)m * D + h * DH + d;
            const float z = bf2f(P[(size_t)m * C_COLS + 2608 + h * DH + d]);
            AO[oi] = f2bf((g0 * bf2f(oc[oi]) + g1 * bf2f(os[oi]) + g2 * o[d] * il) * siluf_(z));
        }
    }
};

struct ConvF {
    const bf16* P; const float *cw, *cb; bf16* uc;
    HD void operator()(long i) const {
        const long m = i / LW; const int c = (int)(i % LW); const int t = (int)(m % T);
        float acc = cb[c];
        for (int w = 0; w < 4; ++w) { const int tt = t - 3 + w; if (tt >= 0) acc += cw[w * LW + c] * bf2f(P[(size_t)(m - 3 + w) * 2560 + c]); }
        uc[i] = f2bf(acc);
    }
};
struct LruGateF {
    const bf16* uc; const float *gaw, *gab, *gxw, *gxb, *lam; bf16* la; bf16* bv;
    HD void operator()(long i) const {
        const long m = i / LW; const int c = (int)(i % LW); const int n = c / 80, d = c % 80;
        const bf16* ub = uc + (size_t)m * LW + n * 80; float ra = gab[c], rx = gxb[c];
        for (int k = 0; k < 80; ++k) { const float u = bf2f(ub[k]); ra += u * gaw[((size_t)n * 80 + k) * 80 + d]; rx += u * gxw[((size_t)n * 80 + k) * 80 + d]; }
        const float r = sigmoidf_(ra), ig = sigmoidf_(rx);
        const float loga = -8.0f * r * softplusf_(-lam[c]);
        la[i] = f2bf(loga);
        bv[i] = f2bf(sqrtf(-expm1f(2.0f * loga)) * (ig * bf2f(uc[i])));
    }
};
struct LruScanF {
    const bf16* P; const bf16* la; const bf16* bv; bf16* AO;
    HD void operator()(long idx) const {
        const int c = (int)(idx % LW); const int b = (int)(idx / LW); float h = 0.f;
        for (int t = 0; t < T; ++t) {
            const size_t m = (size_t)b * T + t;
            h = expf(bf2f(la[m * LW + c])) * h + bf2f(bv[m * LW + c]);
            AO[m * LW + c] = f2bf(h * siluf_(bf2f(P[m * 2560 + LW + c])));
        }
    }
};
struct FinalNormF {
    float* x; const float* g;
    HD void operator()(long m) const {
        float* r = x + (size_t)m * D; float s = 0.f;
        for (int k = 0; k < D; ++k) s += r[k] * r[k];
        const float rs = 1.0f / sqrtf(s / D + 1e-6f);
        for (int k = 0; k < D; ++k) r[k] = r[k] * rs * g[k];
    }
};


#ifndef CPU_SHIM
typedef short bf16x8 __attribute__((ext_vector_type(8)));
typedef float f32x4 __attribute__((ext_vector_type(4)));
typedef unsigned u32x4 __attribute__((ext_vector_type(4)));
typedef unsigned u32x2 __attribute__((ext_vector_type(2)));
#define DI __device__ __forceinline__
#define NTHREADS 256
__device__ __forceinline__ int opaque_tid() { int t = threadIdx.x; asm volatile("" : "+v"(t)); return t; }
#define TIDX (opaque_tid())

typedef __bf16 hbf16x2 __attribute__((ext_vector_type(2)));
typedef float f32x2 __attribute__((ext_vector_type(2)));
DI unsigned pack2bf(float lo, float hi) { f32x2 f = {lo, hi}; return __builtin_bit_cast(unsigned, __builtin_convertvector(f, hbf16x2)); }
DI float bflo(unsigned u) { return __uint_as_float(u << 16); }
DI float bfhi(unsigned u) { return __uint_as_float(u & 0xffff0000u); }

namespace fw {
constexpr size_t MB = 1024 * 1024;
constexpr size_t PARTS = 13 * MB;
constexpr size_t SMALLB = 1 * MB;
constexpr size_t WB = 14 * MB;
constexpr size_t XB = 30 * MB;
constexpr size_t BIG = 62 * MB;
}

DI void convert_tile(const float* __restrict__ W, int ldw, int c0, int K, bf16* __restrict__ Wt, const float* __restrict__ g, int kt, int nt, float* sm) {
    const int tid = TIDX;
    const int k0 = kt * 64, n0 = nt * 64;
#pragma unroll
    for (int i = 0; i < 4; ++i) {
        const int kr = (tid >> 4) + 16 * i; const int nc = (tid & 15) * 4;
        const float4 v = *(const float4*)(W + (size_t)(k0 + kr) * ldw + c0 + n0 + nc);
        const float s = g ? g[k0 + kr] : 1.0f;
        sm[kr * 65 + nc + 0] = v.x * s; sm[kr * 65 + nc + 1] = v.y * s; sm[kr * 65 + nc + 2] = v.z * s; sm[kr * 65 + nc + 3] = v.w * s;
    }
    __syncthreads();
    {
        const int n = tid >> 2, kq = (tid & 3) * 16;
        unsigned w[8];
#pragma unroll
        for (int j = 0; j < 8; ++j) w[j] = pack2bf(sm[(kq + 2 * j) * 65 + n], sm[(kq + 2 * j + 1) * 65 + n]);
        u32x4* dst = (u32x4*)(Wt + (size_t)(n0 + n) * K + k0 + kq);
        dst[0] = (u32x4){w[0], w[1], w[2], w[3]}; dst[1] = (u32x4){w[4], w[5], w[6], w[7]};
    }
    __syncthreads();
}
DI void convert_seg(const float* W, int ldw, int c0, int ncols, int K, bf16* Wt, const float* g, float* sm, int& tbase) {
    const int nkt = K / 64, nnt = ncols / 64, ntile = nkt * nnt;
    const int Gd = (int)gridDim.x;
    for (int t = (((int)blockIdx.x - tbase % Gd) + Gd) % Gd; t < ntile; t += Gd) convert_tile(W, ldw, c0, K, Wt, g, t % nkt, t / nkt, sm);
    tbase += ntile;
}

DI int perm32(int rho) { const int n = rho >> 4, i = rho & 15; return 8 * (i >> 2) + 4 * n + (i & 3); }

struct ALoadPlain {
    const bf16* A; int lda;
    static constexpr bool DMA = true;
    DI const bf16* src(int m, int k) const { return A + (size_t)m * lda + k; }
    struct Raw { u32x4 v; };
    DI Raw load(int m, int k) const { Raw r; r.v = *(const u32x4*)(A + (size_t)m * lda + k); return r; }
    DI u32x4 finish(const Raw& r, int, int) const { return r.v; }
};
struct ALoadLerp {
    const bf16* xn; const float* mu;
    static constexpr bool DMA = false;
    DI const bf16* src(int, int) const { return nullptr; }
    struct Raw { u32x4 c, p; };
    DI Raw load(int m, int k) const {
        Raw r; r.c = *(const u32x4*)(xn + (size_t)m * D + k);
        if ((m % T) != 0) r.p = *(const u32x4*)(xn + (size_t)(m - 1) * D + k); else r.p = (u32x4){0u, 0u, 0u, 0u};
        return r;
    }
    DI u32x4 finish(const Raw& r, int, int k) const {
        const float4 m0 = *(const float4*)(mu + k), m1 = *(const float4*)(mu + k + 4);
        const float mm[8] = {m0.x, m0.y, m0.z, m0.w, m1.x, m1.y, m1.z, m1.w};
        u32x4 o;
#pragma unroll
        for (int j = 0; j < 4; ++j) {
            const float c0 = bflo(r.c[j]), c1 = bfhi(r.c[j]), p0 = bflo(r.p[j]), p1 = bfhi(r.p[j]);
            o[j] = pack2bf(c0 + (p0 - c0) * mm[2 * j], c1 + (p1 - c1) * mm[2 * j + 1]);
        }
        return o;
    }
};

#define GLDS16(gp, lp) __builtin_amdgcn_global_load_lds((const unsigned*)(gp), (unsigned*)(lp), 16, 0, 0)
template <class AL, class Epi>
DI void gemm_tile(const AL& al, const bf16* __restrict__ Bt, int K, int m0, int n0, const Epi& epi, char* smem) {
    const int tid = TIDX, lane = tid & 63, wave = __builtin_amdgcn_readfirstlane(tid >> 6), wr = wave >> 1, wc = wave & 1, q = lane >> 4, l15 = lane & 15;
    const int srow = tid >> 3, sc = tid & 7, scs = sc ^ (srow & 7);
    const int st_off = srow * 128 + (sc << 4);
    const int dma_off = (8 * wave) * 128;
    int brow[4];
#pragma unroll
    for (int i = 0; i < 4; ++i) { const int rho = srow + 32 * i; brow[i] = n0 + (rho & ~31) + perm32(rho & 31); }
    const int fa0 = (wr * 64 + l15) * 128 + ((q ^ (lane & 7)) << 4);
    const int fb0 = (wc * 64 + l15) * 128 + ((q ^ (lane & 7)) << 4);
    f32x4 acc[4][4];
#pragma unroll
    for (int i = 0; i < 4; ++i)
#pragma unroll
        for (int j = 0; j < 4; ++j) acc[i][j] = (f32x4){0.f, 0.f, 0.f, 0.f};
    typename AL::Raw ra[4];
    const int nk = K / 64;
    {
        char* bufA = smem; char* bufB = smem + 16384;
#pragma unroll
        for (int i = 0; i < 4; ++i) {
            GLDS16(Bt + (size_t)brow[i] * K + scs * 8, bufB + dma_off + i * 4096);
            if (AL::DMA) GLDS16(al.src(m0 + srow + 32 * i, scs * 8), bufA + dma_off + i * 4096);
            else ra[i] = al.load(m0 + srow + 32 * i, scs * 8);
        }
        if (!AL::DMA) {
#pragma unroll
            for (int i = 0; i < 4; ++i) *(u32x4*)(bufA + st_off + i * 4096) = al.finish(ra[i], m0 + srow + 32 * i, scs * 8);
        }
    }
    asm volatile("s_waitcnt vmcnt(0)" ::: "memory");
    __syncthreads();
    for (int kt = 0; kt < nk; ++kt) {
        char* bufA = smem + (kt & 1) * 32768; char* bufB = bufA + 16384;
        char* nA = smem + ((kt + 1) & 1) * 32768; char* nB = nA + 16384;
        const bool more = kt + 1 < nk; const int kn = (kt + 1) * 64 + scs * 8;
        if (more) {
#pragma unroll
            for (int i = 0; i < 4; ++i) {
                GLDS16(Bt + (size_t)brow[i] * K + kn, nB + dma_off + i * 4096);
                if (AL::DMA) GLDS16(al.src(m0 + srow + 32 * i, kn), nA + dma_off + i * 4096);
                else ra[i] = al.load(m0 + srow + 32 * i, kn);
            }
        }
#pragma unroll
        for (int ks = 0; ks < 2; ++ks) {
            bf16x8 af[4], bfr[4];
#pragma unroll
            for (int i = 0; i < 4; ++i) {
                af[i] = *(const bf16x8*)(bufA + ((fa0 + i * 2048) ^ (ks << 6)));
                bfr[i] = *(const bf16x8*)(bufB + ((fb0 + i * 2048) ^ (ks << 6)));
            }
#pragma unroll
            for (int i = 0; i < 4; ++i)
#pragma unroll
                for (int j = 0; j < 4; ++j) acc[i][j] = __builtin_amdgcn_mfma_f32_16x16x32_bf16(bfr[j], af[i], acc[i][j], 0, 0, 0);
        }
        if (more && !AL::DMA) {
#pragma unroll
            for (int i = 0; i < 4; ++i) *(u32x4*)(nA + st_off + i * 4096) = al.finish(ra[i], m0 + srow + 32 * i, kn);
        }
        asm volatile("s_waitcnt vmcnt(0)" ::: "memory");
        __syncthreads();
    }
#pragma unroll
    for (int mt = 0; mt < 4; ++mt)
#pragma unroll
        for (int gi = 0; gi < 2; ++gi) {
            float v[8];
#pragma unroll
            for (int r = 0; r < 4; ++r) { v[r] = acc[mt][2 * gi][r]; v[4 + r] = acc[mt][2 * gi + 1][r]; }
            epi(m0 + wr * 64 + mt * 16 + l15, n0 + wc * 64 + gi * 32 + 8 * q, v, mt, gi);
        }
    epi.finish(m0, n0, wr, wc, lane);
}

constexpr int G2_STAGE = 24576;
template <class AL, class Epi>
DI void gemm_tile2(const AL& al, const bf16* __restrict__ Bt, int K, int m0, int n0, const Epi& epi, char* smem) {
    const int tid = TIDX, lane = tid & 63, wave = __builtin_amdgcn_readfirstlane(tid >> 6), wr = wave >> 1, wc = wave & 1, q = lane >> 4, l15 = lane & 15;
    const int prow = tid >> 2, ppos = tid & 3, ca = (ppos - 2 * ((tid >> 4) & 3)) & 3;
    const int dma_off = wave * 1024;
    int brow[4];
#pragma unroll
    for (int i = 0; i < 4; ++i) { const int rho = prow + 64 * i; brow[i] = n0 + (rho & ~31) + perm32(rho & 31); }
    const int fpos = ((q + 2 * ((l15 >> 2) & 3)) & 3) << 4;
    const int fa0 = (wr * 64 + l15) * 64 + fpos, fb0 = 8192 + (wc * 128 + l15) * 64 + fpos;
    f32x4 acc[4][8];
#pragma unroll
    for (int i = 0; i < 4; ++i)
#pragma unroll
        for (int j = 0; j < 8; ++j) acc[i][j] = (f32x4){0.f, 0.f, 0.f, 0.f};
    typename AL::Raw ra[2];
    const int nk = K / 32;
#define G2_ISSUE(kt_) { char* st_ = smem + ((kt_) % 3) * G2_STAGE; const int kk_ = (kt_) * 32 + ca * 8; \
        _Pragma("unroll") for (int i = 0; i < 2; ++i) { if (AL::DMA) GLDS16(al.src(m0 + prow + 64 * i, kk_), st_ + dma_off + i * 4096); else ra[i] = al.load(m0 + prow + 64 * i, kk_); } \
        _Pragma("unroll") for (int i = 0; i < 4; ++i) GLDS16(Bt + (size_t)brow[i] * K + kk_, st_ + 8192 + dma_off + i * 4096); }
#define G2_AWRITE(kt_) { if (!AL::DMA) { char* st_ = smem + ((kt_) % 3) * G2_STAGE; const int kk_ = (kt_) * 32 + ca * 8; \
        _Pragma("unroll") for (int i = 0; i < 2; ++i) *(u32x4*)(st_ + (prow + 64 * i) * 64 + ppos * 16) = al.finish(ra[i], m0 + prow + 64 * i, kk_); } }
#define G2_BARRIER() { asm volatile("s_waitcnt lgkmcnt(0)" ::: "memory"); __builtin_amdgcn_s_barrier(); asm volatile("" ::: "memory"); }
    G2_ISSUE(0); G2_AWRITE(0);
    if (nk > 1) { G2_ISSUE(1); G2_AWRITE(1); }
    if (nk > 1) { if (AL::DMA) asm volatile("s_waitcnt vmcnt(6)" ::: "memory"); else asm volatile("s_waitcnt vmcnt(4)" ::: "memory"); } else asm volatile("s_waitcnt vmcnt(0)" ::: "memory");
    G2_BARRIER();
    for (int kt = 0; kt < nk; ++kt) {
        const char* st = smem + (kt % 3) * G2_STAGE;
        const bool more = kt + 2 < nk;
        if (more) G2_ISSUE(kt + 2);
        bf16x8 af[4];
#pragma unroll
        for (int i = 0; i < 4; ++i) af[i] = *(const bf16x8*)(st + fa0 + i * 1024);
#pragma unroll
        for (int j = 0; j < 8; ++j) {
            const bf16x8 bf_ = *(const bf16x8*)(st + fb0 + j * 1024);
#pragma unroll
            for (int i = 0; i < 4; ++i) acc[i][j] = __builtin_amdgcn_mfma_f32_16x16x32_bf16(bf_, af[i], acc[i][j], 0, 0, 0);
        }
        if (more) G2_AWRITE(kt + 2);
        if (more) { if (AL::DMA) asm volatile("s_waitcnt vmcnt(6)" ::: "memory"); else asm volatile("s_waitcnt vmcnt(4)" ::: "memory"); } else asm volatile("s_waitcnt vmcnt(0)" ::: "memory");
        G2_BARRIER();
    }
#undef G2_ISSUE
#undef G2_AWRITE
#undef G2_BARRIER
#pragma unroll
    for (int mt = 0; mt < 4; ++mt)
#pragma unroll
        for (int gi = 0; gi < 4; ++gi) {
            float v[8];
#pragma unroll
            for (int r = 0; r < 4; ++r) { v[r] = acc[mt][2 * gi][r]; v[4 + r] = acc[mt][2 * gi + 1][r]; }
            epi(m0 + wr * 64 + mt * 16 + l15, n0 + wc * 128 + gi * 32 + 8 * q, v, mt, gi);
        }
    epi.finish_wide(m0, n0, wr, wc, lane);
}
template <class F>
DI void gemm_sched(int nbig, int nsmall, F&& f) {
    const int x = blockIdx.x & 7, lb = blockIdx.x >> 3, nlb = gridDim.x >> 3;
    const int nb16 = 16 * nbig, tot = 16 * (nbig + nsmall);
    for (int s = lb; s < tot; s += nlb) {
        if (s < nb16) f(true, x * 16 + (s & 15), s >> 4);
        else { const int t = s - nb16; f(false, x * 16 + (t & 15), t >> 4); }
    }
}

DI float rstd_from_parts(const float* parts, int m) {
    const float4* p = (const float4*)(parts + (size_t)m * 16); float s = 0.f;
#pragma unroll
    for (int i = 0; i < 4; ++i) { const float4 v = p[i]; s += (v.x + v.y) + (v.z + v.w); }
    return 1.0f / sqrtf(s * (1.0f / D) + 1e-6f);
}
DI void store8bf(bf16* p, const float* v) { *(u32x4*)p = (u32x4){pack2bf(v[0], v[1]), pack2bf(v[2], v[3]), pack2bf(v[4], v[5]), pack2bf(v[6], v[7])}; }

struct EpiBf16 {
    bf16* P; int ldp; const float* parts; mutable float rsc[4];
    DI void operator()(int m, int n, const float* v, int mt, int gi) const {
        if (gi == 0) rsc[mt] = parts ? rstd_from_parts(parts, m) : 1.0f;
        float s = rsc[mt]; float w[8];
#pragma unroll
        for (int j = 0; j < 8; ++j) w[j] = v[j] * s;
        store8bf(P + (size_t)m * ldp + n, w);
    }
    DI void finish(int, int, int, int, int) const {}
    DI void finish_wide(int, int, int, int, int) const {}
};
struct EpiResid {
    const float* xin; float* xout; bf16* xb; float* parts; mutable float sq[4];
    DI void operator()(int m, int n, const float* v, int mt, int gi) const {
        const float4* xi = (const float4*)(xin + (size_t)m * D + n); const float4 a = xi[0], b = xi[1];
        float w[8] = {a.x + v[0], a.y + v[1], a.z + v[2], a.w + v[3], b.x + v[4], b.y + v[5], b.z + v[6], b.w + v[7]};
        float4* xo = (float4*)(xout + (size_t)m * D + n);
        xo[0] = make_float4(w[0], w[1], w[2], w[3]); xo[1] = make_float4(w[4], w[5], w[6], w[7]);
        if (xb) store8bf(xb + (size_t)m * D + n, w);
        float s = 0.f;
#pragma unroll
        for (int j = 0; j < 8; ++j) s += w[j] * w[j];
        if (gi == 0) sq[mt] = s; else sq[mt] += s;
    }
    DI void finish(int m0, int n0, int wr, int wc, int lane) const {
#pragma unroll
        for (int mt = 0; mt < 4; ++mt) {
            float s = sq[mt]; s += __shfl_xor(s, 16); s += __shfl_xor(s, 32);
            if (lane < 16) parts[(size_t)(m0 + wr * 64 + mt * 16 + lane) * 16 + (n0 >> 7) * 2 + wc] = s;
        }
    }
    DI void finish_wide(int m0, int n0, int wr, int wc, int lane) const {
#pragma unroll
        for (int mt = 0; mt < 4; ++mt) {
            float s = sq[mt]; s += __shfl_xor(s, 16); s += __shfl_xor(s, 32);
            if (lane < 16) { float* pr = parts + (size_t)(m0 + wr * 64 + mt * 16 + lane) * 16 + (n0 >> 7) + wc; pr[0] = s; pr[8] = 0.f; }
        }
    }
};
struct EpiRwkv {
    bf16* P; float* hw; float* ha;
    DI void operator()(int m, int n, const float* v, int, int) const {
        if (n < 4096) { store8bf(P + (size_t)m * 4096 + n, v); return; }
        const int c = n - 4096;
        if (c < 64) { float4* o = (float4*)(hw + (size_t)m * 64 + c); o[0] = make_float4(tanhf(v[0]), tanhf(v[1]), tanhf(v[2]), tanhf(v[3])); o[1] = make_float4(tanhf(v[4]), tanhf(v[5]), tanhf(v[6]), tanhf(v[7])); }
        else if (c >= 128 && c < 192) { float4* o = (float4*)(ha + (size_t)m * 64 + (c - 128)); o[0] = make_float4(v[0], v[1], v[2], v[3]); o[1] = make_float4(v[4], v[5], v[6], v[7]); }
    }
    DI void finish(int, int, int, int, int) const {}
    DI void finish_wide(int, int, int, int, int) const {}
};

namespace at {
constexpr int OFF_BIAS = 49152;
constexpr int OFF_X = 61952;
constexpr int OFF_IMP = 49152;
constexpr float L2E = 1.4426950408889634f;
constexpr float NEG_MASK = -1e30f, M_INIT = -1e20f;
}
enum { AM_SWA = 0, AM_WIN = 1, AM_CMP = 2, AM_SEL = 3 };
DI int vt_perm(int k32) { return ((k32 & 15) >> 2) * 8 + (k32 >> 4) * 4 + (k32 & 3); }
DI float fast_exp2(float x) { return __builtin_amdgcn_exp2f(x); }

DI void build_bias_lut(const float* __restrict__ t5, char* smem, bool swa) {
    float* lut = (float*)(smem + at::OFF_BIAS);
    for (int i = TIDX; i < 16 * 200; i += NTHREADS) {
        const int h = i / 200, e = i % 200; float v = at::NEG_MASK;
        if (e >= 64 && e < 192) v = t5[t5_bucket(e - 64) * 16 + h] * at::L2E;
        else if (e >= 192 && !swa) v = t5[31 * 16 + h] * at::L2E;
        lut[i] = v;
    }
    __syncthreads();
}

template <int NQT> struct AttnStateT { f32x4 o[NQT][4]; f32x4 lacc[NQT]; float m[NQT]; };
#ifndef ANQT_SWA
#define ANQT_SWA 4
#endif
#ifndef ANQT_WIN
#define ANQT_WIN 2
#endif
#ifndef ANQT_SEL
#define ANQT_SEL 4
#endif
DI unsigned long long range_mask(int lo, int hi) { return (hi >= 63 ? ~0ull : ((1ull << (hi + 1)) - 1ull)) & ~((1ull << lo) - 1ull); }

template <int NQT>
DI void attn_load_q(bf16x8 (&qf)[NQT][2], const bf16* __restrict__ Qp, int ldq, size_t mbase, int hbase) {
    const int lane = TIDX & 63, wave = TIDX >> 6, q = lane >> 4, l15 = lane & 15;
#pragma unroll
    for (int qt = 0; qt < NQT; ++qt) {
        const size_t m = mbase + wave * (4 * NQT) + qt * 4 + (l15 >> 2);
#pragma unroll
        for (int ks = 0; ks < 2; ++ks) qf[qt][ks] = *(const bf16x8*)(Qp + m * ldq + (hbase + (l15 & 3)) * 64 + ks * 32 + q * 8);
    }
}

enum { SK_FAR = 0, SK_NEAR = 1, SK_EDGE = 2, SK_CMP = 3 };
template <int KIND>
DI float attn_fix(f32x4 (&s)[4], int dbase, float cadd, const float* __restrict__ bl, float mx) {
#pragma unroll
    for (int kt = 0; kt < 4; ++kt)
#pragma unroll
        for (int r = 0; r < 4; ++r) {
            float v = s[kt][r]; const int dist = dbase - (kt * 16 + r);
            if (KIND == SK_NEAR) { int idx = dist + 64; idx = idx < 0 ? 0 : (idx > 192 ? 192 : idx); v += bl[idx] + cadd; }
            else if (KIND == SK_EDGE) v = dist < 512 ? v + cadd : at::NEG_MASK;
            else if (KIND == SK_CMP) v = dist >= 0 ? v : at::NEG_MASK;
            if (KIND != SK_FAR) s[kt][r] = v;
            mx = fmaxf(mx, v);
        }
    return mx;
}
template <int MODE, int NQT>
DI void attn_blocks(AttnStateT<NQT>& st, const bf16x8 (&qf)[NQT][2], const bf16* __restrict__ Kp, size_t krs, const bf16* __restrict__ Vp, size_t vrs,
                    int t0, unsigned long long todo, int hbase, const unsigned long long (&sel)[NQT], char* smem) {
    const int tid = TIDX, lane = tid & 63, wave = __builtin_amdgcn_readfirstlane(tid >> 6), q = lane >> 4, l15 = lane & 15;
    const int tq0 = t0 + wave * (4 * NQT) + (l15 >> 2);
    const float* bl = (const float*)(smem + at::OFF_BIAS) + (hbase + (l15 & 3)) * 200;
    const float bfar = (MODE != AM_CMP) ? bl[192] : 0.f;
    const int srow = tid >> 3, scs = (tid & 7) ^ (srow & 7);
    const int fo = l15 * 128 + ((q ^ (l15 & 7)) << 4);
#define ATT_DMA(kb_, slot_) { _Pragma("unroll") for (int i = 0; i < 2; ++i) { const int row = srow + 32 * i; char* dst = smem + (slot_) * 16384 + (8 * wave + 32 * i) * 128; \
        GLDS16(Kp + (size_t)((kb_) * 64 + row) * krs + scs * 8, dst); GLDS16(Vp + (size_t)row * vrs + (kb_) * 64 + scs * 8, dst + 8192); } }
#define ATT_BARRIER() { asm volatile("s_waitcnt lgkmcnt(0)" ::: "memory"); __builtin_amdgcn_s_barrier(); asm volatile("" ::: "memory"); }
    if (todo == 0ull) return;
    int kb = __builtin_ctzll(todo); todo &= todo - 1ull;
    int kb1 = -1; if (todo) { kb1 = __builtin_ctzll(todo); todo &= todo - 1ull; }
    ATT_DMA(kb, 0);
    if (kb1 >= 0) { ATT_DMA(kb1, 1); asm volatile("s_waitcnt vmcnt(4)" ::: "memory"); } else { asm volatile("s_waitcnt vmcnt(0)" ::: "memory"); }
    ATT_BARRIER();
    int slot = 0;
    for (;;) {
        char* buf = smem + slot * 16384;
        int kb2 = -1; if (todo) { kb2 = __builtin_ctzll(todo); todo &= todo - 1ull; }
        if (kb2 >= 0) { const int s2 = slot >= 1 ? slot - 1 : 2; ATT_DMA(kb2, s2); }
        f32x4 s[NQT][4];
#pragma unroll
        for (int qt = 0; qt < NQT; ++qt)
#pragma unroll
            for (int kt = 0; kt < 4; ++kt) s[qt][kt] = (f32x4){0.f, 0.f, 0.f, 0.f};
#pragma unroll
        for (int kt = 0; kt < 4; ++kt)
#pragma unroll
            for (int ks = 0; ks < 2; ++ks) {
                const bf16x8 kf = *(const bf16x8*)(buf + ((fo + kt * 2048) ^ (ks << 6)));
#pragma unroll
                for (int qt = 0; qt < NQT; ++qt) s[qt][kt] = __builtin_amdgcn_mfma_f32_16x16x32_bf16(kf, qf[qt][ks], s[qt][kt], 0, 0, 0);
            }
        const int mind = (t0 + wave * (4 * NQT)) - (kb * 64 + 63), maxd = (t0 + wave * (4 * NQT) + 4 * NQT - 1) - kb * 64;
        float mx[NQT], cofs[NQT];
#pragma unroll
        for (int qt = 0; qt < NQT; ++qt) cofs[qt] = 0.f;
        if (MODE == AM_CMP) {
#pragma unroll
            for (int qt = 0; qt < NQT; ++qt) { const int nlim = (tq0 + 4 * qt - 31) >> 4; mx[qt] = attn_fix<SK_CMP>(s[qt], nlim - (kb * 64 + 4 * q), 0.f, bl, at::NEG_MASK); }
        } else {
            float cadd[NQT];
#pragma unroll
            for (int qt = 0; qt < NQT; ++qt) cadd[qt] = (MODE == AM_SEL && !((sel[qt] >> kb) & 1ull)) ? at::NEG_MASK : 0.f;
            if (MODE == AM_SWA || mind < 113) {
#pragma unroll
                for (int qt = 0; qt < NQT; ++qt) mx[qt] = attn_fix<SK_NEAR>(s[qt], tq0 + 4 * qt - (kb * 64 + 4 * q), cadd[qt], bl, at::NEG_MASK);
            } else if (MODE == AM_WIN && maxd >= 512) {
#pragma unroll
                for (int qt = 0; qt < NQT; ++qt) mx[qt] = attn_fix<SK_EDGE>(s[qt], tq0 + 4 * qt - (kb * 64 + 4 * q), bfar, bl, at::NEG_MASK);
            } else {
#pragma unroll
                for (int qt = 0; qt < NQT; ++qt) { cofs[qt] = bfar + cadd[qt]; mx[qt] = attn_fix<SK_FAR>(s[qt], 0, 0.f, bl, at::NEG_MASK) + cofs[qt]; }
            }
        }
        float msub[NQT]; bool grow = false;
#pragma unroll
        for (int qt = 0; qt < NQT; ++qt) {
            float m2 = mx[qt];
            m2 = fmaxf(m2, __shfl_xor(m2, 16)); m2 = fmaxf(m2, __shfl_xor(m2, 32));
            const bool g = m2 > st.m[qt] + 4.0f; grow |= g;
            mx[qt] = g ? m2 : st.m[qt];
            msub[qt] = mx[qt] - cofs[qt];
        }
        if (__any(grow)) {
#pragma unroll
            for (int qt = 0; qt < NQT; ++qt) {
                const float alpha = fast_exp2(st.m[qt] - mx[qt]);
#pragma unroll
                for (int dt = 0; dt < 4; ++dt) st.o[qt][dt] *= alpha;
                st.lacc[qt] *= alpha;
            }
        }
#pragma unroll
        for (int qt = 0; qt < NQT; ++qt) st.m[qt] = mx[qt];
#pragma unroll
        for (int qt = 0; qt < NQT; ++qt)
#pragma unroll
            for (int kt = 0; kt < 4; ++kt)
#pragma unroll
                for (int r = 0; r < 4; ++r) s[qt][kt][r] = fast_exp2(s[qt][kt][r] - msub[qt]);
        const bf16x8 ones = {(short)0x3F80, (short)0x3F80, (short)0x3F80, (short)0x3F80, (short)0x3F80, (short)0x3F80, (short)0x3F80, (short)0x3F80};
#pragma unroll
        for (int kp = 0; kp < 2; ++kp) {
            bf16x8 pf[NQT];
#pragma unroll
            for (int qt = 0; qt < NQT; ++qt) {
                const u32x4 w = {pack2bf(s[qt][2 * kp][0], s[qt][2 * kp][1]), pack2bf(s[qt][2 * kp][2], s[qt][2 * kp][3]),
                                 pack2bf(s[qt][2 * kp + 1][0], s[qt][2 * kp + 1][1]), pack2bf(s[qt][2 * kp + 1][2], s[qt][2 * kp + 1][3])};
                pf[qt] = __builtin_bit_cast(bf16x8, w);
            }
#pragma unroll
            for (int qt = 0; qt < NQT; ++qt) st.lacc[qt] = __builtin_amdgcn_mfma_f32_16x16x32_bf16(ones, pf[qt], st.lacc[qt], 0, 0, 0);
#pragma unroll
            for (int dt = 0; dt < 4; ++dt) {
                const bf16x8 vf = *(const bf16x8*)(buf + 8192 + ((fo + dt * 2048) ^ (kp << 6)));
#pragma unroll
                for (int qt = 0; qt < NQT; ++qt) st.o[qt][dt] = __builtin_amdgcn_mfma_f32_16x16x32_bf16(vf, pf[qt], st.o[qt][dt], 0, 0, 0);
            }
        }
        if (kb1 < 0) break;
        if (kb2 >= 0) { asm volatile("s_waitcnt vmcnt(4)" ::: "memory"); } else { asm volatile("s_waitcnt vmcnt(0)" ::: "memory"); }
        ATT_BARRIER();
        kb = kb1; kb1 = kb2; slot = slot == 2 ? 0 : slot + 1;
    }
    ATT_BARRIER();
#undef ATT_DMA
}
template <int NQT>
DI void attn_init(AttnStateT<NQT>& st, float m0, float l0) {
#pragma unroll
    for (int qt = 0; qt < NQT; ++qt) { st.m[qt] = m0; st.lacc[qt] = (f32x4){l0, l0, l0, l0};
#pragma unroll
        for (int dt = 0; dt < 4; ++dt) st.o[qt][dt] = (f32x4){0.f, 0.f, 0.f, 0.f}; }
}
DI float attn_linv(const f32x4& lacc) { const float l = lacc[0]; return l > 0.f ? 1.0f / l : 0.f; }

template <int TT>
DI void attn_item_decode(int item, int& b, int& g, int& t0) {
    constexpr int tiles = T / TT;
    const int Gd = (int)gridDim.x;
    int pair, tile;
    if ((Gd % tiles) == 0 && tiles * B * G % Gd == 0) {
        const int bid = item % Gd, rr = item / Gd, tau = bid % tiles;
        pair = bid / tiles + (Gd / tiles) * rr; tile = (rr & 1) ? tiles - 1 - tau : tau;
    } else { tile = item % tiles; pair = item / tiles; }
    t0 = tile * TT; g = pair % G; b = pair / G;
}
DI void swa_item(const bf16* __restrict__ P0, const bf16* __restrict__ VT, const float* __restrict__ sinks, bf16* __restrict__ AO, int item, char* smem) {
    constexpr int LDP = 2304;
    constexpr int NQT = ANQT_SWA;
    int b, g, t0; attn_item_decode<16 * NQT>(item, b, g, t0);
    const int lane = TIDX & 63, wave = TIDX >> 6, q = lane >> 4, l15 = lane & 15;
    const size_t mbase = (size_t)b * T + t0; const int hbase = g * 4, h = hbase + (l15 & 3);
    bf16x8 qf[NQT][2]; attn_load_q<NQT>(qf, P0, LDP, mbase, hbase);
    AttnStateT<NQT> st; attn_init<NQT>(st, sinks[h] * at::L2E, 1.0f);
    const int lo = t0 - 127 < 0 ? 0 : (t0 - 127) >> 6, hi = (t0 + 16 * NQT - 1) >> 6;
    const unsigned long long nosel[NQT] = {};
    attn_blocks<AM_SWA, NQT>(st, qf, P0 + (size_t)b * T * LDP + 1024 + g * 64, LDP, VT + (size_t)(b * G + g) * 64 * T, T, t0, range_mask(lo, hi), hbase, nosel, smem);
#pragma unroll
    for (int qt = 0; qt < NQT; ++qt) {
        const float li = attn_linv(st.lacc[qt]); const size_t m = mbase + wave * (4 * NQT) + qt * 4 + (l15 >> 2);
#pragma unroll
        for (int dt = 0; dt < 4; ++dt) {
            const int d0 = dt * 16 + 4 * q; const u32x2 zz = *(const u32x2*)(P0 + m * LDP + 1280 + h * 64 + d0);
            const float z0 = bflo(zz[0]), z1 = bfhi(zz[0]), z2 = bflo(zz[1]), z3 = bfhi(zz[1]);
            const f32x4 o = st.o[qt][dt];
            *(u32x2*)(AO + m * D + h * 64 + d0) = (u32x2){pack2bf(o[0] * li * siluf_(z0), o[1] * li * siluf_(z1)), pack2bf(o[2] * li * siluf_(z2), o[3] * li * siluf_(z3))};
        }
    }
}

struct EpiL0 {
    bf16* P0; bf16* VT; const float* parts; mutable float rsc[4];
    DI void operator()(int m, int n, const float* v, int mt, int gi) const {
        if (gi == 0) rsc[mt] = rstd_from_parts(parts, m);
        float s = rsc[mt]; if (n < 1024) s *= 0.125f * at::L2E; float w[8];
#pragma unroll
        for (int j = 0; j < 8; ++j) w[j] = v[j] * s;
        if (n < 1280) store8bf(P0 + (size_t)m * 2304 + n, w);
        else if (n >= 1536) store8bf(P0 + (size_t)m * 2304 + n - 256, w);
        else {
            const int g = (n - 1280) >> 6, d = (n - 1280) & 63, b = m / T, t = m % T; const int pos = (t & ~31) + vt_perm(t & 31);
            bf16* dst = VT + ((size_t)(b * G + g) * 64 + d) * T + pos;
#pragma unroll
            for (int j = 0; j < 8; ++j) dst[(size_t)j * T] = f2bf(w[j]);
        }
    }
    DI void finish(int, int, int, int, int) const {}
    DI void finish_wide(int, int, int, int, int) const {}
};

constexpr int LDP2 = 3200;
struct EpiL2 {
    bf16* P2; bf16* VTs; bf16* VTw; const float* parts; mutable float rsc[4];
    DI void operator()(int m, int n, const float* v, int mt, int gi) const {
        if (gi == 0) rsc[mt] = rstd_from_parts(parts, m);
        if (n >= C_COLS) return;
        float s = rsc[mt]; if (n < 1024) s *= 0.125f * at::L2E; float w[8];
#pragma unroll
        for (int j = 0; j < 8; ++j) w[j] = v[j] * s;
        const bool isvs = n >= 1792 && n < 2048, isvw = n >= 2304 && n < 2560;
        if (isvs || isvw) {
            const int c = n - (isvs ? 1792 : 2304); const int g = c >> 6, d = c & 63, b = m / T, t = m % T; const int pos = (t & ~31) + vt_perm(t & 31);
            bf16* dst = (isvs ? VTs : VTw) + ((size_t)(b * G + g) * 64 + d) * T + pos;
#pragma unroll
            for (int j = 0; j < 8; ++j) dst[(size_t)j * T] = f2bf(w[j]);
        } else {
            const int c = n < 1792 ? n : (n < 2304 ? n - 256 : n - 512);
            store8bf(P2 + (size_t)m * LDP2 + c, w);
        }
    }
    DI void finish(int, int, int, int, int) const {}
    DI void finish_wide(int, int, int, int, int) const {}
};

struct ALoadCmp {
    const bf16* P2; int col;
    static constexpr bool DMA = true;
    DI const bf16* src(int row, int k) const {
        int n = row & 255; const int bg = row >> 8, b = bg >> 2, g = bg & 3; const int l = k >> 6, d = k & 63; n = n < NCMP ? n : NCMP - 1;
        return P2 + (size_t)(b * T + 16 * n + l) * LDP2 + col + g * 64 + d;
    }
    struct Raw { u32x4 v; };
    DI Raw load(int row, int k) const {
        const int n = row & 255, bg = row >> 8, b = bg >> 2, g = bg & 3; const int l = k >> 6, d = k & 63; Raw r;
        if (n < NCMP) r.v = *(const u32x4*)(P2 + (size_t)(b * T + 16 * n + l) * LDP2 + col + g * 64 + d); else r.v = (u32x4){0u, 0u, 0u, 0u};
        return r;
    }
    DI u32x4 finish(const Raw& r, int, int) const { return r.v; }
};
struct EpiCmpH {
    char* smem; const float* bias8;
    DI void operator()(int m, int n, const float* v, int, int) const {
        const int row = m & 127; float w[8];
#pragma unroll
        for (int j = 0; j < 8; ++j) { float bsum = 0.f;
#pragma unroll
            for (int i = 0; i < 8; ++i) bsum += bias8[i * 128 + n + j];
            w[j] = siluf_(v[j] + bsum); }
        const int kk = n >> 6, c = (n & 63) >> 3;
        *(u32x4*)(smem + kk * 16384 + row * 128 + ((c ^ (row & 7)) << 4)) = (u32x4){pack2bf(w[0], w[1]), pack2bf(w[2], w[3]), pack2bf(w[4], w[5]), pack2bf(w[6], w[7])};
    }
    DI void finish(int, int, int, int, int) const {}
    DI void finish_wide(int, int, int, int, int) const {}
};
DI void cmp_tile(const bf16* __restrict__ P2, const bf16* __restrict__ w1t, const float* __restrict__ bias8, const bf16* __restrict__ w2t, int which, int rt,
                 bf16* __restrict__ KCb, bf16* __restrict__ VCT, char* smem) {
    gemm_tile(ALoadCmp{P2, which ? 1280 : 1024}, w1t, 2048, rt * 128, 0, EpiCmpH{smem, bias8}, smem);
    const int tid = TIDX, lane = tid & 63, wave = tid >> 6, q = lane >> 4, l15 = lane & 15;
#pragma unroll
    for (int i = 0; i < 4; ++i) {
        const int id = i * 256 + tid; const int row = id >> 4, c16 = id & 15, kk = c16 >> 3, c = c16 & 7;
        *(u32x4*)(smem + 32768 + kk * 8192 + row * 128 + ((c ^ (row & 7)) << 4)) = *(const u32x4*)(w2t + (size_t)row * 128 + c16 * 8);
    }
    __syncthreads();
    f32x4 acc[2][4];
#pragma unroll
    for (int i = 0; i < 2; ++i)
#pragma unroll
        for (int j = 0; j < 4; ++j) acc[i][j] = (f32x4){0.f, 0.f, 0.f, 0.f};
    const int fo = l15 * 128 + ((q ^ (l15 & 7)) << 4);
#pragma unroll
    for (int kk = 0; kk < 2; ++kk)
#pragma unroll
        for (int ks = 0; ks < 2; ++ks) {
            bf16x8 hf[2], wf[4];
#pragma unroll
            for (int i = 0; i < 2; ++i) hf[i] = *(const bf16x8*)(smem + kk * 16384 + (((wave * 32 + i * 16) * 128 + fo) ^ (ks << 6)));
#pragma unroll
            for (int j = 0; j < 4; ++j) wf[j] = *(const bf16x8*)(smem + 32768 + kk * 8192 + ((j * 2048 + fo) ^ (ks << 6)));
#pragma unroll
            for (int i = 0; i < 2; ++i)
#pragma unroll
                for (int j = 0; j < 4; ++j) acc[i][j] = __builtin_amdgcn_mfma_f32_16x16x32_bf16(wf[j], hf[i], acc[i][j], 0, 0, 0);
        }
#pragma unroll
    for (int i = 0; i < 2; ++i) {
        const int row = rt * 128 + wave * 32 + i * 16 + l15; const int n = row & 255, bg = row >> 8;
#pragma unroll
        for (int j = 0; j < 4; ++j) {
            const int d0 = j * 16 + 4 * q; const f32x4 a = acc[i][j];
            if (which == 0) *(u32x2*)(KCb + (size_t)row * 64 + d0) = (u32x2){pack2bf(a[0], a[1]), pack2bf(a[2], a[3])};
            else {
                const int pos = (n & ~31) + vt_perm(n & 31);
#pragma unroll
                for (int r = 0; r < 4; ++r) VCT[((size_t)bg * 64 + d0 + r) * 256 + pos] = f2bf(a[r]);
            }
        }
    }
    __syncthreads();
}

DI void win_item(const bf16* __restrict__ P2, const bf16* __restrict__ VTw, bf16* __restrict__ OW, int item, char* smem) {
    constexpr int NQT = ANQT_WIN;
    int b, g, t0; attn_item_decode<16 * NQT>(item, b, g, t0);
    const int lane = TIDX & 63, wave = TIDX >> 6, q = lane >> 4, l15 = lane & 15;
    const size_t mbase = (size_t)b * T + t0; const int hbase = g * 4, h = hbase + (l15 & 3);
    bf16x8 qf[NQT][2]; attn_load_q<NQT>(qf, P2, LDP2, mbase, hbase);
    AttnStateT<NQT> st; attn_init<NQT>(st, at::M_INIT, 0.f);
    const int lo = t0 - 511 < 0 ? 0 : (t0 - 511) >> 6, hi = (t0 + 16 * NQT - 1) >> 6;
    const unsigned long long nosel[NQT] = {};
    attn_blocks<AM_WIN, NQT>(st, qf, P2 + (size_t)b * T * LDP2 + 1792 + g * 64, LDP2, VTw + (size_t)(b * G + g) * 64 * T, T, t0, range_mask(lo, hi), hbase, nosel, smem);
#pragma unroll
    for (int qt = 0; qt < NQT; ++qt) {
        const float li = attn_linv(st.lacc[qt]); const size_t m = mbase + wave * (4 * NQT) + qt * 4 + (l15 >> 2);
#pragma unroll
        for (int dt = 0; dt < 4; ++dt) { const f32x4 o = st.o[qt][dt]; *(u32x2*)(OW + m * D + h * 64 + dt * 16 + 4 * q) = (u32x2){pack2bf(o[0] * li, o[1] * li), pack2bf(o[2] * li, o[3] * li)}; }
    }
}

DI void cmpsel_item(const bf16* __restrict__ P2, const bf16* __restrict__ KCb, const bf16* __restrict__ VCT, bf16* __restrict__ OC, unsigned long long* __restrict__ SELM, int item, char* smem) {
    int b, g, t0; attn_item_decode<32>(item, b, g, t0);
    const int tid = TIDX, lane = tid & 63, wave = tid >> 6, q = lane >> 4, l15 = lane & 15;
    const size_t mbase = (size_t)b * T + t0; const int hbase = g * 4, h = hbase + (l15 & 3);
    float* impL = (float*)(smem + at::OFF_IMP);
    for (int i = tid; i < 32 * 64; i += NTHREADS) impL[i] = 0.f;
    bf16x8 qf[2][2]; attn_load_q<2>(qf, P2, LDP2, mbase, hbase);
    AttnStateT<2> st; attn_init<2>(st, at::M_INIT, 0.f);
    const int nvmax = (t0 + 31 - 31) / 16 + 1;
    const int hi = (nvmax - 1) >> 6;
    const bf16* Kp = KCb + (size_t)(b * G + g) * 256 * 64; const bf16* Vp = VCT + (size_t)(b * G + g) * 64 * 256;
    const unsigned long long nosel[2] = {0ull, 0ull};
    attn_blocks<AM_CMP, 2>(st, qf, Kp, 64, Vp, 256, t0, range_mask(0, hi), hbase, nosel, smem);
    float linv[2];
#pragma unroll
    for (int qt = 0; qt < 2; ++qt) {
        linv[qt] = attn_linv(st.lacc[qt]); const size_t m = mbase + wave * 8 + qt * 4 + (l15 >> 2);
#pragma unroll
        for (int dt = 0; dt < 4; ++dt) { const f32x4 o = st.o[qt][dt]; *(u32x2*)(OC + m * D + h * 64 + dt * 16 + 4 * q) = (u32x2){pack2bf(o[0] * linv[qt], o[1] * linv[qt]), pack2bf(o[2] * linv[qt], o[3] * linv[qt])}; }
    }
    {
        const int tq0 = t0 + wave * 8 + (l15 >> 2);
        const bf16* kp0 = Kp + (size_t)l15 * 64 + q * 8;
        bf16x8 kfA[4][2], kfB[4][2];
#define CS_LOADK(dst_, kb_) { _Pragma("unroll") for (int kt = 0; kt < 4; ++kt) _Pragma("unroll") for (int ks = 0; ks < 2; ++ks) \
            dst_[kt][ks] = *(const bf16x8*)(kp0 + (size_t)((kb_) * 64 + kt * 16) * 64 + ks * 32); }
#define CS_QSUM(x_) { x_ += __builtin_bit_cast(float, __builtin_amdgcn_update_dpp(0, __builtin_bit_cast(int, x_), 0xB1, 0xf, 0xf, false)); \
                      x_ += __builtin_bit_cast(float, __builtin_amdgcn_update_dpp(0, __builtin_bit_cast(int, x_), 0x4E, 0xf, 0xf, false)); }
#define CS_BLOCK(kf_, kb_) { const int kbi = (kb_); \
            f32x4 s[2][4]; \
            _Pragma("unroll") for (int qt = 0; qt < 2; ++qt) _Pragma("unroll") for (int kt = 0; kt < 4; ++kt) s[qt][kt] = (f32x4){0.f, 0.f, 0.f, 0.f}; \
            _Pragma("unroll") for (int kt = 0; kt < 4; ++kt) _Pragma("unroll") for (int ks = 0; ks < 2; ++ks) { \
                s[0][kt] = __builtin_amdgcn_mfma_f32_16x16x32_bf16(kf_[kt][ks], qf[0][ks], s[0][kt], 0, 0, 0); \
                s[1][kt] = __builtin_amdgcn_mfma_f32_16x16x32_bf16(kf_[kt][ks], qf[1][ks], s[1][kt], 0, 0, 0); } \
            const bool allvis = 16 * (kbi * 64 + 63) + 31 <= t0;         \
            _Pragma("unroll") for (int qt = 0; qt < 2; ++qt) { \
                const int tq = tq0 + 4 * qt; const int tl = wave * 8 + qt * 4 + (l15 >> 2); \
                _Pragma("unroll") for (int kt = 0; kt < 4; ++kt) { \
                    float pr[4]; \
                    _Pragma("unroll") for (int r = 0; r < 4; ++r) { const int key = kbi * 64 + kt * 16 + 4 * q + r; \
                        const float e = fast_exp2(s[qt][kt][r] - st.m[qt]) * linv[qt]; pr[r] = (allvis || 16 * key + 31 <= tq) ? e : 0.f; } \
                    float s4 = (pr[0] + pr[1]) + (pr[2] + pr[3]), s1 = pr[3]; \
                    CS_QSUM(s4); CS_QSUM(s1); \
                    const int s0 = kbi * 16 + kt * 4 + q; \
                    if ((l15 & 3) == 0) { atomicAdd(&impL[tl * 64 + s0], s4); if (s0 + 1 < 64) atomicAdd(&impL[tl * 64 + s0 + 1], s1); } \
                } \
            } }
        CS_LOADK(kfA, 0);
        for (int kb = 0; kb <= hi; kb += 2) {
            if (kb + 1 <= hi) CS_LOADK(kfB, kb + 1);
            CS_BLOCK(kfA, kb);
            if (kb + 1 > hi) break;
            if (kb + 2 <= hi) CS_LOADK(kfA, kb + 2);
            CS_BLOCK(kfB, kb + 1);
        }
#undef CS_LOADK
#undef CS_QSUM
#undef CS_BLOCK
        __syncthreads();
    }
    {
        const int tl = tid >> 3, sg = tid & 7; const int t = t0 + tl, cur = t >> 6; float* row = impL + tl * 64;
        unsigned hk[8]; unsigned long long mine[8];
#pragma unroll
        for (int j = 0; j < 8; ++j) { const int s = sg * 8 + j; const float v = row[s];
            hk[j] = (s == 0 || s == cur || s == cur - 1) ? 0x7F800000u : (s * 64 > t ? 0u : (v > 0.f ? __float_as_uint(v) + 1u : 1u));
            mine[j] = ((unsigned long long)hk[j] << 32) | (unsigned)(63 - s); }
        __syncthreads();
#pragma unroll
        for (int j = 0; j < 8; ++j) ((unsigned*)row)[sg * 8 + j] = hk[j];
        __syncthreads();
        int rank[8] = {0, 0, 0, 0, 0, 0, 0, 0};
        const int ns4 = ((((t0 + 31) >> 6) >> 2) + 2) & ~1;
#pragma unroll 2
        for (int s4 = 0; s4 < ns4; ++s4) {
            const u32x4 v4 = *(const u32x4*)(row + s4 * 4);
#pragma unroll
            for (int e = 0; e < 4; ++e) { const unsigned long long kv = ((unsigned long long)v4[e] << 32) | (unsigned)(63 - (s4 * 4 + e));
#pragma unroll
                for (int j = 0; j < 8; ++j) rank[j] += kv > mine[j] ? 1 : 0; }
        }
        unsigned long long bits = 0ull;
#pragma unroll
        for (int j = 0; j < 8; ++j) if (rank[j] < KTOP && (sg * 8 + j) * 64 <= t) bits |= 1ull << (sg * 8 + j);
        unsigned lo = (unsigned)bits, hi2 = (unsigned)(bits >> 32);
#pragma unroll
        for (int o = 1; o < 8; o <<= 1) { lo |= __shfl_xor(lo, o); hi2 |= __shfl_xor(hi2, o); }
        if (sg == 0) SELM[(mbase + tl) * 4 + g] = ((unsigned long long)hi2 << 32) | lo;
    }
    __syncthreads();
}

DI void sel_item(const bf16* __restrict__ P2, const bf16* __restrict__ VTs, const unsigned long long* __restrict__ SELM, const bf16* __restrict__ OC, const bf16* __restrict__ OW,
                 bf16* __restrict__ AO, int item, char* smem) {
    constexpr int NQT = ANQT_SEL;
    int b, g, t0; attn_item_decode<16 * NQT>(item, b, g, t0);
    const int tid = TIDX, lane = tid & 63, wave = tid >> 6, q = lane >> 4, l15 = lane & 15;
    const size_t mbase = (size_t)b * T + t0; const int hbase = g * 4, rr = l15 & 3, h = hbase + rr;
    unsigned long long* orw = (unsigned long long*)(smem + at::OFF_X);
    if (tid == 0) *orw = 0ull;
    __syncthreads();
    if (tid < 16 * NQT) atomicOr(orw, SELM[(mbase + tid) * 4 + g]);
    unsigned long long sel[NQT];
#pragma unroll
    for (int qt = 0; qt < NQT; ++qt) sel[qt] = SELM[(mbase + wave * (4 * NQT) + qt * 4 + (l15 >> 2)) * 4 + g];
    bf16x8 qf[NQT][2]; attn_load_q<NQT>(qf, P2, LDP2, mbase, hbase);
    AttnStateT<NQT> st; attn_init<NQT>(st, at::M_INIT, 0.f);
    __syncthreads();
    const unsigned long long todo_v = (*orw) & range_mask(0, (t0 + 16 * NQT - 1) >> 6);
    const unsigned long long todo = ((unsigned long long)(unsigned)__builtin_amdgcn_readfirstlane((int)(todo_v >> 32)) << 32) | (unsigned)__builtin_amdgcn_readfirstlane((int)(unsigned)todo_v);
    attn_blocks<AM_SEL, NQT>(st, qf, P2 + (size_t)b * T * LDP2 + 1536 + g * 64, LDP2, VTs + (size_t)(b * G + g) * 64 * T, T, t0, todo, hbase, sel, smem);
#pragma unroll
    for (int qt = 0; qt < NQT; ++qt) {
        const float li = attn_linv(st.lacc[qt]); const size_t m = mbase + wave * (4 * NQT) + qt * 4 + (l15 >> 2);
        const bf16* gr = P2 + m * LDP2 + 3072;
        const float g0 = sigmoidf_(bf2f(gr[0 * 16 + h])), g1 = sigmoidf_(bf2f(gr[1 * 16 + h])), g2 = sigmoidf_(bf2f(gr[2 * 16 + h]));
#pragma unroll
        for (int dt = 0; dt < 4; ++dt) {
            const int d0 = dt * 16 + 4 * q; const size_t oi = m * D + h * 64 + d0;
            const u32x2 zz = *(const u32x2*)(P2 + m * LDP2 + 2048 + h * 64 + d0), cc = *(const u32x2*)(OC + oi), ww = *(const u32x2*)(OW + oi);
            const f32x4 o = st.o[qt][dt];
            const float r0 = (g0 * bflo(cc[0]) + g1 * o[0] * li + g2 * bflo(ww[0])) * siluf_(bflo(zz[0]));
            const float r1 = (g0 * bfhi(cc[0]) + g1 * o[1] * li + g2 * bfhi(ww[0])) * siluf_(bfhi(zz[0]));
            const float r2 = (g0 * bflo(cc[1]) + g1 * o[2] * li + g2 * bflo(ww[1])) * siluf_(bflo(zz[1]));
            const float r3 = (g0 * bfhi(cc[1]) + g1 * o[3] * li + g2 * bfhi(ww[1])) * siluf_(bfhi(zz[1]));
            *(u32x2*)(AO + oi) = (u32x2){pack2bf(r0, r1), pack2bf(r2, r3)};
        }
    }
    __syncthreads();
}

DI void lru_convert_gates(const float* __restrict__ gaw, const float* __restrict__ gxw, bf16* __restrict__ img) {
    for (int i = blockIdx.x * NTHREADS + TIDX; i < 16 * 160 * 96; i += gridDim.x * NTHREADS) {
        const int k = i % 96, n = (i / 96) % 160, blk = i / (96 * 160);
        float v = 0.f;
        if (k < 80) v = n < 80 ? gaw[((size_t)blk * 80 + k) * 80 + n] : gxw[((size_t)blk * 80 + k) * 80 + (n - 80)];
        img[i] = f2bf(v);
    }
}
DI void lru_gate_item(const bf16* __restrict__ P3, const float* __restrict__ cw, const float* __restrict__ cb, const bf16* __restrict__ gimg, const float* __restrict__ gab, const float* __restrict__ gxb,
                      const float* __restrict__ lam, bf16* __restrict__ LA, bf16* __restrict__ BV, float2* __restrict__ SUM, int item, char* smem) {
    const int rt = item >> 4, nb = item & 15; const int tid = TIDX, lane = tid & 63, wave = tid >> 6, q = lane >> 4, l15 = lane & 15;
    const size_t m0 = (size_t)rt * 128;
    for (int id = tid; id < 128 * 12; id += NTHREADS) {
        const int row = id / 12, c12 = id % 12; u32x4 outv = (u32x4){0u, 0u, 0u, 0u};
        if (c12 < 10) {
            const size_t m = m0 + row; const int t = (int)(m % T); const int ch = nb * 80 + c12 * 8;
            float acc[8];
            { const float4 b0 = *(const float4*)(cb + ch), b1 = *(const float4*)(cb + ch + 4); acc[0] = b0.x; acc[1] = b0.y; acc[2] = b0.z; acc[3] = b0.w; acc[4] = b1.x; acc[5] = b1.y; acc[6] = b1.z; acc[7] = b1.w; }
#pragma unroll
            for (int w = 0; w < 4; ++w) {
                if (t - 3 + w >= 0) {
                    const u32x4 uv = *(const u32x4*)(P3 + (m - 3 + w) * 2560 + ch);
                    const float4 w0 = *(const float4*)(cw + w * LW + ch), w1 = *(const float4*)(cw + w * LW + ch + 4);
                    acc[0] += w0.x * bflo(uv[0]); acc[1] += w0.y * bfhi(uv[0]); acc[2] += w0.z * bflo(uv[1]); acc[3] += w0.w * bfhi(uv[1]);
                    acc[4] += w1.x * bflo(uv[2]); acc[5] += w1.y * bfhi(uv[2]); acc[6] += w1.z * bflo(uv[3]); acc[7] += w1.w * bfhi(uv[3]);
                }
            }
            outv = (u32x4){pack2bf(acc[0], acc[1]), pack2bf(acc[2], acc[3]), pack2bf(acc[4], acc[5]), pack2bf(acc[6], acc[7])};
        }
        const int ks = c12 >> 2, c = c12 & 3;
        *(u32x4*)(smem + ks * 8192 + row * 64 + ((c ^ ((row >> 2) & 3)) << 4)) = outv;
    }
    for (int id = tid; id < 160 * 12; id += NTHREADS) {
        const int row = id / 12, c12 = id % 12; const int ks = c12 >> 2, c = c12 & 3;
        *(u32x4*)(smem + 24576 + ks * 10240 + row * 64 + ((c ^ ((row >> 2) & 3)) << 4)) = *(const u32x4*)(gimg + ((size_t)nb * 160 + row) * 96 + c12 * 8);
    }
    __syncthreads();
    f32x4 acc[2][10];
#pragma unroll
    for (int i = 0; i < 2; ++i)
#pragma unroll
        for (int j = 0; j < 10; ++j) acc[i][j] = (f32x4){0.f, 0.f, 0.f, 0.f};
    const int fo = l15 * 64 + ((q ^ ((l15 >> 2) & 3)) << 4);
#pragma unroll
    for (int ks = 0; ks < 3; ++ks) {
        bf16x8 uf[2];
#pragma unroll
        for (int i = 0; i < 2; ++i) uf[i] = *(const bf16x8*)(smem + ks * 8192 + (wave * 32 + i * 16) * 64 + fo);
#pragma unroll
        for (int j = 0; j < 10; ++j) {
            const bf16x8 wf = *(const bf16x8*)(smem + 24576 + ks * 10240 + j * 1024 + fo);
            acc[0][j] = __builtin_amdgcn_mfma_f32_16x16x32_bf16(wf, uf[0], acc[0][j], 0, 0, 0);
            acc[1][j] = __builtin_amdgcn_mfma_f32_16x16x32_bf16(wf, uf[1], acc[1][j], 0, 0, 0);
        }
    }
    __syncthreads();
#pragma unroll
    for (int i = 0; i < 2; ++i) {
        const int row = wave * 32 + i * 16 + l15; const size_t m = m0 + row;
#pragma unroll
        for (int ct = 0; ct < 5; ++ct) {
            const int kcol = ct * 16 + 4 * q; const int ch = nb * 80 + kcol;
            const u32x2 uu = *(const u32x2*)(smem + (kcol >> 5) * 8192 + row * 64 + ((((kcol & 31) >> 3) ^ ((row >> 2) & 3)) << 4) + (kcol & 7) * 2);
            const float uc[4] = {bflo(uu[0]), bfhi(uu[0]), bflo(uu[1]), bfhi(uu[1])};
            const float4 ba = *(const float4*)(gab + ch), bx = *(const float4*)(gxb + ch), lm = *(const float4*)(lam + ch);
            const float bav[4] = {ba.x, ba.y, ba.z, ba.w}, bxv[4] = {bx.x, bx.y, bx.z, bx.w}, lmv[4] = {lm.x, lm.y, lm.z, lm.w};
            float la[4], bv[4];
#pragma unroll
            for (int r = 0; r < 4; ++r) {
                const float rg = __builtin_amdgcn_rcpf(1.0f + __expf(-(acc[i][ct][r] + bav[r]))), ig = __builtin_amdgcn_rcpf(1.0f + __expf(-(acc[i][ct + 5][r] + bxv[r])));
                la[r] = rg * lmv[r];
                const float om = 1.0f - __expf(2.0f * la[r]);
                bv[r] = __builtin_amdgcn_sqrtf(om > 0.f ? om : 0.f) * (ig * uc[r]);
            }
            const u32x2 lav = {pack2bf(la[0], la[1]), pack2bf(la[2], la[3])}, bvv = {pack2bf(bv[0], bv[1]), pack2bf(bv[2], bv[3])};
            *(u32x2*)(LA + m * LW + ch) = lav; *(u32x2*)(BV + m * LW + ch) = bvv;
            *(u32x2*)(smem + 24576 + (row * 80 + kcol) * 2) = lav; *(u32x2*)(smem + 24576 + 20480 + (row * 80 + kcol) * 2) = bvv;
        }
    }
    __syncthreads();
    if (tid < 160) {
        const int cidx = tid / 80, c = tid % 80; const bf16* li = (const bf16*)(smem + 24576) + (cidx * 64) * 80 + c; const bf16* bi = li + 10240;
        float sla = 0.f, h = 0.f;
#pragma unroll 8
        for (int t = 0; t < 64; ++t) { const float la = bf2f(li[t * 80]), bvv = bf2f(bi[t * 80]); h = __expf(la) * h + bvv; sla += la; }
        const size_t mc = m0 + cidx * 64; const int bb = (int)(mc / T), jj = (int)(mc % T) / 64;
        SUM[((size_t)bb * (T / 64) + jj) * LW + nb * 80 + c] = make_float2(__expf(sla), h);
    }
    __syncthreads();
}
DI void lru_scan2_item(const bf16* __restrict__ LA, const bf16* __restrict__ BV, const float2* __restrict__ SUM, const bf16* __restrict__ P3, bf16* __restrict__ AO, int item) {
    const int cg = item % 5, j = (item / 5) % (T / 64), b = item / (5 * (T / 64)); const int c = cg * 256 + TIDX;
    float h = 0.f;
    for (int jj = 0; jj < j; ++jj) { const float2 s = SUM[((size_t)b * (T / 64) + jj) * LW + c]; h = s.x * h + s.y; }
    const size_t m0 = (size_t)b * T + j * 64;
#pragma unroll 8
    for (int t = 0; t < 64; ++t) {
        const float la = bf2f(LA[(m0 + t) * LW + c]); const float bv = bf2f(BV[(m0 + t) * LW + c]); const float z = bf2f(P3[(m0 + t) * 2560 + LW + c]);
        h = __expf(la) * h + bv; AO[(m0 + t) * LW + c] = f2bf(h * siluf_(z));
    }
}

struct ALoadF32 {
    const float* A;
    static constexpr bool DMA = false;
    DI const bf16* src(int, int) const { return nullptr; }
    struct Raw { float4 a, b; };
    DI Raw load(int m, int k) const { Raw r; r.a = *(const float4*)(A + (size_t)m * 64 + k); r.b = *(const float4*)(A + (size_t)m * 64 + k + 4); return r; }
    DI u32x4 finish(const Raw& r, int, int) const { return (u32x4){pack2bf(r.a.x, r.a.y), pack2bf(r.a.z, r.a.w), pack2bf(r.b.x, r.b.y), pack2bf(r.b.z, r.b.w)}; }
};
struct EpiLora {
    const float* w0; const float* a0; bf16* WL; bf16* AV;
    DI void operator()(int m, int n, const float* v, int, int) const {
        float w[8];
        if (n < 1024) {
#pragma unroll
            for (int j = 0; j < 8; ++j) w[j] = -0.60653065971f * __builtin_amdgcn_rcpf(1.0f + __expf(-(w0[n + j] + v[j])));
            store8bf(WL + (size_t)m * D + n, w);
        } else {
#pragma unroll
            for (int j = 0; j < 8; ++j) w[j] = __builtin_amdgcn_rcpf(1.0f + __expf(-(a0[n - 1024 + j] + v[j])));
            store8bf(AV + (size_t)m * D + n - 1024, w);
        }
    }
    DI void finish(int, int, int, int, int) const {}
    DI void finish_wide(int, int, int, int, int) const {}
};
DI float dpp_sum16(float x) {
    x += __builtin_bit_cast(float, __builtin_amdgcn_update_dpp(0, __builtin_bit_cast(int, x), 0xB1, 0xf, 0xf, false));
    x += __builtin_bit_cast(float, __builtin_amdgcn_update_dpp(0, __builtin_bit_cast(int, x), 0x4E, 0xf, 0xf, false));
    x += __builtin_bit_cast(float, __builtin_amdgcn_update_dpp(0, __builtin_bit_cast(int, x), 0x141, 0xf, 0xf, false));
    x += __builtin_bit_cast(float, __builtin_amdgcn_update_dpp(0, __builtin_bit_cast(int, x), 0x140, 0xf, 0xf, false));
    return x;
}
constexpr int RW_NCH = T / 16;
DI void rwkv_prep_item(bf16* __restrict__ P, bf16* __restrict__ WL, bf16* __restrict__ AV, const float* __restrict__ k_k, const float* __restrict__ k_a, const float* __restrict__ r_k,
                       float* __restrict__ G15, bf16* __restrict__ M2g, bf16* __restrict__ M3g, float* __restrict__ BON, int item, char* smem) {
    const int c = item % RW_NCH, h = (item / RW_NCH) & 15, b = item / (RW_NCH * 16);
    const int tid = TIDX, t = tid >> 4, jq = tid & 15, j0 = jq * 4;
    const size_t m0 = (size_t)b * T + c * 16, m = m0 + t; const size_t ch = (size_t)(b * 16 + h) * RW_NCH + c;
    float* sA = (float*)smem; float* sR = sA + 16 * 68; float* sB = sR + 16 * 68; float* sK = sB + 16 * 68; float* sW = sK + 16 * 68; float* sWl = sW + 16 * 68;
    float* mAab = sWl + 16 * 64; float* mAak = mAab + 16 * 17; float* mArb = mAak + 16 * 17; float* mArk = mArb + 16 * 17; float* mTin = mArk + 16 * 17; float* mM2 = mTin + 16 * 17;
    const u32x2 r2 = *(const u32x2*)(P + m * 4096 + h * 64 + j0), k2 = *(const u32x2*)(P + m * 4096 + 1024 + h * 64 + j0), a2 = *(const u32x2*)(AV + m * D + h * 64 + j0), w2 = *(const u32x2*)(WL + m * D + h * 64 + j0);
    const float rr[4] = {bflo(r2[0]), bfhi(r2[0]), bflo(r2[1]), bfhi(r2[1])}, kr[4] = {bflo(k2[0]), bfhi(k2[0]), bflo(k2[1]), bfhi(k2[1])},
                av[4] = {bflo(a2[0]), bfhi(a2[0]), bflo(a2[1]), bfhi(a2[1])}, wl[4] = {bflo(w2[0]), bfhi(w2[0]), bflo(w2[1]), bfhi(w2[1])};
    const float4 kk4 = *(const float4*)(k_k + h * 64 + j0), ka4 = *(const float4*)(k_a + h * 64 + j0), rk4 = *(const float4*)(r_k + h * 64 + j0);
    const float kkc[4] = {kk4.x, kk4.y, kk4.z, kk4.w}, kac[4] = {ka4.x, ka4.y, ka4.z, ka4.w}, rkc[4] = {rk4.x, rk4.y, rk4.z, rk4.w};
    float kkv[4], n2 = 0.f;
#pragma unroll
    for (int e = 0; e < 4; ++e) { kkv[e] = kr[e] * kkc[e]; n2 += kkv[e] * kkv[e]; }
    n2 = dpp_sum16(n2);
    float nr = sqrtf(n2); nr = nr > 1e-12f ? nr : 1e-12f; const float inr = 1.0f / nr;
    float aa[4], bb[4], kp[4], bon = 0.f;
#pragma unroll
    for (int e = 0; e < 4; ++e) { const float kn = kkv[e] * inr; aa[e] = -kn; bb[e] = kn * av[e]; kp[e] = kr[e] * (1.0f + (av[e] - 1.0f) * kac[e]); bon += rr[e] * kp[e] * rkc[e]; }
    bon = dpp_sum16(bon);
    if (jq == 0) BON[m * 16 + h] = bon;
    *(float4*)(sWl + t * 64 + j0) = make_float4(wl[0], wl[1], wl[2], wl[3]);
    __syncthreads();
    float clx[4] = {0.f, 0.f, 0.f, 0.f};
#pragma unroll
    for (int s = 0; s < 15; ++s) { if (s < t) { const float4 w = *(const float4*)(sWl + s * 64 + j0); clx[0] += w.x; clx[1] += w.y; clx[2] += w.z; clx[3] += w.w; } }
    float bt[4];
    {
        float va[4], vr[4], vk[4], gc[4];
#pragma unroll
        for (int e = 0; e < 4; ++e) { const float cl = clx[e] + wl[e]; const float gp = __expf(clx[e]), gi = __expf(-cl); gc[e] = __expf(cl); va[e] = aa[e] * gp; vr[e] = rr[e] * gc[e]; bt[e] = bb[e] * gi; vk[e] = kp[e] * gi; }
        *(float4*)(sA + t * 68 + j0) = make_float4(va[0], va[1], va[2], va[3]); *(float4*)(sR + t * 68 + j0) = make_float4(vr[0], vr[1], vr[2], vr[3]);
        *(float4*)(sB + t * 68 + j0) = make_float4(bt[0], bt[1], bt[2], bt[3]); *(float4*)(sK + t * 68 + j0) = make_float4(vk[0], vk[1], vk[2], vk[3]);
        {
            char* img = (char*)(mM2 + 16 * 17) + t * 128 + (((j0 >> 3) ^ (t & 7)) << 4) + (j0 & 4) * 2;
            *(u32x2*)(img) = (u32x2){pack2bf(va[0], va[1]), pack2bf(va[2], va[3])}; *(u32x2*)(img + 2048) = (u32x2){pack2bf(vr[0], vr[1]), pack2bf(vr[2], vr[3])};
            *(u32x2*)(img + 4096) = (u32x2){pack2bf(bt[0], bt[1]), pack2bf(bt[2], bt[3])}; *(u32x2*)(img + 6144) = (u32x2){pack2bf(vk[0], vk[1]), pack2bf(vk[2], vk[3])};
        }
        if (t == 15) *(float4*)(G15 + ch * 64 + j0) = make_float4(gc[0], gc[1], gc[2], gc[3]);
#pragma unroll
        for (int e = 0; e < 4; ++e) {   }
#pragma unroll
        for (int e = 0; e < 4; ++e) clx[e] = vk[e];
    }
    __syncthreads();
    {
        const int wv = __builtin_amdgcn_readfirstlane(tid >> 6), lane = tid & 63, q = lane >> 4, l15 = lane & 15;
        const char* xb_ = (const char*)(mM2 + 16 * 17) + (wv >> 1) * 2048;
        const char* yb_ = (const char*)(mM2 + 16 * 17) + 4096 + (wv & 1) * 2048;
        f32x4 acc = {0.f, 0.f, 0.f, 0.f};
#pragma unroll
        for (int ks = 0; ks < 2; ++ks) {
            const int off = l15 * 128 + (((ks * 4 + q) ^ (l15 & 7)) << 4);
            const bf16x8 xf = *(const bf16x8*)(xb_ + off), yf = *(const bf16x8*)(yb_ + off);
            acc = __builtin_amdgcn_mfma_f32_16x16x32_bf16(xf, yf, acc, 0, 0, 0);
        }
        float* dst = wv == 0 ? mAab : (wv == 1 ? mAak : (wv == 2 ? mArb : mArk));
        const bool strict = wv < 2;
#pragma unroll
        for (int r = 0; r < 4; ++r) { const int tt = 4 * q + r, ss = l15; dst[tt * 17 + ss] = (strict ? ss < tt : ss <= tt) ? acc[r] : 0.f; }
    }
    __syncthreads();
    if (tid < 16) {
        float col[16];
#pragma unroll
        for (int i = 0; i < 16; ++i) {
            float acc = (i == tid) ? 1.0f : 0.f;
#pragma unroll
            for (int jj = 0; jj < i; ++jj) acc += mAab[i * 17 + jj] * col[jj];
            col[i] = acc; mTin[i * 17 + tid] = acc;
        }
    }
    __syncthreads();
    float wv[4] = {0.f, 0.f, 0.f, 0.f}, m2 = 0.f;
#pragma unroll
    for (int s = 0; s < 16; ++s) { const float ti = mTin[t * 17 + s]; const float4 a4 = *(const float4*)(sA + s * 68 + j0); wv[0] += ti * a4.x; wv[1] += ti * a4.y; wv[2] += ti * a4.z; wv[3] += ti * a4.w; m2 += ti * mAak[s * 17 + jq]; }
    *(float4*)(sW + t * 68 + j0) = make_float4(wv[0], wv[1], wv[2], wv[3]); mM2[t * 17 + jq] = m2;
    __syncthreads();
    float rh[4]; { const float4 r4 = *(const float4*)(sR + t * 68 + j0); rh[0] = r4.x; rh[1] = r4.y; rh[2] = r4.z; rh[3] = r4.w; }
    float m3 = mArk[t * 17 + jq];
#pragma unroll
    for (int s = 0; s < 16; ++s) { const float ar = mArb[t * 17 + s]; const float4 w4 = *(const float4*)(sW + s * 68 + j0); rh[0] += ar * w4.x; rh[1] += ar * w4.y; rh[2] += ar * w4.z; rh[3] += ar * w4.w; m3 += ar * mM2[s * 17 + jq]; }
    const int jp = (((jq >> 3) * 4 + (jq & 3)) * 8 + ((jq >> 2) & 1) * 4);
    *(u32x2*)(WL + m * D + h * 64 + jp) = (u32x2){pack2bf(wv[0], wv[1]), pack2bf(wv[2], wv[3])};
    *(u32x2*)(P + m * 4096 + h * 64 + jp) = (u32x2){pack2bf(rh[0], rh[1]), pack2bf(rh[2], rh[3])};
#pragma unroll
    for (int e = 0; e < 4; ++e) {
        const int pos = ((e & 1) * 4 + (t >> 2)) * 8 + (t & 3);
        bf16* dst = e < 2 ? P + (m0 + jq) * 4096 + 1024 + h * 64 : AV + (m0 + jq) * D + h * 64;
        dst[pos] = f2bf(clx[e]); dst[pos + 4] = f2bf(bt[e]);
    }
    M2g[ch * 256 + t * 16 + jq] = f2bf(m2); M3g[ch * 256 + t * 16 + jq] = f2bf(m3);
    __syncthreads();
}

#define MFMA32(a, b, c) __builtin_amdgcn_mfma_f32_16x16x32_bf16(__builtin_bit_cast(bf16x8, a), __builtin_bit_cast(bf16x8, b), c, 0, 0, 0)
DI void rwkv_chunk_scan(const bf16* __restrict__ P, const bf16* __restrict__ WL, const bf16* __restrict__ AV, const float* __restrict__ G15, const bf16* __restrict__ M2g, const bf16* __restrict__ M3g,
                        bf16* __restrict__ YS, int bh, char* smem) {
    constexpr int SLOT = 12288, YOFF = 49152;
    const int tid = TIDX, lane = tid & 63, vs = __builtin_amdgcn_readfirstlane(tid >> 6), q = lane >> 4, l15 = lane & 15; const int b = bh >> 4, h = bh & 15;
    const size_t mb = (size_t)b * T; const size_t ch0 = (size_t)(b * 16 + h) * RW_NCH;
    const char *s0, *s1, *s2; size_t d0, d1, d2;
    if (tid < 128) { const int c8 = tid >> 4, t = tid & 15; s0 = (const char*)(WL + (mb + t) * D + h * 64 + c8 * 8); d0 = (size_t)16 * D * 2; }
    else { const int pp = tid - 128, c8 = pp >> 4, t = pp & 15; s0 = (const char*)(P + (mb + t) * 4096 + h * 64 + c8 * 8); d0 = (size_t)16 * 4096 * 2; }
    if (tid < 128) { const int r = tid >> 3, c8 = tid & 7; s1 = (const char*)(P + (mb + r) * 4096 + 1024 + h * 64 + c8 * 8); d1 = (size_t)16 * 4096 * 2; }
    else { const int pp = tid - 128, r = pp >> 3, c8 = pp & 7; s1 = (const char*)(AV + (mb + r) * D + h * 64 + c8 * 8); d1 = (size_t)16 * D * 2; }
    if (tid < 128) { const int r = tid >> 3, c8 = tid & 7; s2 = (const char*)(P + (mb + r) * 4096 + 2048 + h * 64 + c8 * 8); d2 = (size_t)16 * 4096 * 2; }
    else if (tid < 160) { s2 = (const char*)(M2g + ch0 * 256 + (tid - 128) * 8); d2 = 512; }
    else if (tid < 192) { s2 = (const char*)(M3g + ch0 * 256 + (tid - 160) * 8); d2 = 512; }
    else { const int pp = tid < 208 ? tid - 192 : 0; s2 = (const char*)(G15 + ch0 * 64 + pp * 4); d2 = 256; }
    const int dma_off = vs * 1024;
#define RW_DMA(c_) { char* dst = smem + ((c_) & 3) * SLOT + dma_off; GLDS16(s0 + (size_t)(c_) * d0, dst); GLDS16(s1 + (size_t)(c_) * d1, dst + 4096); GLDS16(s2 + (size_t)(c_) * d2, dst + 8192); }
#define RW_BARRIER() { asm volatile("s_waitcnt lgkmcnt(0)" ::: "memory"); __builtin_amdgcn_s_barrier(); asm volatile("" ::: "memory"); }
    f32x4 H0 = {0.f, 0.f, 0.f, 0.f}, H1 = H0, H2 = H0, H3 = H0;
    const int oW = (q * 16 + l15) * 16;
    const int oK = 4096 + ((l15 & 3) >> 1) * 2048 + ((l15 >> 2) * 8 + (l15 & 1) * 4 + q) * 16;
    const int oM = 10240 + l15 * 32 + q * 8;
    const int oV = 8192 + (4 * q) * 128 + (vs * 16 + l15) * 2;
    const int oG = 11264 + (4 * q) * 4;
    const int oY = YOFF + ((4 * q) * 64 + vs * 16 + l15) * 2;
    RW_DMA(0); RW_DMA(1); RW_DMA(2);
    asm volatile("s_waitcnt vmcnt(6)" ::: "memory");
    RW_BARRIER();
    const u32x4 zz4 = {0u, 0u, 0u, 0u};
    u32x4 Hb0A = zz4, Hb1A = zz4, VUA = zz4, m3A = zz4, rAA = zz4, rBA = zz4;
    u32x4 Hb0B = zz4, Hb1B = zz4, VUB = zz4, m3B = zz4, rAB = zz4, rBB = zz4;
    u32x4 m2x = zz4;
    int sincef = 3;
#define RW_FLUSH(cbase_) { u32x4 yv[4]; \
        _Pragma("unroll") for (int k = 0; k < 4; ++k) yv[k] = *(const u32x4*)(smem + YOFF + (tid + 256 * k) * 16); \
        _Pragma("unroll") for (int k = 0; k < 4; ++k) { const int pc = tid + 256 * k, rr = pc >> 3, c8 = pc & 7; *(u32x4*)(YS + (mb + (size_t)(cbase_) * 16 + rr) * D + h * 64 + c8 * 8) = yv[k]; } }
#define RW_YSTORE(Y_, cprev_) { char* yb = smem + oY + ((cprev_) & 7) * 2048; const unsigned y01 = pack2bf(Y_[0], Y_[1]), y23 = pack2bf(Y_[2], Y_[3]); \
        *(unsigned short*)(yb) = (unsigned short)y01; *(unsigned short*)(yb + 128) = (unsigned short)(y01 >> 16); \
        *(unsigned short*)(yb + 256) = (unsigned short)y23; *(unsigned short*)(yb + 384) = (unsigned short)(y23 >> 16); }
#define RW_STEP(c_, P_, N_) { const int c = (c_); \
        if (c + 3 < RW_NCH) RW_DMA(c + 3); \
        const char* sl = smem + (c & 3) * SLOT; \
        { \
            const f32x4 z4 = {0.f, 0.f, 0.f, 0.f}; \
            Hb0##N_ = (u32x4){pack2bf(H0[0], H0[1]), pack2bf(H0[2], H0[3]), pack2bf(H1[0], H1[1]), pack2bf(H1[2], H1[3])}; \
            Hb1##N_ = (u32x4){pack2bf(H2[0], H2[1]), pack2bf(H2[2], H2[3]), pack2bf(H3[0], H3[1]), pack2bf(H3[2], H3[3])}; \
            const unsigned v0 = *(const bf16*)(sl + oV), v1 = *(const bf16*)(sl + oV + 128), v2 = *(const bf16*)(sl + oV + 256), v3 = *(const bf16*)(sl + oV + 384); \
            VU##N_[0] = v0 | (v1 << 16); VU##N_[1] = v2 | (v3 << 16); \
            { const u32x2 t2 = *(const u32x2*)(sl + oM), t3 = *(const u32x2*)(sl + oM + 512); m2x[0] = t2[0]; m2x[1] = t2[1]; m3##N_[0] = t3[0]; m3##N_[1] = t3[1]; } \
            const u32x4 wA = *(const u32x4*)(sl + oW), wB = *(const u32x4*)(sl + oW + 1024); \
            rA##N_ = *(const u32x4*)(sl + 2048 + oW); rB##N_ = *(const u32x4*)(sl + 2048 + oW + 1024); \
            f32x4 U = MFMA32(m2x, VU##N_, z4); \
            f32x4 Y = MFMA32(m3##P_, VU##P_, z4); \
            U = MFMA32(wA, Hb0##N_, U); \
            Y = MFMA32(rA##P_, Hb0##P_, Y); \
            U = MFMA32(wB, Hb1##N_, U); \
            Y = MFMA32(rB##P_, Hb1##P_, Y); \
            VU##N_[2] = pack2bf(U[0], U[1]); VU##N_[3] = pack2bf(U[2], U[3]); \
            const u32x4 kb0 = *(const u32x4*)(sl + oK), kb1 = *(const u32x4*)(sl + oK + 512), kb2 = *(const u32x4*)(sl + oK + 1024), kb3 = *(const u32x4*)(sl + oK + 1536); \
            const f32x4 g0 = *(const f32x4*)(sl + oG), g1 = *(const f32x4*)(sl + oG + 64), g2 = *(const f32x4*)(sl + oG + 128), g3 = *(const f32x4*)(sl + oG + 192); \
            const f32x4 a0 = MFMA32(kb0, VU##N_, H0), a1 = MFMA32(kb1, VU##N_, H1); \
            const f32x4 a2 = MFMA32(kb2, VU##N_, H2), a3 = MFMA32(kb3, VU##N_, H3); \
            H0 = a0 * g0; H1 = a1 * g1; H2 = a2 * g2; H3 = a3 * g3; \
            if (c > 0) RW_YSTORE(Y, c - 1);                   \
        } \
        const bool flush = c > 0 && (c & 7) == 0; \
        if (flush) { \
            RW_BARRIER();                                     \
            RW_FLUSH(c - 8); \
            sincef = 0; \
        } \
          \
          \
        if (c + 3 < RW_NCH) { if (sincef <= 2) asm volatile("s_waitcnt vmcnt(10)" ::: "memory"); else asm volatile("s_waitcnt vmcnt(6)" ::: "memory"); } \
        else if (c + 2 < RW_NCH) { asm volatile("s_waitcnt vmcnt(3)" ::: "memory"); } \
        else { asm volatile("s_waitcnt vmcnt(0)" ::: "memory"); } \
        RW_BARRIER(); \
        ++sincef; }
    for (int cc = 0; cc < RW_NCH; cc += 2) {
        RW_STEP(cc, B, A);
        RW_STEP(cc + 1, A, B);
    }
    {
        const f32x4 z4 = {0.f, 0.f, 0.f, 0.f};
        f32x4 Y = MFMA32(m3B, VUB, z4);
        Y = MFMA32(rAB, Hb0B, Y);
        Y = MFMA32(rBB, Hb1B, Y);
        RW_YSTORE(Y, RW_NCH - 1);
        RW_BARRIER();
        RW_FLUSH(RW_NCH - 8);
    }
#undef RW_STEP
#undef RW_YSTORE
#undef RW_FLUSH
#undef RW_DMA
#undef RW_BARRIER
}
DI void rwkv_gn_rows2(const bf16* __restrict__ P, const float* __restrict__ BON, const float* __restrict__ lnw, const float* __restrict__ lnb, bf16* __restrict__ YS) {
    const int tid = TIDX, lane = tid & 63, wave = tid >> 6; const int c = wave * 256 + lane * 4;
    const float4 lw = *(const float4*)(lnw + c), lb = *(const float4*)(lnb + c);
    for (size_t m = blockIdx.x; m < (size_t)M; m += gridDim.x) {
        const u32x2 yy = *(const u32x2*)(YS + m * D + c), vv = *(const u32x2*)(P + m * 4096 + 2048 + c), zz = *(const u32x2*)(P + m * 4096 + 3072 + c);
        const float bs = BON[m * 16 + (c >> 6)];
        const float y[4] = {bflo(yy[0]), bfhi(yy[0]), bflo(yy[1]), bfhi(yy[1])}, v[4] = {bflo(vv[0]), bfhi(vv[0]), bflo(vv[1]), bfhi(vv[1])}, z[4] = {bflo(zz[0]), bfhi(zz[0]), bflo(zz[1]), bfhi(zz[1])};
        const float lwv[4] = {lw.x, lw.y, lw.z, lw.w}, lbv[4] = {lb.x, lb.y, lb.z, lb.w};
        const float mean = dpp_sum16((y[0] + y[1]) + (y[2] + y[3])) * (1.0f / 64.0f);
        float var = 0.f;
#pragma unroll
        for (int i = 0; i < 4; ++i) { const float d = y[i] - mean; var += d * d; }
        var = dpp_sum16(var) * (1.0f / 64.0f);
        const float rstd = 1.0f / sqrtf(var + 64e-5f);
        float o[4];
#pragma unroll
        for (int i = 0; i < 4; ++i) o[i] = ((y[i] - mean) * rstd * lwv[i] + lbv[i] + bs * v[i]) * siluf_(z[i]);
        *(u32x2*)(YS + m * D + c) = (u32x2){pack2bf(o[0], o[1]), pack2bf(o[2], o[3])};
    }
}

struct FastBufs { char* ws; };

DI void rows_xb_parts(const float* __restrict__ x, bf16* xb, float* parts) {
    const int lane = TIDX & 63, wave = TIDX >> 6;
    for (int m = blockIdx.x * 4 + wave; m < M; m += gridDim.x * 4) {
        const float* xr = x + (size_t)m * D; float s = 0.f;
#pragma unroll
        for (int i = 0; i < 2; ++i) {
            const int k = (i * 64 + lane) * 8; const float4 a = *(const float4*)(xr + k), b = *(const float4*)(xr + k + 4);
            const float w[8] = {a.x, a.y, a.z, a.w, b.x, b.y, b.z, b.w};
#pragma unroll
            for (int j = 0; j < 8; ++j) s += w[j] * w[j];
            store8bf(xb + (size_t)m * D + k, w);
        }
#pragma unroll
        for (int o = 32; o >= 1; o >>= 1) s += __shfl_xor(s, o);
        if (lane < 16) parts[(size_t)m * 16 + lane] = lane == 0 ? s : 0.f;
    }
}
DI void rows_xn(const float* __restrict__ x, const float* parts, const float* __restrict__ g, bf16* xn) {
    const int lane = TIDX & 63, wave = TIDX >> 6;
    for (int m = blockIdx.x * 4 + wave; m < M; m += gridDim.x * 4) {
        const float rs = rstd_from_parts(parts, m); const float* xr = x + (size_t)m * D;
#pragma unroll
        for (int i = 0; i < 2; ++i) {
            const int k = (i * 64 + lane) * 8; const float4 a = *(const float4*)(xr + k), b = *(const float4*)(xr + k + 4);
            const float4 ga = *(const float4*)(g + k), gb = *(const float4*)(g + k + 4);
            const float w[8] = {a.x * rs * ga.x, a.y * rs * ga.y, a.z * rs * ga.z, a.w * rs * ga.w, b.x * rs * gb.x, b.y * rs * gb.y, b.z * rs * gb.z, b.w * rs * gb.w};
            store8bf(xn + (size_t)m * D + k, w);
        }
    }
}
DI void rows_final(float* x, const float* parts, const float* __restrict__ g) {
    const int lane = TIDX & 63, wave = TIDX >> 6;
    for (int m = blockIdx.x * 4 + wave; m < M; m += gridDim.x * 4) {
        const float rs = rstd_from_parts(parts, m); float* xr = x + (size_t)m * D;
#pragma unroll
        for (int i = 0; i < 4; ++i) {
            const int k = (i * 64 + lane) * 4; float4 a = *(float4*)(xr + k); const float4 ga = *(const float4*)(g + k);
            a.x *= rs * ga.x; a.y *= rs * ga.y; a.z *= rs * ga.z; a.w *= rs * ga.w; *(float4*)(xr + k) = a;
        }
    }
}
enum { PH_PREP0 = 0, PH_IN0, PH_ATTN0, PH_OUT0, PH_PREP1, PH_IN1, PH_LORA1, PH_CPREP1, PH_SCAN1, PH_GN1, PH_OUT1, PH_PREP2, PH_IN2, PH_B2, PH_C2, PH_D2, PH_OUT2, PH_PREP3, PH_IN3, PH_GATE3, PH_SCANA3, PH_SCANB3, PH_OUT3, PH_FINAL };

namespace wbo {
constexpr size_t IN = 0;
constexpr size_t OUT = (size_t)4352 * 1024;
constexpr size_t EXTRA = OUT + (size_t)1280 * 1024;
}

template <int PH>
DI void run_phase(const Params& p, char* smem) {
    char* ws = p.ws;
    float* parts = (float*)(ws + fw::PARTS);
    constexpr int LAYER = PH <= PH_OUT0 ? 0 : PH <= PH_OUT1 ? 1 : PH <= PH_OUT2 ? 2 : 3;
    constexpr size_t WBOFF = LAYER == 0 ? 200 * fw::MB : LAYER == 1 ? 238 * fw::MB : LAYER == 2 ? 240 * fw::MB : 1 * fw::MB;
    bf16* WB = (bf16*)(ws + WBOFF);
    bf16* XB = (bf16*)(ws + ((PH == PH_PREP0 || PH == PH_IN0) ? 130 * fw::MB : 174 * fw::MB));
    bf16* P = (bf16*)(ws + wsl::P);
    float* X = p.out;
    float* smf = (float*)smem;
    if (PH == PH_PREP0) {
        rows_xb_parts(p.x, XB, parts);
        int tb = 0;
        convert_seg(p.a_w_in, A_COLS, 0, A_COLS, 1024, WB + wbo::IN, p.norm_g + 0 * D, smf, tb);
        convert_seg(p.a_w_out, 1024, 0, 1024, 1024, WB + wbo::OUT, nullptr, smf, tb);
    } else if (PH == PH_IN0) {
        gemm_sched(8, 4, [&](bool big, int mt, int nt) {
            if (big) gemm_tile2(ALoadPlain{XB, D}, WB + wbo::IN, 1024, mt * 128, nt * 256, EpiL0{P, (bf16*)(ws + 86 * fw::MB), parts}, smem);
            else gemm_tile(ALoadPlain{XB, D}, WB + wbo::IN, 1024, mt * 128, 2048 + nt * 128, EpiL0{P, (bf16*)(ws + 86 * fw::MB), parts}, smem);
        });
    } else if (PH == PH_ATTN0) {
        build_bias_lut(p.t5, smem, true);
        for (int it = blockIdx.x; it < B * G * (T / (16 * ANQT_SWA)); it += gridDim.x) swa_item(P, (const bf16*)(ws + 86 * fw::MB), p.a_sinks, (bf16*)(ws + wsl::L0_AO), it, smem);
    } else if (PH == PH_OUT0) {
        gemm_sched(4, 0, [&](bool, int mt, int nt) { gemm_tile2(ALoadPlain{(const bf16*)(ws + wsl::L0_AO), D}, WB + wbo::OUT, 1024, mt * 128, nt * 256, EpiResid{p.x, X, nullptr, parts}, smem); });
    } else if (PH == PH_PREP1) {
        rows_xn(X, parts, p.norm_g + 1 * D, (bf16*)(ws + wsl::L1_XN));
        int tb = 0;
        convert_seg(p.b_w_in, 4096, 0, 4096, 1024, WB + wbo::IN, nullptr, smf, tb);
        convert_seg(p.b_w1, 64, 0, 64, 1024, WB + wbo::IN + (size_t)4096 * 1024, nullptr, smf, tb);
        convert_seg(p.b_a1, 64, 0, 64, 1024, WB + wbo::IN + (size_t)(4096 + 128) * 1024, nullptr, smf, tb);
        convert_seg(p.b_w_out, 1024, 0, 1024, 1024, WB + wbo::OUT, nullptr, smf, tb);
        convert_seg(p.b_w2, 1024, 0, 1024, 64, WB + wbo::EXTRA, nullptr, smf, tb);
        convert_seg(p.b_a2, 1024, 0, 1024, 64, WB + wbo::EXTRA + (size_t)1024 * 64, nullptr, smf, tb);
        for (size_t i = (size_t)blockIdx.x * 256 + TIDX; i < (size_t)64 * 1024 / 8; i += (size_t)gridDim.x * 256) {
            ((u32x4*)(WB + wbo::IN + (size_t)(4096 + 64) * 1024))[i] = (u32x4){0u, 0u, 0u, 0u};
            ((u32x4*)(WB + wbo::IN + (size_t)(4096 + 192) * 1024))[i] = (u32x4){0u, 0u, 0u, 0u};
        }
    } else if (PH == PH_IN1) {
        const bf16* XN = (const bf16*)(ws + wsl::L1_XN);
        EpiRwkv epi{P, (float*)(ws + wsl::LHW), (float*)(ws + wsl::LHA)};
        gemm_sched(16, 2, [&](bool big, int mt, int nt) {
            if (big) gemm_tile2(ALoadLerp{XN, p.b_mu + (nt >> 2) * D}, WB + wbo::IN, 1024, mt * 128, nt * 256, epi, smem);
            else gemm_tile(ALoadLerp{XN, p.b_mu + (4 + nt) * D}, WB + wbo::IN, 1024, mt * 128, 4096 + nt * 128, epi, smem);
        });
    } else if (PH == PH_LORA1) {
        const int ntile = (M / 128) * 16;
        EpiLora epi{p.b_w0, p.b_a0, (bf16*)(ws + wsl::L1_WL), (bf16*)(ws + wsl::L1_AV)};
        (void)ntile;
        gemm_sched(8, 0, [&](bool, int mt, int nt) { gemm_tile2(ALoadF32{(const float*)(ws + (nt < 4 ? wsl::LHW : wsl::LHA))}, WB + wbo::EXTRA, 64, mt * 128, nt * 256, epi, smem); });
    } else if (PH == PH_CPREP1) {
        for (int it = blockIdx.x; it < B * 16 * RW_NCH; it += gridDim.x)
            rwkv_prep_item(P, (bf16*)(ws + wsl::L1_WL), (bf16*)(ws + wsl::L1_AV), p.b_k_k, p.b_k_a, p.b_r_k, (float*)(ws + 9 * fw::MB), (bf16*)(ws + 1 * fw::MB), WB, (float*)(ws + 254 * fw::MB), it, smem);
    } else if (PH == PH_SCAN1) {
        const int bid = blockIdx.x;
        if ((bid & 31) < 8 && (bid >> 5) < 8) {
            const int it = (bid >> 5) * 8 + (bid & 31);
            rwkv_chunk_scan(P, (const bf16*)(ws + wsl::L1_WL), (const bf16*)(ws + wsl::L1_AV), (const float*)(ws + 9 * fw::MB), (const bf16*)(ws + 1 * fw::MB), WB, (bf16*)(ws + wsl::L1_XN), it, smem);
        }
    } else if (PH == PH_GN1) {
        rwkv_gn_rows2(P, (const float*)(ws + 254 * fw::MB), p.b_lnx_w, p.b_lnx_b, (bf16*)(ws + wsl::L1_XN));
    } else if (PH == PH_OUT1) {
        gemm_sched(4, 0, [&](bool, int mt, int nt) { gemm_tile2(ALoadPlain{(const bf16*)(ws + wsl::L1_XN), D}, WB + wbo::OUT, 1024, mt * 128, nt * 256, EpiResid{X, X, XB, parts}, smem); });
    } else if (PH == PH_PREP2) {
        int tb = 0;
        const float* g2 = p.norm_g + 2 * D;
        convert_seg(p.c_w_in, C_COLS, 0, 2560, 1024, WB + wbo::IN, g2, smf, tb);
        convert_seg(p.c_w_in, C_COLS, 2608, 1024, 1024, WB + wbo::IN + (size_t)2560 * 1024, g2, smf, tb);
        convert_seg(p.c_w_in, C_COLS, 2560, 64, 1024, WB + wbo::IN + (size_t)3584 * 1024, g2, smf, tb);
        convert_seg(p.c_w_out, 1024, 0, 1024, 1024, WB + wbo::OUT, nullptr, smf, tb);
        convert_seg(p.c_k_w1, 128, 0, 128, 2048, WB + wbo::EXTRA, nullptr, smf, tb);
        convert_seg(p.c_v_w1, 128, 0, 128, 2048, WB + wbo::EXTRA + (size_t)128 * 2048, nullptr, smf, tb);
        convert_seg(p.c_k_w2, 64, 0, 64, 128, WB + wbo::EXTRA + (size_t)256 * 2048, nullptr, smf, tb);
        convert_seg(p.c_v_w2, 64, 0, 64, 128, WB + wbo::EXTRA + (size_t)256 * 2048 + 64 * 128, nullptr, smf, tb);
        if (blockIdx.x < 16) {
            const int which = blockIdx.x >> 3, i = blockIdx.x & 7; const float* pos = which ? p.c_pos_v : p.c_pos_k; const float* w1 = which ? p.c_v_w1 : p.c_k_w1;
            float* b8 = (float*)(ws + 12 * fw::MB);
            if (TIDX < 128) { float a = 0.f; for (int k = i * 256; k < i * 256 + 256; ++k) a += pos[k] * w1[(size_t)k * 128 + TIDX]; b8[(which * 8 + i) * 128 + TIDX] = a; }
        }
    } else if (PH == PH_IN2) {
        gemm_sched(14, 1, [&](bool big, int mt, int nt) {
            if (big) gemm_tile2(ALoadPlain{XB, D}, WB + wbo::IN, 1024, mt * 128, nt * 256, EpiL2{P, (bf16*)(ws + 114 * fw::MB), (bf16*)(ws + 122 * fw::MB), parts}, smem);
            else gemm_tile(ALoadPlain{XB, D}, WB + wbo::IN, 1024, mt * 128, 3584 + nt * 128, EpiL2{P, (bf16*)(ws + 114 * fw::MB), (bf16*)(ws + 122 * fw::MB), parts}, smem);
        });
    } else if (PH == PH_B2) {
        for (int it = blockIdx.x; it < 64; it += gridDim.x) { const int which = it >> 5, rt = it & 31;
            cmp_tile(P, WB + wbo::EXTRA + (size_t)which * 128 * 2048, (const float*)(ws + 12 * fw::MB) + which * 8 * 128, WB + wbo::EXTRA + (size_t)256 * 2048 + which * 64 * 128, which, rt,
                     (bf16*)(ws + 5 * fw::MB), (bf16*)(ws + 6 * fw::MB), smem); }
        build_bias_lut(p.t5, smem, false);
        const int nwin = B * G * (T / (16 * ANQT_WIN));
        const bool split = gridDim.x == 512 && nwin == 2048;
        const int bid = blockIdx.x, nb = bid - 64, cnt = bid < 64 ? 2 : (nb < 128 ? 5 : 4);
        for (int k = 0;; ++k) {
            int item;
            if (split) { if (k >= cnt) break; item = bid < 64 ? k * 512 + 448 + bid : (k < 4 ? k * 512 + nb : (2 + (nb >> 6)) * 512 + 448 + (nb & 63)); }
            else { const int it = (bid < 64 ? bid + (int)gridDim.x : bid) + k * (int)gridDim.x; if (it >= 64 + nwin) break; item = it - 64; }
            win_item(P, (const bf16*)(ws + 122 * fw::MB), (bf16*)(ws + 130 * fw::MB), item, smem);
        }
    } else if (PH == PH_C2) {
        for (int it = blockIdx.x; it < B * G * (T / 32); it += gridDim.x)
            cmpsel_item(P, (const bf16*)(ws + 5 * fw::MB), (const bf16*)(ws + 6 * fw::MB), (bf16*)(ws + 162 * fw::MB), (unsigned long long*)(ws + 9 * fw::MB), it, smem);
    } else if (PH == PH_D2) {
        build_bias_lut(p.t5, smem, false);
        for (int it = blockIdx.x; it < B * G * (T / (16 * ANQT_SEL)); it += gridDim.x)
            sel_item(P, (const bf16*)(ws + 114 * fw::MB), (const unsigned long long*)(ws + 9 * fw::MB), (const bf16*)(ws + 162 * fw::MB), (const bf16*)(ws + 130 * fw::MB), (bf16*)(ws + 206 * fw::MB), it, smem);
    } else if (PH == PH_OUT2) {
        gemm_sched(4, 0, [&](bool, int mt, int nt) { gemm_tile2(ALoadPlain{(const bf16*)(ws + 206 * fw::MB), D}, WB + wbo::OUT, 1024, mt * 128, nt * 256, EpiResid{X, X, XB, parts}, smem); });
    } else if (PH == PH_PREP3) {
        int tb = 0;
        convert_seg(p.d_w_in, 2560, 0, 2560, 1024, WB + wbo::IN, p.norm_g + 3 * D, smf, tb);
        convert_seg(p.d_w_out, 1024, 0, 1024, 1280, WB + wbo::OUT, nullptr, smf, tb);
        lru_convert_gates(p.d_ga_w, p.d_gx_w, WB + wbo::EXTRA);
        for (int i = blockIdx.x * NTHREADS + TIDX; i < LW; i += gridDim.x * NTHREADS) ((float*)(ws + 12 * fw::MB + 786432))[i] = -8.0f * softplusf_(-p.d_lambda[i]);
    } else if (PH == PH_IN3) {
        gemm_sched(8, 4, [&](bool big, int mt, int nt) {
            if (big) gemm_tile2(ALoadPlain{XB, D}, WB + wbo::IN, 1024, mt * 128, nt * 256, EpiBf16{P, 2560, parts}, smem);
            else gemm_tile(ALoadPlain{XB, D}, WB + wbo::IN, 1024, mt * 128, 2048 + nt * 128, EpiBf16{P, 2560, parts}, smem);
        });
    } else if (PH == PH_GATE3) {
        for (int it = blockIdx.x; it < (M / 128) * 16; it += gridDim.x)
            lru_gate_item(P, p.d_conv_w, p.d_conv_b, WB + wbo::EXTRA, p.d_ga_b, p.d_gx_b, (const float*)(ws + 12 * fw::MB + 786432), (bf16*)(ws + wsl::L3_LA), (bf16*)(ws + wsl::L3_BV), (float2*)(ws + wsl::L3_UC), it, smem);
    } else if (PH == PH_SCANB3) {
        for (int it = blockIdx.x; it < B * (T / 64) * 5; it += gridDim.x)
            lru_scan2_item((const bf16*)(ws + wsl::L3_LA), (const bf16*)(ws + wsl::L3_BV), (const float2*)(ws + wsl::L3_UC), P, (bf16*)(ws + wsl::L3_AO), it);
    } else if (PH == PH_OUT3) {
        gemm_sched(4, 0, [&](bool, int mt, int nt) { gemm_tile2(ALoadPlain{(const bf16*)(ws + wsl::L3_AO), LW}, WB + wbo::OUT, 1280, mt * 128, nt * 256, EpiResid{X, X, nullptr, parts}, smem); });
    } else if (PH == PH_FINAL) {
        rows_final(X, parts, p.final_g);
    }
}

template <int PH> __global__ void __launch_bounds__(NTHREADS, 2) k_phase(Params p) {
    extern __shared__ __attribute__((aligned(16))) char smem[];
    run_phase<PH>(p, smem);
}
#define LDS_BYTES 73728
#define MEGA_LDS_BYTES (73728 + 64)
template <int PH> static void launch_phase(const Params& p, hipStream_t s) {
    static bool attr = false;
    if (!attr) { hipFuncSetAttribute((const void*)k_phase<PH>, hipFuncAttributeMaxDynamicSharedMemorySize, LDS_BYTES); attr = true; }
    hipLaunchKernelGGL(k_phase<PH>, dim3(512), dim3(NTHREADS), LDS_BYTES, s, p);
}


#define XB_TMO      128
#define XB_XCNT(j)  (256  + 64 * (j))
#define XB_XSUB(j)  (1280 + 64 * (j))
#define XB_XGEN(j)  (2304 + 64 * (j))
#define XB_TOP      3328
#define XB_TOPGEN   3392
#define XCD_BAR_WORDS 3456
#define XB_SPIN_CAP (1u << 22)
#define LAS __attribute__((address_space(3)))
DI unsigned xb_ld(unsigned* p)              { return __hip_atomic_load(p, __ATOMIC_RELAXED, __HIP_MEMORY_SCOPE_AGENT); }
DI unsigned xb_add(unsigned* p, unsigned v) { return __hip_atomic_fetch_add(p, v, __ATOMIC_RELAXED, __HIP_MEMORY_SCOPE_AGENT); }
DI unsigned xb_xcc_id() { return (unsigned)__builtin_amdgcn_s_getreg((3 << 11) | 20) & 0xFu; }
#define XB_SPIN(cond, bar) do { unsigned _sp = 0; while (cond) { if (_sp < 64u) __builtin_amdgcn_s_sleep(2); else __builtin_amdgcn_s_sleep(32); \
    if ((++_sp & 255u) == 0u) { if (xb_ld(&(bar)[XB_TMO])) break; if (_sp > XB_SPIN_CAP) { atomicAdd(&(bar)[XB_TMO], 1u); break; } } } } while (0)
struct XcdBarrier { unsigned* bar; unsigned x; volatile LAS unsigned* st; };
DI XcdBarrier xcd_barrier_post(unsigned* bar, volatile LAS unsigned* st) {
    XcdBarrier b; b.bar = bar; b.x = xb_xcc_id(); b.st = st;
    if (threadIdx.x == 0) (void)xb_add(&bar[XB_XCNT(b.x)], 1u);
    return b;
}
DI void xcd_barrier_complete(unsigned* bar, unsigned x, unsigned& nloc, unsigned& nx) {
    const unsigned G = gridDim.x * gridDim.y * gridDim.z;
    unsigned sum, cnt, mine, sp = 0u;
    for (;;) {
        sum = 0u; cnt = 0u; mine = 0u;
#pragma unroll
        for (unsigned j = 0; j < 16; ++j) { const unsigned c = xb_ld(&bar[XB_XCNT(j)]); sum += c; cnt += (c > 0u) ? 1u : 0u; mine = (j == x) ? c : mine; }
        if (sum == G) break;
        __builtin_amdgcn_s_sleep(1);
        if ((++sp & 255u) == 0u) { if (xb_ld(&bar[XB_TMO])) break; if (sp > XB_SPIN_CAP) { atomicAdd(&bar[XB_TMO], 1u); break; } }
    }
    nloc = mine > 0u ? mine : 1u; nx = cnt > 0u ? cnt : 1u;
}
DI void xcd_barrier(const XcdBarrier& b) {
    asm volatile("s_waitcnt vmcnt(0)" ::: "memory");
    __syncthreads();
    if (threadIdx.x == 0) {
        unsigned* bar = b.bar;
        __builtin_amdgcn_s_waitcnt(0);
        unsigned nloc = b.st[0], nx = b.st[1];
        if (nloc == 0u) { xcd_barrier_complete(bar, b.x, nloc, nx); b.st[0] = nloc; b.st[1] = nx; }
        const unsigned old = xb_add(&bar[XB_XSUB(b.x)], 1u);
        const unsigned gen = old / nloc;
        asm volatile("buffer_inv sc1" ::: "memory");
        if (old + 1u == (gen + 1u) * nloc) {
            __builtin_amdgcn_fence(__ATOMIC_RELEASE, "agent");
            asm volatile("s_waitcnt vmcnt(0)" ::: "memory");
            const unsigned og = xb_add(&bar[XB_TOP], 1u);
            const unsigned tg = og / nx;
            if (og + 1u == (tg + 1u) * nx) xb_add(&bar[XB_TOPGEN], 1u);
            else XB_SPIN(xb_ld(&bar[XB_TOPGEN]) == tg, bar);
            xb_add(&bar[XB_XGEN(b.x)], 1u);
            asm volatile("s_waitcnt vmcnt(0)" ::: "memory");
        } else {
            XB_SPIN(xb_ld(&bar[XB_XGEN(b.x)]) == gen, bar);
            asm volatile("s_waitcnt vmcnt(0)" ::: "memory");
        }
    }
    __syncthreads();
}

#define MEGA_PHASES(X) X(PH_IN0) X(PH_ATTN0) X(PH_OUT0) X(PH_PREP1) X(PH_IN1) X(PH_LORA1) X(PH_CPREP1) X(PH_SCAN1) X(PH_GN1) X(PH_OUT1) \
    X(PH_PREP2) X(PH_IN2) X(PH_B2) X(PH_C2) X(PH_D2) X(PH_OUT2) X(PH_PREP3) X(PH_IN3) X(PH_GATE3) X(PH_SCANB3) X(PH_OUT3)
__global__ void __launch_bounds__(NTHREADS, 2) mega_kernel(Params p) {
    extern __shared__ __attribute__((aligned(16))) char smem[];
    cooperative_groups::grid_group grid = cooperative_groups::this_grid();
    volatile LAS unsigned* xst = (volatile LAS unsigned*)(smem + 73728);
    if (threadIdx.x < 4) xst[threadIdx.x] = 0u;
    __syncthreads();
    XcdBarrier xb = xcd_barrier_post((unsigned*)p.ws, xst);
    run_phase<PH_PREP0>(p, smem);
    if (p.ws == nullptr) grid.sync();
    xcd_barrier(xb);
#define MEGA_STEP(ph) run_phase<ph>(p, smem); xcd_barrier(xb);
    MEGA_PHASES(MEGA_STEP)
#undef MEGA_STEP
    run_phase<PH_FINAL>(p, smem);
}
static void launch_mega(const Params& p, hipStream_t s) {
    static int grid_blocks = 0;
    if (!grid_blocks) {
        int dev = 0, cus = 0, per_cu = 0;
        hipGetDevice(&dev);
        hipDeviceGetAttribute(&cus, hipDeviceAttributeMultiprocessorCount, dev);
        hipFuncSetAttribute((const void*)mega_kernel, hipFuncAttributeMaxDynamicSharedMemorySize, MEGA_LDS_BYTES);
        hipOccupancyMaxActiveBlocksPerMultiprocessor(&per_cu, mega_kernel, NTHREADS, MEGA_LDS_BYTES);
        if (per_cu > 2) per_cu = 2;
        if (per_cu < 1) per_cu = 1;
        grid_blocks = cus * per_cu;
    }
    hipMemsetAsync(p.ws, 0, 16384, s);
    Params pp = p; void* args[] = {&pp};
    hipError_t e = hipLaunchCooperativeKernel((const void*)mega_kernel, dim3(grid_blocks), dim3(NTHREADS), args, MEGA_LDS_BYTES, s);
    if (e != hipSuccess) fprintf(stderr, "cooperative launch failed: %s (grid %d)\n", hipGetErrorString(e), grid_blocks);
}
#endif

#ifndef CPU_SHIM
template <class F> __global__ void __launch_bounds__(256) k_run(F f, long n) {
    const long i = (long)blockIdx.x * 256 + threadIdx.x; if (i < n) f(i);
}
template <class F> static void launch(const F& f, long n, hipStream_t s) {
    hipLaunchKernelGGL(k_run<F>, dim3((unsigned)((n + 255) / 256)), dim3(256), 0, s, f, n);
}
#else
template <class F> static void launch(const F& f, long n, hipStream_t) {
#pragma omp parallel for schedule(dynamic, 64)
    for (long i = 0; i < n; ++i) f(i);
}
#endif

#ifdef CPU_SHIM
void cpu_layer_hook(int layer, const float* X, const char* ws);
#define LAYER_HOOK(l) cpu_layer_hook(l, X, ws)
#else
#define LAYER_HOOK(l)
#endif

#define FAST_GEMM 0
#if FAST_GEMM
#define FASTP(ph) launch_phase<ph>(p, s)
#else
#define FASTP(ph)
#endif

static void run_naive(const Params& p, hipStream_t s) {
    char* ws = p.ws;
    float* rs = (float*)(ws + wsl::RS);
    bf16* P = (bf16*)(ws + wsl::P);
    float* X = p.out;
    (void)rs;
    {
        bf16* AO = (bf16*)(ws + wsl::L0_AO);
#if FAST_GEMM
        FASTP(PH_PREP0); FASTP(PH_IN0);
#else
        launch(RstdF{p.x, rs}, M, s);
        launch(GemmInF{p.x, rs, p.norm_g + 0 * D, p.a_w_in, P, A_COLS}, (long)M * (A_COLS / 4), s);
#endif
#if FAST_GEMM
        FASTP(PH_ATTN0); (void)AO;
#else
        launch(SwaF{P, p.t5, p.a_sinks, AO}, (long)M * H, s);
#endif
#if FAST_GEMM
        FASTP(PH_OUT0);
#else
        launch(GemmOutF{AO, p.a_w_out, p.x, X, 1024}, (long)M * (D / 4), s);
#endif
    }
    LAYER_HOOK(0);
    {
        bf16* XN = (bf16*)(ws + wsl::L1_XN); bf16* WL = (bf16*)(ws + wsl::L1_WL); bf16* AV = (bf16*)(ws + wsl::L1_AV);
        float* hw = (float*)(ws + wsl::LHW); float* ha = (float*)(ws + wsl::LHA);
#if FAST_GEMM
        FASTP(PH_PREP1); FASTP(PH_IN1); FASTP(PH_LORA1); FASTP(PH_CPREP1); FASTP(PH_SCAN1); FASTP(PH_GN1); FASTP(PH_OUT1);
        (void)XN; (void)WL; (void)AV; (void)hw; (void)ha;
#else
        launch(RstdF{X, rs}, M, s);
        launch(XnF{X, rs, p.norm_g + 1 * D, XN}, (long)M * D, s);
        launch(GemmRwkvF{XN, p.b_mu, p.b_w_in, P}, (long)M * 1024, s);
        launch(LoraHidF{XN, p.b_mu, p.b_w1, p.b_a1, hw, ha}, (long)M * 128, s);
        launch(LoraOutF{hw, ha, p.b_w0, p.b_w2, p.b_a0, p.b_a2, WL, AV}, (long)M * D, s);
        launch(RwkvScanF{P, WL, AV, p.b_k_k, p.b_k_a, XN}, (long)B * H * 64, s);
        launch(RwkvGnF{P, AV, p.b_k_a, p.b_r_k, p.b_lnx_w, p.b_lnx_b, XN}, (long)M * H, s);
        launch(GemmOutF{XN, p.b_w_out, X, X, 1024}, (long)M * (D / 4), s);
#endif
    }
    LAYER_HOOK(1);
    {
        float* hk = (float*)(ws + wsl::HK); float* hv = (float*)(ws + wsl::HV);
        float* kc = (float*)(ws + wsl::KC); float* vc = (float*)(ws + wsl::VC);
        float* st = (float*)(ws + wsl::ST); int* sel = (int*)(ws + wsl::SEL); float* imp = (float*)(ws + wsl::L2_IMP);
        bf16* AO = (bf16*)(ws + wsl::L2_AO); bf16* OC = (bf16*)(ws + wsl::L2_OC); bf16* OS = (bf16*)(ws + wsl::L2_OS);
#if FAST_GEMM
        FASTP(PH_PREP2); FASTP(PH_IN2); FASTP(PH_B2); FASTP(PH_C2); FASTP(PH_D2); FASTP(PH_OUT2);
        (void)hk; (void)hv; (void)kc; (void)vc; (void)st; (void)sel; (void)imp; (void)AO; (void)OC; (void)OS;
#else
        launch(RstdF{X, rs}, M, s);
        launch(GemmInF{X, rs, p.norm_g + 2 * D, p.c_w_in, P, C_COLS}, (long)M * (C_COLS / 4), s);
        launch(CmpHidF{P, p.c_pos_k, p.c_k_w1, p.c_pos_v, p.c_v_w1, hk, hv}, 2L * B * G * NCMP * 128, s);
        launch(CmpOutF{hk, hv, p.c_k_w2, p.c_v_w2, kc, vc}, 2L * B * G * NCMP * 64, s);
        launch(CmpAttnF{P, kc, vc, st, OC}, (long)M * H, s);
        launch(ImpF{P, kc, st, imp}, (long)M * G * NSEL, s);
        launch(TopkF{imp, sel}, (long)M * G, s);
        launch(SelAttnF{P, p.t5, sel, OS}, (long)M * H, s);
        launch(WinAttnF{P, p.t5, OC, OS, AO}, (long)M * H, s);
        LAYER_HOOK(20);
        launch(GemmOutF{AO, p.c_w_out, X, X, 1024}, (long)M * (D / 4), s);
#endif
    }
    LAYER_HOOK(2);
    {
        bf16* AO = (bf16*)(ws + wsl::L3_AO); bf16* UC = (bf16*)(ws + wsl::L3_UC); bf16* LA = (bf16*)(ws + wsl::L3_LA); bf16* BV = (bf16*)(ws + wsl::L3_BV);
#if FAST_GEMM
        FASTP(PH_PREP3); FASTP(PH_IN3); FASTP(PH_GATE3); FASTP(PH_SCANA3); FASTP(PH_SCANB3); FASTP(PH_OUT3);
        (void)AO; (void)UC; (void)LA; (void)BV;
#else
        launch(RstdF{X, rs}, M, s);
        launch(GemmInF{X, rs, p.norm_g + 3 * D, p.d_w_in, P, 2560}, (long)M * (2560 / 4), s);
        launch(ConvF{P, p.d_conv_w, p.d_conv_b, UC}, (long)M * LW, s);
        launch(LruGateF{UC, p.d_ga_w, p.d_ga_b, p.d_gx_w, p.d_gx_b, p.d_lambda, LA, BV}, (long)M * LW, s);
        launch(LruScanF{P, LA, BV, AO}, (long)B * LW, s);
        launch(GemmOutF{AO, p.d_w_out, X, X, LW}, (long)M * (D / 4), s);
#endif
    }
    LAYER_HOOK(3);
#if FAST_GEMM
    FASTP(PH_FINAL);
#else
    launch(FinalNormF{X, p.final_g}, M, s);
#endif
}

extern "C" void kernel_launch(void* const* d_in, const int* in_sizes, int n_in, void* d_out, int out_size, void* d_ws, size_t ws_size,
                              hipStream_t stream) {
    (void)in_sizes; (void)n_in; (void)out_size; (void)ws_size;
    Params p{};
    const float* const* in = (const float* const*)d_in;
    int k = 0;
    p.x = in[k++]; p.t5 = in[k++]; p.norm_g = in[k++]; p.final_g = in[k++];
    p.a_w_in = in[k++]; p.a_sinks = in[k++]; p.a_w_out = in[k++];
    p.b_mu = in[k++]; p.b_w_in = in[k++]; p.b_w0 = in[k++]; p.b_w1 = in[k++]; p.b_w2 = in[k++]; p.b_a0 = in[k++]; p.b_a1 = in[k++]; p.b_a2 = in[k++];
    p.b_k_k = in[k++]; p.b_k_a = in[k++]; p.b_r_k = in[k++]; p.b_lnx_w = in[k++]; p.b_lnx_b = in[k++]; p.b_w_out = in[k++];
    p.c_w_in = in[k++]; p.c_pos_k = in[k++]; p.c_k_w1 = in[k++]; p.c_k_w2 = in[k++]; p.c_pos_v = in[k++]; p.c_v_w1 = in[k++]; p.c_v_w2 = in[k++]; p.c_w_out = in[k++];
    p.d_w_in = in[k++]; p.d_conv_w = in[k++]; p.d_conv_b = in[k++]; p.d_ga_w = in[k++]; p.d_ga_b = in[k++]; p.d_gx_w = in[k++]; p.d_gx_b = in[k++];
    p.d_lambda = in[k++]; p.d_w_out = in[k++];
    p.out = (float*)d_out; p.ws = (char*)d_ws;
#if !defined(CPU_SHIM) && !defined(MULTI_LAUNCH) && !defined(ALL_NAIVE)
    launch_mega(p, stream);
#else
    run_naive(p, stream);
#endif
}
```

```cpp
#ifndef CPU_SHIM
#include <hip/hip_runtime.h>
#include <hip/hip_cooperative_groups.h>
#include <cstdio>
#define HD __host__ __device__ __forceinline__
#else
#include <cmath>
#include <cstring>
#include <cstdio>
#include <cstdlib>
#include <cstdint>
#define HD inline
typedef void* hipStream_t;
#endif
#include <cstddef>

#ifndef CFG_B
#define CFG_B 4
#endif
#ifndef CFG_T
#define CFG_T 4096
#endif

namespace cfg {
constexpr int B = CFG_B, T = CFG_T, M = B * T, D = 1024;
constexpr int H = 16, G = 4, R = 4, DH = 64;
constexpr int A_COLS = 2560;
constexpr int C_COLS = 3632;
constexpr int NCMP = (T - 32) / 16 + 1;
constexpr int NSEL = T / 64;
constexpr int KTOP = NSEL < 16 ? NSEL : 16;
constexpr int LW = 1280;
}
using namespace cfg;

typedef unsigned short bf16;

HD unsigned f_as_u(float f) {
#ifndef CPU_SHIM
    return __float_as_uint(f);
#else
    unsigned u; memcpy(&u, &f, 4); return u;
#endif
}
HD float u_as_f(unsigned u) {
#ifndef CPU_SHIM
    return __uint_as_float(u);
#else
    float f; memcpy(&f, &u, 4); return f;
#endif
}
HD float bf2f(bf16 v) { return u_as_f(((unsigned)v) << 16); }
HD bf16 f2bf(float f) { unsigned u = f_as_u(f); u += 0x7fffu + ((u >> 16) & 1u); return (bf16)(u >> 16); }
HD float sigmoidf_(float x) { return 1.0f / (1.0f + expf(-x)); }
HD float siluf_(float x) { return x / (1.0f + expf(-x)); }
HD float softplusf_(float x) { return x > 20.f ? x : log1pf(expf(x)); }

HD int t5_bucket(int d) {
    if (d < 16) return d < 0 ? 0 : d;
    if (d >= 113) return 31;
    if (d >= 99) return 30;
    if (d >= 87) return 29;
    if (d >= 77) return 28;
    if (d >= 67) return 27;
    if (d >= 59) return 26;
    if (d >= 52) return 25;
    if (d >= 46) return 24;
    if (d >= 40) return 23;
    if (d >= 35) return 22;
    if (d >= 31) return 21;
    if (d >= 27) return 20;
    if (d >= 24) return 19;
    if (d >= 21) return 18;
    if (d >= 19) return 17;
    return 16;
}

struct Params {
    const float *x, *t5, *norm_g, *final_g;
    const float *a_w_in, *a_sinks, *a_w_out;
    const float *b_mu, *b_w_in, *b_w0, *b_w1, *b_w2, *b_a0, *b_a1, *b_a2, *b_k_k, *b_k_a, *b_r_k, *b_lnx_w, *b_lnx_b, *b_w_out;
    const float *c_w_in, *c_pos_k, *c_k_w1, *c_k_w2, *c_pos_v, *c_v_w1, *c_v_w2, *c_w_out;
    const float *d_w_in, *d_conv_w, *d_conv_b, *d_ga_w, *d_ga_b, *d_gx_w, *d_gx_b, *d_lambda, *d_w_out;
    float* out;
    char* ws;
};

namespace wsl {
constexpr size_t MB = 1024 * 1024;
constexpr size_t RS = 0;
constexpr size_t HK = 1 * MB;
constexpr size_t HV = 3 * MB;
constexpr size_t KC = 5 * MB;
constexpr size_t VC = 6 * MB;
constexpr size_t ST = 7 * MB;
constexpr size_t SEL = 9 * MB;
constexpr size_t LHW = 1 * MB;
constexpr size_t LHA = 5 * MB;
constexpr size_t P = 14 * MB;
constexpr size_t SZ1024 = (size_t)M * 1024 * 2, SZ1280 = (size_t)M * 1280 * 2;
constexpr size_t L0_AO = P + (size_t)M * 2560 * 2;
constexpr size_t L1_XN = P + (size_t)M * 4096 * 2, L1_WL = L1_XN + SZ1024, L1_AV = L1_WL + SZ1024;
constexpr size_t L2_AO = P + (size_t)M * 3632 * 2, L2_OC = L2_AO + SZ1024, L2_OS = L2_OC + SZ1024, L2_IMP = L2_OS + SZ1024;
constexpr size_t L3_AO = P + (size_t)M * 2560 * 2, L3_UC = L3_AO + SZ1280, L3_LA = L3_UC + SZ1280, L3_BV = L3_LA + SZ1280;
constexpr size_t TOTAL = L3_BV + SZ1280;
}

struct RstdF {
    const float* x; float* rs;
    HD void operator()(long m) const {
        const float* r = x + (size_t)m * D; float s = 0.f;
        for (int k = 0; k < D; ++k) s += r[k] * r[k];
        rs[m] = 1.0f / sqrtf(s / D + 1e-6f);
    }
};
struct XnF {
    const float* x; const float* rs; const float* g; bf16* xn;
    HD void operator()(long i) const { long m = i / D; int k = (int)(i % D); xn[i] = f2bf(x[i] * rs[m] * g[k]); }
};
struct GemmInF {
    const float *x, *rs, *g, *W; bf16* P; long long N;
    HD void operator()(long i) const {
        const int n4 = (int)N / 4; const long m = i / n4; const int n = (int)(i % n4) * 4;
        const float* xr = x + (size_t)m * D; const float r = rs[m];
        float a0 = 0, a1 = 0, a2 = 0, a3 = 0;
        for (int k = 0; k < D; ++k) {
            const float a = xr[k] * r * g[k]; const float* w = W + (size_t)k * N + n;
            a0 += a * w[0]; a1 += a * w[1]; a2 += a * w[2]; a3 += a * w[3];
        }
        bf16* p = P + (size_t)m * N + n; p[0] = f2bf(a0); p[1] = f2bf(a1); p[2] = f2bf(a2); p[3] = f2bf(a3);
    }
};
struct GemmOutF {
    const bf16* A; const float* W; const float* xin; float* xout; long long K;
    HD void operator()(long i) const {
        const int n4 = D / 4; const long m = i / n4; const int n = (int)(i % n4) * 4;
        const bf16* ar = A + (size_t)m * K;
        float a0 = 0, a1 = 0, a2 = 0, a3 = 0;
        for (int k = 0; k < K; ++k) {
            const float a = bf2f(ar[k]); const float* w = W + (size_t)k * D + n;
            a0 += a * w[0]; a1 += a * w[1]; a2 += a * w[2]; a3 += a * w[3];
        }
        const float* xi = xin + (size_t)m * D + n; float* xo = xout + (size_t)m * D + n;
        xo[0] = xi[0] + a0; xo[1] = xi[1] + a1; xo[2] = xi[2] + a2; xo[3] = xi[3] + a3;
    }
};

struct SwaF {
    const bf16* P; const float* t5; const float* sinks; bf16* AO;
    HD void operator()(long i) const {
        const long m = i / H; const int h = (int)(i % H), g = h / R; const int t = (int)(m % T); const long mb = m - t;
        float q[DH], o[DH];
#pragma unroll
        for (int d = 0; d < DH; ++d) { q[d] = bf2f(P[(size_t)m * A_COLS + h * DH + d]); o[d] = 0.f; }
        float mx = sinks[h], l = 1.0f;
        const int s0 = t - 127 < 0 ? 0 : t - 127;
        for (int s = s0; s <= t; ++s) {
            const bf16* kr = P + (size_t)(mb + s) * A_COLS + 1024 + g * DH;
            const bf16* vr = kr + 256;
            float sc = 0.f;
#pragma unroll
            for (int d = 0; d < DH; ++d) sc += q[d] * bf2f(kr[d]);
            sc = sc * 0.125f + t5[t5_bucket(t - s) * H + h];
            const float mn = sc > mx ? sc : mx; const float al = expf(mx - mn), p = expf(sc - mn);
            l = l * al + p; mx = mn;
#pragma unroll
            for (int d = 0; d < DH; ++d) o[d] = o[d] * al + p * bf2f(vr[d]);
        }
        const float il = 1.0f / l;
#pragma unroll
        for (int d = 0; d < DH; ++d) {
            const float z = bf2f(P[(size_t)m * A_COLS + 1536 + h * DH + d]);
            AO[(size_t)m * D + h * DH + d] = f2bf(o[d] * il * siluf_(z));
        }
    }
};

struct GemmRwkvF {
    const bf16* xn; const float* mu; const float* W; bf16* P;
    HD void operator()(long i) const {
        const int N = 4096, n4 = N / 4; const long m = i / n4; const int n = (int)(i % n4) * 4; const int s = n / 1024;
        const int t = (int)(m % T);
        const bf16* xr = xn + (size_t)m * D; const float* mus = mu + s * D;
        float a0 = 0, a1 = 0, a2 = 0, a3 = 0;
        for (int k = 0; k < D; ++k) {
            const float xc = bf2f(xr[k]); const float xp = t > 0 ? bf2f(xr[k - D]) : 0.f;
            const float a = xc + (xp - xc) * mus[k]; const float* w = W + (size_t)k * N + n;
            a0 += a * w[0]; a1 += a * w[1]; a2 += a * w[2]; a3 += a * w[3];
        }
        bf16* p = P + (size_t)m * N + n; p[0] = f2bf(a0); p[1] = f2bf(a1); p[2] = f2bf(a2); p[3] = f2bf(a3);
    }
};
struct LoraHidF {
    const bf16* xn; const float* mu; const float* w1; const float* a1; float* hw; float* ha;
    HD void operator()(long i) const {
        const long m = i / 128; const int jj = (int)(i % 128); const int which = jj / 64, j = jj % 64; const int t = (int)(m % T);
        const bf16* xr = xn + (size_t)m * D; const float* mus = mu + (4 + which) * D; const float* W = which ? a1 : w1;
        float acc = 0.f;
        for (int k = 0; k < D; ++k) {
            const float xc = bf2f(xr[k]); const float xp = t > 0 ? bf2f(xr[k - D]) : 0.f;
            acc += (xc + (xp - xc) * mus[k]) * W[(size_t)k * 64 + j];
        }
        if (which) ha[(size_t)m * 64 + j] = acc; else hw[(size_t)m * 64 + j] = tanhf(acc);
    }
};
struct LoraOutF {
    const float *hw, *ha, *w0, *w2, *a0, *a2; bf16* wlog; bf16* av;
    HD void operator()(long i) const {
        const long m = i / D; const int c = (int)(i % D);
        float sw = 0.f, sa = 0.f;
        for (int j = 0; j < 64; ++j) { sw += hw[(size_t)m * 64 + j] * w2[(size_t)j * D + c]; sa += ha[(size_t)m * 64 + j] * a2[(size_t)j * D + c]; }
        const float wr = -softplusf_(-(w0[c] + sw)) - 0.5f;
        wlog[i] = f2bf(-expf(wr)); av[i] = f2bf(sigmoidf_(a0[c] + sa));
    }
};
struct RwkvScanF {
    const bf16* P; const bf16* wlog; const bf16* av; const float* k_k; const float* k_a; bf16* ys;
    HD void operator()(long idx) const {
        const int i = (int)(idx % 64); const int h = (int)((idx / 64) % H); const int b = (int)(idx / (64 * H));
        float S[64];
#pragma unroll
        for (int j = 0; j < 64; ++j) S[j] = 0.f;
        for (int t = 0; t < T; ++t) {
            const size_t m = (size_t)b * T + t; const bf16* pr = P + m * 4096 + h * 64;
            const bf16* wl = wlog + m * D + h * 64; const bf16* ar = av + m * D + h * 64;
            float n2 = 0.f;
#pragma unroll
            for (int j = 0; j < 64; ++j) { const float kk = bf2f(pr[1024 + j]) * k_k[h * 64 + j]; n2 += kk * kk; }
            float nr = sqrtf(n2); nr = nr > 1e-12f ? nr : 1e-12f; const float inr = 1.0f / nr;
            float sa = 0.f;
#pragma unroll
            for (int j = 0; j < 64; ++j) { const float kk = bf2f(pr[1024 + j]) * k_k[h * 64 + j] * inr; sa += S[j] * (-kk); }
            const float vi = bf2f(pr[2048 + i]); float y = 0.f;
#pragma unroll
            for (int j = 0; j < 64; ++j) {
                const float kr = bf2f(pr[1024 + j]); const float a = bf2f(ar[j]);
                const float kk = kr * k_k[h * 64 + j] * inr; const float kp = kr * (1.0f + (a - 1.0f) * k_a[h * 64 + j]);
                const float dec = expf(bf2f(wl[j]));
                S[j] = S[j] * dec + sa * (kk * a) + vi * kp;
                y += S[j] * bf2f(pr[j]);
            }
            ys[m * D + h * 64 + i] = f2bf(y);
        }
    }
};
struct RwkvGnF {
    const bf16* P; const bf16* av; const float *k_a, *r_k, *lnx_w, *lnx_b; bf16* ys;
    HD void operator()(long idx) const {
        const long m = idx / H; const int h = (int)(idx % H);
        bf16* yr = ys + (size_t)m * D + h * 64; const bf16* pr = P + (size_t)m * 4096 + h * 64; const bf16* ar = av + (size_t)m * D + h * 64;
        float mean = 0.f;
        for (int j = 0; j < 64; ++j) mean += bf2f(yr[j]);
        mean /= 64.f; float var = 0.f;
        for (int j = 0; j < 64; ++j) { const float d = bf2f(yr[j]) - mean; var += d * d; }
        var /= 64.f; const float rstd = 1.0f / sqrtf(var + 64e-5f);
        float bs = 0.f;
        for (int j = 0; j < 64; ++j) { const float kr = bf2f(pr[1024 + j]); const float kp = kr * (1.0f + (bf2f(ar[j]) - 1.0f) * k_a[h * 64 + j]); bs += bf2f(pr[j]) * kp * r_k[h * 64 + j]; }
        for (int j = 0; j < 64; ++j) {
            const float yn = (bf2f(yr[j]) - mean) * rstd * lnx_w[h * 64 + j] + lnx_b[h * 64 + j];
            const float z = bf2f(pr[3072 + j]);
            yr[j] = f2bf((yn + bs * bf2f(pr[2048 + j])) * siluf_(z));
        }
    }
};

struct CmpHidF {
    const bf16* P; const float *pos_k, *w1_k, *pos_v, *w1_v; float* hk; float* hv;
    HD void operator()(long idx) const {
        const int j = (int)(idx % 128); long r = idx / 128; const int n = (int)(r % NCMP); r /= NCMP; const int g = (int)(r % G); r /= G;
        const int b = (int)(r % B); const int which = (int)(r / B);
        const float* pos = which ? pos_v : pos_k; const float* w1 = which ? w1_v : w1_k; const int col = 1024 + (which ? 256 : 0) + g * 64;
        float acc = 0.f;
        for (int l = 0; l < 32; ++l) {
            const bf16* src = P + (size_t)(b * T + 16 * n + l) * C_COLS + col;
            for (int d = 0; d < 64; ++d) acc += (bf2f(src[d]) + pos[l * 64 + d]) * w1[(size_t)(l * 64 + d) * 128 + j];
        }
        (which ? hv : hk)[(((size_t)b * G + g) * NCMP + n) * 128 + j] = siluf_(acc);
    }
};
struct CmpOutF {
    const float *hk, *hv, *w2_k, *w2_v; float* kc; float* vc;
    HD void operator()(long idx) const {
        const int d = (int)(idx % 64); long r = idx / 64; const long row = r % ((long)B * G * NCMP); const int which = (int)(r / ((long)B * G * NCMP));
        const float* hsrc = (which ? hv : hk) + (size_t)row * 128; const float* w2 = which ? w2_v : w2_k;
        float acc = 0.f;
        for (int j = 0; j < 128; ++j) acc += hsrc[j] * w2[j * 64 + d];
        (which ? vc : kc)[(size_t)row * 64 + d] = acc;
    }
};
struct CmpAttnF {
    const bf16* P; const float *kc, *vc; float* st; bf16* oc;
    HD void operator()(long i) const {
        const long m = i / H; const int h = (int)(i % H), g = h / R; const int t = (int)(m % T); const int b = (int)(m / T);
        float q[DH], o[DH];
#pragma unroll
        for (int d = 0; d < DH; ++d) { q[d] = bf2f(P[(size_t)m * C_COLS + h * DH + d]); o[d] = 0.f; }
        const int nv = t < 31 ? 0 : (t - 31) / 16 + 1;
        float mx = -1e30f, l = 0.f;
        for (int n = 0; n < nv; ++n) {
            const float* kr = kc + (((size_t)b * G + g) * NCMP + n) * 64; const float* vr = vc + (((size_t)b * G + g) * NCMP + n) * 64;
            float sc = 0.f;
#pragma unroll
            for (int d = 0; d < DH; ++d) sc += q[d] * kr[d];
            sc *= 0.125f;
            const float mn = sc > mx ? sc : mx; const float al = expf(mx - mn), p = expf(sc - mn);
            l = l * al + p; mx = mn;
#pragma unroll
            for (int d = 0; d < DH; ++d) o[d] = o[d] * al + p * vr[d];
        }
        const float il = nv > 0 ? 1.0f / l : 0.f;
        st[(size_t)i * 2] = mx; st[(size_t)i * 2 + 1] = il;
#pragma unroll
        for (int d = 0; d < DH; ++d) oc[(size_t)m * D + h * DH + d] = f2bf(o[d] * il);
    }
};
struct ImpF {
    const bf16* P; const float *kc, *st; float* imp;
    HD void operator()(long idx) const {
        const int s = (int)(idx % NSEL); long r = idx / NSEL; const int g = (int)(r % G); const long m = r / G;
        const int t = (int)(m % T); const int b = (int)(m / T); const int cur = t / 64;
        float v;
        if (s == 0 || s == cur || s == cur - 1) v = 1e30f;
        else if (s * 64 > t) v = -1e30f;
        else {
            v = 0.f; const int nv = t < 31 ? 0 : (t - 31) / 16 + 1;
            int n0 = 4 * s - 1; if (n0 < 0) n0 = 0; int n1 = 4 * s + 3; if (n1 > NCMP - 1) n1 = NCMP - 1; if (n1 > nv - 1) n1 = nv - 1;
            for (int rr = 0; rr < R; ++rr) {
                const int h = g * R + rr; const bf16* qr = P + (size_t)m * C_COLS + h * DH;
                const float mx = st[((size_t)m * H + h) * 2], il = st[((size_t)m * H + h) * 2 + 1];
                for (int n = n0; n <= n1; ++n) {
                    const float* kr = kc + (((size_t)b * G + g) * NCMP + n) * 64; float sc = 0.f;
                    for (int d = 0; d < DH; ++d) sc += bf2f(qr[d]) * kr[d];
                    v += expf(sc * 0.125f - mx) * il;
                }
            }
        }
        imp[idx] = v;
    }
};
struct TopkF {
    const float* imp; int* sel;
    HD void operator()(long idx) const {
        const float* v = imp + (size_t)idx * NSEL; unsigned long long used = 0ull;
        for (int j = 0; j < KTOP; ++j) {
            int best = -1; float bv = 0.f;
            for (int s = 0; s < NSEL; ++s) { if ((used >> s) & 1ull) continue; const float x = v[s]; if (best < 0 || x > bv) { best = s; bv = x; } }
            used |= 1ull << best; sel[(size_t)idx * 16 + j] = best;
        }
    }
};
struct SelAttnF {
    const bf16* P; const float* t5; const int* sel; bf16* os;
    HD void operator()(long i) const {
        const long m = i / H; const int h = (int)(i % H), g = h / R; const int t = (int)(m % T); const long mb = m - t;
        float q[DH], o[DH];
#pragma unroll
        for (int d = 0; d < DH; ++d) { q[d] = bf2f(P[(size_t)m * C_COLS + h * DH + d]); o[d] = 0.f; }
        float mx = -1e30f, l = 0.f;
        for (int j = 0; j < KTOP; ++j) {
            const int blk = sel[((size_t)m * G + g) * 16 + j];
            for (int ll = 0; ll < 64; ++ll) {
                const int s = blk * 64 + ll; if (s > t) break;
                const bf16* kr = P + (size_t)(mb + s) * C_COLS + 1536 + g * DH; const bf16* vr = kr + 256;
                float sc = 0.f;
#pragma unroll
                for (int d = 0; d < DH; ++d) sc += q[d] * bf2f(kr[d]);
                sc = sc * 0.125f + t5[t5_bucket(t - s) * H + h];
                const float mn = sc > mx ? sc : mx; const float al = expf(mx - mn), p = expf(sc - mn);
                l = l * al + p; mx = mn;
#pragma unroll
                for (int d = 0; d < DH; ++d) o[d] = o[d] * al + p * bf2f(vr[d]);
            }
        }
        const float il = 1.0f / l;
#pragma unroll
        for (int d = 0; d < DH; ++d) os[(size_t)m * D + h * DH + d] = f2bf(o[d] * il);
    }
};
struct WinAttnF {
    const bf16* P; const float* t5; const bf16* oc; const bf16* os; bf16* AO;
    HD void operator()(long i) const {
        const long m = i / H; const int h = (int)(i % H), g = h / R, rr = h % R; const int t = (int)(m % T); const long mb = m - t;
        float q[DH], o[DH];
#pragma unroll
        for (int d = 0; d < DH; ++d) { q[d] = bf2f(P[(size_t)m * C_COLS + h * DH + d]); o[d] = 0.f; }
        float mx = -1e30f, l = 0.f;
        const int s0 = t - 511 < 0 ? 0 : t - 511;
        for (int s = s0; s <= t; ++s) {
            const bf16* kr = P + (size_t)(mb + s) * C_COLS + 2048 + g * DH; const bf16* vr = kr + 256;
            float sc = 0.f;
#pragma unroll
            for (int d = 0; d < DH; ++d) sc += q[d] * bf2f(kr[d]);
            sc = sc * 0.125f + t5[t5_bucket(t - s) * H + h];
            const float mn = sc > mx ? sc : mx; const float al = expf(mx - mn), p = expf(sc - mn);
            l = l * al + p; mx = mn;
#pragma unroll
            for (int d = 0; d < DH; ++d) o[d] = o[d] * al + p * bf2f(vr[d]);
        }
        const float il = 1.0f / l;
        const bf16* gr = P + (size_t)m * C_COLS + 2560;
        const float g0 = sigmoidf_(bf2f(gr[0 * 16 + g * R + rr])), g1 = sigmoidf_(bf2f(gr[1 * 16 + g * R + rr])), g2 = sigmoidf_(bf2f(gr[2 * 16 + g * R + rr]));
#pragma unroll
        for (int d = 0; d < DH; ++d) {
            const size_t oi = (size_t)m * D + h * DH + d;
            const float z = bf2f(P[(size_t)m * C_COLS + 2608 + h * DH + d]);
            AO[oi] = f2bf((g0 * bf2f(oc[oi]) + g1 * bf2f(os[oi]) + g2 * o[d] * il) * siluf_(z));
        }
    }
};

struct ConvF {
    const bf16* P; const float *cw, *cb; bf16* uc;
    HD void operator()(long i) const {
        const long m = i / LW; const int c = (int)(i % LW); const int t = (int)(m % T);
        float acc = cb[c];
        for (int w = 0; w < 4; ++w) { const int tt = t - 3 + w; if (tt >= 0) acc += cw[w * LW + c] * bf2f(P[(size_t)(m - 3 + w) * 2560 + c]); }
        uc[i] = f2bf(acc);
    }
};
struct LruGateF {
    const bf16* uc; const float *gaw, *gab, *gxw, *gxb, *lam; bf16* la; bf16* bv;
    HD void operator()(long i) const {
        const long m = i / LW; const int c = (int)(i % LW); const int n = c / 80, d = c % 80;
        const bf16* ub = uc + (size_t)m * LW + n * 80; float ra = gab[c], rx = gxb[c];
        for (int k = 0; k < 80; ++k) { const float u = bf2f(ub[k]); ra += u * gaw[((size_t)n * 80 + k) * 80 + d]; rx += u * gxw[((size_t)n * 80 + k) * 80 + d]; }
        const float r = sigmoidf_(ra), ig = sigmoidf_(rx);
        const float loga = -8.0f * r * softplusf_(-lam[c]);
        la[i] = f2bf(loga);
        bv[i] = f2bf(sqrtf(-expm1f(2.0f * loga)) * (ig * bf2f(uc[i])));
    }
};
struct LruScanF {
    const bf16* P; const bf16* la; const bf16* bv; bf16* AO;
    HD void operator()(long idx) const {
        const int c = (int)(idx % LW); const int b = (int)(idx / LW); float h = 0.f;
        for (int t = 0; t < T; ++t) {
            const size_t m = (size_t)b * T + t;
            h = expf(bf2f(la[m * LW + c])) * h + bf2f(bv[m * LW + c]);
            AO[m * LW + c] = f2bf(h * siluf_(bf2f(P[m * 2560 + LW + c])));
        }
    }
};
struct FinalNormF {
    float* x; const float* g;
    HD void operator()(long m) const {
        float* r = x + (size_t)m * D; float s = 0.f;
        for (int k = 0; k < D; ++k) s += r[k] * r[k];
        const float rs = 1.0f / sqrtf(s / D + 1e-6f);
        for (int k = 0; k < D; ++k) r[k] = r[k] * rs * g[k];
    }
};


#ifndef CPU_SHIM
typedef short bf16x8 __attribute__((ext_vector_type(8)));
typedef float f32x4 __attribute__((ext_vector_type(4)));
typedef unsigned u32x4 __attribute__((ext_vector_type(4)));
typedef unsigned u32x2 __attribute__((ext_vector_type(2)));
#define DI __device__ __forceinline__
#define NTHREADS 256
__device__ __forceinline__ int opaque_tid() { int t = threadIdx.x; asm volatile("" : "+v"(t)); return t; }
#define TIDX (opaque_tid())

typedef __bf16 hbf16x2 __attribute__((ext_vector_type(2)));
typedef float f32x2 __attribute__((ext_vector_type(2)));
DI unsigned pack2bf(float lo, float hi) { f32x2 f = {lo, hi}; return __builtin_bit_cast(unsigned, __builtin_convertvector(f, hbf16x2)); }
DI float bflo(unsigned u) { return __uint_as_float(u << 16); }
DI float bfhi(unsigned u) { return __uint_as_float(u & 0xffff0000u); }

namespace fw {
constexpr size_t MB = 1024 * 1024;
constexpr size_t PARTS = 13 * MB;
constexpr size_t SMALLB = 1 * MB;
constexpr size_t WB = 14 * MB;
constexpr size_t XB = 30 * MB;
constexpr size_t BIG = 62 * MB;
}

DI void convert_tile(const float* __restrict__ W, int ldw, int c0, int K, bf16* __restrict__ Wt, const float* __restrict__ g, int kt, int nt, float* sm) {
    const int tid = TIDX;
    const int k0 = kt * 64, n0 = nt * 64;
#pragma unroll
    for (int i = 0; i < 4; ++i) {
        const int kr = (tid >> 4) + 16 * i; const int nc = (tid & 15) * 4;
        const float4 v = *(const float4*)(W + (size_t)(k0 + kr) * ldw + c0 + n0 + nc);
        const float s = g ? g[k0 + kr] : 1.0f;
        sm[kr * 65 + nc + 0] = v.x * s; sm[kr * 65 + nc + 1] = v.y * s; sm[kr * 65 + nc + 2] = v.z * s; sm[kr * 65 + nc + 3] = v.w * s;
    }
    __syncthreads();
    {
        const int n = tid >> 2, kq = (tid & 3) * 16;
        unsigned w[8];
#pragma unroll
        for (int j = 0; j < 8; ++j) w[j] = pack2bf(sm[(kq + 2 * j) * 65 + n], sm[(kq + 2 * j + 1) * 65 + n]);
        u32x4* dst = (u32x4*)(Wt + (size_t)(n0 + n) * K + k0 + kq);
        dst[0] = (u32x4){w[0], w[1], w[2], w[3]}; dst[1] = (u32x4){w[4], w[5], w[6], w[7]};
    }
    __syncthreads();
}
DI void convert_seg(const float* W, int ldw, int c0, int ncols, int K, bf16* Wt, const float* g, float* sm, int& tbase) {
    const int nkt = K / 64, nnt = ncols / 64, ntile = nkt * nnt;
    const int Gd = (int)gridDim.x;
    for (int t = (((int)blockIdx.x - tbase % Gd) + Gd) % Gd; t < ntile; t += Gd) convert_tile(W, ldw, c0, K, Wt, g, t % nkt, t / nkt, sm);
    tbase += ntile;
}

DI int perm32(int rho) { const int n = rho >> 4, i = rho & 15; return 8 * (i >> 2) + 4 * n + (i & 3); }

struct ALoadPlain {
    const bf16* A; int lda;
    static constexpr bool DMA = true;
    DI const bf16* src(int m, int k) const { return A + (size_t)m * lda + k; }
    struct Raw { u32x4 v; };
    DI Raw load(int m, int k) const { Raw r; r.v = *(const u32x4*)(A + (size_t)m * lda + k); return r; }
    DI u32x4 finish(const Raw& r, int, int) const { return r.v; }
};
struct ALoadLerp {
    const bf16* xn; const float* mu;
    static constexpr bool DMA = false;
    DI const bf16* src(int, int) const { return nullptr; }
    struct Raw { u32x4 c, p; };
    DI Raw load(int m, int k) const {
        Raw r; r.c = *(const u32x4*)(xn + (size_t)m * D + k);
        if ((m % T) != 0) r.p = *(const u32x4*)(xn + (size_t)(m - 1) * D + k); else r.p = (u32x4){0u, 0u, 0u, 0u};
        return r;
    }
    DI u32x4 finish(const Raw& r, int, int k) const {
        const float4 m0 = *(const float4*)(mu + k), m1 = *(const float4*)(mu + k + 4);
        const float mm[8] = {m0.x, m0.y, m0.z, m0.w, m1.x, m1.y, m1.z, m1.w};
        u32x4 o;
#pragma unroll
        for (int j = 0; j < 4; ++j) {
            const float c0 = bflo(r.c[j]), c1 = bfhi(r.c[j]), p0 = bflo(r.p[j]), p1 = bfhi(r.p[j]);
            o[j] = pack2bf(c0 + (p0 - c0) * mm[2 * j], c1 + (p1 - c1) * mm[2 * j + 1]);
        }
        return o;
    }
};

#define GLDS16(gp, lp) __builtin_amdgcn_global_load_lds((const unsigned*)(gp), (unsigned*)(lp), 16, 0, 0)
template <class AL, class Epi>
DI void gemm_tile(const AL& al, const bf16* __restrict__ Bt, int K, int m0, int n0, const Epi& epi, char* smem) {
    const int tid = TIDX, lane = tid & 63, wave = __builtin_amdgcn_readfirstlane(tid >> 6), wr = wave >> 1, wc = wave & 1, q = lane >> 4, l15 = lane & 15;
    const int srow = tid >> 3, sc = tid & 7, scs = sc ^ (srow & 7);
    const int st_off = srow * 128 + (sc << 4);
    const int dma_off = (8 * wave) * 128;
    int brow[4];
#pragma unroll
    for (int i = 0; i < 4; ++i) { const int rho = srow + 32 * i; brow[i] = n0 + (rho & ~31) + perm32(rho & 31); }
    const int fa0 = (wr * 64 + l15) * 128 + ((q ^ (lane & 7)) << 4);
    const int fb0 = (wc * 64 + l15) * 128 + ((q ^ (lane & 7)) << 4);
    f32x4 acc[4][4];
#pragma unroll
    for (int i = 0; i < 4; ++i)
#pragma unroll
        for (int j = 0; j < 4; ++j) acc[i][j] = (f32x4){0.f, 0.f, 0.f, 0.f};
    typename AL::Raw ra[4];
    const int nk = K / 64;
    {
        char* bufA = smem; char* bufB = smem + 16384;
#pragma unroll
        for (int i = 0; i < 4; ++i) {
            GLDS16(Bt + (size_t)brow[i] * K + scs * 8, bufB + dma_off + i * 4096);
            if (AL::DMA) GLDS16(al.src(m0 + srow + 32 * i, scs * 8), bufA + dma_off + i * 4096);
            else ra[i] = al.load(m0 + srow + 32 * i, scs * 8);
        }
        if (!AL::DMA) {
#pragma unroll
            for (int i = 0; i < 4; ++i) *(u32x4*)(bufA + st_off + i * 4096) = al.finish(ra[i], m0 + srow + 32 * i, scs * 8);
        }
    }
    asm volatile("s_waitcnt vmcnt(0)" ::: "memory");
    __syncthreads();
    for (int kt = 0; kt < nk; ++kt) {
        char* bufA = smem + (kt & 1) * 32768; char* bufB = bufA + 16384;
        char* nA = smem + ((kt + 1) & 1) * 32768; char* nB = nA + 16384;
        const bool more = kt + 1 < nk; const int kn = (kt + 1) * 64 + scs * 8;
        if (more) {
#pragma unroll
            for (int i = 0; i < 4; ++i) {
                GLDS16(Bt + (size_t)brow[i] * K + kn, nB + dma_off + i * 4096);
                if (AL::DMA) GLDS16(al.src(m0 + srow + 32 * i, kn), nA + dma_off + i * 4096);
                else ra[i] = al.load(m0 + srow + 32 * i, kn);
            }
        }
#pragma unroll
        for (int ks = 0; ks < 2; ++ks) {
            bf16x8 af[4], bfr[4];
#pragma unroll
            for (int i = 0; i < 4; ++i) {
                af[i] = *(const bf16x8*)(bufA + ((fa0 + i * 2048) ^ (ks << 6)));
                bfr[i] = *(const bf16x8*)(bufB + ((fb0 + i * 2048) ^ (ks << 6)));
            }
#pragma unroll
            for (int i = 0; i < 4; ++i)
#pragma unroll
                for (int j = 0; j < 4; ++j) acc[i][j] = __builtin_amdgcn_mfma_f32_16x16x32_bf16(bfr[j], af[i], acc[i][j], 0, 0, 0);
        }
        if (more && !AL::DMA) {
#pragma unroll
            for (int i = 0; i < 4; ++i) *(u32x4*)(nA + st_off + i * 4096) = al.finish(ra[i], m0 + srow + 32 * i, kn);
        }
        asm volatile("s_waitcnt vmcnt(0)" ::: "memory");
        __syncthreads();
    }
#pragma unroll
    for (int mt = 0; mt < 4; ++mt)
#pragma unroll
        for (int gi = 0; gi < 2; ++gi) {
            float v[8];
#pragma unroll
            for (int r = 0; r < 4; ++r) { v[r] = acc[mt][2 * gi][r]; v[4 + r] = acc[mt][2 * gi + 1][r]; }
            epi(m0 + wr * 64 + mt * 16 + l15, n0 + wc * 64 + gi * 32 + 8 * q, v, mt, gi);
        }
    epi.finish(m0, n0, wr, wc, lane);
}

constexpr int G2_STAGE = 24576;
template <class AL, class Epi>
DI void gemm_tile2(const AL& al, const bf16* __restrict__ Bt, int K, int m0, int n0, const Epi& epi, char* smem) {
    const int tid = TIDX, lane = tid & 63, wave = __builtin_amdgcn_readfirstlane(tid >> 6), wr = wave >> 1, wc = wave & 1, q = lane >> 4, l15 = lane & 15;
    const int prow = tid >> 2, ppos = tid & 3, ca = (ppos - 2 * ((tid >> 4) & 3)) & 3;
    const int dma_off = wave * 1024;
    int brow[4];
#pragma unroll
    for (int i = 0; i < 4; ++i) { const int rho = prow + 64 * i; brow[i] = n0 + (rho & ~31) + perm32(rho & 31); }
    const int fpos = ((q + 2 * ((l15 >> 2) & 3)) & 3) << 4;
    const int fa0 = (wr * 64 + l15) * 64 + fpos, fb0 = 8192 + (wc * 128 + l15) * 64 + fpos;
    f32x4 acc[4][8];
#pragma unroll
    for (int i = 0; i < 4; ++i)
#pragma unroll
        for (int j = 0; j < 8; ++j) acc[i][j] = (f32x4){0.f, 0.f, 0.f, 0.f};
    typename AL::Raw ra[2];
    const int nk = K / 32;
#define G2_ISSUE(kt_) { char* st_ = smem + ((kt_) % 3) * G2_STAGE; const int kk_ = (kt_) * 32 + ca * 8; \
        _Pragma("unroll") for (int i = 0; i < 2; ++i) { if (AL::DMA) GLDS16(al.src(m0 + prow + 64 * i, kk_), st_ + dma_off + i * 4096); else ra[i] = al.load(m0 + prow + 64 * i, kk_); } \
        _Pragma("unroll") for (int i = 0; i < 4; ++i) GLDS16(Bt + (size_t)brow[i] * K + kk_, st_ + 8192 + dma_off + i * 4096); }
#define G2_AWRITE(kt_) { if (!AL::DMA) { char* st_ = smem + ((kt_) % 3) * G2_STAGE; const int kk_ = (kt_) * 32 + ca * 8; \
        _Pragma("unroll") for (int i = 0; i < 2; ++i) *(u32x4*)(st_ + (prow + 64 * i) * 64 + ppos * 16) = al.finish(ra[i], m0 + prow + 64 * i, kk_); } }
#define G2_BARRIER() { asm volatile("s_waitcnt lgkmcnt(0)" ::: "memory"); __builtin_amdgcn_s_barrier(); asm volatile("" ::: "memory"); }
    G2_ISSUE(0); G2_AWRITE(0);
    if (nk > 1) { G2_ISSUE(1); G2_AWRITE(1); }
    if (nk > 1) { if (AL::DMA) asm volatile("s_waitcnt vmcnt(6)" ::: "memory"); else asm volatile("s_waitcnt vmcnt(4)" ::: "memory"); } else asm volatile("s_waitcnt vmcnt(0)" ::: "memory");
    G2_BARRIER();
    for (int kt = 0; kt < nk; ++kt) {
        const char* st = smem + (kt % 3) * G2_STAGE;
        const bool more = kt + 2 < nk;
        if (more) G2_ISSUE(kt + 2);
        bf16x8 af[4];
#pragma unroll
        for (int i = 0; i < 4; ++i) af[i] = *(const bf16x8*)(st + fa0 + i * 1024);
#pragma unroll
        for (int j = 0; j < 8; ++j) {
            const bf16x8 bf_ = *(const bf16x8*)(st + fb0 + j * 1024);
#pragma unroll
            for (int i = 0; i < 4; ++i) acc[i][j] = __builtin_amdgcn_mfma_f32_16x16x32_bf16(bf_, af[i], acc[i][j], 0, 0, 0);
        }
        if (more) G2_AWRITE(kt + 2);
        if (more) { if (AL::DMA) asm volatile("s_waitcnt vmcnt(6)" ::: "memory"); else asm volatile("s_waitcnt vmcnt(4)" ::: "memory"); } else asm volatile("s_waitcnt vmcnt(0)" ::: "memory");
        G2_BARRIER();
    }
#undef G2_ISSUE
#undef G2_AWRITE
#undef G2_BARRIER
#pragma unroll
    for (int mt = 0; mt < 4; ++mt)
#pragma unroll
        for (int gi = 0; gi < 4; ++gi) {
            float v[8];
#pragma unroll
            for (int r = 0; r < 4; ++r) { v[r] = acc[mt][2 * gi][r]; v[4 + r] = acc[mt][2 * gi + 1][r]; }
            epi(m0 + wr * 64 + mt * 16 + l15, n0 + wc * 128 + gi * 32 + 8 * q, v, mt, gi);
        }
    epi.finish_wide(m0, n0, wr, wc, lane);
}
template <class F>
DI void gemm_sched(int nbig, int nsmall, F&& f) {
    const int x = blockIdx.x & 7, lb = blockIdx.x >> 3, nlb = gridDim.x >> 3;
    const int nb16 = 16 * nbig, tot = 16 * (nbig + nsmall);
    for (int s = lb; s < tot; s += nlb) {
        if (s < nb16) f(true, x * 16 + (s & 15), s >> 4);
        else { const int t = s - nb16; f(false, x * 16 + (t & 15), t >> 4); }
    }
}

DI float rstd_from_parts(const float* parts, int m) {
    const float4* p = (const float4*)(parts + (size_t)m * 16); float s = 0.f;
#pragma unroll
    for (int i = 0; i < 4; ++i) { const float4 v = p[i]; s += (v.x + v.y) + (v.z + v.w); }
    return 1.0f / sqrtf(s * (1.0f / D) + 1e-6f);
}
DI void store8bf(bf16* p, const float* v) { *(u32x4*)p = (u32x4){pack2bf(v[0], v[1]), pack2bf(v[2], v[3]), pack2bf(v[4], v[5]), pack2bf(v[6], v[7])}; }

struct EpiBf16 {
    bf16* P; int ldp; const float* parts; mutable float rsc[4];
    DI void operator()(int m, int n, const float* v, int mt, int gi) const {
        if (gi == 0) rsc[mt] = parts ? rstd_from_parts(parts, m) : 1.0f;
        float s = rsc[mt]; float w[8];
#pragma unroll
        for (int j = 0; j < 8; ++j) w[j] = v[j] * s;
        store8bf(P + (size_t)m * ldp + n, w);
    }
    DI void finish(int, int, int, int, int) const {}
    DI void finish_wide(int, int, int, int, int) const {}
};
struct EpiResid {
    const float* xin; float* xout; bf16* xb; float* parts; mutable float sq[4];
    DI void operator()(int m, int n, const float* v, int mt, int gi) const {
        const float4* xi = (const float4*)(xin + (size_t)m * D + n); const float4 a = xi[0], b = xi[1];
        float w[8] = {a.x + v[0], a.y + v[1], a.z + v[2], a.w + v[3], b.x + v[4], b.y + v[5], b.z + v[6], b.w + v[7]};
        float4* xo = (float4*)(xout + (size_t)m * D + n);
        xo[0] = make_float4(w[0], w[1], w[2], w[3]); xo[1] = make_float4(w[4], w[5], w[6], w[7]);
        if (xb) store8bf(xb + (size_t)m * D + n, w);
        float s = 0.f;
#pragma unroll
        for (int j = 0; j < 8; ++j) s += w[j] * w[j];
        if (gi == 0) sq[mt] = s; else sq[mt] += s;
    }
    DI void finish(int m0, int n0, int wr, int wc, int lane) const {
#pragma unroll
        for (int mt = 0; mt < 4; ++mt) {
            float s = sq[mt]; s += __shfl_xor(s, 16); s += __shfl_xor(s, 32);
            if (lane < 16) parts[(size_t)(m0 + wr * 64 + mt * 16 + lane) * 16 + (n0 >> 7) * 2 + wc] = s;
        }
    }
    DI void finish_wide(int m0, int n0, int wr, int wc, int lane) const {
#pragma unroll
        for (int mt = 0; mt < 4; ++mt) {
            float s = sq[mt]; s += __shfl_xor(s, 16); s += __shfl_xor(s, 32);
            if (lane < 16) { float* pr = parts + (size_t)(m0 + wr * 64 + mt * 16 + lane) * 16 + (n0 >> 7) + wc; pr[0] = s; pr[8] = 0.f; }
        }
    }
};
struct EpiRwkv {
    bf16* P; float* hw; float* ha;
    DI void operator()(int m, int n, const float* v, int, int) const {
        if (n < 4096) { store8bf(P + (size_t)m * 4096 + n, v); return; }
        const int c = n - 4096;
        if (c < 64) { float4* o = (float4*)(hw + (size_t)m * 64 + c); o[0] = make_float4(tanhf(v[0]), tanhf(v[1]), tanhf(v[2]), tanhf(v[3])); o[1] = make_float4(tanhf(v[4]), tanhf(v[5]), tanhf(v[6]), tanhf(v[7])); }
        else if (c >= 128 && c < 192) { float4* o = (float4*)(ha + (size_t)m * 64 + (c - 128)); o[0] = make_float4(v[0], v[1], v[2], v[3]); o[1] = make_float4(v[4], v[5], v[6], v[7]); }
    }
    DI void finish(int, int, int, int, int) const {}
    DI void finish_wide(int, int, int, int, int) const {}
};

namespace at {
constexpr int OFF_BIAS = 49152;
constexpr int OFF_X = 61952;
constexpr int OFF_IMP = 49152;
constexpr float L2E = 1.4426950408889634f;
constexpr float NEG_MASK = -1e30f, M_INIT = -1e20f;
}
enum { AM_SWA = 0, AM_WIN = 1, AM_CMP = 2, AM_SEL = 3 };
DI int vt_perm(int k32) { return ((k32 & 15) >> 2) * 8 + (k32 >> 4) * 4 + (k32 & 3); }
DI float fast_exp2(float x) { return __builtin_amdgcn_exp2f(x); }

DI void build_bias_lut(const float* __restrict__ t5, char* smem, bool swa) {
    float* lut = (float*)(smem + at::OFF_BIAS);
    for (int i = TIDX; i < 16 * 200; i += NTHREADS) {
        const int h = i / 200, e = i % 200; float v = at::NEG_MASK;
        if (e >= 64 && e < 192) v = t5[t5_bucket(e - 64) * 16 + h] * at::L2E;
        else if (e >= 192 && !swa) v = t5[31 * 16 + h] * at::L2E;
        lut[i] = v;
    }
    __syncthreads();
}

template <int NQT> struct AttnStateT { f32x4 o[NQT][4]; f32x4 lacc[NQT]; float m[NQT]; };
#ifndef ANQT_SWA
#define ANQT_SWA 4
#endif
#ifndef ANQT_WIN
#define ANQT_WIN 2
#endif
#ifndef ANQT_SEL
#define ANQT_SEL 4
#endif
DI unsigned long long range_mask(int lo, int hi) { return (hi >= 63 ? ~0ull : ((1ull << (hi + 1)) - 1ull)) & ~((1ull << lo) - 1ull); }

template <int NQT>
DI void attn_load_q(bf16x8 (&qf)[NQT][2], const bf16* __restrict__ Qp, int ldq, size_t mbase, int hbase) {
    const int lane = TIDX & 63, wave = TIDX >> 6, q = lane >> 4, l15 = lane & 15;
#pragma unroll
    for (int qt = 0; qt < NQT; ++qt) {
        const size_t m = mbase + wave * (4 * NQT) + qt * 4 + (l15 >> 2);
#pragma unroll
        for (int ks = 0; ks < 2; ++ks) qf[qt][ks] = *(const bf16x8*)(Qp + m * ldq + (hbase + (l15 & 3)) * 64 + ks * 32 + q * 8);
    }
}

enum { SK_FAR = 0, SK_NEAR = 1, SK_EDGE = 2, SK_CMP = 3 };
template <int KIND>
DI float attn_fix(f32x4 (&s)[4], int dbase, float cadd, const float* __restrict__ bl, float mx) {
#pragma unroll
    for (int kt = 0; kt < 4; ++kt)
#pragma unroll
        for (int r = 0; r < 4; ++r) {
            float v = s[kt][r]; const int dist = dbase - (kt * 16 + r);
            if (KIND == SK_NEAR) { int idx = dist + 64; idx = idx < 0 ? 0 : (idx > 192 ? 192 : idx); v += bl[idx] + cadd; }
            else if (KIND == SK_EDGE) v = dist < 512 ? v + cadd : at::NEG_MASK;
            else if (KIND == SK_CMP) v = dist >= 0 ? v : at::NEG_MASK;
            if (KIND != SK_FAR) s[kt][r] = v;
            mx = fmaxf(mx, v);
        }
    return mx;
}
template <int MODE, int NQT>
DI void attn_blocks(AttnStateT<NQT>& st, const bf16x8 (&qf)[NQT][2], const bf16* __restrict__ Kp, size_t krs, const bf16* __restrict__ Vp, size_t vrs,
                    int t0, unsigned long long todo, int hbase, const unsigned long long (&sel)[NQT], char* smem) {
    const int tid = TIDX, lane = tid & 63, wave = __builtin_amdgcn_readfirstlane(tid >> 6), q = lane >> 4, l15 = lane & 15;
    const int tq0 = t0 + wave * (4 * NQT) + (l15 >> 2);
    const float* bl = (const float*)(smem + at::OFF_BIAS) + (hbase + (l15 & 3)) * 200;
    const float bfar = (MODE != AM_CMP) ? bl[192] : 0.f;
    const int srow = tid >> 3, scs = (tid & 7) ^ (srow & 7);
    const int fo = l15 * 128 + ((q ^ (l15 & 7)) << 4);
#define ATT_DMA(kb_, slot_) { _Pragma("unroll") for (int i = 0; i < 2; ++i) { const int row = srow + 32 * i; char* dst = smem + (slot_) * 16384 + (8 * wave + 32 * i) * 128; \
        GLDS16(Kp + (size_t)((kb_) * 64 + row) * krs + scs * 8, dst); GLDS16(Vp + (size_t)row * vrs + (kb_) * 64 + scs * 8, dst + 8192); } }
#define ATT_BARRIER() { asm volatile("s_waitcnt lgkmcnt(0)" ::: "memory"); __builtin_amdgcn_s_barrier(); asm volatile("" ::: "memory"); }
    if (todo == 0ull) return;
    int kb = __builtin_ctzll(todo); todo &= todo - 1ull;
    int kb1 = -1; if (todo) { kb1 = __builtin_ctzll(todo); todo &= todo - 1ull; }
    ATT_DMA(kb, 0);
    if (kb1 >= 0) { ATT_DMA(kb1, 1); asm volatile("s_waitcnt vmcnt(4)" ::: "memory"); } else { asm volatile("s_waitcnt vmcnt(0)" ::: "memory"); }
    ATT_BARRIER();
    int slot = 0;
    for (;;) {
        char* buf = smem + slot * 16384;
        int kb2 = -1; if (todo) { kb2 = __builtin_ctzll(todo); todo &= todo - 1ull; }
        if (kb2 >= 0) { const int s2 = slot >= 1 ? slot - 1 : 2; ATT_DMA(kb2, s2); }
        f32x4 s[NQT][4];
#pragma unroll
        for (int qt = 0; qt < NQT; ++qt)
#pragma unroll
            for (int kt = 0; kt < 4; ++kt) s[qt][kt] = (f32x4){0.f, 0.f, 0.f, 0.f};
#pragma unroll
        for (int kt = 0; kt < 4; ++kt)
#pragma unroll
            for (int ks = 0; ks < 2; ++ks) {
                const bf16x8 kf = *(const bf16x8*)(buf + ((fo + kt * 2048) ^ (ks << 6)));
#pragma unroll
                for (int qt = 0; qt < NQT; ++qt) s[qt][kt] = __builtin_amdgcn_mfma_f32_16x16x32_bf16(kf, qf[qt][ks], s[qt][kt], 0, 0, 0);
            }
        const int mind = (t0 + wave * (4 * NQT)) - (kb * 64 + 63), maxd = (t0 + wave * (4 * NQT) + 4 * NQT - 1) - kb * 64;
        float mx[NQT], cofs[NQT];
#pragma unroll
        for (int qt = 0; qt < NQT; ++qt) cofs[qt] = 0.f;
        if (MODE == AM_CMP) {
#pragma unroll
            for (int qt = 0; qt < NQT; ++qt) { const int nlim = (tq0 + 4 * qt - 31) >> 4; mx[qt] = attn_fix<SK_CMP>(s[qt], nlim - (kb * 64 + 4 * q), 0.f, bl, at::NEG_MASK); }
        } else {
            float cadd[NQT];
#pragma unroll
            for (int qt = 0; qt < NQT; ++qt) cadd[qt] = (MODE == AM_SEL && !((sel[qt] >> kb) & 1ull)) ? at::NEG_MASK : 0.f;
            if (MODE == AM_SWA || mind < 113) {
#pragma unroll
                for (int qt = 0; qt < NQT; ++qt) mx[qt] = attn_fix<SK_NEAR>(s[qt], tq0 + 4 * qt - (kb * 64 + 4 * q), cadd[qt], bl, at::NEG_MASK);
            } else if (MODE == AM_WIN && maxd >= 512) {
#pragma unroll
                for (int qt = 0; qt < NQT; ++qt) mx[qt] = attn_fix<SK_EDGE>(s[qt], tq0 + 4 * qt - (kb * 64 + 4 * q), bfar, bl, at::NEG_MASK);
            } else {
#pragma unroll
                for (int qt = 0; qt < NQT; ++qt) { cofs[qt] = bfar + cadd[qt]; mx[qt] = attn_fix<SK_FAR>(s[qt], 0, 0.f, bl, at::NEG_MASK) + cofs[qt]; }
            }
        }
        float msub[NQT]; bool grow = false;
#pragma unroll
        for (int qt = 0; qt < NQT; ++qt) {
            float m2 = mx[qt];
            m2 = fmaxf(m2, __shfl_xor(m2, 16)); m2 = fmaxf(m2, __shfl_xor(m2, 32));
            const bool g = m2 > st.m[qt] + 4.0f; grow |= g;
            mx[qt] = g ? m2 : st.m[qt];
            msub[qt] = mx[qt] - cofs[qt];
        }
        if (__any(grow)) {
#pragma unroll
            for (int qt = 0; qt < NQT; ++qt) {
                const float alpha = fast_exp2(st.m[qt] - mx[qt]);
#pragma unroll
                for (int dt = 0; dt < 4; ++dt) st.o[qt][dt] *= alpha;
                st.lacc[qt] *= alpha;
            }
        }
#pragma unroll
        for (int qt = 0; qt < NQT; ++qt) st.m[qt] = mx[qt];
#pragma unroll
        for (int qt = 0; qt < NQT; ++qt)
#pragma unroll
            for (int kt = 0; kt < 4; ++kt)
#pragma unroll
                for (int r = 0; r < 4; ++r) s[qt][kt][r] = fast_exp2(s[qt][kt][r] - msub[qt]);
        const bf16x8 ones = {(short)0x3F80, (short)0x3F80, (short)0x3F80, (short)0x3F80, (short)0x3F80, (short)0x3F80, (short)0x3F80, (short)0x3F80};
#pragma unroll
        for (int kp = 0; kp < 2; ++kp) {
            bf16x8 pf[NQT];
#pragma unroll
            for (int qt = 0; qt < NQT; ++qt) {
                const u32x4 w = {pack2bf(s[qt][2 * kp][0], s[qt][2 * kp][1]), pack2bf(s[qt][2 * kp][2], s[qt][2 * kp][3]),
                                 pack2bf(s[qt][2 * kp + 1][0], s[qt][2 * kp + 1][1]), pack2bf(s[qt][2 * kp + 1][2], s[qt][2 * kp + 1][3])};
                pf[qt] = __builtin_bit_cast(bf16x8, w);
            }
#pragma unroll
            for (int qt = 0; qt < NQT; ++qt) st.lacc[qt] = __builtin_amdgcn_mfma_f32_16x16x32_bf16(ones, pf[qt], st.lacc[qt], 0, 0, 0);
#pragma unroll
            for (int dt = 0; dt < 4; ++dt) {
                const bf16x8 vf = *(const bf16x8*)(buf + 8192 + ((fo + dt * 2048) ^ (kp << 6)));
#pragma unroll
                for (int qt = 0; qt < NQT; ++qt) st.o[qt][dt] = __builtin_amdgcn_mfma_f32_16x16x32_bf16(vf, pf[qt], st.o[qt][dt], 0, 0, 0);
            }
        }
        if (kb1 < 0) break;
        if (kb2 >= 0) { asm volatile("s_waitcnt vmcnt(4)" ::: "memory"); } else { asm volatile("s_waitcnt vmcnt(0)" ::: "memory"); }
        ATT_BARRIER();
        kb = kb1; kb1 = kb2; slot = slot == 2 ? 0 : slot + 1;
    }
    ATT_BARRIER();
#undef ATT_DMA
}
template <int NQT>
DI void attn_init(AttnStateT<NQT>& st, float m0, float l0) {
#pragma unroll
    for (int qt = 0; qt < NQT; ++qt) { st.m[qt] = m0; st.lacc[qt] = (f32x4){l0, l0, l0, l0};
#pragma unroll
        for (int dt = 0; dt < 4; ++dt) st.o[qt][dt] = (f32x4){0.f, 0.f, 0.f, 0.f}; }
}
DI float attn_linv(const f32x4& lacc) { const float l = lacc[0]; return l > 0.f ? 1.0f / l : 0.f; }

template <int TT>
DI void attn_item_decode(int item, int& b, int& g, int& t0) {
    constexpr int tiles = T / TT;
    const int Gd = (int)gridDim.x;
    int pair, tile;
    if ((Gd % tiles) == 0 && tiles * B * G % Gd == 0) {
        const int bid = item % Gd, rr = item / Gd, tau = bid % tiles;
        pair = bid / tiles + (Gd / tiles) * rr; tile = (rr & 1) ? tiles - 1 - tau : tau;
    } else { tile = item % tiles; pair = item / tiles; }
    t0 = tile * TT; g = pair % G; b = pair / G;
}
DI void swa_item(const bf16* __restrict__ P0, const bf16* __restrict__ VT, const float* __restrict__ sinks, bf16* __restrict__ AO, int item, char* smem) {
    constexpr int LDP = 2304;
    constexpr int NQT = ANQT_SWA;
    int b, g, t0; attn_item_decode<16 * NQT>(item, b, g, t0);
    const int lane = TIDX & 63, wave = TIDX >> 6, q = lane >> 4, l15 = lane & 15;
    const size_t mbase = (size_t)b * T + t0; const int hbase = g * 4, h = hbase + (l15 & 3);
    bf16x8 qf[NQT][2]; attn_load_q<NQT>(qf, P0, LDP, mbase, hbase);
    AttnStateT<NQT> st; attn_init<NQT>(st, sinks[h] * at::L2E, 1.0f);
    const int lo = t0 - 127 < 0 ? 0 : (t0 - 127) >> 6, hi = (t0 + 16 * NQT - 1) >> 6;
    const unsigned long long nosel[NQT] = {};
    attn_blocks<AM_SWA, NQT>(st, qf, P0 + (size_t)b * T * LDP + 1024 + g * 64, LDP, VT + (size_t)(b * G + g) * 64 * T, T, t0, range_mask(lo, hi), hbase, nosel, smem);
#pragma unroll
    for (int qt = 0; qt < NQT; ++qt) {
        const float li = attn_linv(st.lacc[qt]); const size_t m = mbase + wave * (4 * NQT) + qt * 4 + (l15 >> 2);
#pragma unroll
        for (int dt = 0; dt < 4; ++dt) {
            const int d0 = dt * 16 + 4 * q; const u32x2 zz = *(const u32x2*)(P0 + m * LDP + 1280 + h * 64 + d0);
            const float z0 = bflo(zz[0]), z1 = bfhi(zz[0]), z2 = bflo(zz[1]), z3 = bfhi(zz[1]);
            const f32x4 o = st.o[qt][dt];
            *(u32x2*)(AO + m * D + h * 64 + d0) = (u32x2){pack2bf(o[0] * li * siluf_(z0), o[1] * li * siluf_(z1)), pack2bf(o[2] * li * siluf_(z2), o[3] * li * siluf_(z3))};
        }
    }
}

struct EpiL0 {
    bf16* P0; bf16* VT; const float* parts; mutable float rsc[4];
    DI void operator()(int m, int n, const float* v, int mt, int gi) const {
        if (gi == 0) rsc[mt] = rstd_from_parts(parts, m);
        float s = rsc[mt]; if (n < 1024) s *= 0.125f * at::L2E; float w[8];
#pragma unroll
        for (int j = 0; j < 8; ++j) w[j] = v[j] * s;
        if (n < 1280) store8bf(P0 + (size_t)m * 2304 + n, w);
        else if (n >= 1536) store8bf(P0 + (size_t)m * 2304 + n - 256, w);
        else {
            const int g = (n - 1280) >> 6, d = (n - 1280) & 63, b = m / T, t = m % T; const int pos = (t & ~31) + vt_perm(t & 31);
            bf16* dst = VT + ((size_t)(b * G + g) * 64 + d) * T + pos;
#pragma unroll
            for (int j = 0; j < 8; ++j) dst[(size_t)j * T] = f2bf(w[j]);
        }
    }
    DI void finish(int, int, int, int, int) const {}
    DI void finish_wide(int, int, int, int, int) const {}
};

constexpr int LDP2 = 3200;
struct EpiL2 {
    bf16* P2; bf16* VTs; bf16* VTw; const float* parts; mutable float rsc[4];
    DI void operator()(int m, int n, const float* v, int mt, int gi) const {
        if (gi == 0) rsc[mt] = rstd_from_parts(parts, m);
        if (n >= C_COLS) return;
        float s = rsc[mt]; if (n < 1024) s *= 0.125f * at::L2E; float w[8];
#pragma unroll
        for (int j = 0; j < 8; ++j) w[j] = v[j] * s;
        const bool isvs = n >= 1792 && n < 2048, isvw = n >= 2304 && n < 2560;
        if (isvs || isvw) {
            const int c = n - (isvs ? 1792 : 2304); const int g = c >> 6, d = c & 63, b = m / T, t = m % T; const int pos = (t & ~31) + vt_perm(t & 31);
            bf16* dst = (isvs ? VTs : VTw) + ((size_t)(b * G + g) * 64 + d) * T + pos;
#pragma unroll
            for (int j = 0; j < 8; ++j) dst[(size_t)j * T] = f2bf(w[j]);
        } else {
            const int c = n < 1792 ? n : (n < 2304 ? n - 256 : n - 512);
            store8bf(P2 + (size_t)m * LDP2 + c, w);
        }
    }
    DI void finish(int, int, int, int, int) const {}
    DI void finish_wide(int, int, int, int, int) const {}
};

struct ALoadCmp {
    const bf16* P2; int col;
    static constexpr bool DMA = true;
    DI const bf16* src(int row, int k) const {
        int n = row & 255; const int bg = row >> 8, b = bg >> 2, g = bg & 3; const int l = k >> 6, d = k & 63; n = n < NCMP ? n : NCMP - 1;
        return P2 + (size_t)(b * T + 16 * n + l) * LDP2 + col + g * 64 + d;
    }
    struct Raw { u32x4 v; };
    DI Raw load(int row, int k) const {
        const int n = row & 255, bg = row >> 8, b = bg >> 2, g = bg & 3; const int l = k >> 6, d = k & 63; Raw r;
        if (n < NCMP) r.v = *(const u32x4*)(P2 + (size_t)(b * T + 16 * n + l) * LDP2 + col + g * 64 + d); else r.v = (u32x4){0u, 0u, 0u, 0u};
        return r;
    }
    DI u32x4 finish(const Raw& r, int, int) const { return r.v; }
};
struct EpiCmpH {
    char* smem; const float* bias8;
    DI void operator()(int m, int n, const float* v, int, int) const {
        const int row = m & 127; float w[8];
#pragma unroll
        for (int j = 0; j < 8; ++j) { float bsum = 0.f;
#pragma unroll
            for (int i = 0; i < 8; ++i) bsum += bias8[i * 128 + n + j];
            w[j] = siluf_(v[j] + bsum); }
        const int kk = n >> 6, c = (n & 63) >> 3;
        *(u32x4*)(smem + kk * 16384 + row * 128 + ((c ^ (row & 7)) << 4)) = (u32x4){pack2bf(w[0], w[1]), pack2bf(w[2], w[3]), pack2bf(w[4], w[5]), pack2bf(w[6], w[7])};
    }
    DI void finish(int, int, int, int, int) const {}
    DI void finish_wide(int, int, int, int, int) const {}
};
DI void cmp_tile(const bf16* __restrict__ P2, const bf16* __restrict__ w1t, const float* __restrict__ bias8, const bf16* __restrict__ w2t, int which, int rt,
                 bf16* __restrict__ KCb, bf16* __restrict__ VCT, char* smem) {
    gemm_tile(ALoadCmp{P2, which ? 1280 : 1024}, w1t, 2048, rt * 128, 0, EpiCmpH{smem, bias8}, smem);
    const int tid = TIDX, lane = tid & 63, wave = tid >> 6, q = lane >> 4, l15 = lane & 15;
#pragma unroll
    for (int i = 0; i < 4; ++i) {
        const int id = i * 256 + tid; const int row = id >> 4, c16 = id & 15, kk = c16 >> 3, c = c16 & 7;
        *(u32x4*)(smem + 32768 + kk * 8192 + row * 128 + ((c ^ (row & 7)) << 4)) = *(const u32x4*)(w2t + (size_t)row * 128 + c16 * 8);
    }
    __syncthreads();
    f32x4 acc[2][4];
#pragma unroll
    for (int i = 0; i < 2; ++i)
#pragma unroll
        for (int j = 0; j < 4; ++j) acc[i][j] = (f32x4){0.f, 0.f, 0.f, 0.f};
    const int fo = l15 * 128 + ((q ^ (l15 & 7)) << 4);
#pragma unroll
    for (int kk = 0; kk < 2; ++kk)
#pragma unroll
        for (int ks = 0; ks < 2; ++ks) {
            bf16x8 hf[2], wf[4];
#pragma unroll
            for (int i = 0; i < 2; ++i) hf[i] = *(const bf16x8*)(smem + kk * 16384 + (((wave * 32 + i * 16) * 128 + fo) ^ (ks << 6)));
#pragma unroll
            for (int j = 0; j < 4; ++j) wf[j] = *(const bf16x8*)(smem + 32768 + kk * 8192 + ((j * 2048 + fo) ^ (ks << 6)));
#pragma unroll
            for (int i = 0; i < 2; ++i)
#pragma unroll
                for (int j = 0; j < 4; ++j) acc[i][j] = __builtin_amdgcn_mfma_f32_16x16x32_bf16(wf[j], hf[i], acc[i][j], 0, 0, 0);
        }
#pragma unroll
    for (int i = 0; i < 2; ++i) {
        const int row = rt * 128 + wave * 32 + i * 16 + l15; const int n = row & 255, bg = row >> 8;
#pragma unroll
        for (int j = 0; j < 4; ++j) {
            const int d0 = j * 16 + 4 * q; const f32x4 a = acc[i][j];
            if (which == 0) *(u32x2*)(KCb + (size_t)row * 64 + d0) = (u32x2){pack2bf(a[0], a[1]), pack2bf(a[2], a[3])};
            else {
                const int pos = (n & ~31) + vt_perm(n & 31);
#pragma unroll
                for (int r = 0; r < 4; ++r) VCT[((size_t)bg * 64 + d0 + r) * 256 + pos] = f2bf(a[r]);
            }
        }
    }
    __syncthreads();
}

DI void win_item(const bf16* __restrict__ P2, const bf16* __restrict__ VTw, bf16* __restrict__ OW, int item, char* smem) {
    constexpr int NQT = ANQT_WIN;
    int b, g, t0; attn_item_decode<16 * NQT>(item, b, g, t0);
    const int lane = TIDX & 63, wave = TIDX >> 6, q = lane >> 4, l15 = lane & 15;
    const size_t mbase = (size_t)b * T + t0; const int hbase = g * 4, h = hbase + (l15 & 3);
    bf16x8 qf[NQT][2]; attn_load_q<NQT>(qf, P2, LDP2, mbase, hbase);
    AttnStateT<NQT> st; attn_init<NQT>(st, at::M_INIT, 0.f);
    const int lo = t0 - 511 < 0 ? 0 : (t0 - 511) >> 6, hi = (t0 + 16 * NQT - 1) >> 6;
    const unsigned long long nosel[NQT] = {};
    attn_blocks<AM_WIN, NQT>(st, qf, P2 + (size_t)b * T * LDP2 + 1792 + g * 64, LDP2, VTw + (size_t)(b * G + g) * 64 * T, T, t0, range_mask(lo, hi), hbase, nosel, smem);
#pragma unroll
    for (int qt = 0; qt < NQT; ++qt) {
        const float li = attn_linv(st.lacc[qt]); const size_t m = mbase + wave * (4 * NQT) + qt * 4 + (l15 >> 2);
#pragma unroll
        for (int dt = 0; dt < 4; ++dt) { const f32x4 o = st.o[qt][dt]; *(u32x2*)(OW + m * D + h * 64 + dt * 16 + 4 * q) = (u32x2){pack2bf(o[0] * li, o[1] * li), pack2bf(o[2] * li, o[3] * li)}; }
    }
}

DI void cmpsel_item(const bf16* __restrict__ P2, const bf16* __restrict__ KCb, const bf16* __restrict__ VCT, bf16* __restrict__ OC, unsigned long long* __restrict__ SELM, int item, char* smem) {
    int b, g, t0; attn_item_decode<32>(item, b, g, t0);
    const int tid = TIDX, lane = tid & 63, wave = tid >> 6, q = lane >> 4, l15 = lane & 15;
    const size_t mbase = (size_t)b * T + t0; const int hbase = g * 4, h = hbase + (l15 & 3);
    float* impL = (float*)(smem + at::OFF_IMP);
    for (int i = tid; i < 32 * 64; i += NTHREADS) impL[i] = 0.f;
    bf16x8 qf[2][2]; attn_load_q<2>(qf, P2, LDP2, mbase, hbase);
    AttnStateT<2> st; attn_init<2>(st, at::M_INIT, 0.f);
    const int nvmax = (t0 + 31 - 31) / 16 + 1;
    const int hi = (nvmax - 1) >> 6;
    const bf16* Kp = KCb + (size_t)(b * G + g) * 256 * 64; const bf16* Vp = VCT + (size_t)(b * G + g) * 64 * 256;
    const unsigned long long nosel[2] = {0ull, 0ull};
    attn_blocks<AM_CMP, 2>(st, qf, Kp, 64, Vp, 256, t0, range_mask(0, hi), hbase, nosel, smem);
    float linv[2];
#pragma unroll
    for (int qt = 0; qt < 2; ++qt) {
        linv[qt] = attn_linv(st.lacc[qt]); const size_t m = mbase + wave * 8 + qt * 4 + (l15 >> 2);
#pragma unroll
        for (int dt = 0; dt < 4; ++dt) { const f32x4 o = st.o[qt][dt]; *(u32x2*)(OC + m * D + h * 64 + dt * 16 + 4 * q) = (u32x2){pack2bf(o[0] * linv[qt], o[1] * linv[qt]), pack2bf(o[2] * linv[qt], o[3] * linv[qt])}; }
    }
    {
        const int tq0 = t0 + wave * 8 + (l15 >> 2);
        const bf16* kp0 = Kp + (size_t)l15 * 64 + q * 8;
        bf16x8 kfA[4][2], kfB[4][2];
#define CS_LOADK(dst_, kb_) { _Pragma("unroll") for (int kt = 0; kt < 4; ++kt) _Pragma("unroll") for (int ks = 0; ks < 2; ++ks) \
            dst_[kt][ks] = *(const bf16x8*)(kp0 + (size_t)((kb_) * 64 + kt * 16) * 64 + ks * 32); }
#define CS_QSUM(x_) { x_ += __builtin_bit_cast(float, __builtin_amdgcn_update_dpp(0, __builtin_bit_cast(int, x_), 0xB1, 0xf, 0xf, false)); \
                      x_ += __builtin_bit_cast(float, __builtin_amdgcn_update_dpp(0, __builtin_bit_cast(int, x_), 0x4E, 0xf, 0xf, false)); }
#define CS_BLOCK(kf_, kb_) { const int kbi = (kb_); \
            f32x4 s[2][4]; \
            _Pragma("unroll") for (int qt = 0; qt < 2; ++qt) _Pragma("unroll") for (int kt = 0; kt < 4; ++kt) s[qt][kt] = (f32x4){0.f, 0.f, 0.f, 0.f}; \
            _Pragma("unroll") for (int kt = 0; kt < 4; ++kt) _Pragma("unroll") for (int ks = 0; ks < 2; ++ks) { \
                s[0][kt] = __builtin_amdgcn_mfma_f32_16x16x32_bf16(kf_[kt][ks], qf[0][ks], s[0][kt], 0, 0, 0); \
                s[1][kt] = __builtin_amdgcn_mfma_f32_16x16x32_bf16(kf_[kt][ks], qf[1][ks], s[1][kt], 0, 0, 0); } \
            const bool allvis = 16 * (kbi * 64 + 63) + 31 <= t0;         \
            _Pragma("unroll") for (int qt = 0; qt < 2; ++qt) { \
                const int tq = tq0 + 4 * qt; const int tl = wave * 8 + qt * 4 + (l15 >> 2); \
                _Pragma("unroll") for (int kt = 0; kt < 4; ++kt) { \
                    float pr[4]; \
                    _Pragma("unroll") for (int r = 0; r < 4; ++r) { const int key = kbi * 64 + kt * 16 + 4 * q + r; \
                        const float e = fast_exp2(s[qt][kt][r] - st.m[qt]) * linv[qt]; pr[r] = (allvis || 16 * key + 31 <= tq) ? e : 0.f; } \
                    float s4 = (pr[0] + pr[1]) + (pr[2] + pr[3]), s1 = pr[3]; \
                    CS_QSUM(s4); CS_QSUM(s1); \
                    const int s0 = kbi * 16 + kt * 4 + q; \
                    if ((l15 & 3) == 0) { atomicAdd(&impL[tl * 64 + s0], s4); if (s0 + 1 < 64) atomicAdd(&impL[tl * 64 + s0 + 1], s1); } \
                } \
            } }
        CS_LOADK(kfA, 0);
        for (int kb = 0; kb <= hi; kb += 2) {
            if (kb + 1 <= hi) CS_LOADK(kfB, kb + 1);
            CS_BLOCK(kfA, kb);
            if (kb + 1 > hi) break;
            if (kb + 2 <= hi) CS_LOADK(kfA, kb + 2);
            CS_BLOCK(kfB, kb + 1);
        }
#undef CS_LOADK
#undef CS_QSUM
#undef CS_BLOCK
        __syncthreads();
    }
    {
        const int tl = tid >> 3, sg = tid & 7; const int t = t0 + tl, cur = t >> 6; float* row = impL + tl * 64;
        unsigned hk[8]; unsigned long long mine[8];
#pragma unroll
        for (int j = 0; j < 8; ++j) { const int s = sg * 8 + j; const float v = row[s];
            hk[j] = (s == 0 || s == cur || s == cur - 1) ? 0x7F800000u : (s * 64 > t ? 0u : (v > 0.f ? __float_as_uint(v) + 1u : 1u));
            mine[j] = ((unsigned long long)hk[j] << 32) | (unsigned)(63 - s); }
        __syncthreads();
#pragma unroll
        for (int j = 0; j < 8; ++j) ((unsigned*)row)[sg * 8 + j] = hk[j];
        __syncthreads();
        int rank[8] = {0, 0, 0, 0, 0, 0, 0, 0};
        const int ns4 = ((((t0 + 31) >> 6) >> 2) + 2) & ~1;
#pragma unroll 2
        for (int s4 = 0; s4 < ns4; ++s4) {
            const u32x4 v4 = *(const u32x4*)(row + s4 * 4);
#pragma unroll
            for (int e = 0; e < 4; ++e) { const unsigned long long kv = ((unsigned long long)v4[e] << 32) | (unsigned)(63 - (s4 * 4 + e));
#pragma unroll
                for (int j = 0; j < 8; ++j) rank[j] += kv > mine[j] ? 1 : 0; }
        }
        unsigned long long bits = 0ull;
#pragma unroll
        for (int j = 0; j < 8; ++j) if (rank[j] < KTOP && (sg * 8 + j) * 64 <= t) bits |= 1ull << (sg * 8 + j);
        unsigned lo = (unsigned)bits, hi2 = (unsigned)(bits >> 32);
#pragma unroll
        for (int o = 1; o < 8; o <<= 1) { lo |= __shfl_xor(lo, o); hi2 |= __shfl_xor(hi2, o); }
        if (sg == 0) SELM[(mbase + tl) * 4 + g] = ((unsigned long long)hi2 << 32) | lo;
    }
    __syncthreads();
}

DI void sel_item(const bf16* __restrict__ P2, const bf16* __restrict__ VTs, const unsigned long long* __restrict__ SELM, const bf16* __restrict__ OC, const bf16* __restrict__ OW,
                 bf16* __restrict__ AO, int item, char* smem) {
    constexpr int NQT = ANQT_SEL;
    int b, g, t0; attn_item_decode<16 * NQT>(item, b, g, t0);
    const int tid = TIDX, lane = tid & 63, wave = tid >> 6, q = lane >> 4, l15 = lane & 15;
    const size_t mbase = (size_t)b * T + t0; const int hbase = g * 4, rr = l15 & 3, h = hbase + rr;
    unsigned long long* orw = (unsigned long long*)(smem + at::OFF_X);
    if (tid == 0) *orw = 0ull;
    __syncthreads();
    if (tid < 16 * NQT) atomicOr(orw, SELM[(mbase + tid) * 4 + g]);
    unsigned long long sel[NQT];
#pragma unroll
    for (int qt = 0; qt < NQT; ++qt) sel[qt] = SELM[(mbase + wave * (4 * NQT) + qt * 4 + (l15 >> 2)) * 4 + g];
    bf16x8 qf[NQT][2]; attn_load_q<NQT>(qf, P2, LDP2, mbase, hbase);
    AttnStateT<NQT> st; attn_init<NQT>(st, at::M_INIT, 0.f);
    __syncthreads();
    const unsigned long long todo_v = (*orw) & range_mask(0, (t0 + 16 * NQT - 1) >> 6);
    const unsigned long long todo = ((unsigned long long)(unsigned)__builtin_amdgcn_readfirstlane((int)(todo_v >> 32)) << 32) | (unsigned)__builtin_amdgcn_readfirstlane((int)(unsigned)todo_v);
    attn_blocks<AM_SEL, NQT>(st, qf, P2 + (size_t)b * T * LDP2 + 1536 + g * 64, LDP2, VTs + (size_t)(b * G + g) * 64 * T, T, t0, todo, hbase, sel, smem);
#pragma unroll
    for (int qt = 0; qt < NQT; ++qt) {
        const float li = attn_linv(st.lacc[qt]); const size_t m = mbase + wave * (4 * NQT) + qt * 4 + (l15 >> 2);
        const bf16* gr = P2 + m * LDP2 + 3072;
        const float g0 = sigmoidf_(bf2f(gr[0 * 16 + h])), g1 = sigmoidf_(bf2f(gr[1 * 16 + h])), g2 = sigmoidf_(bf2f(gr[2 * 16 + h]));
#pragma unroll
        for (int dt = 0; dt < 4; ++dt) {
            const int d0 = dt * 16 + 4 * q; const size_t oi = m * D + h * 64 + d0;
            const u32x2 zz = *(const u32x2*)(P2 + m * LDP2 + 2048 + h * 64 + d0), cc = *(const u32x2*)(OC + oi), ww = *(const u32x2*)(OW + oi);
            const f32x4 o = st.o[qt][dt];
            const float r0 = (g0 * bflo(cc[0]) + g1 * o[0] * li + g2 * bflo(ww[0])) * siluf_(bflo(zz[0]));
            const float r1 = (g0 * bfhi(cc[0]) + g1 * o[1] * li + g2 * bfhi(ww[0])) * siluf_(bfhi(zz[0]));
            const float r2 = (g0 * bflo(cc[1]) + g1 * o[2] * li + g2 * bflo(ww[1])) * siluf_(bflo(zz[1]));
            const float r3 = (g0 * bfhi(cc[1]) + g1 * o[3] * li + g2 * bfhi(ww[1])) * siluf_(bfhi(zz[1]));
            *(u32x2*)(AO + oi) = (u32x2){pack2bf(r0, r1), pack2bf(r2, r3)};
        }
    }
    __syncthreads();
}

DI void lru_convert_gates(const float* __restrict__ gaw, const float* __restrict__ gxw, bf16* __restrict__ img) {
    for (int i = blockIdx.x * NTHREADS + TIDX; i < 16 * 160 * 96; i += gridDim.x * NTHREADS) {
        const int k = i % 96, n = (i / 96) % 160, blk = i / (96 * 160);
        float v = 0.f;
        if (k < 80) v = n < 80 ? gaw[((size_t)blk * 80 + k) * 80 + n] : gxw[((size_t)blk * 80 + k) * 80 + (n - 80)];
        img[i] = f2bf(v);
    }
}
DI void lru_gate_item(const bf16* __restrict__ P3, const float* __restrict__ cw, const float* __restrict__ cb, const bf16* __restrict__ gimg, const float* __restrict__ gab, const float* __restrict__ gxb,
                      const float* __restrict__ lam, bf16* __restrict__ LA, bf16* __restrict__ BV, float2* __restrict__ SUM, int item, char* smem) {
    const int rt = item >> 4, nb = item & 15; const int tid = TIDX, lane = tid & 63, wave = tid >> 6, q = lane >> 4, l15 = lane & 15;
    const size_t m0 = (size_t)rt * 128;
    for (int id = tid; id < 128 * 12; id += NTHREADS) {
        const int row = id / 12, c12 = id % 12; u32x4 outv = (u32x4){0u, 0u, 0u, 0u};
        if (c12 < 10) {
            const size_t m = m0 + row; const int t = (int)(m % T); const int ch = nb * 80 + c12 * 8;
            float acc[8];
            { const float4 b0 = *(const float4*)(cb + ch), b1 = *(const float4*)(cb + ch + 4); acc[0] = b0.x; acc[1] = b0.y; acc[2] = b0.z; acc[3] = b0.w; acc[4] = b1.x; acc[5] = b1.y; acc[6] = b1.z; acc[7] = b1.w; }
#pragma unroll
            for (int w = 0; w < 4; ++w) {
                if (t - 3 + w >= 0) {
                    const u32x4 uv = *(const u32x4*)(P3 + (m - 3 + w) * 2560 + ch);
                    const float4 w0 = *(const float4*)(cw + w * LW + ch), w1 = *(const float4*)(cw + w * LW + ch + 4);
                    acc[0] += w0.x * bflo(uv[0]); acc[1] += w0.y * bfhi(uv[0]); acc[2] += w0.z * bflo(uv[1]); acc[3] += w0.w * bfhi(uv[1]);
                    acc[4] += w1.x * bflo(uv[2]); acc[5] += w1.y * bfhi(uv[2]); acc[6] += w1.z * bflo(uv[3]); acc[7] += w1.w * bfhi(uv[3]);
                }
            }
            outv = (u32x4){pack2bf(acc[0], acc[1]), pack2bf(acc[2], acc[3]), pack2bf(acc[4], acc[5]), pack2bf(acc[6], acc[7])};
        }
        const int ks = c12 >> 2, c = c12 & 3;
        *(u32x4*)(smem + ks * 8192 + row * 64 + ((c ^ ((row >> 2) & 3)) << 4)) = outv;
    }
    for (int id = tid; id < 160 * 12; id += NTHREADS) {
        const int row = id / 12, c12 = id % 12; const int ks = c12 >> 2, c = c12 & 3;
        *(u32x4*)(smem + 24576 + ks * 10240 + row * 64 + ((c ^ ((row >> 2) & 3)) << 4)) = *(const u32x4*)(gimg + ((size_t)nb * 160 + row) * 96 + c12 * 8);
    }
    __syncthreads();
    f32x4 acc[2][10];
#pragma unroll
    for (int i = 0; i < 2; ++i)
#pragma unroll
        for (int j = 0; j < 10; ++j) acc[i][j] = (f32x4){0.f, 0.f, 0.f, 0.f};
    const int fo = l15 * 64 + ((q ^ ((l15 >> 2) & 3)) << 4);
#pragma unroll
    for (int ks = 0; ks < 3; ++ks) {
        bf16x8 uf[2];
#pragma unroll
        for (int i = 0; i < 2; ++i) uf[i] = *(const bf16x8*)(smem + ks * 8192 + (wave * 32 + i * 16) * 64 + fo);
#pragma unroll
        for (int j = 0; j < 10; ++j) {
            const bf16x8 wf = *(const bf16x8*)(smem + 24576 + ks * 10240 + j * 1024 + fo);
            acc[0][j] = __builtin_amdgcn_mfma_f32_16x16x32_bf16(wf, uf[0], acc[0][j], 0, 0, 0);
            acc[1][j] = __builtin_amdgcn_mfma_f32_16x16x32_bf16(wf, uf[1], acc[1][j], 0, 0, 0);
        }
    }
    __syncthreads();
#pragma unroll
    for (int i = 0; i < 2; ++i) {
        const int row = wave * 32 + i * 16 + l15; const size_t m = m0 + row;
#pragma unroll
        for (int ct = 0; ct < 5; ++ct) {
            const int kcol = ct * 16 + 4 * q; const int ch = nb * 80 + kcol;
            const u32x2 uu = *(const u32x2*)(smem + (kcol >> 5) * 8192 + row * 64 + ((((kcol & 31) >> 3) ^ ((row >> 2) & 3)) << 4) + (kcol & 7) * 2);
            const float uc[4] = {bflo(uu[0]), bfhi(uu[0]), bflo(uu[1]), bfhi(uu[1])};
            const float4 ba = *(const float4*)(gab + ch), bx = *(const float4*)(gxb + ch), lm = *(const float4*)(lam + ch);
            const float bav[4] = {ba.x, ba.y, ba.z, ba.w}, bxv[4] = {bx.x, bx.y, bx.z, bx.w}, lmv[4] = {lm.x, lm.y, lm.z, lm.w};
            float la[4], bv[4];
#pragma unroll
            for (int r = 0; r < 4; ++r) {
                const float rg = __builtin_amdgcn_rcpf(1.0f + __expf(-(acc[i][ct][r] + bav[r]))), ig = __builtin_amdgcn_rcpf(1.0f + __expf(-(acc[i][ct + 5][r] + bxv[r])));
                la[r] = rg * lmv[r];
                const float om = 1.0f - __expf(2.0f * la[r]);
                bv[r] = __builtin_amdgcn_sqrtf(om > 0.f ? om : 0.f) * (ig * uc[r]);
            }
            const u32x2 lav = {pack2bf(la[0], la[1]), pack2bf(la[2], la[3])}, bvv = {pack2bf(bv[0], bv[1]), pack2bf(bv[2], bv[3])};
            *(u32x2*)(LA + m * LW + ch) = lav; *(u32x2*)(BV + m * LW + ch) = bvv;
            *(u32x2*)(smem + 24576 + (row * 80 + kcol) * 2) = lav; *(u32x2*)(smem + 24576 + 20480 + (row * 80 + kcol) * 2) = bvv;
        }
    }
    __syncthreads();
    if (tid < 160) {
        const int cidx = tid / 80, c = tid % 80; const bf16* li = (const bf16*)(smem + 24576) + (cidx * 64) * 80 + c; const bf16* bi = li + 10240;
        float sla = 0.f, h = 0.f;
#pragma unroll 8
        for (int t = 0; t < 64; ++t) { const float la = bf2f(li[t * 80]), bvv = bf2f(bi[t * 80]); h = __expf(la) * h + bvv; sla += la; }
        const size_t mc = m0 + cidx * 64; const int bb = (int)(mc / T), jj = (int)(mc % T) / 64;
        SUM[((size_t)bb * (T / 64) + jj) * LW + nb * 80 + c] = make_float2(__expf(sla), h);
    }
    __syncthreads();
}
DI void lru_scan2_item(const bf16* __restrict__ LA, const bf16* __restrict__ BV, const float2* __restrict__ SUM, const bf16* __restrict__ P3, bf16* __restrict__ AO, int item) {
    const int cg = item % 5, j = (item / 5) % (T / 64), b = item / (5 * (T / 64)); const int c = cg * 256 + TIDX;
    float h = 0.f;
    for (int jj = 0; jj < j; ++jj) { const float2 s = SUM[((size_t)b * (T / 64) + jj) * LW + c]; h = s.x * h + s.y; }
    const size_t m0 = (size_t)b * T + j * 64;
#pragma unroll 8
    for (int t = 0; t < 64; ++t) {
        const float la = bf2f(LA[(m0 + t) * LW + c]); const float bv = bf2f(BV[(m0 + t) * LW + c]); const float z = bf2f(P3[(m0 + t) * 2560 + LW + c]);
        h = __expf(la) * h + bv; AO[(m0 + t) * LW + c] = f2bf(h * siluf_(z));
    }
}

struct ALoadF32 {
    const float* A;
    static constexpr bool DMA = false;
    DI const bf16* src(int, int) const { return nullptr; }
    struct Raw { float4 a, b; };
    DI Raw load(int m, int k) const { Raw r; r.a = *(const float4*)(A + (size_t)m * 64 + k); r.b = *(const float4*)(A + (size_t)m * 64 + k + 4); return r; }
    DI u32x4 finish(const Raw& r, int, int) const { return (u32x4){pack2bf(r.a.x, r.a.y), pack2bf(r.a.z, r.a.w), pack2bf(r.b.x, r.b.y), pack2bf(r.b.z, r.b.w)}; }
};
struct EpiLora {
    const float* w0; const float* a0; bf16* WL; bf16* AV;
    DI void operator()(int m, int n, const float* v, int, int) const {
        float w[8];
        if (n < 1024) {
#pragma unroll
            for (int j = 0; j < 8; ++j) w[j] = -0.60653065971f * __builtin_amdgcn_rcpf(1.0f + __expf(-(w0[n + j] + v[j])));
            store8bf(WL + (size_t)m * D + n, w);
        } else {
#pragma unroll
            for (int j = 0; j < 8; ++j) w[j] = __builtin_amdgcn_rcpf(1.0f + __expf(-(a0[n - 1024 + j] + v[j])));
            store8bf(AV + (size_t)m * D + n - 1024, w);
        }
    }
    DI void finish(int, int, int, int, int) const {}
    DI void finish_wide(int, int, int, int, int) const {}
};
DI float dpp_sum16(float x) {
    x += __builtin_bit_cast(float, __builtin_amdgcn_update_dpp(0, __builtin_bit_cast(int, x), 0xB1, 0xf, 0xf, false));
    x += __builtin_bit_cast(float, __builtin_amdgcn_update_dpp(0, __builtin_bit_cast(int, x), 0x4E, 0xf, 0xf, false));
    x += __builtin_bit_cast(float, __builtin_amdgcn_update_dpp(0, __builtin_bit_cast(int, x), 0x141, 0xf, 0xf, false));
    x += __builtin_bit_cast(float, __builtin_amdgcn_update_dpp(0, __builtin_bit_cast(int, x), 0x140, 0xf, 0xf, false));
    return x;
}
constexpr int RW_NCH = T / 16;
DI void rwkv_prep_item(bf16* __restrict__ P, bf16* __restrict__ WL, bf16* __restrict__ AV, const float* __restrict__ k_k, const float* __restrict__ k_a, const float* __restrict__ r_k,
                       float* __restrict__ G15, bf16* __restrict__ M2g, bf16* __restrict__ M3g, float* __restrict__ BON, int item, char* smem) {
    const int c = item % RW_NCH, h = (item / RW_NCH) & 15, b = item / (RW_NCH * 16);
    const int tid = TIDX, t = tid >> 4, jq = tid & 15, j0 = jq * 4;
    const size_t m0 = (size_t)b * T + c * 16, m = m0 + t; const size_t ch = (size_t)(b * 16 + h) * RW_NCH + c;
    float* sA = (float*)smem; float* sR = sA + 16 * 68; float* sB = sR + 16 * 68; float* sK = sB + 16 * 68; float* sW = sK + 16 * 68; float* sWl = sW + 16 * 68;
    float* mAab = sWl + 16 * 64; float* mAak = mAab + 16 * 17; float* mArb = mAak + 16 * 17; float* mArk = mArb + 16 * 17; float* mTin = mArk + 16 * 17; float* mM2 = mTin + 16 * 17;
    const u32x2 r2 = *(const u32x2*)(P + m * 4096 + h * 64 + j0), k2 = *(const u32x2*)(P + m * 4096 + 1024 + h * 64 + j0), a2 = *(const u32x2*)(AV + m * D + h * 64 + j0), w2 = *(const u32x2*)(WL + m * D + h * 64 + j0);
    const float rr[4] = {bflo(r2[0]), bfhi(r2[0]), bflo(r2[1]), bfhi(r2[1])}, kr[4] = {bflo(k2[0]), bfhi(k2[0]), bflo(k2[1]), bfhi(k2[1])},
                av[4] = {bflo(a2[0]), bfhi(a2[0]), bflo(a2[1]), bfhi(a2[1])}, wl[4] = {bflo(w2[0]), bfhi(w2[0]), bflo(w2[1]), bfhi(w2[1])};
    const float4 kk4 = *(const float4*)(k_k + h * 64 + j0), ka4 = *(const float4*)(k_a + h * 64 + j0), rk4 = *(const float4*)(r_k + h * 64 + j0);
    const float kkc[4] = {kk4.x, kk4.y, kk4.z, kk4.w}, kac[4] = {ka4.x, ka4.y, ka4.z, ka4.w}, rkc[4] = {rk4.x, rk4.y, rk4.z, rk4.w};
    float kkv[4], n2 = 0.f;
#pragma unroll
    for (int e = 0; e < 4; ++e) { kkv[e] = kr[e] * kkc[e]; n2 += kkv[e] * kkv[e]; }
    n2 = dpp_sum16(n2);
    float nr = sqrtf(n2); nr = nr > 1e-12f ? nr : 1e-12f; const float inr = 1.0f / nr;
    float aa[4], bb[4], kp[4], bon = 0.f;
#pragma unroll
    for (int e = 0; e < 4; ++e) { const float kn = kkv[e] * inr; aa[e] = -kn; bb[e] = kn * av[e]; kp[e] = kr[e] * (1.0f + (av[e] - 1.0f) * kac[e]); bon += rr[e] * kp[e] * rkc[e]; }
    bon = dpp_sum16(bon);
    if (jq == 0) BON[m * 16 + h] = bon;
    *(float4*)(sWl + t * 64 + j0) = make_float4(wl[0], wl[1], wl[2], wl[3]);
    __syncthreads();
    float clx[4] = {0.f, 0.f, 0.f, 0.f};
#pragma unroll
    for (int s = 0; s < 15; ++s) { if (s < t) { const float4 w = *(const float4*)(sWl + s * 64 + j0); clx[0] += w.x; clx[1] += w.y; clx[2] += w.z; clx[3] += w.w; } }
    float bt[4];
    {
        float va[4], vr[4], vk[4], gc[4];
#pragma unroll
        for (int e = 0; e < 4; ++e) { const float cl = clx[e] + wl[e]; const float gp = __expf(clx[e]), gi = __expf(-cl); gc[e] = __expf(cl); va[e] = aa[e] * gp; vr[e] = rr[e] * gc[e]; bt[e] = bb[e] * gi; vk[e] = kp[e] * gi; }
        *(float4*)(sA + t * 68 + j0) = make_float4(va[0], va[1], va[2], va[3]); *(float4*)(sR + t * 68 + j0) = make_float4(vr[0], vr[1], vr[2], vr[3]);
        *(float4*)(sB + t * 68 + j0) = make_float4(bt[0], bt[1], bt[2], bt[3]); *(float4*)(sK + t * 68 + j0) = make_float4(vk[0], vk[1], vk[2], vk[3]);
        {
            char* img = (char*)(mM2 + 16 * 17) + t * 128 + (((j0 >> 3) ^ (t & 7)) << 4) + (j0 & 4) * 2;
            *(u32x2*)(img) = (u32x2){pack2bf(va[0], va[1]), pack2bf(va[2], va[3])}; *(u32x2*)(img + 2048) = (u32x2){pack2bf(vr[0], vr[1]), pack2bf(vr[2], vr[3])};
            *(u32x2*)(img + 4096) = (u32x2){pack2bf(bt[0], bt[1]), pack2bf(bt[2], bt[3])}; *(u32x2*)(img + 6144) = (u32x2){pack2bf(vk[0], vk[1]), pack2bf(vk[2], vk[3])};
        }
        if (t == 15) *(float4*)(G15 + ch * 64 + j0) = make_float4(gc[0], gc[1], gc[2], gc[3]);
#pragma unroll
        for (int e = 0; e < 4; ++e) {   }
#pragma unroll
        for (int e = 0; e < 4; ++e) clx[e] = vk[e];
    }
    __syncthreads();
    {
        const int wv = __builtin_amdgcn_readfirstlane(tid >> 6), lane = tid & 63, q = lane >> 4, l15 = lane & 15;
        const char* xb_ = (const char*)(mM2 + 16 * 17) + (wv >> 1) * 2048;
        const char* yb_ = (const char*)(mM2 + 16 * 17) + 4096 + (wv & 1) * 2048;
        f32x4 acc = {0.f, 0.f, 0.f, 0.f};
#pragma unroll
        for (int ks = 0; ks < 2; ++ks) {
            const int off = l15 * 128 + (((ks * 4 + q) ^ (l15 & 7)) << 4);
            const bf16x8 xf = *(const bf16x8*)(xb_ + off), yf = *(const bf16x8*)(yb_ + off);
            acc = __builtin_amdgcn_mfma_f32_16x16x32_bf16(xf, yf, acc, 0, 0, 0);
        }
        float* dst = wv == 0 ? mAab : (wv == 1 ? mAak : (wv == 2 ? mArb : mArk));
        const bool strict = wv < 2;
#pragma unroll
        for (int r = 0; r < 4; ++r) { const int tt = 4 * q + r, ss = l15; dst[tt * 17 + ss] = (strict ? ss < tt : ss <= tt) ? acc[r] : 0.f; }
    }
    __syncthreads();
    if (tid < 16) {
        float col[16];
#pragma unroll
        for (int i = 0; i < 16; ++i) {
            float acc = (i == tid) ? 1.0f : 0.f;
#pragma unroll
            for (int jj = 0; jj < i; ++jj) acc += mAab[i * 17 + jj] * col[jj];
            col[i] = acc; mTin[i * 17 + tid] = acc;
        }
    }
    __syncthreads();
    float wv[4] = {0.f, 0.f, 0.f, 0.f}, m2 = 0.f;
#pragma unroll
    for (int s = 0; s < 16; ++s) { const float ti = mTin[t * 17 + s]; const float4 a4 = *(const float4*)(sA + s * 68 + j0); wv[0] += ti * a4.x; wv[1] += ti * a4.y; wv[2] += ti * a4.z; wv[3] += ti * a4.w; m2 += ti * mAak[s * 17 + jq]; }
    *(float4*)(sW + t * 68 + j0) = make_float4(wv[0], wv[1], wv[2], wv[3]); mM2[t * 17 + jq] = m2;
    __syncthreads();
    float rh[4]; { const float4 r4 = *(const float4*)(sR + t * 68 + j0); rh[0] = r4.x; rh[1] = r4.y; rh[2] = r4.z; rh[3] = r4.w; }
    float m3 = mArk[t * 17 + jq];
#pragma unroll
    for (int s = 0; s < 16; ++s) { const float ar = mArb[t * 17 + s]; const float4 w4 = *(const float4*)(sW + s * 68 + j0); rh[0] += ar * w4.x; rh[1] += ar * w4.y; rh[2] += ar * w4.z; rh[3] += ar * w4.w; m3 += ar * mM2[s * 17 + jq]; }
    const int jp = (((jq >> 3) * 4 + (jq & 3)) * 8 + ((jq >> 2) & 1) * 4);
    *(u32x2*)(WL + m * D + h * 64 + jp) = (u32x2){pack2bf(wv[0], wv[1]), pack2bf(wv[2], wv[3])};
    *(u32x2*)(P + m * 4096 + h * 64 + jp) = (u32x2){pack2bf(rh[0], rh[1]), pack2bf(rh[2], rh[3])};
#pragma unroll
    for (int e = 0; e < 4; ++e) {
        const int pos = ((e & 1) * 4 + (t >> 2)) * 8 + (t & 3);
        bf16* dst = e < 2 ? P + (m0 + jq) * 4096 + 1024 + h * 64 : AV + (m0 + jq) * D + h * 64;
        dst[pos] = f2bf(clx[e]); dst[pos + 4] = f2bf(bt[e]);
    }
    M2g[ch * 256 + t * 16 + jq] = f2bf(m2); M3g[ch * 256 + t * 16 + jq] = f2bf(m3);
    __syncthreads();
}

#define MFMA32(a, b, c) __builtin_amdgcn_mfma_f32_16x16x32_bf16(__builtin_bit_cast(bf16x8, a), __builtin_bit_cast(bf16x8, b), c, 0, 0, 0)
DI void rwkv_chunk_scan(const bf16* __restrict__ P, const bf16* __restrict__ WL, const bf16* __restrict__ AV, const float* __restrict__ G15, const bf16* __restrict__ M2g, const bf16* __restrict__ M3g,
                        bf16* __restrict__ YS, int bh, char* smem) {
    constexpr int SLOT = 12288, YOFF = 49152;
    const int tid = TIDX, lane = tid & 63, vs = __builtin_amdgcn_readfirstlane(tid >> 6), q = lane >> 4, l15 = lane & 15; const int b = bh >> 4, h = bh & 15;
    const size_t mb = (size_t)b * T; const size_t ch0 = (size_t)(b * 16 + h) * RW_NCH;
    const char *s0, *s1, *s2; size_t d0, d1, d2;
    if (tid < 128) { const int c8 = tid >> 4, t = tid & 15; s0 = (const char*)(WL + (mb + t) * D + h * 64 + c8 * 8); d0 = (size_t)16 * D * 2; }
    else { const int pp = tid - 128, c8 = pp >> 4, t = pp & 15; s0 = (const char*)(P + (mb + t) * 4096 + h * 64 + c8 * 8); d0 = (size_t)16 * 4096 * 2; }
    if (tid < 128) { const int r = tid >> 3, c8 = tid & 7; s1 = (const char*)(P + (mb + r) * 4096 + 1024 + h * 64 + c8 * 8); d1 = (size_t)16 * 4096 * 2; }
    else { const int pp = tid - 128, r = pp >> 3, c8 = pp & 7; s1 = (const char*)(AV + (mb + r) * D + h * 64 + c8 * 8); d1 = (size_t)16 * D * 2; }
    if (tid < 128) { const int r = tid >> 3, c8 = tid & 7; s2 = (const char*)(P + (mb + r) * 4096 + 2048 + h * 64 + c8 * 8); d2 = (size_t)16 * 4096 * 2; }
    else if (tid < 160) { s2 = (const char*)(M2g + ch0 * 256 + (tid - 128) * 8); d2 = 512; }
    else if (tid < 192) { s2 = (const char*)(M3g + ch0 * 256 + (tid - 160) * 8); d2 = 512; }
    else { const int pp = tid < 208 ? tid - 192 : 0; s2 = (const char*)(G15 + ch0 * 64 + pp * 4); d2 = 256; }
    const int dma_off = vs * 1024;
#define RW_DMA(slot_) { char* dst = smem + (slot_) * SLOT + dma_off; GLDS16(s0, dst); GLDS16(s1, dst + 4096); GLDS16(s2, dst + 8192); s0 += d0; s1 += d1; s2 += d2; }
#define RW_BARRIER() { asm volatile("s_waitcnt lgkmcnt(0)" ::: "memory"); __builtin_amdgcn_s_barrier(); asm volatile("" ::: "memory"); }
    f32x4 H0 = {0.f, 0.f, 0.f, 0.f}, H1 = H0, H2 = H0, H3 = H0;
    const int oW = (q * 16 + l15) * 16;
    const int oK = 4096 + ((l15 & 3) >> 1) * 2048 + ((l15 >> 2) * 8 + (l15 & 1) * 4 + q) * 16;
    const int oM = 10240 + l15 * 32 + q * 8;
    const int oV = 8192 + (4 * q) * 128 + (vs * 16 + l15) * 2;
    const int oG = 11264 + (4 * q) * 4;
    const int oY = YOFF + ((4 * q) * 64 + vs * 16 + l15) * 2;
    RW_DMA(0); RW_DMA(1); RW_DMA(2);
    asm volatile("s_waitcnt vmcnt(6)" ::: "memory");
    RW_BARRIER();
    const u32x4 zz4 = {0u, 0u, 0u, 0u};
    u32x4 Hb0A = zz4, Hb1A = zz4, VUA = zz4, m3A = zz4, rAA = zz4, rBA = zz4;
    u32x4 Hb0B = zz4, Hb1B = zz4, VUB = zz4, m3B = zz4, rAB = zz4, rBB = zz4;
    u32x4 m2x = zz4;
    int sincef = 3;
#define RW_FLUSH(cbase_) { u32x4 yv[4]; \
        _Pragma("unroll") for (int k = 0; k < 4; ++k) yv[k] = *(const u32x4*)(smem + YOFF + (tid + 256 * k) * 16); \
        _Pragma("unroll") for (int k = 0; k < 4; ++k) { const int pc = tid + 256 * k, rr = pc >> 3, c8 = pc & 7; *(u32x4*)(YS + (mb + (size_t)(cbase_) * 16 + rr) * D + h * 64 + c8 * 8) = yv[k]; } }
#define RW_YSTORE(Y_, cprev_) { char* yb = smem + oY + ((cprev_) & 7) * 2048; const unsigned y01 = pack2bf(Y_[0], Y_[1]), y23 = pack2bf(Y_[2], Y_[3]); \
        *(unsigned short*)(yb) = (unsigned short)y01; *(unsigned short*)(yb + 128) = (unsigned short)(y01 >> 16); \
        *(unsigned short*)(yb + 256) = (unsigned short)y23; *(unsigned short*)(yb + 384) = (unsigned short)(y23 >> 16); }
#define RW_STEP(c_, P_, N_, J_) { const int c = (c_);        \
        if (c + 3 < RW_NCH) RW_DMA(((J_) + 3) & 3); \
        const char* sl = smem + (J_) * SLOT; \
        { \
            const f32x4 z4 = {0.f, 0.f, 0.f, 0.f}; \
            Hb0##N_ = (u32x4){pack2bf(H0[0], H0[1]), pack2bf(H0[2], H0[3]), pack2bf(H1[0], H1[1]), pack2bf(H1[2], H1[3])}; \
            Hb1##N_ = (u32x4){pack2bf(H2[0], H2[1]), pack2bf(H2[2], H2[3]), pack2bf(H3[0], H3[1]), pack2bf(H3[2], H3[3])}; \
            const unsigned v0 = *(const bf16*)(sl + oV), v1 = *(const bf16*)(sl + oV + 128), v2 = *(const bf16*)(sl + oV + 256), v3 = *(const bf16*)(sl + oV + 384); \
            VU##N_[0] = v0 | (v1 << 16); VU##N_[1] = v2 | (v3 << 16); \
            { const u32x2 t2 = *(const u32x2*)(sl + oM), t3 = *(const u32x2*)(sl + oM + 512); m2x[0] = t2[0]; m2x[1] = t2[1]; m3##N_[0] = t3[0]; m3##N_[1] = t3[1]; } \
            const u32x4 wA = *(const u32x4*)(sl + oW), wB = *(const u32x4*)(sl + oW + 1024); \
            rA##N_ = *(const u32x4*)(sl + 2048 + oW); rB##N_ = *(const u32x4*)(sl + 2048 + oW + 1024); \
            f32x4 U = MFMA32(m2x, VU##N_, z4); \
            f32x4 Y = MFMA32(m3##P_, VU##P_, z4); \
            U = MFMA32(wA, Hb0##N_, U); \
            Y = MFMA32(rA##P_, Hb0##P_, Y); \
            U = MFMA32(wB, Hb1##N_, U); \
            Y = MFMA32(rB##P_, Hb1##P_, Y); \
            VU##N_[2] = pack2bf(U[0], U[1]); VU##N_[3] = pack2bf(U[2], U[3]); \
            const u32x4 kb0 = *(const u32x4*)(sl + oK), kb1 = *(const u32x4*)(sl + oK + 512), kb2 = *(const u32x4*)(sl + oK + 1024), kb3 = *(const u32x4*)(sl + oK + 1536); \
            const f32x4 g0 = *(const f32x4*)(sl + oG), g1 = *(const f32x4*)(sl + oG + 64), g2 = *(const f32x4*)(sl + oG + 128), g3 = *(const f32x4*)(sl + oG + 192); \
            const f32x4 a0 = MFMA32(kb0, VU##N_, H0), a1 = MFMA32(kb1, VU##N_, H1); \
            const f32x4 a2 = MFMA32(kb2, VU##N_, H2), a3 = MFMA32(kb3, VU##N_, H3); \
            H0 = a0 * g0; H1 = a1 * g1; H2 = a2 * g2; H3 = a3 * g3; \
            if (c > 0) RW_YSTORE(Y, c - 1);                   \
        } \
        const bool flush = c > 0 && (c & 7) == 0; \
        if (flush) { \
            RW_BARRIER();                                     \
            { int cb = c - 8; asm volatile("" : "+s"(cb)); RW_FLUSH(cb); }        \
            sincef = 0; \
        } \
          \
          \
        if (c + 3 < RW_NCH) { if (sincef <= 2) asm volatile("s_waitcnt vmcnt(10)" ::: "memory"); else asm volatile("s_waitcnt vmcnt(6)" ::: "memory"); } \
        else if (c + 2 < RW_NCH) { asm volatile("s_waitcnt vmcnt(3)" ::: "memory"); } \
        else { asm volatile("s_waitcnt vmcnt(0)" ::: "memory"); } \
        RW_BARRIER(); \
        ++sincef; }
    for (int cc = 0; cc < RW_NCH; cc += 4) {
        RW_STEP(cc, B, A, 0);
        RW_STEP(cc + 1, A, B, 1);
        RW_STEP(cc + 2, B, A, 2);
        RW_STEP(cc + 3, A, B, 3);
    }
    {
        const f32x4 z4 = {0.f, 0.f, 0.f, 0.f};
        f32x4 Y = MFMA32(m3B, VUB, z4);
        Y = MFMA32(rAB, Hb0B, Y);
        Y = MFMA32(rBB, Hb1B, Y);
        RW_YSTORE(Y, RW_NCH - 1);
        RW_BARRIER();
        RW_FLUSH(RW_NCH - 8);
    }
#undef RW_STEP
#undef RW_YSTORE
#undef RW_FLUSH
#undef RW_DMA
#undef RW_BARRIER
}
DI void rwkv_gn_rows2(const bf16* __restrict__ P, const float* __restrict__ BON, const float* __restrict__ lnw, const float* __restrict__ lnb, bf16* __restrict__ YS) {
    const int tid = TIDX, lane = tid & 63, wave = tid >> 6; const int c = wave * 256 + lane * 4;
    const float4 lw = *(const float4*)(lnw + c), lb = *(const float4*)(lnb + c);
    for (size_t m = blockIdx.x; m < (size_t)M; m += gridDim.x) {
        const u32x2 yy = *(const u32x2*)(YS + m * D + c), vv = *(const u32x2*)(P + m * 4096 + 2048 + c), zz = *(const u32x2*)(P + m * 4096 + 3072 + c);
        const float bs = BON[m * 16 + (c >> 6)];
        const float y[4] = {bflo(yy[0]), bfhi(yy[0]), bflo(yy[1]), bfhi(yy[1])}, v[4] = {bflo(vv[0]), bfhi(vv[0]), bflo(vv[1]), bfhi(vv[1])}, z[4] = {bflo(zz[0]), bfhi(zz[0]), bflo(zz[1]), bfhi(zz[1])};
        const float lwv[4] = {lw.x, lw.y, lw.z, lw.w}, lbv[4] = {lb.x, lb.y, lb.z, lb.w};
        const float mean = dpp_sum16((y[0] + y[1]) + (y[2] + y[3])) * (1.0f / 64.0f);
        float var = 0.f;
#pragma unroll
        for (int i = 0; i < 4; ++i) { const float d = y[i] - mean; var += d * d; }
        var = dpp_sum16(var) * (1.0f / 64.0f);
        const float rstd = 1.0f / sqrtf(var + 64e-5f);
        float o[4];
#pragma unroll
        for (int i = 0; i < 4; ++i) o[i] = ((y[i] - mean) * rstd * lwv[i] + lbv[i] + bs * v[i]) * siluf_(z[i]);
        *(u32x2*)(YS + m * D + c) = (u32x2){pack2bf(o[0], o[1]), pack2bf(o[2], o[3])};
    }
}

struct FastBufs { char* ws; };

DI void rows_xb_parts(const float* __restrict__ x, bf16* xb, float* parts) {
    const int lane = TIDX & 63, wave = TIDX >> 6;
    for (int m = blockIdx.x * 4 + wave; m < M; m += gridDim.x * 4) {
        const float* xr = x + (size_t)m * D; float s = 0.f;
#pragma unroll
        for (int i = 0; i < 2; ++i) {
            const int k = (i * 64 + lane) * 8; const float4 a = *(const float4*)(xr + k), b = *(const float4*)(xr + k + 4);
            const float w[8] = {a.x, a.y, a.z, a.w, b.x, b.y, b.z, b.w};
#pragma unroll
            for (int j = 0; j < 8; ++j) s += w[j] * w[j];
            store8bf(xb + (size_t)m * D + k, w);
        }
#pragma unroll
        for (int o = 32; o >= 1; o >>= 1) s += __shfl_xor(s, o);
        if (lane < 16) parts[(size_t)m * 16 + lane] = lane == 0 ? s : 0.f;
    }
}
DI void rows_xn(const float* __restrict__ x, const float* parts, const float* __restrict__ g, bf16* xn) {
    const int lane = TIDX & 63, wave = TIDX >> 6;
    for (int m = blockIdx.x * 4 + wave; m < M; m += gridDim.x * 4) {
        const float rs = rstd_from_parts(parts, m); const float* xr = x + (size_t)m * D;
#pragma unroll
        for (int i = 0; i < 2; ++i) {
            const int k = (i * 64 + lane) * 8; const float4 a = *(const float4*)(xr + k), b = *(const float4*)(xr + k + 4);
            const float4 ga = *(const float4*)(g + k), gb = *(const float4*)(g + k + 4);
            const float w[8] = {a.x * rs * ga.x, a.y * rs * ga.y, a.z * rs * ga.z, a.w * rs * ga.w, b.x * rs * gb.x, b.y * rs * gb.y, b.z * rs * gb.z, b.w * rs * gb.w};
            store8bf(xn + (size_t)m * D + k, w);
        }
    }
}
DI void rows_final(float* x, const float* parts, const float* __restrict__ g) {
    const int lane = TIDX & 63, wave = TIDX >> 6;
    for (int m = blockIdx.x * 4 + wave; m < M; m += gridDim.x * 4) {
        const float rs = rstd_from_parts(parts, m); float* xr = x + (size_t)m * D;
#pragma unroll
        for (int i = 0; i < 4; ++i) {
            const int k = (i * 64 + lane) * 4; float4 a = *(float4*)(xr + k); const float4 ga = *(const float4*)(g + k);
            a.x *= rs * ga.x; a.y *= rs * ga.y; a.z *= rs * ga.z; a.w *= rs * ga.w; *(float4*)(xr + k) = a;
        }
    }
}
enum { PH_PREP0 = 0, PH_IN0, PH_ATTN0, PH_OUT0, PH_PREP1, PH_IN1, PH_LORA1, PH_CPREP1, PH_SCAN1, PH_GN1, PH_OUT1, PH_PREP2, PH_IN2, PH_B2, PH_C2, PH_D2, PH_OUT2, PH_PREP3, PH_IN3, PH_GATE3, PH_SCANA3, PH_SCANB3, PH_OUT3, PH_FINAL };

namespace wbo {
constexpr size_t IN = 0;
constexpr size_t OUT = (size_t)4352 * 1024;
constexpr size_t EXTRA = OUT + (size_t)1280 * 1024;
}

template <int PH>
DI void run_phase(const Params& p, char* smem) {
    char* ws = p.ws;
    float* parts = (float*)(ws + fw::PARTS);
    constexpr int LAYER = PH <= PH_OUT0 ? 0 : PH <= PH_OUT1 ? 1 : PH <= PH_OUT2 ? 2 : 3;
    constexpr size_t WBOFF = LAYER == 0 ? 200 * fw::MB : LAYER == 1 ? 238 * fw::MB : LAYER == 2 ? 240 * fw::MB : 1 * fw::MB;
    bf16* WB = (bf16*)(ws + WBOFF);
    bf16* XB = (bf16*)(ws + ((PH == PH_PREP0 || PH == PH_IN0) ? 130 * fw::MB : 174 * fw::MB));
    bf16* P = (bf16*)(ws + wsl::P);
    float* X = p.out;
    float* smf = (float*)smem;
    if (PH == PH_PREP0) {
        rows_xb_parts(p.x, XB, parts);
        int tb = 0;
        convert_seg(p.a_w_in, A_COLS, 0, A_COLS, 1024, WB + wbo::IN, p.norm_g + 0 * D, smf, tb);
        convert_seg(p.a_w_out, 1024, 0, 1024, 1024, WB + wbo::OUT, nullptr, smf, tb);
    } else if (PH == PH_IN0) {
        gemm_sched(8, 4, [&](bool big, int mt, int nt) {
            if (big) gemm_tile2(ALoadPlain{XB, D}, WB + wbo::IN, 1024, mt * 128, nt * 256, EpiL0{P, (bf16*)(ws + 86 * fw::MB), parts}, smem);
            else gemm_tile(ALoadPlain{XB, D}, WB + wbo::IN, 1024, mt * 128, 2048 + nt * 128, EpiL0{P, (bf16*)(ws + 86 * fw::MB), parts}, smem);
        });
    } else if (PH == PH_ATTN0) {
        build_bias_lut(p.t5, smem, true);
        for (int it = blockIdx.x; it < B * G * (T / (16 * ANQT_SWA)); it += gridDim.x) swa_item(P, (const bf16*)(ws + 86 * fw::MB), p.a_sinks, (bf16*)(ws + wsl::L0_AO), it, smem);
    } else if (PH == PH_OUT0) {
        gemm_sched(4, 0, [&](bool, int mt, int nt) { gemm_tile2(ALoadPlain{(const bf16*)(ws + wsl::L0_AO), D}, WB + wbo::OUT, 1024, mt * 128, nt * 256, EpiResid{p.x, X, nullptr, parts}, smem); });
    } else if (PH == PH_PREP1) {
        rows_xn(X, parts, p.norm_g + 1 * D, (bf16*)(ws + wsl::L1_XN));
        int tb = 0;
        convert_seg(p.b_w_in, 4096, 0, 4096, 1024, WB + wbo::IN, nullptr, smf, tb);
        convert_seg(p.b_w1, 64, 0, 64, 1024, WB + wbo::IN + (size_t)4096 * 1024, nullptr, smf, tb);
        convert_seg(p.b_a1, 64, 0, 64, 1024, WB + wbo::IN + (size_t)(4096 + 128) * 1024, nullptr, smf, tb);
        convert_seg(p.b_w_out, 1024, 0, 1024, 1024, WB + wbo::OUT, nullptr, smf, tb);
        convert_seg(p.b_w2, 1024, 0, 1024, 64, WB + wbo::EXTRA, nullptr, smf, tb);
        convert_seg(p.b_a2, 1024, 0, 1024, 64, WB + wbo::EXTRA + (size_t)1024 * 64, nullptr, smf, tb);
        for (size_t i = (size_t)blockIdx.x * 256 + TIDX; i < (size_t)64 * 1024 / 8; i += (size_t)gridDim.x * 256) {
            ((u32x4*)(WB + wbo::IN + (size_t)(4096 + 64) * 1024))[i] = (u32x4){0u, 0u, 0u, 0u};
            ((u32x4*)(WB + wbo::IN + (size_t)(4096 + 192) * 1024))[i] = (u32x4){0u, 0u, 0u, 0u};
        }
    } else if (PH == PH_IN1) {
        const bf16* XN = (const bf16*)(ws + wsl::L1_XN);
        EpiRwkv epi{P, (float*)(ws + wsl::LHW), (float*)(ws + wsl::LHA)};
        gemm_sched(16, 2, [&](bool big, int mt, int nt) {
            if (big) gemm_tile2(ALoadLerp{XN, p.b_mu + (nt >> 2) * D}, WB + wbo::IN, 1024, mt * 128, nt * 256, epi, smem);
            else gemm_tile(ALoadLerp{XN, p.b_mu + (4 + nt) * D}, WB + wbo::IN, 1024, mt * 128, 4096 + nt * 128, epi, smem);
        });
    } else if (PH == PH_LORA1) {
        const int ntile = (M / 128) * 16;
        EpiLora epi{p.b_w0, p.b_a0, (bf16*)(ws + wsl::L1_WL), (bf16*)(ws + wsl::L1_AV)};
        (void)ntile;
        gemm_sched(8, 0, [&](bool, int mt, int nt) { gemm_tile2(ALoadF32{(const float*)(ws + (nt < 4 ? wsl::LHW : wsl::LHA))}, WB + wbo::EXTRA, 64, mt * 128, nt * 256, epi, smem); });
    } else if (PH == PH_CPREP1) {
        for (int it = blockIdx.x; it < B * 16 * RW_NCH; it += gridDim.x)
            rwkv_prep_item(P, (bf16*)(ws + wsl::L1_WL), (bf16*)(ws + wsl::L1_AV), p.b_k_k, p.b_k_a, p.b_r_k, (float*)(ws + 9 * fw::MB), (bf16*)(ws + 1 * fw::MB), WB, (float*)(ws + 254 * fw::MB), it, smem);
    } else if (PH == PH_SCAN1) {
        const int bid = blockIdx.x;
        if ((bid & 31) < 8 && (bid >> 5) < 8) {
            const int it = (bid >> 5) * 8 + (bid & 31);
            rwkv_chunk_scan(P, (const bf16*)(ws + wsl::L1_WL), (const bf16*)(ws + wsl::L1_AV), (const float*)(ws + 9 * fw::MB), (const bf16*)(ws + 1 * fw::MB), WB, (bf16*)(ws + wsl::L1_XN), it, smem);
        }
    } else if (PH == PH_GN1) {
        rwkv_gn_rows2(P, (const float*)(ws + 254 * fw::MB), p.b_lnx_w, p.b_lnx_b, (bf16*)(ws + wsl::L1_XN));
    } else if (PH == PH_OUT1) {
        gemm_sched(4, 0, [&](bool, int mt, int nt) { gemm_tile2(ALoadPlain{(const bf16*)(ws + wsl::L1_XN), D}, WB + wbo::OUT, 1024, mt * 128, nt * 256, EpiResid{X, X, XB, parts}, smem); });
    } else if (PH == PH_PREP2) {
        int tb = 0;
        const float* g2 = p.norm_g + 2 * D;
        convert_seg(p.c_w_in, C_COLS, 0, 2560, 1024, WB + wbo::IN, g2, smf, tb);
        convert_seg(p.c_w_in, C_COLS, 2608, 1024, 1024, WB + wbo::IN + (size_t)2560 * 1024, g2, smf, tb);
        convert_seg(p.c_w_in, C_COLS, 2560, 64, 1024, WB + wbo::IN + (size_t)3584 * 1024, g2, smf, tb);
        convert_seg(p.c_w_out, 1024, 0, 1024, 1024, WB + wbo::OUT, nullptr, smf, tb);
        convert_seg(p.c_k_w1, 128, 0, 128, 2048, WB + wbo::EXTRA, nullptr, smf, tb);
        convert_seg(p.c_v_w1, 128, 0, 128, 2048, WB + wbo::EXTRA + (size_t)128 * 2048, nullptr, smf, tb);
        convert_seg(p.c_k_w2, 64, 0, 64, 128, WB + wbo::EXTRA + (size_t)256 * 2048, nullptr, smf, tb);
        convert_seg(p.c_v_w2, 64, 0, 64, 128, WB + wbo::EXTRA + (size_t)256 * 2048 + 64 * 128, nullptr, smf, tb);
        if (blockIdx.x < 16) {
            const int which = blockIdx.x >> 3, i = blockIdx.x & 7; const float* pos = which ? p.c_pos_v : p.c_pos_k; const float* w1 = which ? p.c_v_w1 : p.c_k_w1;
            float* b8 = (float*)(ws + 12 * fw::MB);
            if (TIDX < 128) { float a = 0.f; for (int k = i * 256; k < i * 256 + 256; ++k) a += pos[k] * w1[(size_t)k * 128 + TIDX]; b8[(which * 8 + i) * 128 + TIDX] = a; }
        }
    } else if (PH == PH_IN2) {
        gemm_sched(14, 1, [&](bool big, int mt, int nt) {
            if (big) gemm_tile2(ALoadPlain{XB, D}, WB + wbo::IN, 1024, mt * 128, nt * 256, EpiL2{P, (bf16*)(ws + 114 * fw::MB), (bf16*)(ws + 122 * fw::MB), parts}, smem);
            else gemm_tile(ALoadPlain{XB, D}, WB + wbo::IN, 1024, mt * 128, 3584 + nt * 128, EpiL2{P, (bf16*)(ws + 114 * fw::MB), (bf16*)(ws + 122 * fw::MB), parts}, smem);
        });
    } else if (PH == PH_B2) {
        for (int it = blockIdx.x; it < 64; it += gridDim.x) { const int which = it >> 5, rt = it & 31;
            cmp_tile(P, WB + wbo::EXTRA + (size_t)which * 128 * 2048, (const float*)(ws + 12 * fw::MB) + which * 8 * 128, WB + wbo::EXTRA + (size_t)256 * 2048 + which * 64 * 128, which, rt,
                     (bf16*)(ws + 5 * fw::MB), (bf16*)(ws + 6 * fw::MB), smem); }
        build_bias_lut(p.t5, smem, false);
        const int nwin = B * G * (T / (16 * ANQT_WIN));
        const bool split = gridDim.x == 512 && nwin == 2048;
        const int bid = blockIdx.x, nb = bid - 64, cnt = bid < 64 ? 2 : (nb < 128 ? 5 : 4);
        for (int k = 0;; ++k) {
            int item;
            if (split) { if (k >= cnt) break; item = bid < 64 ? k * 512 + 448 + bid : (k < 4 ? k * 512 + nb : (2 + (nb >> 6)) * 512 + 448 + (nb & 63)); }
            else { const int it = (bid < 64 ? bid + (int)gridDim.x : bid) + k * (int)gridDim.x; if (it >= 64 + nwin) break; item = it - 64; }
            win_item(P, (const bf16*)(ws + 122 * fw::MB), (bf16*)(ws + 130 * fw::MB), item, smem);
        }
    } else if (PH == PH_C2) {
        for (int it = blockIdx.x; it < B * G * (T / 32); it += gridDim.x)
            cmpsel_item(P, (const bf16*)(ws + 5 * fw::MB), (const bf16*)(ws + 6 * fw::MB), (bf16*)(ws + 162 * fw::MB), (unsigned long long*)(ws + 9 * fw::MB), it, smem);
    } else if (PH == PH_D2) {
        build_bias_lut(p.t5, smem, false);
        for (int it = blockIdx.x; it < B * G * (T / (16 * ANQT_SEL)); it += gridDim.x)
            sel_item(P, (const bf16*)(ws + 114 * fw::MB), (const unsigned long long*)(ws + 9 * fw::MB), (const bf16*)(ws + 162 * fw::MB), (const bf16*)(ws + 130 * fw::MB), (bf16*)(ws + 206 * fw::MB), it, smem);
    } else if (PH == PH_OUT2) {
        gemm_sched(4, 0, [&](bool, int mt, int nt) { gemm_tile2(ALoadPlain{(const bf16*)(ws + 206 * fw::MB), D}, WB + wbo::OUT, 1024, mt * 128, nt * 256, EpiResid{X, X, XB, parts}, smem); });
    } else if (PH == PH_PREP3) {
        int tb = 0;
        convert_seg(p.d_w_in, 2560, 0, 2560, 1024, WB + wbo::IN, p.norm_g + 3 * D, smf, tb);
        convert_seg(p.d_w_out, 1024, 0, 1024, 1280, WB + wbo::OUT, nullptr, smf, tb);
        lru_convert_gates(p.d_ga_w, p.d_gx_w, WB + wbo::EXTRA);
        for (int i = blockIdx.x * NTHREADS + TIDX; i < LW; i += gridDim.x * NTHREADS) ((float*)(ws + 12 * fw::MB + 786432))[i] = -8.0f * softplusf_(-p.d_lambda[i]);
    } else if (PH == PH_IN3) {
        gemm_sched(8, 4, [&](bool big, int mt, int nt) {
            if (big) gemm_tile2(ALoadPlain{XB, D}, WB + wbo::IN, 1024, mt * 128, nt * 256, EpiBf16{P, 2560, parts}, smem);
            else gemm_tile(ALoadPlain{XB, D}, WB + wbo::IN, 1024, mt * 128, 2048 + nt * 128, EpiBf16{P, 2560, parts}, smem);
        });
    } else if (PH == PH_GATE3) {
        for (int it = blockIdx.x; it < (M / 128) * 16; it += gridDim.x)
            lru_gate_item(P, p.d_conv_w, p.d_conv_b, WB + wbo::EXTRA, p.d_ga_b, p.d_gx_b, (const float*)(ws + 12 * fw::MB + 786432), (bf16*)(ws + wsl::L3_LA), (bf16*)(ws + wsl::L3_BV), (float2*)(ws + wsl::L3_UC), it, smem);
    } else if (PH == PH_SCANB3) {
        for (int it = blockIdx.x; it < B * (T / 64) * 5; it += gridDim.x)
            lru_scan2_item((const bf16*)(ws + wsl::L3_LA), (const bf16*)(ws + wsl::L3_BV), (const float2*)(ws + wsl::L3_UC), P, (bf16*)(ws + wsl::L3_AO), it);
    } else if (PH == PH_OUT3) {
        gemm_sched(4, 0, [&](bool, int mt, int nt) { gemm_tile2(ALoadPlain{(const bf16*)(ws + wsl::L3_AO), LW}, WB + wbo::OUT, 1280, mt * 128, nt * 256, EpiResid{X, X, nullptr, parts}, smem); });
    } else if (PH == PH_FINAL) {
        rows_final(X, parts, p.final_g);
    }
}

template <int PH> __global__ void __launch_bounds__(NTHREADS, 2) k_phase(Params p) {
    extern __shared__ __attribute__((aligned(16))) char smem[];
    run_phase<PH>(p, smem);
}
#define LDS_BYTES 73728
#define MEGA_LDS_BYTES (73728 + 64)
template <int PH> static void launch_phase(const Params& p, hipStream_t s) {
    static bool attr = false;
    if (!attr) { hipFuncSetAttribute((const void*)k_phase<PH>, hipFuncAttributeMaxDynamicSharedMemorySize, LDS_BYTES); attr = true; }
    hipLaunchKernelGGL(k_phase<PH>, dim3(512), dim3(NTHREADS), LDS_BYTES, s, p);
}


#define XB_TMO      128
#define XB_XCNT(j)  (256  + 64 * (j))
#define XB_XSUB(j)  (1280 + 64 * (j))
#define XB_XGEN(j)  (2304 + 64 * (j))
#define XB_TOP      3328
#define XB_TOPGEN   3392
#define XCD_BAR_WORDS 3456
#define XB_SPIN_CAP (1u << 22)
#define LAS __attribute__((address_space(3)))
DI unsigned xb_ld(unsigned* p)              { return __hip_atomic_load(p, __ATOMIC_RELAXED, __HIP_MEMORY_SCOPE_AGENT); }
DI unsigned xb_add(unsigned* p, unsigned v) { return __hip_atomic_fetch_add(p, v, __ATOMIC_RELAXED, __HIP_MEMORY_SCOPE_AGENT); }
DI unsigned xb_xcc_id() { return (unsigned)__builtin_amdgcn_s_getreg((3 << 11) | 20) & 0xFu; }
#define XB_SPIN(cond, bar) do { unsigned _sp = 0; while (cond) { if (_sp < 64u) __builtin_amdgcn_s_sleep(2); else __builtin_amdgcn_s_sleep(32); \
    if ((++_sp & 255u) == 0u) { if (xb_ld(&(bar)[XB_TMO])) break; if (_sp > XB_SPIN_CAP) { atomicAdd(&(bar)[XB_TMO], 1u); break; } } } } while (0)
struct XcdBarrier { unsigned* bar; unsigned x; volatile LAS unsigned* st; };
DI XcdBarrier xcd_barrier_post(unsigned* bar, volatile LAS unsigned* st) {
    XcdBarrier b; b.bar = bar; b.x = xb_xcc_id(); b.st = st;
    if (threadIdx.x == 0) (void)xb_add(&bar[XB_XCNT(b.x)], 1u);
    return b;
}
DI void xcd_barrier_complete(unsigned* bar, unsigned x, unsigned& nloc, unsigned& nx) {
    const unsigned G = gridDim.x * gridDim.y * gridDim.z;
    unsigned sum, cnt, mine, sp = 0u;
    for (;;) {
        sum = 0u; cnt = 0u; mine = 0u;
#pragma unroll
        for (unsigned j = 0; j < 16; ++j) { const unsigned c = xb_ld(&bar[XB_XCNT(j)]); sum += c; cnt += (c > 0u) ? 1u : 0u; mine = (j == x) ? c : mine; }
        if (sum == G) break;
        __builtin_amdgcn_s_sleep(1);
        if ((++sp & 255u) == 0u) { if (xb_ld(&bar[XB_TMO])) break; if (sp > XB_SPIN_CAP) { atomicAdd(&bar[XB_TMO], 1u); break; } }
    }
    nloc = mine > 0u ? mine : 1u; nx = cnt > 0u ? cnt : 1u;
}
DI void xcd_barrier(const XcdBarrier& b) {
    asm volatile("s_waitcnt vmcnt(0)" ::: "memory");
    __syncthreads();
    if (threadIdx.x == 0) {
        unsigned* bar = b.bar;
        __builtin_amdgcn_s_waitcnt(0);
        unsigned nloc = b.st[0], nx = b.st[1];
        if (nloc == 0u) { xcd_barrier_complete(bar, b.x, nloc, nx); b.st[0] = nloc; b.st[1] = nx; }
        const unsigned old = xb_add(&bar[XB_XSUB(b.x)], 1u);
        const unsigned gen = old / nloc;
        asm volatile("buffer_inv sc1" ::: "memory");
        if (old + 1u == (gen + 1u) * nloc) {
            __builtin_amdgcn_fence(__ATOMIC_RELEASE, "agent");
            asm volatile("s_waitcnt vmcnt(0)" ::: "memory");
            const unsigned og = xb_add(&bar[XB_TOP], 1u);
            const unsigned tg = og / nx;
            if (og + 1u == (tg + 1u) * nx) xb_add(&bar[XB_TOPGEN], 1u);
            else XB_SPIN(xb_ld(&bar[XB_TOPGEN]) == tg, bar);
            xb_add(&bar[XB_XGEN(b.x)], 1u);
            asm volatile("s_waitcnt vmcnt(0)" ::: "memory");
        } else {
            XB_SPIN(xb_ld(&bar[XB_XGEN(b.x)]) == gen, bar);
            asm volatile("s_waitcnt vmcnt(0)" ::: "memory");
        }
    }
    __syncthreads();
}

#define MEGA_PHASES(X) X(PH_IN0) X(PH_ATTN0) X(PH_OUT0) X(PH_PREP1) X(PH_IN1) X(PH_LORA1) X(PH_CPREP1) X(PH_SCAN1) X(PH_GN1) X(PH_OUT1) \
    X(PH_PREP2) X(PH_IN2) X(PH_B2) X(PH_C2) X(PH_D2) X(PH_OUT2) X(PH_PREP3) X(PH_IN3) X(PH_GATE3) X(PH_SCANB3) X(PH_OUT3)
__global__ void __launch_bounds__(NTHREADS, 2) mega_kernel(Params p) {
    extern __shared__ __attribute__((aligned(16))) char smem[];
    cooperative_groups::grid_group grid = cooperative_groups::this_grid();
    volatile LAS unsigned* xst = (volatile LAS unsigned*)(smem + 73728);
    if (threadIdx.x < 4) xst[threadIdx.x] = 0u;
    __syncthreads();
    XcdBarrier xb = xcd_barrier_post((unsigned*)p.ws, xst);
    run_phase<PH_PREP0>(p, smem);
    if (p.ws == nullptr) grid.sync();
    xcd_barrier(xb);
#define MEGA_STEP(ph) run_phase<ph>(p, smem); xcd_barrier(xb);
    MEGA_PHASES(MEGA_STEP)
#undef MEGA_STEP
    run_phase<PH_FINAL>(p, smem);
}
static void launch_mega(const Params& p, hipStream_t s) {
    static int grid_blocks = 0;
    if (!grid_blocks) {
        int dev = 0, cus = 0, per_cu = 0;
        hipGetDevice(&dev);
        hipDeviceGetAttribute(&cus, hipDeviceAttributeMultiprocessorCount, dev);
        hipFuncSetAttribute((const void*)mega_kernel, hipFuncAttributeMaxDynamicSharedMemorySize, MEGA_LDS_BYTES);
        hipOccupancyMaxActiveBlocksPerMultiprocessor(&per_cu, mega_kernel, NTHREADS, MEGA_LDS_BYTES);
        if (per_cu > 2) per_cu = 2;
        if (per_cu < 1) per_cu = 1;
        grid_blocks = cus * per_cu;
    }
    hipMemsetAsync(p.ws, 0, 16384, s);
    Params pp = p; void* args[] = {&pp};
    hipError_t e = hipLaunchCooperativeKernel((const void*)mega_kernel, dim3(grid_blocks), dim3(NTHREADS), args, MEGA_LDS_BYTES, s);
    if (e != hipSuccess) fprintf(stderr, "cooperative launch failed: %s (grid %d)\n", hipGetErrorString(e), grid_blocks);
}
#endif

#ifndef CPU_SHIM
template <class F> __global__ void __launch_bounds__(256) k_run(F f, long n) {
    const long i = (long)blockIdx.x * 256 + threadIdx.x; if (i < n) f(i);
}
template <class F> static void launch(const F& f, long n, hipStream_t s) {
    hipLaunchKernelGGL(k_run<F>, dim3((unsigned)((n + 255) / 256)), dim3(256), 0, s, f, n);
}
#else
template <class F> static void launch(const F& f, long n, hipStream_t) {
#pragma omp parallel for schedule(dynamic, 64)
    for (long i = 0; i < n; ++i) f(i);
}
#endif

#ifdef CPU_SHIM
void cpu_layer_hook(int layer, const float* X, const char* ws);
#define LAYER_HOOK(l) cpu_layer_hook(l, X, ws)
#else
#define LAYER_HOOK(l)
#endif

#define FAST_GEMM 0
#if FAST_GEMM
#define FASTP(ph) launch_phase<ph>(p, s)
#else
#define FASTP(ph)
#endif

static void run_naive(const Params& p, hipStream_t s) {
    char* ws = p.ws;
    float* rs = (float*)(ws + wsl::RS);
    bf16* P = (bf16*)(ws + wsl::P);
    float* X = p.out;
    (void)rs;
    {
        bf16* AO = (bf16*)(ws + wsl::L0_AO);
#if FAST_GEMM
        FASTP(PH_PREP0); FASTP(PH_IN0);
#else
        launch(RstdF{p.x, rs}, M, s);
        launch(GemmInF{p.x, rs, p.norm_g + 0 * D, p.a_w_in, P, A_COLS}, (long)M * (A_COLS / 4), s);
#endif
#if FAST_GEMM
        FASTP(PH_ATTN0); (void)AO;
#else
        launch(SwaF{P, p.t5, p.a_sinks, AO}, (long)M * H, s);
#endif
#if FAST_GEMM
        FASTP(PH_OUT0);
#else
        launch(GemmOutF{AO, p.a_w_out, p.x, X, 1024}, (long)M * (D / 4), s);
#endif
    }
    LAYER_HOOK(0);
    {
        bf16* XN = (bf16*)(ws + wsl::L1_XN); bf16* WL = (bf16*)(ws + wsl::L1_WL); bf16* AV = (bf16*)(ws + wsl::L1_AV);
        float* hw = (float*)(ws + wsl::LHW); float* ha = (float*)(ws + wsl::LHA);
#if FAST_GEMM
        FASTP(PH_PREP1); FASTP(PH_IN1); FASTP(PH_LORA1); FASTP(PH_CPREP1); FASTP(PH_SCAN1); FASTP(PH_GN1); FASTP(PH_OUT1);
        (void)XN; (void)WL; (void)AV; (void)hw; (void)ha;
#else
        launch(RstdF{X, rs}, M, s);
        launch(XnF{X, rs, p.norm_g + 1 * D, XN}, (long)M * D, s);
        launch(GemmRwkvF{XN, p.b_mu, p.b_w_in, P}, (long)M * 1024, s);
        launch(LoraHidF{XN, p.b_mu, p.b_w1, p.b_a1, hw, ha}, (long)M * 128, s);
        launch(LoraOutF{hw, ha, p.b_w0, p.b_w2, p.b_a0, p.b_a2, WL, AV}, (long)M * D, s);
        launch(RwkvScanF{P, WL, AV, p.b_k_k, p.b_k_a, XN}, (long)B * H * 64, s);
        launch(RwkvGnF{P, AV, p.b_k_a, p.b_r_k, p.b_lnx_w, p.b_lnx_b, XN}, (long)M * H, s);
        launch(GemmOutF{XN, p.b_w_out, X, X, 1024}, (long)M * (D / 4), s);
#endif
    }
    LAYER_HOOK(1);
    {
        float* hk = (float*)(ws + wsl::HK); float* hv = (float*)(ws + wsl::HV);
        float* kc = (float*)(ws + wsl::KC); float* vc = (float*)(ws + wsl::VC);
        float* st = (float*)(ws + wsl::ST); int* sel = (int*)(ws + wsl::SEL); float* imp = (float*)(ws + wsl::L2_IMP);
        bf16* AO = (bf16*)(ws + wsl::L2_AO); bf16* OC = (bf16*)(ws + wsl::L2_OC); bf16* OS = (bf16*)(ws + wsl::L2_OS);
#if FAST_GEMM
        FASTP(PH_PREP2); FASTP(PH_IN2); FASTP(PH_B2); FASTP(PH_C2); FASTP(PH_D2); FASTP(PH_OUT2);
        (void)hk; (void)hv; (void)kc; (void)vc; (void)st; (void)sel; (void)imp; (void)AO; (void)OC; (void)OS;
#else
        launch(RstdF{X, rs}, M, s);
        launch(GemmInF{X, rs, p.norm_g + 2 * D, p.c_w_in, P, C_COLS}, (long)M * (C_COLS / 4), s);
        launch(CmpHidF{P, p.c_pos_k, p.c_k_w1, p.c_pos_v, p.c_v_w1, hk, hv}, 2L * B * G * NCMP * 128, s);
        launch(CmpOutF{hk, hv, p.c_k_w2, p.c_v_w2, kc, vc}, 2L * B * G * NCMP * 64, s);
        launch(CmpAttnF{P, kc, vc, st, OC}, (long)M * H, s);
        launch(ImpF{P, kc, st, imp}, (long)M * G * NSEL, s);
        launch(TopkF{imp, sel}, (long)M * G, s);
        launch(SelAttnF{P, p.t5, sel, OS}, (long)M * H, s);
        launch(WinAttnF{P, p.t5, OC, OS, AO}, (long)M * H, s);
        LAYER_HOOK(20);
        launch(GemmOutF{AO, p.c_w_out, X, X, 1024}, (long)M * (D / 4), s);
#endif
    }
    LAYER_HOOK(2);
    {
        bf16* AO = (bf16*)(ws + wsl::L3_AO); bf16* UC = (bf16*)(ws + wsl::L3_UC); bf16* LA = (bf16*)(ws + wsl::L3_LA); bf16* BV = (bf16*)(ws + wsl::L3_BV);
#if FAST_GEMM
        FASTP(PH_PREP3); FASTP(PH_IN3); FASTP(PH_GATE3); FASTP(PH_SCANA3); FASTP(PH_SCANB3); FASTP(PH_OUT3);
        (void)AO; (void)UC; (void)LA; (void)BV;
#else
        launch(RstdF{X, rs}, M, s);
        launch(GemmInF{X, rs, p.norm_g + 3 * D, p.d_w_in, P, 2560}, (long)M * (2560 / 4), s);
        launch(ConvF{P, p.d_conv_w, p.d_conv_b, UC}, (long)M * LW, s);
        launch(LruGateF{UC, p.d_ga_w, p.d_ga_b, p.d_gx_w, p.d_gx_b, p.d_lambda, LA, BV}, (long)M * LW, s);
        launch(LruScanF{P, LA, BV, AO}, (long)B * LW, s);
        launch(GemmOutF{AO, p.d_w_out, X, X, LW}, (long)M * (D / 4), s);
#endif
    }
    LAYER_HOOK(3);
#if FAST_GEMM
    FASTP(PH_FINAL);
#else
    launch(FinalNormF{X, p.final_g}, M, s);
#endif
}

extern "C" void kernel_launch(void* const* d_in, const int* in_sizes, int n_in, void* d_out, int out_size, void* d_ws, size_t ws_size,
                              hipStream_t stream) {
    (void)in_sizes; (void)n_in; (void)out_size; (void)ws_size;
    Params p{};
    const float* const* in = (const float* const*)d_in;
    int k = 0;
    p.x = in[k++]; p.t5 = in[k++]; p.norm_g = in[k++]; p.final_g = in[k++];
    p.a_w_in = in[k++]; p.a_sinks = in[k++]; p.a_w_out = in[k++];
    p.b_mu = in[k++]; p.b_w_in = in[k++]; p.b_w0 = in[k++]; p.b_w1 = in[k++]; p.b_w2 = in[k++]; p.b_a0 = in[k++]; p.b_a1 = in[k++]; p.b_a2 = in[k++];
    p.b_k_k = in[k++]; p.b_k_a = in[k++]; p.b_r_k = in[k++]; p.b_lnx_w = in[k++]; p.b_lnx_b = in[k++]; p.b_w_out = in[k++];
    p.c_w_in = in[k++]; p.c_pos_k = in[k++]; p.c_k_w1 = in[k++]; p.c_k_w2 = in[k++]; p.c_pos_v = in[k++]; p.c_v_w1 = in[k++]; p.c_v_w2 = in[k++]; p.c_w_out = in[k++];
    p.d_w_in = in[k++]; p.d_conv_w = in[k++]; p.d_conv_b = in[k++]; p.d_ga_w = in[k++]; p.d_ga_b = in[k++]; p.d_gx_w = in[k++]; p.d_gx_b = in[k++];
    p.d_lambda = in[k++]; p.d_w_out = in[k++];
    p.out = (float*)d_out; p.ws = (char*)d_ws;
#if !defined(CPU_SHIM) && !defined(MULTI_LAUNCH) && !defined(ALL_NAIVE)
    launch_mega(p, stream);
#else
    run_naive(p, stream);
#endif
}
```

```cpp
#ifndef CPU_SHIM
#include <hip/hip_runtime.h>
#include <hip/hip_cooperative_groups.h>
#include <cstdio>
#define HD __host__ __device__ __forceinline__
#else
#include <cmath>
#include <cstring>
#include <cstdio>
#include <cstdlib>
#include <cstdint>
#define HD inline
typedef void* hipStream_t;
#endif
#include <cstddef>

#ifndef CFG_B
#define CFG_B 4
#endif
#ifndef CFG_T
#define CFG_T 4096
#endif

namespace cfg {
constexpr int B = CFG_B, T = CFG_T, M = B * T, D = 1024;
constexpr int H = 16, G = 4, R = 4, DH = 64;
constexpr int A_COLS = 2560;
constexpr int C_COLS = 3632;
constexpr int NCMP = (T - 32) / 16 + 1;
constexpr int NSEL = T / 64;
constexpr int KTOP = NSEL < 16 ? NSEL : 16;
constexpr int LW = 1280;
}
using namespace cfg;

typedef unsigned short bf16;

HD unsigned f_as_u(float f) {
#ifndef CPU_SHIM
    return __float_as_uint(f);
#else
    unsigned u; memcpy(&u, &f, 4); return u;
#endif
}
HD float u_as_f(unsigned u) {
#ifndef CPU_SHIM
    return __uint_as_float(u);
#else
    float f; memcpy(&f, &u, 4); return f;
#endif
}
HD float bf2f(bf16 v) { return u_as_f(((unsigned)v) << 16); }
HD bf16 f2bf(float f) { unsigned u = f_as_u(f); u += 0x7fffu + ((u >> 16) & 1u); return (bf16)(u >> 16); }
HD float sigmoidf_(float x) { return 1.0f / (1.0f + expf(-x)); }
HD float siluf_(float x) { return x / (1.0f + expf(-x)); }
HD float softplusf_(float x) { return x > 20.f ? x : log1pf(expf(x)); }

HD int t5_bucket(int d) {
    if (d < 16) return d < 0 ? 0 : d;
    if (d >= 113) return 31;
    if (d >= 99) return 30;
    if (d >= 87) return 29;
    if (d >= 77) return 28;
    if (d >= 67) return 27;
    if (d >= 59) return 26;
    if (d >= 52) return 25;
    if (d >= 46) return 24;
    if (d >= 40) return 23;
    if (d >= 35) return 22;
    if (d >= 31) return 21;
    if (d >= 27) return 20;
    if (d >= 24) return 19;
    if (d >= 21) return 18;
    if (d >= 19) return 17;
    return 16;
}

struct Params {
    const float *x, *t5, *norm_g, *final_g;
    const float *a_w_in, *a_sinks, *a_w_out;
    const float *b_mu, *b_w_in, *b_w0, *b_w1, *b_w2, *b_a0, *b_a1, *b_a2, *b_k_k, *b_k_a, *b_r_k, *b_lnx_w, *b_lnx_b, *b_w_out;
    const float *c_w_in, *c_pos_k, *c_k_w1, *c_k_w2, *c_pos_v, *c_v_w1, *c_v_w2, *c_w_out;
    const float *d_w_in, *d_conv_w, *d_conv_b, *d_ga_w, *d_ga_b, *d_gx_w, *d_gx_b, *d_lambda, *d_w_out;
    float* out;
    char* ws;
};

namespace wsl {
constexpr size_t MB = 1024 * 1024;
constexpr size_t RS = 0;
constexpr size_t HK = 1 * MB;
constexpr size_t HV = 3 * MB;
constexpr size_t KC = 5 * MB;
constexpr size_t VC = 6 * MB;
constexpr size_t ST = 7 * MB;
constexpr size_t SEL = 9 * MB;
constexpr size_t LHW = 1 * MB;
constexpr size_t LHA = 5 * MB;
constexpr size_t P = 14 * MB;
constexpr size_t SZ1024 = (size_t)M * 1024 * 2, SZ1280 = (size_t)M * 1280 * 2;
constexpr size_t L0_AO = P + (size_t)M * 2560 * 2;
constexpr size_t L1_XN = P + (size_t)M * 4096 * 2, L1_WL = L1_XN + SZ1024, L1_AV = L1_WL + SZ1024;
constexpr size_t L2_AO = P + (size_t)M * 3632 * 2, L2_OC = L2_AO + SZ1024, L2_OS = L2_OC + SZ1024, L2_IMP = L2_OS + SZ1024;
constexpr size_t L3_AO = P + (size_t)M * 2560 * 2, L3_UC = L3_AO + SZ1280, L3_LA = L3_UC + SZ1280, L3_BV = L3_LA + SZ1280;
constexpr size_t TOTAL = L3_BV + SZ1280;
}

struct RstdF {
    const float* x; float* rs;
    HD void operator()(long m) const {
        const float* r = x + (size_t)m * D; float s = 0.f;
        for (int k = 0; k < D; ++k) s += r[k] * r[k];
        rs[m] = 1.0f / sqrtf(s / D + 1e-6f);
    }
};
struct XnF {
    const float* x; const float* rs; const float* g; bf16* xn;
    HD void operator()(long i) const { long m = i / D; int k = (int)(i % D); xn[i] = f2bf(x[i] * rs[m] * g[k]); }
};
struct GemmInF {
    const float *x, *rs, *g, *W; bf16* P; long long N;
    HD void operator()(long i) const {
        const int n4 = (int)N / 4; const long m = i / n4; const int n = (int)(i % n4) * 4;
        const float* xr = x + (size_t)m * D; const float r = rs[m];
        float a0 = 0, a1 = 0, a2 = 0, a3 = 0;
        for (int k = 0; k < D; ++k) {
            const float a = xr[k] * r * g[k]; const float* w = W + (size_t)k * N + n;
            a0 += a * w[0]; a1 += a * w[1]; a2 += a * w[2]; a3 += a * w[3];
        }
        bf16* p = P + (size_t)m * N + n; p[0] = f2bf(a0); p[1] = f2bf(a1); p[2] = f2bf(a2); p[3] = f2bf(a3);
    }
};
struct GemmOutF {
    const bf16* A; const float* W; const float* xin; float* xout; long long K;
    HD void operator()(long i) const {
        const int n4 = D / 4; const long m = i / n4; const int n = (int)(i % n4) * 4;
        const bf16* ar = A + (size_t)m * K;
        float a0 = 0, a1 = 0, a2 = 0, a3 = 0;
        for (int k = 0; k < K; ++k) {
            const float a = bf2f(ar[k]); const float* w = W + (size_t)k * D + n;
            a0 += a * w[0]; a1 += a * w[1]; a2 += a * w[2]; a3 += a * w[3];
        }
        const float* xi = xin + (size_t)m * D + n; float* xo = xout + (size_t)m * D + n;
        xo[0] = xi[0] + a0; xo[1] = xi[1] + a1; xo[2] = xi[2] + a2; xo[3] = xi[3] + a3;
    }
};

struct SwaF {
    const bf16* P; const float* t5; const float* sinks; bf16* AO;
    HD void operator()(long i) const {
        const long m = i / H; const int h = (int)(i % H), g = h / R; const int t = (int)(m % T); const long mb = m - t;
        float q[DH], o[DH];
#pragma unroll
        for (int d = 0; d < DH; ++d) { q[d] = bf2f(P[(size_t)m * A_COLS + h * DH + d]); o[d] = 0.f; }
        float mx = sinks[h], l = 1.0f;
        const int s0 = t - 127 < 0 ? 0 : t - 127;
        for (int s = s0; s <= t; ++s) {
            const bf16* kr = P + (size_t)(mb + s) * A_COLS + 1024 + g * DH;
            const bf16* vr = kr + 256;
            float sc = 0.f;
#pragma unroll
            for (int d = 0; d < DH; ++d) sc += q[d] * bf2f(kr[d]);
            sc = sc * 0.125f + t5[t5_bucket(t - s) * H + h];
            const float mn = sc > mx ? sc : mx; const float al = expf(mx - mn), p = expf(sc - mn);
            l = l * al + p; mx = mn;
#pragma unroll
            for (int d = 0; d < DH; ++d) o[d] = o[d] * al + p * bf2f(vr[d]);
        }
        const float il = 1.0f / l;
#pragma unroll
        for (int d = 0; d < DH; ++d) {
            const float z = bf2f(P[(size_t)m * A_COLS + 1536 + h * DH + d]);
            AO[(size_t)m * D + h * DH + d] = f2bf(o[d] * il * siluf_(z));
        }
    }
};

struct GemmRwkvF {
    const bf16* xn; const float* mu; const float* W; bf16* P;
    HD void operator()(long i) const {
        const int N = 4096, n4 = N / 4; const long m = i / n4; const int n = (int)(i % n4) * 4; const int s = n / 1024;
        const int t = (int)(m % T);
        const bf16* xr = xn + (size_t)m * D; const float* mus = mu + s * D;
        float a0 = 0, a1 = 0, a2 = 0, a3 = 0;
        for (int k = 0; k < D; ++k) {
            const float xc = bf2f(xr[k]); const float xp = t > 0 ? bf2f(xr[k - D]) : 0.f;
            const float a = xc + (xp - xc) * mus[k]; const float* w = W + (size_t)k * N + n;
            a0 += a * w[0]; a1 += a * w[1]; a2 += a * w[2]; a3 += a * w[3];
        }
        bf16* p = P + (size_t)m * N + n; p[0] = f2bf(a0); p[1] = f2bf(a1); p[2] = f2bf(a2); p[3] = f2bf(a3);
    }
};
struct LoraHidF {
    const bf16* xn; const float* mu; const float* w1; const float* a1; float* hw; float* ha;
    HD void operator()(long i) const {
        const long m = i / 128; const int jj = (int)(i % 128); const int which = jj / 64, j = jj % 64; const int t = (int)(m % T);
        const bf16* xr = xn + (size_t)m * D; const float* mus = mu + (4 + which) * D; const float* W = which ? a1 : w1;
        float acc = 0.f;
        for (int k = 0; k < D; ++k) {
            const float xc = bf2f(xr[k]); const float xp = t > 0 ? bf2f(xr[k - D]) : 0.f;
            acc += (xc + (xp - xc) * mus[k]) * W[(size_t)k * 64 + j];
        }
        if (which) ha[(size_t)m * 64 + j] = acc; else hw[(size_t)m * 64 + j] = tanhf(acc);
    }
};
struct LoraOutF {
    const float *hw, *ha, *w0, *w2, *a0, *a2; bf16* wlog; bf16* av;
    HD void operator()(long i) const {
        const long m = i / D; const int c = (int)(i % D);
        float sw = 0.f, sa = 0.f;
        for (int j = 0; j < 64; ++j) { sw += hw[(size_t)m * 64 + j] * w2[(size_t)j * D + c]; sa += ha[(size_t)m * 64 + j] * a2[(size_t)j * D + c]; }
        const float wr = -softplusf_(-(w0[c] + sw)) - 0.5f;
        wlog[i] = f2bf(-expf(wr)); av[i] = f2bf(sigmoidf_(a0[c] + sa));
    }
};
struct RwkvScanF {
    const bf16* P; const bf16* wlog; const bf16* av; const float* k_k; const float* k_a; bf16* ys;
    HD void operator()(long idx) const {
        const int i = (int)(idx % 64); const int h = (int)((idx / 64) % H); const int b = (int)(idx / (64 * H));
        float S[64];
#pragma unroll
        for (int j = 0; j < 64; ++j) S[j] = 0.f;
        for (int t = 0; t < T; ++t) {
            const size_t m = (size_t)b * T + t; const bf16* pr = P + m * 4096 + h * 64;
            const bf16* wl = wlog + m * D + h * 64; const bf16* ar = av + m * D + h * 64;
            float n2 = 0.f;
#pragma unroll
            for (int j = 0; j < 64; ++j) { const float kk = bf2f(pr[1024 + j]) * k_k[h * 64 + j]; n2 += kk * kk; }
            float nr = sqrtf(n2); nr = nr > 1e-12f ? nr : 1e-12f; const float inr = 1.0f / nr;
            float sa = 0.f;
#pragma unroll
            for (int j = 0; j < 64; ++j) { const float kk = bf2f(pr[1024 + j]) * k_k[h * 64 + j] * inr; sa += S[j] * (-kk); }
            const float vi = bf2f(pr[2048 + i]); float y = 0.f;
#pragma unroll
            for (int j = 0; j < 64; ++j) {
                const float kr = bf2f(pr[1024 + j]); const float a = bf2f(ar[j]);
                const float kk = kr * k_k[h * 64 + j] * inr; const float kp = kr * (1.0f + (a - 1.0f) * k_a[h * 64 + j]);
                const float dec = expf(bf2f(wl[j]));
                S[j] = S[j] * dec + sa * (kk * a) + vi * kp;
                y += S[j] * bf2f(pr[j]);
            }
            ys[m * D + h * 64 + i] = f2bf(y);
        }
    }
};
struct RwkvGnF {
    const bf16* P; const bf16* av; const float *k_a, *r_k, *lnx_w, *lnx_b; bf16* ys;
    HD void operator()(long idx) const {
        const long m = idx / H; const int h = (int)(idx % H);
        bf16* yr = ys + (size_t)m * D + h * 64; const bf16* pr = P + (size_t)m * 4096 + h * 64; const bf16* ar = av + (size_t)m * D + h * 64;
        float mean = 0.f;
        for (int j = 0; j < 64; ++j) mean += bf2f(yr[j]);
        mean /= 64.f; float var = 0.f;
        for (int j = 0; j < 64; ++j) { const float d = bf2f(yr[j]) - mean; var += d * d; }
        var /= 64.f; const float rstd = 1.0f / sqrtf(var + 64e-5f);
        float bs = 0.f;
        for (int j = 0; j < 64; ++j) { const float kr = bf2f(pr[1024 + j]); const float kp = kr * (1.0f + (bf2f(ar[j]) - 1.0f) * k_a[h * 64 + j]); bs += bf2f(pr[j]) * kp * r_k[h * 64 + j]; }
        for (int j = 0; j < 64; ++j) {
            const float yn = (bf2f(yr[j]) - mean) * rstd * lnx_w[h * 64 + j] + lnx_b[h * 64 + j];
            const float z = bf2f(pr[3072 + j]);
            yr[j] = f2bf((yn + bs * bf2f(pr[2048 + j])) * siluf_(z));
        }
    }
};

struct CmpHidF {
    const bf16* P; const float *pos_k, *w1_k, *pos_v, *w1_v; float* hk; float* hv;
    HD void operator()(long idx) const {
        const int j = (int)(idx % 128); long r = idx / 128; const int n = (int)(r % NCMP); r /= NCMP; const int g = (int)(r % G); r /= G;
        const int b = (int)(r % B); const int which = (int)(r / B);
        const float* pos = which ? pos_v : pos_k; const float* w1 = which ? w1_v : w1_k; const int col = 1024 + (which ? 256 : 0) + g * 64;
        float acc = 0.f;
        for (int l = 0; l < 32; ++l) {
            const bf16* src = P + (size_t)(b * T + 16 * n + l) * C_COLS + col;
            for (int d = 0; d < 64; ++d) acc += (bf2f(src[d]) + pos[l * 64 + d]) * w1[(size_t)(l * 64 + d) * 128 + j];
        }
        (which ? hv : hk)[(((size_t)b * G + g) * NCMP + n) * 128 + j] = siluf_(acc);
    }
};
struct CmpOutF {
    const float *hk, *hv, *w2_k, *w2_v; float* kc; float* vc;
    HD void operator()(long idx) const {
        const int d = (int)(idx % 64); long r = idx / 64; const long row = r % ((long)B * G * NCMP); const int which = (int)(r / ((long)B * G * NCMP));
        const float* hsrc = (which ? hv : hk) + (size_t)row * 128; const float* w2 = which ? w2_v : w2_k;
        float acc = 0.f;
        for (int j = 0; j < 128; ++j) acc += hsrc[j] * w2[j * 64 + d];
        (which ? vc : kc)[(size_t)row * 64 + d] = acc;
    }
};
struct CmpAttnF {
    const bf16* P; const float *kc, *vc; float* st; bf16* oc;
    HD void operator()(long i) const {
        const long m = i / H; const int h = (int)(i % H), g = h / R; const int t = (int)(m % T); const int b = (int)(m / T);
        float q[DH], o[DH];
#pragma unroll
        for (int d = 0; d < DH; ++d) { q[d] = bf2f(P[(size_t)m * C_COLS + h * DH + d]); o[d] = 0.f; }
        const int nv = t < 31 ? 0 : (t - 31) / 16 + 1;
        float mx = -1e30f, l = 0.f;
        for (int n = 0; n < nv; ++n) {
            const float* kr = kc + (((size_t)b * G + g) * NCMP + n) * 64; const float* vr = vc + (((size_t)b * G + g) * NCMP + n) * 64;
            float sc = 0.f;
#pragma unroll
            for (int d = 0; d < DH; ++d) sc += q[d] * kr[d];
            sc *= 0.125f;
            const float mn = sc > mx ? sc : mx; const float al = expf(mx - mn), p = expf(sc - mn);
            l = l * al + p; mx = mn;
#pragma unroll
            for (int d = 0; d < DH; ++d) o[d] = o[d] * al + p * vr[d];
        }
        const float il = nv > 0 ? 1.0f / l : 0.f;
        st[(size_t)i * 2] = mx; st[(size_t)i * 2 + 1] = il;
#pragma unroll
        for (int d = 0; d < DH; ++d) oc[(size_t)m * D + h * DH + d] = f2bf(o[d] * il);
    }
};
struct ImpF {
    const bf16* P; const float *kc, *st; float* imp;
    HD void operator()(long idx) const {
        const int s = (int)(idx % NSEL); long r = idx / NSEL; const int g = (int)(r % G); const long m = r / G;
        const int t = (int)(m % T); const int b = (int)(m / T); const int cur = t / 64;
        float v;
        if (s == 0 || s == cur || s == cur - 1) v = 1e30f;
        else if (s * 64 > t) v = -1e30f;
        else {
            v = 0.f; const int nv = t < 31 ? 0 : (t - 31) / 16 + 1;
            int n0 = 4 * s - 1; if (n0 < 0) n0 = 0; int n1 = 4 * s + 3; if (n1 > NCMP - 1) n1 = NCMP - 1; if (n1 > nv - 1) n1 = nv - 1;
            for (int rr = 0; rr < R; ++rr) {
                const int h = g * R + rr; const bf16* qr = P + (size_t)m * C_COLS + h * DH;
                const float mx = st[((size_t)m * H + h) * 2], il = st[((size_t)m * H + h) * 2 + 1];
                for (int n = n0; n <= n1; ++n) {
                    const float* kr = kc + (((size_t)b * G + g) * NCMP + n) * 64; float sc = 0.f;
                    for (int d = 0; d < DH; ++d) sc += bf2f(qr[d]) * kr[d];
                    v += expf(sc * 0.125f - mx) * il;
                }
            }
        }
        imp[idx] = v;
    }
};
struct TopkF {
    const float* imp; int* sel;
    HD void operator()(long idx) const {
        const float* v = imp + (size_t)idx * NSEL; unsigned long long used = 0ull;
        for (int j = 0; j < KTOP; ++j) {
            int best = -1; float bv = 0.f;
            for (int s = 0; s < NSEL; ++s) { if ((used >> s) & 1ull) continue; const float x = v[s]; if (best < 0 || x > bv) { best = s; bv = x; } }
            used |= 1ull << best; sel[(size_t)idx * 16 + j] = best;
        }
    }
};
struct SelAttnF {
    const bf16* P; const float* t5; const int* sel; bf16* os;
    HD void operator()(long i) const {
        const long m = i / H; const int h = (int)(i % H), g = h / R; const int t = (int)(m % T); const long mb = m - t;
        float q[DH], o[DH];
#pragma unroll
        for (int d = 0; d < DH; ++d) { q[d] = bf2f(P[(size_t)m * C_COLS + h * DH + d]); o[d] = 0.f; }
        float mx = -1e30f, l = 0.f;
        for (int j = 0; j < KTOP; ++j) {
            const int blk = sel[((size_t)m * G + g) * 16 + j];
            for (int ll = 0; ll < 64; ++ll) {
                const int s = blk * 64 + ll; if (s > t) break;
                const bf16* kr = P + (size_t)(mb + s) * C_COLS + 1536 + g * DH; const bf16* vr = kr + 256;
                float sc = 0.f;
#pragma unroll
                for (int d = 0; d < DH; ++d) sc += q[d] * bf2f(kr[d]);
                sc = sc * 0.125f + t5[t5_bucket(t - s) * H + h];
                const float mn = sc > mx ? sc : mx; const float al = expf(mx - mn), p = expf(sc - mn);
                l = l * al + p; mx = mn;
#pragma unroll
                for (int d = 0; d < DH; ++d) o[d] = o[d] * al + p * bf2f(vr[d]);
            }
        }
        const float il = 1.0f / l;
#pragma unroll
        for (int d = 0; d < DH; ++d) os[(size_t)m * D + h * DH + d] = f2bf(o[d] * il);
    }
};
struct WinAttnF {
    const bf16* P; const float* t5; const bf16* oc; const bf16* os; bf16* AO;
    HD void operator()(long i) const {
        const long m = i / H; const int h = (int)(i % H), g = h / R, rr = h % R; const int t = (int)(m % T); const long mb = m - t;
        float q[DH], o[DH];
#pragma unroll
        for (int d = 0; d < DH; ++d) { q[d] = bf2f(P[(size_t)m * C_COLS + h * DH + d]); o[d] = 0.f; }
        float mx = -1e30f, l = 0.f;
        const int s0 = t - 511 < 0 ? 0 : t - 511;
        for (int s = s0; s <= t; ++s) {
            const bf16* kr = P + (size_t)(mb + s) * C_COLS + 2048 + g * DH; const bf16* vr = kr + 256;
            float sc = 0.f;
#pragma unroll
            for (int d = 0; d < DH; ++d) sc += q[d] * bf2f(kr[d]);
            sc = sc * 0.125f + t5[t5_bucket(t - s) * H + h];
            const float mn = sc > mx ? sc : mx; const float al = expf(mx - mn), p = expf(sc - mn);
            l = l * al + p; mx = mn;
#pragma unroll
            for (int d = 0; d < DH; ++d) o[d] = o[d] * al + p * bf2f(vr[d]);
        }
        const float il = 1.0f / l;
        const bf16* gr = P + (size_t)m * C_COLS + 2560;
        const float g0 = sigmoidf_(bf2f(gr[0 * 16 + g * R + rr])), g1 = sigmoidf_(bf2f(gr[1 * 16 + g * R + rr])), g2 = sigmoidf_(bf2f(gr[2 * 16 + g * R + rr]));
#pragma unroll
        for (int d = 0; d < DH; ++d) {
            const size_t oi = (size_t)m * D + h * DH + d;
            const float z = bf2f(P[(size_t)m * C_COLS + 2608 + h * DH + d]);
            AO[oi] = f2bf((g0 * bf2f(oc[oi]) + g1 * bf2f(os[oi]) + g2 * o[d] * il) * siluf_(z));
        }
    }
};

struct ConvF {
    const bf16* P; const float *cw, *cb; bf16* uc;
    HD void operator()(long i) const {
        const long m = i / LW; const int c = (int)(i % LW); const int t = (int)(m % T);
        float acc = cb[c];
        for (int w = 0; w < 4; ++w) { const int tt = t - 3 + w; if (tt >= 0) acc += cw[w * LW + c] * bf2f(P[(size_t)(m - 3 + w) * 2560 + c]); }
        uc[i] = f2bf(acc);
    }
};
struct LruGateF {
    const bf16* uc; const float *gaw, *gab, *gxw, *gxb, *lam; bf16* la; bf16* bv;
    HD void operator()(long i) const {
        const long m = i / LW; const int c = (int)(i % LW); const int n = c / 80, d = c % 80;
        const bf16* ub = uc + (size_t)m * LW + n * 80; float ra = gab[c], rx = gxb[c];
        for (int k = 0; k < 80; ++k) { const float u = bf2f(ub[k]); ra += u * gaw[((size_t)n * 80 + k) * 80 + d]; rx += u * gxw[((size_t)n * 80 + k) * 80 + d]; }
        const float r = sigmoidf_(ra), ig = sigmoidf_(rx);
        const float loga = -8.0f * r * softplusf_(-lam[c]);
        la[i] = f2bf(loga);
        bv[i] = f2bf(sqrtf(-expm1f(2.0f * loga)) * (ig * bf2f(uc[i])));
    }
};
struct LruScanF {
    const bf16* P; const bf16* la; const bf16* bv; bf16* AO;
    HD void operator()(long idx) const {
        const int c = (int)(idx % LW); const int b = (int)(idx / LW); float h = 0.f;
        for (int t = 0; t < T; ++t) {
            const size_t m = (size_t)b * T + t;
            h = expf(bf2f(la[m * LW + c])) * h + bf2f(bv[m * LW + c]);
            AO[m * LW + c] = f2bf(h * siluf_(bf2f(P[m * 2560 + LW + c])));
        }
    }
};
struct FinalNormF {
    float* x; const float* g;
    HD void operator()(long m) const {
        float* r = x + (size_t)m * D; float s = 0.f;
        for (int k = 0; k < D; ++k) s += r[k] * r[k];
        const float rs = 1.0f / sqrtf(s / D + 1e-6f);
        for (int k = 0; k < D; ++k) r[k] = r[k] * rs * g[k];
    }
};


#ifndef CPU_SHIM
typedef short bf16x8 __attribute__((ext_vector_type(8)));
typedef float f32x4 __attribute__((ext_vector_type(4)));
typedef unsigned u32x4 __attribute__((ext_vector_type(4)));
typedef unsigned u32x2 __attribute__((ext_vector_type(2)));
#define DI __device__ __forceinline__
#define NTHREADS 256
__device__ __forceinline__ int opaque_tid() { int t = threadIdx.x; asm volatile("" : "+v"(t)); return t; }
#define TIDX (opaque_tid())

typedef __bf16 hbf16x2 __attribute__((ext_vector_type(2)));
typedef float f32x2 __attribute__((ext_vector_type(2)));
DI unsigned pack2bf(float lo, float hi) { f32x2 f = {lo, hi}; return __builtin_bit_cast(unsigned, __builtin_convertvector(f, hbf16x2)); }
DI float bflo(unsigned u) { return __uint_as_float(u << 16); }
DI float bfhi(unsigned u) { return __uint_as_float(u & 0xffff0000u); }

namespace fw {
constexpr size_t MB = 1024 * 1024;
constexpr size_t PARTS = 13 * MB;
constexpr size_t SMALLB = 1 * MB;
constexpr size_t WB = 14 * MB;
constexpr size_t XB = 30 * MB;
constexpr size_t BIG = 62 * MB;
}

DI void convert_tile(const float* __restrict__ W, int ldw, int c0, int K, bf16* __restrict__ Wt, const float* __restrict__ g, int kt, int nt, float* sm) {
    const int tid = TIDX;
    const int k0 = kt * 64, n0 = nt * 64;
#pragma unroll
    for (int i = 0; i < 4; ++i) {
        const int kr = (tid >> 4) + 16 * i; const int nc = (tid & 15) * 4;
        const float4 v = *(const float4*)(W + (size_t)(k0 + kr) * ldw + c0 + n0 + nc);
        const float s = g ? g[k0 + kr] : 1.0f;
        sm[kr * 65 + nc + 0] = v.x * s; sm[kr * 65 + nc + 1] = v.y * s; sm[kr * 65 + nc + 2] = v.z * s; sm[kr * 65 + nc + 3] = v.w * s;
    }
    __syncthreads();
    {
        const int n = tid >> 2, kq = (tid & 3) * 16;
        unsigned w[8];
#pragma unroll
        for (int j = 0; j < 8; ++j) w[j] = pack2bf(sm[(kq + 2 * j) * 65 + n], sm[(kq + 2 * j + 1) * 65 + n]);
        u32x4* dst = (u32x4*)(Wt + (size_t)(n0 + n) * K + k0 + kq);
        dst[0] = (u32x4){w[0], w[1], w[2], w[3]}; dst[1] = (u32x4){w[4], w[5], w[6], w[7]};
    }
    __syncthreads();
}
DI void convert_seg(const float* W, int ldw, int c0, int ncols, int K, bf16* Wt, const float* g, float* sm, int& tbase) {
    const int nkt = K / 64, nnt = ncols / 64, ntile = nkt * nnt;
    const int Gd = (int)gridDim.x;
    for (int t = (((int)blockIdx.x - tbase % Gd) + Gd) % Gd; t < ntile; t += Gd) convert_tile(W, ldw, c0, K, Wt, g, t % nkt, t / nkt, sm);
    tbase += ntile;
}

DI int perm32(int rho) { const int n = rho >> 4, i = rho & 15; return 8 * (i >> 2) + 4 * n + (i & 3); }

struct ALoadPlain {
    const bf16* A; int lda;
    static constexpr bool DMA = true;
    DI const bf16* src(int m, int k) const { return A + (size_t)m * lda + k; }
    struct Raw { u32x4 v; };
    DI Raw load(int m, int k) const { Raw r; r.v = *(const u32x4*)(A + (size_t)m * lda + k); return r; }
    DI u32x4 finish(const Raw& r, int, int) const { return r.v; }
};
struct ALoadLerp {
    const bf16* xn; const float* mu;
    static constexpr bool DMA = false;
    DI const bf16* src(int, int) const { return nullptr; }
    struct Raw { u32x4 c, p; };
    DI Raw load(int m, int k) const {
        Raw r; r.c = *(const u32x4*)(xn + (size_t)m * D + k);
        if ((m % T) != 0) r.p = *(const u32x4*)(xn + (size_t)(m - 1) * D + k); else r.p = (u32x4){0u, 0u, 0u, 0u};
        return r;
    }
    DI u32x4 finish(const Raw& r, int, int k) const {
        const float4 m0 = *(const float4*)(mu + k), m1 = *(const float4*)(mu + k + 4);
        const float mm[8] = {m0.x, m0.y, m0.z, m0.w, m1.x, m1.y, m1.z, m1.w};
        u32x4 o;
#pragma unroll
        for (int j = 0; j < 4; ++j) {
            const float c0 = bflo(r.c[j]), c1 = bfhi(r.c[j]), p0 = bflo(r.p[j]), p1 = bfhi(r.p[j]);
            o[j] = pack2bf(c0 + (p0 - c0) * mm[2 * j], c1 + (p1 - c1) * mm[2 * j + 1]);
        }
        return o;
    }
};

#define GLDS16(gp, lp) __builtin_amdgcn_global_load_lds((const unsigned*)(gp), (unsigned*)(lp), 16, 0, 0)
template <class AL, class Epi>
DI void gemm_tile(const AL& al, const bf16* __restrict__ Bt, int K, int m0, int n0, const Epi& epi, char* smem) {
    const int tid = TIDX, lane = tid & 63, wave = __builtin_amdgcn_readfirstlane(tid >> 6), wr = wave >> 1, wc = wave & 1, q = lane >> 4, l15 = lane & 15;
    const int srow = tid >> 3, sc = tid & 7, scs = sc ^ (srow & 7);
    const int st_off = srow * 128 + (sc << 4);
    const int dma_off = (8 * wave) * 128;
    int brow[4];
#pragma unroll
    for (int i = 0; i < 4; ++i) { const int rho = srow + 32 * i; brow[i] = n0 + (rho & ~31) + perm32(rho & 31); }
    const int fa0 = (wr * 64 + l15) * 128 + ((q ^ (lane & 7)) << 4);
    const int fb0 = (wc * 64 + l15) * 128 + ((q ^ (lane & 7)) << 4);
    f32x4 acc[4][4];
#pragma unroll
    for (int i = 0; i < 4; ++i)
#pragma unroll
        for (int j = 0; j < 4; ++j) acc[i][j] = (f32x4){0.f, 0.f, 0.f, 0.f};
    typename AL::Raw ra[4];
    const int nk = K / 64;
    {
        char* bufA = smem; char* bufB = smem + 16384;
#pragma unroll
        for (int i = 0; i < 4; ++i) {
            GLDS16(Bt + (size_t)brow[i] * K + scs * 8, bufB + dma_off + i * 4096);
            if (AL::DMA) GLDS16(al.src(m0 + srow + 32 * i, scs * 8), bufA + dma_off + i * 4096);
            else ra[i] = al.load(m0 + srow + 32 * i, scs * 8);
        }
        if (!AL::DMA) {
#pragma unroll
            for (int i = 0; i < 4; ++i) *(u32x4*)(bufA + st_off + i * 4096) = al.finish(ra[i], m0 + srow + 32 * i, scs * 8);
        }
    }
    asm volatile("s_waitcnt vmcnt(0)" ::: "memory");
    __syncthreads();
    for (int kt = 0; kt < nk; ++kt) {
        char* bufA = smem + (kt & 1) * 32768; char* bufB = bufA + 16384;
        char* nA = smem + ((kt + 1) & 1) * 32768; char* nB = nA + 16384;
        const bool more = kt + 1 < nk; const int kn = (kt + 1) * 64 + scs * 8;
        if (more) {
#pragma unroll
            for (int i = 0; i < 4; ++i) {
                GLDS16(Bt + (size_t)brow[i] * K + kn, nB + dma_off + i * 4096);
                if (AL::DMA) GLDS16(al.src(m0 + srow + 32 * i, kn), nA + dma_off + i * 4096);
                else ra[i] = al.load(m0 + srow + 32 * i, kn);
            }
        }
#pragma unroll
        for (int ks = 0; ks < 2; ++ks) {
            bf16x8 af[4], bfr[4];
#pragma unroll
            for (int i = 0; i < 4; ++i) {
                af[i] = *(const bf16x8*)(bufA + ((fa0 + i * 2048) ^ (ks << 6)));
                bfr[i] = *(const bf16x8*)(bufB + ((fb0 + i * 2048) ^ (ks << 6)));
            }
#pragma unroll
            for (int i = 0; i < 4; ++i)
#pragma unroll
                for (int j = 0; j < 4; ++j) acc[i][j] = __builtin_amdgcn_mfma_f32_16x16x32_bf16(bfr[j], af[i], acc[i][j], 0, 0, 0);
        }
        if (more && !AL::DMA) {
#pragma unroll
            for (int i = 0; i < 4; ++i) *(u32x4*)(nA + st_off + i * 4096) = al.finish(ra[i], m0 + srow + 32 * i, kn);
        }
        asm volatile("s_waitcnt vmcnt(0)" ::: "memory");
        __syncthreads();
    }
#pragma unroll
    for (int mt = 0; mt < 4; ++mt)
#pragma unroll
        for (int gi = 0; gi < 2; ++gi) {
            float v[8];
#pragma unroll
            for (int r = 0; r < 4; ++r) { v[r] = acc[mt][2 * gi][r]; v[4 + r] = acc[mt][2 * gi + 1][r]; }
            epi(m0 + wr * 64 + mt * 16 + l15, n0 + wc * 64 + gi * 32 + 8 * q, v, mt, gi);
        }
    epi.finish(m0, n0, wr, wc, lane);
}

constexpr int G2_STAGE = 24576;
template <class AL, class Epi>
DI void gemm_tile2(const AL& al, const bf16* __restrict__ Bt, int K, int m0, int n0, const Epi& epi, char* smem) {
    const int tid = TIDX, lane = tid & 63, wave = __builtin_amdgcn_readfirstlane(tid >> 6), wr = wave >> 1, wc = wave & 1, q = lane >> 4, l15 = lane & 15;
    const int prow = tid >> 2, ppos = tid & 3, ca = (ppos - 2 * ((tid >> 4) & 3)) & 3;
    const int dma_off = wave * 1024;
    int brow[4];
#pragma unroll
    for (int i = 0; i < 4; ++i) { const int rho = prow + 64 * i; brow[i] = n0 + (rho & ~31) + perm32(rho & 31); }
    const int fpos = ((q + 2 * ((l15 >> 2) & 3)) & 3) << 4;
    const int fa0 = (wr * 64 + l15) * 64 + fpos, fb0 = 8192 + (wc * 128 + l15) * 64 + fpos;
    f32x4 acc[4][8];
#pragma unroll
    for (int i = 0; i < 4; ++i)
#pragma unroll
        for (int j = 0; j < 8; ++j) acc[i][j] = (f32x4){0.f, 0.f, 0.f, 0.f};
    typename AL::Raw ra[2];
    const int nk = K / 32;
#define G2_ISSUE(kt_) { char* st_ = smem + ((kt_) % 3) * G2_STAGE; const int kk_ = (kt_) * 32 + ca * 8; \
        _Pragma("unroll") for (int i = 0; i < 2; ++i) { if (AL::DMA) GLDS16(al.src(m0 + prow + 64 * i, kk_), st_ + dma_off + i * 4096); else ra[i] = al.load(m0 + prow + 64 * i, kk_); } \
        _Pragma("unroll") for (int i = 0; i < 4; ++i) GLDS16(Bt + (size_t)brow[i] * K + kk_, st_ + 8192 + dma_off + i * 4096); }
#define G2_AWRITE(kt_) { if (!AL::DMA) { char* st_ = smem + ((kt_) % 3) * G2_STAGE; const int kk_ = (kt_) * 32 + ca * 8; \
        _Pragma("unroll") for (int i = 0; i < 2; ++i) *(u32x4*)(st_ + (prow + 64 * i) * 64 + ppos * 16) = al.finish(ra[i], m0 + prow + 64 * i, kk_); } }
#define G2_BARRIER() { asm volatile("s_waitcnt lgkmcnt(0)" ::: "memory"); __builtin_amdgcn_s_barrier(); asm volatile("" ::: "memory"); }
    G2_ISSUE(0); G2_AWRITE(0);
    if (nk > 1) { G2_ISSUE(1); G2_AWRITE(1); }
    if (nk > 1) { if (AL::DMA) asm volatile("s_waitcnt vmcnt(6)" ::: "memory"); else asm volatile("s_waitcnt vmcnt(4)" ::: "memory"); } else asm volatile("s_waitcnt vmcnt(0)" ::: "memory");
    G2_BARRIER();
    for (int kt = 0; kt < nk; ++kt) {
        const char* st = smem + (kt % 3) * G2_STAGE;
        const bool more = kt + 2 < nk;
        if (more) G2_ISSUE(kt + 2);
        bf16x8 af[4];
#pragma unroll
        for (int i = 0; i < 4; ++i) af[i] = *(const bf16x8*)(st + fa0 + i * 1024);
        bf16x8 bfr[8];
#pragma unroll
        for (int j = 0; j < 8; ++j) bfr[j] = *(const bf16x8*)(st + fb0 + j * 1024);
        __builtin_amdgcn_sched_barrier(0);
#pragma unroll
        for (int j = 0; j < 8; ++j) {
#pragma unroll
            for (int i = 0; i < 4; ++i) acc[i][j] = __builtin_amdgcn_mfma_f32_16x16x32_bf16(bfr[j], af[i], acc[i][j], 0, 0, 0);
        }
        if (more) G2_AWRITE(kt + 2);
        if (more) { if (AL::DMA) asm volatile("s_waitcnt vmcnt(6)" ::: "memory"); else asm volatile("s_waitcnt vmcnt(4)" ::: "memory"); } else asm volatile("s_waitcnt vmcnt(0)" ::: "memory");
        G2_BARRIER();
    }
#undef G2_ISSUE
#undef G2_AWRITE
#undef G2_BARRIER
#pragma unroll
    for (int mt = 0; mt < 4; ++mt)
#pragma unroll
        for (int gi = 0; gi < 4; ++gi) {
            float v[8];
#pragma unroll
            for (int r = 0; r < 4; ++r) { v[r] = acc[mt][2 * gi][r]; v[4 + r] = acc[mt][2 * gi + 1][r]; }
            epi(m0 + wr * 64 + mt * 16 + l15, n0 + wc * 128 + gi * 32 + 8 * q, v, mt, gi);
        }
    epi.finish_wide(m0, n0, wr, wc, lane);
}
template <class F>
DI void gemm_sched(int nbig, int nsmall, F&& f) {
    const int x = blockIdx.x & 7, lb = blockIdx.x >> 3, nlb = gridDim.x >> 3;
    const int nb16 = 16 * nbig, tot = 16 * (nbig + nsmall);
    for (int s = lb; s < tot; s += nlb) {
        if (s < nb16) f(true, x * 16 + (s & 15), s >> 4);
        else { const int t = s - nb16; f(false, x * 16 + (t & 15), t >> 4); }
    }
}

DI float rstd_from_parts(const float* parts, int m) {
    const float4* p = (const float4*)(parts + (size_t)m * 16); float s = 0.f;
#pragma unroll
    for (int i = 0; i < 4; ++i) { const float4 v = p[i]; s += (v.x + v.y) + (v.z + v.w); }
    return 1.0f / sqrtf(s * (1.0f / D) + 1e-6f);
}
DI void store8bf(bf16* p, const float* v) { *(u32x4*)p = (u32x4){pack2bf(v[0], v[1]), pack2bf(v[2], v[3]), pack2bf(v[4], v[5]), pack2bf(v[6], v[7])}; }

struct EpiBf16 {
    bf16* P; int ldp; const float* parts; mutable float rsc[4];
    DI void operator()(int m, int n, const float* v, int mt, int gi) const {
        if (gi == 0) rsc[mt] = parts ? rstd_from_parts(parts, m) : 1.0f;
        float s = rsc[mt]; float w[8];
#pragma unroll
        for (int j = 0; j < 8; ++j) w[j] = v[j] * s;
        store8bf(P + (size_t)m * ldp + n, w);
    }
    DI void finish(int, int, int, int, int) const {}
    DI void finish_wide(int, int, int, int, int) const {}
};
struct EpiResid {
    const float* xin; float* xout; bf16* xb; float* parts; mutable float sq[4];
    DI void operator()(int m, int n, const float* v, int mt, int gi) const {
        const float4* xi = (const float4*)(xin + (size_t)m * D + n); const float4 a = xi[0], b = xi[1];
        float w[8] = {a.x + v[0], a.y + v[1], a.z + v[2], a.w + v[3], b.x + v[4], b.y + v[5], b.z + v[6], b.w + v[7]};
        float4* xo = (float4*)(xout + (size_t)m * D + n);
        xo[0] = make_float4(w[0], w[1], w[2], w[3]); xo[1] = make_float4(w[4], w[5], w[6], w[7]);
        if (xb) store8bf(xb + (size_t)m * D + n, w);
        float s = 0.f;
#pragma unroll
        for (int j = 0; j < 8; ++j) s += w[j] * w[j];
        if (gi == 0) sq[mt] = s; else sq[mt] += s;
    }
    DI void finish(int m0, int n0, int wr, int wc, int lane) const {
#pragma unroll
        for (int mt = 0; mt < 4; ++mt) {
            float s = sq[mt]; s += __shfl_xor(s, 16); s += __shfl_xor(s, 32);
            if (lane < 16) parts[(size_t)(m0 + wr * 64 + mt * 16 + lane) * 16 + (n0 >> 7) * 2 + wc] = s;
        }
    }
    DI void finish_wide(int m0, int n0, int wr, int wc, int lane) const {
#pragma unroll
        for (int mt = 0; mt < 4; ++mt) {
            float s = sq[mt]; s += __shfl_xor(s, 16); s += __shfl_xor(s, 32);
            if (lane < 16) { float* pr = parts + (size_t)(m0 + wr * 64 + mt * 16 + lane) * 16 + (n0 >> 7) + wc; pr[0] = s; pr[8] = 0.f; }
        }
    }
};
struct EpiRwkv {
    bf16* P; float* hw; float* ha;
    DI void operator()(int m, int n, const float* v, int, int) const {
        if (n < 4096) { store8bf(P + (size_t)m * 4096 + n, v); return; }
        const int c = n - 4096;
        if (c < 64) { float4* o = (float4*)(hw + (size_t)m * 64 + c); o[0] = make_float4(tanhf(v[0]), tanhf(v[1]), tanhf(v[2]), tanhf(v[3])); o[1] = make_float4(tanhf(v[4]), tanhf(v[5]), tanhf(v[6]), tanhf(v[7])); }
        else if (c >= 128 && c < 192) { float4* o = (float4*)(ha + (size_t)m * 64 + (c - 128)); o[0] = make_float4(v[0], v[1], v[2], v[3]); o[1] = make_float4(v[4], v[5], v[6], v[7]); }
    }
    DI void finish(int, int, int, int, int) const {}
    DI void finish_wide(int, int, int, int, int) const {}
};

namespace at {
constexpr int OFF_BIAS = 49152;
constexpr int OFF_X = 61952;
constexpr int OFF_IMP = 49152;
constexpr float L2E = 1.4426950408889634f;
constexpr float NEG_MASK = -1e30f, M_INIT = -1e20f;
}
enum { AM_SWA = 0, AM_WIN = 1, AM_CMP = 2, AM_SEL = 3 };
DI int vt_perm(int k32) { return ((k32 & 15) >> 2) * 8 + (k32 >> 4) * 4 + (k32 & 3); }
DI float fast_exp2(float x) { return __builtin_amdgcn_exp2f(x); }

DI void build_bias_lut(const float* __restrict__ t5, char* smem, bool swa) {
    float* lut = (float*)(smem + at::OFF_BIAS);
    for (int i = TIDX; i < 16 * 200; i += NTHREADS) {
        const int h = i / 200, e = i % 200; float v = at::NEG_MASK;
        if (e >= 64 && e < 192) v = t5[t5_bucket(e - 64) * 16 + h] * at::L2E;
        else if (e >= 192 && !swa) v = t5[31 * 16 + h] * at::L2E;
        lut[i] = v;
    }
    __syncthreads();
}

template <int NQT> struct AttnStateT { f32x4 o[NQT][4]; f32x4 lacc[NQT]; float m[NQT]; };
#ifndef ANQT_SWA
#define ANQT_SWA 4
#endif
#ifndef ANQT_WIN
#define ANQT_WIN 2
#endif
#ifndef ANQT_SEL
#define ANQT_SEL 4
#endif
DI unsigned long long range_mask(int lo, int hi) { return (hi >= 63 ? ~0ull : ((1ull << (hi + 1)) - 1ull)) & ~((1ull << lo) - 1ull); }

template <int NQT>
DI void attn_load_q(bf16x8 (&qf)[NQT][2], const bf16* __restrict__ Qp, int ldq, size_t mbase, int hbase) {
    const int lane = TIDX & 63, wave = TIDX >> 6, q = lane >> 4, l15 = lane & 15;
#pragma unroll
    for (int qt = 0; qt < NQT; ++qt) {
        const size_t m = mbase + wave * (4 * NQT) + qt * 4 + (l15 >> 2);
#pragma unroll
        for (int ks = 0; ks < 2; ++ks) qf[qt][ks] = *(const bf16x8*)(Qp + m * ldq + (hbase + (l15 & 3)) * 64 + ks * 32 + q * 8);
    }
}

enum { SK_FAR = 0, SK_NEAR = 1, SK_EDGE = 2, SK_CMP = 3 };
template <int KIND>
DI float attn_fix(f32x4 (&s)[4], int dbase, float cadd, const float* __restrict__ bl, float mx) {
#pragma unroll
    for (int kt = 0; kt < 4; ++kt)
#pragma unroll
        for (int r = 0; r < 4; ++r) {
            float v = s[kt][r]; const int dist = dbase - (kt * 16 + r);
            if (KIND == SK_NEAR) { int idx = dist + 64; idx = idx < 0 ? 0 : (idx > 192 ? 192 : idx); v += bl[idx] + cadd; }
            else if (KIND == SK_EDGE) v = dist < 512 ? v + cadd : at::NEG_MASK;
            else if (KIND == SK_CMP) v = dist >= 0 ? v : at::NEG_MASK;
            if (KIND != SK_FAR) s[kt][r] = v;
            mx = fmaxf(mx, v);
        }
    return mx;
}
template <int MODE, int NQT>
DI void attn_blocks(AttnStateT<NQT>& st, const bf16x8 (&qf)[NQT][2], const bf16* __restrict__ Kp, size_t krs, const bf16* __restrict__ Vp, size_t vrs,
                    int t0, unsigned long long todo, int hbase, const unsigned long long (&sel)[NQT], char* smem) {
    const int tid = TIDX, lane = tid & 63, wave = __builtin_amdgcn_readfirstlane(tid >> 6), q = lane >> 4, l15 = lane & 15;
    const int tq0 = t0 + wave * (4 * NQT) + (l15 >> 2);
    const float* bl = (const float*)(smem + at::OFF_BIAS) + (hbase + (l15 & 3)) * 200;
    const float bfar = (MODE != AM_CMP) ? bl[192] : 0.f;
    const int srow = tid >> 3, scs = (tid & 7) ^ (srow & 7);
    const int fo = l15 * 128 + ((q ^ (l15 & 7)) << 4);
#define ATT_DMA(kb_, slot_) { _Pragma("unroll") for (int i = 0; i < 2; ++i) { const int row = srow + 32 * i; char* dst = smem + (slot_) * 16384 + (8 * wave + 32 * i) * 128; \
        GLDS16(Kp + (size_t)((kb_) * 64 + row) * krs + scs * 8, dst); GLDS16(Vp + (size_t)row * vrs + (kb_) * 64 + scs * 8, dst + 8192); } }
#define ATT_BARRIER() { asm volatile("s_waitcnt lgkmcnt(0)" ::: "memory"); __builtin_amdgcn_s_barrier(); asm volatile("" ::: "memory"); }
    if (todo == 0ull) return;
    int kb = __builtin_ctzll(todo); todo &= todo - 1ull;
    int kb1 = -1; if (todo) { kb1 = __builtin_ctzll(todo); todo &= todo - 1ull; }
    ATT_DMA(kb, 0);
    if (kb1 >= 0) { ATT_DMA(kb1, 1); asm volatile("s_waitcnt vmcnt(4)" ::: "memory"); } else { asm volatile("s_waitcnt vmcnt(0)" ::: "memory"); }
    ATT_BARRIER();
    int slot = 0;
    for (;;) {
        char* buf = smem + slot * 16384;
        int kb2 = -1; if (todo) { kb2 = __builtin_ctzll(todo); todo &= todo - 1ull; }
        if (kb2 >= 0) { const int s2 = slot >= 1 ? slot - 1 : 2; ATT_DMA(kb2, s2); }
        f32x4 s[NQT][4];
#pragma unroll
        for (int qt = 0; qt < NQT; ++qt)
#pragma unroll
            for (int kt = 0; kt < 4; ++kt) s[qt][kt] = (f32x4){0.f, 0.f, 0.f, 0.f};
#pragma unroll
        for (int kt = 0; kt < 4; ++kt)
#pragma unroll
            for (int ks = 0; ks < 2; ++ks) {
                const bf16x8 kf = *(const bf16x8*)(buf + ((fo + kt * 2048) ^ (ks << 6)));
#pragma unroll
                for (int qt = 0; qt < NQT; ++qt) s[qt][kt] = __builtin_amdgcn_mfma_f32_16x16x32_bf16(kf, qf[qt][ks], s[qt][kt], 0, 0, 0);
            }
        const int mind = (t0 + wave * (4 * NQT)) - (kb * 64 + 63), maxd = (t0 + wave * (4 * NQT) + 4 * NQT - 1) - kb * 64;
        float mx[NQT], cofs[NQT];
#pragma unroll
        for (int qt = 0; qt < NQT; ++qt) cofs[qt] = 0.f;
        if (MODE == AM_CMP) {
#pragma unroll
            for (int qt = 0; qt < NQT; ++qt) { const int nlim = (tq0 + 4 * qt - 31) >> 4; mx[qt] = attn_fix<SK_CMP>(s[qt], nlim - (kb * 64 + 4 * q), 0.f, bl, at::NEG_MASK); }
        } else {
            float cadd[NQT];
#pragma unroll
            for (int qt = 0; qt < NQT; ++qt) cadd[qt] = (MODE == AM_SEL && !((sel[qt] >> kb) & 1ull)) ? at::NEG_MASK : 0.f;
            if (MODE == AM_SWA || mind < 113) {
#pragma unroll
                for (int qt = 0; qt < NQT; ++qt) mx[qt] = attn_fix<SK_NEAR>(s[qt], tq0 + 4 * qt - (kb * 64 + 4 * q), cadd[qt], bl, at::NEG_MASK);
            } else if (MODE == AM_WIN && maxd >= 512) {
#pragma unroll
                for (int qt = 0; qt < NQT; ++qt) mx[qt] = attn_fix<SK_EDGE>(s[qt], tq0 + 4 * qt - (kb * 64 + 4 * q), bfar, bl, at::NEG_MASK);
            } else {
#pragma unroll
                for (int qt = 0; qt < NQT; ++qt) { cofs[qt] = bfar + cadd[qt]; mx[qt] = attn_fix<SK_FAR>(s[qt], 0, 0.f, bl, at::NEG_MASK) + cofs[qt]; }
            }
        }
        float msub[NQT]; bool grow = false;
#pragma unroll
        for (int qt = 0; qt < NQT; ++qt) {
            float m2 = mx[qt];
            m2 = fmaxf(m2, __shfl_xor(m2, 16)); m2 = fmaxf(m2, __shfl_xor(m2, 32));
            const bool g = m2 > st.m[qt] + 4.0f; grow |= g;
            mx[qt] = g ? m2 : st.m[qt];
            msub[qt] = mx[qt] - cofs[qt];
        }
        if (__any(grow)) {
#pragma unroll
            for (int qt = 0; qt < NQT; ++qt) {
                const float alpha = fast_exp2(st.m[qt] - mx[qt]);
#pragma unroll
                for (int dt = 0; dt < 4; ++dt) st.o[qt][dt] *= alpha;
                st.lacc[qt] *= alpha;
            }
        }
#pragma unroll
        for (int qt = 0; qt < NQT; ++qt) st.m[qt] = mx[qt];
#pragma unroll
        for (int qt = 0; qt < NQT; ++qt)
#pragma unroll
            for (int kt = 0; kt < 4; ++kt)
#pragma unroll
                for (int r = 0; r < 4; ++r) s[qt][kt][r] = fast_exp2(s[qt][kt][r] - msub[qt]);
        const bf16x8 ones = {(short)0x3F80, (short)0x3F80, (short)0x3F80, (short)0x3F80, (short)0x3F80, (short)0x3F80, (short)0x3F80, (short)0x3F80};
#pragma unroll
        for (int kp = 0; kp < 2; ++kp) {
            bf16x8 pf[NQT];
#pragma unroll
            for (int qt = 0; qt < NQT; ++qt) {
                const u32x4 w = {pack2bf(s[qt][2 * kp][0], s[qt][2 * kp][1]), pack2bf(s[qt][2 * kp][2], s[qt][2 * kp][3]),
                                 pack2bf(s[qt][2 * kp + 1][0], s[qt][2 * kp + 1][1]), pack2bf(s[qt][2 * kp + 1][2], s[qt][2 * kp + 1][3])};
                pf[qt] = __builtin_bit_cast(bf16x8, w);
            }
#pragma unroll
            for (int qt = 0; qt < NQT; ++qt) st.lacc[qt] = __builtin_amdgcn_mfma_f32_16x16x32_bf16(ones, pf[qt], st.lacc[qt], 0, 0, 0);
#pragma unroll
            for (int dt = 0; dt < 4; ++dt) {
                const bf16x8 vf = *(const bf16x8*)(buf + 8192 + ((fo + dt * 2048) ^ (kp << 6)));
#pragma unroll
                for (int qt = 0; qt < NQT; ++qt) st.o[qt][dt] = __builtin_amdgcn_mfma_f32_16x16x32_bf16(vf, pf[qt], st.o[qt][dt], 0, 0, 0);
            }
        }
        if (kb1 < 0) break;
        if (kb2 >= 0) { asm volatile("s_waitcnt vmcnt(4)" ::: "memory"); } else { asm volatile("s_waitcnt vmcnt(0)" ::: "memory"); }
        ATT_BARRIER();
        kb = kb1; kb1 = kb2; slot = slot == 2 ? 0 : slot + 1;
    }
    ATT_BARRIER();
#undef ATT_DMA
}
template <int NQT>
DI void attn_init(AttnStateT<NQT>& st, float m0, float l0) {
#pragma unroll
    for (int qt = 0; qt < NQT; ++qt) { st.m[qt] = m0; st.lacc[qt] = (f32x4){l0, l0, l0, l0};
#pragma unroll
        for (int dt = 0; dt < 4; ++dt) st.o[qt][dt] = (f32x4){0.f, 0.f, 0.f, 0.f}; }
}
DI float attn_linv(const f32x4& lacc) { const float l = lacc[0]; return l > 0.f ? 1.0f / l : 0.f; }

template <int TT>
DI void attn_item_decode(int item, int& b, int& g, int& t0) {
    constexpr int tiles = T / TT;
    const int Gd = (int)gridDim.x;
    int pair, tile;
    if ((Gd % tiles) == 0 && tiles * B * G % Gd == 0) {
        const int bid = item % Gd, rr = item / Gd, tau = bid % tiles;
        pair = bid / tiles + (Gd / tiles) * rr; tile = (rr & 1) ? tiles - 1 - tau : tau;
    } else { tile = item % tiles; pair = item / tiles; }
    t0 = tile * TT; g = pair % G; b = pair / G;
}
DI void swa_item(const bf16* __restrict__ P0, const bf16* __restrict__ VT, const float* __restrict__ sinks, bf16* __restrict__ AO, int item, char* smem) {
    constexpr int LDP = 2304;
    constexpr int NQT = ANQT_SWA;
    int b, g, t0; attn_item_decode<16 * NQT>(item, b, g, t0);
    const int lane = TIDX & 63, wave = TIDX >> 6, q = lane >> 4, l15 = lane & 15;
    const size_t mbase = (size_t)b * T + t0; const int hbase = g * 4, h = hbase + (l15 & 3);
    bf16x8 qf[NQT][2]; attn_load_q<NQT>(qf, P0, LDP, mbase, hbase);
    AttnStateT<NQT> st; attn_init<NQT>(st, sinks[h] * at::L2E, 1.0f);
    const int lo = t0 - 127 < 0 ? 0 : (t0 - 127) >> 6, hi = (t0 + 16 * NQT - 1) >> 6;
    const unsigned long long nosel[NQT] = {};
    attn_blocks<AM_SWA, NQT>(st, qf, P0 + (size_t)b * T * LDP + 1024 + g * 64, LDP, VT + (size_t)(b * G + g) * 64 * T, T, t0, range_mask(lo, hi), hbase, nosel, smem);
#pragma unroll
    for (int qt = 0; qt < NQT; ++qt) {
        const float li = attn_linv(st.lacc[qt]); const size_t m = mbase + wave * (4 * NQT) + qt * 4 + (l15 >> 2);
#pragma unroll
        for (int dt = 0; dt < 4; ++dt) {
            const int d0 = dt * 16 + 4 * q; const u32x2 zz = *(const u32x2*)(P0 + m * LDP + 1280 + h * 64 + d0);
            const float z0 = bflo(zz[0]), z1 = bfhi(zz[0]), z2 = bflo(zz[1]), z3 = bfhi(zz[1]);
            const f32x4 o = st.o[qt][dt];
            *(u32x2*)(AO + m * D + h * 64 + d0) = (u32x2){pack2bf(o[0] * li * siluf_(z0), o[1] * li * siluf_(z1)), pack2bf(o[2] * li * siluf_(z2), o[3] * li * siluf_(z3))};
        }
    }
}

struct EpiL0 {
    bf16* P0; bf16* VT; const float* parts; mutable float rsc[4];
    DI void operator()(int m, int n, const float* v, int mt, int gi) const {
        if (gi == 0) rsc[mt] = rstd_from_parts(parts, m);
        float s = rsc[mt]; if (n < 1024) s *= 0.125f * at::L2E; float w[8];
#pragma unroll
        for (int j = 0; j < 8; ++j) w[j] = v[j] * s;
        if (n < 1280) store8bf(P0 + (size_t)m * 2304 + n, w);
        else if (n >= 1536) store8bf(P0 + (size_t)m * 2304 + n - 256, w);
        else {
            const int g = (n - 1280) >> 6, d = (n - 1280) & 63, b = m / T, t = m % T; const int pos = (t & ~31) + vt_perm(t & 31);
            bf16* dst = VT + ((size_t)(b * G + g) * 64 + d) * T + pos;
#pragma unroll
            for (int j = 0; j < 8; ++j) dst[(size_t)j * T] = f2bf(w[j]);
        }
    }
    DI void finish(int, int, int, int, int) const {}
    DI void finish_wide(int, int, int, int, int) const {}
};

constexpr int LDP2 = 3200;
struct EpiL2 {
    bf16* P2; bf16* VTs; bf16* VTw; const float* parts; mutable float rsc[4];
    DI void operator()(int m, int n, const float* v, int mt, int gi) const {
        if (gi == 0) rsc[mt] = rstd_from_parts(parts, m);
        if (n >= C_COLS) return;
        float s = rsc[mt]; if (n < 1024) s *= 0.125f * at::L2E; float w[8];
#pragma unroll
        for (int j = 0; j < 8; ++j) w[j] = v[j] * s;
        const bool isvs = n >= 1792 && n < 2048, isvw = n >= 2304 && n < 2560;
        if (isvs || isvw) {
            const int c = n - (isvs ? 1792 : 2304); const int g = c >> 6, d = c & 63, b = m / T, t = m % T; const int pos = (t & ~31) + vt_perm(t & 31);
            bf16* dst = (isvs ? VTs : VTw) + ((size_t)(b * G + g) * 64 + d) * T + pos;
#pragma unroll
            for (int j = 0; j < 8; ++j) dst[(size_t)j * T] = f2bf(w[j]);
        } else {
            const int c = n < 1792 ? n : (n < 2304 ? n - 256 : n - 512);
            store8bf(P2 + (size_t)m * LDP2 + c, w);
        }
    }
    DI void finish(int, int, int, int, int) const {}
    DI void finish_wide(int, int, int, int, int) const {}
};

struct ALoadCmp {
    const bf16* P2; int col;
    static constexpr bool DMA = true;
    DI const bf16* src(int row, int k) const {
        int n = row & 255; const int bg = row >> 8, b = bg >> 2, g = bg & 3; const int l = k >> 6, d = k & 63; n = n < NCMP ? n : NCMP - 1;
        return P2 + (size_t)(b * T + 16 * n + l) * LDP2 + col + g * 64 + d;
    }
    struct Raw { u32x4 v; };
    DI Raw load(int row, int k) const {
        const int n = row & 255, bg = row >> 8, b = bg >> 2, g = bg & 3; const int l = k >> 6, d = k & 63; Raw r;
        if (n < NCMP) r.v = *(const u32x4*)(P2 + (size_t)(b * T + 16 * n + l) * LDP2 + col + g * 64 + d); else r.v = (u32x4){0u, 0u, 0u, 0u};
        return r;
    }
    DI u32x4 finish(const Raw& r, int, int) const { return r.v; }
};
struct EpiCmpH {
    char* smem; const float* bias8;
    DI void operator()(int m, int n, const float* v, int, int) const {
        const int row = m & 127; float w[8];
#pragma unroll
        for (int j = 0; j < 8; ++j) { float bsum = 0.f;
#pragma unroll
            for (int i = 0; i < 8; ++i) bsum += bias8[i * 128 + n + j];
            w[j] = siluf_(v[j] + bsum); }
        const int kk = n >> 6, c = (n & 63) >> 3;
        *(u32x4*)(smem + kk * 16384 + row * 128 + ((c ^ (row & 7)) << 4)) = (u32x4){pack2bf(w[0], w[1]), pack2bf(w[2], w[3]), pack2bf(w[4], w[5]), pack2bf(w[6], w[7])};
    }
    DI void finish(int, int, int, int, int) const {}
    DI void finish_wide(int, int, int, int, int) const {}
};
DI void cmp_tile(const bf16* __restrict__ P2, const bf16* __restrict__ w1t, const float* __restrict__ bias8, const bf16* __restrict__ w2t, int which, int rt,
                 bf16* __restrict__ KCb, bf16* __restrict__ VCT, char* smem) {
    gemm_tile(ALoadCmp{P2, which ? 1280 : 1024}, w1t, 2048, rt * 128, 0, EpiCmpH{smem, bias8}, smem);
    const int tid = TIDX, lane = tid & 63, wave = tid >> 6, q = lane >> 4, l15 = lane & 15;
#pragma unroll
    for (int i = 0; i < 4; ++i) {
        const int id = i * 256 + tid; const int row = id >> 4, c16 = id & 15, kk = c16 >> 3, c = c16 & 7;
        *(u32x4*)(smem + 32768 + kk * 8192 + row * 128 + ((c ^ (row & 7)) << 4)) = *(const u32x4*)(w2t + (size_t)row * 128 + c16 * 8);
    }
    __syncthreads();
    f32x4 acc[2][4];
#pragma unroll
    for (int i = 0; i < 2; ++i)
#pragma unroll
        for (int j = 0; j < 4; ++j) acc[i][j] = (f32x4){0.f, 0.f, 0.f, 0.f};
    const int fo = l15 * 128 + ((q ^ (l15 & 7)) << 4);
#pragma unroll
    for (int kk = 0; kk < 2; ++kk)
#pragma unroll
        for (int ks = 0; ks < 2; ++ks) {
            bf16x8 hf[2], wf[4];
#pragma unroll
            for (int i = 0; i < 2; ++i) hf[i] = *(const bf16x8*)(smem + kk * 16384 + (((wave * 32 + i * 16) * 128 + fo) ^ (ks << 6)));
#pragma unroll
            for (int j = 0; j < 4; ++j) wf[j] = *(const bf16x8*)(smem + 32768 + kk * 8192 + ((j * 2048 + fo) ^ (ks << 6)));
#pragma unroll
            for (int i = 0; i < 2; ++i)
#pragma unroll
                for (int j = 0; j < 4; ++j) acc[i][j] = __builtin_amdgcn_mfma_f32_16x16x32_bf16(wf[j], hf[i], acc[i][j], 0, 0, 0);
        }
#pragma unroll
    for (int i = 0; i < 2; ++i) {
        const int row = rt * 128 + wave * 32 + i * 16 + l15; const int n = row & 255, bg = row >> 8;
#pragma unroll
        for (int j = 0; j < 4; ++j) {
            const int d0 = j * 16 + 4 * q; const f32x4 a = acc[i][j];
            if (which == 0) *(u32x2*)(KCb + (size_t)row * 64 + d0) = (u32x2){pack2bf(a[0], a[1]), pack2bf(a[2], a[3])};
            else {
                const int pos = (n & ~31) + vt_perm(n & 31);
#pragma unroll
                for (int r = 0; r < 4; ++r) VCT[((size_t)bg * 64 + d0 + r) * 256 + pos] = f2bf(a[r]);
            }
        }
    }
    __syncthreads();
}

DI void win_item(const bf16* __restrict__ P2, const bf16* __restrict__ VTw, bf16* __restrict__ OW, int item, char* smem) {
    constexpr int NQT = ANQT_WIN;
    int b, g, t0; attn_item_decode<16 * NQT>(item, b, g, t0);
    const int lane = TIDX & 63, wave = TIDX >> 6, q = lane >> 4, l15 = lane & 15;
    const size_t mbase = (size_t)b * T + t0; const int hbase = g * 4, h = hbase + (l15 & 3);
    bf16x8 qf[NQT][2]; attn_load_q<NQT>(qf, P2, LDP2, mbase, hbase);
    AttnStateT<NQT> st; attn_init<NQT>(st, at::M_INIT, 0.f);
    const int lo = t0 - 511 < 0 ? 0 : (t0 - 511) >> 6, hi = (t0 + 16 * NQT - 1) >> 6;
    const unsigned long long nosel[NQT] = {};
    attn_blocks<AM_WIN, NQT>(st, qf, P2 + (size_t)b * T * LDP2 + 1792 + g * 64, LDP2, VTw + (size_t)(b * G + g) * 64 * T, T, t0, range_mask(lo, hi), hbase, nosel, smem);
#pragma unroll
    for (int qt = 0; qt < NQT; ++qt) {
        const float li = attn_linv(st.lacc[qt]); const size_t m = mbase + wave * (4 * NQT) + qt * 4 + (l15 >> 2);
#pragma unroll
        for (int dt = 0; dt < 4; ++dt) { const f32x4 o = st.o[qt][dt]; *(u32x2*)(OW + m * D + h * 64 + dt * 16 + 4 * q) = (u32x2){pack2bf(o[0] * li, o[1] * li), pack2bf(o[2] * li, o[3] * li)}; }
    }
}

DI void cmpsel_item(const bf16* __restrict__ P2, const bf16* __restrict__ KCb, const bf16* __restrict__ VCT, bf16* __restrict__ OC, unsigned long long* __restrict__ SELM, int item, char* smem) {
    int b, g, t0; attn_item_decode<32>(item, b, g, t0);
    const int tid = TIDX, lane = tid & 63, wave = tid >> 6, q = lane >> 4, l15 = lane & 15;
    const size_t mbase = (size_t)b * T + t0; const int hbase = g * 4, h = hbase + (l15 & 3);
    float* impL = (float*)(smem + at::OFF_IMP);
    for (int i = tid; i < 32 * 64; i += NTHREADS) impL[i] = 0.f;
    bf16x8 qf[2][2]; attn_load_q<2>(qf, P2, LDP2, mbase, hbase);
    AttnStateT<2> st; attn_init<2>(st, at::M_INIT, 0.f);
    const int nvmax = (t0 + 31 - 31) / 16 + 1;
    const int hi = (nvmax - 1) >> 6;
    const bf16* Kp = KCb + (size_t)(b * G + g) * 256 * 64; const bf16* Vp = VCT + (size_t)(b * G + g) * 64 * 256;
    const unsigned long long nosel[2] = {0ull, 0ull};
    attn_blocks<AM_CMP, 2>(st, qf, Kp, 64, Vp, 256, t0, range_mask(0, hi), hbase, nosel, smem);
    float linv[2];
#pragma unroll
    for (int qt = 0; qt < 2; ++qt) {
        linv[qt] = attn_linv(st.lacc[qt]); const size_t m = mbase + wave * 8 + qt * 4 + (l15 >> 2);
#pragma unroll
        for (int dt = 0; dt < 4; ++dt) { const f32x4 o = st.o[qt][dt]; *(u32x2*)(OC + m * D + h * 64 + dt * 16 + 4 * q) = (u32x2){pack2bf(o[0] * linv[qt], o[1] * linv[qt]), pack2bf(o[2] * linv[qt], o[3] * linv[qt])}; }
    }
    {
        const int tq0 = t0 + wave * 8 + (l15 >> 2);
        const bf16* kp0 = Kp + (size_t)l15 * 64 + q * 8;
        bf16x8 kfA[4][2], kfB[4][2];
#define CS_LOADK(dst_, kb_) { _Pragma("unroll") for (int kt = 0; kt < 4; ++kt) _Pragma("unroll") for (int ks = 0; ks < 2; ++ks) \
            dst_[kt][ks] = *(const bf16x8*)(kp0 + (size_t)((kb_) * 64 + kt * 16) * 64 + ks * 32); }
#define CS_QSUM(x_) { x_ += __builtin_bit_cast(float, __builtin_amdgcn_update_dpp(0, __builtin_bit_cast(int, x_), 0xB1, 0xf, 0xf, false)); \
                      x_ += __builtin_bit_cast(float, __builtin_amdgcn_update_dpp(0, __builtin_bit_cast(int, x_), 0x4E, 0xf, 0xf, false)); }
#define CS_BLOCK(kf_, kb_) { const int kbi = (kb_); \
            f32x4 s[2][4]; \
            _Pragma("unroll") for (int qt = 0; qt < 2; ++qt) _Pragma("unroll") for (int kt = 0; kt < 4; ++kt) s[qt][kt] = (f32x4){0.f, 0.f, 0.f, 0.f}; \
            _Pragma("unroll") for (int kt = 0; kt < 4; ++kt) _Pragma("unroll") for (int ks = 0; ks < 2; ++ks) { \
                s[0][kt] = __builtin_amdgcn_mfma_f32_16x16x32_bf16(kf_[kt][ks], qf[0][ks], s[0][kt], 0, 0, 0); \
                s[1][kt] = __builtin_amdgcn_mfma_f32_16x16x32_bf16(kf_[kt][ks], qf[1][ks], s[1][kt], 0, 0, 0); } \
            const bool allvis = 16 * (kbi * 64 + 63) + 31 <= t0;         \
            _Pragma("unroll") for (int qt = 0; qt < 2; ++qt) { \
                const int tq = tq0 + 4 * qt; const int tl = wave * 8 + qt * 4 + (l15 >> 2); \
                _Pragma("unroll") for (int kt = 0; kt < 4; ++kt) { \
                    float pr[4]; \
                    _Pragma("unroll") for (int r = 0; r < 4; ++r) { const int key = kbi * 64 + kt * 16 + 4 * q + r; \
                        const float e = fast_exp2(s[qt][kt][r] - st.m[qt]) * linv[qt]; pr[r] = (allvis || 16 * key + 31 <= tq) ? e : 0.f; } \
                    float s4 = (pr[0] + pr[1]) + (pr[2] + pr[3]), s1 = pr[3]; \
                    CS_QSUM(s4); CS_QSUM(s1); \
                    const int s0 = kbi * 16 + kt * 4 + q; \
                    if ((l15 & 3) == 0) { atomicAdd(&impL[tl * 64 + s0], s4); if (s0 + 1 < 64) atomicAdd(&impL[tl * 64 + s0 + 1], s1); } \
                } \
            } }
        CS_LOADK(kfA, 0);
        for (int kb = 0; kb <= hi; kb += 2) {
            if (kb + 1 <= hi) CS_LOADK(kfB, kb + 1);
            CS_BLOCK(kfA, kb);
            if (kb + 1 > hi) break;
            if (kb + 2 <= hi) CS_LOADK(kfA, kb + 2);
            CS_BLOCK(kfB, kb + 1);
        }
#undef CS_LOADK
#undef CS_QSUM
#undef CS_BLOCK
        __syncthreads();
    }
    {
        const int tl = tid >> 3, sg = tid & 7; const int t = t0 + tl, cur = t >> 6; float* row = impL + tl * 64;
        unsigned hk[8]; unsigned long long mine[8];
#pragma unroll
        for (int j = 0; j < 8; ++j) { const int s = sg * 8 + j; const float v = row[s];
            hk[j] = (s == 0 || s == cur || s == cur - 1) ? 0x7F800000u : (s * 64 > t ? 0u : (v > 0.f ? __float_as_uint(v) + 1u : 1u));
            mine[j] = ((unsigned long long)hk[j] << 32) | (unsigned)(63 - s); }
        __syncthreads();
#pragma unroll
        for (int j = 0; j < 8; ++j) ((unsigned*)row)[sg * 8 + j] = hk[j];
        __syncthreads();
        int rank[8] = {0, 0, 0, 0, 0, 0, 0, 0};
        const int ns4 = ((((t0 + 31) >> 6) >> 2) + 2) & ~1;
#pragma unroll 2
        for (int s4 = 0; s4 < ns4; ++s4) {
            const u32x4 v4 = *(const u32x4*)(row + s4 * 4);
#pragma unroll
            for (int e = 0; e < 4; ++e) { const unsigned long long kv = ((unsigned long long)v4[e] << 32) | (unsigned)(63 - (s4 * 4 + e));
#pragma unroll
                for (int j = 0; j < 8; ++j) rank[j] += kv > mine[j] ? 1 : 0; }
        }
        unsigned long long bits = 0ull;
#pragma unroll
        for (int j = 0; j < 8; ++j) if (rank[j] < KTOP && (sg * 8 + j) * 64 <= t) bits |= 1ull << (sg * 8 + j);
        unsigned lo = (unsigned)bits, hi2 = (unsigned)(bits >> 32);
#pragma unroll
        for (int o = 1; o < 8; o <<= 1) { lo |= __shfl_xor(lo, o); hi2 |= __shfl_xor(hi2, o); }
        if (sg == 0) SELM[(mbase + tl) * 4 + g] = ((unsigned long long)hi2 << 32) | lo;
    }
    __syncthreads();
}

DI void sel_item(const bf16* __restrict__ P2, const bf16* __restrict__ VTs, const unsigned long long* __restrict__ SELM, const bf16* __restrict__ OC, const bf16* __restrict__ OW,
                 bf16* __restrict__ AO, int item, char* smem) {
    constexpr int NQT = ANQT_SEL;
    int b, g, t0; attn_item_decode<16 * NQT>(item, b, g, t0);
    const int tid = TIDX, lane = tid & 63, wave = tid >> 6, q = lane >> 4, l15 = lane & 15;
    const size_t mbase = (size_t)b * T + t0; const int hbase = g * 4, rr = l15 & 3, h = hbase + rr;
    unsigned long long* orw = (unsigned long long*)(smem + at::OFF_X);
    if (tid == 0) *orw = 0ull;
    __syncthreads();
    if (tid < 16 * NQT) atomicOr(orw, SELM[(mbase + tid) * 4 + g]);
    unsigned long long sel[NQT];
#pragma unroll
    for (int qt = 0; qt < NQT; ++qt) sel[qt] = SELM[(mbase + wave * (4 * NQT) + qt * 4 + (l15 >> 2)) * 4 + g];
    bf16x8 qf[NQT][2]; attn_load_q<NQT>(qf, P2, LDP2, mbase, hbase);
    AttnStateT<NQT> st; attn_init<NQT>(st, at::M_INIT, 0.f);
    __syncthreads();
    const unsigned long long todo_v = (*orw) & range_mask(0, (t0 + 16 * NQT - 1) >> 6);
    const unsigned long long todo = ((unsigned long long)(unsigned)__builtin_amdgcn_readfirstlane((int)(todo_v >> 32)) << 32) | (unsigned)__builtin_amdgcn_readfirstlane((int)(unsigned)todo_v);
    attn_blocks<AM_SEL, NQT>(st, qf, P2 + (size_t)b * T * LDP2 + 1536 + g * 64, LDP2, VTs + (size_t)(b * G + g) * 64 * T, T, t0, todo, hbase, sel, smem);
#pragma unroll
    for (int qt = 0; qt < NQT; ++qt) {
        const float li = attn_linv(st.lacc[qt]); const size_t m = mbase + wave * (4 * NQT) + qt * 4 + (l15 >> 2);
        const bf16* gr = P2 + m * LDP2 + 3072;
        const float g0 = sigmoidf_(bf2f(gr[0 * 16 + h])), g1 = sigmoidf_(bf2f(gr[1 * 16 + h])), g2 = sigmoidf_(bf2f(gr[2 * 16 + h]));
#pragma unroll
        for (int dt = 0; dt < 4; ++dt) {
            const int d0 = dt * 16 + 4 * q; const size_t oi = m * D + h * 64 + d0;
            const u32x2 zz = *(const u32x2*)(P2 + m * LDP2 + 2048 + h * 64 + d0), cc = *(const u32x2*)(OC + oi), ww = *(const u32x2*)(OW + oi);
            const f32x4 o = st.o[qt][dt];
            const float r0 = (g0 * bflo(cc[0]) + g1 * o[0] * li + g2 * bflo(ww[0])) * siluf_(bflo(zz[0]));
            const float r1 = (g0 * bfhi(cc[0]) + g1 * o[1] * li + g2 * bfhi(ww[0])) * siluf_(bfhi(zz[0]));
            const float r2 = (g0 * bflo(cc[1]) + g1 * o[2] * li + g2 * bflo(ww[1])) * siluf_(bflo(zz[1]));
            const float r3 = (g0 * bfhi(cc[1]) + g1 * o[3] * li + g2 * bfhi(ww[1])) * siluf_(bfhi(zz[1]));
            *(u32x2*)(AO + oi) = (u32x2){pack2bf(r0, r1), pack2bf(r2, r3)};
        }
    }
    __syncthreads();
}

DI void lru_convert_gates(const float* __restrict__ gaw, const float* __restrict__ gxw, bf16* __restrict__ img) {
    for (int i = blockIdx.x * NTHREADS + TIDX; i < 16 * 160 * 96; i += gridDim.x * NTHREADS) {
        const int k = i % 96, n = (i / 96) % 160, blk = i / (96 * 160);
        float v = 0.f;
        if (k < 80) v = n < 80 ? gaw[((size_t)blk * 80 + k) * 80 + n] : gxw[((size_t)blk * 80 + k) * 80 + (n - 80)];
        img[i] = f2bf(v);
    }
}
DI void lru_gate_item(const bf16* __restrict__ P3, const float* __restrict__ cw, const float* __restrict__ cb, const bf16* __restrict__ gimg, const float* __restrict__ gab, const float* __restrict__ gxb,
                      const float* __restrict__ lam, bf16* __restrict__ LA, bf16* __restrict__ BV, float2* __restrict__ SUM, int item, char* smem) {
    const int rt = item >> 4, nb = item & 15; const int tid = TIDX, lane = tid & 63, wave = tid >> 6, q = lane >> 4, l15 = lane & 15;
    const size_t m0 = (size_t)rt * 128;
    for (int id = tid; id < 128 * 12; id += NTHREADS) {
        const int row = id / 12, c12 = id % 12; u32x4 outv = (u32x4){0u, 0u, 0u, 0u};
        if (c12 < 10) {
            const size_t m = m0 + row; const int t = (int)(m % T); const int ch = nb * 80 + c12 * 8;
            float acc[8];
            { const float4 b0 = *(const float4*)(cb + ch), b1 = *(const float4*)(cb + ch + 4); acc[0] = b0.x; acc[1] = b0.y; acc[2] = b0.z; acc[3] = b0.w; acc[4] = b1.x; acc[5] = b1.y; acc[6] = b1.z; acc[7] = b1.w; }
#pragma unroll
            for (int w = 0; w < 4; ++w) {
                if (t - 3 + w >= 0) {
                    const u32x4 uv = *(const u32x4*)(P3 + (m - 3 + w) * 2560 + ch);
                    const float4 w0 = *(const float4*)(cw + w * LW + ch), w1 = *(const float4*)(cw + w * LW + ch + 4);
                    acc[0] += w0.x * bflo(uv[0]); acc[1] += w0.y * bfhi(uv[0]); acc[2] += w0.z * bflo(uv[1]); acc[3] += w0.w * bfhi(uv[1]);
                    acc[4] += w1.x * bflo(uv[2]); acc[5] += w1.y * bfhi(uv[2]); acc[6] += w1.z * bflo(uv[3]); acc[7] += w1.w * bfhi(uv[3]);
                }
            }
            outv = (u32x4){pack2bf(acc[0], acc[1]), pack2bf(acc[2], acc[3]), pack2bf(acc[4], acc[5]), pack2bf(acc[6], acc[7])};
        }
        const int ks = c12 >> 2, c = c12 & 3;
        *(u32x4*)(smem + ks * 8192 + row * 64 + ((c ^ ((row >> 2) & 3)) << 4)) = outv;
    }
    for (int id = tid; id < 160 * 12; id += NTHREADS) {
        const int row = id / 12, c12 = id % 12; const int ks = c12 >> 2, c = c12 & 3;
        *(u32x4*)(smem + 24576 + ks * 10240 + row * 64 + ((c ^ ((row >> 2) & 3)) << 4)) = *(const u32x4*)(gimg + ((size_t)nb * 160 + row) * 96 + c12 * 8);
    }
    __syncthreads();
    f32x4 acc[2][10];
#pragma unroll
    for (int i = 0; i < 2; ++i)
#pragma unroll
        for (int j = 0; j < 10; ++j) acc[i][j] = (f32x4){0.f, 0.f, 0.f, 0.f};
    const int fo = l15 * 64 + ((q ^ ((l15 >> 2) & 3)) << 4);
#pragma unroll
    for (int ks = 0; ks < 3; ++ks) {
        bf16x8 uf[2];
#pragma unroll
        for (int i = 0; i < 2; ++i) uf[i] = *(const bf16x8*)(smem + ks * 8192 + (wave * 32 + i * 16) * 64 + fo);
#pragma unroll
        for (int j = 0; j < 10; ++j) {
            const bf16x8 wf = *(const bf16x8*)(smem + 24576 + ks * 10240 + j * 1024 + fo);
            acc[0][j] = __builtin_amdgcn_mfma_f32_16x16x32_bf16(wf, uf[0], acc[0][j], 0, 0, 0);
            acc[1][j] = __builtin_amdgcn_mfma_f32_16x16x32_bf16(wf, uf[1], acc[1][j], 0, 0, 0);
        }
    }
    __syncthreads();
#pragma unroll
    for (int i = 0; i < 2; ++i) {
        const int row = wave * 32 + i * 16 + l15; const size_t m = m0 + row;
#pragma unroll
        for (int ct = 0; ct < 5; ++ct) {
            const int kcol = ct * 16 + 4 * q; const int ch = nb * 80 + kcol;
            const u32x2 uu = *(const u32x2*)(smem + (kcol >> 5) * 8192 + row * 64 + ((((kcol & 31) >> 3) ^ ((row >> 2) & 3)) << 4) + (kcol & 7) * 2);
            const float uc[4] = {bflo(uu[0]), bfhi(uu[0]), bflo(uu[1]), bfhi(uu[1])};
            const float4 ba = *(const float4*)(gab + ch), bx = *(const float4*)(gxb + ch), lm = *(const float4*)(lam + ch);
            const float bav[4] = {ba.x, ba.y, ba.z, ba.w}, bxv[4] = {bx.x, bx.y, bx.z, bx.w}, lmv[4] = {lm.x, lm.y, lm.z, lm.w};
            float la[4], bv[4];
#pragma unroll
            for (int r = 0; r < 4; ++r) {
                const float rg = __builtin_amdgcn_rcpf(1.0f + __expf(-(acc[i][ct][r] + bav[r]))), ig = __builtin_amdgcn_rcpf(1.0f + __expf(-(acc[i][ct + 5][r] + bxv[r])));
                la[r] = rg * lmv[r];
                const float om = 1.0f - __expf(2.0f * la[r]);
                bv[r] = __builtin_amdgcn_sqrtf(om > 0.f ? om : 0.f) * (ig * uc[r]);
            }
            const u32x2 lav = {pack2bf(la[0], la[1]), pack2bf(la[2], la[3])}, bvv = {pack2bf(bv[0], bv[1]), pack2bf(bv[2], bv[3])};
            *(u32x2*)(LA + m * LW + ch) = lav; *(u32x2*)(BV + m * LW + ch) = bvv;
            *(u32x2*)(smem + 24576 + (row * 80 + kcol) * 2) = lav; *(u32x2*)(smem + 24576 + 20480 + (row * 80 + kcol) * 2) = bvv;
        }
    }
    __syncthreads();
    if (tid < 160) {
        const int cidx = tid / 80, c = tid % 80; const bf16* li = (const bf16*)(smem + 24576) + (cidx * 64) * 80 + c; const bf16* bi = li + 10240;
        float sla = 0.f, h = 0.f;
#pragma unroll 8
        for (int t = 0; t < 64; ++t) { const float la = bf2f(li[t * 80]), bvv = bf2f(bi[t * 80]); h = __expf(la) * h + bvv; sla += la; }
        const size_t mc = m0 + cidx * 64; const int bb = (int)(mc / T), jj = (int)(mc % T) / 64;
        SUM[((size_t)bb * (T / 64) + jj) * LW + nb * 80 + c] = make_float2(__expf(sla), h);
    }
    __syncthreads();
}
DI void lru_scan2_item(const bf16* __restrict__ LA, const bf16* __restrict__ BV, const float2* __restrict__ SUM, const bf16* __restrict__ P3, bf16* __restrict__ AO, int item) {
    const int cg = item % 5, j = (item / 5) % (T / 64), b = item / (5 * (T / 64)); const int c = cg * 256 + TIDX;
    float h = 0.f;
    for (int jj = 0; jj < j; ++jj) { const float2 s = SUM[((size_t)b * (T / 64) + jj) * LW + c]; h = s.x * h + s.y; }
    const size_t m0 = (size_t)b * T + j * 64;
#pragma unroll 8
    for (int t = 0; t < 64; ++t) {
        const float la = bf2f(LA[(m0 + t) * LW + c]); const float bv = bf2f(BV[(m0 + t) * LW + c]); const float z = bf2f(P3[(m0 + t) * 2560 + LW + c]);
        h = __expf(la) * h + bv; AO[(m0 + t) * LW + c] = f2bf(h * siluf_(z));
    }
}

struct ALoadF32 {
    const float* A;
    static constexpr bool DMA = false;
    DI const bf16* src(int, int) const { return nullptr; }
    struct Raw { float4 a, b; };
    DI Raw load(int m, int k) const { Raw r; r.a = *(const float4*)(A + (size_t)m * 64 + k); r.b = *(const float4*)(A + (size_t)m * 64 + k + 4); return r; }
    DI u32x4 finish(const Raw& r, int, int) const { return (u32x4){pack2bf(r.a.x, r.a.y), pack2bf(r.a.z, r.a.w), pack2bf(r.b.x, r.b.y), pack2bf(r.b.z, r.b.w)}; }
};
struct EpiLora {
    const float* w0; const float* a0; bf16* WL; bf16* AV;
    DI void operator()(int m, int n, const float* v, int, int) const {
        float w[8];
        if (n < 1024) {
#pragma unroll
            for (int j = 0; j < 8; ++j) w[j] = -0.60653065971f * __builtin_amdgcn_rcpf(1.0f + __expf(-(w0[n + j] + v[j])));
            store8bf(WL + (size_t)m * D + n, w);
        } else {
#pragma unroll
            for (int j = 0; j < 8; ++j) w[j] = __builtin_amdgcn_rcpf(1.0f + __expf(-(a0[n - 1024 + j] + v[j])));
            store8bf(AV + (size_t)m * D + n - 1024, w);
        }
    }
    DI void finish(int, int, int, int, int) const {}
    DI void finish_wide(int, int, int, int, int) const {}
};
DI float dpp_sum16(float x) {
    x += __builtin_bit_cast(float, __builtin_amdgcn_update_dpp(0, __builtin_bit_cast(int, x), 0xB1, 0xf, 0xf, false));
    x += __builtin_bit_cast(float, __builtin_amdgcn_update_dpp(0, __builtin_bit_cast(int, x), 0x4E, 0xf, 0xf, false));
    x += __builtin_bit_cast(float, __builtin_amdgcn_update_dpp(0, __builtin_bit_cast(int, x), 0x141, 0xf, 0xf, false));
    x += __builtin_bit_cast(float, __builtin_amdgcn_update_dpp(0, __builtin_bit_cast(int, x), 0x140, 0xf, 0xf, false));
    return x;
}
constexpr int RW_NCH = T / 16;
DI void rwkv_prep_item(bf16* __restrict__ P, bf16* __restrict__ WL, bf16* __restrict__ AV, const float* __restrict__ k_k, const float* __restrict__ k_a, const float* __restrict__ r_k,
                       float* __restrict__ G15, bf16* __restrict__ M2g, bf16* __restrict__ M3g, float* __restrict__ BON, int item, char* smem) {
    const int c = item % RW_NCH, h = (item / RW_NCH) & 15, b = item / (RW_NCH * 16);
    const int tid = TIDX, t = tid >> 4, jq = tid & 15, j0 = jq * 4;
    const size_t m0 = (size_t)b * T + c * 16, m = m0 + t; const size_t ch = (size_t)(b * 16 + h) * RW_NCH + c;
    float* sA = (float*)smem; float* sR = sA + 16 * 68; float* sB = sR + 16 * 68; float* sK = sB + 16 * 68; float* sW = sK + 16 * 68; float* sWl = sW + 16 * 68;
    float* mAab = sWl + 16 * 64; float* mAak = mAab + 16 * 17; float* mArb = mAak + 16 * 17; float* mArk = mArb + 16 * 17; float* mTin = mArk + 16 * 17; float* mM2 = mTin + 16 * 17;
    const u32x2 r2 = *(const u32x2*)(P + m * 4096 + h * 64 + j0), k2 = *(const u32x2*)(P + m * 4096 + 1024 + h * 64 + j0), a2 = *(const u32x2*)(AV + m * D + h * 64 + j0), w2 = *(const u32x2*)(WL + m * D + h * 64 + j0);
    const float rr[4] = {bflo(r2[0]), bfhi(r2[0]), bflo(r2[1]), bfhi(r2[1])}, kr[4] = {bflo(k2[0]), bfhi(k2[0]), bflo(k2[1]), bfhi(k2[1])},
                av[4] = {bflo(a2[0]), bfhi(a2[0]), bflo(a2[1]), bfhi(a2[1])}, wl[4] = {bflo(w2[0]), bfhi(w2[0]), bflo(w2[1]), bfhi(w2[1])};
    const float4 kk4 = *(const float4*)(k_k + h * 64 + j0), ka4 = *(const float4*)(k_a + h * 64 + j0), rk4 = *(const float4*)(r_k + h * 64 + j0);
    const float kkc[4] = {kk4.x, kk4.y, kk4.z, kk4.w}, kac[4] = {ka4.x, ka4.y, ka4.z, ka4.w}, rkc[4] = {rk4.x, rk4.y, rk4.z, rk4.w};
    float kkv[4], n2 = 0.f;
#pragma unroll
    for (int e = 0; e < 4; ++e) { kkv[e] = kr[e] * kkc[e]; n2 += kkv[e] * kkv[e]; }
    n2 = dpp_sum16(n2);
    float nr = sqrtf(n2); nr = nr > 1e-12f ? nr : 1e-12f; const float inr = 1.0f / nr;
    float aa[4], bb[4], kp[4], bon = 0.f;
#pragma unroll
    for (int e = 0; e < 4; ++e) { const float kn = kkv[e] * inr; aa[e] = -kn; bb[e] = kn * av[e]; kp[e] = kr[e] * (1.0f + (av[e] - 1.0f) * kac[e]); bon += rr[e] * kp[e] * rkc[e]; }
    bon = dpp_sum16(bon);
    if (jq == 0) BON[m * 16 + h] = bon;
    *(float4*)(sWl + t * 64 + j0) = make_float4(wl[0], wl[1], wl[2], wl[3]);
    __syncthreads();
    float clx[4] = {0.f, 0.f, 0.f, 0.f};
#pragma unroll
    for (int s = 0; s < 15; ++s) { if (s < t) { const float4 w = *(const float4*)(sWl + s * 64 + j0); clx[0] += w.x; clx[1] += w.y; clx[2] += w.z; clx[3] += w.w; } }
    float bt[4];
    {
        float va[4], vr[4], vk[4], gc[4];
#pragma unroll
        for (int e = 0; e < 4; ++e) { const float cl = clx[e] + wl[e]; const float gp = __expf(clx[e]), gi = __expf(-cl); gc[e] = __expf(cl); va[e] = aa[e] * gp; vr[e] = rr[e] * gc[e]; bt[e] = bb[e] * gi; vk[e] = kp[e] * gi; }
        *(float4*)(sA + t * 68 + j0) = make_float4(va[0], va[1], va[2], va[3]); *(float4*)(sR + t * 68 + j0) = make_float4(vr[0], vr[1], vr[2], vr[3]);
        *(float4*)(sB + t * 68 + j0) = make_float4(bt[0], bt[1], bt[2], bt[3]); *(float4*)(sK + t * 68 + j0) = make_float4(vk[0], vk[1], vk[2], vk[3]);
        {
            char* img = (char*)(mM2 + 16 * 17) + t * 128 + (((j0 >> 3) ^ (t & 7)) << 4) + (j0 & 4) * 2;
            *(u32x2*)(img) = (u32x2){pack2bf(va[0], va[1]), pack2bf(va[2], va[3])}; *(u32x2*)(img + 2048) = (u32x2){pack2bf(vr[0], vr[1]), pack2bf(vr[2], vr[3])};
            *(u32x2*)(img + 4096) = (u32x2){pack2bf(bt[0], bt[1]), pack2bf(bt[2], bt[3])}; *(u32x2*)(img + 6144) = (u32x2){pack2bf(vk[0], vk[1]), pack2bf(vk[2], vk[3])};
        }
        if (t == 15) *(float4*)(G15 + ch * 64 + j0) = make_float4(gc[0], gc[1], gc[2], gc[3]);
#pragma unroll
        for (int e = 0; e < 4; ++e) {   }
#pragma unroll
        for (int e = 0; e < 4; ++e) clx[e] = vk[e];
    }
    __syncthreads();
    {
        const int wv = __builtin_amdgcn_readfirstlane(tid >> 6), lane = tid & 63, q = lane >> 4, l15 = lane & 15;
        const char* xb_ = (const char*)(mM2 + 16 * 17) + (wv >> 1) * 2048;
        const char* yb_ = (const char*)(mM2 + 16 * 17) + 4096 + (wv & 1) * 2048;
        f32x4 acc = {0.f, 0.f, 0.f, 0.f};
#pragma unroll
        for (int ks = 0; ks < 2; ++ks) {
            const int off = l15 * 128 + (((ks * 4 + q) ^ (l15 & 7)) << 4);
            const bf16x8 xf = *(const bf16x8*)(xb_ + off), yf = *(const bf16x8*)(yb_ + off);
            acc = __builtin_amdgcn_mfma_f32_16x16x32_bf16(xf, yf, acc, 0, 0, 0);
        }
        float* dst = wv == 0 ? mAab : (wv == 1 ? mAak : (wv == 2 ? mArb : mArk));
        const bool strict = wv < 2;
#pragma unroll
        for (int r = 0; r < 4; ++r) { const int tt = 4 * q + r, ss = l15; dst[tt * 17 + ss] = (strict ? ss < tt : ss <= tt) ? acc[r] : 0.f; }
    }
    __syncthreads();
    if (tid < 16) {
        float col[16];
#pragma unroll
        for (int i = 0; i < 16; ++i) {
            float acc = (i == tid) ? 1.0f : 0.f;
#pragma unroll
            for (int jj = 0; jj < i; ++jj) acc += mAab[i * 17 + jj] * col[jj];
            col[i] = acc; mTin[i * 17 + tid] = acc;
        }
    }
    __syncthreads();
    float wv[4] = {0.f, 0.f, 0.f, 0.f}, m2 = 0.f;
#pragma unroll
    for (int s = 0; s < 16; ++s) { const float ti = mTin[t * 17 + s]; const float4 a4 = *(const float4*)(sA + s * 68 + j0); wv[0] += ti * a4.x; wv[1] += ti * a4.y; wv[2] += ti * a4.z; wv[3] += ti * a4.w; m2 += ti * mAak[s * 17 + jq]; }
    *(float4*)(sW + t * 68 + j0) = make_float4(wv[0], wv[1], wv[2], wv[3]); mM2[t * 17 + jq] = m2;
    __syncthreads();
    float rh[4]; { const float4 r4 = *(const float4*)(sR + t * 68 + j0); rh[0] = r4.x; rh[1] = r4.y; rh[2] = r4.z; rh[3] = r4.w; }
    float m3 = mArk[t * 17 + jq];
#pragma unroll
    for (int s = 0; s < 16; ++s) { const float ar = mArb[t * 17 + s]; const float4 w4 = *(const float4*)(sW + s * 68 + j0); rh[0] += ar * w4.x; rh[1] += ar * w4.y; rh[2] += ar * w4.z; rh[3] += ar * w4.w; m3 += ar * mM2[s * 17 + jq]; }
    const int jp = (((jq >> 3) * 4 + (jq & 3)) * 8 + ((jq >> 2) & 1) * 4);
    *(u32x2*)(WL + m * D + h * 64 + jp) = (u32x2){pack2bf(wv[0], wv[1]), pack2bf(wv[2], wv[3])};
    *(u32x2*)(P + m * 4096 + h * 64 + jp) = (u32x2){pack2bf(rh[0], rh[1]), pack2bf(rh[2], rh[3])};
#pragma unroll
    for (int e = 0; e < 4; ++e) {
        const int pos = ((e & 1) * 4 + (t >> 2)) * 8 + (t & 3);
        bf16* dst = e < 2 ? P + (m0 + jq) * 4096 + 1024 + h * 64 : AV + (m0 + jq) * D + h * 64;
        dst[pos] = f2bf(clx[e]); dst[pos + 4] = f2bf(bt[e]);
    }
    M2g[ch * 256 + t * 16 + jq] = f2bf(m2); M3g[ch * 256 + t * 16 + jq] = f2bf(m3);
    __syncthreads();
}

#define MFMA32(a, b, c) __builtin_amdgcn_mfma_f32_16x16x32_bf16(__builtin_bit_cast(bf16x8, a), __builtin_bit_cast(bf16x8, b), c, 0, 0, 0)
DI void rwkv_chunk_scan(const bf16* __restrict__ P, const bf16* __restrict__ WL, const bf16* __restrict__ AV, const float* __restrict__ G15, const bf16* __restrict__ M2g, const bf16* __restrict__ M3g,
                        bf16* __restrict__ YS, int bh, char* smem) {
    constexpr int SLOT = 12288, YOFF = 49152;
    const int tid = TIDX, lane = tid & 63, vs = __builtin_amdgcn_readfirstlane(tid >> 6), q = lane >> 4, l15 = lane & 15; const int b = bh >> 4, h = bh & 15;
    const size_t mb = (size_t)b * T; const size_t ch0 = (size_t)(b * 16 + h) * RW_NCH;
    const char *s0, *s1, *s2; size_t d0, d1, d2;
    if (tid < 128) { const int c8 = tid >> 4, t = tid & 15; s0 = (const char*)(WL + (mb + t) * D + h * 64 + c8 * 8); d0 = (size_t)16 * D * 2; }
    else { const int pp = tid - 128, c8 = pp >> 4, t = pp & 15; s0 = (const char*)(P + (mb + t) * 4096 + h * 64 + c8 * 8); d0 = (size_t)16 * 4096 * 2; }
    if (tid < 128) { const int r = tid >> 3, c8 = tid & 7; s1 = (const char*)(P + (mb + r) * 4096 + 1024 + h * 64 + c8 * 8); d1 = (size_t)16 * 4096 * 2; }
    else { const int pp = tid - 128, r = pp >> 3, c8 = pp & 7; s1 = (const char*)(AV + (mb + r) * D + h * 64 + c8 * 8); d1 = (size_t)16 * D * 2; }
    if (tid < 128) { const int r = tid >> 3, c8 = tid & 7; s2 = (const char*)(P + (mb + r) * 4096 + 2048 + h * 64 + c8 * 8); d2 = (size_t)16 * 4096 * 2; }
    else if (tid < 160) { s2 = (const char*)(M2g + ch0 * 256 + (tid - 128) * 8); d2 = 512; }
    else if (tid < 192) { s2 = (const char*)(M3g + ch0 * 256 + (tid - 160) * 8); d2 = 512; }
    else { const int pp = tid < 208 ? tid - 192 : 0; s2 = (const char*)(G15 + ch0 * 64 + pp * 4); d2 = 256; }
    const int dma_off = vs * 1024;
#define RW_DMA(slot_) { char* dst = smem + (slot_) * SLOT + dma_off; GLDS16(s0, dst); GLDS16(s1, dst + 4096); GLDS16(s2, dst + 8192); s0 += d0; s1 += d1; s2 += d2; }
#define RW_BARRIER() { asm volatile("s_waitcnt lgkmcnt(0)" ::: "memory"); __builtin_amdgcn_s_barrier(); asm volatile("" ::: "memory"); }
    f32x4 H0 = {0.f, 0.f, 0.f, 0.f}, H1 = H0, H2 = H0, H3 = H0;
    const int oW = (q * 16 + l15) * 16;
    const int oK = 4096 + ((l15 & 3) >> 1) * 2048 + ((l15 >> 2) * 8 + (l15 & 1) * 4 + q) * 16;
    const int oM = 10240 + l15 * 32 + q * 8;
    const int oV = 8192 + (4 * q) * 128 + (vs * 16 + l15) * 2;
    const int oG = 11264 + (4 * q) * 4;
    const int oY = YOFF + ((4 * q) * 64 + vs * 16 + l15) * 2;
    RW_DMA(0); RW_DMA(1); RW_DMA(2);
    asm volatile("s_waitcnt vmcnt(6)" ::: "memory");
    RW_BARRIER();
    const u32x4 zz4 = {0u, 0u, 0u, 0u};
    u32x4 Hb0A = zz4, Hb1A = zz4, VUA = zz4, m3A = zz4, rAA = zz4, rBA = zz4;
    u32x4 Hb0B = zz4, Hb1B = zz4, VUB = zz4, m3B = zz4, rAB = zz4, rBB = zz4;
    u32x4 m2x = zz4;
    int sincef = 3;
#define RW_FLUSH(cbase_) { u32x4 yv[4]; \
        _Pragma("unroll") for (int k = 0; k < 4; ++k) yv[k] = *(const u32x4*)(smem + YOFF + (tid + 256 * k) * 16); \
        _Pragma("unroll") for (int k = 0; k < 4; ++k) { const int pc = tid + 256 * k, rr = pc >> 3, c8 = pc & 7; *(u32x4*)(YS + (mb + (size_t)(cbase_) * 16 + rr) * D + h * 64 + c8 * 8) = yv[k]; } }
#define RW_YSTORE(Y_, cprev_) { char* yb = smem + oY + ((cprev_) & 7) * 2048; const unsigned y01 = pack2bf(Y_[0], Y_[1]), y23 = pack2bf(Y_[2], Y_[3]); \
        *(unsigned short*)(yb) = (unsigned short)y01; *(unsigned short*)(yb + 128) = (unsigned short)(y01 >> 16); \
        *(unsigned short*)(yb + 256) = (unsigned short)y23; *(unsigned short*)(yb + 384) = (unsigned short)(y23 >> 16); }
#define RW_STEP(c_, P_, N_, J_) { const int c = (c_);        \
        if (c + 3 < RW_NCH) RW_DMA(((J_) + 3) & 3); \
        const char* sl = smem + (J_) * SLOT; \
        { \
            const f32x4 z4 = {0.f, 0.f, 0.f, 0.f}; \
            Hb0##N_ = (u32x4){pack2bf(H0[0], H0[1]), pack2bf(H0[2], H0[3]), pack2bf(H1[0], H1[1]), pack2bf(H1[2], H1[3])}; \
            Hb1##N_ = (u32x4){pack2bf(H2[0], H2[1]), pack2bf(H2[2], H2[3]), pack2bf(H3[0], H3[1]), pack2bf(H3[2], H3[3])}; \
            const unsigned v0 = *(const bf16*)(sl + oV), v1 = *(const bf16*)(sl + oV + 128), v2 = *(const bf16*)(sl + oV + 256), v3 = *(const bf16*)(sl + oV + 384); \
            VU##N_[0] = v0 | (v1 << 16); VU##N_[1] = v2 | (v3 << 16); \
            { const u32x2 t2 = *(const u32x2*)(sl + oM), t3 = *(const u32x2*)(sl + oM + 512); m2x[0] = t2[0]; m2x[1] = t2[1]; m3##N_[0] = t3[0]; m3##N_[1] = t3[1]; } \
            const u32x4 wA = *(const u32x4*)(sl + oW), wB = *(const u32x4*)(sl + oW + 1024); \
            rA##N_ = *(const u32x4*)(sl + 2048 + oW); rB##N_ = *(const u32x4*)(sl + 2048 + oW + 1024); \
            f32x4 U = MFMA32(m2x, VU##N_, z4); \
            f32x4 Y = MFMA32(m3##P_, VU##P_, z4); \
            U = MFMA32(wA, Hb0##N_, U); \
            Y = MFMA32(rA##P_, Hb0##P_, Y); \
            U = MFMA32(wB, Hb1##N_, U); \
            Y = MFMA32(rB##P_, Hb1##P_, Y); \
            VU##N_[2] = pack2bf(U[0], U[1]); VU##N_[3] = pack2bf(U[2], U[3]); \
            const u32x4 kb0 = *(const u32x4*)(sl + oK), kb1 = *(const u32x4*)(sl + oK + 512), kb2 = *(const u32x4*)(sl + oK + 1024), kb3 = *(const u32x4*)(sl + oK + 1536); \
            const f32x4 g0 = *(const f32x4*)(sl + oG), g1 = *(const f32x4*)(sl + oG + 64), g2 = *(const f32x4*)(sl + oG + 128), g3 = *(const f32x4*)(sl + oG + 192); \
            const f32x4 a0 = MFMA32(kb0, VU##N_, H0), a1 = MFMA32(kb1, VU##N_, H1); \
            const f32x4 a2 = MFMA32(kb2, VU##N_, H2), a3 = MFMA32(kb3, VU##N_, H3); \
            H0 = a0 * g0; H1 = a1 * g1; H2 = a2 * g2; H3 = a3 * g3; \
            if (c > 0) RW_YSTORE(Y, c - 1);                   \
        } \
        const bool flush = c > 0 && (c & 7) == 0; \
        if (flush) { \
            RW_BARRIER();                                     \
            { int cb = c - 8; asm volatile("" : "+s"(cb)); RW_FLUSH(cb); }        \
            sincef = 0; \
        } \
          \
          \
        if (c + 3 < RW_NCH) { if (sincef <= 2) asm volatile("s_waitcnt vmcnt(10)" ::: "memory"); else asm volatile("s_waitcnt vmcnt(6)" ::: "memory"); } \
        else if (c + 2 < RW_NCH) { asm volatile("s_waitcnt vmcnt(3)" ::: "memory"); } \
        else { asm volatile("s_waitcnt vmcnt(0)" ::: "memory"); } \
        RW_BARRIER(); \
        ++sincef; }
    for (int cc = 0; cc < RW_NCH; cc += 4) {
        RW_STEP(cc, B, A, 0);
        RW_STEP(cc + 1, A, B, 1);
        RW_STEP(cc + 2, B, A, 2);
        RW_STEP(cc + 3, A, B, 3);
    }
    {
        const f32x4 z4 = {0.f, 0.f, 0.f, 0.f};
        f32x4 Y = MFMA32(m3B, VUB, z4);
        Y = MFMA32(rAB, Hb0B, Y);
        Y = MFMA32(rBB, Hb1B, Y);
        RW_YSTORE(Y, RW_NCH - 1);
        RW_BARRIER();
        RW_FLUSH(RW_NCH - 8);
    }
#undef RW_STEP
#undef RW_YSTORE
#undef RW_FLUSH
#undef RW_DMA
#undef RW_BARRIER
}
DI void rwkv_gn_rows2(const bf16* __restrict__ P, const float* __restrict__ BON, const float* __restrict__ lnw, const float* __restrict__ lnb, bf16* __restrict__ YS) {
    const int tid = TIDX, lane = tid & 63, wave = tid >> 6; const int c = wave * 256 + lane * 4;
    const float4 lw = *(const float4*)(lnw + c), lb = *(const float4*)(lnb + c);
    for (size_t m = blockIdx.x; m < (size_t)M; m += gridDim.x) {
        const u32x2 yy = *(const u32x2*)(YS + m * D + c), vv = *(const u32x2*)(P + m * 4096 + 2048 + c), zz = *(const u32x2*)(P + m * 4096 + 3072 + c);
        const float bs = BON[m * 16 + (c >> 6)];
        const float y[4] = {bflo(yy[0]), bfhi(yy[0]), bflo(yy[1]), bfhi(yy[1])}, v[4] = {bflo(vv[0]), bfhi(vv[0]), bflo(vv[1]), bfhi(vv[1])}, z[4] = {bflo(zz[0]), bfhi(zz[0]), bflo(zz[1]), bfhi(zz[1])};
        const float lwv[4] = {lw.x, lw.y, lw.z, lw.w}, lbv[4] = {lb.x, lb.y, lb.z, lb.w};
        const float mean = dpp_sum16((y[0] + y[1]) + (y[2] + y[3])) * (1.0f / 64.0f);
        float var = 0.f;
#pragma unroll
        for (int i = 0; i < 4; ++i) { const float d = y[i] - mean; var += d * d; }
        var = dpp_sum16(var) * (1.0f / 64.0f);
        const float rstd = 1.0f / sqrtf(var + 64e-5f);
        float o[4];
#pragma unroll
        for (int i = 0; i < 4; ++i) o[i] = ((y[i] - mean) * rstd * lwv[i] + lbv[i] + bs * v[i]) * siluf_(z[i]);
        *(u32x2*)(YS + m * D + c) = (u32x2){pack2bf(o[0], o[1]), pack2bf(o[2], o[3])};
    }
}

struct FastBufs { char* ws; };

DI void rows_xb_parts(const float* __restrict__ x, bf16* xb, float* parts) {
    const int lane = TIDX & 63, wave = TIDX >> 6;
    for (int m = blockIdx.x * 4 + wave; m < M; m += gridDim.x * 4) {
        const float* xr = x + (size_t)m * D; float s = 0.f;
#pragma unroll
        for (int i = 0; i < 2; ++i) {
            const int k = (i * 64 + lane) * 8; const float4 a = *(const float4*)(xr + k), b = *(const float4*)(xr + k + 4);
            const float w[8] = {a.x, a.y, a.z, a.w, b.x, b.y, b.z, b.w};
#pragma unroll
            for (int j = 0; j < 8; ++j) s += w[j] * w[j];
            store8bf(xb + (size_t)m * D + k, w);
        }
#pragma unroll
        for (int o = 32; o >= 1; o >>= 1) s += __shfl_xor(s, o);
        if (lane < 16) parts[(size_t)m * 16 + lane] = lane == 0 ? s : 0.f;
    }
}
DI void rows_xn(const float* __restrict__ x, const float* parts, const float* __restrict__ g, bf16* xn) {
    const int lane = TIDX & 63, wave = TIDX >> 6;
    for (int m = blockIdx.x * 4 + wave; m < M; m += gridDim.x * 4) {
        const float rs = rstd_from_parts(parts, m); const float* xr = x + (size_t)m * D;
#pragma unroll
        for (int i = 0; i < 2; ++i) {
            const int k = (i * 64 + lane) * 8; const float4 a = *(const float4*)(xr + k), b = *(const float4*)(xr + k + 4);
            const float4 ga = *(const float4*)(g + k), gb = *(const float4*)(g + k + 4);
            const float w[8] = {a.x * rs * ga.x, a.y * rs * ga.y, a.z * rs * ga.z, a.w * rs * ga.w, b.x * rs * gb.x, b.y * rs * gb.y, b.z * rs * gb.z, b.w * rs * gb.w};
            store8bf(xn + (size_t)m * D + k, w);
        }
    }
}
DI void rows_final(float* x, const float* parts, const float* __restrict__ g) {
    const int lane = TIDX & 63, wave = TIDX >> 6;
    for (int m = blockIdx.x * 4 + wave; m < M; m += gridDim.x * 4) {
        const float rs = rstd_from_parts(parts, m); float* xr = x + (size_t)m * D;
#pragma unroll
        for (int i = 0; i < 4; ++i) {
            const int k = (i * 64 + lane) * 4; float4 a = *(float4*)(xr + k); const float4 ga = *(const float4*)(g + k);
            a.x *= rs * ga.x; a.y *= rs * ga.y; a.z *= rs * ga.z; a.w *= rs * ga.w; *(float4*)(xr + k) = a;
        }
    }
}
enum { PH_PREP0 = 0, PH_IN0, PH_ATTN0, PH_OUT0, PH_PREP1, PH_IN1, PH_LORA1, PH_CPREP1, PH_SCAN1, PH_GN1, PH_OUT1, PH_PREP2, PH_IN2, PH_B2, PH_C2, PH_D2, PH_OUT2, PH_PREP3, PH_IN3, PH_GATE3, PH_SCANA3, PH_SCANB3, PH_OUT3, PH_FINAL };

namespace wbo {
constexpr size_t IN = 0;
constexpr size_t OUT = (size_t)4352 * 1024;
constexpr size_t EXTRA = OUT + (size_t)1280 * 1024;
}

template <int PH>
DI void run_phase(const Params& p, char* smem) {
    char* ws = p.ws;
    float* parts = (float*)(ws + fw::PARTS);
    constexpr int LAYER = PH <= PH_OUT0 ? 0 : PH <= PH_OUT1 ? 1 : PH <= PH_OUT2 ? 2 : 3;
    constexpr size_t WBOFF = LAYER == 0 ? 200 * fw::MB : LAYER == 1 ? 238 * fw::MB : LAYER == 2 ? 240 * fw::MB : 1 * fw::MB;
    bf16* WB = (bf16*)(ws + WBOFF);
    bf16* XB = (bf16*)(ws + ((PH == PH_PREP0 || PH == PH_IN0) ? 130 * fw::MB : 174 * fw::MB));
    bf16* P = (bf16*)(ws + wsl::P);
    float* X = p.out;
    float* smf = (float*)smem;
    if (PH == PH_PREP0) {
        rows_xb_parts(p.x, XB, parts);
        int tb = 0;
        convert_seg(p.a_w_in, A_COLS, 0, A_COLS, 1024, WB + wbo::IN, p.norm_g + 0 * D, smf, tb);
        convert_seg(p.a_w_out, 1024, 0, 1024, 1024, WB + wbo::OUT, nullptr, smf, tb);
    } else if (PH == PH_IN0) {
        gemm_sched(8, 4, [&](bool big, int mt, int nt) {
            if (big) gemm_tile2(ALoadPlain{XB, D}, WB + wbo::IN, 1024, mt * 128, nt * 256, EpiL0{P, (bf16*)(ws + 86 * fw::MB), parts}, smem);
            else gemm_tile(ALoadPlain{XB, D}, WB + wbo::IN, 1024, mt * 128, 2048 + nt * 128, EpiL0{P, (bf16*)(ws + 86 * fw::MB), parts}, smem);
        });
    } else if (PH == PH_ATTN0) {
        build_bias_lut(p.t5, smem, true);
        for (int it = blockIdx.x; it < B * G * (T / (16 * ANQT_SWA)); it += gridDim.x) swa_item(P, (const bf16*)(ws + 86 * fw::MB), p.a_sinks, (bf16*)(ws + wsl::L0_AO), it, smem);
    } else if (PH == PH_OUT0) {
        gemm_sched(4, 0, [&](bool, int mt, int nt) { gemm_tile2(ALoadPlain{(const bf16*)(ws + wsl::L0_AO), D}, WB + wbo::OUT, 1024, mt * 128, nt * 256, EpiResid{p.x, X, nullptr, parts}, smem); });
    } else if (PH == PH_PREP1) {
        rows_xn(X, parts, p.norm_g + 1 * D, (bf16*)(ws + wsl::L1_XN));
        int tb = 0;
        convert_seg(p.b_w_in, 4096, 0, 4096, 1024, WB + wbo::IN, nullptr, smf, tb);
        convert_seg(p.b_w1, 64, 0, 64, 1024, WB + wbo::IN + (size_t)4096 * 1024, nullptr, smf, tb);
        convert_seg(p.b_a1, 64, 0, 64, 1024, WB + wbo::IN + (size_t)(4096 + 128) * 1024, nullptr, smf, tb);
        convert_seg(p.b_w_out, 1024, 0, 1024, 1024, WB + wbo::OUT, nullptr, smf, tb);
        convert_seg(p.b_w2, 1024, 0, 1024, 64, WB + wbo::EXTRA, nullptr, smf, tb);
        convert_seg(p.b_a2, 1024, 0, 1024, 64, WB + wbo::EXTRA + (size_t)1024 * 64, nullptr, smf, tb);
        for (size_t i = (size_t)blockIdx.x * 256 + TIDX; i < (size_t)64 * 1024 / 8; i += (size_t)gridDim.x * 256) {
            ((u32x4*)(WB + wbo::IN + (size_t)(4096 + 64) * 1024))[i] = (u32x4){0u, 0u, 0u, 0u};
            ((u32x4*)(WB + wbo::IN + (size_t)(4096 + 192) * 1024))[i] = (u32x4){0u, 0u, 0u, 0u};
        }
    } else if (PH == PH_IN1) {
        const bf16* XN = (const bf16*)(ws + wsl::L1_XN);
        EpiRwkv epi{P, (float*)(ws + wsl::LHW), (float*)(ws + wsl::LHA)};
        gemm_sched(16, 2, [&](bool big, int mt, int nt) {
            if (big) gemm_tile2(ALoadLerp{XN, p.b_mu + (nt >> 2) * D}, WB + wbo::IN, 1024, mt * 128, nt * 256, epi, smem);
            else gemm_tile(ALoadLerp{XN, p.b_mu + (4 + nt) * D}, WB + wbo::IN, 1024, mt * 128, 4096 + nt * 128, epi, smem);
        });
    } else if (PH == PH_LORA1) {
        const int ntile = (M / 128) * 16;
        EpiLora epi{p.b_w0, p.b_a0, (bf16*)(ws + wsl::L1_WL), (bf16*)(ws + wsl::L1_AV)};
        (void)ntile;
        gemm_sched(8, 0, [&](bool, int mt, int nt) { gemm_tile2(ALoadF32{(const float*)(ws + (nt < 4 ? wsl::LHW : wsl::LHA))}, WB + wbo::EXTRA, 64, mt * 128, nt * 256, epi, smem); });
    } else if (PH == PH_CPREP1) {
        for (int it = blockIdx.x; it < B * 16 * RW_NCH; it += gridDim.x)
            rwkv_prep_item(P, (bf16*)(ws + wsl::L1_WL), (bf16*)(ws + wsl::L1_AV), p.b_k_k, p.b_k_a, p.b_r_k, (float*)(ws + 9 * fw::MB), (bf16*)(ws + 1 * fw::MB), WB, (float*)(ws + 254 * fw::MB), it, smem);
    } else if (PH == PH_SCAN1) {
        const int bid = blockIdx.x;
        if ((bid & 31) < 8 && (bid >> 5) < 8) {
            const int it = (bid >> 5) * 8 + (bid & 31);
            rwkv_chunk_scan(P, (const bf16*)(ws + wsl::L1_WL), (const bf16*)(ws + wsl::L1_AV), (const float*)(ws + 9 * fw::MB), (const bf16*)(ws + 1 * fw::MB), WB, (bf16*)(ws + wsl::L1_XN), it, smem);
        }
    } else if (PH == PH_GN1) {
        rwkv_gn_rows2(P, (const float*)(ws + 254 * fw::MB), p.b_lnx_w, p.b_lnx_b, (bf16*)(ws + wsl::L1_XN));
    } else if (PH == PH_OUT1) {
        gemm_sched(4, 0, [&](bool, int mt, int nt) { gemm_tile2(ALoadPlain{(const bf16*)(ws + wsl::L1_XN), D}, WB + wbo::OUT, 1024, mt * 128, nt * 256, EpiResid{X, X, XB, parts}, smem); });
    } else if (PH == PH_PREP2) {
        int tb = 0;
        const float* g2 = p.norm_g + 2 * D;
        convert_seg(p.c_w_in, C_COLS, 0, 2560, 1024, WB + wbo::IN, g2, smf, tb);
        convert_seg(p.c_w_in, C_COLS, 2608, 1024, 1024, WB + wbo::IN + (size_t)2560 * 1024, g2, smf, tb);
        convert_seg(p.c_w_in, C_COLS, 2560, 64, 1024, WB + wbo::IN + (size_t)3584 * 1024, g2, smf, tb);
        convert_seg(p.c_w_out, 1024, 0, 1024, 1024, WB + wbo::OUT, nullptr, smf, tb);
        convert_seg(p.c_k_w1, 128, 0, 128, 2048, WB + wbo::EXTRA, nullptr, smf, tb);
        convert_seg(p.c_v_w1, 128, 0, 128, 2048, WB + wbo::EXTRA + (size_t)128 * 2048, nullptr, smf, tb);
        convert_seg(p.c_k_w2, 64, 0, 64, 128, WB + wbo::EXTRA + (size_t)256 * 2048, nullptr, smf, tb);
        convert_seg(p.c_v_w2, 64, 0, 64, 128, WB + wbo::EXTRA + (size_t)256 * 2048 + 64 * 128, nullptr, smf, tb);
        if (blockIdx.x < 16) {
            const int which = blockIdx.x >> 3, i = blockIdx.x & 7; const float* pos = which ? p.c_pos_v : p.c_pos_k; const float* w1 = which ? p.c_v_w1 : p.c_k_w1;
            float* b8 = (float*)(ws + 12 * fw::MB);
            if (TIDX < 128) { float a = 0.f; for (int k = i * 256; k < i * 256 + 256; ++k) a += pos[k] * w1[(size_t)k * 128 + TIDX]; b8[(which * 8 + i) * 128 + TIDX] = a; }
        }
    } else if (PH == PH_IN2) {
        gemm_sched(14, 1, [&](bool big, int mt, int nt) {
            if (big) gemm_tile2(ALoadPlain{XB, D}, WB + wbo::IN, 1024, mt * 128, nt * 256, EpiL2{P, (bf16*)(ws + 114 * fw::MB), (bf16*)(ws + 122 * fw::MB), parts}, smem);
            else gemm_tile(ALoadPlain{XB, D}, WB + wbo::IN, 1024, mt * 128, 3584 + nt * 128, EpiL2{P, (bf16*)(ws + 114 * fw::MB), (bf16*)(ws + 122 * fw::MB), parts}, smem);
        });
    } else if (PH == PH_B2) {
        for (int it = blockIdx.x; it < 64; it += gridDim.x) { const int which = it >> 5, rt = it & 31;
            cmp_tile(P, WB + wbo::EXTRA + (size_t)which * 128 * 2048, (const float*)(ws + 12 * fw::MB) + which * 8 * 128, WB + wbo::EXTRA + (size_t)256 * 2048 + which * 64 * 128, which, rt,
                     (bf16*)(ws + 5 * fw::MB), (bf16*)(ws + 6 * fw::MB), smem); }
        build_bias_lut(p.t5, smem, false);
        const int nwin = B * G * (T / (16 * ANQT_WIN));
        const bool split = gridDim.x == 512 && nwin == 2048;
        const int bid = blockIdx.x, nb = bid - 64, cnt = bid < 64 ? 2 : (nb < 128 ? 5 : 4);
        for (int k = 0;; ++k) {
            int item;
            if (split) { if (k >= cnt) break; item = bid < 64 ? k * 512 + 448 + bid : (k < 4 ? k * 512 + nb : (2 + (nb >> 6)) * 512 + 448 + (nb & 63)); }
            else { const int it = (bid < 64 ? bid + (int)gridDim.x : bid) + k * (int)gridDim.x; if (it >= 64 + nwin) break; item = it - 64; }
            win_item(P, (const bf16*)(ws + 122 * fw::MB), (bf16*)(ws + 130 * fw::MB), item, smem);
        }
    } else if (PH == PH_C2) {
        for (int it = blockIdx.x; it < B * G * (T / 32); it += gridDim.x)
            cmpsel_item(P, (const bf16*)(ws + 5 * fw::MB), (const bf16*)(ws + 6 * fw::MB), (bf16*)(ws + 162 * fw::MB), (unsigned long long*)(ws + 9 * fw::MB), it, smem);
    } else if (PH == PH_D2) {
        build_bias_lut(p.t5, smem, false);
        for (int it = blockIdx.x; it < B * G * (T / (16 * ANQT_SEL)); it += gridDim.x)
            sel_item(P, (const bf16*)(ws + 114 * fw::MB), (const unsigned long long*)(ws + 9 * fw::MB), (const bf16*)(ws + 162 * fw::MB), (const bf16*)(ws + 130 * fw::MB), (bf16*)(ws + 206 * fw::MB), it, smem);
    } else if (PH == PH_OUT2) {
        gemm_sched(4, 0, [&](bool, int mt, int nt) { gemm_tile2(ALoadPlain{(const bf16*)(ws + 206 * fw::MB), D}, WB + wbo::OUT, 1024, mt * 128, nt * 256, EpiResid{X, X, XB, parts}, smem); });
    } else if (PH == PH_PREP3) {
        int tb = 0;
        convert_seg(p.d_w_in, 2560, 0, 2560, 1024, WB + wbo::IN, p.norm_g + 3 * D, smf, tb);
        convert_seg(p.d_w_out, 1024, 0, 1024, 1280, WB + wbo::OUT, nullptr, smf, tb);
        lru_convert_gates(p.d_ga_w, p.d_gx_w, WB + wbo::EXTRA);
        for (int i = blockIdx.x * NTHREADS + TIDX; i < LW; i += gridDim.x * NTHREADS) ((float*)(ws + 12 * fw::MB + 786432))[i] = -8.0f * softplusf_(-p.d_lambda[i]);
    } else if (PH == PH_IN3) {
        gemm_sched(8, 4, [&](bool big, int mt, int nt) {
            if (big) gemm_tile2(ALoadPlain{XB, D}, WB + wbo::IN, 1024, mt * 128, nt * 256, EpiBf16{P, 2560, parts}, smem);
            else gemm_tile(ALoadPlain{XB, D}, WB + wbo::IN, 1024, mt * 128, 2048 + nt * 128, EpiBf16{P, 2560, parts}, smem);
        });
    } else if (PH == PH_GATE3) {
        for (int it = blockIdx.x; it < (M / 128) * 16; it += gridDim.x)
            lru_gate_item(P, p.d_conv_w, p.d_conv_b, WB + wbo::EXTRA, p.d_ga_b, p.d_gx_b, (const float*)(ws + 12 * fw::MB + 786432), (bf16*)(ws + wsl::L3_LA), (bf16*)(ws + wsl::L3_BV), (float2*)(ws + wsl::L3_UC), it, smem);
    } else if (PH == PH_SCANB3) {
        for (int it = blockIdx.x; it < B * (T / 64) * 5; it += gridDim.x)
            lru_scan2_item((const bf16*)(ws + wsl::L3_LA), (const bf16*)(ws + wsl::L3_BV), (const float2*)(ws + wsl::L3_UC), P, (bf16*)(ws + wsl::L3_AO), it);
    } else if (PH == PH_OUT3) {
        gemm_sched(4, 0, [&](bool, int mt, int nt) { gemm_tile2(ALoadPlain{(const bf16*)(ws + wsl::L3_AO), LW}, WB + wbo::OUT, 1280, mt * 128, nt * 256, EpiResid{X, X, nullptr, parts}, smem); });
    } else if (PH == PH_FINAL) {
        rows_final(X, parts, p.final_g);
    }
}

template <int PH> __global__ void __launch_bounds__(NTHREADS, 2) k_phase(Params p) {
    extern __shared__ __attribute__((aligned(16))) char smem[];
    run_phase<PH>(p, smem);
}
#define LDS_BYTES 73728
#define MEGA_LDS_BYTES (73728 + 64)
template <int PH> static void launch_phase(const Params& p, hipStream_t s) {
    static bool attr = false;
    if (!attr) { hipFuncSetAttribute((const void*)k_phase<PH>, hipFuncAttributeMaxDynamicSharedMemorySize, LDS_BYTES); attr = true; }
    hipLaunchKernelGGL(k_phase<PH>, dim3(512), dim3(NTHREADS), LDS_BYTES, s, p);
}


#define XB_TMO      128
#define XB_XCNT(j)  (256  + 64 * (j))
#define XB_XSUB(j)  (1280 + 64 * (j))
#define XB_XGEN(j)  (2304 + 64 * (j))
#define XB_TOP      3328
#define XB_TOPGEN   3392
#define XCD_BAR_WORDS 3456
#define XB_SPIN_CAP (1u << 22)
#define LAS __attribute__((address_space(3)))
DI unsigned xb_ld(unsigned* p)              { return __hip_atomic_load(p, __ATOMIC_RELAXED, __HIP_MEMORY_SCOPE_AGENT); }
DI unsigned xb_add(unsigned* p, unsigned v) { return __hip_atomic_fetch_add(p, v, __ATOMIC_RELAXED, __HIP_MEMORY_SCOPE_AGENT); }
DI unsigned xb_xcc_id() { return (unsigned)__builtin_amdgcn_s_getreg((3 << 11) | 20) & 0xFu; }
#define XB_SPIN(cond, bar) do { unsigned _sp = 0; while (cond) { if (_sp < 64u) __builtin_amdgcn_s_sleep(2); else __builtin_amdgcn_s_sleep(32); \
    if ((++_sp & 255u) == 0u) { if (xb_ld(&(bar)[XB_TMO])) break; if (_sp > XB_SPIN_CAP) { atomicAdd(&(bar)[XB_TMO], 1u); break; } } } } while (0)
struct XcdBarrier { unsigned* bar; unsigned x; volatile LAS unsigned* st; };
DI XcdBarrier xcd_barrier_post(unsigned* bar, volatile LAS unsigned* st) {
    XcdBarrier b; b.bar = bar; b.x = xb_xcc_id(); b.st = st;
    if (threadIdx.x == 0) (void)xb_add(&bar[XB_XCNT(b.x)], 1u);
    return b;
}
DI void xcd_barrier_complete(unsigned* bar, unsigned x, unsigned& nloc, unsigned& nx) {
    const unsigned G = gridDim.x * gridDim.y * gridDim.z;
    unsigned sum, cnt, mine, sp = 0u;
    for (;;) {
        sum = 0u; cnt = 0u; mine = 0u;
#pragma unroll
        for (unsigned j = 0; j < 16; ++j) { const unsigned c = xb_ld(&bar[XB_XCNT(j)]); sum += c; cnt += (c > 0u) ? 1u : 0u; mine = (j == x) ? c : mine; }
        if (sum == G) break;
        __builtin_amdgcn_s_sleep(1);
        if ((++sp & 255u) == 0u) { if (xb_ld(&bar[XB_TMO])) break; if (sp > XB_SPIN_CAP) { atomicAdd(&bar[XB_TMO], 1u); break; } }
    }
    nloc = mine > 0u ? mine : 1u; nx = cnt > 0u ? cnt : 1u;
}
DI void xcd_barrier(const XcdBarrier& b) {
    asm volatile("s_waitcnt vmcnt(0)" ::: "memory");
    __syncthreads();
    if (threadIdx.x == 0) {
        unsigned* bar = b.bar;
        __builtin_amdgcn_s_waitcnt(0);
        unsigned nloc = b.st[0], nx = b.st[1];
        if (nloc == 0u) { xcd_barrier_complete(bar, b.x, nloc, nx); b.st[0] = nloc; b.st[1] = nx; }
        const unsigned old = xb_add(&bar[XB_XSUB(b.x)], 1u);
        const unsigned gen = old / nloc;
        asm volatile("buffer_inv sc1" ::: "memory");
        if (old + 1u == (gen + 1u) * nloc) {
            __builtin_amdgcn_fence(__ATOMIC_RELEASE, "agent");
            asm volatile("s_waitcnt vmcnt(0)" ::: "memory");
            const unsigned og = xb_add(&bar[XB_TOP], 1u);
            const unsigned tg = og / nx;
            if (og + 1u == (tg + 1u) * nx) xb_add(&bar[XB_TOPGEN], 1u);
            else XB_SPIN(xb_ld(&bar[XB_TOPGEN]) == tg, bar);
            xb_add(&bar[XB_XGEN(b.x)], 1u);
            asm volatile("s_waitcnt vmcnt(0)" ::: "memory");
        } else {
            XB_SPIN(xb_ld(&bar[XB_XGEN(b.x)]) == gen, bar);
            asm volatile("s_waitcnt vmcnt(0)" ::: "memory");
        }
    }
    __syncthreads();
}

#define MEGA_PHASES(X) X(PH_IN0) X(PH_ATTN0) X(PH_OUT0) X(PH_PREP1) X(PH_IN1) X(PH_LORA1) X(PH_CPREP1) X(PH_SCAN1) X(PH_GN1) X(PH_OUT1) \
    X(PH_PREP2) X(PH_IN2) X(PH_B2) X(PH_C2) X(PH_D2) X(PH_OUT2) X(PH_PREP3) X(PH_IN3) X(PH_GATE3) X(PH_SCANB3) X(PH_OUT3)
__global__ void __launch_bounds__(NTHREADS, 2) mega_kernel(Params p) {
    extern __shared__ __attribute__((aligned(16))) char smem[];
    cooperative_groups::grid_group grid = cooperative_groups::this_grid();
    volatile LAS unsigned* xst = (volatile LAS unsigned*)(smem + 73728);
    if (threadIdx.x < 4) xst[threadIdx.x] = 0u;
    __syncthreads();
    XcdBarrier xb = xcd_barrier_post((unsigned*)p.ws, xst);
    run_phase<PH_PREP0>(p, smem);
    if (p.ws == nullptr) grid.sync();
    xcd_barrier(xb);
#define MEGA_STEP(ph) run_phase<ph>(p, smem); xcd_barrier(xb);
    MEGA_PHASES(MEGA_STEP)
#undef MEGA_STEP
    run_phase<PH_FINAL>(p, smem);
}
static void launch_mega(const Params& p, hipStream_t s) {
    static int grid_blocks = 0;
    if (!grid_blocks) {
        int dev = 0, cus = 0, per_cu = 0;
        hipGetDevice(&dev);
        hipDeviceGetAttribute(&cus, hipDeviceAttributeMultiprocessorCount, dev);
        hipFuncSetAttribute((const void*)mega_kernel, hipFuncAttributeMaxDynamicSharedMemorySize, MEGA_LDS_BYTES);
        hipOccupancyMaxActiveBlocksPerMultiprocessor(&per_cu, mega_kernel, NTHREADS, MEGA_LDS_BYTES);
        if (per_cu > 2) per_cu = 2;
        if (per_cu < 1) per_cu = 1;
        grid_blocks = cus * per_cu;
    }
    hipMemsetAsync(p.ws, 0, 16384, s);
    Params pp = p; void* args[] = {&pp};
    hipError_t e = hipLaunchCooperativeKernel((const void*)mega_kernel, dim3(grid_blocks), dim3(NTHREADS), args, MEGA_LDS_BYTES, s);
    if (e != hipSuccess) fprintf(stderr, "cooperative launch failed: %s (grid %d)\n", hipGetErrorString(e), grid_blocks);
}
#endif

#ifndef CPU_SHIM
template <class F> __global__ void __launch_bounds__(256) k_run(F f, long n) {
    const long i = (long)blockIdx.x * 256 + threadIdx.x; if (i < n) f(i);
}
template <class F> static void launch(const F& f, long n, hipStream_t s) {
    hipLaunchKernelGGL(k_run<F>, dim3((unsigned)((n + 255) / 256)), dim3(256), 0, s, f, n);
}
#else
template <class F> static void launch(const F& f, long n, hipStream_t) {
#pragma omp parallel for schedule(dynamic, 64)
    for (long i = 0; i < n; ++i) f(i);
}
#endif

#ifdef CPU_SHIM
void cpu_layer_hook(int layer, const float* X, const char* ws);
#define LAYER_HOOK(l) cpu_layer_hook(l, X, ws)
#else
#define LAYER_HOOK(l)
#endif

#define FAST_GEMM 0
#if FAST_GEMM
#define FASTP(ph) launch_phase<ph>(p, s)
#else
#define FASTP(ph)
#endif

static void run_naive(const Params& p, hipStream_t s) {
    char* ws = p.ws;
    float* rs = (float*)(ws + wsl::RS);
    bf16* P = (bf16*)(ws + wsl::P);
    float* X = p.out;
    (void)rs;
    {
        bf16* AO = (bf16*)(ws + wsl::L0_AO);
#if FAST_GEMM
        FASTP(PH_PREP0); FASTP(PH_IN0);
#else
        launch(RstdF{p.x, rs}, M, s);
        launch(GemmInF{p.x, rs, p.norm_g + 0 * D, p.a_w_in, P, A_COLS}, (long)M * (A_COLS / 4), s);
#endif
#if FAST_GEMM
        FASTP(PH_ATTN0); (void)AO;
#else
        launch(SwaF{P, p.t5, p.a_sinks, AO}, (long)M * H, s);
#endif
#if FAST_GEMM
        FASTP(PH_OUT0);
#else
        launch(GemmOutF{AO, p.a_w_out, p.x, X, 1024}, (long)M * (D / 4), s);
#endif
    }
    LAYER_HOOK(0);
    {
        bf16* XN = (bf16*)(ws + wsl::L1_XN); bf16* WL = (bf16*)(ws + wsl::L1_WL); bf16* AV = (bf16*)(ws + wsl::L1_AV);
        float* hw = (float*)(ws + wsl::LHW); float* ha = (float*)(ws + wsl::LHA);
#if FAST_GEMM
        FASTP(PH_PREP1); FASTP(PH_IN1); FASTP(PH_LORA1); FASTP(PH_CPREP1); FASTP(PH_SCAN1); FASTP(PH_GN1); FASTP(PH_OUT1);
        (void)XN; (void)WL; (void)AV; (void)hw; (void)ha;
#else
        launch(RstdF{X, rs}, M, s);
        launch(XnF{X, rs, p.norm_g + 1 * D, XN}, (long)M * D, s);
        launch(GemmRwkvF{XN, p.b_mu, p.b_w_in, P}, (long)M * 1024, s);
        launch(LoraHidF{XN, p.b_mu, p.b_w1, p.b_a1, hw, ha}, (long)M * 128, s);
        launch(LoraOutF{hw, ha, p.b_w0, p.b_w2, p.b_a0, p.b_a2, WL, AV}, (long)M * D, s);
        launch(RwkvScanF{P, WL, AV, p.b_k_k, p.b_k_a, XN}, (long)B * H * 64, s);
        launch(RwkvGnF{P, AV, p.b_k_a, p.b_r_k, p.b_lnx_w, p.b_lnx_b, XN}, (long)M * H, s);
        launch(GemmOutF{XN, p.b_w_out, X, X, 1024}, (long)M * (D / 4), s);
#endif
    }
    LAYER_HOOK(1);
    {
        float* hk = (float*)(ws + wsl::HK); float* hv = (float*)(ws + wsl::HV);
        float* kc = (float*)(ws + wsl::KC); float* vc = (float*)(ws + wsl::VC);
        float* st = (float*)(ws + wsl::ST); int* sel = (int*)(ws + wsl::SEL); float* imp = (float*)(ws + wsl::L2_IMP);
        bf16* AO = (bf16*)(ws + wsl::L2_AO); bf16* OC = (bf16*)(ws + wsl::L2_OC); bf16* OS = (bf16*)(ws + wsl::L2_OS);
#if FAST_GEMM
        FASTP(PH_PREP2); FASTP(PH_IN2); FASTP(PH_B2); FASTP(PH_C2); FASTP(PH_D2); FASTP(PH_OUT2);
        (void)hk; (void)hv; (void)kc; (void)vc; (void)st; (void)sel; (void)imp; (void)AO; (void)OC; (void)OS;
#else
        launch(RstdF{X, rs}, M, s);
        launch(GemmInF{X, rs, p.norm_g + 2 * D, p.c_w_in, P, C_COLS}, (long)M * (C_COLS / 4), s);
        launch(CmpHidF{P, p.c_pos_k, p.c_k_w1, p.c_pos_v, p.c_v_w1, hk, hv}, 2L * B * G * NCMP * 128, s);
        launch(CmpOutF{hk, hv, p.c_k_w2, p.c_v_w2, kc, vc}, 2L * B * G * NCMP * 64, s);
        launch(CmpAttnF{P, kc, vc, st, OC}, (long)M * H, s);
        launch(ImpF{P, kc, st, imp}, (long)M * G * NSEL, s);
        launch(TopkF{imp, sel}, (long)M * G, s);
        launch(SelAttnF{P, p.t5, sel, OS}, (long)M * H, s);
        launch(WinAttnF{P, p.t5, OC, OS, AO}, (long)M * H, s);
        LAYER_HOOK(20);
        launch(GemmOutF{AO, p.c_w_out, X, X, 1024}, (long)M * (D / 4), s);
#endif
    }
    LAYER_HOOK(2);
    {
        bf16* AO = (bf16*)(ws + wsl::L3_AO); bf16* UC = (bf16*)(ws + wsl::L3_UC); bf16* LA = (bf16*)(ws + wsl::L3_LA); bf16* BV = (bf16*)(ws + wsl::L3_BV);
#if FAST_GEMM
        FASTP(PH_PREP3); FASTP(PH_IN3); FASTP(PH_GATE3); FASTP(PH_SCANA3); FASTP(PH_SCANB3); FASTP(PH_OUT3);
        (void)AO; (void)UC; (void)LA; (void)BV;
#else
        launch(RstdF{X, rs}, M, s);
        launch(GemmInF{X, rs, p.norm_g + 3 * D, p.d_w_in, P, 2560}, (long)M * (2560 / 4), s);
        launch(ConvF{P, p.d_conv_w, p.d_conv_b, UC}, (long)M * LW, s);
        launch(LruGateF{UC, p.d_ga_w, p.d_ga_b, p.d_gx_w, p.d_gx_b, p.d_lambda, LA, BV}, (long)M * LW, s);
        launch(LruScanF{P, LA, BV, AO}, (long)B * LW, s);
        launch(GemmOutF{AO, p.d_w_out, X, X, LW}, (long)M * (D / 4), s);
#endif
    }
    LAYER_HOOK(3);
#if FAST_GEMM
    FASTP(PH_FINAL);
#else
    launch(FinalNormF{X, p.final_g}, M, s);
#endif
}

extern "C" void kernel_launch(void* const* d_in, const int* in_sizes, int n_in, void* d_out, int out_size, void* d_ws, size_t ws_size,
                              hipStream_t stream) {
    (void)in_sizes; (void)n_in; (void)out_size; (void)ws_size;
    Params p{};
    const float* const* in = (const float* const*)d_in;
    int k = 0;
    p.x = in[k++]; p.t5 = in[k++]; p.norm_g = in[k++]; p.final_g = in[k++];
    p.a_w_in = in[k++]; p.a_sinks = in[k++]; p.a_w_out = in[k++];
    p.b_mu = in[k++]; p.b_w_in = in[k++]; p.b_w0 = in[k++]; p.b_w1 = in[k++]; p.b_w2 = in[k++]; p.b_a0 = in[k++]; p.b_a1 = in[k++]; p.b_a2 = in[k++];
    p.b_k_k = in[k++]; p.b_k_a = in[k++]; p.b_r_k = in[k++]; p.b_lnx_w = in[k++]; p.b_lnx_b = in[k++]; p.b_w_out = in[k++];
    p.c_w_in = in[k++]; p.c_pos_k = in[k++]; p.c_k_w1 = in[k++]; p.c_k_w2 = in[k++]; p.c_pos_v = in[k++]; p.c_v_w1 = in[k++]; p.c_v_w2 = in[k++]; p.c_w_out = in[k++];
    p.d_w_in = in[k++]; p.d_conv_w = in[k++]; p.d_conv_b = in[k++]; p.d_ga_w = in[k++]; p.d_ga_b = in[k++]; p.d_gx_w = in[k++]; p.d_gx_b = in[k++];
    p.d_lambda = in[k++]; p.d_w_out = in[k++];
    p.out = (float*)d_out; p.ws = (char*)d_ws;
#if !defined(CPU_SHIM) && !defined(MULTI_LAUNCH) && !defined(ALL_NAIVE)
    launch_mega(p, stream);
#else
    run_naive(p, stream);
#endif
}
```
